# Optimizing an MI355X kernel written in HIP

```python
import numpy as np
import jax
import jax.numpy as jnp
from jax import lax

D_MODEL = 1024
BATCH = 4
SEQ = 8192
DEPTH = 2

HEAD_DIM = 64
NSA_HEADS = 8
NSA_KV_HEADS = 2
NSA_GROUP = NSA_HEADS // NSA_KV_HEADS
NSA_WIDTH = NSA_HEADS * HEAD_DIM
KV_WIDTH = NSA_KV_HEADS * HEAD_DIM
CMP_LEN = 32
CMP_STRIDE = 16
CMP_HIDDEN = 2 * HEAD_DIM
SEL_BLOCK = 64
N_SELECT = 16
WINDOW = 512
Q_BLOCK = 128
MASK_VALUE = -1e30
SEL_FORCE = 1e6
CONV_WIDTH = 256
CONV_K = 3
HGRN_HEADS = 4
HGRN_WIDTH = HGRN_HEADS * HEAD_DIM
HGRN_CHUNK = 64
LB_FLOOR = 1e-30
MIX_WIDTH = NSA_WIDTH + CONV_WIDTH + HGRN_WIDTH
ROPE_THETA = 10000.0
MEM_LEN = 256
CROSS_HEADS = 4
CROSS_WIDTH = CROSS_HEADS * HEAD_DIM
N_GROUPS = 4
EXPERTS_PER_GROUP = 8
N_EXPERTS = N_GROUPS * EXPERTS_PER_GROUP
EXPERT_TOP_K = 2
D_EXPERT = 512
RMS_EPS = 1e-6

IN_SIZES = (NSA_WIDTH, KV_WIDTH, KV_WIDTH, KV_WIDTH, KV_WIDTH, KV_WIDTH, KV_WIDTH, NSA_HEADS * 3,
            CONV_WIDTH, CONV_WIDTH, CONV_WIDTH, HGRN_WIDTH, HGRN_WIDTH, HGRN_WIDTH, HGRN_WIDTH)
IN_WIDTH = sum(IN_SIZES)
IN_OFFSETS = tuple(sum(IN_SIZES[:i + 1]) for i in range(len(IN_SIZES) - 1))

kernel_name = 'hymba_nsa_conv_hgrn2_hmoe'


def rmsnorm(x, g):
    x32 = x.astype(jnp.float32)
    y = x32 * lax.rsqrt(jnp.mean(x32 * x32, axis=-1, keepdims=True) + RMS_EPS)
    return (y * g.astype(jnp.float32)).astype(x.dtype)


def rope(x, pos):
    T = x.shape[1]
    half = x.shape[-1] // 2
    inv = ROPE_THETA ** (-jnp.arange(half, dtype=jnp.float32) / half)
    ang = pos.astype(jnp.float32)[:, None] * inv[None, :]
    bshape = (1, T) + (1,) * (x.ndim - 3) + (half,)
    cos = jnp.cos(ang).reshape(bshape)
    sin = jnp.sin(ang).reshape(bshape)
    x32 = x.astype(jnp.float32)
    x1, x2 = x32[..., :half], x32[..., half:]
    return jnp.concatenate([x1 * cos - x2 * sin, x2 * cos + x1 * sin], axis=-1).astype(x.dtype)


def masked_softmax(s, mask):
    s = jnp.where(mask, s.astype(jnp.float32), MASK_VALUE)
    m = jnp.max(s, axis=-1, keepdims=True)
    e = jnp.where(mask, jnp.exp(s - m), 0.0)
    den = jnp.sum(e, axis=-1, keepdims=True)
    return e / jnp.where(den > 0, den, 1.0)


def to_blocks(a):
    B, T = a.shape[:2]
    return jnp.moveaxis(a.reshape((B, T // Q_BLOCK, Q_BLOCK) + a.shape[2:]), 1, 0)


def nsa_compress(k, pe, w1, w2):
    B, T, H, dh = k.shape
    nc = (T - CMP_LEN) // CMP_STRIDE + 1
    idx = np.arange(nc)[:, None] * CMP_STRIDE + np.arange(CMP_LEN)[None, :]
    blk = k[:, idx] + pe[None, None, :, None, :]
    blk = jnp.swapaxes(blk, 2, 3).reshape(B, nc, H, CMP_LEN * dh)
    return jnp.dot(jax.nn.silu(jnp.dot(blk, w1)), w2)


def nsa_attention(q, q_rot, gate, kc, vc, ks, vs, kw, vw):
    B, T, H, G, dh = q.shape
    nc = kc.shape[1]
    ns = T // SEL_BLOCK
    n_sel = min(N_SELECT, ns)
    nblk = T // Q_BLOCK
    scale = dh ** -0.5
    cmp_end = jnp.arange(nc) * CMP_STRIDE + CMP_LEN - 1
    cs = np.arange(nc) * CMP_STRIDE
    ss = np.arange(ns) * SEL_BLOCK
    ov = np.clip(np.minimum(cs[:, None] + CMP_LEN, ss[None, :] + SEL_BLOCK)
                 - np.maximum(cs[:, None], ss[None, :]), 0, None) / CMP_LEN
    cmp_to_sel = jnp.asarray(ov, dtype=jnp.float32)
    ks_blk = jnp.swapaxes(ks, 1, 2).reshape(B, H, ns, SEL_BLOCK, dh)
    vs_blk = jnp.swapaxes(vs, 1, 2).reshape(B, H, ns, SEL_BLOCK, dh)
    kw_pad = jnp.pad(kw, ((0, 0), (WINDOW, 0), (0, 0), (0, 0)))
    vw_pad = jnp.pad(vw, ((0, 0), (WINDOW, 0), (0, 0), (0, 0)))
    bi = jnp.arange(B)[:, None, None, None]
    hi = jnp.arange(H)[None, :, None, None]
    j = jnp.arange(ns)

    def block(args):
        i, qb, qrb, gb = args
        t = i * Q_BLOCK + jnp.arange(Q_BLOCK)
        s_c = jnp.einsum('bqhgd,bchd->bhgqc', qb, kc) * scale
        p_c = masked_softmax(s_c, cmp_end[None, :] <= t[:, None])
        o_c = jnp.einsum('bhgqc,bchd->bqhgd', p_c.astype(vc.dtype), vc)
        imp = jnp.einsum('bhgqc,cj->bhqj', p_c, cmp_to_sel)
        cur = t // SEL_BLOCK
        forced = (j[None, :] == 0) | (j[None, :] == cur[:, None]) | (j[None, :] == cur[:, None] - 1)
        imp = jnp.where(j[None, :] > cur[:, None], -SEL_FORCE, jnp.where(forced, SEL_FORCE, imp))
        _, sel = lax.top_k(imp, n_sel)
        m = n_sel * SEL_BLOCK
        ks_g = ks_blk[bi, hi, sel].reshape(B, H, Q_BLOCK, m, dh)
        vs_g = vs_blk[bi, hi, sel].reshape(B, H, Q_BLOCK, m, dh)
        kpos_s = (sel[..., None] * SEL_BLOCK + jnp.arange(SEL_BLOCK)).reshape(B, H, 1, Q_BLOCK, m)
        s_s = jnp.einsum('bqhgd,bhqmd->bhgqm', qrb, ks_g) * scale
        p_s = masked_softmax(s_s, kpos_s <= t[:, None])
        o_s = jnp.einsum('bhgqm,bhqmd->bqhgd', p_s.astype(vs.dtype), vs_g)
        start = i * Q_BLOCK
        kwb = lax.dynamic_slice_in_dim(kw_pad, start, WINDOW + Q_BLOCK, axis=1)
        vwb = lax.dynamic_slice_in_dim(vw_pad, start, WINDOW + Q_BLOCK, axis=1)
        kpos_w = start - WINDOW + jnp.arange(WINDOW + Q_BLOCK)
        dist = t[:, None] - kpos_w[None, :]
        mask_w = (dist >= 0) & (dist < WINDOW) & (kpos_w[None, :] >= 0)
        s_w = jnp.einsum('bqhgd,bkhd->bhgqk', qrb, kwb) * scale
        p_w = masked_softmax(s_w, mask_w)
        o_w = jnp.einsum('bhgqk,bkhd->bqhgd', p_w.astype(vw.dtype), vwb)
        g = jax.nn.sigmoid(gb.astype(jnp.float32)).astype(qb.dtype)
        return g[..., 0:1] * o_c + g[..., 1:2] * o_s + g[..., 2:3] * o_w

    out = lax.map(block, (jnp.arange(nblk), to_blocks(q), to_blocks(q_rot), to_blocks(gate)))
    return jnp.moveaxis(out, 0, 1).reshape(B, T, H * G * dh)


def short_conv(b_gate, c_gate, h, w):
    u = c_gate * h
    y = lax.conv_general_dilated(u, w[:, None, :].astype(u.dtype), window_strides=(1,),
                                 padding=[(CONV_K - 1, 0)], dimension_numbers=('NWC', 'WIO', 'NWC'),
                                 feature_group_count=u.shape[-1])
    return b_gate * y


def hgrn2(q, f_logit, i_in, g, lb, norm_g):
    B, T, H, d = q.shape
    dt = q.dtype
    z = f_logit.astype(jnp.float32)
    lb32 = lb.astype(jnp.float32)
    log_f = jnp.logaddexp(jnp.log(jnp.maximum(lb32, LB_FLOOR)), jnp.log1p(-lb32) + jax.nn.log_sigmoid(z))
    k = (1.0 - lb32) * jax.nn.sigmoid(-z)
    qs = q.astype(jnp.float32) * d ** -0.5
    v = i_in.astype(jnp.float32)
    nch = T // HGRN_CHUNK

    def chunks(a):
        return a.reshape(B, nch, HGRN_CHUNK, H, d).transpose(1, 0, 3, 2, 4)

    causal = jnp.tril(jnp.ones((HGRN_CHUNK, HGRN_CHUNK), dtype=bool))[:, :, None]

    def step(S, inp):
        qc, kc, vc, lfc = inp
        b = jnp.cumsum(lfc, axis=2)
        diff = b[:, :, :, None, :] - b[:, :, None, :, :]
        decay = jnp.where(causal, jnp.exp(jnp.where(causal, diff, 0.0)), 0.0)
        a = jnp.einsum('bhtd,bhsd,bhtsd->bhts', qc, kc, decay)
        o = jnp.einsum('bhts,bhse->bhte', a, vc) + jnp.einsum('bhtd,bhde->bhte', qc * jnp.exp(b), S)
        b_last = b[:, :, -1:, :]
        S = jnp.exp(b_last[:, :, 0, :])[..., None] * S + jnp.einsum('bhsd,bhse->bhde', kc * jnp.exp(b_last - b), vc)
        return S, o

    S0 = jnp.zeros((B, H, d, d), jnp.float32)
    _, o = lax.scan(step, S0, (chunks(qs), chunks(k), chunks(v), chunks(log_f)))
    o = o.transpose(1, 0, 3, 2, 4).reshape(B, T, H, d)
    o = o * lax.rsqrt(jnp.mean(o * o, axis=-1, keepdims=True) + RMS_EPS) * norm_g.astype(jnp.float32)
    o = o * jax.nn.silu(g.astype(jnp.float32))
    return o.reshape(B, T, H * d).astype(dt)


def cross_attention(xn, mem_n, wq, wkv, wo):
    B, T, _ = xn.shape
    M = mem_n.shape[1]
    q = jnp.dot(xn, wq).reshape(B, T, CROSS_HEADS, HEAD_DIM)
    k, v = jnp.split(jnp.dot(mem_n, wkv).reshape(B, M, 2 * CROSS_HEADS, HEAD_DIM), 2, axis=2)
    s = jnp.einsum('bqhd,bkhd->bhqk', q, k) * HEAD_DIM ** -0.5
    p = jax.nn.softmax(s.astype(jnp.float32), axis=-1).astype(v.dtype)
    o = jnp.einsum('bhqk,bkhd->bqhd', p, v).reshape(B, T, CROSS_WIDTH)
    return jnp.dot(o, wo)


def hier_moe(xn, w_rg, b_rg, w_re, b_re, w_gu, w_dn):
    B, T, D = xn.shape
    n_tok = B * T
    xf = xn.reshape(n_tok, D)
    lg = jnp.dot(xf, w_rg).astype(jnp.float32) + b_rg.astype(jnp.float32)
    p_grp = jax.nn.softmax(lg, axis=-1)
    grp = jnp.argmax(lg, axis=-1)
    p_grp_sel = jnp.take_along_axis(p_grp, grp[:, None], axis=1)
    le = (jnp.dot(xf, w_re).astype(jnp.float32) + b_re.astype(jnp.float32)).reshape(n_tok, N_GROUPS, EXPERTS_PER_GROUP)
    le = jnp.take_along_axis(le, grp[:, None, None], axis=1)[:, 0]
    top_p, top_e = lax.top_k(jax.nn.softmax(le, axis=-1), EXPERT_TOP_K)
    gate = p_grp_sel * top_p / jnp.sum(top_p, axis=-1, keepdims=True)
    eid = (grp[:, None] * EXPERTS_PER_GROUP + top_e).reshape(-1)
    tok = jnp.arange(n_tok * EXPERT_TOP_K) // EXPERT_TOP_K
    order = jnp.argsort(eid)
    tok_s = tok[order]
    sizes = jnp.bincount(eid, length=N_EXPERTS).astype(jnp.int32)
    xs = xf[tok_s]
    gu = lax.ragged_dot(xs, w_gu, sizes)
    g_, u_ = jnp.split(gu, 2, axis=-1)
    ys = lax.ragged_dot(jax.nn.silu(g_) * u_, w_dn, sizes)
    ys = ys * gate.reshape(-1)[order][:, None].astype(ys.dtype)
    return jnp.zeros_like(xf).at[tok_s].add(ys).reshape(B, T, D)


def setup_inputs(seed: int = 0) -> dict:
    key = jax.random.key(seed)
    ks = jax.random.split(key, 24)
    f32 = jnp.float32

    def nrm(k, shape, scale):
        return jax.random.normal(k, shape, f32) * scale

    def gain(k, shape):
        return 1.0 + 0.1 * jax.random.normal(k, shape, f32)

    D = D_MODEL
    return {
        'x': nrm(ks[0], (BATCH, SEQ, D), 1.0),
        'mem': nrm(ks[1], (BATCH, MEM_LEN, D), 1.0),
        'w_in': nrm(ks[2], (DEPTH, D, IN_WIDTH), D ** -0.5),
        'conv_w': nrm(ks[3], (DEPTH, CONV_K, CONV_WIDTH), CONV_K ** -0.5),
        'cmp_pe': nrm(ks[4], (DEPTH, 2, CMP_LEN, HEAD_DIM), 0.02),
        'cmp_w1': nrm(ks[5], (DEPTH, 2, CMP_LEN * HEAD_DIM, CMP_HIDDEN), (CMP_LEN * HEAD_DIM) ** -0.5),
        'cmp_w2': nrm(ks[6], (DEPTH, 2, CMP_HIDDEN, HEAD_DIM), CMP_HIDDEN ** -0.5),
        'hgrn_lb_logits': nrm(ks[7], (DEPTH, HGRN_WIDTH), 1.0),
        'hgrn_norm': gain(ks[8], (DEPTH, HGRN_WIDTH)),
        'w_out': nrm(ks[9], (DEPTH, MIX_WIDTH, D), MIX_WIDTH ** -0.5),
        'cross_wq': nrm(ks[10], (DEPTH, D, CROSS_WIDTH), D ** -0.5),
        'cross_wkv': nrm(ks[11], (DEPTH, D, 2 * CROSS_WIDTH), D ** -0.5),
        'cross_wo': nrm(ks[12], (DEPTH, CROSS_WIDTH, D), CROSS_WIDTH ** -0.5),
        'router_group_w': nrm(ks[13], (DEPTH, D, N_GROUPS), D ** -0.5),
        'router_group_b': nrm(ks[14], (DEPTH, N_GROUPS), 0.01),
        'router_expert_w': nrm(ks[15], (DEPTH, D, N_EXPERTS), D ** -0.5),
        'router_expert_b': nrm(ks[16], (DEPTH, N_EXPERTS), 0.01),
        'expert_w_gate_up': nrm(ks[17], (DEPTH, N_EXPERTS, D, 2 * D_EXPERT), D ** -0.5),
        'expert_w_down': nrm(ks[18], (DEPTH, N_EXPERTS, D_EXPERT, D), D_EXPERT ** -0.5),
        'norm_mix': gain(ks[19], (DEPTH, D)),
        'norm_cross': gain(ks[20], (DEPTH, D)),
        'norm_mem': gain(ks[21], (DEPTH, D)),
        'norm_ffn': gain(ks[22], (DEPTH, D)),
        'norm_final': gain(ks[23], (D,)),
    }


def reference(x, mem, w_in, conv_w, cmp_pe, cmp_w1, cmp_w2, hgrn_lb_logits, hgrn_norm, w_out,
              cross_wq, cross_wkv, cross_wo, router_group_w, router_group_b, router_expert_w,
              router_expert_b, expert_w_gate_up, expert_w_down, norm_mix, norm_cross, norm_mem,
              norm_ffn, norm_final):
    B, T, _ = x.shape
    pos = jnp.arange(T)
    p_lb = jax.nn.softmax(hgrn_lb_logits.astype(jnp.float32), axis=0)
    lower_bounds = jnp.cumsum(p_lb, axis=0) - p_lb[0:1]
    h = x
    for l in range(DEPTH):
        xn = rmsnorm(h, norm_mix[l])
        (q, kc, vc, ksl, vsl, kwn, vwn, gl, cb, cc, ch,
         hq, hf, hi, hg) = jnp.split(jnp.dot(xn, w_in[l]), IN_OFFSETS, axis=-1)
        q = q.reshape(B, T, NSA_KV_HEADS, NSA_GROUP, HEAD_DIM)
        q_rot = rope(q, pos)
        kvh = (B, T, NSA_KV_HEADS, HEAD_DIM)
        kc = nsa_compress(kc.reshape(kvh), cmp_pe[l, 0], cmp_w1[l, 0], cmp_w2[l, 0])
        vc = nsa_compress(vc.reshape(kvh), cmp_pe[l, 1], cmp_w1[l, 1], cmp_w2[l, 1])
        ksl = rope(ksl.reshape(kvh), pos)
        kwn = rope(kwn.reshape(kvh), pos)
        gate = gl.reshape(B, T, NSA_KV_HEADS, NSA_GROUP, 3)
        o_nsa = nsa_attention(q, q_rot, gate, kc, vc, ksl, vsl.reshape(kvh), kwn, vwn.reshape(kvh))
        o_conv = short_conv(cb, cc, ch, conv_w[l])
        hh = (B, T, HGRN_HEADS, HEAD_DIM)
        o_hgrn = hgrn2(hq.reshape(hh), hf.reshape(hh), hi.reshape(hh), hg.reshape(hh),
                       lower_bounds[l].reshape(HGRN_HEADS, HEAD_DIM), hgrn_norm[l].reshape(HGRN_HEADS, HEAD_DIM))
        h = h + jnp.dot(jnp.concatenate([o_nsa, o_conv, o_hgrn], axis=-1), w_out[l])
        h = h + cross_attention(rmsnorm(h, norm_cross[l]), rmsnorm(mem, norm_mem[l]),
                                cross_wq[l], cross_wkv[l], cross_wo[l])
        h = h + hier_moe(rmsnorm(h, norm_ffn[l]), router_group_w[l], router_group_b[l],
                         router_expert_w[l], router_expert_b[l], expert_w_gate_up[l], expert_w_down[l])
    return rmsnorm(h, norm_final)
```

```cpp
#define MK_ONE_LAUNCH 1
#include <hip/hip_runtime.h>
#include <cstdio>
#include <cstdint>
#include <cmath>
namespace pg8 {
#define PG8_LAS __attribute__((address_space(3)))
typedef unsigned short bf16_t;
typedef short bf16x8 __attribute__((ext_vector_type(8)));
typedef float f32x4 __attribute__((ext_vector_type(4)));
typedef unsigned u32x4 __attribute__((ext_vector_type(4)));
constexpr int BM = 256, BK = 64, HALF = 128, HTB = HALF * BK * 2  , STAGE_BYTES = 8 * HTB, NXCD = 8, WGM = 8;

__host__ __device__ __forceinline__ int lds_byte(int r, int c) { const int st = (r >> 4) * 2 + (c >> 5), rr = r & 15, cc = c & 31, ob = rr * 64 + cc * 2; return st * 1024 + (ob ^ (((ob >> 9) & 1) << 5)); }
__host__ __device__ __forceinline__ void stage_rc(int b, int& R, int& C) { const int st = b / 1024, sb = b % 1024, swz = sb ^ (((sb >> 9) & 1) << 5); R = (st >> 1) * 16 + swz / 64; C = (st & 1) * 32 + (swz % 64) / 2; }
__host__ __device__ __forceinline__ int perm32(int rho) { const int n = rho >> 4, i = rho & 15; return 8 * (i >> 2) + 4 * n + (i & 3); }

struct Unit { int pm, pn; };
struct Gemm { const bf16_t* A; const bf16_t* Bt; int M, N, K; };

struct StaticOrder {
    int nM, nN, nwg, G, c;
    __host__ __device__ void init(int M, int N, int G_, int c_) { nM = M / BM; nN = N / BM; nwg = nM * nN; G = G_; c = c_; }
    __host__ __device__ bool next(int i, Unit& u) const {
        const long L = (long)i * G + c; if (L >= nwg) return false;
        int wgid = (int)L; { const int q = nwg / NXCD, r = nwg % NXCD, xcd = wgid % NXCD, off = wgid / NXCD; wgid = (xcd < r ? xcd * (q + 1) : r * (q + 1) + (xcd - r) * q) + off; }
        const int nig = WGM * nN, gid = wgid / nig, fm = gid * WGM, gsz = (nM - fm) < WGM ? (nM - fm) : WGM;
        u.pm = fm + ((wgid % nig) % gsz); u.pn = (wgid % nig) / gsz; return true;
    }
    __device__ __forceinline__ void a_ready(const Unit&) const {}
    __device__ __forceinline__ void done(const Unit&) const {}
};

__device__ __forceinline__ unsigned cvt_pk_bf16(float lo, float hi) { unsigned r; asm volatile("v_cvt_pk_bf16_f32 %0, %1, %2" : "=v"(r) : "v"(lo), "v"(hi)); return r; }
typedef float f32x2 __attribute__((ext_vector_type(2)));
template <class Epi, class Sched, bool ALIGN_EPI = false, bool SP2 = false>
__device__ __forceinline__ void gemm_phase(PG8_LAS unsigned char* lds, const Gemm g, const Sched& S, const Epi& E, int wave_id) {
    unsigned z_ = 0u; asm volatile("" : "+v"(z_)); int tid_ = wave_id * 64 + (int)__builtin_amdgcn_mbcnt_hi(~0u, __builtin_amdgcn_mbcnt_lo(~0u, z_));
    const int tid = tid_, wid = __builtin_amdgcn_readfirstlane(tid >> 6), lane = tid & 63, wr = wid >> 2, wc = wid & 3, fr = lane & 15, fq = lane >> 4;
    const int K = g.K, nt = K / BK;
    unsigned voffA[2], voffB[2];
#pragma unroll
    for (int i = 0; i < 2; ++i) { int R, C; stage_rc(tid * 16 + i * 8192, R, C); const int Rb = Epi::PERM ? ((R & ~31) + perm32(R & 31)) : R;
        voffA[i] = (unsigned)(R * K + C) * 2u; voffB[i] = (unsigned)(Rb * K + C) * 2u; }
    const size_t kstep = (size_t)(BK * 2);
    const size_t hstep = (size_t)HALF * K * 2;
    const size_t tstep = 2 * hstep;
    const unsigned ldsw = (unsigned)wid * 1024u;
    const int aoff = lds_byte(wr * 64 + fr, fq * 8), boff = lds_byte(wc * 32 + fr, fq * 8);
#define PG8_SA(b, h) (((b) * 2 + (h)) * HTB)
#define PG8_SB(b, h) ((4 + (b) * 2 + (h)) * HTB)
#define PG8_STAGE(bufoff, gbase, voff) do { _Pragma("unroll") for (int _i = 0; _i < 2; ++_i) \
        __builtin_amdgcn_global_load_lds((const unsigned*)((const char*)(gbase) + (voff)[_i]), (PG8_LAS unsigned*)(lds + (bufoff) + ldsw + _i * 8192), 16, 0, 0); } while (0)
#define PG8_LDA(dst, b, h) do { _Pragma("unroll") for (int m = 0; m < 4; ++m) _Pragma("unroll") for (int k = 0; k < 2; ++k) dst[m][k] = *(const PG8_LAS bf16x8*)(lds + PG8_SA(b, h) + aoff + m * 2048 + k * 1024); } while (0)
#define PG8_LDB(dst, b, h) do { _Pragma("unroll") for (int n = 0; n < 2; ++n) _Pragma("unroll") for (int k = 0; k < 2; ++k) dst[n][k] = *(const PG8_LAS bf16x8*)(lds + PG8_SB(b, h) + boff + n * 2048 + k * 1024); } while (0)
#define PG8_MMA(ai, bj, At, Bt) do { __builtin_amdgcn_s_setprio(1); _Pragma("unroll") for (int m = 0; m < 4; ++m) _Pragma("unroll") for (int n = 0; n < 2; ++n) _Pragma("unroll") for (int k = 0; k < 2; ++k) \
        acc[ai][bj][m][n] = __builtin_amdgcn_mfma_f32_16x16x32_bf16(Bt[n][k], At[m][k], acc[ai][bj][m][n], 0, 0, 0); __builtin_amdgcn_s_setprio(0); } while (0)
#define PG8_WAIT_V(n) asm volatile("s_waitcnt vmcnt(" #n ")" ::: "memory")
#define PG8_WAIT_L(n) asm volatile("s_waitcnt lgkmcnt(" #n ")" ::: "memory")
#define PG8_BAR __builtin_amdgcn_s_barrier()
#define PG8_SCHED __builtin_amdgcn_sched_barrier(0)
    Unit cur, nxt; int ui = 0;
    if (!S.next(0, cur)) return;
    f32x4 acc[2][2][4][2];
#pragma unroll
    for (int a = 0; a < 2; ++a)
#pragma unroll
        for (int b = 0; b < 2; ++b)
#pragma unroll
            for (int m = 0; m < 4; ++m)
#pragma unroll
                for (int n = 0; n < 2; ++n) acc[a][b][m][n] = (f32x4){0.f, 0.f, 0.f, 0.f};
    bf16x8 At[4][2], B0[2][2], B1[2][2];
    const char* cA = (const char*)g.A + (size_t)cur.pm * tstep; const char* cB = (const char*)g.Bt + (size_t)cur.pn * tstep;
    S.a_ready(cur);
    if constexpr (SP2) {
        PG8_STAGE(PG8_SB(0, 0), cB, voffB); PG8_STAGE(PG8_SB(0, 1), cB + hstep, voffB); PG8_STAGE(PG8_SA(0, 0), cA, voffA); PG8_STAGE(PG8_SA(0, 1), cA + hstep, voffA);
        if (wr == 1) PG8_BAR;
        PG8_WAIT_V(2); PG8_BAR;
        PG8_STAGE(PG8_SB(1, 0), cB + kstep, voffB); PG8_STAGE(PG8_SA(1, 0), cA + kstep, voffA); PG8_STAGE(PG8_SB(1, 1), cB + hstep + kstep, voffB);
        PG8_WAIT_V(6); PG8_BAR;
    } else {
        PG8_STAGE(PG8_SB(0, 0), cB, voffB); PG8_STAGE(PG8_SA(0, 0), cA, voffA); PG8_STAGE(PG8_SB(0, 1), cB + hstep, voffB); PG8_STAGE(PG8_SA(0, 1), cA + hstep, voffA);
        if (wr == 1) PG8_BAR;
        PG8_WAIT_V(4); PG8_BAR;
        PG8_STAGE(PG8_SB(1, 0), cB + kstep, voffB); PG8_STAGE(PG8_SA(1, 0), cA + kstep, voffA); PG8_STAGE(PG8_SB(1, 1), cB + hstep + kstep, voffB);
        PG8_WAIT_V(6); PG8_BAR;
    }
    for (;;) {
        const bool has_next = S.next(ui + 1, nxt);
        const char* nA = has_next ? (const char*)g.A + (size_t)nxt.pm * tstep : cA; const char* nB = has_next ? (const char*)g.Bt + (size_t)nxt.pn * tstep : cB;
        for (int t = 0; t < nt; t += 2) {
            const bool last = (t == nt - 2);
            const char* a1 = cA + (size_t)(t + 1) * kstep;
            const char* a2 = last ? nA : cA + (size_t)(t + 2) * kstep; const char* b2 = last ? nB : cB + (size_t)(t + 2) * kstep;
            const char* a3 = a2 + kstep; const char* b3 = b2 + kstep;
            if (last && has_next) S.a_ready(nxt);
            if constexpr (SP2) {
            PG8_LDB(B0, 0, 0); PG8_LDB(B1, 0, 1); PG8_SCHED; PG8_LDA(At, 0, 0); PG8_STAGE(PG8_SA(1, 1), a1 + hstep, voffA);
            PG8_WAIT_V(8); PG8_WAIT_L(0); PG8_BAR; PG8_MMA(0, 0, At, B0); PG8_MMA(0, 1, At, B1); PG8_BAR; PG8_SCHED;
            PG8_LDA(At, 0, 1); PG8_STAGE(PG8_SB(0, 0), b2, voffB); PG8_STAGE(PG8_SB(0, 1), b2 + hstep, voffB); PG8_STAGE(PG8_SA(0, 0), a2, voffA);
            PG8_WAIT_V(8); PG8_WAIT_L(0); PG8_BAR; PG8_MMA(1, 0, At, B0); PG8_MMA(1, 1, At, B1); PG8_BAR; PG8_SCHED;
            PG8_LDB(B0, 1, 0); PG8_LDB(B1, 1, 1); PG8_SCHED; PG8_LDA(At, 1, 0); PG8_STAGE(PG8_SA(0, 1), a2 + hstep, voffA);
            PG8_WAIT_V(8); PG8_WAIT_L(0); PG8_BAR; PG8_MMA(0, 0, At, B0); PG8_MMA(0, 1, At, B1); PG8_BAR; PG8_SCHED;
            PG8_LDA(At, 1, 1); PG8_STAGE(PG8_SB(1, 0), b3, voffB); PG8_STAGE(PG8_SB(1, 1), b3 + hstep, voffB); PG8_STAGE(PG8_SA(1, 0), a3, voffA);
            PG8_WAIT_V(8); PG8_WAIT_L(0); PG8_BAR; PG8_MMA(1, 0, At, B0); PG8_MMA(1, 1, At, B1); PG8_BAR; PG8_SCHED;
            } else {
            PG8_LDB(B0, 0, 0); PG8_SCHED; PG8_LDA(At, 0, 0); PG8_STAGE(PG8_SA(1, 1), a1 + hstep, voffA);
            PG8_WAIT_L(8); PG8_BAR; PG8_WAIT_L(0); PG8_MMA(0, 0, At, B0); PG8_BAR; PG8_SCHED;
            PG8_LDB(B1, 0, 1); PG8_STAGE(PG8_SB(0, 0), b2, voffB);
            PG8_BAR; PG8_WAIT_L(0); PG8_MMA(0, 1, At, B1); PG8_BAR;
            PG8_LDA(At, 0, 1); PG8_STAGE(PG8_SA(0, 0), a2, voffA);
            PG8_BAR; PG8_WAIT_L(0); PG8_MMA(1, 0, At, B0); PG8_BAR; PG8_SCHED;
            PG8_STAGE(PG8_SB(0, 1), b2 + hstep, voffB);
            PG8_WAIT_V(6); PG8_BAR; PG8_MMA(1, 1, At, B1); PG8_BAR;
            PG8_LDB(B0, 1, 0); PG8_SCHED; PG8_LDA(At, 1, 0); PG8_STAGE(PG8_SA(0, 1), a2 + hstep, voffA);
            PG8_WAIT_L(8); PG8_BAR; PG8_WAIT_L(0); PG8_MMA(0, 0, At, B0); PG8_BAR; PG8_SCHED;
            PG8_LDB(B1, 1, 1); PG8_STAGE(PG8_SB(1, 0), b3, voffB);
            PG8_BAR; PG8_WAIT_L(0); PG8_MMA(0, 1, At, B1); PG8_BAR;
            PG8_LDA(At, 1, 1); PG8_STAGE(PG8_SA(1, 0), a3, voffA);
            PG8_BAR; PG8_WAIT_L(0); PG8_MMA(1, 0, At, B0); PG8_BAR; PG8_SCHED;
            PG8_STAGE(PG8_SB(1, 1), b3 + hstep, voffB);
            PG8_WAIT_V(6); PG8_BAR; PG8_MMA(1, 1, At, B1); PG8_BAR;
            }
        }
        if constexpr (ALIGN_EPI) { if (wr == 0) PG8_BAR; }
        if constexpr (!Epi::AFTER_DRAIN) { E(acc, cur, wr, wc, fr, fq); S.done(cur); }
        if (!has_next) break;
#pragma unroll
        for (int a = 0; a < 2; ++a)
#pragma unroll
            for (int b = 0; b < 2; ++b)
#pragma unroll
                for (int m = 0; m < 4; ++m)
#pragma unroll
                    for (int n = 0; n < 2; ++n) acc[a][b][m][n] = (f32x4){0.f, 0.f, 0.f, 0.f};
        cur = nxt; cA = nA; cB = nB; ++ui;
        if constexpr (ALIGN_EPI) { if (wr == 1) PG8_BAR; }
    }
    PG8_WAIT_V(0);
    if constexpr (!ALIGN_EPI) { if (wr == 0) PG8_BAR; }
    PG8_BAR;
    if constexpr (Epi::AFTER_DRAIN) { E.fused(acc, cur, wr, wc, fr, fq, lds, wid, lane); S.done(cur); }
#undef PG8_SA
#undef PG8_SB
#undef PG8_STAGE
#undef PG8_LDA
#undef PG8_LDB
#undef PG8_MMA
#undef PG8_WAIT_V
#undef PG8_WAIT_L
#undef PG8_BAR
#undef PG8_SCHED
}
}
constexpr int NB = 4, T = 8192, D = 1024, NTOK = NB * T, DEPTH = 2;
constexpr int NIN = 3328;
constexpr int IN_W = 3096;
constexpr int NSLOT_MAX = 65536 + 32 * 256;
constexpr float RMS_EPS = 1e-6f;
constexpr float QSCALE = 0.125f * 1.44269504088896f;
constexpr int NWAVES = 8;

constexpr size_t MiB = 1u << 20;
constexpr size_t WS_CTL = 0, CTL_ZERO_BYTES = 1 * MiB;
constexpr size_t WS_ROPE = 1 * MiB;
constexpr size_t WS_SMALL = 3 * MiB;
constexpr size_t WS_WG = 3 * MiB + 65536;
constexpr size_t WS_SSQ = 4 * MiB;
constexpr size_t WS_WIN = 8 * MiB;
constexpr size_t WS_WOUT = 22 * MiB;
constexpr size_t WS_WQ = 26 * MiB;
constexpr size_t WS_WKV = 27 * MiB;
constexpr size_t WS_WO = 29 * MiB;
constexpr size_t WS_WR = 30 * MiB;
constexpr size_t WS_W1C = 31 * MiB;
constexpr size_t WS_W2C = 33 * MiB;
constexpr size_t WS_MEMB = 34 * MiB;
constexpr size_t WS_MK = 36 * MiB;
constexpr size_t WS_MVT = 37 * MiB;
constexpr size_t WS_WGU = 40 * MiB;
constexpr size_t WS_WDN = 168 * MiB;
constexpr size_t WS_HB = 232 * MiB;
constexpr size_t WS_Q = 296 * MiB, WS_QR = 328 * MiB, WS_KCR = 360 * MiB, WS_VCR = 368 * MiB, WS_KS = 376 * MiB, WS_KW = 384 * MiB;
constexpr size_t WS_VST = 392 * MiB, WS_VWT = 400 * MiB, WS_KCC = 408 * MiB, WS_VCT = 409 * MiB, WS_GATE = 410 * MiB;
constexpr size_t WS_CB = 414 * MiB, WS_CC = 430 * MiB, WS_CH = 446 * MiB;
constexpr size_t WS_HQ = 462 * MiB, WS_HF = 494 * MiB, WS_HI = 526 * MiB, WS_HG = 558 * MiB;
constexpr size_t WS_CAT = 590 * MiB, WS_U = 654 * MiB, WS_DEC = 686 * MiB;
constexpr size_t WS_XQ = 688 * MiB, WS_XO = 704 * MiB;
constexpr size_t WS_XS = 296 * MiB, WS_ACT = 440 * MiB, WS_YS = 512 * MiB;
constexpr size_t WS_TOKE = 720 * MiB, WS_TOKG = 721 * MiB, WS_TOKP = 722 * MiB, WS_TOKS = 723 * MiB, WS_SRSTD = 724 * MiB, WS_SGATE = 725 * MiB;
constexpr size_t WS_U2 = 728 * MiB;
constexpr size_t WS_PROBE = 760 * MiB;
constexpr size_t WS_END = 760 * MiB;
static_assert(WS_XS + (size_t)NSLOT_MAX * 1024 * 2 <= WS_ACT && WS_ACT + (size_t)NSLOT_MAX * 512 * 2 <= WS_YS && WS_YS + (size_t)NSLOT_MAX * 1024 * 2 <= WS_XQ, "moe map");
constexpr int CW_CNT = 64;
constexpr int CW_KMAX = 256;
constexpr int CW_BAR = 4096;

constexpr int RING_BYTES = 131072;
constexpr int NSA_LDS_WAVE = 10752;
constexpr int MISC_OFF = RING_BYTES;
constexpr int TAB_OFF = RING_BYTES + 512;
constexpr int LDS_BYTES = 147456;
static_assert(8 * NSA_LDS_WAVE <= RING_BYTES && TAB_OFF + 4 * (40 + 320) <= LDS_BYTES, "LDS map");

#define GAS __attribute__((address_space(1)))
#define LAS __attribute__((address_space(3)))
#define DEV __device__ __forceinline__
typedef unsigned short bf16;
typedef unsigned v4u __attribute__((ext_vector_type(4)));
typedef unsigned v2u __attribute__((ext_vector_type(2)));
typedef float f32x4 __attribute__((ext_vector_type(4)));
typedef short bf16x8 __attribute__((ext_vector_type(8)));
typedef GAS unsigned gu32;
#define RLX_AGENT __ATOMIC_RELAXED, __HIP_MEMORY_SCOPE_AGENT
#define LDS_WAIT() asm volatile("s_waitcnt lgkmcnt(0)" ::: "memory")
#define VM_WAIT() asm volatile("s_waitcnt vmcnt(0)" ::: "memory")
typedef __bf16 bf16x2_t __attribute__((ext_vector_type(2)));
typedef float f32x2_t __attribute__((ext_vector_type(2)));
DEV unsigned pk2(float lo, float hi) { const f32x2_t v = {lo, hi}; return __builtin_bit_cast(unsigned, __builtin_convertvector(v, bf16x2_t)); }
DEV unsigned f2bf(float f) { return pk2(f, 0.f) & 0xffffu; }
DEV float bf2f(unsigned short b) { return __builtin_bit_cast(float, (unsigned)b << 16); }
DEV float bflo(unsigned w) { return __builtin_bit_cast(float, w << 16); }
DEV float bfhi(unsigned w) { return __builtin_bit_cast(float, w & 0xffff0000u); }
DEV float ex2(float x) { return __builtin_amdgcn_exp2f(x); }
DEV float wave_sum(float v) {
#pragma unroll
    for (int o = 1; o < 64; o <<= 1) v += __shfl_xor(v, o);
    return v;
}
DEV f32x4 mfma16(bf16x8 a, bf16x8 b, f32x4 c) { return __builtin_amdgcn_mfma_f32_16x16x32_bf16(a, b, c, 0, 0, 0); }
DEV int slot32(int k) { return ((k >> 2) & 3) * 8 + (k >> 4) * 4 + (k & 3); }
DEV float sigmoidf_(float x) { return 1.0f / (1.0f + __expf(-x)); }
DEV float siluf_(float x) { return x / (1.0f + __expf(-x)); }
#define XB_TMO      128
#define XB_XCNT(j)  (256  + 64 * (j))
#define XB_XSUB(j)  (1280 + 64 * (j))
#define XB_XGEN(j)  (2304 + 64 * (j))
#define XB_TOP      3328
#define XB_TOPGEN   3392
#define XCD_BAR_WORDS 3456
#define XB_SPIN_CAP (1u << 18)

__device__ __forceinline__ unsigned xb_ld(unsigned* p)              { return __hip_atomic_load(p, __ATOMIC_RELAXED, __HIP_MEMORY_SCOPE_AGENT); }
__device__ __forceinline__ unsigned xb_add(unsigned* p, unsigned v) { return __hip_atomic_fetch_add(p, v, __ATOMIC_RELAXED, __HIP_MEMORY_SCOPE_AGENT); }
__device__ __forceinline__ unsigned xb_xcc_id() { return (unsigned)__builtin_amdgcn_s_getreg((3 << 11) | 20) & 0xFu; }
#define XB_SPIN(cond, bar) do { unsigned _sp = 0; while (cond) { __builtin_amdgcn_s_sleep(1); \
    if ((++_sp & 255u) == 0u) { if (xb_ld(&(bar)[XB_TMO])) break; if (_sp > XB_SPIN_CAP) { atomicAdd(&(bar)[XB_TMO], 1u); break; } } } } while (0)

struct XcdBarrier {
    unsigned* bar; unsigned x;
    volatile LAS unsigned* st;
};

__device__ __forceinline__ XcdBarrier xcd_barrier_post(unsigned* bar, volatile LAS unsigned* st) {
    XcdBarrier b; b.bar = bar; b.x = xb_xcc_id(); b.st = st;
    if (threadIdx.x == 0) (void)xb_add(&bar[XB_XCNT(b.x)], 1u);
    return b;
}
__device__ __forceinline__ void xcd_barrier_complete(unsigned* bar, unsigned x, unsigned& nloc, unsigned& nx) {
    const unsigned G = gridDim.x * gridDim.y * gridDim.z;
    unsigned sum, cnt, mine, sp = 0u;
    for (;;) {
        sum = 0u; cnt = 0u; mine = 0u;
#pragma unroll
        for (unsigned j = 0; j < 16; ++j) { const unsigned c = xb_ld(&bar[XB_XCNT(j)]); sum += c; cnt += (c > 0u) ? 1u : 0u; mine = (j == x) ? c : mine; }
        if (sum == G) break;
        __builtin_amdgcn_s_sleep(1);
        if ((++sp & 255u) == 0u) { if (xb_ld(&bar[XB_TMO])) break; if (sp > XB_SPIN_CAP) { atomicAdd(&bar[XB_TMO], 1u); break; } }
    }
    nloc = mine > 0u ? mine : 1u; nx = cnt > 0u ? cnt : 1u;
}

__device__ __forceinline__ void xcd_barrier(const XcdBarrier& b) {
    asm volatile("s_waitcnt vmcnt(0)" ::: "memory");
    __syncthreads();
    if (threadIdx.x == 0) {
        unsigned* bar = b.bar;
        __builtin_amdgcn_s_waitcnt(0);
        unsigned nloc = b.st[0], nx = b.st[1];
        if (nloc == 0u) { xcd_barrier_complete(bar, b.x, nloc, nx); b.st[0] = nloc; b.st[1] = nx; }
        const unsigned old = xb_add(&bar[XB_XSUB(b.x)], 1u);
        const unsigned gen = old / nloc;
        if (old + 1u == (gen + 1u) * nloc) {
            __builtin_amdgcn_fence(__ATOMIC_RELEASE, "agent");
            asm volatile("s_waitcnt vmcnt(0)" ::: "memory");
            const unsigned og = xb_add(&bar[XB_TOP], 1u);
            const unsigned tg = og / nx;
            if (og + 1u == (tg + 1u) * nx) xb_add(&bar[XB_TOPGEN], 1u);
            else XB_SPIN(xb_ld(&bar[XB_TOPGEN]) == tg, bar);
            __builtin_amdgcn_fence(__ATOMIC_ACQUIRE, "agent");
            xb_add(&bar[XB_XGEN(b.x)], 1u);
            asm volatile("s_waitcnt vmcnt(0)" ::: "memory");
        } else {
            XB_SPIN(xb_ld(&bar[XB_XGEN(b.x)]) == gen, bar);
            __builtin_amdgcn_fence(__ATOMIC_ACQUIRE, "agent");
            asm volatile("s_waitcnt vmcnt(0)" ::: "memory");
        }
    }
    __syncthreads();
}
DEV float row_rstd(const float* ssq, int row, int fq) {
    const f32x4 p = *(const f32x4*)(ssq + (size_t)row * 16 + fq * 4);
    float s = (p.x + p.y) + (p.z + p.w);
    s += __shfl_xor(s, 16); s += __shfl_xor(s, 32);
    return 1.0f / sqrtf(s * (1.0f / 1024.0f) + RMS_EPS);
}
DEV float row_rstd_full(const float* ssq, int row) {
    const f32x4* p = (const f32x4*)(ssq + (size_t)row * 16);
    const f32x4 a = p[0], b = p[1], c = p[2], d = p[3];
    const float s = ((a.x + a.y) + (a.z + a.w)) + ((b.x + b.y) + (b.z + b.w)) + ((c.x + c.y) + (c.z + c.w)) + ((d.x + d.y) + (d.z + d.w));
    return 1.0f / sqrtf(s * (1.0f / 1024.0f) + RMS_EPS);
}

DEV void rope4(const float* rope, int t, int i, const f32x4& v0, const f32x4& v1, float (&lo)[4], float (&hi)[4]) {
    const f32x4 c0 = *(const f32x4*)(rope + ((size_t)t * 32 + i) * 2), c1 = *(const f32x4*)(rope + ((size_t)t * 32 + i + 2) * 2);
    lo[0] = v0[0] * c0[0] - v0[1] * c0[1]; hi[0] = v0[1] * c0[0] + v0[0] * c0[1];
    lo[1] = v0[2] * c0[2] - v0[3] * c0[3]; hi[1] = v0[3] * c0[2] + v0[2] * c0[3];
    lo[2] = v1[0] * c1[0] - v1[1] * c1[1]; hi[2] = v1[1] * c1[0] + v1[0] * c1[1];
    lo[3] = v1[2] * c1[2] - v1[3] * c1[3]; hi[3] = v1[3] * c1[2] + v1[2] * c1[3];
}
struct EpiIn {
    static constexpr bool PERM = true, AFTER_DRAIN = false;
    unsigned char* ws;
    template <class Tp> DEV Tp* P(size_t off) const { return (Tp*)(GAS Tp*)(ws + off); }
    DEV void operator()(const f32x4 (&acc)[2][2][4][2], const pg8::Unit& u, int wr, int wc, int fr, int fq) const {
        asm volatile("" : "+v"(fr), "+v"(fq), "+s"(wr), "+s"(wc));
        const int pn = u.pn;
        const float* ssq = P<float>(WS_SSQ); const float* rope = P<float>(WS_ROPE);
#pragma unroll
        for (int ai = 0; ai < 2; ++ai)
#pragma unroll
            for (int m = 0; m < 4; ++m) {
                const int row = u.pm * 256 + ai * 128 + wr * 64 + m * 16 + fr;
                const float rstd = row_rstd(ssq, row, fq);
                const int t = row & (T - 1), b = row >> 13;
#pragma unroll
                for (int bj = 0; bj < 2; ++bj) {
                    const int col = bj * 128 + wc * 32 + fq * 8;
                    const f32x4 v0 = acc[ai][bj][m][0] * rstd, v1 = acc[ai][bj][m][1] * rstd;
                    if (pn < 2) {
                        const int g = pn * 256 + col, head = g >> 6, i = (g & 63) >> 1;
                        float lo[4], hi[4]; rope4(rope, t, i, v0, v1, lo, hi);
                        const size_t o = (size_t)row * 512 + head * 64 + i;
                        bf16* Q = P<bf16>(WS_Q); bf16* QR = P<bf16>(WS_QR);
                        v2u w;
                        w.x = pk2(v0[0] * QSCALE, v0[2] * QSCALE); w.y = pk2(v1[0] * QSCALE, v1[2] * QSCALE); *(v2u*)(Q + o) = w;
                        w.x = pk2(v0[1] * QSCALE, v0[3] * QSCALE); w.y = pk2(v1[1] * QSCALE, v1[3] * QSCALE); *(v2u*)(Q + o + 32) = w;
                        w.x = pk2(lo[0] * QSCALE, lo[1] * QSCALE); w.y = pk2(lo[2] * QSCALE, lo[3] * QSCALE); *(v2u*)(QR + o) = w;
                        w.x = pk2(hi[0] * QSCALE, hi[1] * QSCALE); w.y = pk2(hi[2] * QSCALE, hi[3] * QSCALE); *(v2u*)(QR + o + 32) = w;
                    } else if (pn == 2) {
                        bf16* dst = P<bf16>((col < 128) ? WS_KCR : WS_VCR);
                        v4u w; w.x = pk2(v0[0], v0[1]); w.y = pk2(v0[2], v0[3]); w.z = pk2(v1[0], v1[1]); w.w = pk2(v1[2], v1[3]);
                        *(v4u*)(dst + (size_t)row * 128 + (col & 127)) = w;
                    } else if (pn == 3 || pn == 4) {
                        if (col < 128) {
                            bf16* dst = P<bf16>((pn == 3) ? WS_KS : WS_KW);
                            const int hkv = col >> 6, i = (col & 63) >> 1;
                            float lo[4], hi[4]; rope4(rope, t, i, v0, v1, lo, hi);
                            const size_t o = ((size_t)(b * 2 + hkv) * T + t) * 64 + i;
                            v2u w;
                            w.x = pk2(lo[0], lo[1]); w.y = pk2(lo[2], lo[3]); *(v2u*)(dst + o) = w;
                            w.x = pk2(hi[0], hi[1]); w.y = pk2(hi[2], hi[3]); *(v2u*)(dst + o + 32) = w;
                        } else {
                            bf16* dst = P<bf16>((pn == 3) ? WS_VST : WS_VWT);
                            const int c2 = col - 128, hkv = c2 >> 6, d = c2 & 63;
                            const size_t o = (((size_t)(b * 2 + hkv) * 256 + (t >> 5)) * 64 + d) * 32 + slot32(t & 31);
#pragma unroll
                            for (int j = 0; j < 4; ++j) { dst[o + j * 32] = (bf16)f2bf(v0[j]); dst[o + (j + 4) * 32] = (bf16)f2bf(v1[j]); }
                        }
                    } else if (pn == 9) {
                        float* dst = P<float>(WS_HF) + (size_t)row * 256 + col;
                        *(f32x4*)dst = v0; *(f32x4*)(dst + 4) = v1;
                    } else {
                        bf16* dst = (pn < 8) ? P<bf16>(WS_CB + (size_t)(pn - 5) * (WS_CC - WS_CB)) : P<bf16>(WS_HQ + (size_t)(pn - 8) * (WS_HF - WS_HQ));
                        v4u w; w.x = pk2(v0[0], v0[1]); w.y = pk2(v0[2], v0[3]); w.z = pk2(v1[0], v1[1]); w.w = pk2(v1[2], v1[3]);
                        *(v4u*)(dst + (size_t)row * 256 + col) = w;
                    }
                }
            }
    }
};

struct EpiRes {
    static constexpr bool PERM = true, AFTER_DRAIN = false;
    const float* base; float* out; bf16* hb; float* ssq;
    DEV void operator()(const f32x4 (&acc)[2][2][4][2], const pg8::Unit& u, int wr, int wc, int fr, int fq) const {
        asm volatile("" : "+v"(fr), "+v"(fq), "+s"(wr), "+s"(wc));
#pragma unroll
        for (int ai = 0; ai < 2; ++ai)
#pragma unroll
            for (int m = 0; m < 4; ++m) {
                const int row = u.pm * 256 + ai * 128 + wr * 64 + m * 16 + fr;
                float ss = 0.f;
#pragma unroll
                for (int bj = 0; bj < 2; ++bj) {
                    const size_t o = (size_t)row * 1024 + u.pn * 256 + bj * 128 + wc * 32 + fq * 8;
                    const f32x4 v0 = *(const f32x4*)(base + o) + acc[ai][bj][m][0], v1 = *(const f32x4*)(base + o + 4) + acc[ai][bj][m][1];
                    *(f32x4*)(out + o) = v0; *(f32x4*)(out + o + 4) = v1;
                    v4u w; w.x = pk2(v0[0], v0[1]); w.y = pk2(v0[2], v0[3]); w.z = pk2(v1[0], v1[1]); w.w = pk2(v1[2], v1[3]);
                    *(v4u*)(hb + o) = w;
                    ss += ((v0[0] * v0[0] + v0[1] * v0[1]) + (v0[2] * v0[2] + v0[3] * v0[3])) + ((v1[0] * v1[0] + v1[1] * v1[1]) + (v1[2] * v1[2] + v1[3] * v1[3]));
                }
                ss += __shfl_xor(ss, 16); ss += __shfl_xor(ss, 32);
                if (fq == 0) ssq[(size_t)row * 16 + u.pn * 4 + wc] = ss;
            }
    }
};

struct EpiXQ {
    static constexpr bool PERM = true, AFTER_DRAIN = false;
    const float* ssq; bf16* XQ;
    DEV void operator()(const f32x4 (&acc)[2][2][4][2], const pg8::Unit& u, int wr, int wc, int fr, int fq) const {
        asm volatile("" : "+v"(fr), "+v"(fq), "+s"(wr), "+s"(wc));
#pragma unroll
        for (int ai = 0; ai < 2; ++ai)
#pragma unroll
            for (int m = 0; m < 4; ++m) {
                const int row = u.pm * 256 + ai * 128 + wr * 64 + m * 16 + fr;
                const float sc = row_rstd(ssq, row, fq) * QSCALE;
#pragma unroll
                for (int bj = 0; bj < 2; ++bj) {
                    const f32x4 v0 = acc[ai][bj][m][0] * sc, v1 = acc[ai][bj][m][1] * sc;
                    v4u w; w.x = pk2(v0[0], v0[1]); w.y = pk2(v0[2], v0[3]); w.z = pk2(v1[0], v1[1]); w.w = pk2(v1[2], v1[3]);
                    *(v4u*)(XQ + (size_t)row * 256 + bj * 128 + wc * 32 + fq * 8) = w;
                }
            }
    }
};

struct EpiGU {
    static constexpr bool PERM = true, AFTER_DRAIN = false;
    const float* srstd; bf16* ACT;
    DEV void operator()(const f32x4 (&acc)[2][2][4][2], const pg8::Unit& u, int wr, int wc, int fr, int fq) const {
        asm volatile("" : "+v"(fr), "+v"(fq), "+s"(wr), "+s"(wc));
        const int nt = u.pn & 3;
#pragma unroll
        for (int ai = 0; ai < 2; ++ai)
#pragma unroll
            for (int m = 0; m < 4; ++m) {
                const int row = u.pm * 256 + ai * 128 + wr * 64 + m * 16 + fr;
                const float rs = srstd[row];
#pragma unroll
                for (int bj = 0; bj < 2; ++bj) {
                    const f32x4 v0 = acc[ai][bj][m][0] * rs, v1 = acc[ai][bj][m][1] * rs;
                    const int j = (nt * 256 + bj * 128 + wc * 32 + fq * 8) >> 1;
                    v2u w; w.x = pk2(siluf_(v0[0]) * v0[1], siluf_(v0[2]) * v0[3]); w.y = pk2(siluf_(v1[0]) * v1[1], siluf_(v1[2]) * v1[3]);
                    *(v2u*)(ACT + (size_t)row * 512 + j) = w;
                }
            }
    }
};

struct EpiDN {
    static constexpr bool PERM = true, AFTER_DRAIN = false;
    const float* sgate; bf16* YS;
    DEV void operator()(const f32x4 (&acc)[2][2][4][2], const pg8::Unit& u, int wr, int wc, int fr, int fq) const {
        asm volatile("" : "+v"(fr), "+v"(fq), "+s"(wr), "+s"(wc));
        const int nt = u.pn & 3;
#pragma unroll
        for (int ai = 0; ai < 2; ++ai)
#pragma unroll
            for (int m = 0; m < 4; ++m) {
                const int row = u.pm * 256 + ai * 128 + wr * 64 + m * 16 + fr;
                const float gt = sgate[row];
#pragma unroll
                for (int bj = 0; bj < 2; ++bj) {
                    const f32x4 v0 = acc[ai][bj][m][0] * gt, v1 = acc[ai][bj][m][1] * gt;
                    v4u w; w.x = pk2(v0[0], v0[1]); w.y = pk2(v0[2], v0[3]); w.z = pk2(v1[0], v1[1]); w.w = pk2(v1[2], v1[3]);
                    *(v4u*)(YS + (size_t)row * 1024 + nt * 256 + bj * 128 + wc * 32 + fq * 8) = w;
                }
            }
    }
};

struct MoeOrder {
    int nunits, G, c; const LAS int* tileE;
    DEV bool next(int i, pg8::Unit& u) const {
        const int L = i * G + c; if (L >= nunits) return false;
        const int rt = L >> 2; u.pm = rt; u.pn = tileE[rt] * 4 + (L & 3); return true;
    }
    DEV void a_ready(const pg8::Unit&) const {}
    DEV void done(const pg8::Unit&) const {}
};
struct Frame {
    LAS unsigned char* lds;
    unsigned char* ldsg;
    volatile LAS unsigned* MISC;
    gu32* ctl;
    unsigned char* ws;
    int tid, lane, wave, vcu, G;
    float* out;
};
template <class Tp> DEV Tp* wsp(const Frame& F, size_t off) { return (Tp*)(F.ws + off); }
DEV const float* inp(int i) { const float* const* ka = (const float* const*)__builtin_amdgcn_kernarg_segment_ptr(); asm volatile("" : "+s"(i)); return (const float*)(const GAS float*)ka[i]; }

template <class Map>
DEV void tr_item(const float* W, int K, int Nsrc, const float* gain, bf16* WT, float* scr, int item, int lane, Map map) {
    const int nblk = (Nsrc + 31) >> 5, kb = item / nblk, nb = item - kb * nblk, k0 = 64 * kb, n0 = 32 * nb;
    {
        const int nq = (lane & 7) * 4; f32x4 v[8];
#pragma unroll
        for (int i = 0; i < 8; ++i) { const int kk = 8 * i + (lane >> 3);
            v[i] = (n0 + nq < Nsrc) ? *(const f32x4*)(W + (size_t)(k0 + kk) * Nsrc + n0 + nq) : (f32x4){0.f, 0.f, 0.f, 0.f}; }
#pragma unroll
        for (int i = 0; i < 8; ++i) { const int kk = 8 * i + (lane >> 3); const float g = gain ? gain[k0 + kk] : 1.0f; float* s = scr + kk * 33 + nq;
            s[0] = v[i][0] * g; s[1] = v[i][1] * g; s[2] = v[i][2] * g; s[3] = v[i][3] * g; }
    }
    LDS_WAIT();
    const int c = lane & 7;
#pragma unroll
    for (int j = 0; j < 4; ++j) {
        const int n = (lane >> 3) + 8 * j; const float* s = scr + (8 * c) * 33 + n;
        if (n0 + n < Nsrc) {
            v4u o; o.x = pk2(s[0 * 33], s[1 * 33]); o.y = pk2(s[2 * 33], s[3 * 33]); o.z = pk2(s[4 * 33], s[5 * 33]); o.w = pk2(s[6 * 33], s[7 * 33]);
            *(v4u*)(WT + (size_t)map(n0 + n) * K + k0 + 8 * c) = o;
        }
    }
    LDS_WAIT();
}
template <class Map>
DEV void tr_experts(const float* W, int K, int Nsrc, const float* gain, bf16* WT, bf16* scr, int gw, int NGW, int lane, Map map) {
    const int nblk = Nsrc >> 6, per_e = (K >> 6) * nblk, NIT = 32 * per_e; const size_t esz = (size_t)K * Nsrc;
#pragma unroll 1
    for (int it = gw; it < NIT; it += NGW) {
        const int e = it / per_e, sub = it - e * per_e, kb = sub / nblk, nb = sub - kb * nblk, k0 = 64 * kb, n0 = 64 * nb, nq = (lane & 15) * 4;
        const float* Wp = W + (size_t)e * esz; bf16* Wo = WT + (size_t)e * esz;
        f32x4 v[16];
#pragma unroll
        for (int i = 0; i < 16; ++i) v[i] = *(const f32x4*)(Wp + (size_t)(k0 + 4 * i + (lane >> 4)) * Nsrc + n0 + nq);
#pragma unroll
        for (int i = 0; i < 16; ++i) { const int kk = 4 * i + (lane >> 4); const float g = gain ? gain[k0 + kk] : 1.0f;
            v2u w; w.x = pk2(v[i][0] * g, v[i][1] * g); w.y = pk2(v[i][2] * g, v[i][3] * g);
            *(v2u*)(scr + kk * 68 + nq) = w; }
        LDS_WAIT();
        const int cc = lane & 7;
#pragma unroll
        for (int j = 0; j < 8; ++j) { const int n = (lane >> 3) + 8 * j; const bf16* s = scr + (8 * cc) * 68 + n;
            v4u o; o.x = (unsigned)s[0] | ((unsigned)s[68] << 16); o.y = (unsigned)s[2 * 68] | ((unsigned)s[3 * 68] << 16);
            o.z = (unsigned)s[4 * 68] | ((unsigned)s[5 * 68] << 16); o.w = (unsigned)s[6 * 68] | ((unsigned)s[7 * 68] << 16);
            *(v4u*)(Wo + (size_t)map(n0 + n) * K + k0 + 8 * cc) = o; }
        LDS_WAIT();
    }
}
struct MapId { DEV int operator()(int n) const { return n; } };
struct MapIn {
    DEV int operator()(int n) const {
        if (n < 512) { const int d = n & 63; return (n & ~63) + 2 * (d & 31) + (d >> 5); }
        if (n < 768) return n;
        if (n < 1280) { const int r = n - 768; if ((r & 255) < 128) { const int d = r & 63; return 768 + (r & ~63) + 2 * (d & 31) + (d >> 5); } return n; }
        if (n < 1304) return 3072 + (n - 1280);
        return n - 24;
    }
};
struct MapGU { DEV int operator()(int n) const { return n < 512 ? 2 * n : 2 * (n - 512) + 1; } };

DEV void p0_prologue(Frame& F) {
    float* scr = (float*)(F.ldsg + F.wave * 16384);
    const int gw = F.vcu * NWAVES + F.wave, NGW = F.G * NWAVES, lane = F.lane;
    for (int l = 0; l < DEPTH; ++l) {
        { const int NIT = 16 * 97; bf16* dst = wsp<bf16>(F, WS_WIN) + (size_t)l * NIN * 1024;
          for (int it = gw; it < NIT; it += NGW) tr_item(inp(2) + (size_t)l * 1024 * IN_W, 1024, IN_W, inp(19) + l * 1024, dst, scr, it, lane, MapIn());
          for (int i = gw * 64 + lane; i < (NIN - 3096) * 1024 / 8; i += NGW * 64) ((v4u*)(dst + (size_t)3096 * 1024))[i] = (v4u){0u, 0u, 0u, 0u}; }
        { const int NIT = 16 * 32; for (int it = gw; it < NIT; it += NGW) tr_item(inp(9) + (size_t)l * 1024 * 1024, 1024, 1024, nullptr, wsp<bf16>(F, WS_WOUT) + (size_t)l * 1024 * 1024, scr, it, lane, MapId()); }
        { const int NIT = 16 * 8; for (int it = gw; it < NIT; it += NGW) tr_item(inp(10) + (size_t)l * 1024 * 256, 1024, 256, inp(20) + l * 1024, wsp<bf16>(F, WS_WQ) + (size_t)l * 256 * 1024, scr, it, lane, MapId()); }
        { const int NIT = 16 * 16; for (int it = gw; it < NIT; it += NGW) tr_item(inp(11) + (size_t)l * 1024 * 512, 1024, 512, inp(21) + l * 1024, wsp<bf16>(F, WS_WKV) + (size_t)l * 512 * 1024, scr, it, lane, MapId()); }
        { const int NIT = 4 * 32; for (int it = gw; it < NIT; it += NGW) tr_item(inp(12) + (size_t)l * 256 * 1024, 256, 1024, nullptr, wsp<bf16>(F, WS_WO) + (size_t)l * 1024 * 256, scr, it, lane, MapId()); }
        for (int kv = 0; kv < 2; ++kv) {
            { const int NIT = 32 * 4; for (int it = gw; it < NIT; it += NGW) tr_item(inp(5) + (size_t)(l * 2 + kv) * 2048 * 128, 2048, 128, nullptr, wsp<bf16>(F, WS_W1C) + (size_t)(l * 2 + kv) * 128 * 2048, scr, it, lane, MapId()); }
            { const int NIT = 2 * 2; for (int it = gw; it < NIT; it += NGW) tr_item(inp(6) + (size_t)(l * 2 + kv) * 128 * 64, 128, 64, nullptr, wsp<bf16>(F, WS_W2C) + (size_t)(l * 2 + kv) * 64 * 128, scr, it, lane, MapId()); }
        }
        tr_experts(inp(17) + (size_t)l * 32 * 1024 * 1024, 1024, 1024, inp(22) + l * 1024, wsp<bf16>(F, WS_WGU) + (size_t)l * 32 * 1024 * 1024, (bf16*)scr, gw, NGW, lane, MapGU());
        tr_experts(inp(18) + (size_t)l * 32 * 512 * 1024, 512, 1024, nullptr, wsp<bf16>(F, WS_WDN) + (size_t)l * 32 * 1024 * 512, (bf16*)scr, gw, NGW, lane, MapId());
        { bf16* dst = wsp<bf16>(F, WS_WR) + (size_t)l * 96 * 1024; const float* gn = inp(22) + l * 1024;
          for (int i = gw * 64 + lane; i < 48 * 1024; i += NGW * 64) { const int n = i >> 10, k = i & 1023;
            float v = 0.f; if (n < 4) v = inp(13)[(size_t)(l * 1024 + k) * 4 + n]; else if (n < 36) v = inp(15)[(size_t)(l * 1024 + k) * 32 + (n - 4)];
            v *= gn[k]; const unsigned h = f2bf(v); dst[i] = (bf16)h; dst[i + 48 * 1024] = (bf16)f2bf(v - bf2f((unsigned short)h)); } }
    }
    { bf16* wg = wsp<bf16>(F, WS_WG);
      for (int i = gw * 64 + lane; i < DEPTH * 32 * 1024; i += NGW * 64) { const int l2 = i >> 15, row = (i >> 10) & 31, k = i & 1023, hk = row >> 4, gi = row & 15;
        const float v = gi < 12 ? inp(2)[((size_t)l2 * 1024 + k) * IN_W + 1280 + hk * 12 + gi] * inp(19)[l2 * 1024 + k] : 0.f;
        wg[i] = (bf16)f2bf(v); } }
    { float* rope = wsp<float>(F, WS_ROPE);
      for (int i = gw * 64 + lane; i < T * 32; i += NGW * 64) { const int t = i >> 5, k = i & 31;
        const float inv = powf(10000.0f, -(float)k / 32.0f); const float ang = (float)t * inv;
        rope[2 * i] = cosf(ang); rope[2 * i + 1] = sinf(ang); } }
    { float* b1 = wsp<float>(F, WS_SMALL);
      for (int i = gw * 64 + lane; i < 4 * 128; i += NGW * 64) { const int lk = i >> 7, n = i & 127;
        const float* pe = inp(4) + (size_t)lk * 2048; const float* w1 = inp(5) + (size_t)lk * 2048 * 128 + n; float s = 0.f;
        for (int kk = 0; kk < 2048; ++kk) s += pe[kk] * w1[(size_t)kk * 128];
        b1[i] = s; } }
    { bf16* HB = wsp<bf16>(F, WS_HB); float* SSQ = wsp<float>(F, WS_SSQ); bf16* MB = wsp<bf16>(F, WS_MEMB); float* SSQM = wsp<float>(F, WS_SMALL) + 1024;
      for (int m = gw; m < NTOK + NB * 256; m += NGW) {
        const bool ism = m >= NTOK; const int r = ism ? m - NTOK : m;
        const f32x4* xr = (const f32x4*)((ism ? inp(1) : inp(0)) + (size_t)r * 1024) + lane;
        unsigned long long* o8 = (unsigned long long*)((ism ? MB : HB) + (size_t)r * 1024) + lane;
        float s = 0.f;
#pragma unroll
        for (int j = 0; j < 4; ++j) { const f32x4 v = xr[64 * j]; s += (v.x * v.x + v.y * v.y) + (v.z * v.z + v.w * v.w);
            o8[64 * j] = (unsigned long long)pk2(v.x, v.y) | ((unsigned long long)pk2(v.z, v.w) << 32); }
        s = wave_sum(s);
        if (ism) { if (lane == 0) SSQM[r] = s; }
        else if (lane < 16) SSQ[(size_t)r * 16 + lane] = lane == 0 ? s : 0.f;
      } }
}

template <int NT>
DEV void skinny16(const bf16* A, size_t lda, const bf16* Bt, size_t ldb, int K, int lane, f32x4 (&acc)[NT]) {
    const int l16 = lane & 15, g4 = lane >> 4;
    const bf16* ap = A + (size_t)l16 * lda + g4 * 8; const bf16* bp = Bt + (size_t)l16 * ldb + g4 * 8;
#pragma unroll
    for (int n = 0; n < NT; ++n) acc[n] = (f32x4){0.f, 0.f, 0.f, 0.f};
#pragma unroll 2
    for (int k = 0; k < K; k += 32) {
        const bf16x8 a = *(const bf16x8*)(ap + k);
#pragma unroll
        for (int n = 0; n < NT; ++n) { const bf16x8 b = *(const bf16x8*)(bp + (size_t)n * 16 * ldb + k); acc[n] = mfma16(a, b, acc[n]); }
    }
}

DEV void memkv_phase(Frame& F) {
    const int gw = F.vcu * NWAVES + F.wave, NGW = F.G * NWAVES, lane = F.lane, l16 = lane & 15, g4 = lane >> 4;
    const bf16* MB = wsp<bf16>(F, WS_MEMB); const float* SSQM = wsp<float>(F, WS_SMALL) + 1024;
    bf16* MK = wsp<bf16>(F, WS_MK); bf16* MVT = wsp<bf16>(F, WS_MVT);
    for (int task = gw; task < 1024; task += NGW) {
        const int l2 = task >> 9, rt = (task >> 3) & 63, chunk = task & 7;
        f32x4 acc[4];
        skinny16<4>(MB + (size_t)rt * 16 * 1024, 1024, wsp<bf16>(F, WS_WKV) + ((size_t)l2 * 512 + chunk * 64) * 1024, 1024, 1024, lane, acc);
        const int b = rt >> 4, key0 = (rt & 15) * 16 + g4 * 4;
        float rs[4];
#pragma unroll
        for (int r = 0; r < 4; ++r) rs[r] = 1.0f / sqrtf(SSQM[rt * 16 + g4 * 4 + r] * (1.0f / 1024.0f) + RMS_EPS);
#pragma unroll
        for (int nt = 0; nt < 4; ++nt) {
            const int n = chunk * 64 + nt * 16 + l16;
            if (chunk < 4) { const int head = n >> 6, d = n & 63;
#pragma unroll
                for (int r = 0; r < 4; ++r) MK[((size_t)((l2 * 4 + b) * 4 + head) * 256 + key0 + r) * 64 + d] = (bf16)f2bf(acc[nt][r] * rs[r]);
            } else { const int n2 = n - 256, head = n2 >> 6, d = n2 & 63;
                v2u w; w.x = pk2(acc[nt][0] * rs[0], acc[nt][1] * rs[1]); w.y = pk2(acc[nt][2] * rs[2], acc[nt][3] * rs[3]);
                *(v2u*)(MVT + (((size_t)((l2 * 4 + b) * 4 + head) * 8 + (key0 >> 5)) * 64 + d) * 32 + slot32(key0 & 31)) = w; }
        }
    }
}

DEV void compress_phase(Frame& F, int l) {
    const int lane = F.lane, l16 = lane & 15, g4 = lane >> 4, quad = F.wave >> 2, q = F.wave & 3;
    float* part = (float*)F.ldsg + quad * (4 * 16 * 128);
    const bf16* KCR = wsp<bf16>(F, WS_KCR); const bf16* VCR = wsp<bf16>(F, WS_VCR);
    bf16* KCC = wsp<bf16>(F, WS_KCC); bf16* VCT = wsp<bf16>(F, WS_VCT);
    const float* bias1 = wsp<float>(F, WS_SMALL);
    for (int tk0 = F.vcu * 2; tk0 < 512; tk0 += F.G * 2) {
        const int tk = tk0 + quad; const int kv = tk >> 8, tile = tk & 255;
        const bf16* raw = kv ? VCR : KCR;
        const bf16* w1 = wsp<bf16>(F, WS_W1C) + (size_t)(l * 2 + kv) * 128 * 2048;
        const bf16* w2 = wsp<bf16>(F, WS_W2C) + (size_t)(l * 2 + kv) * 64 * 128;
        { const int r = tile * 16 + l16, bh = r >> 9, c = r & 511, b = bh >> 1, hkv = bh & 1;
          f32x4 acc[8];
#pragma unroll
          for (int n = 0; n < 8; ++n) acc[n] = (f32x4){0.f, 0.f, 0.f, 0.f};
#pragma unroll 2
          for (int ks = q * 16; ks < q * 16 + 16; ++ks) {
              const int kk = ks * 32 + g4 * 8, ll = kk >> 6, d = kk & 63;
              int tok = 16 * c + ll; tok = tok > T - 1 ? T - 1 : tok;
              const bf16x8 a = *(const bf16x8*)(raw + ((size_t)b * T + tok) * 128 + hkv * 64 + d);
#pragma unroll
              for (int n = 0; n < 8; ++n) { const bf16x8 bb = *(const bf16x8*)(w1 + (size_t)(n * 16 + l16) * 2048 + kk); acc[n] = mfma16(a, bb, acc[n]); }
          }
#pragma unroll
          for (int n = 0; n < 8; ++n)
#pragma unroll
              for (int r2 = 0; r2 < 4; ++r2) part[(q * 16 + g4 * 4 + r2) * 128 + n * 16 + l16] = acc[n][r2];
        }
        __syncthreads();
        { f32x4 o = (f32x4){0.f, 0.f, 0.f, 0.f};
#pragma unroll
          for (int k2 = 0; k2 < 4; ++k2) {
              const int h0 = k2 * 32 + g4 * 8;
              float hv[8];
#pragma unroll
              for (int j = 0; j < 8; ++j) { float s = bias1[(l * 2 + kv) * 128 + h0 + j];
#pragma unroll
                  for (int p = 0; p < 4; ++p) s += part[(p * 16 + l16) * 128 + h0 + j];
                  hv[j] = siluf_(s); }
              bf16x8 a; { v4u w; w.x = pk2(hv[0], hv[1]); w.y = pk2(hv[2], hv[3]); w.z = pk2(hv[4], hv[5]); w.w = pk2(hv[6], hv[7]); a = __builtin_bit_cast(bf16x8, w); }
              const bf16x8 bb = *(const bf16x8*)(w2 + (size_t)(q * 16 + l16) * 128 + h0);
              o = mfma16(a, bb, o);
          }
          const int r0 = tile * 16 + g4 * 4, bh = r0 >> 9, c0 = r0 & 511, d = q * 16 + l16;
          if (kv == 0) {
#pragma unroll
              for (int r2 = 0; r2 < 4; ++r2) KCC[((size_t)bh * 512 + c0 + r2) * 64 + d] = (c0 + r2 == 511) ? (bf16)0 : (bf16)f2bf(o[r2]);
          } else {
              v2u w; w.x = pk2(o[0], o[1]); w.y = pk2(o[2], (c0 + 3 == 511) ? 0.f : o[3]);
              *(v2u*)(VCT + (((size_t)bh * 16 + (c0 >> 5)) * 64 + d) * 32 + slot32(c0 & 31)) = w;
          }
        }
        __syncthreads();
    }
}

DEV float hgrn_lb(const Frame& F, int l, int c) {
    if (l == 0) return 0.f;
    const float a = inp(7)[c], b = inp(7)[256 + c];
    return 1.0f / (1.0f + expf(a - b));
}
DEV float hgrn_logf(float z, float lb) {
    const float la = logf(fmaxf(lb, 1e-30f));
    const float ls = fminf(z, 0.f) - log1pf(expf(-fabsf(z)));
    const float lc = log1pf(-lb) + ls;
    const float mx = fmaxf(la, lc), mn = fminf(la, lc);
    return mx + log1pf(expf(mn - mx));
}
constexpr int HS = 68;
DEV f32x4 mfma4(float a, float b, f32x4 c) { return __builtin_amdgcn_mfma_f32_16x16x4f32(a, b, c, 0, 0, 0); }
DEV void hgrn_setup_chunk(Frame& F, float lb, const float (&z)[8], float* Bc, float* Kc, float* tot) {
    const int d = F.tid & 63, sg = F.tid >> 6;
    const float la = logf(fmaxf(lb, 1e-30f)), l1m = log1pf(-lb), onem = 1.0f - lb;
    float loc[8], kv[8]; float run = 0.f;
#pragma unroll
    for (int i = 0; i < 8; ++i) {
        const float ez = __expf(-fabsf(z[i]));
        const float lc = l1m + (fminf(z[i], 0.f) - __logf(1.0f + ez));
        const float mx = fmaxf(la, lc), mn = fminf(la, lc);
        run += mx + __logf(1.0f + __expf(mn - mx)); loc[i] = run;
        kv[i] = onem * (z[i] >= 0.f ? ez : 1.0f) / (1.0f + ez);
    }
    tot[sg * 64 + d] = run;
    __syncthreads();
    float off = 0.f;
    for (int g = 0; g < sg; ++g) off += tot[g * 64 + d];
#pragma unroll
    for (int i = 0; i < 8; ++i) { Bc[(sg * 8 + i) * HS + d] = off + loc[i]; Kc[(sg * 8 + i) * HS + d] = kv[i]; }
    __syncthreads();
}
DEV void hgrn_local_phase(Frame& F, int l) {
    float* Bc = (float*)F.ldsg; float* Kc = Bc + 64 * HS; float* Vc = Kc + 64 * HS; float* tot = Vc + 64 * HS;
    float* U = wsp<float>(F, WS_U); float* DEC = wsp<float>(F, WS_DEC);
    const int lane = F.lane, w = F.wave, li = lane & 15, kq = lane >> 4;
    for (int task = F.vcu; task < 2048; task += F.G) {
        const int bh = task >> 7, ch = task & 127, b = bh >> 2, h = bh & 3;
        { const int d = F.tid & 63, sg = F.tid >> 6;
          const size_t go = ((size_t)b * T + ch * 64 + sg * 8) * 256 + h * 64 + d;
          const float* HFp = wsp<float>(F, WS_HF) + go; const bf16* HIp = wsp<bf16>(F, WS_HI) + go;
          float z[8], vi[8];
#pragma unroll
          for (int i = 0; i < 8; ++i) { z[i] = HFp[(size_t)i * 256]; vi[i] = bf2f(HIp[(size_t)i * 256]); }
          hgrn_setup_chunk(F, hgrn_lb(F, l, h * 64 + d), z, Bc, Kc, tot);
          const float bl = Bc[63 * HS + d];
#pragma unroll
          for (int i = 0; i < 8; ++i) { const int s = sg * 8 + i; Kc[s * HS + d] *= __expf(bl - Bc[s * HS + d]); Vc[s * HS + d] = vi[i]; }
          if (sg == 0) DEC[(size_t)task * 64 + d] = expf(bl); }
        __syncthreads();
        { const int dI = w >> 1, e0 = (w & 1) * 32;
          f32x4 a0 = (f32x4){0.f, 0.f, 0.f, 0.f}, a1 = a0;
#pragma unroll 4
          for (int k0 = 0; k0 < 64; k0 += 4) { const int s = k0 + kq;
              const float a = Kc[s * HS + dI * 16 + li], b0 = Vc[s * HS + e0 + li], b1 = Vc[s * HS + e0 + 16 + li];
              a0 = mfma4(a, b0, a0); a1 = mfma4(a, b1, a1); }
#pragma unroll
          for (int r = 0; r < 4; ++r) { float* up = U + ((size_t)task * 64 + dI * 16 + 4 * kq + r) * 64 + e0 + li; up[0] = a0[r]; up[16] = a1[r]; } }
        __syncthreads();
    }
}
DEV void hgrn_scan_phase(Frame& F, int probe = 0) {
    const float* U = wsp<float>(F, WS_U); float* U2 = wsp<float>(F, probe ? WS_PROBE : WS_U2); const float* DEC = wsp<float>(F, WS_DEC);
    const int nact = (F.G * 256 >= 65536) ? 256 : 512;
    if (F.tid < nact)
    for (int gid = F.vcu * nact + F.tid; gid < 65536; gid += F.G * nact) {
        const int bh = gid >> 12, de = gid & 4095, d = de >> 6;
        float S = 0.f; const float* up = U + (size_t)bh * 128 * 4096 + de; float* op = U2 + (size_t)bh * 128 * 4096 + de; const float* dp = DEC + (size_t)bh * 128 * 64 + d;
#pragma unroll 16
        for (int ch = 0; ch < 128; ++ch) { const float u = up[(size_t)ch * 4096]; const float dc = dp[ch * 64]; op[(size_t)ch * 4096] = S; S = dc * S + u; }
    }
}
DEV void hgrn_out_phase(Frame& F, int l) {
    float* Bc = (float*)F.ldsg; float* Kb = Bc + 64 * HS; float* Vc = Kb + 64 * HS; float* Qs = Vc + 64 * HS; float* Sc = Qs + 64 * HS; float* Ac = Sc + 64 * HS; float* tot = Ac + 64 * HS;
    float* Oc = Kb;
    const float* U = wsp<float>(F, WS_U2); bf16* CAT = wsp<bf16>(F, WS_CAT);
    const int lane = F.lane, w = F.wave, li = lane & 15, kq = lane >> 4;
    for (int task = F.vcu; task < 2048; task += F.G) {
        const int bh = task >> 7, ch = task & 127, b = bh >> 2, h = bh & 3;
        float gv[8];
        { const int d = F.tid & 63, sg = F.tid >> 6;
          const size_t go = ((size_t)b * T + ch * 64 + sg * 8) * 256 + h * 64 + d;
          const float* HFp = wsp<float>(F, WS_HF) + go; const bf16* HIp = wsp<bf16>(F, WS_HI) + go; const bf16* HQp = wsp<bf16>(F, WS_HQ) + go; const bf16* HGp = wsp<bf16>(F, WS_HG) + go;
          const float* Up = U + ((size_t)task * 64 + sg * 8) * 64 + d;
          float z[8], vi[8], qi[8], si[8];
#pragma unroll
          for (int i = 0; i < 8; ++i) { z[i] = HFp[(size_t)i * 256]; vi[i] = bf2f(HIp[(size_t)i * 256]); qi[i] = bf2f(HQp[(size_t)i * 256]); gv[i] = bf2f(HGp[(size_t)i * 256]); si[i] = Up[(size_t)i * 64]; }
          hgrn_setup_chunk(F, hgrn_lb(F, l, h * 64 + d), z, Bc, Kb, tot);
#pragma unroll
          for (int i = 0; i < 8; ++i) { const int s = sg * 8 + i, J = s >> 4; const float rJ = J ? Bc[(16 * J - 1) * HS + d] : 0.f;
              Kb[s * HS + d] *= __expf(fminf(rJ - Bc[s * HS + d], 80.f));
              Vc[s * HS + d] = vi[i]; Qs[s * HS + d] = qi[i] * 0.125f; Sc[s * HS + d] = si[i]; } }
        __syncthreads();
#pragma unroll 1
        for (int ti = w; ti < 10; ti += 8) {
            const int I = ti < 1 ? 0 : (ti < 3 ? 1 : (ti < 6 ? 2 : 3)), J = ti - (I * (I + 1)) / 2;
            const int t = I * 16 + li; f32x4 acc = (f32x4){0.f, 0.f, 0.f, 0.f};
#pragma unroll 4
            for (int k0 = 0; k0 < 64; k0 += 4) { const int d = k0 + kq; const float rJ = J ? Bc[(16 * J - 1) * HS + d] : 0.f;
                const float a = Qs[t * HS + d] * __expf(Bc[t * HS + d] - rJ), bb = Kb[(J * 16 + li) * HS + d];
                acc = mfma4(a, bb, acc); }
#pragma unroll
            for (int r = 0; r < 4; ++r) { const int tt = I * 16 + 4 * kq + r, ss = J * 16 + li; Ac[tt * HS + ss] = (ss <= tt) ? acc[r] : 0.f; }
        }
        __syncthreads();
        { const int I = w >> 1, e0 = (w & 1) * 32, t = I * 16 + li;
          f32x4 a0 = (f32x4){0.f, 0.f, 0.f, 0.f}, a1 = a0;
#pragma unroll 4
          for (int k0 = 0; k0 < 64; k0 += 4) { const int d = k0 + kq;
              const float a = Qs[t * HS + d] * __expf(Bc[t * HS + d]), b0 = Sc[d * HS + e0 + li], b1 = Sc[d * HS + e0 + 16 + li];
              a0 = mfma4(a, b0, a0); a1 = mfma4(a, b1, a1); }
#pragma unroll 1
          for (int s0 = 0; s0 < 16 * (I + 1); s0 += 4) { const int s = s0 + kq;
              const float a = Ac[t * HS + s], b0 = Vc[s * HS + e0 + li], b1 = Vc[s * HS + e0 + 16 + li];
              a0 = mfma4(a, b0, a0); a1 = mfma4(a, b1, a1); }
#pragma unroll
          for (int r = 0; r < 4; ++r) { float* op = Oc + (I * 16 + 4 * kq + r) * HS + e0 + li; op[0] = a0[r]; op[16] = a1[r]; } }
        __syncthreads();
        { const float ng = inp(8)[l * 256 + h * 64 + lane];
          { const int t = w * 8 + (lane >> 3); const float* op = Oc + t * HS + (lane & 7) * 8; float s = 0.f;
#pragma unroll
            for (int j = 0; j < 8; ++j) s += op[j] * op[j];
            s += __shfl_xor(s, 1); s += __shfl_xor(s, 2); s += __shfl_xor(s, 4);
            if ((lane & 7) == 0) tot[t] = 1.0f / sqrtf(s * (1.0f / 64.0f) + RMS_EPS); }
          LDS_WAIT();
#pragma unroll
          for (int i = 0; i < 8; ++i) { const int t = w * 8 + i; const float o = Oc[t * HS + lane];
              const size_t row = (size_t)b * T + ch * 64 + t;
              CAT[row * 1024 + 768 + h * 64 + lane] = (bf16)f2bf(o * tot[t] * ng * siluf_(gv[i])); } }
        __syncthreads();
    }
}

DEV void conv_phase(Frame& F, int l) {
    const bf16* CB = wsp<bf16>(F, WS_CB); const bf16* CC = wsp<bf16>(F, WS_CC); const bf16* CH = wsp<bf16>(F, WS_CH); bf16* CAT = wsp<bf16>(F, WS_CAT);
    const float* cw = inp(3) + l * 3 * 256;
    for (int it = F.vcu * 512 + F.tid; it < NTOK * 32; it += F.G * 512) {
        const int m = it >> 5, c0 = (it & 31) * 8, t = m & (T - 1);
        const v4u bb = *(const v4u*)(CB + (size_t)m * 256 + c0);
        float y[8];
#pragma unroll
        for (int j = 0; j < 8; ++j) y[j] = 0.f;
#pragma unroll
        for (int k = 0; k < 3; ++k) {
            if (t + k - 2 >= 0) {
                const size_t o = (size_t)(m + k - 2) * 256 + c0;
                const v4u cc = *(const v4u*)(CC + o), hh = *(const v4u*)(CH + o);
#pragma unroll
                for (int j = 0; j < 4; ++j) { const float w0 = cw[k * 256 + c0 + 2 * j], w1 = cw[k * 256 + c0 + 2 * j + 1];
                    y[2 * j] += w0 * (bflo(cc[j]) * bflo(hh[j])); y[2 * j + 1] += w1 * (bfhi(cc[j]) * bfhi(hh[j])); }
            }
        }
        v4u o4;
#pragma unroll
        for (int j = 0; j < 4; ++j) o4[j] = pk2(bflo(bb[j]) * y[2 * j], bfhi(bb[j]) * y[2 * j + 1]);
        *(v4u*)(CAT + (size_t)m * 1024 + 512 + c0) = o4;
    }
}
struct SmState { float m, l; f32x4 o[4]; };
DEV void sm_reset(SmState& st) { st.m = -INFINITY; st.l = 0.f;
#pragma unroll
    for (int i = 0; i < 4; ++i) st.o[i] = (f32x4){0.f, 0.f, 0.f, 0.f}; }
DEV float sm_lsum(const SmState& st) { float l = st.l; l += __shfl_xor(l, 16); l += __shfl_xor(l, 32); return l; }
DEV void load_k(const bf16* kbase, int lane, bf16x8 (&kf)[2][2]) {
    const int l16 = lane & 15, g4 = lane >> 4;
#pragma unroll
    for (int tt = 0; tt < 2; ++tt)
#pragma unroll
        for (int ks = 0; ks < 2; ++ks) kf[tt][ks] = *(const bf16x8*)(kbase + (size_t)(16 * tt + l16) * 64 + ks * 32 + g4 * 8);
}
DEV void load_v(const bf16* vbase, int lane, bf16x8 (&vf)[4]) {
    const int l16 = lane & 15, g4 = lane >> 4;
#pragma unroll
    for (int dt = 0; dt < 4; ++dt) vf[dt] = *(const bf16x8*)(vbase + (size_t)(dt * 16 + l16) * 32 + g4 * 8);
}
DEV void qk_tile(const bf16x8 (&kf)[2][2], const bf16x8 (&qf)[2], f32x4 (&s)[2]) {
#pragma unroll
    for (int tt = 0; tt < 2; ++tt) { s[tt] = mfma16(kf[tt][0], qf[0], (f32x4){0.f, 0.f, 0.f, 0.f}); s[tt] = mfma16(kf[tt][1], qf[1], s[tt]); }
}
DEV bf16x8 pack_p(const float (&p)[2][4]) {
    v4u w; w.x = pk2(p[0][0], p[0][1]); w.y = pk2(p[0][2], p[0][3]); w.z = pk2(p[1][0], p[1][1]); w.w = pk2(p[1][2], p[1][3]);
    return __builtin_bit_cast(bf16x8, w);
}
template <int MODE, class MaskF>
DEV void attn_compute(const bf16x8 (&kf)[2][2], const bf16x8 (&vf)[4], const bf16x8 (&qf)[2], SmState& st, int lane, bool colok, MaskF mask) {
    const int g4 = lane >> 4;
    f32x4 s[2]; qk_tile(kf, qf, s);
    float sv[2][4]; float tmax = -INFINITY;
#pragma unroll
    for (int tt = 0; tt < 2; ++tt)
#pragma unroll
        for (int r = 0; r < 4; ++r) { float x = s[tt][r]; if (MODE == 2) x = mask(16 * tt + 4 * g4 + r) ? x : -INFINITY; sv[tt][r] = x; tmax = fmaxf(tmax, x); }
    if (MODE == 1) tmax = colok ? tmax : -INFINITY;
    tmax = fmaxf(tmax, __shfl_xor(tmax, 16)); tmax = fmaxf(tmax, __shfl_xor(tmax, 32));
    const float mnew = fmaxf(st.m, tmax), muse = (mnew == -INFINITY) ? 0.f : mnew;
    const float alpha = ex2(st.m - muse);
    const float msub = (MODE == 1) ? (colok ? muse : INFINITY) : muse;
    float p[2][4]; float ps = 0.f;
#pragma unroll
    for (int tt = 0; tt < 2; ++tt)
#pragma unroll
        for (int r = 0; r < 4; ++r) { p[tt][r] = ex2(sv[tt][r] - msub); ps += p[tt][r]; }
    st.l = st.l * alpha + ps; st.m = mnew;
    const bf16x8 pf = pack_p(p);
#pragma unroll
    for (int dt = 0; dt < 4; ++dt) { st.o[dt] = st.o[dt] * alpha; st.o[dt] = mfma16(vf[dt], pf, st.o[dt]); }
}
template <int MODE, class MaskF>
DEV void attn_compute_fixed(const bf16x8 (&kf)[2][2], const bf16x8 (&vf)[4], const bf16x8 (&qf)[2], SmState& st, float mref, int lane, bool colok, MaskF mask) {
    const int g4 = lane >> 4;
    f32x4 s[2]; qk_tile(kf, qf, s);
    const float msub = (MODE == 1) ? (colok ? mref : INFINITY) : mref;
    float p[2][4]; float ps = 0.f;
#pragma unroll
    for (int tt = 0; tt < 2; ++tt)
#pragma unroll
        for (int r = 0; r < 4; ++r) { float x = s[tt][r] - msub; if (MODE == 2) x = mask(16 * tt + 4 * g4 + r) ? x : -INFINITY; p[tt][r] = ex2(x); ps += p[tt][r]; }
    st.l += ps;
    const bf16x8 pf = pack_p(p);
#pragma unroll
    for (int dt = 0; dt < 4; ++dt) st.o[dt] = mfma16(vf[dt], pf, st.o[dt]);
}
template <int MODE, class MaskF>
DEV void attn_max(const bf16x8 (&kf)[2][2], const bf16x8 (&qf)[2], float& mx, int lane, bool colok, MaskF mask) {
    const int g4 = lane >> 4;
    f32x4 s[2]; qk_tile(kf, qf, s);
    float tmax = -INFINITY;
#pragma unroll
    for (int tt = 0; tt < 2; ++tt)
#pragma unroll
        for (int r = 0; r < 4; ++r) { float x = s[tt][r]; if (MODE == 2) x = mask(16 * tt + 4 * g4 + r) ? x : -INFINITY; tmax = fmaxf(tmax, x); }
    if (MODE == 1) tmax = colok ? tmax : -INFINITY;
    mx = fmaxf(mx, tmax);
}
DEV float colmax_finish(float mx) { mx = fmaxf(mx, __shfl_xor(mx, 16)); mx = fmaxf(mx, __shfl_xor(mx, 32)); return mx == -INFINITY ? 0.f : mx; }
DEV float col_norm(const bf16x8 (&qf)[2]) {
    float s = 0.f;
#pragma unroll
    for (int ks = 0; ks < 2; ++ks) { const v4u w = __builtin_bit_cast(v4u, qf[ks]);
#pragma unroll
        for (int j = 0; j < 4; ++j) { const float a = bflo(w[j]), b = bfhi(w[j]); s += a * a + b * b; } }
    s += __shfl_xor(s, 16); s += __shfl_xor(s, 32);
    return sqrtf(s);
}
DEV float wave_max_uniform(float v) {
#pragma unroll
    for (int o = 1; o < 64; o <<= 1) v = fmaxf(v, __shfl_xor(v, o));
    return __builtin_bit_cast(float, __builtin_amdgcn_readfirstlane(__builtin_bit_cast(int, v)));
}
constexpr float FIXED_REF_MAX = 40.f;
DEV void kmax_phase(Frame& F, int l) {
    const int lane = F.lane; const int gw = F.vcu * NWAVES + F.wave, NGW = F.G * NWAVES;
    for (int item = gw; item < 2048; item += NGW) {
        const int br = item >> 10, bh = (item >> 7) & 7, key = (item & 127) * 64 + lane;
        const bf16* kp = wsp<bf16>(F, br ? WS_KW : WS_KS) + ((size_t)bh * T + key) * 64;
        float s = 0.f;
#pragma unroll
        for (int i = 0; i < 8; ++i) { const v4u w = *(const v4u*)(kp + i * 8);
#pragma unroll
            for (int j = 0; j < 4; ++j) { const float a = bflo(w[j]), b = bfhi(w[j]); s += a * a + b * b; } }
#pragma unroll
        for (int o = 1; o < 64; o <<= 1) s = fmaxf(s, __shfl_xor(s, o));
        if (lane == 0) __hip_atomic_fetch_max((unsigned*)F.ctl + CW_KMAX + l * 16 + br * 8 + bh, __builtin_bit_cast(unsigned, s), RLX_AGENT);
    }
}
struct NoMask { DEV bool operator()(int) const { return true; } };
template <int D, bool WITHV, class AddrF, class BodyF>
DEV void pipe_run(int n, int lane, AddrF addr, BodyF body) {
    if (n <= 0) return;
    bf16x8 kf[D][2][2], vf[D][4];
#pragma unroll
    for (int d = 0; d < D; ++d) { const bf16* kb; const bf16* vb; addr(d < n ? d : n - 1, kb, vb); load_k(kb, lane, kf[d]); if (WITHV) load_v(vb, lane, vf[d]); }
#pragma unroll 1
    for (int i = 0; i < n; i += D) {
#pragma unroll
        for (int d = 0; d < D; ++d) { const int s = i + d;
            if (s < n) body(s, kf[d], vf[d]);
            if (D > 1 || s + 1 < n) { const bf16* kb; const bf16* vb; addr(s + D < n ? s + D : n - 1, kb, vb); load_k(kb, lane, kf[d]); if (WITHV) load_v(vb, lane, vf[d]); } }
    }
}
template <class AddrF, class BodyF>
DEV void pipe_run_k2(int n, int lane, AddrF addr, BodyF body) {
    if (n <= 0) return;
    bf16x8 kf[2][2][2], vf[4];
    { const bf16* kb; const bf16* vb; addr(0, kb, vb); load_k(kb, lane, kf[0]); }
#pragma unroll 1
    for (int i = 0; i < n; i += 2) {
#pragma unroll
        for (int d = 0; d < 2; ++d) { const int s = i + d;
            { const bf16* kb; const bf16* vb; addr(s < n ? s : n - 1, kb, vb); load_v(vb, lane, vf); }
            { const bf16* kb; const bf16* vb; addr(s + 1 < n ? s + 1 : n - 1, kb, vb); load_k(kb, lane, kf[d ^ 1]); }
            if (s < n) body(s, kf[d], vf); }
    }
}
constexpr int PIPE_D = 2;

DEV void acc_add_packed(unsigned (&pk)[4][4][2], int ct, const f32x4 (&o)[4], float sc, bool first) {
#pragma unroll
    for (int dt = 0; dt < 4; ++dt) {
        f32x4 v = o[dt] * sc;
        if (!first) { v[0] += bflo(pk[ct][dt][0]); v[1] += bfhi(pk[ct][dt][0]); v[2] += bflo(pk[ct][dt][1]); v[3] += bfhi(pk[ct][dt][1]); }
        pk[ct][dt][0] = pk2(v[0], v[1]); pk[ct][dt][1] = pk2(v[2], v[3]);
    }
}
template <int VAR>
DEV void nsa_phase_t(Frame& F, int l) {
#define NSA_RELANE() int ln_ = lane; asm volatile("" : "+v"(ln_)); const int l16 = ln_ & 15, g4 = ln_ >> 4, tq = l16 >> 2, gh = l16 & 3; const size_t mrow0 = (size_t)b * T + t0 + tq; const int tl0 = t0 + tq; (void)l16; (void)g4; (void)gh; (void)mrow0; (void)tl0
    float* IMP = (float*)(F.ldsg + F.wave * NSA_LDS_WAVE);
    float* VALS = IMP + 2048; int* BL = (int*)(IMP + 2176); unsigned* SELB = (unsigned*)(IMP + 2304); float* GL = IMP + 2432;
    const bf16* Q = wsp<bf16>(F, WS_Q); const bf16* QR = wsp<bf16>(F, WS_QR);
    const bf16* KCC = wsp<bf16>(F, WS_KCC); const bf16* VCT = wsp<bf16>(F, WS_VCT);
    const bf16* KS = wsp<bf16>(F, WS_KS); const bf16* VST = wsp<bf16>(F, WS_VST);
    const bf16* KW = wsp<bf16>(F, WS_KW); const bf16* VWT = wsp<bf16>(F, WS_VWT);
    bf16* CAT = wsp<bf16>(F, WS_CAT);
    const int gw = F.vcu * NWAVES + F.wave, NGW = F.G * NWAVES;
    const bool xmap = (F.G == 256);
#pragma unroll 1
    for (int task = gw; task < 4096; task += NGW) {
        unsigned zl_ = 0u; asm volatile("" : "+v"(zl_)); const int lane = (int)__builtin_amdgcn_mbcnt_hi(~0u, __builtin_amdgcn_mbcnt_lo(~0u, zl_));
        const int bh = xmap ? (gw >> 8) : (task & 7), idx = xmap ? ((task >> 11) ? 511 - (gw & 255) : (gw & 255)) : (task >> 3);
        const int t0 = idx * 16, b = bh >> 1, hkv = bh & 1, cur = t0 >> 6;
        bf16x8 qf[4][2];
        unsigned opk[4][4][2];
        SmState st[4];
        float qnmax = 0.f;
        { NSA_RELANE();
#pragma unroll
        for (int ct = 0; ct < 4; ++ct)
#pragma unroll
            for (int ks = 0; ks < 2; ++ks) qf[ct][ks] = *(const bf16x8*)(Q + (mrow0 + 4 * ct) * 512 + hkv * 256 + gh * 64 + ks * 32 + g4 * 8);
        { NSA_RELANE();
          f32x4 ga[1]; ga[0] = (f32x4){0.f, 0.f, 0.f, 0.f};
          { const bf16* ap = wsp<bf16>(F, WS_HB) + ((size_t)b * T + t0 + l16) * 1024 + g4 * 8; const bf16* bp = wsp<bf16>(F, WS_WG) + (size_t)((l * 2 + hkv) * 16 + l16) * 1024 + g4 * 8;
#pragma unroll 1
            for (int k0 = 0; k0 < 1024; k0 += 256) {
                bf16x8 av[8], bv[8];
#pragma unroll
                for (int i = 0; i < 8; ++i) { av[i] = *(const bf16x8*)(ap + k0 + 32 * i); bv[i] = *(const bf16x8*)(bp + k0 + 32 * i); }
#pragma unroll
                for (int i = 0; i < 8; ++i) ga[0] = mfma16(av[i], bv[i], ga[0]);
            } }
          const float rs = (ln_ < 16) ? row_rstd_full(wsp<float>(F, WS_SSQ), b * T + t0 + ln_) : 0.f;
#pragma unroll
          for (int r = 0; r < 4; ++r) GL[(g4 * 4 + r) * 16 + l16] = sigmoidf_(ga[0][r] * __shfl(rs, g4 * 4 + r));
        }
        const int ngc = (t0 + 15 >= 31) ? (((t0 + 15 - 31) >> 4) >> 5) + 1 : 0;
        const bf16* kcb = KCC + (size_t)bh * 512 * 64; const bf16* vcb = VCT + (size_t)bh * 16 * 64 * 32;
        float cm[4], cl[4];
#pragma unroll
        for (int ct = 0; ct < 4; ++ct) { cm[ct] = -INFINITY; cl[ct] = 0.f; }
        pipe_run<1, false>(ngc, ln_, [&](int s, const bf16*& kb, const bf16*& vb) { kb = kcb + (size_t)s * 32 * 64; vb = vcb; },
            [&](int kg, const bf16x8 (&kf)[2][2], const bf16x8 (&)[4]) {
#pragma unroll
                for (int ct = 0; ct < 4; ++ct) {
                    const int tl = tl0 + 4 * ct;
                    f32x4 s[2]; qk_tile(kf, qf[ct], s);
                    float sv[2][4]; float tmax = -INFINITY;
#pragma unroll
                    for (int tt = 0; tt < 2; ++tt)
#pragma unroll
                        for (int r = 0; r < 4; ++r) { const int c = kg * 32 + 16 * tt + 4 * g4 + r; sv[tt][r] = (16 * c + 31 <= tl) ? s[tt][r] : -INFINITY; tmax = fmaxf(tmax, sv[tt][r]); }
                    tmax = fmaxf(tmax, __shfl_xor(tmax, 16)); tmax = fmaxf(tmax, __shfl_xor(tmax, 32));
                    const float mnew = fmaxf(cm[ct], tmax), muse = (mnew == -INFINITY) ? 0.f : mnew;
                    float ps = 0.f;
#pragma unroll
                    for (int tt = 0; tt < 2; ++tt)
#pragma unroll
                        for (int r = 0; r < 4; ++r) ps += ex2(sv[tt][r] - muse);
                    cl[ct] = cl[ct] * ex2(cm[ct] - muse) + ps; cm[ct] = mnew;
                }
            });
        {
            float cmu[4], cinv[4], carry[4];
#pragma unroll
            for (int ct = 0; ct < 4; ++ct) { float l = cl[ct]; l += __shfl_xor(l, 16); l += __shfl_xor(l, 32);
                cmu[ct] = (cm[ct] == -INFINITY) ? 0.f : cm[ct]; cinv[ct] = l > 0.f ? 1.0f / l : 0.f; carry[ct] = 0.f; sm_reset(st[ct]); }
            pipe_run<1, true>(ngc, ln_, [&](int s, const bf16*& kb, const bf16*& vb) { kb = kcb + (size_t)s * 32 * 64; vb = vcb + (size_t)s * 64 * 32; },
                [&](int kg, const bf16x8 (&kf)[2][2], const bf16x8 (&vf)[4]) {
#pragma unroll
                    for (int ct = 0; ct < 4; ++ct) {
                        const int tl = tl0 + 4 * ct;
                        f32x4 s[2]; qk_tile(kf, qf[ct], s);
                        float p[2][4];
#pragma unroll
                        for (int tt = 0; tt < 2; ++tt) {
#pragma unroll
                            for (int r = 0; r < 4; ++r) { const int c = kg * 32 + 16 * tt + 4 * g4 + r; p[tt][r] = (16 * c + 31 <= tl) ? ex2(s[tt][r] - cmu[ct]) * cinv[ct] : 0.f; }
                            const float hb = 0.5f * p[tt][3];
                            const float bsh = __shfl(hb, (ln_ + 48) & 63);
                            float v = ((p[tt][0] + p[tt][1]) + (p[tt][2] + hb)) + ((g4 == 0) ? carry[ct] : bsh);
                            carry[ct] = bsh;
                            v += __shfl_xor(v, 1); v += __shfl_xor(v, 2);
                            if (gh == 0) IMP[(4 * ct + tq) * 128 + kg * 8 + 4 * tt + g4] = v;
                        }
                        const bf16x8 pf = pack_p(p);
#pragma unroll
                        for (int dt = 0; dt < 4; ++dt) st[ct].o[dt] = mfma16(vf[dt], pf, st[ct].o[dt]);
                    }
                });
#pragma unroll
            for (int ct = 0; ct < 4; ++ct) acc_add_packed(opk, ct, st[ct].o, GL[(4 * ct + tq) * 16 + gh * 3 + 0], true);
        }
        }
        LDS_WAIT();
        unsigned sb0 = 0u, sb1 = 0u;
        if (cur < 16) { sb0 = (lane <= cur) ? 0xffffu : 0u; }
        else {
            const unsigned long long below = (1ull << lane) - 1ull;
#pragma unroll 1
            for (int q = 0; q < 16; ++q) {
                unsigned k0, k1;
                { const int j = lane; const float v = (j == 0 || j == cur || j == cur - 1) ? 1e6f : IMP[q * 128 + j]; k0 = (j > cur) ? 0u : __builtin_bit_cast(unsigned, v) + 1u; }
                { const int j = lane + 64; const float v = (j == cur || j == cur - 1) ? 1e6f : IMP[q * 128 + j]; k1 = (j > cur) ? 0u : __builtin_bit_cast(unsigned, v) + 1u; }
                unsigned lo = 0u, hi = 0xffffffffu;
                while (hi - lo > 1u) { const unsigned mid = lo + ((hi - lo) >> 1);
                    const int c = __builtin_popcountll(__ballot(k0 >= mid)) + __builtin_popcountll(__ballot(k1 >= mid));
                    if (c >= 16) lo = mid; else hi = mid; }
                const unsigned long long g0 = __ballot(k0 > lo), g1 = __ballot(k1 > lo), e0 = __ballot(k0 == lo), e1 = __ballot(k1 == lo);
                const int need = 16 - __builtin_popcountll(g0) - __builtin_popcountll(g1);
                const bool s0 = (k0 > lo) || (k0 == lo && __builtin_popcountll(e0 & below) < need);
                const bool s1 = (k1 > lo) || (k1 == lo && __builtin_popcountll(e0) + __builtin_popcountll(e1 & below) < need);
                sb0 |= (s0 ? 1u : 0u) << q; sb1 |= (s1 ? 1u : 0u) << q;
            }
        }
        SELB[lane] = sb0; SELB[lane + 64] = sb1;
        LDS_WAIT();
#define NSA_PARK() do { _Pragma("unroll") for (int i_ = 0; i_ < 8; ++i_) { v4u w_; w_.x = opk[i_ >> 1][(i_ & 1) * 2][0]; w_.y = opk[i_ >> 1][(i_ & 1) * 2][1]; w_.z = opk[i_ >> 1][(i_ & 1) * 2 + 1][0]; w_.w = opk[i_ >> 1][(i_ & 1) * 2 + 1][1]; ((v4u*)IMP)[i_ * 64 + lane] = w_; } } while (0)
#define NSA_UNPARK() do { _Pragma("unroll") for (int i_ = 0; i_ < 8; ++i_) { const v4u w_ = ((const v4u*)IMP)[i_ * 64 + lane]; opk[i_ >> 1][(i_ & 1) * 2][0] = w_.x; opk[i_ >> 1][(i_ & 1) * 2][1] = w_.y; opk[i_ >> 1][(i_ & 1) * 2 + 1][0] = w_.z; opk[i_ >> 1][(i_ & 1) * 2 + 1][1] = w_.w; } } while (0)
        NSA_PARK();
        { NSA_RELANE();
#pragma unroll
        for (int ct = 0; ct < 4; ++ct)
#pragma unroll
            for (int ks = 0; ks < 2; ++ks) qf[ct][ks] = *(const bf16x8*)(QR + (mrow0 + 4 * ct) * 512 + hkv * 256 + gh * 64 + ks * 32 + g4 * 8);
        {
            const unsigned long long ulo = __ballot(sb0 != 0u), uhi = __ballot(sb1 != 0u);
            const unsigned long long below = (1ull << ln_) - 1ull;
            const int nlo = __builtin_popcountll(ulo), nblk = nlo + __builtin_popcountll(uhi);
            if (sb0 != 0u) BL[__builtin_popcountll(ulo & below)] = ln_;
            if (sb1 != 0u) BL[nlo + __builtin_popcountll(uhi & below)] = ln_ + 64;
            LDS_WAIT();
#pragma unroll
            for (int ct = 0; ct < 4; ++ct) sm_reset(st[ct]);
            const bf16* kb0 = KS + (size_t)bh * T * 64; const bf16* vb0 = VST + (size_t)bh * 256 * 64 * 32;
            float mr; bool fixed;
            { const float kmx = sqrtf(__builtin_bit_cast(float, __hip_atomic_load((const unsigned*)F.ctl + CW_KMAX + l * 16 + bh, RLX_AGENT))); float mm = 0.f;
#pragma unroll
              for (int ct = 0; ct < 4; ++ct) mm = fmaxf(mm, col_norm(qf[ct]));
              qnmax = wave_max_uniform(mm); mr = qnmax * kmx * 1.002f + 1e-3f;
              fixed = mr < FIXED_REF_MAX; }
            auto addr_sel = [&](int s, const bf16*& kb, const bf16*& vb) { const int g32 = BL[s >> 1] * 2 + (s & 1); kb = kb0 + (size_t)g32 * 32 * 64; vb = vb0 + (size_t)g32 * 64 * 32; };
            asm volatile("" ::: "memory");
            if (!fixed) {
                float mx[4] = {-INFINITY, -INFINITY, -INFINITY, -INFINITY};
                pipe_run<1, false>(2 * nblk, ln_, addr_sel,
                    [&](int s, const bf16x8 (&kf)[2][2], const bf16x8 (&)[4]) {
                        const int j = BL[s >> 1], key0 = j * 64 + (s & 1) * 32;
                        const unsigned tm = (unsigned)__builtin_amdgcn_readfirstlane((int)SELB[j]);
#pragma unroll
                        for (int ct = 0; ct < 4; ++ct) { const unsigned tmk = (tm >> (4 * ct)) & 0xFu;
                            if (tmk) { const bool colok = (tmk >> tq) & 1u; const int tl = tl0 + 4 * ct;
                                if (j == cur) attn_max<2>(kf, qf[ct], mx[ct], ln_, true, [&](int kk) { return colok && (key0 + kk <= tl); });
                                else attn_max<1>(kf, qf[ct], mx[ct], ln_, colok, NoMask()); } }
                    });
                mr = wave_max_uniform(fmaxf(fmaxf(mx[0], mx[1]), fmaxf(mx[2], mx[3]))); if (mr == -INFINITY) mr = 0.f;
            }
            asm volatile("" ::: "memory");
            pipe_run_k2(2 * nblk, ln_, addr_sel,
                [&](int s, const bf16x8 (&kf)[2][2], const bf16x8 (&vf)[4]) {
                    const int j = BL[s >> 1], key0 = j * 64 + (s & 1) * 32;
                    const unsigned tm = (unsigned)__builtin_amdgcn_readfirstlane((int)SELB[j]);
#pragma unroll
                    for (int ct = 0; ct < 4; ++ct) {
                        const unsigned tmk = (tm >> (4 * ct)) & 0xFu;
                        if (tmk) {
                            const bool colok = (tmk >> tq) & 1u; const int tl = tl0 + 4 * ct;
                            if (j == cur) attn_compute_fixed<2>(kf, vf, qf[ct], st[ct], mr, ln_, true, [&](int kk) { return colok && (key0 + kk <= tl); });
                            else attn_compute_fixed<1>(kf, vf, qf[ct], st[ct], mr, ln_, colok, NoMask());
                        }
                        __builtin_amdgcn_sched_barrier(0);
                    }
                });
            LDS_WAIT();
            NSA_UNPARK();
#pragma unroll
            for (int ct = 0; ct < 4; ++ct) { const float ls = sm_lsum(st[ct]); const float gs = GL[(4 * ct + tq) * 16 + gh * 3 + 1];
                acc_add_packed(opk, ct, st[ct].o, ls > 0.f ? gs / ls : 0.f, false); }
            NSA_PARK();
        }
        }
        { NSA_RELANE();
#pragma unroll
            for (int ct = 0; ct < 4; ++ct) sm_reset(st[ct]);
            const bf16* kb0 = (VAR == 3 ? KS : KW) + (size_t)bh * T * 64; const bf16* vb0 = (VAR == 3 ? VST : VWT) + (size_t)bh * 256 * 64 * 32;
            const int glo = (t0 - 511 > 0 ? t0 - 511 : 0) >> 5, ghi = (t0 + 15) >> 5;
            float mr; bool fixed;
            { const float kmx = sqrtf(__builtin_bit_cast(float, __hip_atomic_load((const unsigned*)F.ctl + CW_KMAX + l * 16 + 8 + bh, RLX_AGENT)));
              mr = qnmax * kmx * 1.002f + 1e-3f;
              fixed = mr < FIXED_REF_MAX; }
            auto addr_win = [&](int s, const bf16*& kb, const bf16*& vb) { kb = kb0 + (size_t)(glo + s) * 32 * 64; vb = vb0 + (size_t)(glo + s) * 64 * 32; };
            asm volatile("" ::: "memory");
            if (!fixed) {
                float mx[4] = {-INFINITY, -INFINITY, -INFINITY, -INFINITY};
                pipe_run<1, false>(ghi - glo + 1, ln_, addr_win,
                    [&](int s, const bf16x8 (&kf)[2][2], const bf16x8 (&)[4]) {
                        const int key0 = (glo + s) * 32;
#pragma unroll
                        for (int ct = 0; ct < 4; ++ct) { const int tl = tl0 + 4 * ct;
                            attn_max<2>(kf, qf[ct], mx[ct], ln_, true, [&](int kk) { const int kp = key0 + kk; return kp <= tl && kp + 512 > tl; }); }
                    });
                mr = wave_max_uniform(fmaxf(fmaxf(mx[0], mx[1]), fmaxf(mx[2], mx[3]))); if (mr == -INFINITY) mr = 0.f;
            }
            asm volatile("" ::: "memory");
            pipe_run_k2(ghi - glo + 1, ln_, addr_win,
                [&](int s, const bf16x8 (&kf)[2][2], const bf16x8 (&vf)[4]) {
                    const int key0 = (glo + s) * 32;
#pragma unroll
                    for (int ct = 0; ct < 4; ++ct) {
                        const int tlo = t0 + 4 * ct, thi = tlo + 3, tl = tl0 + 4 * ct;
                        if (key0 > thi || key0 + 31 + 512 <= tlo) continue;
                        if (key0 + 512 > thi && key0 + 31 <= tlo) attn_compute_fixed<0>(kf, vf, qf[ct], st[ct], mr, ln_, true, NoMask());
                        else attn_compute_fixed<2>(kf, vf, qf[ct], st[ct], mr, ln_, true, [&](int kk) { const int kp = key0 + kk; return kp <= tl && kp + 512 > tl; });
                        __builtin_amdgcn_sched_barrier(0);
                    }
                });
            NSA_UNPARK();
#pragma unroll
            for (int ct = 0; ct < 4; ++ct) { const float ls = sm_lsum(st[ct]); const float gwn = GL[(4 * ct + tq) * 16 + gh * 3 + 2];
                acc_add_packed(opk, ct, st[ct].o, ls > 0.f ? gwn / ls : 0.f, false); }
        }
        { NSA_RELANE();
#pragma unroll
        for (int ct = 0; ct < 4; ++ct)
#pragma unroll
            for (int dt = 0; dt < 4; ++dt) { v2u w; w.x = opk[ct][dt][0]; w.y = opk[ct][dt][1];
                if (VAR == 0 || w.x == 0x7fc17fc1u) *(v2u*)(CAT + (mrow0 + 4 * ct) * 1024 + hkv * 256 + gh * 64 + dt * 16 + g4 * 4) = w; }
        }
        LDS_WAIT();
    }
#undef NSA_RELANE
#undef NSA_PARK
#undef NSA_UNPARK
}

DEV void nsa_phase(Frame& F, int l) { nsa_phase_t<0>(F, l); }

DEV void cross_phase(Frame& F, int l) {
    const int lane = F.lane, l16 = lane & 15, g4 = lane >> 4;
    const bf16* XQ = wsp<bf16>(F, WS_XQ); bf16* XO = wsp<bf16>(F, WS_XO);
    const int gw = F.vcu * NWAVES + F.wave, NGW = F.G * NWAVES;
#pragma unroll 1
    for (int task = gw; task < 8192; task += NGW) {
        const int head = task & 3, m0 = (task >> 2) * 16, b = m0 >> 13;
        bf16x8 qf[2];
#pragma unroll
        for (int ks = 0; ks < 2; ++ks) qf[ks] = *(const bf16x8*)(XQ + (size_t)(m0 + l16) * 256 + head * 64 + ks * 32 + g4 * 8);
        const bf16* kb0 = wsp<bf16>(F, WS_MK) + (size_t)((l * 4 + b) * 4 + head) * 256 * 64;
        const bf16* vb0 = wsp<bf16>(F, WS_MVT) + (size_t)((l * 4 + b) * 4 + head) * 8 * 64 * 32;
        SmState st; sm_reset(st);
        pipe_run<PIPE_D, true>(8, lane, [&](int s, const bf16*& kb, const bf16*& vb) { kb = kb0 + (size_t)s * 32 * 64; vb = vb0 + (size_t)s * 64 * 32; },
            [&](int, const bf16x8 (&kf)[2][2], const bf16x8 (&vf)[4]) { attn_compute<0>(kf, vf, qf, st, lane, true, NoMask()); });
        const float inv = 1.0f / sm_lsum(st);
#pragma unroll
        for (int dt = 0; dt < 4; ++dt) { const f32x4 o = st.o[dt] * inv; v2u w; w.x = pk2(o[0], o[1]); w.y = pk2(o[2], o[3]);
            *(v2u*)(XO + (size_t)(m0 + l16) * 256 + head * 64 + dt * 16 + g4 * 4) = w; }
    }
}

DEV void router_phase(Frame& F, int l, int probe = 0) {
    const int lane = F.lane, l16 = lane & 15, g4 = lane >> 4;
    float* LG = (float*)F.ldsg + F.wave * 768;
    const float* H = (const float*)(const GAS float*)F.out; const float* SSQ = wsp<float>(F, WS_SSQ);
    const bf16* WR = wsp<bf16>(F, WS_WR) + (size_t)l * 96 * 1024;
    int* TOKE = wsp<int>(F, probe ? WS_PROBE : WS_TOKE); float* TOKG = wsp<float>(F, probe ? WS_PROBE + MiB : WS_TOKG); int* TOKP = wsp<int>(F, probe ? WS_PROBE + 2 * MiB : WS_TOKP);
    unsigned* CNT = (unsigned*)F.ctl + CW_CNT + l * 32 + (probe ? 64 : 0);
    const float* bg = inp(14) + l * 4; const float* be = inp(16) + l * 32;
    unsigned* HIST = (unsigned*)((float*)F.ldsg + 8 * 768);
#pragma unroll 1
    for (int tb = F.vcu * NWAVES; tb < NTOK / 16; tb += F.G * NWAVES) {
        const int task = tb + F.wave; const bool live = task < NTOK / 16;
        const int m0 = (live ? task : tb) * 16;
        if (F.tid < 64) HIST[F.tid] = 0u;
        f32x4 acc[3];
        {
            const float* ap = H + (size_t)(m0 + l16) * 1024 + g4 * 8; const bf16* bp = WR + (size_t)l16 * 1024 + g4 * 8;
#pragma unroll
            for (int n = 0; n < 3; ++n) acc[n] = (f32x4){0.f, 0.f, 0.f, 0.f};
#pragma unroll 4
            for (int k = 0; k < 1024; k += 32) {
                const f32x4 a0 = *(const f32x4*)(ap + k), a1 = *(const f32x4*)(ap + k + 4);
                float av[8] = {a0[0], a0[1], a0[2], a0[3], a1[0], a1[1], a1[2], a1[3]}; unsigned hi[8], lo[8];
#pragma unroll
                for (int j = 0; j < 8; ++j) { hi[j] = f2bf(av[j]); lo[j] = f2bf(av[j] - bf2f((unsigned short)hi[j])); }
                v4u wh, wl; wh.x = hi[0] | (hi[1] << 16); wh.y = hi[2] | (hi[3] << 16); wh.z = hi[4] | (hi[5] << 16); wh.w = hi[6] | (hi[7] << 16);
                wl.x = lo[0] | (lo[1] << 16); wl.y = lo[2] | (lo[3] << 16); wl.z = lo[4] | (lo[5] << 16); wl.w = lo[6] | (lo[7] << 16);
                const bf16x8 ah = __builtin_bit_cast(bf16x8, wh), al = __builtin_bit_cast(bf16x8, wl);
#pragma unroll
                for (int n = 0; n < 3; ++n) { const bf16x8 bh = *(const bf16x8*)(bp + (size_t)n * 16 * 1024 + k), bl = *(const bf16x8*)(bp + (size_t)(48 + n * 16) * 1024 + k);
                    acc[n] = mfma16(ah, bh, acc[n]); acc[n] = mfma16(ah, bl, acc[n]); acc[n] = mfma16(al, bh, acc[n]); }
            }
        }
#pragma unroll
        for (int nt = 0; nt < 3; ++nt)
#pragma unroll
            for (int r = 0; r < 4; ++r) LG[(g4 * 4 + r) * 48 + nt * 16 + l16] = acc[nt][r];
        LDS_WAIT();
        int id1 = 0, id2 = 0;
        if (lane < 16) {
            const int m = m0 + lane; const float rstd = row_rstd_full(SSQ, m); const float* lg = LG + lane * 48;
            float g[4];
#pragma unroll
            for (int j = 0; j < 4; ++j) g[j] = lg[j] * rstd + bg[j];
            float gmax = g[0]; int grp = 0;
#pragma unroll
            for (int j = 1; j < 4; ++j) if (g[j] > gmax) { gmax = g[j]; grp = j; }
            float den = 0.f;
#pragma unroll
            for (int j = 0; j < 4; ++j) den += expf(g[j] - gmax);
            const float psel = 1.0f / den;
            float e1 = -INFINITY, e2 = -INFINITY; int i1 = 0, i2 = 0;
            for (int j = 0; j < 8; ++j) { const float v = lg[4 + grp * 8 + j] * rstd + be[grp * 8 + j];
                if (v > e1) { e2 = e1; i2 = i1; e1 = v; i1 = j; } else if (v > e2) { e2 = v; i2 = j; } }
            const float x = expf(e2 - e1), w1 = 1.0f / (1.0f + x), w2 = x * w1;
            id1 = grp * 8 + i1; id2 = grp * 8 + i2;
            if (live) { TOKE[m * 2] = id1; TOKE[m * 2 + 1] = id2; TOKG[m * 2] = psel * w1; TOKG[m * 2 + 1] = psel * w2; }
        }
        __syncthreads();
        unsigned lp1 = 0u, lp2 = 0u;
        if (lane < 16 && live) { lp1 = __hip_atomic_fetch_add(HIST + id1, 1u, __ATOMIC_RELAXED, __HIP_MEMORY_SCOPE_WORKGROUP); lp2 = __hip_atomic_fetch_add(HIST + id2, 1u, __ATOMIC_RELAXED, __HIP_MEMORY_SCOPE_WORKGROUP); }
        __syncthreads();
        if (F.tid < 32) { const unsigned c = HIST[F.tid]; HIST[32 + F.tid] = c ? __hip_atomic_fetch_add(CNT + F.tid, c, RLX_AGENT) : 0u; }
        __syncthreads();
        if (lane < 16 && live) { const int m = m0 + lane; TOKP[m * 2] = (int)(HIST[32 + id1] + lp1); TOKP[m * 2 + 1] = (int)(HIST[32 + id2] + lp2); }
        __syncthreads();
    }
}
DEV int moe_tables(Frame& F, int l) {
    int* tab = (int*)(F.ldsg + TAB_OFF);
    if (F.tid == 0) {
        const unsigned* CNT = (const unsigned*)F.ctl + CW_CNT + l * 32; int off = 0;
#pragma unroll 1
        for (int e = 0; e < 32; ++e) { tab[e] = off; const int c = (int)__hip_atomic_load(CNT + e, RLX_AGENT); const int nt = (c + 255) >> 8;
            for (int i = 0; i < nt; ++i) tab[40 + (off >> 8) + i] = e;
            off += nt << 8; }
        tab[32] = off;
    }
    __syncthreads();
    return tab[32];
}
DEV void gather_phase(Frame& F, int l) {
    (void)moe_tables(F, l);
    const int* tab = (const int*)(F.ldsg + TAB_OFF);
    const int lane = F.lane; const int gw = F.vcu * NWAVES + F.wave, NGW = F.G * NWAVES;
    const bf16* HB = wsp<bf16>(F, WS_HB); const float* SSQ = wsp<float>(F, WS_SSQ); bf16* XS = wsp<bf16>(F, WS_XS);
    const int* TOKE = wsp<int>(F, WS_TOKE); const float* TOKG = wsp<float>(F, WS_TOKG); const int* TOKP = wsp<int>(F, WS_TOKP); int* TOKS = wsp<int>(F, WS_TOKS);
    float* SRSTD = wsp<float>(F, WS_SRSTD); float* SGATE = wsp<float>(F, WS_SGATE);
    const unsigned* CNT = (const unsigned*)F.ctl + CW_CNT + l * 32;
#pragma unroll 1
    for (int m0 = gw; m0 < NTOK; m0 += 4 * NGW) {
        int s0[4], s1[4]; float g0[4], g1[4], rs[4]; v4u a[4], c[4];
#pragma unroll
        for (int k = 0; k < 4; ++k) { const int m = m0 + k * NGW; const bool ok = m < NTOK; const int mm = ok ? m : m0;
            const int e0 = TOKE[mm * 2], e1 = TOKE[mm * 2 + 1], p0 = TOKP[mm * 2], p1 = TOKP[mm * 2 + 1];
            g0[k] = TOKG[mm * 2]; g1[k] = TOKG[mm * 2 + 1];
            a[k] = *(const v4u*)(HB + (size_t)mm * 1024 + lane * 8); c[k] = *(const v4u*)(HB + (size_t)mm * 1024 + 512 + lane * 8);
            rs[k] = row_rstd_full(SSQ, mm);
            s0[k] = tab[e0] + p0; s1[k] = tab[e1] + p1; }
#pragma unroll
        for (int k = 0; k < 4; ++k) { const int m = m0 + k * NGW;
            if (m < NTOK) {
                *(v4u*)(XS + (size_t)s0[k] * 1024 + lane * 8) = a[k]; *(v4u*)(XS + (size_t)s0[k] * 1024 + 512 + lane * 8) = c[k];
                *(v4u*)(XS + (size_t)s1[k] * 1024 + lane * 8) = a[k]; *(v4u*)(XS + (size_t)s1[k] * 1024 + 512 + lane * 8) = c[k];
                if (lane == 0) { SRSTD[s0[k]] = rs[k]; SRSTD[s1[k]] = rs[k]; SGATE[s0[k]] = g0[k]; SGATE[s1[k]] = g1[k]; TOKS[m * 2] = s0[k]; TOKS[m * 2 + 1] = s1[k]; } } }
    }
#pragma unroll 1
    for (int e = 0; e < 32; ++e) {
        const int c = (int)__hip_atomic_load(CNT + e, RLX_AGENT), base = tab[e], end = (e == 31 ? tab[32] : tab[e + 1]);
        for (int r = base + c + gw; r < end; r += NGW) {
            *(v4u*)(XS + (size_t)r * 1024 + lane * 8) = (v4u){0u, 0u, 0u, 0u}; *(v4u*)(XS + (size_t)r * 1024 + 512 + lane * 8) = (v4u){0u, 0u, 0u, 0u};
            if (lane == 0) { SRSTD[r] = 0.f; SGATE[r] = 0.f; }
        }
    }
}
DEV void combine_phase(Frame& F, int l, int probe = 0) {
    const int lane = F.lane; const int gw = F.vcu * NWAVES + F.wave, NGW = F.G * NWAVES;
    const float* H = (const float*)(const GAS float*)F.out; float* Ho = probe ? wsp<float>(F, WS_PROBE) : (float*)(GAS float*)F.out; bf16* HB = wsp<bf16>(F, probe ? WS_PROBE + 128 * MiB : WS_HB); float* SSQ = wsp<float>(F, probe ? WS_PROBE + 192 * MiB : WS_SSQ); const bf16* YS = wsp<bf16>(F, WS_YS); const int* TOKS = wsp<int>(F, WS_TOKS);
    const float* gf = inp(23);
#pragma unroll 1
    for (int m0 = gw; m0 < NTOK; m0 += 2 * NGW) {
        f32x4 v[2][4]; float ssum[2];
        int sl[2][2];
#pragma unroll
        for (int k = 0; k < 2; ++k) { const int m = (m0 + k * NGW < NTOK) ? m0 + k * NGW : m0; sl[k][0] = TOKS[m * 2]; sl[k][1] = TOKS[m * 2 + 1]; }
        f32x4 h[2][4]; v2u ya[2][4], yb[2][4];
#pragma unroll
        for (int k = 0; k < 2; ++k) { const int m = (m0 + k * NGW < NTOK) ? m0 + k * NGW : m0;
#pragma unroll
            for (int j = 0; j < 4; ++j) { const int c = lane * 4 + 256 * j;
                h[k][j] = *(const f32x4*)(H + (size_t)m * 1024 + c);
                ya[k][j] = *(const v2u*)(YS + (size_t)sl[k][0] * 1024 + c); yb[k][j] = *(const v2u*)(YS + (size_t)sl[k][1] * 1024 + c); } }
#pragma unroll
        for (int k = 0; k < 2; ++k) { float ss = 0.f;
#pragma unroll
            for (int j = 0; j < 4; ++j) { const v2u a = ya[k][j], bq = yb[k][j]; const f32x4 hh = h[k][j];
                f32x4 r; r[0] = hh[0] + (bflo(a.x) + bflo(bq.x)); r[1] = hh[1] + (bfhi(a.x) + bfhi(bq.x)); r[2] = hh[2] + (bflo(a.y) + bflo(bq.y)); r[3] = hh[3] + (bfhi(a.y) + bfhi(bq.y));
                v[k][j] = r; ss += (r[0] * r[0] + r[1] * r[1]) + (r[2] * r[2] + r[3] * r[3]); }
            ssum[k] = wave_sum(ss); }
#pragma unroll
        for (int k = 0; k < 2; ++k) { const int m = m0 + k * NGW;
            if (m < NTOK) {
                if (l == DEPTH - 1) {
                    const float rstd = 1.0f / sqrtf(ssum[k] * (1.0f / 1024.0f) + RMS_EPS);
#pragma unroll
                    for (int j = 0; j < 4; ++j) { const int c = lane * 4 + 256 * j; const f32x4 g = *(const f32x4*)(gf + c); *(f32x4*)(Ho + (size_t)m * 1024 + c) = v[k][j] * rstd * g; }
                } else {
#pragma unroll
                    for (int j = 0; j < 4; ++j) { const int c = lane * 4 + 256 * j; *(f32x4*)(Ho + (size_t)m * 1024 + c) = v[k][j];
                        v2u w; w.x = pk2(v[k][j][0], v[k][j][1]); w.y = pk2(v[k][j][2], v[k][j][3]); *(v2u*)(HB + (size_t)m * 1024 + c) = w; }
                    if (lane < 16) SSQ[(size_t)m * 16 + lane] = lane == 0 ? ssum[k] : 0.f;
                } } }
    }
}
#ifndef MK_ONE_LAUNCH
#define MK_ONE_LAUNCH 1
#endif
constexpr int NPH_LAYER = 13, NPHASES = 1 + DEPTH * NPH_LAYER;
struct Args { const float* in[24]; float* out; unsigned char* ws; int ph_lo, ph_hi; };
static_assert(sizeof(Args) == 24 * 8 + 8 + 8 + 8, "Args has no padding");

__global__ void __launch_bounds__(NWAVES * 64, 2) hymba_fwd(Args args) {
    extern __shared__ __attribute__((aligned(16))) unsigned char lds[];
    Frame F;
    F.lds = (LAS unsigned char*)lds; F.ldsg = lds;
    F.MISC = (volatile LAS unsigned*)(F.lds + MISC_OFF);
    F.tid = threadIdx.x; F.lane = F.tid & 63; F.wave = __builtin_amdgcn_readfirstlane(F.tid >> 6);
    F.G = gridDim.x; { const int bx = blockIdx.x; F.vcu = (F.G % 8 == 0) ? (bx % 8) * (F.G / 8) + bx / 8 : bx; }
    F.ws = args.ws; F.ctl = (gu32*)(args.ws + WS_CTL); F.out = args.out;
    if (F.tid < 64) ((LAS unsigned*)(F.lds + MISC_OFF))[F.tid] = 0u;
    __syncthreads();
    int wave0 = F.wave;
    const int lo = args.ph_lo, hi = args.ph_hi;
    XcdBarrier bar; bar.bar = (unsigned*)(F.ctl + CW_BAR); bar.x = 0; bar.st = nullptr;
    if (hi - lo > 1) bar = xcd_barrier_post((unsigned*)(F.ctl + CW_BAR), F.MISC + 8);
#ifndef PHMASK
#define PHMASK 0xFFFF
#endif
#define IN(k) (lo <= (k) && (k) < hi)
#define EN(j) ((PHMASK >> (j)) & 1)
#define RELAUNDER() do { asm volatile("" : "+s"(wave0)); unsigned z_ = 0u; asm volatile("" : "+v"(z_)); int t_ = wave0 * 64 + (int)__builtin_amdgcn_mbcnt_hi(~0u, __builtin_amdgcn_mbcnt_lo(~0u, z_)); F.tid = t_; F.lane = t_ & 63; F.wave = wave0; \
    size_t zo_ = 0; asm volatile("" : "+s"(zo_), "+s"(F.vcu), "+s"(F.G)); F.ws = args.ws + zo_; F.out = args.out + zo_; F.ctl = (gu32*)(F.ws + WS_CTL); } while (0)
#ifndef NSA_VAR
#define NSA_VAR 0
#endif
#ifndef BAR2X
#define BAR2X 0
#endif
#ifndef DUPMASK
#define DUPMASK 0
#endif
#define DUP(j) ((DUPMASK >> (j)) & 1)
#ifndef STAG_J0
#define STAG_J0 0
#endif
#ifndef STAG_MOE
#define STAG_MOE 0
#endif
#define STAGGER(ticks) do { if ((ticks) > 0 && (F.vcu & 1)) { const unsigned long long t0_ = __builtin_amdgcn_s_memrealtime(); while (__builtin_amdgcn_s_memrealtime() - t0_ < (unsigned long long)(ticks)) __builtin_amdgcn_s_sleep(32); } } while (0)
#define SEAM(k) do { if (IN(k) && IN((k) + 1)) { XcdBarrier b_ = bar; size_t zb_ = 0; asm volatile("" : "+s"(b_.x), "+s"(zb_)); b_.bar = (unsigned*)(args.ws + WS_CTL + zb_) + CW_BAR; xcd_barrier(b_); if (BAR2X) xcd_barrier(b_); } } while (0)

    if (IN(0) && EN(13)) { RELAUNDER(); p0_prologue(F); if (DUP(13)) { __syncthreads(); p0_prologue(F); } } SEAM(0);

#pragma unroll 1
    for (int l = 0; l < DEPTH; ++l) {
        const int pb = 1 + l * NPH_LAYER;
        bf16* HB = wsp<bf16>(F, WS_HB); float* SSQ = wsp<float>(F, WS_SSQ);
        if (IN(pb + 0) && EN(0)) for (int rep_ = 0; rep_ < (DUP(0) ? 2 : 1); ++rep_) { RELAUNDER(); if (rep_) __syncthreads();
            pg8::Gemm g{HB, wsp<bf16>(F, WS_WIN) + (size_t)l * NIN * 1024, NTOK, 3072, D};
            pg8::StaticOrder S; S.init(NTOK, 3072, F.G, (int)blockIdx.x);
            EpiIn E{F.ws};
            STAGGER(STAG_J0);
            pg8::gemm_phase<EpiIn, pg8::StaticOrder, true, true>(F.lds, g, S, E, F.wave);
        }
        SEAM(pb + 0);
        if (IN(pb + 1) && EN(1)) { RELAUNDER();
            compress_phase(F, l);
            hgrn_local_phase(F, l);
            conv_phase(F, l);
            kmax_phase(F, l);
            if (l == 0) memkv_phase(F);
            if (DUP(1)) { __syncthreads(); compress_phase(F, l); hgrn_local_phase(F, l); conv_phase(F, l); }
        }
        SEAM(pb + 1);
        if (IN(pb + 2) && EN(2)) { RELAUNDER(); hgrn_scan_phase(F); if (DUP(14)) hgrn_scan_phase(F, 1); nsa_phase(F, l); if (DUP(2)) { __syncthreads(); nsa_phase_t<NSA_VAR>(F, l); } }
        SEAM(pb + 2);
        if (IN(pb + 3) && EN(3)) { RELAUNDER(); hgrn_out_phase(F, l); if (DUP(3)) { __syncthreads(); hgrn_out_phase(F, l); } }
        SEAM(pb + 3);
        if (IN(pb + 4) && EN(4)) for (int rep_ = 0; rep_ < ((DUP(4) && l == 0) ? 2 : 1); ++rep_) { RELAUNDER(); if (rep_) __syncthreads();
            pg8::Gemm g{wsp<bf16>(F, WS_CAT), wsp<bf16>(F, WS_WOUT) + (size_t)l * 1024 * 1024, NTOK, D, D};
            pg8::StaticOrder S; S.init(NTOK, D, F.G, (int)blockIdx.x);
            float* Hres = (float*)(GAS float*)F.out; EpiRes E{l == 0 ? inp(0) : (const float*)Hres, Hres, HB, SSQ};
            pg8::gemm_phase<EpiRes, pg8::StaticOrder, true, true>(F.lds, g, S, E, F.wave);
        }
        SEAM(pb + 4);
        if (IN(pb + 5) && EN(5)) for (int rep_ = 0; rep_ < (DUP(5) ? 2 : 1); ++rep_) { RELAUNDER(); if (rep_) __syncthreads();
            pg8::Gemm g{HB, wsp<bf16>(F, WS_WQ) + (size_t)l * 256 * 1024, NTOK, 256, D};
            pg8::StaticOrder S; S.init(NTOK, 256, F.G, (int)blockIdx.x);
            EpiXQ E{SSQ, wsp<bf16>(F, WS_XQ)};
            pg8::gemm_phase<EpiXQ, pg8::StaticOrder, true, true>(F.lds, g, S, E, F.wave);
        }
        SEAM(pb + 5);
        if (IN(pb + 6) && EN(6)) { RELAUNDER(); cross_phase(F, l); if (DUP(6)) { __syncthreads(); cross_phase(F, l); } }
        SEAM(pb + 6);
        if (IN(pb + 7) && EN(7)) { RELAUNDER();
            pg8::Gemm g{wsp<bf16>(F, WS_XO), wsp<bf16>(F, WS_WO) + (size_t)l * 1024 * 256, NTOK, D, 256};
            pg8::StaticOrder S; S.init(NTOK, D, F.G, (int)blockIdx.x);
            float* Hres = (float*)(GAS float*)F.out; EpiRes E{(const float*)Hres, Hres, HB, SSQ};
            pg8::gemm_phase<EpiRes, pg8::StaticOrder, true, true>(F.lds, g, S, E, F.wave);
        }
        SEAM(pb + 7);
        if (IN(pb + 8) && EN(8)) { RELAUNDER(); router_phase(F, l); if (DUP(8)) router_phase(F, l, 1); }
        SEAM(pb + 8);
        if (IN(pb + 9) && EN(9)) { RELAUNDER(); gather_phase(F, l); if (DUP(9)) { __syncthreads(); gather_phase(F, l); } }
        SEAM(pb + 9);
        if (IN(pb + 10) && EN(10)) for (int rep_ = 0; rep_ < (DUP(10) ? 2 : 1); ++rep_) { RELAUNDER(); if (rep_) __syncthreads();
            const int ns = moe_tables(F, l);
            pg8::Gemm g{wsp<bf16>(F, WS_XS), wsp<bf16>(F, WS_WGU) + (size_t)l * 32 * 1024 * 1024, ns, 32 * 1024, D};
            MoeOrder S{(ns >> 8) * 4, F.G, (int)blockIdx.x, (const LAS int*)(F.lds + TAB_OFF) + 40};
            EpiGU E{wsp<float>(F, WS_SRSTD), wsp<bf16>(F, WS_ACT)};
            STAGGER(STAG_MOE);
            pg8::gemm_phase<EpiGU, MoeOrder, true, true>(F.lds, g, S, E, F.wave);
        }
        SEAM(pb + 10);
        if (IN(pb + 11) && EN(11)) for (int rep_ = 0; rep_ < (DUP(11) ? 2 : 1); ++rep_) { RELAUNDER(); if (rep_) __syncthreads();
            const int ns = moe_tables(F, l);
            pg8::Gemm g{wsp<bf16>(F, WS_ACT), wsp<bf16>(F, WS_WDN) + (size_t)l * 32 * 1024 * 512, ns, 32 * 1024, 512};
            MoeOrder S{(ns >> 8) * 4, F.G, (int)blockIdx.x, (const LAS int*)(F.lds + TAB_OFF) + 40};
            EpiDN E{wsp<float>(F, WS_SGATE), wsp<bf16>(F, WS_YS)};
            STAGGER(STAG_MOE / 2);
            pg8::gemm_phase<EpiDN, MoeOrder, true, true>(F.lds, g, S, E, F.wave);
        }
        SEAM(pb + 11);
        if (IN(pb + 12) && EN(12)) { RELAUNDER(); combine_phase(F, l); if (DUP(12)) combine_phase(F, l, 1); }
        SEAM(pb + 12);
    }
#undef IN
#undef SEAM
}

extern "C" void kernel_launch(void* const* d_in, const int* in_sizes, int n_in, void* d_out, int out_size, void* d_ws, size_t ws_size, hipStream_t stream) {
    static int grid = 0;
    if (grid == 0) {
        if (n_in != 24 || in_sizes[0] != NTOK * D || out_size != NTOK * D || ws_size < WS_END) {
            fprintf(stderr, "kernel_launch: unexpected shapes: n_in %d in0 %d out %d ws %zu (need %zu)\n", n_in, n_in > 0 ? in_sizes[0] : -1, out_size, ws_size, (size_t)WS_END); grid = -1; return; }
        int dev = 0, cus = 0, per_cu = 0;
        if (hipGetDevice(&dev) != hipSuccess || hipDeviceGetAttribute(&cus, hipDeviceAttributeMultiprocessorCount, dev) != hipSuccess) { grid = -1; return; }
        if (hipFuncSetAttribute((const void*)hymba_fwd, hipFuncAttributeMaxDynamicSharedMemorySize, LDS_BYTES) != hipSuccess) { fprintf(stderr, "kernel_launch: hipFuncSetAttribute failed\n"); grid = -1; return; }
        if (hipOccupancyMaxActiveBlocksPerMultiprocessor(&per_cu, (const void*)hymba_fwd, NWAVES * 64, LDS_BYTES) != hipSuccess || per_cu < 1)
            fprintf(stderr, "kernel_launch: note: occupancy query reports %d blocks per CU\n", per_cu);
        (void)hipGetLastError();
        grid = cus;
    }
    if (grid < 0) return;
    if (hipMemsetAsync((char*)d_ws + WS_CTL, 0, CTL_ZERO_BYTES, stream) != hipSuccess) { fprintf(stderr, "kernel_launch: memset failed\n"); return; }
    Args a{};
    for (int i = 0; i < 24; ++i) a.in[i] = (const float*)d_in[i];
    a.out = (float*)d_out; a.ws = (unsigned char*)d_ws;
#if MK_ONE_LAUNCH
    a.ph_lo = 0; a.ph_hi = NPHASES;
    hipLaunchKernelGGL(hymba_fwd, dim3(grid), dim3(NWAVES * 64), LDS_BYTES, stream, a);
#else
    for (int p = 0; p < NPHASES; ++p) { a.ph_lo = p; a.ph_hi = p + 1; hipLaunchKernelGGL(hymba_fwd, dim3(grid), dim3(NWAVES * 64), LDS_BYTES, stream, a); }
#endif
    const hipError_t le = hipPeekAtLastError();
    if (le != hipSuccess) fprintf(stderr, "kernel_launch: launch failed: %s\n", hipGetErrorName(le));
}
```

```cpp
#define MK_ONE_LAUNCH 1
#include <hip/hip_runtime.h>
#include <cstdio>
#include <cstdint>
#include <cmath>
namespace pg8 {
#define PG8_LAS __attribute__((address_space(3)))
typedef unsigned short bf16_t;
typedef short bf16x8 __attribute__((ext_vector_type(8)));
typedef float f32x4 __attribute__((ext_vector_type(4)));
typedef unsigned u32x4 __attribute__((ext_vector_type(4)));
constexpr int BM = 256, BK = 64, HALF = 128, HTB = HALF * BK * 2  , STAGE_BYTES = 8 * HTB, NXCD = 8, WGM = 8;

__host__ __device__ __forceinline__ int lds_byte(int r, int c) { const int st = (r >> 4) * 2 + (c >> 5), rr = r & 15, cc = c & 31, ob = rr * 64 + cc * 2; return st * 1024 + (ob ^ (((ob >> 9) & 1) << 5)); }
__host__ __device__ __forceinline__ void stage_rc(int b, int& R, int& C) { const int st = b / 1024, sb = b % 1024, swz = sb ^ (((sb >> 9) & 1) << 5); R = (st >> 1) * 16 + swz / 64; C = (st & 1) * 32 + (swz % 64) / 2; }
__host__ __device__ __forceinline__ int perm32(int rho) { const int n = rho >> 4, i = rho & 15; return 8 * (i >> 2) + 4 * n + (i & 3); }

struct Unit { int pm, pn; };
struct Gemm { const bf16_t* A; const bf16_t* Bt; int M, N, K; };

struct StaticOrder {
    int nM, nN, nwg, G, c;
    __host__ __device__ void init(int M, int N, int G_, int c_) { nM = M / BM; nN = N / BM; nwg = nM * nN; G = G_; c = c_; }
    __host__ __device__ bool next(int i, Unit& u) const {
        const long L = (long)i * G + c; if (L >= nwg) return false;
        int wgid = (int)L; { const int q = nwg / NXCD, r = nwg % NXCD, xcd = wgid % NXCD, off = wgid / NXCD; wgid = (xcd < r ? xcd * (q + 1) : r * (q + 1) + (xcd - r) * q) + off; }
        const int nig = WGM * nN, gid = wgid / nig, fm = gid * WGM, gsz = (nM - fm) < WGM ? (nM - fm) : WGM;
        u.pm = fm + ((wgid % nig) % gsz); u.pn = (wgid % nig) / gsz; return true;
    }
    __device__ __forceinline__ void a_ready(const Unit&) const {}
    __device__ __forceinline__ void done(const Unit&) const {}
};

__device__ __forceinline__ unsigned cvt_pk_bf16(float lo, float hi) { unsigned r; asm volatile("v_cvt_pk_bf16_f32 %0, %1, %2" : "=v"(r) : "v"(lo), "v"(hi)); return r; }
typedef float f32x2 __attribute__((ext_vector_type(2)));
template <class Epi, class Sched, bool ALIGN_EPI = false, bool SP2 = false>
__device__ __forceinline__ void gemm_phase(PG8_LAS unsigned char* lds, const Gemm g, const Sched& S, const Epi& E, int wave_id) {
    unsigned z_ = 0u; asm volatile("" : "+v"(z_)); int tid_ = wave_id * 64 + (int)__builtin_amdgcn_mbcnt_hi(~0u, __builtin_amdgcn_mbcnt_lo(~0u, z_));
    const int tid = tid_, wid = __builtin_amdgcn_readfirstlane(tid >> 6), lane = tid & 63, wr = wid >> 2, wc = wid & 3, fr = lane & 15, fq = lane >> 4;
    const int K = g.K, nt = K / BK;
    unsigned voffA[2], voffB[2];
#pragma unroll
    for (int i = 0; i < 2; ++i) { int R, C; stage_rc(tid * 16 + i * 8192, R, C); const int Rb = Epi::PERM ? ((R & ~31) + perm32(R & 31)) : R;
        voffA[i] = (unsigned)(R * K + C) * 2u; voffB[i] = (unsigned)(Rb * K + C) * 2u; }
    const size_t kstep = (size_t)(BK * 2);
    const size_t hstep = (size_t)HALF * K * 2;
    const size_t tstep = 2 * hstep;
    const unsigned ldsw = (unsigned)wid * 1024u;
    const int aoff = lds_byte(wr * 64 + fr, fq * 8), boff = lds_byte(wc * 32 + fr, fq * 8);
#define PG8_SA(b, h) (((b) * 2 + (h)) * HTB)
#define PG8_SB(b, h) ((4 + (b) * 2 + (h)) * HTB)
#define PG8_STAGE(bufoff, gbase, voff) do { _Pragma("unroll") for (int _i = 0; _i < 2; ++_i) \
        __builtin_amdgcn_global_load_lds((const unsigned*)((const char*)(gbase) + (voff)[_i]), (PG8_LAS unsigned*)(lds + (bufoff) + ldsw + _i * 8192), 16, 0, 0); } while (0)
#define PG8_LDA(dst, b, h) do { _Pragma("unroll") for (int m = 0; m < 4; ++m) _Pragma("unroll") for (int k = 0; k < 2; ++k) dst[m][k] = *(const PG8_LAS bf16x8*)(lds + PG8_SA(b, h) + aoff + m * 2048 + k * 1024); } while (0)
#define PG8_LDB(dst, b, h) do { _Pragma("unroll") for (int n = 0; n < 2; ++n) _Pragma("unroll") for (int k = 0; k < 2; ++k) dst[n][k] = *(const PG8_LAS bf16x8*)(lds + PG8_SB(b, h) + boff + n * 2048 + k * 1024); } while (0)
#define PG8_MMA(ai, bj, At, Bt) do { __builtin_amdgcn_s_setprio(1); _Pragma("unroll") for (int m = 0; m < 4; ++m) _Pragma("unroll") for (int n = 0; n < 2; ++n) _Pragma("unroll") for (int k = 0; k < 2; ++k) \
        acc[ai][bj][m][n] = __builtin_amdgcn_mfma_f32_16x16x32_bf16(Bt[n][k], At[m][k], acc[ai][bj][m][n], 0, 0, 0); __builtin_amdgcn_s_setprio(0); } while (0)
#define PG8_WAIT_V(n) asm volatile("s_waitcnt vmcnt(" #n ")" ::: "memory")
#define PG8_WAIT_L(n) asm volatile("s_waitcnt lgkmcnt(" #n ")" ::: "memory")
#define PG8_BAR __builtin_amdgcn_s_barrier()
#define PG8_SCHED __builtin_amdgcn_sched_barrier(0)
    Unit cur, nxt; int ui = 0;
    if (!S.next(0, cur)) return;
    f32x4 acc[2][2][4][2];
#pragma unroll
    for (int a = 0; a < 2; ++a)
#pragma unroll
        for (int b = 0; b < 2; ++b)
#pragma unroll
            for (int m = 0; m < 4; ++m)
#pragma unroll
                for (int n = 0; n < 2; ++n) acc[a][b][m][n] = (f32x4){0.f, 0.f, 0.f, 0.f};
    bf16x8 At[4][2], B0[2][2], B1[2][2];
    const char* cA = (const char*)g.A + (size_t)cur.pm * tstep; const char* cB = (const char*)g.Bt + (size_t)cur.pn * tstep;
    S.a_ready(cur);
    if constexpr (SP2) {
        PG8_STAGE(PG8_SB(0, 0), cB, voffB); PG8_STAGE(PG8_SB(0, 1), cB + hstep, voffB); PG8_STAGE(PG8_SA(0, 0), cA, voffA); PG8_STAGE(PG8_SA(0, 1), cA + hstep, voffA);
        if (wr == 1) PG8_BAR;
        PG8_WAIT_V(2); PG8_BAR;
        PG8_STAGE(PG8_SB(1, 0), cB + kstep, voffB); PG8_STAGE(PG8_SA(1, 0), cA + kstep, voffA); PG8_STAGE(PG8_SB(1, 1), cB + hstep + kstep, voffB);
        PG8_WAIT_V(6); PG8_BAR;
    } else {
        PG8_STAGE(PG8_SB(0, 0), cB, voffB); PG8_STAGE(PG8_SA(0, 0), cA, voffA); PG8_STAGE(PG8_SB(0, 1), cB + hstep, voffB); PG8_STAGE(PG8_SA(0, 1), cA + hstep, voffA);
        if (wr == 1) PG8_BAR;
        PG8_WAIT_V(4); PG8_BAR;
        PG8_STAGE(PG8_SB(1, 0), cB + kstep, voffB); PG8_STAGE(PG8_SA(1, 0), cA + kstep, voffA); PG8_STAGE(PG8_SB(1, 1), cB + hstep + kstep, voffB);
        PG8_WAIT_V(6); PG8_BAR;
    }
    for (;;) {
        const bool has_next = S.next(ui + 1, nxt);
        const char* nA = has_next ? (const char*)g.A + (size_t)nxt.pm * tstep : cA; const char* nB = has_next ? (const char*)g.Bt + (size_t)nxt.pn * tstep : cB;
        for (int t = 0; t < nt; t += 2) {
            const bool last = (t == nt - 2);
            const char* a1 = cA + (size_t)(t + 1) * kstep;
            const char* a2 = last ? nA : cA + (size_t)(t + 2) * kstep; const char* b2 = last ? nB : cB + (size_t)(t + 2) * kstep;
            const char* a3 = a2 + kstep; const char* b3 = b2 + kstep;
            if (last && has_next) S.a_ready(nxt);
            if constexpr (SP2) {
            PG8_LDB(B0, 0, 0); PG8_LDB(B1, 0, 1); PG8_SCHED; PG8_LDA(At, 0, 0); PG8_STAGE(PG8_SA(1, 1), a1 + hstep, voffA);
            PG8_WAIT_V(8); PG8_WAIT_L(0); PG8_BAR; PG8_MMA(0, 0, At, B0); PG8_MMA(0, 1, At, B1); PG8_BAR; PG8_SCHED;
            PG8_LDA(At, 0, 1); PG8_STAGE(PG8_SB(0, 0), b2, voffB); PG8_STAGE(PG8_SB(0, 1), b2 + hstep, voffB); PG8_STAGE(PG8_SA(0, 0), a2, voffA);
            PG8_WAIT_V(8); PG8_WAIT_L(0); PG8_BAR; PG8_MMA(1, 0, At, B0); PG8_MMA(1, 1, At, B1); PG8_BAR; PG8_SCHED;
            PG8_LDB(B0, 1, 0); PG8_LDB(B1, 1, 1); PG8_SCHED; PG8_LDA(At, 1, 0); PG8_STAGE(PG8_SA(0, 1), a2 + hstep, voffA);
            PG8_WAIT_V(8); PG8_WAIT_L(0); PG8_BAR; PG8_MMA(0, 0, At, B0); PG8_MMA(0, 1, At, B1); PG8_BAR; PG8_SCHED;
            PG8_LDA(At, 1, 1); PG8_STAGE(PG8_SB(1, 0), b3, voffB); PG8_STAGE(PG8_SB(1, 1), b3 + hstep, voffB); PG8_STAGE(PG8_SA(1, 0), a3, voffA);
            PG8_WAIT_V(8); PG8_WAIT_L(0); PG8_BAR; PG8_MMA(1, 0, At, B0); PG8_MMA(1, 1, At, B1); PG8_BAR; PG8_SCHED;
            } else {
            PG8_LDB(B0, 0, 0); PG8_SCHED; PG8_LDA(At, 0, 0); PG8_STAGE(PG8_SA(1, 1), a1 + hstep, voffA);
            PG8_WAIT_L(8); PG8_BAR; PG8_WAIT_L(0); PG8_MMA(0, 0, At, B0); PG8_BAR; PG8_SCHED;
            PG8_LDB(B1, 0, 1); PG8_STAGE(PG8_SB(0, 0), b2, voffB);
            PG8_BAR; PG8_WAIT_L(0); PG8_MMA(0, 1, At, B1); PG8_BAR;
            PG8_LDA(At, 0, 1); PG8_STAGE(PG8_SA(0, 0), a2, voffA);
            PG8_BAR; PG8_WAIT_L(0); PG8_MMA(1, 0, At, B0); PG8_BAR; PG8_SCHED;
            PG8_STAGE(PG8_SB(0, 1), b2 + hstep, voffB);
            PG8_WAIT_V(6); PG8_BAR; PG8_MMA(1, 1, At, B1); PG8_BAR;
            PG8_LDB(B0, 1, 0); PG8_SCHED; PG8_LDA(At, 1, 0); PG8_STAGE(PG8_SA(0, 1), a2 + hstep, voffA);
            PG8_WAIT_L(8); PG8_BAR; PG8_WAIT_L(0); PG8_MMA(0, 0, At, B0); PG8_BAR; PG8_SCHED;
            PG8_LDB(B1, 1, 1); PG8_STAGE(PG8_SB(1, 0), b3, voffB);
            PG8_BAR; PG8_WAIT_L(0); PG8_MMA(0, 1, At, B1); PG8_BAR;
            PG8_LDA(At, 1, 1); PG8_STAGE(PG8_SA(1, 0), a3, voffA);
            PG8_BAR; PG8_WAIT_L(0); PG8_MMA(1, 0, At, B0); PG8_BAR; PG8_SCHED;
            PG8_STAGE(PG8_SB(1, 1), b3 + hstep, voffB);
            PG8_WAIT_V(6); PG8_BAR; PG8_MMA(1, 1, At, B1); PG8_BAR;
            }
        }
        if constexpr (ALIGN_EPI) { if (wr == 0) PG8_BAR; }
        if constexpr (!Epi::AFTER_DRAIN) { E(acc, cur, wr, wc, fr, fq); S.done(cur); }
        if (!has_next) break;
#pragma unroll
        for (int a = 0; a < 2; ++a)
#pragma unroll
            for (int b = 0; b < 2; ++b)
#pragma unroll
                for (int m = 0; m < 4; ++m)
#pragma unroll
                    for (int n = 0; n < 2; ++n) acc[a][b][m][n] = (f32x4){0.f, 0.f, 0.f, 0.f};
        cur = nxt; cA = nA; cB = nB; ++ui;
        if constexpr (ALIGN_EPI) { if (wr == 1) PG8_BAR; }
    }
    PG8_WAIT_V(0);
    if constexpr (!ALIGN_EPI) { if (wr == 0) PG8_BAR; }
    PG8_BAR;
    if constexpr (Epi::AFTER_DRAIN) { E.fused(acc, cur, wr, wc, fr, fq, lds, wid, lane); S.done(cur); }
#undef PG8_SA
#undef PG8_SB
#undef PG8_STAGE
#undef PG8_LDA
#undef PG8_LDB
#undef PG8_MMA
#undef PG8_WAIT_V
#undef PG8_WAIT_L
#undef PG8_BAR
#undef PG8_SCHED
}
}
constexpr int NB = 4, T = 8192, D = 1024, NTOK = NB * T, DEPTH = 2;
constexpr int NIN = 3328;
constexpr int IN_W = 3096;
constexpr int NSLOT_MAX = 65536 + 32 * 256;
constexpr float RMS_EPS = 1e-6f;
constexpr float QSCALE = 0.125f * 1.44269504088896f;
constexpr int NWAVES = 8;

constexpr size_t MiB = 1u << 20;
constexpr size_t WS_CTL = 0, CTL_ZERO_BYTES = 1 * MiB;
constexpr size_t WS_ROPE = 1 * MiB;
constexpr size_t WS_SMALL = 3 * MiB;
constexpr size_t WS_WG = 3 * MiB + 65536;
constexpr size_t WS_SSQ = 4 * MiB;
constexpr size_t WS_WIN = 8 * MiB;
constexpr size_t WS_WOUT = 22 * MiB;
constexpr size_t WS_WQ = 26 * MiB;
constexpr size_t WS_WKV = 27 * MiB;
constexpr size_t WS_WO = 29 * MiB;
constexpr size_t WS_WR = 30 * MiB;
constexpr size_t WS_W1C = 31 * MiB;
constexpr size_t WS_W2C = 33 * MiB;
constexpr size_t WS_MEMB = 34 * MiB;
constexpr size_t WS_MK = 36 * MiB;
constexpr size_t WS_MVT = 37 * MiB;
constexpr size_t WS_WGU = 40 * MiB;
constexpr size_t WS_WDN = 168 * MiB;
constexpr size_t WS_HB = 232 * MiB;
constexpr size_t WS_Q = 296 * MiB, WS_QR = 328 * MiB, WS_KCR = 360 * MiB, WS_VCR = 368 * MiB, WS_KS = 376 * MiB, WS_KW = 384 * MiB;
constexpr size_t WS_VST = 392 * MiB, WS_VWT = 400 * MiB, WS_KCC = 408 * MiB, WS_VCT = 409 * MiB, WS_GATE = 410 * MiB;
constexpr size_t WS_CB = 414 * MiB, WS_CC = 430 * MiB, WS_CH = 446 * MiB;
constexpr size_t WS_HQ = 462 * MiB, WS_HF = 494 * MiB, WS_HI = 526 * MiB, WS_HG = 558 * MiB;
constexpr size_t WS_CAT = 590 * MiB, WS_U = 654 * MiB, WS_DEC = 686 * MiB;
constexpr size_t WS_XQ = 688 * MiB, WS_XO = 704 * MiB;
constexpr size_t WS_XS = 296 * MiB, WS_ACT = 440 * MiB, WS_YS = 512 * MiB;
constexpr size_t WS_TOKE = 720 * MiB, WS_TOKG = 721 * MiB, WS_TOKP = 722 * MiB, WS_TOKS = 723 * MiB, WS_SRSTD = 724 * MiB, WS_SGATE = 725 * MiB;
constexpr size_t WS_U2 = 728 * MiB;
constexpr size_t WS_PROBE = 760 * MiB;
constexpr size_t WS_END = 760 * MiB;
static_assert(WS_XS + (size_t)NSLOT_MAX * 1024 * 2 <= WS_ACT && WS_ACT + (size_t)NSLOT_MAX * 512 * 2 <= WS_YS && WS_YS + (size_t)NSLOT_MAX * 1024 * 2 <= WS_XQ, "moe map");
constexpr int CW_CNT = 64;
constexpr int CW_KMAX = 256;
constexpr int CW_BAR = 4096;

constexpr int RING_BYTES = 131072;
constexpr int NSA_LDS_WAVE = 10752;
constexpr int MISC_OFF = RING_BYTES;
constexpr int TAB_OFF = RING_BYTES + 512;
constexpr int LDS_BYTES = 147456;
static_assert(8 * NSA_LDS_WAVE <= RING_BYTES && TAB_OFF + 4 * (40 + 320) <= LDS_BYTES, "LDS map");

#define GAS __attribute__((address_space(1)))
#define LAS __attribute__((address_space(3)))
#define DEV __device__ __forceinline__
typedef unsigned short bf16;
typedef unsigned v4u __attribute__((ext_vector_type(4)));
typedef unsigned v2u __attribute__((ext_vector_type(2)));
typedef float f32x4 __attribute__((ext_vector_type(4)));
typedef short bf16x8 __attribute__((ext_vector_type(8)));
typedef GAS unsigned gu32;
#define RLX_AGENT __ATOMIC_RELAXED, __HIP_MEMORY_SCOPE_AGENT
#define LDS_WAIT() asm volatile("s_waitcnt lgkmcnt(0)" ::: "memory")
#define VM_WAIT() asm volatile("s_waitcnt vmcnt(0)" ::: "memory")
typedef __bf16 bf16x2_t __attribute__((ext_vector_type(2)));
typedef float f32x2_t __attribute__((ext_vector_type(2)));
DEV unsigned pk2(float lo, float hi) { const f32x2_t v = {lo, hi}; return __builtin_bit_cast(unsigned, __builtin_convertvector(v, bf16x2_t)); }
DEV unsigned f2bf(float f) { return pk2(f, 0.f) & 0xffffu; }
DEV float bf2f(unsigned short b) { return __builtin_bit_cast(float, (unsigned)b << 16); }
DEV float bflo(unsigned w) { return __builtin_bit_cast(float, w << 16); }
DEV float bfhi(unsigned w) { return __builtin_bit_cast(float, w & 0xffff0000u); }
DEV float ex2(float x) { return __builtin_amdgcn_exp2f(x); }
DEV float wave_sum(float v) {
#pragma unroll
    for (int o = 1; o < 64; o <<= 1) v += __shfl_xor(v, o);
    return v;
}
DEV f32x4 mfma16(bf16x8 a, bf16x8 b, f32x4 c) { return __builtin_amdgcn_mfma_f32_16x16x32_bf16(a, b, c, 0, 0, 0); }
DEV int slot32(int k) { return ((k >> 2) & 3) * 8 + (k >> 4) * 4 + (k & 3); }
DEV float sigmoidf_(float x) { return 1.0f / (1.0f + __expf(-x)); }
DEV float siluf_(float x) { return x / (1.0f + __expf(-x)); }
#define XB_TMO      128
#define XB_XCNT(j)  (256  + 64 * (j))
#define XB_XSUB(j)  (1280 + 64 * (j))
#define XB_XGEN(j)  (2304 + 64 * (j))
#define XB_TOP      3328
#define XB_TOPGEN   3392
#define XCD_BAR_WORDS 3456
#define XB_SPIN_CAP (1u << 18)

__device__ __forceinline__ unsigned xb_ld(unsigned* p)              { return __hip_atomic_load(p, __ATOMIC_RELAXED, __HIP_MEMORY_SCOPE_AGENT); }
__device__ __forceinline__ unsigned xb_add(unsigned* p, unsigned v) { return __hip_atomic_fetch_add(p, v, __ATOMIC_RELAXED, __HIP_MEMORY_SCOPE_AGENT); }
__device__ __forceinline__ unsigned xb_xcc_id() { return (unsigned)__builtin_amdgcn_s_getreg((3 << 11) | 20) & 0xFu; }
#define XB_SPIN(cond, bar) do { unsigned _sp = 0; while (cond) { __builtin_amdgcn_s_sleep(1); \
    if ((++_sp & 255u) == 0u) { if (xb_ld(&(bar)[XB_TMO])) break; if (_sp > XB_SPIN_CAP) { atomicAdd(&(bar)[XB_TMO], 1u); break; } } } } while (0)

struct XcdBarrier {
    unsigned* bar; unsigned x;
    volatile LAS unsigned* st;
};

__device__ __forceinline__ XcdBarrier xcd_barrier_post(unsigned* bar, volatile LAS unsigned* st) {
    XcdBarrier b; b.bar = bar; b.x = xb_xcc_id(); b.st = st;
    if (threadIdx.x == 0) (void)xb_add(&bar[XB_XCNT(b.x)], 1u);
    return b;
}
__device__ __forceinline__ void xcd_barrier_complete(unsigned* bar, unsigned x, unsigned& nloc, unsigned& nx) {
    const unsigned G = gridDim.x * gridDim.y * gridDim.z;
    unsigned sum, cnt, mine, sp = 0u;
    for (;;) {
        sum = 0u; cnt = 0u; mine = 0u;
#pragma unroll
        for (unsigned j = 0; j < 16; ++j) { const unsigned c = xb_ld(&bar[XB_XCNT(j)]); sum += c; cnt += (c > 0u) ? 1u : 0u; mine = (j == x) ? c : mine; }
        if (sum == G) break;
        __builtin_amdgcn_s_sleep(1);
        if ((++sp & 255u) == 0u) { if (xb_ld(&bar[XB_TMO])) break; if (sp > XB_SPIN_CAP) { atomicAdd(&bar[XB_TMO], 1u); break; } }
    }
    nloc = mine > 0u ? mine : 1u; nx = cnt > 0u ? cnt : 1u;
}

__device__ __forceinline__ void xcd_barrier(const XcdBarrier& b) {
    asm volatile("s_waitcnt vmcnt(0)" ::: "memory");
    __syncthreads();
    if (threadIdx.x == 0) {
        unsigned* bar = b.bar;
        __builtin_amdgcn_s_waitcnt(0);
        unsigned nloc = b.st[0], nx = b.st[1];
        if (nloc == 0u) { xcd_barrier_complete(bar, b.x, nloc, nx); b.st[0] = nloc; b.st[1] = nx; }
        const unsigned old = xb_add(&bar[XB_XSUB(b.x)], 1u);
        const unsigned gen = old / nloc;
        if (old + 1u == (gen + 1u) * nloc) {
            __builtin_amdgcn_fence(__ATOMIC_RELEASE, "agent");
            asm volatile("s_waitcnt vmcnt(0)" ::: "memory");
            const unsigned og = xb_add(&bar[XB_TOP], 1u);
            const unsigned tg = og / nx;
            if (og + 1u == (tg + 1u) * nx) xb_add(&bar[XB_TOPGEN], 1u);
            else XB_SPIN(xb_ld(&bar[XB_TOPGEN]) == tg, bar);
            __builtin_amdgcn_fence(__ATOMIC_ACQUIRE, "agent");
            xb_add(&bar[XB_XGEN(b.x)], 1u);
            asm volatile("s_waitcnt vmcnt(0)" ::: "memory");
        } else {
            XB_SPIN(xb_ld(&bar[XB_XGEN(b.x)]) == gen, bar);
            __builtin_amdgcn_fence(__ATOMIC_ACQUIRE, "agent");
            asm volatile("s_waitcnt vmcnt(0)" ::: "memory");
        }
    }
    __syncthreads();
}
DEV float row_rstd(const float* ssq, int row, int fq) {
    const f32x4 p = *(const f32x4*)(ssq + (size_t)row * 16 + fq * 4);
    float s = (p.x + p.y) + (p.z + p.w);
    s += __shfl_xor(s, 16); s += __shfl_xor(s, 32);
    return 1.0f / sqrtf(s * (1.0f / 1024.0f) + RMS_EPS);
}
DEV float row_rstd_full(const float* ssq, int row) {
    const f32x4* p = (const f32x4*)(ssq + (size_t)row * 16);
    const f32x4 a = p[0], b = p[1], c = p[2], d = p[3];
    const float s = ((a.x + a.y) + (a.z + a.w)) + ((b.x + b.y) + (b.z + b.w)) + ((c.x + c.y) + (c.z + c.w)) + ((d.x + d.y) + (d.z + d.w));
    return 1.0f / sqrtf(s * (1.0f / 1024.0f) + RMS_EPS);
}

DEV void rope4(const float* rope, int t, int i, const f32x4& v0, const f32x4& v1, float (&lo)[4], float (&hi)[4]) {
    const f32x4 c0 = *(const f32x4*)(rope + ((size_t)t * 32 + i) * 2), c1 = *(const f32x4*)(rope + ((size_t)t * 32 + i + 2) * 2);
    lo[0] = v0[0] * c0[0] - v0[1] * c0[1]; hi[0] = v0[1] * c0[0] + v0[0] * c0[1];
    lo[1] = v0[2] * c0[2] - v0[3] * c0[3]; hi[1] = v0[3] * c0[2] + v0[2] * c0[3];
    lo[2] = v1[0] * c1[0] - v1[1] * c1[1]; hi[2] = v1[1] * c1[0] + v1[0] * c1[1];
    lo[3] = v1[2] * c1[2] - v1[3] * c1[3]; hi[3] = v1[3] * c1[2] + v1[2] * c1[3];
}
struct EpiIn {
    static constexpr bool PERM = true, AFTER_DRAIN = false;
    unsigned char* ws;
    template <class Tp> DEV Tp* P(size_t off) const { return (Tp*)(GAS Tp*)(ws + off); }
    DEV void operator()(const f32x4 (&acc)[2][2][4][2], const pg8::Unit& u, int wr, int wc, int fr, int fq) const {
        asm volatile("" : "+v"(fr), "+v"(fq), "+s"(wr), "+s"(wc));
        const int pn = u.pn;
        const float* ssq = P<float>(WS_SSQ); const float* rope = P<float>(WS_ROPE);
#pragma unroll
        for (int ai = 0; ai < 2; ++ai)
#pragma unroll
            for (int m = 0; m < 4; ++m) {
                const int row = u.pm * 256 + ai * 128 + wr * 64 + m * 16 + fr;
                const float rstd = row_rstd(ssq, row, fq);
                const int t = row & (T - 1), b = row >> 13;
#pragma unroll
                for (int bj = 0; bj < 2; ++bj) {
                    const int col = bj * 128 + wc * 32 + fq * 8;
                    const f32x4 v0 = acc[ai][bj][m][0] * rstd, v1 = acc[ai][bj][m][1] * rstd;
                    if (pn < 2) {
                        const int g = pn * 256 + col, head = g >> 6, i = (g & 63) >> 1;
                        float lo[4], hi[4]; rope4(rope, t, i, v0, v1, lo, hi);
                        const size_t o = (size_t)row * 512 + head * 64 + i;
                        bf16* Q = P<bf16>(WS_Q); bf16* QR = P<bf16>(WS_QR);
                        v2u w;
                        w.x = pk2(v0[0] * QSCALE, v0[2] * QSCALE); w.y = pk2(v1[0] * QSCALE, v1[2] * QSCALE); *(v2u*)(Q + o) = w;
                        w.x = pk2(v0[1] * QSCALE, v0[3] * QSCALE); w.y = pk2(v1[1] * QSCALE, v1[3] * QSCALE); *(v2u*)(Q + o + 32) = w;
                        w.x = pk2(lo[0] * QSCALE, lo[1] * QSCALE); w.y = pk2(lo[2] * QSCALE, lo[3] * QSCALE); *(v2u*)(QR + o) = w;
                        w.x = pk2(hi[0] * QSCALE, hi[1] * QSCALE); w.y = pk2(hi[2] * QSCALE, hi[3] * QSCALE); *(v2u*)(QR + o + 32) = w;
                    } else if (pn == 2) {
                        bf16* dst = P<bf16>((col < 128) ? WS_KCR : WS_VCR);
                        v4u w; w.x = pk2(v0[0], v0[1]); w.y = pk2(v0[2], v0[3]); w.z = pk2(v1[0], v1[1]); w.w = pk2(v1[2], v1[3]);
                        *(v4u*)(dst + (size_t)row * 128 + (col & 127)) = w;
                    } else if (pn == 3 || pn == 4) {
                        if (col < 128) {
                            bf16* dst = P<bf16>((pn == 3) ? WS_KS : WS_KW);
                            const int hkv = col >> 6, i = (col & 63) >> 1;
                            float lo[4], hi[4]; rope4(rope, t, i, v0, v1, lo, hi);
                            const size_t o = ((size_t)(b * 2 + hkv) * T + t) * 64 + i;
                            v2u w;
                            w.x = pk2(lo[0], lo[1]); w.y = pk2(lo[2], lo[3]); *(v2u*)(dst + o) = w;
                            w.x = pk2(hi[0], hi[1]); w.y = pk2(hi[2], hi[3]); *(v2u*)(dst + o + 32) = w;
                        } else {
                            bf16* dst = P<bf16>((pn == 3) ? WS_VST : WS_VWT);
                            const int c2 = col - 128, hkv = c2 >> 6, d = c2 & 63;
                            const size_t o = (((size_t)(b * 2 + hkv) * 256 + (t >> 5)) * 64 + d) * 32 + slot32(t & 31);
#pragma unroll
                            for (int j = 0; j < 4; ++j) { dst[o + j * 32] = (bf16)f2bf(v0[j]); dst[o + (j + 4) * 32] = (bf16)f2bf(v1[j]); }
                        }
                    } else if (pn == 9) {
                        float* dst = P<float>(WS_HF) + (size_t)row * 256 + col;
                        *(f32x4*)dst = v0; *(f32x4*)(dst + 4) = v1;
                    } else {
                        bf16* dst = (pn < 8) ? P<bf16>(WS_CB + (size_t)(pn - 5) * (WS_CC - WS_CB)) : P<bf16>(WS_HQ + (size_t)(pn - 8) * (WS_HF - WS_HQ));
                        v4u w; w.x = pk2(v0[0], v0[1]); w.y = pk2(v0[2], v0[3]); w.z = pk2(v1[0], v1[1]); w.w = pk2(v1[2], v1[3]);
                        *(v4u*)(dst + (size_t)row * 256 + col) = w;
                    }
                }
            }
    }
};

struct EpiRes {
    static constexpr bool PERM = true, AFTER_DRAIN = false;
    const float* base32; bf16* hb; float* ssq;
    DEV void operator()(const f32x4 (&acc)[2][2][4][2], const pg8::Unit& u, int wr, int wc, int fr, int fq) const {
        asm volatile("" : "+v"(fr), "+v"(fq), "+s"(wr), "+s"(wc));
#pragma unroll
        for (int ai = 0; ai < 2; ++ai)
#pragma unroll
            for (int m = 0; m < 4; ++m) {
                const int row = u.pm * 256 + ai * 128 + wr * 64 + m * 16 + fr;
                float ss = 0.f;
#pragma unroll
                for (int bj = 0; bj < 2; ++bj) {
                    const size_t o = (size_t)row * 1024 + u.pn * 256 + bj * 128 + wc * 32 + fq * 8;
                    f32x4 v0, v1;
                    if (base32) { v0 = *(const f32x4*)(base32 + o); v1 = *(const f32x4*)(base32 + o + 4); }
                    else { const v4u hw = *(const v4u*)(hb + o); v0 = (f32x4){bflo(hw.x), bfhi(hw.x), bflo(hw.y), bfhi(hw.y)}; v1 = (f32x4){bflo(hw.z), bfhi(hw.z), bflo(hw.w), bfhi(hw.w)}; }
                    v0 = v0 + acc[ai][bj][m][0]; v1 = v1 + acc[ai][bj][m][1];
                    v4u w; w.x = pk2(v0[0], v0[1]); w.y = pk2(v0[2], v0[3]); w.z = pk2(v1[0], v1[1]); w.w = pk2(v1[2], v1[3]);
                    *(v4u*)(hb + o) = w;
                    ss += ((v0[0] * v0[0] + v0[1] * v0[1]) + (v0[2] * v0[2] + v0[3] * v0[3])) + ((v1[0] * v1[0] + v1[1] * v1[1]) + (v1[2] * v1[2] + v1[3] * v1[3]));
                }
                ss += __shfl_xor(ss, 16); ss += __shfl_xor(ss, 32);
                if (fq == 0) ssq[(size_t)row * 16 + u.pn * 4 + wc] = ss;
            }
    }
};

struct EpiXQ {
    static constexpr bool PERM = true, AFTER_DRAIN = false;
    const float* ssq; bf16* XQ;
    DEV void operator()(const f32x4 (&acc)[2][2][4][2], const pg8::Unit& u, int wr, int wc, int fr, int fq) const {
        asm volatile("" : "+v"(fr), "+v"(fq), "+s"(wr), "+s"(wc));
#pragma unroll
        for (int ai = 0; ai < 2; ++ai)
#pragma unroll
            for (int m = 0; m < 4; ++m) {
                const int row = u.pm * 256 + ai * 128 + wr * 64 + m * 16 + fr;
                const float sc = row_rstd(ssq, row, fq) * QSCALE;
#pragma unroll
                for (int bj = 0; bj < 2; ++bj) {
                    const f32x4 v0 = acc[ai][bj][m][0] * sc, v1 = acc[ai][bj][m][1] * sc;
                    v4u w; w.x = pk2(v0[0], v0[1]); w.y = pk2(v0[2], v0[3]); w.z = pk2(v1[0], v1[1]); w.w = pk2(v1[2], v1[3]);
                    *(v4u*)(XQ + (size_t)row * 256 + bj * 128 + wc * 32 + fq * 8) = w;
                }
            }
    }
};

struct EpiGU {
    static constexpr bool PERM = true, AFTER_DRAIN = false;
    const float* srstd; bf16* ACT;
    DEV void operator()(const f32x4 (&acc)[2][2][4][2], const pg8::Unit& u, int wr, int wc, int fr, int fq) const {
        asm volatile("" : "+v"(fr), "+v"(fq), "+s"(wr), "+s"(wc));
        const int nt = u.pn & 3;
#pragma unroll
        for (int ai = 0; ai < 2; ++ai)
#pragma unroll
            for (int m = 0; m < 4; ++m) {
                const int row = u.pm * 256 + ai * 128 + wr * 64 + m * 16 + fr;
                const float rs = srstd[row];
#pragma unroll
                for (int bj = 0; bj < 2; ++bj) {
                    const f32x4 v0 = acc[ai][bj][m][0] * rs, v1 = acc[ai][bj][m][1] * rs;
                    const int j = (nt * 256 + bj * 128 + wc * 32 + fq * 8) >> 1;
                    v2u w; w.x = pk2(siluf_(v0[0]) * v0[1], siluf_(v0[2]) * v0[3]); w.y = pk2(siluf_(v1[0]) * v1[1], siluf_(v1[2]) * v1[3]);
                    *(v2u*)(ACT + (size_t)row * 512 + j) = w;
                }
            }
    }
};

struct EpiDN {
    static constexpr bool PERM = true, AFTER_DRAIN = false;
    const float* sgate; bf16* YS;
    DEV void operator()(const f32x4 (&acc)[2][2][4][2], const pg8::Unit& u, int wr, int wc, int fr, int fq) const {
        asm volatile("" : "+v"(fr), "+v"(fq), "+s"(wr), "+s"(wc));
        const int nt = u.pn & 3;
#pragma unroll
        for (int ai = 0; ai < 2; ++ai)
#pragma unroll
            for (int m = 0; m < 4; ++m) {
                const int row = u.pm * 256 + ai * 128 + wr * 64 + m * 16 + fr;
                const float gt = sgate[row];
#pragma unroll
                for (int bj = 0; bj < 2; ++bj) {
                    const f32x4 v0 = acc[ai][bj][m][0] * gt, v1 = acc[ai][bj][m][1] * gt;
                    v4u w; w.x = pk2(v0[0], v0[1]); w.y = pk2(v0[2], v0[3]); w.z = pk2(v1[0], v1[1]); w.w = pk2(v1[2], v1[3]);
                    *(v4u*)(YS + (size_t)row * 1024 + nt * 256 + bj * 128 + wc * 32 + fq * 8) = w;
                }
            }
    }
};

struct MoeOrder {
    int nunits, G, c; const LAS int* tileE;
    DEV bool next(int i, pg8::Unit& u) const {
        const int L = i * G + c; if (L >= nunits) return false;
        const int rt = L >> 2; u.pm = rt; u.pn = tileE[rt] * 4 + (L & 3); return true;
    }
    DEV void a_ready(const pg8::Unit&) const {}
    DEV void done(const pg8::Unit&) const {}
};
struct Frame {
    LAS unsigned char* lds;
    unsigned char* ldsg;
    volatile LAS unsigned* MISC;
    gu32* ctl;
    unsigned char* ws;
    int tid, lane, wave, vcu, G;
    float* out;
};
template <class Tp> DEV Tp* wsp(const Frame& F, size_t off) { return (Tp*)(F.ws + off); }
DEV const float* inp(int i) { const float* const* ka = (const float* const*)__builtin_amdgcn_kernarg_segment_ptr(); asm volatile("" : "+s"(i)); return (const float*)(const GAS float*)ka[i]; }

template <class Map>
DEV void tr_item(const float* W, int K, int Nsrc, const float* gain, bf16* WT, float* scr, int item, int lane, Map map) {
    const int nblk = (Nsrc + 31) >> 5, kb = item / nblk, nb = item - kb * nblk, k0 = 64 * kb, n0 = 32 * nb;
    {
        const int nq = (lane & 7) * 4; f32x4 v[8];
#pragma unroll
        for (int i = 0; i < 8; ++i) { const int kk = 8 * i + (lane >> 3);
            v[i] = (n0 + nq < Nsrc) ? *(const f32x4*)(W + (size_t)(k0 + kk) * Nsrc + n0 + nq) : (f32x4){0.f, 0.f, 0.f, 0.f}; }
#pragma unroll
        for (int i = 0; i < 8; ++i) { const int kk = 8 * i + (lane >> 3); const float g = gain ? gain[k0 + kk] : 1.0f; float* s = scr + kk * 33 + nq;
            s[0] = v[i][0] * g; s[1] = v[i][1] * g; s[2] = v[i][2] * g; s[3] = v[i][3] * g; }
    }
    LDS_WAIT();
    const int c = lane & 7;
#pragma unroll
    for (int j = 0; j < 4; ++j) {
        const int n = (lane >> 3) + 8 * j; const float* s = scr + (8 * c) * 33 + n;
        if (n0 + n < Nsrc) {
            v4u o; o.x = pk2(s[0 * 33], s[1 * 33]); o.y = pk2(s[2 * 33], s[3 * 33]); o.z = pk2(s[4 * 33], s[5 * 33]); o.w = pk2(s[6 * 33], s[7 * 33]);
            *(v4u*)(WT + (size_t)map(n0 + n) * K + k0 + 8 * c) = o;
        }
    }
    LDS_WAIT();
}
template <class Map>
DEV void tr_experts(const float* W, int K, int Nsrc, const float* gain, bf16* WT, bf16* scr, int gw, int NGW, int lane, Map map) {
    const int nblk = Nsrc >> 6, per_e = (K >> 6) * nblk, NIT = 32 * per_e; const size_t esz = (size_t)K * Nsrc;
#pragma unroll 1
    for (int it = gw; it < NIT; it += NGW) {
        const int e = it / per_e, sub = it - e * per_e, kb = sub / nblk, nb = sub - kb * nblk, k0 = 64 * kb, n0 = 64 * nb, nq = (lane & 15) * 4;
        const float* Wp = W + (size_t)e * esz; bf16* Wo = WT + (size_t)e * esz;
        f32x4 v[16];
#pragma unroll
        for (int i = 0; i < 16; ++i) v[i] = *(const f32x4*)(Wp + (size_t)(k0 + 4 * i + (lane >> 4)) * Nsrc + n0 + nq);
#pragma unroll
        for (int i = 0; i < 16; ++i) { const int kk = 4 * i + (lane >> 4); const float g = gain ? gain[k0 + kk] : 1.0f;
            v2u w; w.x = pk2(v[i][0] * g, v[i][1] * g); w.y = pk2(v[i][2] * g, v[i][3] * g);
            *(v2u*)(scr + kk * 68 + nq) = w; }
        LDS_WAIT();
        const int cc = lane & 7;
#pragma unroll
        for (int j = 0; j < 8; ++j) { const int n = (lane >> 3) + 8 * j; const bf16* s = scr + (8 * cc) * 68 + n;
            v4u o; o.x = (unsigned)s[0] | ((unsigned)s[68] << 16); o.y = (unsigned)s[2 * 68] | ((unsigned)s[3 * 68] << 16);
            o.z = (unsigned)s[4 * 68] | ((unsigned)s[5 * 68] << 16); o.w = (unsigned)s[6 * 68] | ((unsigned)s[7 * 68] << 16);
            *(v4u*)(Wo + (size_t)map(n0 + n) * K + k0 + 8 * cc) = o; }
        LDS_WAIT();
    }
}
struct MapId { DEV int operator()(int n) const { return n; } };
struct MapIn {
    DEV int operator()(int n) const {
        if (n < 512) { const int d = n & 63; return (n & ~63) + 2 * (d & 31) + (d >> 5); }
        if (n < 768) return n;
        if (n < 1280) { const int r = n - 768; if ((r & 255) < 128) { const int d = r & 63; return 768 + (r & ~63) + 2 * (d & 31) + (d >> 5); } return n; }
        if (n < 1304) return 3072 + (n - 1280);
        return n - 24;
    }
};
struct MapGU { DEV int operator()(int n) const { return n < 512 ? 2 * n : 2 * (n - 512) + 1; } };

DEV void p0_prologue(Frame& F) {
    float* scr = (float*)(F.ldsg + F.wave * 16384);
    const int gw = F.vcu * NWAVES + F.wave, NGW = F.G * NWAVES, lane = F.lane;
    for (int l = 0; l < DEPTH; ++l) {
        { const int NIT = 16 * 97; bf16* dst = wsp<bf16>(F, WS_WIN) + (size_t)l * NIN * 1024;
          for (int it = gw; it < NIT; it += NGW) tr_item(inp(2) + (size_t)l * 1024 * IN_W, 1024, IN_W, inp(19) + l * 1024, dst, scr, it, lane, MapIn());
          for (int i = gw * 64 + lane; i < (NIN - 3096) * 1024 / 8; i += NGW * 64) ((v4u*)(dst + (size_t)3096 * 1024))[i] = (v4u){0u, 0u, 0u, 0u}; }
        { const int NIT = 16 * 32; for (int it = gw; it < NIT; it += NGW) tr_item(inp(9) + (size_t)l * 1024 * 1024, 1024, 1024, nullptr, wsp<bf16>(F, WS_WOUT) + (size_t)l * 1024 * 1024, scr, it, lane, MapId()); }
        { const int NIT = 16 * 8; for (int it = gw; it < NIT; it += NGW) tr_item(inp(10) + (size_t)l * 1024 * 256, 1024, 256, inp(20) + l * 1024, wsp<bf16>(F, WS_WQ) + (size_t)l * 256 * 1024, scr, it, lane, MapId()); }
        { const int NIT = 16 * 16; for (int it = gw; it < NIT; it += NGW) tr_item(inp(11) + (size_t)l * 1024 * 512, 1024, 512, inp(21) + l * 1024, wsp<bf16>(F, WS_WKV) + (size_t)l * 512 * 1024, scr, it, lane, MapId()); }
        { const int NIT = 4 * 32; for (int it = gw; it < NIT; it += NGW) tr_item(inp(12) + (size_t)l * 256 * 1024, 256, 1024, nullptr, wsp<bf16>(F, WS_WO) + (size_t)l * 1024 * 256, scr, it, lane, MapId()); }
        for (int kv = 0; kv < 2; ++kv) {
            { const int NIT = 32 * 4; for (int it = gw; it < NIT; it += NGW) tr_item(inp(5) + (size_t)(l * 2 + kv) * 2048 * 128, 2048, 128, nullptr, wsp<bf16>(F, WS_W1C) + (size_t)(l * 2 + kv) * 128 * 2048, scr, it, lane, MapId()); }
            { const int NIT = 2 * 2; for (int it = gw; it < NIT; it += NGW) tr_item(inp(6) + (size_t)(l * 2 + kv) * 128 * 64, 128, 64, nullptr, wsp<bf16>(F, WS_W2C) + (size_t)(l * 2 + kv) * 64 * 128, scr, it, lane, MapId()); }
        }
        tr_experts(inp(17) + (size_t)l * 32 * 1024 * 1024, 1024, 1024, inp(22) + l * 1024, wsp<bf16>(F, WS_WGU) + (size_t)l * 32 * 1024 * 1024, (bf16*)scr, gw, NGW, lane, MapGU());
        tr_experts(inp(18) + (size_t)l * 32 * 512 * 1024, 512, 1024, nullptr, wsp<bf16>(F, WS_WDN) + (size_t)l * 32 * 1024 * 512, (bf16*)scr, gw, NGW, lane, MapId());
        { bf16* dst = wsp<bf16>(F, WS_WR) + (size_t)l * 96 * 1024; const float* gn = inp(22) + l * 1024;
          for (int i = gw * 64 + lane; i < 48 * 1024; i += NGW * 64) { const int n = i >> 10, k = i & 1023;
            float v = 0.f; if (n < 4) v = inp(13)[(size_t)(l * 1024 + k) * 4 + n]; else if (n < 36) v = inp(15)[(size_t)(l * 1024 + k) * 32 + (n - 4)];
            v *= gn[k]; const unsigned h = f2bf(v); dst[i] = (bf16)h; dst[i + 48 * 1024] = (bf16)f2bf(v - bf2f((unsigned short)h)); } }
    }
    { bf16* wg = wsp<bf16>(F, WS_WG);
      for (int i = gw * 64 + lane; i < DEPTH * 32 * 1024; i += NGW * 64) { const int l2 = i >> 15, row = (i >> 10) & 31, k = i & 1023, hk = row >> 4, gi = row & 15;
        const float v = gi < 12 ? inp(2)[((size_t)l2 * 1024 + k) * IN_W + 1280 + hk * 12 + gi] * inp(19)[l2 * 1024 + k] : 0.f;
        wg[i] = (bf16)f2bf(v); } }
    { float* rope = wsp<float>(F, WS_ROPE);
      for (int i = gw * 64 + lane; i < T * 32; i += NGW * 64) { const int t = i >> 5, k = i & 31;
        const float inv = powf(10000.0f, -(float)k / 32.0f); const float ang = (float)t * inv;
        rope[2 * i] = cosf(ang); rope[2 * i + 1] = sinf(ang); } }
    { float* b1 = wsp<float>(F, WS_SMALL);
      for (int i = gw * 64 + lane; i < 4 * 128; i += NGW * 64) { const int lk = i >> 7, n = i & 127;
        const float* pe = inp(4) + (size_t)lk * 2048; const float* w1 = inp(5) + (size_t)lk * 2048 * 128 + n; float s = 0.f;
        for (int kk = 0; kk < 2048; ++kk) s += pe[kk] * w1[(size_t)kk * 128];
        b1[i] = s; } }
    { bf16* HB = wsp<bf16>(F, WS_HB); float* SSQ = wsp<float>(F, WS_SSQ); bf16* MB = wsp<bf16>(F, WS_MEMB); float* SSQM = wsp<float>(F, WS_SMALL) + 1024;
      for (int m = gw; m < NTOK + NB * 256; m += NGW) {
        const bool ism = m >= NTOK; const int r = ism ? m - NTOK : m;
        const f32x4* xr = (const f32x4*)((ism ? inp(1) : inp(0)) + (size_t)r * 1024) + lane;
        unsigned long long* o8 = (unsigned long long*)((ism ? MB : HB) + (size_t)r * 1024) + lane;
        float s = 0.f;
#pragma unroll
        for (int j = 0; j < 4; ++j) { const f32x4 v = xr[64 * j]; s += (v.x * v.x + v.y * v.y) + (v.z * v.z + v.w * v.w);
            o8[64 * j] = (unsigned long long)pk2(v.x, v.y) | ((unsigned long long)pk2(v.z, v.w) << 32); }
        s = wave_sum(s);
        if (ism) { if (lane == 0) SSQM[r] = s; }
        else if (lane < 16) SSQ[(size_t)r * 16 + lane] = lane == 0 ? s : 0.f;
      } }
}

template <int NT>
DEV void skinny16(const bf16* A, size_t lda, const bf16* Bt, size_t ldb, int K, int lane, f32x4 (&acc)[NT]) {
    const int l16 = lane & 15, g4 = lane >> 4;
    const bf16* ap = A + (size_t)l16 * lda + g4 * 8; const bf16* bp = Bt + (size_t)l16 * ldb + g4 * 8;
#pragma unroll
    for (int n = 0; n < NT; ++n) acc[n] = (f32x4){0.f, 0.f, 0.f, 0.f};
#pragma unroll 2
    for (int k = 0; k < K; k += 32) {
        const bf16x8 a = *(const bf16x8*)(ap + k);
#pragma unroll
        for (int n = 0; n < NT; ++n) { const bf16x8 b = *(const bf16x8*)(bp + (size_t)n * 16 * ldb + k); acc[n] = mfma16(a, b, acc[n]); }
    }
}

DEV void memkv_phase(Frame& F) {
    const int gw = F.vcu * NWAVES + F.wave, NGW = F.G * NWAVES, lane = F.lane, l16 = lane & 15, g4 = lane >> 4;
    const bf16* MB = wsp<bf16>(F, WS_MEMB); const float* SSQM = wsp<float>(F, WS_SMALL) + 1024;
    bf16* MK = wsp<bf16>(F, WS_MK); bf16* MVT = wsp<bf16>(F, WS_MVT);
    for (int task = gw; task < 1024; task += NGW) {
        const int l2 = task >> 9, rt = (task >> 3) & 63, chunk = task & 7;
        f32x4 acc[4];
        skinny16<4>(MB + (size_t)rt * 16 * 1024, 1024, wsp<bf16>(F, WS_WKV) + ((size_t)l2 * 512 + chunk * 64) * 1024, 1024, 1024, lane, acc);
        const int b = rt >> 4, key0 = (rt & 15) * 16 + g4 * 4;
        float rs[4];
#pragma unroll
        for (int r = 0; r < 4; ++r) rs[r] = 1.0f / sqrtf(SSQM[rt * 16 + g4 * 4 + r] * (1.0f / 1024.0f) + RMS_EPS);
#pragma unroll
        for (int nt = 0; nt < 4; ++nt) {
            const int n = chunk * 64 + nt * 16 + l16;
            if (chunk < 4) { const int head = n >> 6, d = n & 63;
#pragma unroll
                for (int r = 0; r < 4; ++r) MK[((size_t)((l2 * 4 + b) * 4 + head) * 256 + key0 + r) * 64 + d] = (bf16)f2bf(acc[nt][r] * rs[r]);
            } else { const int n2 = n - 256, head = n2 >> 6, d = n2 & 63;
                v2u w; w.x = pk2(acc[nt][0] * rs[0], acc[nt][1] * rs[1]); w.y = pk2(acc[nt][2] * rs[2], acc[nt][3] * rs[3]);
                *(v2u*)(MVT + (((size_t)((l2 * 4 + b) * 4 + head) * 8 + (key0 >> 5)) * 64 + d) * 32 + slot32(key0 & 31)) = w; }
        }
    }
}

DEV void compress_phase(Frame& F, int l) {
    const int lane = F.lane, l16 = lane & 15, g4 = lane >> 4, quad = F.wave >> 2, q = F.wave & 3;
    float* part = (float*)F.ldsg + quad * (4 * 16 * 128);
    const bf16* KCR = wsp<bf16>(F, WS_KCR); const bf16* VCR = wsp<bf16>(F, WS_VCR);
    bf16* KCC = wsp<bf16>(F, WS_KCC); bf16* VCT = wsp<bf16>(F, WS_VCT);
    const float* bias1 = wsp<float>(F, WS_SMALL);
    for (int tk0 = F.vcu * 2; tk0 < 512; tk0 += F.G * 2) {
        const int tk = tk0 + quad; const int kv = tk >> 8, tile = tk & 255;
        const bf16* raw = kv ? VCR : KCR;
        const bf16* w1 = wsp<bf16>(F, WS_W1C) + (size_t)(l * 2 + kv) * 128 * 2048;
        const bf16* w2 = wsp<bf16>(F, WS_W2C) + (size_t)(l * 2 + kv) * 64 * 128;
        { const int r = tile * 16 + l16, bh = r >> 9, c = r & 511, b = bh >> 1, hkv = bh & 1;
          f32x4 acc[8];
#pragma unroll
          for (int n = 0; n < 8; ++n) acc[n] = (f32x4){0.f, 0.f, 0.f, 0.f};
#pragma unroll 2
          for (int ks = q * 16; ks < q * 16 + 16; ++ks) {
              const int kk = ks * 32 + g4 * 8, ll = kk >> 6, d = kk & 63;
              int tok = 16 * c + ll; tok = tok > T - 1 ? T - 1 : tok;
              const bf16x8 a = *(const bf16x8*)(raw + ((size_t)b * T + tok) * 128 + hkv * 64 + d);
#pragma unroll
              for (int n = 0; n < 8; ++n) { const bf16x8 bb = *(const bf16x8*)(w1 + (size_t)(n * 16 + l16) * 2048 + kk); acc[n] = mfma16(a, bb, acc[n]); }
          }
#pragma unroll
          for (int n = 0; n < 8; ++n)
#pragma unroll
              for (int r2 = 0; r2 < 4; ++r2) part[(q * 16 + g4 * 4 + r2) * 128 + n * 16 + l16] = acc[n][r2];
        }
        __syncthreads();
        { f32x4 o = (f32x4){0.f, 0.f, 0.f, 0.f};
#pragma unroll
          for (int k2 = 0; k2 < 4; ++k2) {
              const int h0 = k2 * 32 + g4 * 8;
              float hv[8];
#pragma unroll
              for (int j = 0; j < 8; ++j) { float s = bias1[(l * 2 + kv) * 128 + h0 + j];
#pragma unroll
                  for (int p = 0; p < 4; ++p) s += part[(p * 16 + l16) * 128 + h0 + j];
                  hv[j] = siluf_(s); }
              bf16x8 a; { v4u w; w.x = pk2(hv[0], hv[1]); w.y = pk2(hv[2], hv[3]); w.z = pk2(hv[4], hv[5]); w.w = pk2(hv[6], hv[7]); a = __builtin_bit_cast(bf16x8, w); }
              const bf16x8 bb = *(const bf16x8*)(w2 + (size_t)(q * 16 + l16) * 128 + h0);
              o = mfma16(a, bb, o);
          }
          const int r0 = tile * 16 + g4 * 4, bh = r0 >> 9, c0 = r0 & 511, d = q * 16 + l16;
          if (kv == 0) {
#pragma unroll
              for (int r2 = 0; r2 < 4; ++r2) KCC[((size_t)bh * 512 + c0 + r2) * 64 + d] = (c0 + r2 == 511) ? (bf16)0 : (bf16)f2bf(o[r2]);
          } else {
              v2u w; w.x = pk2(o[0], o[1]); w.y = pk2(o[2], (c0 + 3 == 511) ? 0.f : o[3]);
              *(v2u*)(VCT + (((size_t)bh * 16 + (c0 >> 5)) * 64 + d) * 32 + slot32(c0 & 31)) = w;
          }
        }
        __syncthreads();
    }
}

DEV float hgrn_lb(const Frame& F, int l, int c) {
    if (l == 0) return 0.f;
    const float a = inp(7)[c], b = inp(7)[256 + c];
    return 1.0f / (1.0f + expf(a - b));
}
DEV float hgrn_logf(float z, float lb) {
    const float la = logf(fmaxf(lb, 1e-30f));
    const float ls = fminf(z, 0.f) - log1pf(expf(-fabsf(z)));
    const float lc = log1pf(-lb) + ls;
    const float mx = fmaxf(la, lc), mn = fminf(la, lc);
    return mx + log1pf(expf(mn - mx));
}
constexpr int HS = 68;
DEV f32x4 mfma4(float a, float b, f32x4 c) { return __builtin_amdgcn_mfma_f32_16x16x4f32(a, b, c, 0, 0, 0); }
DEV void hgrn_setup_chunk(Frame& F, float lb, const float (&z)[8], float* Bc, float* Kc, float* tot) {
    const int d = F.tid & 63, sg = F.tid >> 6;
    const float la = logf(fmaxf(lb, 1e-30f)), l1m = log1pf(-lb), onem = 1.0f - lb;
    float loc[8], kv[8]; float run = 0.f;
#pragma unroll
    for (int i = 0; i < 8; ++i) {
        const float ez = __expf(-fabsf(z[i]));
        const float lc = l1m + (fminf(z[i], 0.f) - __logf(1.0f + ez));
        const float mx = fmaxf(la, lc), mn = fminf(la, lc);
        run += mx + __logf(1.0f + __expf(mn - mx)); loc[i] = run;
        kv[i] = onem * (z[i] >= 0.f ? ez : 1.0f) / (1.0f + ez);
    }
    tot[sg * 64 + d] = run;
    __syncthreads();
    float off = 0.f;
    for (int g = 0; g < sg; ++g) off += tot[g * 64 + d];
#pragma unroll
    for (int i = 0; i < 8; ++i) { Bc[(sg * 8 + i) * HS + d] = off + loc[i]; Kc[(sg * 8 + i) * HS + d] = kv[i]; }
    __syncthreads();
}
DEV void hgrn_local_phase(Frame& F, int l) {
    float* Bc = (float*)F.ldsg; float* Kc = Bc + 64 * HS; float* Vc = Kc + 64 * HS; float* tot = Vc + 64 * HS;
    float* U = wsp<float>(F, WS_U); float* DEC = wsp<float>(F, WS_DEC);
    const int lane = F.lane, w = F.wave, li = lane & 15, kq = lane >> 4;
    for (int task = F.vcu; task < 2048; task += F.G) {
        const int bh = task >> 7, ch = task & 127, b = bh >> 2, h = bh & 3;
        { const int d = F.tid & 63, sg = F.tid >> 6;
          const size_t go = ((size_t)b * T + ch * 64 + sg * 8) * 256 + h * 64 + d;
          const float* HFp = wsp<float>(F, WS_HF) + go; const bf16* HIp = wsp<bf16>(F, WS_HI) + go;
          float z[8], vi[8];
#pragma unroll
          for (int i = 0; i < 8; ++i) { z[i] = HFp[(size_t)i * 256]; vi[i] = bf2f(HIp[(size_t)i * 256]); }
          hgrn_setup_chunk(F, hgrn_lb(F, l, h * 64 + d), z, Bc, Kc, tot);
          const float bl = Bc[63 * HS + d];
#pragma unroll
          for (int i = 0; i < 8; ++i) { const int s = sg * 8 + i; Kc[s * HS + d] *= __expf(bl - Bc[s * HS + d]); Vc[s * HS + d] = vi[i]; }
          if (sg == 0) DEC[(size_t)task * 64 + d] = expf(bl); }
        __syncthreads();
        { const int dI = w >> 1, e0 = (w & 1) * 32;
          f32x4 a0 = (f32x4){0.f, 0.f, 0.f, 0.f}, a1 = a0;
#pragma unroll 4
          for (int k0 = 0; k0 < 64; k0 += 4) { const int s = k0 + kq;
              const float a = Kc[s * HS + dI * 16 + li], b0 = Vc[s * HS + e0 + li], b1 = Vc[s * HS + e0 + 16 + li];
              a0 = mfma4(a, b0, a0); a1 = mfma4(a, b1, a1); }
#pragma unroll
          for (int r = 0; r < 4; ++r) { float* up = U + ((size_t)task * 64 + dI * 16 + 4 * kq + r) * 64 + e0 + li; up[0] = a0[r]; up[16] = a1[r]; } }
        __syncthreads();
    }
}
DEV void hgrn_scan_phase(Frame& F, int probe = 0) {
    const float* U = wsp<float>(F, WS_U); float* U2 = wsp<float>(F, probe ? WS_PROBE : WS_U2); const float* DEC = wsp<float>(F, WS_DEC);
    const int nact = (F.G * 256 >= 65536) ? 256 : 512;
    if (F.tid < nact)
    for (int gid = F.vcu * nact + F.tid; gid < 65536; gid += F.G * nact) {
        const int bh = gid >> 12, de = gid & 4095, d = de >> 6;
        float S = 0.f; const float* up = U + (size_t)bh * 128 * 4096 + de; float* op = U2 + (size_t)bh * 128 * 4096 + de; const float* dp = DEC + (size_t)bh * 128 * 64 + d;
#pragma unroll 16
        for (int ch = 0; ch < 128; ++ch) { const float u = up[(size_t)ch * 4096]; const float dc = dp[ch * 64]; op[(size_t)ch * 4096] = S; S = dc * S + u; }
    }
}
DEV void hgrn_out_phase(Frame& F, int l) {
    float* Bc = (float*)F.ldsg; float* Kb = Bc + 64 * HS; float* Vc = Kb + 64 * HS; float* Qs = Vc + 64 * HS; float* Sc = Qs + 64 * HS; float* Ac = Sc + 64 * HS; float* tot = Ac + 64 * HS;
    float* Oc = Kb;
    const float* U = wsp<float>(F, WS_U2); bf16* CAT = wsp<bf16>(F, WS_CAT);
    const int lane = F.lane, w = F.wave, li = lane & 15, kq = lane >> 4;
    for (int task = F.vcu; task < 2048; task += F.G) {
        const int bh = task >> 7, ch = task & 127, b = bh >> 2, h = bh & 3;
        float gv[8];
        { const int d = F.tid & 63, sg = F.tid >> 6;
          const size_t go = ((size_t)b * T + ch * 64 + sg * 8) * 256 + h * 64 + d;
          const float* HFp = wsp<float>(F, WS_HF) + go; const bf16* HIp = wsp<bf16>(F, WS_HI) + go; const bf16* HQp = wsp<bf16>(F, WS_HQ) + go; const bf16* HGp = wsp<bf16>(F, WS_HG) + go;
          const float* Up = U + ((size_t)task * 64 + sg * 8) * 64 + d;
          float z[8], vi[8], qi[8], si[8];
#pragma unroll
          for (int i = 0; i < 8; ++i) { z[i] = HFp[(size_t)i * 256]; vi[i] = bf2f(HIp[(size_t)i * 256]); qi[i] = bf2f(HQp[(size_t)i * 256]); gv[i] = bf2f(HGp[(size_t)i * 256]); si[i] = Up[(size_t)i * 64]; }
          hgrn_setup_chunk(F, hgrn_lb(F, l, h * 64 + d), z, Bc, Kb, tot);
#pragma unroll
          for (int i = 0; i < 8; ++i) { const int s = sg * 8 + i, J = s >> 4; const float rJ = J ? Bc[(16 * J - 1) * HS + d] : 0.f;
              Kb[s * HS + d] *= __expf(fminf(rJ - Bc[s * HS + d], 80.f));
              Vc[s * HS + d] = vi[i]; Qs[s * HS + d] = qi[i] * 0.125f; Sc[s * HS + d] = si[i]; } }
        __syncthreads();
#pragma unroll 1
        for (int ti = w; ti < 10; ti += 8) {
            const int I = ti < 1 ? 0 : (ti < 3 ? 1 : (ti < 6 ? 2 : 3)), J = ti - (I * (I + 1)) / 2;
            const int t = I * 16 + li; f32x4 acc = (f32x4){0.f, 0.f, 0.f, 0.f};
#pragma unroll 4
            for (int k0 = 0; k0 < 64; k0 += 4) { const int d = k0 + kq; const float rJ = J ? Bc[(16 * J - 1) * HS + d] : 0.f;
                const float a = Qs[t * HS + d] * __expf(Bc[t * HS + d] - rJ), bb = Kb[(J * 16 + li) * HS + d];
                acc = mfma4(a, bb, acc); }
#pragma unroll
            for (int r = 0; r < 4; ++r) { const int tt = I * 16 + 4 * kq + r, ss = J * 16 + li; Ac[tt * HS + ss] = (ss <= tt) ? acc[r] : 0.f; }
        }
        __syncthreads();
        { const int I = w >> 1, e0 = (w & 1) * 32, t = I * 16 + li;
          f32x4 a0 = (f32x4){0.f, 0.f, 0.f, 0.f}, a1 = a0;
#pragma unroll 4
          for (int k0 = 0; k0 < 64; k0 += 4) { const int d = k0 + kq;
              const float a = Qs[t * HS + d] * __expf(Bc[t * HS + d]), b0 = Sc[d * HS + e0 + li], b1 = Sc[d * HS + e0 + 16 + li];
              a0 = mfma4(a, b0, a0); a1 = mfma4(a, b1, a1); }
#pragma unroll 1
          for (int s0 = 0; s0 < 16 * (I + 1); s0 += 4) { const int s = s0 + kq;
              const float a = Ac[t * HS + s], b0 = Vc[s * HS + e0 + li], b1 = Vc[s * HS + e0 + 16 + li];
              a0 = mfma4(a, b0, a0); a1 = mfma4(a, b1, a1); }
#pragma unroll
          for (int r = 0; r < 4; ++r) { float* op = Oc + (I * 16 + 4 * kq + r) * HS + e0 + li; op[0] = a0[r]; op[16] = a1[r]; } }
        __syncthreads();
        { const float ng = inp(8)[l * 256 + h * 64 + lane];
          { const int t = w * 8 + (lane >> 3); const float* op = Oc + t * HS + (lane & 7) * 8; float s = 0.f;
#pragma unroll
            for (int j = 0; j < 8; ++j) s += op[j] * op[j];
            s += __shfl_xor(s, 1); s += __shfl_xor(s, 2); s += __shfl_xor(s, 4);
            if ((lane & 7) == 0) tot[t] = 1.0f / sqrtf(s * (1.0f / 64.0f) + RMS_EPS); }
          LDS_WAIT();
#pragma unroll
          for (int i = 0; i < 8; ++i) { const int t = w * 8 + i; const float o = Oc[t * HS + lane];
              const size_t row = (size_t)b * T + ch * 64 + t;
              CAT[row * 1024 + 768 + h * 64 + lane] = (bf16)f2bf(o * tot[t] * ng * siluf_(gv[i])); } }
        __syncthreads();
    }
}

DEV void conv_phase(Frame& F, int l) {
    const bf16* CB = wsp<bf16>(F, WS_CB); const bf16* CC = wsp<bf16>(F, WS_CC); const bf16* CH = wsp<bf16>(F, WS_CH); bf16* CAT = wsp<bf16>(F, WS_CAT);
    const float* cw = inp(3) + l * 3 * 256;
    for (int it = F.vcu * 512 + F.tid; it < NTOK * 32; it += F.G * 512) {
        const int m = it >> 5, c0 = (it & 31) * 8, t = m & (T - 1);
        const v4u bb = *(const v4u*)(CB + (size_t)m * 256 + c0);
        float y[8];
#pragma unroll
        for (int j = 0; j < 8; ++j) y[j] = 0.f;
#pragma unroll
        for (int k = 0; k < 3; ++k) {
            if (t + k - 2 >= 0) {
                const size_t o = (size_t)(m + k - 2) * 256 + c0;
                const v4u cc = *(const v4u*)(CC + o), hh = *(const v4u*)(CH + o);
#pragma unroll
                for (int j = 0; j < 4; ++j) { const float w0 = cw[k * 256 + c0 + 2 * j], w1 = cw[k * 256 + c0 + 2 * j + 1];
                    y[2 * j] += w0 * (bflo(cc[j]) * bflo(hh[j])); y[2 * j + 1] += w1 * (bfhi(cc[j]) * bfhi(hh[j])); }
            }
        }
        v4u o4;
#pragma unroll
        for (int j = 0; j < 4; ++j) o4[j] = pk2(bflo(bb[j]) * y[2 * j], bfhi(bb[j]) * y[2 * j + 1]);
        *(v4u*)(CAT + (size_t)m * 1024 + 512 + c0) = o4;
    }
}
struct SmState { float m, l; f32x4 o[4]; };
DEV void sm_reset(SmState& st) { st.m = -INFINITY; st.l = 0.f;
#pragma unroll
    for (int i = 0; i < 4; ++i) st.o[i] = (f32x4){0.f, 0.f, 0.f, 0.f}; }
DEV float sm_lsum(const SmState& st) { float l = st.l; l += __shfl_xor(l, 16); l += __shfl_xor(l, 32); return l; }
DEV void load_k(const bf16* kbase, int lane, bf16x8 (&kf)[2][2]) {
    const int l16 = lane & 15, g4 = lane >> 4;
#pragma unroll
    for (int tt = 0; tt < 2; ++tt)
#pragma unroll
        for (int ks = 0; ks < 2; ++ks) kf[tt][ks] = *(const bf16x8*)(kbase + (size_t)(16 * tt + l16) * 64 + ks * 32 + g4 * 8);
}
DEV void load_v(const bf16* vbase, int lane, bf16x8 (&vf)[4]) {
    const int l16 = lane & 15, g4 = lane >> 4;
#pragma unroll
    for (int dt = 0; dt < 4; ++dt) vf[dt] = *(const bf16x8*)(vbase + (size_t)(dt * 16 + l16) * 32 + g4 * 8);
}
DEV void qk_tile(const bf16x8 (&kf)[2][2], const bf16x8 (&qf)[2], f32x4 (&s)[2]) {
#pragma unroll
    for (int tt = 0; tt < 2; ++tt) { s[tt] = mfma16(kf[tt][0], qf[0], (f32x4){0.f, 0.f, 0.f, 0.f}); s[tt] = mfma16(kf[tt][1], qf[1], s[tt]); }
}
DEV bf16x8 pack_p(const float (&p)[2][4]) {
    v4u w; w.x = pk2(p[0][0], p[0][1]); w.y = pk2(p[0][2], p[0][3]); w.z = pk2(p[1][0], p[1][1]); w.w = pk2(p[1][2], p[1][3]);
    return __builtin_bit_cast(bf16x8, w);
}
template <int MODE, class MaskF>
DEV void attn_compute(const bf16x8 (&kf)[2][2], const bf16x8 (&vf)[4], const bf16x8 (&qf)[2], SmState& st, int lane, bool colok, MaskF mask) {
    const int g4 = lane >> 4;
    f32x4 s[2]; qk_tile(kf, qf, s);
    float sv[2][4]; float tmax = -INFINITY;
#pragma unroll
    for (int tt = 0; tt < 2; ++tt)
#pragma unroll
        for (int r = 0; r < 4; ++r) { float x = s[tt][r]; if (MODE == 2) x = mask(16 * tt + 4 * g4 + r) ? x : -INFINITY; sv[tt][r] = x; tmax = fmaxf(tmax, x); }
    if (MODE == 1) tmax = colok ? tmax : -INFINITY;
    tmax = fmaxf(tmax, __shfl_xor(tmax, 16)); tmax = fmaxf(tmax, __shfl_xor(tmax, 32));
    const float mnew = fmaxf(st.m, tmax), muse = (mnew == -INFINITY) ? 0.f : mnew;
    const float alpha = ex2(st.m - muse);
    const float msub = (MODE == 1) ? (colok ? muse : INFINITY) : muse;
    float p[2][4]; float ps = 0.f;
#pragma unroll
    for (int tt = 0; tt < 2; ++tt)
#pragma unroll
        for (int r = 0; r < 4; ++r) { p[tt][r] = ex2(sv[tt][r] - msub); ps += p[tt][r]; }
    st.l = st.l * alpha + ps; st.m = mnew;
    const bf16x8 pf = pack_p(p);
#pragma unroll
    for (int dt = 0; dt < 4; ++dt) { st.o[dt] = st.o[dt] * alpha; st.o[dt] = mfma16(vf[dt], pf, st.o[dt]); }
}
template <int MODE, class MaskF>
DEV void attn_compute_fixed(const bf16x8 (&kf)[2][2], const bf16x8 (&vf)[4], const bf16x8 (&qf)[2], SmState& st, float mref, int lane, bool colok, MaskF mask) {
    const int g4 = lane >> 4;
    f32x4 s[2]; qk_tile(kf, qf, s);
    const float msub = (MODE == 1) ? (colok ? mref : INFINITY) : mref;
    float p[2][4]; float ps = 0.f;
#pragma unroll
    for (int tt = 0; tt < 2; ++tt)
#pragma unroll
        for (int r = 0; r < 4; ++r) { float x = s[tt][r] - msub; if (MODE == 2) x = mask(16 * tt + 4 * g4 + r) ? x : -INFINITY; p[tt][r] = ex2(x); ps += p[tt][r]; }
    st.l += ps;
    const bf16x8 pf = pack_p(p);
#pragma unroll
    for (int dt = 0; dt < 4; ++dt) st.o[dt] = mfma16(vf[dt], pf, st.o[dt]);
}
template <int MODE, class MaskF>
DEV void attn_max(const bf16x8 (&kf)[2][2], const bf16x8 (&qf)[2], float& mx, int lane, bool colok, MaskF mask) {
    const int g4 = lane >> 4;
    f32x4 s[2]; qk_tile(kf, qf, s);
    float tmax = -INFINITY;
#pragma unroll
    for (int tt = 0; tt < 2; ++tt)
#pragma unroll
        for (int r = 0; r < 4; ++r) { float x = s[tt][r]; if (MODE == 2) x = mask(16 * tt + 4 * g4 + r) ? x : -INFINITY; tmax = fmaxf(tmax, x); }
    if (MODE == 1) tmax = colok ? tmax : -INFINITY;
    mx = fmaxf(mx, tmax);
}
DEV float colmax_finish(float mx) { mx = fmaxf(mx, __shfl_xor(mx, 16)); mx = fmaxf(mx, __shfl_xor(mx, 32)); return mx == -INFINITY ? 0.f : mx; }
DEV float col_norm(const bf16x8 (&qf)[2]) {
    float s = 0.f;
#pragma unroll
    for (int ks = 0; ks < 2; ++ks) { const v4u w = __builtin_bit_cast(v4u, qf[ks]);
#pragma unroll
        for (int j = 0; j < 4; ++j) { const float a = bflo(w[j]), b = bfhi(w[j]); s += a * a + b * b; } }
    s += __shfl_xor(s, 16); s += __shfl_xor(s, 32);
    return sqrtf(s);
}
DEV float wave_max_uniform(float v) {
#pragma unroll
    for (int o = 1; o < 64; o <<= 1) v = fmaxf(v, __shfl_xor(v, o));
    return __builtin_bit_cast(float, __builtin_amdgcn_readfirstlane(__builtin_bit_cast(int, v)));
}
constexpr float FIXED_REF_MAX = 40.f;
DEV void kmax_phase(Frame& F, int l) {
    const int lane = F.lane; const int gw = F.vcu * NWAVES + F.wave, NGW = F.G * NWAVES;
    for (int item = gw; item < 2048; item += NGW) {
        const int br = item >> 10, bh = (item >> 7) & 7, key = (item & 127) * 64 + lane;
        const bf16* kp = wsp<bf16>(F, br ? WS_KW : WS_KS) + ((size_t)bh * T + key) * 64;
        float s = 0.f;
#pragma unroll
        for (int i = 0; i < 8; ++i) { const v4u w = *(const v4u*)(kp + i * 8);
#pragma unroll
            for (int j = 0; j < 4; ++j) { const float a = bflo(w[j]), b = bfhi(w[j]); s += a * a + b * b; } }
#pragma unroll
        for (int o = 1; o < 64; o <<= 1) s = fmaxf(s, __shfl_xor(s, o));
        if (lane == 0) __hip_atomic_fetch_max((unsigned*)F.ctl + CW_KMAX + l * 16 + br * 8 + bh, __builtin_bit_cast(unsigned, s), RLX_AGENT);
    }
}
struct NoMask { DEV bool operator()(int) const { return true; } };
template <int D, bool WITHV, class AddrF, class BodyF>
DEV void pipe_run(int n, int lane, AddrF addr, BodyF body) {
    if (n <= 0) return;
    bf16x8 kf[D][2][2], vf[D][4];
#pragma unroll
    for (int d = 0; d < D; ++d) { const bf16* kb; const bf16* vb; addr(d < n ? d : n - 1, kb, vb); load_k(kb, lane, kf[d]); if (WITHV) load_v(vb, lane, vf[d]); }
#pragma unroll 1
    for (int i = 0; i < n; i += D) {
#pragma unroll
        for (int d = 0; d < D; ++d) { const int s = i + d;
            if (s < n) body(s, kf[d], vf[d]);
            if (D > 1 || s + 1 < n) { const bf16* kb; const bf16* vb; addr(s + D < n ? s + D : n - 1, kb, vb); load_k(kb, lane, kf[d]); if (WITHV) load_v(vb, lane, vf[d]); } }
    }
}
template <class AddrF, class BodyF>
DEV void pipe_run_k2(int n, int lane, AddrF addr, BodyF body) {
    if (n <= 0) return;
    bf16x8 kf[2][2][2], vf[4];
    { const bf16* kb; const bf16* vb; addr(0, kb, vb); load_k(kb, lane, kf[0]); }
#pragma unroll 1
    for (int i = 0; i < n; i += 2) {
#pragma unroll
        for (int d = 0; d < 2; ++d) { const int s = i + d;
            { const bf16* kb; const bf16* vb; addr(s < n ? s : n - 1, kb, vb); load_v(vb, lane, vf); }
            { const bf16* kb; const bf16* vb; addr(s + 1 < n ? s + 1 : n - 1, kb, vb); load_k(kb, lane, kf[d ^ 1]); }
            if (s < n) body(s, kf[d], vf); }
    }
}
constexpr int PIPE_D = 2;

DEV void acc_add_packed(unsigned (&pk)[4][4][2], int ct, const f32x4 (&o)[4], float sc, bool first) {
#pragma unroll
    for (int dt = 0; dt < 4; ++dt) {
        f32x4 v = o[dt] * sc;
        if (!first) { v[0] += bflo(pk[ct][dt][0]); v[1] += bfhi(pk[ct][dt][0]); v[2] += bflo(pk[ct][dt][1]); v[3] += bfhi(pk[ct][dt][1]); }
        pk[ct][dt][0] = pk2(v[0], v[1]); pk[ct][dt][1] = pk2(v[2], v[3]);
    }
}
template <int VAR>
DEV void nsa_phase_t(Frame& F, int l) {
#define NSA_RELANE() int ln_ = lane; asm volatile("" : "+v"(ln_)); const int l16 = ln_ & 15, g4 = ln_ >> 4, tq = l16 >> 2, gh = l16 & 3; const size_t mrow0 = (size_t)b * T + t0 + tq; const int tl0 = t0 + tq; (void)l16; (void)g4; (void)gh; (void)mrow0; (void)tl0
    float* IMP = (float*)(F.ldsg + F.wave * NSA_LDS_WAVE);
    float* VALS = IMP + 2048; int* BL = (int*)(IMP + 2176); unsigned* SELB = (unsigned*)(IMP + 2304); float* GL = IMP + 2432;
    const bf16* Q = wsp<bf16>(F, WS_Q); const bf16* QR = wsp<bf16>(F, WS_QR);
    const bf16* KCC = wsp<bf16>(F, WS_KCC); const bf16* VCT = wsp<bf16>(F, WS_VCT);
    const bf16* KS = wsp<bf16>(F, WS_KS); const bf16* VST = wsp<bf16>(F, WS_VST);
    const bf16* KW = wsp<bf16>(F, WS_KW); const bf16* VWT = wsp<bf16>(F, WS_VWT);
    bf16* CAT = wsp<bf16>(F, WS_CAT);
    const int gw = F.vcu * NWAVES + F.wave, NGW = F.G * NWAVES;
    const bool xmap = (F.G == 256);
#pragma unroll 1
    for (int task = gw; task < 4096; task += NGW) {
        unsigned zl_ = 0u; asm volatile("" : "+v"(zl_)); const int lane = (int)__builtin_amdgcn_mbcnt_hi(~0u, __builtin_amdgcn_mbcnt_lo(~0u, zl_));
        const int bh = xmap ? (gw >> 8) : (task & 7), idx = xmap ? ((task >> 11) ? 511 - (gw & 255) : (gw & 255)) : (task >> 3);
        const int t0 = idx * 16, b = bh >> 1, hkv = bh & 1, cur = t0 >> 6;
        bf16x8 qf[4][2];
        unsigned opk[4][4][2];
        SmState st[4];
        float qnmax = 0.f;
        { NSA_RELANE();
#pragma unroll
        for (int ct = 0; ct < 4; ++ct)
#pragma unroll
            for (int ks = 0; ks < 2; ++ks) qf[ct][ks] = *(const bf16x8*)(Q + (mrow0 + 4 * ct) * 512 + hkv * 256 + gh * 64 + ks * 32 + g4 * 8);
        { NSA_RELANE();
          f32x4 ga[1]; ga[0] = (f32x4){0.f, 0.f, 0.f, 0.f};
          { const bf16* ap = wsp<bf16>(F, WS_HB) + ((size_t)b * T + t0 + l16) * 1024 + g4 * 8; const bf16* bp = wsp<bf16>(F, WS_WG) + (size_t)((l * 2 + hkv) * 16 + l16) * 1024 + g4 * 8;
#pragma unroll 1
            for (int k0 = 0; k0 < 1024; k0 += 256) {
                bf16x8 av[8], bv[8];
#pragma unroll
                for (int i = 0; i < 8; ++i) { av[i] = *(const bf16x8*)(ap + k0 + 32 * i); bv[i] = *(const bf16x8*)(bp + k0 + 32 * i); }
#pragma unroll
                for (int i = 0; i < 8; ++i) ga[0] = mfma16(av[i], bv[i], ga[0]);
            } }
          const float rs = (ln_ < 16) ? row_rstd_full(wsp<float>(F, WS_SSQ), b * T + t0 + ln_) : 0.f;
#pragma unroll
          for (int r = 0; r < 4; ++r) GL[(g4 * 4 + r) * 16 + l16] = sigmoidf_(ga[0][r] * __shfl(rs, g4 * 4 + r));
        }
        const int ngc = (t0 + 15 >= 31) ? (((t0 + 15 - 31) >> 4) >> 5) + 1 : 0;
        const bf16* kcb = KCC + (size_t)bh * 512 * 64; const bf16* vcb = VCT + (size_t)bh * 16 * 64 * 32;
        float cm[4], cl[4];
#pragma unroll
        for (int ct = 0; ct < 4; ++ct) { cm[ct] = -INFINITY; cl[ct] = 0.f; }
        pipe_run<1, false>(ngc, ln_, [&](int s, const bf16*& kb, const bf16*& vb) { kb = kcb + (size_t)s * 32 * 64; vb = vcb; },
            [&](int kg, const bf16x8 (&kf)[2][2], const bf16x8 (&)[4]) {
#pragma unroll
                for (int ct = 0; ct < 4; ++ct) {
                    const int tl = tl0 + 4 * ct;
                    f32x4 s[2]; qk_tile(kf, qf[ct], s);
                    float sv[2][4]; float tmax = -INFINITY;
#pragma unroll
                    for (int tt = 0; tt < 2; ++tt)
#pragma unroll
                        for (int r = 0; r < 4; ++r) { const int c = kg * 32 + 16 * tt + 4 * g4 + r; sv[tt][r] = (16 * c + 31 <= tl) ? s[tt][r] : -INFINITY; tmax = fmaxf(tmax, sv[tt][r]); }
                    tmax = fmaxf(tmax, __shfl_xor(tmax, 16)); tmax = fmaxf(tmax, __shfl_xor(tmax, 32));
                    const float mnew = fmaxf(cm[ct], tmax), muse = (mnew == -INFINITY) ? 0.f : mnew;
                    float ps = 0.f;
#pragma unroll
                    for (int tt = 0; tt < 2; ++tt)
#pragma unroll
                        for (int r = 0; r < 4; ++r) ps += ex2(sv[tt][r] - muse);
                    cl[ct] = cl[ct] * ex2(cm[ct] - muse) + ps; cm[ct] = mnew;
                }
            });
        {
            float cmu[4], cinv[4], carry[4];
#pragma unroll
            for (int ct = 0; ct < 4; ++ct) { float l = cl[ct]; l += __shfl_xor(l, 16); l += __shfl_xor(l, 32);
                cmu[ct] = (cm[ct] == -INFINITY) ? 0.f : cm[ct]; cinv[ct] = l > 0.f ? 1.0f / l : 0.f; carry[ct] = 0.f; sm_reset(st[ct]); }
            pipe_run<1, true>(ngc, ln_, [&](int s, const bf16*& kb, const bf16*& vb) { kb = kcb + (size_t)s * 32 * 64; vb = vcb + (size_t)s * 64 * 32; },
                [&](int kg, const bf16x8 (&kf)[2][2], const bf16x8 (&vf)[4]) {
#pragma unroll
                    for (int ct = 0; ct < 4; ++ct) {
                        const int tl = tl0 + 4 * ct;
                        f32x4 s[2]; qk_tile(kf, qf[ct], s);
                        float p[2][4];
#pragma unroll
                        for (int tt = 0; tt < 2; ++tt) {
#pragma unroll
                            for (int r = 0; r < 4; ++r) { const int c = kg * 32 + 16 * tt + 4 * g4 + r; p[tt][r] = (16 * c + 31 <= tl) ? ex2(s[tt][r] - cmu[ct]) * cinv[ct] : 0.f; }
                            const float hb = 0.5f * p[tt][3];
                            const float bsh = __shfl(hb, (ln_ + 48) & 63);
                            float v = ((p[tt][0] + p[tt][1]) + (p[tt][2] + hb)) + ((g4 == 0) ? carry[ct] : bsh);
                            carry[ct] = bsh;
                            v += __shfl_xor(v, 1); v += __shfl_xor(v, 2);
                            if (gh == 0) IMP[(4 * ct + tq) * 128 + kg * 8 + 4 * tt + g4] = v;
                        }
                        const bf16x8 pf = pack_p(p);
#pragma unroll
                        for (int dt = 0; dt < 4; ++dt) st[ct].o[dt] = mfma16(vf[dt], pf, st[ct].o[dt]);
                    }
                });
#pragma unroll
            for (int ct = 0; ct < 4; ++ct) acc_add_packed(opk, ct, st[ct].o, GL[(4 * ct + tq) * 16 + gh * 3 + 0], true);
        }
        }
        LDS_WAIT();
        unsigned sb0 = 0u, sb1 = 0u;
        if (cur < 16) { sb0 = (lane <= cur) ? 0xffffu : 0u; }
        else {
            const unsigned long long below = (1ull << lane) - 1ull;
#pragma unroll 1
            for (int q = 0; q < 16; ++q) {
                unsigned k0, k1;
                { const int j = lane; const float v = (j == 0 || j == cur || j == cur - 1) ? 1e6f : IMP[q * 128 + j]; k0 = (j > cur) ? 0u : __builtin_bit_cast(unsigned, v) + 1u; }
                { const int j = lane + 64; const float v = (j == cur || j == cur - 1) ? 1e6f : IMP[q * 128 + j]; k1 = (j > cur) ? 0u : __builtin_bit_cast(unsigned, v) + 1u; }
                unsigned lo = 0u, hi = 0xffffffffu;
                while (hi - lo > 1u) { const unsigned mid = lo + ((hi - lo) >> 1);
                    const int c = __builtin_popcountll(__ballot(k0 >= mid)) + __builtin_popcountll(__ballot(k1 >= mid));
                    if (c >= 16) lo = mid; else hi = mid; }
                const unsigned long long g0 = __ballot(k0 > lo), g1 = __ballot(k1 > lo), e0 = __ballot(k0 == lo), e1 = __ballot(k1 == lo);
                const int need = 16 - __builtin_popcountll(g0) - __builtin_popcountll(g1);
                const bool s0 = (k0 > lo) || (k0 == lo && __builtin_popcountll(e0 & below) < need);
                const bool s1 = (k1 > lo) || (k1 == lo && __builtin_popcountll(e0) + __builtin_popcountll(e1 & below) < need);
                sb0 |= (s0 ? 1u : 0u) << q; sb1 |= (s1 ? 1u : 0u) << q;
            }
        }
        SELB[lane] = sb0; SELB[lane + 64] = sb1;
        LDS_WAIT();
#define NSA_PARK() do { _Pragma("unroll") for (int i_ = 0; i_ < 8; ++i_) { v4u w_; w_.x = opk[i_ >> 1][(i_ & 1) * 2][0]; w_.y = opk[i_ >> 1][(i_ & 1) * 2][1]; w_.z = opk[i_ >> 1][(i_ & 1) * 2 + 1][0]; w_.w = opk[i_ >> 1][(i_ & 1) * 2 + 1][1]; ((v4u*)IMP)[i_ * 64 + lane] = w_; } } while (0)
#define NSA_UNPARK() do { _Pragma("unroll") for (int i_ = 0; i_ < 8; ++i_) { const v4u w_ = ((const v4u*)IMP)[i_ * 64 + lane]; opk[i_ >> 1][(i_ & 1) * 2][0] = w_.x; opk[i_ >> 1][(i_ & 1) * 2][1] = w_.y; opk[i_ >> 1][(i_ & 1) * 2 + 1][0] = w_.z; opk[i_ >> 1][(i_ & 1) * 2 + 1][1] = w_.w; } } while (0)
        NSA_PARK();
        { NSA_RELANE();
#pragma unroll
        for (int ct = 0; ct < 4; ++ct)
#pragma unroll
            for (int ks = 0; ks < 2; ++ks) qf[ct][ks] = *(const bf16x8*)(QR + (mrow0 + 4 * ct) * 512 + hkv * 256 + gh * 64 + ks * 32 + g4 * 8);
        {
            const unsigned long long ulo = __ballot(sb0 != 0u), uhi = __ballot(sb1 != 0u);
            const unsigned long long below = (1ull << ln_) - 1ull;
            const int nlo = __builtin_popcountll(ulo), nblk = nlo + __builtin_popcountll(uhi);
            if (sb0 != 0u) BL[__builtin_popcountll(ulo & below)] = ln_;
            if (sb1 != 0u) BL[nlo + __builtin_popcountll(uhi & below)] = ln_ + 64;
            LDS_WAIT();
#pragma unroll
            for (int ct = 0; ct < 4; ++ct) sm_reset(st[ct]);
            const bf16* kb0 = KS + (size_t)bh * T * 64; const bf16* vb0 = VST + (size_t)bh * 256 * 64 * 32;
            float mr; bool fixed;
            { const float kmx = sqrtf(__builtin_bit_cast(float, __hip_atomic_load((const unsigned*)F.ctl + CW_KMAX + l * 16 + bh, RLX_AGENT))); float mm = 0.f;
#pragma unroll
              for (int ct = 0; ct < 4; ++ct) mm = fmaxf(mm, col_norm(qf[ct]));
              qnmax = wave_max_uniform(mm); mr = qnmax * kmx * 1.002f + 1e-3f;
              fixed = mr < FIXED_REF_MAX; }
            auto addr_sel = [&](int s, const bf16*& kb, const bf16*& vb) { const int g32 = BL[s >> 1] * 2 + (s & 1); kb = kb0 + (size_t)g32 * 32 * 64; vb = vb0 + (size_t)g32 * 64 * 32; };
            asm volatile("" ::: "memory");
            if (!fixed) {
                float mx[4] = {-INFINITY, -INFINITY, -INFINITY, -INFINITY};
                pipe_run<1, false>(2 * nblk, ln_, addr_sel,
                    [&](int s, const bf16x8 (&kf)[2][2], const bf16x8 (&)[4]) {
                        const int j = BL[s >> 1], key0 = j * 64 + (s & 1) * 32;
                        const unsigned tm = (unsigned)__builtin_amdgcn_readfirstlane((int)SELB[j]);
#pragma unroll
                        for (int ct = 0; ct < 4; ++ct) { const unsigned tmk = (tm >> (4 * ct)) & 0xFu;
                            if (tmk) { const bool colok = (tmk >> tq) & 1u; const int tl = tl0 + 4 * ct;
                                if (j == cur) attn_max<2>(kf, qf[ct], mx[ct], ln_, true, [&](int kk) { return colok && (key0 + kk <= tl); });
                                else attn_max<1>(kf, qf[ct], mx[ct], ln_, colok, NoMask()); } }
                    });
                mr = wave_max_uniform(fmaxf(fmaxf(mx[0], mx[1]), fmaxf(mx[2], mx[3]))); if (mr == -INFINITY) mr = 0.f;
            }
            asm volatile("" ::: "memory");
            pipe_run_k2(2 * nblk, ln_, addr_sel,
                [&](int s, const bf16x8 (&kf)[2][2], const bf16x8 (&vf)[4]) {
                    const int j = BL[s >> 1], key0 = j * 64 + (s & 1) * 32;
                    const unsigned tm = (unsigned)__builtin_amdgcn_readfirstlane((int)SELB[j]);
#pragma unroll
                    for (int ct = 0; ct < 4; ++ct) {
                        const unsigned tmk = (tm >> (4 * ct)) & 0xFu;
                        if (tmk) {
                            const bool colok = (tmk >> tq) & 1u; const int tl = tl0 + 4 * ct;
                            if (j == cur) attn_compute_fixed<2>(kf, vf, qf[ct], st[ct], mr, ln_, true, [&](int kk) { return colok && (key0 + kk <= tl); });
                            else attn_compute_fixed<1>(kf, vf, qf[ct], st[ct], mr, ln_, colok, NoMask());
                        }
                        __builtin_amdgcn_sched_barrier(0);
                    }
                });
            LDS_WAIT();
            NSA_UNPARK();
#pragma unroll
            for (int ct = 0; ct < 4; ++ct) { const float ls = sm_lsum(st[ct]); const float gs = GL[(4 * ct + tq) * 16 + gh * 3 + 1];
                acc_add_packed(opk, ct, st[ct].o, ls > 0.f ? gs / ls : 0.f, false); }
            NSA_PARK();
        }
        }
        { NSA_RELANE();
#pragma unroll
            for (int ct = 0; ct < 4; ++ct) sm_reset(st[ct]);
            const bf16* kb0 = (VAR == 3 ? KS : KW) + (size_t)bh * T * 64; const bf16* vb0 = (VAR == 3 ? VST : VWT) + (size_t)bh * 256 * 64 * 32;
            const int glo = (t0 - 511 > 0 ? t0 - 511 : 0) >> 5, ghi = (t0 + 15) >> 5;
            float mr; bool fixed;
            { const float kmx = sqrtf(__builtin_bit_cast(float, __hip_atomic_load((const unsigned*)F.ctl + CW_KMAX + l * 16 + 8 + bh, RLX_AGENT)));
              mr = qnmax * kmx * 1.002f + 1e-3f;
              fixed = mr < FIXED_REF_MAX; }
            auto addr_win = [&](int s, const bf16*& kb, const bf16*& vb) { kb = kb0 + (size_t)(glo + s) * 32 * 64; vb = vb0 + (size_t)(glo + s) * 64 * 32; };
            asm volatile("" ::: "memory");
            if (!fixed) {
                float mx[4] = {-INFINITY, -INFINITY, -INFINITY, -INFINITY};
                pipe_run<1, false>(ghi - glo + 1, ln_, addr_win,
                    [&](int s, const bf16x8 (&kf)[2][2], const bf16x8 (&)[4]) {
                        const int key0 = (glo + s) * 32;
#pragma unroll
                        for (int ct = 0; ct < 4; ++ct) { const int tl = tl0 + 4 * ct;
                            attn_max<2>(kf, qf[ct], mx[ct], ln_, true, [&](int kk) { const int kp = key0 + kk; return kp <= tl && kp + 512 > tl; }); }
                    });
                mr = wave_max_uniform(fmaxf(fmaxf(mx[0], mx[1]), fmaxf(mx[2], mx[3]))); if (mr == -INFINITY) mr = 0.f;
            }
            asm volatile("" ::: "memory");
            pipe_run_k2(ghi - glo + 1, ln_, addr_win,
                [&](int s, const bf16x8 (&kf)[2][2], const bf16x8 (&vf)[4]) {
                    const int key0 = (glo + s) * 32;
#pragma unroll
                    for (int ct = 0; ct < 4; ++ct) {
                        const int tlo = t0 + 4 * ct, thi = tlo + 3, tl = tl0 + 4 * ct;
                        if (key0 > thi || key0 + 31 + 512 <= tlo) continue;
                        if (key0 + 512 > thi && key0 + 31 <= tlo) attn_compute_fixed<0>(kf, vf, qf[ct], st[ct], mr, ln_, true, NoMask());
                        else attn_compute_fixed<2>(kf, vf, qf[ct], st[ct], mr, ln_, true, [&](int kk) { const int kp = key0 + kk; return kp <= tl && kp + 512 > tl; });
                        __builtin_amdgcn_sched_barrier(0);
                    }
                });
            NSA_UNPARK();
#pragma unroll
            for (int ct = 0; ct < 4; ++ct) { const float ls = sm_lsum(st[ct]); const float gwn = GL[(4 * ct + tq) * 16 + gh * 3 + 2];
                acc_add_packed(opk, ct, st[ct].o, ls > 0.f ? gwn / ls : 0.f, false); }
        }
        { NSA_RELANE();
#pragma unroll
        for (int ct = 0; ct < 4; ++ct)
#pragma unroll
            for (int dt = 0; dt < 4; ++dt) { v2u w; w.x = opk[ct][dt][0]; w.y = opk[ct][dt][1];
                if (VAR == 0 || w.x == 0x7fc17fc1u) *(v2u*)(CAT + (mrow0 + 4 * ct) * 1024 + hkv * 256 + gh * 64 + dt * 16 + g4 * 4) = w; }
        }
        LDS_WAIT();
    }
#undef NSA_RELANE
#undef NSA_PARK
#undef NSA_UNPARK
}

DEV void nsa_phase(Frame& F, int l) { nsa_phase_t<0>(F, l); }

DEV void cross_phase(Frame& F, int l) {
    const int lane = F.lane, l16 = lane & 15, g4 = lane >> 4;
    const bf16* XQ = wsp<bf16>(F, WS_XQ); bf16* XO = wsp<bf16>(F, WS_XO);
    const int gw = F.vcu * NWAVES + F.wave, NGW = F.G * NWAVES;
#pragma unroll 1
    for (int task = gw; task < 8192; task += NGW) {
        const int head = task & 3, m0 = (task >> 2) * 16, b = m0 >> 13;
        bf16x8 qf[2];
#pragma unroll
        for (int ks = 0; ks < 2; ++ks) qf[ks] = *(const bf16x8*)(XQ + (size_t)(m0 + l16) * 256 + head * 64 + ks * 32 + g4 * 8);
        const bf16* kb0 = wsp<bf16>(F, WS_MK) + (size_t)((l * 4 + b) * 4 + head) * 256 * 64;
        const bf16* vb0 = wsp<bf16>(F, WS_MVT) + (size_t)((l * 4 + b) * 4 + head) * 8 * 64 * 32;
        SmState st; sm_reset(st);
        pipe_run<PIPE_D, true>(8, lane, [&](int s, const bf16*& kb, const bf16*& vb) { kb = kb0 + (size_t)s * 32 * 64; vb = vb0 + (size_t)s * 64 * 32; },
            [&](int, const bf16x8 (&kf)[2][2], const bf16x8 (&vf)[4]) { attn_compute<0>(kf, vf, qf, st, lane, true, NoMask()); });
        const float inv = 1.0f / sm_lsum(st);
#pragma unroll
        for (int dt = 0; dt < 4; ++dt) { const f32x4 o = st.o[dt] * inv; v2u w; w.x = pk2(o[0], o[1]); w.y = pk2(o[2], o[3]);
            *(v2u*)(XO + (size_t)(m0 + l16) * 256 + head * 64 + dt * 16 + g4 * 4) = w; }
    }
}

DEV void router_phase(Frame& F, int l, int probe = 0) {
    const int lane = F.lane, l16 = lane & 15, g4 = lane >> 4;
    float* LG = (float*)F.ldsg + F.wave * 768;
    const bf16* HB = wsp<bf16>(F, WS_HB); const float* SSQ = wsp<float>(F, WS_SSQ);
    const bf16* WR = wsp<bf16>(F, WS_WR) + (size_t)l * 96 * 1024;
    int* TOKE = wsp<int>(F, probe ? WS_PROBE : WS_TOKE); float* TOKG = wsp<float>(F, probe ? WS_PROBE + MiB : WS_TOKG); int* TOKP = wsp<int>(F, probe ? WS_PROBE + 2 * MiB : WS_TOKP);
    unsigned* CNT = (unsigned*)F.ctl + CW_CNT + l * 32 + (probe ? 64 : 0);
    const float* bg = inp(14) + l * 4; const float* be = inp(16) + l * 32;
    unsigned* HIST = (unsigned*)((float*)F.ldsg + 8 * 768);
#pragma unroll 1
    for (int tb = F.vcu * NWAVES; tb < NTOK / 16; tb += F.G * NWAVES) {
        const int task = tb + F.wave; const bool live = task < NTOK / 16;
        const int m0 = (live ? task : tb) * 16;
        if (F.tid < 64) HIST[F.tid] = 0u;
        f32x4 acc[3];
        {
            const bf16* ap = HB + (size_t)(m0 + l16) * 1024 + g4 * 8; const bf16* bp = WR + (size_t)l16 * 1024 + g4 * 8;
#pragma unroll
            for (int n = 0; n < 3; ++n) acc[n] = (f32x4){0.f, 0.f, 0.f, 0.f};
#pragma unroll 4
            for (int k = 0; k < 1024; k += 32) {
                const bf16x8 a = *(const bf16x8*)(ap + k);
#pragma unroll
                for (int n = 0; n < 3; ++n) { const bf16x8 bh = *(const bf16x8*)(bp + (size_t)n * 16 * 1024 + k), bl = *(const bf16x8*)(bp + (size_t)(48 + n * 16) * 1024 + k);
                    acc[n] = mfma16(a, bh, acc[n]); acc[n] = mfma16(a, bl, acc[n]); }
            }
        }
#pragma unroll
        for (int nt = 0; nt < 3; ++nt)
#pragma unroll
            for (int r = 0; r < 4; ++r) LG[(g4 * 4 + r) * 48 + nt * 16 + l16] = acc[nt][r];
        LDS_WAIT();
        int id1 = 0, id2 = 0;
        if (lane < 16) {
            const int m = m0 + lane; const float rstd = row_rstd_full(SSQ, m); const float* lg = LG + lane * 48;
            float g[4];
#pragma unroll
            for (int j = 0; j < 4; ++j) g[j] = lg[j] * rstd + bg[j];
            float gmax = g[0]; int grp = 0;
#pragma unroll
            for (int j = 1; j < 4; ++j) if (g[j] > gmax) { gmax = g[j]; grp = j; }
            float den = 0.f;
#pragma unroll
            for (int j = 0; j < 4; ++j) den += expf(g[j] - gmax);
            const float psel = 1.0f / den;
            float e1 = -INFINITY, e2 = -INFINITY; int i1 = 0, i2 = 0;
            for (int j = 0; j < 8; ++j) { const float v = lg[4 + grp * 8 + j] * rstd + be[grp * 8 + j];
                if (v > e1) { e2 = e1; i2 = i1; e1 = v; i1 = j; } else if (v > e2) { e2 = v; i2 = j; } }
            const float x = expf(e2 - e1), w1 = 1.0f / (1.0f + x), w2 = x * w1;
            id1 = grp * 8 + i1; id2 = grp * 8 + i2;
            if (live) { TOKE[m * 2] = id1; TOKE[m * 2 + 1] = id2; TOKG[m * 2] = psel * w1; TOKG[m * 2 + 1] = psel * w2; }
        }
        __syncthreads();
        unsigned lp1 = 0u, lp2 = 0u;
        if (lane < 16 && live) { lp1 = __hip_atomic_fetch_add(HIST + id1, 1u, __ATOMIC_RELAXED, __HIP_MEMORY_SCOPE_WORKGROUP); lp2 = __hip_atomic_fetch_add(HIST + id2, 1u, __ATOMIC_RELAXED, __HIP_MEMORY_SCOPE_WORKGROUP); }
        __syncthreads();
        if (F.tid < 32) { const unsigned c = HIST[F.tid]; HIST[32 + F.tid] = c ? __hip_atomic_fetch_add(CNT + F.tid, c, RLX_AGENT) : 0u; }
        __syncthreads();
        if (lane < 16 && live) { const int m = m0 + lane; TOKP[m * 2] = (int)(HIST[32 + id1] + lp1); TOKP[m * 2 + 1] = (int)(HIST[32 + id2] + lp2); }
        __syncthreads();
    }
}
DEV int moe_tables(Frame& F, int l) {
    int* tab = (int*)(F.ldsg + TAB_OFF);
    if (F.tid == 0) {
        const unsigned* CNT = (const unsigned*)F.ctl + CW_CNT + l * 32; int off = 0;
#pragma unroll 1
        for (int e = 0; e < 32; ++e) { tab[e] = off; const int c = (int)__hip_atomic_load(CNT + e, RLX_AGENT); const int nt = (c + 255) >> 8;
            for (int i = 0; i < nt; ++i) tab[40 + (off >> 8) + i] = e;
            off += nt << 8; }
        tab[32] = off;
    }
    __syncthreads();
    return tab[32];
}
DEV void gather_phase(Frame& F, int l) {
    (void)moe_tables(F, l);
    const int* tab = (const int*)(F.ldsg + TAB_OFF);
    const int lane = F.lane; const int gw = F.vcu * NWAVES + F.wave, NGW = F.G * NWAVES;
    const bf16* HB = wsp<bf16>(F, WS_HB); const float* SSQ = wsp<float>(F, WS_SSQ); bf16* XS = wsp<bf16>(F, WS_XS);
    const int* TOKE = wsp<int>(F, WS_TOKE); const float* TOKG = wsp<float>(F, WS_TOKG); const int* TOKP = wsp<int>(F, WS_TOKP); int* TOKS = wsp<int>(F, WS_TOKS);
    float* SRSTD = wsp<float>(F, WS_SRSTD); float* SGATE = wsp<float>(F, WS_SGATE);
    const unsigned* CNT = (const unsigned*)F.ctl + CW_CNT + l * 32;
#pragma unroll 1
    for (int m0 = gw; m0 < NTOK; m0 += 4 * NGW) {
        int s0[4], s1[4]; float g0[4], g1[4], rs[4]; v4u a[4], c[4];
#pragma unroll
        for (int k = 0; k < 4; ++k) { const int m = m0 + k * NGW; const bool ok = m < NTOK; const int mm = ok ? m : m0;
            const int e0 = TOKE[mm * 2], e1 = TOKE[mm * 2 + 1], p0 = TOKP[mm * 2], p1 = TOKP[mm * 2 + 1];
            g0[k] = TOKG[mm * 2]; g1[k] = TOKG[mm * 2 + 1];
            a[k] = *(const v4u*)(HB + (size_t)mm * 1024 + lane * 8); c[k] = *(const v4u*)(HB + (size_t)mm * 1024 + 512 + lane * 8);
            rs[k] = row_rstd_full(SSQ, mm);
            s0[k] = tab[e0] + p0; s1[k] = tab[e1] + p1; }
#pragma unroll
        for (int k = 0; k < 4; ++k) { const int m = m0 + k * NGW;
            if (m < NTOK) {
                *(v4u*)(XS + (size_t)s0[k] * 1024 + lane * 8) = a[k]; *(v4u*)(XS + (size_t)s0[k] * 1024 + 512 + lane * 8) = c[k];
                *(v4u*)(XS + (size_t)s1[k] * 1024 + lane * 8) = a[k]; *(v4u*)(XS + (size_t)s1[k] * 1024 + 512 + lane * 8) = c[k];
                if (lane == 0) { SRSTD[s0[k]] = rs[k]; SRSTD[s1[k]] = rs[k]; SGATE[s0[k]] = g0[k]; SGATE[s1[k]] = g1[k]; TOKS[m * 2] = s0[k]; TOKS[m * 2 + 1] = s1[k]; } } }
    }
#pragma unroll 1
    for (int e = 0; e < 32; ++e) {
        const int c = (int)__hip_atomic_load(CNT + e, RLX_AGENT), base = tab[e], end = (e == 31 ? tab[32] : tab[e + 1]);
        for (int r = base + c + gw; r < end; r += NGW) {
            *(v4u*)(XS + (size_t)r * 1024 + lane * 8) = (v4u){0u, 0u, 0u, 0u}; *(v4u*)(XS + (size_t)r * 1024 + 512 + lane * 8) = (v4u){0u, 0u, 0u, 0u};
            if (lane == 0) { SRSTD[r] = 0.f; SGATE[r] = 0.f; }
        }
    }
}
DEV void combine_phase(Frame& F, int l, int probe = 0) {
    const int lane = F.lane; const int gw = F.vcu * NWAVES + F.wave, NGW = F.G * NWAVES;
    float* Ho = probe ? wsp<float>(F, WS_PROBE) : (float*)(GAS float*)F.out; const bf16* HBi = wsp<bf16>(F, WS_HB); bf16* HB = wsp<bf16>(F, probe ? WS_PROBE + 128 * MiB : WS_HB); float* SSQ = wsp<float>(F, probe ? WS_PROBE + 192 * MiB : WS_SSQ); const bf16* YS = wsp<bf16>(F, WS_YS); const int* TOKS = wsp<int>(F, WS_TOKS);
    const float* gf = inp(23);
#pragma unroll 1
    for (int m0 = gw; m0 < NTOK; m0 += 2 * NGW) {
        f32x4 v[2][4]; float ssum[2];
        int sl[2][2];
#pragma unroll
        for (int k = 0; k < 2; ++k) { const int m = (m0 + k * NGW < NTOK) ? m0 + k * NGW : m0; sl[k][0] = TOKS[m * 2]; sl[k][1] = TOKS[m * 2 + 1]; }
        v2u h[2][4]; v2u ya[2][4], yb[2][4];
#pragma unroll
        for (int k = 0; k < 2; ++k) { const int m = (m0 + k * NGW < NTOK) ? m0 + k * NGW : m0;
#pragma unroll
            for (int j = 0; j < 4; ++j) { const int c = lane * 4 + 256 * j;
                h[k][j] = *(const v2u*)(HBi + (size_t)m * 1024 + c);
                ya[k][j] = *(const v2u*)(YS + (size_t)sl[k][0] * 1024 + c); yb[k][j] = *(const v2u*)(YS + (size_t)sl[k][1] * 1024 + c); } }
#pragma unroll
        for (int k = 0; k < 2; ++k) { float ss = 0.f;
#pragma unroll
            for (int j = 0; j < 4; ++j) { const v2u a = ya[k][j], bq = yb[k][j]; const f32x4 hh = (f32x4){bflo(h[k][j].x), bfhi(h[k][j].x), bflo(h[k][j].y), bfhi(h[k][j].y)};
                f32x4 r; r[0] = hh[0] + (bflo(a.x) + bflo(bq.x)); r[1] = hh[1] + (bfhi(a.x) + bfhi(bq.x)); r[2] = hh[2] + (bflo(a.y) + bflo(bq.y)); r[3] = hh[3] + (bfhi(a.y) + bfhi(bq.y));
                v[k][j] = r; ss += (r[0] * r[0] + r[1] * r[1]) + (r[2] * r[2] + r[3] * r[3]); }
            ssum[k] = wave_sum(ss); }
#pragma unroll
        for (int k = 0; k < 2; ++k) { const int m = m0 + k * NGW;
            if (m < NTOK) {
                if (l == DEPTH - 1) {
                    const float rstd = 1.0f / sqrtf(ssum[k] * (1.0f / 1024.0f) + RMS_EPS);
#pragma unroll
                    for (int j = 0; j < 4; ++j) { const int c = lane * 4 + 256 * j; const f32x4 g = *(const f32x4*)(gf + c); *(f32x4*)(Ho + (size_t)m * 1024 + c) = v[k][j] * rstd * g; }
                } else {
#pragma unroll
                    for (int j = 0; j < 4; ++j) { const int c = lane * 4 + 256 * j;
                        v2u w; w.x = pk2(v[k][j][0], v[k][j][1]); w.y = pk2(v[k][j][2], v[k][j][3]); *(v2u*)(HB + (size_t)m * 1024 + c) = w; }
                    if (lane < 16) SSQ[(size_t)m * 16 + lane] = lane == 0 ? ssum[k] : 0.f;
                } } }
    }
}
#ifndef MK_ONE_LAUNCH
#define MK_ONE_LAUNCH 1
#endif
constexpr int NPH_LAYER = 13, NPHASES = 1 + DEPTH * NPH_LAYER;
struct Args { const float* in[24]; float* out; unsigned char* ws; int ph_lo, ph_hi; };
static_assert(sizeof(Args) == 24 * 8 + 8 + 8 + 8, "Args has no padding");

__global__ void __launch_bounds__(NWAVES * 64, 2) hymba_fwd(Args args) {
    extern __shared__ __attribute__((aligned(16))) unsigned char lds[];
    Frame F;
    F.lds = (LAS unsigned char*)lds; F.ldsg = lds;
    F.MISC = (volatile LAS unsigned*)(F.lds + MISC_OFF);
    F.tid = threadIdx.x; F.lane = F.tid & 63; F.wave = __builtin_amdgcn_readfirstlane(F.tid >> 6);
    F.G = gridDim.x; { const int bx = blockIdx.x; F.vcu = (F.G % 8 == 0) ? (bx % 8) * (F.G / 8) + bx / 8 : bx; }
    F.ws = args.ws; F.ctl = (gu32*)(args.ws + WS_CTL); F.out = args.out;
    if (F.tid < 64) ((LAS unsigned*)(F.lds + MISC_OFF))[F.tid] = 0u;
    __syncthreads();
    int wave0 = F.wave;
    const int lo = args.ph_lo, hi = args.ph_hi;
    XcdBarrier bar; bar.bar = (unsigned*)(F.ctl + CW_BAR); bar.x = 0; bar.st = nullptr;
    if (hi - lo > 1) bar = xcd_barrier_post((unsigned*)(F.ctl + CW_BAR), F.MISC + 8);
#ifndef PHMASK
#define PHMASK 0xFFFF
#endif
#define IN(k) (lo <= (k) && (k) < hi)
#define EN(j) ((PHMASK >> (j)) & 1)
#define RELAUNDER() do { asm volatile("" : "+s"(wave0)); unsigned z_ = 0u; asm volatile("" : "+v"(z_)); int t_ = wave0 * 64 + (int)__builtin_amdgcn_mbcnt_hi(~0u, __builtin_amdgcn_mbcnt_lo(~0u, z_)); F.tid = t_; F.lane = t_ & 63; F.wave = wave0; \
    size_t zo_ = 0; asm volatile("" : "+s"(zo_), "+s"(F.vcu), "+s"(F.G)); F.ws = args.ws + zo_; F.out = args.out + zo_; F.ctl = (gu32*)(F.ws + WS_CTL); } while (0)
#ifndef NSA_VAR
#define NSA_VAR 0
#endif
#ifndef BAR2X
#define BAR2X 0
#endif
#ifndef DUPMASK
#define DUPMASK 0
#endif
#define DUP(j) ((DUPMASK >> (j)) & 1)
#ifndef STAG_J0
#define STAG_J0 0
#endif
#ifndef STAG_MOE
#define STAG_MOE 0
#endif
#define STAGGER(ticks) do { if ((ticks) > 0 && (F.vcu & 1)) { const unsigned long long t0_ = __builtin_amdgcn_s_memrealtime(); while (__builtin_amdgcn_s_memrealtime() - t0_ < (unsigned long long)(ticks)) __builtin_amdgcn_s_sleep(32); } } while (0)
#define SEAM(k) do { if (IN(k) && IN((k) + 1)) { XcdBarrier b_ = bar; size_t zb_ = 0; asm volatile("" : "+s"(b_.x), "+s"(zb_)); b_.bar = (unsigned*)(args.ws + WS_CTL + zb_) + CW_BAR; xcd_barrier(b_); if (BAR2X) xcd_barrier(b_); } } while (0)

    if (IN(0) && EN(13)) { RELAUNDER(); p0_prologue(F); if (DUP(13)) { __syncthreads(); p0_prologue(F); } } SEAM(0);

#pragma unroll 1
    for (int l = 0; l < DEPTH; ++l) {
        const int pb = 1 + l * NPH_LAYER;
        bf16* HB = wsp<bf16>(F, WS_HB); float* SSQ = wsp<float>(F, WS_SSQ);
        if (IN(pb + 0) && EN(0)) for (int rep_ = 0; rep_ < (DUP(0) ? 2 : 1); ++rep_) { RELAUNDER(); if (rep_) __syncthreads();
            pg8::Gemm g{HB, wsp<bf16>(F, WS_WIN) + (size_t)l * NIN * 1024, NTOK, 3072, D};
            pg8::StaticOrder S; S.init(NTOK, 3072, F.G, (int)blockIdx.x);
            EpiIn E{F.ws};
            STAGGER(STAG_J0);
            pg8::gemm_phase<EpiIn, pg8::StaticOrder, true, true>(F.lds, g, S, E, F.wave);
        }
        SEAM(pb + 0);
        if (IN(pb + 1) && EN(1)) { RELAUNDER();
            compress_phase(F, l);
            hgrn_local_phase(F, l);
            conv_phase(F, l);
            kmax_phase(F, l);
            if (l == 0) memkv_phase(F);
            if (DUP(1)) { __syncthreads(); compress_phase(F, l); hgrn_local_phase(F, l); conv_phase(F, l); }
        }
        SEAM(pb + 1);
        if (IN(pb + 2) && EN(2)) { RELAUNDER(); hgrn_scan_phase(F); if (DUP(14)) hgrn_scan_phase(F, 1); nsa_phase(F, l); if (DUP(2)) { __syncthreads(); nsa_phase_t<NSA_VAR>(F, l); } }
        SEAM(pb + 2);
        if (IN(pb + 3) && EN(3)) { RELAUNDER(); hgrn_out_phase(F, l); if (DUP(3)) { __syncthreads(); hgrn_out_phase(F, l); } }
        SEAM(pb + 3);
        if (IN(pb + 4) && EN(4)) for (int rep_ = 0; rep_ < ((DUP(4) && l == 0) ? 2 : 1); ++rep_) { RELAUNDER(); if (rep_) __syncthreads();
            pg8::Gemm g{wsp<bf16>(F, WS_CAT), wsp<bf16>(F, WS_WOUT) + (size_t)l * 1024 * 1024, NTOK, D, D};
            pg8::StaticOrder S; S.init(NTOK, D, F.G, (int)blockIdx.x);
            EpiRes E{l == 0 ? inp(0) : (const float*)nullptr, HB, SSQ};
            pg8::gemm_phase<EpiRes, pg8::StaticOrder, true, true>(F.lds, g, S, E, F.wave);
        }
        SEAM(pb + 4);
        if (IN(pb + 5) && EN(5)) for (int rep_ = 0; rep_ < (DUP(5) ? 2 : 1); ++rep_) { RELAUNDER(); if (rep_) __syncthreads();
            pg8::Gemm g{HB, wsp<bf16>(F, WS_WQ) + (size_t)l * 256 * 1024, NTOK, 256, D};
            pg8::StaticOrder S; S.init(NTOK, 256, F.G, (int)blockIdx.x);
            EpiXQ E{SSQ, wsp<bf16>(F, WS_XQ)};
            pg8::gemm_phase<EpiXQ, pg8::StaticOrder, true, true>(F.lds, g, S, E, F.wave);
        }
        SEAM(pb + 5);
        if (IN(pb + 6) && EN(6)) { RELAUNDER(); cross_phase(F, l); if (DUP(6)) { __syncthreads(); cross_phase(F, l); } }
        SEAM(pb + 6);
        if (IN(pb + 7) && EN(7)) { RELAUNDER();
            pg8::Gemm g{wsp<bf16>(F, WS_XO), wsp<bf16>(F, WS_WO) + (size_t)l * 1024 * 256, NTOK, D, 256};
            pg8::StaticOrder S; S.init(NTOK, D, F.G, (int)blockIdx.x);
            EpiRes E{(const float*)nullptr, HB, SSQ};
            pg8::gemm_phase<EpiRes, pg8::StaticOrder, true, true>(F.lds, g, S, E, F.wave);
        }
        SEAM(pb + 7);
        if (IN(pb + 8) && EN(8)) { RELAUNDER(); router_phase(F, l); if (DUP(8)) router_phase(F, l, 1); }
        SEAM(pb + 8);
        if (IN(pb + 9) && EN(9)) { RELAUNDER(); gather_phase(F, l); if (DUP(9)) { __syncthreads(); gather_phase(F, l); } }
        SEAM(pb + 9);
        if (IN(pb + 10) && EN(10)) for (int rep_ = 0; rep_ < (DUP(10) ? 2 : 1); ++rep_) { RELAUNDER(); if (rep_) __syncthreads();
            const int ns = moe_tables(F, l);
            pg8::Gemm g{wsp<bf16>(F, WS_XS), wsp<bf16>(F, WS_WGU) + (size_t)l * 32 * 1024 * 1024, ns, 32 * 1024, D};
            MoeOrder S{(ns >> 8) * 4, F.G, (int)blockIdx.x, (const LAS int*)(F.lds + TAB_OFF) + 40};
            EpiGU E{wsp<float>(F, WS_SRSTD), wsp<bf16>(F, WS_ACT)};
            STAGGER(STAG_MOE);
            pg8::gemm_phase<EpiGU, MoeOrder, true, true>(F.lds, g, S, E, F.wave);
        }
        SEAM(pb + 10);
        if (IN(pb + 11) && EN(11)) for (int rep_ = 0; rep_ < (DUP(11) ? 2 : 1); ++rep_) { RELAUNDER(); if (rep_) __syncthreads();
            const int ns = moe_tables(F, l);
            pg8::Gemm g{wsp<bf16>(F, WS_ACT), wsp<bf16>(F, WS_WDN) + (size_t)l * 32 * 1024 * 512, ns, 32 * 1024, 512};
            MoeOrder S{(ns >> 8) * 4, F.G, (int)blockIdx.x, (const LAS int*)(F.lds + TAB_OFF) + 40};
            EpiDN E{wsp<float>(F, WS_SGATE), wsp<bf16>(F, WS_YS)};
            STAGGER(STAG_MOE / 2);
            pg8::gemm_phase<EpiDN, MoeOrder, true, true>(F.lds, g, S, E, F.wave);
        }
        SEAM(pb + 11);
        if (IN(pb + 12) && EN(12)) { RELAUNDER(); combine_phase(F, l); if (DUP(12)) combine_phase(F, l, 1); }
        SEAM(pb + 12);
    }
#undef IN
#undef SEAM
}

extern "C" void kernel_launch(void* const* d_in, const int* in_sizes, int n_in, void* d_out, int out_size, void* d_ws, size_t ws_size, hipStream_t stream) {
    static int grid = 0;
    if (grid == 0) {
        if (n_in != 24 || in_sizes[0] != NTOK * D || out_size != NTOK * D || ws_size < WS_END) {
            fprintf(stderr, "kernel_launch: unexpected shapes: n_in %d in0 %d out %d ws %zu (need %zu)\n", n_in, n_in > 0 ? in_sizes[0] : -1, out_size, ws_size, (size_t)WS_END); grid = -1; return; }
        int dev = 0, cus = 0, per_cu = 0;
        if (hipGetDevice(&dev) != hipSuccess || hipDeviceGetAttribute(&cus, hipDeviceAttributeMultiprocessorCount, dev) != hipSuccess) { grid = -1; return; }
        if (hipFuncSetAttribute((const void*)hymba_fwd, hipFuncAttributeMaxDynamicSharedMemorySize, LDS_BYTES) != hipSuccess) { fprintf(stderr, "kernel_launch: hipFuncSetAttribute failed\n"); grid = -1; return; }
        if (hipOccupancyMaxActiveBlocksPerMultiprocessor(&per_cu, (const void*)hymba_fwd, NWAVES * 64, LDS_BYTES) != hipSuccess || per_cu < 1)
            fprintf(stderr, "kernel_launch: note: occupancy query reports %d blocks per CU\n", per_cu);
        (void)hipGetLastError();
        grid = cus;
    }
    if (grid < 0) return;
    if (hipMemsetAsync((char*)d_ws + WS_CTL, 0, CTL_ZERO_BYTES, stream) != hipSuccess) { fprintf(stderr, "kernel_launch: memset failed\n"); return; }
    Args a{};
    for (int i = 0; i < 24; ++i) a.in[i] = (const float*)d_in[i];
    a.out = (float*)d_out; a.ws = (unsigned char*)d_ws;
#if MK_ONE_LAUNCH
    a.ph_lo = 0; a.ph_hi = NPHASES;
    hipLaunchKernelGGL(hymba_fwd, dim3(grid), dim3(NWAVES * 64), LDS_BYTES, stream, a);
#else
    for (int p = 0; p < NPHASES; ++p) { a.ph_lo = p; a.ph_hi = p + 1; hipLaunchKernelGGL(hymba_fwd, dim3(grid), dim3(NWAVES * 64), LDS_BYTES, stream, a); }
#endif
    const hipError_t le = hipPeekAtLastError();
    if (le != hipSuccess) fprintf(stderr, "kernel_launch: launch failed: %s\n", hipGetErrorName(le));
}
```

```cpp
#define MK_ONE_LAUNCH 1
#include <hip/hip_runtime.h>
#include <cstdio>
#include <cstdint>
#include <cmath>
namespace pg8 {
#define PG8_LAS __attribute__((address_space(3)))
typedef unsigned short bf16_t;
typedef short bf16x8 __attribute__((ext_vector_type(8)));
typedef float f32x4 __attribute__((ext_vector_type(4)));
typedef unsigned u32x4 __attribute__((ext_vector_type(4)));
constexpr int BM = 256, BK = 64, HALF = 128, HTB = HALF * BK * 2  , STAGE_BYTES = 8 * HTB, NXCD = 8, WGM = 8;

__host__ __device__ __forceinline__ int lds_byte(int r, int c) { const int st = (r >> 4) * 2 + (c >> 5), rr = r & 15, cc = c & 31, ob = rr * 64 + cc * 2; return st * 1024 + (ob ^ (((ob >> 9) & 1) << 5)); }
__host__ __device__ __forceinline__ void stage_rc(int b, int& R, int& C) { const int st = b / 1024, sb = b % 1024, swz = sb ^ (((sb >> 9) & 1) << 5); R = (st >> 1) * 16 + swz / 64; C = (st & 1) * 32 + (swz % 64) / 2; }
__host__ __device__ __forceinline__ int perm32(int rho) { const int n = rho >> 4, i = rho & 15; return 8 * (i >> 2) + 4 * n + (i & 3); }

struct Unit { int pm, pn; };
struct Gemm { const bf16_t* A; const bf16_t* Bt; int M, N, K; };

struct StaticOrder {
    int nM, nN, nwg, G, c;
    __host__ __device__ void init(int M, int N, int G_, int c_) { nM = M / BM; nN = N / BM; nwg = nM * nN; G = G_; c = c_; }
    __host__ __device__ bool next(int i, Unit& u) const {
        const long L = (long)i * G + c; if (L >= nwg) return false;
        int wgid = (int)L; { const int q = nwg / NXCD, r = nwg % NXCD, xcd = wgid % NXCD, off = wgid / NXCD; wgid = (xcd < r ? xcd * (q + 1) : r * (q + 1) + (xcd - r) * q) + off; }
        const int nig = WGM * nN, gid = wgid / nig, fm = gid * WGM, gsz = (nM - fm) < WGM ? (nM - fm) : WGM;
        u.pm = fm + ((wgid % nig) % gsz); u.pn = (wgid % nig) / gsz; return true;
    }
    __device__ __forceinline__ void a_ready(const Unit&) const {}
    __device__ __forceinline__ void done(const Unit&) const {}
};

__device__ __forceinline__ unsigned cvt_pk_bf16(float lo, float hi) { unsigned r; asm volatile("v_cvt_pk_bf16_f32 %0, %1, %2" : "=v"(r) : "v"(lo), "v"(hi)); return r; }
typedef float f32x2 __attribute__((ext_vector_type(2)));
template <class Epi, class Sched, bool ALIGN_EPI = false, bool SP2 = false>
__device__ __forceinline__ void gemm_phase(PG8_LAS unsigned char* lds, const Gemm g, const Sched& S, const Epi& E, int wave_id) {
    unsigned z_ = 0u; asm volatile("" : "+v"(z_)); int tid_ = wave_id * 64 + (int)__builtin_amdgcn_mbcnt_hi(~0u, __builtin_amdgcn_mbcnt_lo(~0u, z_));
    const int tid = tid_, wid = __builtin_amdgcn_readfirstlane(tid >> 6), lane = tid & 63, wr = wid >> 2, wc = wid & 3, fr = lane & 15, fq = lane >> 4;
    const int K = g.K, nt = K / BK;
    unsigned voffA[2], voffB[2];
#pragma unroll
    for (int i = 0; i < 2; ++i) { int R, C; stage_rc(tid * 16 + i * 8192, R, C); const int Rb = Epi::PERM ? ((R & ~31) + perm32(R & 31)) : R;
        voffA[i] = (unsigned)(R * K + C) * 2u; voffB[i] = (unsigned)(Rb * K + C) * 2u; }
    const size_t kstep = (size_t)(BK * 2);
    const size_t hstep = (size_t)HALF * K * 2;
    const size_t tstep = 2 * hstep;
    const unsigned ldsw = (unsigned)wid * 1024u;
    const int aoff = lds_byte(wr * 64 + fr, fq * 8), boff = lds_byte(wc * 32 + fr, fq * 8);
#define PG8_SA(b, h) (((b) * 2 + (h)) * HTB)
#define PG8_SB(b, h) ((4 + (b) * 2 + (h)) * HTB)
#define PG8_STAGE(bufoff, gbase, voff) do { _Pragma("unroll") for (int _i = 0; _i < 2; ++_i) \
        __builtin_amdgcn_global_load_lds((const unsigned*)((const char*)(gbase) + (voff)[_i]), (PG8_LAS unsigned*)(lds + (bufoff) + ldsw + _i * 8192), 16, 0, 0); } while (0)
#define PG8_LDA(dst, b, h) do { _Pragma("unroll") for (int m = 0; m < 4; ++m) _Pragma("unroll") for (int k = 0; k < 2; ++k) dst[m][k] = *(const PG8_LAS bf16x8*)(lds + PG8_SA(b, h) + aoff + m * 2048 + k * 1024); } while (0)
#define PG8_LDB(dst, b, h) do { _Pragma("unroll") for (int n = 0; n < 2; ++n) _Pragma("unroll") for (int k = 0; k < 2; ++k) dst[n][k] = *(const PG8_LAS bf16x8*)(lds + PG8_SB(b, h) + boff + n * 2048 + k * 1024); } while (0)
#define PG8_MMA(ai, bj, At, Bt) do { __builtin_amdgcn_s_setprio(1); _Pragma("unroll") for (int m = 0; m < 4; ++m) _Pragma("unroll") for (int n = 0; n < 2; ++n) _Pragma("unroll") for (int k = 0; k < 2; ++k) \
        acc[ai][bj][m][n] = __builtin_amdgcn_mfma_f32_16x16x32_bf16(Bt[n][k], At[m][k], acc[ai][bj][m][n], 0, 0, 0); __builtin_amdgcn_s_setprio(0); } while (0)
#define PG8_WAIT_V(n) asm volatile("s_waitcnt vmcnt(" #n ")" ::: "memory")
#define PG8_WAIT_L(n) asm volatile("s_waitcnt lgkmcnt(" #n ")" ::: "memory")
#define PG8_BAR __builtin_amdgcn_s_barrier()
#define PG8_SCHED __builtin_amdgcn_sched_barrier(0)
    Unit cur, nxt; int ui = 0;
    if (!S.next(0, cur)) return;
    f32x4 acc[2][2][4][2];
#pragma unroll
    for (int a = 0; a < 2; ++a)
#pragma unroll
        for (int b = 0; b < 2; ++b)
#pragma unroll
            for (int m = 0; m < 4; ++m)
#pragma unroll
                for (int n = 0; n < 2; ++n) acc[a][b][m][n] = (f32x4){0.f, 0.f, 0.f, 0.f};
    bf16x8 At[4][2], B0[2][2], B1[2][2];
    const char* cA = (const char*)g.A + (size_t)cur.pm * tstep; const char* cB = (const char*)g.Bt + (size_t)cur.pn * tstep;
    S.a_ready(cur);
    if constexpr (SP2) {
        PG8_STAGE(PG8_SB(0, 0), cB, voffB); PG8_STAGE(PG8_SB(0, 1), cB + hstep, voffB); PG8_STAGE(PG8_SA(0, 0), cA, voffA); PG8_STAGE(PG8_SA(0, 1), cA + hstep, voffA);
        if (wr == 1) PG8_BAR;
        PG8_WAIT_V(2); PG8_BAR;
        PG8_STAGE(PG8_SB(1, 0), cB + kstep, voffB); PG8_STAGE(PG8_SA(1, 0), cA + kstep, voffA); PG8_STAGE(PG8_SB(1, 1), cB + hstep + kstep, voffB);
        PG8_WAIT_V(6); PG8_BAR;
    } else {
        PG8_STAGE(PG8_SB(0, 0), cB, voffB); PG8_STAGE(PG8_SA(0, 0), cA, voffA); PG8_STAGE(PG8_SB(0, 1), cB + hstep, voffB); PG8_STAGE(PG8_SA(0, 1), cA + hstep, voffA);
        if (wr == 1) PG8_BAR;
        PG8_WAIT_V(4); PG8_BAR;
        PG8_STAGE(PG8_SB(1, 0), cB + kstep, voffB); PG8_STAGE(PG8_SA(1, 0), cA + kstep, voffA); PG8_STAGE(PG8_SB(1, 1), cB + hstep + kstep, voffB);
        PG8_WAIT_V(6); PG8_BAR;
    }
    for (;;) {
        const bool has_next = S.next(ui + 1, nxt);
        const char* nA = has_next ? (const char*)g.A + (size_t)nxt.pm * tstep : cA; const char* nB = has_next ? (const char*)g.Bt + (size_t)nxt.pn * tstep : cB;
        for (int t = 0; t < nt; t += 2) {
            const bool last = (t == nt - 2);
            const char* a1 = cA + (size_t)(t + 1) * kstep;
            const char* a2 = last ? nA : cA + (size_t)(t + 2) * kstep; const char* b2 = last ? nB : cB + (size_t)(t + 2) * kstep;
            const char* a3 = a2 + kstep; const char* b3 = b2 + kstep;
            if (last && has_next) S.a_ready(nxt);
            if constexpr (SP2) {
            PG8_LDB(B0, 0, 0); PG8_LDB(B1, 0, 1); PG8_SCHED; PG8_LDA(At, 0, 0); PG8_STAGE(PG8_SA(1, 1), a1 + hstep, voffA);
            PG8_WAIT_V(8); PG8_WAIT_L(0); PG8_BAR; PG8_MMA(0, 0, At, B0); PG8_MMA(0, 1, At, B1); PG8_BAR; PG8_SCHED;
            PG8_LDA(At, 0, 1); PG8_STAGE(PG8_SB(0, 0), b2, voffB); PG8_STAGE(PG8_SB(0, 1), b2 + hstep, voffB); PG8_STAGE(PG8_SA(0, 0), a2, voffA);
            PG8_WAIT_V(8); PG8_WAIT_L(0); PG8_BAR; PG8_MMA(1, 0, At, B0); PG8_MMA(1, 1, At, B1); PG8_BAR; PG8_SCHED;
            PG8_LDB(B0, 1, 0); PG8_LDB(B1, 1, 1); PG8_SCHED; PG8_LDA(At, 1, 0); PG8_STAGE(PG8_SA(0, 1), a2 + hstep, voffA);
            PG8_WAIT_V(8); PG8_WAIT_L(0); PG8_BAR; PG8_MMA(0, 0, At, B0); PG8_MMA(0, 1, At, B1); PG8_BAR; PG8_SCHED;
            PG8_LDA(At, 1, 1); PG8_STAGE(PG8_SB(1, 0), b3, voffB); PG8_STAGE(PG8_SB(1, 1), b3 + hstep, voffB); PG8_STAGE(PG8_SA(1, 0), a3, voffA);
            PG8_WAIT_V(8); PG8_WAIT_L(0); PG8_BAR; PG8_MMA(1, 0, At, B0); PG8_MMA(1, 1, At, B1); PG8_BAR; PG8_SCHED;
            } else {
            PG8_LDB(B0, 0, 0); PG8_SCHED; PG8_LDA(At, 0, 0); PG8_STAGE(PG8_SA(1, 1), a1 + hstep, voffA);
            PG8_WAIT_L(8); PG8_BAR; PG8_WAIT_L(0); PG8_MMA(0, 0, At, B0); PG8_BAR; PG8_SCHED;
            PG8_LDB(B1, 0, 1); PG8_STAGE(PG8_SB(0, 0), b2, voffB);
            PG8_BAR; PG8_WAIT_L(0); PG8_MMA(0, 1, At, B1); PG8_BAR;
            PG8_LDA(At, 0, 1); PG8_STAGE(PG8_SA(0, 0), a2, voffA);
            PG8_BAR; PG8_WAIT_L(0); PG8_MMA(1, 0, At, B0); PG8_BAR; PG8_SCHED;
            PG8_STAGE(PG8_SB(0, 1), b2 + hstep, voffB);
            PG8_WAIT_V(6); PG8_BAR; PG8_MMA(1, 1, At, B1); PG8_BAR;
            PG8_LDB(B0, 1, 0); PG8_SCHED; PG8_LDA(At, 1, 0); PG8_STAGE(PG8_SA(0, 1), a2 + hstep, voffA);
            PG8_WAIT_L(8); PG8_BAR; PG8_WAIT_L(0); PG8_MMA(0, 0, At, B0); PG8_BAR; PG8_SCHED;
            PG8_LDB(B1, 1, 1); PG8_STAGE(PG8_SB(1, 0), b3, voffB);
            PG8_BAR; PG8_WAIT_L(0); PG8_MMA(0, 1, At, B1); PG8_BAR;
            PG8_LDA(At, 1, 1); PG8_STAGE(PG8_SA(1, 0), a3, voffA);
            PG8_BAR; PG8_WAIT_L(0); PG8_MMA(1, 0, At, B0); PG8_BAR; PG8_SCHED;
            PG8_STAGE(PG8_SB(1, 1), b3 + hstep, voffB);
            PG8_WAIT_V(6); PG8_BAR; PG8_MMA(1, 1, At, B1); PG8_BAR;
            }
        }
        if constexpr (ALIGN_EPI) { if (wr == 0) PG8_BAR; }
        if constexpr (!Epi::AFTER_DRAIN) { E(acc, cur, wr, wc, fr, fq); S.done(cur); }
        if (!has_next) break;
#pragma unroll
        for (int a = 0; a < 2; ++a)
#pragma unroll
            for (int b = 0; b < 2; ++b)
#pragma unroll
                for (int m = 0; m < 4; ++m)
#pragma unroll
                    for (int n = 0; n < 2; ++n) acc[a][b][m][n] = (f32x4){0.f, 0.f, 0.f, 0.f};
        cur = nxt; cA = nA; cB = nB; ++ui;
        if constexpr (ALIGN_EPI) { if (wr == 1) PG8_BAR; }
    }
    PG8_WAIT_V(0);
    if constexpr (!ALIGN_EPI) { if (wr == 0) PG8_BAR; }
    PG8_BAR;
    if constexpr (Epi::AFTER_DRAIN) { E.fused(acc, cur, wr, wc, fr, fq, lds, wid, lane); S.done(cur); }
#undef PG8_SA
#undef PG8_SB
#undef PG8_STAGE
#undef PG8_LDA
#undef PG8_LDB
#undef PG8_MMA
#undef PG8_WAIT_V
#undef PG8_WAIT_L
#undef PG8_BAR
#undef PG8_SCHED
}
}
constexpr int NB = 4, T = 8192, D = 1024, NTOK = NB * T, DEPTH = 2;
constexpr int NIN = 3328;
constexpr int IN_W = 3096;
constexpr int NSLOT_MAX = 65536 + 32 * 256;
constexpr float RMS_EPS = 1e-6f;
constexpr float QSCALE = 0.125f * 1.44269504088896f;
constexpr int NWAVES = 8;

constexpr size_t MiB = 1u << 20;
constexpr size_t WS_CTL = 0, CTL_ZERO_BYTES = 1 * MiB;
constexpr size_t WS_ROPE = 1 * MiB;
constexpr size_t WS_SMALL = 3 * MiB;
constexpr size_t WS_WG = 3 * MiB + 65536;
constexpr size_t WS_SSQ = 4 * MiB;
constexpr size_t WS_WIN = 8 * MiB;
constexpr size_t WS_WOUT = 22 * MiB;
constexpr size_t WS_WQ = 26 * MiB;
constexpr size_t WS_WKV = 27 * MiB;
constexpr size_t WS_WO = 29 * MiB;
constexpr size_t WS_WR = 30 * MiB;
constexpr size_t WS_W1C = 31 * MiB;
constexpr size_t WS_W2C = 33 * MiB;
constexpr size_t WS_MEMB = 34 * MiB;
constexpr size_t WS_MK = 36 * MiB;
constexpr size_t WS_MVT = 37 * MiB;
constexpr size_t WS_WGU = 40 * MiB;
constexpr size_t WS_WDN = 168 * MiB;
constexpr size_t WS_HB = 232 * MiB;
constexpr size_t WS_Q = 296 * MiB, WS_QR = 328 * MiB, WS_KCR = 360 * MiB, WS_VCR = 368 * MiB, WS_KS = 376 * MiB, WS_KW = 384 * MiB;
constexpr size_t WS_VST = 392 * MiB, WS_VWT = 400 * MiB, WS_KCC = 408 * MiB, WS_VCT = 409 * MiB, WS_GATE = 410 * MiB;
constexpr size_t WS_CB = 414 * MiB, WS_CC = 430 * MiB, WS_CH = 446 * MiB;
constexpr size_t WS_HQ = 462 * MiB, WS_HF = 494 * MiB, WS_HI = 526 * MiB, WS_HG = 558 * MiB;
constexpr size_t WS_CAT = 590 * MiB, WS_U = 654 * MiB, WS_DEC = 686 * MiB;
constexpr size_t WS_XQ = 688 * MiB, WS_XO = 704 * MiB;
constexpr size_t WS_XS = 296 * MiB, WS_ACT = 440 * MiB, WS_YS = 512 * MiB;
constexpr size_t WS_TOKE = 720 * MiB, WS_TOKG = 721 * MiB, WS_TOKP = 722 * MiB, WS_TOKS = 723 * MiB, WS_SRSTD = 724 * MiB, WS_SGATE = 725 * MiB;
constexpr size_t WS_U2 = 728 * MiB;
constexpr size_t WS_PROBE = 760 * MiB;
constexpr size_t WS_END = 760 * MiB;
static_assert(WS_XS + (size_t)NSLOT_MAX * 1024 * 2 <= WS_ACT && WS_ACT + (size_t)NSLOT_MAX * 512 * 2 <= WS_YS && WS_YS + (size_t)NSLOT_MAX * 1024 * 2 <= WS_XQ, "moe map");
constexpr int CW_CNT = 64;
constexpr int CW_KMAX = 256;
constexpr int CW_BAR = 4096;

constexpr int RING_BYTES = 131072;
constexpr int NSA_LDS_WAVE = 10752;
constexpr int MISC_OFF = RING_BYTES;
constexpr int TAB_OFF = RING_BYTES + 512;
constexpr int LDS_BYTES = 147456;
static_assert(8 * NSA_LDS_WAVE <= RING_BYTES && TAB_OFF + 4 * (40 + 320) <= LDS_BYTES, "LDS map");

#define GAS __attribute__((address_space(1)))
#define LAS __attribute__((address_space(3)))
#define DEV __device__ __forceinline__
typedef unsigned short bf16;
typedef unsigned v4u __attribute__((ext_vector_type(4)));
typedef unsigned v2u __attribute__((ext_vector_type(2)));
typedef float f32x4 __attribute__((ext_vector_type(4)));
typedef short bf16x8 __attribute__((ext_vector_type(8)));
typedef GAS unsigned gu32;
#define RLX_AGENT __ATOMIC_RELAXED, __HIP_MEMORY_SCOPE_AGENT
#define LDS_WAIT() asm volatile("s_waitcnt lgkmcnt(0)" ::: "memory")
#define VM_WAIT() asm volatile("s_waitcnt vmcnt(0)" ::: "memory")
typedef __bf16 bf16x2_t __attribute__((ext_vector_type(2)));
typedef float f32x2_t __attribute__((ext_vector_type(2)));
DEV unsigned pk2(float lo, float hi) { const f32x2_t v = {lo, hi}; return __builtin_bit_cast(unsigned, __builtin_convertvector(v, bf16x2_t)); }
DEV unsigned f2bf(float f) { return pk2(f, 0.f) & 0xffffu; }
DEV float bf2f(unsigned short b) { return __builtin_bit_cast(float, (unsigned)b << 16); }
DEV float bflo(unsigned w) { return __builtin_bit_cast(float, w << 16); }
DEV float bfhi(unsigned w) { return __builtin_bit_cast(float, w & 0xffff0000u); }
DEV float ex2(float x) { return __builtin_amdgcn_exp2f(x); }
DEV float wave_sum(float v) {
#pragma unroll
    for (int o = 1; o < 64; o <<= 1) v += __shfl_xor(v, o);
    return v;
}
DEV f32x4 mfma16(bf16x8 a, bf16x8 b, f32x4 c) { return __builtin_amdgcn_mfma_f32_16x16x32_bf16(a, b, c, 0, 0, 0); }
DEV int slot32(int k) { return ((k >> 2) & 3) * 8 + (k >> 4) * 4 + (k & 3); }
DEV float sigmoidf_(float x) { return 1.0f / (1.0f + __expf(-x)); }
DEV float siluf_(float x) { return x / (1.0f + __expf(-x)); }
#define XB_TMO      128
#define XB_XCNT(j)  (256  + 64 * (j))
#define XB_XSUB(j)  (1280 + 64 * (j))
#define XB_XGEN(j)  (2304 + 64 * (j))
#define XB_TOP      3328
#define XB_TOPGEN   3392
#define XCD_BAR_WORDS 3456
#define XB_SPIN_CAP (1u << 18)

__device__ __forceinline__ unsigned xb_ld(unsigned* p)              { return __hip_atomic_load(p, __ATOMIC_RELAXED, __HIP_MEMORY_SCOPE_AGENT); }
__device__ __forceinline__ unsigned xb_add(unsigned* p, unsigned v) { return __hip_atomic_fetch_add(p, v, __ATOMIC_RELAXED, __HIP_MEMORY_SCOPE_AGENT); }
__device__ __forceinline__ unsigned xb_xcc_id() { return (unsigned)__builtin_amdgcn_s_getreg((3 << 11) | 20) & 0xFu; }
#define XB_SPIN(cond, bar) do { unsigned _sp = 0; while (cond) { __builtin_amdgcn_s_sleep(1); \
    if ((++_sp & 255u) == 0u) { if (xb_ld(&(bar)[XB_TMO])) break; if (_sp > XB_SPIN_CAP) { atomicAdd(&(bar)[XB_TMO], 1u); break; } } } } while (0)

struct XcdBarrier {
    unsigned* bar; unsigned x;
    volatile LAS unsigned* st;
};

__device__ __forceinline__ XcdBarrier xcd_barrier_post(unsigned* bar, volatile LAS unsigned* st) {
    XcdBarrier b; b.bar = bar; b.x = xb_xcc_id(); b.st = st;
    if (threadIdx.x == 0) (void)xb_add(&bar[XB_XCNT(b.x)], 1u);
    return b;
}
__device__ __forceinline__ void xcd_barrier_complete(unsigned* bar, unsigned x, unsigned& nloc, unsigned& nx) {
    const unsigned G = gridDim.x * gridDim.y * gridDim.z;
    unsigned sum, cnt, mine, sp = 0u;
    for (;;) {
        sum = 0u; cnt = 0u; mine = 0u;
#pragma unroll
        for (unsigned j = 0; j < 16; ++j) { const unsigned c = xb_ld(&bar[XB_XCNT(j)]); sum += c; cnt += (c > 0u) ? 1u : 0u; mine = (j == x) ? c : mine; }
        if (sum == G) break;
        __builtin_amdgcn_s_sleep(1);
        if ((++sp & 255u) == 0u) { if (xb_ld(&bar[XB_TMO])) break; if (sp > XB_SPIN_CAP) { atomicAdd(&bar[XB_TMO], 1u); break; } }
    }
    nloc = mine > 0u ? mine : 1u; nx = cnt > 0u ? cnt : 1u;
}

__device__ __forceinline__ void xcd_barrier(const XcdBarrier& b) {
    asm volatile("s_waitcnt vmcnt(0)" ::: "memory");
    __syncthreads();
    if (threadIdx.x == 0) {
        unsigned* bar = b.bar;
        __builtin_amdgcn_s_waitcnt(0);
        unsigned nloc = b.st[0], nx = b.st[1];
        if (nloc == 0u) { xcd_barrier_complete(bar, b.x, nloc, nx); b.st[0] = nloc; b.st[1] = nx; }
        const unsigned old = xb_add(&bar[XB_XSUB(b.x)], 1u);
        const unsigned gen = old / nloc;
        if (old + 1u == (gen + 1u) * nloc) {
            __builtin_amdgcn_fence(__ATOMIC_RELEASE, "agent");
            asm volatile("s_waitcnt vmcnt(0)" ::: "memory");
            const unsigned og = xb_add(&bar[XB_TOP], 1u);
            const unsigned tg = og / nx;
            if (og + 1u == (tg + 1u) * nx) xb_add(&bar[XB_TOPGEN], 1u);
            else XB_SPIN(xb_ld(&bar[XB_TOPGEN]) == tg, bar);
            __builtin_amdgcn_fence(__ATOMIC_ACQUIRE, "agent");
            xb_add(&bar[XB_XGEN(b.x)], 1u);
            asm volatile("s_waitcnt vmcnt(0)" ::: "memory");
        } else {
            XB_SPIN(xb_ld(&bar[XB_XGEN(b.x)]) == gen, bar);
            __builtin_amdgcn_fence(__ATOMIC_ACQUIRE, "agent");
            asm volatile("s_waitcnt vmcnt(0)" ::: "memory");
        }
    }
    __syncthreads();
}
DEV float row_rstd(const float* ssq, int row, int fq) {
    const f32x4 p = *(const f32x4*)(ssq + (size_t)row * 16 + fq * 4);
    float s = (p.x + p.y) + (p.z + p.w);
    s += __shfl_xor(s, 16); s += __shfl_xor(s, 32);
    return 1.0f / sqrtf(s * (1.0f / 1024.0f) + RMS_EPS);
}
DEV float row_rstd_full(const float* ssq, int row) {
    const f32x4* p = (const f32x4*)(ssq + (size_t)row * 16);
    const f32x4 a = p[0], b = p[1], c = p[2], d = p[3];
    const float s = ((a.x + a.y) + (a.z + a.w)) + ((b.x + b.y) + (b.z + b.w)) + ((c.x + c.y) + (c.z + c.w)) + ((d.x + d.y) + (d.z + d.w));
    return 1.0f / sqrtf(s * (1.0f / 1024.0f) + RMS_EPS);
}

DEV void rope4(const float* rope, int t, int i, const f32x4& v0, const f32x4& v1, float (&lo)[4], float (&hi)[4]) {
    const f32x4 c0 = *(const f32x4*)(rope + ((size_t)t * 32 + i) * 2), c1 = *(const f32x4*)(rope + ((size_t)t * 32 + i + 2) * 2);
    lo[0] = v0[0] * c0[0] - v0[1] * c0[1]; hi[0] = v0[1] * c0[0] + v0[0] * c0[1];
    lo[1] = v0[2] * c0[2] - v0[3] * c0[3]; hi[1] = v0[3] * c0[2] + v0[2] * c0[3];
    lo[2] = v1[0] * c1[0] - v1[1] * c1[1]; hi[2] = v1[1] * c1[0] + v1[0] * c1[1];
    lo[3] = v1[2] * c1[2] - v1[3] * c1[3]; hi[3] = v1[3] * c1[2] + v1[2] * c1[3];
}
struct EpiIn {
    static constexpr bool PERM = true, AFTER_DRAIN = false;
    unsigned char* ws;
    template <class Tp> DEV Tp* P(size_t off) const { return (Tp*)(GAS Tp*)(ws + off); }
    DEV void operator()(const f32x4 (&acc)[2][2][4][2], const pg8::Unit& u, int wr, int wc, int fr, int fq) const {
        asm volatile("" : "+v"(fr), "+v"(fq), "+s"(wr), "+s"(wc));
        const int pn = u.pn;
        const float* ssq = P<float>(WS_SSQ); const float* rope = P<float>(WS_ROPE);
#pragma unroll
        for (int ai = 0; ai < 2; ++ai)
#pragma unroll
            for (int m = 0; m < 4; ++m) {
                const int row = u.pm * 256 + ai * 128 + wr * 64 + m * 16 + fr;
                const float rstd = row_rstd(ssq, row, fq);
                const int t = row & (T - 1), b = row >> 13;
#pragma unroll
                for (int bj = 0; bj < 2; ++bj) {
                    const int col = bj * 128 + wc * 32 + fq * 8;
                    const f32x4 v0 = acc[ai][bj][m][0] * rstd, v1 = acc[ai][bj][m][1] * rstd;
                    if (pn < 2) {
                        const int g = pn * 256 + col, head = g >> 6, i = (g & 63) >> 1;
                        const size_t o = (size_t)row * 512 + head * 64 + i;
                        bf16* Q = P<bf16>(WS_Q);
                        v2u w;
                        w.x = pk2(v0[0] * QSCALE, v0[2] * QSCALE); w.y = pk2(v1[0] * QSCALE, v1[2] * QSCALE); *(v2u*)(Q + o) = w;
                        w.x = pk2(v0[1] * QSCALE, v0[3] * QSCALE); w.y = pk2(v1[1] * QSCALE, v1[3] * QSCALE); *(v2u*)(Q + o + 32) = w;
                    } else if (pn == 2) {
                        bf16* dst = P<bf16>((col < 128) ? WS_KCR : WS_VCR);
                        v4u w; w.x = pk2(v0[0], v0[1]); w.y = pk2(v0[2], v0[3]); w.z = pk2(v1[0], v1[1]); w.w = pk2(v1[2], v1[3]);
                        *(v4u*)(dst + (size_t)row * 128 + (col & 127)) = w;
                    } else if (pn == 3 || pn == 4) {
                        if (col < 128) {
                            bf16* dst = P<bf16>((pn == 3) ? WS_KS : WS_KW);
                            const int hkv = col >> 6, i = (col & 63) >> 1;
                            float lo[4], hi[4]; rope4(rope, t, i, v0, v1, lo, hi);
                            const size_t o = ((size_t)(b * 2 + hkv) * T + t) * 64 + i;
                            v2u w;
                            w.x = pk2(lo[0], lo[1]); w.y = pk2(lo[2], lo[3]); *(v2u*)(dst + o) = w;
                            w.x = pk2(hi[0], hi[1]); w.y = pk2(hi[2], hi[3]); *(v2u*)(dst + o + 32) = w;
                        } else {
                            bf16* dst = P<bf16>((pn == 3) ? WS_VST : WS_VWT);
                            const int c2 = col - 128, hkv = c2 >> 6, d = c2 & 63;
                            const size_t o = (((size_t)(b * 2 + hkv) * 256 + (t >> 5)) * 64 + d) * 32 + slot32(t & 31);
#pragma unroll
                            for (int j = 0; j < 4; ++j) { dst[o + j * 32] = (bf16)f2bf(v0[j]); dst[o + (j + 4) * 32] = (bf16)f2bf(v1[j]); }
                        }
                    } else if (pn == 9) {
                        float* dst = P<float>(WS_HF) + (size_t)row * 256 + col;
                        *(f32x4*)dst = v0; *(f32x4*)(dst + 4) = v1;
                    } else {
                        bf16* dst = (pn < 8) ? P<bf16>(WS_CB + (size_t)(pn - 5) * (WS_CC - WS_CB)) : P<bf16>(WS_HQ + (size_t)(pn - 8) * (WS_HF - WS_HQ));
                        v4u w; w.x = pk2(v0[0], v0[1]); w.y = pk2(v0[2], v0[3]); w.z = pk2(v1[0], v1[1]); w.w = pk2(v1[2], v1[3]);
                        *(v4u*)(dst + (size_t)row * 256 + col) = w;
                    }
                }
            }
    }
};

struct EpiRes {
    static constexpr bool PERM = true, AFTER_DRAIN = false;
    const float* base32; bf16* hb; float* ssq;
    DEV void operator()(const f32x4 (&acc)[2][2][4][2], const pg8::Unit& u, int wr, int wc, int fr, int fq) const {
        asm volatile("" : "+v"(fr), "+v"(fq), "+s"(wr), "+s"(wc));
#pragma unroll
        for (int ai = 0; ai < 2; ++ai)
#pragma unroll
            for (int m = 0; m < 4; ++m) {
                const int row = u.pm * 256 + ai * 128 + wr * 64 + m * 16 + fr;
                float ss = 0.f;
#pragma unroll
                for (int bj = 0; bj < 2; ++bj) {
                    const size_t o = (size_t)row * 1024 + u.pn * 256 + bj * 128 + wc * 32 + fq * 8;
                    f32x4 v0, v1;
                    if (base32) { v0 = *(const f32x4*)(base32 + o); v1 = *(const f32x4*)(base32 + o + 4); }
                    else { const v4u hw = *(const v4u*)(hb + o); v0 = (f32x4){bflo(hw.x), bfhi(hw.x), bflo(hw.y), bfhi(hw.y)}; v1 = (f32x4){bflo(hw.z), bfhi(hw.z), bflo(hw.w), bfhi(hw.w)}; }
                    v0 = v0 + acc[ai][bj][m][0]; v1 = v1 + acc[ai][bj][m][1];
                    v4u w; w.x = pk2(v0[0], v0[1]); w.y = pk2(v0[2], v0[3]); w.z = pk2(v1[0], v1[1]); w.w = pk2(v1[2], v1[3]);
                    *(v4u*)(hb + o) = w;
                    ss += ((v0[0] * v0[0] + v0[1] * v0[1]) + (v0[2] * v0[2] + v0[3] * v0[3])) + ((v1[0] * v1[0] + v1[1] * v1[1]) + (v1[2] * v1[2] + v1[3] * v1[3]));
                }
                ss += __shfl_xor(ss, 16); ss += __shfl_xor(ss, 32);
                if (fq == 0) ssq[(size_t)row * 16 + u.pn * 4 + wc] = ss;
            }
    }
};

struct EpiXQ {
    static constexpr bool PERM = true, AFTER_DRAIN = false;
    const float* ssq; bf16* XQ;
    DEV void operator()(const f32x4 (&acc)[2][2][4][2], const pg8::Unit& u, int wr, int wc, int fr, int fq) const {
        asm volatile("" : "+v"(fr), "+v"(fq), "+s"(wr), "+s"(wc));
#pragma unroll
        for (int ai = 0; ai < 2; ++ai)
#pragma unroll
            for (int m = 0; m < 4; ++m) {
                const int row = u.pm * 256 + ai * 128 + wr * 64 + m * 16 + fr;
                const float sc = row_rstd(ssq, row, fq) * QSCALE;
#pragma unroll
                for (int bj = 0; bj < 2; ++bj) {
                    const f32x4 v0 = acc[ai][bj][m][0] * sc, v1 = acc[ai][bj][m][1] * sc;
                    v4u w; w.x = pk2(v0[0], v0[1]); w.y = pk2(v0[2], v0[3]); w.z = pk2(v1[0], v1[1]); w.w = pk2(v1[2], v1[3]);
                    *(v4u*)(XQ + (size_t)row * 256 + bj * 128 + wc * 32 + fq * 8) = w;
                }
            }
    }
};

struct EpiGU {
    static constexpr bool PERM = true, AFTER_DRAIN = false;
    const float* srstd; bf16* ACT;
    DEV void operator()(const f32x4 (&acc)[2][2][4][2], const pg8::Unit& u, int wr, int wc, int fr, int fq) const {
        asm volatile("" : "+v"(fr), "+v"(fq), "+s"(wr), "+s"(wc));
        const int nt = u.pn & 3;
#pragma unroll
        for (int ai = 0; ai < 2; ++ai)
#pragma unroll
            for (int m = 0; m < 4; ++m) {
                const int row = u.pm * 256 + ai * 128 + wr * 64 + m * 16 + fr;
                const float rs = srstd[row];
#pragma unroll
                for (int bj = 0; bj < 2; ++bj) {
                    const f32x4 v0 = acc[ai][bj][m][0] * rs, v1 = acc[ai][bj][m][1] * rs;
                    const int j = (nt * 256 + bj * 128 + wc * 32 + fq * 8) >> 1;
                    v2u w; w.x = pk2(siluf_(v0[0]) * v0[1], siluf_(v0[2]) * v0[3]); w.y = pk2(siluf_(v1[0]) * v1[1], siluf_(v1[2]) * v1[3]);
                    *(v2u*)(ACT + (size_t)row * 512 + j) = w;
                }
            }
    }
};

struct EpiDN {
    static constexpr bool PERM = true, AFTER_DRAIN = false;
    const float* sgate; bf16* YS;
    DEV void operator()(const f32x4 (&acc)[2][2][4][2], const pg8::Unit& u, int wr, int wc, int fr, int fq) const {
        asm volatile("" : "+v"(fr), "+v"(fq), "+s"(wr), "+s"(wc));
        const int nt = u.pn & 3;
#pragma unroll
        for (int ai = 0; ai < 2; ++ai)
#pragma unroll
            for (int m = 0; m < 4; ++m) {
                const int row = u.pm * 256 + ai * 128 + wr * 64 + m * 16 + fr;
                const float gt = sgate[row];
#pragma unroll
                for (int bj = 0; bj < 2; ++bj) {
                    const f32x4 v0 = acc[ai][bj][m][0] * gt, v1 = acc[ai][bj][m][1] * gt;
                    v4u w; w.x = pk2(v0[0], v0[1]); w.y = pk2(v0[2], v0[3]); w.z = pk2(v1[0], v1[1]); w.w = pk2(v1[2], v1[3]);
                    *(v4u*)(YS + (size_t)row * 1024 + nt * 256 + bj * 128 + wc * 32 + fq * 8) = w;
                }
            }
    }
};

struct MoeOrder {
    int nunits, G, c; const LAS int* tileE;
    DEV bool next(int i, pg8::Unit& u) const {
        const int L = i * G + c; if (L >= nunits) return false;
        const int rt = L >> 2; u.pm = rt; u.pn = tileE[rt] * 4 + (L & 3); return true;
    }
    DEV void a_ready(const pg8::Unit&) const {}
    DEV void done(const pg8::Unit&) const {}
};
struct Frame {
    LAS unsigned char* lds;
    unsigned char* ldsg;
    volatile LAS unsigned* MISC;
    gu32* ctl;
    unsigned char* ws;
    int tid, lane, wave, vcu, G;
    float* out;
};
template <class Tp> DEV Tp* wsp(const Frame& F, size_t off) { return (Tp*)(F.ws + off); }
DEV const float* inp(int i) { const float* const* ka = (const float* const*)__builtin_amdgcn_kernarg_segment_ptr(); asm volatile("" : "+s"(i)); return (const float*)(const GAS float*)ka[i]; }

template <class Map>
DEV void tr_item(const float* W, int K, int Nsrc, const float* gain, bf16* WT, float* scr, int item, int lane, Map map) {
    const int nblk = (Nsrc + 31) >> 5, kb = item / nblk, nb = item - kb * nblk, k0 = 64 * kb, n0 = 32 * nb;
    {
        const int nq = (lane & 7) * 4; f32x4 v[8];
#pragma unroll
        for (int i = 0; i < 8; ++i) { const int kk = 8 * i + (lane >> 3);
            v[i] = (n0 + nq < Nsrc) ? *(const f32x4*)(W + (size_t)(k0 + kk) * Nsrc + n0 + nq) : (f32x4){0.f, 0.f, 0.f, 0.f}; }
#pragma unroll
        for (int i = 0; i < 8; ++i) { const int kk = 8 * i + (lane >> 3); const float g = gain ? gain[k0 + kk] : 1.0f; float* s = scr + kk * 33 + nq;
            s[0] = v[i][0] * g; s[1] = v[i][1] * g; s[2] = v[i][2] * g; s[3] = v[i][3] * g; }
    }
    LDS_WAIT();
    const int c = lane & 7;
#pragma unroll
    for (int j = 0; j < 4; ++j) {
        const int n = (lane >> 3) + 8 * j; const float* s = scr + (8 * c) * 33 + n;
        if (n0 + n < Nsrc) {
            v4u o; o.x = pk2(s[0 * 33], s[1 * 33]); o.y = pk2(s[2 * 33], s[3 * 33]); o.z = pk2(s[4 * 33], s[5 * 33]); o.w = pk2(s[6 * 33], s[7 * 33]);
            *(v4u*)(WT + (size_t)map(n0 + n) * K + k0 + 8 * c) = o;
        }
    }
    LDS_WAIT();
}
template <class Map>
DEV void tr_experts(const float* W, int K, int Nsrc, const float* gain, bf16* WT, bf16* scr, int gw, int NGW, int lane, Map map) {
    const int nblk = Nsrc >> 6, per_e = (K >> 6) * nblk, NIT = 32 * per_e; const size_t esz = (size_t)K * Nsrc;
#pragma unroll 1
    for (int it = gw; it < NIT; it += NGW) {
        const int e = it / per_e, sub = it - e * per_e, kb = sub / nblk, nb = sub - kb * nblk, k0 = 64 * kb, n0 = 64 * nb, nq = (lane & 15) * 4;
        const float* Wp = W + (size_t)e * esz; bf16* Wo = WT + (size_t)e * esz;
        f32x4 v[16];
#pragma unroll
        for (int i = 0; i < 16; ++i) v[i] = *(const f32x4*)(Wp + (size_t)(k0 + 4 * i + (lane >> 4)) * Nsrc + n0 + nq);
#pragma unroll
        for (int i = 0; i < 16; ++i) { const int kk = 4 * i + (lane >> 4); const float g = gain ? gain[k0 + kk] : 1.0f;
            v2u w; w.x = pk2(v[i][0] * g, v[i][1] * g); w.y = pk2(v[i][2] * g, v[i][3] * g);
            *(v2u*)(scr + kk * 68 + nq) = w; }
        LDS_WAIT();
        const int cc = lane & 7;
#pragma unroll
        for (int j = 0; j < 8; ++j) { const int n = (lane >> 3) + 8 * j; const bf16* s = scr + (8 * cc) * 68 + n;
            v4u o; o.x = (unsigned)s[0] | ((unsigned)s[68] << 16); o.y = (unsigned)s[2 * 68] | ((unsigned)s[3 * 68] << 16);
            o.z = (unsigned)s[4 * 68] | ((unsigned)s[5 * 68] << 16); o.w = (unsigned)s[6 * 68] | ((unsigned)s[7 * 68] << 16);
            *(v4u*)(Wo + (size_t)map(n0 + n) * K + k0 + 8 * cc) = o; }
        LDS_WAIT();
    }
}
struct MapId { DEV int operator()(int n) const { return n; } };
struct MapIn {
    DEV int operator()(int n) const {
        if (n < 512) { const int d = n & 63; return (n & ~63) + 2 * (d & 31) + (d >> 5); }
        if (n < 768) return n;
        if (n < 1280) { const int r = n - 768; if ((r & 255) < 128) { const int d = r & 63; return 768 + (r & ~63) + 2 * (d & 31) + (d >> 5); } return n; }
        if (n < 1304) return 3072 + (n - 1280);
        return n - 24;
    }
};
struct MapGU { DEV int operator()(int n) const { return n < 512 ? 2 * n : 2 * (n - 512) + 1; } };

DEV void convert_experts(Frame& F, int l, bf16* scr, int part) {
    unsigned zl_ = 0u; asm volatile("" : "+v"(zl_)); const int lane = (int)__builtin_amdgcn_mbcnt_hi(~0u, __builtin_amdgcn_mbcnt_lo(~0u, zl_));
    const int gw = F.vcu * NWAVES + F.wave, NGW = F.G * NWAVES;
    if (part == 0) tr_experts(inp(17) + (size_t)l * 32 * 1024 * 1024, 1024, 1024, inp(22) + l * 1024, wsp<bf16>(F, WS_WGU) + (size_t)l * 32 * 1024 * 1024, scr, gw, NGW, lane, MapGU());
    else tr_experts(inp(18) + (size_t)l * 32 * 512 * 1024, 512, 1024, nullptr, wsp<bf16>(F, WS_WDN) + (size_t)l * 32 * 1024 * 512, scr, gw, NGW, lane, MapId());
}
DEV void p0_prologue(Frame& F) {
    float* scr = (float*)(F.ldsg + F.wave * 16384);
    const int gw = F.vcu * NWAVES + F.wave, NGW = F.G * NWAVES, lane = F.lane;
    for (int l = 0; l < DEPTH; ++l) {
        { const int NIT = 16 * 97; bf16* dst = wsp<bf16>(F, WS_WIN) + (size_t)l * NIN * 1024;
          for (int it = gw; it < NIT; it += NGW) tr_item(inp(2) + (size_t)l * 1024 * IN_W, 1024, IN_W, inp(19) + l * 1024, dst, scr, it, lane, MapIn());
          for (int i = gw * 64 + lane; i < (NIN - 3096) * 1024 / 8; i += NGW * 64) ((v4u*)(dst + (size_t)3096 * 1024))[i] = (v4u){0u, 0u, 0u, 0u}; }
        { const int NIT = 16 * 32; for (int it = gw; it < NIT; it += NGW) tr_item(inp(9) + (size_t)l * 1024 * 1024, 1024, 1024, nullptr, wsp<bf16>(F, WS_WOUT) + (size_t)l * 1024 * 1024, scr, it, lane, MapId()); }
        { const int NIT = 16 * 8; for (int it = gw; it < NIT; it += NGW) tr_item(inp(10) + (size_t)l * 1024 * 256, 1024, 256, inp(20) + l * 1024, wsp<bf16>(F, WS_WQ) + (size_t)l * 256 * 1024, scr, it, lane, MapId()); }
        { const int NIT = 16 * 16; for (int it = gw; it < NIT; it += NGW) tr_item(inp(11) + (size_t)l * 1024 * 512, 1024, 512, inp(21) + l * 1024, wsp<bf16>(F, WS_WKV) + (size_t)l * 512 * 1024, scr, it, lane, MapId()); }
        { const int NIT = 4 * 32; for (int it = gw; it < NIT; it += NGW) tr_item(inp(12) + (size_t)l * 256 * 1024, 256, 1024, nullptr, wsp<bf16>(F, WS_WO) + (size_t)l * 1024 * 256, scr, it, lane, MapId()); }
        for (int kv = 0; kv < 2; ++kv) {
            { const int NIT = 32 * 4; for (int it = gw; it < NIT; it += NGW) tr_item(inp(5) + (size_t)(l * 2 + kv) * 2048 * 128, 2048, 128, nullptr, wsp<bf16>(F, WS_W1C) + (size_t)(l * 2 + kv) * 128 * 2048, scr, it, lane, MapId()); }
            { const int NIT = 2 * 2; for (int it = gw; it < NIT; it += NGW) tr_item(inp(6) + (size_t)(l * 2 + kv) * 128 * 64, 128, 64, nullptr, wsp<bf16>(F, WS_W2C) + (size_t)(l * 2 + kv) * 64 * 128, scr, it, lane, MapId()); }
        }
        if (F.G != 256) { convert_experts(F, l, (bf16*)scr, 0); convert_experts(F, l, (bf16*)scr, 1); }
        { bf16* dst = wsp<bf16>(F, WS_WR) + (size_t)l * 96 * 1024; const float* gn = inp(22) + l * 1024;
          for (int i = gw * 64 + lane; i < 48 * 1024; i += NGW * 64) { const int n = i >> 10, k = i & 1023;
            float v = 0.f; if (n < 4) v = inp(13)[(size_t)(l * 1024 + k) * 4 + n]; else if (n < 36) v = inp(15)[(size_t)(l * 1024 + k) * 32 + (n - 4)];
            v *= gn[k]; const unsigned h = f2bf(v); dst[i] = (bf16)h; dst[i + 48 * 1024] = (bf16)f2bf(v - bf2f((unsigned short)h)); } }
    }
    { bf16* wg = wsp<bf16>(F, WS_WG);
      for (int i = gw * 64 + lane; i < DEPTH * 32 * 1024; i += NGW * 64) { const int l2 = i >> 15, row = (i >> 10) & 31, k = i & 1023, hk = row >> 4, gi = row & 15;
        const float v = gi < 12 ? inp(2)[((size_t)l2 * 1024 + k) * IN_W + 1280 + hk * 12 + gi] * inp(19)[l2 * 1024 + k] : 0.f;
        wg[i] = (bf16)f2bf(v); } }
    { float* rope = wsp<float>(F, WS_ROPE);
      for (int i = gw * 64 + lane; i < T * 32; i += NGW * 64) { const int t = i >> 5, k = i & 31;
        const float inv = powf(10000.0f, -(float)k / 32.0f); const float ang = (float)t * inv;
        rope[2 * i] = cosf(ang); rope[2 * i + 1] = sinf(ang); } }
    { float* b1 = wsp<float>(F, WS_SMALL);
      for (int i = gw * 64 + lane; i < 4 * 128; i += NGW * 64) { const int lk = i >> 7, n = i & 127;
        const float* pe = inp(4) + (size_t)lk * 2048; const float* w1 = inp(5) + (size_t)lk * 2048 * 128 + n; float s = 0.f;
        for (int kk = 0; kk < 2048; ++kk) s += pe[kk] * w1[(size_t)kk * 128];
        b1[i] = s; } }
    { bf16* HB = wsp<bf16>(F, WS_HB); float* SSQ = wsp<float>(F, WS_SSQ); bf16* MB = wsp<bf16>(F, WS_MEMB); float* SSQM = wsp<float>(F, WS_SMALL) + 1024;
      for (int m = gw; m < NTOK + NB * 256; m += NGW) {
        const bool ism = m >= NTOK; const int r = ism ? m - NTOK : m;
        const f32x4* xr = (const f32x4*)((ism ? inp(1) : inp(0)) + (size_t)r * 1024) + lane;
        unsigned long long* o8 = (unsigned long long*)((ism ? MB : HB) + (size_t)r * 1024) + lane;
        float s = 0.f;
#pragma unroll
        for (int j = 0; j < 4; ++j) { const f32x4 v = xr[64 * j]; s += (v.x * v.x + v.y * v.y) + (v.z * v.z + v.w * v.w);
            o8[64 * j] = (unsigned long long)pk2(v.x, v.y) | ((unsigned long long)pk2(v.z, v.w) << 32); }
        s = wave_sum(s);
        if (ism) { if (lane == 0) SSQM[r] = s; }
        else if (lane < 16) SSQ[(size_t)r * 16 + lane] = lane == 0 ? s : 0.f;
      } }
}

template <int NT>
DEV void skinny16(const bf16* A, size_t lda, const bf16* Bt, size_t ldb, int K, int lane, f32x4 (&acc)[NT]) {
    const int l16 = lane & 15, g4 = lane >> 4;
    const bf16* ap = A + (size_t)l16 * lda + g4 * 8; const bf16* bp = Bt + (size_t)l16 * ldb + g4 * 8;
#pragma unroll
    for (int n = 0; n < NT; ++n) acc[n] = (f32x4){0.f, 0.f, 0.f, 0.f};
#pragma unroll 2
    for (int k = 0; k < K; k += 32) {
        const bf16x8 a = *(const bf16x8*)(ap + k);
#pragma unroll
        for (int n = 0; n < NT; ++n) { const bf16x8 b = *(const bf16x8*)(bp + (size_t)n * 16 * ldb + k); acc[n] = mfma16(a, b, acc[n]); }
    }
}

DEV void memkv_phase(Frame& F) {
    const int gw = F.vcu * NWAVES + F.wave, NGW = F.G * NWAVES, lane = F.lane, l16 = lane & 15, g4 = lane >> 4;
    const bf16* MB = wsp<bf16>(F, WS_MEMB); const float* SSQM = wsp<float>(F, WS_SMALL) + 1024;
    bf16* MK = wsp<bf16>(F, WS_MK); bf16* MVT = wsp<bf16>(F, WS_MVT);
    for (int task = gw; task < 1024; task += NGW) {
        const int l2 = task >> 9, rt = (task >> 3) & 63, chunk = task & 7;
        f32x4 acc[4];
        skinny16<4>(MB + (size_t)rt * 16 * 1024, 1024, wsp<bf16>(F, WS_WKV) + ((size_t)l2 * 512 + chunk * 64) * 1024, 1024, 1024, lane, acc);
        const int b = rt >> 4, key0 = (rt & 15) * 16 + g4 * 4;
        float rs[4];
#pragma unroll
        for (int r = 0; r < 4; ++r) rs[r] = 1.0f / sqrtf(SSQM[rt * 16 + g4 * 4 + r] * (1.0f / 1024.0f) + RMS_EPS);
#pragma unroll
        for (int nt = 0; nt < 4; ++nt) {
            const int n = chunk * 64 + nt * 16 + l16;
            if (chunk < 4) { const int head = n >> 6, d = n & 63;
#pragma unroll
                for (int r = 0; r < 4; ++r) MK[((size_t)((l2 * 4 + b) * 4 + head) * 256 + key0 + r) * 64 + d] = (bf16)f2bf(acc[nt][r] * rs[r]);
            } else { const int n2 = n - 256, head = n2 >> 6, d = n2 & 63;
                v2u w; w.x = pk2(acc[nt][0] * rs[0], acc[nt][1] * rs[1]); w.y = pk2(acc[nt][2] * rs[2], acc[nt][3] * rs[3]);
                *(v2u*)(MVT + (((size_t)((l2 * 4 + b) * 4 + head) * 8 + (key0 >> 5)) * 64 + d) * 32 + slot32(key0 & 31)) = w; }
        }
    }
}

DEV void compress_phase(Frame& F, int l) {
    const int lane = F.lane, l16 = lane & 15, g4 = lane >> 4, quad = F.wave >> 2, q = F.wave & 3;
    float* part = (float*)F.ldsg + quad * (4 * 16 * 128);
    const bf16* KCR = wsp<bf16>(F, WS_KCR); const bf16* VCR = wsp<bf16>(F, WS_VCR);
    bf16* KCC = wsp<bf16>(F, WS_KCC); bf16* VCT = wsp<bf16>(F, WS_VCT);
    const float* bias1 = wsp<float>(F, WS_SMALL);
    for (int tk0 = F.vcu * 2; tk0 < 512; tk0 += F.G * 2) {
        const int tk = tk0 + quad; const int kv = tk >> 8, tile = tk & 255;
        const bf16* raw = kv ? VCR : KCR;
        const bf16* w1 = wsp<bf16>(F, WS_W1C) + (size_t)(l * 2 + kv) * 128 * 2048;
        const bf16* w2 = wsp<bf16>(F, WS_W2C) + (size_t)(l * 2 + kv) * 64 * 128;
        { const int r = tile * 16 + l16, bh = r >> 9, c = r & 511, b = bh >> 1, hkv = bh & 1;
          f32x4 acc[8];
#pragma unroll
          for (int n = 0; n < 8; ++n) acc[n] = (f32x4){0.f, 0.f, 0.f, 0.f};
#pragma unroll 2
          for (int ks = q * 16; ks < q * 16 + 16; ++ks) {
              const int kk = ks * 32 + g4 * 8, ll = kk >> 6, d = kk & 63;
              int tok = 16 * c + ll; tok = tok > T - 1 ? T - 1 : tok;
              const bf16x8 a = *(const bf16x8*)(raw + ((size_t)b * T + tok) * 128 + hkv * 64 + d);
#pragma unroll
              for (int n = 0; n < 8; ++n) { const bf16x8 bb = *(const bf16x8*)(w1 + (size_t)(n * 16 + l16) * 2048 + kk); acc[n] = mfma16(a, bb, acc[n]); }
          }
#pragma unroll
          for (int n = 0; n < 8; ++n)
#pragma unroll
              for (int r2 = 0; r2 < 4; ++r2) part[(q * 16 + g4 * 4 + r2) * 128 + n * 16 + l16] = acc[n][r2];
        }
        __syncthreads();
        { f32x4 o = (f32x4){0.f, 0.f, 0.f, 0.f};
#pragma unroll
          for (int k2 = 0; k2 < 4; ++k2) {
              const int h0 = k2 * 32 + g4 * 8;
              float hv[8];
#pragma unroll
              for (int j = 0; j < 8; ++j) { float s = bias1[(l * 2 + kv) * 128 + h0 + j];
#pragma unroll
                  for (int p = 0; p < 4; ++p) s += part[(p * 16 + l16) * 128 + h0 + j];
                  hv[j] = siluf_(s); }
              bf16x8 a; { v4u w; w.x = pk2(hv[0], hv[1]); w.y = pk2(hv[2], hv[3]); w.z = pk2(hv[4], hv[5]); w.w = pk2(hv[6], hv[7]); a = __builtin_bit_cast(bf16x8, w); }
              const bf16x8 bb = *(const bf16x8*)(w2 + (size_t)(q * 16 + l16) * 128 + h0);
              o = mfma16(a, bb, o);
          }
          const int r0 = tile * 16 + g4 * 4, bh = r0 >> 9, c0 = r0 & 511, d = q * 16 + l16;
          if (kv == 0) {
#pragma unroll
              for (int r2 = 0; r2 < 4; ++r2) KCC[((size_t)bh * 512 + c0 + r2) * 64 + d] = (c0 + r2 == 511) ? (bf16)0 : (bf16)f2bf(o[r2]);
          } else {
              v2u w; w.x = pk2(o[0], o[1]); w.y = pk2(o[2], (c0 + 3 == 511) ? 0.f : o[3]);
              *(v2u*)(VCT + (((size_t)bh * 16 + (c0 >> 5)) * 64 + d) * 32 + slot32(c0 & 31)) = w;
          }
        }
        __syncthreads();
    }
}

DEV float hgrn_lb(const Frame& F, int l, int c) {
    if (l == 0) return 0.f;
    const float a = inp(7)[c], b = inp(7)[256 + c];
    return 1.0f / (1.0f + expf(a - b));
}
DEV float hgrn_logf(float z, float lb) {
    const float la = logf(fmaxf(lb, 1e-30f));
    const float ls = fminf(z, 0.f) - log1pf(expf(-fabsf(z)));
    const float lc = log1pf(-lb) + ls;
    const float mx = fmaxf(la, lc), mn = fminf(la, lc);
    return mx + log1pf(expf(mn - mx));
}
constexpr int HS = 68;
DEV f32x4 mfma4(float a, float b, f32x4 c) { return __builtin_amdgcn_mfma_f32_16x16x4f32(a, b, c, 0, 0, 0); }
DEV void hgrn_setup_chunk(Frame& F, float lb, const float (&z)[8], float* Bc, float* Kc, float* tot) {
    const int d = F.tid & 63, sg = F.tid >> 6;
    const float la = logf(fmaxf(lb, 1e-30f)), l1m = log1pf(-lb), onem = 1.0f - lb;
    float loc[8], kv[8]; float run = 0.f;
#pragma unroll
    for (int i = 0; i < 8; ++i) {
        const float ez = __expf(-fabsf(z[i]));
        const float lc = l1m + (fminf(z[i], 0.f) - __logf(1.0f + ez));
        const float mx = fmaxf(la, lc), mn = fminf(la, lc);
        run += mx + __logf(1.0f + __expf(mn - mx)); loc[i] = run;
        kv[i] = onem * (z[i] >= 0.f ? ez : 1.0f) / (1.0f + ez);
    }
    tot[sg * 64 + d] = run;
    __syncthreads();
    float off = 0.f;
    for (int g = 0; g < sg; ++g) off += tot[g * 64 + d];
#pragma unroll
    for (int i = 0; i < 8; ++i) { Bc[(sg * 8 + i) * HS + d] = off + loc[i]; Kc[(sg * 8 + i) * HS + d] = kv[i]; }
    __syncthreads();
}
DEV void hgrn_local_phase(Frame& F, int l) {
    float* Bc = (float*)F.ldsg; float* Kc = Bc + 64 * HS; float* Vc = Kc + 64 * HS; float* tot = Vc + 64 * HS;
    bf16* U = wsp<bf16>(F, WS_U); float* DEC = wsp<float>(F, WS_DEC);
    const int lane = F.lane, w = F.wave, li = lane & 15, kq = lane >> 4;
    for (int task = F.vcu; task < 2048; task += F.G) {
        const int bh = task >> 7, ch = task & 127, b = bh >> 2, h = bh & 3;
        { const int d = F.tid & 63, sg = F.tid >> 6;
          const size_t go = ((size_t)b * T + ch * 64 + sg * 8) * 256 + h * 64 + d;
          const float* HFp = wsp<float>(F, WS_HF) + go; const bf16* HIp = wsp<bf16>(F, WS_HI) + go;
          float z[8], vi[8];
#pragma unroll
          for (int i = 0; i < 8; ++i) { z[i] = HFp[(size_t)i * 256]; vi[i] = bf2f(HIp[(size_t)i * 256]); }
          hgrn_setup_chunk(F, hgrn_lb(F, l, h * 64 + d), z, Bc, Kc, tot);
          const float bl = Bc[63 * HS + d];
#pragma unroll
          for (int i = 0; i < 8; ++i) { const int s = sg * 8 + i; Kc[s * HS + d] *= __expf(bl - Bc[s * HS + d]); Vc[s * HS + d] = vi[i]; }
          if (sg == 0) DEC[(size_t)task * 64 + d] = expf(bl); }
        __syncthreads();
        { const int dI = w >> 1, e0 = (w & 1) * 32;
          f32x4 a0 = (f32x4){0.f, 0.f, 0.f, 0.f}, a1 = a0;
#pragma unroll 4
          for (int k0 = 0; k0 < 64; k0 += 4) { const int s = k0 + kq;
              const float a = Kc[s * HS + dI * 16 + li], b0 = Vc[s * HS + e0 + li], b1 = Vc[s * HS + e0 + 16 + li];
              a0 = mfma4(a, b0, a0); a1 = mfma4(a, b1, a1); }
#pragma unroll
          for (int r = 0; r < 4; ++r) { bf16* up = U + ((size_t)task * 64 + dI * 16 + 4 * kq + r) * 64 + e0 + li; up[0] = (bf16)f2bf(a0[r]); up[16] = (bf16)f2bf(a1[r]); } }
        __syncthreads();
    }
}
DEV void hgrn_scan_phase(Frame& F, int probe = 0) {
    const bf16* U = wsp<bf16>(F, WS_U); bf16* U2 = wsp<bf16>(F, probe ? WS_PROBE : WS_U2); const float* DEC = wsp<float>(F, WS_DEC);
    const int nact = (F.G * 256 >= 65536) ? 256 : 512;
    if (F.tid < nact)
    for (int gid = F.vcu * nact + F.tid; gid < 65536; gid += F.G * nact) {
        const int bh = gid >> 12, de = gid & 4095, d = de >> 6;
        float S = 0.f; const bf16* up = U + (size_t)bh * 128 * 4096 + de; bf16* op = U2 + (size_t)bh * 128 * 4096 + de; const float* dp = DEC + (size_t)bh * 128 * 64 + d;
#pragma unroll 16
        for (int ch = 0; ch < 128; ++ch) { const float u = bf2f(up[(size_t)ch * 4096]); const float dc = dp[ch * 64]; op[(size_t)ch * 4096] = (bf16)f2bf(S); S = dc * S + u; }
    }
}
DEV void hgrn_out_phase(Frame& F, int l) {
    float* Bc = (float*)F.ldsg; float* Kb = Bc + 64 * HS; float* Vc = Kb + 64 * HS; float* Qs = Vc + 64 * HS; float* Sc = Qs + 64 * HS; float* Ac = Sc + 64 * HS; float* tot = Ac + 64 * HS;
    float* Oc = Kb;
    const bf16* U = wsp<bf16>(F, WS_U2); bf16* CAT = wsp<bf16>(F, WS_CAT);
    const int lane = F.lane, w = F.wave, li = lane & 15, kq = lane >> 4;
    for (int task = F.vcu; task < 2048; task += F.G) {
        const int bh = task >> 7, ch = task & 127, b = bh >> 2, h = bh & 3;
        float gv[8];
        { const int d = F.tid & 63, sg = F.tid >> 6;
          const size_t go = ((size_t)b * T + ch * 64 + sg * 8) * 256 + h * 64 + d;
          const float* HFp = wsp<float>(F, WS_HF) + go; const bf16* HIp = wsp<bf16>(F, WS_HI) + go; const bf16* HQp = wsp<bf16>(F, WS_HQ) + go; const bf16* HGp = wsp<bf16>(F, WS_HG) + go;
          const bf16* Up = U + ((size_t)task * 64 + sg * 8) * 64 + d;
          float z[8], vi[8], qi[8], si[8];
#pragma unroll
          for (int i = 0; i < 8; ++i) { z[i] = HFp[(size_t)i * 256]; vi[i] = bf2f(HIp[(size_t)i * 256]); qi[i] = bf2f(HQp[(size_t)i * 256]); gv[i] = bf2f(HGp[(size_t)i * 256]); si[i] = bf2f(Up[(size_t)i * 64]); }
          hgrn_setup_chunk(F, hgrn_lb(F, l, h * 64 + d), z, Bc, Kb, tot);
#pragma unroll
          for (int i = 0; i < 8; ++i) { const int s = sg * 8 + i, J = s >> 4; const float rJ = J ? Bc[(16 * J - 1) * HS + d] : 0.f;
              Kb[s * HS + d] *= __expf(fminf(rJ - Bc[s * HS + d], 80.f));
              Vc[s * HS + d] = vi[i]; Qs[s * HS + d] = qi[i] * 0.125f; Sc[s * HS + d] = si[i]; } }
        __syncthreads();
#pragma unroll 1
        for (int ti = w; ti < 10; ti += 8) {
            const int I = ti < 1 ? 0 : (ti < 3 ? 1 : (ti < 6 ? 2 : 3)), J = ti - (I * (I + 1)) / 2;
            const int t = I * 16 + li; f32x4 acc = (f32x4){0.f, 0.f, 0.f, 0.f};
#pragma unroll 4
            for (int k0 = 0; k0 < 64; k0 += 4) { const int d = k0 + kq; const float rJ = J ? Bc[(16 * J - 1) * HS + d] : 0.f;
                const float a = Qs[t * HS + d] * __expf(Bc[t * HS + d] - rJ), bb = Kb[(J * 16 + li) * HS + d];
                acc = mfma4(a, bb, acc); }
#pragma unroll
            for (int r = 0; r < 4; ++r) { const int tt = I * 16 + 4 * kq + r, ss = J * 16 + li; Ac[tt * HS + ss] = (ss <= tt) ? acc[r] : 0.f; }
        }
        __syncthreads();
        { const int I = w >> 1, e0 = (w & 1) * 32, t = I * 16 + li;
          f32x4 a0 = (f32x4){0.f, 0.f, 0.f, 0.f}, a1 = a0;
#pragma unroll 4
          for (int k0 = 0; k0 < 64; k0 += 4) { const int d = k0 + kq;
              const float a = Qs[t * HS + d] * __expf(Bc[t * HS + d]), b0 = Sc[d * HS + e0 + li], b1 = Sc[d * HS + e0 + 16 + li];
              a0 = mfma4(a, b0, a0); a1 = mfma4(a, b1, a1); }
#pragma unroll 1
          for (int s0 = 0; s0 < 16 * (I + 1); s0 += 4) { const int s = s0 + kq;
              const float a = Ac[t * HS + s], b0 = Vc[s * HS + e0 + li], b1 = Vc[s * HS + e0 + 16 + li];
              a0 = mfma4(a, b0, a0); a1 = mfma4(a, b1, a1); }
#pragma unroll
          for (int r = 0; r < 4; ++r) { float* op = Oc + (I * 16 + 4 * kq + r) * HS + e0 + li; op[0] = a0[r]; op[16] = a1[r]; } }
        __syncthreads();
        { const float ng = inp(8)[l * 256 + h * 64 + lane];
          { const int t = w * 8 + (lane >> 3); const float* op = Oc + t * HS + (lane & 7) * 8; float s = 0.f;
#pragma unroll
            for (int j = 0; j < 8; ++j) s += op[j] * op[j];
            s += __shfl_xor(s, 1); s += __shfl_xor(s, 2); s += __shfl_xor(s, 4);
            if ((lane & 7) == 0) tot[t] = 1.0f / sqrtf(s * (1.0f / 64.0f) + RMS_EPS); }
          LDS_WAIT();
#pragma unroll
          for (int i = 0; i < 8; ++i) { const int t = w * 8 + i; const float o = Oc[t * HS + lane];
              const size_t row = (size_t)b * T + ch * 64 + t;
              CAT[row * 1024 + 768 + h * 64 + lane] = (bf16)f2bf(o * tot[t] * ng * siluf_(gv[i])); } }
        __syncthreads();
    }
}

DEV void conv_phase(Frame& F, int l) {
    const bf16* CB = wsp<bf16>(F, WS_CB); const bf16* CC = wsp<bf16>(F, WS_CC); const bf16* CH = wsp<bf16>(F, WS_CH); bf16* CAT = wsp<bf16>(F, WS_CAT);
    const float* cw = inp(3) + l * 3 * 256;
    for (int it = F.vcu * 512 + F.tid; it < NTOK * 32; it += F.G * 512) {
        const int m = it >> 5, c0 = (it & 31) * 8, t = m & (T - 1);
        const v4u bb = *(const v4u*)(CB + (size_t)m * 256 + c0);
        float y[8];
#pragma unroll
        for (int j = 0; j < 8; ++j) y[j] = 0.f;
#pragma unroll
        for (int k = 0; k < 3; ++k) {
            if (t + k - 2 >= 0) {
                const size_t o = (size_t)(m + k - 2) * 256 + c0;
                const v4u cc = *(const v4u*)(CC + o), hh = *(const v4u*)(CH + o);
#pragma unroll
                for (int j = 0; j < 4; ++j) { const float w0 = cw[k * 256 + c0 + 2 * j], w1 = cw[k * 256 + c0 + 2 * j + 1];
                    y[2 * j] += w0 * (bflo(cc[j]) * bflo(hh[j])); y[2 * j + 1] += w1 * (bfhi(cc[j]) * bfhi(hh[j])); }
            }
        }
        v4u o4;
#pragma unroll
        for (int j = 0; j < 4; ++j) o4[j] = pk2(bflo(bb[j]) * y[2 * j], bfhi(bb[j]) * y[2 * j + 1]);
        *(v4u*)(CAT + (size_t)m * 1024 + 512 + c0) = o4;
    }
}
struct SmState { float m, l; f32x4 o[4]; };
DEV void sm_reset(SmState& st) { st.m = -INFINITY; st.l = 0.f;
#pragma unroll
    for (int i = 0; i < 4; ++i) st.o[i] = (f32x4){0.f, 0.f, 0.f, 0.f}; }
DEV float sm_lsum(const SmState& st) { float l = st.l; l += __shfl_xor(l, 16); l += __shfl_xor(l, 32); return l; }
DEV void load_k(const bf16* kbase, int lane, bf16x8 (&kf)[2][2]) {
    const int l16 = lane & 15, g4 = lane >> 4;
#pragma unroll
    for (int tt = 0; tt < 2; ++tt)
#pragma unroll
        for (int ks = 0; ks < 2; ++ks) kf[tt][ks] = *(const bf16x8*)(kbase + (size_t)(16 * tt + l16) * 64 + ks * 32 + g4 * 8);
}
DEV void load_v(const bf16* vbase, int lane, bf16x8 (&vf)[4]) {
    const int l16 = lane & 15, g4 = lane >> 4;
#pragma unroll
    for (int dt = 0; dt < 4; ++dt) vf[dt] = *(const bf16x8*)(vbase + (size_t)(dt * 16 + l16) * 32 + g4 * 8);
}
DEV void qk_tile(const bf16x8 (&kf)[2][2], const bf16x8 (&qf)[2], f32x4 (&s)[2]) {
#pragma unroll
    for (int tt = 0; tt < 2; ++tt) { s[tt] = mfma16(kf[tt][0], qf[0], (f32x4){0.f, 0.f, 0.f, 0.f}); s[tt] = mfma16(kf[tt][1], qf[1], s[tt]); }
}
DEV bf16x8 pack_p(const float (&p)[2][4]) {
    v4u w; w.x = pk2(p[0][0], p[0][1]); w.y = pk2(p[0][2], p[0][3]); w.z = pk2(p[1][0], p[1][1]); w.w = pk2(p[1][2], p[1][3]);
    return __builtin_bit_cast(bf16x8, w);
}
template <int MODE, class MaskF>
DEV void attn_compute(const bf16x8 (&kf)[2][2], const bf16x8 (&vf)[4], const bf16x8 (&qf)[2], SmState& st, int lane, bool colok, MaskF mask) {
    const int g4 = lane >> 4;
    f32x4 s[2]; qk_tile(kf, qf, s);
    float sv[2][4]; float tmax = -INFINITY;
#pragma unroll
    for (int tt = 0; tt < 2; ++tt)
#pragma unroll
        for (int r = 0; r < 4; ++r) { float x = s[tt][r]; if (MODE == 2) x = mask(16 * tt + 4 * g4 + r) ? x : -INFINITY; sv[tt][r] = x; tmax = fmaxf(tmax, x); }
    if (MODE == 1) tmax = colok ? tmax : -INFINITY;
    tmax = fmaxf(tmax, __shfl_xor(tmax, 16)); tmax = fmaxf(tmax, __shfl_xor(tmax, 32));
    const float mnew = fmaxf(st.m, tmax), muse = (mnew == -INFINITY) ? 0.f : mnew;
    const float alpha = ex2(st.m - muse);
    const float msub = (MODE == 1) ? (colok ? muse : INFINITY) : muse;
    float p[2][4]; float ps = 0.f;
#pragma unroll
    for (int tt = 0; tt < 2; ++tt)
#pragma unroll
        for (int r = 0; r < 4; ++r) { p[tt][r] = ex2(sv[tt][r] - msub); ps += p[tt][r]; }
    st.l = st.l * alpha + ps; st.m = mnew;
    const bf16x8 pf = pack_p(p);
#pragma unroll
    for (int dt = 0; dt < 4; ++dt) { st.o[dt] = st.o[dt] * alpha; st.o[dt] = mfma16(vf[dt], pf, st.o[dt]); }
}
template <int MODE, class MaskF>
DEV void attn_compute_fixed(const bf16x8 (&kf)[2][2], const bf16x8 (&vf)[4], const bf16x8 (&qf)[2], SmState& st, float mref, int lane, bool colok, MaskF mask) {
    const int g4 = lane >> 4;
    f32x4 s[2]; qk_tile(kf, qf, s);
    const float msub = (MODE == 1) ? (colok ? mref : INFINITY) : mref;
    float p[2][4]; float ps = 0.f;
#pragma unroll
    for (int tt = 0; tt < 2; ++tt)
#pragma unroll
        for (int r = 0; r < 4; ++r) { float x = s[tt][r] - msub; if (MODE == 2) x = mask(16 * tt + 4 * g4 + r) ? x : -INFINITY; p[tt][r] = ex2(x); ps += p[tt][r]; }
    st.l += ps;
    const bf16x8 pf = pack_p(p);
#pragma unroll
    for (int dt = 0; dt < 4; ++dt) st.o[dt] = mfma16(vf[dt], pf, st.o[dt]);
}
template <int MODE, class MaskF>
DEV void attn_max(const bf16x8 (&kf)[2][2], const bf16x8 (&qf)[2], float& mx, int lane, bool colok, MaskF mask) {
    const int g4 = lane >> 4;
    f32x4 s[2]; qk_tile(kf, qf, s);
    float tmax = -INFINITY;
#pragma unroll
    for (int tt = 0; tt < 2; ++tt)
#pragma unroll
        for (int r = 0; r < 4; ++r) { float x = s[tt][r]; if (MODE == 2) x = mask(16 * tt + 4 * g4 + r) ? x : -INFINITY; tmax = fmaxf(tmax, x); }
    if (MODE == 1) tmax = colok ? tmax : -INFINITY;
    mx = fmaxf(mx, tmax);
}
DEV float colmax_finish(float mx) { mx = fmaxf(mx, __shfl_xor(mx, 16)); mx = fmaxf(mx, __shfl_xor(mx, 32)); return mx == -INFINITY ? 0.f : mx; }
DEV float col_norm(const bf16x8 (&qf)[2]) {
    float s = 0.f;
#pragma unroll
    for (int ks = 0; ks < 2; ++ks) { const v4u w = __builtin_bit_cast(v4u, qf[ks]);
#pragma unroll
        for (int j = 0; j < 4; ++j) { const float a = bflo(w[j]), b = bfhi(w[j]); s += a * a + b * b; } }
    s += __shfl_xor(s, 16); s += __shfl_xor(s, 32);
    return sqrtf(s);
}
DEV float wave_max_uniform(float v) {
#pragma unroll
    for (int o = 1; o < 64; o <<= 1) v = fmaxf(v, __shfl_xor(v, o));
    return __builtin_bit_cast(float, __builtin_amdgcn_readfirstlane(__builtin_bit_cast(int, v)));
}
constexpr float FIXED_REF_MAX = 40.f;
DEV void kmax_phase(Frame& F, int l) {
    const int lane = F.lane; const int gw = F.vcu * NWAVES + F.wave, NGW = F.G * NWAVES;
    for (int item = gw; item < 2048; item += NGW) {
        const int br = item >> 10, bh = (item >> 7) & 7, key = (item & 127) * 64 + lane;
        const bf16* kp = wsp<bf16>(F, br ? WS_KW : WS_KS) + ((size_t)bh * T + key) * 64;
        float s = 0.f;
#pragma unroll
        for (int i = 0; i < 8; ++i) { const v4u w = *(const v4u*)(kp + i * 8);
#pragma unroll
            for (int j = 0; j < 4; ++j) { const float a = bflo(w[j]), b = bfhi(w[j]); s += a * a + b * b; } }
#pragma unroll
        for (int o = 1; o < 64; o <<= 1) s = fmaxf(s, __shfl_xor(s, o));
        if (lane == 0) __hip_atomic_fetch_max((unsigned*)F.ctl + CW_KMAX + l * 16 + br * 8 + bh, __builtin_bit_cast(unsigned, s), RLX_AGENT);
    }
}
struct NoMask { DEV bool operator()(int) const { return true; } };
template <int D, bool WITHV, class AddrF, class BodyF>
DEV void pipe_run(int n, int lane, AddrF addr, BodyF body) {
    if (n <= 0) return;
    bf16x8 kf[D][2][2], vf[D][4];
#pragma unroll
    for (int d = 0; d < D; ++d) { const bf16* kb; const bf16* vb; addr(d < n ? d : n - 1, kb, vb); load_k(kb, lane, kf[d]); if (WITHV) load_v(vb, lane, vf[d]); }
#pragma unroll 1
    for (int i = 0; i < n; i += D) {
#pragma unroll
        for (int d = 0; d < D; ++d) { const int s = i + d;
            if (s < n) body(s, kf[d], vf[d]);
            if (D > 1 || s + 1 < n) { const bf16* kb; const bf16* vb; addr(s + D < n ? s + D : n - 1, kb, vb); load_k(kb, lane, kf[d]); if (WITHV) load_v(vb, lane, vf[d]); } }
    }
}
template <class AddrF, class BodyF>
DEV void pipe_run_k2(int n, int lane, AddrF addr, BodyF body) {
    if (n <= 0) return;
    bf16x8 kf[2][2][2], vf[4];
    { const bf16* kb; const bf16* vb; addr(0, kb, vb); load_k(kb, lane, kf[0]); }
#pragma unroll 1
    for (int i = 0; i < n; i += 2) {
#pragma unroll
        for (int d = 0; d < 2; ++d) { const int s = i + d;
            { const bf16* kb; const bf16* vb; addr(s < n ? s : n - 1, kb, vb); load_v(vb, lane, vf); }
            { const bf16* kb; const bf16* vb; addr(s + 1 < n ? s + 1 : n - 1, kb, vb); load_k(kb, lane, kf[d ^ 1]); }
            if (s < n) body(s, kf[d], vf); }
    }
}
constexpr int PIPE_D = 2;

DEV void acc_add_packed(unsigned (&pk)[4][4][2], int ct, const f32x4 (&o)[4], float sc, bool first) {
#pragma unroll
    for (int dt = 0; dt < 4; ++dt) {
        f32x4 v = o[dt] * sc;
        if (!first) { v[0] += bflo(pk[ct][dt][0]); v[1] += bfhi(pk[ct][dt][0]); v[2] += bflo(pk[ct][dt][1]); v[3] += bfhi(pk[ct][dt][1]); }
        pk[ct][dt][0] = pk2(v[0], v[1]); pk[ct][dt][1] = pk2(v[2], v[3]);
    }
}
template <int VAR>
DEV void nsa_phase_t(Frame& F, int l) {
#define NSA_RELANE() int ln_ = lane; asm volatile("" : "+v"(ln_)); const int l16 = ln_ & 15, g4 = ln_ >> 4, tq = l16 >> 2, gh = l16 & 3; const size_t mrow0 = (size_t)b * T + t0 + tq; const int tl0 = t0 + tq; (void)l16; (void)g4; (void)gh; (void)mrow0; (void)tl0
    float* IMP = (float*)(F.ldsg + F.wave * NSA_LDS_WAVE);
    float* VALS = IMP + 2048; int* BL = (int*)(IMP + 2176); unsigned* SELB = (unsigned*)(IMP + 2304); float* GL = IMP + 2432;
    const bf16* Q = wsp<bf16>(F, WS_Q);
    const bf16* KCC = wsp<bf16>(F, WS_KCC); const bf16* VCT = wsp<bf16>(F, WS_VCT);
    const bf16* KS = wsp<bf16>(F, WS_KS); const bf16* VST = wsp<bf16>(F, WS_VST);
    const bf16* KW = wsp<bf16>(F, WS_KW); const bf16* VWT = wsp<bf16>(F, WS_VWT);
    bf16* CAT = wsp<bf16>(F, WS_CAT);
    const int gw = F.vcu * NWAVES + F.wave, NGW = F.G * NWAVES;
    const bool xmap = (F.G == 256);
#pragma unroll 1
    for (int task = gw; task < 4096; task += NGW) {
        unsigned zl_ = 0u; asm volatile("" : "+v"(zl_)); const int lane = (int)__builtin_amdgcn_mbcnt_hi(~0u, __builtin_amdgcn_mbcnt_lo(~0u, zl_));
        const int bh = xmap ? (gw >> 8) : (task & 7), idx = xmap ? ((task >> 11) ? 511 - (gw & 255) : (gw & 255)) : (task >> 3);
        const int t0 = idx * 16, b = bh >> 1, hkv = bh & 1, cur = t0 >> 6;
        bf16x8 qf[4][2];
        unsigned opk[4][4][2];
        SmState st[4];
        float qnmax = 0.f;
        { NSA_RELANE();
#pragma unroll
        for (int ct = 0; ct < 4; ++ct)
#pragma unroll
            for (int ks = 0; ks < 2; ++ks) qf[ct][ks] = *(const bf16x8*)(Q + (mrow0 + 4 * ct) * 512 + hkv * 256 + gh * 64 + ks * 32 + g4 * 8);
        { NSA_RELANE();
          f32x4 ga[1]; ga[0] = (f32x4){0.f, 0.f, 0.f, 0.f};
          { const bf16* ap = wsp<bf16>(F, WS_HB) + ((size_t)b * T + t0 + l16) * 1024 + g4 * 8; const bf16* bp = wsp<bf16>(F, WS_WG) + (size_t)((l * 2 + hkv) * 16 + l16) * 1024 + g4 * 8;
#pragma unroll 1
            for (int k0 = 0; k0 < 1024; k0 += 256) {
                bf16x8 av[8], bv[8];
#pragma unroll
                for (int i = 0; i < 8; ++i) { av[i] = *(const bf16x8*)(ap + k0 + 32 * i); bv[i] = *(const bf16x8*)(bp + k0 + 32 * i); }
#pragma unroll
                for (int i = 0; i < 8; ++i) ga[0] = mfma16(av[i], bv[i], ga[0]);
            } }
          const float rs = (ln_ < 16) ? row_rstd_full(wsp<float>(F, WS_SSQ), b * T + t0 + ln_) : 0.f;
#pragma unroll
          for (int r = 0; r < 4; ++r) GL[(g4 * 4 + r) * 16 + l16] = sigmoidf_(ga[0][r] * __shfl(rs, g4 * 4 + r));
        }
        const int ngc = (t0 + 15 >= 31) ? (((t0 + 15 - 31) >> 4) >> 5) + 1 : 0;
        const bf16* kcb = KCC + (size_t)bh * 512 * 64; const bf16* vcb = VCT + (size_t)bh * 16 * 64 * 32;
        float cm[4], cl[4];
#pragma unroll
        for (int ct = 0; ct < 4; ++ct) { cm[ct] = -INFINITY; cl[ct] = 0.f; }
        pipe_run<1, false>(ngc, ln_, [&](int s, const bf16*& kb, const bf16*& vb) { kb = kcb + (size_t)s * 32 * 64; vb = vcb; },
            [&](int kg, const bf16x8 (&kf)[2][2], const bf16x8 (&)[4]) {
#pragma unroll
                for (int ct = 0; ct < 4; ++ct) {
                    const int tl = tl0 + 4 * ct;
                    f32x4 s[2]; qk_tile(kf, qf[ct], s);
                    float sv[2][4]; float tmax = -INFINITY;
#pragma unroll
                    for (int tt = 0; tt < 2; ++tt)
#pragma unroll
                        for (int r = 0; r < 4; ++r) { const int c = kg * 32 + 16 * tt + 4 * g4 + r; sv[tt][r] = (16 * c + 31 <= tl) ? s[tt][r] : -INFINITY; tmax = fmaxf(tmax, sv[tt][r]); }
                    tmax = fmaxf(tmax, __shfl_xor(tmax, 16)); tmax = fmaxf(tmax, __shfl_xor(tmax, 32));
                    const float mnew = fmaxf(cm[ct], tmax), muse = (mnew == -INFINITY) ? 0.f : mnew;
                    float ps = 0.f;
#pragma unroll
                    for (int tt = 0; tt < 2; ++tt)
#pragma unroll
                        for (int r = 0; r < 4; ++r) ps += ex2(sv[tt][r] - muse);
                    cl[ct] = cl[ct] * ex2(cm[ct] - muse) + ps; cm[ct] = mnew;
                }
            });
        {
            float cmu[4], cinv[4], carry[4];
#pragma unroll
            for (int ct = 0; ct < 4; ++ct) { float l = cl[ct]; l += __shfl_xor(l, 16); l += __shfl_xor(l, 32);
                cmu[ct] = (cm[ct] == -INFINITY) ? 0.f : cm[ct]; cinv[ct] = l > 0.f ? 1.0f / l : 0.f; carry[ct] = 0.f; sm_reset(st[ct]); }
            pipe_run<1, true>(ngc, ln_, [&](int s, const bf16*& kb, const bf16*& vb) { kb = kcb + (size_t)s * 32 * 64; vb = vcb + (size_t)s * 64 * 32; },
                [&](int kg, const bf16x8 (&kf)[2][2], const bf16x8 (&vf)[4]) {
#pragma unroll
                    for (int ct = 0; ct < 4; ++ct) {
                        const int tl = tl0 + 4 * ct;
                        f32x4 s[2]; qk_tile(kf, qf[ct], s);
                        float p[2][4];
#pragma unroll
                        for (int tt = 0; tt < 2; ++tt) {
#pragma unroll
                            for (int r = 0; r < 4; ++r) { const int c = kg * 32 + 16 * tt + 4 * g4 + r; p[tt][r] = (16 * c + 31 <= tl) ? ex2(s[tt][r] - cmu[ct]) * cinv[ct] : 0.f; }
                            const float hb = 0.5f * p[tt][3];
                            const float bsh = __shfl(hb, (ln_ + 48) & 63);
                            float v = ((p[tt][0] + p[tt][1]) + (p[tt][2] + hb)) + ((g4 == 0) ? carry[ct] : bsh);
                            carry[ct] = bsh;
                            v += __shfl_xor(v, 1); v += __shfl_xor(v, 2);
                            if (gh == 0) IMP[(4 * ct + tq) * 128 + kg * 8 + 4 * tt + g4] = v;
                        }
                        const bf16x8 pf = pack_p(p);
#pragma unroll
                        for (int dt = 0; dt < 4; ++dt) st[ct].o[dt] = mfma16(vf[dt], pf, st[ct].o[dt]);
                    }
                });
#pragma unroll
            for (int ct = 0; ct < 4; ++ct) acc_add_packed(opk, ct, st[ct].o, GL[(4 * ct + tq) * 16 + gh * 3 + 0], true);
        }
        }
        LDS_WAIT();
        unsigned sb0 = 0u, sb1 = 0u;
        if (cur < 16) { sb0 = (lane <= cur) ? 0xffffu : 0u; }
        else {
            const unsigned long long below = (1ull << lane) - 1ull;
#pragma unroll 1
            for (int q = 0; q < 16; ++q) {
                unsigned k0, k1;
                { const int j = lane; const float v = (j == 0 || j == cur || j == cur - 1) ? 1e6f : IMP[q * 128 + j]; k0 = (j > cur) ? 0u : __builtin_bit_cast(unsigned, v) + 1u; }
                { const int j = lane + 64; const float v = (j == cur || j == cur - 1) ? 1e6f : IMP[q * 128 + j]; k1 = (j > cur) ? 0u : __builtin_bit_cast(unsigned, v) + 1u; }
                unsigned lo = 0u, hi = 0xffffffffu;
                while (hi - lo > 1u) { const unsigned mid = lo + ((hi - lo) >> 1);
                    const int c = __builtin_popcountll(__ballot(k0 >= mid)) + __builtin_popcountll(__ballot(k1 >= mid));
                    if (c >= 16) lo = mid; else hi = mid; }
                const unsigned long long g0 = __ballot(k0 > lo), g1 = __ballot(k1 > lo), e0 = __ballot(k0 == lo), e1 = __ballot(k1 == lo);
                const int need = 16 - __builtin_popcountll(g0) - __builtin_popcountll(g1);
                const bool s0 = (k0 > lo) || (k0 == lo && __builtin_popcountll(e0 & below) < need);
                const bool s1 = (k1 > lo) || (k1 == lo && __builtin_popcountll(e0) + __builtin_popcountll(e1 & below) < need);
                sb0 |= (s0 ? 1u : 0u) << q; sb1 |= (s1 ? 1u : 0u) << q;
            }
        }
        SELB[lane] = sb0; SELB[lane + 64] = sb1;
        LDS_WAIT();
#define NSA_PARK() do { _Pragma("unroll") for (int i_ = 0; i_ < 8; ++i_) { v4u w_; w_.x = opk[i_ >> 1][(i_ & 1) * 2][0]; w_.y = opk[i_ >> 1][(i_ & 1) * 2][1]; w_.z = opk[i_ >> 1][(i_ & 1) * 2 + 1][0]; w_.w = opk[i_ >> 1][(i_ & 1) * 2 + 1][1]; ((v4u*)IMP)[i_ * 64 + lane] = w_; } } while (0)
#define NSA_UNPARK() do { _Pragma("unroll") for (int i_ = 0; i_ < 8; ++i_) { const v4u w_ = ((const v4u*)IMP)[i_ * 64 + lane]; opk[i_ >> 1][(i_ & 1) * 2][0] = w_.x; opk[i_ >> 1][(i_ & 1) * 2][1] = w_.y; opk[i_ >> 1][(i_ & 1) * 2 + 1][0] = w_.z; opk[i_ >> 1][(i_ & 1) * 2 + 1][1] = w_.w; } } while (0)
        NSA_PARK();
        { NSA_RELANE();
#pragma unroll
        for (int ct = 0; ct < 4; ++ct) {
            const float* rp = wsp<float>(F, WS_ROPE) + ((size_t)(tl0 + 4 * ct) * 32 + g4 * 8) * 2;
            const v4u a = __builtin_bit_cast(v4u, qf[ct][0]), b2 = __builtin_bit_cast(v4u, qf[ct][1]); v4u ra, rb;
#pragma unroll
            for (int jj = 0; jj < 4; ++jj) { const f32x4 cs = *(const f32x4*)(rp + 4 * jj);
                const float x1a = bflo(a[jj]), x1b = bfhi(a[jj]), x2a = bflo(b2[jj]), x2b = bfhi(b2[jj]);
                ra[jj] = pk2(x1a * cs[0] - x2a * cs[1], x1b * cs[2] - x2b * cs[3]);
                rb[jj] = pk2(x2a * cs[0] + x1a * cs[1], x2b * cs[2] + x1b * cs[3]); }
            qf[ct][0] = __builtin_bit_cast(bf16x8, ra); qf[ct][1] = __builtin_bit_cast(bf16x8, rb);
        }
        {
            const unsigned long long ulo = __ballot(sb0 != 0u), uhi = __ballot(sb1 != 0u);
            const unsigned long long below = (1ull << ln_) - 1ull;
            const int nlo = __builtin_popcountll(ulo), nblk = nlo + __builtin_popcountll(uhi);
            if (sb0 != 0u) BL[__builtin_popcountll(ulo & below)] = ln_;
            if (sb1 != 0u) BL[nlo + __builtin_popcountll(uhi & below)] = ln_ + 64;
            LDS_WAIT();
#pragma unroll
            for (int ct = 0; ct < 4; ++ct) sm_reset(st[ct]);
            const bf16* kb0 = KS + (size_t)bh * T * 64; const bf16* vb0 = VST + (size_t)bh * 256 * 64 * 32;
            float mr; bool fixed;
            { const float kmx = sqrtf(__builtin_bit_cast(float, __hip_atomic_load((const unsigned*)F.ctl + CW_KMAX + l * 16 + bh, RLX_AGENT))); float mm = 0.f;
#pragma unroll
              for (int ct = 0; ct < 4; ++ct) mm = fmaxf(mm, col_norm(qf[ct]));
              qnmax = wave_max_uniform(mm); mr = qnmax * kmx * 1.002f + 1e-3f;
              fixed = mr < FIXED_REF_MAX; }
            auto addr_sel = [&](int s, const bf16*& kb, const bf16*& vb) { const int g32 = BL[s >> 1] * 2 + (s & 1); kb = kb0 + (size_t)g32 * 32 * 64; vb = vb0 + (size_t)g32 * 64 * 32; };
            asm volatile("" ::: "memory");
            if (!fixed) {
                float mx[4] = {-INFINITY, -INFINITY, -INFINITY, -INFINITY};
                pipe_run<1, false>(2 * nblk, ln_, addr_sel,
                    [&](int s, const bf16x8 (&kf)[2][2], const bf16x8 (&)[4]) {
                        const int j = BL[s >> 1], key0 = j * 64 + (s & 1) * 32;
                        const unsigned tm = (unsigned)__builtin_amdgcn_readfirstlane((int)SELB[j]);
#pragma unroll
                        for (int ct = 0; ct < 4; ++ct) { const unsigned tmk = (tm >> (4 * ct)) & 0xFu;
                            if (tmk) { const bool colok = (tmk >> tq) & 1u; const int tl = tl0 + 4 * ct;
                                if (j == cur) attn_max<2>(kf, qf[ct], mx[ct], ln_, true, [&](int kk) { return colok && (key0 + kk <= tl); });
                                else attn_max<1>(kf, qf[ct], mx[ct], ln_, colok, NoMask()); } }
                    });
                mr = wave_max_uniform(fmaxf(fmaxf(mx[0], mx[1]), fmaxf(mx[2], mx[3]))); if (mr == -INFINITY) mr = 0.f;
            }
            asm volatile("" ::: "memory");
            pipe_run_k2(2 * nblk, ln_, addr_sel,
                [&](int s, const bf16x8 (&kf)[2][2], const bf16x8 (&vf)[4]) {
                    const int j = BL[s >> 1], key0 = j * 64 + (s & 1) * 32;
                    const unsigned tm = (unsigned)__builtin_amdgcn_readfirstlane((int)SELB[j]);
#pragma unroll
                    for (int ct = 0; ct < 4; ++ct) {
                        const unsigned tmk = (tm >> (4 * ct)) & 0xFu;
                        if (tmk) {
                            const bool colok = (tmk >> tq) & 1u; const int tl = tl0 + 4 * ct;
                            if (j == cur) attn_compute_fixed<2>(kf, vf, qf[ct], st[ct], mr, ln_, true, [&](int kk) { return colok && (key0 + kk <= tl); });
                            else attn_compute_fixed<1>(kf, vf, qf[ct], st[ct], mr, ln_, colok, NoMask());
                        }
                        __builtin_amdgcn_sched_barrier(0);
                    }
                });
            LDS_WAIT();
            NSA_UNPARK();
#pragma unroll
            for (int ct = 0; ct < 4; ++ct) { const float ls = sm_lsum(st[ct]); const float gs = GL[(4 * ct + tq) * 16 + gh * 3 + 1];
                acc_add_packed(opk, ct, st[ct].o, ls > 0.f ? gs / ls : 0.f, false); }
            NSA_PARK();
        }
        }
        { NSA_RELANE();
#pragma unroll
            for (int ct = 0; ct < 4; ++ct) sm_reset(st[ct]);
            const bf16* kb0 = (VAR == 3 ? KS : KW) + (size_t)bh * T * 64; const bf16* vb0 = (VAR == 3 ? VST : VWT) + (size_t)bh * 256 * 64 * 32;
            const int glo = (t0 - 511 > 0 ? t0 - 511 : 0) >> 5, ghi = (t0 + 15) >> 5;
            float mr; bool fixed;
            { const float kmx = sqrtf(__builtin_bit_cast(float, __hip_atomic_load((const unsigned*)F.ctl + CW_KMAX + l * 16 + 8 + bh, RLX_AGENT)));
              mr = qnmax * kmx * 1.002f + 1e-3f;
              fixed = mr < FIXED_REF_MAX; }
            auto addr_win = [&](int s, const bf16*& kb, const bf16*& vb) { kb = kb0 + (size_t)(glo + s) * 32 * 64; vb = vb0 + (size_t)(glo + s) * 64 * 32; };
            asm volatile("" ::: "memory");
            if (!fixed) {
                float mx[4] = {-INFINITY, -INFINITY, -INFINITY, -INFINITY};
                pipe_run<1, false>(ghi - glo + 1, ln_, addr_win,
                    [&](int s, const bf16x8 (&kf)[2][2], const bf16x8 (&)[4]) {
                        const int key0 = (glo + s) * 32;
#pragma unroll
                        for (int ct = 0; ct < 4; ++ct) { const int tl = tl0 + 4 * ct;
                            attn_max<2>(kf, qf[ct], mx[ct], ln_, true, [&](int kk) { const int kp = key0 + kk; return kp <= tl && kp + 512 > tl; }); }
                    });
                mr = wave_max_uniform(fmaxf(fmaxf(mx[0], mx[1]), fmaxf(mx[2], mx[3]))); if (mr == -INFINITY) mr = 0.f;
            }
            asm volatile("" ::: "memory");
            pipe_run_k2(ghi - glo + 1, ln_, addr_win,
                [&](int s, const bf16x8 (&kf)[2][2], const bf16x8 (&vf)[4]) {
                    const int key0 = (glo + s) * 32;
#pragma unroll
                    for (int ct = 0; ct < 4; ++ct) {
                        const int tlo = t0 + 4 * ct, thi = tlo + 3, tl = tl0 + 4 * ct;
                        if (key0 > thi || key0 + 31 + 512 <= tlo) continue;
                        if (key0 + 512 > thi && key0 + 31 <= tlo) attn_compute_fixed<0>(kf, vf, qf[ct], st[ct], mr, ln_, true, NoMask());
                        else attn_compute_fixed<2>(kf, vf, qf[ct], st[ct], mr, ln_, true, [&](int kk) { const int kp = key0 + kk; return kp <= tl && kp + 512 > tl; });
                        __builtin_amdgcn_sched_barrier(0);
                    }
                });
            NSA_UNPARK();
#pragma unroll
            for (int ct = 0; ct < 4; ++ct) { const float ls = sm_lsum(st[ct]); const float gwn = GL[(4 * ct + tq) * 16 + gh * 3 + 2];
                acc_add_packed(opk, ct, st[ct].o, ls > 0.f ? gwn / ls : 0.f, false); }
        }
        { NSA_RELANE();
#pragma unroll
        for (int ct = 0; ct < 4; ++ct)
#pragma unroll
            for (int dt = 0; dt < 4; ++dt) { v2u w; w.x = opk[ct][dt][0]; w.y = opk[ct][dt][1];
                if (VAR == 0 || w.x == 0x7fc17fc1u) *(v2u*)(CAT + (mrow0 + 4 * ct) * 1024 + hkv * 256 + gh * 64 + dt * 16 + g4 * 4) = w; }
        }
        LDS_WAIT();
        if (VAR == 0 && xmap) convert_experts(F, l, (bf16*)IMP, task >> 11);
    }
#undef NSA_RELANE
#undef NSA_PARK
#undef NSA_UNPARK
}

DEV void nsa_phase(Frame& F, int l) { nsa_phase_t<0>(F, l); }

DEV void cross_phase(Frame& F, int l) {
    const int lane = F.lane, l16 = lane & 15, g4 = lane >> 4;
    const bf16* XQ = wsp<bf16>(F, WS_XQ); bf16* XO = wsp<bf16>(F, WS_XO);
    const int gw = F.vcu * NWAVES + F.wave, NGW = F.G * NWAVES;
#pragma unroll 1
    for (int task = gw; task < 8192; task += NGW) {
        const int head = task & 3, m0 = (task >> 2) * 16, b = m0 >> 13;
        bf16x8 qf[2];
#pragma unroll
        for (int ks = 0; ks < 2; ++ks) qf[ks] = *(const bf16x8*)(XQ + (size_t)(m0 + l16) * 256 + head * 64 + ks * 32 + g4 * 8);
        const bf16* kb0 = wsp<bf16>(F, WS_MK) + (size_t)((l * 4 + b) * 4 + head) * 256 * 64;
        const bf16* vb0 = wsp<bf16>(F, WS_MVT) + (size_t)((l * 4 + b) * 4 + head) * 8 * 64 * 32;
        SmState st; sm_reset(st);
        pipe_run<PIPE_D, true>(8, lane, [&](int s, const bf16*& kb, const bf16*& vb) { kb = kb0 + (size_t)s * 32 * 64; vb = vb0 + (size_t)s * 64 * 32; },
            [&](int, const bf16x8 (&kf)[2][2], const bf16x8 (&vf)[4]) { attn_compute<0>(kf, vf, qf, st, lane, true, NoMask()); });
        const float inv = 1.0f / sm_lsum(st);
#pragma unroll
        for (int dt = 0; dt < 4; ++dt) { const f32x4 o = st.o[dt] * inv; v2u w; w.x = pk2(o[0], o[1]); w.y = pk2(o[2], o[3]);
            *(v2u*)(XO + (size_t)(m0 + l16) * 256 + head * 64 + dt * 16 + g4 * 4) = w; }
    }
}

DEV void router_phase(Frame& F, int l, int probe = 0) {
    const int lane = F.lane, l16 = lane & 15, g4 = lane >> 4;
    float* LG = (float*)F.ldsg + F.wave * 768;
    const bf16* HB = wsp<bf16>(F, WS_HB); const float* SSQ = wsp<float>(F, WS_SSQ);
    const bf16* WR = wsp<bf16>(F, WS_WR) + (size_t)l * 96 * 1024;
    int* TOKE = wsp<int>(F, probe ? WS_PROBE : WS_TOKE); float* TOKG = wsp<float>(F, probe ? WS_PROBE + MiB : WS_TOKG); int* TOKP = wsp<int>(F, probe ? WS_PROBE + 2 * MiB : WS_TOKP);
    unsigned* CNT = (unsigned*)F.ctl + CW_CNT + l * 32 + (probe ? 64 : 0);
    const float* bg = inp(14) + l * 4; const float* be = inp(16) + l * 32;
    unsigned* HIST = (unsigned*)((float*)F.ldsg + 8 * 768);
#pragma unroll 1
    for (int tb = F.vcu * NWAVES; tb < NTOK / 16; tb += F.G * NWAVES) {
        const int task = tb + F.wave; const bool live = task < NTOK / 16;
        const int m0 = (live ? task : tb) * 16;
        if (F.tid < 64) HIST[F.tid] = 0u;
        f32x4 acc[3];
        {
            const bf16* ap = HB + (size_t)(m0 + l16) * 1024 + g4 * 8; const bf16* bp = WR + (size_t)l16 * 1024 + g4 * 8;
#pragma unroll
            for (int n = 0; n < 3; ++n) acc[n] = (f32x4){0.f, 0.f, 0.f, 0.f};
#pragma unroll 4
            for (int k = 0; k < 1024; k += 32) {
                const bf16x8 a = *(const bf16x8*)(ap + k);
#pragma unroll
                for (int n = 0; n < 3; ++n) { const bf16x8 bh = *(const bf16x8*)(bp + (size_t)n * 16 * 1024 + k), bl = *(const bf16x8*)(bp + (size_t)(48 + n * 16) * 1024 + k);
                    acc[n] = mfma16(a, bh, acc[n]); acc[n] = mfma16(a, bl, acc[n]); }
            }
        }
#pragma unroll
        for (int nt = 0; nt < 3; ++nt)
#pragma unroll
            for (int r = 0; r < 4; ++r) LG[(g4 * 4 + r) * 48 + nt * 16 + l16] = acc[nt][r];
        LDS_WAIT();
        int id1 = 0, id2 = 0;
        if (lane < 16) {
            const int m = m0 + lane; const float rstd = row_rstd_full(SSQ, m); const float* lg = LG + lane * 48;
            float g[4];
#pragma unroll
            for (int j = 0; j < 4; ++j) g[j] = lg[j] * rstd + bg[j];
            float gmax = g[0]; int grp = 0;
#pragma unroll
            for (int j = 1; j < 4; ++j) if (g[j] > gmax) { gmax = g[j]; grp = j; }
            float den = 0.f;
#pragma unroll
            for (int j = 0; j < 4; ++j) den += expf(g[j] - gmax);
            const float psel = 1.0f / den;
            float e1 = -INFINITY, e2 = -INFINITY; int i1 = 0, i2 = 0;
            for (int j = 0; j < 8; ++j) { const float v = lg[4 + grp * 8 + j] * rstd + be[grp * 8 + j];
                if (v > e1) { e2 = e1; i2 = i1; e1 = v; i1 = j; } else if (v > e2) { e2 = v; i2 = j; } }
            const float x = expf(e2 - e1), w1 = 1.0f / (1.0f + x), w2 = x * w1;
            id1 = grp * 8 + i1; id2 = grp * 8 + i2;
            if (live) { TOKE[m * 2] = id1; TOKE[m * 2 + 1] = id2; TOKG[m * 2] = psel * w1; TOKG[m * 2 + 1] = psel * w2; }
        }
        __syncthreads();
        unsigned lp1 = 0u, lp2 = 0u;
        if (lane < 16 && live) { lp1 = __hip_atomic_fetch_add(HIST + id1, 1u, __ATOMIC_RELAXED, __HIP_MEMORY_SCOPE_WORKGROUP); lp2 = __hip_atomic_fetch_add(HIST + id2, 1u, __ATOMIC_RELAXED, __HIP_MEMORY_SCOPE_WORKGROUP); }
        __syncthreads();
        if (F.tid < 32) { const unsigned c = HIST[F.tid]; HIST[32 + F.tid] = c ? __hip_atomic_fetch_add(CNT + F.tid, c, RLX_AGENT) : 0u; }
        __syncthreads();
        if (lane < 16 && live) { const int m = m0 + lane; TOKP[m * 2] = (int)(HIST[32 + id1] + lp1); TOKP[m * 2 + 1] = (int)(HIST[32 + id2] + lp2); }
        __syncthreads();
    }
}
DEV int moe_tables(Frame& F, int l) {
    int* tab = (int*)(F.ldsg + TAB_OFF);
    if (F.tid == 0) {
        const unsigned* CNT = (const unsigned*)F.ctl + CW_CNT + l * 32; int off = 0;
#pragma unroll 1
        for (int e = 0; e < 32; ++e) { tab[e] = off; const int c = (int)__hip_atomic_load(CNT + e, RLX_AGENT); const int nt = (c + 255) >> 8;
            for (int i = 0; i < nt; ++i) tab[40 + (off >> 8) + i] = e;
            off += nt << 8; }
        tab[32] = off;
    }
    __syncthreads();
    return tab[32];
}
DEV void gather_phase(Frame& F, int l) {
    (void)moe_tables(F, l);
    const int* tab = (const int*)(F.ldsg + TAB_OFF);
    const int lane = F.lane; const int gw = F.vcu * NWAVES + F.wave, NGW = F.G * NWAVES;
    const bf16* HB = wsp<bf16>(F, WS_HB); const float* SSQ = wsp<float>(F, WS_SSQ); bf16* XS = wsp<bf16>(F, WS_XS);
    const int* TOKE = wsp<int>(F, WS_TOKE); const float* TOKG = wsp<float>(F, WS_TOKG); const int* TOKP = wsp<int>(F, WS_TOKP); int* TOKS = wsp<int>(F, WS_TOKS);
    float* SRSTD = wsp<float>(F, WS_SRSTD); float* SGATE = wsp<float>(F, WS_SGATE);
    const unsigned* CNT = (const unsigned*)F.ctl + CW_CNT + l * 32;
#pragma unroll 1
    for (int m0 = gw; m0 < NTOK; m0 += 4 * NGW) {
        int s0[4], s1[4]; float g0[4], g1[4], rs[4]; v4u a[4], c[4];
#pragma unroll
        for (int k = 0; k < 4; ++k) { const int m = m0 + k * NGW; const bool ok = m < NTOK; const int mm = ok ? m : m0;
            const int e0 = TOKE[mm * 2], e1 = TOKE[mm * 2 + 1], p0 = TOKP[mm * 2], p1 = TOKP[mm * 2 + 1];
            g0[k] = TOKG[mm * 2]; g1[k] = TOKG[mm * 2 + 1];
            a[k] = *(const v4u*)(HB + (size_t)mm * 1024 + lane * 8); c[k] = *(const v4u*)(HB + (size_t)mm * 1024 + 512 + lane * 8);
            rs[k] = row_rstd_full(SSQ, mm);
            s0[k] = tab[e0] + p0; s1[k] = tab[e1] + p1; }
#pragma unroll
        for (int k = 0; k < 4; ++k) { const int m = m0 + k * NGW;
            if (m < NTOK) {
                *(v4u*)(XS + (size_t)s0[k] * 1024 + lane * 8) = a[k]; *(v4u*)(XS + (size_t)s0[k] * 1024 + 512 + lane * 8) = c[k];
                *(v4u*)(XS + (size_t)s1[k] * 1024 + lane * 8) = a[k]; *(v4u*)(XS + (size_t)s1[k] * 1024 + 512 + lane * 8) = c[k];
                if (lane == 0) { SRSTD[s0[k]] = rs[k]; SRSTD[s1[k]] = rs[k]; SGATE[s0[k]] = g0[k]; SGATE[s1[k]] = g1[k]; TOKS[m * 2] = s0[k]; TOKS[m * 2 + 1] = s1[k]; } } }
    }
#pragma unroll 1
    for (int e = 0; e < 32; ++e) {
        const int c = (int)__hip_atomic_load(CNT + e, RLX_AGENT), base = tab[e], end = (e == 31 ? tab[32] : tab[e + 1]);
        for (int r = base + c + gw; r < end; r += NGW) {
            *(v4u*)(XS + (size_t)r * 1024 + lane * 8) = (v4u){0u, 0u, 0u, 0u}; *(v4u*)(XS + (size_t)r * 1024 + 512 + lane * 8) = (v4u){0u, 0u, 0u, 0u};
            if (lane == 0) { SRSTD[r] = 0.f; SGATE[r] = 0.f; }
        }
    }
}
DEV void combine_phase(Frame& F, int l, int probe = 0) {
    const int lane = F.lane; const int gw = F.vcu * NWAVES + F.wave, NGW = F.G * NWAVES;
    float* Ho = probe ? wsp<float>(F, WS_PROBE) : (float*)(GAS float*)F.out; const bf16* HBi = wsp<bf16>(F, WS_HB); bf16* HB = wsp<bf16>(F, probe ? WS_PROBE + 128 * MiB : WS_HB); float* SSQ = wsp<float>(F, probe ? WS_PROBE + 192 * MiB : WS_SSQ); const bf16* YS = wsp<bf16>(F, WS_YS); const int* TOKS = wsp<int>(F, WS_TOKS);
    const float* gf = inp(23);
#pragma unroll 1
    for (int m0 = gw; m0 < NTOK; m0 += 2 * NGW) {
        f32x4 v[2][4]; float ssum[2];
        int sl[2][2];
#pragma unroll
        for (int k = 0; k < 2; ++k) { const int m = (m0 + k * NGW < NTOK) ? m0 + k * NGW : m0; sl[k][0] = TOKS[m * 2]; sl[k][1] = TOKS[m * 2 + 1]; }
        v2u h[2][4]; v2u ya[2][4], yb[2][4];
#pragma unroll
        for (int k = 0; k < 2; ++k) { const int m = (m0 + k * NGW < NTOK) ? m0 + k * NGW : m0;
#pragma unroll
            for (int j = 0; j < 4; ++j) { const int c = lane * 4 + 256 * j;
                h[k][j] = *(const v2u*)(HBi + (size_t)m * 1024 + c);
                ya[k][j] = *(const v2u*)(YS + (size_t)sl[k][0] * 1024 + c); yb[k][j] = *(const v2u*)(YS + (size_t)sl[k][1] * 1024 + c); } }
#pragma unroll
        for (int k = 0; k < 2; ++k) { float ss = 0.f;
#pragma unroll
            for (int j = 0; j < 4; ++j) { const v2u a = ya[k][j], bq = yb[k][j]; const f32x4 hh = (f32x4){bflo(h[k][j].x), bfhi(h[k][j].x), bflo(h[k][j].y), bfhi(h[k][j].y)};
                f32x4 r; r[0] = hh[0] + (bflo(a.x) + bflo(bq.x)); r[1] = hh[1] + (bfhi(a.x) + bfhi(bq.x)); r[2] = hh[2] + (bflo(a.y) + bflo(bq.y)); r[3] = hh[3] + (bfhi(a.y) + bfhi(bq.y));
                v[k][j] = r; ss += (r[0] * r[0] + r[1] * r[1]) + (r[2] * r[2] + r[3] * r[3]); }
            ssum[k] = wave_sum(ss); }
#pragma unroll
        for (int k = 0; k < 2; ++k) { const int m = m0 + k * NGW;
            if (m < NTOK) {
                if (l == DEPTH - 1) {
                    const float rstd = 1.0f / sqrtf(ssum[k] * (1.0f / 1024.0f) + RMS_EPS);
#pragma unroll
                    for (int j = 0; j < 4; ++j) { const int c = lane * 4 + 256 * j; const f32x4 g = *(const f32x4*)(gf + c); *(f32x4*)(Ho + (size_t)m * 1024 + c) = v[k][j] * rstd * g; }
                } else {
#pragma unroll
                    for (int j = 0; j < 4; ++j) { const int c = lane * 4 + 256 * j;
                        v2u w; w.x = pk2(v[k][j][0], v[k][j][1]); w.y = pk2(v[k][j][2], v[k][j][3]); *(v2u*)(HB + (size_t)m * 1024 + c) = w; }
                    if (lane < 16) SSQ[(size_t)m * 16 + lane] = lane == 0 ? ssum[k] : 0.f;
                } } }
    }
}
#ifndef MK_ONE_LAUNCH
#define MK_ONE_LAUNCH 1
#endif
constexpr int NPH_LAYER = 13, NPHASES = 1 + DEPTH * NPH_LAYER;
struct Args { const float* in[24]; float* out; unsigned char* ws; int ph_lo, ph_hi; };
static_assert(sizeof(Args) == 24 * 8 + 8 + 8 + 8, "Args has no padding");

__global__ void __launch_bounds__(NWAVES * 64, 2) hymba_fwd(Args args) {
    extern __shared__ __attribute__((aligned(16))) unsigned char lds[];
    Frame F;
    F.lds = (LAS unsigned char*)lds; F.ldsg = lds;
    F.MISC = (volatile LAS unsigned*)(F.lds + MISC_OFF);
    F.tid = threadIdx.x; F.lane = F.tid & 63; F.wave = __builtin_amdgcn_readfirstlane(F.tid >> 6);
    F.G = gridDim.x; { const int bx = blockIdx.x; F.vcu = (F.G % 8 == 0) ? (bx % 8) * (F.G / 8) + bx / 8 : bx; }
    F.ws = args.ws; F.ctl = (gu32*)(args.ws + WS_CTL); F.out = args.out;
    if (F.tid < 64) ((LAS unsigned*)(F.lds + MISC_OFF))[F.tid] = 0u;
    __syncthreads();
    int wave0 = F.wave;
    const int lo = args.ph_lo, hi = args.ph_hi;
    XcdBarrier bar; bar.bar = (unsigned*)(F.ctl + CW_BAR); bar.x = 0; bar.st = nullptr;
    if (hi - lo > 1) bar = xcd_barrier_post((unsigned*)(F.ctl + CW_BAR), F.MISC + 8);
#ifndef PHMASK
#define PHMASK 0xFFFF
#endif
#define IN(k) (lo <= (k) && (k) < hi)
#define EN(j) ((PHMASK >> (j)) & 1)
#define RELAUNDER() do { asm volatile("" : "+s"(wave0)); unsigned z_ = 0u; asm volatile("" : "+v"(z_)); int t_ = wave0 * 64 + (int)__builtin_amdgcn_mbcnt_hi(~0u, __builtin_amdgcn_mbcnt_lo(~0u, z_)); F.tid = t_; F.lane = t_ & 63; F.wave = wave0; \
    size_t zo_ = 0; asm volatile("" : "+s"(zo_), "+s"(F.vcu), "+s"(F.G)); F.ws = args.ws + zo_; F.out = args.out + zo_; F.ctl = (gu32*)(F.ws + WS_CTL); } while (0)
#ifndef NSA_VAR
#define NSA_VAR 0
#endif
#ifndef BAR2X
#define BAR2X 0
#endif
#ifndef DUPMASK
#define DUPMASK 0
#endif
#define DUP(j) ((DUPMASK >> (j)) & 1)
#ifndef STAG_J0
#define STAG_J0 0
#endif
#ifndef STAG_MOE
#define STAG_MOE 0
#endif
#define STAGGER(ticks) do { if ((ticks) > 0 && (F.vcu & 1)) { const unsigned long long t0_ = __builtin_amdgcn_s_memrealtime(); while (__builtin_amdgcn_s_memrealtime() - t0_ < (unsigned long long)(ticks)) __builtin_amdgcn_s_sleep(32); } } while (0)
#define SEAM(k) do { if (IN(k) && IN((k) + 1)) { XcdBarrier b_ = bar; size_t zb_ = 0; asm volatile("" : "+s"(b_.x), "+s"(zb_)); b_.bar = (unsigned*)(args.ws + WS_CTL + zb_) + CW_BAR; xcd_barrier(b_); if (BAR2X) xcd_barrier(b_); } } while (0)

    if (IN(0) && EN(13)) { RELAUNDER(); p0_prologue(F); if (DUP(13)) { __syncthreads(); p0_prologue(F); } } SEAM(0);

#pragma unroll 1
    for (int l = 0; l < DEPTH; ++l) {
        const int pb = 1 + l * NPH_LAYER;
        bf16* HB = wsp<bf16>(F, WS_HB); float* SSQ = wsp<float>(F, WS_SSQ);
        if (IN(pb + 0) && EN(0)) for (int rep_ = 0; rep_ < (DUP(0) ? 2 : 1); ++rep_) { RELAUNDER(); if (rep_) __syncthreads();
            pg8::Gemm g{HB, wsp<bf16>(F, WS_WIN) + (size_t)l * NIN * 1024, NTOK, 3072, D};
            pg8::StaticOrder S; S.init(NTOK, 3072, F.G, (int)blockIdx.x);
            EpiIn E{F.ws};
            STAGGER(STAG_J0);
            pg8::gemm_phase<EpiIn, pg8::StaticOrder, true, true>(F.lds, g, S, E, F.wave);
        }
        SEAM(pb + 0);
        if (IN(pb + 1) && EN(1)) { RELAUNDER();
            compress_phase(F, l);
            hgrn_local_phase(F, l);
            conv_phase(F, l);
            kmax_phase(F, l);
            if (l == 0) memkv_phase(F);
            if (DUP(1)) { __syncthreads(); compress_phase(F, l); hgrn_local_phase(F, l); conv_phase(F, l); }
        }
        SEAM(pb + 1);
        if (IN(pb + 2) && EN(2)) { RELAUNDER(); hgrn_scan_phase(F); if (DUP(14)) hgrn_scan_phase(F, 1); nsa_phase(F, l); if (DUP(2)) { __syncthreads(); nsa_phase_t<NSA_VAR>(F, l); } }
        SEAM(pb + 2);
        if (IN(pb + 3) && EN(3)) { RELAUNDER(); hgrn_out_phase(F, l); if (DUP(3)) { __syncthreads(); hgrn_out_phase(F, l); } }
        SEAM(pb + 3);
        if (IN(pb + 4) && EN(4)) for (int rep_ = 0; rep_ < ((DUP(4) && l == 0) ? 2 : 1); ++rep_) { RELAUNDER(); if (rep_) __syncthreads();
            pg8::Gemm g{wsp<bf16>(F, WS_CAT), wsp<bf16>(F, WS_WOUT) + (size_t)l * 1024 * 1024, NTOK, D, D};
            pg8::StaticOrder S; S.init(NTOK, D, F.G, (int)blockIdx.x);
            EpiRes E{l == 0 ? inp(0) : (const float*)nullptr, HB, SSQ};
            pg8::gemm_phase<EpiRes, pg8::StaticOrder, true, true>(F.lds, g, S, E, F.wave);
        }
        SEAM(pb + 4);
        if (IN(pb + 5) && EN(5)) for (int rep_ = 0; rep_ < (DUP(5) ? 2 : 1); ++rep_) { RELAUNDER(); if (rep_) __syncthreads();
            pg8::Gemm g{HB, wsp<bf16>(F, WS_WQ) + (size_t)l * 256 * 1024, NTOK, 256, D};
            pg8::StaticOrder S; S.init(NTOK, 256, F.G, (int)blockIdx.x);
            EpiXQ E{SSQ, wsp<bf16>(F, WS_XQ)};
            pg8::gemm_phase<EpiXQ, pg8::StaticOrder, true, true>(F.lds, g, S, E, F.wave);
        }
        SEAM(pb + 5);
        if (IN(pb + 6) && EN(6)) { RELAUNDER(); cross_phase(F, l); if (DUP(6)) { __syncthreads(); cross_phase(F, l); } }
        SEAM(pb + 6);
        if (IN(pb + 7) && EN(7)) { RELAUNDER();
            pg8::Gemm g{wsp<bf16>(F, WS_XO), wsp<bf16>(F, WS_WO) + (size_t)l * 1024 * 256, NTOK, D, 256};
            pg8::StaticOrder S; S.init(NTOK, D, F.G, (int)blockIdx.x);
            EpiRes E{(const float*)nullptr, HB, SSQ};
            pg8::gemm_phase<EpiRes, pg8::StaticOrder, true, true>(F.lds, g, S, E, F.wave);
        }
        SEAM(pb + 7);
        if (IN(pb + 8) && EN(8)) { RELAUNDER(); router_phase(F, l); if (DUP(8)) router_phase(F, l, 1); }
        SEAM(pb + 8);
        if (IN(pb + 9) && EN(9)) { RELAUNDER(); gather_phase(F, l); if (DUP(9)) { __syncthreads(); gather_phase(F, l); } }
        SEAM(pb + 9);
        if (IN(pb + 10) && EN(10)) for (int rep_ = 0; rep_ < (DUP(10) ? 2 : 1); ++rep_) { RELAUNDER(); if (rep_) __syncthreads();
            const int ns = moe_tables(F, l);
            pg8::Gemm g{wsp<bf16>(F, WS_XS), wsp<bf16>(F, WS_WGU) + (size_t)l * 32 * 1024 * 1024, ns, 32 * 1024, D};
            MoeOrder S{(ns >> 8) * 4, F.G, (int)blockIdx.x, (const LAS int*)(F.lds + TAB_OFF) + 40};
            EpiGU E{wsp<float>(F, WS_SRSTD), wsp<bf16>(F, WS_ACT)};
            STAGGER(STAG_MOE);
            pg8::gemm_phase<EpiGU, MoeOrder, true, true>(F.lds, g, S, E, F.wave);
        }
        SEAM(pb + 10);
        if (IN(pb + 11) && EN(11)) for (int rep_ = 0; rep_ < (DUP(11) ? 2 : 1); ++rep_) { RELAUNDER(); if (rep_) __syncthreads();
            const int ns = moe_tables(F, l);
            pg8::Gemm g{wsp<bf16>(F, WS_ACT), wsp<bf16>(F, WS_WDN) + (size_t)l * 32 * 1024 * 512, ns, 32 * 1024, 512};
            MoeOrder S{(ns >> 8) * 4, F.G, (int)blockIdx.x, (const LAS int*)(F.lds + TAB_OFF) + 40};
            EpiDN E{wsp<float>(F, WS_SGATE), wsp<bf16>(F, WS_YS)};
            STAGGER(STAG_MOE / 2);
            pg8::gemm_phase<EpiDN, MoeOrder, true, true>(F.lds, g, S, E, F.wave);
        }
        SEAM(pb + 11);
        if (IN(pb + 12) && EN(12)) { RELAUNDER(); combine_phase(F, l); if (DUP(12)) combine_phase(F, l, 1); }
        SEAM(pb + 12);
    }
#undef IN
#undef SEAM
}

extern "C" void kernel_launch(void* const* d_in, const int* in_sizes, int n_in, void* d_out, int out_size, void* d_ws, size_t ws_size, hipStream_t stream) {
    static int grid = 0;
    if (grid == 0) {
        if (n_in != 24 || in_sizes[0] != NTOK * D || out_size != NTOK * D || ws_size < WS_END) {
            fprintf(stderr, "kernel_launch: unexpected shapes: n_in %d in0 %d out %d ws %zu (need %zu)\n", n_in, n_in > 0 ? in_sizes[0] : -1, out_size, ws_size, (size_t)WS_END); grid = -1; return; }
        int dev = 0, cus = 0, per_cu = 0;
        if (hipGetDevice(&dev) != hipSuccess || hipDeviceGetAttribute(&cus, hipDeviceAttributeMultiprocessorCount, dev) != hipSuccess) { grid = -1; return; }
        if (hipFuncSetAttribute((const void*)hymba_fwd, hipFuncAttributeMaxDynamicSharedMemorySize, LDS_BYTES) != hipSuccess) { fprintf(stderr, "kernel_launch: hipFuncSetAttribute failed\n"); grid = -1; return; }
        if (hipOccupancyMaxActiveBlocksPerMultiprocessor(&per_cu, (const void*)hymba_fwd, NWAVES * 64, LDS_BYTES) != hipSuccess || per_cu < 1)
            fprintf(stderr, "kernel_launch: note: occupancy query reports %d blocks per CU\n", per_cu);
        (void)hipGetLastError();
        grid = cus;
    }
    if (grid < 0) return;
    if (hipMemsetAsync((char*)d_ws + WS_CTL, 0, CTL_ZERO_BYTES, stream) != hipSuccess) { fprintf(stderr, "kernel_launch: memset failed\n"); return; }
    Args a{};
    for (int i = 0; i < 24; ++i) a.in[i] = (const float*)d_in[i];
    a.out = (float*)d_out; a.ws = (unsigned char*)d_ws;
#if MK_ONE_LAUNCH
    a.ph_lo = 0; a.ph_hi = NPHASES;
    hipLaunchKernelGGL(hymba_fwd, dim3(grid), dim3(NWAVES * 64), LDS_BYTES, stream, a);
#else
    for (int p = 0; p < NPHASES; ++p) { a.ph_lo = p; a.ph_hi = p + 1; hipLaunchKernelGGL(hymba_fwd, dim3(grid), dim3(NWAVES * 64), LDS_BYTES, stream, a); }
#endif
    const hipError_t le = hipPeekAtLastError();
    if (le != hipSuccess) fprintf(stderr, "kernel_launch: launch failed: %s\n", hipGetErrorName(le));
}
```

```cpp
#define MK_ONE_LAUNCH 1
#include <hip/hip_runtime.h>
#include <cstdio>
#include <cstdint>
#include <cmath>
namespace pg8 {
#define PG8_LAS __attribute__((address_space(3)))
typedef unsigned short bf16_t;
typedef short bf16x8 __attribute__((ext_vector_type(8)));
typedef float f32x4 __attribute__((ext_vector_type(4)));
typedef unsigned u32x4 __attribute__((ext_vector_type(4)));
constexpr int BM = 256, BK = 64, HALF = 128, HTB = HALF * BK * 2  , STAGE_BYTES = 8 * HTB, NXCD = 8, WGM = 8;

__host__ __device__ __forceinline__ int lds_byte(int r, int c) { const int st = (r >> 4) * 2 + (c >> 5), rr = r & 15, cc = c & 31, ob = rr * 64 + cc * 2; return st * 1024 + (ob ^ (((ob >> 9) & 1) << 5)); }
__host__ __device__ __forceinline__ void stage_rc(int b, int& R, int& C) { const int st = b / 1024, sb = b % 1024, swz = sb ^ (((sb >> 9) & 1) << 5); R = (st >> 1) * 16 + swz / 64; C = (st & 1) * 32 + (swz % 64) / 2; }
__host__ __device__ __forceinline__ int perm32(int rho) { const int n = rho >> 4, i = rho & 15; return 8 * (i >> 2) + 4 * n + (i & 3); }

struct Unit { int pm, pn; };
struct Gemm { const bf16_t* A; const bf16_t* Bt; int M, N, K; };

struct StaticOrder {
    int nM, nN, nwg, G, c;
    __host__ __device__ void init(int M, int N, int G_, int c_) { nM = M / BM; nN = N / BM; nwg = nM * nN; G = G_; c = c_; }
    __host__ __device__ bool next(int i, Unit& u) const {
        const long L = (long)i * G + c; if (L >= nwg) return false;
        int wgid = (int)L; { const int q = nwg / NXCD, r = nwg % NXCD, xcd = wgid % NXCD, off = wgid / NXCD; wgid = (xcd < r ? xcd * (q + 1) : r * (q + 1) + (xcd - r) * q) + off; }
        const int nig = WGM * nN, gid = wgid / nig, fm = gid * WGM, gsz = (nM - fm) < WGM ? (nM - fm) : WGM;
        u.pm = fm + ((wgid % nig) % gsz); u.pn = (wgid % nig) / gsz; return true;
    }
    __device__ __forceinline__ void a_ready(const Unit&) const {}
    __device__ __forceinline__ void done(const Unit&) const {}
};

__device__ __forceinline__ unsigned cvt_pk_bf16(float lo, float hi) { unsigned r; asm volatile("v_cvt_pk_bf16_f32 %0, %1, %2" : "=v"(r) : "v"(lo), "v"(hi)); return r; }
typedef float f32x2 __attribute__((ext_vector_type(2)));
template <class Epi, class Sched, bool ALIGN_EPI = false, bool SP2 = false>
__device__ __forceinline__ void gemm_phase(PG8_LAS unsigned char* lds, const Gemm g, const Sched& S, const Epi& E, int wave_id) {
    unsigned z_ = 0u; asm volatile("" : "+v"(z_)); int tid_ = wave_id * 64 + (int)__builtin_amdgcn_mbcnt_hi(~0u, __builtin_amdgcn_mbcnt_lo(~0u, z_));
    const int tid = tid_, wid = __builtin_amdgcn_readfirstlane(tid >> 6), lane = tid & 63, wr = wid >> 2, wc = wid & 3, fr = lane & 15, fq = lane >> 4;
    const int K = g.K, nt = K / BK;
    unsigned voffA[2], voffB[2];
#pragma unroll
    for (int i = 0; i < 2; ++i) { int R, C; stage_rc(tid * 16 + i * 8192, R, C); const int Rb = Epi::PERM ? ((R & ~31) + perm32(R & 31)) : R;
        voffA[i] = (unsigned)(R * K + C) * 2u; voffB[i] = (unsigned)(Rb * K + C) * 2u; }
    const size_t kstep = (size_t)(BK * 2);
    const size_t hstep = (size_t)HALF * K * 2;
    const size_t tstep = 2 * hstep;
    const unsigned ldsw = (unsigned)wid * 1024u;
    const int aoff = lds_byte(wr * 64 + fr, fq * 8), boff = lds_byte(wc * 32 + fr, fq * 8);
#define PG8_SA(b, h) (((b) * 2 + (h)) * HTB)
#define PG8_SB(b, h) ((4 + (b) * 2 + (h)) * HTB)
#define PG8_STAGE(bufoff, gbase, voff) do { _Pragma("unroll") for (int _i = 0; _i < 2; ++_i) \
        __builtin_amdgcn_global_load_lds((const unsigned*)((const char*)(gbase) + (voff)[_i]), (PG8_LAS unsigned*)(lds + (bufoff) + ldsw + _i * 8192), 16, 0, 0); } while (0)
#define PG8_LDA(dst, b, h) do { _Pragma("unroll") for (int m = 0; m < 4; ++m) _Pragma("unroll") for (int k = 0; k < 2; ++k) dst[m][k] = *(const PG8_LAS bf16x8*)(lds + PG8_SA(b, h) + aoff + m * 2048 + k * 1024); } while (0)
#define PG8_LDB(dst, b, h) do { _Pragma("unroll") for (int n = 0; n < 2; ++n) _Pragma("unroll") for (int k = 0; k < 2; ++k) dst[n][k] = *(const PG8_LAS bf16x8*)(lds + PG8_SB(b, h) + boff + n * 2048 + k * 1024); } while (0)
#define PG8_MMA(ai, bj, At, Bt) do { __builtin_amdgcn_s_setprio(1); _Pragma("unroll") for (int m = 0; m < 4; ++m) _Pragma("unroll") for (int n = 0; n < 2; ++n) _Pragma("unroll") for (int k = 0; k < 2; ++k) \
        acc[ai][bj][m][n] = __builtin_amdgcn_mfma_f32_16x16x32_bf16(Bt[n][k], At[m][k], acc[ai][bj][m][n], 0, 0, 0); __builtin_amdgcn_s_setprio(0); } while (0)
#define PG8_WAIT_V(n) asm volatile("s_waitcnt vmcnt(" #n ")" ::: "memory")
#define PG8_WAIT_L(n) asm volatile("s_waitcnt lgkmcnt(" #n ")" ::: "memory")
#define PG8_BAR __builtin_amdgcn_s_barrier()
#define PG8_SCHED __builtin_amdgcn_sched_barrier(0)
    Unit cur, nxt; int ui = 0;
    if (!S.next(0, cur)) return;
    f32x4 acc[2][2][4][2];
#pragma unroll
    for (int a = 0; a < 2; ++a)
#pragma unroll
        for (int b = 0; b < 2; ++b)
#pragma unroll
            for (int m = 0; m < 4; ++m)
#pragma unroll
                for (int n = 0; n < 2; ++n) acc[a][b][m][n] = (f32x4){0.f, 0.f, 0.f, 0.f};
    bf16x8 At[4][2], B0[2][2], B1[2][2];
    const char* cA = (const char*)g.A + (size_t)cur.pm * tstep; const char* cB = (const char*)g.Bt + (size_t)cur.pn * tstep;
    S.a_ready(cur);
    if constexpr (SP2) {
        PG8_STAGE(PG8_SB(0, 0), cB, voffB); PG8_STAGE(PG8_SB(0, 1), cB + hstep, voffB); PG8_STAGE(PG8_SA(0, 0), cA, voffA); PG8_STAGE(PG8_SA(0, 1), cA + hstep, voffA);
        if (wr == 1) PG8_BAR;
        PG8_WAIT_V(2); PG8_BAR;
        PG8_STAGE(PG8_SB(1, 0), cB + kstep, voffB); PG8_STAGE(PG8_SA(1, 0), cA + kstep, voffA); PG8_STAGE(PG8_SB(1, 1), cB + hstep + kstep, voffB);
        PG8_WAIT_V(6); PG8_BAR;
    } else {
        PG8_STAGE(PG8_SB(0, 0), cB, voffB); PG8_STAGE(PG8_SA(0, 0), cA, voffA); PG8_STAGE(PG8_SB(0, 1), cB + hstep, voffB); PG8_STAGE(PG8_SA(0, 1), cA + hstep, voffA);
        if (wr == 1) PG8_BAR;
        PG8_WAIT_V(4); PG8_BAR;
        PG8_STAGE(PG8_SB(1, 0), cB + kstep, voffB); PG8_STAGE(PG8_SA(1, 0), cA + kstep, voffA); PG8_STAGE(PG8_SB(1, 1), cB + hstep + kstep, voffB);
        PG8_WAIT_V(6); PG8_BAR;
    }
    for (;;) {
        const bool has_next = S.next(ui + 1, nxt);
        const char* nA = has_next ? (const char*)g.A + (size_t)nxt.pm * tstep : cA; const char* nB = has_next ? (const char*)g.Bt + (size_t)nxt.pn * tstep : cB;
        for (int t = 0; t < nt; t += 2) {
            const bool last = (t == nt - 2);
            const char* a1 = cA + (size_t)(t + 1) * kstep;
            const char* a2 = last ? nA : cA + (size_t)(t + 2) * kstep; const char* b2 = last ? nB : cB + (size_t)(t + 2) * kstep;
            const char* a3 = a2 + kstep; const char* b3 = b2 + kstep;
            if (last && has_next) S.a_ready(nxt);
            if constexpr (SP2) {
            PG8_LDB(B0, 0, 0); PG8_LDB(B1, 0, 1); PG8_SCHED; PG8_LDA(At, 0, 0); PG8_STAGE(PG8_SA(1, 1), a1 + hstep, voffA);
            PG8_WAIT_V(8); PG8_WAIT_L(0); PG8_BAR; PG8_MMA(0, 0, At, B0); PG8_MMA(0, 1, At, B1); PG8_BAR; PG8_SCHED;
            PG8_LDA(At, 0, 1); PG8_STAGE(PG8_SB(0, 0), b2, voffB); PG8_STAGE(PG8_SB(0, 1), b2 + hstep, voffB); PG8_STAGE(PG8_SA(0, 0), a2, voffA);
            PG8_WAIT_V(8); PG8_WAIT_L(0); PG8_BAR; PG8_MMA(1, 0, At, B0); PG8_MMA(1, 1, At, B1); PG8_BAR; PG8_SCHED;
            PG8_LDB(B0, 1, 0); PG8_LDB(B1, 1, 1); PG8_SCHED; PG8_LDA(At, 1, 0); PG8_STAGE(PG8_SA(0, 1), a2 + hstep, voffA);
            PG8_WAIT_V(8); PG8_WAIT_L(0); PG8_BAR; PG8_MMA(0, 0, At, B0); PG8_MMA(0, 1, At, B1); PG8_BAR; PG8_SCHED;
            PG8_LDA(At, 1, 1); PG8_STAGE(PG8_SB(1, 0), b3, voffB); PG8_STAGE(PG8_SB(1, 1), b3 + hstep, voffB); PG8_STAGE(PG8_SA(1, 0), a3, voffA);
            PG8_WAIT_V(8); PG8_WAIT_L(0); PG8_BAR; PG8_MMA(1, 0, At, B0); PG8_MMA(1, 1, At, B1); PG8_BAR; PG8_SCHED;
            } else {
            PG8_LDB(B0, 0, 0); PG8_SCHED; PG8_LDA(At, 0, 0); PG8_STAGE(PG8_SA(1, 1), a1 + hstep, voffA);
            PG8_WAIT_L(8); PG8_BAR; PG8_WAIT_L(0); PG8_MMA(0, 0, At, B0); PG8_BAR; PG8_SCHED;
            PG8_LDB(B1, 0, 1); PG8_STAGE(PG8_SB(0, 0), b2, voffB);
            PG8_BAR; PG8_WAIT_L(0); PG8_MMA(0, 1, At, B1); PG8_BAR;
            PG8_LDA(At, 0, 1); PG8_STAGE(PG8_SA(0, 0), a2, voffA);
            PG8_BAR; PG8_WAIT_L(0); PG8_MMA(1, 0, At, B0); PG8_BAR; PG8_SCHED;
            PG8_STAGE(PG8_SB(0, 1), b2 + hstep, voffB);
            PG8_WAIT_V(6); PG8_BAR; PG8_MMA(1, 1, At, B1); PG8_BAR;
            PG8_LDB(B0, 1, 0); PG8_SCHED; PG8_LDA(At, 1, 0); PG8_STAGE(PG8_SA(0, 1), a2 + hstep, voffA);
            PG8_WAIT_L(8); PG8_BAR; PG8_WAIT_L(0); PG8_MMA(0, 0, At, B0); PG8_BAR; PG8_SCHED;
            PG8_LDB(B1, 1, 1); PG8_STAGE(PG8_SB(1, 0), b3, voffB);
            PG8_BAR; PG8_WAIT_L(0); PG8_MMA(0, 1, At, B1); PG8_BAR;
            PG8_LDA(At, 1, 1); PG8_STAGE(PG8_SA(1, 0), a3, voffA);
            PG8_BAR; PG8_WAIT_L(0); PG8_MMA(1, 0, At, B0); PG8_BAR; PG8_SCHED;
            PG8_STAGE(PG8_SB(1, 1), b3 + hstep, voffB);
            PG8_WAIT_V(6); PG8_BAR; PG8_MMA(1, 1, At, B1); PG8_BAR;
            }
        }
        if constexpr (ALIGN_EPI) { if (wr == 0) PG8_BAR; }
        if constexpr (!Epi::AFTER_DRAIN) { E(acc, cur, wr, wc, fr, fq); S.done(cur); }
        if (!has_next) break;
#pragma unroll
        for (int a = 0; a < 2; ++a)
#pragma unroll
            for (int b = 0; b < 2; ++b)
#pragma unroll
                for (int m = 0; m < 4; ++m)
#pragma unroll
                    for (int n = 0; n < 2; ++n) acc[a][b][m][n] = (f32x4){0.f, 0.f, 0.f, 0.f};
        cur = nxt; cA = nA; cB = nB; ++ui;
        if constexpr (ALIGN_EPI) { if (wr == 1) PG8_BAR; }
    }
    PG8_WAIT_V(0);
    if constexpr (!ALIGN_EPI) { if (wr == 0) PG8_BAR; }
    PG8_BAR;
    if constexpr (Epi::AFTER_DRAIN) { E.fused(acc, cur, wr, wc, fr, fq, lds, wid, lane); S.done(cur); }
#undef PG8_SA
#undef PG8_SB
#undef PG8_STAGE
#undef PG8_LDA
#undef PG8_LDB
#undef PG8_MMA
#undef PG8_WAIT_V
#undef PG8_WAIT_L
#undef PG8_BAR
#undef PG8_SCHED
}
}
constexpr int NB = 4, T = 8192, D = 1024, NTOK = NB * T, DEPTH = 2;
constexpr int NIN = 3328;
constexpr int IN_W = 3096;
constexpr int NSLOT_MAX = 65536 + 32 * 256;
constexpr float RMS_EPS = 1e-6f;
constexpr float QSCALE = 0.125f * 1.44269504088896f;
constexpr int NWAVES = 8;

constexpr size_t MiB = 1u << 20;
constexpr size_t WS_CTL = 0, CTL_ZERO_BYTES = 1 * MiB;
constexpr size_t WS_ROPE = 1 * MiB;
constexpr size_t WS_SMALL = 3 * MiB;
constexpr size_t WS_WG = 3 * MiB + 65536;
constexpr size_t WS_SSQ = 4 * MiB;
constexpr size_t WS_WIN = 8 * MiB;
constexpr size_t WS_WOUT = 22 * MiB;
constexpr size_t WS_WQ = 26 * MiB;
constexpr size_t WS_WKV = 27 * MiB;
constexpr size_t WS_WO = 29 * MiB;
constexpr size_t WS_WR = 30 * MiB;
constexpr size_t WS_W1C = 31 * MiB;
constexpr size_t WS_W2C = 33 * MiB;
constexpr size_t WS_MEMB = 34 * MiB;
constexpr size_t WS_MK = 36 * MiB;
constexpr size_t WS_MVT = 37 * MiB;
constexpr size_t WS_WGU = 40 * MiB;
constexpr size_t WS_WDN = 168 * MiB;
constexpr size_t WS_HB = 232 * MiB;
constexpr size_t WS_Q = 296 * MiB, WS_QR = 328 * MiB, WS_KCR = 360 * MiB, WS_VCR = 368 * MiB, WS_KS = 376 * MiB, WS_KW = 384 * MiB;
constexpr size_t WS_VST = 392 * MiB, WS_VWT = 400 * MiB, WS_KCC = 408 * MiB, WS_VCT = 409 * MiB, WS_GATE = 410 * MiB;
constexpr size_t WS_CB = 414 * MiB, WS_CC = 430 * MiB, WS_CH = 446 * MiB;
constexpr size_t WS_HQ = 462 * MiB, WS_HF = 494 * MiB, WS_HI = 526 * MiB, WS_HG = 558 * MiB;
constexpr size_t WS_CAT = 590 * MiB, WS_U = 654 * MiB, WS_DEC = 686 * MiB;
constexpr size_t WS_XQ = 688 * MiB, WS_XO = 704 * MiB;
constexpr size_t WS_XS = 296 * MiB, WS_ACT = 440 * MiB, WS_YS = 512 * MiB;
constexpr size_t WS_TOKE = 720 * MiB, WS_TOKG = 721 * MiB, WS_TOKP = 722 * MiB, WS_TOKS = 723 * MiB, WS_SRSTD = 724 * MiB, WS_SGATE = 725 * MiB;
constexpr size_t WS_U2 = 728 * MiB;
constexpr size_t WS_PROBE = 760 * MiB;
constexpr size_t WS_END = 760 * MiB;
static_assert(WS_XS + (size_t)NSLOT_MAX * 1024 * 2 <= WS_ACT && WS_ACT + (size_t)NSLOT_MAX * 512 * 2 <= WS_YS && WS_YS + (size_t)NSLOT_MAX * 1024 * 2 <= WS_XQ, "moe map");
constexpr int CW_CNT = 64;
constexpr int CW_KMAX = 256;
constexpr int CW_BAR = 4096;

constexpr int RING_BYTES = 131072;
constexpr int NSA_LDS_WAVE = 10752;
constexpr int MISC_OFF = RING_BYTES;
constexpr int TAB_OFF = RING_BYTES + 512;
constexpr int LDS_BYTES = 147456;
static_assert(8 * NSA_LDS_WAVE <= RING_BYTES && TAB_OFF + 4 * (40 + 320) <= LDS_BYTES, "LDS map");

#define GAS __attribute__((address_space(1)))
#define LAS __attribute__((address_space(3)))
#define DEV __device__ __forceinline__
typedef unsigned short bf16;
typedef unsigned v4u __attribute__((ext_vector_type(4)));
typedef unsigned v2u __attribute__((ext_vector_type(2)));
typedef float f32x4 __attribute__((ext_vector_type(4)));
typedef short bf16x8 __attribute__((ext_vector_type(8)));
typedef GAS unsigned gu32;
#define RLX_AGENT __ATOMIC_RELAXED, __HIP_MEMORY_SCOPE_AGENT
#define LDS_WAIT() asm volatile("s_waitcnt lgkmcnt(0)" ::: "memory")
#define VM_WAIT() asm volatile("s_waitcnt vmcnt(0)" ::: "memory")
typedef __bf16 bf16x2_t __attribute__((ext_vector_type(2)));
typedef float f32x2_t __attribute__((ext_vector_type(2)));
DEV unsigned pk2(float lo, float hi) { const f32x2_t v = {lo, hi}; return __builtin_bit_cast(unsigned, __builtin_convertvector(v, bf16x2_t)); }
DEV unsigned f2bf(float f) { return pk2(f, 0.f) & 0xffffu; }
DEV float bf2f(unsigned short b) { return __builtin_bit_cast(float, (unsigned)b << 16); }
DEV float bflo(unsigned w) { return __builtin_bit_cast(float, w << 16); }
DEV float bfhi(unsigned w) { return __builtin_bit_cast(float, w & 0xffff0000u); }
DEV float ex2(float x) { return __builtin_amdgcn_exp2f(x); }
DEV float wave_sum(float v) {
#pragma unroll
    for (int o = 1; o < 64; o <<= 1) v += __shfl_xor(v, o);
    return v;
}
DEV f32x4 mfma16(bf16x8 a, bf16x8 b, f32x4 c) { return __builtin_amdgcn_mfma_f32_16x16x32_bf16(a, b, c, 0, 0, 0); }
DEV int slot32(int k) { return ((k >> 2) & 3) * 8 + (k >> 4) * 4 + (k & 3); }
DEV float sigmoidf_(float x) { return 1.0f / (1.0f + __expf(-x)); }
DEV float siluf_(float x) { return x / (1.0f + __expf(-x)); }
#define XB_TMO      128
#define XB_XCNT(j)  (256  + 64 * (j))
#define XB_XSUB(j)  (1280 + 64 * (j))
#define XB_XGEN(j)  (2304 + 64 * (j))
#define XB_TOP      3328
#define XB_TOPGEN   3392
#define XCD_BAR_WORDS 3456
#define XB_SPIN_CAP (1u << 18)

__device__ __forceinline__ unsigned xb_ld(unsigned* p)              { return __hip_atomic_load(p, __ATOMIC_RELAXED, __HIP_MEMORY_SCOPE_AGENT); }
__device__ __forceinline__ unsigned xb_add(unsigned* p, unsigned v) { return __hip_atomic_fetch_add(p, v, __ATOMIC_RELAXED, __HIP_MEMORY_SCOPE_AGENT); }
__device__ __forceinline__ unsigned xb_xcc_id() { return (unsigned)__builtin_amdgcn_s_getreg((3 << 11) | 20) & 0xFu; }
#define XB_SPIN(cond, bar) do { unsigned _sp = 0; while (cond) { __builtin_amdgcn_s_sleep(1); \
    if ((++_sp & 255u) == 0u) { if (xb_ld(&(bar)[XB_TMO])) break; if (_sp > XB_SPIN_CAP) { atomicAdd(&(bar)[XB_TMO], 1u); break; } } } } while (0)

struct XcdBarrier {
    unsigned* bar; unsigned x;
    volatile LAS unsigned* st;
};

__device__ __forceinline__ XcdBarrier xcd_barrier_post(unsigned* bar, volatile LAS unsigned* st) {
    XcdBarrier b; b.bar = bar; b.x = xb_xcc_id(); b.st = st;
    if (threadIdx.x == 0) (void)xb_add(&bar[XB_XCNT(b.x)], 1u);
    return b;
}
__device__ __forceinline__ void xcd_barrier_complete(unsigned* bar, unsigned x, unsigned& nloc, unsigned& nx) {
    const unsigned G = gridDim.x * gridDim.y * gridDim.z;
    unsigned sum, cnt, mine, sp = 0u;
    for (;;) {
        sum = 0u; cnt = 0u; mine = 0u;
#pragma unroll
        for (unsigned j = 0; j < 16; ++j) { const unsigned c = xb_ld(&bar[XB_XCNT(j)]); sum += c; cnt += (c > 0u) ? 1u : 0u; mine = (j == x) ? c : mine; }
        if (sum == G) break;
        __builtin_amdgcn_s_sleep(1);
        if ((++sp & 255u) == 0u) { if (xb_ld(&bar[XB_TMO])) break; if (sp > XB_SPIN_CAP) { atomicAdd(&bar[XB_TMO], 1u); break; } }
    }
    nloc = mine > 0u ? mine : 1u; nx = cnt > 0u ? cnt : 1u;
}

__device__ __forceinline__ void xcd_barrier(const XcdBarrier& b) {
    asm volatile("s_waitcnt vmcnt(0)" ::: "memory");
    __syncthreads();
    if (threadIdx.x == 0) {
        unsigned* bar = b.bar;
        __builtin_amdgcn_s_waitcnt(0);
        unsigned nloc = b.st[0], nx = b.st[1];
        if (nloc == 0u) { xcd_barrier_complete(bar, b.x, nloc, nx); b.st[0] = nloc; b.st[1] = nx; }
        const unsigned old = xb_add(&bar[XB_XSUB(b.x)], 1u);
        const unsigned gen = old / nloc;
        if (old + 1u == (gen + 1u) * nloc) {
            __builtin_amdgcn_fence(__ATOMIC_RELEASE, "agent");
            asm volatile("s_waitcnt vmcnt(0)" ::: "memory");
            const unsigned og = xb_add(&bar[XB_TOP], 1u);
            const unsigned tg = og / nx;
            if (og + 1u == (tg + 1u) * nx) xb_add(&bar[XB_TOPGEN], 1u);
            else XB_SPIN(xb_ld(&bar[XB_TOPGEN]) == tg, bar);
            __builtin_amdgcn_fence(__ATOMIC_ACQUIRE, "agent");
            xb_add(&bar[XB_XGEN(b.x)], 1u);
            asm volatile("s_waitcnt vmcnt(0)" ::: "memory");
        } else {
            XB_SPIN(xb_ld(&bar[XB_XGEN(b.x)]) == gen, bar);
            __builtin_amdgcn_fence(__ATOMIC_ACQUIRE, "agent");
            asm volatile("s_waitcnt vmcnt(0)" ::: "memory");
        }
    }
    __syncthreads();
}
DEV float row_rstd(const float* ssq, int row, int fq) {
    const f32x4 p = *(const f32x4*)(ssq + (size_t)row * 16 + fq * 4);
    float s = (p.x + p.y) + (p.z + p.w);
    s += __shfl_xor(s, 16); s += __shfl_xor(s, 32);
    return 1.0f / sqrtf(s * (1.0f / 1024.0f) + RMS_EPS);
}
DEV float row_rstd_full(const float* ssq, int row) {
    const f32x4* p = (const f32x4*)(ssq + (size_t)row * 16);
    const f32x4 a = p[0], b = p[1], c = p[2], d = p[3];
    const float s = ((a.x + a.y) + (a.z + a.w)) + ((b.x + b.y) + (b.z + b.w)) + ((c.x + c.y) + (c.z + c.w)) + ((d.x + d.y) + (d.z + d.w));
    return 1.0f / sqrtf(s * (1.0f / 1024.0f) + RMS_EPS);
}

DEV void rope4(const float* rope, int t, int i, const f32x4& v0, const f32x4& v1, float (&lo)[4], float (&hi)[4]) {
    const f32x4 c0 = *(const f32x4*)(rope + ((size_t)t * 32 + i) * 2), c1 = *(const f32x4*)(rope + ((size_t)t * 32 + i + 2) * 2);
    lo[0] = v0[0] * c0[0] - v0[1] * c0[1]; hi[0] = v0[1] * c0[0] + v0[0] * c0[1];
    lo[1] = v0[2] * c0[2] - v0[3] * c0[3]; hi[1] = v0[3] * c0[2] + v0[2] * c0[3];
    lo[2] = v1[0] * c1[0] - v1[1] * c1[1]; hi[2] = v1[1] * c1[0] + v1[0] * c1[1];
    lo[3] = v1[2] * c1[2] - v1[3] * c1[3]; hi[3] = v1[3] * c1[2] + v1[2] * c1[3];
}
struct EpiIn {
    static constexpr bool PERM = true, AFTER_DRAIN = false;
    unsigned char* ws;
    template <class Tp> DEV Tp* P(size_t off) const { return (Tp*)(GAS Tp*)(ws + off); }
    DEV void operator()(const f32x4 (&acc)[2][2][4][2], const pg8::Unit& u, int wr, int wc, int fr, int fq) const {
        asm volatile("" : "+v"(fr), "+v"(fq), "+s"(wr), "+s"(wc));
        const int pn = u.pn;
        const float* ssq = P<float>(WS_SSQ); const float* rope = P<float>(WS_ROPE);
#pragma unroll
        for (int ai = 0; ai < 2; ++ai)
#pragma unroll
            for (int m = 0; m < 4; ++m) {
                const int row = u.pm * 256 + ai * 128 + wr * 64 + m * 16 + fr;
                const float rstd = row_rstd(ssq, row, fq);
                const int t = row & (T - 1), b = row >> 13;
#pragma unroll
                for (int bj = 0; bj < 2; ++bj) {
                    const int col = bj * 128 + wc * 32 + fq * 8;
                    const f32x4 v0 = acc[ai][bj][m][0] * rstd, v1 = acc[ai][bj][m][1] * rstd;
                    if (pn < 2) {
                        const int g = pn * 256 + col, head = g >> 6, i = (g & 63) >> 1;
                        const size_t o = (size_t)row * 512 + head * 64 + i;
                        bf16* Q = P<bf16>(WS_Q);
                        v2u w;
                        w.x = pk2(v0[0] * QSCALE, v0[2] * QSCALE); w.y = pk2(v1[0] * QSCALE, v1[2] * QSCALE); *(v2u*)(Q + o) = w;
                        w.x = pk2(v0[1] * QSCALE, v0[3] * QSCALE); w.y = pk2(v1[1] * QSCALE, v1[3] * QSCALE); *(v2u*)(Q + o + 32) = w;
                    } else if (pn == 2) {
                        bf16* dst = P<bf16>((col < 128) ? WS_KCR : WS_VCR);
                        v4u w; w.x = pk2(v0[0], v0[1]); w.y = pk2(v0[2], v0[3]); w.z = pk2(v1[0], v1[1]); w.w = pk2(v1[2], v1[3]);
                        *(v4u*)(dst + (size_t)row * 128 + (col & 127)) = w;
                    } else if (pn == 3 || pn == 4) {
                        if (col < 128) {
                            bf16* dst = P<bf16>((pn == 3) ? WS_KS : WS_KW);
                            const int hkv = col >> 6, i = (col & 63) >> 1;
                            float lo[4], hi[4]; rope4(rope, t, i, v0, v1, lo, hi);
                            const size_t o = ((size_t)(b * 2 + hkv) * T + t) * 64 + i;
                            v2u w;
                            w.x = pk2(lo[0], lo[1]); w.y = pk2(lo[2], lo[3]); *(v2u*)(dst + o) = w;
                            w.x = pk2(hi[0], hi[1]); w.y = pk2(hi[2], hi[3]); *(v2u*)(dst + o + 32) = w;
                        } else {
                            bf16* dst = P<bf16>((pn == 3) ? WS_VST : WS_VWT);
                            const int c2 = col - 128, hkv = c2 >> 6, d = c2 & 63;
                            const size_t o = (((size_t)(b * 2 + hkv) * 256 + (t >> 5)) * 64 + d) * 32 + slot32(t & 31);
#pragma unroll
                            for (int j = 0; j < 4; ++j) { dst[o + j * 32] = (bf16)f2bf(v0[j]); dst[o + (j + 4) * 32] = (bf16)f2bf(v1[j]); }
                        }
                    } else if (pn == 9) {
                        float* dst = P<float>(WS_HF) + (size_t)row * 256 + col;
                        *(f32x4*)dst = v0; *(f32x4*)(dst + 4) = v1;
                    } else {
                        bf16* dst = (pn < 8) ? P<bf16>(WS_CB + (size_t)(pn - 5) * (WS_CC - WS_CB)) : P<bf16>(WS_HQ + (size_t)(pn - 8) * (WS_HF - WS_HQ));
                        v4u w; w.x = pk2(v0[0], v0[1]); w.y = pk2(v0[2], v0[3]); w.z = pk2(v1[0], v1[1]); w.w = pk2(v1[2], v1[3]);
                        *(v4u*)(dst + (size_t)row * 256 + col) = w;
                    }
                }
            }
    }
};

struct EpiRes {
    static constexpr bool PERM = true, AFTER_DRAIN = false;
    const float* base32; bf16* hb; float* ssq;
    DEV void operator()(const f32x4 (&acc)[2][2][4][2], const pg8::Unit& u, int wr, int wc, int fr, int fq) const {
        asm volatile("" : "+v"(fr), "+v"(fq), "+s"(wr), "+s"(wc));
#pragma unroll
        for (int ai = 0; ai < 2; ++ai)
#pragma unroll
            for (int m = 0; m < 4; ++m) {
                const int row = u.pm * 256 + ai * 128 + wr * 64 + m * 16 + fr;
                float ss = 0.f;
#pragma unroll
                for (int bj = 0; bj < 2; ++bj) {
                    const size_t o = (size_t)row * 1024 + u.pn * 256 + bj * 128 + wc * 32 + fq * 8;
                    f32x4 v0, v1;
                    if (base32) { v0 = *(const f32x4*)(base32 + o); v1 = *(const f32x4*)(base32 + o + 4); }
                    else { const v4u hw = *(const v4u*)(hb + o); v0 = (f32x4){bflo(hw.x), bfhi(hw.x), bflo(hw.y), bfhi(hw.y)}; v1 = (f32x4){bflo(hw.z), bfhi(hw.z), bflo(hw.w), bfhi(hw.w)}; }
                    v0 = v0 + acc[ai][bj][m][0]; v1 = v1 + acc[ai][bj][m][1];
                    v4u w; w.x = pk2(v0[0], v0[1]); w.y = pk2(v0[2], v0[3]); w.z = pk2(v1[0], v1[1]); w.w = pk2(v1[2], v1[3]);
                    *(v4u*)(hb + o) = w;
                    ss += ((v0[0] * v0[0] + v0[1] * v0[1]) + (v0[2] * v0[2] + v0[3] * v0[3])) + ((v1[0] * v1[0] + v1[1] * v1[1]) + (v1[2] * v1[2] + v1[3] * v1[3]));
                }
                ss += __shfl_xor(ss, 16); ss += __shfl_xor(ss, 32);
                if (fq == 0) ssq[(size_t)row * 16 + u.pn * 4 + wc] = ss;
            }
    }
};

struct EpiXQ {
    static constexpr bool PERM = true, AFTER_DRAIN = false;
    const float* ssq; bf16* XQ;
    DEV void operator()(const f32x4 (&acc)[2][2][4][2], const pg8::Unit& u, int wr, int wc, int fr, int fq) const {
        asm volatile("" : "+v"(fr), "+v"(fq), "+s"(wr), "+s"(wc));
#pragma unroll
        for (int ai = 0; ai < 2; ++ai)
#pragma unroll
            for (int m = 0; m < 4; ++m) {
                const int row = u.pm * 256 + ai * 128 + wr * 64 + m * 16 + fr;
                const float sc = row_rstd(ssq, row, fq) * QSCALE;
#pragma unroll
                for (int bj = 0; bj < 2; ++bj) {
                    const f32x4 v0 = acc[ai][bj][m][0] * sc, v1 = acc[ai][bj][m][1] * sc;
                    v4u w; w.x = pk2(v0[0], v0[1]); w.y = pk2(v0[2], v0[3]); w.z = pk2(v1[0], v1[1]); w.w = pk2(v1[2], v1[3]);
                    *(v4u*)(XQ + (size_t)row * 256 + bj * 128 + wc * 32 + fq * 8) = w;
                }
            }
    }
};

struct EpiGU {
    static constexpr bool PERM = true, AFTER_DRAIN = false;
    const float* srstd; bf16* ACT;
    DEV void operator()(const f32x4 (&acc)[2][2][4][2], const pg8::Unit& u, int wr, int wc, int fr, int fq) const {
        asm volatile("" : "+v"(fr), "+v"(fq), "+s"(wr), "+s"(wc));
        const int nt = u.pn & 3;
#pragma unroll
        for (int ai = 0; ai < 2; ++ai)
#pragma unroll
            for (int m = 0; m < 4; ++m) {
                const int row = u.pm * 256 + ai * 128 + wr * 64 + m * 16 + fr;
                const float rs = srstd[row];
#pragma unroll
                for (int bj = 0; bj < 2; ++bj) {
                    const f32x4 v0 = acc[ai][bj][m][0] * rs, v1 = acc[ai][bj][m][1] * rs;
                    const int j = (nt * 256 + bj * 128 + wc * 32 + fq * 8) >> 1;
                    v2u w; w.x = pk2(siluf_(v0[0]) * v0[1], siluf_(v0[2]) * v0[3]); w.y = pk2(siluf_(v1[0]) * v1[1], siluf_(v1[2]) * v1[3]);
                    *(v2u*)(ACT + (size_t)row * 512 + j) = w;
                }
            }
    }
};

struct EpiDN {
    static constexpr bool PERM = true, AFTER_DRAIN = false;
    const float* sgate; bf16* YS;
    DEV void operator()(const f32x4 (&acc)[2][2][4][2], const pg8::Unit& u, int wr, int wc, int fr, int fq) const {
        asm volatile("" : "+v"(fr), "+v"(fq), "+s"(wr), "+s"(wc));
        const int nt = u.pn & 3;
#pragma unroll
        for (int ai = 0; ai < 2; ++ai)
#pragma unroll
            for (int m = 0; m < 4; ++m) {
                const int row = u.pm * 256 + ai * 128 + wr * 64 + m * 16 + fr;
                const float gt = sgate[row];
#pragma unroll
                for (int bj = 0; bj < 2; ++bj) {
                    const f32x4 v0 = acc[ai][bj][m][0] * gt, v1 = acc[ai][bj][m][1] * gt;
                    v4u w; w.x = pk2(v0[0], v0[1]); w.y = pk2(v0[2], v0[3]); w.z = pk2(v1[0], v1[1]); w.w = pk2(v1[2], v1[3]);
                    *(v4u*)(YS + (size_t)row * 1024 + nt * 256 + bj * 128 + wc * 32 + fq * 8) = w;
                }
            }
    }
};

struct MoeOrder {
    int nunits, G, c; const LAS int* tileE;
    DEV bool next(int i, pg8::Unit& u) const {
        const int L = i * G + c; if (L >= nunits) return false;
        const int rt = L >> 2; u.pm = rt; u.pn = tileE[rt] * 4 + (L & 3); return true;
    }
    DEV void a_ready(const pg8::Unit&) const {}
    DEV void done(const pg8::Unit&) const {}
};
struct Frame {
    LAS unsigned char* lds;
    unsigned char* ldsg;
    volatile LAS unsigned* MISC;
    gu32* ctl;
    unsigned char* ws;
    int tid, lane, wave, vcu, G;
    float* out;
};
template <class Tp> DEV Tp* wsp(const Frame& F, size_t off) { return (Tp*)(F.ws + off); }
DEV const float* inp(int i) { const float* const* ka = (const float* const*)__builtin_amdgcn_kernarg_segment_ptr(); asm volatile("" : "+s"(i)); return (const float*)(const GAS float*)ka[i]; }

template <class Map>
DEV void tr_item(const float* W, int K, int Nsrc, const float* gain, bf16* WT, float* scr, int item, int lane, Map map) {
    const int nblk = (Nsrc + 31) >> 5, kb = item / nblk, nb = item - kb * nblk, k0 = 64 * kb, n0 = 32 * nb;
    {
        const int nq = (lane & 7) * 4; f32x4 v[8];
#pragma unroll
        for (int i = 0; i < 8; ++i) { const int kk = 8 * i + (lane >> 3);
            v[i] = (n0 + nq < Nsrc) ? *(const f32x4*)(W + (size_t)(k0 + kk) * Nsrc + n0 + nq) : (f32x4){0.f, 0.f, 0.f, 0.f}; }
#pragma unroll
        for (int i = 0; i < 8; ++i) { const int kk = 8 * i + (lane >> 3); const float g = gain ? gain[k0 + kk] : 1.0f; float* s = scr + kk * 33 + nq;
            s[0] = v[i][0] * g; s[1] = v[i][1] * g; s[2] = v[i][2] * g; s[3] = v[i][3] * g; }
    }
    LDS_WAIT();
    const int c = lane & 7;
#pragma unroll
    for (int j = 0; j < 4; ++j) {
        const int n = (lane >> 3) + 8 * j; const float* s = scr + (8 * c) * 33 + n;
        if (n0 + n < Nsrc) {
            v4u o; o.x = pk2(s[0 * 33], s[1 * 33]); o.y = pk2(s[2 * 33], s[3 * 33]); o.z = pk2(s[4 * 33], s[5 * 33]); o.w = pk2(s[6 * 33], s[7 * 33]);
            *(v4u*)(WT + (size_t)map(n0 + n) * K + k0 + 8 * c) = o;
        }
    }
    LDS_WAIT();
}
template <class Map>
DEV void tr_experts(const float* W, int K, int Nsrc, const float* gain, bf16* WT, bf16* scr, int gw, int NGW, int lane, Map map) {
    const int nblk = Nsrc >> 6, per_e = (K >> 6) * nblk, NIT = 32 * per_e; const size_t esz = (size_t)K * Nsrc;
#pragma unroll 1
    for (int it = gw; it < NIT; it += NGW) {
        const int e = it / per_e, sub = it - e * per_e, kb = sub / nblk, nb = sub - kb * nblk, k0 = 64 * kb, n0 = 64 * nb, nq = (lane & 15) * 4;
        const float* Wp = W + (size_t)e * esz; bf16* Wo = WT + (size_t)e * esz;
        f32x4 v[16];
#pragma unroll
        for (int i = 0; i < 16; ++i) v[i] = *(const f32x4*)(Wp + (size_t)(k0 + 4 * i + (lane >> 4)) * Nsrc + n0 + nq);
#pragma unroll
        for (int i = 0; i < 16; ++i) { const int kk = 4 * i + (lane >> 4); const float g = gain ? gain[k0 + kk] : 1.0f;
            v2u w; w.x = pk2(v[i][0] * g, v[i][1] * g); w.y = pk2(v[i][2] * g, v[i][3] * g);
            *(v2u*)(scr + kk * 68 + nq) = w; }
        LDS_WAIT();
        const int cc = lane & 7;
#pragma unroll
        for (int j = 0; j < 8; ++j) { const int n = (lane >> 3) + 8 * j; const bf16* s = scr + (8 * cc) * 68 + n;
            v4u o; o.x = (unsigned)s[0] | ((unsigned)s[68] << 16); o.y = (unsigned)s[2 * 68] | ((unsigned)s[3 * 68] << 16);
            o.z = (unsigned)s[4 * 68] | ((unsigned)s[5 * 68] << 16); o.w = (unsigned)s[6 * 68] | ((unsigned)s[7 * 68] << 16);
            *(v4u*)(Wo + (size_t)map(n0 + n) * K + k0 + 8 * cc) = o; }
        LDS_WAIT();
    }
}
struct MapId { DEV int operator()(int n) const { return n; } };
struct MapIn {
    DEV int operator()(int n) const {
        if (n < 512) { const int d = n & 63; return (n & ~63) + 2 * (d & 31) + (d >> 5); }
        if (n < 768) return n;
        if (n < 1280) { const int r = n - 768; if ((r & 255) < 128) { const int d = r & 63; return 768 + (r & ~63) + 2 * (d & 31) + (d >> 5); } return n; }
        if (n < 1304) return 3072 + (n - 1280);
        return n - 24;
    }
};
struct MapGU { DEV int operator()(int n) const { return n < 512 ? 2 * n : 2 * (n - 512) + 1; } };

DEV void convert_experts(Frame& F, int l, bf16* scr, int part) {
    unsigned zl_ = 0u; asm volatile("" : "+v"(zl_)); const int lane = (int)__builtin_amdgcn_mbcnt_hi(~0u, __builtin_amdgcn_mbcnt_lo(~0u, zl_));
    const int gw = F.vcu * NWAVES + F.wave, NGW = F.G * NWAVES;
    if (part == 0) tr_experts(inp(17) + (size_t)l * 32 * 1024 * 1024, 1024, 1024, inp(22) + l * 1024, wsp<bf16>(F, WS_WGU) + (size_t)l * 32 * 1024 * 1024, scr, gw, NGW, lane, MapGU());
    else tr_experts(inp(18) + (size_t)l * 32 * 512 * 1024, 512, 1024, nullptr, wsp<bf16>(F, WS_WDN) + (size_t)l * 32 * 1024 * 512, scr, gw, NGW, lane, MapId());
}
DEV void p0_prologue(Frame& F) {
    float* scr = (float*)(F.ldsg + F.wave * 16384);
    const int gw = F.vcu * NWAVES + F.wave, NGW = F.G * NWAVES, lane = F.lane;
    for (int l = 0; l < DEPTH; ++l) {
        { const int NIT = 16 * 97; bf16* dst = wsp<bf16>(F, WS_WIN) + (size_t)l * NIN * 1024;
          for (int it = gw; it < NIT; it += NGW) tr_item(inp(2) + (size_t)l * 1024 * IN_W, 1024, IN_W, inp(19) + l * 1024, dst, scr, it, lane, MapIn());
          for (int i = gw * 64 + lane; i < (NIN - 3096) * 1024 / 8; i += NGW * 64) ((v4u*)(dst + (size_t)3096 * 1024))[i] = (v4u){0u, 0u, 0u, 0u}; }
        { const int NIT = 16 * 32; for (int it = gw; it < NIT; it += NGW) tr_item(inp(9) + (size_t)l * 1024 * 1024, 1024, 1024, nullptr, wsp<bf16>(F, WS_WOUT) + (size_t)l * 1024 * 1024, scr, it, lane, MapId()); }
        { const int NIT = 16 * 8; for (int it = gw; it < NIT; it += NGW) tr_item(inp(10) + (size_t)l * 1024 * 256, 1024, 256, inp(20) + l * 1024, wsp<bf16>(F, WS_WQ) + (size_t)l * 256 * 1024, scr, it, lane, MapId()); }
        { const int NIT = 16 * 16; for (int it = gw; it < NIT; it += NGW) tr_item(inp(11) + (size_t)l * 1024 * 512, 1024, 512, inp(21) + l * 1024, wsp<bf16>(F, WS_WKV) + (size_t)l * 512 * 1024, scr, it, lane, MapId()); }
        { const int NIT = 4 * 32; for (int it = gw; it < NIT; it += NGW) tr_item(inp(12) + (size_t)l * 256 * 1024, 256, 1024, nullptr, wsp<bf16>(F, WS_WO) + (size_t)l * 1024 * 256, scr, it, lane, MapId()); }
        for (int kv = 0; kv < 2; ++kv) {
            { const int NIT = 32 * 4; for (int it = gw; it < NIT; it += NGW) tr_item(inp(5) + (size_t)(l * 2 + kv) * 2048 * 128, 2048, 128, nullptr, wsp<bf16>(F, WS_W1C) + (size_t)(l * 2 + kv) * 128 * 2048, scr, it, lane, MapId()); }
            { const int NIT = 2 * 2; for (int it = gw; it < NIT; it += NGW) tr_item(inp(6) + (size_t)(l * 2 + kv) * 128 * 64, 128, 64, nullptr, wsp<bf16>(F, WS_W2C) + (size_t)(l * 2 + kv) * 64 * 128, scr, it, lane, MapId()); }
        }
        if (F.G != 256) { convert_experts(F, l, (bf16*)scr, 0); convert_experts(F, l, (bf16*)scr, 1); }
        { bf16* dst = wsp<bf16>(F, WS_WR) + (size_t)l * 96 * 1024; const float* gn = inp(22) + l * 1024;
          for (int i = gw * 64 + lane; i < 48 * 1024; i += NGW * 64) { const int n = i >> 10, k = i & 1023;
            float v = 0.f; if (n < 4) v = inp(13)[(size_t)(l * 1024 + k) * 4 + n]; else if (n < 36) v = inp(15)[(size_t)(l * 1024 + k) * 32 + (n - 4)];
            v *= gn[k]; const unsigned h = f2bf(v); dst[i] = (bf16)h; dst[i + 48 * 1024] = (bf16)f2bf(v - bf2f((unsigned short)h)); } }
    }
    { bf16* wg = wsp<bf16>(F, WS_WG);
      for (int i = gw * 64 + lane; i < DEPTH * 32 * 1024; i += NGW * 64) { const int l2 = i >> 15, row = (i >> 10) & 31, k = i & 1023, hk = row >> 4, gi = row & 15;
        const float v = gi < 12 ? inp(2)[((size_t)l2 * 1024 + k) * IN_W + 1280 + hk * 12 + gi] * inp(19)[l2 * 1024 + k] : 0.f;
        wg[i] = (bf16)f2bf(v); } }
    { float* rope = wsp<float>(F, WS_ROPE);
      for (int i = gw * 64 + lane; i < T * 32; i += NGW * 64) { const int t = i >> 5, k = i & 31;
        const float inv = powf(10000.0f, -(float)k / 32.0f); const float ang = (float)t * inv;
        rope[2 * i] = cosf(ang); rope[2 * i + 1] = sinf(ang); } }
    { float* b1 = wsp<float>(F, WS_SMALL);
      for (int i = gw * 64 + lane; i < 4 * 128; i += NGW * 64) { const int lk = i >> 7, n = i & 127;
        const float* pe = inp(4) + (size_t)lk * 2048; const float* w1 = inp(5) + (size_t)lk * 2048 * 128 + n; float s = 0.f;
        for (int kk = 0; kk < 2048; ++kk) s += pe[kk] * w1[(size_t)kk * 128];
        b1[i] = s; } }
    { bf16* HB = wsp<bf16>(F, WS_HB); float* SSQ = wsp<float>(F, WS_SSQ); bf16* MB = wsp<bf16>(F, WS_MEMB); float* SSQM = wsp<float>(F, WS_SMALL) + 1024;
      for (int m = gw; m < NTOK + NB * 256; m += NGW) {
        const bool ism = m >= NTOK; const int r = ism ? m - NTOK : m;
        const f32x4* xr = (const f32x4*)((ism ? inp(1) : inp(0)) + (size_t)r * 1024) + lane;
        unsigned long long* o8 = (unsigned long long*)((ism ? MB : HB) + (size_t)r * 1024) + lane;
        float s = 0.f;
#pragma unroll
        for (int j = 0; j < 4; ++j) { const f32x4 v = xr[64 * j]; s += (v.x * v.x + v.y * v.y) + (v.z * v.z + v.w * v.w);
            o8[64 * j] = (unsigned long long)pk2(v.x, v.y) | ((unsigned long long)pk2(v.z, v.w) << 32); }
        s = wave_sum(s);
        if (ism) { if (lane == 0) SSQM[r] = s; }
        else if (lane < 16) SSQ[(size_t)r * 16 + lane] = lane == 0 ? s : 0.f;
      } }
}

template <int NT>
DEV void skinny16(const bf16* A, size_t lda, const bf16* Bt, size_t ldb, int K, int lane, f32x4 (&acc)[NT]) {
    const int l16 = lane & 15, g4 = lane >> 4;
    const bf16* ap = A + (size_t)l16 * lda + g4 * 8; const bf16* bp = Bt + (size_t)l16 * ldb + g4 * 8;
#pragma unroll
    for (int n = 0; n < NT; ++n) acc[n] = (f32x4){0.f, 0.f, 0.f, 0.f};
#pragma unroll 2
    for (int k = 0; k < K; k += 32) {
        const bf16x8 a = *(const bf16x8*)(ap + k);
#pragma unroll
        for (int n = 0; n < NT; ++n) { const bf16x8 b = *(const bf16x8*)(bp + (size_t)n * 16 * ldb + k); acc[n] = mfma16(a, b, acc[n]); }
    }
}

DEV void memkv_phase(Frame& F) {
    const int gw = F.vcu * NWAVES + F.wave, NGW = F.G * NWAVES, lane = F.lane, l16 = lane & 15, g4 = lane >> 4;
    const bf16* MB = wsp<bf16>(F, WS_MEMB); const float* SSQM = wsp<float>(F, WS_SMALL) + 1024;
    bf16* MK = wsp<bf16>(F, WS_MK); bf16* MVT = wsp<bf16>(F, WS_MVT);
    for (int task = gw; task < 1024; task += NGW) {
        const int l2 = task >> 9, rt = (task >> 3) & 63, chunk = task & 7;
        f32x4 acc[4];
        skinny16<4>(MB + (size_t)rt * 16 * 1024, 1024, wsp<bf16>(F, WS_WKV) + ((size_t)l2 * 512 + chunk * 64) * 1024, 1024, 1024, lane, acc);
        const int b = rt >> 4, key0 = (rt & 15) * 16 + g4 * 4;
        float rs[4];
#pragma unroll
        for (int r = 0; r < 4; ++r) rs[r] = 1.0f / sqrtf(SSQM[rt * 16 + g4 * 4 + r] * (1.0f / 1024.0f) + RMS_EPS);
#pragma unroll
        for (int nt = 0; nt < 4; ++nt) {
            const int n = chunk * 64 + nt * 16 + l16;
            if (chunk < 4) { const int head = n >> 6, d = n & 63;
#pragma unroll
                for (int r = 0; r < 4; ++r) MK[((size_t)((l2 * 4 + b) * 4 + head) * 256 + key0 + r) * 64 + d] = (bf16)f2bf(acc[nt][r] * rs[r]);
            } else { const int n2 = n - 256, head = n2 >> 6, d = n2 & 63;
                v2u w; w.x = pk2(acc[nt][0] * rs[0], acc[nt][1] * rs[1]); w.y = pk2(acc[nt][2] * rs[2], acc[nt][3] * rs[3]);
                *(v2u*)(MVT + (((size_t)((l2 * 4 + b) * 4 + head) * 8 + (key0 >> 5)) * 64 + d) * 32 + slot32(key0 & 31)) = w; }
        }
    }
}

DEV void compress_phase(Frame& F, int l) {
    const int lane = F.lane, l16 = lane & 15, g4 = lane >> 4, quad = F.wave >> 2, q = F.wave & 3;
    float* part = (float*)F.ldsg + quad * (4 * 16 * 128);
    const bf16* KCR = wsp<bf16>(F, WS_KCR); const bf16* VCR = wsp<bf16>(F, WS_VCR);
    bf16* KCC = wsp<bf16>(F, WS_KCC); bf16* VCT = wsp<bf16>(F, WS_VCT);
    const float* bias1 = wsp<float>(F, WS_SMALL);
    for (int tk0 = F.vcu * 2; tk0 < 512; tk0 += F.G * 2) {
        const int tk = tk0 + quad; const int kv = tk >> 8, tile = tk & 255;
        const bf16* raw = kv ? VCR : KCR;
        const bf16* w1 = wsp<bf16>(F, WS_W1C) + (size_t)(l * 2 + kv) * 128 * 2048;
        const bf16* w2 = wsp<bf16>(F, WS_W2C) + (size_t)(l * 2 + kv) * 64 * 128;
        { const int r = tile * 16 + l16, bh = r >> 9, c = r & 511, b = bh >> 1, hkv = bh & 1;
          f32x4 acc[8];
#pragma unroll
          for (int n = 0; n < 8; ++n) acc[n] = (f32x4){0.f, 0.f, 0.f, 0.f};
#pragma unroll 2
          for (int ks = q * 16; ks < q * 16 + 16; ++ks) {
              const int kk = ks * 32 + g4 * 8, ll = kk >> 6, d = kk & 63;
              int tok = 16 * c + ll; tok = tok > T - 1 ? T - 1 : tok;
              const bf16x8 a = *(const bf16x8*)(raw + ((size_t)b * T + tok) * 128 + hkv * 64 + d);
#pragma unroll
              for (int n = 0; n < 8; ++n) { const bf16x8 bb = *(const bf16x8*)(w1 + (size_t)(n * 16 + l16) * 2048 + kk); acc[n] = mfma16(a, bb, acc[n]); }
          }
#pragma unroll
          for (int n = 0; n < 8; ++n)
#pragma unroll
              for (int r2 = 0; r2 < 4; ++r2) part[(q * 16 + g4 * 4 + r2) * 128 + n * 16 + l16] = acc[n][r2];
        }
        __syncthreads();
        { f32x4 o = (f32x4){0.f, 0.f, 0.f, 0.f};
#pragma unroll
          for (int k2 = 0; k2 < 4; ++k2) {
              const int h0 = k2 * 32 + g4 * 8;
              float hv[8];
#pragma unroll
              for (int j = 0; j < 8; ++j) { float s = bias1[(l * 2 + kv) * 128 + h0 + j];
#pragma unroll
                  for (int p = 0; p < 4; ++p) s += part[(p * 16 + l16) * 128 + h0 + j];
                  hv[j] = siluf_(s); }
              bf16x8 a; { v4u w; w.x = pk2(hv[0], hv[1]); w.y = pk2(hv[2], hv[3]); w.z = pk2(hv[4], hv[5]); w.w = pk2(hv[6], hv[7]); a = __builtin_bit_cast(bf16x8, w); }
              const bf16x8 bb = *(const bf16x8*)(w2 + (size_t)(q * 16 + l16) * 128 + h0);
              o = mfma16(a, bb, o);
          }
          const int r0 = tile * 16 + g4 * 4, bh = r0 >> 9, c0 = r0 & 511, d = q * 16 + l16;
          if (kv == 0) {
#pragma unroll
              for (int r2 = 0; r2 < 4; ++r2) KCC[((size_t)bh * 512 + c0 + r2) * 64 + d] = (c0 + r2 == 511) ? (bf16)0 : (bf16)f2bf(o[r2]);
          } else {
              v2u w; w.x = pk2(o[0], o[1]); w.y = pk2(o[2], (c0 + 3 == 511) ? 0.f : o[3]);
              *(v2u*)(VCT + (((size_t)bh * 16 + (c0 >> 5)) * 64 + d) * 32 + slot32(c0 & 31)) = w;
          }
        }
        __syncthreads();
    }
}

DEV float hgrn_lb(const Frame& F, int l, int c) {
    if (l == 0) return 0.f;
    const float a = inp(7)[c], b = inp(7)[256 + c];
    return 1.0f / (1.0f + expf(a - b));
}
DEV float hgrn_logf(float z, float lb) {
    const float la = logf(fmaxf(lb, 1e-30f));
    const float ls = fminf(z, 0.f) - log1pf(expf(-fabsf(z)));
    const float lc = log1pf(-lb) + ls;
    const float mx = fmaxf(la, lc), mn = fminf(la, lc);
    return mx + log1pf(expf(mn - mx));
}
constexpr int HS = 68;
DEV f32x4 mfma4(float a, float b, f32x4 c) { return __builtin_amdgcn_mfma_f32_16x16x4f32(a, b, c, 0, 0, 0); }
DEV void hgrn_setup_chunk(Frame& F, float lb, const float (&z)[8], float* Bc, float* Kc, float* tot) {
    const int d = F.tid & 63, sg = F.tid >> 6;
    const float la = logf(fmaxf(lb, 1e-30f)), l1m = log1pf(-lb), onem = 1.0f - lb;
    float loc[8], kv[8]; float run = 0.f;
#pragma unroll
    for (int i = 0; i < 8; ++i) {
        const float ez = __expf(-fabsf(z[i]));
        const float lc = l1m + (fminf(z[i], 0.f) - __logf(1.0f + ez));
        const float mx = fmaxf(la, lc), mn = fminf(la, lc);
        run += mx + __logf(1.0f + __expf(mn - mx)); loc[i] = run;
        kv[i] = onem * (z[i] >= 0.f ? ez : 1.0f) / (1.0f + ez);
    }
    tot[sg * 64 + d] = run;
    __syncthreads();
    float off = 0.f;
    for (int g = 0; g < sg; ++g) off += tot[g * 64 + d];
#pragma unroll
    for (int i = 0; i < 8; ++i) { Bc[(sg * 8 + i) * HS + d] = off + loc[i]; Kc[(sg * 8 + i) * HS + d] = kv[i]; }
    __syncthreads();
}
DEV void hgrn_local_phase(Frame& F, int l) {
    float* Bc = (float*)F.ldsg; float* Kc = Bc + 64 * HS; float* Vc = Kc + 64 * HS; float* tot = Vc + 64 * HS;
    bf16* U = wsp<bf16>(F, WS_U); float* DEC = wsp<float>(F, WS_DEC);
    const int lane = F.lane, w = F.wave, li = lane & 15, kq = lane >> 4;
    for (int task = F.vcu; task < 2048; task += F.G) {
        const int bh = task >> 7, ch = task & 127, b = bh >> 2, h = bh & 3;
        { const int d = F.tid & 63, sg = F.tid >> 6;
          const size_t go = ((size_t)b * T + ch * 64 + sg * 8) * 256 + h * 64 + d;
          const float* HFp = wsp<float>(F, WS_HF) + go; const bf16* HIp = wsp<bf16>(F, WS_HI) + go;
          float z[8], vi[8];
#pragma unroll
          for (int i = 0; i < 8; ++i) { z[i] = HFp[(size_t)i * 256]; vi[i] = bf2f(HIp[(size_t)i * 256]); }
          hgrn_setup_chunk(F, hgrn_lb(F, l, h * 64 + d), z, Bc, Kc, tot);
          const float bl = Bc[63 * HS + d];
#pragma unroll
          for (int i = 0; i < 8; ++i) { const int s = sg * 8 + i; Kc[s * HS + d] *= __expf(bl - Bc[s * HS + d]); Vc[s * HS + d] = vi[i]; }
          if (sg == 0) DEC[(size_t)task * 64 + d] = expf(bl); }
        __syncthreads();
        { const int dI = w >> 1, e0 = (w & 1) * 32;
          f32x4 a0 = (f32x4){0.f, 0.f, 0.f, 0.f}, a1 = a0;
#pragma unroll 4
          for (int k0 = 0; k0 < 64; k0 += 4) { const int s = k0 + kq;
              const float a = Kc[s * HS + dI * 16 + li], b0 = Vc[s * HS + e0 + li], b1 = Vc[s * HS + e0 + 16 + li];
              a0 = mfma4(a, b0, a0); a1 = mfma4(a, b1, a1); }
#pragma unroll
          for (int r = 0; r < 4; ++r) { bf16* up = U + ((size_t)task * 64 + dI * 16 + 4 * kq + r) * 64 + e0 + li; up[0] = (bf16)f2bf(a0[r]); up[16] = (bf16)f2bf(a1[r]); } }
        __syncthreads();
    }
}
DEV void hgrn_scan_phase(Frame& F, int probe = 0) {
    const bf16* U = wsp<bf16>(F, WS_U); bf16* U2 = wsp<bf16>(F, probe ? WS_PROBE : WS_U2); const float* DEC = wsp<float>(F, WS_DEC);
    const int nact = (F.G * 256 >= 65536) ? 256 : 512;
    if (F.tid < nact)
    for (int gid = F.vcu * nact + F.tid; gid < 65536; gid += F.G * nact) {
        const int bh = gid >> 12, de = gid & 4095, d = de >> 6;
        float S = 0.f; const bf16* up = U + (size_t)bh * 128 * 4096 + de; bf16* op = U2 + (size_t)bh * 128 * 4096 + de; const float* dp = DEC + (size_t)bh * 128 * 64 + d;
#pragma unroll 16
        for (int ch = 0; ch < 128; ++ch) { const float u = bf2f(up[(size_t)ch * 4096]); const float dc = dp[ch * 64]; op[(size_t)ch * 4096] = (bf16)f2bf(S); S = dc * S + u; }
    }
}
DEV void hgrn_out_phase(Frame& F, int l) {
    float* Bc = (float*)F.ldsg; float* Kb = Bc + 64 * HS; float* Vc = Kb + 64 * HS; float* Qs = Vc + 64 * HS; float* Sc = Qs + 64 * HS; float* Ac = Sc + 64 * HS; float* tot = Ac + 64 * HS;
    float* Oc = Kb;
    const bf16* U = wsp<bf16>(F, WS_U2); bf16* CAT = wsp<bf16>(F, WS_CAT);
    const int lane = F.lane, w = F.wave, li = lane & 15, kq = lane >> 4;
    for (int task = F.vcu; task < 2048; task += F.G) {
        const int bh = task >> 7, ch = task & 127, b = bh >> 2, h = bh & 3;
        float gv[8];
        { const int d = F.tid & 63, sg = F.tid >> 6;
          const size_t go = ((size_t)b * T + ch * 64 + sg * 8) * 256 + h * 64 + d;
          const float* HFp = wsp<float>(F, WS_HF) + go; const bf16* HIp = wsp<bf16>(F, WS_HI) + go; const bf16* HQp = wsp<bf16>(F, WS_HQ) + go; const bf16* HGp = wsp<bf16>(F, WS_HG) + go;
          const bf16* Up = U + ((size_t)task * 64 + sg * 8) * 64 + d;
          float z[8], vi[8], qi[8], si[8];
#pragma unroll
          for (int i = 0; i < 8; ++i) { z[i] = HFp[(size_t)i * 256]; vi[i] = bf2f(HIp[(size_t)i * 256]); qi[i] = bf2f(HQp[(size_t)i * 256]); gv[i] = bf2f(HGp[(size_t)i * 256]); si[i] = bf2f(Up[(size_t)i * 64]); }
          hgrn_setup_chunk(F, hgrn_lb(F, l, h * 64 + d), z, Bc, Kb, tot);
#pragma unroll
          for (int i = 0; i < 8; ++i) { const int s = sg * 8 + i, J = s >> 4; const float rJ = J ? Bc[(16 * J - 1) * HS + d] : 0.f;
              Kb[s * HS + d] *= __expf(fminf(rJ - Bc[s * HS + d], 80.f));
              Vc[s * HS + d] = vi[i]; Qs[s * HS + d] = qi[i] * 0.125f; Sc[s * HS + d] = si[i]; } }
        __syncthreads();
#pragma unroll 1
        for (int ti = w; ti < 10; ti += 8) {
            const int I = ti < 1 ? 0 : (ti < 3 ? 1 : (ti < 6 ? 2 : 3)), J = ti - (I * (I + 1)) / 2;
            const int t = I * 16 + li; f32x4 acc = (f32x4){0.f, 0.f, 0.f, 0.f};
#pragma unroll 4
            for (int k0 = 0; k0 < 64; k0 += 4) { const int d = k0 + kq; const float rJ = J ? Bc[(16 * J - 1) * HS + d] : 0.f;
                const float a = Qs[t * HS + d] * __expf(Bc[t * HS + d] - rJ), bb = Kb[(J * 16 + li) * HS + d];
                acc = mfma4(a, bb, acc); }
#pragma unroll
            for (int r = 0; r < 4; ++r) { const int tt = I * 16 + 4 * kq + r, ss = J * 16 + li; Ac[tt * HS + ss] = (ss <= tt) ? acc[r] : 0.f; }
        }
        __syncthreads();
        { const int I = w >> 1, e0 = (w & 1) * 32, t = I * 16 + li;
          f32x4 a0 = (f32x4){0.f, 0.f, 0.f, 0.f}, a1 = a0;
#pragma unroll 4
          for (int k0 = 0; k0 < 64; k0 += 4) { const int d = k0 + kq;
              const float a = Qs[t * HS + d] * __expf(Bc[t * HS + d]), b0 = Sc[d * HS + e0 + li], b1 = Sc[d * HS + e0 + 16 + li];
              a0 = mfma4(a, b0, a0); a1 = mfma4(a, b1, a1); }
#pragma unroll 1
          for (int s0 = 0; s0 < 16 * (I + 1); s0 += 4) { const int s = s0 + kq;
              const float a = Ac[t * HS + s], b0 = Vc[s * HS + e0 + li], b1 = Vc[s * HS + e0 + 16 + li];
              a0 = mfma4(a, b0, a0); a1 = mfma4(a, b1, a1); }
#pragma unroll
          for (int r = 0; r < 4; ++r) { float* op = Oc + (I * 16 + 4 * kq + r) * HS + e0 + li; op[0] = a0[r]; op[16] = a1[r]; } }
        __syncthreads();
        { const float ng = inp(8)[l * 256 + h * 64 + lane];
          { const int t = w * 8 + (lane >> 3); const float* op = Oc + t * HS + (lane & 7) * 8; float s = 0.f;
#pragma unroll
            for (int j = 0; j < 8; ++j) s += op[j] * op[j];
            s += __shfl_xor(s, 1); s += __shfl_xor(s, 2); s += __shfl_xor(s, 4);
            if ((lane & 7) == 0) tot[t] = 1.0f / sqrtf(s * (1.0f / 64.0f) + RMS_EPS); }
          LDS_WAIT();
#pragma unroll
          for (int i = 0; i < 8; ++i) { const int t = w * 8 + i; const float o = Oc[t * HS + lane];
              const size_t row = (size_t)b * T + ch * 64 + t;
              CAT[row * 1024 + 768 + h * 64 + lane] = (bf16)f2bf(o * tot[t] * ng * siluf_(gv[i])); } }
        __syncthreads();
    }
}

DEV void conv_phase(Frame& F, int l) {
    const bf16* CB = wsp<bf16>(F, WS_CB); const bf16* CC = wsp<bf16>(F, WS_CC); const bf16* CH = wsp<bf16>(F, WS_CH); bf16* CAT = wsp<bf16>(F, WS_CAT);
    const float* cw = inp(3) + l * 3 * 256;
    for (int it = F.vcu * 512 + F.tid; it < NTOK * 32; it += F.G * 512) {
        const int m = it >> 5, c0 = (it & 31) * 8, t = m & (T - 1);
        const v4u bb = *(const v4u*)(CB + (size_t)m * 256 + c0);
        float y[8];
#pragma unroll
        for (int j = 0; j < 8; ++j) y[j] = 0.f;
#pragma unroll
        for (int k = 0; k < 3; ++k) {
            if (t + k - 2 >= 0) {
                const size_t o = (size_t)(m + k - 2) * 256 + c0;
                const v4u cc = *(const v4u*)(CC + o), hh = *(const v4u*)(CH + o);
#pragma unroll
                for (int j = 0; j < 4; ++j) { const float w0 = cw[k * 256 + c0 + 2 * j], w1 = cw[k * 256 + c0 + 2 * j + 1];
                    y[2 * j] += w0 * (bflo(cc[j]) * bflo(hh[j])); y[2 * j + 1] += w1 * (bfhi(cc[j]) * bfhi(hh[j])); }
            }
        }
        v4u o4;
#pragma unroll
        for (int j = 0; j < 4; ++j) o4[j] = pk2(bflo(bb[j]) * y[2 * j], bfhi(bb[j]) * y[2 * j + 1]);
        *(v4u*)(CAT + (size_t)m * 1024 + 512 + c0) = o4;
    }
}
struct SmState { float m, l; f32x4 o[4]; };
DEV void sm_reset(SmState& st) { st.m = -INFINITY; st.l = 0.f;
#pragma unroll
    for (int i = 0; i < 4; ++i) st.o[i] = (f32x4){0.f, 0.f, 0.f, 0.f}; }
DEV float sm_lsum(const SmState& st) { float l = st.l; l += __shfl_xor(l, 16); l += __shfl_xor(l, 32); return l; }
DEV void load_k(const bf16* kbase, int lane, bf16x8 (&kf)[2][2]) {
    const int l16 = lane & 15, g4 = lane >> 4;
#pragma unroll
    for (int tt = 0; tt < 2; ++tt)
#pragma unroll
        for (int ks = 0; ks < 2; ++ks) kf[tt][ks] = *(const bf16x8*)(kbase + (size_t)(16 * tt + l16) * 64 + ks * 32 + g4 * 8);
}
DEV void load_v(const bf16* vbase, int lane, bf16x8 (&vf)[4]) {
    const int l16 = lane & 15, g4 = lane >> 4;
#pragma unroll
    for (int dt = 0; dt < 4; ++dt) vf[dt] = *(const bf16x8*)(vbase + (size_t)(dt * 16 + l16) * 32 + g4 * 8);
}
DEV void qk_tile(const bf16x8 (&kf)[2][2], const bf16x8 (&qf)[2], f32x4 (&s)[2]) {
#pragma unroll
    for (int tt = 0; tt < 2; ++tt) { s[tt] = mfma16(kf[tt][0], qf[0], (f32x4){0.f, 0.f, 0.f, 0.f}); s[tt] = mfma16(kf[tt][1], qf[1], s[tt]); }
}
DEV bf16x8 pack_p(const float (&p)[2][4]) {
    v4u w; w.x = pk2(p[0][0], p[0][1]); w.y = pk2(p[0][2], p[0][3]); w.z = pk2(p[1][0], p[1][1]); w.w = pk2(p[1][2], p[1][3]);
    return __builtin_bit_cast(bf16x8, w);
}
template <int MODE, class MaskF>
DEV void attn_compute(const bf16x8 (&kf)[2][2], const bf16x8 (&vf)[4], const bf16x8 (&qf)[2], SmState& st, int lane, bool colok, MaskF mask) {
    const int g4 = lane >> 4;
    f32x4 s[2]; qk_tile(kf, qf, s);
    float sv[2][4]; float tmax = -INFINITY;
#pragma unroll
    for (int tt = 0; tt < 2; ++tt)
#pragma unroll
        for (int r = 0; r < 4; ++r) { float x = s[tt][r]; if (MODE == 2) x = mask(16 * tt + 4 * g4 + r) ? x : -INFINITY; sv[tt][r] = x; tmax = fmaxf(tmax, x); }
    if (MODE == 1) tmax = colok ? tmax : -INFINITY;
    tmax = fmaxf(tmax, __shfl_xor(tmax, 16)); tmax = fmaxf(tmax, __shfl_xor(tmax, 32));
    const float mnew = fmaxf(st.m, tmax), muse = (mnew == -INFINITY) ? 0.f : mnew;
    const float alpha = ex2(st.m - muse);
    const float msub = (MODE == 1) ? (colok ? muse : INFINITY) : muse;
    float p[2][4]; float ps = 0.f;
#pragma unroll
    for (int tt = 0; tt < 2; ++tt)
#pragma unroll
        for (int r = 0; r < 4; ++r) { p[tt][r] = ex2(sv[tt][r] - msub); ps += p[tt][r]; }
    st.l = st.l * alpha + ps; st.m = mnew;
    const bf16x8 pf = pack_p(p);
#pragma unroll
    for (int dt = 0; dt < 4; ++dt) { st.o[dt] = st.o[dt] * alpha; st.o[dt] = mfma16(vf[dt], pf, st.o[dt]); }
}
template <int MODE, class MaskF>
DEV void attn_compute_fixed(const bf16x8 (&kf)[2][2], const bf16x8 (&vf)[4], const bf16x8 (&qf)[2], SmState& st, float mref, int lane, bool colok, MaskF mask) {
    const int g4 = lane >> 4;
    f32x4 s[2]; qk_tile(kf, qf, s);
    const float msub = (MODE == 1) ? (colok ? mref : INFINITY) : mref;
    float p[2][4]; float ps = 0.f;
#pragma unroll
    for (int tt = 0; tt < 2; ++tt)
#pragma unroll
        for (int r = 0; r < 4; ++r) { float x = s[tt][r] - msub; if (MODE == 2) x = mask(16 * tt + 4 * g4 + r) ? x : -INFINITY; p[tt][r] = ex2(x); ps += p[tt][r]; }
    st.l += ps;
    const bf16x8 pf = pack_p(p);
#pragma unroll
    for (int dt = 0; dt < 4; ++dt) st.o[dt] = mfma16(vf[dt], pf, st.o[dt]);
}
template <int MODE, class MaskF>
DEV void attn_max(const bf16x8 (&kf)[2][2], const bf16x8 (&qf)[2], float& mx, int lane, bool colok, MaskF mask) {
    const int g4 = lane >> 4;
    f32x4 s[2]; qk_tile(kf, qf, s);
    float tmax = -INFINITY;
#pragma unroll
    for (int tt = 0; tt < 2; ++tt)
#pragma unroll
        for (int r = 0; r < 4; ++r) { float x = s[tt][r]; if (MODE == 2) x = mask(16 * tt + 4 * g4 + r) ? x : -INFINITY; tmax = fmaxf(tmax, x); }
    if (MODE == 1) tmax = colok ? tmax : -INFINITY;
    mx = fmaxf(mx, tmax);
}
DEV float colmax_finish(float mx) { mx = fmaxf(mx, __shfl_xor(mx, 16)); mx = fmaxf(mx, __shfl_xor(mx, 32)); return mx == -INFINITY ? 0.f : mx; }
DEV float col_norm(const bf16x8 (&qf)[2]) {
    float s = 0.f;
#pragma unroll
    for (int ks = 0; ks < 2; ++ks) { const v4u w = __builtin_bit_cast(v4u, qf[ks]);
#pragma unroll
        for (int j = 0; j < 4; ++j) { const float a = bflo(w[j]), b = bfhi(w[j]); s += a * a + b * b; } }
    s += __shfl_xor(s, 16); s += __shfl_xor(s, 32);
    return sqrtf(s);
}
DEV float wave_max_uniform(float v) {
#pragma unroll
    for (int o = 1; o < 64; o <<= 1) v = fmaxf(v, __shfl_xor(v, o));
    return __builtin_bit_cast(float, __builtin_amdgcn_readfirstlane(__builtin_bit_cast(int, v)));
}
constexpr float FIXED_REF_MAX = 40.f;
DEV void kmax_phase(Frame& F, int l) {
    const int lane = F.lane; const int gw = F.vcu * NWAVES + F.wave, NGW = F.G * NWAVES;
    for (int item = gw; item < 2048; item += NGW) {
        const int br = item >> 10, bh = (item >> 7) & 7, key = (item & 127) * 64 + lane;
        const bf16* kp = wsp<bf16>(F, br ? WS_KW : WS_KS) + ((size_t)bh * T + key) * 64;
        float s = 0.f;
#pragma unroll
        for (int i = 0; i < 8; ++i) { const v4u w = *(const v4u*)(kp + i * 8);
#pragma unroll
            for (int j = 0; j < 4; ++j) { const float a = bflo(w[j]), b = bfhi(w[j]); s += a * a + b * b; } }
#pragma unroll
        for (int o = 1; o < 64; o <<= 1) s = fmaxf(s, __shfl_xor(s, o));
        if (lane == 0) __hip_atomic_fetch_max((unsigned*)F.ctl + CW_KMAX + l * 16 + br * 8 + bh, __builtin_bit_cast(unsigned, s), RLX_AGENT);
    }
}
struct NoMask { DEV bool operator()(int) const { return true; } };
template <int D, bool WITHV, class AddrF, class BodyF>
DEV void pipe_run(int n, int lane, AddrF addr, BodyF body) {
    if (n <= 0) return;
    bf16x8 kf[D][2][2], vf[D][4];
#pragma unroll
    for (int d = 0; d < D; ++d) { const bf16* kb; const bf16* vb; addr(d < n ? d : n - 1, kb, vb); load_k(kb, lane, kf[d]); if (WITHV) load_v(vb, lane, vf[d]); }
#pragma unroll 1
    for (int i = 0; i < n; i += D) {
#pragma unroll
        for (int d = 0; d < D; ++d) { const int s = i + d;
            if (s < n) body(s, kf[d], vf[d]);
            if (D > 1 || s + 1 < n) { const bf16* kb; const bf16* vb; addr(s + D < n ? s + D : n - 1, kb, vb); load_k(kb, lane, kf[d]); if (WITHV) load_v(vb, lane, vf[d]); } }
    }
}
template <class AddrF, class BodyF>
DEV void pipe_run_k2(int n, int lane, AddrF addr, BodyF body) {
    if (n <= 0) return;
    bf16x8 kf[2][2][2], vf[4];
    { const bf16* kb; const bf16* vb; addr(0, kb, vb); load_k(kb, lane, kf[0]); }
#pragma unroll 1
    for (int i = 0; i < n; i += 2) {
#pragma unroll
        for (int d = 0; d < 2; ++d) { const int s = i + d;
            { const bf16* kb; const bf16* vb; addr(s < n ? s : n - 1, kb, vb); load_v(vb, lane, vf); }
            { const bf16* kb; const bf16* vb; addr(s + 1 < n ? s + 1 : n - 1, kb, vb); load_k(kb, lane, kf[d ^ 1]); }
            if (s < n) body(s, kf[d], vf); }
    }
}
constexpr int PIPE_D = 2;

DEV void acc_add_packed(unsigned (&pk)[4][4][2], int ct, const f32x4 (&o)[4], float sc, bool first) {
#pragma unroll
    for (int dt = 0; dt < 4; ++dt) {
        f32x4 v = o[dt] * sc;
        if (!first) { v[0] += bflo(pk[ct][dt][0]); v[1] += bfhi(pk[ct][dt][0]); v[2] += bflo(pk[ct][dt][1]); v[3] += bfhi(pk[ct][dt][1]); }
        pk[ct][dt][0] = pk2(v[0], v[1]); pk[ct][dt][1] = pk2(v[2], v[3]);
    }
}
template <int VAR>
DEV void nsa_phase_t(Frame& F, int l) {
#define NSA_RELANE() int ln_ = lane; asm volatile("" : "+v"(ln_)); const int l16 = ln_ & 15, g4 = ln_ >> 4, tq = l16 >> 2, gh = l16 & 3; const size_t mrow0 = (size_t)b * T + t0 + tq; const int tl0 = t0 + tq; (void)l16; (void)g4; (void)gh; (void)mrow0; (void)tl0
    float* IMP = (float*)(F.ldsg + F.wave * NSA_LDS_WAVE);
    float* VALS = IMP + 2048; int* BL = (int*)(IMP + 2176); unsigned* SELB = (unsigned*)(IMP + 2304); float* GL = IMP + 2432;
    const bf16* Q = wsp<bf16>(F, WS_Q);
    const bf16* KCC = wsp<bf16>(F, WS_KCC); const bf16* VCT = wsp<bf16>(F, WS_VCT);
    const bf16* KS = wsp<bf16>(F, WS_KS); const bf16* VST = wsp<bf16>(F, WS_VST);
    const bf16* KW = wsp<bf16>(F, WS_KW); const bf16* VWT = wsp<bf16>(F, WS_VWT);
    bf16* CAT = wsp<bf16>(F, WS_CAT);
    const int gw = F.vcu * NWAVES + F.wave, NGW = F.G * NWAVES;
    const bool xmap = (F.G == 256);
#pragma unroll 1
    for (int task = gw; task < 4096; task += NGW) {
        unsigned zl_ = 0u; asm volatile("" : "+v"(zl_)); const int lane = (int)__builtin_amdgcn_mbcnt_hi(~0u, __builtin_amdgcn_mbcnt_lo(~0u, zl_));
        const int bh = xmap ? (gw >> 8) : (task & 7), idx = xmap ? ((task >> 11) ? 511 - (gw & 255) : (gw & 255)) : (task >> 3);
        const int t0 = idx * 16, b = bh >> 1, hkv = bh & 1, cur = t0 >> 6;
        bf16x8 qf[4][2];
        unsigned opk[4][4][2];
        SmState st[4];
        float qnmax = 0.f;
        { NSA_RELANE();
#pragma unroll
        for (int ct = 0; ct < 4; ++ct)
#pragma unroll
            for (int ks = 0; ks < 2; ++ks) qf[ct][ks] = *(const bf16x8*)(Q + (mrow0 + 4 * ct) * 512 + hkv * 256 + gh * 64 + ks * 32 + g4 * 8);
        { NSA_RELANE();
          f32x4 ga[1]; ga[0] = (f32x4){0.f, 0.f, 0.f, 0.f};
          { const bf16* ap = wsp<bf16>(F, WS_HB) + ((size_t)b * T + t0 + l16) * 1024 + g4 * 8; const bf16* bp = wsp<bf16>(F, WS_WG) + (size_t)((l * 2 + hkv) * 16 + l16) * 1024 + g4 * 8;
#pragma unroll 1
            for (int k0 = 0; k0 < 1024; k0 += 256) {
                bf16x8 av[8], bv[8];
#pragma unroll
                for (int i = 0; i < 8; ++i) { av[i] = *(const bf16x8*)(ap + k0 + 32 * i); bv[i] = *(const bf16x8*)(bp + k0 + 32 * i); }
#pragma unroll
                for (int i = 0; i < 8; ++i) ga[0] = mfma16(av[i], bv[i], ga[0]);
            } }
          const float rs = (ln_ < 16) ? row_rstd_full(wsp<float>(F, WS_SSQ), b * T + t0 + ln_) : 0.f;
#pragma unroll
          for (int r = 0; r < 4; ++r) GL[(g4 * 4 + r) * 16 + l16] = sigmoidf_(ga[0][r] * __shfl(rs, g4 * 4 + r));
        }
        const int ngc = (t0 + 15 >= 31) ? (((t0 + 15 - 31) >> 4) >> 5) + 1 : 0;
        const bf16* kcb = KCC + (size_t)bh * 512 * 64; const bf16* vcb = VCT + (size_t)bh * 16 * 64 * 32;
        float cm[4], cl[4];
#pragma unroll
        for (int ct = 0; ct < 4; ++ct) { cm[ct] = -INFINITY; cl[ct] = 0.f; }
        pipe_run<1, false>(ngc, ln_, [&](int s, const bf16*& kb, const bf16*& vb) { kb = kcb + (size_t)s * 32 * 64; vb = vcb; },
            [&](int kg, const bf16x8 (&kf)[2][2], const bf16x8 (&)[4]) {
#pragma unroll
                for (int ct = 0; ct < 4; ++ct) {
                    const int tl = tl0 + 4 * ct;
                    f32x4 s[2]; qk_tile(kf, qf[ct], s);
                    float sv[2][4]; float tmax = -INFINITY;
#pragma unroll
                    for (int tt = 0; tt < 2; ++tt)
#pragma unroll
                        for (int r = 0; r < 4; ++r) { const int c = kg * 32 + 16 * tt + 4 * g4 + r; sv[tt][r] = (16 * c + 31 <= tl) ? s[tt][r] : -INFINITY; tmax = fmaxf(tmax, sv[tt][r]); }
                    tmax = fmaxf(tmax, __shfl_xor(tmax, 16)); tmax = fmaxf(tmax, __shfl_xor(tmax, 32));
                    const float mnew = fmaxf(cm[ct], tmax), muse = (mnew == -INFINITY) ? 0.f : mnew;
                    float ps = 0.f;
#pragma unroll
                    for (int tt = 0; tt < 2; ++tt)
#pragma unroll
                        for (int r = 0; r < 4; ++r) ps += ex2(sv[tt][r] - muse);
                    cl[ct] = cl[ct] * ex2(cm[ct] - muse) + ps; cm[ct] = mnew;
                }
            });
        {
            float cmu[4], cinv[4], carry[4];
#pragma unroll
            for (int ct = 0; ct < 4; ++ct) { float l = cl[ct]; l += __shfl_xor(l, 16); l += __shfl_xor(l, 32);
                cmu[ct] = (cm[ct] == -INFINITY) ? 0.f : cm[ct]; cinv[ct] = l > 0.f ? 1.0f / l : 0.f; carry[ct] = 0.f; sm_reset(st[ct]); }
            pipe_run<1, true>(ngc, ln_, [&](int s, const bf16*& kb, const bf16*& vb) { kb = kcb + (size_t)s * 32 * 64; vb = vcb + (size_t)s * 64 * 32; },
                [&](int kg, const bf16x8 (&kf)[2][2], const bf16x8 (&vf)[4]) {
#pragma unroll
                    for (int ct = 0; ct < 4; ++ct) {
                        const int tl = tl0 + 4 * ct;
                        f32x4 s[2]; qk_tile(kf, qf[ct], s);
                        float p[2][4];
#pragma unroll
                        for (int tt = 0; tt < 2; ++tt) {
#pragma unroll
                            for (int r = 0; r < 4; ++r) { const int c = kg * 32 + 16 * tt + 4 * g4 + r; p[tt][r] = (16 * c + 31 <= tl) ? ex2(s[tt][r] - cmu[ct]) * cinv[ct] : 0.f; }
                            const float hb = 0.5f * p[tt][3];
                            const float bsh = __shfl(hb, (ln_ + 48) & 63);
                            float v = ((p[tt][0] + p[tt][1]) + (p[tt][2] + hb)) + ((g4 == 0) ? carry[ct] : bsh);
                            carry[ct] = bsh;
                            v += __shfl_xor(v, 1); v += __shfl_xor(v, 2);
                            if (gh == 0) IMP[(4 * ct + tq) * 128 + kg * 8 + 4 * tt + g4] = v;
                        }
                        const bf16x8 pf = pack_p(p);
#pragma unroll
                        for (int dt = 0; dt < 4; ++dt) st[ct].o[dt] = mfma16(vf[dt], pf, st[ct].o[dt]);
                    }
                });
#pragma unroll
            for (int ct = 0; ct < 4; ++ct) acc_add_packed(opk, ct, st[ct].o, GL[(4 * ct + tq) * 16 + gh * 3 + 0], true);
        }
        }
        LDS_WAIT();
        unsigned sb0 = 0u, sb1 = 0u;
        if (cur < 16) { sb0 = (lane <= cur) ? 0xffffu : 0u; }
        else {
            const unsigned long long below = (1ull << lane) - 1ull;
#pragma unroll 1
            for (int q = 0; q < 16; ++q) {
                unsigned k0, k1;
                { const int j = lane; const float v = (j == 0 || j == cur || j == cur - 1) ? 1e6f : IMP[q * 128 + j]; k0 = (j > cur) ? 0u : __builtin_bit_cast(unsigned, v) + 1u; }
                { const int j = lane + 64; const float v = (j == cur || j == cur - 1) ? 1e6f : IMP[q * 128 + j]; k1 = (j > cur) ? 0u : __builtin_bit_cast(unsigned, v) + 1u; }
                unsigned lo = 0u, hi = 0xffffffffu;
                while (hi - lo > 1u) { const unsigned mid = lo + ((hi - lo) >> 1);
                    const int c = __builtin_popcountll(__ballot(k0 >= mid)) + __builtin_popcountll(__ballot(k1 >= mid));
                    if (c >= 16) lo = mid; else hi = mid; }
                const unsigned long long g0 = __ballot(k0 > lo), g1 = __ballot(k1 > lo), e0 = __ballot(k0 == lo), e1 = __ballot(k1 == lo);
                const int need = 16 - __builtin_popcountll(g0) - __builtin_popcountll(g1);
                const bool s0 = (k0 > lo) || (k0 == lo && __builtin_popcountll(e0 & below) < need);
                const bool s1 = (k1 > lo) || (k1 == lo && __builtin_popcountll(e0) + __builtin_popcountll(e1 & below) < need);
                sb0 |= (s0 ? 1u : 0u) << q; sb1 |= (s1 ? 1u : 0u) << q;
            }
        }
        SELB[lane] = sb0; SELB[lane + 64] = sb1;
        LDS_WAIT();
#define NSA_PARK() do { _Pragma("unroll") for (int i_ = 0; i_ < 8; ++i_) { v4u w_; w_.x = opk[i_ >> 1][(i_ & 1) * 2][0]; w_.y = opk[i_ >> 1][(i_ & 1) * 2][1]; w_.z = opk[i_ >> 1][(i_ & 1) * 2 + 1][0]; w_.w = opk[i_ >> 1][(i_ & 1) * 2 + 1][1]; ((v4u*)IMP)[i_ * 64 + lane] = w_; } } while (0)
#define NSA_UNPARK() do { _Pragma("unroll") for (int i_ = 0; i_ < 8; ++i_) { const v4u w_ = ((const v4u*)IMP)[i_ * 64 + lane]; opk[i_ >> 1][(i_ & 1) * 2][0] = w_.x; opk[i_ >> 1][(i_ & 1) * 2][1] = w_.y; opk[i_ >> 1][(i_ & 1) * 2 + 1][0] = w_.z; opk[i_ >> 1][(i_ & 1) * 2 + 1][1] = w_.w; } } while (0)
        NSA_PARK();
        { NSA_RELANE();
#pragma unroll
        for (int ct = 0; ct < 4; ++ct) {
            const float* rp = wsp<float>(F, WS_ROPE) + ((size_t)(tl0 + 4 * ct) * 32 + g4 * 8) * 2;
            const v4u a = __builtin_bit_cast(v4u, qf[ct][0]), b2 = __builtin_bit_cast(v4u, qf[ct][1]); v4u ra, rb;
#pragma unroll
            for (int jj = 0; jj < 4; ++jj) { const f32x4 cs = *(const f32x4*)(rp + 4 * jj);
                const float x1a = bflo(a[jj]), x1b = bfhi(a[jj]), x2a = bflo(b2[jj]), x2b = bfhi(b2[jj]);
                ra[jj] = pk2(x1a * cs[0] - x2a * cs[1], x1b * cs[2] - x2b * cs[3]);
                rb[jj] = pk2(x2a * cs[0] + x1a * cs[1], x2b * cs[2] + x1b * cs[3]); }
            qf[ct][0] = __builtin_bit_cast(bf16x8, ra); qf[ct][1] = __builtin_bit_cast(bf16x8, rb);
        }
        {
            const unsigned long long ulo = __ballot(sb0 != 0u), uhi = __ballot(sb1 != 0u);
            const unsigned long long below = (1ull << ln_) - 1ull;
            const int nlo = __builtin_popcountll(ulo), nblk = nlo + __builtin_popcountll(uhi);
            if (sb0 != 0u) BL[__builtin_popcountll(ulo & below)] = ln_;
            if (sb1 != 0u) BL[nlo + __builtin_popcountll(uhi & below)] = ln_ + 64;
            LDS_WAIT();
#pragma unroll
            for (int ct = 0; ct < 4; ++ct) sm_reset(st[ct]);
            const bf16* kb0 = KS + (size_t)bh * T * 64; const bf16* vb0 = VST + (size_t)bh * 256 * 64 * 32;
            float mr; bool fixed;
            { const float kmx = sqrtf(__builtin_bit_cast(float, __hip_atomic_load((const unsigned*)F.ctl + CW_KMAX + l * 16 + bh, RLX_AGENT))); float mm = 0.f;
#pragma unroll
              for (int ct = 0; ct < 4; ++ct) mm = fmaxf(mm, col_norm(qf[ct]));
              qnmax = wave_max_uniform(mm); mr = qnmax * kmx * 1.002f + 1e-3f;
              fixed = mr < FIXED_REF_MAX; }
            auto addr_sel = [&](int s, const bf16*& kb, const bf16*& vb) { const int g32 = BL[s >> 1] * 2 + (s & 1); kb = kb0 + (size_t)g32 * 32 * 64; vb = vb0 + (size_t)g32 * 64 * 32; };
            asm volatile("" ::: "memory");
            if (!fixed) {
                float mx[4] = {-INFINITY, -INFINITY, -INFINITY, -INFINITY};
                pipe_run<1, false>(2 * nblk, ln_, addr_sel,
                    [&](int s, const bf16x8 (&kf)[2][2], const bf16x8 (&)[4]) {
                        const int j = BL[s >> 1], key0 = j * 64 + (s & 1) * 32;
                        const unsigned tm = (unsigned)__builtin_amdgcn_readfirstlane((int)SELB[j]);
#pragma unroll
                        for (int ct = 0; ct < 4; ++ct) { const unsigned tmk = (tm >> (4 * ct)) & 0xFu;
                            if (tmk) { const bool colok = (tmk >> tq) & 1u; const int tl = tl0 + 4 * ct;
                                if (j == cur) attn_max<2>(kf, qf[ct], mx[ct], ln_, true, [&](int kk) { return colok && (key0 + kk <= tl); });
                                else attn_max<1>(kf, qf[ct], mx[ct], ln_, colok, NoMask()); } }
                    });
                mr = wave_max_uniform(fmaxf(fmaxf(mx[0], mx[1]), fmaxf(mx[2], mx[3]))); if (mr == -INFINITY) mr = 0.f;
            }
            asm volatile("" ::: "memory");
            pipe_run_k2(2 * nblk, ln_, addr_sel,
                [&](int s, const bf16x8 (&kf)[2][2], const bf16x8 (&vf)[4]) {
                    const int j = BL[s >> 1], key0 = j * 64 + (s & 1) * 32;
                    const unsigned tm = (unsigned)__builtin_amdgcn_readfirstlane((int)SELB[j]);
#pragma unroll
                    for (int ct = 0; ct < 4; ++ct) {
                        const unsigned tmk = (tm >> (4 * ct)) & 0xFu;
                        if (tmk) {
                            const bool colok = (tmk >> tq) & 1u; const int tl = tl0 + 4 * ct;
                            if (j == cur) attn_compute_fixed<2>(kf, vf, qf[ct], st[ct], mr, ln_, true, [&](int kk) { return colok && (key0 + kk <= tl); });
                            else attn_compute_fixed<1>(kf, vf, qf[ct], st[ct], mr, ln_, colok, NoMask());
                        }
                        __builtin_amdgcn_sched_barrier(0);
                    }
                });
            LDS_WAIT();
            NSA_UNPARK();
#pragma unroll
            for (int ct = 0; ct < 4; ++ct) { const float ls = sm_lsum(st[ct]); const float gs = GL[(4 * ct + tq) * 16 + gh * 3 + 1];
                acc_add_packed(opk, ct, st[ct].o, ls > 0.f ? gs / ls : 0.f, false); }
            NSA_PARK();
        }
        }
        { NSA_RELANE();
#pragma unroll
            for (int ct = 0; ct < 4; ++ct) sm_reset(st[ct]);
            const bf16* kb0 = (VAR == 3 ? KS : KW) + (size_t)bh * T * 64; const bf16* vb0 = (VAR == 3 ? VST : VWT) + (size_t)bh * 256 * 64 * 32;
            const int glo = (t0 - 511 > 0 ? t0 - 511 : 0) >> 5, ghi = (t0 + 15) >> 5;
            float mr; bool fixed;
            { const float kmx = sqrtf(__builtin_bit_cast(float, __hip_atomic_load((const unsigned*)F.ctl + CW_KMAX + l * 16 + 8 + bh, RLX_AGENT)));
              mr = qnmax * kmx * 1.002f + 1e-3f;
              fixed = mr < FIXED_REF_MAX; }
            auto addr_win = [&](int s, const bf16*& kb, const bf16*& vb) { kb = kb0 + (size_t)(glo + s) * 32 * 64; vb = vb0 + (size_t)(glo + s) * 64 * 32; };
            asm volatile("" ::: "memory");
            if (!fixed) {
                float mx[4] = {-INFINITY, -INFINITY, -INFINITY, -INFINITY};
                pipe_run<1, false>(ghi - glo + 1, ln_, addr_win,
                    [&](int s, const bf16x8 (&kf)[2][2], const bf16x8 (&)[4]) {
                        const int key0 = (glo + s) * 32;
#pragma unroll
                        for (int ct = 0; ct < 4; ++ct) { const int tl = tl0 + 4 * ct;
                            attn_max<2>(kf, qf[ct], mx[ct], ln_, true, [&](int kk) { const int kp = key0 + kk; return kp <= tl && kp + 512 > tl; }); }
                    });
                mr = wave_max_uniform(fmaxf(fmaxf(mx[0], mx[1]), fmaxf(mx[2], mx[3]))); if (mr == -INFINITY) mr = 0.f;
            }
            asm volatile("" ::: "memory");
            pipe_run_k2(ghi - glo + 1, ln_, addr_win,
                [&](int s, const bf16x8 (&kf)[2][2], const bf16x8 (&vf)[4]) {
                    const int key0 = (glo + s) * 32;
#pragma unroll
                    for (int ct = 0; ct < 4; ++ct) {
                        const int tlo = t0 + 4 * ct, thi = tlo + 3, tl = tl0 + 4 * ct;
                        if (key0 > thi || key0 + 31 + 512 <= tlo) continue;
                        if (key0 + 512 > thi && key0 + 31 <= tlo) attn_compute_fixed<0>(kf, vf, qf[ct], st[ct], mr, ln_, true, NoMask());
                        else attn_compute_fixed<2>(kf, vf, qf[ct], st[ct], mr, ln_, true, [&](int kk) { const int kp = key0 + kk; return kp <= tl && kp + 512 > tl; });
                        __builtin_amdgcn_sched_barrier(0);
                    }
                });
            NSA_UNPARK();
#pragma unroll
            for (int ct = 0; ct < 4; ++ct) { const float ls = sm_lsum(st[ct]); const float gwn = GL[(4 * ct + tq) * 16 + gh * 3 + 2];
                acc_add_packed(opk, ct, st[ct].o, ls > 0.f ? gwn / ls : 0.f, false); }
        }
        { NSA_RELANE();
#pragma unroll
        for (int ct = 0; ct < 4; ++ct)
#pragma unroll
            for (int dt = 0; dt < 4; ++dt) { v2u w; w.x = opk[ct][dt][0]; w.y = opk[ct][dt][1];
                if (VAR == 0 || w.x == 0x7fc17fc1u) *(v2u*)(CAT + (mrow0 + 4 * ct) * 1024 + hkv * 256 + gh * 64 + dt * 16 + g4 * 4) = w; }
        }
        LDS_WAIT();
        if (VAR == 0 && xmap) convert_experts(F, l, (bf16*)IMP, task >> 11);
    }
#undef NSA_RELANE
#undef NSA_PARK
#undef NSA_UNPARK
}

DEV void nsa_phase(Frame& F, int l) { nsa_phase_t<0>(F, l); }

DEV void cross_phase(Frame& F, int l) {
    const int lane = F.lane, l16 = lane & 15, g4 = lane >> 4;
    const bf16* XQ = wsp<bf16>(F, WS_XQ); bf16* XO = wsp<bf16>(F, WS_XO);
    const int gw = F.vcu * NWAVES + F.wave, NGW = F.G * NWAVES;
#pragma unroll 1
    for (int task = gw; task < 2048; task += NGW) {
        const int head = task & 3, m0 = (task >> 2) * 64, b = m0 >> 13;
        bf16x8 qf[4][2];
#pragma unroll
        for (int ct = 0; ct < 4; ++ct)
#pragma unroll
            for (int ks = 0; ks < 2; ++ks) qf[ct][ks] = *(const bf16x8*)(XQ + (size_t)(m0 + 16 * ct + l16) * 256 + head * 64 + ks * 32 + g4 * 8);
        const bf16* kb0 = wsp<bf16>(F, WS_MK) + (size_t)((l * 4 + b) * 4 + head) * 256 * 64;
        const bf16* vb0 = wsp<bf16>(F, WS_MVT) + (size_t)((l * 4 + b) * 4 + head) * 8 * 64 * 32;
        SmState st[4];
#pragma unroll
        for (int ct = 0; ct < 4; ++ct) sm_reset(st[ct]);
        pipe_run<PIPE_D, true>(8, lane, [&](int s, const bf16*& kb, const bf16*& vb) { kb = kb0 + (size_t)s * 32 * 64; vb = vb0 + (size_t)s * 64 * 32; },
            [&](int, const bf16x8 (&kf)[2][2], const bf16x8 (&vf)[4]) {
#pragma unroll
                for (int ct = 0; ct < 4; ++ct) attn_compute<0>(kf, vf, qf[ct], st[ct], lane, true, NoMask());
            });
#pragma unroll
        for (int ct = 0; ct < 4; ++ct) {
            const float inv = 1.0f / sm_lsum(st[ct]);
#pragma unroll
            for (int dt = 0; dt < 4; ++dt) { const f32x4 o = st[ct].o[dt] * inv; v2u w; w.x = pk2(o[0], o[1]); w.y = pk2(o[2], o[3]);
                *(v2u*)(XO + (size_t)(m0 + 16 * ct + l16) * 256 + head * 64 + dt * 16 + g4 * 4) = w; }
        }
    }
}


DEV void router_phase(Frame& F, int l, int probe = 0) {
    const int lane = F.lane, l16 = lane & 15, g4 = lane >> 4;
    float* LG = (float*)F.ldsg + F.wave * 768;
    const bf16* HB = wsp<bf16>(F, WS_HB); const float* SSQ = wsp<float>(F, WS_SSQ);
    const bf16* WR = wsp<bf16>(F, WS_WR) + (size_t)l * 96 * 1024;
    int* TOKE = wsp<int>(F, probe ? WS_PROBE : WS_TOKE); float* TOKG = wsp<float>(F, probe ? WS_PROBE + MiB : WS_TOKG); int* TOKP = wsp<int>(F, probe ? WS_PROBE + 2 * MiB : WS_TOKP);
    unsigned* CNT = (unsigned*)F.ctl + CW_CNT + l * 32 + (probe ? 64 : 0);
    const float* bg = inp(14) + l * 4; const float* be = inp(16) + l * 32;
    unsigned* HIST = (unsigned*)((float*)F.ldsg + 8 * 768);
#pragma unroll 1
    for (int tb = F.vcu * NWAVES; tb < NTOK / 16; tb += F.G * NWAVES) {
        const int task = tb + F.wave; const bool live = task < NTOK / 16;
        const int m0 = (live ? task : tb) * 16;
        if (F.tid < 64) HIST[F.tid] = 0u;
        f32x4 acc[3];
        {
            const bf16* ap = HB + (size_t)(m0 + l16) * 1024 + g4 * 8; const bf16* bp = WR + (size_t)l16 * 1024 + g4 * 8;
#pragma unroll
            for (int n = 0; n < 3; ++n) acc[n] = (f32x4){0.f, 0.f, 0.f, 0.f};
#pragma unroll 4
            for (int k = 0; k < 1024; k += 32) {
                const bf16x8 a = *(const bf16x8*)(ap + k);
#pragma unroll
                for (int n = 0; n < 3; ++n) { const bf16x8 bh = *(const bf16x8*)(bp + (size_t)n * 16 * 1024 + k), bl = *(const bf16x8*)(bp + (size_t)(48 + n * 16) * 1024 + k);
                    acc[n] = mfma16(a, bh, acc[n]); acc[n] = mfma16(a, bl, acc[n]); }
            }
        }
#pragma unroll
        for (int nt = 0; nt < 3; ++nt)
#pragma unroll
            for (int r = 0; r < 4; ++r) LG[(g4 * 4 + r) * 48 + nt * 16 + l16] = acc[nt][r];
        LDS_WAIT();
        int id1 = 0, id2 = 0;
        if (lane < 16) {
            const int m = m0 + lane; const float rstd = row_rstd_full(SSQ, m); const float* lg = LG + lane * 48;
            float g[4];
#pragma unroll
            for (int j = 0; j < 4; ++j) g[j] = lg[j] * rstd + bg[j];
            float gmax = g[0]; int grp = 0;
#pragma unroll
            for (int j = 1; j < 4; ++j) if (g[j] > gmax) { gmax = g[j]; grp = j; }
            float den = 0.f;
#pragma unroll
            for (int j = 0; j < 4; ++j) den += expf(g[j] - gmax);
            const float psel = 1.0f / den;
            float e1 = -INFINITY, e2 = -INFINITY; int i1 = 0, i2 = 0;
            for (int j = 0; j < 8; ++j) { const float v = lg[4 + grp * 8 + j] * rstd + be[grp * 8 + j];
                if (v > e1) { e2 = e1; i2 = i1; e1 = v; i1 = j; } else if (v > e2) { e2 = v; i2 = j; } }
            const float x = expf(e2 - e1), w1 = 1.0f / (1.0f + x), w2 = x * w1;
            id1 = grp * 8 + i1; id2 = grp * 8 + i2;
            if (live) { TOKE[m * 2] = id1; TOKE[m * 2 + 1] = id2; TOKG[m * 2] = psel * w1; TOKG[m * 2 + 1] = psel * w2; }
        }
        __syncthreads();
        unsigned lp1 = 0u, lp2 = 0u;
        if (lane < 16 && live) { lp1 = __hip_atomic_fetch_add(HIST + id1, 1u, __ATOMIC_RELAXED, __HIP_MEMORY_SCOPE_WORKGROUP); lp2 = __hip_atomic_fetch_add(HIST + id2, 1u, __ATOMIC_RELAXED, __HIP_MEMORY_SCOPE_WORKGROUP); }
        __syncthreads();
        if (F.tid < 32) { const unsigned c = HIST[F.tid]; HIST[32 + F.tid] = c ? __hip_atomic_fetch_add(CNT + F.tid, c, RLX_AGENT) : 0u; }
        __syncthreads();
        if (lane < 16 && live) { const int m = m0 + lane; TOKP[m * 2] = (int)(HIST[32 + id1] + lp1); TOKP[m * 2 + 1] = (int)(HIST[32 + id2] + lp2); }
        __syncthreads();
    }
}
DEV int moe_tables(Frame& F, int l) {
    int* tab = (int*)(F.ldsg + TAB_OFF);
    if (F.tid == 0) {
        const unsigned* CNT = (const unsigned*)F.ctl + CW_CNT + l * 32; int off = 0;
#pragma unroll 1
        for (int e = 0; e < 32; ++e) { tab[e] = off; const int c = (int)__hip_atomic_load(CNT + e, RLX_AGENT); const int nt = (c + 255) >> 8;
            for (int i = 0; i < nt; ++i) tab[40 + (off >> 8) + i] = e;
            off += nt << 8; }
        tab[32] = off;
    }
    __syncthreads();
    return tab[32];
}
DEV void gather_phase(Frame& F, int l) {
    (void)moe_tables(F, l);
    const int* tab = (const int*)(F.ldsg + TAB_OFF);
    const int lane = F.lane; const int gw = F.vcu * NWAVES + F.wave, NGW = F.G * NWAVES;
    const bf16* HB = wsp<bf16>(F, WS_HB); const float* SSQ = wsp<float>(F, WS_SSQ); bf16* XS = wsp<bf16>(F, WS_XS);
    const int* TOKE = wsp<int>(F, WS_TOKE); const float* TOKG = wsp<float>(F, WS_TOKG); const int* TOKP = wsp<int>(F, WS_TOKP); int* TOKS = wsp<int>(F, WS_TOKS);
    float* SRSTD = wsp<float>(F, WS_SRSTD); float* SGATE = wsp<float>(F, WS_SGATE);
    const unsigned* CNT = (const unsigned*)F.ctl + CW_CNT + l * 32;
#pragma unroll 1
    for (int m0 = gw; m0 < NTOK; m0 += 4 * NGW) {
        int s0[4], s1[4]; float g0[4], g1[4], rs[4]; v4u a[4], c[4];
#pragma unroll
        for (int k = 0; k < 4; ++k) { const int m = m0 + k * NGW; const bool ok = m < NTOK; const int mm = ok ? m : m0;
            const int e0 = TOKE[mm * 2], e1 = TOKE[mm * 2 + 1], p0 = TOKP[mm * 2], p1 = TOKP[mm * 2 + 1];
            g0[k] = TOKG[mm * 2]; g1[k] = TOKG[mm * 2 + 1];
            a[k] = *(const v4u*)(HB + (size_t)mm * 1024 + lane * 8); c[k] = *(const v4u*)(HB + (size_t)mm * 1024 + 512 + lane * 8);
            rs[k] = row_rstd_full(SSQ, mm);
            s0[k] = tab[e0] + p0; s1[k] = tab[e1] + p1; }
#pragma unroll
        for (int k = 0; k < 4; ++k) { const int m = m0 + k * NGW;
            if (m < NTOK) {
                *(v4u*)(XS + (size_t)s0[k] * 1024 + lane * 8) = a[k]; *(v4u*)(XS + (size_t)s0[k] * 1024 + 512 + lane * 8) = c[k];
                *(v4u*)(XS + (size_t)s1[k] * 1024 + lane * 8) = a[k]; *(v4u*)(XS + (size_t)s1[k] * 1024 + 512 + lane * 8) = c[k];
                if (lane == 0) { SRSTD[s0[k]] = rs[k]; SRSTD[s1[k]] = rs[k]; SGATE[s0[k]] = g0[k]; SGATE[s1[k]] = g1[k]; TOKS[m * 2] = s0[k]; TOKS[m * 2 + 1] = s1[k]; } } }
    }
#pragma unroll 1
    for (int e = 0; e < 32; ++e) {
        const int c = (int)__hip_atomic_load(CNT + e, RLX_AGENT), base = tab[e], end = (e == 31 ? tab[32] : tab[e + 1]);
        for (int r = base + c + gw; r < end; r += NGW) {
            *(v4u*)(XS + (size_t)r * 1024 + lane * 8) = (v4u){0u, 0u, 0u, 0u}; *(v4u*)(XS + (size_t)r * 1024 + 512 + lane * 8) = (v4u){0u, 0u, 0u, 0u};
            if (lane == 0) { SRSTD[r] = 0.f; SGATE[r] = 0.f; }
        }
    }
}
DEV void combine_phase(Frame& F, int l, int probe = 0) {
    const int lane = F.lane; const int gw = F.vcu * NWAVES + F.wave, NGW = F.G * NWAVES;
    float* Ho = probe ? wsp<float>(F, WS_PROBE) : (float*)(GAS float*)F.out; const bf16* HBi = wsp<bf16>(F, WS_HB); bf16* HB = wsp<bf16>(F, probe ? WS_PROBE + 128 * MiB : WS_HB); float* SSQ = wsp<float>(F, probe ? WS_PROBE + 192 * MiB : WS_SSQ); const bf16* YS = wsp<bf16>(F, WS_YS); const int* TOKS = wsp<int>(F, WS_TOKS);
    const float* gf = inp(23);
#pragma unroll 1
    for (int m0 = gw; m0 < NTOK; m0 += 2 * NGW) {
        f32x4 v[2][4]; float ssum[2];
        int sl[2][2];
#pragma unroll
        for (int k = 0; k < 2; ++k) { const int m = (m0 + k * NGW < NTOK) ? m0 + k * NGW : m0; sl[k][0] = TOKS[m * 2]; sl[k][1] = TOKS[m * 2 + 1]; }
        v2u h[2][4]; v2u ya[2][4], yb[2][4];
#pragma unroll
        for (int k = 0; k < 2; ++k) { const int m = (m0 + k * NGW < NTOK) ? m0 + k * NGW : m0;
#pragma unroll
            for (int j = 0; j < 4; ++j) { const int c = lane * 4 + 256 * j;
                h[k][j] = *(const v2u*)(HBi + (size_t)m * 1024 + c);
                ya[k][j] = *(const v2u*)(YS + (size_t)sl[k][0] * 1024 + c); yb[k][j] = *(const v2u*)(YS + (size_t)sl[k][1] * 1024 + c); } }
#pragma unroll
        for (int k = 0; k < 2; ++k) { float ss = 0.f;
#pragma unroll
            for (int j = 0; j < 4; ++j) { const v2u a = ya[k][j], bq = yb[k][j]; const f32x4 hh = (f32x4){bflo(h[k][j].x), bfhi(h[k][j].x), bflo(h[k][j].y), bfhi(h[k][j].y)};
                f32x4 r; r[0] = hh[0] + (bflo(a.x) + bflo(bq.x)); r[1] = hh[1] + (bfhi(a.x) + bfhi(bq.x)); r[2] = hh[2] + (bflo(a.y) + bflo(bq.y)); r[3] = hh[3] + (bfhi(a.y) + bfhi(bq.y));
                v[k][j] = r; ss += (r[0] * r[0] + r[1] * r[1]) + (r[2] * r[2] + r[3] * r[3]); }
            ssum[k] = wave_sum(ss); }
#pragma unroll
        for (int k = 0; k < 2; ++k) { const int m = m0 + k * NGW;
            if (m < NTOK) {
                if (l == DEPTH - 1) {
                    const float rstd = 1.0f / sqrtf(ssum[k] * (1.0f / 1024.0f) + RMS_EPS);
#pragma unroll
                    for (int j = 0; j < 4; ++j) { const int c = lane * 4 + 256 * j; const f32x4 g = *(const f32x4*)(gf + c); *(f32x4*)(Ho + (size_t)m * 1024 + c) = v[k][j] * rstd * g; }
                } else {
#pragma unroll
                    for (int j = 0; j < 4; ++j) { const int c = lane * 4 + 256 * j;
                        v2u w; w.x = pk2(v[k][j][0], v[k][j][1]); w.y = pk2(v[k][j][2], v[k][j][3]); *(v2u*)(HB + (size_t)m * 1024 + c) = w; }
                    if (lane < 16) SSQ[(size_t)m * 16 + lane] = lane == 0 ? ssum[k] : 0.f;
                } } }
    }
}
#ifndef MK_ONE_LAUNCH
#define MK_ONE_LAUNCH 1
#endif
constexpr int NPH_LAYER = 13, NPHASES = 1 + DEPTH * NPH_LAYER;
struct Args { const float* in[24]; float* out; unsigned char* ws; int ph_lo, ph_hi; };
static_assert(sizeof(Args) == 24 * 8 + 8 + 8 + 8, "Args has no padding");

__global__ void __launch_bounds__(NWAVES * 64, 2) hymba_fwd(Args args) {
    extern __shared__ __attribute__((aligned(16))) unsigned char lds[];
    Frame F;
    F.lds = (LAS unsigned char*)lds; F.ldsg = lds;
    F.MISC = (volatile LAS unsigned*)(F.lds + MISC_OFF);
    F.tid = threadIdx.x; F.lane = F.tid & 63; F.wave = __builtin_amdgcn_readfirstlane(F.tid >> 6);
    F.G = gridDim.x; { const int bx = blockIdx.x; F.vcu = (F.G % 8 == 0) ? (bx % 8) * (F.G / 8) + bx / 8 : bx; }
    F.ws = args.ws; F.ctl = (gu32*)(args.ws + WS_CTL); F.out = args.out;
    if (F.tid < 64) ((LAS unsigned*)(F.lds + MISC_OFF))[F.tid] = 0u;
    __syncthreads();
    int wave0 = F.wave;
    const int lo = args.ph_lo, hi = args.ph_hi;
    XcdBarrier bar; bar.bar = (unsigned*)(F.ctl + CW_BAR); bar.x = 0; bar.st = nullptr;
    if (hi - lo > 1) bar = xcd_barrier_post((unsigned*)(F.ctl + CW_BAR), F.MISC + 8);
#ifndef PHMASK
#define PHMASK 0xFFFF
#endif
#define IN(k) (lo <= (k) && (k) < hi)
#define EN(j) ((PHMASK >> (j)) & 1)
#define RELAUNDER() do { asm volatile("" : "+s"(wave0)); unsigned z_ = 0u; asm volatile("" : "+v"(z_)); int t_ = wave0 * 64 + (int)__builtin_amdgcn_mbcnt_hi(~0u, __builtin_amdgcn_mbcnt_lo(~0u, z_)); F.tid = t_; F.lane = t_ & 63; F.wave = wave0; \
    size_t zo_ = 0; asm volatile("" : "+s"(zo_), "+s"(F.vcu), "+s"(F.G)); F.ws = args.ws + zo_; F.out = args.out + zo_; F.ctl = (gu32*)(F.ws + WS_CTL); } while (0)
#ifndef NSA_VAR
#define NSA_VAR 0
#endif
#ifndef BAR2X
#define BAR2X 0
#endif
#ifndef DUPMASK
#define DUPMASK 0
#endif
#define DUP(j) ((DUPMASK >> (j)) & 1)
#ifndef STAG_J0
#define STAG_J0 0
#endif
#ifndef STAG_MOE
#define STAG_MOE 0
#endif
#define STAGGER(ticks) do { if ((ticks) > 0 && (F.vcu & 1)) { const unsigned long long t0_ = __builtin_amdgcn_s_memrealtime(); while (__builtin_amdgcn_s_memrealtime() - t0_ < (unsigned long long)(ticks)) __builtin_amdgcn_s_sleep(32); } } while (0)
#define SEAM(k) do { if (IN(k) && IN((k) + 1)) { XcdBarrier b_ = bar; size_t zb_ = 0; asm volatile("" : "+s"(b_.x), "+s"(zb_)); b_.bar = (unsigned*)(args.ws + WS_CTL + zb_) + CW_BAR; xcd_barrier(b_); if (BAR2X) xcd_barrier(b_); } } while (0)

    if (IN(0) && EN(13)) { RELAUNDER(); p0_prologue(F); if (DUP(13)) { __syncthreads(); p0_prologue(F); } } SEAM(0);

#pragma unroll 1
    for (int l = 0; l < DEPTH; ++l) {
        const int pb = 1 + l * NPH_LAYER;
        bf16* HB = wsp<bf16>(F, WS_HB); float* SSQ = wsp<float>(F, WS_SSQ);
        if (IN(pb + 0) && EN(0)) for (int rep_ = 0; rep_ < (DUP(0) ? 2 : 1); ++rep_) { RELAUNDER(); if (rep_) __syncthreads();
            pg8::Gemm g{HB, wsp<bf16>(F, WS_WIN) + (size_t)l * NIN * 1024, NTOK, 3072, D};
            pg8::StaticOrder S; S.init(NTOK, 3072, F.G, (int)blockIdx.x);
            EpiIn E{F.ws};
            STAGGER(STAG_J0);
            pg8::gemm_phase<EpiIn, pg8::StaticOrder, true, true>(F.lds, g, S, E, F.wave);
        }
        SEAM(pb + 0);
        if (IN(pb + 1) && EN(1)) { RELAUNDER();
            compress_phase(F, l);
            hgrn_local_phase(F, l);
            conv_phase(F, l);
            kmax_phase(F, l);
            if (l == 0) memkv_phase(F);
            if (DUP(1)) { __syncthreads(); compress_phase(F, l); hgrn_local_phase(F, l); conv_phase(F, l); }
        }
        SEAM(pb + 1);
        if (IN(pb + 2) && EN(2)) { RELAUNDER(); hgrn_scan_phase(F); if (DUP(14)) hgrn_scan_phase(F, 1); nsa_phase(F, l); if (DUP(2)) { __syncthreads(); nsa_phase_t<NSA_VAR>(F, l); } }
        SEAM(pb + 2);
        if (IN(pb + 3) && EN(3)) { RELAUNDER(); hgrn_out_phase(F, l); if (DUP(3)) { __syncthreads(); hgrn_out_phase(F, l); } }
        SEAM(pb + 3);
        if (IN(pb + 4) && EN(4)) for (int rep_ = 0; rep_ < ((DUP(4) && l == 0) ? 2 : 1); ++rep_) { RELAUNDER(); if (rep_) __syncthreads();
            pg8::Gemm g{wsp<bf16>(F, WS_CAT), wsp<bf16>(F, WS_WOUT) + (size_t)l * 1024 * 1024, NTOK, D, D};
            pg8::StaticOrder S; S.init(NTOK, D, F.G, (int)blockIdx.x);
            EpiRes E{l == 0 ? inp(0) : (const float*)nullptr, HB, SSQ};
            pg8::gemm_phase<EpiRes, pg8::StaticOrder, true, true>(F.lds, g, S, E, F.wave);
        }
        SEAM(pb + 4);
        if (IN(pb + 5) && EN(5)) for (int rep_ = 0; rep_ < (DUP(5) ? 2 : 1); ++rep_) { RELAUNDER(); if (rep_) __syncthreads();
            pg8::Gemm g{HB, wsp<bf16>(F, WS_WQ) + (size_t)l * 256 * 1024, NTOK, 256, D};
            pg8::StaticOrder S; S.init(NTOK, 256, F.G, (int)blockIdx.x);
            EpiXQ E{SSQ, wsp<bf16>(F, WS_XQ)};
            pg8::gemm_phase<EpiXQ, pg8::StaticOrder, true, true>(F.lds, g, S, E, F.wave);
        }
        SEAM(pb + 5);
        if (IN(pb + 6) && EN(6)) { RELAUNDER(); cross_phase(F, l); if (DUP(6)) { __syncthreads(); cross_phase(F, l); } }
        SEAM(pb + 6);
        if (IN(pb + 7) && EN(7)) { RELAUNDER();
            pg8::Gemm g{wsp<bf16>(F, WS_XO), wsp<bf16>(F, WS_WO) + (size_t)l * 1024 * 256, NTOK, D, 256};
            pg8::StaticOrder S; S.init(NTOK, D, F.G, (int)blockIdx.x);
            EpiRes E{(const float*)nullptr, HB, SSQ};
            pg8::gemm_phase<EpiRes, pg8::StaticOrder, true, true>(F.lds, g, S, E, F.wave);
        }
        SEAM(pb + 7);
        if (IN(pb + 8) && EN(8)) { RELAUNDER(); router_phase(F, l); if (DUP(8)) router_phase(F, l, 1); }
        SEAM(pb + 8);
        if (IN(pb + 9) && EN(9)) { RELAUNDER(); gather_phase(F, l); if (DUP(9)) { __syncthreads(); gather_phase(F, l); } }
        SEAM(pb + 9);
        if (IN(pb + 10) && EN(10)) for (int rep_ = 0; rep_ < (DUP(10) ? 2 : 1); ++rep_) { RELAUNDER(); if (rep_) __syncthreads();
            const int ns = moe_tables(F, l);
            pg8::Gemm g{wsp<bf16>(F, WS_XS), wsp<bf16>(F, WS_WGU) + (size_t)l * 32 * 1024 * 1024, ns, 32 * 1024, D};
            MoeOrder S{(ns >> 8) * 4, F.G, (int)blockIdx.x, (const LAS int*)(F.lds + TAB_OFF) + 40};
            EpiGU E{wsp<float>(F, WS_SRSTD), wsp<bf16>(F, WS_ACT)};
            STAGGER(STAG_MOE);
            pg8::gemm_phase<EpiGU, MoeOrder, true, true>(F.lds, g, S, E, F.wave);
        }
        SEAM(pb + 10);
        if (IN(pb + 11) && EN(11)) for (int rep_ = 0; rep_ < (DUP(11) ? 2 : 1); ++rep_) { RELAUNDER(); if (rep_) __syncthreads();
            const int ns = moe_tables(F, l);
            pg8::Gemm g{wsp<bf16>(F, WS_ACT), wsp<bf16>(F, WS_WDN) + (size_t)l * 32 * 1024 * 512, ns, 32 * 1024, 512};
            MoeOrder S{(ns >> 8) * 4, F.G, (int)blockIdx.x, (const LAS int*)(F.lds + TAB_OFF) + 40};
            EpiDN E{wsp<float>(F, WS_SGATE), wsp<bf16>(F, WS_YS)};
            STAGGER(STAG_MOE / 2);
            pg8::gemm_phase<EpiDN, MoeOrder, true, true>(F.lds, g, S, E, F.wave);
        }
        SEAM(pb + 11);
        if (IN(pb + 12) && EN(12)) { RELAUNDER(); combine_phase(F, l); if (DUP(12)) combine_phase(F, l, 1); }
        SEAM(pb + 12);
    }
#undef IN
#undef SEAM
}

extern "C" void kernel_launch(void* const* d_in, const int* in_sizes, int n_in, void* d_out, int out_size, void* d_ws, size_t ws_size, hipStream_t stream) {
    static int grid = 0;
    if (grid == 0) {
        if (n_in != 24 || in_sizes[0] != NTOK * D || out_size != NTOK * D || ws_size < WS_END) {
            fprintf(stderr, "kernel_launch: unexpected shapes: n_in %d in0 %d out %d ws %zu (need %zu)\n", n_in, n_in > 0 ? in_sizes[0] : -1, out_size, ws_size, (size_t)WS_END); grid = -1; return; }
        int dev = 0, cus = 0, per_cu = 0;
        if (hipGetDevice(&dev) != hipSuccess || hipDeviceGetAttribute(&cus, hipDeviceAttributeMultiprocessorCount, dev) != hipSuccess) { grid = -1; return; }
        if (hipFuncSetAttribute((const void*)hymba_fwd, hipFuncAttributeMaxDynamicSharedMemorySize, LDS_BYTES) != hipSuccess) { fprintf(stderr, "kernel_launch: hipFuncSetAttribute failed\n"); grid = -1; return; }
        if (hipOccupancyMaxActiveBlocksPerMultiprocessor(&per_cu, (const void*)hymba_fwd, NWAVES * 64, LDS_BYTES) != hipSuccess || per_cu < 1)
            fprintf(stderr, "kernel_launch: note: occupancy query reports %d blocks per CU\n", per_cu);
        (void)hipGetLastError();
        grid = cus;
    }
    if (grid < 0) return;
    if (hipMemsetAsync((char*)d_ws + WS_CTL, 0, CTL_ZERO_BYTES, stream) != hipSuccess) { fprintf(stderr, "kernel_launch: memset failed\n"); return; }
    Args a{};
    for (int i = 0; i < 24; ++i) a.in[i] = (const float*)d_in[i];
    a.out = (float*)d_out; a.ws = (unsigned char*)d_ws;
#if MK_ONE_LAUNCH
    a.ph_lo = 0; a.ph_hi = NPHASES;
    hipLaunchKernelGGL(hymba_fwd, dim3(grid), dim3(NWAVES * 64), LDS_BYTES, stream, a);
#else
    for (int p = 0; p < NPHASES; ++p) { a.ph_lo = p; a.ph_hi = p + 1; hipLaunchKernelGGL(hymba_fwd, dim3(grid), dim3(NWAVES * 64), LDS_BYTES, stream, a); }
#endif
    const hipError_t le = hipPeekAtLastError();
    if (le != hipSuccess) fprintf(stderr, "kernel_launch: launch failed: %s\n", hipGetErrorName(le));
}
```

```cpp
#define MK_ONE_LAUNCH 1
#include <hip/hip_runtime.h>
#include <cstdio>
#include <cstdint>
#include <cmath>
namespace pg8 {
#define PG8_LAS __attribute__((address_space(3)))
typedef unsigned short bf16_t;
typedef short bf16x8 __attribute__((ext_vector_type(8)));
typedef float f32x4 __attribute__((ext_vector_type(4)));
typedef unsigned u32x4 __attribute__((ext_vector_type(4)));
constexpr int BM = 256, BK = 64, HALF = 128, HTB = HALF * BK * 2  , STAGE_BYTES = 8 * HTB, NXCD = 8, WGM = 8;

__host__ __device__ __forceinline__ int lds_byte(int r, int c) { const int st = (r >> 4) * 2 + (c >> 5), rr = r & 15, cc = c & 31, ob = rr * 64 + cc * 2; return st * 1024 + (ob ^ (((ob >> 9) & 1) << 5)); }
__host__ __device__ __forceinline__ void stage_rc(int b, int& R, int& C) { const int st = b / 1024, sb = b % 1024, swz = sb ^ (((sb >> 9) & 1) << 5); R = (st >> 1) * 16 + swz / 64; C = (st & 1) * 32 + (swz % 64) / 2; }
__host__ __device__ __forceinline__ int perm32(int rho) { const int n = rho >> 4, i = rho & 15; return 8 * (i >> 2) + 4 * n + (i & 3); }

struct Unit { int pm, pn; };
struct Gemm { const bf16_t* A; const bf16_t* Bt; int M, N, K; };

struct StaticOrder {
    int nM, nN, nwg, G, c;
    __host__ __device__ void init(int M, int N, int G_, int c_) { nM = M / BM; nN = N / BM; nwg = nM * nN; G = G_; c = c_; }
    __host__ __device__ bool next(int i, Unit& u) const {
        const long L = (long)i * G + c; if (L >= nwg) return false;
        int wgid = (int)L; { const int q = nwg / NXCD, r = nwg % NXCD, xcd = wgid % NXCD, off = wgid / NXCD; wgid = (xcd < r ? xcd * (q + 1) : r * (q + 1) + (xcd - r) * q) + off; }
        const int nig = WGM * nN, gid = wgid / nig, fm = gid * WGM, gsz = (nM - fm) < WGM ? (nM - fm) : WGM;
        u.pm = fm + ((wgid % nig) % gsz); u.pn = (wgid % nig) / gsz; return true;
    }
    __device__ __forceinline__ void a_ready(const Unit&) const {}
    __device__ __forceinline__ void done(const Unit&) const {}
};

__device__ __forceinline__ unsigned cvt_pk_bf16(float lo, float hi) { unsigned r; asm volatile("v_cvt_pk_bf16_f32 %0, %1, %2" : "=v"(r) : "v"(lo), "v"(hi)); return r; }
typedef float f32x2 __attribute__((ext_vector_type(2)));
template <class Epi, class Sched, bool ALIGN_EPI = false, bool SP2 = false>
__device__ __forceinline__ void gemm_phase(PG8_LAS unsigned char* lds, const Gemm g, const Sched& S, const Epi& E, int wave_id) {
    unsigned z_ = 0u; asm volatile("" : "+v"(z_)); int tid_ = wave_id * 64 + (int)__builtin_amdgcn_mbcnt_hi(~0u, __builtin_amdgcn_mbcnt_lo(~0u, z_));
    const int tid = tid_, wid = __builtin_amdgcn_readfirstlane(tid >> 6), lane = tid & 63, wr = wid >> 2, wc = wid & 3, fr = lane & 15, fq = lane >> 4;
    const int K = g.K, nt = K / BK;
    unsigned voffA[2], voffB[2];
#pragma unroll
    for (int i = 0; i < 2; ++i) { int R, C; stage_rc(tid * 16 + i * 8192, R, C); const int Rb = Epi::PERM ? ((R & ~31) + perm32(R & 31)) : R;
        voffA[i] = (unsigned)(R * K + C) * 2u; voffB[i] = (unsigned)(Rb * K + C) * 2u; }
    const size_t kstep = (size_t)(BK * 2);
    const size_t hstep = (size_t)HALF * K * 2;
    const size_t tstep = 2 * hstep;
    const unsigned ldsw = (unsigned)wid * 1024u;
    const int aoff = lds_byte(wr * 64 + fr, fq * 8), boff = lds_byte(wc * 32 + fr, fq * 8);
#define PG8_SA(b, h) (((b) * 2 + (h)) * HTB)
#define PG8_SB(b, h) ((4 + (b) * 2 + (h)) * HTB)
#define PG8_STAGE(bufoff, gbase, voff) do { _Pragma("unroll") for (int _i = 0; _i < 2; ++_i) \
        __builtin_amdgcn_global_load_lds((const unsigned*)((const char*)(gbase) + (voff)[_i]), (PG8_LAS unsigned*)(lds + (bufoff) + ldsw + _i * 8192), 16, 0, 0); } while (0)
#define PG8_LDA(dst, b, h) do { _Pragma("unroll") for (int m = 0; m < 4; ++m) _Pragma("unroll") for (int k = 0; k < 2; ++k) dst[m][k] = *(const PG8_LAS bf16x8*)(lds + PG8_SA(b, h) + aoff + m * 2048 + k * 1024); } while (0)
#define PG8_LDB(dst, b, h) do { _Pragma("unroll") for (int n = 0; n < 2; ++n) _Pragma("unroll") for (int k = 0; k < 2; ++k) dst[n][k] = *(const PG8_LAS bf16x8*)(lds + PG8_SB(b, h) + boff + n * 2048 + k * 1024); } while (0)
#define PG8_MMA(ai, bj, At, Bt) do { __builtin_amdgcn_s_setprio(1); _Pragma("unroll") for (int m = 0; m < 4; ++m) _Pragma("unroll") for (int n = 0; n < 2; ++n) _Pragma("unroll") for (int k = 0; k < 2; ++k) \
        acc[ai][bj][m][n] = __builtin_amdgcn_mfma_f32_16x16x32_bf16(Bt[n][k], At[m][k], acc[ai][bj][m][n], 0, 0, 0); __builtin_amdgcn_s_setprio(0); } while (0)
#define PG8_WAIT_V(n) asm volatile("s_waitcnt vmcnt(" #n ")" ::: "memory")
#define PG8_WAIT_L(n) asm volatile("s_waitcnt lgkmcnt(" #n ")" ::: "memory")
#define PG8_BAR __builtin_amdgcn_s_barrier()
#define PG8_SCHED __builtin_amdgcn_sched_barrier(0)
    Unit cur, nxt; int ui = 0;
    if (!S.next(0, cur)) return;
    f32x4 acc[2][2][4][2];
#pragma unroll
    for (int a = 0; a < 2; ++a)
#pragma unroll
        for (int b = 0; b < 2; ++b)
#pragma unroll
            for (int m = 0; m < 4; ++m)
#pragma unroll
                for (int n = 0; n < 2; ++n) acc[a][b][m][n] = (f32x4){0.f, 0.f, 0.f, 0.f};
    bf16x8 At[4][2], B0[2][2], B1[2][2];
    const char* cA = (const char*)g.A + (size_t)cur.pm * tstep; const char* cB = (const char*)g.Bt + (size_t)cur.pn * tstep;
    S.a_ready(cur);
    if constexpr (SP2) {
        PG8_STAGE(PG8_SB(0, 0), cB, voffB); PG8_STAGE(PG8_SB(0, 1), cB + hstep, voffB); PG8_STAGE(PG8_SA(0, 0), cA, voffA); PG8_STAGE(PG8_SA(0, 1), cA + hstep, voffA);
        if (wr == 1) PG8_BAR;
        PG8_WAIT_V(2); PG8_BAR;
        PG8_STAGE(PG8_SB(1, 0), cB + kstep, voffB); PG8_STAGE(PG8_SA(1, 0), cA + kstep, voffA); PG8_STAGE(PG8_SB(1, 1), cB + hstep + kstep, voffB);
        PG8_WAIT_V(6); PG8_BAR;
    } else {
        PG8_STAGE(PG8_SB(0, 0), cB, voffB); PG8_STAGE(PG8_SA(0, 0), cA, voffA); PG8_STAGE(PG8_SB(0, 1), cB + hstep, voffB); PG8_STAGE(PG8_SA(0, 1), cA + hstep, voffA);
        if (wr == 1) PG8_BAR;
        PG8_WAIT_V(4); PG8_BAR;
        PG8_STAGE(PG8_SB(1, 0), cB + kstep, voffB); PG8_STAGE(PG8_SA(1, 0), cA + kstep, voffA); PG8_STAGE(PG8_SB(1, 1), cB + hstep + kstep, voffB);
        PG8_WAIT_V(6); PG8_BAR;
    }
    for (;;) {
        const bool has_next = S.next(ui + 1, nxt);
        const char* nA = has_next ? (const char*)g.A + (size_t)nxt.pm * tstep : cA; const char* nB = has_next ? (const char*)g.Bt + (size_t)nxt.pn * tstep : cB;
        for (int t = 0; t < nt; t += 2) {
            const bool last = (t == nt - 2);
            const char* a1 = cA + (size_t)(t + 1) * kstep;
            const char* a2 = last ? nA : cA + (size_t)(t + 2) * kstep; const char* b2 = last ? nB : cB + (size_t)(t + 2) * kstep;
            const char* a3 = a2 + kstep; const char* b3 = b2 + kstep;
            if (last && has_next) S.a_ready(nxt);
            if constexpr (SP2) {
            PG8_LDB(B0, 0, 0); PG8_LDB(B1, 0, 1); PG8_SCHED; PG8_LDA(At, 0, 0); PG8_STAGE(PG8_SA(1, 1), a1 + hstep, voffA);
            PG8_WAIT_V(8); PG8_WAIT_L(0); PG8_BAR; PG8_MMA(0, 0, At, B0); PG8_MMA(0, 1, At, B1); PG8_BAR; PG8_SCHED;
            PG8_LDA(At, 0, 1); PG8_STAGE(PG8_SB(0, 0), b2, voffB); PG8_STAGE(PG8_SB(0, 1), b2 + hstep, voffB); PG8_STAGE(PG8_SA(0, 0), a2, voffA);
            PG8_WAIT_V(8); PG8_WAIT_L(0); PG8_BAR; PG8_MMA(1, 0, At, B0); PG8_MMA(1, 1, At, B1); PG8_BAR; PG8_SCHED;
            PG8_LDB(B0, 1, 0); PG8_LDB(B1, 1, 1); PG8_SCHED; PG8_LDA(At, 1, 0); PG8_STAGE(PG8_SA(0, 1), a2 + hstep, voffA);
            PG8_WAIT_V(8); PG8_WAIT_L(0); PG8_BAR; PG8_MMA(0, 0, At, B0); PG8_MMA(0, 1, At, B1); PG8_BAR; PG8_SCHED;
            PG8_LDA(At, 1, 1); PG8_STAGE(PG8_SB(1, 0), b3, voffB); PG8_STAGE(PG8_SB(1, 1), b3 + hstep, voffB); PG8_STAGE(PG8_SA(1, 0), a3, voffA);
            PG8_WAIT_V(8); PG8_WAIT_L(0); PG8_BAR; PG8_MMA(1, 0, At, B0); PG8_MMA(1, 1, At, B1); PG8_BAR; PG8_SCHED;
            } else {
            PG8_LDB(B0, 0, 0); PG8_SCHED; PG8_LDA(At, 0, 0); PG8_STAGE(PG8_SA(1, 1), a1 + hstep, voffA);
            PG8_WAIT_L(8); PG8_BAR; PG8_WAIT_L(0); PG8_MMA(0, 0, At, B0); PG8_BAR; PG8_SCHED;
            PG8_LDB(B1, 0, 1); PG8_STAGE(PG8_SB(0, 0), b2, voffB);
            PG8_BAR; PG8_WAIT_L(0); PG8_MMA(0, 1, At, B1); PG8_BAR;
            PG8_LDA(At, 0, 1); PG8_STAGE(PG8_SA(0, 0), a2, voffA);
            PG8_BAR; PG8_WAIT_L(0); PG8_MMA(1, 0, At, B0); PG8_BAR; PG8_SCHED;
            PG8_STAGE(PG8_SB(0, 1), b2 + hstep, voffB);
            PG8_WAIT_V(6); PG8_BAR; PG8_MMA(1, 1, At, B1); PG8_BAR;
            PG8_LDB(B0, 1, 0); PG8_SCHED; PG8_LDA(At, 1, 0); PG8_STAGE(PG8_SA(0, 1), a2 + hstep, voffA);
            PG8_WAIT_L(8); PG8_BAR; PG8_WAIT_L(0); PG8_MMA(0, 0, At, B0); PG8_BAR; PG8_SCHED;
            PG8_LDB(B1, 1, 1); PG8_STAGE(PG8_SB(1, 0), b3, voffB);
            PG8_BAR; PG8_WAIT_L(0); PG8_MMA(0, 1, At, B1); PG8_BAR;
            PG8_LDA(At, 1, 1); PG8_STAGE(PG8_SA(1, 0), a3, voffA);
            PG8_BAR; PG8_WAIT_L(0); PG8_MMA(1, 0, At, B0); PG8_BAR; PG8_SCHED;
            PG8_STAGE(PG8_SB(1, 1), b3 + hstep, voffB);
            PG8_WAIT_V(6); PG8_BAR; PG8_MMA(1, 1, At, B1); PG8_BAR;
            }
        }
        if constexpr (ALIGN_EPI) { if (wr == 0) PG8_BAR; }
        if constexpr (!Epi::AFTER_DRAIN) { E(acc, cur, wr, wc, fr, fq); S.done(cur); }
        if (!has_next) break;
#pragma unroll
        for (int a = 0; a < 2; ++a)
#pragma unroll
            for (int b = 0; b < 2; ++b)
#pragma unroll
                for (int m = 0; m < 4; ++m)
#pragma unroll
                    for (int n = 0; n < 2; ++n) acc[a][b][m][n] = (f32x4){0.f, 0.f, 0.f, 0.f};
        cur = nxt; cA = nA; cB = nB; ++ui;
        if constexpr (ALIGN_EPI) { if (wr == 1) PG8_BAR; }
    }
    PG8_WAIT_V(0);
    if constexpr (!ALIGN_EPI) { if (wr == 0) PG8_BAR; }
    PG8_BAR;
    if constexpr (Epi::AFTER_DRAIN) { E.fused(acc, cur, wr, wc, fr, fq, lds, wid, lane); S.done(cur); }
#undef PG8_SA
#undef PG8_SB
#undef PG8_STAGE
#undef PG8_LDA
#undef PG8_LDB
#undef PG8_MMA
#undef PG8_WAIT_V
#undef PG8_WAIT_L
#undef PG8_BAR
#undef PG8_SCHED
}
}
constexpr int NB = 4, T = 8192, D = 1024, NTOK = NB * T, DEPTH = 2;
constexpr int NIN = 3328;
constexpr int IN_W = 3096;
constexpr int NSLOT_MAX = 65536 + 32 * 256;
constexpr float RMS_EPS = 1e-6f;
constexpr float QSCALE = 0.125f * 1.44269504088896f;
constexpr int NWAVES = 8;

constexpr size_t MiB = 1u << 20;
constexpr size_t WS_CTL = 0, CTL_ZERO_BYTES = 1 * MiB;
constexpr size_t WS_ROPE = 1 * MiB;
constexpr size_t WS_SMALL = 3 * MiB;
constexpr size_t WS_WG = 3 * MiB + 65536;
constexpr size_t WS_SSQ = 4 * MiB;
constexpr size_t WS_WIN = 8 * MiB;
constexpr size_t WS_WOUT = 22 * MiB;
constexpr size_t WS_WQ = 26 * MiB;
constexpr size_t WS_WKV = 27 * MiB;
constexpr size_t WS_WO = 29 * MiB;
constexpr size_t WS_WR = 30 * MiB;
constexpr size_t WS_W1C = 31 * MiB;
constexpr size_t WS_W2C = 33 * MiB;
constexpr size_t WS_MEMB = 34 * MiB;
constexpr size_t WS_MK = 36 * MiB;
constexpr size_t WS_MVT = 37 * MiB;
constexpr size_t WS_WGU = 40 * MiB;
constexpr size_t WS_WDN = 168 * MiB;
constexpr size_t WS_HB = 232 * MiB;
constexpr size_t WS_Q = 296 * MiB, WS_QR = 328 * MiB, WS_KCR = 360 * MiB, WS_VCR = 368 * MiB, WS_KS = 376 * MiB, WS_KW = 384 * MiB;
constexpr size_t WS_VST = 392 * MiB, WS_VWT = 400 * MiB, WS_KCC = 408 * MiB, WS_VCT = 409 * MiB, WS_GATE = 410 * MiB;
constexpr size_t WS_CB = 414 * MiB, WS_CC = 430 * MiB, WS_CH = 446 * MiB;
constexpr size_t WS_HQ = 462 * MiB, WS_HF = 494 * MiB, WS_HI = 526 * MiB, WS_HG = 558 * MiB;
constexpr size_t WS_CAT = 590 * MiB, WS_U = 654 * MiB, WS_DEC = 686 * MiB;
constexpr size_t WS_XQ = 688 * MiB, WS_XO = 704 * MiB;
constexpr size_t WS_XS = 296 * MiB, WS_ACT = 440 * MiB, WS_YS = 512 * MiB;
constexpr size_t WS_TOKE = 720 * MiB, WS_TOKG = 721 * MiB, WS_TOKP = 722 * MiB, WS_TOKS = 723 * MiB, WS_SRSTD = 724 * MiB, WS_SGATE = 725 * MiB;
constexpr size_t WS_U2 = 728 * MiB;
constexpr size_t WS_PROBE = 760 * MiB;
constexpr size_t WS_END = 760 * MiB;
static_assert(WS_XS + (size_t)NSLOT_MAX * 1024 * 2 <= WS_ACT && WS_ACT + (size_t)NSLOT_MAX * 512 * 2 <= WS_YS && WS_YS + (size_t)NSLOT_MAX * 1024 * 2 <= WS_XQ, "moe map");
constexpr int CW_CNT = 64;
constexpr int CW_KMAX = 256;
constexpr int CW_BAR = 4096;

constexpr int RING_BYTES = 131072;
constexpr int NSA_LDS_WAVE = 10752;
constexpr int MISC_OFF = RING_BYTES;
constexpr int TAB_OFF = RING_BYTES + 512;
constexpr int LDS_BYTES = 147456;
static_assert(8 * NSA_LDS_WAVE <= RING_BYTES && TAB_OFF + 4 * (40 + 320) <= LDS_BYTES, "LDS map");

#define GAS __attribute__((address_space(1)))
#define LAS __attribute__((address_space(3)))
#define DEV __device__ __forceinline__
typedef unsigned short bf16;
typedef unsigned v4u __attribute__((ext_vector_type(4)));
typedef unsigned v2u __attribute__((ext_vector_type(2)));
typedef float f32x4 __attribute__((ext_vector_type(4)));
typedef short bf16x8 __attribute__((ext_vector_type(8)));
typedef GAS unsigned gu32;
#define RLX_AGENT __ATOMIC_RELAXED, __HIP_MEMORY_SCOPE_AGENT
#define LDS_WAIT() asm volatile("s_waitcnt lgkmcnt(0)" ::: "memory")
#define VM_WAIT() asm volatile("s_waitcnt vmcnt(0)" ::: "memory")
typedef __bf16 bf16x2_t __attribute__((ext_vector_type(2)));
typedef float f32x2_t __attribute__((ext_vector_type(2)));
DEV unsigned pk2(float lo, float hi) { const f32x2_t v = {lo, hi}; return __builtin_bit_cast(unsigned, __builtin_convertvector(v, bf16x2_t)); }
DEV unsigned f2bf(float f) { return pk2(f, 0.f) & 0xffffu; }
DEV float bf2f(unsigned short b) { return __builtin_bit_cast(float, (unsigned)b << 16); }
DEV float bflo(unsigned w) { return __builtin_bit_cast(float, w << 16); }
DEV float bfhi(unsigned w) { return __builtin_bit_cast(float, w & 0xffff0000u); }
DEV float ex2(float x) { return __builtin_amdgcn_exp2f(x); }
DEV float wave_sum(float v) {
#pragma unroll
    for (int o = 1; o < 64; o <<= 1) v += __shfl_xor(v, o);
    return v;
}
DEV f32x4 mfma16(bf16x8 a, bf16x8 b, f32x4 c) { return __builtin_amdgcn_mfma_f32_16x16x32_bf16(a, b, c, 0, 0, 0); }
DEV int slot32(int k) { return ((k >> 2) & 3) * 8 + (k >> 4) * 4 + (k & 3); }
DEV float sigmoidf_(float x) { return 1.0f / (1.0f + __expf(-x)); }
DEV float siluf_(float x) { return x / (1.0f + __expf(-x)); }
#define XB_TMO      128
#define XB_XCNT(j)  (256  + 64 * (j))
#define XB_XSUB(j)  (1280 + 64 * (j))
#define XB_XGEN(j)  (2304 + 64 * (j))
#define XB_TOP      3328
#define XB_TOPGEN   3392
#define XCD_BAR_WORDS 3456
#define XB_SPIN_CAP (1u << 18)

__device__ __forceinline__ unsigned xb_ld(unsigned* p)              { return __hip_atomic_load(p, __ATOMIC_RELAXED, __HIP_MEMORY_SCOPE_AGENT); }
__device__ __forceinline__ unsigned xb_add(unsigned* p, unsigned v) { return __hip_atomic_fetch_add(p, v, __ATOMIC_RELAXED, __HIP_MEMORY_SCOPE_AGENT); }
__device__ __forceinline__ unsigned xb_xcc_id() { return (unsigned)__builtin_amdgcn_s_getreg((3 << 11) | 20) & 0xFu; }
#define XB_SPIN(cond, bar) do { unsigned _sp = 0; while (cond) { __builtin_amdgcn_s_sleep(1); \
    if ((++_sp & 255u) == 0u) { if (xb_ld(&(bar)[XB_TMO])) break; if (_sp > XB_SPIN_CAP) { atomicAdd(&(bar)[XB_TMO], 1u); break; } } } } while (0)

struct XcdBarrier {
    unsigned* bar; unsigned x;
    volatile LAS unsigned* st;
};

__device__ __forceinline__ XcdBarrier xcd_barrier_post(unsigned* bar, volatile LAS unsigned* st) {
    XcdBarrier b; b.bar = bar; b.x = xb_xcc_id(); b.st = st;
    if (threadIdx.x == 0) (void)xb_add(&bar[XB_XCNT(b.x)], 1u);
    return b;
}
__device__ __forceinline__ void xcd_barrier_complete(unsigned* bar, unsigned x, unsigned& nloc, unsigned& nx) {
    const unsigned G = gridDim.x * gridDim.y * gridDim.z;
    unsigned sum, cnt, mine, sp = 0u;
    for (;;) {
        sum = 0u; cnt = 0u; mine = 0u;
#pragma unroll
        for (unsigned j = 0; j < 16; ++j) { const unsigned c = xb_ld(&bar[XB_XCNT(j)]); sum += c; cnt += (c > 0u) ? 1u : 0u; mine = (j == x) ? c : mine; }
        if (sum == G) break;
        __builtin_amdgcn_s_sleep(1);
        if ((++sp & 255u) == 0u) { if (xb_ld(&bar[XB_TMO])) break; if (sp > XB_SPIN_CAP) { atomicAdd(&bar[XB_TMO], 1u); break; } }
    }
    nloc = mine > 0u ? mine : 1u; nx = cnt > 0u ? cnt : 1u;
}

__device__ __forceinline__ void xcd_barrier(const XcdBarrier& b) {
    asm volatile("s_waitcnt vmcnt(0)" ::: "memory");
    __syncthreads();
    if (threadIdx.x == 0) {
        unsigned* bar = b.bar;
        __builtin_amdgcn_s_waitcnt(0);
        unsigned nloc = b.st[0], nx = b.st[1];
        if (nloc == 0u) { xcd_barrier_complete(bar, b.x, nloc, nx); b.st[0] = nloc; b.st[1] = nx; }
        const unsigned old = xb_add(&bar[XB_XSUB(b.x)], 1u);
        const unsigned gen = old / nloc;
        if (old + 1u == (gen + 1u) * nloc) {
            __builtin_amdgcn_fence(__ATOMIC_RELEASE, "agent");
            asm volatile("s_waitcnt vmcnt(0)" ::: "memory");
            const unsigned og = xb_add(&bar[XB_TOP], 1u);
            const unsigned tg = og / nx;
            if (og + 1u == (tg + 1u) * nx) xb_add(&bar[XB_TOPGEN], 1u);
            else XB_SPIN(xb_ld(&bar[XB_TOPGEN]) == tg, bar);
            __builtin_amdgcn_fence(__ATOMIC_ACQUIRE, "agent");
            xb_add(&bar[XB_XGEN(b.x)], 1u);
            asm volatile("s_waitcnt vmcnt(0)" ::: "memory");
        } else {
            XB_SPIN(xb_ld(&bar[XB_XGEN(b.x)]) == gen, bar);
            __builtin_amdgcn_fence(__ATOMIC_ACQUIRE, "agent");
            asm volatile("s_waitcnt vmcnt(0)" ::: "memory");
        }
    }
    __syncthreads();
}
DEV float row_rstd(const float* ssq, int row, int fq) {
    const f32x4 p = *(const f32x4*)(ssq + (size_t)row * 16 + fq * 4);
    float s = (p.x + p.y) + (p.z + p.w);
    s += __shfl_xor(s, 16); s += __shfl_xor(s, 32);
    return 1.0f / sqrtf(s * (1.0f / 1024.0f) + RMS_EPS);
}
DEV float row_rstd_full(const float* ssq, int row) {
    const f32x4* p = (const f32x4*)(ssq + (size_t)row * 16);
    const f32x4 a = p[0], b = p[1], c = p[2], d = p[3];
    const float s = ((a.x + a.y) + (a.z + a.w)) + ((b.x + b.y) + (b.z + b.w)) + ((c.x + c.y) + (c.z + c.w)) + ((d.x + d.y) + (d.z + d.w));
    return 1.0f / sqrtf(s * (1.0f / 1024.0f) + RMS_EPS);
}

DEV void rope4(const float* rope, int t, int i, const f32x4& v0, const f32x4& v1, float (&lo)[4], float (&hi)[4]) {
    const f32x4 c0 = *(const f32x4*)(rope + ((size_t)t * 32 + i) * 2), c1 = *(const f32x4*)(rope + ((size_t)t * 32 + i + 2) * 2);
    lo[0] = v0[0] * c0[0] - v0[1] * c0[1]; hi[0] = v0[1] * c0[0] + v0[0] * c0[1];
    lo[1] = v0[2] * c0[2] - v0[3] * c0[3]; hi[1] = v0[3] * c0[2] + v0[2] * c0[3];
    lo[2] = v1[0] * c1[0] - v1[1] * c1[1]; hi[2] = v1[1] * c1[0] + v1[0] * c1[1];
    lo[3] = v1[2] * c1[2] - v1[3] * c1[3]; hi[3] = v1[3] * c1[2] + v1[2] * c1[3];
}
struct EpiIn {
    static constexpr bool PERM = true, AFTER_DRAIN = false;
    unsigned char* ws;
    template <class Tp> DEV Tp* P(size_t off) const { return (Tp*)(GAS Tp*)(ws + off); }
    DEV void operator()(const f32x4 (&acc)[2][2][4][2], const pg8::Unit& u, int wr, int wc, int fr, int fq) const {
        asm volatile("" : "+v"(fr), "+v"(fq), "+s"(wr), "+s"(wc));
        const int pn = u.pn;
        const float* ssq = P<float>(WS_SSQ); const float* rope = P<float>(WS_ROPE);
#pragma unroll
        for (int ai = 0; ai < 2; ++ai)
#pragma unroll
            for (int m = 0; m < 4; ++m) {
                const int row = u.pm * 256 + ai * 128 + wr * 64 + m * 16 + fr;
                const float rstd = row_rstd(ssq, row, fq);
                const int t = row & (T - 1), b = row >> 13;
#pragma unroll
                for (int bj = 0; bj < 2; ++bj) {
                    const int col = bj * 128 + wc * 32 + fq * 8;
                    const f32x4 v0 = acc[ai][bj][m][0] * rstd, v1 = acc[ai][bj][m][1] * rstd;
                    if (pn < 2) {
                        const int g = pn * 256 + col, head = g >> 6, i = (g & 63) >> 1;
                        const size_t o = (size_t)row * 512 + head * 64 + i;
                        bf16* Q = P<bf16>(WS_Q);
                        v2u w;
                        w.x = pk2(v0[0] * QSCALE, v0[2] * QSCALE); w.y = pk2(v1[0] * QSCALE, v1[2] * QSCALE); *(v2u*)(Q + o) = w;
                        w.x = pk2(v0[1] * QSCALE, v0[3] * QSCALE); w.y = pk2(v1[1] * QSCALE, v1[3] * QSCALE); *(v2u*)(Q + o + 32) = w;
                    } else if (pn == 2) {
                        bf16* dst = P<bf16>((col < 128) ? WS_KCR : WS_VCR);
                        v4u w; w.x = pk2(v0[0], v0[1]); w.y = pk2(v0[2], v0[3]); w.z = pk2(v1[0], v1[1]); w.w = pk2(v1[2], v1[3]);
                        *(v4u*)(dst + (size_t)row * 128 + (col & 127)) = w;
                    } else if (pn == 3 || pn == 4) {
                        if (col < 128) {
                            bf16* dst = P<bf16>((pn == 3) ? WS_KS : WS_KW);
                            const int hkv = col >> 6, i = (col & 63) >> 1;
                            float lo[4], hi[4]; rope4(rope, t, i, v0, v1, lo, hi);
                            const size_t o = ((size_t)(b * 2 + hkv) * T + t) * 64 + i;
                            v2u w;
                            w.x = pk2(lo[0], lo[1]); w.y = pk2(lo[2], lo[3]); *(v2u*)(dst + o) = w;
                            w.x = pk2(hi[0], hi[1]); w.y = pk2(hi[2], hi[3]); *(v2u*)(dst + o + 32) = w;
                        } else {
                            bf16* dst = P<bf16>((pn == 3) ? WS_VST : WS_VWT);
                            const int c2 = col - 128, hkv = c2 >> 6, d = c2 & 63;
                            const size_t o = (((size_t)(b * 2 + hkv) * 256 + (t >> 5)) * 64 + d) * 32 + slot32(t & 31);
#pragma unroll
                            for (int j = 0; j < 4; ++j) { dst[o + j * 32] = (bf16)f2bf(v0[j]); dst[o + (j + 4) * 32] = (bf16)f2bf(v1[j]); }
                        }
                    } else if (pn == 9) {
                        float* dst = P<float>(WS_HF) + (size_t)row * 256 + col;
                        *(f32x4*)dst = v0; *(f32x4*)(dst + 4) = v1;
                    } else {
                        bf16* dst = (pn < 8) ? P<bf16>(WS_CB + (size_t)(pn - 5) * (WS_CC - WS_CB)) : P<bf16>(WS_HQ + (size_t)(pn - 8) * (WS_HF - WS_HQ));
                        v4u w; w.x = pk2(v0[0], v0[1]); w.y = pk2(v0[2], v0[3]); w.z = pk2(v1[0], v1[1]); w.w = pk2(v1[2], v1[3]);
                        *(v4u*)(dst + (size_t)row * 256 + col) = w;
                    }
                }
            }
    }
};

struct EpiRes {
    static constexpr bool PERM = true, AFTER_DRAIN = false;
    const float* base32; bf16* hb; float* ssq;
    DEV void operator()(const f32x4 (&acc)[2][2][4][2], const pg8::Unit& u, int wr, int wc, int fr, int fq) const {
        asm volatile("" : "+v"(fr), "+v"(fq), "+s"(wr), "+s"(wc));
#pragma unroll
        for (int ai = 0; ai < 2; ++ai)
#pragma unroll
            for (int m = 0; m < 4; ++m) {
                const int row = u.pm * 256 + ai * 128 + wr * 64 + m * 16 + fr;
                float ss = 0.f;
#pragma unroll
                for (int bj = 0; bj < 2; ++bj) {
                    const size_t o = (size_t)row * 1024 + u.pn * 256 + bj * 128 + wc * 32 + fq * 8;
                    f32x4 v0, v1;
                    if (base32) { v0 = *(const f32x4*)(base32 + o); v1 = *(const f32x4*)(base32 + o + 4); }
                    else { const v4u hw = *(const v4u*)(hb + o); v0 = (f32x4){bflo(hw.x), bfhi(hw.x), bflo(hw.y), bfhi(hw.y)}; v1 = (f32x4){bflo(hw.z), bfhi(hw.z), bflo(hw.w), bfhi(hw.w)}; }
                    v0 = v0 + acc[ai][bj][m][0]; v1 = v1 + acc[ai][bj][m][1];
                    v4u w; w.x = pk2(v0[0], v0[1]); w.y = pk2(v0[2], v0[3]); w.z = pk2(v1[0], v1[1]); w.w = pk2(v1[2], v1[3]);
                    *(v4u*)(hb + o) = w;
                    ss += ((v0[0] * v0[0] + v0[1] * v0[1]) + (v0[2] * v0[2] + v0[3] * v0[3])) + ((v1[0] * v1[0] + v1[1] * v1[1]) + (v1[2] * v1[2] + v1[3] * v1[3]));
                }
                ss += __shfl_xor(ss, 16); ss += __shfl_xor(ss, 32);
                if (fq == 0) ssq[(size_t)row * 16 + u.pn * 4 + wc] = ss;
            }
    }
};

struct EpiXQ {
    static constexpr bool PERM = true, AFTER_DRAIN = false;
    const float* ssq; bf16* XQ;
    DEV void operator()(const f32x4 (&acc)[2][2][4][2], const pg8::Unit& u, int wr, int wc, int fr, int fq) const {
        asm volatile("" : "+v"(fr), "+v"(fq), "+s"(wr), "+s"(wc));
#pragma unroll
        for (int ai = 0; ai < 2; ++ai)
#pragma unroll
            for (int m = 0; m < 4; ++m) {
                const int row = u.pm * 256 + ai * 128 + wr * 64 + m * 16 + fr;
                const float sc = row_rstd(ssq, row, fq) * QSCALE;
#pragma unroll
                for (int bj = 0; bj < 2; ++bj) {
                    const f32x4 v0 = acc[ai][bj][m][0] * sc, v1 = acc[ai][bj][m][1] * sc;
                    v4u w; w.x = pk2(v0[0], v0[1]); w.y = pk2(v0[2], v0[3]); w.z = pk2(v1[0], v1[1]); w.w = pk2(v1[2], v1[3]);
                    *(v4u*)(XQ + (size_t)row * 256 + bj * 128 + wc * 32 + fq * 8) = w;
                }
            }
    }
};

struct EpiGU {
    static constexpr bool PERM = true, AFTER_DRAIN = false;
    const float* srstd; bf16* ACT;
    DEV void operator()(const f32x4 (&acc)[2][2][4][2], const pg8::Unit& u, int wr, int wc, int fr, int fq) const {
        asm volatile("" : "+v"(fr), "+v"(fq), "+s"(wr), "+s"(wc));
        const int nt = u.pn & 3;
#pragma unroll
        for (int ai = 0; ai < 2; ++ai)
#pragma unroll
            for (int m = 0; m < 4; ++m) {
                const int row = u.pm * 256 + ai * 128 + wr * 64 + m * 16 + fr;
                const float rs = srstd[row];
#pragma unroll
                for (int bj = 0; bj < 2; ++bj) {
                    const f32x4 v0 = acc[ai][bj][m][0] * rs, v1 = acc[ai][bj][m][1] * rs;
                    const int j = (nt * 256 + bj * 128 + wc * 32 + fq * 8) >> 1;
                    v2u w; w.x = pk2(siluf_(v0[0]) * v0[1], siluf_(v0[2]) * v0[3]); w.y = pk2(siluf_(v1[0]) * v1[1], siluf_(v1[2]) * v1[3]);
                    *(v2u*)(ACT + (size_t)row * 512 + j) = w;
                }
            }
    }
};

struct EpiDN {
    static constexpr bool PERM = true, AFTER_DRAIN = false;
    const float* sgate; bf16* YS;
    DEV void operator()(const f32x4 (&acc)[2][2][4][2], const pg8::Unit& u, int wr, int wc, int fr, int fq) const {
        asm volatile("" : "+v"(fr), "+v"(fq), "+s"(wr), "+s"(wc));
        const int nt = u.pn & 3;
#pragma unroll
        for (int ai = 0; ai < 2; ++ai)
#pragma unroll
            for (int m = 0; m < 4; ++m) {
                const int row = u.pm * 256 + ai * 128 + wr * 64 + m * 16 + fr;
                const float gt = sgate[row];
#pragma unroll
                for (int bj = 0; bj < 2; ++bj) {
                    const f32x4 v0 = acc[ai][bj][m][0] * gt, v1 = acc[ai][bj][m][1] * gt;
                    v4u w; w.x = pk2(v0[0], v0[1]); w.y = pk2(v0[2], v0[3]); w.z = pk2(v1[0], v1[1]); w.w = pk2(v1[2], v1[3]);
                    *(v4u*)(YS + (size_t)row * 1024 + nt * 256 + bj * 128 + wc * 32 + fq * 8) = w;
                }
            }
    }
};

struct MoeOrder {
    int nunits, G, c; const LAS int* tileE;
    DEV bool next(int i, pg8::Unit& u) const {
        const int L = i * G + c; if (L >= nunits) return false;
        const int rt = L >> 2; u.pm = rt; u.pn = tileE[rt] * 4 + (L & 3); return true;
    }
    DEV void a_ready(const pg8::Unit&) const {}
    DEV void done(const pg8::Unit&) const {}
};
struct Frame {
    LAS unsigned char* lds;
    unsigned char* ldsg;
    volatile LAS unsigned* MISC;
    gu32* ctl;
    unsigned char* ws;
    int tid, lane, wave, vcu, G;
    float* out;
};
template <class Tp> DEV Tp* wsp(const Frame& F, size_t off) { return (Tp*)(F.ws + off); }
DEV const float* inp(int i) { const float* const* ka = (const float* const*)__builtin_amdgcn_kernarg_segment_ptr(); asm volatile("" : "+s"(i)); return (const float*)(const GAS float*)ka[i]; }

template <class Map>
DEV void tr_item(const float* W, int K, int Nsrc, const float* gain, bf16* WT, float* scr, int item, int lane, Map map) {
    const int nblk = (Nsrc + 31) >> 5, kb = item / nblk, nb = item - kb * nblk, k0 = 64 * kb, n0 = 32 * nb;
    {
        const int nq = (lane & 7) * 4; f32x4 v[8];
#pragma unroll
        for (int i = 0; i < 8; ++i) { const int kk = 8 * i + (lane >> 3);
            v[i] = (n0 + nq < Nsrc) ? *(const f32x4*)(W + (size_t)(k0 + kk) * Nsrc + n0 + nq) : (f32x4){0.f, 0.f, 0.f, 0.f}; }
#pragma unroll
        for (int i = 0; i < 8; ++i) { const int kk = 8 * i + (lane >> 3); const float g = gain ? gain[k0 + kk] : 1.0f; float* s = scr + kk * 33 + nq;
            s[0] = v[i][0] * g; s[1] = v[i][1] * g; s[2] = v[i][2] * g; s[3] = v[i][3] * g; }
    }
    LDS_WAIT();
    const int c = lane & 7;
#pragma unroll
    for (int j = 0; j < 4; ++j) {
        const int n = (lane >> 3) + 8 * j; const float* s = scr + (8 * c) * 33 + n;
        if (n0 + n < Nsrc) {
            v4u o; o.x = pk2(s[0 * 33], s[1 * 33]); o.y = pk2(s[2 * 33], s[3 * 33]); o.z = pk2(s[4 * 33], s[5 * 33]); o.w = pk2(s[6 * 33], s[7 * 33]);
            *(v4u*)(WT + (size_t)map(n0 + n) * K + k0 + 8 * c) = o;
        }
    }
    LDS_WAIT();
}
template <class Map>
DEV void tr_experts(const float* W, int K, int Nsrc, const float* gain, bf16* WT, bf16* scr, int gw, int NGW, int lane, Map map) {
    const int nblk = Nsrc >> 6, per_e = (K >> 6) * nblk, NIT = 32 * per_e; const size_t esz = (size_t)K * Nsrc;
#pragma unroll 1
    for (int it = gw; it < NIT; it += NGW) {
        const int e = it / per_e, sub = it - e * per_e, kb = sub / nblk, nb = sub - kb * nblk, k0 = 64 * kb, n0 = 64 * nb, nq = (lane & 15) * 4;
        const float* Wp = W + (size_t)e * esz; bf16* Wo = WT + (size_t)e * esz;
        f32x4 v[16];
#pragma unroll
        for (int i = 0; i < 16; ++i) v[i] = *(const f32x4*)(Wp + (size_t)(k0 + 4 * i + (lane >> 4)) * Nsrc + n0 + nq);
#pragma unroll
        for (int i = 0; i < 16; ++i) { const int kk = 4 * i + (lane >> 4); const float g = gain ? gain[k0 + kk] : 1.0f;
            v2u w; w.x = pk2(v[i][0] * g, v[i][1] * g); w.y = pk2(v[i][2] * g, v[i][3] * g);
            *(v2u*)(scr + kk * 68 + nq) = w; }
        LDS_WAIT();
        const int cc = lane & 7;
#pragma unroll
        for (int j = 0; j < 8; ++j) { const int n = (lane >> 3) + 8 * j; const bf16* s = scr + (8 * cc) * 68 + n;
            v4u o; o.x = (unsigned)s[0] | ((unsigned)s[68] << 16); o.y = (unsigned)s[2 * 68] | ((unsigned)s[3 * 68] << 16);
            o.z = (unsigned)s[4 * 68] | ((unsigned)s[5 * 68] << 16); o.w = (unsigned)s[6 * 68] | ((unsigned)s[7 * 68] << 16);
            *(v4u*)(Wo + (size_t)map(n0 + n) * K + k0 + 8 * cc) = o; }
        LDS_WAIT();
    }
}
struct MapId { DEV int operator()(int n) const { return n; } };
struct MapIn {
    DEV int operator()(int n) const {
        if (n < 512) { const int d = n & 63; return (n & ~63) + 2 * (d & 31) + (d >> 5); }
        if (n < 768) return n;
        if (n < 1280) { const int r = n - 768; if ((r & 255) < 128) { const int d = r & 63; return 768 + (r & ~63) + 2 * (d & 31) + (d >> 5); } return n; }
        if (n < 1304) return 3072 + (n - 1280);
        return n - 24;
    }
};
struct MapGU { DEV int operator()(int n) const { return n < 512 ? 2 * n : 2 * (n - 512) + 1; } };

DEV void convert_experts(Frame& F, int l, bf16* scr, int part) {
    unsigned zl_ = 0u; asm volatile("" : "+v"(zl_)); const int lane = (int)__builtin_amdgcn_mbcnt_hi(~0u, __builtin_amdgcn_mbcnt_lo(~0u, zl_));
    const int gw = F.vcu * NWAVES + F.wave, NGW = F.G * NWAVES;
    if (part == 0) tr_experts(inp(17) + (size_t)l * 32 * 1024 * 1024, 1024, 1024, inp(22) + l * 1024, wsp<bf16>(F, WS_WGU) + (size_t)l * 32 * 1024 * 1024, scr, gw, NGW, lane, MapGU());
    else tr_experts(inp(18) + (size_t)l * 32 * 512 * 1024, 512, 1024, nullptr, wsp<bf16>(F, WS_WDN) + (size_t)l * 32 * 1024 * 512, scr, gw, NGW, lane, MapId());
}
DEV void p0_prologue(Frame& F) {
    float* scr = (float*)(F.ldsg + F.wave * 16384);
    const int gw = F.vcu * NWAVES + F.wave, NGW = F.G * NWAVES, lane = F.lane;
    for (int l = 0; l < DEPTH; ++l) {
        { const int NIT = 16 * 97; bf16* dst = wsp<bf16>(F, WS_WIN) + (size_t)l * NIN * 1024;
          for (int it = gw; it < NIT; it += NGW) tr_item(inp(2) + (size_t)l * 1024 * IN_W, 1024, IN_W, inp(19) + l * 1024, dst, scr, it, lane, MapIn());
          for (int i = gw * 64 + lane; i < (NIN - 3096) * 1024 / 8; i += NGW * 64) ((v4u*)(dst + (size_t)3096 * 1024))[i] = (v4u){0u, 0u, 0u, 0u}; }
        { const int NIT = 16 * 32; for (int it = gw; it < NIT; it += NGW) tr_item(inp(9) + (size_t)l * 1024 * 1024, 1024, 1024, nullptr, wsp<bf16>(F, WS_WOUT) + (size_t)l * 1024 * 1024, scr, it, lane, MapId()); }
        { const int NIT = 16 * 8; for (int it = gw; it < NIT; it += NGW) tr_item(inp(10) + (size_t)l * 1024 * 256, 1024, 256, inp(20) + l * 1024, wsp<bf16>(F, WS_WQ) + (size_t)l * 256 * 1024, scr, it, lane, MapId()); }
        { const int NIT = 16 * 16; for (int it = gw; it < NIT; it += NGW) tr_item(inp(11) + (size_t)l * 1024 * 512, 1024, 512, inp(21) + l * 1024, wsp<bf16>(F, WS_WKV) + (size_t)l * 512 * 1024, scr, it, lane, MapId()); }
        { const int NIT = 4 * 32; for (int it = gw; it < NIT; it += NGW) tr_item(inp(12) + (size_t)l * 256 * 1024, 256, 1024, nullptr, wsp<bf16>(F, WS_WO) + (size_t)l * 1024 * 256, scr, it, lane, MapId()); }
        for (int kv = 0; kv < 2; ++kv) {
            { const int NIT = 32 * 4; for (int it = gw; it < NIT; it += NGW) tr_item(inp(5) + (size_t)(l * 2 + kv) * 2048 * 128, 2048, 128, nullptr, wsp<bf16>(F, WS_W1C) + (size_t)(l * 2 + kv) * 128 * 2048, scr, it, lane, MapId()); }
            { const int NIT = 2 * 2; for (int it = gw; it < NIT; it += NGW) tr_item(inp(6) + (size_t)(l * 2 + kv) * 128 * 64, 128, 64, nullptr, wsp<bf16>(F, WS_W2C) + (size_t)(l * 2 + kv) * 64 * 128, scr, it, lane, MapId()); }
        }
        if (F.G != 256) { convert_experts(F, l, (bf16*)scr, 0); convert_experts(F, l, (bf16*)scr, 1); }
        { bf16* dst = wsp<bf16>(F, WS_WR) + (size_t)l * 96 * 1024; const float* gn = inp(22) + l * 1024;
          for (int i = gw * 64 + lane; i < 48 * 1024; i += NGW * 64) { const int n = i >> 10, k = i & 1023;
            float v = 0.f; if (n < 4) v = inp(13)[(size_t)(l * 1024 + k) * 4 + n]; else if (n < 36) v = inp(15)[(size_t)(l * 1024 + k) * 32 + (n - 4)];
            v *= gn[k]; const unsigned h = f2bf(v); dst[i] = (bf16)h; dst[i + 48 * 1024] = (bf16)f2bf(v - bf2f((unsigned short)h)); } }
    }
    { bf16* wg = wsp<bf16>(F, WS_WG);
      for (int i = gw * 64 + lane; i < DEPTH * 32 * 1024; i += NGW * 64) { const int l2 = i >> 15, row = (i >> 10) & 31, k = i & 1023, hk = row >> 4, gi = row & 15;
        const float v = gi < 12 ? inp(2)[((size_t)l2 * 1024 + k) * IN_W + 1280 + hk * 12 + gi] * inp(19)[l2 * 1024 + k] : 0.f;
        wg[i] = (bf16)f2bf(v); } }
    { float* rope = wsp<float>(F, WS_ROPE);
      for (int i = gw * 64 + lane; i < T * 32; i += NGW * 64) { const int t = i >> 5, k = i & 31;
        const float inv = powf(10000.0f, -(float)k / 32.0f); const float ang = (float)t * inv;
        rope[2 * i] = cosf(ang); rope[2 * i + 1] = sinf(ang); } }
    { float* b1 = wsp<float>(F, WS_SMALL);
      for (int i = gw * 64 + lane; i < 4 * 128; i += NGW * 64) { const int lk = i >> 7, n = i & 127;
        const float* pe = inp(4) + (size_t)lk * 2048; const float* w1 = inp(5) + (size_t)lk * 2048 * 128 + n; float s = 0.f;
        for (int kk = 0; kk < 2048; ++kk) s += pe[kk] * w1[(size_t)kk * 128];
        b1[i] = s; } }
    { bf16* HB = wsp<bf16>(F, WS_HB); float* SSQ = wsp<float>(F, WS_SSQ); bf16* MB = wsp<bf16>(F, WS_MEMB); float* SSQM = wsp<float>(F, WS_SMALL) + 1024;
      for (int m = gw; m < NTOK + NB * 256; m += NGW) {
        const bool ism = m >= NTOK; const int r = ism ? m - NTOK : m;
        const f32x4* xr = (const f32x4*)((ism ? inp(1) : inp(0)) + (size_t)r * 1024) + lane;
        unsigned long long* o8 = (unsigned long long*)((ism ? MB : HB) + (size_t)r * 1024) + lane;
        float s = 0.f;
#pragma unroll
        for (int j = 0; j < 4; ++j) { const f32x4 v = xr[64 * j]; s += (v.x * v.x + v.y * v.y) + (v.z * v.z + v.w * v.w);
            o8[64 * j] = (unsigned long long)pk2(v.x, v.y) | ((unsigned long long)pk2(v.z, v.w) << 32); }
        s = wave_sum(s);
        if (ism) { if (lane == 0) SSQM[r] = s; }
        else if (lane < 16) SSQ[(size_t)r * 16 + lane] = lane == 0 ? s : 0.f;
      } }
}

template <int NT>
DEV void skinny16(const bf16* A, size_t lda, const bf16* Bt, size_t ldb, int K, int lane, f32x4 (&acc)[NT]) {
    const int l16 = lane & 15, g4 = lane >> 4;
    const bf16* ap = A + (size_t)l16 * lda + g4 * 8; const bf16* bp = Bt + (size_t)l16 * ldb + g4 * 8;
#pragma unroll
    for (int n = 0; n < NT; ++n) acc[n] = (f32x4){0.f, 0.f, 0.f, 0.f};
#pragma unroll 2
    for (int k = 0; k < K; k += 32) {
        const bf16x8 a = *(const bf16x8*)(ap + k);
#pragma unroll
        for (int n = 0; n < NT; ++n) { const bf16x8 b = *(const bf16x8*)(bp + (size_t)n * 16 * ldb + k); acc[n] = mfma16(a, b, acc[n]); }
    }
}

DEV void memkv_phase(Frame& F) {
    const int gw = F.vcu * NWAVES + F.wave, NGW = F.G * NWAVES, lane = F.lane, l16 = lane & 15, g4 = lane >> 4;
    const bf16* MB = wsp<bf16>(F, WS_MEMB); const float* SSQM = wsp<float>(F, WS_SMALL) + 1024;
    bf16* MK = wsp<bf16>(F, WS_MK); bf16* MVT = wsp<bf16>(F, WS_MVT);
    for (int task = gw; task < 1024; task += NGW) {
        const int l2 = task >> 9, rt = (task >> 3) & 63, chunk = task & 7;
        f32x4 acc[4];
        skinny16<4>(MB + (size_t)rt * 16 * 1024, 1024, wsp<bf16>(F, WS_WKV) + ((size_t)l2 * 512 + chunk * 64) * 1024, 1024, 1024, lane, acc);
        const int b = rt >> 4, key0 = (rt & 15) * 16 + g4 * 4;
        float rs[4];
#pragma unroll
        for (int r = 0; r < 4; ++r) rs[r] = 1.0f / sqrtf(SSQM[rt * 16 + g4 * 4 + r] * (1.0f / 1024.0f) + RMS_EPS);
#pragma unroll
        for (int nt = 0; nt < 4; ++nt) {
            const int n = chunk * 64 + nt * 16 + l16;
            if (chunk < 4) { const int head = n >> 6, d = n & 63;
#pragma unroll
                for (int r = 0; r < 4; ++r) MK[((size_t)((l2 * 4 + b) * 4 + head) * 256 + key0 + r) * 64 + d] = (bf16)f2bf(acc[nt][r] * rs[r]);
            } else { const int n2 = n - 256, head = n2 >> 6, d = n2 & 63;
                v2u w; w.x = pk2(acc[nt][0] * rs[0], acc[nt][1] * rs[1]); w.y = pk2(acc[nt][2] * rs[2], acc[nt][3] * rs[3]);
                *(v2u*)(MVT + (((size_t)((l2 * 4 + b) * 4 + head) * 8 + (key0 >> 5)) * 64 + d) * 32 + slot32(key0 & 31)) = w; }
        }
    }
}

DEV void compress_phase(Frame& F, int l) {
    const int lane = F.lane, l16 = lane & 15, g4 = lane >> 4, quad = F.wave >> 2, q = F.wave & 3;
    float* part = (float*)F.ldsg + quad * (4 * 16 * 128);
    const bf16* KCR = wsp<bf16>(F, WS_KCR); const bf16* VCR = wsp<bf16>(F, WS_VCR);
    bf16* KCC = wsp<bf16>(F, WS_KCC); bf16* VCT = wsp<bf16>(F, WS_VCT);
    const float* bias1 = wsp<float>(F, WS_SMALL);
    for (int tk0 = F.vcu * 2; tk0 < 512; tk0 += F.G * 2) {
        const int tk = tk0 + quad; const int kv = tk >> 8, tile = tk & 255;
        const bf16* raw = kv ? VCR : KCR;
        const bf16* w1 = wsp<bf16>(F, WS_W1C) + (size_t)(l * 2 + kv) * 128 * 2048;
        const bf16* w2 = wsp<bf16>(F, WS_W2C) + (size_t)(l * 2 + kv) * 64 * 128;
        { const int r = tile * 16 + l16, bh = r >> 9, c = r & 511, b = bh >> 1, hkv = bh & 1;
          f32x4 acc[8];
#pragma unroll
          for (int n = 0; n < 8; ++n) acc[n] = (f32x4){0.f, 0.f, 0.f, 0.f};
#pragma unroll 2
          for (int ks = q * 16; ks < q * 16 + 16; ++ks) {
              const int kk = ks * 32 + g4 * 8, ll = kk >> 6, d = kk & 63;
              int tok = 16 * c + ll; tok = tok > T - 1 ? T - 1 : tok;
              const bf16x8 a = *(const bf16x8*)(raw + ((size_t)b * T + tok) * 128 + hkv * 64 + d);
#pragma unroll
              for (int n = 0; n < 8; ++n) { const bf16x8 bb = *(const bf16x8*)(w1 + (size_t)(n * 16 + l16) * 2048 + kk); acc[n] = mfma16(a, bb, acc[n]); }
          }
#pragma unroll
          for (int n = 0; n < 8; ++n)
#pragma unroll
              for (int r2 = 0; r2 < 4; ++r2) part[(q * 16 + g4 * 4 + r2) * 128 + n * 16 + l16] = acc[n][r2];
        }
        __syncthreads();
        { f32x4 o = (f32x4){0.f, 0.f, 0.f, 0.f};
#pragma unroll
          for (int k2 = 0; k2 < 4; ++k2) {
              const int h0 = k2 * 32 + g4 * 8;
              float hv[8];
#pragma unroll
              for (int j = 0; j < 8; ++j) { float s = bias1[(l * 2 + kv) * 128 + h0 + j];
#pragma unroll
                  for (int p = 0; p < 4; ++p) s += part[(p * 16 + l16) * 128 + h0 + j];
                  hv[j] = siluf_(s); }
              bf16x8 a; { v4u w; w.x = pk2(hv[0], hv[1]); w.y = pk2(hv[2], hv[3]); w.z = pk2(hv[4], hv[5]); w.w = pk2(hv[6], hv[7]); a = __builtin_bit_cast(bf16x8, w); }
              const bf16x8 bb = *(const bf16x8*)(w2 + (size_t)(q * 16 + l16) * 128 + h0);
              o = mfma16(a, bb, o);
          }
          const int r0 = tile * 16 + g4 * 4, bh = r0 >> 9, c0 = r0 & 511, d = q * 16 + l16;
          if (kv == 0) {
#pragma unroll
              for (int r2 = 0; r2 < 4; ++r2) KCC[((size_t)bh * 512 + c0 + r2) * 64 + d] = (c0 + r2 == 511) ? (bf16)0 : (bf16)f2bf(o[r2]);
          } else {
              v2u w; w.x = pk2(o[0], o[1]); w.y = pk2(o[2], (c0 + 3 == 511) ? 0.f : o[3]);
              *(v2u*)(VCT + (((size_t)bh * 16 + (c0 >> 5)) * 64 + d) * 32 + slot32(c0 & 31)) = w;
          }
        }
        __syncthreads();
    }
}

DEV float hgrn_lb(const Frame& F, int l, int c) {
    if (l == 0) return 0.f;
    const float a = inp(7)[c], b = inp(7)[256 + c];
    return 1.0f / (1.0f + expf(a - b));
}
DEV float hgrn_logf(float z, float lb) {
    const float la = logf(fmaxf(lb, 1e-30f));
    const float ls = fminf(z, 0.f) - log1pf(expf(-fabsf(z)));
    const float lc = log1pf(-lb) + ls;
    const float mx = fmaxf(la, lc), mn = fminf(la, lc);
    return mx + log1pf(expf(mn - mx));
}
constexpr int HS = 68;
DEV f32x4 mfma4(float a, float b, f32x4 c) { return __builtin_amdgcn_mfma_f32_16x16x4f32(a, b, c, 0, 0, 0); }
DEV void hgrn_setup_chunk(Frame& F, float lb, const float (&z)[8], float* Bc, float* Kc, float* tot) {
    const int d = F.tid & 63, sg = F.tid >> 6;
    const float la = logf(fmaxf(lb, 1e-30f)), l1m = log1pf(-lb), onem = 1.0f - lb;
    float loc[8], kv[8]; float run = 0.f;
#pragma unroll
    for (int i = 0; i < 8; ++i) {
        const float ez = __expf(-fabsf(z[i]));
        const float lc = l1m + (fminf(z[i], 0.f) - __logf(1.0f + ez));
        const float mx = fmaxf(la, lc), mn = fminf(la, lc);
        run += mx + __logf(1.0f + __expf(mn - mx)); loc[i] = run;
        kv[i] = onem * (z[i] >= 0.f ? ez : 1.0f) / (1.0f + ez);
    }
    tot[sg * 64 + d] = run;
    __syncthreads();
    float off = 0.f;
    for (int g = 0; g < sg; ++g) off += tot[g * 64 + d];
#pragma unroll
    for (int i = 0; i < 8; ++i) { Bc[(sg * 8 + i) * HS + d] = off + loc[i]; Kc[(sg * 8 + i) * HS + d] = kv[i]; }
    __syncthreads();
}
DEV void hgrn_local_phase(Frame& F, int l) {
    float* Bc = (float*)F.ldsg; float* Kc = Bc + 64 * HS; float* Vc = Kc + 64 * HS; float* tot = Vc + 64 * HS;
    bf16* U = wsp<bf16>(F, WS_U); float* DEC = wsp<float>(F, WS_DEC);
    const int lane = F.lane, w = F.wave, li = lane & 15, kq = lane >> 4;
    for (int task = F.vcu; task < 2048; task += F.G) {
        const int bh = task >> 7, ch = task & 127, b = bh >> 2, h = bh & 3;
        { const int d = F.tid & 63, sg = F.tid >> 6;
          const size_t go = ((size_t)b * T + ch * 64 + sg * 8) * 256 + h * 64 + d;
          const float* HFp = wsp<float>(F, WS_HF) + go; const bf16* HIp = wsp<bf16>(F, WS_HI) + go;
          float z[8], vi[8];
#pragma unroll
          for (int i = 0; i < 8; ++i) { z[i] = HFp[(size_t)i * 256]; vi[i] = bf2f(HIp[(size_t)i * 256]); }
          hgrn_setup_chunk(F, hgrn_lb(F, l, h * 64 + d), z, Bc, Kc, tot);
          const float bl = Bc[63 * HS + d];
#pragma unroll
          for (int i = 0; i < 8; ++i) { const int s = sg * 8 + i; Kc[s * HS + d] *= __expf(bl - Bc[s * HS + d]); Vc[s * HS + d] = vi[i]; }
          if (sg == 0) DEC[(size_t)task * 64 + d] = expf(bl); }
        __syncthreads();
        { const int dI = w >> 1, e0 = (w & 1) * 32;
          f32x4 a0 = (f32x4){0.f, 0.f, 0.f, 0.f}, a1 = a0;
#pragma unroll 4
          for (int k0 = 0; k0 < 64; k0 += 4) { const int s = k0 + kq;
              const float a = Kc[s * HS + dI * 16 + li], b0 = Vc[s * HS + e0 + li], b1 = Vc[s * HS + e0 + 16 + li];
              a0 = mfma4(a, b0, a0); a1 = mfma4(a, b1, a1); }
#pragma unroll
          for (int r = 0; r < 4; ++r) { bf16* up = U + ((size_t)task * 64 + dI * 16 + 4 * kq + r) * 64 + e0 + li; up[0] = (bf16)f2bf(a0[r]); up[16] = (bf16)f2bf(a1[r]); } }
        __syncthreads();
    }
}
DEV void hgrn_scan_phase(Frame& F, int probe = 0) {
    const bf16* U = wsp<bf16>(F, WS_U); bf16* U2 = wsp<bf16>(F, probe ? WS_PROBE : WS_U2); const float* DEC = wsp<float>(F, WS_DEC);
    const int nact = (F.G * 256 >= 65536) ? 256 : 512;
    if (F.tid < nact)
    for (int gid = F.vcu * nact + F.tid; gid < 65536; gid += F.G * nact) {
        const int bh = gid >> 12, de = gid & 4095, d = de >> 6;
        float S = 0.f; const bf16* up = U + (size_t)bh * 128 * 4096 + de; bf16* op = U2 + (size_t)bh * 128 * 4096 + de; const float* dp = DEC + (size_t)bh * 128 * 64 + d;
#pragma unroll 16
        for (int ch = 0; ch < 128; ++ch) { const float u = bf2f(up[(size_t)ch * 4096]); const float dc = dp[ch * 64]; op[(size_t)ch * 4096] = (bf16)f2bf(S); S = dc * S + u; }
    }
}
DEV void hgrn_out_phase(Frame& F, int l) {
    float* Bc = (float*)F.ldsg; float* Kb = Bc + 64 * HS; float* Vc = Kb + 64 * HS; float* Qs = Vc + 64 * HS; float* Sc = Qs + 64 * HS; float* Ac = Sc + 64 * HS; float* tot = Ac + 64 * HS;
    float* Oc = Kb;
    const bf16* U = wsp<bf16>(F, WS_U2); bf16* CAT = wsp<bf16>(F, WS_CAT);
    const int lane = F.lane, w = F.wave, li = lane & 15, kq = lane >> 4;
    for (int task = F.vcu; task < 2048; task += F.G) {
        const int bh = task >> 7, ch = task & 127, b = bh >> 2, h = bh & 3;
        float gv[8];
        { const int d = F.tid & 63, sg = F.tid >> 6;
          const size_t go = ((size_t)b * T + ch * 64 + sg * 8) * 256 + h * 64 + d;
          const float* HFp = wsp<float>(F, WS_HF) + go; const bf16* HIp = wsp<bf16>(F, WS_HI) + go; const bf16* HQp = wsp<bf16>(F, WS_HQ) + go; const bf16* HGp = wsp<bf16>(F, WS_HG) + go;
          const bf16* Up = U + ((size_t)task * 64 + sg * 8) * 64 + d;
          float z[8], vi[8], qi[8], si[8];
#pragma unroll
          for (int i = 0; i < 8; ++i) { z[i] = HFp[(size_t)i * 256]; vi[i] = bf2f(HIp[(size_t)i * 256]); qi[i] = bf2f(HQp[(size_t)i * 256]); gv[i] = bf2f(HGp[(size_t)i * 256]); si[i] = bf2f(Up[(size_t)i * 64]); }
          hgrn_setup_chunk(F, hgrn_lb(F, l, h * 64 + d), z, Bc, Kb, tot);
#pragma unroll
          for (int i = 0; i < 8; ++i) { const int s = sg * 8 + i, J = s >> 4; const float rJ = J ? Bc[(16 * J - 1) * HS + d] : 0.f;
              Kb[s * HS + d] *= __expf(fminf(rJ - Bc[s * HS + d], 80.f));
              Vc[s * HS + d] = vi[i]; Qs[s * HS + d] = qi[i] * 0.125f; Sc[s * HS + d] = si[i]; } }
        __syncthreads();
#pragma unroll 1
        for (int ti = w; ti < 10; ti += 8) {
            const int I = ti < 1 ? 0 : (ti < 3 ? 1 : (ti < 6 ? 2 : 3)), J = ti - (I * (I + 1)) / 2;
            const int t = I * 16 + li; f32x4 acc = (f32x4){0.f, 0.f, 0.f, 0.f};
#pragma unroll 4
            for (int k0 = 0; k0 < 64; k0 += 4) { const int d = k0 + kq; const float rJ = J ? Bc[(16 * J - 1) * HS + d] : 0.f;
                const float a = Qs[t * HS + d] * __expf(Bc[t * HS + d] - rJ), bb = Kb[(J * 16 + li) * HS + d];
                acc = mfma4(a, bb, acc); }
#pragma unroll
            for (int r = 0; r < 4; ++r) { const int tt = I * 16 + 4 * kq + r, ss = J * 16 + li; Ac[tt * HS + ss] = (ss <= tt) ? acc[r] : 0.f; }
        }
        __syncthreads();
        { const int I = w >> 1, e0 = (w & 1) * 32, t = I * 16 + li;
          f32x4 a0 = (f32x4){0.f, 0.f, 0.f, 0.f}, a1 = a0;
#pragma unroll 4
          for (int k0 = 0; k0 < 64; k0 += 4) { const int d = k0 + kq;
              const float a = Qs[t * HS + d] * __expf(Bc[t * HS + d]), b0 = Sc[d * HS + e0 + li], b1 = Sc[d * HS + e0 + 16 + li];
              a0 = mfma4(a, b0, a0); a1 = mfma4(a, b1, a1); }
#pragma unroll 1
          for (int s0 = 0; s0 < 16 * (I + 1); s0 += 4) { const int s = s0 + kq;
              const float a = Ac[t * HS + s], b0 = Vc[s * HS + e0 + li], b1 = Vc[s * HS + e0 + 16 + li];
              a0 = mfma4(a, b0, a0); a1 = mfma4(a, b1, a1); }
#pragma unroll
          for (int r = 0; r < 4; ++r) { float* op = Oc + (I * 16 + 4 * kq + r) * HS + e0 + li; op[0] = a0[r]; op[16] = a1[r]; } }
        __syncthreads();
        { const float ng = inp(8)[l * 256 + h * 64 + lane];
          { const int t = w * 8 + (lane >> 3); const float* op = Oc + t * HS + (lane & 7) * 8; float s = 0.f;
#pragma unroll
            for (int j = 0; j < 8; ++j) s += op[j] * op[j];
            s += __shfl_xor(s, 1); s += __shfl_xor(s, 2); s += __shfl_xor(s, 4);
            if ((lane & 7) == 0) tot[t] = 1.0f / sqrtf(s * (1.0f / 64.0f) + RMS_EPS); }
          LDS_WAIT();
#pragma unroll
          for (int i = 0; i < 8; ++i) { const int t = w * 8 + i; const float o = Oc[t * HS + lane];
              const size_t row = (size_t)b * T + ch * 64 + t;
              CAT[row * 1024 + 768 + h * 64 + lane] = (bf16)f2bf(o * tot[t] * ng * siluf_(gv[i])); } }
        __syncthreads();
    }
}

DEV void conv_phase(Frame& F, int l) {
    const bf16* CB = wsp<bf16>(F, WS_CB); const bf16* CC = wsp<bf16>(F, WS_CC); const bf16* CH = wsp<bf16>(F, WS_CH); bf16* CAT = wsp<bf16>(F, WS_CAT);
    const float* cw = inp(3) + l * 3 * 256;
    for (int it = F.vcu * 512 + F.tid; it < NTOK * 32; it += F.G * 512) {
        const int m = it >> 5, c0 = (it & 31) * 8, t = m & (T - 1);
        const v4u bb = *(const v4u*)(CB + (size_t)m * 256 + c0);
        float y[8];
#pragma unroll
        for (int j = 0; j < 8; ++j) y[j] = 0.f;
#pragma unroll
        for (int k = 0; k < 3; ++k) {
            if (t + k - 2 >= 0) {
                const size_t o = (size_t)(m + k - 2) * 256 + c0;
                const v4u cc = *(const v4u*)(CC + o), hh = *(const v4u*)(CH + o);
#pragma unroll
                for (int j = 0; j < 4; ++j) { const float w0 = cw[k * 256 + c0 + 2 * j], w1 = cw[k * 256 + c0 + 2 * j + 1];
                    y[2 * j] += w0 * (bflo(cc[j]) * bflo(hh[j])); y[2 * j + 1] += w1 * (bfhi(cc[j]) * bfhi(hh[j])); }
            }
        }
        v4u o4;
#pragma unroll
        for (int j = 0; j < 4; ++j) o4[j] = pk2(bflo(bb[j]) * y[2 * j], bfhi(bb[j]) * y[2 * j + 1]);
        *(v4u*)(CAT + (size_t)m * 1024 + 512 + c0) = o4;
    }
}
struct SmState { float m, l; f32x4 o[4]; };
DEV void sm_reset(SmState& st) { st.m = -INFINITY; st.l = 0.f;
#pragma unroll
    for (int i = 0; i < 4; ++i) st.o[i] = (f32x4){0.f, 0.f, 0.f, 0.f}; }
DEV float sm_lsum(const SmState& st) { float l = st.l; l += __shfl_xor(l, 16); l += __shfl_xor(l, 32); return l; }
DEV void load_k(const bf16* kbase, int lane, bf16x8 (&kf)[2][2]) {
    const int l16 = lane & 15, g4 = lane >> 4;
#pragma unroll
    for (int tt = 0; tt < 2; ++tt)
#pragma unroll
        for (int ks = 0; ks < 2; ++ks) kf[tt][ks] = *(const bf16x8*)(kbase + (size_t)(16 * tt + l16) * 64 + ks * 32 + g4 * 8);
}
DEV void load_v(const bf16* vbase, int lane, bf16x8 (&vf)[4]) {
    const int l16 = lane & 15, g4 = lane >> 4;
#pragma unroll
    for (int dt = 0; dt < 4; ++dt) vf[dt] = *(const bf16x8*)(vbase + (size_t)(dt * 16 + l16) * 32 + g4 * 8);
}
DEV void qk_tile(const bf16x8 (&kf)[2][2], const bf16x8 (&qf)[2], f32x4 (&s)[2]) {
#pragma unroll
    for (int tt = 0; tt < 2; ++tt) { s[tt] = mfma16(kf[tt][0], qf[0], (f32x4){0.f, 0.f, 0.f, 0.f}); s[tt] = mfma16(kf[tt][1], qf[1], s[tt]); }
}
DEV bf16x8 pack_p(const float (&p)[2][4]) {
    v4u w; w.x = pk2(p[0][0], p[0][1]); w.y = pk2(p[0][2], p[0][3]); w.z = pk2(p[1][0], p[1][1]); w.w = pk2(p[1][2], p[1][3]);
    return __builtin_bit_cast(bf16x8, w);
}
template <int MODE, class MaskF>
DEV void attn_compute(const bf16x8 (&kf)[2][2], const bf16x8 (&vf)[4], const bf16x8 (&qf)[2], SmState& st, int lane, bool colok, MaskF mask) {
    const int g4 = lane >> 4;
    f32x4 s[2]; qk_tile(kf, qf, s);
    float sv[2][4]; float tmax = -INFINITY;
#pragma unroll
    for (int tt = 0; tt < 2; ++tt)
#pragma unroll
        for (int r = 0; r < 4; ++r) { float x = s[tt][r]; if (MODE == 2) x = mask(16 * tt + 4 * g4 + r) ? x : -INFINITY; sv[tt][r] = x; tmax = fmaxf(tmax, x); }
    if (MODE == 1) tmax = colok ? tmax : -INFINITY;
    tmax = fmaxf(tmax, __shfl_xor(tmax, 16)); tmax = fmaxf(tmax, __shfl_xor(tmax, 32));
    const float mnew = fmaxf(st.m, tmax), muse = (mnew == -INFINITY) ? 0.f : mnew;
    const float alpha = ex2(st.m - muse);
    const float msub = (MODE == 1) ? (colok ? muse : INFINITY) : muse;
    float p[2][4]; float ps = 0.f;
#pragma unroll
    for (int tt = 0; tt < 2; ++tt)
#pragma unroll
        for (int r = 0; r < 4; ++r) { p[tt][r] = ex2(sv[tt][r] - msub); ps += p[tt][r]; }
    st.l = st.l * alpha + ps; st.m = mnew;
    const bf16x8 pf = pack_p(p);
#pragma unroll
    for (int dt = 0; dt < 4; ++dt) { st.o[dt] = st.o[dt] * alpha; st.o[dt] = mfma16(vf[dt], pf, st.o[dt]); }
}
template <int MODE, class MaskF>
DEV void attn_compute_fixed(const bf16x8 (&kf)[2][2], const bf16x8 (&vf)[4], const bf16x8 (&qf)[2], SmState& st, float mref, int lane, bool colok, MaskF mask) {
    const int g4 = lane >> 4;
    f32x4 s[2]; qk_tile(kf, qf, s);
    const float msub = (MODE == 1) ? (colok ? mref : INFINITY) : mref;
    float p[2][4]; float ps = 0.f;
#pragma unroll
    for (int tt = 0; tt < 2; ++tt)
#pragma unroll
        for (int r = 0; r < 4; ++r) { float x = s[tt][r] - msub; if (MODE == 2) x = mask(16 * tt + 4 * g4 + r) ? x : -INFINITY; p[tt][r] = ex2(x); ps += p[tt][r]; }
    st.l += ps;
    const bf16x8 pf = pack_p(p);
#pragma unroll
    for (int dt = 0; dt < 4; ++dt) st.o[dt] = mfma16(vf[dt], pf, st.o[dt]);
}
template <int MODE, class MaskF>
DEV void attn_max(const bf16x8 (&kf)[2][2], const bf16x8 (&qf)[2], float& mx, int lane, bool colok, MaskF mask) {
    const int g4 = lane >> 4;
    f32x4 s[2]; qk_tile(kf, qf, s);
    float tmax = -INFINITY;
#pragma unroll
    for (int tt = 0; tt < 2; ++tt)
#pragma unroll
        for (int r = 0; r < 4; ++r) { float x = s[tt][r]; if (MODE == 2) x = mask(16 * tt + 4 * g4 + r) ? x : -INFINITY; tmax = fmaxf(tmax, x); }
    if (MODE == 1) tmax = colok ? tmax : -INFINITY;
    mx = fmaxf(mx, tmax);
}
DEV float colmax_finish(float mx) { mx = fmaxf(mx, __shfl_xor(mx, 16)); mx = fmaxf(mx, __shfl_xor(mx, 32)); return mx == -INFINITY ? 0.f : mx; }
DEV float col_norm(const bf16x8 (&qf)[2]) {
    float s = 0.f;
#pragma unroll
    for (int ks = 0; ks < 2; ++ks) { const v4u w = __builtin_bit_cast(v4u, qf[ks]);
#pragma unroll
        for (int j = 0; j < 4; ++j) { const float a = bflo(w[j]), b = bfhi(w[j]); s += a * a + b * b; } }
    s += __shfl_xor(s, 16); s += __shfl_xor(s, 32);
    return sqrtf(s);
}
DEV float wave_max_uniform(float v) {
#pragma unroll
    for (int o = 1; o < 64; o <<= 1) v = fmaxf(v, __shfl_xor(v, o));
    return __builtin_bit_cast(float, __builtin_amdgcn_readfirstlane(__builtin_bit_cast(int, v)));
}
constexpr float FIXED_REF_MAX = 40.f;
DEV void kmax_phase(Frame& F, int l) {
    const int lane = F.lane; const int gw = F.vcu * NWAVES + F.wave, NGW = F.G * NWAVES;
    for (int item = gw; item < 2048; item += NGW) {
        const int br = item >> 10, bh = (item >> 7) & 7, key = (item & 127) * 64 + lane;
        const bf16* kp = wsp<bf16>(F, br ? WS_KW : WS_KS) + ((size_t)bh * T + key) * 64;
        float s = 0.f;
#pragma unroll
        for (int i = 0; i < 8; ++i) { const v4u w = *(const v4u*)(kp + i * 8);
#pragma unroll
            for (int j = 0; j < 4; ++j) { const float a = bflo(w[j]), b = bfhi(w[j]); s += a * a + b * b; } }
#pragma unroll
        for (int o = 1; o < 64; o <<= 1) s = fmaxf(s, __shfl_xor(s, o));
        if (lane == 0) __hip_atomic_fetch_max((unsigned*)F.ctl + CW_KMAX + l * 16 + br * 8 + bh, __builtin_bit_cast(unsigned, s), RLX_AGENT);
    }
}
struct NoMask { DEV bool operator()(int) const { return true; } };
template <int D, bool WITHV, class AddrF, class BodyF>
DEV void pipe_run(int n, int lane, AddrF addr, BodyF body) {
    if (n <= 0) return;
    bf16x8 kf[D][2][2], vf[D][4];
#pragma unroll
    for (int d = 0; d < D; ++d) { const bf16* kb; const bf16* vb; addr(d < n ? d : n - 1, kb, vb); load_k(kb, lane, kf[d]); if (WITHV) load_v(vb, lane, vf[d]); }
#pragma unroll 1
    for (int i = 0; i < n; i += D) {
#pragma unroll
        for (int d = 0; d < D; ++d) { const int s = i + d;
            if (s < n) body(s, kf[d], vf[d]);
            if (D > 1 || s + 1 < n) { const bf16* kb; const bf16* vb; addr(s + D < n ? s + D : n - 1, kb, vb); load_k(kb, lane, kf[d]); if (WITHV) load_v(vb, lane, vf[d]); } }
    }
}
template <class AddrF, class BodyF>
DEV void pipe_run_k2(int n, int lane, AddrF addr, BodyF body) {
    if (n <= 0) return;
    bf16x8 kf[2][2][2], vf[4];
    { const bf16* kb; const bf16* vb; addr(0, kb, vb); load_k(kb, lane, kf[0]); }
#pragma unroll 1
    for (int i = 0; i < n; i += 2) {
#pragma unroll
        for (int d = 0; d < 2; ++d) { const int s = i + d;
            { const bf16* kb; const bf16* vb; addr(s < n ? s : n - 1, kb, vb); load_v(vb, lane, vf); }
            { const bf16* kb; const bf16* vb; addr(s + 1 < n ? s + 1 : n - 1, kb, vb); load_k(kb, lane, kf[d ^ 1]); }
            if (s < n) body(s, kf[d], vf); }
    }
}
constexpr int PIPE_D = 2;

DEV void acc_add_packed(unsigned (&pk)[4][4][2], int ct, const f32x4 (&o)[4], float sc, bool first) {
#pragma unroll
    for (int dt = 0; dt < 4; ++dt) {
        f32x4 v = o[dt] * sc;
        if (!first) { v[0] += bflo(pk[ct][dt][0]); v[1] += bfhi(pk[ct][dt][0]); v[2] += bflo(pk[ct][dt][1]); v[3] += bfhi(pk[ct][dt][1]); }
        pk[ct][dt][0] = pk2(v[0], v[1]); pk[ct][dt][1] = pk2(v[2], v[3]);
    }
}
template <int VAR>
DEV void nsa_phase_t(Frame& F, int l) {
#define NSA_RELANE() int ln_ = lane; asm volatile("" : "+v"(ln_)); const int l16 = ln_ & 15, g4 = ln_ >> 4, tq = l16 >> 2, gh = l16 & 3; const size_t mrow0 = (size_t)b * T + t0 + tq; const int tl0 = t0 + tq; (void)l16; (void)g4; (void)gh; (void)mrow0; (void)tl0
    float* IMP = (float*)(F.ldsg + F.wave * NSA_LDS_WAVE);
    float* VALS = IMP + 2048; int* BL = (int*)(IMP + 2176); unsigned* SELB = (unsigned*)(IMP + 2304); float* GL = IMP + 2432;
    const bf16* Q = wsp<bf16>(F, WS_Q);
    const bf16* KCC = wsp<bf16>(F, WS_KCC); const bf16* VCT = wsp<bf16>(F, WS_VCT);
    const bf16* KS = wsp<bf16>(F, WS_KS); const bf16* VST = wsp<bf16>(F, WS_VST);
    const bf16* KW = wsp<bf16>(F, WS_KW); const bf16* VWT = wsp<bf16>(F, WS_VWT);
    bf16* CAT = wsp<bf16>(F, WS_CAT);
    const int gw = F.vcu * NWAVES + F.wave, NGW = F.G * NWAVES;
    const bool xmap = (F.G == 256);
#pragma unroll 1
    for (int task = gw; task < 4096; task += NGW) {
        unsigned zl_ = 0u; asm volatile("" : "+v"(zl_)); const int lane = (int)__builtin_amdgcn_mbcnt_hi(~0u, __builtin_amdgcn_mbcnt_lo(~0u, zl_));
        const int bh = xmap ? (gw >> 8) : (task & 7), idx = xmap ? ((task >> 11) ? 511 - (gw & 255) : (gw & 255)) : (task >> 3);
        const int t0 = idx * 16, b = bh >> 1, hkv = bh & 1, cur = t0 >> 6;
        bf16x8 qf[4][2];
        unsigned opk[4][4][2];
        SmState st[4];
        float qnmax = 0.f;
        { NSA_RELANE();
#pragma unroll
        for (int ct = 0; ct < 4; ++ct)
#pragma unroll
            for (int ks = 0; ks < 2; ++ks) qf[ct][ks] = *(const bf16x8*)(Q + (mrow0 + 4 * ct) * 512 + hkv * 256 + gh * 64 + ks * 32 + g4 * 8);
        { NSA_RELANE();
          f32x4 ga[1]; ga[0] = (f32x4){0.f, 0.f, 0.f, 0.f};
          { const bf16* ap = wsp<bf16>(F, WS_HB) + ((size_t)b * T + t0 + l16) * 1024 + g4 * 8; const bf16* bp = wsp<bf16>(F, WS_WG) + (size_t)((l * 2 + hkv) * 16 + l16) * 1024 + g4 * 8;
#pragma unroll 1
            for (int k0 = 0; k0 < 1024; k0 += 256) {
                bf16x8 av[8], bv[8];
#pragma unroll
                for (int i = 0; i < 8; ++i) { av[i] = *(const bf16x8*)(ap + k0 + 32 * i); bv[i] = *(const bf16x8*)(bp + k0 + 32 * i); }
#pragma unroll
                for (int i = 0; i < 8; ++i) ga[0] = mfma16(av[i], bv[i], ga[0]);
            } }
          const float rs = (ln_ < 16) ? row_rstd_full(wsp<float>(F, WS_SSQ), b * T + t0 + ln_) : 0.f;
#pragma unroll
          for (int r = 0; r < 4; ++r) GL[(g4 * 4 + r) * 16 + l16] = sigmoidf_(ga[0][r] * __shfl(rs, g4 * 4 + r));
        }
        const int ngc = (t0 + 15 >= 31) ? (((t0 + 15 - 31) >> 4) >> 5) + 1 : 0;
        const bf16* kcb = KCC + (size_t)bh * 512 * 64; const bf16* vcb = VCT + (size_t)bh * 16 * 64 * 32;
        float cm[4], cl[4];
#pragma unroll
        for (int ct = 0; ct < 4; ++ct) { cm[ct] = -INFINITY; cl[ct] = 0.f; }
        pipe_run<1, false>(ngc, ln_, [&](int s, const bf16*& kb, const bf16*& vb) { kb = kcb + (size_t)s * 32 * 64; vb = vcb; },
            [&](int kg, const bf16x8 (&kf)[2][2], const bf16x8 (&)[4]) {
#pragma unroll
                for (int ct = 0; ct < 4; ++ct) {
                    const int tl = tl0 + 4 * ct;
                    f32x4 s[2]; qk_tile(kf, qf[ct], s);
                    float sv[2][4]; float tmax = -INFINITY;
#pragma unroll
                    for (int tt = 0; tt < 2; ++tt)
#pragma unroll
                        for (int r = 0; r < 4; ++r) { const int c = kg * 32 + 16 * tt + 4 * g4 + r; sv[tt][r] = (16 * c + 31 <= tl) ? s[tt][r] : -INFINITY; tmax = fmaxf(tmax, sv[tt][r]); }
                    tmax = fmaxf(tmax, __shfl_xor(tmax, 16)); tmax = fmaxf(tmax, __shfl_xor(tmax, 32));
                    const float mnew = fmaxf(cm[ct], tmax), muse = (mnew == -INFINITY) ? 0.f : mnew;
                    float ps = 0.f;
#pragma unroll
                    for (int tt = 0; tt < 2; ++tt)
#pragma unroll
                        for (int r = 0; r < 4; ++r) ps += ex2(sv[tt][r] - muse);
                    cl[ct] = cl[ct] * ex2(cm[ct] - muse) + ps; cm[ct] = mnew;
                }
            });
        {
            float cmu[4], cinv[4], carry[4];
#pragma unroll
            for (int ct = 0; ct < 4; ++ct) { float l = cl[ct]; l += __shfl_xor(l, 16); l += __shfl_xor(l, 32);
                cmu[ct] = (cm[ct] == -INFINITY) ? 0.f : cm[ct]; cinv[ct] = l > 0.f ? 1.0f / l : 0.f; carry[ct] = 0.f; sm_reset(st[ct]); }
            pipe_run<1, true>(ngc, ln_, [&](int s, const bf16*& kb, const bf16*& vb) { kb = kcb + (size_t)s * 32 * 64; vb = vcb + (size_t)s * 64 * 32; },
                [&](int kg, const bf16x8 (&kf)[2][2], const bf16x8 (&vf)[4]) {
#pragma unroll
                    for (int ct = 0; ct < 4; ++ct) {
                        const int tl = tl0 + 4 * ct;
                        f32x4 s[2]; qk_tile(kf, qf[ct], s);
                        float p[2][4];
#pragma unroll
                        for (int tt = 0; tt < 2; ++tt) {
#pragma unroll
                            for (int r = 0; r < 4; ++r) { const int c = kg * 32 + 16 * tt + 4 * g4 + r; p[tt][r] = (16 * c + 31 <= tl) ? ex2(s[tt][r] - cmu[ct]) * cinv[ct] : 0.f; }
                            const float hb = 0.5f * p[tt][3];
                            const float bsh = __shfl(hb, (ln_ + 48) & 63);
                            float v = ((p[tt][0] + p[tt][1]) + (p[tt][2] + hb)) + ((g4 == 0) ? carry[ct] : bsh);
                            carry[ct] = bsh;
                            v += __shfl_xor(v, 1); v += __shfl_xor(v, 2);
                            if (gh == 0) IMP[(4 * ct + tq) * 128 + kg * 8 + 4 * tt + g4] = v;
                        }
                        const bf16x8 pf = pack_p(p);
#pragma unroll
                        for (int dt = 0; dt < 4; ++dt) st[ct].o[dt] = mfma16(vf[dt], pf, st[ct].o[dt]);
                    }
                });
#pragma unroll
            for (int ct = 0; ct < 4; ++ct) acc_add_packed(opk, ct, st[ct].o, GL[(4 * ct + tq) * 16 + gh * 3 + 0], true);
        }
        }
        LDS_WAIT();
        unsigned sb0 = 0u, sb1 = 0u;
        if (cur < 16) { sb0 = (lane <= cur) ? 0xffffu : 0u; }
        else {
            const unsigned long long below = (1ull << lane) - 1ull;
#pragma unroll 1
            for (int q = 0; q < 16; ++q) {
                unsigned k0, k1;
                { const int j = lane; const float v = (j == 0 || j == cur || j == cur - 1) ? 1e6f : IMP[q * 128 + j]; k0 = (j > cur) ? 0u : __builtin_bit_cast(unsigned, v) + 1u; }
                { const int j = lane + 64; const float v = (j == cur || j == cur - 1) ? 1e6f : IMP[q * 128 + j]; k1 = (j > cur) ? 0u : __builtin_bit_cast(unsigned, v) + 1u; }
                unsigned lo = 0u, hi = 0xffffffffu;
                while (hi - lo > 1u) { const unsigned mid = lo + ((hi - lo) >> 1);
                    const int c = __builtin_popcountll(__ballot(k0 >= mid)) + __builtin_popcountll(__ballot(k1 >= mid));
                    if (c >= 16) lo = mid; else hi = mid; }
                const unsigned long long g0 = __ballot(k0 > lo), g1 = __ballot(k1 > lo), e0 = __ballot(k0 == lo), e1 = __ballot(k1 == lo);
                const int need = 16 - __builtin_popcountll(g0) - __builtin_popcountll(g1);
                const bool s0 = (k0 > lo) || (k0 == lo && __builtin_popcountll(e0 & below) < need);
                const bool s1 = (k1 > lo) || (k1 == lo && __builtin_popcountll(e0) + __builtin_popcountll(e1 & below) < need);
                sb0 |= (s0 ? 1u : 0u) << q; sb1 |= (s1 ? 1u : 0u) << q;
            }
        }
        SELB[lane] = sb0; SELB[lane + 64] = sb1;
        LDS_WAIT();
#define NSA_PARK() do { _Pragma("unroll") for (int i_ = 0; i_ < 8; ++i_) { v4u w_; w_.x = opk[i_ >> 1][(i_ & 1) * 2][0]; w_.y = opk[i_ >> 1][(i_ & 1) * 2][1]; w_.z = opk[i_ >> 1][(i_ & 1) * 2 + 1][0]; w_.w = opk[i_ >> 1][(i_ & 1) * 2 + 1][1]; ((v4u*)IMP)[i_ * 64 + lane] = w_; } } while (0)
#define NSA_UNPARK() do { _Pragma("unroll") for (int i_ = 0; i_ < 8; ++i_) { const v4u w_ = ((const v4u*)IMP)[i_ * 64 + lane]; opk[i_ >> 1][(i_ & 1) * 2][0] = w_.x; opk[i_ >> 1][(i_ & 1) * 2][1] = w_.y; opk[i_ >> 1][(i_ & 1) * 2 + 1][0] = w_.z; opk[i_ >> 1][(i_ & 1) * 2 + 1][1] = w_.w; } } while (0)
        NSA_PARK();
        { NSA_RELANE();
#pragma unroll
        for (int ct = 0; ct < 4; ++ct) {
            const float* rp = wsp<float>(F, WS_ROPE) + ((size_t)(tl0 + 4 * ct) * 32 + g4 * 8) * 2;
            const v4u a = __builtin_bit_cast(v4u, qf[ct][0]), b2 = __builtin_bit_cast(v4u, qf[ct][1]); v4u ra, rb;
#pragma unroll
            for (int jj = 0; jj < 4; ++jj) { const f32x4 cs = *(const f32x4*)(rp + 4 * jj);
                const float x1a = bflo(a[jj]), x1b = bfhi(a[jj]), x2a = bflo(b2[jj]), x2b = bfhi(b2[jj]);
                ra[jj] = pk2(x1a * cs[0] - x2a * cs[1], x1b * cs[2] - x2b * cs[3]);
                rb[jj] = pk2(x2a * cs[0] + x1a * cs[1], x2b * cs[2] + x1b * cs[3]); }
            qf[ct][0] = __builtin_bit_cast(bf16x8, ra); qf[ct][1] = __builtin_bit_cast(bf16x8, rb);
        }
        {
            const unsigned long long ulo = __ballot(sb0 != 0u), uhi = __ballot(sb1 != 0u);
            const unsigned long long below = (1ull << ln_) - 1ull;
            const int nlo = __builtin_popcountll(ulo), nblk = nlo + __builtin_popcountll(uhi);
            if (sb0 != 0u) BL[__builtin_popcountll(ulo & below)] = ln_;
            if (sb1 != 0u) BL[nlo + __builtin_popcountll(uhi & below)] = ln_ + 64;
            LDS_WAIT();
#pragma unroll
            for (int ct = 0; ct < 4; ++ct) sm_reset(st[ct]);
            const bf16* kb0 = KS + (size_t)bh * T * 64; const bf16* vb0 = VST + (size_t)bh * 256 * 64 * 32;
            float mr; bool fixed;
            { const float kmx = sqrtf(__builtin_bit_cast(float, __hip_atomic_load((const unsigned*)F.ctl + CW_KMAX + l * 16 + bh, RLX_AGENT))); float mm = 0.f;
#pragma unroll
              for (int ct = 0; ct < 4; ++ct) mm = fmaxf(mm, col_norm(qf[ct]));
              qnmax = wave_max_uniform(mm); mr = qnmax * kmx * 1.002f + 1e-3f;
              fixed = mr < FIXED_REF_MAX; }
            auto addr_sel = [&](int s, const bf16*& kb, const bf16*& vb) { const int g32 = BL[s >> 1] * 2 + (s & 1); kb = kb0 + (size_t)g32 * 32 * 64; vb = vb0 + (size_t)g32 * 64 * 32; };
            asm volatile("" ::: "memory");
            if (!fixed) {
                float mx[4] = {-INFINITY, -INFINITY, -INFINITY, -INFINITY};
                pipe_run<1, false>(2 * nblk, ln_, addr_sel,
                    [&](int s, const bf16x8 (&kf)[2][2], const bf16x8 (&)[4]) {
                        const int j = BL[s >> 1], key0 = j * 64 + (s & 1) * 32;
                        const unsigned tm = (unsigned)__builtin_amdgcn_readfirstlane((int)SELB[j]);
#pragma unroll
                        for (int ct = 0; ct < 4; ++ct) { const unsigned tmk = (tm >> (4 * ct)) & 0xFu;
                            if (tmk) { const bool colok = (tmk >> tq) & 1u; const int tl = tl0 + 4 * ct;
                                if (j == cur) attn_max<2>(kf, qf[ct], mx[ct], ln_, true, [&](int kk) { return colok && (key0 + kk <= tl); });
                                else attn_max<1>(kf, qf[ct], mx[ct], ln_, colok, NoMask()); } }
                    });
                mr = wave_max_uniform(fmaxf(fmaxf(mx[0], mx[1]), fmaxf(mx[2], mx[3]))); if (mr == -INFINITY) mr = 0.f;
            }
            asm volatile("" ::: "memory");
            pipe_run_k2(2 * nblk, ln_, addr_sel,
                [&](int s, const bf16x8 (&kf)[2][2], const bf16x8 (&vf)[4]) {
                    const int j = BL[s >> 1], key0 = j * 64 + (s & 1) * 32;
                    const unsigned tm = (unsigned)__builtin_amdgcn_readfirstlane((int)SELB[j]);
#pragma unroll
                    for (int ct = 0; ct < 4; ++ct) {
                        const unsigned tmk = (tm >> (4 * ct)) & 0xFu;
                        if (tmk) {
                            const bool colok = (tmk >> tq) & 1u; const int tl = tl0 + 4 * ct;
                            if (j == cur) attn_compute_fixed<2>(kf, vf, qf[ct], st[ct], mr, ln_, true, [&](int kk) { return colok && (key0 + kk <= tl); });
                            else attn_compute_fixed<1>(kf, vf, qf[ct], st[ct], mr, ln_, colok, NoMask());
                        }
                    }
                });
            LDS_WAIT();
            NSA_UNPARK();
#pragma unroll
            for (int ct = 0; ct < 4; ++ct) { const float ls = sm_lsum(st[ct]); const float gs = GL[(4 * ct + tq) * 16 + gh * 3 + 1];
                acc_add_packed(opk, ct, st[ct].o, ls > 0.f ? gs / ls : 0.f, false); }
            NSA_PARK();
        }
        }
        { NSA_RELANE();
#pragma unroll
            for (int ct = 0; ct < 4; ++ct) sm_reset(st[ct]);
            const bf16* kb0 = (VAR == 3 ? KS : KW) + (size_t)bh * T * 64; const bf16* vb0 = (VAR == 3 ? VST : VWT) + (size_t)bh * 256 * 64 * 32;
            const int glo = (t0 - 511 > 0 ? t0 - 511 : 0) >> 5, ghi = (t0 + 15) >> 5;
            float mr; bool fixed;
            { const float kmx = sqrtf(__builtin_bit_cast(float, __hip_atomic_load((const unsigned*)F.ctl + CW_KMAX + l * 16 + 8 + bh, RLX_AGENT)));
              mr = qnmax * kmx * 1.002f + 1e-3f;
              fixed = mr < FIXED_REF_MAX; }
            auto addr_win = [&](int s, const bf16*& kb, const bf16*& vb) { kb = kb0 + (size_t)(glo + s) * 32 * 64; vb = vb0 + (size_t)(glo + s) * 64 * 32; };
            asm volatile("" ::: "memory");
            if (!fixed) {
                float mx[4] = {-INFINITY, -INFINITY, -INFINITY, -INFINITY};
                pipe_run<1, false>(ghi - glo + 1, ln_, addr_win,
                    [&](int s, const bf16x8 (&kf)[2][2], const bf16x8 (&)[4]) {
                        const int key0 = (glo + s) * 32;
#pragma unroll
                        for (int ct = 0; ct < 4; ++ct) { const int tl = tl0 + 4 * ct;
                            attn_max<2>(kf, qf[ct], mx[ct], ln_, true, [&](int kk) { const int kp = key0 + kk; return kp <= tl && kp + 512 > tl; }); }
                    });
                mr = wave_max_uniform(fmaxf(fmaxf(mx[0], mx[1]), fmaxf(mx[2], mx[3]))); if (mr == -INFINITY) mr = 0.f;
            }
            asm volatile("" ::: "memory");
            pipe_run_k2(ghi - glo + 1, ln_, addr_win,
                [&](int s, const bf16x8 (&kf)[2][2], const bf16x8 (&vf)[4]) {
                    const int key0 = (glo + s) * 32;
#pragma unroll
                    for (int ct = 0; ct < 4; ++ct) {
                        const int tlo = t0 + 4 * ct, thi = tlo + 3, tl = tl0 + 4 * ct;
                        if (key0 > thi || key0 + 31 + 512 <= tlo) continue;
                        if (key0 + 512 > thi && key0 + 31 <= tlo) attn_compute_fixed<0>(kf, vf, qf[ct], st[ct], mr, ln_, true, NoMask());
                        else attn_compute_fixed<2>(kf, vf, qf[ct], st[ct], mr, ln_, true, [&](int kk) { const int kp = key0 + kk; return kp <= tl && kp + 512 > tl; });
                    }
                });
            NSA_UNPARK();
#pragma unroll
            for (int ct = 0; ct < 4; ++ct) { const float ls = sm_lsum(st[ct]); const float gwn = GL[(4 * ct + tq) * 16 + gh * 3 + 2];
                acc_add_packed(opk, ct, st[ct].o, ls > 0.f ? gwn / ls : 0.f, false); }
        }
        { NSA_RELANE();
#pragma unroll
        for (int ct = 0; ct < 4; ++ct)
#pragma unroll
            for (int dt = 0; dt < 4; ++dt) { v2u w; w.x = opk[ct][dt][0]; w.y = opk[ct][dt][1];
                if (VAR == 0 || w.x == 0x7fc17fc1u) *(v2u*)(CAT + (mrow0 + 4 * ct) * 1024 + hkv * 256 + gh * 64 + dt * 16 + g4 * 4) = w; }
        }
        LDS_WAIT();
        if (VAR == 0 && xmap) convert_experts(F, l, (bf16*)IMP, task >> 11);
    }
#undef NSA_RELANE
#undef NSA_PARK
#undef NSA_UNPARK
}

DEV void nsa_phase(Frame& F, int l) { nsa_phase_t<0>(F, l); }

DEV void cross_phase(Frame& F, int l) {
    const int lane = F.lane, l16 = lane & 15, g4 = lane >> 4;
    const bf16* XQ = wsp<bf16>(F, WS_XQ); bf16* XO = wsp<bf16>(F, WS_XO);
    const int gw = F.vcu * NWAVES + F.wave, NGW = F.G * NWAVES;
#pragma unroll 1
    for (int task = gw; task < 2048; task += NGW) {
        const int head = task & 3, m0 = (task >> 2) * 64, b = m0 >> 13;
        bf16x8 qf[4][2];
#pragma unroll
        for (int ct = 0; ct < 4; ++ct)
#pragma unroll
            for (int ks = 0; ks < 2; ++ks) qf[ct][ks] = *(const bf16x8*)(XQ + (size_t)(m0 + 16 * ct + l16) * 256 + head * 64 + ks * 32 + g4 * 8);
        const bf16* kb0 = wsp<bf16>(F, WS_MK) + (size_t)((l * 4 + b) * 4 + head) * 256 * 64;
        const bf16* vb0 = wsp<bf16>(F, WS_MVT) + (size_t)((l * 4 + b) * 4 + head) * 8 * 64 * 32;
        SmState st[4];
#pragma unroll
        for (int ct = 0; ct < 4; ++ct) sm_reset(st[ct]);
        pipe_run<PIPE_D, true>(8, lane, [&](int s, const bf16*& kb, const bf16*& vb) { kb = kb0 + (size_t)s * 32 * 64; vb = vb0 + (size_t)s * 64 * 32; },
            [&](int, const bf16x8 (&kf)[2][2], const bf16x8 (&vf)[4]) {
#pragma unroll
                for (int ct = 0; ct < 4; ++ct) attn_compute<0>(kf, vf, qf[ct], st[ct], lane, true, NoMask());
            });
#pragma unroll
        for (int ct = 0; ct < 4; ++ct) {
            const float inv = 1.0f / sm_lsum(st[ct]);
#pragma unroll
            for (int dt = 0; dt < 4; ++dt) { const f32x4 o = st[ct].o[dt] * inv; v2u w; w.x = pk2(o[0], o[1]); w.y = pk2(o[2], o[3]);
                *(v2u*)(XO + (size_t)(m0 + 16 * ct + l16) * 256 + head * 64 + dt * 16 + g4 * 4) = w; }
        }
    }
}


DEV void router_phase(Frame& F, int l, int probe = 0) {
    const int lane = F.lane, l16 = lane & 15, g4 = lane >> 4;
    float* LG = (float*)F.ldsg + F.wave * 768;
    const bf16* HB = wsp<bf16>(F, WS_HB); const float* SSQ = wsp<float>(F, WS_SSQ);
    const bf16* WR = wsp<bf16>(F, WS_WR) + (size_t)l * 96 * 1024;
    int* TOKE = wsp<int>(F, probe ? WS_PROBE : WS_TOKE); float* TOKG = wsp<float>(F, probe ? WS_PROBE + MiB : WS_TOKG); int* TOKP = wsp<int>(F, probe ? WS_PROBE + 2 * MiB : WS_TOKP);
    unsigned* CNT = (unsigned*)F.ctl + CW_CNT + l * 32 + (probe ? 64 : 0);
    const float* bg = inp(14) + l * 4; const float* be = inp(16) + l * 32;
    unsigned* HIST = (unsigned*)((float*)F.ldsg + 8 * 768);
#pragma unroll 1
    for (int tb = F.vcu * NWAVES; tb < NTOK / 16; tb += F.G * NWAVES) {
        const int task = tb + F.wave; const bool live = task < NTOK / 16;
        const int m0 = (live ? task : tb) * 16;
        if (F.tid < 64) HIST[F.tid] = 0u;
        f32x4 acc[3];
        {
            const bf16* ap = HB + (size_t)(m0 + l16) * 1024 + g4 * 8; const bf16* bp = WR + (size_t)l16 * 1024 + g4 * 8;
#pragma unroll
            for (int n = 0; n < 3; ++n) acc[n] = (f32x4){0.f, 0.f, 0.f, 0.f};
#pragma unroll 4
            for (int k = 0; k < 1024; k += 32) {
                const bf16x8 a = *(const bf16x8*)(ap + k);
#pragma unroll
                for (int n = 0; n < 3; ++n) { const bf16x8 bh = *(const bf16x8*)(bp + (size_t)n * 16 * 1024 + k), bl = *(const bf16x8*)(bp + (size_t)(48 + n * 16) * 1024 + k);
                    acc[n] = mfma16(a, bh, acc[n]); acc[n] = mfma16(a, bl, acc[n]); }
            }
        }
#pragma unroll
        for (int nt = 0; nt < 3; ++nt)
#pragma unroll
            for (int r = 0; r < 4; ++r) LG[(g4 * 4 + r) * 48 + nt * 16 + l16] = acc[nt][r];
        LDS_WAIT();
        int id1 = 0, id2 = 0;
        if (lane < 16) {
            const int m = m0 + lane; const float rstd = row_rstd_full(SSQ, m); const float* lg = LG + lane * 48;
            float g[4];
#pragma unroll
            for (int j = 0; j < 4; ++j) g[j] = lg[j] * rstd + bg[j];
            float gmax = g[0]; int grp = 0;
#pragma unroll
            for (int j = 1; j < 4; ++j) if (g[j] > gmax) { gmax = g[j]; grp = j; }
            float den = 0.f;
#pragma unroll
            for (int j = 0; j < 4; ++j) den += expf(g[j] - gmax);
            const float psel = 1.0f / den;
            float e1 = -INFINITY, e2 = -INFINITY; int i1 = 0, i2 = 0;
            for (int j = 0; j < 8; ++j) { const float v = lg[4 + grp * 8 + j] * rstd + be[grp * 8 + j];
                if (v > e1) { e2 = e1; i2 = i1; e1 = v; i1 = j; } else if (v > e2) { e2 = v; i2 = j; } }
            const float x = expf(e2 - e1), w1 = 1.0f / (1.0f + x), w2 = x * w1;
            id1 = grp * 8 + i1; id2 = grp * 8 + i2;
            if (live) { TOKE[m * 2] = id1; TOKE[m * 2 + 1] = id2; TOKG[m * 2] = psel * w1; TOKG[m * 2 + 1] = psel * w2; }
        }
        __syncthreads();
        unsigned lp1 = 0u, lp2 = 0u;
        if (lane < 16 && live) { lp1 = __hip_atomic_fetch_add(HIST + id1, 1u, __ATOMIC_RELAXED, __HIP_MEMORY_SCOPE_WORKGROUP); lp2 = __hip_atomic_fetch_add(HIST + id2, 1u, __ATOMIC_RELAXED, __HIP_MEMORY_SCOPE_WORKGROUP); }
        __syncthreads();
        if (F.tid < 32) { const unsigned c = HIST[F.tid]; HIST[32 + F.tid] = c ? __hip_atomic_fetch_add(CNT + F.tid, c, RLX_AGENT) : 0u; }
        __syncthreads();
        if (lane < 16 && live) { const int m = m0 + lane; TOKP[m * 2] = (int)(HIST[32 + id1] + lp1); TOKP[m * 2 + 1] = (int)(HIST[32 + id2] + lp2); }
        __syncthreads();
    }
}
DEV int moe_tables(Frame& F, int l) {
    int* tab = (int*)(F.ldsg + TAB_OFF);
    if (F.tid == 0) {
        const unsigned* CNT = (const unsigned*)F.ctl + CW_CNT + l * 32; int off = 0;
#pragma unroll 1
        for (int e = 0; e < 32; ++e) { tab[e] = off; const int c = (int)__hip_atomic_load(CNT + e, RLX_AGENT); const int nt = (c + 255) >> 8;
            for (int i = 0; i < nt; ++i) tab[40 + (off >> 8) + i] = e;
            off += nt << 8; }
        tab[32] = off;
    }
    __syncthreads();
    return tab[32];
}
DEV void gather_phase(Frame& F, int l) {
    (void)moe_tables(F, l);
    const int* tab = (const int*)(F.ldsg + TAB_OFF);
    const int lane = F.lane; const int gw = F.vcu * NWAVES + F.wave, NGW = F.G * NWAVES;
    const bf16* HB = wsp<bf16>(F, WS_HB); const float* SSQ = wsp<float>(F, WS_SSQ); bf16* XS = wsp<bf16>(F, WS_XS);
    const int* TOKE = wsp<int>(F, WS_TOKE); const float* TOKG = wsp<float>(F, WS_TOKG); const int* TOKP = wsp<int>(F, WS_TOKP); int* TOKS = wsp<int>(F, WS_TOKS);
    float* SRSTD = wsp<float>(F, WS_SRSTD); float* SGATE = wsp<float>(F, WS_SGATE);
    const unsigned* CNT = (const unsigned*)F.ctl + CW_CNT + l * 32;
#pragma unroll 1
    for (int m0 = gw; m0 < NTOK; m0 += 4 * NGW) {
        int s0[4], s1[4]; float g0[4], g1[4], rs[4]; v4u a[4], c[4];
#pragma unroll
        for (int k = 0; k < 4; ++k) { const int m = m0 + k * NGW; const bool ok = m < NTOK; const int mm = ok ? m : m0;
            const int e0 = TOKE[mm * 2], e1 = TOKE[mm * 2 + 1], p0 = TOKP[mm * 2], p1 = TOKP[mm * 2 + 1];
            g0[k] = TOKG[mm * 2]; g1[k] = TOKG[mm * 2 + 1];
            a[k] = *(const v4u*)(HB + (size_t)mm * 1024 + lane * 8); c[k] = *(const v4u*)(HB + (size_t)mm * 1024 + 512 + lane * 8);
            rs[k] = row_rstd_full(SSQ, mm);
            s0[k] = tab[e0] + p0; s1[k] = tab[e1] + p1; }
#pragma unroll
        for (int k = 0; k < 4; ++k) { const int m = m0 + k * NGW;
            if (m < NTOK) {
                *(v4u*)(XS + (size_t)s0[k] * 1024 + lane * 8) = a[k]; *(v4u*)(XS + (size_t)s0[k] * 1024 + 512 + lane * 8) = c[k];
                *(v4u*)(XS + (size_t)s1[k] * 1024 + lane * 8) = a[k]; *(v4u*)(XS + (size_t)s1[k] * 1024 + 512 + lane * 8) = c[k];
                if (lane == 0) { SRSTD[s0[k]] = rs[k]; SRSTD[s1[k]] = rs[k]; SGATE[s0[k]] = g0[k]; SGATE[s1[k]] = g1[k]; TOKS[m * 2] = s0[k]; TOKS[m * 2 + 1] = s1[k]; } } }
    }
#pragma unroll 1
    for (int e = 0; e < 32; ++e) {
        const int c = (int)__hip_atomic_load(CNT + e, RLX_AGENT), base = tab[e], end = (e == 31 ? tab[32] : tab[e + 1]);
        for (int r = base + c + gw; r < end; r += NGW) {
            *(v4u*)(XS + (size_t)r * 1024 + lane * 8) = (v4u){0u, 0u, 0u, 0u}; *(v4u*)(XS + (size_t)r * 1024 + 512 + lane * 8) = (v4u){0u, 0u, 0u, 0u};
            if (lane == 0) { SRSTD[r] = 0.f; SGATE[r] = 0.f; }
        }
    }
}
DEV void combine_phase(Frame& F, int l, int probe = 0) {
    const int lane = F.lane; const int gw = F.vcu * NWAVES + F.wave, NGW = F.G * NWAVES;
    float* Ho = probe ? wsp<float>(F, WS_PROBE) : (float*)(GAS float*)F.out; const bf16* HBi = wsp<bf16>(F, WS_HB); bf16* HB = wsp<bf16>(F, probe ? WS_PROBE + 128 * MiB : WS_HB); float* SSQ = wsp<float>(F, probe ? WS_PROBE + 192 * MiB : WS_SSQ); const bf16* YS = wsp<bf16>(F, WS_YS); const int* TOKS = wsp<int>(F, WS_TOKS);
    const float* gf = inp(23);
#pragma unroll 1
    for (int m0 = gw; m0 < NTOK; m0 += 2 * NGW) {
        f32x4 v[2][4]; float ssum[2];
        int sl[2][2];
#pragma unroll
        for (int k = 0; k < 2; ++k) { const int m = (m0 + k * NGW < NTOK) ? m0 + k * NGW : m0; sl[k][0] = TOKS[m * 2]; sl[k][1] = TOKS[m * 2 + 1]; }
        v2u h[2][4]; v2u ya[2][4], yb[2][4];
#pragma unroll
        for (int k = 0; k < 2; ++k) { const int m = (m0 + k * NGW < NTOK) ? m0 + k * NGW : m0;
#pragma unroll
            for (int j = 0; j < 4; ++j) { const int c = lane * 4 + 256 * j;
                h[k][j] = *(const v2u*)(HBi + (size_t)m * 1024 + c);
                ya[k][j] = *(const v2u*)(YS + (size_t)sl[k][0] * 1024 + c); yb[k][j] = *(const v2u*)(YS + (size_t)sl[k][1] * 1024 + c); } }
#pragma unroll
        for (int k = 0; k < 2; ++k) { float ss = 0.f;
#pragma unroll
            for (int j = 0; j < 4; ++j) { const v2u a = ya[k][j], bq = yb[k][j]; const f32x4 hh = (f32x4){bflo(h[k][j].x), bfhi(h[k][j].x), bflo(h[k][j].y), bfhi(h[k][j].y)};
                f32x4 r; r[0] = hh[0] + (bflo(a.x) + bflo(bq.x)); r[1] = hh[1] + (bfhi(a.x) + bfhi(bq.x)); r[2] = hh[2] + (bflo(a.y) + bflo(bq.y)); r[3] = hh[3] + (bfhi(a.y) + bfhi(bq.y));
                v[k][j] = r; ss += (r[0] * r[0] + r[1] * r[1]) + (r[2] * r[2] + r[3] * r[3]); }
            ssum[k] = wave_sum(ss); }
#pragma unroll
        for (int k = 0; k < 2; ++k) { const int m = m0 + k * NGW;
            if (m < NTOK) {
                if (l == DEPTH - 1) {
                    const float rstd = 1.0f / sqrtf(ssum[k] * (1.0f / 1024.0f) + RMS_EPS);
#pragma unroll
                    for (int j = 0; j < 4; ++j) { const int c = lane * 4 + 256 * j; const f32x4 g = *(const f32x4*)(gf + c); *(f32x4*)(Ho + (size_t)m * 1024 + c) = v[k][j] * rstd * g; }
                } else {
#pragma unroll
                    for (int j = 0; j < 4; ++j) { const int c = lane * 4 + 256 * j;
                        v2u w; w.x = pk2(v[k][j][0], v[k][j][1]); w.y = pk2(v[k][j][2], v[k][j][3]); *(v2u*)(HB + (size_t)m * 1024 + c) = w; }
                    if (lane < 16) SSQ[(size_t)m * 16 + lane] = lane == 0 ? ssum[k] : 0.f;
                } } }
    }
}
#ifndef MK_ONE_LAUNCH
#define MK_ONE_LAUNCH 1
#endif
constexpr int NPH_LAYER = 13, NPHASES = 1 + DEPTH * NPH_LAYER;
struct Args { const float* in[24]; float* out; unsigned char* ws; int ph_lo, ph_hi; };
static_assert(sizeof(Args) == 24 * 8 + 8 + 8 + 8, "Args has no padding");

__global__ void __launch_bounds__(NWAVES * 64, 2) hymba_fwd(Args args) {
    extern __shared__ __attribute__((aligned(16))) unsigned char lds[];
    Frame F;
    F.lds = (LAS unsigned char*)lds; F.ldsg = lds;
    F.MISC = (volatile LAS unsigned*)(F.lds + MISC_OFF);
    F.tid = threadIdx.x; F.lane = F.tid & 63; F.wave = __builtin_amdgcn_readfirstlane(F.tid >> 6);
    F.G = gridDim.x; { const int bx = blockIdx.x; F.vcu = (F.G % 8 == 0) ? (bx % 8) * (F.G / 8) + bx / 8 : bx; }
    F.ws = args.ws; F.ctl = (gu32*)(args.ws + WS_CTL); F.out = args.out;
    if (F.tid < 64) ((LAS unsigned*)(F.lds + MISC_OFF))[F.tid] = 0u;
    __syncthreads();
    int wave0 = F.wave;
    const int lo = args.ph_lo, hi = args.ph_hi;
    XcdBarrier bar; bar.bar = (unsigned*)(F.ctl + CW_BAR); bar.x = 0; bar.st = nullptr;
    if (hi - lo > 1) bar = xcd_barrier_post((unsigned*)(F.ctl + CW_BAR), F.MISC + 8);
#ifndef PHMASK
#define PHMASK 0xFFFF
#endif
#define IN(k) (lo <= (k) && (k) < hi)
#define EN(j) ((PHMASK >> (j)) & 1)
#define RELAUNDER() do { asm volatile("" : "+s"(wave0)); unsigned z_ = 0u; asm volatile("" : "+v"(z_)); int t_ = wave0 * 64 + (int)__builtin_amdgcn_mbcnt_hi(~0u, __builtin_amdgcn_mbcnt_lo(~0u, z_)); F.tid = t_; F.lane = t_ & 63; F.wave = wave0; \
    size_t zo_ = 0; asm volatile("" : "+s"(zo_), "+s"(F.vcu), "+s"(F.G)); F.ws = args.ws + zo_; F.out = args.out + zo_; F.ctl = (gu32*)(F.ws + WS_CTL); } while (0)
#ifndef NSA_VAR
#define NSA_VAR 0
#endif
#ifndef BAR2X
#define BAR2X 0
#endif
#ifndef DUPMASK
#define DUPMASK 0
#endif
#define DUP(j) ((DUPMASK >> (j)) & 1)
#ifndef STAG_J0
#define STAG_J0 0
#endif
#ifndef STAG_MOE
#define STAG_MOE 0
#endif
#define STAGGER(ticks) do { if ((ticks) > 0 && (F.vcu & 1)) { const unsigned long long t0_ = __builtin_amdgcn_s_memrealtime(); while (__builtin_amdgcn_s_memrealtime() - t0_ < (unsigned long long)(ticks)) __builtin_amdgcn_s_sleep(32); } } while (0)
#define SEAM(k) do { if (IN(k) && IN((k) + 1)) { XcdBarrier b_ = bar; size_t zb_ = 0; asm volatile("" : "+s"(b_.x), "+s"(zb_)); b_.bar = (unsigned*)(args.ws + WS_CTL + zb_) + CW_BAR; xcd_barrier(b_); if (BAR2X) xcd_barrier(b_); } } while (0)

    if (IN(0) && EN(13)) { RELAUNDER(); p0_prologue(F); if (DUP(13)) { __syncthreads(); p0_prologue(F); } } SEAM(0);

#pragma unroll 1
    for (int l = 0; l < DEPTH; ++l) {
        const int pb = 1 + l * NPH_LAYER;
        bf16* HB = wsp<bf16>(F, WS_HB); float* SSQ = wsp<float>(F, WS_SSQ);
        if (IN(pb + 0) && EN(0)) for (int rep_ = 0; rep_ < (DUP(0) ? 2 : 1); ++rep_) { RELAUNDER(); if (rep_) __syncthreads();
            pg8::Gemm g{HB, wsp<bf16>(F, WS_WIN) + (size_t)l * NIN * 1024, NTOK, 3072, D};
            pg8::StaticOrder S; S.init(NTOK, 3072, F.G, (int)blockIdx.x);
            EpiIn E{F.ws};
            STAGGER(STAG_J0);
            pg8::gemm_phase<EpiIn, pg8::StaticOrder, true, true>(F.lds, g, S, E, F.wave);
        }
        SEAM(pb + 0);
        if (IN(pb + 1) && EN(1)) { RELAUNDER();
            compress_phase(F, l);
            hgrn_local_phase(F, l);
            conv_phase(F, l);
            kmax_phase(F, l);
            if (l == 0) memkv_phase(F);
            if (DUP(1)) { __syncthreads(); compress_phase(F, l); hgrn_local_phase(F, l); conv_phase(F, l); }
        }
        SEAM(pb + 1);
        if (IN(pb + 2) && EN(2)) { RELAUNDER(); hgrn_scan_phase(F); if (DUP(14)) hgrn_scan_phase(F, 1); nsa_phase(F, l); if (DUP(2)) { __syncthreads(); nsa_phase_t<NSA_VAR>(F, l); } }
        SEAM(pb + 2);
        if (IN(pb + 3) && EN(3)) { RELAUNDER(); hgrn_out_phase(F, l); if (DUP(3)) { __syncthreads(); hgrn_out_phase(F, l); } }
        SEAM(pb + 3);
        if (IN(pb + 4) && EN(4)) for (int rep_ = 0; rep_ < ((DUP(4) && l == 0) ? 2 : 1); ++rep_) { RELAUNDER(); if (rep_) __syncthreads();
            pg8::Gemm g{wsp<bf16>(F, WS_CAT), wsp<bf16>(F, WS_WOUT) + (size_t)l * 1024 * 1024, NTOK, D, D};
            pg8::StaticOrder S; S.init(NTOK, D, F.G, (int)blockIdx.x);
            EpiRes E{l == 0 ? inp(0) : (const float*)nullptr, HB, SSQ};
            pg8::gemm_phase<EpiRes, pg8::StaticOrder, true, true>(F.lds, g, S, E, F.wave);
        }
        SEAM(pb + 4);
        if (IN(pb + 5) && EN(5)) for (int rep_ = 0; rep_ < (DUP(5) ? 2 : 1); ++rep_) { RELAUNDER(); if (rep_) __syncthreads();
            pg8::Gemm g{HB, wsp<bf16>(F, WS_WQ) + (size_t)l * 256 * 1024, NTOK, 256, D};
            pg8::StaticOrder S; S.init(NTOK, 256, F.G, (int)blockIdx.x);
            EpiXQ E{SSQ, wsp<bf16>(F, WS_XQ)};
            pg8::gemm_phase<EpiXQ, pg8::StaticOrder, true, true>(F.lds, g, S, E, F.wave);
        }
        SEAM(pb + 5);
        if (IN(pb + 6) && EN(6)) { RELAUNDER(); cross_phase(F, l); if (DUP(6)) { __syncthreads(); cross_phase(F, l); } }
        SEAM(pb + 6);
        if (IN(pb + 7) && EN(7)) { RELAUNDER();
            pg8::Gemm g{wsp<bf16>(F, WS_XO), wsp<bf16>(F, WS_WO) + (size_t)l * 1024 * 256, NTOK, D, 256};
            pg8::StaticOrder S; S.init(NTOK, D, F.G, (int)blockIdx.x);
            EpiRes E{(const float*)nullptr, HB, SSQ};
            pg8::gemm_phase<EpiRes, pg8::StaticOrder, true, true>(F.lds, g, S, E, F.wave);
        }
        SEAM(pb + 7);
        if (IN(pb + 8) && EN(8)) { RELAUNDER(); router_phase(F, l); if (DUP(8)) router_phase(F, l, 1); }
        SEAM(pb + 8);
        if (IN(pb + 9) && EN(9)) { RELAUNDER(); gather_phase(F, l); if (DUP(9)) { __syncthreads(); gather_phase(F, l); } }
        SEAM(pb + 9);
        if (IN(pb + 10) && EN(10)) for (int rep_ = 0; rep_ < (DUP(10) ? 2 : 1); ++rep_) { RELAUNDER(); if (rep_) __syncthreads();
            const int ns = moe_tables(F, l);
            pg8::Gemm g{wsp<bf16>(F, WS_XS), wsp<bf16>(F, WS_WGU) + (size_t)l * 32 * 1024 * 1024, ns, 32 * 1024, D};
            MoeOrder S{(ns >> 8) * 4, F.G, (int)blockIdx.x, (const LAS int*)(F.lds + TAB_OFF) + 40};
            EpiGU E{wsp<float>(F, WS_SRSTD), wsp<bf16>(F, WS_ACT)};
            STAGGER(STAG_MOE);
            pg8::gemm_phase<EpiGU, MoeOrder, true, true>(F.lds, g, S, E, F.wave);
        }
        SEAM(pb + 10);
        if (IN(pb + 11) && EN(11)) for (int rep_ = 0; rep_ < (DUP(11) ? 2 : 1); ++rep_) { RELAUNDER(); if (rep_) __syncthreads();
            const int ns = moe_tables(F, l);
            pg8::Gemm g{wsp<bf16>(F, WS_ACT), wsp<bf16>(F, WS_WDN) + (size_t)l * 32 * 1024 * 512, ns, 32 * 1024, 512};
            MoeOrder S{(ns >> 8) * 4, F.G, (int)blockIdx.x, (const LAS int*)(F.lds + TAB_OFF) + 40};
            EpiDN E{wsp<float>(F, WS_SGATE), wsp<bf16>(F, WS_YS)};
            STAGGER(STAG_MOE / 2);
            pg8::gemm_phase<EpiDN, MoeOrder, true, true>(F.lds, g, S, E, F.wave);
        }
        SEAM(pb + 11);
        if (IN(pb + 12) && EN(12)) { RELAUNDER(); combine_phase(F, l); if (DUP(12)) combine_phase(F, l, 1); }
        SEAM(pb + 12);
    }
#undef IN
#undef SEAM
}

extern "C" void kernel_launch(void* const* d_in, const int* in_sizes, int n_in, void* d_out, int out_size, void* d_ws, size_t ws_size, hipStream_t stream) {
    static int grid = 0;
    if (grid == 0) {
        if (n_in != 24 || in_sizes[0] != NTOK * D || out_size != NTOK * D || ws_size < WS_END) {
            fprintf(stderr, "kernel_launch: unexpected shapes: n_in %d in0 %d out %d ws %zu (need %zu)\n", n_in, n_in > 0 ? in_sizes[0] : -1, out_size, ws_size, (size_t)WS_END); grid = -1; return; }
        int dev = 0, cus = 0, per_cu = 0;
        if (hipGetDevice(&dev) != hipSuccess || hipDeviceGetAttribute(&cus, hipDeviceAttributeMultiprocessorCount, dev) != hipSuccess) { grid = -1; return; }
        if (hipFuncSetAttribute((const void*)hymba_fwd, hipFuncAttributeMaxDynamicSharedMemorySize, LDS_BYTES) != hipSuccess) { fprintf(stderr, "kernel_launch: hipFuncSetAttribute failed\n"); grid = -1; return; }
        if (hipOccupancyMaxActiveBlocksPerMultiprocessor(&per_cu, (const void*)hymba_fwd, NWAVES * 64, LDS_BYTES) != hipSuccess || per_cu < 1)
            fprintf(stderr, "kernel_launch: note: occupancy query reports %d blocks per CU\n", per_cu);
        (void)hipGetLastError();
        grid = cus;
    }
    if (grid < 0) return;
    if (hipMemsetAsync((char*)d_ws + WS_CTL, 0, CTL_ZERO_BYTES, stream) != hipSuccess) { fprintf(stderr, "kernel_launch: memset failed\n"); return; }
    Args a{};
    for (int i = 0; i < 24; ++i) a.in[i] = (const float*)d_in[i];
    a.out = (float*)d_out; a.ws = (unsigned char*)d_ws;
#if MK_ONE_LAUNCH
    a.ph_lo = 0; a.ph_hi = NPHASES;
    hipLaunchKernelGGL(hymba_fwd, dim3(grid), dim3(NWAVES * 64), LDS_BYTES, stream, a);
#else
    for (int p = 0; p < NPHASES; ++p) { a.ph_lo = p; a.ph_hi = p + 1; hipLaunchKernelGGL(hymba_fwd, dim3(grid), dim3(NWAVES * 64), LDS_BYTES, stream, a); }
#endif
    const hipError_t le = hipPeekAtLastError();
    if (le != hipSuccess) fprintf(stderr, "kernel_launch: launch failed: %s\n", hipGetErrorName(le));
}
```

```cpp
#define MK_ONE_LAUNCH 1
#include <hip/hip_runtime.h>
#include <cstdio>
#include <cstdint>
#include <cmath>
namespace pg8 {
#define PG8_LAS __attribute__((address_space(3)))
typedef unsigned short bf16_t;
typedef short bf16x8 __attribute__((ext_vector_type(8)));
typedef float f32x4 __attribute__((ext_vector_type(4)));
typedef unsigned u32x4 __attribute__((ext_vector_type(4)));
constexpr int BM = 256, BK = 64, HALF = 128, HTB = HALF * BK * 2  , STAGE_BYTES = 8 * HTB, NXCD = 8, WGM = 8;

__host__ __device__ __forceinline__ int lds_byte(int r, int c) { const int st = (r >> 4) * 2 + (c >> 5), rr = r & 15, cc = c & 31, ob = rr * 64 + cc * 2; return st * 1024 + (ob ^ (((ob >> 9) & 1) << 5)); }
__host__ __device__ __forceinline__ void stage_rc(int b, int& R, int& C) { const int st = b / 1024, sb = b % 1024, swz = sb ^ (((sb >> 9) & 1) << 5); R = (st >> 1) * 16 + swz / 64; C = (st & 1) * 32 + (swz % 64) / 2; }
__host__ __device__ __forceinline__ int perm32(int rho) { const int n = rho >> 4, i = rho & 15; return 8 * (i >> 2) + 4 * n + (i & 3); }

struct Unit { int pm, pn; };
struct Gemm { const bf16_t* A; const bf16_t* Bt; int M, N, K; };

struct StaticOrder {
    int nM, nN, nwg, G, c;
    __host__ __device__ void init(int M, int N, int G_, int c_) { nM = M / BM; nN = N / BM; nwg = nM * nN; G = G_; c = c_; }
    __host__ __device__ bool next(int i, Unit& u) const {
        const long L = (long)i * G + c; if (L >= nwg) return false;
        int wgid = (int)L; { const int q = nwg / NXCD, r = nwg % NXCD, xcd = wgid % NXCD, off = wgid / NXCD; wgid = (xcd < r ? xcd * (q + 1) : r * (q + 1) + (xcd - r) * q) + off; }
        const int nig = WGM * nN, gid = wgid / nig, fm = gid * WGM, gsz = (nM - fm) < WGM ? (nM - fm) : WGM;
        u.pm = fm + ((wgid % nig) % gsz); u.pn = (wgid % nig) / gsz; return true;
    }
    __device__ __forceinline__ void a_ready(const Unit&) const {}
    __device__ __forceinline__ void done(const Unit&) const {}
};

__device__ __forceinline__ unsigned cvt_pk_bf16(float lo, float hi) { unsigned r; asm volatile("v_cvt_pk_bf16_f32 %0, %1, %2" : "=v"(r) : "v"(lo), "v"(hi)); return r; }
typedef float f32x2 __attribute__((ext_vector_type(2)));
template <class Epi, class Sched, bool ALIGN_EPI = false, bool SP2 = false>
__device__ __forceinline__ void gemm_phase(PG8_LAS unsigned char* lds, const Gemm g, const Sched& S, const Epi& E, int wave_id) {
    unsigned z_ = 0u; asm volatile("" : "+v"(z_)); int tid_ = wave_id * 64 + (int)__builtin_amdgcn_mbcnt_hi(~0u, __builtin_amdgcn_mbcnt_lo(~0u, z_));
    const int tid = tid_, wid = __builtin_amdgcn_readfirstlane(tid >> 6), lane = tid & 63, wr = wid >> 2, wc = wid & 3, fr = lane & 15, fq = lane >> 4;
    const int K = g.K, nt = K / BK;
    unsigned voffA[2], voffB[2];
#pragma unroll
    for (int i = 0; i < 2; ++i) { int R, C; stage_rc(tid * 16 + i * 8192, R, C); const int Rb = Epi::PERM ? ((R & ~31) + perm32(R & 31)) : R;
        voffA[i] = (unsigned)(R * K + C) * 2u; voffB[i] = (unsigned)(Rb * K + C) * 2u; }
    const size_t kstep = (size_t)(BK * 2);
    const size_t hstep = (size_t)HALF * K * 2;
    const size_t tstep = 2 * hstep;
    const unsigned ldsw = (unsigned)wid * 1024u;
    const int aoff = lds_byte(wr * 64 + fr, fq * 8), boff = lds_byte(wc * 32 + fr, fq * 8);
#define PG8_SA(b, h) (((b) * 2 + (h)) * HTB)
#define PG8_SB(b, h) ((4 + (b) * 2 + (h)) * HTB)
#define PG8_STAGE(bufoff, gbase, voff) do { _Pragma("unroll") for (int _i = 0; _i < 2; ++_i) \
        __builtin_amdgcn_global_load_lds((const unsigned*)((const char*)(gbase) + (voff)[_i]), (PG8_LAS unsigned*)(lds + (bufoff) + ldsw + _i * 8192), 16, 0, 0); } while (0)
#define PG8_LDA(dst, b, h) do { _Pragma("unroll") for (int m = 0; m < 4; ++m) _Pragma("unroll") for (int k = 0; k < 2; ++k) dst[m][k] = *(const PG8_LAS bf16x8*)(lds + PG8_SA(b, h) + aoff + m * 2048 + k * 1024); } while (0)
#define PG8_LDB(dst, b, h) do { _Pragma("unroll") for (int n = 0; n < 2; ++n) _Pragma("unroll") for (int k = 0; k < 2; ++k) dst[n][k] = *(const PG8_LAS bf16x8*)(lds + PG8_SB(b, h) + boff + n * 2048 + k * 1024); } while (0)
#define PG8_MMA(ai, bj, At, Bt) do { __builtin_amdgcn_s_setprio(1); _Pragma("unroll") for (int m = 0; m < 4; ++m) _Pragma("unroll") for (int n = 0; n < 2; ++n) _Pragma("unroll") for (int k = 0; k < 2; ++k) \
        acc[ai][bj][m][n] = __builtin_amdgcn_mfma_f32_16x16x32_bf16(Bt[n][k], At[m][k], acc[ai][bj][m][n], 0, 0, 0); __builtin_amdgcn_s_setprio(0); } while (0)
#define PG8_WAIT_V(n) asm volatile("s_waitcnt vmcnt(" #n ")" ::: "memory")
#define PG8_WAIT_L(n) asm volatile("s_waitcnt lgkmcnt(" #n ")" ::: "memory")
#define PG8_BAR __builtin_amdgcn_s_barrier()
#define PG8_SCHED __builtin_amdgcn_sched_barrier(0)
    Unit cur, nxt; int ui = 0;
    if (!S.next(0, cur)) return;
    f32x4 acc[2][2][4][2];
#pragma unroll
    for (int a = 0; a < 2; ++a)
#pragma unroll
        for (int b = 0; b < 2; ++b)
#pragma unroll
            for (int m = 0; m < 4; ++m)
#pragma unroll
                for (int n = 0; n < 2; ++n) acc[a][b][m][n] = (f32x4){0.f, 0.f, 0.f, 0.f};
    bf16x8 At[4][2], B0[2][2], B1[2][2];
    const char* cA = (const char*)g.A + (size_t)cur.pm * tstep; const char* cB = (const char*)g.Bt + (size_t)cur.pn * tstep;
    S.a_ready(cur);
    if constexpr (SP2) {
        PG8_STAGE(PG8_SB(0, 0), cB, voffB); PG8_STAGE(PG8_SB(0, 1), cB + hstep, voffB); PG8_STAGE(PG8_SA(0, 0), cA, voffA); PG8_STAGE(PG8_SA(0, 1), cA + hstep, voffA);
        if (wr == 1) PG8_BAR;
        PG8_WAIT_V(2); PG8_BAR;
        PG8_STAGE(PG8_SB(1, 0), cB + kstep, voffB); PG8_STAGE(PG8_SA(1, 0), cA + kstep, voffA); PG8_STAGE(PG8_SB(1, 1), cB + hstep + kstep, voffB);
        PG8_WAIT_V(6); PG8_BAR;
    } else {
        PG8_STAGE(PG8_SB(0, 0), cB, voffB); PG8_STAGE(PG8_SA(0, 0), cA, voffA); PG8_STAGE(PG8_SB(0, 1), cB + hstep, voffB); PG8_STAGE(PG8_SA(0, 1), cA + hstep, voffA);
        if (wr == 1) PG8_BAR;
        PG8_WAIT_V(4); PG8_BAR;
        PG8_STAGE(PG8_SB(1, 0), cB + kstep, voffB); PG8_STAGE(PG8_SA(1, 0), cA + kstep, voffA); PG8_STAGE(PG8_SB(1, 1), cB + hstep + kstep, voffB);
        PG8_WAIT_V(6); PG8_BAR;
    }
    for (;;) {
        const bool has_next = S.next(ui + 1, nxt);
        const char* nA = has_next ? (const char*)g.A + (size_t)nxt.pm * tstep : cA; const char* nB = has_next ? (const char*)g.Bt + (size_t)nxt.pn * tstep : cB;
        for (int t = 0; t < nt; t += 2) {
            const bool last = (t == nt - 2);
            const char* a1 = cA + (size_t)(t + 1) * kstep;
            const char* a2 = last ? nA : cA + (size_t)(t + 2) * kstep; const char* b2 = last ? nB : cB + (size_t)(t + 2) * kstep;
            const char* a3 = a2 + kstep; const char* b3 = b2 + kstep;
            if (last && has_next) S.a_ready(nxt);
            if constexpr (SP2) {
            PG8_LDB(B0, 0, 0); PG8_LDB(B1, 0, 1); PG8_SCHED; PG8_LDA(At, 0, 0); PG8_STAGE(PG8_SA(1, 1), a1 + hstep, voffA);
            PG8_WAIT_V(8); PG8_WAIT_L(0); PG8_BAR; PG8_MMA(0, 0, At, B0); PG8_MMA(0, 1, At, B1); PG8_BAR; PG8_SCHED;
            PG8_LDA(At, 0, 1); PG8_STAGE(PG8_SB(0, 0), b2, voffB); PG8_STAGE(PG8_SB(0, 1), b2 + hstep, voffB); PG8_STAGE(PG8_SA(0, 0), a2, voffA);
            PG8_WAIT_V(8); PG8_WAIT_L(0); PG8_BAR; PG8_MMA(1, 0, At, B0); PG8_MMA(1, 1, At, B1); PG8_BAR; PG8_SCHED;
            PG8_LDB(B0, 1, 0); PG8_LDB(B1, 1, 1); PG8_SCHED; PG8_LDA(At, 1, 0); PG8_STAGE(PG8_SA(0, 1), a2 + hstep, voffA);
            PG8_WAIT_V(8); PG8_WAIT_L(0); PG8_BAR; PG8_MMA(0, 0, At, B0); PG8_MMA(0, 1, At, B1); PG8_BAR; PG8_SCHED;
            PG8_LDA(At, 1, 1); PG8_STAGE(PG8_SB(1, 0), b3, voffB); PG8_STAGE(PG8_SB(1, 1), b3 + hstep, voffB); PG8_STAGE(PG8_SA(1, 0), a3, voffA);
            PG8_WAIT_V(8); PG8_WAIT_L(0); PG8_BAR; PG8_MMA(1, 0, At, B0); PG8_MMA(1, 1, At, B1); PG8_BAR; PG8_SCHED;
            } else {
            PG8_LDB(B0, 0, 0); PG8_SCHED; PG8_LDA(At, 0, 0); PG8_STAGE(PG8_SA(1, 1), a1 + hstep, voffA);
            PG8_WAIT_L(8); PG8_BAR; PG8_WAIT_L(0); PG8_MMA(0, 0, At, B0); PG8_BAR; PG8_SCHED;
            PG8_LDB(B1, 0, 1); PG8_STAGE(PG8_SB(0, 0), b2, voffB);
            PG8_BAR; PG8_WAIT_L(0); PG8_MMA(0, 1, At, B1); PG8_BAR;
            PG8_LDA(At, 0, 1); PG8_STAGE(PG8_SA(0, 0), a2, voffA);
            PG8_BAR; PG8_WAIT_L(0); PG8_MMA(1, 0, At, B0); PG8_BAR; PG8_SCHED;
            PG8_STAGE(PG8_SB(0, 1), b2 + hstep, voffB);
            PG8_WAIT_V(6); PG8_BAR; PG8_MMA(1, 1, At, B1); PG8_BAR;
            PG8_LDB(B0, 1, 0); PG8_SCHED; PG8_LDA(At, 1, 0); PG8_STAGE(PG8_SA(0, 1), a2 + hstep, voffA);
            PG8_WAIT_L(8); PG8_BAR; PG8_WAIT_L(0); PG8_MMA(0, 0, At, B0); PG8_BAR; PG8_SCHED;
            PG8_LDB(B1, 1, 1); PG8_STAGE(PG8_SB(1, 0), b3, voffB);
            PG8_BAR; PG8_WAIT_L(0); PG8_MMA(0, 1, At, B1); PG8_BAR;
            PG8_LDA(At, 1, 1); PG8_STAGE(PG8_SA(1, 0), a3, voffA);
            PG8_BAR; PG8_WAIT_L(0); PG8_MMA(1, 0, At, B0); PG8_BAR; PG8_SCHED;
            PG8_STAGE(PG8_SB(1, 1), b3 + hstep, voffB);
            PG8_WAIT_V(6); PG8_BAR; PG8_MMA(1, 1, At, B1); PG8_BAR;
            }
        }
        if constexpr (ALIGN_EPI) { if (wr == 0) PG8_BAR; }
        if constexpr (!Epi::AFTER_DRAIN) { E(acc, cur, wr, wc, fr, fq); S.done(cur); }
        if (!has_next) break;
#pragma unroll
        for (int a = 0; a < 2; ++a)
#pragma unroll
            for (int b = 0; b < 2; ++b)
#pragma unroll
                for (int m = 0; m < 4; ++m)
#pragma unroll
                    for (int n = 0; n < 2; ++n) acc[a][b][m][n] = (f32x4){0.f, 0.f, 0.f, 0.f};
        cur = nxt; cA = nA; cB = nB; ++ui;
        if constexpr (ALIGN_EPI) { if (wr == 1) PG8_BAR; }
    }
    PG8_WAIT_V(0);
    if constexpr (!ALIGN_EPI) { if (wr == 0) PG8_BAR; }
    PG8_BAR;
    if constexpr (Epi::AFTER_DRAIN) { E.fused(acc, cur, wr, wc, fr, fq, lds, wid, lane); S.done(cur); }
#undef PG8_SA
#undef PG8_SB
#undef PG8_STAGE
#undef PG8_LDA
#undef PG8_LDB
#undef PG8_MMA
#undef PG8_WAIT_V
#undef PG8_WAIT_L
#undef PG8_BAR
#undef PG8_SCHED
}
}
constexpr int NB = 4, T = 8192, D = 1024, NTOK = NB * T, DEPTH = 2;
constexpr int NIN = 3328;
constexpr int IN_W = 3096;
constexpr int NSLOT_MAX = 65536 + 32 * 256;
constexpr float RMS_EPS = 1e-6f;
constexpr float QSCALE = 0.125f * 1.44269504088896f;
constexpr int NWAVES = 8;

constexpr size_t MiB = 1u << 20;
constexpr size_t WS_CTL = 0, CTL_ZERO_BYTES = 1 * MiB;
constexpr size_t WS_ROPE = 1 * MiB;
constexpr size_t WS_SMALL = 3 * MiB;
constexpr size_t WS_WG = 3 * MiB + 65536;
constexpr size_t WS_SSQ = 4 * MiB;
constexpr size_t WS_WIN = 8 * MiB;
constexpr size_t WS_WOUT = 22 * MiB;
constexpr size_t WS_WQ = 26 * MiB;
constexpr size_t WS_WKV = 27 * MiB;
constexpr size_t WS_WO = 29 * MiB;
constexpr size_t WS_WR = 30 * MiB;
constexpr size_t WS_W1C = 31 * MiB;
constexpr size_t WS_W2C = 33 * MiB;
constexpr size_t WS_MEMB = 34 * MiB;
constexpr size_t WS_MK = 36 * MiB;
constexpr size_t WS_MVT = 37 * MiB;
constexpr size_t WS_WGU = 40 * MiB;
constexpr size_t WS_WDN = 168 * MiB;
constexpr size_t WS_HB = 232 * MiB;
constexpr size_t WS_Q = 296 * MiB, WS_QR = 328 * MiB, WS_KCR = 360 * MiB, WS_VCR = 368 * MiB, WS_KS = 376 * MiB, WS_KW = 384 * MiB;
constexpr size_t WS_VST = 392 * MiB, WS_VWT = 400 * MiB, WS_KCC = 408 * MiB, WS_VCT = 409 * MiB, WS_GATE = 410 * MiB;
constexpr size_t WS_CB = 414 * MiB, WS_CC = 430 * MiB, WS_CH = 446 * MiB;
constexpr size_t WS_HQ = 462 * MiB, WS_HF = 494 * MiB, WS_HI = 526 * MiB, WS_HG = 558 * MiB;
constexpr size_t WS_CAT = 590 * MiB, WS_U = 654 * MiB, WS_DEC = 686 * MiB;
constexpr size_t WS_XQ = 688 * MiB, WS_XO = 704 * MiB;
constexpr size_t WS_XS = 296 * MiB, WS_ACT = 440 * MiB, WS_YS = 512 * MiB;
constexpr size_t WS_TOKE = 720 * MiB, WS_TOKG = 721 * MiB, WS_TOKP = 722 * MiB, WS_TOKS = 723 * MiB, WS_SRSTD = 724 * MiB, WS_SGATE = 725 * MiB;
constexpr size_t WS_U2 = 728 * MiB;
constexpr size_t WS_PROBE = 760 * MiB;
constexpr size_t WS_END = 760 * MiB;
static_assert(WS_XS + (size_t)NSLOT_MAX * 1024 * 2 <= WS_ACT && WS_ACT + (size_t)NSLOT_MAX * 512 * 2 <= WS_YS && WS_YS + (size_t)NSLOT_MAX * 1024 * 2 <= WS_XQ, "moe map");
constexpr int CW_CNT = 64;
constexpr int CW_KMAX = 256;
constexpr int CW_BAR = 4096;

constexpr int RING_BYTES = 131072;
constexpr int NSA_LDS_WAVE = 10752;
constexpr int MISC_OFF = RING_BYTES;
constexpr int TAB_OFF = RING_BYTES + 512;
constexpr int LDS_BYTES = 147456;
static_assert(8 * NSA_LDS_WAVE <= RING_BYTES && TAB_OFF + 4 * (40 + 320) <= LDS_BYTES, "LDS map");

#define GAS __attribute__((address_space(1)))
#define LAS __attribute__((address_space(3)))
#define DEV __device__ __forceinline__
typedef unsigned short bf16;
typedef unsigned v4u __attribute__((ext_vector_type(4)));
typedef unsigned v2u __attribute__((ext_vector_type(2)));
typedef float f32x4 __attribute__((ext_vector_type(4)));
typedef short bf16x8 __attribute__((ext_vector_type(8)));
typedef GAS unsigned gu32;
#define RLX_AGENT __ATOMIC_RELAXED, __HIP_MEMORY_SCOPE_AGENT
#define LDS_WAIT() asm volatile("s_waitcnt lgkmcnt(0)" ::: "memory")
#define VM_WAIT() asm volatile("s_waitcnt vmcnt(0)" ::: "memory")
typedef __bf16 bf16x2_t __attribute__((ext_vector_type(2)));
typedef float f32x2_t __attribute__((ext_vector_type(2)));
DEV unsigned pk2(float lo, float hi) { const f32x2_t v = {lo, hi}; return __builtin_bit_cast(unsigned, __builtin_convertvector(v, bf16x2_t)); }
DEV unsigned f2bf(float f) { return pk2(f, 0.f) & 0xffffu; }
DEV float bf2f(unsigned short b) { return __builtin_bit_cast(float, (unsigned)b << 16); }
DEV float bflo(unsigned w) { return __builtin_bit_cast(float, w << 16); }
DEV float bfhi(unsigned w) { return __builtin_bit_cast(float, w & 0xffff0000u); }
DEV float ex2(float x) { return __builtin_amdgcn_exp2f(x); }
DEV float wave_sum(float v) {
#pragma unroll
    for (int o = 1; o < 64; o <<= 1) v += __shfl_xor(v, o);
    return v;
}
DEV f32x4 mfma16(bf16x8 a, bf16x8 b, f32x4 c) { return __builtin_amdgcn_mfma_f32_16x16x32_bf16(a, b, c, 0, 0, 0); }
DEV int slot32(int k) { return ((k >> 2) & 3) * 8 + (k >> 4) * 4 + (k & 3); }
DEV int kfrag_off(int key, int d) { return (key >> 5) * 2048 + ((((key >> 4) & 1) * 2 + (d >> 5)) * 64 + ((d >> 3) & 3) * 16 + (key & 15)) * 8 + (d & 7); }
DEV float sigmoidf_(float x) { return 1.0f / (1.0f + __expf(-x)); }
DEV float siluf_(float x) { return x / (1.0f + __expf(-x)); }
#define XB_TMO      128
#define XB_XCNT(j)  (256  + 64 * (j))
#define XB_XSUB(j)  (1280 + 64 * (j))
#define XB_XGEN(j)  (2304 + 64 * (j))
#define XB_TOP      3328
#define XB_TOPGEN   3392
#define XCD_BAR_WORDS 3456
#define XB_SPIN_CAP (1u << 18)

__device__ __forceinline__ unsigned xb_ld(unsigned* p)              { return __hip_atomic_load(p, __ATOMIC_RELAXED, __HIP_MEMORY_SCOPE_AGENT); }
__device__ __forceinline__ unsigned xb_add(unsigned* p, unsigned v) { return __hip_atomic_fetch_add(p, v, __ATOMIC_RELAXED, __HIP_MEMORY_SCOPE_AGENT); }
__device__ __forceinline__ unsigned xb_xcc_id() { return (unsigned)__builtin_amdgcn_s_getreg((3 << 11) | 20) & 0xFu; }
#define XB_SPIN(cond, bar) do { unsigned _sp = 0; while (cond) { __builtin_amdgcn_s_sleep(1); \
    if ((++_sp & 255u) == 0u) { if (xb_ld(&(bar)[XB_TMO])) break; if (_sp > XB_SPIN_CAP) { atomicAdd(&(bar)[XB_TMO], 1u); break; } } } } while (0)

struct XcdBarrier {
    unsigned* bar; unsigned x;
    volatile LAS unsigned* st;
};

__device__ __forceinline__ XcdBarrier xcd_barrier_post(unsigned* bar, volatile LAS unsigned* st) {
    XcdBarrier b; b.bar = bar; b.x = xb_xcc_id(); b.st = st;
    if (threadIdx.x == 0) (void)xb_add(&bar[XB_XCNT(b.x)], 1u);
    return b;
}
__device__ __forceinline__ void xcd_barrier_complete(unsigned* bar, unsigned x, unsigned& nloc, unsigned& nx) {
    const unsigned G = gridDim.x * gridDim.y * gridDim.z;
    unsigned sum, cnt, mine, sp = 0u;
    for (;;) {
        sum = 0u; cnt = 0u; mine = 0u;
#pragma unroll
        for (unsigned j = 0; j < 16; ++j) { const unsigned c = xb_ld(&bar[XB_XCNT(j)]); sum += c; cnt += (c > 0u) ? 1u : 0u; mine = (j == x) ? c : mine; }
        if (sum == G) break;
        __builtin_amdgcn_s_sleep(1);
        if ((++sp & 255u) == 0u) { if (xb_ld(&bar[XB_TMO])) break; if (sp > XB_SPIN_CAP) { atomicAdd(&bar[XB_TMO], 1u); break; } }
    }
    nloc = mine > 0u ? mine : 1u; nx = cnt > 0u ? cnt : 1u;
}

__device__ __forceinline__ void xcd_barrier(const XcdBarrier& b) {
    asm volatile("s_waitcnt vmcnt(0)" ::: "memory");
    __syncthreads();
    if (threadIdx.x == 0) {
        unsigned* bar = b.bar;
        __builtin_amdgcn_s_waitcnt(0);
        unsigned nloc = b.st[0], nx = b.st[1];
        if (nloc == 0u) { xcd_barrier_complete(bar, b.x, nloc, nx); b.st[0] = nloc; b.st[1] = nx; }
        const unsigned old = xb_add(&bar[XB_XSUB(b.x)], 1u);
        const unsigned gen = old / nloc;
        if (old + 1u == (gen + 1u) * nloc) {
            __builtin_amdgcn_fence(__ATOMIC_RELEASE, "agent");
            asm volatile("s_waitcnt vmcnt(0)" ::: "memory");
            const unsigned og = xb_add(&bar[XB_TOP], 1u);
            const unsigned tg = og / nx;
            if (og + 1u == (tg + 1u) * nx) xb_add(&bar[XB_TOPGEN], 1u);
            else XB_SPIN(xb_ld(&bar[XB_TOPGEN]) == tg, bar);
            __builtin_amdgcn_fence(__ATOMIC_ACQUIRE, "agent");
            xb_add(&bar[XB_XGEN(b.x)], 1u);
            asm volatile("s_waitcnt vmcnt(0)" ::: "memory");
        } else {
            XB_SPIN(xb_ld(&bar[XB_XGEN(b.x)]) == gen, bar);
            __builtin_amdgcn_fence(__ATOMIC_ACQUIRE, "agent");
            asm volatile("s_waitcnt vmcnt(0)" ::: "memory");
        }
    }
    __syncthreads();
}
DEV float row_rstd(const float* ssq, int row, int fq) {
    const f32x4 p = *(const f32x4*)(ssq + (size_t)row * 16 + fq * 4);
    float s = (p.x + p.y) + (p.z + p.w);
    s += __shfl_xor(s, 16); s += __shfl_xor(s, 32);
    return 1.0f / sqrtf(s * (1.0f / 1024.0f) + RMS_EPS);
}
DEV float row_rstd_full(const float* ssq, int row) {
    const f32x4* p = (const f32x4*)(ssq + (size_t)row * 16);
    const f32x4 a = p[0], b = p[1], c = p[2], d = p[3];
    const float s = ((a.x + a.y) + (a.z + a.w)) + ((b.x + b.y) + (b.z + b.w)) + ((c.x + c.y) + (c.z + c.w)) + ((d.x + d.y) + (d.z + d.w));
    return 1.0f / sqrtf(s * (1.0f / 1024.0f) + RMS_EPS);
}

DEV void rope4(const float* rope, int t, int i, const f32x4& v0, const f32x4& v1, float (&lo)[4], float (&hi)[4]) {
    const f32x4 c0 = *(const f32x4*)(rope + ((size_t)t * 32 + i) * 2), c1 = *(const f32x4*)(rope + ((size_t)t * 32 + i + 2) * 2);
    lo[0] = v0[0] * c0[0] - v0[1] * c0[1]; hi[0] = v0[1] * c0[0] + v0[0] * c0[1];
    lo[1] = v0[2] * c0[2] - v0[3] * c0[3]; hi[1] = v0[3] * c0[2] + v0[2] * c0[3];
    lo[2] = v1[0] * c1[0] - v1[1] * c1[1]; hi[2] = v1[1] * c1[0] + v1[0] * c1[1];
    lo[3] = v1[2] * c1[2] - v1[3] * c1[3]; hi[3] = v1[3] * c1[2] + v1[2] * c1[3];
}
struct EpiIn {
    static constexpr bool PERM = true, AFTER_DRAIN = false;
    unsigned char* ws;
    template <class Tp> DEV Tp* P(size_t off) const { return (Tp*)(GAS Tp*)(ws + off); }
    DEV void operator()(const f32x4 (&acc)[2][2][4][2], const pg8::Unit& u, int wr, int wc, int fr, int fq) const {
        asm volatile("" : "+v"(fr), "+v"(fq), "+s"(wr), "+s"(wc));
        const int pn = u.pn;
        const float* ssq = P<float>(WS_SSQ); const float* rope = P<float>(WS_ROPE);
#pragma unroll
        for (int ai = 0; ai < 2; ++ai)
#pragma unroll
            for (int m = 0; m < 4; ++m) {
                const int row = u.pm * 256 + ai * 128 + wr * 64 + m * 16 + fr;
                const float rstd = row_rstd(ssq, row, fq);
                const int t = row & (T - 1), b = row >> 13;
#pragma unroll
                for (int bj = 0; bj < 2; ++bj) {
                    const int col = bj * 128 + wc * 32 + fq * 8;
                    const f32x4 v0 = acc[ai][bj][m][0] * rstd, v1 = acc[ai][bj][m][1] * rstd;
                    if (pn < 2) {
                        const int g = pn * 256 + col, head = g >> 6, i = (g & 63) >> 1;
                        const size_t o = (size_t)row * 512 + head * 64 + i;
                        bf16* Q = P<bf16>(WS_Q);
                        v2u w;
                        w.x = pk2(v0[0] * QSCALE, v0[2] * QSCALE); w.y = pk2(v1[0] * QSCALE, v1[2] * QSCALE); *(v2u*)(Q + o) = w;
                        w.x = pk2(v0[1] * QSCALE, v0[3] * QSCALE); w.y = pk2(v1[1] * QSCALE, v1[3] * QSCALE); *(v2u*)(Q + o + 32) = w;
                    } else if (pn == 2) {
                        bf16* dst = P<bf16>((col < 128) ? WS_KCR : WS_VCR);
                        v4u w; w.x = pk2(v0[0], v0[1]); w.y = pk2(v0[2], v0[3]); w.z = pk2(v1[0], v1[1]); w.w = pk2(v1[2], v1[3]);
                        *(v4u*)(dst + (size_t)row * 128 + (col & 127)) = w;
                    } else if (pn == 3 || pn == 4) {
                        if (col < 128) {
                            bf16* dst = P<bf16>((pn == 3) ? WS_KS : WS_KW);
                            const int hkv = col >> 6, i = (col & 63) >> 1;
                            float lo[4], hi[4]; rope4(rope, t, i, v0, v1, lo, hi);
                            const size_t o = (size_t)(b * 2 + hkv) * T * 64 + kfrag_off(t, i);
                            v2u w;
                            w.x = pk2(lo[0], lo[1]); w.y = pk2(lo[2], lo[3]); *(v2u*)(dst + o) = w;
                            w.x = pk2(hi[0], hi[1]); w.y = pk2(hi[2], hi[3]); *(v2u*)(dst + o + 512) = w;
                        } else {
                            bf16* dst = P<bf16>((pn == 3) ? WS_VST : WS_VWT);
                            const int c2 = col - 128, hkv = c2 >> 6, d = c2 & 63;
                            const size_t o = (((size_t)(b * 2 + hkv) * 256 + (t >> 5)) * 64 + d) * 32 + slot32(t & 31);
#pragma unroll
                            for (int j = 0; j < 4; ++j) { dst[o + j * 32] = (bf16)f2bf(v0[j]); dst[o + (j + 4) * 32] = (bf16)f2bf(v1[j]); }
                        }
                    } else if (pn == 9) {
                        float* dst = P<float>(WS_HF) + (size_t)row * 256 + col;
                        *(f32x4*)dst = v0; *(f32x4*)(dst + 4) = v1;
                    } else {
                        bf16* dst = (pn < 8) ? P<bf16>(WS_CB + (size_t)(pn - 5) * (WS_CC - WS_CB)) : P<bf16>(WS_HQ + (size_t)(pn - 8) * (WS_HF - WS_HQ));
                        v4u w; w.x = pk2(v0[0], v0[1]); w.y = pk2(v0[2], v0[3]); w.z = pk2(v1[0], v1[1]); w.w = pk2(v1[2], v1[3]);
                        *(v4u*)(dst + (size_t)row * 256 + col) = w;
                    }
                }
            }
    }
};

struct EpiRes {
    static constexpr bool PERM = true, AFTER_DRAIN = false;
    const float* base32; bf16* hb; float* ssq;
    DEV void operator()(const f32x4 (&acc)[2][2][4][2], const pg8::Unit& u, int wr, int wc, int fr, int fq) const {
        asm volatile("" : "+v"(fr), "+v"(fq), "+s"(wr), "+s"(wc));
#pragma unroll
        for (int ai = 0; ai < 2; ++ai)
#pragma unroll
            for (int m = 0; m < 4; ++m) {
                const int row = u.pm * 256 + ai * 128 + wr * 64 + m * 16 + fr;
                float ss = 0.f;
#pragma unroll
                for (int bj = 0; bj < 2; ++bj) {
                    const size_t o = (size_t)row * 1024 + u.pn * 256 + bj * 128 + wc * 32 + fq * 8;
                    f32x4 v0, v1;
                    if (base32) { v0 = *(const f32x4*)(base32 + o); v1 = *(const f32x4*)(base32 + o + 4); }
                    else { const v4u hw = *(const v4u*)(hb + o); v0 = (f32x4){bflo(hw.x), bfhi(hw.x), bflo(hw.y), bfhi(hw.y)}; v1 = (f32x4){bflo(hw.z), bfhi(hw.z), bflo(hw.w), bfhi(hw.w)}; }
                    v0 = v0 + acc[ai][bj][m][0]; v1 = v1 + acc[ai][bj][m][1];
                    v4u w; w.x = pk2(v0[0], v0[1]); w.y = pk2(v0[2], v0[3]); w.z = pk2(v1[0], v1[1]); w.w = pk2(v1[2], v1[3]);
                    *(v4u*)(hb + o) = w;
                    ss += ((v0[0] * v0[0] + v0[1] * v0[1]) + (v0[2] * v0[2] + v0[3] * v0[3])) + ((v1[0] * v1[0] + v1[1] * v1[1]) + (v1[2] * v1[2] + v1[3] * v1[3]));
                }
                ss += __shfl_xor(ss, 16); ss += __shfl_xor(ss, 32);
                if (fq == 0) ssq[(size_t)row * 16 + u.pn * 4 + wc] = ss;
            }
    }
};

struct EpiXQ {
    static constexpr bool PERM = true, AFTER_DRAIN = false;
    const float* ssq; bf16* XQ;
    DEV void operator()(const f32x4 (&acc)[2][2][4][2], const pg8::Unit& u, int wr, int wc, int fr, int fq) const {
        asm volatile("" : "+v"(fr), "+v"(fq), "+s"(wr), "+s"(wc));
#pragma unroll
        for (int ai = 0; ai < 2; ++ai)
#pragma unroll
            for (int m = 0; m < 4; ++m) {
                const int row = u.pm * 256 + ai * 128 + wr * 64 + m * 16 + fr;
                const float sc = row_rstd(ssq, row, fq) * QSCALE;
#pragma unroll
                for (int bj = 0; bj < 2; ++bj) {
                    const f32x4 v0 = acc[ai][bj][m][0] * sc, v1 = acc[ai][bj][m][1] * sc;
                    v4u w; w.x = pk2(v0[0], v0[1]); w.y = pk2(v0[2], v0[3]); w.z = pk2(v1[0], v1[1]); w.w = pk2(v1[2], v1[3]);
                    *(v4u*)(XQ + (size_t)row * 256 + bj * 128 + wc * 32 + fq * 8) = w;
                }
            }
    }
};

struct EpiGU {
    static constexpr bool PERM = true, AFTER_DRAIN = false;
    const float* srstd; bf16* ACT;
    DEV void operator()(const f32x4 (&acc)[2][2][4][2], const pg8::Unit& u, int wr, int wc, int fr, int fq) const {
        asm volatile("" : "+v"(fr), "+v"(fq), "+s"(wr), "+s"(wc));
        const int nt = u.pn & 3;
#pragma unroll
        for (int ai = 0; ai < 2; ++ai)
#pragma unroll
            for (int m = 0; m < 4; ++m) {
                const int row = u.pm * 256 + ai * 128 + wr * 64 + m * 16 + fr;
                const float rs = srstd[row];
#pragma unroll
                for (int bj = 0; bj < 2; ++bj) {
                    const f32x4 v0 = acc[ai][bj][m][0] * rs, v1 = acc[ai][bj][m][1] * rs;
                    const int j = (nt * 256 + bj * 128 + wc * 32 + fq * 8) >> 1;
                    v2u w; w.x = pk2(siluf_(v0[0]) * v0[1], siluf_(v0[2]) * v0[3]); w.y = pk2(siluf_(v1[0]) * v1[1], siluf_(v1[2]) * v1[3]);
                    *(v2u*)(ACT + (size_t)row * 512 + j) = w;
                }
            }
    }
};

struct EpiDN {
    static constexpr bool PERM = true, AFTER_DRAIN = false;
    const float* sgate; bf16* YS;
    DEV void operator()(const f32x4 (&acc)[2][2][4][2], const pg8::Unit& u, int wr, int wc, int fr, int fq) const {
        asm volatile("" : "+v"(fr), "+v"(fq), "+s"(wr), "+s"(wc));
        const int nt = u.pn & 3;
#pragma unroll
        for (int ai = 0; ai < 2; ++ai)
#pragma unroll
            for (int m = 0; m < 4; ++m) {
                const int row = u.pm * 256 + ai * 128 + wr * 64 + m * 16 + fr;
                const float gt = sgate[row];
#pragma unroll
                for (int bj = 0; bj < 2; ++bj) {
                    const f32x4 v0 = acc[ai][bj][m][0] * gt, v1 = acc[ai][bj][m][1] * gt;
                    v4u w; w.x = pk2(v0[0], v0[1]); w.y = pk2(v0[2], v0[3]); w.z = pk2(v1[0], v1[1]); w.w = pk2(v1[2], v1[3]);
                    *(v4u*)(YS + (size_t)row * 1024 + nt * 256 + bj * 128 + wc * 32 + fq * 8) = w;
                }
            }
    }
};

struct MoeOrder {
    int nunits, G, c; const LAS int* tileE;
    DEV bool next(int i, pg8::Unit& u) const {
        const int L = i * G + c; if (L >= nunits) return false;
        const int rt = L >> 2; u.pm = rt; u.pn = tileE[rt] * 4 + (L & 3); return true;
    }
    DEV void a_ready(const pg8::Unit&) const {}
    DEV void done(const pg8::Unit&) const {}
};
struct Frame {
    LAS unsigned char* lds;
    unsigned char* ldsg;
    volatile LAS unsigned* MISC;
    gu32* ctl;
    unsigned char* ws;
    int tid, lane, wave, vcu, G;
    float* out;
};
template <class Tp> DEV Tp* wsp(const Frame& F, size_t off) { return (Tp*)(F.ws + off); }
DEV const float* inp(int i) { const float* const* ka = (const float* const*)__builtin_amdgcn_kernarg_segment_ptr(); asm volatile("" : "+s"(i)); return (const float*)(const GAS float*)ka[i]; }

template <class Map>
DEV void tr_item(const float* W, int K, int Nsrc, const float* gain, bf16* WT, float* scr, int item, int lane, Map map) {
    const int nblk = (Nsrc + 31) >> 5, kb = item / nblk, nb = item - kb * nblk, k0 = 64 * kb, n0 = 32 * nb;
    {
        const int nq = (lane & 7) * 4; f32x4 v[8];
#pragma unroll
        for (int i = 0; i < 8; ++i) { const int kk = 8 * i + (lane >> 3);
            v[i] = (n0 + nq < Nsrc) ? *(const f32x4*)(W + (size_t)(k0 + kk) * Nsrc + n0 + nq) : (f32x4){0.f, 0.f, 0.f, 0.f}; }
#pragma unroll
        for (int i = 0; i < 8; ++i) { const int kk = 8 * i + (lane >> 3); const float g = gain ? gain[k0 + kk] : 1.0f; float* s = scr + kk * 33 + nq;
            s[0] = v[i][0] * g; s[1] = v[i][1] * g; s[2] = v[i][2] * g; s[3] = v[i][3] * g; }
    }
    LDS_WAIT();
    const int c = lane & 7;
#pragma unroll
    for (int j = 0; j < 4; ++j) {
        const int n = (lane >> 3) + 8 * j; const float* s = scr + (8 * c) * 33 + n;
        if (n0 + n < Nsrc) {
            v4u o; o.x = pk2(s[0 * 33], s[1 * 33]); o.y = pk2(s[2 * 33], s[3 * 33]); o.z = pk2(s[4 * 33], s[5 * 33]); o.w = pk2(s[6 * 33], s[7 * 33]);
            *(v4u*)(WT + (size_t)map(n0 + n) * K + k0 + 8 * c) = o;
        }
    }
    LDS_WAIT();
}
template <class Map>
DEV void tr_experts(const float* W, int K, int Nsrc, const float* gain, bf16* WT, bf16* scr, int gw, int NGW, int lane, Map map) {
    const int nblk = Nsrc >> 6, per_e = (K >> 6) * nblk, NIT = 32 * per_e; const size_t esz = (size_t)K * Nsrc;
#pragma unroll 1
    for (int it = gw; it < NIT; it += NGW) {
        const int e = it / per_e, sub = it - e * per_e, kb = sub / nblk, nb = sub - kb * nblk, k0 = 64 * kb, n0 = 64 * nb, nq = (lane & 15) * 4;
        const float* Wp = W + (size_t)e * esz; bf16* Wo = WT + (size_t)e * esz;
        f32x4 v[16];
#pragma unroll
        for (int i = 0; i < 16; ++i) v[i] = *(const f32x4*)(Wp + (size_t)(k0 + 4 * i + (lane >> 4)) * Nsrc + n0 + nq);
#pragma unroll
        for (int i = 0; i < 16; ++i) { const int kk = 4 * i + (lane >> 4); const float g = gain ? gain[k0 + kk] : 1.0f;
            v2u w; w.x = pk2(v[i][0] * g, v[i][1] * g); w.y = pk2(v[i][2] * g, v[i][3] * g);
            *(v2u*)(scr + kk * 68 + nq) = w; }
        LDS_WAIT();
        const int cc = lane & 7;
#pragma unroll
        for (int j = 0; j < 8; ++j) { const int n = (lane >> 3) + 8 * j; const bf16* s = scr + (8 * cc) * 68 + n;
            v4u o; o.x = (unsigned)s[0] | ((unsigned)s[68] << 16); o.y = (unsigned)s[2 * 68] | ((unsigned)s[3 * 68] << 16);
            o.z = (unsigned)s[4 * 68] | ((unsigned)s[5 * 68] << 16); o.w = (unsigned)s[6 * 68] | ((unsigned)s[7 * 68] << 16);
            *(v4u*)(Wo + (size_t)map(n0 + n) * K + k0 + 8 * cc) = o; }
        LDS_WAIT();
    }
}
struct MapId { DEV int operator()(int n) const { return n; } };
struct MapIn {
    DEV int operator()(int n) const {
        if (n < 512) { const int d = n & 63; return (n & ~63) + 2 * (d & 31) + (d >> 5); }
        if (n < 768) return n;
        if (n < 1280) { const int r = n - 768; if ((r & 255) < 128) { const int d = r & 63; return 768 + (r & ~63) + 2 * (d & 31) + (d >> 5); } return n; }
        if (n < 1304) return 3072 + (n - 1280);
        return n - 24;
    }
};
struct MapGU { DEV int operator()(int n) const { return n < 512 ? 2 * n : 2 * (n - 512) + 1; } };

DEV void convert_experts(Frame& F, int l, bf16* scr, int part) {
    unsigned zl_ = 0u; asm volatile("" : "+v"(zl_)); const int lane = (int)__builtin_amdgcn_mbcnt_hi(~0u, __builtin_amdgcn_mbcnt_lo(~0u, zl_));
    const int gw = F.vcu * NWAVES + F.wave, NGW = F.G * NWAVES;
    if (part == 0) tr_experts(inp(17) + (size_t)l * 32 * 1024 * 1024, 1024, 1024, inp(22) + l * 1024, wsp<bf16>(F, WS_WGU) + (size_t)l * 32 * 1024 * 1024, scr, gw, NGW, lane, MapGU());
    else tr_experts(inp(18) + (size_t)l * 32 * 512 * 1024, 512, 1024, nullptr, wsp<bf16>(F, WS_WDN) + (size_t)l * 32 * 1024 * 512, scr, gw, NGW, lane, MapId());
}
DEV void p0_prologue(Frame& F) {
    float* scr = (float*)(F.ldsg + F.wave * 16384);
    const int gw = F.vcu * NWAVES + F.wave, NGW = F.G * NWAVES, lane = F.lane;
    for (int l = 0; l < DEPTH; ++l) {
        { const int NIT = 16 * 97; bf16* dst = wsp<bf16>(F, WS_WIN) + (size_t)l * NIN * 1024;
          for (int it = gw; it < NIT; it += NGW) tr_item(inp(2) + (size_t)l * 1024 * IN_W, 1024, IN_W, inp(19) + l * 1024, dst, scr, it, lane, MapIn());
          for (int i = gw * 64 + lane; i < (NIN - 3096) * 1024 / 8; i += NGW * 64) ((v4u*)(dst + (size_t)3096 * 1024))[i] = (v4u){0u, 0u, 0u, 0u}; }
        { const int NIT = 16 * 32; for (int it = gw; it < NIT; it += NGW) tr_item(inp(9) + (size_t)l * 1024 * 1024, 1024, 1024, nullptr, wsp<bf16>(F, WS_WOUT) + (size_t)l * 1024 * 1024, scr, it, lane, MapId()); }
        { const int NIT = 16 * 8; for (int it = gw; it < NIT; it += NGW) tr_item(inp(10) + (size_t)l * 1024 * 256, 1024, 256, inp(20) + l * 1024, wsp<bf16>(F, WS_WQ) + (size_t)l * 256 * 1024, scr, it, lane, MapId()); }
        { const int NIT = 16 * 16; for (int it = gw; it < NIT; it += NGW) tr_item(inp(11) + (size_t)l * 1024 * 512, 1024, 512, inp(21) + l * 1024, wsp<bf16>(F, WS_WKV) + (size_t)l * 512 * 1024, scr, it, lane, MapId()); }
        { const int NIT = 4 * 32; for (int it = gw; it < NIT; it += NGW) tr_item(inp(12) + (size_t)l * 256 * 1024, 256, 1024, nullptr, wsp<bf16>(F, WS_WO) + (size_t)l * 1024 * 256, scr, it, lane, MapId()); }
        for (int kv = 0; kv < 2; ++kv) {
            { const int NIT = 32 * 4; for (int it = gw; it < NIT; it += NGW) tr_item(inp(5) + (size_t)(l * 2 + kv) * 2048 * 128, 2048, 128, nullptr, wsp<bf16>(F, WS_W1C) + (size_t)(l * 2 + kv) * 128 * 2048, scr, it, lane, MapId()); }
            { const int NIT = 2 * 2; for (int it = gw; it < NIT; it += NGW) tr_item(inp(6) + (size_t)(l * 2 + kv) * 128 * 64, 128, 64, nullptr, wsp<bf16>(F, WS_W2C) + (size_t)(l * 2 + kv) * 64 * 128, scr, it, lane, MapId()); }
        }
        if (F.G != 256) { convert_experts(F, l, (bf16*)scr, 0); convert_experts(F, l, (bf16*)scr, 1); }
        { bf16* dst = wsp<bf16>(F, WS_WR) + (size_t)l * 96 * 1024; const float* gn = inp(22) + l * 1024;
          for (int i = gw * 64 + lane; i < 48 * 1024; i += NGW * 64) { const int n = i >> 10, k = i & 1023;
            float v = 0.f; if (n < 4) v = inp(13)[(size_t)(l * 1024 + k) * 4 + n]; else if (n < 36) v = inp(15)[(size_t)(l * 1024 + k) * 32 + (n - 4)];
            v *= gn[k]; const unsigned h = f2bf(v); dst[i] = (bf16)h; dst[i + 48 * 1024] = (bf16)f2bf(v - bf2f((unsigned short)h)); } }
    }
    { bf16* wg = wsp<bf16>(F, WS_WG);
      for (int i = gw * 64 + lane; i < DEPTH * 32 * 1024; i += NGW * 64) { const int l2 = i >> 15, row = (i >> 10) & 31, k = i & 1023, hk = row >> 4, gi = row & 15;
        const float v = gi < 12 ? inp(2)[((size_t)l2 * 1024 + k) * IN_W + 1280 + hk * 12 + gi] * inp(19)[l2 * 1024 + k] : 0.f;
        wg[i] = (bf16)f2bf(v); } }
    { float* rope = wsp<float>(F, WS_ROPE);
      for (int i = gw * 64 + lane; i < T * 32; i += NGW * 64) { const int t = i >> 5, k = i & 31;
        const float inv = powf(10000.0f, -(float)k / 32.0f); const float ang = (float)t * inv;
        rope[2 * i] = cosf(ang); rope[2 * i + 1] = sinf(ang); } }
    { float* b1 = wsp<float>(F, WS_SMALL);
      for (int i = gw * 64 + lane; i < 4 * 128; i += NGW * 64) { const int lk = i >> 7, n = i & 127;
        const float* pe = inp(4) + (size_t)lk * 2048; const float* w1 = inp(5) + (size_t)lk * 2048 * 128 + n; float s = 0.f;
        for (int kk = 0; kk < 2048; ++kk) s += pe[kk] * w1[(size_t)kk * 128];
        b1[i] = s; } }
    { bf16* HB = wsp<bf16>(F, WS_HB); float* SSQ = wsp<float>(F, WS_SSQ); bf16* MB = wsp<bf16>(F, WS_MEMB); float* SSQM = wsp<float>(F, WS_SMALL) + 1024;
      for (int m = gw; m < NTOK + NB * 256; m += NGW) {
        const bool ism = m >= NTOK; const int r = ism ? m - NTOK : m;
        const f32x4* xr = (const f32x4*)((ism ? inp(1) : inp(0)) + (size_t)r * 1024) + lane;
        unsigned long long* o8 = (unsigned long long*)((ism ? MB : HB) + (size_t)r * 1024) + lane;
        float s = 0.f;
#pragma unroll
        for (int j = 0; j < 4; ++j) { const f32x4 v = xr[64 * j]; s += (v.x * v.x + v.y * v.y) + (v.z * v.z + v.w * v.w);
            o8[64 * j] = (unsigned long long)pk2(v.x, v.y) | ((unsigned long long)pk2(v.z, v.w) << 32); }
        s = wave_sum(s);
        if (ism) { if (lane == 0) SSQM[r] = s; }
        else if (lane < 16) SSQ[(size_t)r * 16 + lane] = lane == 0 ? s : 0.f;
      } }
}

template <int NT>
DEV void skinny16(const bf16* A, size_t lda, const bf16* Bt, size_t ldb, int K, int lane, f32x4 (&acc)[NT]) {
    const int l16 = lane & 15, g4 = lane >> 4;
    const bf16* ap = A + (size_t)l16 * lda + g4 * 8; const bf16* bp = Bt + (size_t)l16 * ldb + g4 * 8;
#pragma unroll
    for (int n = 0; n < NT; ++n) acc[n] = (f32x4){0.f, 0.f, 0.f, 0.f};
#pragma unroll 2
    for (int k = 0; k < K; k += 32) {
        const bf16x8 a = *(const bf16x8*)(ap + k);
#pragma unroll
        for (int n = 0; n < NT; ++n) { const bf16x8 b = *(const bf16x8*)(bp + (size_t)n * 16 * ldb + k); acc[n] = mfma16(a, b, acc[n]); }
    }
}

DEV void memkv_phase(Frame& F) {
    const int gw = F.vcu * NWAVES + F.wave, NGW = F.G * NWAVES, lane = F.lane, l16 = lane & 15, g4 = lane >> 4;
    const bf16* MB = wsp<bf16>(F, WS_MEMB); const float* SSQM = wsp<float>(F, WS_SMALL) + 1024;
    bf16* MK = wsp<bf16>(F, WS_MK); bf16* MVT = wsp<bf16>(F, WS_MVT);
    for (int task = gw; task < 1024; task += NGW) {
        const int l2 = task >> 9, rt = (task >> 3) & 63, chunk = task & 7;
        f32x4 acc[4];
        skinny16<4>(MB + (size_t)rt * 16 * 1024, 1024, wsp<bf16>(F, WS_WKV) + ((size_t)l2 * 512 + chunk * 64) * 1024, 1024, 1024, lane, acc);
        const int b = rt >> 4, key0 = (rt & 15) * 16 + g4 * 4;
        float rs[4];
#pragma unroll
        for (int r = 0; r < 4; ++r) rs[r] = 1.0f / sqrtf(SSQM[rt * 16 + g4 * 4 + r] * (1.0f / 1024.0f) + RMS_EPS);
#pragma unroll
        for (int nt = 0; nt < 4; ++nt) {
            const int n = chunk * 64 + nt * 16 + l16;
            if (chunk < 4) { const int head = n >> 6, d = n & 63;
#pragma unroll
                for (int r = 0; r < 4; ++r) MK[(size_t)((l2 * 4 + b) * 4 + head) * 256 * 64 + kfrag_off(key0 + r, d)] = (bf16)f2bf(acc[nt][r] * rs[r]);
            } else { const int n2 = n - 256, head = n2 >> 6, d = n2 & 63;
                v2u w; w.x = pk2(acc[nt][0] * rs[0], acc[nt][1] * rs[1]); w.y = pk2(acc[nt][2] * rs[2], acc[nt][3] * rs[3]);
                *(v2u*)(MVT + (((size_t)((l2 * 4 + b) * 4 + head) * 8 + (key0 >> 5)) * 64 + d) * 32 + slot32(key0 & 31)) = w; }
        }
    }
}

DEV void compress_phase(Frame& F, int l) {
    const int lane = F.lane, l16 = lane & 15, g4 = lane >> 4, quad = F.wave >> 2, q = F.wave & 3;
    float* part = (float*)F.ldsg + quad * (4 * 16 * 128);
    const bf16* KCR = wsp<bf16>(F, WS_KCR); const bf16* VCR = wsp<bf16>(F, WS_VCR);
    bf16* KCC = wsp<bf16>(F, WS_KCC); bf16* VCT = wsp<bf16>(F, WS_VCT);
    const float* bias1 = wsp<float>(F, WS_SMALL);
    for (int tk0 = F.vcu * 2; tk0 < 512; tk0 += F.G * 2) {
        const int tk = tk0 + quad; const int kv = tk >> 8, tile = tk & 255;
        const bf16* raw = kv ? VCR : KCR;
        const bf16* w1 = wsp<bf16>(F, WS_W1C) + (size_t)(l * 2 + kv) * 128 * 2048;
        const bf16* w2 = wsp<bf16>(F, WS_W2C) + (size_t)(l * 2 + kv) * 64 * 128;
        { const int r = tile * 16 + l16, bh = r >> 9, c = r & 511, b = bh >> 1, hkv = bh & 1;
          f32x4 acc[8];
#pragma unroll
          for (int n = 0; n < 8; ++n) acc[n] = (f32x4){0.f, 0.f, 0.f, 0.f};
#pragma unroll 2
          for (int ks = q * 16; ks < q * 16 + 16; ++ks) {
              const int kk = ks * 32 + g4 * 8, ll = kk >> 6, d = kk & 63;
              int tok = 16 * c + ll; tok = tok > T - 1 ? T - 1 : tok;
              const bf16x8 a = *(const bf16x8*)(raw + ((size_t)b * T + tok) * 128 + hkv * 64 + d);
#pragma unroll
              for (int n = 0; n < 8; ++n) { const bf16x8 bb = *(const bf16x8*)(w1 + (size_t)(n * 16 + l16) * 2048 + kk); acc[n] = mfma16(a, bb, acc[n]); }
          }
#pragma unroll
          for (int n = 0; n < 8; ++n)
#pragma unroll
              for (int r2 = 0; r2 < 4; ++r2) part[(q * 16 + g4 * 4 + r2) * 128 + n * 16 + l16] = acc[n][r2];
        }
        __syncthreads();
        { f32x4 o = (f32x4){0.f, 0.f, 0.f, 0.f};
#pragma unroll
          for (int k2 = 0; k2 < 4; ++k2) {
              const int h0 = k2 * 32 + g4 * 8;
              float hv[8];
#pragma unroll
              for (int j = 0; j < 8; ++j) { float s = bias1[(l * 2 + kv) * 128 + h0 + j];
#pragma unroll
                  for (int p = 0; p < 4; ++p) s += part[(p * 16 + l16) * 128 + h0 + j];
                  hv[j] = siluf_(s); }
              bf16x8 a; { v4u w; w.x = pk2(hv[0], hv[1]); w.y = pk2(hv[2], hv[3]); w.z = pk2(hv[4], hv[5]); w.w = pk2(hv[6], hv[7]); a = __builtin_bit_cast(bf16x8, w); }
              const bf16x8 bb = *(const bf16x8*)(w2 + (size_t)(q * 16 + l16) * 128 + h0);
              o = mfma16(a, bb, o);
          }
          const int r0 = tile * 16 + g4 * 4, bh = r0 >> 9, c0 = r0 & 511, d = q * 16 + l16;
          if (kv == 0) {
#pragma unroll
              for (int r2 = 0; r2 < 4; ++r2) KCC[(size_t)bh * 512 * 64 + kfrag_off(c0 + r2, d)] = (c0 + r2 == 511) ? (bf16)0 : (bf16)f2bf(o[r2]);
          } else {
              v2u w; w.x = pk2(o[0], o[1]); w.y = pk2(o[2], (c0 + 3 == 511) ? 0.f : o[3]);
              *(v2u*)(VCT + (((size_t)bh * 16 + (c0 >> 5)) * 64 + d) * 32 + slot32(c0 & 31)) = w;
          }
        }
        __syncthreads();
    }
}

DEV float hgrn_lb(const Frame& F, int l, int c) {
    if (l == 0) return 0.f;
    const float a = inp(7)[c], b = inp(7)[256 + c];
    return 1.0f / (1.0f + expf(a - b));
}
DEV float hgrn_logf(float z, float lb) {
    const float la = logf(fmaxf(lb, 1e-30f));
    const float ls = fminf(z, 0.f) - log1pf(expf(-fabsf(z)));
    const float lc = log1pf(-lb) + ls;
    const float mx = fmaxf(la, lc), mn = fminf(la, lc);
    return mx + log1pf(expf(mn - mx));
}
constexpr int HS = 68;
DEV f32x4 mfma4(float a, float b, f32x4 c) { return __builtin_amdgcn_mfma_f32_16x16x4f32(a, b, c, 0, 0, 0); }
DEV void hgrn_setup_chunk(Frame& F, float lb, const float (&z)[8], float* Bc, float* Kc, float* tot) {
    const int d = F.tid & 63, sg = F.tid >> 6;
    const float la = logf(fmaxf(lb, 1e-30f)), l1m = log1pf(-lb), onem = 1.0f - lb;
    float loc[8], kv[8]; float run = 0.f;
#pragma unroll
    for (int i = 0; i < 8; ++i) {
        const float ez = __expf(-fabsf(z[i]));
        const float lc = l1m + (fminf(z[i], 0.f) - __logf(1.0f + ez));
        const float mx = fmaxf(la, lc), mn = fminf(la, lc);
        run += mx + __logf(1.0f + __expf(mn - mx)); loc[i] = run;
        kv[i] = onem * (z[i] >= 0.f ? ez : 1.0f) / (1.0f + ez);
    }
    tot[sg * 64 + d] = run;
    __syncthreads();
    float off = 0.f;
    for (int g = 0; g < sg; ++g) off += tot[g * 64 + d];
#pragma unroll
    for (int i = 0; i < 8; ++i) { Bc[(sg * 8 + i) * HS + d] = off + loc[i]; Kc[(sg * 8 + i) * HS + d] = kv[i]; }
    __syncthreads();
}
DEV void hgrn_local_phase(Frame& F, int l) {
    float* Bc = (float*)F.ldsg; float* Kc = Bc + 64 * HS; float* Vc = Kc + 64 * HS; float* tot = Vc + 64 * HS;
    bf16* U = wsp<bf16>(F, WS_U); float* DEC = wsp<float>(F, WS_DEC);
    const int lane = F.lane, w = F.wave, li = lane & 15, kq = lane >> 4;
    for (int task = F.vcu; task < 2048; task += F.G) {
        const int bh = task >> 7, ch = task & 127, b = bh >> 2, h = bh & 3;
        { const int d = F.tid & 63, sg = F.tid >> 6;
          const size_t go = ((size_t)b * T + ch * 64 + sg * 8) * 256 + h * 64 + d;
          const float* HFp = wsp<float>(F, WS_HF) + go; const bf16* HIp = wsp<bf16>(F, WS_HI) + go;
          float z[8], vi[8];
#pragma unroll
          for (int i = 0; i < 8; ++i) { z[i] = HFp[(size_t)i * 256]; vi[i] = bf2f(HIp[(size_t)i * 256]); }
          hgrn_setup_chunk(F, hgrn_lb(F, l, h * 64 + d), z, Bc, Kc, tot);
          const float bl = Bc[63 * HS + d];
#pragma unroll
          for (int i = 0; i < 8; ++i) { const int s = sg * 8 + i; Kc[s * HS + d] *= __expf(bl - Bc[s * HS + d]); Vc[s * HS + d] = vi[i]; }
          if (sg == 0) DEC[(size_t)task * 64 + d] = expf(bl); }
        __syncthreads();
        { const int dI = w >> 1, e0 = (w & 1) * 32;
          f32x4 a0 = (f32x4){0.f, 0.f, 0.f, 0.f}, a1 = a0;
#pragma unroll 4
          for (int k0 = 0; k0 < 64; k0 += 4) { const int s = k0 + kq;
              const float a = Kc[s * HS + dI * 16 + li], b0 = Vc[s * HS + e0 + li], b1 = Vc[s * HS + e0 + 16 + li];
              a0 = mfma4(a, b0, a0); a1 = mfma4(a, b1, a1); }
#pragma unroll
          for (int r = 0; r < 4; ++r) { bf16* up = U + ((size_t)task * 64 + dI * 16 + 4 * kq + r) * 64 + e0 + li; up[0] = (bf16)f2bf(a0[r]); up[16] = (bf16)f2bf(a1[r]); } }
        __syncthreads();
    }
}
DEV void hgrn_scan_phase(Frame& F, int probe = 0) {
    const bf16* U = wsp<bf16>(F, WS_U); bf16* U2 = wsp<bf16>(F, probe ? WS_PROBE : WS_U2); const float* DEC = wsp<float>(F, WS_DEC);
    const int nact = (F.G * 256 >= 65536) ? 256 : 512;
    if (F.tid < nact)
    for (int gid = F.vcu * nact + F.tid; gid < 65536; gid += F.G * nact) {
        const int bh = gid >> 12, de = gid & 4095, d = de >> 6;
        float S = 0.f; const bf16* up = U + (size_t)bh * 128 * 4096 + de; bf16* op = U2 + (size_t)bh * 128 * 4096 + de; const float* dp = DEC + (size_t)bh * 128 * 64 + d;
#pragma unroll 16
        for (int ch = 0; ch < 128; ++ch) { const float u = bf2f(up[(size_t)ch * 4096]); const float dc = dp[ch * 64]; op[(size_t)ch * 4096] = (bf16)f2bf(S); S = dc * S + u; }
    }
}
DEV void hgrn_out_phase(Frame& F, int l) {
    float* Bc = (float*)F.ldsg; float* Kb = Bc + 64 * HS; float* Vc = Kb + 64 * HS; float* Qs = Vc + 64 * HS; float* Sc = Qs + 64 * HS; float* Ac = Sc + 64 * HS; float* tot = Ac + 64 * HS;
    float* Oc = Kb;
    const bf16* U = wsp<bf16>(F, WS_U2); bf16* CAT = wsp<bf16>(F, WS_CAT);
    const int lane = F.lane, w = F.wave, li = lane & 15, kq = lane >> 4;
    for (int task = F.vcu; task < 2048; task += F.G) {
        const int bh = task >> 7, ch = task & 127, b = bh >> 2, h = bh & 3;
        float gv[8];
        { const int d = F.tid & 63, sg = F.tid >> 6;
          const size_t go = ((size_t)b * T + ch * 64 + sg * 8) * 256 + h * 64 + d;
          const float* HFp = wsp<float>(F, WS_HF) + go; const bf16* HIp = wsp<bf16>(F, WS_HI) + go; const bf16* HQp = wsp<bf16>(F, WS_HQ) + go; const bf16* HGp = wsp<bf16>(F, WS_HG) + go;
          const bf16* Up = U + ((size_t)task * 64 + sg * 8) * 64 + d;
          float z[8], vi[8], qi[8], si[8];
#pragma unroll
          for (int i = 0; i < 8; ++i) { z[i] = HFp[(size_t)i * 256]; vi[i] = bf2f(HIp[(size_t)i * 256]); qi[i] = bf2f(HQp[(size_t)i * 256]); gv[i] = bf2f(HGp[(size_t)i * 256]); si[i] = bf2f(Up[(size_t)i * 64]); }
          hgrn_setup_chunk(F, hgrn_lb(F, l, h * 64 + d), z, Bc, Kb, tot);
#pragma unroll
          for (int i = 0; i < 8; ++i) { const int s = sg * 8 + i, J = s >> 4; const float rJ = J ? Bc[(16 * J - 1) * HS + d] : 0.f;
              Kb[s * HS + d] *= __expf(fminf(rJ - Bc[s * HS + d], 80.f));
              Vc[s * HS + d] = vi[i]; Qs[s * HS + d] = qi[i] * 0.125f; Sc[s * HS + d] = si[i]; } }
        __syncthreads();
#pragma unroll 1
        for (int ti = w; ti < 10; ti += 8) {
            const int I = ti < 1 ? 0 : (ti < 3 ? 1 : (ti < 6 ? 2 : 3)), J = ti - (I * (I + 1)) / 2;
            const int t = I * 16 + li; f32x4 acc = (f32x4){0.f, 0.f, 0.f, 0.f};
#pragma unroll 4
            for (int k0 = 0; k0 < 64; k0 += 4) { const int d = k0 + kq; const float rJ = J ? Bc[(16 * J - 1) * HS + d] : 0.f;
                const float a = Qs[t * HS + d] * __expf(Bc[t * HS + d] - rJ), bb = Kb[(J * 16 + li) * HS + d];
                acc = mfma4(a, bb, acc); }
#pragma unroll
            for (int r = 0; r < 4; ++r) { const int tt = I * 16 + 4 * kq + r, ss = J * 16 + li; Ac[tt * HS + ss] = (ss <= tt) ? acc[r] : 0.f; }
        }
        __syncthreads();
        { const int I = w >> 1, e0 = (w & 1) * 32, t = I * 16 + li;
          f32x4 a0 = (f32x4){0.f, 0.f, 0.f, 0.f}, a1 = a0;
#pragma unroll 4
          for (int k0 = 0; k0 < 64; k0 += 4) { const int d = k0 + kq;
              const float a = Qs[t * HS + d] * __expf(Bc[t * HS + d]), b0 = Sc[d * HS + e0 + li], b1 = Sc[d * HS + e0 + 16 + li];
              a0 = mfma4(a, b0, a0); a1 = mfma4(a, b1, a1); }
#pragma unroll 1
          for (int s0 = 0; s0 < 16 * (I + 1); s0 += 4) { const int s = s0 + kq;
              const float a = Ac[t * HS + s], b0 = Vc[s * HS + e0 + li], b1 = Vc[s * HS + e0 + 16 + li];
              a0 = mfma4(a, b0, a0); a1 = mfma4(a, b1, a1); }
#pragma unroll
          for (int r = 0; r < 4; ++r) { float* op = Oc + (I * 16 + 4 * kq + r) * HS + e0 + li; op[0] = a0[r]; op[16] = a1[r]; } }
        __syncthreads();
        { const float ng = inp(8)[l * 256 + h * 64 + lane];
          { const int t = w * 8 + (lane >> 3); const float* op = Oc + t * HS + (lane & 7) * 8; float s = 0.f;
#pragma unroll
            for (int j = 0; j < 8; ++j) s += op[j] * op[j];
            s += __shfl_xor(s, 1); s += __shfl_xor(s, 2); s += __shfl_xor(s, 4);
            if ((lane & 7) == 0) tot[t] = 1.0f / sqrtf(s * (1.0f / 64.0f) + RMS_EPS); }
          LDS_WAIT();
#pragma unroll
          for (int i = 0; i < 8; ++i) { const int t = w * 8 + i; const float o = Oc[t * HS + lane];
              const size_t row = (size_t)b * T + ch * 64 + t;
              CAT[row * 1024 + 768 + h * 64 + lane] = (bf16)f2bf(o * tot[t] * ng * siluf_(gv[i])); } }
        __syncthreads();
    }
}

DEV void conv_phase(Frame& F, int l) {
    const bf16* CB = wsp<bf16>(F, WS_CB); const bf16* CC = wsp<bf16>(F, WS_CC); const bf16* CH = wsp<bf16>(F, WS_CH); bf16* CAT = wsp<bf16>(F, WS_CAT);
    const float* cw = inp(3) + l * 3 * 256;
    for (int it = F.vcu * 512 + F.tid; it < NTOK * 32; it += F.G * 512) {
        const int m = it >> 5, c0 = (it & 31) * 8, t = m & (T - 1);
        const v4u bb = *(const v4u*)(CB + (size_t)m * 256 + c0);
        float y[8];
#pragma unroll
        for (int j = 0; j < 8; ++j) y[j] = 0.f;
#pragma unroll
        for (int k = 0; k < 3; ++k) {
            if (t + k - 2 >= 0) {
                const size_t o = (size_t)(m + k - 2) * 256 + c0;
                const v4u cc = *(const v4u*)(CC + o), hh = *(const v4u*)(CH + o);
#pragma unroll
                for (int j = 0; j < 4; ++j) { const float w0 = cw[k * 256 + c0 + 2 * j], w1 = cw[k * 256 + c0 + 2 * j + 1];
                    y[2 * j] += w0 * (bflo(cc[j]) * bflo(hh[j])); y[2 * j + 1] += w1 * (bfhi(cc[j]) * bfhi(hh[j])); }
            }
        }
        v4u o4;
#pragma unroll
        for (int j = 0; j < 4; ++j) o4[j] = pk2(bflo(bb[j]) * y[2 * j], bfhi(bb[j]) * y[2 * j + 1]);
        *(v4u*)(CAT + (size_t)m * 1024 + 512 + c0) = o4;
    }
}
struct SmState { float m, l; f32x4 o[4]; };
DEV void sm_reset(SmState& st) { st.m = -INFINITY; st.l = 0.f;
#pragma unroll
    for (int i = 0; i < 4; ++i) st.o[i] = (f32x4){0.f, 0.f, 0.f, 0.f}; }
DEV float sm_lsum(const SmState& st) { float l = st.l; l += __shfl_xor(l, 16); l += __shfl_xor(l, 32); return l; }
DEV void load_k(const bf16* kbase, int lane, bf16x8 (&kf)[2][2]) {
#pragma unroll
    for (int tt = 0; tt < 2; ++tt)
#pragma unroll
        for (int ks = 0; ks < 2; ++ks) kf[tt][ks] = *(const bf16x8*)(kbase + lane * 8 + (tt * 2 + ks) * 512);
}
DEV void load_v(const bf16* vbase, int lane, bf16x8 (&vf)[4]) {
    const int l16 = lane & 15, g4 = lane >> 4;
#pragma unroll
    for (int dt = 0; dt < 4; ++dt) vf[dt] = *(const bf16x8*)(vbase + (size_t)(dt * 16 + l16) * 32 + g4 * 8);
}
DEV void qk_tile(const bf16x8 (&kf)[2][2], const bf16x8 (&qf)[2], f32x4 (&s)[2]) {
#pragma unroll
    for (int tt = 0; tt < 2; ++tt) { s[tt] = mfma16(kf[tt][0], qf[0], (f32x4){0.f, 0.f, 0.f, 0.f}); s[tt] = mfma16(kf[tt][1], qf[1], s[tt]); }
}
DEV bf16x8 pack_p(const float (&p)[2][4]) {
    v4u w; w.x = pk2(p[0][0], p[0][1]); w.y = pk2(p[0][2], p[0][3]); w.z = pk2(p[1][0], p[1][1]); w.w = pk2(p[1][2], p[1][3]);
    return __builtin_bit_cast(bf16x8, w);
}
template <int MODE, class MaskF>
DEV void attn_compute(const bf16x8 (&kf)[2][2], const bf16x8 (&vf)[4], const bf16x8 (&qf)[2], SmState& st, int lane, bool colok, MaskF mask) {
    const int g4 = lane >> 4;
    f32x4 s[2]; qk_tile(kf, qf, s);
    float sv[2][4]; float tmax = -INFINITY;
#pragma unroll
    for (int tt = 0; tt < 2; ++tt)
#pragma unroll
        for (int r = 0; r < 4; ++r) { float x = s[tt][r]; if (MODE == 2) x = mask(16 * tt + 4 * g4 + r) ? x : -INFINITY; sv[tt][r] = x; tmax = fmaxf(tmax, x); }
    if (MODE == 1) tmax = colok ? tmax : -INFINITY;
    tmax = fmaxf(tmax, __shfl_xor(tmax, 16)); tmax = fmaxf(tmax, __shfl_xor(tmax, 32));
    const float mnew = fmaxf(st.m, tmax), muse = (mnew == -INFINITY) ? 0.f : mnew;
    const float alpha = ex2(st.m - muse);
    const float msub = (MODE == 1) ? (colok ? muse : INFINITY) : muse;
    float p[2][4]; float ps = 0.f;
#pragma unroll
    for (int tt = 0; tt < 2; ++tt)
#pragma unroll
        for (int r = 0; r < 4; ++r) { p[tt][r] = ex2(sv[tt][r] - msub); ps += p[tt][r]; }
    st.l = st.l * alpha + ps; st.m = mnew;
    const bf16x8 pf = pack_p(p);
#pragma unroll
    for (int dt = 0; dt < 4; ++dt) { st.o[dt] = st.o[dt] * alpha; st.o[dt] = mfma16(vf[dt], pf, st.o[dt]); }
}
template <int MODE, class MaskF>
DEV void attn_compute_fixed(const bf16x8 (&kf)[2][2], const bf16x8 (&vf)[4], const bf16x8 (&qf)[2], SmState& st, float mref, int lane, bool colok, MaskF mask) {
    const int g4 = lane >> 4;
    f32x4 s[2]; qk_tile(kf, qf, s);
    const float msub = (MODE == 1) ? (colok ? mref : INFINITY) : mref;
    float p[2][4]; float ps = 0.f;
#pragma unroll
    for (int tt = 0; tt < 2; ++tt)
#pragma unroll
        for (int r = 0; r < 4; ++r) { float x = s[tt][r] - msub; if (MODE == 2) x = mask(16 * tt + 4 * g4 + r) ? x : -INFINITY; p[tt][r] = ex2(x); ps += p[tt][r]; }
    st.l += ps;
    const bf16x8 pf = pack_p(p);
#pragma unroll
    for (int dt = 0; dt < 4; ++dt) st.o[dt] = mfma16(vf[dt], pf, st.o[dt]);
}
template <int MODE, class MaskF>
DEV void attn_max(const bf16x8 (&kf)[2][2], const bf16x8 (&qf)[2], float& mx, int lane, bool colok, MaskF mask) {
    const int g4 = lane >> 4;
    f32x4 s[2]; qk_tile(kf, qf, s);
    float tmax = -INFINITY;
#pragma unroll
    for (int tt = 0; tt < 2; ++tt)
#pragma unroll
        for (int r = 0; r < 4; ++r) { float x = s[tt][r]; if (MODE == 2) x = mask(16 * tt + 4 * g4 + r) ? x : -INFINITY; tmax = fmaxf(tmax, x); }
    if (MODE == 1) tmax = colok ? tmax : -INFINITY;
    mx = fmaxf(mx, tmax);
}
DEV float colmax_finish(float mx) { mx = fmaxf(mx, __shfl_xor(mx, 16)); mx = fmaxf(mx, __shfl_xor(mx, 32)); return mx == -INFINITY ? 0.f : mx; }
DEV float col_norm(const bf16x8 (&qf)[2]) {
    float s = 0.f;
#pragma unroll
    for (int ks = 0; ks < 2; ++ks) { const v4u w = __builtin_bit_cast(v4u, qf[ks]);
#pragma unroll
        for (int j = 0; j < 4; ++j) { const float a = bflo(w[j]), b = bfhi(w[j]); s += a * a + b * b; } }
    s += __shfl_xor(s, 16); s += __shfl_xor(s, 32);
    return sqrtf(s);
}
DEV float wave_max_uniform(float v) {
#pragma unroll
    for (int o = 1; o < 64; o <<= 1) v = fmaxf(v, __shfl_xor(v, o));
    return __builtin_bit_cast(float, __builtin_amdgcn_readfirstlane(__builtin_bit_cast(int, v)));
}
constexpr float FIXED_REF_MAX = 40.f;
DEV void kmax_phase(Frame& F, int l) {
    const int lane = F.lane; const int gw = F.vcu * NWAVES + F.wave, NGW = F.G * NWAVES;
    for (int item = gw; item < 2048; item += NGW) {
        const int br = item >> 10, bh = (item >> 7) & 7, key = (item & 127) * 64 + lane;
        const bf16* kp = wsp<bf16>(F, br ? WS_KW : WS_KS) + (size_t)bh * T * 64;
        float s = 0.f;
#pragma unroll
        for (int i = 0; i < 8; ++i) { const v4u w = *(const v4u*)(kp + kfrag_off(key, i * 8));
#pragma unroll
            for (int j = 0; j < 4; ++j) { const float a = bflo(w[j]), b = bfhi(w[j]); s += a * a + b * b; } }
#pragma unroll
        for (int o = 1; o < 64; o <<= 1) s = fmaxf(s, __shfl_xor(s, o));
        if (lane == 0) __hip_atomic_fetch_max((unsigned*)F.ctl + CW_KMAX + l * 16 + br * 8 + bh, __builtin_bit_cast(unsigned, s), RLX_AGENT);
    }
}
struct NoMask { DEV bool operator()(int) const { return true; } };
template <int D, bool WITHV, class AddrF, class BodyF>
DEV void pipe_run(int n, int lane, AddrF addr, BodyF body) {
    if (n <= 0) return;
    bf16x8 kf[D][2][2], vf[D][4];
#pragma unroll
    for (int d = 0; d < D; ++d) { const bf16* kb; const bf16* vb; addr(d < n ? d : n - 1, kb, vb); load_k(kb, lane, kf[d]); if (WITHV) load_v(vb, lane, vf[d]); }
#pragma unroll 1
    for (int i = 0; i < n; i += D) {
#pragma unroll
        for (int d = 0; d < D; ++d) { const int s = i + d;
            if (s < n) body(s, kf[d], vf[d]);
            if (D > 1 || s + 1 < n) { const bf16* kb; const bf16* vb; addr(s + D < n ? s + D : n - 1, kb, vb); load_k(kb, lane, kf[d]); if (WITHV) load_v(vb, lane, vf[d]); } }
    }
}
template <class AddrF, class BodyF>
DEV void pipe_run_k2(int n, int lane, AddrF addr, BodyF body) {
    if (n <= 0) return;
    bf16x8 kf[2][2][2], vf[4];
    { const bf16* kb; const bf16* vb; addr(0, kb, vb); load_k(kb, lane, kf[0]); }
#pragma unroll 1
    for (int i = 0; i < n; i += 2) {
#pragma unroll
        for (int d = 0; d < 2; ++d) { const int s = i + d;
            { const bf16* kb; const bf16* vb; addr(s < n ? s : n - 1, kb, vb); load_v(vb, lane, vf); }
            { const bf16* kb; const bf16* vb; addr(s + 1 < n ? s + 1 : n - 1, kb, vb); load_k(kb, lane, kf[d ^ 1]); }
            if (s < n) body(s, kf[d], vf); }
    }
}
constexpr int PIPE_D = 2;

DEV void acc_add_packed(unsigned (&pk)[4][4][2], int ct, const f32x4 (&o)[4], float sc, bool first) {
#pragma unroll
    for (int dt = 0; dt < 4; ++dt) {
        f32x4 v = o[dt] * sc;
        if (!first) { v[0] += bflo(pk[ct][dt][0]); v[1] += bfhi(pk[ct][dt][0]); v[2] += bflo(pk[ct][dt][1]); v[3] += bfhi(pk[ct][dt][1]); }
        pk[ct][dt][0] = pk2(v[0], v[1]); pk[ct][dt][1] = pk2(v[2], v[3]);
    }
}
template <int VAR>
DEV void nsa_phase_t(Frame& F, int l) {
#define NSA_RELANE() int ln_ = lane; asm volatile("" : "+v"(ln_)); const int l16 = ln_ & 15, g4 = ln_ >> 4, tq = l16 >> 2, gh = l16 & 3; const size_t mrow0 = (size_t)b * T + t0 + tq; const int tl0 = t0 + tq; (void)l16; (void)g4; (void)gh; (void)mrow0; (void)tl0
    float* IMP = (float*)(F.ldsg + F.wave * NSA_LDS_WAVE);
    float* VALS = IMP + 2048; int* BL = (int*)(IMP + 2176); unsigned* SELB = (unsigned*)(IMP + 2304); float* GL = IMP + 2432;
    const bf16* Q = wsp<bf16>(F, WS_Q);
    const bf16* KCC = wsp<bf16>(F, WS_KCC); const bf16* VCT = wsp<bf16>(F, WS_VCT);
    const bf16* KS = wsp<bf16>(F, WS_KS); const bf16* VST = wsp<bf16>(F, WS_VST);
    const bf16* KW = wsp<bf16>(F, WS_KW); const bf16* VWT = wsp<bf16>(F, WS_VWT);
    bf16* CAT = wsp<bf16>(F, WS_CAT);
    const int gw = F.vcu * NWAVES + F.wave, NGW = F.G * NWAVES;
    const bool xmap = (F.G == 256);
#pragma unroll 1
    for (int task = gw; task < 4096; task += NGW) {
        unsigned zl_ = 0u; asm volatile("" : "+v"(zl_)); const int lane = (int)__builtin_amdgcn_mbcnt_hi(~0u, __builtin_amdgcn_mbcnt_lo(~0u, zl_));
        const int bh = xmap ? (gw >> 8) : (task & 7), idx = xmap ? ((task >> 11) ? 511 - (gw & 255) : (gw & 255)) : (task >> 3);
        const int t0 = idx * 16, b = bh >> 1, hkv = bh & 1, cur = t0 >> 6;
        bf16x8 qf[4][2];
        unsigned opk[4][4][2];
        SmState st[4];
        float qnmax = 0.f;
        { NSA_RELANE();
#pragma unroll
        for (int ct = 0; ct < 4; ++ct)
#pragma unroll
            for (int ks = 0; ks < 2; ++ks) qf[ct][ks] = *(const bf16x8*)(Q + (mrow0 + 4 * ct) * 512 + hkv * 256 + gh * 64 + ks * 32 + g4 * 8);
        { NSA_RELANE();
          f32x4 ga[1]; ga[0] = (f32x4){0.f, 0.f, 0.f, 0.f};
          { const bf16* ap = wsp<bf16>(F, WS_HB) + ((size_t)b * T + t0 + l16) * 1024 + g4 * 8; const bf16* bp = wsp<bf16>(F, WS_WG) + (size_t)((l * 2 + hkv) * 16 + l16) * 1024 + g4 * 8;
#pragma unroll 1
            for (int k0 = 0; k0 < 1024; k0 += 256) {
                bf16x8 av[8], bv[8];
#pragma unroll
                for (int i = 0; i < 8; ++i) { av[i] = *(const bf16x8*)(ap + k0 + 32 * i); bv[i] = *(const bf16x8*)(bp + k0 + 32 * i); }
#pragma unroll
                for (int i = 0; i < 8; ++i) ga[0] = mfma16(av[i], bv[i], ga[0]);
            } }
          const float rs = (ln_ < 16) ? row_rstd_full(wsp<float>(F, WS_SSQ), b * T + t0 + ln_) : 0.f;
#pragma unroll
          for (int r = 0; r < 4; ++r) GL[(g4 * 4 + r) * 16 + l16] = sigmoidf_(ga[0][r] * __shfl(rs, g4 * 4 + r));
        }
        const int ngc = (t0 + 15 >= 31) ? (((t0 + 15 - 31) >> 4) >> 5) + 1 : 0;
        const bf16* kcb = KCC + (size_t)bh * 512 * 64; const bf16* vcb = VCT + (size_t)bh * 16 * 64 * 32;
        float cm[4], cl[4];
#pragma unroll
        for (int ct = 0; ct < 4; ++ct) { cm[ct] = -INFINITY; cl[ct] = 0.f; }
        pipe_run<1, false>(ngc, ln_, [&](int s, const bf16*& kb, const bf16*& vb) { kb = kcb + (size_t)s * 32 * 64; vb = vcb; },
            [&](int kg, const bf16x8 (&kf)[2][2], const bf16x8 (&)[4]) {
#pragma unroll
                for (int ct = 0; ct < 4; ++ct) {
                    const int tl = tl0 + 4 * ct;
                    f32x4 s[2]; qk_tile(kf, qf[ct], s);
                    float sv[2][4]; float tmax = -INFINITY;
#pragma unroll
                    for (int tt = 0; tt < 2; ++tt)
#pragma unroll
                        for (int r = 0; r < 4; ++r) { const int c = kg * 32 + 16 * tt + 4 * g4 + r; sv[tt][r] = (16 * c + 31 <= tl) ? s[tt][r] : -INFINITY; tmax = fmaxf(tmax, sv[tt][r]); }
                    tmax = fmaxf(tmax, __shfl_xor(tmax, 16)); tmax = fmaxf(tmax, __shfl_xor(tmax, 32));
                    const float mnew = fmaxf(cm[ct], tmax), muse = (mnew == -INFINITY) ? 0.f : mnew;
                    float ps = 0.f;
#pragma unroll
                    for (int tt = 0; tt < 2; ++tt)
#pragma unroll
                        for (int r = 0; r < 4; ++r) ps += ex2(sv[tt][r] - muse);
                    cl[ct] = cl[ct] * ex2(cm[ct] - muse) + ps; cm[ct] = mnew;
                }
            });
        {
            float cmu[4], cinv[4], carry[4];
#pragma unroll
            for (int ct = 0; ct < 4; ++ct) { float l = cl[ct]; l += __shfl_xor(l, 16); l += __shfl_xor(l, 32);
                cmu[ct] = (cm[ct] == -INFINITY) ? 0.f : cm[ct]; cinv[ct] = l > 0.f ? 1.0f / l : 0.f; carry[ct] = 0.f; sm_reset(st[ct]); }
            pipe_run<1, true>(ngc, ln_, [&](int s, const bf16*& kb, const bf16*& vb) { kb = kcb + (size_t)s * 32 * 64; vb = vcb + (size_t)s * 64 * 32; },
                [&](int kg, const bf16x8 (&kf)[2][2], const bf16x8 (&vf)[4]) {
#pragma unroll
                    for (int ct = 0; ct < 4; ++ct) {
                        const int tl = tl0 + 4 * ct;
                        f32x4 s[2]; qk_tile(kf, qf[ct], s);
                        float p[2][4];
#pragma unroll
                        for (int tt = 0; tt < 2; ++tt) {
#pragma unroll
                            for (int r = 0; r < 4; ++r) { const int c = kg * 32 + 16 * tt + 4 * g4 + r; p[tt][r] = (16 * c + 31 <= tl) ? ex2(s[tt][r] - cmu[ct]) * cinv[ct] : 0.f; }
                            const float hb = 0.5f * p[tt][3];
                            const float bsh = __shfl(hb, (ln_ + 48) & 63);
                            float v = ((p[tt][0] + p[tt][1]) + (p[tt][2] + hb)) + ((g4 == 0) ? carry[ct] : bsh);
                            carry[ct] = bsh;
                            v += __shfl_xor(v, 1); v += __shfl_xor(v, 2);
                            if (gh == 0) IMP[(4 * ct + tq) * 128 + kg * 8 + 4 * tt + g4] = v;
                        }
                        const bf16x8 pf = pack_p(p);
#pragma unroll
                        for (int dt = 0; dt < 4; ++dt) st[ct].o[dt] = mfma16(vf[dt], pf, st[ct].o[dt]);
                    }
                });
#pragma unroll
            for (int ct = 0; ct < 4; ++ct) acc_add_packed(opk, ct, st[ct].o, GL[(4 * ct + tq) * 16 + gh * 3 + 0], true);
        }
        }
        LDS_WAIT();
        unsigned sb0 = 0u, sb1 = 0u;
        if (cur < 16) { sb0 = (lane <= cur) ? 0xffffu : 0u; }
        else if (VAR == 6) {
#pragma unroll 1
            for (int q = 0; q < 16; ++q) { const bool s0 = (lane <= cur) && ((lane * 37 + q * 11) % (cur + 1)) < 16, s1 = (lane + 64 <= cur) && (((lane + 64) * 37 + q * 11) % (cur + 1)) < 16;
                sb0 |= (s0 ? 1u : 0u) << q; sb1 |= (s1 ? 1u : 0u) << q; }
        }
        else {
            const unsigned long long below = (1ull << lane) - 1ull;
#pragma unroll 1
            for (int q = 0; q < 16; ++q) {
                unsigned k0, k1;
                { const int j = lane; const float v = (j == 0 || j == cur || j == cur - 1) ? 1e6f : IMP[q * 128 + j]; k0 = (j > cur) ? 0u : __builtin_bit_cast(unsigned, v) + 1u; }
                { const int j = lane + 64; const float v = (j == cur || j == cur - 1) ? 1e6f : IMP[q * 128 + j]; k1 = (j > cur) ? 0u : __builtin_bit_cast(unsigned, v) + 1u; }
                unsigned lo = 0u, hi = 0xffffffffu;
                while (hi - lo > 1u) { const unsigned mid = lo + ((hi - lo) >> 1);
                    const int c = __builtin_popcountll(__ballot(k0 >= mid)) + __builtin_popcountll(__ballot(k1 >= mid));
                    if (c >= 16) lo = mid; else hi = mid; }
                const unsigned long long g0 = __ballot(k0 > lo), g1 = __ballot(k1 > lo), e0 = __ballot(k0 == lo), e1 = __ballot(k1 == lo);
                const int need = 16 - __builtin_popcountll(g0) - __builtin_popcountll(g1);
                const bool s0 = (k0 > lo) || (k0 == lo && __builtin_popcountll(e0 & below) < need);
                const bool s1 = (k1 > lo) || (k1 == lo && __builtin_popcountll(e0) + __builtin_popcountll(e1 & below) < need);
                sb0 |= (s0 ? 1u : 0u) << q; sb1 |= (s1 ? 1u : 0u) << q;
            }
        }
        SELB[lane] = sb0; SELB[lane + 64] = sb1;
        LDS_WAIT();
#define NSA_PARK() do { _Pragma("unroll") for (int i_ = 0; i_ < 8; ++i_) { v4u w_; w_.x = opk[i_ >> 1][(i_ & 1) * 2][0]; w_.y = opk[i_ >> 1][(i_ & 1) * 2][1]; w_.z = opk[i_ >> 1][(i_ & 1) * 2 + 1][0]; w_.w = opk[i_ >> 1][(i_ & 1) * 2 + 1][1]; ((v4u*)IMP)[i_ * 64 + lane] = w_; } } while (0)
#define NSA_UNPARK() do { _Pragma("unroll") for (int i_ = 0; i_ < 8; ++i_) { const v4u w_ = ((const v4u*)IMP)[i_ * 64 + lane]; opk[i_ >> 1][(i_ & 1) * 2][0] = w_.x; opk[i_ >> 1][(i_ & 1) * 2][1] = w_.y; opk[i_ >> 1][(i_ & 1) * 2 + 1][0] = w_.z; opk[i_ >> 1][(i_ & 1) * 2 + 1][1] = w_.w; } } while (0)
        NSA_PARK();
        { NSA_RELANE();
#pragma unroll
        for (int ct = 0; ct < 4; ++ct) {
            const float* rp = wsp<float>(F, WS_ROPE) + ((size_t)(tl0 + 4 * ct) * 32 + g4 * 8) * 2;
            const v4u a = __builtin_bit_cast(v4u, qf[ct][0]), b2 = __builtin_bit_cast(v4u, qf[ct][1]); v4u ra, rb;
#pragma unroll
            for (int jj = 0; jj < 4; ++jj) { const f32x4 cs = *(const f32x4*)(rp + 4 * jj);
                const float x1a = bflo(a[jj]), x1b = bfhi(a[jj]), x2a = bflo(b2[jj]), x2b = bfhi(b2[jj]);
                ra[jj] = pk2(x1a * cs[0] - x2a * cs[1], x1b * cs[2] - x2b * cs[3]);
                rb[jj] = pk2(x2a * cs[0] + x1a * cs[1], x2b * cs[2] + x1b * cs[3]); }
            qf[ct][0] = __builtin_bit_cast(bf16x8, ra); qf[ct][1] = __builtin_bit_cast(bf16x8, rb);
        }
        {
            const unsigned long long ulo = __ballot(sb0 != 0u), uhi = __ballot(sb1 != 0u);
            const unsigned long long below = (1ull << ln_) - 1ull;
            const int nlo = __builtin_popcountll(ulo), nblk = nlo + __builtin_popcountll(uhi);
            if (sb0 != 0u) BL[__builtin_popcountll(ulo & below)] = ln_;
            if (sb1 != 0u) BL[nlo + __builtin_popcountll(uhi & below)] = ln_ + 64;
            LDS_WAIT();
#pragma unroll
            for (int ct = 0; ct < 4; ++ct) sm_reset(st[ct]);
            const bf16* kb0 = KS + (size_t)bh * T * 64; const bf16* vb0 = VST + (size_t)bh * 256 * 64 * 32;
            float mr; bool fixed;
            { const float kmx = sqrtf(__builtin_bit_cast(float, __hip_atomic_load((const unsigned*)F.ctl + CW_KMAX + l * 16 + bh, RLX_AGENT))); float mm = 0.f;
#pragma unroll
              for (int ct = 0; ct < 4; ++ct) mm = fmaxf(mm, col_norm(qf[ct]));
              qnmax = wave_max_uniform(mm); mr = qnmax * kmx * 1.002f + 1e-3f;
              fixed = mr < FIXED_REF_MAX; }
            auto addr_sel = [&](int s, const bf16*& kb, const bf16*& vb) { const int g32 = (VAR == 7) ? (s & 1) : BL[s >> 1] * 2 + (s & 1); kb = kb0 + (size_t)g32 * 32 * 64; vb = vb0 + (size_t)g32 * 64 * 32; };
            asm volatile("" ::: "memory");
            if (!fixed) {
                float mx[4] = {-INFINITY, -INFINITY, -INFINITY, -INFINITY};
                pipe_run<1, false>(2 * nblk, ln_, addr_sel,
                    [&](int s, const bf16x8 (&kf)[2][2], const bf16x8 (&)[4]) {
                        const int j = BL[s >> 1], key0 = j * 64 + (s & 1) * 32;
                        const unsigned tm = (unsigned)__builtin_amdgcn_readfirstlane((int)SELB[j]);
#pragma unroll
                        for (int ct = 0; ct < 4; ++ct) { const unsigned tmk = (tm >> (4 * ct)) & 0xFu;
                            if (tmk) { const bool colok = (tmk >> tq) & 1u; const int tl = tl0 + 4 * ct;
                                if (j == cur) attn_max<2>(kf, qf[ct], mx[ct], ln_, true, [&](int kk) { return colok && (key0 + kk <= tl); });
                                else attn_max<1>(kf, qf[ct], mx[ct], ln_, colok, NoMask()); } }
                    });
                mr = wave_max_uniform(fmaxf(fmaxf(mx[0], mx[1]), fmaxf(mx[2], mx[3]))); if (mr == -INFINITY) mr = 0.f;
            }
            asm volatile("" ::: "memory");
            pipe_run_k2(VAR == 4 ? 0 : 2 * nblk, ln_, addr_sel,
                [&](int s, const bf16x8 (&kf)[2][2], const bf16x8 (&vf)[4]) {
                    const int j = BL[s >> 1], key0 = j * 64 + (s & 1) * 32;
                    const unsigned tm = (unsigned)__builtin_amdgcn_readfirstlane((int)SELB[j]);
#pragma unroll
                    for (int ct = 0; ct < 4; ++ct) {
                        const unsigned tmk = (tm >> (4 * ct)) & 0xFu;
                        if (tmk) {
                            const bool colok = (tmk >> tq) & 1u; const int tl = tl0 + 4 * ct;
                            if (j == cur) attn_compute_fixed<2>(kf, vf, qf[ct], st[ct], mr, ln_, true, [&](int kk) { return colok && (key0 + kk <= tl); });
                            else attn_compute_fixed<1>(kf, vf, qf[ct], st[ct], mr, ln_, colok, NoMask());
                        }
                    }
                });
            LDS_WAIT();
            NSA_UNPARK();
#pragma unroll
            for (int ct = 0; ct < 4; ++ct) { const float ls = sm_lsum(st[ct]); const float gs = GL[(4 * ct + tq) * 16 + gh * 3 + 1];
                acc_add_packed(opk, ct, st[ct].o, ls > 0.f ? gs / ls : 0.f, false); }
            NSA_PARK();
        }
        }
        { NSA_RELANE();
#pragma unroll
            for (int ct = 0; ct < 4; ++ct) sm_reset(st[ct]);
            const bf16* kb0 = (VAR == 3 ? KS : KW) + (size_t)bh * T * 64; const bf16* vb0 = (VAR == 3 ? VST : VWT) + (size_t)bh * 256 * 64 * 32;
            const int glo = (t0 - 511 > 0 ? t0 - 511 : 0) >> 5, ghi = (t0 + 15) >> 5;
            float mr; bool fixed;
            { const float kmx = sqrtf(__builtin_bit_cast(float, __hip_atomic_load((const unsigned*)F.ctl + CW_KMAX + l * 16 + 8 + bh, RLX_AGENT)));
              mr = qnmax * kmx * 1.002f + 1e-3f;
              fixed = mr < FIXED_REF_MAX; }
            auto addr_win = [&](int s, const bf16*& kb, const bf16*& vb) { kb = kb0 + (size_t)(glo + s) * 32 * 64; vb = vb0 + (size_t)(glo + s) * 64 * 32; };
            asm volatile("" ::: "memory");
            if (!fixed) {
                float mx[4] = {-INFINITY, -INFINITY, -INFINITY, -INFINITY};
                pipe_run<1, false>(ghi - glo + 1, ln_, addr_win,
                    [&](int s, const bf16x8 (&kf)[2][2], const bf16x8 (&)[4]) {
                        const int key0 = (glo + s) * 32;
#pragma unroll
                        for (int ct = 0; ct < 4; ++ct) { const int tl = tl0 + 4 * ct;
                            attn_max<2>(kf, qf[ct], mx[ct], ln_, true, [&](int kk) { const int kp = key0 + kk; return kp <= tl && kp + 512 > tl; }); }
                    });
                mr = wave_max_uniform(fmaxf(fmaxf(mx[0], mx[1]), fmaxf(mx[2], mx[3]))); if (mr == -INFINITY) mr = 0.f;
            }
            asm volatile("" ::: "memory");
            pipe_run_k2(VAR == 5 ? 0 : ghi - glo + 1, ln_, addr_win,
                [&](int s, const bf16x8 (&kf)[2][2], const bf16x8 (&vf)[4]) {
                    const int key0 = (glo + s) * 32;
#pragma unroll
                    for (int ct = 0; ct < 4; ++ct) {
                        const int tlo = t0 + 4 * ct, thi = tlo + 3, tl = tl0 + 4 * ct;
                        if (key0 > thi || key0 + 31 + 512 <= tlo) continue;
                        if (key0 + 512 > thi && key0 + 31 <= tlo) attn_compute_fixed<0>(kf, vf, qf[ct], st[ct], mr, ln_, true, NoMask());
                        else attn_compute_fixed<2>(kf, vf, qf[ct], st[ct], mr, ln_, true, [&](int kk) { const int kp = key0 + kk; return kp <= tl && kp + 512 > tl; });
                    }
                });
            NSA_UNPARK();
#pragma unroll
            for (int ct = 0; ct < 4; ++ct) { const float ls = sm_lsum(st[ct]); const float gwn = GL[(4 * ct + tq) * 16 + gh * 3 + 2];
                acc_add_packed(opk, ct, st[ct].o, ls > 0.f ? gwn / ls : 0.f, false); }
        }
        { NSA_RELANE();
#pragma unroll
        for (int ct = 0; ct < 4; ++ct)
#pragma unroll
            for (int dt = 0; dt < 4; ++dt) { v2u w; w.x = opk[ct][dt][0]; w.y = opk[ct][dt][1];
                if (VAR == 0 || w.x == 0x7fc17fc1u) *(v2u*)(CAT + (mrow0 + 4 * ct) * 1024 + hkv * 256 + gh * 64 + dt * 16 + g4 * 4) = w; }
        }
        LDS_WAIT();
        if (VAR == 0 && xmap) convert_experts(F, l, (bf16*)IMP, task >> 11);
    }
#undef NSA_RELANE
#undef NSA_PARK
#undef NSA_UNPARK
}

DEV void nsa_phase(Frame& F, int l) { nsa_phase_t<0>(F, l); }

DEV void cross_phase(Frame& F, int l) {
    const int lane = F.lane, l16 = lane & 15, g4 = lane >> 4;
    const bf16* XQ = wsp<bf16>(F, WS_XQ); bf16* XO = wsp<bf16>(F, WS_XO);
    const int gw = F.vcu * NWAVES + F.wave, NGW = F.G * NWAVES;
#pragma unroll 1
    for (int task = gw; task < 2048; task += NGW) {
        const int head = task & 3, m0 = (task >> 2) * 64, b = m0 >> 13;
        bf16x8 qf[4][2];
#pragma unroll
        for (int ct = 0; ct < 4; ++ct)
#pragma unroll
            for (int ks = 0; ks < 2; ++ks) qf[ct][ks] = *(const bf16x8*)(XQ + (size_t)(m0 + 16 * ct + l16) * 256 + head * 64 + ks * 32 + g4 * 8);
        const bf16* kb0 = wsp<bf16>(F, WS_MK) + (size_t)((l * 4 + b) * 4 + head) * 256 * 64;
        const bf16* vb0 = wsp<bf16>(F, WS_MVT) + (size_t)((l * 4 + b) * 4 + head) * 8 * 64 * 32;
        SmState st[4];
#pragma unroll
        for (int ct = 0; ct < 4; ++ct) sm_reset(st[ct]);
        pipe_run<PIPE_D, true>(8, lane, [&](int s, const bf16*& kb, const bf16*& vb) { kb = kb0 + (size_t)s * 32 * 64; vb = vb0 + (size_t)s * 64 * 32; },
            [&](int, const bf16x8 (&kf)[2][2], const bf16x8 (&vf)[4]) {
#pragma unroll
                for (int ct = 0; ct < 4; ++ct) attn_compute<0>(kf, vf, qf[ct], st[ct], lane, true, NoMask());
            });
#pragma unroll
        for (int ct = 0; ct < 4; ++ct) {
            const float inv = 1.0f / sm_lsum(st[ct]);
#pragma unroll
            for (int dt = 0; dt < 4; ++dt) { const f32x4 o = st[ct].o[dt] * inv; v2u w; w.x = pk2(o[0], o[1]); w.y = pk2(o[2], o[3]);
                *(v2u*)(XO + (size_t)(m0 + 16 * ct + l16) * 256 + head * 64 + dt * 16 + g4 * 4) = w; }
        }
    }
}


DEV void router_phase(Frame& F, int l, int probe = 0) {
    const int lane = F.lane, l16 = lane & 15, g4 = lane >> 4;
    float* LG = (float*)F.ldsg + F.wave * 768;
    const bf16* HB = wsp<bf16>(F, WS_HB); const float* SSQ = wsp<float>(F, WS_SSQ);
    const bf16* WR = wsp<bf16>(F, WS_WR) + (size_t)l * 96 * 1024;
    int* TOKE = wsp<int>(F, probe ? WS_PROBE : WS_TOKE); float* TOKG = wsp<float>(F, probe ? WS_PROBE + MiB : WS_TOKG); int* TOKP = wsp<int>(F, probe ? WS_PROBE + 2 * MiB : WS_TOKP);
    unsigned* CNT = (unsigned*)F.ctl + CW_CNT + l * 32 + (probe ? 64 : 0);
    const float* bg = inp(14) + l * 4; const float* be = inp(16) + l * 32;
    unsigned* HIST = (unsigned*)((float*)F.ldsg + 8 * 768);
#pragma unroll 1
    for (int tb = F.vcu * NWAVES; tb < NTOK / 16; tb += F.G * NWAVES) {
        const int task = tb + F.wave; const bool live = task < NTOK / 16;
        const int m0 = (live ? task : tb) * 16;
        if (F.tid < 64) HIST[F.tid] = 0u;
        f32x4 acc[3];
        {
            const bf16* ap = HB + (size_t)(m0 + l16) * 1024 + g4 * 8; const bf16* bp = WR + (size_t)l16 * 1024 + g4 * 8;
#pragma unroll
            for (int n = 0; n < 3; ++n) acc[n] = (f32x4){0.f, 0.f, 0.f, 0.f};
#pragma unroll 4
            for (int k = 0; k < 1024; k += 32) {
                const bf16x8 a = *(const bf16x8*)(ap + k);
#pragma unroll
                for (int n = 0; n < 3; ++n) { const bf16x8 bh = *(const bf16x8*)(bp + (size_t)n * 16 * 1024 + k), bl = *(const bf16x8*)(bp + (size_t)(48 + n * 16) * 1024 + k);
                    acc[n] = mfma16(a, bh, acc[n]); acc[n] = mfma16(a, bl, acc[n]); }
            }
        }
#pragma unroll
        for (int nt = 0; nt < 3; ++nt)
#pragma unroll
            for (int r = 0; r < 4; ++r) LG[(g4 * 4 + r) * 48 + nt * 16 + l16] = acc[nt][r];
        LDS_WAIT();
        int id1 = 0, id2 = 0;
        if (lane < 16) {
            const int m = m0 + lane; const float rstd = row_rstd_full(SSQ, m); const float* lg = LG + lane * 48;
            float g[4];
#pragma unroll
            for (int j = 0; j < 4; ++j) g[j] = lg[j] * rstd + bg[j];
            float gmax = g[0]; int grp = 0;
#pragma unroll
            for (int j = 1; j < 4; ++j) if (g[j] > gmax) { gmax = g[j]; grp = j; }
            float den = 0.f;
#pragma unroll
            for (int j = 0; j < 4; ++j) den += expf(g[j] - gmax);
            const float psel = 1.0f / den;
            float e1 = -INFINITY, e2 = -INFINITY; int i1 = 0, i2 = 0;
            for (int j = 0; j < 8; ++j) { const float v = lg[4 + grp * 8 + j] * rstd + be[grp * 8 + j];
                if (v > e1) { e2 = e1; i2 = i1; e1 = v; i1 = j; } else if (v > e2) { e2 = v; i2 = j; } }
            const float x = expf(e2 - e1), w1 = 1.0f / (1.0f + x), w2 = x * w1;
            id1 = grp * 8 + i1; id2 = grp * 8 + i2;
            if (live) { TOKE[m * 2] = id1; TOKE[m * 2 + 1] = id2; TOKG[m * 2] = psel * w1; TOKG[m * 2 + 1] = psel * w2; }
        }
        __syncthreads();
        unsigned lp1 = 0u, lp2 = 0u;
        if (lane < 16 && live) { lp1 = __hip_atomic_fetch_add(HIST + id1, 1u, __ATOMIC_RELAXED, __HIP_MEMORY_SCOPE_WORKGROUP); lp2 = __hip_atomic_fetch_add(HIST + id2, 1u, __ATOMIC_RELAXED, __HIP_MEMORY_SCOPE_WORKGROUP); }
        __syncthreads();
        if (F.tid < 32) { const unsigned c = HIST[F.tid]; HIST[32 + F.tid] = c ? __hip_atomic_fetch_add(CNT + F.tid, c, RLX_AGENT) : 0u; }
        __syncthreads();
        if (lane < 16 && live) { const int m = m0 + lane; TOKP[m * 2] = (int)(HIST[32 + id1] + lp1); TOKP[m * 2 + 1] = (int)(HIST[32 + id2] + lp2); }
        __syncthreads();
    }
}
DEV int moe_tables(Frame& F, int l) {
    int* tab = (int*)(F.ldsg + TAB_OFF);
    if (F.tid == 0) {
        const unsigned* CNT = (const unsigned*)F.ctl + CW_CNT + l * 32; int off = 0;
#pragma unroll 1
        for (int e = 0; e < 32; ++e) { tab[e] = off; const int c = (int)__hip_atomic_load(CNT + e, RLX_AGENT); const int nt = (c + 255) >> 8;
            for (int i = 0; i < nt; ++i) tab[40 + (off >> 8) + i] = e;
            off += nt << 8; }
        tab[32] = off;
    }
    __syncthreads();
    return tab[32];
}
DEV void gather_phase(Frame& F, int l) {
    (void)moe_tables(F, l);
    const int* tab = (const int*)(F.ldsg + TAB_OFF);
    const int lane = F.lane; const int gw = F.vcu * NWAVES + F.wave, NGW = F.G * NWAVES;
    const bf16* HB = wsp<bf16>(F, WS_HB); const float* SSQ = wsp<float>(F, WS_SSQ); bf16* XS = wsp<bf16>(F, WS_XS);
    const int* TOKE = wsp<int>(F, WS_TOKE); const float* TOKG = wsp<float>(F, WS_TOKG); const int* TOKP = wsp<int>(F, WS_TOKP); int* TOKS = wsp<int>(F, WS_TOKS);
    float* SRSTD = wsp<float>(F, WS_SRSTD); float* SGATE = wsp<float>(F, WS_SGATE);
    const unsigned* CNT = (const unsigned*)F.ctl + CW_CNT + l * 32;
#pragma unroll 1
    for (int m0 = gw; m0 < NTOK; m0 += 4 * NGW) {
        int s0[4], s1[4]; float g0[4], g1[4], rs[4]; v4u a[4], c[4];
#pragma unroll
        for (int k = 0; k < 4; ++k) { const int m = m0 + k * NGW; const bool ok = m < NTOK; const int mm = ok ? m : m0;
            const int e0 = TOKE[mm * 2], e1 = TOKE[mm * 2 + 1], p0 = TOKP[mm * 2], p1 = TOKP[mm * 2 + 1];
            g0[k] = TOKG[mm * 2]; g1[k] = TOKG[mm * 2 + 1];
            a[k] = *(const v4u*)(HB + (size_t)mm * 1024 + lane * 8); c[k] = *(const v4u*)(HB + (size_t)mm * 1024 + 512 + lane * 8);
            rs[k] = row_rstd_full(SSQ, mm);
            s0[k] = tab[e0] + p0; s1[k] = tab[e1] + p1; }
#pragma unroll
        for (int k = 0; k < 4; ++k) { const int m = m0 + k * NGW;
            if (m < NTOK) {
                *(v4u*)(XS + (size_t)s0[k] * 1024 + lane * 8) = a[k]; *(v4u*)(XS + (size_t)s0[k] * 1024 + 512 + lane * 8) = c[k];
                *(v4u*)(XS + (size_t)s1[k] * 1024 + lane * 8) = a[k]; *(v4u*)(XS + (size_t)s1[k] * 1024 + 512 + lane * 8) = c[k];
                if (lane == 0) { SRSTD[s0[k]] = rs[k]; SRSTD[s1[k]] = rs[k]; SGATE[s0[k]] = g0[k]; SGATE[s1[k]] = g1[k]; TOKS[m * 2] = s0[k]; TOKS[m * 2 + 1] = s1[k]; } } }
    }
#pragma unroll 1
    for (int e = 0; e < 32; ++e) {
        const int c = (int)__hip_atomic_load(CNT + e, RLX_AGENT), base = tab[e], end = (e == 31 ? tab[32] : tab[e + 1]);
        for (int r = base + c + gw; r < end; r += NGW) {
            *(v4u*)(XS + (size_t)r * 1024 + lane * 8) = (v4u){0u, 0u, 0u, 0u}; *(v4u*)(XS + (size_t)r * 1024 + 512 + lane * 8) = (v4u){0u, 0u, 0u, 0u};
            if (lane == 0) { SRSTD[r] = 0.f; SGATE[r] = 0.f; }
        }
    }
}
DEV void combine_phase(Frame& F, int l, int probe = 0) {
    const int lane = F.lane; const int gw = F.vcu * NWAVES + F.wave, NGW = F.G * NWAVES;
    float* Ho = probe ? wsp<float>(F, WS_PROBE) : (float*)(GAS float*)F.out; const bf16* HBi = wsp<bf16>(F, WS_HB); bf16* HB = wsp<bf16>(F, probe ? WS_PROBE + 128 * MiB : WS_HB); float* SSQ = wsp<float>(F, probe ? WS_PROBE + 192 * MiB : WS_SSQ); const bf16* YS = wsp<bf16>(F, WS_YS); const int* TOKS = wsp<int>(F, WS_TOKS);
    const float* gf = inp(23);
#pragma unroll 1
    for (int m0 = gw; m0 < NTOK; m0 += 2 * NGW) {
        f32x4 v[2][4]; float ssum[2];
        int sl[2][2];
#pragma unroll
        for (int k = 0; k < 2; ++k) { const int m = (m0 + k * NGW < NTOK) ? m0 + k * NGW : m0; sl[k][0] = TOKS[m * 2]; sl[k][1] = TOKS[m * 2 + 1]; }
        v2u h[2][4]; v2u ya[2][4], yb[2][4];
#pragma unroll
        for (int k = 0; k < 2; ++k) { const int m = (m0 + k * NGW < NTOK) ? m0 + k * NGW : m0;
#pragma unroll
            for (int j = 0; j < 4; ++j) { const int c = lane * 4 + 256 * j;
                h[k][j] = *(const v2u*)(HBi + (size_t)m * 1024 + c);
                ya[k][j] = *(const v2u*)(YS + (size_t)sl[k][0] * 1024 + c); yb[k][j] = *(const v2u*)(YS + (size_t)sl[k][1] * 1024 + c); } }
#pragma unroll
        for (int k = 0; k < 2; ++k) { float ss = 0.f;
#pragma unroll
            for (int j = 0; j < 4; ++j) { const v2u a = ya[k][j], bq = yb[k][j]; const f32x4 hh = (f32x4){bflo(h[k][j].x), bfhi(h[k][j].x), bflo(h[k][j].y), bfhi(h[k][j].y)};
                f32x4 r; r[0] = hh[0] + (bflo(a.x) + bflo(bq.x)); r[1] = hh[1] + (bfhi(a.x) + bfhi(bq.x)); r[2] = hh[2] + (bflo(a.y) + bflo(bq.y)); r[3] = hh[3] + (bfhi(a.y) + bfhi(bq.y));
                v[k][j] = r; ss += (r[0] * r[0] + r[1] * r[1]) + (r[2] * r[2] + r[3] * r[3]); }
            ssum[k] = wave_sum(ss); }
#pragma unroll
        for (int k = 0; k < 2; ++k) { const int m = m0 + k * NGW;
            if (m < NTOK) {
                if (l == DEPTH - 1) {
                    const float rstd = 1.0f / sqrtf(ssum[k] * (1.0f / 1024.0f) + RMS_EPS);
#pragma unroll
                    for (int j = 0; j < 4; ++j) { const int c = lane * 4 + 256 * j; const f32x4 g = *(const f32x4*)(gf + c); *(f32x4*)(Ho + (size_t)m * 1024 + c) = v[k][j] * rstd * g; }
                } else {
#pragma unroll
                    for (int j = 0; j < 4; ++j) { const int c = lane * 4 + 256 * j;
                        v2u w; w.x = pk2(v[k][j][0], v[k][j][1]); w.y = pk2(v[k][j][2], v[k][j][3]); *(v2u*)(HB + (size_t)m * 1024 + c) = w; }
                    if (lane < 16) SSQ[(size_t)m * 16 + lane] = lane == 0 ? ssum[k] : 0.f;
                } } }
    }
}
#ifndef MK_ONE_LAUNCH
#define MK_ONE_LAUNCH 1
#endif
constexpr int NPH_LAYER = 13, NPHASES = 1 + DEPTH * NPH_LAYER;
struct Args { const float* in[24]; float* out; unsigned char* ws; int ph_lo, ph_hi; };
static_assert(sizeof(Args) == 24 * 8 + 8 + 8 + 8, "Args has no padding");

__global__ void __launch_bounds__(NWAVES * 64, 2) hymba_fwd(Args args) {
    extern __shared__ __attribute__((aligned(16))) unsigned char lds[];
    Frame F;
    F.lds = (LAS unsigned char*)lds; F.ldsg = lds;
    F.MISC = (volatile LAS unsigned*)(F.lds + MISC_OFF);
    F.tid = threadIdx.x; F.lane = F.tid & 63; F.wave = __builtin_amdgcn_readfirstlane(F.tid >> 6);
    F.G = gridDim.x; { const int bx = blockIdx.x; F.vcu = (F.G % 8 == 0) ? (bx % 8) * (F.G / 8) + bx / 8 : bx; }
    F.ws = args.ws; F.ctl = (gu32*)(args.ws + WS_CTL); F.out = args.out;
    if (F.tid < 64) ((LAS unsigned*)(F.lds + MISC_OFF))[F.tid] = 0u;
    __syncthreads();
    int wave0 = F.wave;
    const int lo = args.ph_lo, hi = args.ph_hi;
    XcdBarrier bar; bar.bar = (unsigned*)(F.ctl + CW_BAR); bar.x = 0; bar.st = nullptr;
    if (hi - lo > 1) bar = xcd_barrier_post((unsigned*)(F.ctl + CW_BAR), F.MISC + 8);
#ifndef PHMASK
#define PHMASK 0xFFFF
#endif
#define IN(k) (lo <= (k) && (k) < hi)
#define EN(j) ((PHMASK >> (j)) & 1)
#define RELAUNDER() do { asm volatile("" : "+s"(wave0)); unsigned z_ = 0u; asm volatile("" : "+v"(z_)); int t_ = wave0 * 64 + (int)__builtin_amdgcn_mbcnt_hi(~0u, __builtin_amdgcn_mbcnt_lo(~0u, z_)); F.tid = t_; F.lane = t_ & 63; F.wave = wave0; \
    size_t zo_ = 0; asm volatile("" : "+s"(zo_), "+s"(F.vcu), "+s"(F.G)); F.ws = args.ws + zo_; F.out = args.out + zo_; F.ctl = (gu32*)(F.ws + WS_CTL); } while (0)
#ifndef NSA_VAR
#define NSA_VAR 0
#endif
#ifndef BAR2X
#define BAR2X 0
#endif
#ifndef DUPMASK
#define DUPMASK 0
#endif
#define DUP(j) ((DUPMASK >> (j)) & 1)
#ifndef STAG_J0
#define STAG_J0 0
#endif
#ifndef STAG_MOE
#define STAG_MOE 0
#endif
#define STAGGER(ticks) do { if ((ticks) > 0 && (F.vcu & 1)) { const unsigned long long t0_ = __builtin_amdgcn_s_memrealtime(); while (__builtin_amdgcn_s_memrealtime() - t0_ < (unsigned long long)(ticks)) __builtin_amdgcn_s_sleep(32); } } while (0)
#define SEAM(k) do { if (IN(k) && IN((k) + 1)) { XcdBarrier b_ = bar; size_t zb_ = 0; asm volatile("" : "+s"(b_.x), "+s"(zb_)); b_.bar = (unsigned*)(args.ws + WS_CTL + zb_) + CW_BAR; xcd_barrier(b_); if (BAR2X) xcd_barrier(b_); } } while (0)

    if (IN(0) && EN(13)) { RELAUNDER(); p0_prologue(F); if (DUP(13)) { __syncthreads(); p0_prologue(F); } } SEAM(0);

#pragma unroll 1
    for (int l = 0; l < DEPTH; ++l) {
        const int pb = 1 + l * NPH_LAYER;
        bf16* HB = wsp<bf16>(F, WS_HB); float* SSQ = wsp<float>(F, WS_SSQ);
        if (IN(pb + 0) && EN(0)) for (int rep_ = 0; rep_ < (DUP(0) ? 2 : 1); ++rep_) { RELAUNDER(); if (rep_) __syncthreads();
            pg8::Gemm g{HB, wsp<bf16>(F, WS_WIN) + (size_t)l * NIN * 1024, NTOK, 3072, D};
            pg8::StaticOrder S; S.init(NTOK, 3072, F.G, (int)blockIdx.x);
            EpiIn E{F.ws};
            STAGGER(STAG_J0);
            pg8::gemm_phase<EpiIn, pg8::StaticOrder, true, true>(F.lds, g, S, E, F.wave);
        }
        SEAM(pb + 0);
        if (IN(pb + 1) && EN(1)) { RELAUNDER();
            compress_phase(F, l);
            hgrn_local_phase(F, l);
            conv_phase(F, l);
            kmax_phase(F, l);
            if (l == 0) memkv_phase(F);
            if (DUP(1)) { __syncthreads(); compress_phase(F, l); hgrn_local_phase(F, l); conv_phase(F, l); }
        }
        SEAM(pb + 1);
        if (IN(pb + 2) && EN(2)) { RELAUNDER(); hgrn_scan_phase(F); if (DUP(14)) hgrn_scan_phase(F, 1); nsa_phase(F, l); if (DUP(2)) { __syncthreads(); nsa_phase_t<NSA_VAR>(F, l); } }
        SEAM(pb + 2);
        if (IN(pb + 3) && EN(3)) { RELAUNDER(); hgrn_out_phase(F, l); if (DUP(3)) { __syncthreads(); hgrn_out_phase(F, l); } }
        SEAM(pb + 3);
        if (IN(pb + 4) && EN(4)) for (int rep_ = 0; rep_ < ((DUP(4) && l == 0) ? 2 : 1); ++rep_) { RELAUNDER(); if (rep_) __syncthreads();
            pg8::Gemm g{wsp<bf16>(F, WS_CAT), wsp<bf16>(F, WS_WOUT) + (size_t)l * 1024 * 1024, NTOK, D, D};
            pg8::StaticOrder S; S.init(NTOK, D, F.G, (int)blockIdx.x);
            EpiRes E{l == 0 ? inp(0) : (const float*)nullptr, HB, SSQ};
            pg8::gemm_phase<EpiRes, pg8::StaticOrder, true, true>(F.lds, g, S, E, F.wave);
        }
        SEAM(pb + 4);
        if (IN(pb + 5) && EN(5)) for (int rep_ = 0; rep_ < (DUP(5) ? 2 : 1); ++rep_) { RELAUNDER(); if (rep_) __syncthreads();
            pg8::Gemm g{HB, wsp<bf16>(F, WS_WQ) + (size_t)l * 256 * 1024, NTOK, 256, D};
            pg8::StaticOrder S; S.init(NTOK, 256, F.G, (int)blockIdx.x);
            EpiXQ E{SSQ, wsp<bf16>(F, WS_XQ)};
            pg8::gemm_phase<EpiXQ, pg8::StaticOrder, true, true>(F.lds, g, S, E, F.wave);
        }
        SEAM(pb + 5);
        if (IN(pb + 6) && EN(6)) { RELAUNDER(); cross_phase(F, l); if (DUP(6)) { __syncthreads(); cross_phase(F, l); } }
        SEAM(pb + 6);
        if (IN(pb + 7) && EN(7)) { RELAUNDER();
            pg8::Gemm g{wsp<bf16>(F, WS_XO), wsp<bf16>(F, WS_WO) + (size_t)l * 1024 * 256, NTOK, D, 256};
            pg8::StaticOrder S; S.init(NTOK, D, F.G, (int)blockIdx.x);
            EpiRes E{(const float*)nullptr, HB, SSQ};
            pg8::gemm_phase<EpiRes, pg8::StaticOrder, true, true>(F.lds, g, S, E, F.wave);
        }
        SEAM(pb + 7);
        if (IN(pb + 8) && EN(8)) { RELAUNDER(); router_phase(F, l); if (DUP(8)) router_phase(F, l, 1); }
        SEAM(pb + 8);
        if (IN(pb + 9) && EN(9)) { RELAUNDER(); gather_phase(F, l); if (DUP(9)) { __syncthreads(); gather_phase(F, l); } }
        SEAM(pb + 9);
        if (IN(pb + 10) && EN(10)) for (int rep_ = 0; rep_ < (DUP(10) ? 2 : 1); ++rep_) { RELAUNDER(); if (rep_) __syncthreads();
            const int ns = moe_tables(F, l);
            pg8::Gemm g{wsp<bf16>(F, WS_XS), wsp<bf16>(F, WS_WGU) + (size_t)l * 32 * 1024 * 1024, ns, 32 * 1024, D};
            MoeOrder S{(ns >> 8) * 4, F.G, (int)blockIdx.x, (const LAS int*)(F.lds + TAB_OFF) + 40};
            EpiGU E{wsp<float>(F, WS_SRSTD), wsp<bf16>(F, WS_ACT)};
            STAGGER(STAG_MOE);
            pg8::gemm_phase<EpiGU, MoeOrder, true, true>(F.lds, g, S, E, F.wave);
        }
        SEAM(pb + 10);
        if (IN(pb + 11) && EN(11)) for (int rep_ = 0; rep_ < (DUP(11) ? 2 : 1); ++rep_) { RELAUNDER(); if (rep_) __syncthreads();
            const int ns = moe_tables(F, l);
            pg8::Gemm g{wsp<bf16>(F, WS_ACT), wsp<bf16>(F, WS_WDN) + (size_t)l * 32 * 1024 * 512, ns, 32 * 1024, 512};
            MoeOrder S{(ns >> 8) * 4, F.G, (int)blockIdx.x, (const LAS int*)(F.lds + TAB_OFF) + 40};
            EpiDN E{wsp<float>(F, WS_SGATE), wsp<bf16>(F, WS_YS)};
            STAGGER(STAG_MOE / 2);
            pg8::gemm_phase<EpiDN, MoeOrder, true, true>(F.lds, g, S, E, F.wave);
        }
        SEAM(pb + 11);
        if (IN(pb + 12) && EN(12)) { RELAUNDER(); combine_phase(F, l); if (DUP(12)) combine_phase(F, l, 1); }
        SEAM(pb + 12);
    }
#undef IN
#undef SEAM
}

extern "C" void kernel_launch(void* const* d_in, const int* in_sizes, int n_in, void* d_out, int out_size, void* d_ws, size_t ws_size, hipStream_t stream) {
    static int grid = 0;
    if (grid == 0) {
        if (n_in != 24 || in_sizes[0] != NTOK * D || out_size != NTOK * D || ws_size < WS_END) {
            fprintf(stderr, "kernel_launch: unexpected shapes: n_in %d in0 %d out %d ws %zu (need %zu)\n", n_in, n_in > 0 ? in_sizes[0] : -1, out_size, ws_size, (size_t)WS_END); grid = -1; return; }
        int dev = 0, cus = 0, per_cu = 0;
        if (hipGetDevice(&dev) != hipSuccess || hipDeviceGetAttribute(&cus, hipDeviceAttributeMultiprocessorCount, dev) != hipSuccess) { grid = -1; return; }
        if (hipFuncSetAttribute((const void*)hymba_fwd, hipFuncAttributeMaxDynamicSharedMemorySize, LDS_BYTES) != hipSuccess) { fprintf(stderr, "kernel_launch: hipFuncSetAttribute failed\n"); grid = -1; return; }
        if (hipOccupancyMaxActiveBlocksPerMultiprocessor(&per_cu, (const void*)hymba_fwd, NWAVES * 64, LDS_BYTES) != hipSuccess || per_cu < 1)
            fprintf(stderr, "kernel_launch: note: occupancy query reports %d blocks per CU\n", per_cu);
        (void)hipGetLastError();
        grid = cus;
    }
    if (grid < 0) return;
    if (hipMemsetAsync((char*)d_ws + WS_CTL, 0, CTL_ZERO_BYTES, stream) != hipSuccess) { fprintf(stderr, "kernel_launch: memset failed\n"); return; }
    Args a{};
    for (int i = 0; i < 24; ++i) a.in[i] = (const float*)d_in[i];
    a.out = (float*)d_out; a.ws = (unsigned char*)d_ws;
#if MK_ONE_LAUNCH
    a.ph_lo = 0; a.ph_hi = NPHASES;
    hipLaunchKernelGGL(hymba_fwd, dim3(grid), dim3(NWAVES * 64), LDS_BYTES, stream, a);
#else
    for (int p = 0; p < NPHASES; ++p) { a.ph_lo = p; a.ph_hi = p + 1; hipLaunchKernelGGL(hymba_fwd, dim3(grid), dim3(NWAVES * 64), LDS_BYTES, stream, a); }
#endif
    const hipError_t le = hipPeekAtLastError();
    if (le != hipSuccess) fprintf(stderr, "kernel_launch: launch failed: %s\n", hipGetErrorName(le));
}
```

```cpp
#define MK_ONE_LAUNCH 1
#include <hip/hip_runtime.h>
#include <cstdio>
#include <cstdint>
#include <cmath>
namespace pg8 {
#define PG8_LAS __attribute__((address_space(3)))
typedef unsigned short bf16_t;
typedef short bf16x8 __attribute__((ext_vector_type(8)));
typedef float f32x4 __attribute__((ext_vector_type(4)));
typedef unsigned u32x4 __attribute__((ext_vector_type(4)));
constexpr int BM = 256, BK = 64, HALF = 128, HTB = HALF * BK * 2  , STAGE_BYTES = 8 * HTB, NXCD = 8, WGM = 8;

__host__ __device__ __forceinline__ int lds_byte(int r, int c) { const int st = (r >> 4) * 2 + (c >> 5), rr = r & 15, cc = c & 31, ob = rr * 64 + cc * 2; return st * 1024 + (ob ^ (((ob >> 9) & 1) << 5)); }
__host__ __device__ __forceinline__ void stage_rc(int b, int& R, int& C) { const int st = b / 1024, sb = b % 1024, swz = sb ^ (((sb >> 9) & 1) << 5); R = (st >> 1) * 16 + swz / 64; C = (st & 1) * 32 + (swz % 64) / 2; }
__host__ __device__ __forceinline__ int perm32(int rho) { const int n = rho >> 4, i = rho & 15; return 8 * (i >> 2) + 4 * n + (i & 3); }

struct Unit { int pm, pn; };
struct Gemm { const bf16_t* A; const bf16_t* Bt; int M, N, K; };

struct StaticOrder {
    int nM, nN, nwg, G, c;
    __host__ __device__ void init(int M, int N, int G_, int c_) { nM = M / BM; nN = N / BM; nwg = nM * nN; G = G_; c = c_; }
    __host__ __device__ bool next(int i, Unit& u) const {
        const long L = (long)i * G + c; if (L >= nwg) return false;
        int wgid = (int)L; { const int q = nwg / NXCD, r = nwg % NXCD, xcd = wgid % NXCD, off = wgid / NXCD; wgid = (xcd < r ? xcd * (q + 1) : r * (q + 1) + (xcd - r) * q) + off; }
        const int nig = WGM * nN, gid = wgid / nig, fm = gid * WGM, gsz = (nM - fm) < WGM ? (nM - fm) : WGM;
        u.pm = fm + ((wgid % nig) % gsz); u.pn = (wgid % nig) / gsz; return true;
    }
    __device__ __forceinline__ void a_ready(const Unit&) const {}
    __device__ __forceinline__ void done(const Unit&) const {}
};

__device__ __forceinline__ unsigned cvt_pk_bf16(float lo, float hi) { unsigned r; asm volatile("v_cvt_pk_bf16_f32 %0, %1, %2" : "=v"(r) : "v"(lo), "v"(hi)); return r; }
typedef float f32x2 __attribute__((ext_vector_type(2)));
template <class Epi, class Sched, bool ALIGN_EPI = false, bool SP2 = false>
__device__ __forceinline__ void gemm_phase(PG8_LAS unsigned char* lds, const Gemm g, const Sched& S, const Epi& E, int wave_id) {
    unsigned z_ = 0u; asm volatile("" : "+v"(z_)); int tid_ = wave_id * 64 + (int)__builtin_amdgcn_mbcnt_hi(~0u, __builtin_amdgcn_mbcnt_lo(~0u, z_));
    const int tid = tid_, wid = __builtin_amdgcn_readfirstlane(tid >> 6), lane = tid & 63, wr = wid >> 2, wc = wid & 3, fr = lane & 15, fq = lane >> 4;
    const int K = g.K, nt = K / BK;
    unsigned voffA[2], voffB[2];
#pragma unroll
    for (int i = 0; i < 2; ++i) { int R, C; stage_rc(tid * 16 + i * 8192, R, C); const int Rb = Epi::PERM ? ((R & ~31) + perm32(R & 31)) : R;
        voffA[i] = (unsigned)(R * K + C) * 2u; voffB[i] = (unsigned)(Rb * K + C) * 2u; }
    const size_t kstep = (size_t)(BK * 2);
    const size_t hstep = (size_t)HALF * K * 2;
    const size_t tstep = 2 * hstep;
    const unsigned ldsw = (unsigned)wid * 1024u;
    const int aoff = lds_byte(wr * 64 + fr, fq * 8), boff = lds_byte(wc * 32 + fr, fq * 8);
#define PG8_SA(b, h) (((b) * 2 + (h)) * HTB)
#define PG8_SB(b, h) ((4 + (b) * 2 + (h)) * HTB)
#define PG8_STAGE(bufoff, gbase, voff) do { _Pragma("unroll") for (int _i = 0; _i < 2; ++_i) \
        __builtin_amdgcn_global_load_lds((const unsigned*)((const char*)(gbase) + (voff)[_i]), (PG8_LAS unsigned*)(lds + (bufoff) + ldsw + _i * 8192), 16, 0, 0); } while (0)
#define PG8_LDA(dst, b, h) do { _Pragma("unroll") for (int m = 0; m < 4; ++m) _Pragma("unroll") for (int k = 0; k < 2; ++k) dst[m][k] = *(const PG8_LAS bf16x8*)(lds + PG8_SA(b, h) + aoff + m * 2048 + k * 1024); } while (0)
#define PG8_LDB(dst, b, h) do { _Pragma("unroll") for (int n = 0; n < 2; ++n) _Pragma("unroll") for (int k = 0; k < 2; ++k) dst[n][k] = *(const PG8_LAS bf16x8*)(lds + PG8_SB(b, h) + boff + n * 2048 + k * 1024); } while (0)
#define PG8_MMA(ai, bj, At, Bt) do { __builtin_amdgcn_s_setprio(1); _Pragma("unroll") for (int m = 0; m < 4; ++m) _Pragma("unroll") for (int n = 0; n < 2; ++n) _Pragma("unroll") for (int k = 0; k < 2; ++k) \
        acc[ai][bj][m][n] = __builtin_amdgcn_mfma_f32_16x16x32_bf16(Bt[n][k], At[m][k], acc[ai][bj][m][n], 0, 0, 0); __builtin_amdgcn_s_setprio(0); } while (0)
#define PG8_WAIT_V(n) asm volatile("s_waitcnt vmcnt(" #n ")" ::: "memory")
#define PG8_WAIT_L(n) asm volatile("s_waitcnt lgkmcnt(" #n ")" ::: "memory")
#define PG8_BAR __builtin_amdgcn_s_barrier()
#define PG8_SCHED __builtin_amdgcn_sched_barrier(0)
    Unit cur, nxt; int ui = 0;
    if (!S.next(0, cur)) return;
    f32x4 acc[2][2][4][2];
#pragma unroll
    for (int a = 0; a < 2; ++a)
#pragma unroll
        for (int b = 0; b < 2; ++b)
#pragma unroll
            for (int m = 0; m < 4; ++m)
#pragma unroll
                for (int n = 0; n < 2; ++n) acc[a][b][m][n] = (f32x4){0.f, 0.f, 0.f, 0.f};
    bf16x8 At[4][2], B0[2][2], B1[2][2];
    const char* cA = (const char*)g.A + (size_t)cur.pm * tstep; const char* cB = (const char*)g.Bt + (size_t)cur.pn * tstep;
    S.a_ready(cur);
    if constexpr (SP2) {
        PG8_STAGE(PG8_SB(0, 0), cB, voffB); PG8_STAGE(PG8_SB(0, 1), cB + hstep, voffB); PG8_STAGE(PG8_SA(0, 0), cA, voffA); PG8_STAGE(PG8_SA(0, 1), cA + hstep, voffA);
        if (wr == 1) PG8_BAR;
        PG8_WAIT_V(2); PG8_BAR;
        PG8_STAGE(PG8_SB(1, 0), cB + kstep, voffB); PG8_STAGE(PG8_SA(1, 0), cA + kstep, voffA); PG8_STAGE(PG8_SB(1, 1), cB + hstep + kstep, voffB);
        PG8_WAIT_V(6); PG8_BAR;
    } else {
        PG8_STAGE(PG8_SB(0, 0), cB, voffB); PG8_STAGE(PG8_SA(0, 0), cA, voffA); PG8_STAGE(PG8_SB(0, 1), cB + hstep, voffB); PG8_STAGE(PG8_SA(0, 1), cA + hstep, voffA);
        if (wr == 1) PG8_BAR;
        PG8_WAIT_V(4); PG8_BAR;
        PG8_STAGE(PG8_SB(1, 0), cB + kstep, voffB); PG8_STAGE(PG8_SA(1, 0), cA + kstep, voffA); PG8_STAGE(PG8_SB(1, 1), cB + hstep + kstep, voffB);
        PG8_WAIT_V(6); PG8_BAR;
    }
    for (;;) {
        const bool has_next = S.next(ui + 1, nxt);
        const char* nA = has_next ? (const char*)g.A + (size_t)nxt.pm * tstep : cA; const char* nB = has_next ? (const char*)g.Bt + (size_t)nxt.pn * tstep : cB;
        for (int t = 0; t < nt; t += 2) {
            const bool last = (t == nt - 2);
            const char* a1 = cA + (size_t)(t + 1) * kstep;
            const char* a2 = last ? nA : cA + (size_t)(t + 2) * kstep; const char* b2 = last ? nB : cB + (size_t)(t + 2) * kstep;
            const char* a3 = a2 + kstep; const char* b3 = b2 + kstep;
            if (last && has_next) S.a_ready(nxt);
            if constexpr (SP2) {
            PG8_LDB(B0, 0, 0); PG8_LDB(B1, 0, 1); PG8_SCHED; PG8_LDA(At, 0, 0); PG8_STAGE(PG8_SA(1, 1), a1 + hstep, voffA);
            PG8_WAIT_V(8); PG8_WAIT_L(0); PG8_BAR; PG8_MMA(0, 0, At, B0); PG8_MMA(0, 1, At, B1); PG8_BAR; PG8_SCHED;
            PG8_LDA(At, 0, 1); PG8_STAGE(PG8_SB(0, 0), b2, voffB); PG8_STAGE(PG8_SB(0, 1), b2 + hstep, voffB); PG8_STAGE(PG8_SA(0, 0), a2, voffA);
            PG8_WAIT_V(8); PG8_WAIT_L(0); PG8_BAR; PG8_MMA(1, 0, At, B0); PG8_MMA(1, 1, At, B1); PG8_BAR; PG8_SCHED;
            PG8_LDB(B0, 1, 0); PG8_LDB(B1, 1, 1); PG8_SCHED; PG8_LDA(At, 1, 0); PG8_STAGE(PG8_SA(0, 1), a2 + hstep, voffA);
            PG8_WAIT_V(8); PG8_WAIT_L(0); PG8_BAR; PG8_MMA(0, 0, At, B0); PG8_MMA(0, 1, At, B1); PG8_BAR; PG8_SCHED;
            PG8_LDA(At, 1, 1); PG8_STAGE(PG8_SB(1, 0), b3, voffB); PG8_STAGE(PG8_SB(1, 1), b3 + hstep, voffB); PG8_STAGE(PG8_SA(1, 0), a3, voffA);
            PG8_WAIT_V(8); PG8_WAIT_L(0); PG8_BAR; PG8_MMA(1, 0, At, B0); PG8_MMA(1, 1, At, B1); PG8_BAR; PG8_SCHED;
            } else {
            PG8_LDB(B0, 0, 0); PG8_SCHED; PG8_LDA(At, 0, 0); PG8_STAGE(PG8_SA(1, 1), a1 + hstep, voffA);
            PG8_WAIT_L(8); PG8_BAR; PG8_WAIT_L(0); PG8_MMA(0, 0, At, B0); PG8_BAR; PG8_SCHED;
            PG8_LDB(B1, 0, 1); PG8_STAGE(PG8_SB(0, 0), b2, voffB);
            PG8_BAR; PG8_WAIT_L(0); PG8_MMA(0, 1, At, B1); PG8_BAR;
            PG8_LDA(At, 0, 1); PG8_STAGE(PG8_SA(0, 0), a2, voffA);
            PG8_BAR; PG8_WAIT_L(0); PG8_MMA(1, 0, At, B0); PG8_BAR; PG8_SCHED;
            PG8_STAGE(PG8_SB(0, 1), b2 + hstep, voffB);
            PG8_WAIT_V(6); PG8_BAR; PG8_MMA(1, 1, At, B1); PG8_BAR;
            PG8_LDB(B0, 1, 0); PG8_SCHED; PG8_LDA(At, 1, 0); PG8_STAGE(PG8_SA(0, 1), a2 + hstep, voffA);
            PG8_WAIT_L(8); PG8_BAR; PG8_WAIT_L(0); PG8_MMA(0, 0, At, B0); PG8_BAR; PG8_SCHED;
            PG8_LDB(B1, 1, 1); PG8_STAGE(PG8_SB(1, 0), b3, voffB);
            PG8_BAR; PG8_WAIT_L(0); PG8_MMA(0, 1, At, B1); PG8_BAR;
            PG8_LDA(At, 1, 1); PG8_STAGE(PG8_SA(1, 0), a3, voffA);
            PG8_BAR; PG8_WAIT_L(0); PG8_MMA(1, 0, At, B0); PG8_BAR; PG8_SCHED;
            PG8_STAGE(PG8_SB(1, 1), b3 + hstep, voffB);
            PG8_WAIT_V(6); PG8_BAR; PG8_MMA(1, 1, At, B1); PG8_BAR;
            }
        }
        if constexpr (ALIGN_EPI) { if (wr == 0) PG8_BAR; }
        if constexpr (!Epi::AFTER_DRAIN) { E(acc, cur, wr, wc, fr, fq); S.done(cur); }
        if (!has_next) break;
#pragma unroll
        for (int a = 0; a < 2; ++a)
#pragma unroll
            for (int b = 0; b < 2; ++b)
#pragma unroll
                for (int m = 0; m < 4; ++m)
#pragma unroll
                    for (int n = 0; n < 2; ++n) acc[a][b][m][n] = (f32x4){0.f, 0.f, 0.f, 0.f};
        cur = nxt; cA = nA; cB = nB; ++ui;
        if constexpr (ALIGN_EPI) { if (wr == 1) PG8_BAR; }
    }
    PG8_WAIT_V(0);
    if constexpr (!ALIGN_EPI) { if (wr == 0) PG8_BAR; }
    PG8_BAR;
    if constexpr (Epi::AFTER_DRAIN) { E.fused(acc, cur, wr, wc, fr, fq, lds, wid, lane); S.done(cur); }
#undef PG8_SA
#undef PG8_SB
#undef PG8_STAGE
#undef PG8_LDA
#undef PG8_LDB
#undef PG8_MMA
#undef PG8_WAIT_V
#undef PG8_WAIT_L
#undef PG8_BAR
#undef PG8_SCHED
}
}
constexpr int NB = 4, T = 8192, D = 1024, NTOK = NB * T, DEPTH = 2;
constexpr int NIN = 3328;
constexpr int IN_W = 3096;
constexpr int NSLOT_MAX = 65536 + 32 * 256;
constexpr float RMS_EPS = 1e-6f;
constexpr float QSCALE = 0.125f * 1.44269504088896f;
constexpr int NWAVES = 8;

constexpr size_t MiB = 1u << 20;
constexpr size_t WS_CTL = 0, CTL_ZERO_BYTES = 1 * MiB;
constexpr size_t WS_ROPE = 1 * MiB;
constexpr size_t WS_SMALL = 3 * MiB;
constexpr size_t WS_WG = 3 * MiB + 65536;
constexpr size_t WS_SSQ = 4 * MiB;
constexpr size_t WS_WIN = 8 * MiB;
constexpr size_t WS_WOUT = 22 * MiB;
constexpr size_t WS_WQ = 26 * MiB;
constexpr size_t WS_WKV = 27 * MiB;
constexpr size_t WS_WO = 29 * MiB;
constexpr size_t WS_WR = 30 * MiB;
constexpr size_t WS_W1C = 31 * MiB;
constexpr size_t WS_W2C = 33 * MiB;
constexpr size_t WS_MEMB = 34 * MiB;
constexpr size_t WS_MK = 36 * MiB;
constexpr size_t WS_MVT = 37 * MiB;
constexpr size_t WS_WGU = 40 * MiB;
constexpr size_t WS_WDN = 168 * MiB;
constexpr size_t WS_HB = 232 * MiB;
constexpr size_t WS_Q = 296 * MiB, WS_QR = 328 * MiB, WS_KCR = 360 * MiB, WS_VCR = 368 * MiB, WS_KS = 376 * MiB, WS_KW = 384 * MiB;
constexpr size_t WS_VST = 392 * MiB, WS_VWT = 400 * MiB, WS_KCC = 408 * MiB, WS_VCT = 409 * MiB, WS_GATE = 410 * MiB;
constexpr size_t WS_CB = 414 * MiB, WS_CC = 430 * MiB, WS_CH = 446 * MiB;
constexpr size_t WS_HQ = 462 * MiB, WS_HF = 494 * MiB, WS_HI = 526 * MiB, WS_HG = 558 * MiB;
constexpr size_t WS_CAT = 590 * MiB, WS_U = 654 * MiB, WS_DEC = 686 * MiB;
constexpr size_t WS_XQ = 688 * MiB, WS_XO = 704 * MiB;
constexpr size_t WS_XS = 296 * MiB, WS_ACT = 440 * MiB, WS_YS = 512 * MiB;
constexpr size_t WS_TOKE = 720 * MiB, WS_TOKG = 721 * MiB, WS_TOKP = 722 * MiB, WS_TOKS = 723 * MiB, WS_SRSTD = 724 * MiB, WS_SGATE = 725 * MiB;
constexpr size_t WS_U2 = 728 * MiB;
constexpr size_t WS_PROBE = 760 * MiB;
constexpr size_t WS_END = 760 * MiB;
static_assert(WS_XS + (size_t)NSLOT_MAX * 1024 * 2 <= WS_ACT && WS_ACT + (size_t)NSLOT_MAX * 512 * 2 <= WS_YS && WS_YS + (size_t)NSLOT_MAX * 1024 * 2 <= WS_XQ, "moe map");
constexpr int CW_CNT = 64;
constexpr int CW_KMAX = 256;
constexpr int CW_BAR = 4096;

constexpr int RING_BYTES = 131072;
constexpr int NSA_LDS_WAVE = 10752;
constexpr int MISC_OFF = RING_BYTES;
constexpr int TAB_OFF = RING_BYTES + 512;
constexpr int LDS_BYTES = 147456;
static_assert(8 * NSA_LDS_WAVE <= RING_BYTES && TAB_OFF + 4 * (40 + 320) <= LDS_BYTES, "LDS map");

#define GAS __attribute__((address_space(1)))
#define LAS __attribute__((address_space(3)))
#define DEV __device__ __forceinline__
typedef unsigned short bf16;
typedef unsigned v4u __attribute__((ext_vector_type(4)));
typedef unsigned v2u __attribute__((ext_vector_type(2)));
typedef float f32x4 __attribute__((ext_vector_type(4)));
typedef short bf16x8 __attribute__((ext_vector_type(8)));
typedef GAS unsigned gu32;
#define RLX_AGENT __ATOMIC_RELAXED, __HIP_MEMORY_SCOPE_AGENT
#define LDS_WAIT() asm volatile("s_waitcnt lgkmcnt(0)" ::: "memory")
#define VM_WAIT() asm volatile("s_waitcnt vmcnt(0)" ::: "memory")
typedef __bf16 bf16x2_t __attribute__((ext_vector_type(2)));
typedef float f32x2_t __attribute__((ext_vector_type(2)));
DEV unsigned pk2(float lo, float hi) { const f32x2_t v = {lo, hi}; return __builtin_bit_cast(unsigned, __builtin_convertvector(v, bf16x2_t)); }
DEV unsigned f2bf(float f) { return pk2(f, 0.f) & 0xffffu; }
DEV float bf2f(unsigned short b) { return __builtin_bit_cast(float, (unsigned)b << 16); }
DEV float bflo(unsigned w) { return __builtin_bit_cast(float, w << 16); }
DEV float bfhi(unsigned w) { return __builtin_bit_cast(float, w & 0xffff0000u); }
DEV float ex2(float x) { return __builtin_amdgcn_exp2f(x); }
DEV float wave_sum(float v) {
#pragma unroll
    for (int o = 1; o < 64; o <<= 1) v += __shfl_xor(v, o);
    return v;
}
DEV f32x4 mfma16(bf16x8 a, bf16x8 b, f32x4 c) { return __builtin_amdgcn_mfma_f32_16x16x32_bf16(a, b, c, 0, 0, 0); }
DEV int slot32(int k) { return ((k >> 2) & 3) * 8 + (k >> 4) * 4 + (k & 3); }
DEV int kfrag_off(int key, int d) { return (key >> 5) * 2048 + ((((key >> 4) & 1) * 2 + (d >> 5)) * 64 + ((d >> 3) & 3) * 16 + (key & 15)) * 8 + (d & 7); }
DEV float sigmoidf_(float x) { return 1.0f / (1.0f + __expf(-x)); }
DEV float siluf_(float x) { return x / (1.0f + __expf(-x)); }
#define XB_TMO      128
#define XB_XCNT(j)  (256  + 64 * (j))
#define XB_XSUB(j)  (1280 + 64 * (j))
#define XB_XGEN(j)  (2304 + 64 * (j))
#define XB_TOP      3328
#define XB_TOPGEN   3392
#define XCD_BAR_WORDS 3456
#define XB_SPIN_CAP (1u << 18)

__device__ __forceinline__ unsigned xb_ld(unsigned* p)              { return __hip_atomic_load(p, __ATOMIC_RELAXED, __HIP_MEMORY_SCOPE_AGENT); }
__device__ __forceinline__ unsigned xb_add(unsigned* p, unsigned v) { return __hip_atomic_fetch_add(p, v, __ATOMIC_RELAXED, __HIP_MEMORY_SCOPE_AGENT); }
__device__ __forceinline__ unsigned xb_xcc_id() { return (unsigned)__builtin_amdgcn_s_getreg((3 << 11) | 20) & 0xFu; }
#define XB_SPIN(cond, bar) do { unsigned _sp = 0; while (cond) { __builtin_amdgcn_s_sleep(1); \
    if ((++_sp & 255u) == 0u) { if (xb_ld(&(bar)[XB_TMO])) break; if (_sp > XB_SPIN_CAP) { atomicAdd(&(bar)[XB_TMO], 1u); break; } } } } while (0)

struct XcdBarrier {
    unsigned* bar; unsigned x;
    volatile LAS unsigned* st;
};

__device__ __forceinline__ XcdBarrier xcd_barrier_post(unsigned* bar, volatile LAS unsigned* st) {
    XcdBarrier b; b.bar = bar; b.x = xb_xcc_id(); b.st = st;
    if (threadIdx.x == 0) (void)xb_add(&bar[XB_XCNT(b.x)], 1u);
    return b;
}
__device__ __forceinline__ void xcd_barrier_complete(unsigned* bar, unsigned x, unsigned& nloc, unsigned& nx) {
    const unsigned G = gridDim.x * gridDim.y * gridDim.z;
    unsigned sum, cnt, mine, sp = 0u;
    for (;;) {
        sum = 0u; cnt = 0u; mine = 0u;
#pragma unroll
        for (unsigned j = 0; j < 16; ++j) { const unsigned c = xb_ld(&bar[XB_XCNT(j)]); sum += c; cnt += (c > 0u) ? 1u : 0u; mine = (j == x) ? c : mine; }
        if (sum == G) break;
        __builtin_amdgcn_s_sleep(1);
        if ((++sp & 255u) == 0u) { if (xb_ld(&bar[XB_TMO])) break; if (sp > XB_SPIN_CAP) { atomicAdd(&bar[XB_TMO], 1u); break; } }
    }
    nloc = mine > 0u ? mine : 1u; nx = cnt > 0u ? cnt : 1u;
}

__device__ __forceinline__ void xcd_barrier(const XcdBarrier& b) {
    asm volatile("s_waitcnt vmcnt(0)" ::: "memory");
    __syncthreads();
    if (threadIdx.x == 0) {
        unsigned* bar = b.bar;
        __builtin_amdgcn_s_waitcnt(0);
        unsigned nloc = b.st[0], nx = b.st[1];
        if (nloc == 0u) { xcd_barrier_complete(bar, b.x, nloc, nx); b.st[0] = nloc; b.st[1] = nx; }
        const unsigned old = xb_add(&bar[XB_XSUB(b.x)], 1u);
        const unsigned gen = old / nloc;
        if (old + 1u == (gen + 1u) * nloc) {
            __builtin_amdgcn_fence(__ATOMIC_RELEASE, "agent");
            asm volatile("s_waitcnt vmcnt(0)" ::: "memory");
            const unsigned og = xb_add(&bar[XB_TOP], 1u);
            const unsigned tg = og / nx;
            if (og + 1u == (tg + 1u) * nx) xb_add(&bar[XB_TOPGEN], 1u);
            else XB_SPIN(xb_ld(&bar[XB_TOPGEN]) == tg, bar);
            __builtin_amdgcn_fence(__ATOMIC_ACQUIRE, "agent");
            xb_add(&bar[XB_XGEN(b.x)], 1u);
            asm volatile("s_waitcnt vmcnt(0)" ::: "memory");
        } else {
            XB_SPIN(xb_ld(&bar[XB_XGEN(b.x)]) == gen, bar);
            __builtin_amdgcn_fence(__ATOMIC_ACQUIRE, "agent");
            asm volatile("s_waitcnt vmcnt(0)" ::: "memory");
        }
    }
    __syncthreads();
}
DEV float row_rstd(const float* ssq, int row, int fq) {
    const f32x4 p = *(const f32x4*)(ssq + (size_t)row * 16 + fq * 4);
    float s = (p.x + p.y) + (p.z + p.w);
    s += __shfl_xor(s, 16); s += __shfl_xor(s, 32);
    return 1.0f / sqrtf(s * (1.0f / 1024.0f) + RMS_EPS);
}
DEV float row_rstd_full(const float* ssq, int row) {
    const f32x4* p = (const f32x4*)(ssq + (size_t)row * 16);
    const f32x4 a = p[0], b = p[1], c = p[2], d = p[3];
    const float s = ((a.x + a.y) + (a.z + a.w)) + ((b.x + b.y) + (b.z + b.w)) + ((c.x + c.y) + (c.z + c.w)) + ((d.x + d.y) + (d.z + d.w));
    return 1.0f / sqrtf(s * (1.0f / 1024.0f) + RMS_EPS);
}

DEV void rope4(const float* rope, int t, int i, const f32x4& v0, const f32x4& v1, float (&lo)[4], float (&hi)[4]) {
    const f32x4 c0 = *(const f32x4*)(rope + ((size_t)t * 32 + i) * 2), c1 = *(const f32x4*)(rope + ((size_t)t * 32 + i + 2) * 2);
    lo[0] = v0[0] * c0[0] - v0[1] * c0[1]; hi[0] = v0[1] * c0[0] + v0[0] * c0[1];
    lo[1] = v0[2] * c0[2] - v0[3] * c0[3]; hi[1] = v0[3] * c0[2] + v0[2] * c0[3];
    lo[2] = v1[0] * c1[0] - v1[1] * c1[1]; hi[2] = v1[1] * c1[0] + v1[0] * c1[1];
    lo[3] = v1[2] * c1[2] - v1[3] * c1[3]; hi[3] = v1[3] * c1[2] + v1[2] * c1[3];
}
struct EpiIn {
    static constexpr bool PERM = true, AFTER_DRAIN = false;
    unsigned char* ws;
    template <class Tp> DEV Tp* P(size_t off) const { return (Tp*)(GAS Tp*)(ws + off); }
    DEV void operator()(const f32x4 (&acc)[2][2][4][2], const pg8::Unit& u, int wr, int wc, int fr, int fq) const {
        asm volatile("" : "+v"(fr), "+v"(fq), "+s"(wr), "+s"(wc));
        const int pn = u.pn;
        const float* ssq = P<float>(WS_SSQ); const float* rope = P<float>(WS_ROPE);
#pragma unroll
        for (int ai = 0; ai < 2; ++ai)
#pragma unroll
            for (int m = 0; m < 4; ++m) {
                const int row = u.pm * 256 + ai * 128 + wr * 64 + m * 16 + fr;
                const float rstd = row_rstd(ssq, row, fq);
                const int t = row & (T - 1), b = row >> 13;
#pragma unroll
                for (int bj = 0; bj < 2; ++bj) {
                    const int col = bj * 128 + wc * 32 + fq * 8;
                    const f32x4 v0 = acc[ai][bj][m][0] * rstd, v1 = acc[ai][bj][m][1] * rstd;
                    if (pn < 2) {
                        const int g = pn * 256 + col, head = g >> 6, i = (g & 63) >> 1;
                        const size_t o = (size_t)row * 512 + head * 64 + i;
                        bf16* Q = P<bf16>(WS_Q);
                        v2u w;
                        w.x = pk2(v0[0] * QSCALE, v0[2] * QSCALE); w.y = pk2(v1[0] * QSCALE, v1[2] * QSCALE); *(v2u*)(Q + o) = w;
                        w.x = pk2(v0[1] * QSCALE, v0[3] * QSCALE); w.y = pk2(v1[1] * QSCALE, v1[3] * QSCALE); *(v2u*)(Q + o + 32) = w;
                    } else if (pn == 2) {
                        bf16* dst = P<bf16>((col < 128) ? WS_KCR : WS_VCR);
                        v4u w; w.x = pk2(v0[0], v0[1]); w.y = pk2(v0[2], v0[3]); w.z = pk2(v1[0], v1[1]); w.w = pk2(v1[2], v1[3]);
                        *(v4u*)(dst + (size_t)row * 128 + (col & 127)) = w;
                    } else if (pn == 3 || pn == 4) {
                        if (col < 128) {
                            bf16* dst = P<bf16>((pn == 3) ? WS_KS : WS_KW);
                            const int hkv = col >> 6, i = (col & 63) >> 1;
                            float lo[4], hi[4]; rope4(rope, t, i, v0, v1, lo, hi);
                            const size_t o = (size_t)(b * 2 + hkv) * T * 64 + kfrag_off(t, i);
                            v2u w;
                            w.x = pk2(lo[0], lo[1]); w.y = pk2(lo[2], lo[3]); *(v2u*)(dst + o) = w;
                            w.x = pk2(hi[0], hi[1]); w.y = pk2(hi[2], hi[3]); *(v2u*)(dst + o + 512) = w;
                        } else {
                            bf16* dst = P<bf16>((pn == 3) ? WS_VST : WS_VWT);
                            const int c2 = col - 128, hkv = c2 >> 6, d = c2 & 63;
                            const size_t o = (((size_t)(b * 2 + hkv) * 256 + (t >> 5)) * 64 + d) * 32 + slot32(t & 31);
#pragma unroll
                            for (int j = 0; j < 4; ++j) { dst[o + j * 32] = (bf16)f2bf(v0[j]); dst[o + (j + 4) * 32] = (bf16)f2bf(v1[j]); }
#if defined(DUPMASK) && ((DUPMASK >> 20) & 1)
                            { bf16* dst2 = P<bf16>(WS_U2) + (pn - 3) * (4u << 20);
#pragma unroll
                            for (int j = 0; j < 4; ++j) { dst2[o + j * 32] = (bf16)f2bf(v0[j]); dst2[o + (j + 4) * 32] = (bf16)f2bf(v1[j]); } }
#endif
                        }
                    } else if (pn == 9) {
                        float* dst = P<float>(WS_HF) + (size_t)row * 256 + col;
                        *(f32x4*)dst = v0; *(f32x4*)(dst + 4) = v1;
                    } else {
                        bf16* dst = (pn < 8) ? P<bf16>(WS_CB + (size_t)(pn - 5) * (WS_CC - WS_CB)) : P<bf16>(WS_HQ + (size_t)(pn - 8) * (WS_HF - WS_HQ));
                        v4u w; w.x = pk2(v0[0], v0[1]); w.y = pk2(v0[2], v0[3]); w.z = pk2(v1[0], v1[1]); w.w = pk2(v1[2], v1[3]);
                        *(v4u*)(dst + (size_t)row * 256 + col) = w;
                    }
                }
            }
    }
};

struct EpiRes {
    static constexpr bool PERM = true, AFTER_DRAIN = false;
    const float* base32; bf16* hb; float* ssq;
    DEV void operator()(const f32x4 (&acc)[2][2][4][2], const pg8::Unit& u, int wr, int wc, int fr, int fq) const {
        asm volatile("" : "+v"(fr), "+v"(fq), "+s"(wr), "+s"(wc));
#pragma unroll
        for (int ai = 0; ai < 2; ++ai)
#pragma unroll
            for (int m = 0; m < 4; ++m) {
                const int row = u.pm * 256 + ai * 128 + wr * 64 + m * 16 + fr;
                float ss = 0.f;
#pragma unroll
                for (int bj = 0; bj < 2; ++bj) {
                    const size_t o = (size_t)row * 1024 + u.pn * 256 + bj * 128 + wc * 32 + fq * 8;
                    f32x4 v0, v1;
                    if (base32) { v0 = *(const f32x4*)(base32 + o); v1 = *(const f32x4*)(base32 + o + 4); }
                    else { const v4u hw = *(const v4u*)(hb + o); v0 = (f32x4){bflo(hw.x), bfhi(hw.x), bflo(hw.y), bfhi(hw.y)}; v1 = (f32x4){bflo(hw.z), bfhi(hw.z), bflo(hw.w), bfhi(hw.w)}; }
                    v0 = v0 + acc[ai][bj][m][0]; v1 = v1 + acc[ai][bj][m][1];
                    v4u w; w.x = pk2(v0[0], v0[1]); w.y = pk2(v0[2], v0[3]); w.z = pk2(v1[0], v1[1]); w.w = pk2(v1[2], v1[3]);
                    *(v4u*)(hb + o) = w;
                    ss += ((v0[0] * v0[0] + v0[1] * v0[1]) + (v0[2] * v0[2] + v0[3] * v0[3])) + ((v1[0] * v1[0] + v1[1] * v1[1]) + (v1[2] * v1[2] + v1[3] * v1[3]));
                }
                ss += __shfl_xor(ss, 16); ss += __shfl_xor(ss, 32);
                if (fq == 0) ssq[(size_t)row * 16 + u.pn * 4 + wc] = ss;
            }
    }
};

struct EpiXQ {
    static constexpr bool PERM = true, AFTER_DRAIN = false;
    const float* ssq; bf16* XQ;
    DEV void operator()(const f32x4 (&acc)[2][2][4][2], const pg8::Unit& u, int wr, int wc, int fr, int fq) const {
        asm volatile("" : "+v"(fr), "+v"(fq), "+s"(wr), "+s"(wc));
#pragma unroll
        for (int ai = 0; ai < 2; ++ai)
#pragma unroll
            for (int m = 0; m < 4; ++m) {
                const int row = u.pm * 256 + ai * 128 + wr * 64 + m * 16 + fr;
                const float sc = row_rstd(ssq, row, fq) * QSCALE;
#pragma unroll
                for (int bj = 0; bj < 2; ++bj) {
                    const f32x4 v0 = acc[ai][bj][m][0] * sc, v1 = acc[ai][bj][m][1] * sc;
                    v4u w; w.x = pk2(v0[0], v0[1]); w.y = pk2(v0[2], v0[3]); w.z = pk2(v1[0], v1[1]); w.w = pk2(v1[2], v1[3]);
                    *(v4u*)(XQ + (size_t)row * 256 + bj * 128 + wc * 32 + fq * 8) = w;
                }
            }
    }
};

struct EpiGU {
    static constexpr bool PERM = true, AFTER_DRAIN = false;
    const float* srstd; bf16* ACT;
    DEV void operator()(const f32x4 (&acc)[2][2][4][2], const pg8::Unit& u, int wr, int wc, int fr, int fq) const {
        asm volatile("" : "+v"(fr), "+v"(fq), "+s"(wr), "+s"(wc));
        const int nt = u.pn & 3;
#pragma unroll
        for (int ai = 0; ai < 2; ++ai)
#pragma unroll
            for (int m = 0; m < 4; ++m) {
                const int row = u.pm * 256 + ai * 128 + wr * 64 + m * 16 + fr;
                const float rs = srstd[row];
#pragma unroll
                for (int bj = 0; bj < 2; ++bj) {
                    const f32x4 v0 = acc[ai][bj][m][0] * rs, v1 = acc[ai][bj][m][1] * rs;
                    const int j = (nt * 256 + bj * 128 + wc * 32 + fq * 8) >> 1;
                    v2u w; w.x = pk2(siluf_(v0[0]) * v0[1], siluf_(v0[2]) * v0[3]); w.y = pk2(siluf_(v1[0]) * v1[1], siluf_(v1[2]) * v1[3]);
                    *(v2u*)(ACT + (size_t)row * 512 + j) = w;
                }
            }
    }
};

struct EpiDN {
    static constexpr bool PERM = true, AFTER_DRAIN = false;
    const float* sgate; bf16* YS;
    DEV void operator()(const f32x4 (&acc)[2][2][4][2], const pg8::Unit& u, int wr, int wc, int fr, int fq) const {
        asm volatile("" : "+v"(fr), "+v"(fq), "+s"(wr), "+s"(wc));
        const int nt = u.pn & 3;
#pragma unroll
        for (int ai = 0; ai < 2; ++ai)
#pragma unroll
            for (int m = 0; m < 4; ++m) {
                const int row = u.pm * 256 + ai * 128 + wr * 64 + m * 16 + fr;
                const float gt = sgate[row];
#pragma unroll
                for (int bj = 0; bj < 2; ++bj) {
                    const f32x4 v0 = acc[ai][bj][m][0] * gt, v1 = acc[ai][bj][m][1] * gt;
                    v4u w; w.x = pk2(v0[0], v0[1]); w.y = pk2(v0[2], v0[3]); w.z = pk2(v1[0], v1[1]); w.w = pk2(v1[2], v1[3]);
                    *(v4u*)(YS + (size_t)row * 1024 + nt * 256 + bj * 128 + wc * 32 + fq * 8) = w;
                }
            }
    }
};

struct MoeOrder {
    int nunits, G, c; const LAS int* tileE;
    DEV bool next(int i, pg8::Unit& u) const {
        const int L = i * G + c; if (L >= nunits) return false;
        const int rt = L >> 2; u.pm = rt; u.pn = tileE[rt] * 4 + (L & 3); return true;
    }
    DEV void a_ready(const pg8::Unit&) const {}
    DEV void done(const pg8::Unit&) const {}
};
struct Frame {
    LAS unsigned char* lds;
    unsigned char* ldsg;
    volatile LAS unsigned* MISC;
    gu32* ctl;
    unsigned char* ws;
    int tid, lane, wave, vcu, G;
    float* out;
};
template <class Tp> DEV Tp* wsp(const Frame& F, size_t off) { return (Tp*)(F.ws + off); }
DEV const float* inp(int i) { const float* const* ka = (const float* const*)__builtin_amdgcn_kernarg_segment_ptr(); asm volatile("" : "+s"(i)); return (const float*)(const GAS float*)ka[i]; }

template <class Map>
DEV void tr_item(const float* W, int K, int Nsrc, const float* gain, bf16* WT, float* scr, int item, int lane, Map map) {
    const int nblk = (Nsrc + 31) >> 5, kb = item / nblk, nb = item - kb * nblk, k0 = 64 * kb, n0 = 32 * nb;
    {
        const int nq = (lane & 7) * 4; f32x4 v[8];
#pragma unroll
        for (int i = 0; i < 8; ++i) { const int kk = 8 * i + (lane >> 3);
            v[i] = (n0 + nq < Nsrc) ? *(const f32x4*)(W + (size_t)(k0 + kk) * Nsrc + n0 + nq) : (f32x4){0.f, 0.f, 0.f, 0.f}; }
#pragma unroll
        for (int i = 0; i < 8; ++i) { const int kk = 8 * i + (lane >> 3); const float g = gain ? gain[k0 + kk] : 1.0f; float* s = scr + kk * 33 + nq;
            s[0] = v[i][0] * g; s[1] = v[i][1] * g; s[2] = v[i][2] * g; s[3] = v[i][3] * g; }
    }
    LDS_WAIT();
    const int c = lane & 7;
#pragma unroll
    for (int j = 0; j < 4; ++j) {
        const int n = (lane >> 3) + 8 * j; const float* s = scr + (8 * c) * 33 + n;
        if (n0 + n < Nsrc) {
            v4u o; o.x = pk2(s[0 * 33], s[1 * 33]); o.y = pk2(s[2 * 33], s[3 * 33]); o.z = pk2(s[4 * 33], s[5 * 33]); o.w = pk2(s[6 * 33], s[7 * 33]);
            *(v4u*)(WT + (size_t)map(n0 + n) * K + k0 + 8 * c) = o;
        }
    }
    LDS_WAIT();
}
template <class Map>
DEV void tr_experts(const float* W, int K, int Nsrc, const float* gain, bf16* WT, bf16* scr, int gw, int NGW, int lane, Map map) {
    const int nblk = Nsrc >> 6, per_e = (K >> 6) * nblk, NIT = 32 * per_e; const size_t esz = (size_t)K * Nsrc;
#pragma unroll 1
    for (int it = gw; it < NIT; it += NGW) {
        const int e = it / per_e, sub = it - e * per_e, kb = sub / nblk, nb = sub - kb * nblk, k0 = 64 * kb, n0 = 64 * nb, nq = (lane & 15) * 4;
        const float* Wp = W + (size_t)e * esz; bf16* Wo = WT + (size_t)e * esz;
        f32x4 v[16];
#pragma unroll
        for (int i = 0; i < 16; ++i) v[i] = *(const f32x4*)(Wp + (size_t)(k0 + 4 * i + (lane >> 4)) * Nsrc + n0 + nq);
#pragma unroll
        for (int i = 0; i < 16; ++i) { const int kk = 4 * i + (lane >> 4); const float g = gain ? gain[k0 + kk] : 1.0f;
            v2u w; w.x = pk2(v[i][0] * g, v[i][1] * g); w.y = pk2(v[i][2] * g, v[i][3] * g);
            *(v2u*)(scr + kk * 68 + nq) = w; }
        LDS_WAIT();
        const int cc = lane & 7;
#pragma unroll
        for (int j = 0; j < 8; ++j) { const int n = (lane >> 3) + 8 * j; const bf16* s = scr + (8 * cc) * 68 + n;
            v4u o; o.x = (unsigned)s[0] | ((unsigned)s[68] << 16); o.y = (unsigned)s[2 * 68] | ((unsigned)s[3 * 68] << 16);
            o.z = (unsigned)s[4 * 68] | ((unsigned)s[5 * 68] << 16); o.w = (unsigned)s[6 * 68] | ((unsigned)s[7 * 68] << 16);
            *(v4u*)(Wo + (size_t)map(n0 + n) * K + k0 + 8 * cc) = o; }
        LDS_WAIT();
    }
}
struct MapId { DEV int operator()(int n) const { return n; } };
struct MapIn {
    DEV int operator()(int n) const {
        if (n < 512) { const int d = n & 63; return (n & ~63) + 2 * (d & 31) + (d >> 5); }
        if (n < 768) return n;
        if (n < 1280) { const int r = n - 768; if ((r & 255) < 128) { const int d = r & 63; return 768 + (r & ~63) + 2 * (d & 31) + (d >> 5); } return n; }
        if (n < 1304) return 3072 + (n - 1280);
        return n - 24;
    }
};
struct MapGU { DEV int operator()(int n) const { return n < 512 ? 2 * n : 2 * (n - 512) + 1; } };

DEV void convert_experts(Frame& F, int l, bf16* scr, int part) {
    unsigned zl_ = 0u; asm volatile("" : "+v"(zl_)); const int lane = (int)__builtin_amdgcn_mbcnt_hi(~0u, __builtin_amdgcn_mbcnt_lo(~0u, zl_));
    const int gw = F.vcu * NWAVES + F.wave, NGW = F.G * NWAVES;
    if (part == 0) tr_experts(inp(17) + (size_t)l * 32 * 1024 * 1024, 1024, 1024, inp(22) + l * 1024, wsp<bf16>(F, WS_WGU) + (size_t)l * 32 * 1024 * 1024, scr, gw, NGW, lane, MapGU());
    else tr_experts(inp(18) + (size_t)l * 32 * 512 * 1024, 512, 1024, nullptr, wsp<bf16>(F, WS_WDN) + (size_t)l * 32 * 1024 * 512, scr, gw, NGW, lane, MapId());
}
DEV void p0_prologue(Frame& F) {
    float* scr = (float*)(F.ldsg + F.wave * 16384);
    const int gw = F.vcu * NWAVES + F.wave, NGW = F.G * NWAVES, lane = F.lane;
    for (int l = 0; l < DEPTH; ++l) {
        { const int NIT = 16 * 97; bf16* dst = wsp<bf16>(F, WS_WIN) + (size_t)l * NIN * 1024;
          for (int it = gw; it < NIT; it += NGW) tr_item(inp(2) + (size_t)l * 1024 * IN_W, 1024, IN_W, inp(19) + l * 1024, dst, scr, it, lane, MapIn());
          for (int i = gw * 64 + lane; i < (NIN - 3096) * 1024 / 8; i += NGW * 64) ((v4u*)(dst + (size_t)3096 * 1024))[i] = (v4u){0u, 0u, 0u, 0u}; }
        { const int NIT = 16 * 32; for (int it = gw; it < NIT; it += NGW) tr_item(inp(9) + (size_t)l * 1024 * 1024, 1024, 1024, nullptr, wsp<bf16>(F, WS_WOUT) + (size_t)l * 1024 * 1024, scr, it, lane, MapId()); }
        { const int NIT = 16 * 8; for (int it = gw; it < NIT; it += NGW) tr_item(inp(10) + (size_t)l * 1024 * 256, 1024, 256, inp(20) + l * 1024, wsp<bf16>(F, WS_WQ) + (size_t)l * 256 * 1024, scr, it, lane, MapId()); }
        { const int NIT = 16 * 16; for (int it = gw; it < NIT; it += NGW) tr_item(inp(11) + (size_t)l * 1024 * 512, 1024, 512, inp(21) + l * 1024, wsp<bf16>(F, WS_WKV) + (size_t)l * 512 * 1024, scr, it, lane, MapId()); }
        { const int NIT = 4 * 32; for (int it = gw; it < NIT; it += NGW) tr_item(inp(12) + (size_t)l * 256 * 1024, 256, 1024, nullptr, wsp<bf16>(F, WS_WO) + (size_t)l * 1024 * 256, scr, it, lane, MapId()); }
        for (int kv = 0; kv < 2; ++kv) {
            { const int NIT = 32 * 4; for (int it = gw; it < NIT; it += NGW) tr_item(inp(5) + (size_t)(l * 2 + kv) * 2048 * 128, 2048, 128, nullptr, wsp<bf16>(F, WS_W1C) + (size_t)(l * 2 + kv) * 128 * 2048, scr, it, lane, MapId()); }
            { const int NIT = 2 * 2; for (int it = gw; it < NIT; it += NGW) tr_item(inp(6) + (size_t)(l * 2 + kv) * 128 * 64, 128, 64, nullptr, wsp<bf16>(F, WS_W2C) + (size_t)(l * 2 + kv) * 64 * 128, scr, it, lane, MapId()); }
        }
        if (F.G != 256) { convert_experts(F, l, (bf16*)scr, 0); convert_experts(F, l, (bf16*)scr, 1); }
        { bf16* dst = wsp<bf16>(F, WS_WR) + (size_t)l * 96 * 1024; const float* gn = inp(22) + l * 1024;
          for (int i = gw * 64 + lane; i < 48 * 1024; i += NGW * 64) { const int n = i >> 10, k = i & 1023;
            float v = 0.f; if (n < 4) v = inp(13)[(size_t)(l * 1024 + k) * 4 + n]; else if (n < 36) v = inp(15)[(size_t)(l * 1024 + k) * 32 + (n - 4)];
            v *= gn[k]; const unsigned h = f2bf(v); dst[i] = (bf16)h; dst[i + 48 * 1024] = (bf16)f2bf(v - bf2f((unsigned short)h)); } }
    }
    { bf16* wg = wsp<bf16>(F, WS_WG);
      for (int i = gw * 64 + lane; i < DEPTH * 32 * 1024; i += NGW * 64) { const int l2 = i >> 15, row = (i >> 10) & 31, k = i & 1023, hk = row >> 4, gi = row & 15;
        const float v = gi < 12 ? inp(2)[((size_t)l2 * 1024 + k) * IN_W + 1280 + hk * 12 + gi] * inp(19)[l2 * 1024 + k] : 0.f;
        wg[i] = (bf16)f2bf(v); } }
    { float* rope = wsp<float>(F, WS_ROPE);
      for (int i = gw * 64 + lane; i < T * 32; i += NGW * 64) { const int t = i >> 5, k = i & 31;
        const float inv = powf(10000.0f, -(float)k / 32.0f); const float ang = (float)t * inv;
        rope[2 * i] = cosf(ang); rope[2 * i + 1] = sinf(ang); } }
    { float* b1 = wsp<float>(F, WS_SMALL);
      for (int i = gw * 64 + lane; i < 4 * 128; i += NGW * 64) { const int lk = i >> 7, n = i & 127;
        const float* pe = inp(4) + (size_t)lk * 2048; const float* w1 = inp(5) + (size_t)lk * 2048 * 128 + n; float s = 0.f;
        for (int kk = 0; kk < 2048; ++kk) s += pe[kk] * w1[(size_t)kk * 128];
        b1[i] = s; } }
    { bf16* HB = wsp<bf16>(F, WS_HB); float* SSQ = wsp<float>(F, WS_SSQ); bf16* MB = wsp<bf16>(F, WS_MEMB); float* SSQM = wsp<float>(F, WS_SMALL) + 1024;
      for (int m = gw; m < NTOK + NB * 256; m += NGW) {
        const bool ism = m >= NTOK; const int r = ism ? m - NTOK : m;
        const f32x4* xr = (const f32x4*)((ism ? inp(1) : inp(0)) + (size_t)r * 1024) + lane;
        unsigned long long* o8 = (unsigned long long*)((ism ? MB : HB) + (size_t)r * 1024) + lane;
        float s = 0.f;
#pragma unroll
        for (int j = 0; j < 4; ++j) { const f32x4 v = xr[64 * j]; s += (v.x * v.x + v.y * v.y) + (v.z * v.z + v.w * v.w);
            o8[64 * j] = (unsigned long long)pk2(v.x, v.y) | ((unsigned long long)pk2(v.z, v.w) << 32); }
        s = wave_sum(s);
        if (ism) { if (lane == 0) SSQM[r] = s; }
        else if (lane < 16) SSQ[(size_t)r * 16 + lane] = lane == 0 ? s : 0.f;
      } }
}

template <int NT>
DEV void skinny16(const bf16* A, size_t lda, const bf16* Bt, size_t ldb, int K, int lane, f32x4 (&acc)[NT]) {
    const int l16 = lane & 15, g4 = lane >> 4;
    const bf16* ap = A + (size_t)l16 * lda + g4 * 8; const bf16* bp = Bt + (size_t)l16 * ldb + g4 * 8;
#pragma unroll
    for (int n = 0; n < NT; ++n) acc[n] = (f32x4){0.f, 0.f, 0.f, 0.f};
#pragma unroll 2
    for (int k = 0; k < K; k += 32) {
        const bf16x8 a = *(const bf16x8*)(ap + k);
#pragma unroll
        for (int n = 0; n < NT; ++n) { const bf16x8 b = *(const bf16x8*)(bp + (size_t)n * 16 * ldb + k); acc[n] = mfma16(a, b, acc[n]); }
    }
}

DEV void memkv_phase(Frame& F) {
    const int gw = F.vcu * NWAVES + F.wave, NGW = F.G * NWAVES, lane = F.lane, l16 = lane & 15, g4 = lane >> 4;
    const bf16* MB = wsp<bf16>(F, WS_MEMB); const float* SSQM = wsp<float>(F, WS_SMALL) + 1024;
    bf16* MK = wsp<bf16>(F, WS_MK); bf16* MVT = wsp<bf16>(F, WS_MVT);
    for (int task = gw; task < 1024; task += NGW) {
        const int l2 = task >> 9, rt = (task >> 3) & 63, chunk = task & 7;
        f32x4 acc[4];
        skinny16<4>(MB + (size_t)rt * 16 * 1024, 1024, wsp<bf16>(F, WS_WKV) + ((size_t)l2 * 512 + chunk * 64) * 1024, 1024, 1024, lane, acc);
        const int b = rt >> 4, key0 = (rt & 15) * 16 + g4 * 4;
        float rs[4];
#pragma unroll
        for (int r = 0; r < 4; ++r) rs[r] = 1.0f / sqrtf(SSQM[rt * 16 + g4 * 4 + r] * (1.0f / 1024.0f) + RMS_EPS);
#pragma unroll
        for (int nt = 0; nt < 4; ++nt) {
            const int n = chunk * 64 + nt * 16 + l16;
            if (chunk < 4) { const int head = n >> 6, d = n & 63;
#pragma unroll
                for (int r = 0; r < 4; ++r) MK[(size_t)((l2 * 4 + b) * 4 + head) * 256 * 64 + kfrag_off(key0 + r, d)] = (bf16)f2bf(acc[nt][r] * rs[r]);
            } else { const int n2 = n - 256, head = n2 >> 6, d = n2 & 63;
                v2u w; w.x = pk2(acc[nt][0] * rs[0], acc[nt][1] * rs[1]); w.y = pk2(acc[nt][2] * rs[2], acc[nt][3] * rs[3]);
                *(v2u*)(MVT + (((size_t)((l2 * 4 + b) * 4 + head) * 8 + (key0 >> 5)) * 64 + d) * 32 + slot32(key0 & 31)) = w; }
        }
    }
}

DEV void compress_phase(Frame& F, int l) {
    const int lane = F.lane, l16 = lane & 15, g4 = lane >> 4, quad = F.wave >> 2, q = F.wave & 3;
    float* part = (float*)F.ldsg + quad * (4 * 16 * 128);
    const bf16* KCR = wsp<bf16>(F, WS_KCR); const bf16* VCR = wsp<bf16>(F, WS_VCR);
    bf16* KCC = wsp<bf16>(F, WS_KCC); bf16* VCT = wsp<bf16>(F, WS_VCT);
    const float* bias1 = wsp<float>(F, WS_SMALL);
    for (int tk0 = F.vcu * 2; tk0 < 512; tk0 += F.G * 2) {
        const int tk = tk0 + quad; const int kv = tk >> 8, tile = tk & 255;
        const bf16* raw = kv ? VCR : KCR;
        const bf16* w1 = wsp<bf16>(F, WS_W1C) + (size_t)(l * 2 + kv) * 128 * 2048;
        const bf16* w2 = wsp<bf16>(F, WS_W2C) + (size_t)(l * 2 + kv) * 64 * 128;
        { const int r = tile * 16 + l16, bh = r >> 9, c = r & 511, b = bh >> 1, hkv = bh & 1;
          f32x4 acc[8];
#pragma unroll
          for (int n = 0; n < 8; ++n) acc[n] = (f32x4){0.f, 0.f, 0.f, 0.f};
#pragma unroll 2
          for (int ks = q * 16; ks < q * 16 + 16; ++ks) {
              const int kk = ks * 32 + g4 * 8, ll = kk >> 6, d = kk & 63;
              int tok = 16 * c + ll; tok = tok > T - 1 ? T - 1 : tok;
              const bf16x8 a = *(const bf16x8*)(raw + ((size_t)b * T + tok) * 128 + hkv * 64 + d);
#pragma unroll
              for (int n = 0; n < 8; ++n) { const bf16x8 bb = *(const bf16x8*)(w1 + (size_t)(n * 16 + l16) * 2048 + kk); acc[n] = mfma16(a, bb, acc[n]); }
          }
#pragma unroll
          for (int n = 0; n < 8; ++n)
#pragma unroll
              for (int r2 = 0; r2 < 4; ++r2) part[(q * 16 + g4 * 4 + r2) * 128 + n * 16 + l16] = acc[n][r2];
        }
        __syncthreads();
        { f32x4 o = (f32x4){0.f, 0.f, 0.f, 0.f};
#pragma unroll
          for (int k2 = 0; k2 < 4; ++k2) {
              const int h0 = k2 * 32 + g4 * 8;
              float hv[8];
#pragma unroll
              for (int j = 0; j < 8; ++j) { float s = bias1[(l * 2 + kv) * 128 + h0 + j];
#pragma unroll
                  for (int p = 0; p < 4; ++p) s += part[(p * 16 + l16) * 128 + h0 + j];
                  hv[j] = siluf_(s); }
              bf16x8 a; { v4u w; w.x = pk2(hv[0], hv[1]); w.y = pk2(hv[2], hv[3]); w.z = pk2(hv[4], hv[5]); w.w = pk2(hv[6], hv[7]); a = __builtin_bit_cast(bf16x8, w); }
              const bf16x8 bb = *(const bf16x8*)(w2 + (size_t)(q * 16 + l16) * 128 + h0);
              o = mfma16(a, bb, o);
          }
          const int r0 = tile * 16 + g4 * 4, bh = r0 >> 9, c0 = r0 & 511, d = q * 16 + l16;
          if (kv == 0) {
#pragma unroll
              for (int r2 = 0; r2 < 4; ++r2) KCC[(size_t)bh * 512 * 64 + kfrag_off(c0 + r2, d)] = (c0 + r2 == 511) ? (bf16)0 : (bf16)f2bf(o[r2]);
          } else {
              v2u w; w.x = pk2(o[0], o[1]); w.y = pk2(o[2], (c0 + 3 == 511) ? 0.f : o[3]);
              *(v2u*)(VCT + (((size_t)bh * 16 + (c0 >> 5)) * 64 + d) * 32 + slot32(c0 & 31)) = w;
          }
        }
        __syncthreads();
    }
}

DEV float hgrn_lb(const Frame& F, int l, int c) {
    if (l == 0) return 0.f;
    const float a = inp(7)[c], b = inp(7)[256 + c];
    return 1.0f / (1.0f + expf(a - b));
}
DEV float hgrn_logf(float z, float lb) {
    const float la = logf(fmaxf(lb, 1e-30f));
    const float ls = fminf(z, 0.f) - log1pf(expf(-fabsf(z)));
    const float lc = log1pf(-lb) + ls;
    const float mx = fmaxf(la, lc), mn = fminf(la, lc);
    return mx + log1pf(expf(mn - mx));
}
constexpr int HS = 68;
DEV f32x4 mfma4(float a, float b, f32x4 c) { return __builtin_amdgcn_mfma_f32_16x16x4f32(a, b, c, 0, 0, 0); }
DEV void hgrn_setup_chunk(Frame& F, float lb, const float (&z)[8], float* Bc, float* Kc, float* tot) {
    const int d = F.tid & 63, sg = F.tid >> 6;
    const float la = logf(fmaxf(lb, 1e-30f)), l1m = log1pf(-lb), onem = 1.0f - lb;
    float loc[8], kv[8]; float run = 0.f;
#pragma unroll
    for (int i = 0; i < 8; ++i) {
        const float ez = __expf(-fabsf(z[i]));
        const float lc = l1m + (fminf(z[i], 0.f) - __logf(1.0f + ez));
        const float mx = fmaxf(la, lc), mn = fminf(la, lc);
        run += mx + __logf(1.0f + __expf(mn - mx)); loc[i] = run;
        kv[i] = onem * (z[i] >= 0.f ? ez : 1.0f) / (1.0f + ez);
    }
    tot[sg * 64 + d] = run;
    __syncthreads();
    float off = 0.f;
    for (int g = 0; g < sg; ++g) off += tot[g * 64 + d];
#pragma unroll
    for (int i = 0; i < 8; ++i) { Bc[(sg * 8 + i) * HS + d] = off + loc[i]; Kc[(sg * 8 + i) * HS + d] = kv[i]; }
    __syncthreads();
}
DEV void hgrn_local_phase(Frame& F, int l) {
    float* Bc = (float*)F.ldsg; float* Kc = Bc + 64 * HS; float* Vc = Kc + 64 * HS; float* tot = Vc + 64 * HS;
    bf16* U = wsp<bf16>(F, WS_U); float* DEC = wsp<float>(F, WS_DEC);
    const int lane = F.lane, w = F.wave, li = lane & 15, kq = lane >> 4;
    for (int task = F.vcu; task < 2048; task += F.G) {
        const int bh = task >> 7, ch = task & 127, b = bh >> 2, h = bh & 3;
        { const int d = F.tid & 63, sg = F.tid >> 6;
          const size_t go = ((size_t)b * T + ch * 64 + sg * 8) * 256 + h * 64 + d;
          const float* HFp = wsp<float>(F, WS_HF) + go; const bf16* HIp = wsp<bf16>(F, WS_HI) + go;
          float z[8], vi[8];
#pragma unroll
          for (int i = 0; i < 8; ++i) { z[i] = HFp[(size_t)i * 256]; vi[i] = bf2f(HIp[(size_t)i * 256]); }
          hgrn_setup_chunk(F, hgrn_lb(F, l, h * 64 + d), z, Bc, Kc, tot);
          const float bl = Bc[63 * HS + d];
#pragma unroll
          for (int i = 0; i < 8; ++i) { const int s = sg * 8 + i; Kc[s * HS + d] *= __expf(bl - Bc[s * HS + d]); Vc[s * HS + d] = vi[i]; }
          if (sg == 0) DEC[(size_t)task * 64 + d] = expf(bl); }
        __syncthreads();
        { const int dI = w >> 1, e0 = (w & 1) * 32;
          f32x4 a0 = (f32x4){0.f, 0.f, 0.f, 0.f}, a1 = a0;
#pragma unroll 4
          for (int k0 = 0; k0 < 64; k0 += 4) { const int s = k0 + kq;
              const float a = Kc[s * HS + dI * 16 + li], b0 = Vc[s * HS + e0 + li], b1 = Vc[s * HS + e0 + 16 + li];
              a0 = mfma4(a, b0, a0); a1 = mfma4(a, b1, a1); }
#pragma unroll
          for (int r = 0; r < 4; ++r) { bf16* up = U + ((size_t)task * 64 + dI * 16 + 4 * kq + r) * 64 + e0 + li; up[0] = (bf16)f2bf(a0[r]); up[16] = (bf16)f2bf(a1[r]); } }
        __syncthreads();
    }
}
DEV void hgrn_scan_phase(Frame& F, int probe = 0) {
    const bf16* U = wsp<bf16>(F, WS_U); bf16* U2 = wsp<bf16>(F, probe ? WS_PROBE : WS_U2); const float* DEC = wsp<float>(F, WS_DEC);
    const int nact = (F.G * 256 >= 65536) ? 256 : 512;
    if (F.tid < nact)
    for (int gid = F.vcu * nact + F.tid; gid < 65536; gid += F.G * nact) {
        const int bh = gid >> 12, de = gid & 4095, d = de >> 6;
        float S = 0.f; const bf16* up = U + (size_t)bh * 128 * 4096 + de; bf16* op = U2 + (size_t)bh * 128 * 4096 + de; const float* dp = DEC + (size_t)bh * 128 * 64 + d;
#pragma unroll 16
        for (int ch = 0; ch < 128; ++ch) { const float u = bf2f(up[(size_t)ch * 4096]); const float dc = dp[ch * 64]; op[(size_t)ch * 4096] = (bf16)f2bf(S); S = dc * S + u; }
    }
}
DEV void hgrn_out_phase(Frame& F, int l) {
    float* Bc = (float*)F.ldsg; float* Kb = Bc + 64 * HS; float* Vc = Kb + 64 * HS; float* Qs = Vc + 64 * HS; float* Sc = Qs + 64 * HS; float* Ac = Sc + 64 * HS; float* tot = Ac + 64 * HS;
    float* Oc = Kb;
    const bf16* U = wsp<bf16>(F, WS_U2); bf16* CAT = wsp<bf16>(F, WS_CAT);
    const int lane = F.lane, w = F.wave, li = lane & 15, kq = lane >> 4;
    for (int task = F.vcu; task < 2048; task += F.G) {
        const int bh = task >> 7, ch = task & 127, b = bh >> 2, h = bh & 3;
        float gv[8];
        { const int d = F.tid & 63, sg = F.tid >> 6;
          const size_t go = ((size_t)b * T + ch * 64 + sg * 8) * 256 + h * 64 + d;
          const float* HFp = wsp<float>(F, WS_HF) + go; const bf16* HIp = wsp<bf16>(F, WS_HI) + go; const bf16* HQp = wsp<bf16>(F, WS_HQ) + go; const bf16* HGp = wsp<bf16>(F, WS_HG) + go;
          const bf16* Up = U + ((size_t)task * 64 + sg * 8) * 64 + d;
          float z[8], vi[8], qi[8], si[8];
#pragma unroll
          for (int i = 0; i < 8; ++i) { z[i] = HFp[(size_t)i * 256]; vi[i] = bf2f(HIp[(size_t)i * 256]); qi[i] = bf2f(HQp[(size_t)i * 256]); gv[i] = bf2f(HGp[(size_t)i * 256]); si[i] = bf2f(Up[(size_t)i * 64]); }
          hgrn_setup_chunk(F, hgrn_lb(F, l, h * 64 + d), z, Bc, Kb, tot);
#pragma unroll
          for (int i = 0; i < 8; ++i) { const int s = sg * 8 + i, J = s >> 4; const float rJ = J ? Bc[(16 * J - 1) * HS + d] : 0.f;
              Kb[s * HS + d] *= __expf(fminf(rJ - Bc[s * HS + d], 80.f));
              Vc[s * HS + d] = vi[i]; Qs[s * HS + d] = qi[i] * 0.125f; Sc[s * HS + d] = si[i]; } }
        __syncthreads();
#pragma unroll 1
        for (int ti = w; ti < 10; ti += 8) {
            const int I = ti < 1 ? 0 : (ti < 3 ? 1 : (ti < 6 ? 2 : 3)), J = ti - (I * (I + 1)) / 2;
            const int t = I * 16 + li; f32x4 acc = (f32x4){0.f, 0.f, 0.f, 0.f};
#pragma unroll 4
            for (int k0 = 0; k0 < 64; k0 += 4) { const int d = k0 + kq; const float rJ = J ? Bc[(16 * J - 1) * HS + d] : 0.f;
                const float a = Qs[t * HS + d] * __expf(Bc[t * HS + d] - rJ), bb = Kb[(J * 16 + li) * HS + d];
                acc = mfma4(a, bb, acc); }
#pragma unroll
            for (int r = 0; r < 4; ++r) { const int tt = I * 16 + 4 * kq + r, ss = J * 16 + li; Ac[tt * HS + ss] = (ss <= tt) ? acc[r] : 0.f; }
        }
        __syncthreads();
        { const int I = w >> 1, e0 = (w & 1) * 32, t = I * 16 + li;
          f32x4 a0 = (f32x4){0.f, 0.f, 0.f, 0.f}, a1 = a0;
#pragma unroll 4
          for (int k0 = 0; k0 < 64; k0 += 4) { const int d = k0 + kq;
              const float a = Qs[t * HS + d] * __expf(Bc[t * HS + d]), b0 = Sc[d * HS + e0 + li], b1 = Sc[d * HS + e0 + 16 + li];
              a0 = mfma4(a, b0, a0); a1 = mfma4(a, b1, a1); }
#pragma unroll 1
          for (int s0 = 0; s0 < 16 * (I + 1); s0 += 4) { const int s = s0 + kq;
              const float a = Ac[t * HS + s], b0 = Vc[s * HS + e0 + li], b1 = Vc[s * HS + e0 + 16 + li];
              a0 = mfma4(a, b0, a0); a1 = mfma4(a, b1, a1); }
#pragma unroll
          for (int r = 0; r < 4; ++r) { float* op = Oc + (I * 16 + 4 * kq + r) * HS + e0 + li; op[0] = a0[r]; op[16] = a1[r]; } }
        __syncthreads();
        { const float ng = inp(8)[l * 256 + h * 64 + lane];
          { const int t = w * 8 + (lane >> 3); const float* op = Oc + t * HS + (lane & 7) * 8; float s = 0.f;
#pragma unroll
            for (int j = 0; j < 8; ++j) s += op[j] * op[j];
            s += __shfl_xor(s, 1); s += __shfl_xor(s, 2); s += __shfl_xor(s, 4);
            if ((lane & 7) == 0) tot[t] = 1.0f / sqrtf(s * (1.0f / 64.0f) + RMS_EPS); }
          LDS_WAIT();
#pragma unroll
          for (int i = 0; i < 8; ++i) { const int t = w * 8 + i; const float o = Oc[t * HS + lane];
              const size_t row = (size_t)b * T + ch * 64 + t;
              CAT[row * 1024 + 768 + h * 64 + lane] = (bf16)f2bf(o * tot[t] * ng * siluf_(gv[i])); } }
        __syncthreads();
    }
}

DEV void conv_phase(Frame& F, int l) {
    const bf16* CB = wsp<bf16>(F, WS_CB); const bf16* CC = wsp<bf16>(F, WS_CC); const bf16* CH = wsp<bf16>(F, WS_CH); bf16* CAT = wsp<bf16>(F, WS_CAT);
    const float* cw = inp(3) + l * 3 * 256;
    for (int it = F.vcu * 512 + F.tid; it < NTOK * 32; it += F.G * 512) {
        const int m = it >> 5, c0 = (it & 31) * 8, t = m & (T - 1);
        const v4u bb = *(const v4u*)(CB + (size_t)m * 256 + c0);
        float y[8];
#pragma unroll
        for (int j = 0; j < 8; ++j) y[j] = 0.f;
#pragma unroll
        for (int k = 0; k < 3; ++k) {
            if (t + k - 2 >= 0) {
                const size_t o = (size_t)(m + k - 2) * 256 + c0;
                const v4u cc = *(const v4u*)(CC + o), hh = *(const v4u*)(CH + o);
#pragma unroll
                for (int j = 0; j < 4; ++j) { const float w0 = cw[k * 256 + c0 + 2 * j], w1 = cw[k * 256 + c0 + 2 * j + 1];
                    y[2 * j] += w0 * (bflo(cc[j]) * bflo(hh[j])); y[2 * j + 1] += w1 * (bfhi(cc[j]) * bfhi(hh[j])); }
            }
        }
        v4u o4;
#pragma unroll
        for (int j = 0; j < 4; ++j) o4[j] = pk2(bflo(bb[j]) * y[2 * j], bfhi(bb[j]) * y[2 * j + 1]);
        *(v4u*)(CAT + (size_t)m * 1024 + 512 + c0) = o4;
    }
}
struct SmState { float m, l; f32x4 o[4]; };
DEV void sm_reset(SmState& st) { st.m = -INFINITY; st.l = 0.f;
#pragma unroll
    for (int i = 0; i < 4; ++i) st.o[i] = (f32x4){0.f, 0.f, 0.f, 0.f}; }
DEV float sm_lsum(const SmState& st) { float l = st.l; l += __shfl_xor(l, 16); l += __shfl_xor(l, 32); return l; }
DEV void load_k(const bf16* kbase, int lane, bf16x8 (&kf)[2][2]) {
#pragma unroll
    for (int tt = 0; tt < 2; ++tt)
#pragma unroll
        for (int ks = 0; ks < 2; ++ks) kf[tt][ks] = *(const bf16x8*)(kbase + lane * 8 + (tt * 2 + ks) * 512);
}
DEV void load_v(const bf16* vbase, int lane, bf16x8 (&vf)[4]) {
    const int l16 = lane & 15, g4 = lane >> 4;
#pragma unroll
    for (int dt = 0; dt < 4; ++dt) vf[dt] = *(const bf16x8*)(vbase + (size_t)(dt * 16 + l16) * 32 + g4 * 8);
}
DEV void qk_tile(const bf16x8 (&kf)[2][2], const bf16x8 (&qf)[2], f32x4 (&s)[2]) {
#pragma unroll
    for (int tt = 0; tt < 2; ++tt) { s[tt] = mfma16(kf[tt][0], qf[0], (f32x4){0.f, 0.f, 0.f, 0.f}); s[tt] = mfma16(kf[tt][1], qf[1], s[tt]); }
}
DEV bf16x8 pack_p(const float (&p)[2][4]) {
    v4u w; w.x = pk2(p[0][0], p[0][1]); w.y = pk2(p[0][2], p[0][3]); w.z = pk2(p[1][0], p[1][1]); w.w = pk2(p[1][2], p[1][3]);
    return __builtin_bit_cast(bf16x8, w);
}
template <int MODE, class MaskF>
DEV void attn_compute(const bf16x8 (&kf)[2][2], const bf16x8 (&vf)[4], const bf16x8 (&qf)[2], SmState& st, int lane, bool colok, MaskF mask) {
    const int g4 = lane >> 4;
    f32x4 s[2]; qk_tile(kf, qf, s);
    float sv[2][4]; float tmax = -INFINITY;
#pragma unroll
    for (int tt = 0; tt < 2; ++tt)
#pragma unroll
        for (int r = 0; r < 4; ++r) { float x = s[tt][r]; if (MODE == 2) x = mask(16 * tt + 4 * g4 + r) ? x : -INFINITY; sv[tt][r] = x; tmax = fmaxf(tmax, x); }
    if (MODE == 1) tmax = colok ? tmax : -INFINITY;
    tmax = fmaxf(tmax, __shfl_xor(tmax, 16)); tmax = fmaxf(tmax, __shfl_xor(tmax, 32));
    const float mnew = fmaxf(st.m, tmax), muse = (mnew == -INFINITY) ? 0.f : mnew;
    const float alpha = ex2(st.m - muse);
    const float msub = (MODE == 1) ? (colok ? muse : INFINITY) : muse;
    float p[2][4]; float ps = 0.f;
#pragma unroll
    for (int tt = 0; tt < 2; ++tt)
#pragma unroll
        for (int r = 0; r < 4; ++r) { p[tt][r] = ex2(sv[tt][r] - msub); ps += p[tt][r]; }
    st.l = st.l * alpha + ps; st.m = mnew;
    const bf16x8 pf = pack_p(p);
#pragma unroll
    for (int dt = 0; dt < 4; ++dt) { st.o[dt] = st.o[dt] * alpha; st.o[dt] = mfma16(vf[dt], pf, st.o[dt]); }
}
template <int MODE, class MaskF>
DEV void attn_compute_fixed(const bf16x8 (&kf)[2][2], const bf16x8 (&vf)[4], const bf16x8 (&qf)[2], SmState& st, float mref, int lane, bool colok, MaskF mask) {
    const int g4 = lane >> 4;
    const float c0 = (MODE == 1) ? (colok ? -mref : -INFINITY) : -mref;
    const f32x4 ci = {c0, c0, c0, c0};
    f32x4 s[2];
#pragma unroll
    for (int tt = 0; tt < 2; ++tt) { s[tt] = mfma16(kf[tt][0], qf[0], ci); s[tt] = mfma16(kf[tt][1], qf[1], s[tt]); }
    float p[2][4];
#pragma unroll
    for (int tt = 0; tt < 2; ++tt)
#pragma unroll
        for (int r = 0; r < 4; ++r) { float x = s[tt][r]; if (MODE == 2) x = mask(16 * tt + 4 * g4 + r) ? x : -INFINITY; p[tt][r] = ex2(x); }
    st.l += ((p[0][0] + p[0][1]) + (p[0][2] + p[0][3])) + ((p[1][0] + p[1][1]) + (p[1][2] + p[1][3]));
    const bf16x8 pf = pack_p(p);
#pragma unroll
    for (int dt = 0; dt < 4; ++dt) st.o[dt] = mfma16(vf[dt], pf, st.o[dt]);
}
template <int MODE, class MaskF>
DEV void attn_max(const bf16x8 (&kf)[2][2], const bf16x8 (&qf)[2], float& mx, int lane, bool colok, MaskF mask) {
    const int g4 = lane >> 4;
    f32x4 s[2]; qk_tile(kf, qf, s);
    float tmax = -INFINITY;
#pragma unroll
    for (int tt = 0; tt < 2; ++tt)
#pragma unroll
        for (int r = 0; r < 4; ++r) { float x = s[tt][r]; if (MODE == 2) x = mask(16 * tt + 4 * g4 + r) ? x : -INFINITY; tmax = fmaxf(tmax, x); }
    if (MODE == 1) tmax = colok ? tmax : -INFINITY;
    mx = fmaxf(mx, tmax);
}
DEV float colmax_finish(float mx) { mx = fmaxf(mx, __shfl_xor(mx, 16)); mx = fmaxf(mx, __shfl_xor(mx, 32)); return mx == -INFINITY ? 0.f : mx; }
DEV float col_norm(const bf16x8 (&qf)[2]) {
    float s = 0.f;
#pragma unroll
    for (int ks = 0; ks < 2; ++ks) { const v4u w = __builtin_bit_cast(v4u, qf[ks]);
#pragma unroll
        for (int j = 0; j < 4; ++j) { const float a = bflo(w[j]), b = bfhi(w[j]); s += a * a + b * b; } }
    s += __shfl_xor(s, 16); s += __shfl_xor(s, 32);
    return sqrtf(s);
}
DEV float wave_max_uniform(float v) {
#pragma unroll
    for (int o = 1; o < 64; o <<= 1) v = fmaxf(v, __shfl_xor(v, o));
    return __builtin_bit_cast(float, __builtin_amdgcn_readfirstlane(__builtin_bit_cast(int, v)));
}
constexpr float FIXED_REF_MAX = 40.f;
DEV void kmax_phase(Frame& F, int l) {
    const int lane = F.lane; const int gw = F.vcu * NWAVES + F.wave, NGW = F.G * NWAVES;
    for (int item = gw; item < 2048; item += NGW) {
        const int br = item >> 10, bh = (item >> 7) & 7, key = (item & 127) * 64 + lane;
        const bf16* kp = wsp<bf16>(F, br ? WS_KW : WS_KS) + (size_t)bh * T * 64;
        float s = 0.f;
#pragma unroll
        for (int i = 0; i < 8; ++i) { const v4u w = *(const v4u*)(kp + kfrag_off(key, i * 8));
#pragma unroll
            for (int j = 0; j < 4; ++j) { const float a = bflo(w[j]), b = bfhi(w[j]); s += a * a + b * b; } }
#pragma unroll
        for (int o = 1; o < 64; o <<= 1) s = fmaxf(s, __shfl_xor(s, o));
        if (lane == 0) __hip_atomic_fetch_max((unsigned*)F.ctl + CW_KMAX + l * 16 + br * 8 + bh, __builtin_bit_cast(unsigned, s), RLX_AGENT);
    }
}
struct NoMask { DEV bool operator()(int) const { return true; } };
template <int D, bool WITHV, class AddrF, class BodyF>
DEV void pipe_run(int n, int lane, AddrF addr, BodyF body) {
    if (n <= 0) return;
    bf16x8 kf[D][2][2], vf[D][4];
#pragma unroll
    for (int d = 0; d < D; ++d) { const bf16* kb; const bf16* vb; addr(d < n ? d : n - 1, kb, vb); load_k(kb, lane, kf[d]); if (WITHV) load_v(vb, lane, vf[d]); }
#pragma unroll 1
    for (int i = 0; i < n; i += D) {
#pragma unroll
        for (int d = 0; d < D; ++d) { const int s = i + d;
            if (s < n) body(s, kf[d], vf[d]);
            if (D > 1 || s + 1 < n) { const bf16* kb; const bf16* vb; addr(s + D < n ? s + D : n - 1, kb, vb); load_k(kb, lane, kf[d]); if (WITHV) load_v(vb, lane, vf[d]); } }
    }
}
template <class AddrF, class BodyF>
DEV void pipe_run_k2(int n, int lane, AddrF addr, BodyF body) {
    if (n <= 0) return;
    bf16x8 kf[2][2][2], vf[4];
    { const bf16* kb; const bf16* vb; addr(0, kb, vb); load_k(kb, lane, kf[0]); }
#pragma unroll 1
    for (int i = 0; i < n; i += 2) {
#pragma unroll
        for (int d = 0; d < 2; ++d) { const int s = i + d;
            { const bf16* kb; const bf16* vb; addr(s < n ? s : n - 1, kb, vb); load_v(vb, lane, vf); }
            { const bf16* kb; const bf16* vb; addr(s + 1 < n ? s + 1 : n - 1, kb, vb); load_k(kb, lane, kf[d ^ 1]); }
            if (s < n) body(s, kf[d], vf); }
    }
}
template <class AddrF, class BodyA, class BodyB>
DEV void pipe_run_mt(int n_main, int n_tail, int lane, AddrF addr, BodyA mainb, BodyB tailb) {
    const int n = n_main + n_tail;
    bf16x8 kf[2][2][2], vf[4];
    { const bf16* kb; const bf16* vb; addr(0, kb, vb); load_k(kb, lane, kf[0]); }
    int i = 0;
#define PIPE_STEP_(s_, d_, BODY_) do { { const bf16* kb; const bf16* vb; addr((s_) < n ? (s_) : n - 1, kb, vb); load_v(vb, lane, vf); } \
        { const bf16* kb; const bf16* vb; addr((s_) + 1 < n ? (s_) + 1 : n - 1, kb, vb); load_k(kb, lane, kf[(d_) ^ 1]); } BODY_((s_), kf[d_], vf); } while (0)
#pragma unroll 1
    for (; i + 2 <= n_main; i += 2) { PIPE_STEP_(i, 0, mainb); PIPE_STEP_(i + 1, 1, mainb); }
    if (i < n_main) { PIPE_STEP_(i, 0, mainb); ++i;
#pragma unroll
        for (int a = 0; a < 2; ++a)
#pragma unroll
            for (int b = 0; b < 2; ++b) kf[0][a][b] = kf[1][a][b]; }
#pragma unroll 1
    for (; i < n; ++i) { PIPE_STEP_(i, 0, tailb);
#pragma unroll
        for (int a = 0; a < 2; ++a)
#pragma unroll
            for (int b = 0; b < 2; ++b) kf[0][a][b] = kf[1][a][b]; }
#undef PIPE_STEP_
}
constexpr int PIPE_D = 2;

DEV void acc_add_packed(unsigned (&pk)[4][4][2], int ct, const f32x4 (&o)[4], float sc, bool first) {
#pragma unroll
    for (int dt = 0; dt < 4; ++dt) {
        f32x4 v = o[dt] * sc;
        if (!first) { v[0] += bflo(pk[ct][dt][0]); v[1] += bfhi(pk[ct][dt][0]); v[2] += bflo(pk[ct][dt][1]); v[3] += bfhi(pk[ct][dt][1]); }
        pk[ct][dt][0] = pk2(v[0], v[1]); pk[ct][dt][1] = pk2(v[2], v[3]);
    }
}
template <int VAR>
DEV void nsa_phase_t(Frame& F, int l) {
#define NSA_RELANE() int ln_ = lane; asm volatile("" : "+v"(ln_)); const int l16 = ln_ & 15, g4 = ln_ >> 4, tq = l16 >> 2, gh = l16 & 3; const size_t mrow0 = (size_t)b * T + t0 + tq; const int tl0 = t0 + tq; (void)l16; (void)g4; (void)gh; (void)mrow0; (void)tl0
    float* IMP = (float*)(F.ldsg + F.wave * NSA_LDS_WAVE);
    float* VALS = IMP + 2048; int* BL = (int*)(IMP + 2176); unsigned* SELB = (unsigned*)(IMP + 2304); float* GL = IMP + 2432;
    const bf16* Q = wsp<bf16>(F, WS_Q);
    const bf16* KCC = wsp<bf16>(F, WS_KCC); const bf16* VCT = wsp<bf16>(F, WS_VCT);
    const bf16* KS = wsp<bf16>(F, WS_KS); const bf16* VST = wsp<bf16>(F, WS_VST);
    const bf16* KW = wsp<bf16>(F, WS_KW); const bf16* VWT = wsp<bf16>(F, WS_VWT);
    bf16* CAT = wsp<bf16>(F, WS_CAT);
    const int gw = F.vcu * NWAVES + F.wave, NGW = F.G * NWAVES;
    const bool xmap = (F.G == 256);
#pragma unroll 1
    for (int task = gw; task < 4096; task += NGW) {
        unsigned zl_ = 0u; asm volatile("" : "+v"(zl_)); const int lane = (int)__builtin_amdgcn_mbcnt_hi(~0u, __builtin_amdgcn_mbcnt_lo(~0u, zl_));
        const int bh = xmap ? (gw >> 8) : (task & 7), idx = xmap ? ((task >> 11) ? 511 - (gw & 255) : (gw & 255)) : (task >> 3);
        const int t0 = idx * 16, b = bh >> 1, hkv = bh & 1, cur = t0 >> 6;
        bf16x8 qf[4][2];
        unsigned opk[4][4][2];
        SmState st[4];
        float qnmax = 0.f;
        { NSA_RELANE();
#pragma unroll
        for (int ct = 0; ct < 4; ++ct)
#pragma unroll
            for (int ks = 0; ks < 2; ++ks) qf[ct][ks] = *(const bf16x8*)(Q + (mrow0 + 4 * ct) * 512 + hkv * 256 + gh * 64 + ks * 32 + g4 * 8);
        { NSA_RELANE();
          f32x4 ga[1]; ga[0] = (f32x4){0.f, 0.f, 0.f, 0.f};
          { const bf16* ap = wsp<bf16>(F, WS_HB) + ((size_t)b * T + t0 + l16) * 1024 + g4 * 8; const bf16* bp = wsp<bf16>(F, WS_WG) + (size_t)((l * 2 + hkv) * 16 + l16) * 1024 + g4 * 8;
#pragma unroll 1
            for (int k0 = 0; k0 < 1024; k0 += 256) {
                bf16x8 av[8], bv[8];
#pragma unroll
                for (int i = 0; i < 8; ++i) { av[i] = *(const bf16x8*)(ap + k0 + 32 * i); bv[i] = *(const bf16x8*)(bp + k0 + 32 * i); }
#pragma unroll
                for (int i = 0; i < 8; ++i) ga[0] = mfma16(av[i], bv[i], ga[0]);
            } }
          const float rs = (ln_ < 16) ? row_rstd_full(wsp<float>(F, WS_SSQ), b * T + t0 + ln_) : 0.f;
#pragma unroll
          for (int r = 0; r < 4; ++r) GL[(g4 * 4 + r) * 16 + l16] = sigmoidf_(ga[0][r] * __shfl(rs, g4 * 4 + r));
        }
        const int ngc = (t0 + 15 >= 31) ? (((t0 + 15 - 31) >> 4) >> 5) + 1 : 0;
        const bf16* kcb = KCC + (size_t)bh * 512 * 64; const bf16* vcb = VCT + (size_t)bh * 16 * 64 * 32;
        float cm[4], cl[4];
#pragma unroll
        for (int ct = 0; ct < 4; ++ct) { cm[ct] = -INFINITY; cl[ct] = 0.f; }
        pipe_run<1, false>(ngc, ln_, [&](int s, const bf16*& kb, const bf16*& vb) { kb = kcb + (size_t)s * 32 * 64; vb = vcb; },
            [&](int kg, const bf16x8 (&kf)[2][2], const bf16x8 (&)[4]) {
#pragma unroll
                for (int ct = 0; ct < 4; ++ct) {
                    const int tl = tl0 + 4 * ct;
                    f32x4 s[2]; qk_tile(kf, qf[ct], s);
                    float sv[2][4]; float tmax = -INFINITY;
#pragma unroll
                    for (int tt = 0; tt < 2; ++tt)
#pragma unroll
                        for (int r = 0; r < 4; ++r) { const int c = kg * 32 + 16 * tt + 4 * g4 + r; sv[tt][r] = (16 * c + 31 <= tl) ? s[tt][r] : -INFINITY; tmax = fmaxf(tmax, sv[tt][r]); }
                    tmax = fmaxf(tmax, __shfl_xor(tmax, 16)); tmax = fmaxf(tmax, __shfl_xor(tmax, 32));
                    const float mnew = fmaxf(cm[ct], tmax), muse = (mnew == -INFINITY) ? 0.f : mnew;
                    float ps = 0.f;
#pragma unroll
                    for (int tt = 0; tt < 2; ++tt)
#pragma unroll
                        for (int r = 0; r < 4; ++r) ps += ex2(sv[tt][r] - muse);
                    cl[ct] = cl[ct] * ex2(cm[ct] - muse) + ps; cm[ct] = mnew;
                }
            });
        {
            float cmu[4], cinv[4], carry[4];
#pragma unroll
            for (int ct = 0; ct < 4; ++ct) { float l = cl[ct]; l += __shfl_xor(l, 16); l += __shfl_xor(l, 32);
                cmu[ct] = (cm[ct] == -INFINITY) ? 0.f : cm[ct]; cinv[ct] = l > 0.f ? 1.0f / l : 0.f; carry[ct] = 0.f; sm_reset(st[ct]); }
            pipe_run<1, true>(ngc, ln_, [&](int s, const bf16*& kb, const bf16*& vb) { kb = kcb + (size_t)s * 32 * 64; vb = vcb + (size_t)s * 64 * 32; },
                [&](int kg, const bf16x8 (&kf)[2][2], const bf16x8 (&vf)[4]) {
#pragma unroll
                    for (int ct = 0; ct < 4; ++ct) {
                        const int tl = tl0 + 4 * ct;
                        f32x4 s[2]; qk_tile(kf, qf[ct], s);
                        float p[2][4];
#pragma unroll
                        for (int tt = 0; tt < 2; ++tt) {
#pragma unroll
                            for (int r = 0; r < 4; ++r) { const int c = kg * 32 + 16 * tt + 4 * g4 + r; p[tt][r] = (16 * c + 31 <= tl) ? ex2(s[tt][r] - cmu[ct]) * cinv[ct] : 0.f; }
                            const float hb = 0.5f * p[tt][3];
                            const float bsh = __shfl(hb, (ln_ + 48) & 63);
                            float v = ((p[tt][0] + p[tt][1]) + (p[tt][2] + hb)) + ((g4 == 0) ? carry[ct] : bsh);
                            carry[ct] = bsh;
                            v += __shfl_xor(v, 1); v += __shfl_xor(v, 2);
                            if (gh == 0) IMP[(4 * ct + tq) * 128 + kg * 8 + 4 * tt + g4] = v;
                        }
                        const bf16x8 pf = pack_p(p);
#pragma unroll
                        for (int dt = 0; dt < 4; ++dt) st[ct].o[dt] = mfma16(vf[dt], pf, st[ct].o[dt]);
                    }
                });
#pragma unroll
            for (int ct = 0; ct < 4; ++ct) acc_add_packed(opk, ct, st[ct].o, GL[(4 * ct + tq) * 16 + gh * 3 + 0], true);
        }
        }
        LDS_WAIT();
        unsigned sb0 = 0u, sb1 = 0u;
        if (cur < 16) { sb0 = (lane <= cur) ? 0xffffu : 0u; }
        else if (VAR == 6) {
#pragma unroll 1
            for (int q = 0; q < 16; ++q) { const bool s0 = (lane <= cur) && ((lane * 37 + q * 11) % (cur + 1)) < 16, s1 = (lane + 64 <= cur) && (((lane + 64) * 37 + q * 11) % (cur + 1)) < 16;
                sb0 |= (s0 ? 1u : 0u) << q; sb1 |= (s1 ? 1u : 0u) << q; }
        }
        else {
            const unsigned long long below = (1ull << lane) - 1ull;
#pragma unroll 1
            for (int q = 0; q < 16; ++q) {
                unsigned k0, k1;
                { const int j = lane; const float v = (j == 0 || j == cur || j == cur - 1) ? 1e6f : IMP[q * 128 + j]; k0 = (j > cur) ? 0u : __builtin_bit_cast(unsigned, v) + 1u; }
                { const int j = lane + 64; const float v = (j == cur || j == cur - 1) ? 1e6f : IMP[q * 128 + j]; k1 = (j > cur) ? 0u : __builtin_bit_cast(unsigned, v) + 1u; }
                unsigned lo = 0u, hi = 0xffffffffu;
                while (hi - lo > 1u) { const unsigned mid = lo + ((hi - lo) >> 1);
                    const int c = __builtin_popcountll(__ballot(k0 >= mid)) + __builtin_popcountll(__ballot(k1 >= mid));
                    if (c >= 16) lo = mid; else hi = mid; }
                const unsigned long long g0 = __ballot(k0 > lo), g1 = __ballot(k1 > lo), e0 = __ballot(k0 == lo), e1 = __ballot(k1 == lo);
                const int need = 16 - __builtin_popcountll(g0) - __builtin_popcountll(g1);
                const bool s0 = (k0 > lo) || (k0 == lo && __builtin_popcountll(e0 & below) < need);
                const bool s1 = (k1 > lo) || (k1 == lo && __builtin_popcountll(e0) + __builtin_popcountll(e1 & below) < need);
                sb0 |= (s0 ? 1u : 0u) << q; sb1 |= (s1 ? 1u : 0u) << q;
            }
        }
        SELB[lane] = sb0; SELB[lane + 64] = sb1;
        LDS_WAIT();
#define NSA_PARK() do { _Pragma("unroll") for (int i_ = 0; i_ < 8; ++i_) { v4u w_; w_.x = opk[i_ >> 1][(i_ & 1) * 2][0]; w_.y = opk[i_ >> 1][(i_ & 1) * 2][1]; w_.z = opk[i_ >> 1][(i_ & 1) * 2 + 1][0]; w_.w = opk[i_ >> 1][(i_ & 1) * 2 + 1][1]; ((v4u*)IMP)[i_ * 64 + lane] = w_; } } while (0)
#define NSA_UNPARK() do { _Pragma("unroll") for (int i_ = 0; i_ < 8; ++i_) { const v4u w_ = ((const v4u*)IMP)[i_ * 64 + lane]; opk[i_ >> 1][(i_ & 1) * 2][0] = w_.x; opk[i_ >> 1][(i_ & 1) * 2][1] = w_.y; opk[i_ >> 1][(i_ & 1) * 2 + 1][0] = w_.z; opk[i_ >> 1][(i_ & 1) * 2 + 1][1] = w_.w; } } while (0)
        NSA_PARK();
        { NSA_RELANE();
#pragma unroll
        for (int ct = 0; ct < 4; ++ct) {
            const float* rp = wsp<float>(F, WS_ROPE) + ((size_t)(tl0 + 4 * ct) * 32 + g4 * 8) * 2;
            const v4u a = __builtin_bit_cast(v4u, qf[ct][0]), b2 = __builtin_bit_cast(v4u, qf[ct][1]); v4u ra, rb;
#pragma unroll
            for (int jj = 0; jj < 4; ++jj) { const f32x4 cs = *(const f32x4*)(rp + 4 * jj);
                const float x1a = bflo(a[jj]), x1b = bfhi(a[jj]), x2a = bflo(b2[jj]), x2b = bfhi(b2[jj]);
                ra[jj] = pk2(x1a * cs[0] - x2a * cs[1], x1b * cs[2] - x2b * cs[3]);
                rb[jj] = pk2(x2a * cs[0] + x1a * cs[1], x2b * cs[2] + x1b * cs[3]); }
            qf[ct][0] = __builtin_bit_cast(bf16x8, ra); qf[ct][1] = __builtin_bit_cast(bf16x8, rb);
        }
        {
            const unsigned long long ulo = __ballot(sb0 != 0u), uhi = __ballot(sb1 != 0u);
            const unsigned long long below = (1ull << ln_) - 1ull;
            const int nlo = __builtin_popcountll(ulo), nblk = nlo + __builtin_popcountll(uhi);
            if (sb0 != 0u) BL[__builtin_popcountll(ulo & below)] = ln_;
            if (sb1 != 0u) BL[nlo + __builtin_popcountll(uhi & below)] = ln_ + 64;
            LDS_WAIT();
#pragma unroll
            for (int ct = 0; ct < 4; ++ct) sm_reset(st[ct]);
            const bf16* kb0 = KS + (size_t)bh * T * 64; const bf16* vb0 = VST + (size_t)bh * 256 * 64 * 32;
            float mr; bool fixed;
            { const float kmx = sqrtf(__builtin_bit_cast(float, __hip_atomic_load((const unsigned*)F.ctl + CW_KMAX + l * 16 + bh, RLX_AGENT))); float mm = 0.f;
#pragma unroll
              for (int ct = 0; ct < 4; ++ct) mm = fmaxf(mm, col_norm(qf[ct]));
              qnmax = wave_max_uniform(mm); mr = qnmax * kmx * 1.002f + 1e-3f;
              fixed = mr < FIXED_REF_MAX; }
            auto addr_sel = [&](int s, const bf16*& kb, const bf16*& vb) { const int g32 = (VAR == 7) ? (s & 1) : BL[s >> 1] * 2 + (s & 1); kb = kb0 + (size_t)g32 * 32 * 64; vb = vb0 + (size_t)g32 * 64 * 32; };
            asm volatile("" ::: "memory");
            if (!fixed) {
                float mx[4] = {-INFINITY, -INFINITY, -INFINITY, -INFINITY};
                pipe_run<1, false>(2 * nblk, ln_, addr_sel,
                    [&](int s, const bf16x8 (&kf)[2][2], const bf16x8 (&)[4]) {
                        const int j = BL[s >> 1], key0 = j * 64 + (s & 1) * 32;
                        const unsigned tm = (unsigned)__builtin_amdgcn_readfirstlane((int)SELB[j]);
#pragma unroll
                        for (int ct = 0; ct < 4; ++ct) { const unsigned tmk = (tm >> (4 * ct)) & 0xFu;
                            if (tmk) { const bool colok = (tmk >> tq) & 1u; const int tl = tl0 + 4 * ct;
                                if (j == cur) attn_max<2>(kf, qf[ct], mx[ct], ln_, true, [&](int kk) { return colok && (key0 + kk <= tl); });
                                else attn_max<1>(kf, qf[ct], mx[ct], ln_, colok, NoMask()); } }
                    });
                mr = wave_max_uniform(fmaxf(fmaxf(mx[0], mx[1]), fmaxf(mx[2], mx[3]))); if (mr == -INFINITY) mr = 0.f;
            }
            asm volatile("" ::: "memory");
            if (VAR != 4)
            pipe_run_mt(2 * nblk - 2, 2, ln_, addr_sel,
                [&](int s, const bf16x8 (&kf)[2][2], const bf16x8 (&vf)[4]) {
                    const int j = BL[s >> 1];
                    const unsigned tm = (unsigned)__builtin_amdgcn_readfirstlane((int)SELB[j]);
#pragma unroll
                    for (int ct = 0; ct < 4; ++ct) {
                        const unsigned tmk = (tm >> (4 * ct)) & 0xFu;
                        if (tmk) attn_compute_fixed<1>(kf, vf, qf[ct], st[ct], mr, ln_, (tmk >> tq) & 1u, NoMask());
                    }
                },
                [&](int s, const bf16x8 (&kf)[2][2], const bf16x8 (&vf)[4]) {
                    const int key0 = cur * 64 + (s & 1) * 32;
#pragma unroll
                    for (int ct = 0; ct < 4; ++ct) { const int tl = tl0 + 4 * ct;
                        attn_compute_fixed<2>(kf, vf, qf[ct], st[ct], mr, ln_, true, [&](int kk) { return key0 + kk <= tl; }); }
                });
            LDS_WAIT();
            NSA_UNPARK();
#pragma unroll
            for (int ct = 0; ct < 4; ++ct) { const float ls = sm_lsum(st[ct]); const float gs = GL[(4 * ct + tq) * 16 + gh * 3 + 1];
                acc_add_packed(opk, ct, st[ct].o, ls > 0.f ? gs / ls : 0.f, false); }
            NSA_PARK();
        }
        }
        { NSA_RELANE();
#pragma unroll
            for (int ct = 0; ct < 4; ++ct) sm_reset(st[ct]);
            const bf16* kb0 = (VAR == 3 ? KS : KW) + (size_t)bh * T * 64; const bf16* vb0 = (VAR == 3 ? VST : VWT) + (size_t)bh * 256 * 64 * 32;
            const int glo = (t0 - 511 > 0 ? t0 - 511 : 0) >> 5, ghi = (t0 + 15) >> 5;
            float mr; bool fixed;
            { const float kmx = sqrtf(__builtin_bit_cast(float, __hip_atomic_load((const unsigned*)F.ctl + CW_KMAX + l * 16 + 8 + bh, RLX_AGENT)));
              mr = qnmax * kmx * 1.002f + 1e-3f;
              fixed = mr < FIXED_REF_MAX; }
            auto addr_win = [&](int s, const bf16*& kb, const bf16*& vb) { kb = kb0 + (size_t)(glo + s) * 32 * 64; vb = vb0 + (size_t)(glo + s) * 64 * 32; };
            asm volatile("" ::: "memory");
            if (!fixed) {
                float mx[4] = {-INFINITY, -INFINITY, -INFINITY, -INFINITY};
                pipe_run<1, false>(ghi - glo + 1, ln_, addr_win,
                    [&](int s, const bf16x8 (&kf)[2][2], const bf16x8 (&)[4]) {
                        const int key0 = (glo + s) * 32;
#pragma unroll
                        for (int ct = 0; ct < 4; ++ct) { const int tl = tl0 + 4 * ct;
                            attn_max<2>(kf, qf[ct], mx[ct], ln_, true, [&](int kk) { const int kp = key0 + kk; return kp <= tl && kp + 512 > tl; }); }
                    });
                mr = wave_max_uniform(fmaxf(fmaxf(mx[0], mx[1]), fmaxf(mx[2], mx[3]))); if (mr == -INFINITY) mr = 0.f;
            }
            asm volatile("" ::: "memory");
            pipe_run_k2(VAR == 5 ? 0 : ghi - glo + 1, ln_, addr_win,
                [&](int s, const bf16x8 (&kf)[2][2], const bf16x8 (&vf)[4]) {
                    const int key0 = (glo + s) * 32;
#pragma unroll
                    for (int ct = 0; ct < 4; ++ct) {
                        const int tlo = t0 + 4 * ct, thi = tlo + 3, tl = tl0 + 4 * ct;
                        if (key0 > thi || key0 + 31 + 512 <= tlo) continue;
                        if (key0 + 512 > thi && key0 + 31 <= tlo) attn_compute_fixed<0>(kf, vf, qf[ct], st[ct], mr, ln_, true, NoMask());
                        else attn_compute_fixed<2>(kf, vf, qf[ct], st[ct], mr, ln_, true, [&](int kk) { const int kp = key0 + kk; return kp <= tl && kp + 512 > tl; });
                    }
                });
            NSA_UNPARK();
#pragma unroll
            for (int ct = 0; ct < 4; ++ct) { const float ls = sm_lsum(st[ct]); const float gwn = GL[(4 * ct + tq) * 16 + gh * 3 + 2];
                acc_add_packed(opk, ct, st[ct].o, ls > 0.f ? gwn / ls : 0.f, false); }
        }
        { NSA_RELANE();
#pragma unroll
        for (int ct = 0; ct < 4; ++ct)
#pragma unroll
            for (int dt = 0; dt < 4; ++dt) { v2u w; w.x = opk[ct][dt][0]; w.y = opk[ct][dt][1];
                if (VAR == 0 || w.x == 0x7fc17fc1u) *(v2u*)(CAT + (mrow0 + 4 * ct) * 1024 + hkv * 256 + gh * 64 + dt * 16 + g4 * 4) = w; }
        }
        LDS_WAIT();
        if (VAR == 0 && xmap) convert_experts(F, l, (bf16*)IMP, task >> 11);
    }
#undef NSA_RELANE
#undef NSA_PARK
#undef NSA_UNPARK
}

DEV void nsa_phase(Frame& F, int l) { nsa_phase_t<0>(F, l); }

DEV void cross_phase(Frame& F, int l) {
    const int lane = F.lane, l16 = lane & 15, g4 = lane >> 4;
    const bf16* XQ = wsp<bf16>(F, WS_XQ); bf16* XO = wsp<bf16>(F, WS_XO);
    const int gw = F.vcu * NWAVES + F.wave, NGW = F.G * NWAVES;
#pragma unroll 1
    for (int task = gw; task < 2048; task += NGW) {
        const int head = task & 3, m0 = (task >> 2) * 64, b = m0 >> 13;
        bf16x8 qf[4][2];
#pragma unroll
        for (int ct = 0; ct < 4; ++ct)
#pragma unroll
            for (int ks = 0; ks < 2; ++ks) qf[ct][ks] = *(const bf16x8*)(XQ + (size_t)(m0 + 16 * ct + l16) * 256 + head * 64 + ks * 32 + g4 * 8);
        const bf16* kb0 = wsp<bf16>(F, WS_MK) + (size_t)((l * 4 + b) * 4 + head) * 256 * 64;
        const bf16* vb0 = wsp<bf16>(F, WS_MVT) + (size_t)((l * 4 + b) * 4 + head) * 8 * 64 * 32;
        SmState st[4];
#pragma unroll
        for (int ct = 0; ct < 4; ++ct) sm_reset(st[ct]);
        pipe_run<PIPE_D, true>(8, lane, [&](int s, const bf16*& kb, const bf16*& vb) { kb = kb0 + (size_t)s * 32 * 64; vb = vb0 + (size_t)s * 64 * 32; },
            [&](int, const bf16x8 (&kf)[2][2], const bf16x8 (&vf)[4]) {
#pragma unroll
                for (int ct = 0; ct < 4; ++ct) attn_compute<0>(kf, vf, qf[ct], st[ct], lane, true, NoMask());
            });
#pragma unroll
        for (int ct = 0; ct < 4; ++ct) {
            const float inv = 1.0f / sm_lsum(st[ct]);
#pragma unroll
            for (int dt = 0; dt < 4; ++dt) { const f32x4 o = st[ct].o[dt] * inv; v2u w; w.x = pk2(o[0], o[1]); w.y = pk2(o[2], o[3]);
                *(v2u*)(XO + (size_t)(m0 + 16 * ct + l16) * 256 + head * 64 + dt * 16 + g4 * 4) = w; }
        }
    }
}


DEV void router_phase(Frame& F, int l, int probe = 0) {
    const int lane = F.lane, l16 = lane & 15, g4 = lane >> 4;
    float* LG = (float*)F.ldsg + F.wave * 768;
    const bf16* HB = wsp<bf16>(F, WS_HB); const float* SSQ = wsp<float>(F, WS_SSQ);
    const bf16* WR = wsp<bf16>(F, WS_WR) + (size_t)l * 96 * 1024;
    int* TOKE = wsp<int>(F, probe ? WS_PROBE : WS_TOKE); float* TOKG = wsp<float>(F, probe ? WS_PROBE + MiB : WS_TOKG); int* TOKP = wsp<int>(F, probe ? WS_PROBE + 2 * MiB : WS_TOKP);
    unsigned* CNT = (unsigned*)F.ctl + CW_CNT + l * 32 + (probe ? 64 : 0);
    const float* bg = inp(14) + l * 4; const float* be = inp(16) + l * 32;
    unsigned* HIST = (unsigned*)((float*)F.ldsg + 8 * 768);
#pragma unroll 1
    for (int tb = F.vcu * NWAVES; tb < NTOK / 16; tb += F.G * NWAVES) {
        const int task = tb + F.wave; const bool live = task < NTOK / 16;
        const int m0 = (live ? task : tb) * 16;
        if (F.tid < 64) HIST[F.tid] = 0u;
        f32x4 acc[3];
        {
            const bf16* ap = HB + (size_t)(m0 + l16) * 1024 + g4 * 8; const bf16* bp = WR + (size_t)l16 * 1024 + g4 * 8;
#pragma unroll
            for (int n = 0; n < 3; ++n) acc[n] = (f32x4){0.f, 0.f, 0.f, 0.f};
#pragma unroll 4
            for (int k = 0; k < 1024; k += 32) {
                const bf16x8 a = *(const bf16x8*)(ap + k);
#pragma unroll
                for (int n = 0; n < 3; ++n) { const bf16x8 bh = *(const bf16x8*)(bp + (size_t)n * 16 * 1024 + k), bl = *(const bf16x8*)(bp + (size_t)(48 + n * 16) * 1024 + k);
                    acc[n] = mfma16(a, bh, acc[n]); acc[n] = mfma16(a, bl, acc[n]); }
            }
        }
#pragma unroll
        for (int nt = 0; nt < 3; ++nt)
#pragma unroll
            for (int r = 0; r < 4; ++r) LG[(g4 * 4 + r) * 48 + nt * 16 + l16] = acc[nt][r];
        LDS_WAIT();
        int id1 = 0, id2 = 0;
        if (lane < 16) {
            const int m = m0 + lane; const float rstd = row_rstd_full(SSQ, m); const float* lg = LG + lane * 48;
            float g[4];
#pragma unroll
            for (int j = 0; j < 4; ++j) g[j] = lg[j] * rstd + bg[j];
            float gmax = g[0]; int grp = 0;
#pragma unroll
            for (int j = 1; j < 4; ++j) if (g[j] > gmax) { gmax = g[j]; grp = j; }
            float den = 0.f;
#pragma unroll
            for (int j = 0; j < 4; ++j) den += expf(g[j] - gmax);
            const float psel = 1.0f / den;
            float e1 = -INFINITY, e2 = -INFINITY; int i1 = 0, i2 = 0;
            for (int j = 0; j < 8; ++j) { const float v = lg[4 + grp * 8 + j] * rstd + be[grp * 8 + j];
                if (v > e1) { e2 = e1; i2 = i1; e1 = v; i1 = j; } else if (v > e2) { e2 = v; i2 = j; } }
            const float x = expf(e2 - e1), w1 = 1.0f / (1.0f + x), w2 = x * w1;
            id1 = grp * 8 + i1; id2 = grp * 8 + i2;
            if (live) { TOKE[m * 2] = id1; TOKE[m * 2 + 1] = id2; TOKG[m * 2] = psel * w1; TOKG[m * 2 + 1] = psel * w2; }
        }
        __syncthreads();
        unsigned lp1 = 0u, lp2 = 0u;
        if (lane < 16 && live) { lp1 = __hip_atomic_fetch_add(HIST + id1, 1u, __ATOMIC_RELAXED, __HIP_MEMORY_SCOPE_WORKGROUP); lp2 = __hip_atomic_fetch_add(HIST + id2, 1u, __ATOMIC_RELAXED, __HIP_MEMORY_SCOPE_WORKGROUP); }
        __syncthreads();
        if (F.tid < 32) { const unsigned c = HIST[F.tid]; HIST[32 + F.tid] = c ? __hip_atomic_fetch_add(CNT + F.tid, c, RLX_AGENT) : 0u; }
        __syncthreads();
        if (lane < 16 && live) { const int m = m0 + lane; TOKP[m * 2] = (int)(HIST[32 + id1] + lp1); TOKP[m * 2 + 1] = (int)(HIST[32 + id2] + lp2); }
        __syncthreads();
    }
}
DEV int moe_tables(Frame& F, int l) {
    int* tab = (int*)(F.ldsg + TAB_OFF);
    if (F.tid == 0) {
        const unsigned* CNT = (const unsigned*)F.ctl + CW_CNT + l * 32; int off = 0;
#pragma unroll 1
        for (int e = 0; e < 32; ++e) { tab[e] = off; const int c = (int)__hip_atomic_load(CNT + e, RLX_AGENT); const int nt = (c + 255) >> 8;
            for (int i = 0; i < nt; ++i) tab[40 + (off >> 8) + i] = e;
            off += nt << 8; }
        tab[32] = off;
    }
    __syncthreads();
    return tab[32];
}
DEV void gather_phase(Frame& F, int l) {
    (void)moe_tables(F, l);
    const int* tab = (const int*)(F.ldsg + TAB_OFF);
    const int lane = F.lane; const int gw = F.vcu * NWAVES + F.wave, NGW = F.G * NWAVES;
    const bf16* HB = wsp<bf16>(F, WS_HB); const float* SSQ = wsp<float>(F, WS_SSQ); bf16* XS = wsp<bf16>(F, WS_XS);
    const int* TOKE = wsp<int>(F, WS_TOKE); const float* TOKG = wsp<float>(F, WS_TOKG); const int* TOKP = wsp<int>(F, WS_TOKP); int* TOKS = wsp<int>(F, WS_TOKS);
    float* SRSTD = wsp<float>(F, WS_SRSTD); float* SGATE = wsp<float>(F, WS_SGATE);
    const unsigned* CNT = (const unsigned*)F.ctl + CW_CNT + l * 32;
#pragma unroll 1
    for (int m0 = gw; m0 < NTOK; m0 += 4 * NGW) {
        int s0[4], s1[4]; float g0[4], g1[4], rs[4]; v4u a[4], c[4];
#pragma unroll
        for (int k = 0; k < 4; ++k) { const int m = m0 + k * NGW; const bool ok = m < NTOK; const int mm = ok ? m : m0;
            const int e0 = TOKE[mm * 2], e1 = TOKE[mm * 2 + 1], p0 = TOKP[mm * 2], p1 = TOKP[mm * 2 + 1];
            g0[k] = TOKG[mm * 2]; g1[k] = TOKG[mm * 2 + 1];
            a[k] = *(const v4u*)(HB + (size_t)mm * 1024 + lane * 8); c[k] = *(const v4u*)(HB + (size_t)mm * 1024 + 512 + lane * 8);
            rs[k] = row_rstd_full(SSQ, mm);
            s0[k] = tab[e0] + p0; s1[k] = tab[e1] + p1; }
#pragma unroll
        for (int k = 0; k < 4; ++k) { const int m = m0 + k * NGW;
            if (m < NTOK) {
                *(v4u*)(XS + (size_t)s0[k] * 1024 + lane * 8) = a[k]; *(v4u*)(XS + (size_t)s0[k] * 1024 + 512 + lane * 8) = c[k];
                *(v4u*)(XS + (size_t)s1[k] * 1024 + lane * 8) = a[k]; *(v4u*)(XS + (size_t)s1[k] * 1024 + 512 + lane * 8) = c[k];
                if (lane == 0) { SRSTD[s0[k]] = rs[k]; SRSTD[s1[k]] = rs[k]; SGATE[s0[k]] = g0[k]; SGATE[s1[k]] = g1[k]; TOKS[m * 2] = s0[k]; TOKS[m * 2 + 1] = s1[k]; } } }
    }
#pragma unroll 1
    for (int e = 0; e < 32; ++e) {
        const int c = (int)__hip_atomic_load(CNT + e, RLX_AGENT), base = tab[e], end = (e == 31 ? tab[32] : tab[e + 1]);
        for (int r = base + c + gw; r < end; r += NGW) {
            *(v4u*)(XS + (size_t)r * 1024 + lane * 8) = (v4u){0u, 0u, 0u, 0u}; *(v4u*)(XS + (size_t)r * 1024 + 512 + lane * 8) = (v4u){0u, 0u, 0u, 0u};
            if (lane == 0) { SRSTD[r] = 0.f; SGATE[r] = 0.f; }
        }
    }
}
DEV void combine_phase(Frame& F, int l, int probe = 0) {
    const int lane = F.lane; const int gw = F.vcu * NWAVES + F.wave, NGW = F.G * NWAVES;
    float* Ho = probe ? wsp<float>(F, WS_PROBE) : (float*)(GAS float*)F.out; const bf16* HBi = wsp<bf16>(F, WS_HB); bf16* HB = wsp<bf16>(F, probe ? WS_PROBE + 128 * MiB : WS_HB); float* SSQ = wsp<float>(F, probe ? WS_PROBE + 192 * MiB : WS_SSQ); const bf16* YS = wsp<bf16>(F, WS_YS); const int* TOKS = wsp<int>(F, WS_TOKS);
    const float* gf = inp(23);
#pragma unroll 1
    for (int m0 = gw; m0 < NTOK; m0 += 2 * NGW) {
        f32x4 v[2][4]; float ssum[2];
        int sl[2][2];
#pragma unroll
        for (int k = 0; k < 2; ++k) { const int m = (m0 + k * NGW < NTOK) ? m0 + k * NGW : m0; sl[k][0] = TOKS[m * 2]; sl[k][1] = TOKS[m * 2 + 1]; }
        v2u h[2][4]; v2u ya[2][4], yb[2][4];
#pragma unroll
        for (int k = 0; k < 2; ++k) { const int m = (m0 + k * NGW < NTOK) ? m0 + k * NGW : m0;
#pragma unroll
            for (int j = 0; j < 4; ++j) { const int c = lane * 4 + 256 * j;
                h[k][j] = *(const v2u*)(HBi + (size_t)m * 1024 + c);
                ya[k][j] = *(const v2u*)(YS + (size_t)sl[k][0] * 1024 + c); yb[k][j] = *(const v2u*)(YS + (size_t)sl[k][1] * 1024 + c); } }
#pragma unroll
        for (int k = 0; k < 2; ++k) { float ss = 0.f;
#pragma unroll
            for (int j = 0; j < 4; ++j) { const v2u a = ya[k][j], bq = yb[k][j]; const f32x4 hh = (f32x4){bflo(h[k][j].x), bfhi(h[k][j].x), bflo(h[k][j].y), bfhi(h[k][j].y)};
                f32x4 r; r[0] = hh[0] + (bflo(a.x) + bflo(bq.x)); r[1] = hh[1] + (bfhi(a.x) + bfhi(bq.x)); r[2] = hh[2] + (bflo(a.y) + bflo(bq.y)); r[3] = hh[3] + (bfhi(a.y) + bfhi(bq.y));
                v[k][j] = r; ss += (r[0] * r[0] + r[1] * r[1]) + (r[2] * r[2] + r[3] * r[3]); }
            ssum[k] = wave_sum(ss); }
#pragma unroll
        for (int k = 0; k < 2; ++k) { const int m = m0 + k * NGW;
            if (m < NTOK) {
                if (l == DEPTH - 1) {
                    const float rstd = 1.0f / sqrtf(ssum[k] * (1.0f / 1024.0f) + RMS_EPS);
#pragma unroll
                    for (int j = 0; j < 4; ++j) { const int c = lane * 4 + 256 * j; const f32x4 g = *(const f32x4*)(gf + c); *(f32x4*)(Ho + (size_t)m * 1024 + c) = v[k][j] * rstd * g; }
                } else {
#pragma unroll
                    for (int j = 0; j < 4; ++j) { const int c = lane * 4 + 256 * j;
                        v2u w; w.x = pk2(v[k][j][0], v[k][j][1]); w.y = pk2(v[k][j][2], v[k][j][3]); *(v2u*)(HB + (size_t)m * 1024 + c) = w; }
                    if (lane < 16) SSQ[(size_t)m * 16 + lane] = lane == 0 ? ssum[k] : 0.f;
                } } }
    }
}
#ifndef MK_ONE_LAUNCH
#define MK_ONE_LAUNCH 1
#endif
constexpr int NPH_LAYER = 13, NPHASES = 1 + DEPTH * NPH_LAYER;
struct Args { const float* in[24]; float* out; unsigned char* ws; int ph_lo, ph_hi; };
static_assert(sizeof(Args) == 24 * 8 + 8 + 8 + 8, "Args has no padding");

__global__ void __launch_bounds__(NWAVES * 64, 2) hymba_fwd(Args args) {
    extern __shared__ __attribute__((aligned(16))) unsigned char lds[];
    Frame F;
    F.lds = (LAS unsigned char*)lds; F.ldsg = lds;
    F.MISC = (volatile LAS unsigned*)(F.lds + MISC_OFF);
    F.tid = threadIdx.x; F.lane = F.tid & 63; F.wave = __builtin_amdgcn_readfirstlane(F.tid >> 6);
    F.G = gridDim.x; { const int bx = blockIdx.x; F.vcu = (F.G % 8 == 0) ? (bx % 8) * (F.G / 8) + bx / 8 : bx; }
    F.ws = args.ws; F.ctl = (gu32*)(args.ws + WS_CTL); F.out = args.out;
    if (F.tid < 64) ((LAS unsigned*)(F.lds + MISC_OFF))[F.tid] = 0u;
    __syncthreads();
    int wave0 = F.wave;
    const int lo = args.ph_lo, hi = args.ph_hi;
    XcdBarrier bar; bar.bar = (unsigned*)(F.ctl + CW_BAR); bar.x = 0; bar.st = nullptr;
    if (hi - lo > 1) bar = xcd_barrier_post((unsigned*)(F.ctl + CW_BAR), F.MISC + 8);
#ifndef PHMASK
#define PHMASK 0xFFFF
#endif
#define IN(k) (lo <= (k) && (k) < hi)
#define EN(j) ((PHMASK >> (j)) & 1)
#define RELAUNDER() do { asm volatile("" : "+s"(wave0)); unsigned z_ = 0u; asm volatile("" : "+v"(z_)); int t_ = wave0 * 64 + (int)__builtin_amdgcn_mbcnt_hi(~0u, __builtin_amdgcn_mbcnt_lo(~0u, z_)); F.tid = t_; F.lane = t_ & 63; F.wave = wave0; \
    size_t zo_ = 0; asm volatile("" : "+s"(zo_), "+s"(F.vcu), "+s"(F.G)); F.ws = args.ws + zo_; F.out = args.out + zo_; F.ctl = (gu32*)(F.ws + WS_CTL); } while (0)
#ifndef NSA_VAR
#define NSA_VAR 0
#endif
#ifndef BAR2X
#define BAR2X 0
#endif
#ifndef DUPMASK
#define DUPMASK 0
#endif
#define DUP(j) ((DUPMASK >> (j)) & 1)
#ifndef STAG_J0
#define STAG_J0 0
#endif
#ifndef STAG_MOE
#define STAG_MOE 0
#endif
#define STAGGER(ticks) do { if ((ticks) > 0 && (F.vcu & 1)) { const unsigned long long t0_ = __builtin_amdgcn_s_memrealtime(); while (__builtin_amdgcn_s_memrealtime() - t0_ < (unsigned long long)(ticks)) __builtin_amdgcn_s_sleep(32); } } while (0)
#define SEAM(k) do { if (IN(k) && IN((k) + 1)) { XcdBarrier b_ = bar; size_t zb_ = 0; asm volatile("" : "+s"(b_.x), "+s"(zb_)); b_.bar = (unsigned*)(args.ws + WS_CTL + zb_) + CW_BAR; xcd_barrier(b_); if (BAR2X) xcd_barrier(b_); } } while (0)

    if (IN(0) && EN(13)) { RELAUNDER(); p0_prologue(F); if (DUP(13)) { __syncthreads(); p0_prologue(F); } } SEAM(0);

#pragma unroll 1
    for (int l = 0; l < DEPTH; ++l) {
        const int pb = 1 + l * NPH_LAYER;
        bf16* HB = wsp<bf16>(F, WS_HB); float* SSQ = wsp<float>(F, WS_SSQ);
        if (IN(pb + 0) && EN(0)) for (int rep_ = 0; rep_ < (DUP(0) ? 2 : 1); ++rep_) { RELAUNDER(); if (rep_) __syncthreads();
            pg8::Gemm g{HB, wsp<bf16>(F, WS_WIN) + (size_t)l * NIN * 1024, NTOK, 3072, D};
            pg8::StaticOrder S; S.init(NTOK, 3072, F.G, (int)blockIdx.x);
            EpiIn E{F.ws};
            STAGGER(STAG_J0);
            pg8::gemm_phase<EpiIn, pg8::StaticOrder, true, true>(F.lds, g, S, E, F.wave);
        }
        SEAM(pb + 0);
        if (IN(pb + 1) && EN(1)) { RELAUNDER();
            compress_phase(F, l);
            hgrn_local_phase(F, l);
            conv_phase(F, l);
            kmax_phase(F, l);
            if (l == 0) memkv_phase(F);
            if (DUP(1)) { __syncthreads(); compress_phase(F, l); hgrn_local_phase(F, l); conv_phase(F, l); }
        }
        SEAM(pb + 1);
        if (IN(pb + 2) && EN(2)) { RELAUNDER(); hgrn_scan_phase(F); if (DUP(14)) hgrn_scan_phase(F, 1); nsa_phase(F, l); if (DUP(2)) { __syncthreads(); nsa_phase_t<NSA_VAR>(F, l); } }
        SEAM(pb + 2);
        if (IN(pb + 3) && EN(3)) { RELAUNDER(); hgrn_out_phase(F, l); if (DUP(3)) { __syncthreads(); hgrn_out_phase(F, l); } }
        SEAM(pb + 3);
        if (IN(pb + 4) && EN(4)) for (int rep_ = 0; rep_ < ((DUP(4) && l == 0) ? 2 : 1); ++rep_) { RELAUNDER(); if (rep_) __syncthreads();
            pg8::Gemm g{wsp<bf16>(F, WS_CAT), wsp<bf16>(F, WS_WOUT) + (size_t)l * 1024 * 1024, NTOK, D, D};
            pg8::StaticOrder S; S.init(NTOK, D, F.G, (int)blockIdx.x);
            EpiRes E{l == 0 ? inp(0) : (const float*)nullptr, HB, SSQ};
            pg8::gemm_phase<EpiRes, pg8::StaticOrder, true, true>(F.lds, g, S, E, F.wave);
        }
        SEAM(pb + 4);
        if (IN(pb + 5) && EN(5)) for (int rep_ = 0; rep_ < (DUP(5) ? 2 : 1); ++rep_) { RELAUNDER(); if (rep_) __syncthreads();
            pg8::Gemm g{HB, wsp<bf16>(F, WS_WQ) + (size_t)l * 256 * 1024, NTOK, 256, D};
            pg8::StaticOrder S; S.init(NTOK, 256, F.G, (int)blockIdx.x);
            EpiXQ E{SSQ, wsp<bf16>(F, WS_XQ)};
            pg8::gemm_phase<EpiXQ, pg8::StaticOrder, true, true>(F.lds, g, S, E, F.wave);
        }
        SEAM(pb + 5);
        if (IN(pb + 6) && EN(6)) { RELAUNDER(); cross_phase(F, l); if (DUP(6)) { __syncthreads(); cross_phase(F, l); } }
        SEAM(pb + 6);
        if (IN(pb + 7) && EN(7)) { RELAUNDER();
            pg8::Gemm g{wsp<bf16>(F, WS_XO), wsp<bf16>(F, WS_WO) + (size_t)l * 1024 * 256, NTOK, D, 256};
            pg8::StaticOrder S; S.init(NTOK, D, F.G, (int)blockIdx.x);
            EpiRes E{(const float*)nullptr, HB, SSQ};
            pg8::gemm_phase<EpiRes, pg8::StaticOrder, true, true>(F.lds, g, S, E, F.wave);
        }
        SEAM(pb + 7);
        if (IN(pb + 8) && EN(8)) { RELAUNDER(); router_phase(F, l); if (DUP(8)) router_phase(F, l, 1); }
        SEAM(pb + 8);
        if (IN(pb + 9) && EN(9)) { RELAUNDER(); gather_phase(F, l); if (DUP(9)) { __syncthreads(); gather_phase(F, l); } }
        SEAM(pb + 9);
        if (IN(pb + 10) && EN(10)) for (int rep_ = 0; rep_ < (DUP(10) ? 2 : 1); ++rep_) { RELAUNDER(); if (rep_) __syncthreads();
            const int ns = moe_tables(F, l);
            pg8::Gemm g{wsp<bf16>(F, WS_XS), wsp<bf16>(F, WS_WGU) + (size_t)l * 32 * 1024 * 1024, ns, 32 * 1024, D};
            MoeOrder S{(ns >> 8) * 4, F.G, (int)blockIdx.x, (const LAS int*)(F.lds + TAB_OFF) + 40};
            EpiGU E{wsp<float>(F, WS_SRSTD), wsp<bf16>(F, WS_ACT)};
            STAGGER(STAG_MOE);
            pg8::gemm_phase<EpiGU, MoeOrder, true, true>(F.lds, g, S, E, F.wave);
        }
        SEAM(pb + 10);
        if (IN(pb + 11) && EN(11)) for (int rep_ = 0; rep_ < (DUP(11) ? 2 : 1); ++rep_) { RELAUNDER(); if (rep_) __syncthreads();
            const int ns = moe_tables(F, l);
            pg8::Gemm g{wsp<bf16>(F, WS_ACT), wsp<bf16>(F, WS_WDN) + (size_t)l * 32 * 1024 * 512, ns, 32 * 1024, 512};
            MoeOrder S{(ns >> 8) * 4, F.G, (int)blockIdx.x, (const LAS int*)(F.lds + TAB_OFF) + 40};
            EpiDN E{wsp<float>(F, WS_SGATE), wsp<bf16>(F, WS_YS)};
            STAGGER(STAG_MOE / 2);
            pg8::gemm_phase<EpiDN, MoeOrder, true, true>(F.lds, g, S, E, F.wave);
        }
        SEAM(pb + 11);
        if (IN(pb + 12) && EN(12)) { RELAUNDER(); combine_phase(F, l); if (DUP(12)) combine_phase(F, l, 1); }
        SEAM(pb + 12);
    }
#undef IN
#undef SEAM
}

extern "C" void kernel_launch(void* const* d_in, const int* in_sizes, int n_in, void* d_out, int out_size, void* d_ws, size_t ws_size, hipStream_t stream) {
    static int grid = 0;
    if (grid == 0) {
        if (n_in != 24 || in_sizes[0] != NTOK * D || out_size != NTOK * D || ws_size < WS_END) {
            fprintf(stderr, "kernel_launch: unexpected shapes: n_in %d in0 %d out %d ws %zu (need %zu)\n", n_in, n_in > 0 ? in_sizes[0] : -1, out_size, ws_size, (size_t)WS_END); grid = -1; return; }
        int dev = 0, cus = 0, per_cu = 0;
        if (hipGetDevice(&dev) != hipSuccess || hipDeviceGetAttribute(&cus, hipDeviceAttributeMultiprocessorCount, dev) != hipSuccess) { grid = -1; return; }
        if (hipFuncSetAttribute((const void*)hymba_fwd, hipFuncAttributeMaxDynamicSharedMemorySize, LDS_BYTES) != hipSuccess) { fprintf(stderr, "kernel_launch: hipFuncSetAttribute failed\n"); grid = -1; return; }
        if (hipOccupancyMaxActiveBlocksPerMultiprocessor(&per_cu, (const void*)hymba_fwd, NWAVES * 64, LDS_BYTES) != hipSuccess || per_cu < 1)
            fprintf(stderr, "kernel_launch: note: occupancy query reports %d blocks per CU\n", per_cu);
        (void)hipGetLastError();
        grid = cus;
    }
    if (grid < 0) return;
    if (hipMemsetAsync((char*)d_ws + WS_CTL, 0, CTL_ZERO_BYTES, stream) != hipSuccess) { fprintf(stderr, "kernel_launch: memset failed\n"); return; }
    Args a{};
    for (int i = 0; i < 24; ++i) a.in[i] = (const float*)d_in[i];
    a.out = (float*)d_out; a.ws = (unsigned char*)d_ws;
#if MK_ONE_LAUNCH
    a.ph_lo = 0; a.ph_hi = NPHASES;
    hipLaunchKernelGGL(hymba_fwd, dim3(grid), dim3(NWAVES * 64), LDS_BYTES, stream, a);
#else
    for (int p = 0; p < NPHASES; ++p) { a.ph_lo = p; a.ph_hi = p + 1; hipLaunchKernelGGL(hymba_fwd, dim3(grid), dim3(NWAVES * 64), LDS_BYTES, stream, a); }
#endif
    const hipError_t le = hipPeekAtLastError();
    if (le != hipSuccess) fprintf(stderr, "kernel_launch: launch failed: %s\n", hipGetErrorName(le));
}
```

```cpp
#define MK_ONE_LAUNCH 1
#include <hip/hip_runtime.h>
#include <cstdio>
#include <cstdint>
#include <cmath>
namespace pg8 {
#define PG8_LAS __attribute__((address_space(3)))
typedef unsigned short bf16_t;
typedef short bf16x8 __attribute__((ext_vector_type(8)));
typedef float f32x4 __attribute__((ext_vector_type(4)));
typedef unsigned u32x4 __attribute__((ext_vector_type(4)));
constexpr int BM = 256, BK = 64, HALF = 128, HTB = HALF * BK * 2  , STAGE_BYTES = 8 * HTB, NXCD = 8, WGM = 8;

__host__ __device__ __forceinline__ int lds_byte(int r, int c) { const int st = (r >> 4) * 2 + (c >> 5), rr = r & 15, cc = c & 31, ob = rr * 64 + cc * 2; return st * 1024 + (ob ^ (((ob >> 9) & 1) << 5)); }
__host__ __device__ __forceinline__ void stage_rc(int b, int& R, int& C) { const int st = b / 1024, sb = b % 1024, swz = sb ^ (((sb >> 9) & 1) << 5); R = (st >> 1) * 16 + swz / 64; C = (st & 1) * 32 + (swz % 64) / 2; }
__host__ __device__ __forceinline__ int perm32(int rho) { const int n = rho >> 4, i = rho & 15; return 8 * (i >> 2) + 4 * n + (i & 3); }

struct Unit { int pm, pn; };
struct Gemm { const bf16_t* A; const bf16_t* Bt; int M, N, K; };

struct StaticOrder {
    int nM, nN, nwg, G, c;
    __host__ __device__ void init(int M, int N, int G_, int c_) { nM = M / BM; nN = N / BM; nwg = nM * nN; G = G_; c = c_; }
    __host__ __device__ bool next(int i, Unit& u) const {
        const long L = (long)i * G + c; if (L >= nwg) return false;
        int wgid = (int)L; { const int q = nwg / NXCD, r = nwg % NXCD, xcd = wgid % NXCD, off = wgid / NXCD; wgid = (xcd < r ? xcd * (q + 1) : r * (q + 1) + (xcd - r) * q) + off; }
        const int nig = WGM * nN, gid = wgid / nig, fm = gid * WGM, gsz = (nM - fm) < WGM ? (nM - fm) : WGM;
        u.pm = fm + ((wgid % nig) % gsz); u.pn = (wgid % nig) / gsz; return true;
    }
    __device__ __forceinline__ void a_ready(const Unit&) const {}
    __device__ __forceinline__ void done(const Unit&) const {}
};

__device__ __forceinline__ unsigned cvt_pk_bf16(float lo, float hi) { unsigned r; asm volatile("v_cvt_pk_bf16_f32 %0, %1, %2" : "=v"(r) : "v"(lo), "v"(hi)); return r; }
typedef float f32x2 __attribute__((ext_vector_type(2)));
template <class Epi, class Sched, bool ALIGN_EPI = false, bool SP2 = false>
__device__ __forceinline__ void gemm_phase(PG8_LAS unsigned char* lds, const Gemm g, const Sched& S, const Epi& E, int wave_id) {
    unsigned z_ = 0u; asm volatile("" : "+v"(z_)); int tid_ = wave_id * 64 + (int)__builtin_amdgcn_mbcnt_hi(~0u, __builtin_amdgcn_mbcnt_lo(~0u, z_));
    const int tid = tid_, wid = __builtin_amdgcn_readfirstlane(tid >> 6), lane = tid & 63, wr = wid >> 2, wc = wid & 3, fr = lane & 15, fq = lane >> 4;
    const int K = g.K, nt = K / BK;
    unsigned voffA[2], voffB[2];
#pragma unroll
    for (int i = 0; i < 2; ++i) { int R, C; stage_rc(tid * 16 + i * 8192, R, C); const int Rb = Epi::PERM ? ((R & ~31) + perm32(R & 31)) : R;
        voffA[i] = (unsigned)(R * K + C) * 2u; voffB[i] = (unsigned)(Rb * K + C) * 2u; }
    const size_t kstep = (size_t)(BK * 2);
    const size_t hstep = (size_t)HALF * K * 2;
    const size_t tstep = 2 * hstep;
    const unsigned ldsw = (unsigned)wid * 1024u;
    const int aoff = lds_byte(wr * 64 + fr, fq * 8), boff = lds_byte(wc * 32 + fr, fq * 8);
#define PG8_SA(b, h) (((b) * 2 + (h)) * HTB)
#define PG8_SB(b, h) ((4 + (b) * 2 + (h)) * HTB)
#define PG8_STAGE(bufoff, gbase, voff) do { _Pragma("unroll") for (int _i = 0; _i < 2; ++_i) \
        __builtin_amdgcn_global_load_lds((const unsigned*)((const char*)(gbase) + (voff)[_i]), (PG8_LAS unsigned*)(lds + (bufoff) + ldsw + _i * 8192), 16, 0, 0); } while (0)
#define PG8_LDA(dst, b, h) do { _Pragma("unroll") for (int m = 0; m < 4; ++m) _Pragma("unroll") for (int k = 0; k < 2; ++k) dst[m][k] = *(const PG8_LAS bf16x8*)(lds + PG8_SA(b, h) + aoff + m * 2048 + k * 1024); } while (0)
#define PG8_LDB(dst, b, h) do { _Pragma("unroll") for (int n = 0; n < 2; ++n) _Pragma("unroll") for (int k = 0; k < 2; ++k) dst[n][k] = *(const PG8_LAS bf16x8*)(lds + PG8_SB(b, h) + boff + n * 2048 + k * 1024); } while (0)
#define PG8_MMA(ai, bj, At, Bt) do { __builtin_amdgcn_s_setprio(1); _Pragma("unroll") for (int m = 0; m < 4; ++m) _Pragma("unroll") for (int n = 0; n < 2; ++n) _Pragma("unroll") for (int k = 0; k < 2; ++k) \
        acc[ai][bj][m][n] = __builtin_amdgcn_mfma_f32_16x16x32_bf16(Bt[n][k], At[m][k], acc[ai][bj][m][n], 0, 0, 0); __builtin_amdgcn_s_setprio(0); } while (0)
#define PG8_WAIT_V(n) asm volatile("s_waitcnt vmcnt(" #n ")" ::: "memory")
#define PG8_WAIT_L(n) asm volatile("s_waitcnt lgkmcnt(" #n ")" ::: "memory")
#define PG8_BAR __builtin_amdgcn_s_barrier()
#define PG8_SCHED __builtin_amdgcn_sched_barrier(0)
    Unit cur, nxt; int ui = 0;
    if (!S.next(0, cur)) return;
    f32x4 acc[2][2][4][2];
#pragma unroll
    for (int a = 0; a < 2; ++a)
#pragma unroll
        for (int b = 0; b < 2; ++b)
#pragma unroll
            for (int m = 0; m < 4; ++m)
#pragma unroll
                for (int n = 0; n < 2; ++n) acc[a][b][m][n] = (f32x4){0.f, 0.f, 0.f, 0.f};
    bf16x8 At[4][2], B0[2][2], B1[2][2];
    const char* cA = (const char*)g.A + (size_t)cur.pm * tstep; const char* cB = (const char*)g.Bt + (size_t)cur.pn * tstep;
    S.a_ready(cur);
    if constexpr (SP2) {
        PG8_STAGE(PG8_SB(0, 0), cB, voffB); PG8_STAGE(PG8_SB(0, 1), cB + hstep, voffB); PG8_STAGE(PG8_SA(0, 0), cA, voffA); PG8_STAGE(PG8_SA(0, 1), cA + hstep, voffA);
        if (wr == 1) PG8_BAR;
        PG8_WAIT_V(2); PG8_BAR;
        PG8_STAGE(PG8_SB(1, 0), cB + kstep, voffB); PG8_STAGE(PG8_SA(1, 0), cA + kstep, voffA); PG8_STAGE(PG8_SB(1, 1), cB + hstep + kstep, voffB);
        PG8_WAIT_V(6); PG8_BAR;
    } else {
        PG8_STAGE(PG8_SB(0, 0), cB, voffB); PG8_STAGE(PG8_SA(0, 0), cA, voffA); PG8_STAGE(PG8_SB(0, 1), cB + hstep, voffB); PG8_STAGE(PG8_SA(0, 1), cA + hstep, voffA);
        if (wr == 1) PG8_BAR;
        PG8_WAIT_V(4); PG8_BAR;
        PG8_STAGE(PG8_SB(1, 0), cB + kstep, voffB); PG8_STAGE(PG8_SA(1, 0), cA + kstep, voffA); PG8_STAGE(PG8_SB(1, 1), cB + hstep + kstep, voffB);
        PG8_WAIT_V(6); PG8_BAR;
    }
    for (;;) {
        const bool has_next = S.next(ui + 1, nxt);
        const char* nA = has_next ? (const char*)g.A + (size_t)nxt.pm * tstep : cA; const char* nB = has_next ? (const char*)g.Bt + (size_t)nxt.pn * tstep : cB;
        for (int t = 0; t < nt; t += 2) {
            const bool last = (t == nt - 2);
            const char* a1 = cA + (size_t)(t + 1) * kstep;
            const char* a2 = last ? nA : cA + (size_t)(t + 2) * kstep; const char* b2 = last ? nB : cB + (size_t)(t + 2) * kstep;
            const char* a3 = a2 + kstep; const char* b3 = b2 + kstep;
            if (last && has_next) S.a_ready(nxt);
            if constexpr (SP2) {
            PG8_LDB(B0, 0, 0); PG8_LDB(B1, 0, 1); PG8_SCHED; PG8_LDA(At, 0, 0); PG8_STAGE(PG8_SA(1, 1), a1 + hstep, voffA);
            PG8_WAIT_V(8); PG8_WAIT_L(0); PG8_BAR; PG8_MMA(0, 0, At, B0); PG8_MMA(0, 1, At, B1); PG8_BAR; PG8_SCHED;
            PG8_LDA(At, 0, 1); PG8_STAGE(PG8_SB(0, 0), b2, voffB); PG8_STAGE(PG8_SB(0, 1), b2 + hstep, voffB); PG8_STAGE(PG8_SA(0, 0), a2, voffA);
            PG8_WAIT_V(8); PG8_WAIT_L(0); PG8_BAR; PG8_MMA(1, 0, At, B0); PG8_MMA(1, 1, At, B1); PG8_BAR; PG8_SCHED;
            PG8_LDB(B0, 1, 0); PG8_LDB(B1, 1, 1); PG8_SCHED; PG8_LDA(At, 1, 0); PG8_STAGE(PG8_SA(0, 1), a2 + hstep, voffA);
            PG8_WAIT_V(8); PG8_WAIT_L(0); PG8_BAR; PG8_MMA(0, 0, At, B0); PG8_MMA(0, 1, At, B1); PG8_BAR; PG8_SCHED;
            PG8_LDA(At, 1, 1); PG8_STAGE(PG8_SB(1, 0), b3, voffB); PG8_STAGE(PG8_SB(1, 1), b3 + hstep, voffB); PG8_STAGE(PG8_SA(1, 0), a3, voffA);
            PG8_WAIT_V(8); PG8_WAIT_L(0); PG8_BAR; PG8_MMA(1, 0, At, B0); PG8_MMA(1, 1, At, B1); PG8_BAR; PG8_SCHED;
            } else {
            PG8_LDB(B0, 0, 0); PG8_SCHED; PG8_LDA(At, 0, 0); PG8_STAGE(PG8_SA(1, 1), a1 + hstep, voffA);
            PG8_WAIT_L(8); PG8_BAR; PG8_WAIT_L(0); PG8_MMA(0, 0, At, B0); PG8_BAR; PG8_SCHED;
            PG8_LDB(B1, 0, 1); PG8_STAGE(PG8_SB(0, 0), b2, voffB);
            PG8_BAR; PG8_WAIT_L(0); PG8_MMA(0, 1, At, B1); PG8_BAR;
            PG8_LDA(At, 0, 1); PG8_STAGE(PG8_SA(0, 0), a2, voffA);
            PG8_BAR; PG8_WAIT_L(0); PG8_MMA(1, 0, At, B0); PG8_BAR; PG8_SCHED;
            PG8_STAGE(PG8_SB(0, 1), b2 + hstep, voffB);
            PG8_WAIT_V(6); PG8_BAR; PG8_MMA(1, 1, At, B1); PG8_BAR;
            PG8_LDB(B0, 1, 0); PG8_SCHED; PG8_LDA(At, 1, 0); PG8_STAGE(PG8_SA(0, 1), a2 + hstep, voffA);
            PG8_WAIT_L(8); PG8_BAR; PG8_WAIT_L(0); PG8_MMA(0, 0, At, B0); PG8_BAR; PG8_SCHED;
            PG8_LDB(B1, 1, 1); PG8_STAGE(PG8_SB(1, 0), b3, voffB);
            PG8_BAR; PG8_WAIT_L(0); PG8_MMA(0, 1, At, B1); PG8_BAR;
            PG8_LDA(At, 1, 1); PG8_STAGE(PG8_SA(1, 0), a3, voffA);
            PG8_BAR; PG8_WAIT_L(0); PG8_MMA(1, 0, At, B0); PG8_BAR; PG8_SCHED;
            PG8_STAGE(PG8_SB(1, 1), b3 + hstep, voffB);
            PG8_WAIT_V(6); PG8_BAR; PG8_MMA(1, 1, At, B1); PG8_BAR;
            }
        }
        if constexpr (ALIGN_EPI) { if (wr == 0) PG8_BAR; }
        if constexpr (!Epi::AFTER_DRAIN) { E(acc, cur, wr, wc, fr, fq); S.done(cur); }
        if (!has_next) break;
#pragma unroll
        for (int a = 0; a < 2; ++a)
#pragma unroll
            for (int b = 0; b < 2; ++b)
#pragma unroll
                for (int m = 0; m < 4; ++m)
#pragma unroll
                    for (int n = 0; n < 2; ++n) acc[a][b][m][n] = (f32x4){0.f, 0.f, 0.f, 0.f};
        cur = nxt; cA = nA; cB = nB; ++ui;
        if constexpr (ALIGN_EPI) { if (wr == 1) PG8_BAR; }
    }
    PG8_WAIT_V(0);
    if constexpr (!ALIGN_EPI) { if (wr == 0) PG8_BAR; }
    PG8_BAR;
    if constexpr (Epi::AFTER_DRAIN) { E.fused(acc, cur, wr, wc, fr, fq, lds, wid, lane); S.done(cur); }
#undef PG8_SA
#undef PG8_SB
#undef PG8_STAGE
#undef PG8_LDA
#undef PG8_LDB
#undef PG8_MMA
#undef PG8_WAIT_V
#undef PG8_WAIT_L
#undef PG8_BAR
#undef PG8_SCHED
}
}
constexpr int NB = 4, T = 8192, D = 1024, NTOK = NB * T, DEPTH = 2;
constexpr int NIN = 3328;
constexpr int IN_W = 3096;
constexpr int NSLOT_MAX = 65536 + 32 * 256;
constexpr float RMS_EPS = 1e-6f;
constexpr float QSCALE = 0.125f * 1.44269504088896f;
constexpr int NWAVES = 8;

constexpr size_t MiB = 1u << 20;
constexpr size_t WS_CTL = 0, CTL_ZERO_BYTES = 1 * MiB;
constexpr size_t WS_ROPE = 1 * MiB;
constexpr size_t WS_SMALL = 3 * MiB;
constexpr size_t WS_WG = 3 * MiB + 65536;
constexpr size_t WS_SSQ = 4 * MiB;
constexpr size_t WS_WIN = 8 * MiB;
constexpr size_t WS_WOUT = 22 * MiB;
constexpr size_t WS_WQ = 26 * MiB;
constexpr size_t WS_WKV = 27 * MiB;
constexpr size_t WS_WO = 29 * MiB;
constexpr size_t WS_WR = 30 * MiB;
constexpr size_t WS_W1C = 31 * MiB;
constexpr size_t WS_W2C = 33 * MiB;
constexpr size_t WS_MEMB = 34 * MiB;
constexpr size_t WS_MK = 36 * MiB;
constexpr size_t WS_MVT = 37 * MiB;
constexpr size_t WS_WGU = 40 * MiB;
constexpr size_t WS_WDN = 168 * MiB;
constexpr size_t WS_HB = 232 * MiB;
constexpr size_t WS_Q = 296 * MiB, WS_QR = 328 * MiB, WS_KCR = 360 * MiB, WS_VCR = 368 * MiB, WS_KS = 376 * MiB, WS_KW = 384 * MiB;
constexpr size_t WS_VST = 392 * MiB, WS_VWT = 400 * MiB, WS_KCC = 408 * MiB, WS_VCT = 409 * MiB, WS_GATE = 410 * MiB;
constexpr size_t WS_CB = 414 * MiB, WS_CC = 430 * MiB, WS_CH = 446 * MiB;
constexpr size_t WS_HQ = 462 * MiB, WS_HF = 494 * MiB, WS_HI = 526 * MiB, WS_HG = 558 * MiB;
constexpr size_t WS_CAT = 590 * MiB, WS_U = 654 * MiB, WS_DEC = 686 * MiB;
constexpr size_t WS_XQ = 688 * MiB, WS_XO = 704 * MiB;
constexpr size_t WS_XS = 296 * MiB, WS_ACT = 440 * MiB, WS_YS = 512 * MiB;
constexpr size_t WS_TOKE = 720 * MiB, WS_TOKG = 721 * MiB, WS_TOKP = 722 * MiB, WS_TOKS = 723 * MiB, WS_SRSTD = 724 * MiB, WS_SGATE = 725 * MiB;
constexpr size_t WS_U2 = 728 * MiB;
constexpr size_t WS_PROBE = 760 * MiB;
constexpr size_t WS_END = 760 * MiB;
static_assert(WS_XS + (size_t)NSLOT_MAX * 1024 * 2 <= WS_ACT && WS_ACT + (size_t)NSLOT_MAX * 512 * 2 <= WS_YS && WS_YS + (size_t)NSLOT_MAX * 1024 * 2 <= WS_XQ, "moe map");
constexpr int CW_CNT = 64;
constexpr int CW_KMAX = 256;
constexpr int CW_BAR = 4096;

constexpr int RING_BYTES = 131072;
constexpr int NSA_LDS_WAVE = 10752;
constexpr int MISC_OFF = RING_BYTES;
constexpr int TAB_OFF = RING_BYTES + 512;
constexpr int LDS_BYTES = 147456;
static_assert(8 * NSA_LDS_WAVE <= RING_BYTES && TAB_OFF + 4 * (40 + 320) <= LDS_BYTES, "LDS map");

#define GAS __attribute__((address_space(1)))
#define LAS __attribute__((address_space(3)))
#define DEV __device__ __forceinline__
typedef unsigned short bf16;
typedef unsigned v4u __attribute__((ext_vector_type(4)));
typedef unsigned v2u __attribute__((ext_vector_type(2)));
typedef float f32x4 __attribute__((ext_vector_type(4)));
typedef short bf16x8 __attribute__((ext_vector_type(8)));
typedef GAS unsigned gu32;
#define RLX_AGENT __ATOMIC_RELAXED, __HIP_MEMORY_SCOPE_AGENT
#define LDS_WAIT() asm volatile("s_waitcnt lgkmcnt(0)" ::: "memory")
#define VM_WAIT() asm volatile("s_waitcnt vmcnt(0)" ::: "memory")
typedef __bf16 bf16x2_t __attribute__((ext_vector_type(2)));
typedef float f32x2_t __attribute__((ext_vector_type(2)));
DEV unsigned pk2(float lo, float hi) { const f32x2_t v = {lo, hi}; return __builtin_bit_cast(unsigned, __builtin_convertvector(v, bf16x2_t)); }
DEV unsigned f2bf(float f) { return pk2(f, 0.f) & 0xffffu; }
DEV float bf2f(unsigned short b) { return __builtin_bit_cast(float, (unsigned)b << 16); }
DEV float bflo(unsigned w) { return __builtin_bit_cast(float, w << 16); }
DEV float bfhi(unsigned w) { return __builtin_bit_cast(float, w & 0xffff0000u); }
DEV float ex2(float x) { return __builtin_amdgcn_exp2f(x); }
DEV float wave_sum(float v) {
#pragma unroll
    for (int o = 1; o < 64; o <<= 1) v += __shfl_xor(v, o);
    return v;
}
DEV f32x4 mfma16(bf16x8 a, bf16x8 b, f32x4 c) { return __builtin_amdgcn_mfma_f32_16x16x32_bf16(a, b, c, 0, 0, 0); }
DEV int slot32(int k) { return ((k >> 2) & 3) * 8 + (k >> 4) * 4 + (k & 3); }
DEV int kfrag_off(int key, int d) { return (key >> 5) * 2048 + ((((key >> 4) & 1) * 2 + (d >> 5)) * 64 + ((d >> 3) & 3) * 16 + (key & 15)) * 8 + (d & 7); }
DEV float sigmoidf_(float x) { return 1.0f / (1.0f + __expf(-x)); }
DEV float siluf_(float x) { return x / (1.0f + __expf(-x)); }
#define XB_TMO      128
#define XB_XCNT(j)  (256  + 64 * (j))
#define XB_XSUB(j)  (1280 + 64 * (j))
#define XB_XGEN(j)  (2304 + 64 * (j))
#define XB_TOP      3328
#define XB_TOPGEN   3392
#define XCD_BAR_WORDS 3456
#define XB_SPIN_CAP (1u << 18)

__device__ __forceinline__ unsigned xb_ld(unsigned* p)              { return __hip_atomic_load(p, __ATOMIC_RELAXED, __HIP_MEMORY_SCOPE_AGENT); }
__device__ __forceinline__ unsigned xb_add(unsigned* p, unsigned v) { return __hip_atomic_fetch_add(p, v, __ATOMIC_RELAXED, __HIP_MEMORY_SCOPE_AGENT); }
__device__ __forceinline__ unsigned xb_xcc_id() { return (unsigned)__builtin_amdgcn_s_getreg((3 << 11) | 20) & 0xFu; }
#define XB_SPIN(cond, bar) do { unsigned _sp = 0; while (cond) { __builtin_amdgcn_s_sleep(1); \
    if ((++_sp & 255u) == 0u) { if (xb_ld(&(bar)[XB_TMO])) break; if (_sp > XB_SPIN_CAP) { atomicAdd(&(bar)[XB_TMO], 1u); break; } } } } while (0)

struct XcdBarrier {
    unsigned* bar; unsigned x;
    volatile LAS unsigned* st;
};

__device__ __forceinline__ XcdBarrier xcd_barrier_post(unsigned* bar, volatile LAS unsigned* st) {
    XcdBarrier b; b.bar = bar; b.x = xb_xcc_id(); b.st = st;
    if (threadIdx.x == 0) (void)xb_add(&bar[XB_XCNT(b.x)], 1u);
    return b;
}
__device__ __forceinline__ void xcd_barrier_complete(unsigned* bar, unsigned x, unsigned& nloc, unsigned& nx) {
    const unsigned G = gridDim.x * gridDim.y * gridDim.z;
    unsigned sum, cnt, mine, sp = 0u;
    for (;;) {
        sum = 0u; cnt = 0u; mine = 0u;
#pragma unroll
        for (unsigned j = 0; j < 16; ++j) { const unsigned c = xb_ld(&bar[XB_XCNT(j)]); sum += c; cnt += (c > 0u) ? 1u : 0u; mine = (j == x) ? c : mine; }
        if (sum == G) break;
        __builtin_amdgcn_s_sleep(1);
        if ((++sp & 255u) == 0u) { if (xb_ld(&bar[XB_TMO])) break; if (sp > XB_SPIN_CAP) { atomicAdd(&bar[XB_TMO], 1u); break; } }
    }
    nloc = mine > 0u ? mine : 1u; nx = cnt > 0u ? cnt : 1u;
}

__device__ __forceinline__ void xcd_barrier(const XcdBarrier& b) {
    asm volatile("s_waitcnt vmcnt(0)" ::: "memory");
    __syncthreads();
    if (threadIdx.x == 0) {
        unsigned* bar = b.bar;
        __builtin_amdgcn_s_waitcnt(0);
        unsigned nloc = b.st[0], nx = b.st[1];
        if (nloc == 0u) { xcd_barrier_complete(bar, b.x, nloc, nx); b.st[0] = nloc; b.st[1] = nx; }
        const unsigned old = xb_add(&bar[XB_XSUB(b.x)], 1u);
        const unsigned gen = old / nloc;
        if (old + 1u == (gen + 1u) * nloc) {
            __builtin_amdgcn_fence(__ATOMIC_RELEASE, "agent");
            asm volatile("s_waitcnt vmcnt(0)" ::: "memory");
            const unsigned og = xb_add(&bar[XB_TOP], 1u);
            const unsigned tg = og / nx;
            if (og + 1u == (tg + 1u) * nx) xb_add(&bar[XB_TOPGEN], 1u);
            else XB_SPIN(xb_ld(&bar[XB_TOPGEN]) == tg, bar);
            __builtin_amdgcn_fence(__ATOMIC_ACQUIRE, "agent");
            xb_add(&bar[XB_XGEN(b.x)], 1u);
            asm volatile("s_waitcnt vmcnt(0)" ::: "memory");
        } else {
            XB_SPIN(xb_ld(&bar[XB_XGEN(b.x)]) == gen, bar);
            __builtin_amdgcn_fence(__ATOMIC_ACQUIRE, "agent");
            asm volatile("s_waitcnt vmcnt(0)" ::: "memory");
        }
    }
    __syncthreads();
}
DEV float row_rstd(const float* ssq, int row, int fq) {
    const f32x4 p = *(const f32x4*)(ssq + (size_t)row * 16 + fq * 4);
    float s = (p.x + p.y) + (p.z + p.w);
    s += __shfl_xor(s, 16); s += __shfl_xor(s, 32);
    return 1.0f / sqrtf(s * (1.0f / 1024.0f) + RMS_EPS);
}
DEV float row_rstd_full(const float* ssq, int row) {
    const f32x4* p = (const f32x4*)(ssq + (size_t)row * 16);
    const f32x4 a = p[0], b = p[1], c = p[2], d = p[3];
    const float s = ((a.x + a.y) + (a.z + a.w)) + ((b.x + b.y) + (b.z + b.w)) + ((c.x + c.y) + (c.z + c.w)) + ((d.x + d.y) + (d.z + d.w));
    return 1.0f / sqrtf(s * (1.0f / 1024.0f) + RMS_EPS);
}

DEV void rope4(const float* rope, int t, int i, const f32x4& v0, const f32x4& v1, float (&lo)[4], float (&hi)[4]) {
    const f32x4 c0 = *(const f32x4*)(rope + ((size_t)t * 32 + i) * 2), c1 = *(const f32x4*)(rope + ((size_t)t * 32 + i + 2) * 2);
    lo[0] = v0[0] * c0[0] - v0[1] * c0[1]; hi[0] = v0[1] * c0[0] + v0[0] * c0[1];
    lo[1] = v0[2] * c0[2] - v0[3] * c0[3]; hi[1] = v0[3] * c0[2] + v0[2] * c0[3];
    lo[2] = v1[0] * c1[0] - v1[1] * c1[1]; hi[2] = v1[1] * c1[0] + v1[0] * c1[1];
    lo[3] = v1[2] * c1[2] - v1[3] * c1[3]; hi[3] = v1[3] * c1[2] + v1[2] * c1[3];
}
struct EpiIn {
    static constexpr bool PERM = true, AFTER_DRAIN = false;
    unsigned char* ws;
    template <class Tp> DEV Tp* P(size_t off) const { return (Tp*)(GAS Tp*)(ws + off); }
    DEV void operator()(const f32x4 (&acc)[2][2][4][2], const pg8::Unit& u, int wr, int wc, int fr, int fq) const {
        asm volatile("" : "+v"(fr), "+v"(fq), "+s"(wr), "+s"(wc));
        const int pn = u.pn;
        const float* ssq = P<float>(WS_SSQ); const float* rope = P<float>(WS_ROPE);
#pragma unroll
        for (int ai = 0; ai < 2; ++ai)
#pragma unroll
            for (int m = 0; m < 4; ++m) {
                const int row = u.pm * 256 + ai * 128 + wr * 64 + m * 16 + fr;
                const float rstd = row_rstd(ssq, row, fq);
                const int t = row & (T - 1), b = row >> 13;
#pragma unroll
                for (int bj = 0; bj < 2; ++bj) {
                    const int col = bj * 128 + wc * 32 + fq * 8;
                    const f32x4 v0 = acc[ai][bj][m][0] * rstd, v1 = acc[ai][bj][m][1] * rstd;
                    if (pn < 2) {
                        const int g = pn * 256 + col, head = g >> 6, i = (g & 63) >> 1;
                        const size_t o = (size_t)row * 512 + head * 64 + i;
                        bf16* Q = P<bf16>(WS_Q);
                        v2u w;
                        w.x = pk2(v0[0] * QSCALE, v0[2] * QSCALE); w.y = pk2(v1[0] * QSCALE, v1[2] * QSCALE); *(v2u*)(Q + o) = w;
                        w.x = pk2(v0[1] * QSCALE, v0[3] * QSCALE); w.y = pk2(v1[1] * QSCALE, v1[3] * QSCALE); *(v2u*)(Q + o + 32) = w;
                    } else if (pn == 2) {
                        bf16* dst = P<bf16>((col < 128) ? WS_KCR : WS_VCR);
                        v4u w; w.x = pk2(v0[0], v0[1]); w.y = pk2(v0[2], v0[3]); w.z = pk2(v1[0], v1[1]); w.w = pk2(v1[2], v1[3]);
                        *(v4u*)(dst + (size_t)row * 128 + (col & 127)) = w;
                    } else if (pn == 3 || pn == 4) {
                        if (col < 128) {
                            bf16* dst = P<bf16>((pn == 3) ? WS_KS : WS_KW);
                            const int hkv = col >> 6, i = (col & 63) >> 1;
                            float lo[4], hi[4]; rope4(rope, t, i, v0, v1, lo, hi);
                            const size_t o = (size_t)(b * 2 + hkv) * T * 64 + kfrag_off(t, i);
                            v2u w;
                            w.x = pk2(lo[0], lo[1]); w.y = pk2(lo[2], lo[3]); *(v2u*)(dst + o) = w;
                            w.x = pk2(hi[0], hi[1]); w.y = pk2(hi[2], hi[3]); *(v2u*)(dst + o + 512) = w;
                        } else {
                            bf16* dst = P<bf16>((pn == 3) ? WS_VST : WS_VWT);
                            const int c2 = col - 128, hkv = c2 >> 6, d = c2 & 63;
                            const size_t o = (((size_t)(b * 2 + hkv) * 256 + (t >> 5)) * 64 + d) * 32 + slot32(t & 31);
#pragma unroll
                            for (int j = 0; j < 4; ++j) { dst[o + j * 32] = (bf16)f2bf(v0[j]); dst[o + (j + 4) * 32] = (bf16)f2bf(v1[j]); }
#if defined(DUPMASK) && ((DUPMASK >> 20) & 1)
                            { bf16* dst2 = P<bf16>(WS_U2) + (pn - 3) * (4u << 20);
#pragma unroll
                            for (int j = 0; j < 4; ++j) { dst2[o + j * 32] = (bf16)f2bf(v0[j]); dst2[o + (j + 4) * 32] = (bf16)f2bf(v1[j]); } }
#endif
                        }
                    } else if (pn == 9) {
                        float* dst = P<float>(WS_HF) + (size_t)row * 256 + col;
                        *(f32x4*)dst = v0; *(f32x4*)(dst + 4) = v1;
                    } else {
                        bf16* dst = (pn < 8) ? P<bf16>(WS_CB + (size_t)(pn - 5) * (WS_CC - WS_CB)) : P<bf16>(WS_HQ + (size_t)(pn - 8) * (WS_HF - WS_HQ));
                        v4u w; w.x = pk2(v0[0], v0[1]); w.y = pk2(v0[2], v0[3]); w.z = pk2(v1[0], v1[1]); w.w = pk2(v1[2], v1[3]);
                        *(v4u*)(dst + (size_t)row * 256 + col) = w;
                    }
                }
            }
    }
};

struct EpiRes {
    static constexpr bool PERM = true, AFTER_DRAIN = false;
    const float* base32; bf16* hb; float* ssq;
    DEV void operator()(const f32x4 (&acc)[2][2][4][2], const pg8::Unit& u, int wr, int wc, int fr, int fq) const {
        asm volatile("" : "+v"(fr), "+v"(fq), "+s"(wr), "+s"(wc));
#pragma unroll
        for (int ai = 0; ai < 2; ++ai)
#pragma unroll
            for (int m = 0; m < 4; ++m) {
                const int row = u.pm * 256 + ai * 128 + wr * 64 + m * 16 + fr;
                float ss = 0.f;
#pragma unroll
                for (int bj = 0; bj < 2; ++bj) {
                    const size_t o = (size_t)row * 1024 + u.pn * 256 + bj * 128 + wc * 32 + fq * 8;
                    f32x4 v0, v1;
                    if (base32) { v0 = *(const f32x4*)(base32 + o); v1 = *(const f32x4*)(base32 + o + 4); }
                    else { const v4u hw = *(const v4u*)(hb + o); v0 = (f32x4){bflo(hw.x), bfhi(hw.x), bflo(hw.y), bfhi(hw.y)}; v1 = (f32x4){bflo(hw.z), bfhi(hw.z), bflo(hw.w), bfhi(hw.w)}; }
                    v0 = v0 + acc[ai][bj][m][0]; v1 = v1 + acc[ai][bj][m][1];
                    v4u w; w.x = pk2(v0[0], v0[1]); w.y = pk2(v0[2], v0[3]); w.z = pk2(v1[0], v1[1]); w.w = pk2(v1[2], v1[3]);
                    *(v4u*)(hb + o) = w;
                    ss += ((v0[0] * v0[0] + v0[1] * v0[1]) + (v0[2] * v0[2] + v0[3] * v0[3])) + ((v1[0] * v1[0] + v1[1] * v1[1]) + (v1[2] * v1[2] + v1[3] * v1[3]));
                }
                ss += __shfl_xor(ss, 16); ss += __shfl_xor(ss, 32);
                if (fq == 0) ssq[(size_t)row * 16 + u.pn * 4 + wc] = ss;
            }
    }
};

struct EpiXQ {
    static constexpr bool PERM = true, AFTER_DRAIN = false;
    const float* ssq; bf16* XQ;
    DEV void operator()(const f32x4 (&acc)[2][2][4][2], const pg8::Unit& u, int wr, int wc, int fr, int fq) const {
        asm volatile("" : "+v"(fr), "+v"(fq), "+s"(wr), "+s"(wc));
#pragma unroll
        for (int ai = 0; ai < 2; ++ai)
#pragma unroll
            for (int m = 0; m < 4; ++m) {
                const int row = u.pm * 256 + ai * 128 + wr * 64 + m * 16 + fr;
                const float sc = row_rstd(ssq, row, fq) * QSCALE;
#pragma unroll
                for (int bj = 0; bj < 2; ++bj) {
                    const f32x4 v0 = acc[ai][bj][m][0] * sc, v1 = acc[ai][bj][m][1] * sc;
                    v4u w; w.x = pk2(v0[0], v0[1]); w.y = pk2(v0[2], v0[3]); w.z = pk2(v1[0], v1[1]); w.w = pk2(v1[2], v1[3]);
                    *(v4u*)(XQ + (size_t)row * 256 + bj * 128 + wc * 32 + fq * 8) = w;
                }
            }
    }
};

struct EpiGU {
    static constexpr bool PERM = true, AFTER_DRAIN = false;
    const float* srstd; bf16* ACT;
    DEV void operator()(const f32x4 (&acc)[2][2][4][2], const pg8::Unit& u, int wr, int wc, int fr, int fq) const {
        asm volatile("" : "+v"(fr), "+v"(fq), "+s"(wr), "+s"(wc));
        const int nt = u.pn & 3;
#pragma unroll
        for (int ai = 0; ai < 2; ++ai)
#pragma unroll
            for (int m = 0; m < 4; ++m) {
                const int row = u.pm * 256 + ai * 128 + wr * 64 + m * 16 + fr;
                const float rs = srstd[row];
#pragma unroll
                for (int bj = 0; bj < 2; ++bj) {
                    const f32x4 v0 = acc[ai][bj][m][0] * rs, v1 = acc[ai][bj][m][1] * rs;
                    const int j = (nt * 256 + bj * 128 + wc * 32 + fq * 8) >> 1;
                    v2u w; w.x = pk2(siluf_(v0[0]) * v0[1], siluf_(v0[2]) * v0[3]); w.y = pk2(siluf_(v1[0]) * v1[1], siluf_(v1[2]) * v1[3]);
                    *(v2u*)(ACT + (size_t)row * 512 + j) = w;
                }
            }
    }
};

struct EpiDN {
    static constexpr bool PERM = true, AFTER_DRAIN = false;
    const float* sgate; bf16* YS;
    DEV void operator()(const f32x4 (&acc)[2][2][4][2], const pg8::Unit& u, int wr, int wc, int fr, int fq) const {
        asm volatile("" : "+v"(fr), "+v"(fq), "+s"(wr), "+s"(wc));
        const int nt = u.pn & 3;
#pragma unroll
        for (int ai = 0; ai < 2; ++ai)
#pragma unroll
            for (int m = 0; m < 4; ++m) {
                const int row = u.pm * 256 + ai * 128 + wr * 64 + m * 16 + fr;
                const float gt = sgate[row];
#pragma unroll
                for (int bj = 0; bj < 2; ++bj) {
                    const f32x4 v0 = acc[ai][bj][m][0] * gt, v1 = acc[ai][bj][m][1] * gt;
                    v4u w; w.x = pk2(v0[0], v0[1]); w.y = pk2(v0[2], v0[3]); w.z = pk2(v1[0], v1[1]); w.w = pk2(v1[2], v1[3]);
                    *(v4u*)(YS + (size_t)row * 1024 + nt * 256 + bj * 128 + wc * 32 + fq * 8) = w;
                }
            }
    }
};

struct MoeOrder {
    int nunits, G, c; const LAS int* tileE;
    DEV bool next(int i, pg8::Unit& u) const {
        const int L = i * G + c; if (L >= nunits) return false;
        const int rt = L >> 2; u.pm = rt; u.pn = tileE[rt] * 4 + (L & 3); return true;
    }
    DEV void a_ready(const pg8::Unit&) const {}
    DEV void done(const pg8::Unit&) const {}
};
struct Frame {
    LAS unsigned char* lds;
    unsigned char* ldsg;
    volatile LAS unsigned* MISC;
    gu32* ctl;
    unsigned char* ws;
    int tid, lane, wave, vcu, G;
    float* out;
};
template <class Tp> DEV Tp* wsp(const Frame& F, size_t off) { return (Tp*)(F.ws + off); }
DEV const float* inp(int i) { const float* const* ka = (const float* const*)__builtin_amdgcn_kernarg_segment_ptr(); asm volatile("" : "+s"(i)); return (const float*)(const GAS float*)ka[i]; }

template <class Map>
DEV void tr_item(const float* W, int K, int Nsrc, const float* gain, bf16* WT, float* scr, int item, int lane, Map map) {
    const int nblk = (Nsrc + 31) >> 5, kb = item / nblk, nb = item - kb * nblk, k0 = 64 * kb, n0 = 32 * nb;
    {
        const int nq = (lane & 7) * 4; f32x4 v[8];
#pragma unroll
        for (int i = 0; i < 8; ++i) { const int kk = 8 * i + (lane >> 3);
            v[i] = (n0 + nq < Nsrc) ? *(const f32x4*)(W + (size_t)(k0 + kk) * Nsrc + n0 + nq) : (f32x4){0.f, 0.f, 0.f, 0.f}; }
#pragma unroll
        for (int i = 0; i < 8; ++i) { const int kk = 8 * i + (lane >> 3); const float g = gain ? gain[k0 + kk] : 1.0f; float* s = scr + kk * 33 + nq;
            s[0] = v[i][0] * g; s[1] = v[i][1] * g; s[2] = v[i][2] * g; s[3] = v[i][3] * g; }
    }
    LDS_WAIT();
    const int c = lane & 7;
#pragma unroll
    for (int j = 0; j < 4; ++j) {
        const int n = (lane >> 3) + 8 * j; const float* s = scr + (8 * c) * 33 + n;
        if (n0 + n < Nsrc) {
            v4u o; o.x = pk2(s[0 * 33], s[1 * 33]); o.y = pk2(s[2 * 33], s[3 * 33]); o.z = pk2(s[4 * 33], s[5 * 33]); o.w = pk2(s[6 * 33], s[7 * 33]);
            *(v4u*)(WT + (size_t)map(n0 + n) * K + k0 + 8 * c) = o;
        }
    }
    LDS_WAIT();
}
template <class Map>
DEV void tr_experts(const float* W, int K, int Nsrc, const float* gain, bf16* WT, bf16* scr, int gw, int NGW, int lane, Map map) {
    const int nblk = Nsrc >> 6, per_e = (K >> 6) * nblk, NIT = 32 * per_e; const size_t esz = (size_t)K * Nsrc;
#pragma unroll 1
    for (int it = gw; it < NIT; it += NGW) {
        const int e = it / per_e, sub = it - e * per_e, kb = sub / nblk, nb = sub - kb * nblk, k0 = 64 * kb, n0 = 64 * nb, nq = (lane & 15) * 4;
        const float* Wp = W + (size_t)e * esz; bf16* Wo = WT + (size_t)e * esz;
        f32x4 v[16];
#pragma unroll
        for (int i = 0; i < 16; ++i) v[i] = *(const f32x4*)(Wp + (size_t)(k0 + 4 * i + (lane >> 4)) * Nsrc + n0 + nq);
#pragma unroll
        for (int i = 0; i < 16; ++i) { const int kk = 4 * i + (lane >> 4); const float g = gain ? gain[k0 + kk] : 1.0f;
            v2u w; w.x = pk2(v[i][0] * g, v[i][1] * g); w.y = pk2(v[i][2] * g, v[i][3] * g);
            *(v2u*)(scr + kk * 68 + nq) = w; }
        LDS_WAIT();
        const int cc = lane & 7;
#pragma unroll
        for (int j = 0; j < 8; ++j) { const int n = (lane >> 3) + 8 * j; const bf16* s = scr + (8 * cc) * 68 + n;
            v4u o; o.x = (unsigned)s[0] | ((unsigned)s[68] << 16); o.y = (unsigned)s[2 * 68] | ((unsigned)s[3 * 68] << 16);
            o.z = (unsigned)s[4 * 68] | ((unsigned)s[5 * 68] << 16); o.w = (unsigned)s[6 * 68] | ((unsigned)s[7 * 68] << 16);
            *(v4u*)(Wo + (size_t)map(n0 + n) * K + k0 + 8 * cc) = o; }
        LDS_WAIT();
    }
}
struct MapId { DEV int operator()(int n) const { return n; } };
struct MapIn {
    DEV int operator()(int n) const {
        if (n < 512) { const int d = n & 63; return (n & ~63) + 2 * (d & 31) + (d >> 5); }
        if (n < 768) return n;
        if (n < 1280) { const int r = n - 768; if ((r & 255) < 128) { const int d = r & 63; return 768 + (r & ~63) + 2 * (d & 31) + (d >> 5); } return n; }
        if (n < 1304) return 3072 + (n - 1280);
        return n - 24;
    }
};
struct MapGU { DEV int operator()(int n) const { return n < 512 ? 2 * n : 2 * (n - 512) + 1; } };

DEV void convert_experts(Frame& F, int l, bf16* scr, int part) {
    unsigned zl_ = 0u; asm volatile("" : "+v"(zl_)); const int lane = (int)__builtin_amdgcn_mbcnt_hi(~0u, __builtin_amdgcn_mbcnt_lo(~0u, zl_));
    const int gw = F.vcu * NWAVES + F.wave, NGW = F.G * NWAVES;
    if (part == 0) tr_experts(inp(17) + (size_t)l * 32 * 1024 * 1024, 1024, 1024, inp(22) + l * 1024, wsp<bf16>(F, WS_WGU) + (size_t)l * 32 * 1024 * 1024, scr, gw, NGW, lane, MapGU());
    else tr_experts(inp(18) + (size_t)l * 32 * 512 * 1024, 512, 1024, nullptr, wsp<bf16>(F, WS_WDN) + (size_t)l * 32 * 1024 * 512, scr, gw, NGW, lane, MapId());
}
DEV void p0_prologue(Frame& F) {
    float* scr = (float*)(F.ldsg + F.wave * 16384);
    const int gw = F.vcu * NWAVES + F.wave, NGW = F.G * NWAVES, lane = F.lane;
    for (int l = 0; l < DEPTH; ++l) {
        { const int NIT = 16 * 97; bf16* dst = wsp<bf16>(F, WS_WIN) + (size_t)l * NIN * 1024;
          for (int it = gw; it < NIT; it += NGW) tr_item(inp(2) + (size_t)l * 1024 * IN_W, 1024, IN_W, inp(19) + l * 1024, dst, scr, it, lane, MapIn());
          for (int i = gw * 64 + lane; i < (NIN - 3096) * 1024 / 8; i += NGW * 64) ((v4u*)(dst + (size_t)3096 * 1024))[i] = (v4u){0u, 0u, 0u, 0u}; }
        { const int NIT = 16 * 32; for (int it = gw; it < NIT; it += NGW) tr_item(inp(9) + (size_t)l * 1024 * 1024, 1024, 1024, nullptr, wsp<bf16>(F, WS_WOUT) + (size_t)l * 1024 * 1024, scr, it, lane, MapId()); }
        { const int NIT = 16 * 8; for (int it = gw; it < NIT; it += NGW) tr_item(inp(10) + (size_t)l * 1024 * 256, 1024, 256, inp(20) + l * 1024, wsp<bf16>(F, WS_WQ) + (size_t)l * 256 * 1024, scr, it, lane, MapId()); }
        { const int NIT = 16 * 16; for (int it = gw; it < NIT; it += NGW) tr_item(inp(11) + (size_t)l * 1024 * 512, 1024, 512, inp(21) + l * 1024, wsp<bf16>(F, WS_WKV) + (size_t)l * 512 * 1024, scr, it, lane, MapId()); }
        { const int NIT = 4 * 32; for (int it = gw; it < NIT; it += NGW) tr_item(inp(12) + (size_t)l * 256 * 1024, 256, 1024, nullptr, wsp<bf16>(F, WS_WO) + (size_t)l * 1024 * 256, scr, it, lane, MapId()); }
        for (int kv = 0; kv < 2; ++kv) {
            { const int NIT = 32 * 4; for (int it = gw; it < NIT; it += NGW) tr_item(inp(5) + (size_t)(l * 2 + kv) * 2048 * 128, 2048, 128, nullptr, wsp<bf16>(F, WS_W1C) + (size_t)(l * 2 + kv) * 128 * 2048, scr, it, lane, MapId()); }
            { const int NIT = 2 * 2; for (int it = gw; it < NIT; it += NGW) tr_item(inp(6) + (size_t)(l * 2 + kv) * 128 * 64, 128, 64, nullptr, wsp<bf16>(F, WS_W2C) + (size_t)(l * 2 + kv) * 64 * 128, scr, it, lane, MapId()); }
        }
        if (F.G != 256) { convert_experts(F, l, (bf16*)scr, 0); convert_experts(F, l, (bf16*)scr, 1); }
        { bf16* dst = wsp<bf16>(F, WS_WR) + (size_t)l * 96 * 1024; const float* gn = inp(22) + l * 1024;
          for (int i = gw * 64 + lane; i < 48 * 1024; i += NGW * 64) { const int n = i >> 10, k = i & 1023;
            float v = 0.f; if (n < 4) v = inp(13)[(size_t)(l * 1024 + k) * 4 + n]; else if (n < 36) v = inp(15)[(size_t)(l * 1024 + k) * 32 + (n - 4)];
            v *= gn[k]; const unsigned h = f2bf(v); dst[i] = (bf16)h; dst[i + 48 * 1024] = (bf16)f2bf(v - bf2f((unsigned short)h)); } }
    }
    { bf16* wg = wsp<bf16>(F, WS_WG);
      for (int i = gw * 64 + lane; i < DEPTH * 32 * 1024; i += NGW * 64) { const int l2 = i >> 15, row = (i >> 10) & 31, k = i & 1023, hk = row >> 4, gi = row & 15;
        const float v = gi < 12 ? inp(2)[((size_t)l2 * 1024 + k) * IN_W + 1280 + hk * 12 + gi] * inp(19)[l2 * 1024 + k] : 0.f;
        wg[i] = (bf16)f2bf(v); } }
    { float* rope = wsp<float>(F, WS_ROPE);
      for (int i = gw * 64 + lane; i < T * 32; i += NGW * 64) { const int t = i >> 5, k = i & 31;
        const float inv = powf(10000.0f, -(float)k / 32.0f); const float ang = (float)t * inv;
        rope[2 * i] = cosf(ang); rope[2 * i + 1] = sinf(ang); } }
    { float* b1 = wsp<float>(F, WS_SMALL);
      for (int i = gw * 64 + lane; i < 4 * 128; i += NGW * 64) { const int lk = i >> 7, n = i & 127;
        const float* pe = inp(4) + (size_t)lk * 2048; const float* w1 = inp(5) + (size_t)lk * 2048 * 128 + n; float s = 0.f;
        for (int kk = 0; kk < 2048; ++kk) s += pe[kk] * w1[(size_t)kk * 128];
        b1[i] = s; } }
    { bf16* HB = wsp<bf16>(F, WS_HB); float* SSQ = wsp<float>(F, WS_SSQ); bf16* MB = wsp<bf16>(F, WS_MEMB); float* SSQM = wsp<float>(F, WS_SMALL) + 1024;
      for (int m = gw; m < NTOK + NB * 256; m += NGW) {
        const bool ism = m >= NTOK; const int r = ism ? m - NTOK : m;
        const f32x4* xr = (const f32x4*)((ism ? inp(1) : inp(0)) + (size_t)r * 1024) + lane;
        unsigned long long* o8 = (unsigned long long*)((ism ? MB : HB) + (size_t)r * 1024) + lane;
        float s = 0.f;
#pragma unroll
        for (int j = 0; j < 4; ++j) { const f32x4 v = xr[64 * j]; s += (v.x * v.x + v.y * v.y) + (v.z * v.z + v.w * v.w);
            o8[64 * j] = (unsigned long long)pk2(v.x, v.y) | ((unsigned long long)pk2(v.z, v.w) << 32); }
        s = wave_sum(s);
        if (ism) { if (lane == 0) SSQM[r] = s; }
        else if (lane < 16) SSQ[(size_t)r * 16 + lane] = lane == 0 ? s : 0.f;
      } }
}

template <int NT>
DEV void skinny16(const bf16* A, size_t lda, const bf16* Bt, size_t ldb, int K, int lane, f32x4 (&acc)[NT]) {
    const int l16 = lane & 15, g4 = lane >> 4;
    const bf16* ap = A + (size_t)l16 * lda + g4 * 8; const bf16* bp = Bt + (size_t)l16 * ldb + g4 * 8;
#pragma unroll
    for (int n = 0; n < NT; ++n) acc[n] = (f32x4){0.f, 0.f, 0.f, 0.f};
#pragma unroll 2
    for (int k = 0; k < K; k += 32) {
        const bf16x8 a = *(const bf16x8*)(ap + k);
#pragma unroll
        for (int n = 0; n < NT; ++n) { const bf16x8 b = *(const bf16x8*)(bp + (size_t)n * 16 * ldb + k); acc[n] = mfma16(a, b, acc[n]); }
    }
}

DEV void memkv_phase(Frame& F) {
    const int gw = F.vcu * NWAVES + F.wave, NGW = F.G * NWAVES, lane = F.lane, l16 = lane & 15, g4 = lane >> 4;
    const bf16* MB = wsp<bf16>(F, WS_MEMB); const float* SSQM = wsp<float>(F, WS_SMALL) + 1024;
    bf16* MK = wsp<bf16>(F, WS_MK); bf16* MVT = wsp<bf16>(F, WS_MVT);
    for (int task = gw; task < 1024; task += NGW) {
        const int l2 = task >> 9, rt = (task >> 3) & 63, chunk = task & 7;
        f32x4 acc[4];
        skinny16<4>(MB + (size_t)rt * 16 * 1024, 1024, wsp<bf16>(F, WS_WKV) + ((size_t)l2 * 512 + chunk * 64) * 1024, 1024, 1024, lane, acc);
        const int b = rt >> 4, key0 = (rt & 15) * 16 + g4 * 4;
        float rs[4];
#pragma unroll
        for (int r = 0; r < 4; ++r) rs[r] = 1.0f / sqrtf(SSQM[rt * 16 + g4 * 4 + r] * (1.0f / 1024.0f) + RMS_EPS);
#pragma unroll
        for (int nt = 0; nt < 4; ++nt) {
            const int n = chunk * 64 + nt * 16 + l16;
            if (chunk < 4) { const int head = n >> 6, d = n & 63;
#pragma unroll
                for (int r = 0; r < 4; ++r) MK[(size_t)((l2 * 4 + b) * 4 + head) * 256 * 64 + kfrag_off(key0 + r, d)] = (bf16)f2bf(acc[nt][r] * rs[r]);
            } else { const int n2 = n - 256, head = n2 >> 6, d = n2 & 63;
                v2u w; w.x = pk2(acc[nt][0] * rs[0], acc[nt][1] * rs[1]); w.y = pk2(acc[nt][2] * rs[2], acc[nt][3] * rs[3]);
                *(v2u*)(MVT + (((size_t)((l2 * 4 + b) * 4 + head) * 8 + (key0 >> 5)) * 64 + d) * 32 + slot32(key0 & 31)) = w; }
        }
    }
}

DEV void compress_phase(Frame& F, int l) {
    const int lane = F.lane, l16 = lane & 15, g4 = lane >> 4, quad = F.wave >> 2, q = F.wave & 3;
    float* part = (float*)F.ldsg + quad * (4 * 16 * 128);
    const bf16* KCR = wsp<bf16>(F, WS_KCR); const bf16* VCR = wsp<bf16>(F, WS_VCR);
    bf16* KCC = wsp<bf16>(F, WS_KCC); bf16* VCT = wsp<bf16>(F, WS_VCT);
    const float* bias1 = wsp<float>(F, WS_SMALL);
    for (int tk0 = F.vcu * 2; tk0 < 512; tk0 += F.G * 2) {
        const int tk = tk0 + quad; const int kv = tk >> 8, tile = tk & 255;
        const bf16* raw = kv ? VCR : KCR;
        const bf16* w1 = wsp<bf16>(F, WS_W1C) + (size_t)(l * 2 + kv) * 128 * 2048;
        const bf16* w2 = wsp<bf16>(F, WS_W2C) + (size_t)(l * 2 + kv) * 64 * 128;
        { const int r = tile * 16 + l16, bh = r >> 9, c = r & 511, b = bh >> 1, hkv = bh & 1;
          f32x4 acc[8];
#pragma unroll
          for (int n = 0; n < 8; ++n) acc[n] = (f32x4){0.f, 0.f, 0.f, 0.f};
#pragma unroll 2
          for (int ks = q * 16; ks < q * 16 + 16; ++ks) {
              const int kk = ks * 32 + g4 * 8, ll = kk >> 6, d = kk & 63;
              int tok = 16 * c + ll; tok = tok > T - 1 ? T - 1 : tok;
              const bf16x8 a = *(const bf16x8*)(raw + ((size_t)b * T + tok) * 128 + hkv * 64 + d);
#pragma unroll
              for (int n = 0; n < 8; ++n) { const bf16x8 bb = *(const bf16x8*)(w1 + (size_t)(n * 16 + l16) * 2048 + kk); acc[n] = mfma16(a, bb, acc[n]); }
          }
#pragma unroll
          for (int n = 0; n < 8; ++n)
#pragma unroll
              for (int r2 = 0; r2 < 4; ++r2) part[(q * 16 + g4 * 4 + r2) * 128 + n * 16 + l16] = acc[n][r2];
        }
        __syncthreads();
        { f32x4 o = (f32x4){0.f, 0.f, 0.f, 0.f};
#pragma unroll
          for (int k2 = 0; k2 < 4; ++k2) {
              const int h0 = k2 * 32 + g4 * 8;
              float hv[8];
#pragma unroll
              for (int j = 0; j < 8; ++j) { float s = bias1[(l * 2 + kv) * 128 + h0 + j];
#pragma unroll
                  for (int p = 0; p < 4; ++p) s += part[(p * 16 + l16) * 128 + h0 + j];
                  hv[j] = siluf_(s); }
              bf16x8 a; { v4u w; w.x = pk2(hv[0], hv[1]); w.y = pk2(hv[2], hv[3]); w.z = pk2(hv[4], hv[5]); w.w = pk2(hv[6], hv[7]); a = __builtin_bit_cast(bf16x8, w); }
              const bf16x8 bb = *(const bf16x8*)(w2 + (size_t)(q * 16 + l16) * 128 + h0);
              o = mfma16(a, bb, o);
          }
          const int r0 = tile * 16 + g4 * 4, bh = r0 >> 9, c0 = r0 & 511, d = q * 16 + l16;
          if (kv == 0) {
#pragma unroll
              for (int r2 = 0; r2 < 4; ++r2) KCC[(size_t)bh * 512 * 64 + kfrag_off(c0 + r2, d)] = (c0 + r2 == 511) ? (bf16)0 : (bf16)f2bf(o[r2]);
          } else {
              v2u w; w.x = pk2(o[0], o[1]); w.y = pk2(o[2], (c0 + 3 == 511) ? 0.f : o[3]);
              *(v2u*)(VCT + (((size_t)bh * 16 + (c0 >> 5)) * 64 + d) * 32 + slot32(c0 & 31)) = w;
          }
        }
        __syncthreads();
    }
}

DEV float hgrn_lb(const Frame& F, int l, int c) {
    if (l == 0) return 0.f;
    const float a = inp(7)[c], b = inp(7)[256 + c];
    return 1.0f / (1.0f + expf(a - b));
}
DEV float hgrn_logf(float z, float lb) {
    const float la = logf(fmaxf(lb, 1e-30f));
    const float ls = fminf(z, 0.f) - log1pf(expf(-fabsf(z)));
    const float lc = log1pf(-lb) + ls;
    const float mx = fmaxf(la, lc), mn = fminf(la, lc);
    return mx + log1pf(expf(mn - mx));
}
constexpr int HS = 68;
DEV f32x4 mfma4(float a, float b, f32x4 c) { return __builtin_amdgcn_mfma_f32_16x16x4f32(a, b, c, 0, 0, 0); }
DEV void hgrn_setup_chunk(Frame& F, float lb, const float (&z)[8], float* Bc, float* Kc, float* tot) {
    const int d = F.tid & 63, sg = F.tid >> 6;
    const float la = logf(fmaxf(lb, 1e-30f)), l1m = log1pf(-lb), onem = 1.0f - lb;
    float loc[8], kv[8]; float run = 0.f;
#pragma unroll
    for (int i = 0; i < 8; ++i) {
        const float ez = __expf(-fabsf(z[i]));
        const float lc = l1m + (fminf(z[i], 0.f) - __logf(1.0f + ez));
        const float mx = fmaxf(la, lc), mn = fminf(la, lc);
        run += mx + __logf(1.0f + __expf(mn - mx)); loc[i] = run;
        kv[i] = onem * (z[i] >= 0.f ? ez : 1.0f) / (1.0f + ez);
    }
    tot[sg * 64 + d] = run;
    __syncthreads();
    float off = 0.f;
    for (int g = 0; g < sg; ++g) off += tot[g * 64 + d];
#pragma unroll
    for (int i = 0; i < 8; ++i) { Bc[(sg * 8 + i) * HS + d] = off + loc[i]; Kc[(sg * 8 + i) * HS + d] = kv[i]; }
    __syncthreads();
}
DEV void hgrn_local_phase(Frame& F, int l) {
    float* Bc = (float*)F.ldsg; float* Kc = Bc + 64 * HS; float* Vc = Kc + 64 * HS; float* tot = Vc + 64 * HS;
    bf16* U = wsp<bf16>(F, WS_U); float* DEC = wsp<float>(F, WS_DEC);
    const int lane = F.lane, w = F.wave, li = lane & 15, kq = lane >> 4;
    for (int task = F.vcu; task < 2048; task += F.G) {
        const int bh = task >> 7, ch = task & 127, b = bh >> 2, h = bh & 3;
        { const int d = F.tid & 63, sg = F.tid >> 6;
          const size_t go = ((size_t)b * T + ch * 64 + sg * 8) * 256 + h * 64 + d;
          const float* HFp = wsp<float>(F, WS_HF) + go; const bf16* HIp = wsp<bf16>(F, WS_HI) + go;
          float z[8], vi[8];
#pragma unroll
          for (int i = 0; i < 8; ++i) { z[i] = HFp[(size_t)i * 256]; vi[i] = bf2f(HIp[(size_t)i * 256]); }
          hgrn_setup_chunk(F, hgrn_lb(F, l, h * 64 + d), z, Bc, Kc, tot);
          const float bl = Bc[63 * HS + d];
#pragma unroll
          for (int i = 0; i < 8; ++i) { const int s = sg * 8 + i; Kc[s * HS + d] *= __expf(bl - Bc[s * HS + d]); Vc[s * HS + d] = vi[i]; }
          if (sg == 0) DEC[(size_t)task * 64 + d] = expf(bl); }
        __syncthreads();
        { const int dI = w >> 1, e0 = (w & 1) * 32;
          f32x4 a0 = (f32x4){0.f, 0.f, 0.f, 0.f}, a1 = a0;
#pragma unroll 4
          for (int k0 = 0; k0 < 64; k0 += 4) { const int s = k0 + kq;
              const float a = Kc[s * HS + dI * 16 + li], b0 = Vc[s * HS + e0 + li], b1 = Vc[s * HS + e0 + 16 + li];
              a0 = mfma4(a, b0, a0); a1 = mfma4(a, b1, a1); }
#pragma unroll
          for (int r = 0; r < 4; ++r) { bf16* up = U + ((size_t)task * 64 + dI * 16 + 4 * kq + r) * 64 + e0 + li; up[0] = (bf16)f2bf(a0[r]); up[16] = (bf16)f2bf(a1[r]); } }
        __syncthreads();
    }
}
DEV void hgrn_scan_phase(Frame& F, int probe = 0) {
    const bf16* U = wsp<bf16>(F, WS_U); bf16* U2 = wsp<bf16>(F, probe ? WS_PROBE : WS_U2); const float* DEC = wsp<float>(F, WS_DEC);
    const int nact = (F.G * 256 >= 65536) ? 256 : 512;
    if (F.tid < nact)
    for (int gid = F.vcu * nact + F.tid; gid < 65536; gid += F.G * nact) {
        const int bh = gid >> 12, de = gid & 4095, d = de >> 6;
        float S = 0.f; const bf16* up = U + (size_t)bh * 128 * 4096 + de; bf16* op = U2 + (size_t)bh * 128 * 4096 + de; const float* dp = DEC + (size_t)bh * 128 * 64 + d;
#pragma unroll 16
        for (int ch = 0; ch < 128; ++ch) { const float u = bf2f(up[(size_t)ch * 4096]); const float dc = dp[ch * 64]; op[(size_t)ch * 4096] = (bf16)f2bf(S); S = dc * S + u; }
    }
}
DEV void hgrn_out_phase(Frame& F, int l) {
    float* Bc = (float*)F.ldsg; float* Kb = Bc + 64 * HS; float* Vc = Kb + 64 * HS; float* Qs = Vc + 64 * HS; float* Sc = Qs + 64 * HS; float* Ac = Sc + 64 * HS; float* tot = Ac + 64 * HS;
    float* Oc = Kb;
    const bf16* U = wsp<bf16>(F, WS_U2); bf16* CAT = wsp<bf16>(F, WS_CAT);
    const int lane = F.lane, w = F.wave, li = lane & 15, kq = lane >> 4;
    for (int task = F.vcu; task < 2048; task += F.G) {
        const int bh = task >> 7, ch = task & 127, b = bh >> 2, h = bh & 3;
        float gv[8];
        { const int d = F.tid & 63, sg = F.tid >> 6;
          const size_t go = ((size_t)b * T + ch * 64 + sg * 8) * 256 + h * 64 + d;
          const float* HFp = wsp<float>(F, WS_HF) + go; const bf16* HIp = wsp<bf16>(F, WS_HI) + go; const bf16* HQp = wsp<bf16>(F, WS_HQ) + go; const bf16* HGp = wsp<bf16>(F, WS_HG) + go;
          const bf16* Up = U + ((size_t)task * 64 + sg * 8) * 64 + d;
          float z[8], vi[8], qi[8], si[8];
#pragma unroll
          for (int i = 0; i < 8; ++i) { z[i] = HFp[(size_t)i * 256]; vi[i] = bf2f(HIp[(size_t)i * 256]); qi[i] = bf2f(HQp[(size_t)i * 256]); gv[i] = bf2f(HGp[(size_t)i * 256]); si[i] = bf2f(Up[(size_t)i * 64]); }
          hgrn_setup_chunk(F, hgrn_lb(F, l, h * 64 + d), z, Bc, Kb, tot);
#pragma unroll
          for (int i = 0; i < 8; ++i) { const int s = sg * 8 + i, J = s >> 4; const float rJ = J ? Bc[(16 * J - 1) * HS + d] : 0.f;
              Kb[s * HS + d] *= __expf(fminf(rJ - Bc[s * HS + d], 80.f));
              Vc[s * HS + d] = vi[i]; Qs[s * HS + d] = qi[i] * 0.125f; Sc[s * HS + d] = si[i]; } }
        __syncthreads();
#pragma unroll 1
        for (int ti = w; ti < 10; ti += 8) {
            const int I = ti < 1 ? 0 : (ti < 3 ? 1 : (ti < 6 ? 2 : 3)), J = ti - (I * (I + 1)) / 2;
            const int t = I * 16 + li; f32x4 acc = (f32x4){0.f, 0.f, 0.f, 0.f};
#pragma unroll 4
            for (int k0 = 0; k0 < 64; k0 += 4) { const int d = k0 + kq; const float rJ = J ? Bc[(16 * J - 1) * HS + d] : 0.f;
                const float a = Qs[t * HS + d] * __expf(Bc[t * HS + d] - rJ), bb = Kb[(J * 16 + li) * HS + d];
                acc = mfma4(a, bb, acc); }
#pragma unroll
            for (int r = 0; r < 4; ++r) { const int tt = I * 16 + 4 * kq + r, ss = J * 16 + li; Ac[tt * HS + ss] = (ss <= tt) ? acc[r] : 0.f; }
        }
        __syncthreads();
        { const int I = w >> 1, e0 = (w & 1) * 32, t = I * 16 + li;
          f32x4 a0 = (f32x4){0.f, 0.f, 0.f, 0.f}, a1 = a0;
#pragma unroll 4
          for (int k0 = 0; k0 < 64; k0 += 4) { const int d = k0 + kq;
              const float a = Qs[t * HS + d] * __expf(Bc[t * HS + d]), b0 = Sc[d * HS + e0 + li], b1 = Sc[d * HS + e0 + 16 + li];
              a0 = mfma4(a, b0, a0); a1 = mfma4(a, b1, a1); }
#pragma unroll 1
          for (int s0 = 0; s0 < 16 * (I + 1); s0 += 4) { const int s = s0 + kq;
              const float a = Ac[t * HS + s], b0 = Vc[s * HS + e0 + li], b1 = Vc[s * HS + e0 + 16 + li];
              a0 = mfma4(a, b0, a0); a1 = mfma4(a, b1, a1); }
#pragma unroll
          for (int r = 0; r < 4; ++r) { float* op = Oc + (I * 16 + 4 * kq + r) * HS + e0 + li; op[0] = a0[r]; op[16] = a1[r]; } }
        __syncthreads();
        { const float ng = inp(8)[l * 256 + h * 64 + lane];
          { const int t = w * 8 + (lane >> 3); const float* op = Oc + t * HS + (lane & 7) * 8; float s = 0.f;
#pragma unroll
            for (int j = 0; j < 8; ++j) s += op[j] * op[j];
            s += __shfl_xor(s, 1); s += __shfl_xor(s, 2); s += __shfl_xor(s, 4);
            if ((lane & 7) == 0) tot[t] = 1.0f / sqrtf(s * (1.0f / 64.0f) + RMS_EPS); }
          LDS_WAIT();
#pragma unroll
          for (int i = 0; i < 8; ++i) { const int t = w * 8 + i; const float o = Oc[t * HS + lane];
              const size_t row = (size_t)b * T + ch * 64 + t;
              CAT[row * 1024 + 768 + h * 64 + lane] = (bf16)f2bf(o * tot[t] * ng * siluf_(gv[i])); } }
        __syncthreads();
    }
}

DEV void conv_phase(Frame& F, int l) {
    const bf16* CB = wsp<bf16>(F, WS_CB); const bf16* CC = wsp<bf16>(F, WS_CC); const bf16* CH = wsp<bf16>(F, WS_CH); bf16* CAT = wsp<bf16>(F, WS_CAT);
    const float* cw = inp(3) + l * 3 * 256;
    for (int it = F.vcu * 512 + F.tid; it < NTOK * 32; it += F.G * 512) {
        const int m = it >> 5, c0 = (it & 31) * 8, t = m & (T - 1);
        const v4u bb = *(const v4u*)(CB + (size_t)m * 256 + c0);
        float y[8];
#pragma unroll
        for (int j = 0; j < 8; ++j) y[j] = 0.f;
#pragma unroll
        for (int k = 0; k < 3; ++k) {
            if (t + k - 2 >= 0) {
                const size_t o = (size_t)(m + k - 2) * 256 + c0;
                const v4u cc = *(const v4u*)(CC + o), hh = *(const v4u*)(CH + o);
#pragma unroll
                for (int j = 0; j < 4; ++j) { const float w0 = cw[k * 256 + c0 + 2 * j], w1 = cw[k * 256 + c0 + 2 * j + 1];
                    y[2 * j] += w0 * (bflo(cc[j]) * bflo(hh[j])); y[2 * j + 1] += w1 * (bfhi(cc[j]) * bfhi(hh[j])); }
            }
        }
        v4u o4;
#pragma unroll
        for (int j = 0; j < 4; ++j) o4[j] = pk2(bflo(bb[j]) * y[2 * j], bfhi(bb[j]) * y[2 * j + 1]);
        *(v4u*)(CAT + (size_t)m * 1024 + 512 + c0) = o4;
    }
}
struct SmState { float m, l; f32x4 o[4]; };
DEV void sm_reset(SmState& st) { st.m = -INFINITY; st.l = 0.f;
#pragma unroll
    for (int i = 0; i < 4; ++i) st.o[i] = (f32x4){0.f, 0.f, 0.f, 0.f}; }
DEV float sm_lsum(const SmState& st) { float l = st.l; l += __shfl_xor(l, 16); l += __shfl_xor(l, 32); return l; }
DEV void load_k(const bf16* kbase, int lane, bf16x8 (&kf)[2][2]) {
#pragma unroll
    for (int tt = 0; tt < 2; ++tt)
#pragma unroll
        for (int ks = 0; ks < 2; ++ks) kf[tt][ks] = *(const bf16x8*)(kbase + lane * 8 + (tt * 2 + ks) * 512);
}
DEV void load_v(const bf16* vbase, int lane, bf16x8 (&vf)[4]) {
    const int l16 = lane & 15, g4 = lane >> 4;
#pragma unroll
    for (int dt = 0; dt < 4; ++dt) vf[dt] = *(const bf16x8*)(vbase + (size_t)(dt * 16 + l16) * 32 + g4 * 8);
}
DEV void qk_tile(const bf16x8 (&kf)[2][2], const bf16x8 (&qf)[2], f32x4 (&s)[2]) {
#pragma unroll
    for (int tt = 0; tt < 2; ++tt) { s[tt] = mfma16(kf[tt][0], qf[0], (f32x4){0.f, 0.f, 0.f, 0.f}); s[tt] = mfma16(kf[tt][1], qf[1], s[tt]); }
}
DEV bf16x8 pack_p(const float (&p)[2][4]) {
    v4u w; w.x = pk2(p[0][0], p[0][1]); w.y = pk2(p[0][2], p[0][3]); w.z = pk2(p[1][0], p[1][1]); w.w = pk2(p[1][2], p[1][3]);
    return __builtin_bit_cast(bf16x8, w);
}
template <int MODE, class MaskF>
DEV void attn_compute(const bf16x8 (&kf)[2][2], const bf16x8 (&vf)[4], const bf16x8 (&qf)[2], SmState& st, int lane, bool colok, MaskF mask) {
    const int g4 = lane >> 4;
    f32x4 s[2]; qk_tile(kf, qf, s);
    float sv[2][4]; float tmax = -INFINITY;
#pragma unroll
    for (int tt = 0; tt < 2; ++tt)
#pragma unroll
        for (int r = 0; r < 4; ++r) { float x = s[tt][r]; if (MODE == 2) x = mask(16 * tt + 4 * g4 + r) ? x : -INFINITY; sv[tt][r] = x; tmax = fmaxf(tmax, x); }
    if (MODE == 1) tmax = colok ? tmax : -INFINITY;
    tmax = fmaxf(tmax, __shfl_xor(tmax, 16)); tmax = fmaxf(tmax, __shfl_xor(tmax, 32));
    const float mnew = fmaxf(st.m, tmax), muse = (mnew == -INFINITY) ? 0.f : mnew;
    const float alpha = ex2(st.m - muse);
    const float msub = (MODE == 1) ? (colok ? muse : INFINITY) : muse;
    float p[2][4]; float ps = 0.f;
#pragma unroll
    for (int tt = 0; tt < 2; ++tt)
#pragma unroll
        for (int r = 0; r < 4; ++r) { p[tt][r] = ex2(sv[tt][r] - msub); ps += p[tt][r]; }
    st.l = st.l * alpha + ps; st.m = mnew;
    const bf16x8 pf = pack_p(p);
#pragma unroll
    for (int dt = 0; dt < 4; ++dt) { st.o[dt] = st.o[dt] * alpha; st.o[dt] = mfma16(vf[dt], pf, st.o[dt]); }
}
template <int MODE, class MaskF>
DEV void attn_compute_fixed(const bf16x8 (&kf)[2][2], const bf16x8 (&vf)[4], const bf16x8 (&qf)[2], SmState& st, float mref, int lane, bool colok, MaskF mask) {
    const int g4 = lane >> 4;
    const float c0 = (MODE == 1) ? (colok ? -mref : -INFINITY) : -mref;
    const f32x4 ci = {c0, c0, c0, c0};
    f32x4 s[2];
#pragma unroll
    for (int tt = 0; tt < 2; ++tt) { s[tt] = mfma16(kf[tt][0], qf[0], ci); s[tt] = mfma16(kf[tt][1], qf[1], s[tt]); }
    float p[2][4];
#pragma unroll
    for (int tt = 0; tt < 2; ++tt)
#pragma unroll
        for (int r = 0; r < 4; ++r) { float x = s[tt][r]; if (MODE == 2) x = mask(16 * tt + 4 * g4 + r) ? x : -INFINITY; p[tt][r] = ex2(x); }
    st.l += ((p[0][0] + p[0][1]) + (p[0][2] + p[0][3])) + ((p[1][0] + p[1][1]) + (p[1][2] + p[1][3]));
    const bf16x8 pf = pack_p(p);
#pragma unroll
    for (int dt = 0; dt < 4; ++dt) st.o[dt] = mfma16(vf[dt], pf, st.o[dt]);
}
template <int MODE, class MaskF>
DEV void attn_max(const bf16x8 (&kf)[2][2], const bf16x8 (&qf)[2], float& mx, int lane, bool colok, MaskF mask) {
    const int g4 = lane >> 4;
    f32x4 s[2]; qk_tile(kf, qf, s);
    float tmax = -INFINITY;
#pragma unroll
    for (int tt = 0; tt < 2; ++tt)
#pragma unroll
        for (int r = 0; r < 4; ++r) { float x = s[tt][r]; if (MODE == 2) x = mask(16 * tt + 4 * g4 + r) ? x : -INFINITY; tmax = fmaxf(tmax, x); }
    if (MODE == 1) tmax = colok ? tmax : -INFINITY;
    mx = fmaxf(mx, tmax);
}
DEV float colmax_finish(float mx) { mx = fmaxf(mx, __shfl_xor(mx, 16)); mx = fmaxf(mx, __shfl_xor(mx, 32)); return mx == -INFINITY ? 0.f : mx; }
DEV float col_norm(const bf16x8 (&qf)[2]) {
    float s = 0.f;
#pragma unroll
    for (int ks = 0; ks < 2; ++ks) { const v4u w = __builtin_bit_cast(v4u, qf[ks]);
#pragma unroll
        for (int j = 0; j < 4; ++j) { const float a = bflo(w[j]), b = bfhi(w[j]); s += a * a + b * b; } }
    s += __shfl_xor(s, 16); s += __shfl_xor(s, 32);
    return sqrtf(s);
}
DEV float wave_max_uniform(float v) {
#pragma unroll
    for (int o = 1; o < 64; o <<= 1) v = fmaxf(v, __shfl_xor(v, o));
    return __builtin_bit_cast(float, __builtin_amdgcn_readfirstlane(__builtin_bit_cast(int, v)));
}
constexpr float FIXED_REF_MAX = 40.f;
DEV void kmax_phase(Frame& F, int l) {
    const int lane = F.lane; const int gw = F.vcu * NWAVES + F.wave, NGW = F.G * NWAVES;
    for (int item = gw; item < 2048; item += NGW) {
        const int br = item >> 10, bh = (item >> 7) & 7, key = (item & 127) * 64 + lane;
        const bf16* kp = wsp<bf16>(F, br ? WS_KW : WS_KS) + (size_t)bh * T * 64;
        float s = 0.f;
#pragma unroll
        for (int i = 0; i < 8; ++i) { const v4u w = *(const v4u*)(kp + kfrag_off(key, i * 8));
#pragma unroll
            for (int j = 0; j < 4; ++j) { const float a = bflo(w[j]), b = bfhi(w[j]); s += a * a + b * b; } }
#pragma unroll
        for (int o = 1; o < 64; o <<= 1) s = fmaxf(s, __shfl_xor(s, o));
        if (lane == 0) __hip_atomic_fetch_max((unsigned*)F.ctl + CW_KMAX + l * 16 + br * 8 + bh, __builtin_bit_cast(unsigned, s), RLX_AGENT);
    }
}
struct NoMask { DEV bool operator()(int) const { return true; } };
template <int D, bool WITHV, class AddrF, class BodyF>
DEV void pipe_run(int n, int lane, AddrF addr, BodyF body) {
    if (n <= 0) return;
    bf16x8 kf[D][2][2], vf[D][4];
#pragma unroll
    for (int d = 0; d < D; ++d) { const bf16* kb; const bf16* vb; addr(d < n ? d : n - 1, kb, vb); load_k(kb, lane, kf[d]); if (WITHV) load_v(vb, lane, vf[d]); }
#pragma unroll 1
    for (int i = 0; i < n; i += D) {
#pragma unroll
        for (int d = 0; d < D; ++d) { const int s = i + d;
            if (s < n) body(s, kf[d], vf[d]);
            if (D > 1 || s + 1 < n) { const bf16* kb; const bf16* vb; addr(s + D < n ? s + D : n - 1, kb, vb); load_k(kb, lane, kf[d]); if (WITHV) load_v(vb, lane, vf[d]); } }
    }
}
template <class AddrF, class BodyF>
DEV void pipe_run_k2(int n, int lane, AddrF addr, BodyF body) {
    if (n <= 0) return;
    bf16x8 kf[2][2][2], vf[4];
    { const bf16* kb; const bf16* vb; addr(0, kb, vb); load_k(kb, lane, kf[0]); }
#pragma unroll 1
    for (int i = 0; i < n; i += 2) {
#pragma unroll
        for (int d = 0; d < 2; ++d) { const int s = i + d;
            { const bf16* kb; const bf16* vb; addr(s < n ? s : n - 1, kb, vb); load_v(vb, lane, vf); }
            { const bf16* kb; const bf16* vb; addr(s + 1 < n ? s + 1 : n - 1, kb, vb); load_k(kb, lane, kf[d ^ 1]); }
            if (s < n) body(s, kf[d], vf); }
    }
}
template <class AddrF, class BodyA, class BodyB>
DEV void pipe_run_mt(int n_main, int n_tail, int lane, AddrF addr, BodyA mainb, BodyB tailb) {
    const int n = n_main + n_tail;
    bf16x8 kf[2][2][2], vf[4];
    { const bf16* kb; const bf16* vb; addr(0, kb, vb); load_k(kb, lane, kf[0]); }
    int i = 0;
#define PIPE_STEP_(s_, d_, BODY_) do { { const bf16* kb; const bf16* vb; addr((s_) < n ? (s_) : n - 1, kb, vb); load_v(vb, lane, vf); } \
        { const bf16* kb; const bf16* vb; addr((s_) + 1 < n ? (s_) + 1 : n - 1, kb, vb); load_k(kb, lane, kf[(d_) ^ 1]); } BODY_((s_), kf[d_], vf); } while (0)
#pragma unroll 1
    for (; i + 2 <= n_main; i += 2) { PIPE_STEP_(i, 0, mainb); PIPE_STEP_(i + 1, 1, mainb); }
    if (i < n_main) { PIPE_STEP_(i, 0, mainb); ++i;
#pragma unroll
        for (int a = 0; a < 2; ++a)
#pragma unroll
            for (int b = 0; b < 2; ++b) kf[0][a][b] = kf[1][a][b]; }
#pragma unroll 1
    for (; i < n; ++i) { PIPE_STEP_(i, 0, tailb);
#pragma unroll
        for (int a = 0; a < 2; ++a)
#pragma unroll
            for (int b = 0; b < 2; ++b) kf[0][a][b] = kf[1][a][b]; }
#undef PIPE_STEP_
}
constexpr int PIPE_D = 2;

DEV void acc_add_packed(unsigned (&pk)[4][4][2], int ct, const f32x4 (&o)[4], float sc, bool first) {
#pragma unroll
    for (int dt = 0; dt < 4; ++dt) {
        f32x4 v = o[dt] * sc;
        if (!first) { v[0] += bflo(pk[ct][dt][0]); v[1] += bfhi(pk[ct][dt][0]); v[2] += bflo(pk[ct][dt][1]); v[3] += bfhi(pk[ct][dt][1]); }
        pk[ct][dt][0] = pk2(v[0], v[1]); pk[ct][dt][1] = pk2(v[2], v[3]);
    }
}
template <int VAR>
DEV void nsa_phase_t(Frame& F, int l) {
#define NSA_RELANE() int ln_ = lane; asm volatile("" : "+v"(ln_)); const int l16 = ln_ & 15, g4 = ln_ >> 4, tq = l16 >> 2, gh = l16 & 3; const size_t mrow0 = (size_t)b * T + t0 + tq; const int tl0 = t0 + tq; (void)l16; (void)g4; (void)gh; (void)mrow0; (void)tl0
    float* IMP = (float*)(F.ldsg + F.wave * NSA_LDS_WAVE);
    float* VALS = IMP + 2048; int* BL = (int*)(IMP + 2176); unsigned* SELB = (unsigned*)(IMP + 2304); float* GL = IMP + 2432;
    const bf16* Q = wsp<bf16>(F, WS_Q);
    const bf16* KCC = wsp<bf16>(F, WS_KCC); const bf16* VCT = wsp<bf16>(F, WS_VCT);
    const bf16* KS = wsp<bf16>(F, WS_KS); const bf16* VST = wsp<bf16>(F, WS_VST);
    const bf16* KW = wsp<bf16>(F, WS_KW); const bf16* VWT = wsp<bf16>(F, WS_VWT);
    bf16* CAT = wsp<bf16>(F, WS_CAT);
    const int gw = F.vcu * NWAVES + F.wave, NGW = F.G * NWAVES;
    const bool xmap = (F.G == 256);
#pragma unroll 1
    for (int task = gw; task < 4096; task += NGW) {
        unsigned zl_ = 0u; asm volatile("" : "+v"(zl_)); const int lane = (int)__builtin_amdgcn_mbcnt_hi(~0u, __builtin_amdgcn_mbcnt_lo(~0u, zl_));
        const int bh = xmap ? (gw >> 8) : (task & 7), idx = xmap ? ((task >> 11) ? 511 - (gw & 255) : (gw & 255)) : (task >> 3);
        const int t0 = idx * 16, b = bh >> 1, hkv = bh & 1, cur = t0 >> 6;
        bf16x8 qf[4][2];
        unsigned opk[4][4][2];
        SmState st[4];
        float qnmax = 0.f;
        { NSA_RELANE();
#pragma unroll
        for (int ct = 0; ct < 4; ++ct)
#pragma unroll
            for (int ks = 0; ks < 2; ++ks) qf[ct][ks] = *(const bf16x8*)(Q + (mrow0 + 4 * ct) * 512 + hkv * 256 + gh * 64 + ks * 32 + g4 * 8);
        { NSA_RELANE();
          f32x4 ga[1]; ga[0] = (f32x4){0.f, 0.f, 0.f, 0.f};
          { const bf16* ap = wsp<bf16>(F, WS_HB) + ((size_t)b * T + t0 + l16) * 1024 + g4 * 8; const bf16* bp = wsp<bf16>(F, WS_WG) + (size_t)((l * 2 + hkv) * 16 + l16) * 1024 + g4 * 8;
#pragma unroll 1
            for (int k0 = 0; k0 < 1024; k0 += 256) {
                bf16x8 av[8], bv[8];
#pragma unroll
                for (int i = 0; i < 8; ++i) { av[i] = *(const bf16x8*)(ap + k0 + 32 * i); bv[i] = *(const bf16x8*)(bp + k0 + 32 * i); }
#pragma unroll
                for (int i = 0; i < 8; ++i) ga[0] = mfma16(av[i], bv[i], ga[0]);
            } }
          const float rs = (ln_ < 16) ? row_rstd_full(wsp<float>(F, WS_SSQ), b * T + t0 + ln_) : 0.f;
#pragma unroll
          for (int r = 0; r < 4; ++r) GL[(g4 * 4 + r) * 16 + l16] = sigmoidf_(ga[0][r] * __shfl(rs, g4 * 4 + r));
        }
        const int ngc = (t0 + 15 >= 31) ? (((t0 + 15 - 31) >> 4) >> 5) + 1 : 0;
        const bf16* kcb = KCC + (size_t)bh * 512 * 64; const bf16* vcb = VCT + (size_t)bh * 16 * 64 * 32;
        float cm[4], cl[4];
#pragma unroll
        for (int ct = 0; ct < 4; ++ct) { cm[ct] = -INFINITY; cl[ct] = 0.f; }
        pipe_run<1, false>(ngc, ln_, [&](int s, const bf16*& kb, const bf16*& vb) { kb = kcb + (size_t)s * 32 * 64; vb = vcb; },
            [&](int kg, const bf16x8 (&kf)[2][2], const bf16x8 (&)[4]) {
#pragma unroll
                for (int ct = 0; ct < 4; ++ct) {
                    const int tl = tl0 + 4 * ct;
                    f32x4 s[2]; qk_tile(kf, qf[ct], s);
                    float sv[2][4]; float tmax = -INFINITY;
#pragma unroll
                    for (int tt = 0; tt < 2; ++tt)
#pragma unroll
                        for (int r = 0; r < 4; ++r) { const int c = kg * 32 + 16 * tt + 4 * g4 + r; sv[tt][r] = (16 * c + 31 <= tl) ? s[tt][r] : -INFINITY; tmax = fmaxf(tmax, sv[tt][r]); }
                    tmax = fmaxf(tmax, __shfl_xor(tmax, 16)); tmax = fmaxf(tmax, __shfl_xor(tmax, 32));
                    const float mnew = fmaxf(cm[ct], tmax), muse = (mnew == -INFINITY) ? 0.f : mnew;
                    float ps = 0.f;
#pragma unroll
                    for (int tt = 0; tt < 2; ++tt)
#pragma unroll
                        for (int r = 0; r < 4; ++r) ps += ex2(sv[tt][r] - muse);
                    cl[ct] = cl[ct] * ex2(cm[ct] - muse) + ps; cm[ct] = mnew;
                }
            });
        {
            float cmu[4], cinv[4], carry[4];
#pragma unroll
            for (int ct = 0; ct < 4; ++ct) { float l = cl[ct]; l += __shfl_xor(l, 16); l += __shfl_xor(l, 32);
                cmu[ct] = (cm[ct] == -INFINITY) ? 0.f : cm[ct]; cinv[ct] = l > 0.f ? 1.0f / l : 0.f; carry[ct] = 0.f; sm_reset(st[ct]); }
            pipe_run<1, true>(ngc, ln_, [&](int s, const bf16*& kb, const bf16*& vb) { kb = kcb + (size_t)s * 32 * 64; vb = vcb + (size_t)s * 64 * 32; },
                [&](int kg, const bf16x8 (&kf)[2][2], const bf16x8 (&vf)[4]) {
#pragma unroll
                    for (int ct = 0; ct < 4; ++ct) {
                        const int tl = tl0 + 4 * ct;
                        f32x4 s[2]; qk_tile(kf, qf[ct], s);
                        float p[2][4];
#pragma unroll
                        for (int tt = 0; tt < 2; ++tt) {
#pragma unroll
                            for (int r = 0; r < 4; ++r) { const int c = kg * 32 + 16 * tt + 4 * g4 + r; p[tt][r] = (16 * c + 31 <= tl) ? ex2(s[tt][r] - cmu[ct]) * cinv[ct] : 0.f; }
                            const float hb = 0.5f * p[tt][3];
                            const float bsh = __shfl(hb, (ln_ + 48) & 63);
                            float v = ((p[tt][0] + p[tt][1]) + (p[tt][2] + hb)) + ((g4 == 0) ? carry[ct] : bsh);
                            carry[ct] = bsh;
                            v += __shfl_xor(v, 1); v += __shfl_xor(v, 2);
                            if (gh == 0) IMP[(4 * ct + tq) * 128 + kg * 8 + 4 * tt + g4] = v;
                        }
                        const bf16x8 pf = pack_p(p);
#pragma unroll
                        for (int dt = 0; dt < 4; ++dt) st[ct].o[dt] = mfma16(vf[dt], pf, st[ct].o[dt]);
                    }
                });
#pragma unroll
            for (int ct = 0; ct < 4; ++ct) acc_add_packed(opk, ct, st[ct].o, GL[(4 * ct + tq) * 16 + gh * 3 + 0], true);
        }
        }
        LDS_WAIT();
        unsigned sb0 = 0u, sb1 = 0u;
        if (cur < 16) { sb0 = (lane <= cur) ? 0xffffu : 0u; }
        else if (VAR == 6) {
#pragma unroll 1
            for (int q = 0; q < 16; ++q) { const bool s0 = (lane <= cur) && ((lane * 37 + q * 11) % (cur + 1)) < 16, s1 = (lane + 64 <= cur) && (((lane + 64) * 37 + q * 11) % (cur + 1)) < 16;
                sb0 |= (s0 ? 1u : 0u) << q; sb1 |= (s1 ? 1u : 0u) << q; }
        }
        else {
            const unsigned long long below = (1ull << lane) - 1ull;
#pragma unroll 1
            for (int q = 0; q < 16; ++q) {
                unsigned k0, k1;
                { const int j = lane; const float v = (j == 0 || j == cur || j == cur - 1) ? 1e6f : IMP[q * 128 + j]; k0 = (j > cur) ? 0u : __builtin_bit_cast(unsigned, v) + 1u; }
                { const int j = lane + 64; const float v = (j == cur || j == cur - 1) ? 1e6f : IMP[q * 128 + j]; k1 = (j > cur) ? 0u : __builtin_bit_cast(unsigned, v) + 1u; }
                unsigned lo = 0u, hi = 0xffffffffu;
                while (hi - lo > 1u) { const unsigned mid = lo + ((hi - lo) >> 1);
                    const int c = __builtin_popcountll(__ballot(k0 >= mid)) + __builtin_popcountll(__ballot(k1 >= mid));
                    if (c >= 16) lo = mid; else hi = mid; }
                const unsigned long long g0 = __ballot(k0 > lo), g1 = __ballot(k1 > lo), e0 = __ballot(k0 == lo), e1 = __ballot(k1 == lo);
                const int need = 16 - __builtin_popcountll(g0) - __builtin_popcountll(g1);
                const bool s0 = (k0 > lo) || (k0 == lo && __builtin_popcountll(e0 & below) < need);
                const bool s1 = (k1 > lo) || (k1 == lo && __builtin_popcountll(e0) + __builtin_popcountll(e1 & below) < need);
                sb0 |= (s0 ? 1u : 0u) << q; sb1 |= (s1 ? 1u : 0u) << q;
            }
        }
        SELB[lane] = sb0; SELB[lane + 64] = sb1;
        LDS_WAIT();
#define NSA_PARK() do { _Pragma("unroll") for (int i_ = 0; i_ < 8; ++i_) { v4u w_; w_.x = opk[i_ >> 1][(i_ & 1) * 2][0]; w_.y = opk[i_ >> 1][(i_ & 1) * 2][1]; w_.z = opk[i_ >> 1][(i_ & 1) * 2 + 1][0]; w_.w = opk[i_ >> 1][(i_ & 1) * 2 + 1][1]; ((v4u*)IMP)[i_ * 64 + lane] = w_; } } while (0)
#define NSA_UNPARK() do { _Pragma("unroll") for (int i_ = 0; i_ < 8; ++i_) { const v4u w_ = ((const v4u*)IMP)[i_ * 64 + lane]; opk[i_ >> 1][(i_ & 1) * 2][0] = w_.x; opk[i_ >> 1][(i_ & 1) * 2][1] = w_.y; opk[i_ >> 1][(i_ & 1) * 2 + 1][0] = w_.z; opk[i_ >> 1][(i_ & 1) * 2 + 1][1] = w_.w; } } while (0)
        NSA_PARK();
        { NSA_RELANE();
#pragma unroll
        for (int ct = 0; ct < 4; ++ct) {
            const float* rp = wsp<float>(F, WS_ROPE) + ((size_t)(tl0 + 4 * ct) * 32 + g4 * 8) * 2;
            const v4u a = __builtin_bit_cast(v4u, qf[ct][0]), b2 = __builtin_bit_cast(v4u, qf[ct][1]); v4u ra, rb;
#pragma unroll
            for (int jj = 0; jj < 4; ++jj) { const f32x4 cs = *(const f32x4*)(rp + 4 * jj);
                const float x1a = bflo(a[jj]), x1b = bfhi(a[jj]), x2a = bflo(b2[jj]), x2b = bfhi(b2[jj]);
                ra[jj] = pk2(x1a * cs[0] - x2a * cs[1], x1b * cs[2] - x2b * cs[3]);
                rb[jj] = pk2(x2a * cs[0] + x1a * cs[1], x2b * cs[2] + x1b * cs[3]); }
            qf[ct][0] = __builtin_bit_cast(bf16x8, ra); qf[ct][1] = __builtin_bit_cast(bf16x8, rb);
        }
        {
            const unsigned long long ulo = __ballot(sb0 != 0u), uhi = __ballot(sb1 != 0u);
            const unsigned long long below = (1ull << ln_) - 1ull;
            const int nlo = __builtin_popcountll(ulo), nblk = nlo + __builtin_popcountll(uhi);
            if (sb0 != 0u) BL[__builtin_popcountll(ulo & below)] = ln_;
            if (sb1 != 0u) BL[nlo + __builtin_popcountll(uhi & below)] = ln_ + 64;
            LDS_WAIT();
#pragma unroll
            for (int ct = 0; ct < 4; ++ct) sm_reset(st[ct]);
            const bf16* kb0 = KS + (size_t)bh * T * 64; const bf16* vb0 = VST + (size_t)bh * 256 * 64 * 32;
            float mr; bool fixed;
            { const float kmx = sqrtf(__builtin_bit_cast(float, __hip_atomic_load((const unsigned*)F.ctl + CW_KMAX + l * 16 + bh, RLX_AGENT))); float mm = 0.f;
#pragma unroll
              for (int ct = 0; ct < 4; ++ct) mm = fmaxf(mm, col_norm(qf[ct]));
              qnmax = wave_max_uniform(mm); mr = qnmax * kmx * 1.002f + 1e-3f;
              fixed = mr < FIXED_REF_MAX; }
            auto addr_sel = [&](int s, const bf16*& kb, const bf16*& vb) { const int g32 = (VAR == 7) ? (s & 1) : BL[s >> 1] * 2 + (s & 1); kb = kb0 + (size_t)g32 * 32 * 64; vb = vb0 + (size_t)g32 * 64 * 32; };
            asm volatile("" ::: "memory");
            if (!fixed) {
                float mx[4] = {-INFINITY, -INFINITY, -INFINITY, -INFINITY};
                pipe_run<1, false>(2 * nblk, ln_, addr_sel,
                    [&](int s, const bf16x8 (&kf)[2][2], const bf16x8 (&)[4]) {
                        const int j = BL[s >> 1], key0 = j * 64 + (s & 1) * 32;
                        const unsigned tm = (unsigned)__builtin_amdgcn_readfirstlane((int)SELB[j]);
#pragma unroll
                        for (int ct = 0; ct < 4; ++ct) { const unsigned tmk = (tm >> (4 * ct)) & 0xFu;
                            if (tmk) { const bool colok = (tmk >> tq) & 1u; const int tl = tl0 + 4 * ct;
                                if (j == cur) attn_max<2>(kf, qf[ct], mx[ct], ln_, true, [&](int kk) { return colok && (key0 + kk <= tl); });
                                else attn_max<1>(kf, qf[ct], mx[ct], ln_, colok, NoMask()); } }
                    });
                mr = wave_max_uniform(fmaxf(fmaxf(mx[0], mx[1]), fmaxf(mx[2], mx[3]))); if (mr == -INFINITY) mr = 0.f;
            }
            asm volatile("" ::: "memory");
            if (VAR != 4)
            pipe_run_mt(2 * nblk - 2, 2, ln_, addr_sel,
                [&](int s, const bf16x8 (&kf)[2][2], const bf16x8 (&vf)[4]) {
                    const int j = BL[s >> 1];
                    const unsigned tm = (unsigned)__builtin_amdgcn_readfirstlane((int)SELB[j]);
#pragma unroll
                    for (int ct = 0; ct < 4; ++ct) {
                        const unsigned tmk = (tm >> (4 * ct)) & 0xFu;
                        if (tmk) attn_compute_fixed<1>(kf, vf, qf[ct], st[ct], mr, ln_, (tmk >> tq) & 1u, NoMask());
                    }
                },
                [&](int s, const bf16x8 (&kf)[2][2], const bf16x8 (&vf)[4]) {
                    const int key0 = cur * 64 + (s & 1) * 32;
#pragma unroll
                    for (int ct = 0; ct < 4; ++ct) { const int tl = tl0 + 4 * ct;
                        attn_compute_fixed<2>(kf, vf, qf[ct], st[ct], mr, ln_, true, [&](int kk) { return key0 + kk <= tl; }); }
                });
            LDS_WAIT();
            NSA_UNPARK();
#pragma unroll
            for (int ct = 0; ct < 4; ++ct) { const float ls = sm_lsum(st[ct]); const float gs = GL[(4 * ct + tq) * 16 + gh * 3 + 1];
                acc_add_packed(opk, ct, st[ct].o, ls > 0.f ? gs / ls : 0.f, false); }
            NSA_PARK();
        }
        }
        { NSA_RELANE();
#pragma unroll
            for (int ct = 0; ct < 4; ++ct) sm_reset(st[ct]);
            const bf16* kb0 = (VAR == 3 ? KS : KW) + (size_t)bh * T * 64; const bf16* vb0 = (VAR == 3 ? VST : VWT) + (size_t)bh * 256 * 64 * 32;
            const int glo = (t0 - 511 > 0 ? t0 - 511 : 0) >> 5, ghi = (t0 + 15) >> 5;
            float mr; bool fixed;
            { const float kmx = sqrtf(__builtin_bit_cast(float, __hip_atomic_load((const unsigned*)F.ctl + CW_KMAX + l * 16 + 8 + bh, RLX_AGENT)));
              mr = qnmax * kmx * 1.002f + 1e-3f;
              fixed = mr < FIXED_REF_MAX; }
            auto addr_win = [&](int s, const bf16*& kb, const bf16*& vb) { kb = kb0 + (size_t)(glo + s) * 32 * 64; vb = vb0 + (size_t)(glo + s) * 64 * 32; };
            asm volatile("" ::: "memory");
            if (!fixed) {
                float mx[4] = {-INFINITY, -INFINITY, -INFINITY, -INFINITY};
                pipe_run<1, false>(ghi - glo + 1, ln_, addr_win,
                    [&](int s, const bf16x8 (&kf)[2][2], const bf16x8 (&)[4]) {
                        const int key0 = (glo + s) * 32;
#pragma unroll
                        for (int ct = 0; ct < 4; ++ct) { const int tl = tl0 + 4 * ct;
                            attn_max<2>(kf, qf[ct], mx[ct], ln_, true, [&](int kk) { const int kp = key0 + kk; return kp <= tl && kp + 512 > tl; }); }
                    });
                mr = wave_max_uniform(fmaxf(fmaxf(mx[0], mx[1]), fmaxf(mx[2], mx[3]))); if (mr == -INFINITY) mr = 0.f;
            }
            asm volatile("" ::: "memory");
            const int g_a = (t0 >= 497) ? ((t0 - 497) >> 5) + 1 : 0, g_b = (t0 - 31) >> 5;
            const int n_main = g_b >= g_a ? g_b - g_a + 1 : 0, n_up = ghi - (g_b >= g_a ? g_b : g_a - 1), n_tail = n_up + (g_a - glo);
            auto grp = [&](int s) { const int u = s - n_main; return s < n_main ? g_a + s : (u < n_up ? ghi - n_up + 1 + u : glo + (u - n_up)); };
            auto addr_w2 = [&](int s, const bf16*& kb, const bf16*& vb) { const int g = grp(s); kb = kb0 + (size_t)g * 32 * 64; vb = vb0 + (size_t)g * 64 * 32; };
            if (VAR != 5)
            pipe_run_mt(n_main, n_tail, ln_, addr_w2,
                [&](int, const bf16x8 (&kf)[2][2], const bf16x8 (&vf)[4]) {
#pragma unroll
                    for (int ct = 0; ct < 4; ++ct) attn_compute_fixed<0>(kf, vf, qf[ct], st[ct], mr, ln_, true, NoMask());
                },
                [&](int s, const bf16x8 (&kf)[2][2], const bf16x8 (&vf)[4]) {
                    const int key0 = grp(s) * 32;
#pragma unroll
                    for (int ct = 0; ct < 4; ++ct) {
                        const int tlo = t0 + 4 * ct, thi = tlo + 3, tl = tl0 + 4 * ct;
                        if (key0 > thi || key0 + 31 + 512 <= tlo) continue;
                        attn_compute_fixed<2>(kf, vf, qf[ct], st[ct], mr, ln_, true, [&](int kk) { const int kp = key0 + kk; return kp <= tl && kp + 512 > tl; });
                    }
                });
            NSA_UNPARK();
#pragma unroll
            for (int ct = 0; ct < 4; ++ct) { const float ls = sm_lsum(st[ct]); const float gwn = GL[(4 * ct + tq) * 16 + gh * 3 + 2];
                acc_add_packed(opk, ct, st[ct].o, ls > 0.f ? gwn / ls : 0.f, false); }
        }
        { NSA_RELANE();
#pragma unroll
        for (int ct = 0; ct < 4; ++ct)
#pragma unroll
            for (int dt = 0; dt < 4; ++dt) { v2u w; w.x = opk[ct][dt][0]; w.y = opk[ct][dt][1];
                if (VAR == 0 || w.x == 0x7fc17fc1u) *(v2u*)(CAT + (mrow0 + 4 * ct) * 1024 + hkv * 256 + gh * 64 + dt * 16 + g4 * 4) = w; }
        }
        LDS_WAIT();
        if (VAR == 0 && xmap) convert_experts(F, l, (bf16*)IMP, task >> 11);
    }
#undef NSA_RELANE
#undef NSA_PARK
#undef NSA_UNPARK
}

DEV void nsa_phase(Frame& F, int l) { nsa_phase_t<0>(F, l); }

DEV void cross_phase(Frame& F, int l) {
    const int lane = F.lane, l16 = lane & 15, g4 = lane >> 4;
    const bf16* XQ = wsp<bf16>(F, WS_XQ); bf16* XO = wsp<bf16>(F, WS_XO);
    const int gw = F.vcu * NWAVES + F.wave, NGW = F.G * NWAVES;
#pragma unroll 1
    for (int task = gw; task < 2048; task += NGW) {
        const int head = task & 3, m0 = (task >> 2) * 64, b = m0 >> 13;
        bf16x8 qf[4][2];
#pragma unroll
        for (int ct = 0; ct < 4; ++ct)
#pragma unroll
            for (int ks = 0; ks < 2; ++ks) qf[ct][ks] = *(const bf16x8*)(XQ + (size_t)(m0 + 16 * ct + l16) * 256 + head * 64 + ks * 32 + g4 * 8);
        const bf16* kb0 = wsp<bf16>(F, WS_MK) + (size_t)((l * 4 + b) * 4 + head) * 256 * 64;
        const bf16* vb0 = wsp<bf16>(F, WS_MVT) + (size_t)((l * 4 + b) * 4 + head) * 8 * 64 * 32;
        SmState st[4];
#pragma unroll
        for (int ct = 0; ct < 4; ++ct) sm_reset(st[ct]);
        pipe_run<PIPE_D, true>(8, lane, [&](int s, const bf16*& kb, const bf16*& vb) { kb = kb0 + (size_t)s * 32 * 64; vb = vb0 + (size_t)s * 64 * 32; },
            [&](int, const bf16x8 (&kf)[2][2], const bf16x8 (&vf)[4]) {
#pragma unroll
                for (int ct = 0; ct < 4; ++ct) attn_compute<0>(kf, vf, qf[ct], st[ct], lane, true, NoMask());
            });
#pragma unroll
        for (int ct = 0; ct < 4; ++ct) {
            const float inv = 1.0f / sm_lsum(st[ct]);
#pragma unroll
            for (int dt = 0; dt < 4; ++dt) { const f32x4 o = st[ct].o[dt] * inv; v2u w; w.x = pk2(o[0], o[1]); w.y = pk2(o[2], o[3]);
                *(v2u*)(XO + (size_t)(m0 + 16 * ct + l16) * 256 + head * 64 + dt * 16 + g4 * 4) = w; }
        }
    }
}


DEV void router_phase(Frame& F, int l, int probe = 0) {
    const int lane = F.lane, l16 = lane & 15, g4 = lane >> 4;
    float* LG = (float*)F.ldsg + F.wave * 768;
    const bf16* HB = wsp<bf16>(F, WS_HB); const float* SSQ = wsp<float>(F, WS_SSQ);
    const bf16* WR = wsp<bf16>(F, WS_WR) + (size_t)l * 96 * 1024;
    int* TOKE = wsp<int>(F, probe ? WS_PROBE : WS_TOKE); float* TOKG = wsp<float>(F, probe ? WS_PROBE + MiB : WS_TOKG); int* TOKP = wsp<int>(F, probe ? WS_PROBE + 2 * MiB : WS_TOKP);
    unsigned* CNT = (unsigned*)F.ctl + CW_CNT + l * 32 + (probe ? 64 : 0);
    const float* bg = inp(14) + l * 4; const float* be = inp(16) + l * 32;
    unsigned* HIST = (unsigned*)((float*)F.ldsg + 8 * 768);
#pragma unroll 1
    for (int tb = F.vcu * NWAVES; tb < NTOK / 16; tb += F.G * NWAVES) {
        const int task = tb + F.wave; const bool live = task < NTOK / 16;
        const int m0 = (live ? task : tb) * 16;
        if (F.tid < 64) HIST[F.tid] = 0u;
        f32x4 acc[3];
        {
            const bf16* ap = HB + (size_t)(m0 + l16) * 1024 + g4 * 8; const bf16* bp = WR + (size_t)l16 * 1024 + g4 * 8;
#pragma unroll
            for (int n = 0; n < 3; ++n) acc[n] = (f32x4){0.f, 0.f, 0.f, 0.f};
#pragma unroll 4
            for (int k = 0; k < 1024; k += 32) {
                const bf16x8 a = *(const bf16x8*)(ap + k);
#pragma unroll
                for (int n = 0; n < 3; ++n) { const bf16x8 bh = *(const bf16x8*)(bp + (size_t)n * 16 * 1024 + k), bl = *(const bf16x8*)(bp + (size_t)(48 + n * 16) * 1024 + k);
                    acc[n] = mfma16(a, bh, acc[n]); acc[n] = mfma16(a, bl, acc[n]); }
            }
        }
#pragma unroll
        for (int nt = 0; nt < 3; ++nt)
#pragma unroll
            for (int r = 0; r < 4; ++r) LG[(g4 * 4 + r) * 48 + nt * 16 + l16] = acc[nt][r];
        LDS_WAIT();
        int id1 = 0, id2 = 0;
        if (lane < 16) {
            const int m = m0 + lane; const float rstd = row_rstd_full(SSQ, m); const float* lg = LG + lane * 48;
            float g[4];
#pragma unroll
            for (int j = 0; j < 4; ++j) g[j] = lg[j] * rstd + bg[j];
            float gmax = g[0]; int grp = 0;
#pragma unroll
            for (int j = 1; j < 4; ++j) if (g[j] > gmax) { gmax = g[j]; grp = j; }
            float den = 0.f;
#pragma unroll
            for (int j = 0; j < 4; ++j) den += expf(g[j] - gmax);
            const float psel = 1.0f / den;
            float e1 = -INFINITY, e2 = -INFINITY; int i1 = 0, i2 = 0;
            for (int j = 0; j < 8; ++j) { const float v = lg[4 + grp * 8 + j] * rstd + be[grp * 8 + j];
                if (v > e1) { e2 = e1; i2 = i1; e1 = v; i1 = j; } else if (v > e2) { e2 = v; i2 = j; } }
            const float x = expf(e2 - e1), w1 = 1.0f / (1.0f + x), w2 = x * w1;
            id1 = grp * 8 + i1; id2 = grp * 8 + i2;
            if (live) { TOKE[m * 2] = id1; TOKE[m * 2 + 1] = id2; TOKG[m * 2] = psel * w1; TOKG[m * 2 + 1] = psel * w2; }
        }
        __syncthreads();
        unsigned lp1 = 0u, lp2 = 0u;
        if (lane < 16 && live) { lp1 = __hip_atomic_fetch_add(HIST + id1, 1u, __ATOMIC_RELAXED, __HIP_MEMORY_SCOPE_WORKGROUP); lp2 = __hip_atomic_fetch_add(HIST + id2, 1u, __ATOMIC_RELAXED, __HIP_MEMORY_SCOPE_WORKGROUP); }
        __syncthreads();
        if (F.tid < 32) { const unsigned c = HIST[F.tid]; HIST[32 + F.tid] = c ? __hip_atomic_fetch_add(CNT + F.tid, c, RLX_AGENT) : 0u; }
        __syncthreads();
        if (lane < 16 && live) { const int m = m0 + lane; TOKP[m * 2] = (int)(HIST[32 + id1] + lp1); TOKP[m * 2 + 1] = (int)(HIST[32 + id2] + lp2); }
        __syncthreads();
    }
}
DEV int moe_tables(Frame& F, int l) {
    int* tab = (int*)(F.ldsg + TAB_OFF);
    if (F.tid == 0) {
        const unsigned* CNT = (const unsigned*)F.ctl + CW_CNT + l * 32; int off = 0;
#pragma unroll 1
        for (int e = 0; e < 32; ++e) { tab[e] = off; const int c = (int)__hip_atomic_load(CNT + e, RLX_AGENT); const int nt = (c + 255) >> 8;
            for (int i = 0; i < nt; ++i) tab[40 + (off >> 8) + i] = e;
            off += nt << 8; }
        tab[32] = off;
    }
    __syncthreads();
    return tab[32];
}
DEV void gather_phase(Frame& F, int l) {
    (void)moe_tables(F, l);
    const int* tab = (const int*)(F.ldsg + TAB_OFF);
    const int lane = F.lane; const int gw = F.vcu * NWAVES + F.wave, NGW = F.G * NWAVES;
    const bf16* HB = wsp<bf16>(F, WS_HB); const float* SSQ = wsp<float>(F, WS_SSQ); bf16* XS = wsp<bf16>(F, WS_XS);
    const int* TOKE = wsp<int>(F, WS_TOKE); const float* TOKG = wsp<float>(F, WS_TOKG); const int* TOKP = wsp<int>(F, WS_TOKP); int* TOKS = wsp<int>(F, WS_TOKS);
    float* SRSTD = wsp<float>(F, WS_SRSTD); float* SGATE = wsp<float>(F, WS_SGATE);
    const unsigned* CNT = (const unsigned*)F.ctl + CW_CNT + l * 32;
#pragma unroll 1
    for (int m0 = gw; m0 < NTOK; m0 += 4 * NGW) {
        int s0[4], s1[4]; float g0[4], g1[4], rs[4]; v4u a[4], c[4];
#pragma unroll
        for (int k = 0; k < 4; ++k) { const int m = m0 + k * NGW; const bool ok = m < NTOK; const int mm = ok ? m : m0;
            const int e0 = TOKE[mm * 2], e1 = TOKE[mm * 2 + 1], p0 = TOKP[mm * 2], p1 = TOKP[mm * 2 + 1];
            g0[k] = TOKG[mm * 2]; g1[k] = TOKG[mm * 2 + 1];
            a[k] = *(const v4u*)(HB + (size_t)mm * 1024 + lane * 8); c[k] = *(const v4u*)(HB + (size_t)mm * 1024 + 512 + lane * 8);
            rs[k] = row_rstd_full(SSQ, mm);
            s0[k] = tab[e0] + p0; s1[k] = tab[e1] + p1; }
#pragma unroll
        for (int k = 0; k < 4; ++k) { const int m = m0 + k * NGW;
            if (m < NTOK) {
                *(v4u*)(XS + (size_t)s0[k] * 1024 + lane * 8) = a[k]; *(v4u*)(XS + (size_t)s0[k] * 1024 + 512 + lane * 8) = c[k];
                *(v4u*)(XS + (size_t)s1[k] * 1024 + lane * 8) = a[k]; *(v4u*)(XS + (size_t)s1[k] * 1024 + 512 + lane * 8) = c[k];
                if (lane == 0) { SRSTD[s0[k]] = rs[k]; SRSTD[s1[k]] = rs[k]; SGATE[s0[k]] = g0[k]; SGATE[s1[k]] = g1[k]; TOKS[m * 2] = s0[k]; TOKS[m * 2 + 1] = s1[k]; } } }
    }
#pragma unroll 1
    for (int e = 0; e < 32; ++e) {
        const int c = (int)__hip_atomic_load(CNT + e, RLX_AGENT), base = tab[e], end = (e == 31 ? tab[32] : tab[e + 1]);
        for (int r = base + c + gw; r < end; r += NGW) {
            *(v4u*)(XS + (size_t)r * 1024 + lane * 8) = (v4u){0u, 0u, 0u, 0u}; *(v4u*)(XS + (size_t)r * 1024 + 512 + lane * 8) = (v4u){0u, 0u, 0u, 0u};
            if (lane == 0) { SRSTD[r] = 0.f; SGATE[r] = 0.f; }
        }
    }
}
DEV void combine_phase(Frame& F, int l, int probe = 0) {
    const int lane = F.lane; const int gw = F.vcu * NWAVES + F.wave, NGW = F.G * NWAVES;
    float* Ho = probe ? wsp<float>(F, WS_PROBE) : (float*)(GAS float*)F.out; const bf16* HBi = wsp<bf16>(F, WS_HB); bf16* HB = wsp<bf16>(F, probe ? WS_PROBE + 128 * MiB : WS_HB); float* SSQ = wsp<float>(F, probe ? WS_PROBE + 192 * MiB : WS_SSQ); const bf16* YS = wsp<bf16>(F, WS_YS); const int* TOKS = wsp<int>(F, WS_TOKS);
    const float* gf = inp(23);
#pragma unroll 1
    for (int m0 = gw; m0 < NTOK; m0 += 2 * NGW) {
        f32x4 v[2][4]; float ssum[2];
        int sl[2][2];
#pragma unroll
        for (int k = 0; k < 2; ++k) { const int m = (m0 + k * NGW < NTOK) ? m0 + k * NGW : m0; sl[k][0] = TOKS[m * 2]; sl[k][1] = TOKS[m * 2 + 1]; }
        v2u h[2][4]; v2u ya[2][4], yb[2][4];
#pragma unroll
        for (int k = 0; k < 2; ++k) { const int m = (m0 + k * NGW < NTOK) ? m0 + k * NGW : m0;
#pragma unroll
            for (int j = 0; j < 4; ++j) { const int c = lane * 4 + 256 * j;
                h[k][j] = *(const v2u*)(HBi + (size_t)m * 1024 + c);
                ya[k][j] = *(const v2u*)(YS + (size_t)sl[k][0] * 1024 + c); yb[k][j] = *(const v2u*)(YS + (size_t)sl[k][1] * 1024 + c); } }
#pragma unroll
        for (int k = 0; k < 2; ++k) { float ss = 0.f;
#pragma unroll
            for (int j = 0; j < 4; ++j) { const v2u a = ya[k][j], bq = yb[k][j]; const f32x4 hh = (f32x4){bflo(h[k][j].x), bfhi(h[k][j].x), bflo(h[k][j].y), bfhi(h[k][j].y)};
                f32x4 r; r[0] = hh[0] + (bflo(a.x) + bflo(bq.x)); r[1] = hh[1] + (bfhi(a.x) + bfhi(bq.x)); r[2] = hh[2] + (bflo(a.y) + bflo(bq.y)); r[3] = hh[3] + (bfhi(a.y) + bfhi(bq.y));
                v[k][j] = r; ss += (r[0] * r[0] + r[1] * r[1]) + (r[2] * r[2] + r[3] * r[3]); }
            ssum[k] = wave_sum(ss); }
#pragma unroll
        for (int k = 0; k < 2; ++k) { const int m = m0 + k * NGW;
            if (m < NTOK) {
                if (l == DEPTH - 1) {
                    const float rstd = 1.0f / sqrtf(ssum[k] * (1.0f / 1024.0f) + RMS_EPS);
#pragma unroll
                    for (int j = 0; j < 4; ++j) { const int c = lane * 4 + 256 * j; const f32x4 g = *(const f32x4*)(gf + c); *(f32x4*)(Ho + (size_t)m * 1024 + c) = v[k][j] * rstd * g; }
                } else {
#pragma unroll
                    for (int j = 0; j < 4; ++j) { const int c = lane * 4 + 256 * j;
                        v2u w; w.x = pk2(v[k][j][0], v[k][j][1]); w.y = pk2(v[k][j][2], v[k][j][3]); *(v2u*)(HB + (size_t)m * 1024 + c) = w; }
                    if (lane < 16) SSQ[(size_t)m * 16 + lane] = lane == 0 ? ssum[k] : 0.f;
                } } }
    }
}
#ifndef MK_ONE_LAUNCH
#define MK_ONE_LAUNCH 1
#endif
constexpr int NPH_LAYER = 13, NPHASES = 1 + DEPTH * NPH_LAYER;
struct Args { const float* in[24]; float* out; unsigned char* ws; int ph_lo, ph_hi; };
static_assert(sizeof(Args) == 24 * 8 + 8 + 8 + 8, "Args has no padding");

__global__ void __launch_bounds__(NWAVES * 64, 2) hymba_fwd(Args args) {
    extern __shared__ __attribute__((aligned(16))) unsigned char lds[];
    Frame F;
    F.lds = (LAS unsigned char*)lds; F.ldsg = lds;
    F.MISC = (volatile LAS unsigned*)(F.lds + MISC_OFF);
    F.tid = threadIdx.x; F.lane = F.tid & 63; F.wave = __builtin_amdgcn_readfirstlane(F.tid >> 6);
    F.G = gridDim.x; { const int bx = blockIdx.x; F.vcu = (F.G % 8 == 0) ? (bx % 8) * (F.G / 8) + bx / 8 : bx; }
    F.ws = args.ws; F.ctl = (gu32*)(args.ws + WS_CTL); F.out = args.out;
    if (F.tid < 64) ((LAS unsigned*)(F.lds + MISC_OFF))[F.tid] = 0u;
    __syncthreads();
    int wave0 = F.wave;
    const int lo = args.ph_lo, hi = args.ph_hi;
    XcdBarrier bar; bar.bar = (unsigned*)(F.ctl + CW_BAR); bar.x = 0; bar.st = nullptr;
    if (hi - lo > 1) bar = xcd_barrier_post((unsigned*)(F.ctl + CW_BAR), F.MISC + 8);
#ifndef PHMASK
#define PHMASK 0xFFFF
#endif
#define IN(k) (lo <= (k) && (k) < hi)
#define EN(j) ((PHMASK >> (j)) & 1)
#define RELAUNDER() do { asm volatile("" : "+s"(wave0)); unsigned z_ = 0u; asm volatile("" : "+v"(z_)); int t_ = wave0 * 64 + (int)__builtin_amdgcn_mbcnt_hi(~0u, __builtin_amdgcn_mbcnt_lo(~0u, z_)); F.tid = t_; F.lane = t_ & 63; F.wave = wave0; \
    size_t zo_ = 0; asm volatile("" : "+s"(zo_), "+s"(F.vcu), "+s"(F.G)); F.ws = args.ws + zo_; F.out = args.out + zo_; F.ctl = (gu32*)(F.ws + WS_CTL); } while (0)
#ifndef NSA_VAR
#define NSA_VAR 0
#endif
#ifndef BAR2X
#define BAR2X 0
#endif
#ifndef DUPMASK
#define DUPMASK 0
#endif
#define DUP(j) ((DUPMASK >> (j)) & 1)
#ifndef STAG_J0
#define STAG_J0 0
#endif
#ifndef STAG_MOE
#define STAG_MOE 0
#endif
#define STAGGER(ticks) do { if ((ticks) > 0 && (F.vcu & 1)) { const unsigned long long t0_ = __builtin_amdgcn_s_memrealtime(); while (__builtin_amdgcn_s_memrealtime() - t0_ < (unsigned long long)(ticks)) __builtin_amdgcn_s_sleep(32); } } while (0)
#define SEAM(k) do { if (IN(k) && IN((k) + 1)) { XcdBarrier b_ = bar; size_t zb_ = 0; asm volatile("" : "+s"(b_.x), "+s"(zb_)); b_.bar = (unsigned*)(args.ws + WS_CTL + zb_) + CW_BAR; xcd_barrier(b_); if (BAR2X) xcd_barrier(b_); } } while (0)

    if (IN(0) && EN(13)) { RELAUNDER(); p0_prologue(F); if (DUP(13)) { __syncthreads(); p0_prologue(F); } } SEAM(0);

#pragma unroll 1
    for (int l = 0; l < DEPTH; ++l) {
        const int pb = 1 + l * NPH_LAYER;
        bf16* HB = wsp<bf16>(F, WS_HB); float* SSQ = wsp<float>(F, WS_SSQ);
        if (IN(pb + 0) && EN(0)) for (int rep_ = 0; rep_ < (DUP(0) ? 2 : 1); ++rep_) { RELAUNDER(); if (rep_) __syncthreads();
            pg8::Gemm g{HB, wsp<bf16>(F, WS_WIN) + (size_t)l * NIN * 1024, NTOK, 3072, D};
            pg8::StaticOrder S; S.init(NTOK, 3072, F.G, (int)blockIdx.x);
            EpiIn E{F.ws};
            STAGGER(STAG_J0);
            pg8::gemm_phase<EpiIn, pg8::StaticOrder, true, true>(F.lds, g, S, E, F.wave);
        }
        SEAM(pb + 0);
        if (IN(pb + 1) && EN(1)) { RELAUNDER();
            compress_phase(F, l);
            hgrn_local_phase(F, l);
            conv_phase(F, l);
            kmax_phase(F, l);
            if (l == 0) memkv_phase(F);
            if (DUP(1)) { __syncthreads(); compress_phase(F, l); hgrn_local_phase(F, l); conv_phase(F, l); }
        }
        SEAM(pb + 1);
        if (IN(pb + 2) && EN(2)) { RELAUNDER(); hgrn_scan_phase(F); if (DUP(14)) hgrn_scan_phase(F, 1); nsa_phase(F, l); if (DUP(2)) { __syncthreads(); nsa_phase_t<NSA_VAR>(F, l); } }
        SEAM(pb + 2);
        if (IN(pb + 3) && EN(3)) { RELAUNDER(); hgrn_out_phase(F, l); if (DUP(3)) { __syncthreads(); hgrn_out_phase(F, l); } }
        SEAM(pb + 3);
        if (IN(pb + 4) && EN(4)) for (int rep_ = 0; rep_ < ((DUP(4) && l == 0) ? 2 : 1); ++rep_) { RELAUNDER(); if (rep_) __syncthreads();
            pg8::Gemm g{wsp<bf16>(F, WS_CAT), wsp<bf16>(F, WS_WOUT) + (size_t)l * 1024 * 1024, NTOK, D, D};
            pg8::StaticOrder S; S.init(NTOK, D, F.G, (int)blockIdx.x);
            EpiRes E{l == 0 ? inp(0) : (const float*)nullptr, HB, SSQ};
            pg8::gemm_phase<EpiRes, pg8::StaticOrder, true, true>(F.lds, g, S, E, F.wave);
        }
        SEAM(pb + 4);
        if (IN(pb + 5) && EN(5)) for (int rep_ = 0; rep_ < (DUP(5) ? 2 : 1); ++rep_) { RELAUNDER(); if (rep_) __syncthreads();
            pg8::Gemm g{HB, wsp<bf16>(F, WS_WQ) + (size_t)l * 256 * 1024, NTOK, 256, D};
            pg8::StaticOrder S; S.init(NTOK, 256, F.G, (int)blockIdx.x);
            EpiXQ E{SSQ, wsp<bf16>(F, WS_XQ)};
            pg8::gemm_phase<EpiXQ, pg8::StaticOrder, true, true>(F.lds, g, S, E, F.wave);
        }
        SEAM(pb + 5);
        if (IN(pb + 6) && EN(6)) { RELAUNDER(); cross_phase(F, l); if (DUP(6)) { __syncthreads(); cross_phase(F, l); } }
        SEAM(pb + 6);
        if (IN(pb + 7) && EN(7)) { RELAUNDER();
            pg8::Gemm g{wsp<bf16>(F, WS_XO), wsp<bf16>(F, WS_WO) + (size_t)l * 1024 * 256, NTOK, D, 256};
            pg8::StaticOrder S; S.init(NTOK, D, F.G, (int)blockIdx.x);
            EpiRes E{(const float*)nullptr, HB, SSQ};
            pg8::gemm_phase<EpiRes, pg8::StaticOrder, true, true>(F.lds, g, S, E, F.wave);
        }
        SEAM(pb + 7);
        if (IN(pb + 8) && EN(8)) { RELAUNDER(); router_phase(F, l); if (DUP(8)) router_phase(F, l, 1); }
        SEAM(pb + 8);
        if (IN(pb + 9) && EN(9)) { RELAUNDER(); gather_phase(F, l); if (DUP(9)) { __syncthreads(); gather_phase(F, l); } }
        SEAM(pb + 9);
        if (IN(pb + 10) && EN(10)) for (int rep_ = 0; rep_ < (DUP(10) ? 2 : 1); ++rep_) { RELAUNDER(); if (rep_) __syncthreads();
            const int ns = moe_tables(F, l);
            pg8::Gemm g{wsp<bf16>(F, WS_XS), wsp<bf16>(F, WS_WGU) + (size_t)l * 32 * 1024 * 1024, ns, 32 * 1024, D};
            MoeOrder S{(ns >> 8) * 4, F.G, (int)blockIdx.x, (const LAS int*)(F.lds + TAB_OFF) + 40};
            EpiGU E{wsp<float>(F, WS_SRSTD), wsp<bf16>(F, WS_ACT)};
            STAGGER(STAG_MOE);
            pg8::gemm_phase<EpiGU, MoeOrder, true, true>(F.lds, g, S, E, F.wave);
        }
        SEAM(pb + 10);
        if (IN(pb + 11) && EN(11)) for (int rep_ = 0; rep_ < (DUP(11) ? 2 : 1); ++rep_) { RELAUNDER(); if (rep_) __syncthreads();
            const int ns = moe_tables(F, l);
            pg8::Gemm g{wsp<bf16>(F, WS_ACT), wsp<bf16>(F, WS_WDN) + (size_t)l * 32 * 1024 * 512, ns, 32 * 1024, 512};
            MoeOrder S{(ns >> 8) * 4, F.G, (int)blockIdx.x, (const LAS int*)(F.lds + TAB_OFF) + 40};
            EpiDN E{wsp<float>(F, WS_SGATE), wsp<bf16>(F, WS_YS)};
            STAGGER(STAG_MOE / 2);
            pg8::gemm_phase<EpiDN, MoeOrder, true, true>(F.lds, g, S, E, F.wave);
        }
        SEAM(pb + 11);
        if (IN(pb + 12) && EN(12)) { RELAUNDER(); combine_phase(F, l); if (DUP(12)) combine_phase(F, l, 1); }
        SEAM(pb + 12);
    }
#undef IN
#undef SEAM
}

extern "C" void kernel_launch(void* const* d_in, const int* in_sizes, int n_in, void* d_out, int out_size, void* d_ws, size_t ws_size, hipStream_t stream) {
    static int grid = 0;
    if (grid == 0) {
        if (n_in != 24 || in_sizes[0] != NTOK * D || out_size != NTOK * D || ws_size < WS_END) {
            fprintf(stderr, "kernel_launch: unexpected shapes: n_in %d in0 %d out %d ws %zu (need %zu)\n", n_in, n_in > 0 ? in_sizes[0] : -1, out_size, ws_size, (size_t)WS_END); grid = -1; return; }
        int dev = 0, cus = 0, per_cu = 0;
        if (hipGetDevice(&dev) != hipSuccess || hipDeviceGetAttribute(&cus, hipDeviceAttributeMultiprocessorCount, dev) != hipSuccess) { grid = -1; return; }
        if (hipFuncSetAttribute((const void*)hymba_fwd, hipFuncAttributeMaxDynamicSharedMemorySize, LDS_BYTES) != hipSuccess) { fprintf(stderr, "kernel_launch: hipFuncSetAttribute failed\n"); grid = -1; return; }
        if (hipOccupancyMaxActiveBlocksPerMultiprocessor(&per_cu, (const void*)hymba_fwd, NWAVES * 64, LDS_BYTES) != hipSuccess || per_cu < 1)
            fprintf(stderr, "kernel_launch: note: occupancy query reports %d blocks per CU\n", per_cu);
        (void)hipGetLastError();
        grid = cus;
    }
    if (grid < 0) return;
    if (hipMemsetAsync((char*)d_ws + WS_CTL, 0, CTL_ZERO_BYTES, stream) != hipSuccess) { fprintf(stderr, "kernel_launch: memset failed\n"); return; }
    Args a{};
    for (int i = 0; i < 24; ++i) a.in[i] = (const float*)d_in[i];
    a.out = (float*)d_out; a.ws = (unsigned char*)d_ws;
#if MK_ONE_LAUNCH
    a.ph_lo = 0; a.ph_hi = NPHASES;
    hipLaunchKernelGGL(hymba_fwd, dim3(grid), dim3(NWAVES * 64), LDS_BYTES, stream, a);
#else
    for (int p = 0; p < NPHASES; ++p) { a.ph_lo = p; a.ph_hi = p + 1; hipLaunchKernelGGL(hymba_fwd, dim3(grid), dim3(NWAVES * 64), LDS_BYTES, stream, a); }
#endif
    const hipError_t le = hipPeekAtLastError();
    if (le != hipSuccess) fprintf(stderr, "kernel_launch: launch failed: %s\n", hipGetErrorName(le));
}
```

```cpp
#define MK_ONE_LAUNCH 1
#include <hip/hip_runtime.h>
#include <cstdio>
#include <cstdint>
#include <cmath>
namespace pg8 {
#define PG8_LAS __attribute__((address_space(3)))
typedef unsigned short bf16_t;
typedef short bf16x8 __attribute__((ext_vector_type(8)));
typedef float f32x4 __attribute__((ext_vector_type(4)));
typedef unsigned u32x4 __attribute__((ext_vector_type(4)));
constexpr int BM = 256, BK = 64, HALF = 128, HTB = HALF * BK * 2  , STAGE_BYTES = 8 * HTB, NXCD = 8, WGM = 8;

__host__ __device__ __forceinline__ int lds_byte(int r, int c) { const int st = (r >> 4) * 2 + (c >> 5), rr = r & 15, cc = c & 31, ob = rr * 64 + cc * 2; return st * 1024 + (ob ^ (((ob >> 9) & 1) << 5)); }
__host__ __device__ __forceinline__ void stage_rc(int b, int& R, int& C) { const int st = b / 1024, sb = b % 1024, swz = sb ^ (((sb >> 9) & 1) << 5); R = (st >> 1) * 16 + swz / 64; C = (st & 1) * 32 + (swz % 64) / 2; }
__host__ __device__ __forceinline__ int perm32(int rho) { const int n = rho >> 4, i = rho & 15; return 8 * (i >> 2) + 4 * n + (i & 3); }

struct Unit { int pm, pn; };
struct Gemm { const bf16_t* A; const bf16_t* Bt; int M, N, K; };

struct StaticOrder {
    int nM, nN, nwg, G, c;
    __host__ __device__ void init(int M, int N, int G_, int c_) { nM = M / BM; nN = N / BM; nwg = nM * nN; G = G_; c = c_; }
    __host__ __device__ bool next(int i, Unit& u) const {
        const long L = (long)i * G + c; if (L >= nwg) return false;
        int wgid = (int)L; { const int q = nwg / NXCD, r = nwg % NXCD, xcd = wgid % NXCD, off = wgid / NXCD; wgid = (xcd < r ? xcd * (q + 1) : r * (q + 1) + (xcd - r) * q) + off; }
        const int nig = WGM * nN, gid = wgid / nig, fm = gid * WGM, gsz = (nM - fm) < WGM ? (nM - fm) : WGM;
        u.pm = fm + ((wgid % nig) % gsz); u.pn = (wgid % nig) / gsz; return true;
    }
    __device__ __forceinline__ void a_ready(const Unit&) const {}
    __device__ __forceinline__ void done(const Unit&) const {}
};

__device__ __forceinline__ unsigned cvt_pk_bf16(float lo, float hi) { unsigned r; asm volatile("v_cvt_pk_bf16_f32 %0, %1, %2" : "=v"(r) : "v"(lo), "v"(hi)); return r; }
typedef float f32x2 __attribute__((ext_vector_type(2)));
template <class Epi, class Sched, bool ALIGN_EPI = false, bool SP2 = false>
__device__ __forceinline__ void gemm_phase(PG8_LAS unsigned char* lds, const Gemm g, const Sched& S, const Epi& E, int wave_id) {
    unsigned z_ = 0u; asm volatile("" : "+v"(z_)); int tid_ = wave_id * 64 + (int)__builtin_amdgcn_mbcnt_hi(~0u, __builtin_amdgcn_mbcnt_lo(~0u, z_));
    const int tid = tid_, wid = __builtin_amdgcn_readfirstlane(tid >> 6), lane = tid & 63, wr = wid >> 2, wc = wid & 3, fr = lane & 15, fq = lane >> 4;
    const int K = g.K, nt = K / BK;
    unsigned voffA[2], voffB[2];
#pragma unroll
    for (int i = 0; i < 2; ++i) { int R, C; stage_rc(tid * 16 + i * 8192, R, C); const int Rb = Epi::PERM ? ((R & ~31) + perm32(R & 31)) : R;
        voffA[i] = (unsigned)(R * K + C) * 2u; voffB[i] = (unsigned)(Rb * K + C) * 2u; }
    const size_t kstep = (size_t)(BK * 2);
    const size_t hstep = (size_t)HALF * K * 2;
    const size_t tstep = 2 * hstep;
    const unsigned ldsw = (unsigned)wid * 1024u;
    const int aoff = lds_byte(wr * 64 + fr, fq * 8), boff = lds_byte(wc * 32 + fr, fq * 8);
#define PG8_SA(b, h) (((b) * 2 + (h)) * HTB)
#define PG8_SB(b, h) ((4 + (b) * 2 + (h)) * HTB)
#define PG8_STAGE(bufoff, gbase, voff) do { _Pragma("unroll") for (int _i = 0; _i < 2; ++_i) \
        __builtin_amdgcn_global_load_lds((const unsigned*)((const char*)(gbase) + (voff)[_i]), (PG8_LAS unsigned*)(lds + (bufoff) + ldsw + _i * 8192), 16, 0, 0); } while (0)
#define PG8_LDA(dst, b, h) do { _Pragma("unroll") for (int m = 0; m < 4; ++m) _Pragma("unroll") for (int k = 0; k < 2; ++k) dst[m][k] = *(const PG8_LAS bf16x8*)(lds + PG8_SA(b, h) + aoff + m * 2048 + k * 1024); } while (0)
#define PG8_LDB(dst, b, h) do { _Pragma("unroll") for (int n = 0; n < 2; ++n) _Pragma("unroll") for (int k = 0; k < 2; ++k) dst[n][k] = *(const PG8_LAS bf16x8*)(lds + PG8_SB(b, h) + boff + n * 2048 + k * 1024); } while (0)
#define PG8_MMA(ai, bj, At, Bt) do { __builtin_amdgcn_s_setprio(1); _Pragma("unroll") for (int m = 0; m < 4; ++m) _Pragma("unroll") for (int n = 0; n < 2; ++n) _Pragma("unroll") for (int k = 0; k < 2; ++k) \
        acc[ai][bj][m][n] = __builtin_amdgcn_mfma_f32_16x16x32_bf16(Bt[n][k], At[m][k], acc[ai][bj][m][n], 0, 0, 0); __builtin_amdgcn_s_setprio(0); } while (0)
#define PG8_WAIT_V(n) asm volatile("s_waitcnt vmcnt(" #n ")" ::: "memory")
#define PG8_WAIT_L(n) asm volatile("s_waitcnt lgkmcnt(" #n ")" ::: "memory")
#define PG8_BAR __builtin_amdgcn_s_barrier()
#define PG8_SCHED __builtin_amdgcn_sched_barrier(0)
    Unit cur, nxt; int ui = 0;
    if (!S.next(0, cur)) return;
    f32x4 acc[2][2][4][2];
#pragma unroll
    for (int a = 0; a < 2; ++a)
#pragma unroll
        for (int b = 0; b < 2; ++b)
#pragma unroll
            for (int m = 0; m < 4; ++m)
#pragma unroll
                for (int n = 0; n < 2; ++n) acc[a][b][m][n] = (f32x4){0.f, 0.f, 0.f, 0.f};
    bf16x8 At[4][2], B0[2][2], B1[2][2];
    const char* cA = (const char*)g.A + (size_t)cur.pm * tstep; const char* cB = (const char*)g.Bt + (size_t)cur.pn * tstep;
    S.a_ready(cur);
    if constexpr (SP2) {
        PG8_STAGE(PG8_SB(0, 0), cB, voffB); PG8_STAGE(PG8_SB(0, 1), cB + hstep, voffB); PG8_STAGE(PG8_SA(0, 0), cA, voffA); PG8_STAGE(PG8_SA(0, 1), cA + hstep, voffA);
        if (wr == 1) PG8_BAR;
        PG8_WAIT_V(2); PG8_BAR;
        PG8_STAGE(PG8_SB(1, 0), cB + kstep, voffB); PG8_STAGE(PG8_SA(1, 0), cA + kstep, voffA); PG8_STAGE(PG8_SB(1, 1), cB + hstep + kstep, voffB);
        PG8_WAIT_V(6); PG8_BAR;
    } else {
        PG8_STAGE(PG8_SB(0, 0), cB, voffB); PG8_STAGE(PG8_SA(0, 0), cA, voffA); PG8_STAGE(PG8_SB(0, 1), cB + hstep, voffB); PG8_STAGE(PG8_SA(0, 1), cA + hstep, voffA);
        if (wr == 1) PG8_BAR;
        PG8_WAIT_V(4); PG8_BAR;
        PG8_STAGE(PG8_SB(1, 0), cB + kstep, voffB); PG8_STAGE(PG8_SA(1, 0), cA + kstep, voffA); PG8_STAGE(PG8_SB(1, 1), cB + hstep + kstep, voffB);
        PG8_WAIT_V(6); PG8_BAR;
    }
    for (;;) {
        const bool has_next = S.next(ui + 1, nxt);
        const char* nA = has_next ? (const char*)g.A + (size_t)nxt.pm * tstep : cA; const char* nB = has_next ? (const char*)g.Bt + (size_t)nxt.pn * tstep : cB;
        for (int t = 0; t < nt; t += 2) {
            const bool last = (t == nt - 2);
            const char* a1 = cA + (size_t)(t + 1) * kstep;
            const char* a2 = last ? nA : cA + (size_t)(t + 2) * kstep; const char* b2 = last ? nB : cB + (size_t)(t + 2) * kstep;
            const char* a3 = a2 + kstep; const char* b3 = b2 + kstep;
            if (last && has_next) S.a_ready(nxt);
            if constexpr (SP2) {
            PG8_LDB(B0, 0, 0); PG8_LDB(B1, 0, 1); PG8_SCHED; PG8_LDA(At, 0, 0); PG8_STAGE(PG8_SA(1, 1), a1 + hstep, voffA);
            PG8_WAIT_V(8); PG8_WAIT_L(0); PG8_BAR; PG8_MMA(0, 0, At, B0); PG8_MMA(0, 1, At, B1); PG8_BAR; PG8_SCHED;
            PG8_LDA(At, 0, 1); PG8_STAGE(PG8_SB(0, 0), b2, voffB); PG8_STAGE(PG8_SB(0, 1), b2 + hstep, voffB); PG8_STAGE(PG8_SA(0, 0), a2, voffA);
            PG8_WAIT_V(8); PG8_WAIT_L(0); PG8_BAR; PG8_MMA(1, 0, At, B0); PG8_MMA(1, 1, At, B1); PG8_BAR; PG8_SCHED;
            PG8_LDB(B0, 1, 0); PG8_LDB(B1, 1, 1); PG8_SCHED; PG8_LDA(At, 1, 0); PG8_STAGE(PG8_SA(0, 1), a2 + hstep, voffA);
            PG8_WAIT_V(8); PG8_WAIT_L(0); PG8_BAR; PG8_MMA(0, 0, At, B0); PG8_MMA(0, 1, At, B1); PG8_BAR; PG8_SCHED;
            PG8_LDA(At, 1, 1); PG8_STAGE(PG8_SB(1, 0), b3, voffB); PG8_STAGE(PG8_SB(1, 1), b3 + hstep, voffB); PG8_STAGE(PG8_SA(1, 0), a3, voffA);
            PG8_WAIT_V(8); PG8_WAIT_L(0); PG8_BAR; PG8_MMA(1, 0, At, B0); PG8_MMA(1, 1, At, B1); PG8_BAR; PG8_SCHED;
            } else {
            PG8_LDB(B0, 0, 0); PG8_SCHED; PG8_LDA(At, 0, 0); PG8_STAGE(PG8_SA(1, 1), a1 + hstep, voffA);
            PG8_WAIT_L(8); PG8_BAR; PG8_WAIT_L(0); PG8_MMA(0, 0, At, B0); PG8_BAR; PG8_SCHED;
            PG8_LDB(B1, 0, 1); PG8_STAGE(PG8_SB(0, 0), b2, voffB);
            PG8_BAR; PG8_WAIT_L(0); PG8_MMA(0, 1, At, B1); PG8_BAR;
            PG8_LDA(At, 0, 1); PG8_STAGE(PG8_SA(0, 0), a2, voffA);
            PG8_BAR; PG8_WAIT_L(0); PG8_MMA(1, 0, At, B0); PG8_BAR; PG8_SCHED;
            PG8_STAGE(PG8_SB(0, 1), b2 + hstep, voffB);
            PG8_WAIT_V(6); PG8_BAR; PG8_MMA(1, 1, At, B1); PG8_BAR;
            PG8_LDB(B0, 1, 0); PG8_SCHED; PG8_LDA(At, 1, 0); PG8_STAGE(PG8_SA(0, 1), a2 + hstep, voffA);
            PG8_WAIT_L(8); PG8_BAR; PG8_WAIT_L(0); PG8_MMA(0, 0, At, B0); PG8_BAR; PG8_SCHED;
            PG8_LDB(B1, 1, 1); PG8_STAGE(PG8_SB(1, 0), b3, voffB);
            PG8_BAR; PG8_WAIT_L(0); PG8_MMA(0, 1, At, B1); PG8_BAR;
            PG8_LDA(At, 1, 1); PG8_STAGE(PG8_SA(1, 0), a3, voffA);
            PG8_BAR; PG8_WAIT_L(0); PG8_MMA(1, 0, At, B0); PG8_BAR; PG8_SCHED;
            PG8_STAGE(PG8_SB(1, 1), b3 + hstep, voffB);
            PG8_WAIT_V(6); PG8_BAR; PG8_MMA(1, 1, At, B1); PG8_BAR;
            }
        }
        if constexpr (ALIGN_EPI) { if (wr == 0) PG8_BAR; }
        if constexpr (!Epi::AFTER_DRAIN) { E(acc, cur, wr, wc, fr, fq); S.done(cur); }
        if (!has_next) break;
#pragma unroll
        for (int a = 0; a < 2; ++a)
#pragma unroll
            for (int b = 0; b < 2; ++b)
#pragma unroll
                for (int m = 0; m < 4; ++m)
#pragma unroll
                    for (int n = 0; n < 2; ++n) acc[a][b][m][n] = (f32x4){0.f, 0.f, 0.f, 0.f};
        cur = nxt; cA = nA; cB = nB; ++ui;
        if constexpr (ALIGN_EPI) { if (wr == 1) PG8_BAR; }
    }
    PG8_WAIT_V(0);
    if constexpr (!ALIGN_EPI) { if (wr == 0) PG8_BAR; }
    PG8_BAR;
    if constexpr (Epi::AFTER_DRAIN) { E.fused(acc, cur, wr, wc, fr, fq, lds, wid, lane); S.done(cur); }
#undef PG8_SA
#undef PG8_SB
#undef PG8_STAGE
#undef PG8_LDA
#undef PG8_LDB
#undef PG8_MMA
#undef PG8_WAIT_V
#undef PG8_WAIT_L
#undef PG8_BAR
#undef PG8_SCHED
}
}
constexpr int NB = 4, T = 8192, D = 1024, NTOK = NB * T, DEPTH = 2;
constexpr int NIN = 3328;
constexpr int IN_W = 3096;
constexpr int NSLOT_MAX = 65536 + 32 * 256;
constexpr float RMS_EPS = 1e-6f;
constexpr float QSCALE = 0.125f * 1.44269504088896f;
constexpr int NWAVES = 8;

constexpr size_t MiB = 1u << 20;
constexpr size_t WS_CTL = 0, CTL_ZERO_BYTES = 1 * MiB;
constexpr size_t WS_ROPE = 1 * MiB;
constexpr size_t WS_SMALL = 3 * MiB;
constexpr size_t WS_WG = 3 * MiB + 65536;
constexpr size_t WS_SSQ = 4 * MiB;
constexpr size_t WS_WIN = 8 * MiB;
constexpr size_t WS_WOUT = 22 * MiB;
constexpr size_t WS_WQ = 26 * MiB;
constexpr size_t WS_WKV = 27 * MiB;
constexpr size_t WS_WO = 29 * MiB;
constexpr size_t WS_WR = 30 * MiB;
constexpr size_t WS_W1C = 31 * MiB;
constexpr size_t WS_W2C = 33 * MiB;
constexpr size_t WS_MEMB = 34 * MiB;
constexpr size_t WS_MK = 36 * MiB;
constexpr size_t WS_MVT = 37 * MiB;
constexpr size_t WS_WGU = 40 * MiB;
constexpr size_t WS_WDN = 168 * MiB;
constexpr size_t WS_HB = 232 * MiB;
constexpr size_t WS_Q = 296 * MiB, WS_QR = 328 * MiB, WS_KCR = 360 * MiB, WS_VCR = 368 * MiB, WS_KS = 376 * MiB, WS_KW = 384 * MiB;
constexpr size_t WS_VST = 392 * MiB, WS_VWT = 400 * MiB, WS_KCC = 408 * MiB, WS_VCT = 409 * MiB, WS_GATE = 410 * MiB;
constexpr size_t WS_CB = 414 * MiB, WS_CC = 430 * MiB, WS_CH = 446 * MiB;
constexpr size_t WS_HQ = 462 * MiB, WS_HF = 494 * MiB, WS_HI = 526 * MiB, WS_HG = 558 * MiB;
constexpr size_t WS_CAT = 590 * MiB, WS_U = 654 * MiB, WS_DEC = 686 * MiB;
constexpr size_t WS_XQ = 688 * MiB, WS_XO = 704 * MiB;
constexpr size_t WS_XS = 296 * MiB, WS_ACT = 440 * MiB, WS_YS = 512 * MiB;
constexpr size_t WS_TOKE = 720 * MiB, WS_TOKG = 721 * MiB, WS_TOKP = 722 * MiB, WS_TOKS = 723 * MiB, WS_SRSTD = 724 * MiB, WS_SGATE = 725 * MiB;
constexpr size_t WS_U2 = 728 * MiB;
constexpr size_t WS_PROBE = 760 * MiB;
constexpr size_t WS_END = 760 * MiB;
static_assert(WS_XS + (size_t)NSLOT_MAX * 1024 * 2 <= WS_ACT && WS_ACT + (size_t)NSLOT_MAX * 512 * 2 <= WS_YS && WS_YS + (size_t)NSLOT_MAX * 1024 * 2 <= WS_XQ, "moe map");
constexpr int CW_CNT = 64;
constexpr int CW_KMAX = 256;
constexpr int CW_NSAQ = 512;
constexpr int CW_BAR = 4096;

constexpr int RING_BYTES = 131072;
constexpr int NSA_LDS_WAVE = 10752;
constexpr int MISC_OFF = RING_BYTES;
constexpr int TAB_OFF = RING_BYTES + 512;
constexpr int LDS_BYTES = 147456;
static_assert(8 * NSA_LDS_WAVE <= RING_BYTES && TAB_OFF + 4 * (40 + 320) <= LDS_BYTES, "LDS map");

#define GAS __attribute__((address_space(1)))
#define LAS __attribute__((address_space(3)))
#define DEV __device__ __forceinline__
typedef unsigned short bf16;
typedef unsigned v4u __attribute__((ext_vector_type(4)));
typedef unsigned v2u __attribute__((ext_vector_type(2)));
typedef float f32x4 __attribute__((ext_vector_type(4)));
typedef short bf16x8 __attribute__((ext_vector_type(8)));
typedef GAS unsigned gu32;
#define RLX_AGENT __ATOMIC_RELAXED, __HIP_MEMORY_SCOPE_AGENT
#define LDS_WAIT() asm volatile("s_waitcnt lgkmcnt(0)" ::: "memory")
#define VM_WAIT() asm volatile("s_waitcnt vmcnt(0)" ::: "memory")
typedef __bf16 bf16x2_t __attribute__((ext_vector_type(2)));
typedef float f32x2_t __attribute__((ext_vector_type(2)));
DEV unsigned pk2(float lo, float hi) { const f32x2_t v = {lo, hi}; return __builtin_bit_cast(unsigned, __builtin_convertvector(v, bf16x2_t)); }
DEV unsigned f2bf(float f) { return pk2(f, 0.f) & 0xffffu; }
DEV float bf2f(unsigned short b) { return __builtin_bit_cast(float, (unsigned)b << 16); }
DEV float bflo(unsigned w) { return __builtin_bit_cast(float, w << 16); }
DEV float bfhi(unsigned w) { return __builtin_bit_cast(float, w & 0xffff0000u); }
DEV float ex2(float x) { return __builtin_amdgcn_exp2f(x); }
DEV float wave_sum(float v) {
#pragma unroll
    for (int o = 1; o < 64; o <<= 1) v += __shfl_xor(v, o);
    return v;
}
DEV f32x4 mfma16(bf16x8 a, bf16x8 b, f32x4 c) { return __builtin_amdgcn_mfma_f32_16x16x32_bf16(a, b, c, 0, 0, 0); }
DEV int slot32(int k) { return ((k >> 2) & 3) * 8 + (k >> 4) * 4 + (k & 3); }
DEV int kfrag_off(int key, int d) { return (key >> 5) * 2048 + ((((key >> 4) & 1) * 2 + (d >> 5)) * 64 + ((d >> 3) & 3) * 16 + (key & 15)) * 8 + (d & 7); }
DEV float sigmoidf_(float x) { return 1.0f / (1.0f + __expf(-x)); }
DEV float siluf_(float x) { return x / (1.0f + __expf(-x)); }
#define XB_TMO      128
#define XB_XCNT(j)  (256  + 64 * (j))
#define XB_XSUB(j)  (1280 + 64 * (j))
#define XB_XGEN(j)  (2304 + 64 * (j))
#define XB_TOP      3328
#define XB_TOPGEN   3392
#define XCD_BAR_WORDS 3456
#define XB_SPIN_CAP (1u << 18)

__device__ __forceinline__ unsigned xb_ld(unsigned* p)              { return __hip_atomic_load(p, __ATOMIC_RELAXED, __HIP_MEMORY_SCOPE_AGENT); }
__device__ __forceinline__ unsigned xb_add(unsigned* p, unsigned v) { return __hip_atomic_fetch_add(p, v, __ATOMIC_RELAXED, __HIP_MEMORY_SCOPE_AGENT); }
__device__ __forceinline__ unsigned xb_xcc_id() { return (unsigned)__builtin_amdgcn_s_getreg((3 << 11) | 20) & 0xFu; }
#define XB_SPIN(cond, bar) do { unsigned _sp = 0; while (cond) { __builtin_amdgcn_s_sleep(1); \
    if ((++_sp & 255u) == 0u) { if (xb_ld(&(bar)[XB_TMO])) break; if (_sp > XB_SPIN_CAP) { atomicAdd(&(bar)[XB_TMO], 1u); break; } } } } while (0)

struct XcdBarrier {
    unsigned* bar; unsigned x;
    volatile LAS unsigned* st;
};

__device__ __forceinline__ XcdBarrier xcd_barrier_post(unsigned* bar, volatile LAS unsigned* st) {
    XcdBarrier b; b.bar = bar; b.x = xb_xcc_id(); b.st = st;
    if (threadIdx.x == 0) (void)xb_add(&bar[XB_XCNT(b.x)], 1u);
    return b;
}
__device__ __forceinline__ void xcd_barrier_complete(unsigned* bar, unsigned x, unsigned& nloc, unsigned& nx) {
    const unsigned G = gridDim.x * gridDim.y * gridDim.z;
    unsigned sum, cnt, mine, sp = 0u;
    for (;;) {
        sum = 0u; cnt = 0u; mine = 0u;
#pragma unroll
        for (unsigned j = 0; j < 16; ++j) { const unsigned c = xb_ld(&bar[XB_XCNT(j)]); sum += c; cnt += (c > 0u) ? 1u : 0u; mine = (j == x) ? c : mine; }
        if (sum == G) break;
        __builtin_amdgcn_s_sleep(1);
        if ((++sp & 255u) == 0u) { if (xb_ld(&bar[XB_TMO])) break; if (sp > XB_SPIN_CAP) { atomicAdd(&bar[XB_TMO], 1u); break; } }
    }
    nloc = mine > 0u ? mine : 1u; nx = cnt > 0u ? cnt : 1u;
}

__device__ __forceinline__ void xcd_barrier(const XcdBarrier& b) {
    asm volatile("s_waitcnt vmcnt(0)" ::: "memory");
    __syncthreads();
    if (threadIdx.x == 0) {
        unsigned* bar = b.bar;
        __builtin_amdgcn_s_waitcnt(0);
        unsigned nloc = b.st[0], nx = b.st[1];
        if (nloc == 0u) { xcd_barrier_complete(bar, b.x, nloc, nx); b.st[0] = nloc; b.st[1] = nx; }
        const unsigned old = xb_add(&bar[XB_XSUB(b.x)], 1u);
        const unsigned gen = old / nloc;
        if (old + 1u == (gen + 1u) * nloc) {
            __builtin_amdgcn_fence(__ATOMIC_RELEASE, "agent");
            asm volatile("s_waitcnt vmcnt(0)" ::: "memory");
            const unsigned og = xb_add(&bar[XB_TOP], 1u);
            const unsigned tg = og / nx;
            if (og + 1u == (tg + 1u) * nx) xb_add(&bar[XB_TOPGEN], 1u);
            else XB_SPIN(xb_ld(&bar[XB_TOPGEN]) == tg, bar);
            __builtin_amdgcn_fence(__ATOMIC_ACQUIRE, "agent");
            xb_add(&bar[XB_XGEN(b.x)], 1u);
            asm volatile("s_waitcnt vmcnt(0)" ::: "memory");
        } else {
            XB_SPIN(xb_ld(&bar[XB_XGEN(b.x)]) == gen, bar);
            __builtin_amdgcn_fence(__ATOMIC_ACQUIRE, "agent");
            asm volatile("s_waitcnt vmcnt(0)" ::: "memory");
        }
    }
    __syncthreads();
}
DEV float row_rstd(const float* ssq, int row, int fq) {
    const f32x4 p = *(const f32x4*)(ssq + (size_t)row * 16 + fq * 4);
    float s = (p.x + p.y) + (p.z + p.w);
    s += __shfl_xor(s, 16); s += __shfl_xor(s, 32);
    return 1.0f / sqrtf(s * (1.0f / 1024.0f) + RMS_EPS);
}
DEV float row_rstd_full(const float* ssq, int row) {
    const f32x4* p = (const f32x4*)(ssq + (size_t)row * 16);
    const f32x4 a = p[0], b = p[1], c = p[2], d = p[3];
    const float s = ((a.x + a.y) + (a.z + a.w)) + ((b.x + b.y) + (b.z + b.w)) + ((c.x + c.y) + (c.z + c.w)) + ((d.x + d.y) + (d.z + d.w));
    return 1.0f / sqrtf(s * (1.0f / 1024.0f) + RMS_EPS);
}

DEV void rope4(const float* rope, int t, int i, const f32x4& v0, const f32x4& v1, float (&lo)[4], float (&hi)[4]) {
    const f32x4 c0 = *(const f32x4*)(rope + ((size_t)t * 32 + i) * 2), c1 = *(const f32x4*)(rope + ((size_t)t * 32 + i + 2) * 2);
    lo[0] = v0[0] * c0[0] - v0[1] * c0[1]; hi[0] = v0[1] * c0[0] + v0[0] * c0[1];
    lo[1] = v0[2] * c0[2] - v0[3] * c0[3]; hi[1] = v0[3] * c0[2] + v0[2] * c0[3];
    lo[2] = v1[0] * c1[0] - v1[1] * c1[1]; hi[2] = v1[1] * c1[0] + v1[0] * c1[1];
    lo[3] = v1[2] * c1[2] - v1[3] * c1[3]; hi[3] = v1[3] * c1[2] + v1[2] * c1[3];
}
struct EpiIn {
    static constexpr bool PERM = true, AFTER_DRAIN = false;
    unsigned char* ws;
    template <class Tp> DEV Tp* P(size_t off) const { return (Tp*)(GAS Tp*)(ws + off); }
    DEV void operator()(const f32x4 (&acc)[2][2][4][2], const pg8::Unit& u, int wr, int wc, int fr, int fq) const {
        asm volatile("" : "+v"(fr), "+v"(fq), "+s"(wr), "+s"(wc));
        const int pn = u.pn;
        const float* ssq = P<float>(WS_SSQ); const float* rope = P<float>(WS_ROPE);
#pragma unroll
        for (int ai = 0; ai < 2; ++ai)
#pragma unroll
            for (int m = 0; m < 4; ++m) {
                const int row = u.pm * 256 + ai * 128 + wr * 64 + m * 16 + fr;
                const float rstd = row_rstd(ssq, row, fq);
                const int t = row & (T - 1), b = row >> 13;
#pragma unroll
                for (int bj = 0; bj < 2; ++bj) {
                    const int col = bj * 128 + wc * 32 + fq * 8;
                    const f32x4 v0 = acc[ai][bj][m][0] * rstd, v1 = acc[ai][bj][m][1] * rstd;
                    if (pn < 2) {
                        const int g = pn * 256 + col, head = g >> 6, i = (g & 63) >> 1;
                        const size_t o = (size_t)row * 512 + head * 64 + i;
                        bf16* Q = P<bf16>(WS_Q);
                        v2u w;
                        w.x = pk2(v0[0] * QSCALE, v0[2] * QSCALE); w.y = pk2(v1[0] * QSCALE, v1[2] * QSCALE); *(v2u*)(Q + o) = w;
                        w.x = pk2(v0[1] * QSCALE, v0[3] * QSCALE); w.y = pk2(v1[1] * QSCALE, v1[3] * QSCALE); *(v2u*)(Q + o + 32) = w;
                    } else if (pn == 2) {
                        bf16* dst = P<bf16>((col < 128) ? WS_KCR : WS_VCR);
                        v4u w; w.x = pk2(v0[0], v0[1]); w.y = pk2(v0[2], v0[3]); w.z = pk2(v1[0], v1[1]); w.w = pk2(v1[2], v1[3]);
                        *(v4u*)(dst + (size_t)row * 128 + (col & 127)) = w;
                    } else if (pn == 3 || pn == 4) {
                        if (col < 128) {
                            bf16* dst = P<bf16>((pn == 3) ? WS_KS : WS_KW);
                            const int hkv = col >> 6, i = (col & 63) >> 1;
                            float lo[4], hi[4]; rope4(rope, t, i, v0, v1, lo, hi);
                            const size_t o = (size_t)(b * 2 + hkv) * T * 64 + kfrag_off(t, i);
                            v2u w;
                            w.x = pk2(lo[0], lo[1]); w.y = pk2(lo[2], lo[3]); *(v2u*)(dst + o) = w;
                            w.x = pk2(hi[0], hi[1]); w.y = pk2(hi[2], hi[3]); *(v2u*)(dst + o + 512) = w;
                        } else {
                            bf16* dst = P<bf16>((pn == 3) ? WS_VST : WS_VWT);
                            const int c2 = col - 128, hkv = c2 >> 6, d = c2 & 63;
                            const size_t o = (((size_t)(b * 2 + hkv) * 256 + (t >> 5)) * 64 + d) * 32 + slot32(t & 31);
#pragma unroll
                            for (int j = 0; j < 4; ++j) { dst[o + j * 32] = (bf16)f2bf(v0[j]); dst[o + (j + 4) * 32] = (bf16)f2bf(v1[j]); }
#if defined(DUPMASK) && ((DUPMASK >> 20) & 1)
                            { bf16* dst2 = P<bf16>(WS_U2) + (pn - 3) * (4u << 20);
#pragma unroll
                            for (int j = 0; j < 4; ++j) { dst2[o + j * 32] = (bf16)f2bf(v0[j]); dst2[o + (j + 4) * 32] = (bf16)f2bf(v1[j]); } }
#endif
                        }
                    } else if (pn == 9) {
                        float* dst = P<float>(WS_HF) + (size_t)row * 256 + col;
                        *(f32x4*)dst = v0; *(f32x4*)(dst + 4) = v1;
                    } else {
                        bf16* dst = (pn < 8) ? P<bf16>(WS_CB + (size_t)(pn - 5) * (WS_CC - WS_CB)) : P<bf16>(WS_HQ + (size_t)(pn - 8) * (WS_HF - WS_HQ));
                        v4u w; w.x = pk2(v0[0], v0[1]); w.y = pk2(v0[2], v0[3]); w.z = pk2(v1[0], v1[1]); w.w = pk2(v1[2], v1[3]);
                        *(v4u*)(dst + (size_t)row * 256 + col) = w;
                    }
                }
            }
    }
};

struct EpiRes {
    static constexpr bool PERM = true, AFTER_DRAIN = false;
    const float* base32; bf16* hb; float* ssq;
    DEV void operator()(const f32x4 (&acc)[2][2][4][2], const pg8::Unit& u, int wr, int wc, int fr, int fq) const {
        asm volatile("" : "+v"(fr), "+v"(fq), "+s"(wr), "+s"(wc));
#pragma unroll
        for (int ai = 0; ai < 2; ++ai)
#pragma unroll
            for (int m = 0; m < 4; ++m) {
                const int row = u.pm * 256 + ai * 128 + wr * 64 + m * 16 + fr;
                float ss = 0.f;
#pragma unroll
                for (int bj = 0; bj < 2; ++bj) {
                    const size_t o = (size_t)row * 1024 + u.pn * 256 + bj * 128 + wc * 32 + fq * 8;
                    f32x4 v0, v1;
                    if (base32) { v0 = *(const f32x4*)(base32 + o); v1 = *(const f32x4*)(base32 + o + 4); }
                    else { const v4u hw = *(const v4u*)(hb + o); v0 = (f32x4){bflo(hw.x), bfhi(hw.x), bflo(hw.y), bfhi(hw.y)}; v1 = (f32x4){bflo(hw.z), bfhi(hw.z), bflo(hw.w), bfhi(hw.w)}; }
                    v0 = v0 + acc[ai][bj][m][0]; v1 = v1 + acc[ai][bj][m][1];
                    v4u w; w.x = pk2(v0[0], v0[1]); w.y = pk2(v0[2], v0[3]); w.z = pk2(v1[0], v1[1]); w.w = pk2(v1[2], v1[3]);
                    *(v4u*)(hb + o) = w;
                    ss += ((v0[0] * v0[0] + v0[1] * v0[1]) + (v0[2] * v0[2] + v0[3] * v0[3])) + ((v1[0] * v1[0] + v1[1] * v1[1]) + (v1[2] * v1[2] + v1[3] * v1[3]));
                }
                ss += __shfl_xor(ss, 16); ss += __shfl_xor(ss, 32);
                if (fq == 0) ssq[(size_t)row * 16 + u.pn * 4 + wc] = ss;
            }
    }
};

struct EpiXQ {
    static constexpr bool PERM = true, AFTER_DRAIN = false;
    const float* ssq; bf16* XQ;
    DEV void operator()(const f32x4 (&acc)[2][2][4][2], const pg8::Unit& u, int wr, int wc, int fr, int fq) const {
        asm volatile("" : "+v"(fr), "+v"(fq), "+s"(wr), "+s"(wc));
#pragma unroll
        for (int ai = 0; ai < 2; ++ai)
#pragma unroll
            for (int m = 0; m < 4; ++m) {
                const int row = u.pm * 256 + ai * 128 + wr * 64 + m * 16 + fr;
                const float sc = row_rstd(ssq, row, fq) * QSCALE;
#pragma unroll
                for (int bj = 0; bj < 2; ++bj) {
                    const f32x4 v0 = acc[ai][bj][m][0] * sc, v1 = acc[ai][bj][m][1] * sc;
                    v4u w; w.x = pk2(v0[0], v0[1]); w.y = pk2(v0[2], v0[3]); w.z = pk2(v1[0], v1[1]); w.w = pk2(v1[2], v1[3]);
                    *(v4u*)(XQ + (size_t)row * 256 + bj * 128 + wc * 32 + fq * 8) = w;
                }
            }
    }
};

struct EpiGU {
    static constexpr bool PERM = true, AFTER_DRAIN = false;
    const float* srstd; bf16* ACT;
    DEV void operator()(const f32x4 (&acc)[2][2][4][2], const pg8::Unit& u, int wr, int wc, int fr, int fq) const {
        asm volatile("" : "+v"(fr), "+v"(fq), "+s"(wr), "+s"(wc));
        const int nt = u.pn & 3;
#pragma unroll
        for (int ai = 0; ai < 2; ++ai)
#pragma unroll
            for (int m = 0; m < 4; ++m) {
                const int row = u.pm * 256 + ai * 128 + wr * 64 + m * 16 + fr;
                const float rs = srstd[row];
#pragma unroll
                for (int bj = 0; bj < 2; ++bj) {
                    const f32x4 v0 = acc[ai][bj][m][0] * rs, v1 = acc[ai][bj][m][1] * rs;
                    const int j = (nt * 256 + bj * 128 + wc * 32 + fq * 8) >> 1;
                    v2u w; w.x = pk2(siluf_(v0[0]) * v0[1], siluf_(v0[2]) * v0[3]); w.y = pk2(siluf_(v1[0]) * v1[1], siluf_(v1[2]) * v1[3]);
                    *(v2u*)(ACT + (size_t)row * 512 + j) = w;
                }
            }
    }
};

struct EpiDN {
    static constexpr bool PERM = true, AFTER_DRAIN = false;
    const float* sgate; bf16* YS;
    DEV void operator()(const f32x4 (&acc)[2][2][4][2], const pg8::Unit& u, int wr, int wc, int fr, int fq) const {
        asm volatile("" : "+v"(fr), "+v"(fq), "+s"(wr), "+s"(wc));
        const int nt = u.pn & 3;
#pragma unroll
        for (int ai = 0; ai < 2; ++ai)
#pragma unroll
            for (int m = 0; m < 4; ++m) {
                const int row = u.pm * 256 + ai * 128 + wr * 64 + m * 16 + fr;
                const float gt = sgate[row];
#pragma unroll
                for (int bj = 0; bj < 2; ++bj) {
                    const f32x4 v0 = acc[ai][bj][m][0] * gt, v1 = acc[ai][bj][m][1] * gt;
                    v4u w; w.x = pk2(v0[0], v0[1]); w.y = pk2(v0[2], v0[3]); w.z = pk2(v1[0], v1[1]); w.w = pk2(v1[2], v1[3]);
                    *(v4u*)(YS + (size_t)row * 1024 + nt * 256 + bj * 128 + wc * 32 + fq * 8) = w;
                }
            }
    }
};

struct MoeOrder {
    int nunits, G, c; const LAS int* tileE;
    DEV bool next(int i, pg8::Unit& u) const {
        const int L = i * G + c; if (L >= nunits) return false;
        const int rt = L >> 2; u.pm = rt; u.pn = tileE[rt] * 4 + (L & 3); return true;
    }
    DEV void a_ready(const pg8::Unit&) const {}
    DEV void done(const pg8::Unit&) const {}
};
struct Frame {
    LAS unsigned char* lds;
    unsigned char* ldsg;
    volatile LAS unsigned* MISC;
    gu32* ctl;
    unsigned char* ws;
    int tid, lane, wave, vcu, G;
    float* out;
};
template <class Tp> DEV Tp* wsp(const Frame& F, size_t off) { return (Tp*)(F.ws + off); }
DEV const float* inp(int i) { const float* const* ka = (const float* const*)__builtin_amdgcn_kernarg_segment_ptr(); asm volatile("" : "+s"(i)); return (const float*)(const GAS float*)ka[i]; }

template <class Map>
DEV void tr_item(const float* W, int K, int Nsrc, const float* gain, bf16* WT, float* scr, int item, int lane, Map map) {
    const int nblk = (Nsrc + 31) >> 5, kb = item / nblk, nb = item - kb * nblk, k0 = 64 * kb, n0 = 32 * nb;
    {
        const int nq = (lane & 7) * 4; f32x4 v[8];
#pragma unroll
        for (int i = 0; i < 8; ++i) { const int kk = 8 * i + (lane >> 3);
            v[i] = (n0 + nq < Nsrc) ? *(const f32x4*)(W + (size_t)(k0 + kk) * Nsrc + n0 + nq) : (f32x4){0.f, 0.f, 0.f, 0.f}; }
#pragma unroll
        for (int i = 0; i < 8; ++i) { const int kk = 8 * i + (lane >> 3); const float g = gain ? gain[k0 + kk] : 1.0f; float* s = scr + kk * 33 + nq;
            s[0] = v[i][0] * g; s[1] = v[i][1] * g; s[2] = v[i][2] * g; s[3] = v[i][3] * g; }
    }
    LDS_WAIT();
    const int c = lane & 7;
#pragma unroll
    for (int j = 0; j < 4; ++j) {
        const int n = (lane >> 3) + 8 * j; const float* s = scr + (8 * c) * 33 + n;
        if (n0 + n < Nsrc) {
            v4u o; o.x = pk2(s[0 * 33], s[1 * 33]); o.y = pk2(s[2 * 33], s[3 * 33]); o.z = pk2(s[4 * 33], s[5 * 33]); o.w = pk2(s[6 * 33], s[7 * 33]);
            *(v4u*)(WT + (size_t)map(n0 + n) * K + k0 + 8 * c) = o;
        }
    }
    LDS_WAIT();
}
template <class Map>
DEV void tr_experts(const float* W, int K, int Nsrc, const float* gain, bf16* WT, bf16* scr, int gw, int NGW, int lane, Map map) {
    const int nblk = Nsrc >> 6, per_e = (K >> 6) * nblk, NIT = 32 * per_e; const size_t esz = (size_t)K * Nsrc;
#pragma unroll 1
    for (int it = gw; it < NIT; it += NGW) {
        const int e = it / per_e, sub = it - e * per_e, kb = sub / nblk, nb = sub - kb * nblk, k0 = 64 * kb, n0 = 64 * nb, nq = (lane & 15) * 4;
        const float* Wp = W + (size_t)e * esz; bf16* Wo = WT + (size_t)e * esz;
        f32x4 v[16];
#pragma unroll
        for (int i = 0; i < 16; ++i) v[i] = *(const f32x4*)(Wp + (size_t)(k0 + 4 * i + (lane >> 4)) * Nsrc + n0 + nq);
#pragma unroll
        for (int i = 0; i < 16; ++i) { const int kk = 4 * i + (lane >> 4); const float g = gain ? gain[k0 + kk] : 1.0f;
            v2u w; w.x = pk2(v[i][0] * g, v[i][1] * g); w.y = pk2(v[i][2] * g, v[i][3] * g);
            *(v2u*)(scr + kk * 68 + nq) = w; }
        LDS_WAIT();
        const int cc = lane & 7;
#pragma unroll
        for (int j = 0; j < 8; ++j) { const int n = (lane >> 3) + 8 * j; const bf16* s = scr + (8 * cc) * 68 + n;
            v4u o; o.x = (unsigned)s[0] | ((unsigned)s[68] << 16); o.y = (unsigned)s[2 * 68] | ((unsigned)s[3 * 68] << 16);
            o.z = (unsigned)s[4 * 68] | ((unsigned)s[5 * 68] << 16); o.w = (unsigned)s[6 * 68] | ((unsigned)s[7 * 68] << 16);
            *(v4u*)(Wo + (size_t)map(n0 + n) * K + k0 + 8 * cc) = o; }
        LDS_WAIT();
    }
}
struct MapId { DEV int operator()(int n) const { return n; } };
struct MapIn {
    DEV int operator()(int n) const {
        if (n < 512) { const int d = n & 63; return (n & ~63) + 2 * (d & 31) + (d >> 5); }
        if (n < 768) return n;
        if (n < 1280) { const int r = n - 768; if ((r & 255) < 128) { const int d = r & 63; return 768 + (r & ~63) + 2 * (d & 31) + (d >> 5); } return n; }
        if (n < 1304) return 3072 + (n - 1280);
        return n - 24;
    }
};
struct MapGU { DEV int operator()(int n) const { return n < 512 ? 2 * n : 2 * (n - 512) + 1; } };

DEV void convert_experts(Frame& F, int l, bf16* scr, int part, int gw_ = -1, int ngw_ = 0) {
    unsigned zl_ = 0u; asm volatile("" : "+v"(zl_)); const int lane = (int)__builtin_amdgcn_mbcnt_hi(~0u, __builtin_amdgcn_mbcnt_lo(~0u, zl_));
    const int gw = gw_ >= 0 ? gw_ : F.vcu * NWAVES + F.wave, NGW = gw_ >= 0 ? ngw_ : F.G * NWAVES;
    if (part == 0) tr_experts(inp(17) + (size_t)l * 32 * 1024 * 1024, 1024, 1024, inp(22) + l * 1024, wsp<bf16>(F, WS_WGU) + (size_t)l * 32 * 1024 * 1024, scr, gw, NGW, lane, MapGU());
    else tr_experts(inp(18) + (size_t)l * 32 * 512 * 1024, 512, 1024, nullptr, wsp<bf16>(F, WS_WDN) + (size_t)l * 32 * 1024 * 512, scr, gw, NGW, lane, MapId());
}
DEV void p0_prologue(Frame& F) {
    float* scr = (float*)(F.ldsg + F.wave * 16384);
    const int gw = F.vcu * NWAVES + F.wave, NGW = F.G * NWAVES, lane = F.lane;
    for (int l = 0; l < DEPTH; ++l) {
        { const int NIT = 16 * 97; bf16* dst = wsp<bf16>(F, WS_WIN) + (size_t)l * NIN * 1024;
          for (int it = gw; it < NIT; it += NGW) tr_item(inp(2) + (size_t)l * 1024 * IN_W, 1024, IN_W, inp(19) + l * 1024, dst, scr, it, lane, MapIn());
          for (int i = gw * 64 + lane; i < (NIN - 3096) * 1024 / 8; i += NGW * 64) ((v4u*)(dst + (size_t)3096 * 1024))[i] = (v4u){0u, 0u, 0u, 0u}; }
        { const int NIT = 16 * 32; for (int it = gw; it < NIT; it += NGW) tr_item(inp(9) + (size_t)l * 1024 * 1024, 1024, 1024, nullptr, wsp<bf16>(F, WS_WOUT) + (size_t)l * 1024 * 1024, scr, it, lane, MapId()); }
        { const int NIT = 16 * 8; for (int it = gw; it < NIT; it += NGW) tr_item(inp(10) + (size_t)l * 1024 * 256, 1024, 256, inp(20) + l * 1024, wsp<bf16>(F, WS_WQ) + (size_t)l * 256 * 1024, scr, it, lane, MapId()); }
        { const int NIT = 16 * 16; for (int it = gw; it < NIT; it += NGW) tr_item(inp(11) + (size_t)l * 1024 * 512, 1024, 512, inp(21) + l * 1024, wsp<bf16>(F, WS_WKV) + (size_t)l * 512 * 1024, scr, it, lane, MapId()); }
        { const int NIT = 4 * 32; for (int it = gw; it < NIT; it += NGW) tr_item(inp(12) + (size_t)l * 256 * 1024, 256, 1024, nullptr, wsp<bf16>(F, WS_WO) + (size_t)l * 1024 * 256, scr, it, lane, MapId()); }
        for (int kv = 0; kv < 2; ++kv) {
            { const int NIT = 32 * 4; for (int it = gw; it < NIT; it += NGW) tr_item(inp(5) + (size_t)(l * 2 + kv) * 2048 * 128, 2048, 128, nullptr, wsp<bf16>(F, WS_W1C) + (size_t)(l * 2 + kv) * 128 * 2048, scr, it, lane, MapId()); }
            { const int NIT = 2 * 2; for (int it = gw; it < NIT; it += NGW) tr_item(inp(6) + (size_t)(l * 2 + kv) * 128 * 64, 128, 64, nullptr, wsp<bf16>(F, WS_W2C) + (size_t)(l * 2 + kv) * 64 * 128, scr, it, lane, MapId()); }
        }
        if (F.G != 256) { convert_experts(F, l, (bf16*)scr, 0); convert_experts(F, l, (bf16*)scr, 1); }
        { bf16* dst = wsp<bf16>(F, WS_WR) + (size_t)l * 96 * 1024; const float* gn = inp(22) + l * 1024;
          for (int i = gw * 64 + lane; i < 48 * 1024; i += NGW * 64) { const int n = i >> 10, k = i & 1023;
            float v = 0.f; if (n < 4) v = inp(13)[(size_t)(l * 1024 + k) * 4 + n]; else if (n < 36) v = inp(15)[(size_t)(l * 1024 + k) * 32 + (n - 4)];
            v *= gn[k]; const unsigned h = f2bf(v);
            const int fo = ((((k >> 5) * 3 + (n >> 4)) * 2) * 64 + ((k >> 3) & 3) * 16 + (n & 15)) * 8 + (k & 7);
            dst[fo] = (bf16)h; dst[fo + 512] = (bf16)f2bf(v - bf2f((unsigned short)h)); } }
    }
    { bf16* wg = wsp<bf16>(F, WS_WG);
      for (int i = gw * 64 + lane; i < DEPTH * 32 * 1024; i += NGW * 64) { const int l2 = i >> 15, row = (i >> 10) & 31, k = i & 1023, hk = row >> 4, gi = row & 15;
        const float v = gi < 12 ? inp(2)[((size_t)l2 * 1024 + k) * IN_W + 1280 + hk * 12 + gi] * inp(19)[l2 * 1024 + k] : 0.f;
        wg[(l2 * 2 + hk) * 16384 + ((k >> 5) * 64 + ((k >> 3) & 3) * 16 + gi) * 8 + (k & 7)] = (bf16)f2bf(v); } }
    { float* rope = wsp<float>(F, WS_ROPE);
      for (int i = gw * 64 + lane; i < T * 32; i += NGW * 64) { const int t = i >> 5, k = i & 31;
        const float inv = powf(10000.0f, -(float)k / 32.0f); const float ang = (float)t * inv;
        rope[2 * i] = cosf(ang); rope[2 * i + 1] = sinf(ang); } }
    { float* b1 = wsp<float>(F, WS_SMALL);
      for (int i = gw * 64 + lane; i < 4 * 128; i += NGW * 64) { const int lk = i >> 7, n = i & 127;
        const float* pe = inp(4) + (size_t)lk * 2048; const float* w1 = inp(5) + (size_t)lk * 2048 * 128 + n; float s = 0.f;
        for (int kk = 0; kk < 2048; ++kk) s += pe[kk] * w1[(size_t)kk * 128];
        b1[i] = s; } }
    { bf16* HB = wsp<bf16>(F, WS_HB); float* SSQ = wsp<float>(F, WS_SSQ); bf16* MB = wsp<bf16>(F, WS_MEMB); float* SSQM = wsp<float>(F, WS_SMALL) + 1024;
      for (int m = gw; m < NTOK + NB * 256; m += NGW) {
        const bool ism = m >= NTOK; const int r = ism ? m - NTOK : m;
        const f32x4* xr = (const f32x4*)((ism ? inp(1) : inp(0)) + (size_t)r * 1024) + lane;
        unsigned long long* o8 = (unsigned long long*)((ism ? MB : HB) + (size_t)r * 1024) + lane;
        float s = 0.f;
#pragma unroll
        for (int j = 0; j < 4; ++j) { const f32x4 v = xr[64 * j]; s += (v.x * v.x + v.y * v.y) + (v.z * v.z + v.w * v.w);
            o8[64 * j] = (unsigned long long)pk2(v.x, v.y) | ((unsigned long long)pk2(v.z, v.w) << 32); }
        s = wave_sum(s);
        if (ism) { if (lane == 0) SSQM[r] = s; }
        else if (lane < 16) SSQ[(size_t)r * 16 + lane] = lane == 0 ? s : 0.f;
      } }
}

template <int NT>
DEV void skinny16(const bf16* A, size_t lda, const bf16* Bt, size_t ldb, int K, int lane, f32x4 (&acc)[NT]) {
    const int l16 = lane & 15, g4 = lane >> 4;
    const bf16* ap = A + (size_t)l16 * lda + g4 * 8; const bf16* bp = Bt + (size_t)l16 * ldb + g4 * 8;
#pragma unroll
    for (int n = 0; n < NT; ++n) acc[n] = (f32x4){0.f, 0.f, 0.f, 0.f};
#pragma unroll 2
    for (int k = 0; k < K; k += 32) {
        const bf16x8 a = *(const bf16x8*)(ap + k);
#pragma unroll
        for (int n = 0; n < NT; ++n) { const bf16x8 b = *(const bf16x8*)(bp + (size_t)n * 16 * ldb + k); acc[n] = mfma16(a, b, acc[n]); }
    }
}

DEV void memkv_phase(Frame& F) {
    const int gw = F.vcu * NWAVES + F.wave, NGW = F.G * NWAVES, lane = F.lane, l16 = lane & 15, g4 = lane >> 4;
    const bf16* MB = wsp<bf16>(F, WS_MEMB); const float* SSQM = wsp<float>(F, WS_SMALL) + 1024;
    bf16* MK = wsp<bf16>(F, WS_MK); bf16* MVT = wsp<bf16>(F, WS_MVT);
    for (int task = gw; task < 1024; task += NGW) {
        const int l2 = task >> 9, rt = (task >> 3) & 63, chunk = task & 7;
        f32x4 acc[4];
        skinny16<4>(MB + (size_t)rt * 16 * 1024, 1024, wsp<bf16>(F, WS_WKV) + ((size_t)l2 * 512 + chunk * 64) * 1024, 1024, 1024, lane, acc);
        const int b = rt >> 4, key0 = (rt & 15) * 16 + g4 * 4;
        float rs[4];
#pragma unroll
        for (int r = 0; r < 4; ++r) rs[r] = 1.0f / sqrtf(SSQM[rt * 16 + g4 * 4 + r] * (1.0f / 1024.0f) + RMS_EPS);
#pragma unroll
        for (int nt = 0; nt < 4; ++nt) {
            const int n = chunk * 64 + nt * 16 + l16;
            if (chunk < 4) { const int head = n >> 6, d = n & 63;
#pragma unroll
                for (int r = 0; r < 4; ++r) MK[(size_t)((l2 * 4 + b) * 4 + head) * 256 * 64 + kfrag_off(key0 + r, d)] = (bf16)f2bf(acc[nt][r] * rs[r]);
            } else { const int n2 = n - 256, head = n2 >> 6, d = n2 & 63;
                v2u w; w.x = pk2(acc[nt][0] * rs[0], acc[nt][1] * rs[1]); w.y = pk2(acc[nt][2] * rs[2], acc[nt][3] * rs[3]);
                *(v2u*)(MVT + (((size_t)((l2 * 4 + b) * 4 + head) * 8 + (key0 >> 5)) * 64 + d) * 32 + slot32(key0 & 31)) = w; }
        }
    }
}

DEV void compress_phase(Frame& F, int l) {
    const int lane = F.lane, l16 = lane & 15, g4 = lane >> 4, quad = F.wave >> 2, q = F.wave & 3;
    float* part = (float*)F.ldsg + quad * (4 * 16 * 128);
    const bf16* KCR = wsp<bf16>(F, WS_KCR); const bf16* VCR = wsp<bf16>(F, WS_VCR);
    bf16* KCC = wsp<bf16>(F, WS_KCC); bf16* VCT = wsp<bf16>(F, WS_VCT);
    const float* bias1 = wsp<float>(F, WS_SMALL);
    for (int tk0 = F.vcu * 2; tk0 < 512; tk0 += F.G * 2) {
        const int tk = tk0 + quad; const int kv = tk >> 8, tile = tk & 255;
        const bf16* raw = kv ? VCR : KCR;
        const bf16* w1 = wsp<bf16>(F, WS_W1C) + (size_t)(l * 2 + kv) * 128 * 2048;
        const bf16* w2 = wsp<bf16>(F, WS_W2C) + (size_t)(l * 2 + kv) * 64 * 128;
        { const int r = tile * 16 + l16, bh = r >> 9, c = r & 511, b = bh >> 1, hkv = bh & 1;
          f32x4 acc[8];
#pragma unroll
          for (int n = 0; n < 8; ++n) acc[n] = (f32x4){0.f, 0.f, 0.f, 0.f};
#pragma unroll 2
          for (int ks = q * 16; ks < q * 16 + 16; ++ks) {
              const int kk = ks * 32 + g4 * 8, ll = kk >> 6, d = kk & 63;
              int tok = 16 * c + ll; tok = tok > T - 1 ? T - 1 : tok;
              const bf16x8 a = *(const bf16x8*)(raw + ((size_t)b * T + tok) * 128 + hkv * 64 + d);
#pragma unroll
              for (int n = 0; n < 8; ++n) { const bf16x8 bb = *(const bf16x8*)(w1 + (size_t)(n * 16 + l16) * 2048 + kk); acc[n] = mfma16(a, bb, acc[n]); }
          }
#pragma unroll
          for (int n = 0; n < 8; ++n)
#pragma unroll
              for (int r2 = 0; r2 < 4; ++r2) part[(q * 16 + g4 * 4 + r2) * 128 + n * 16 + l16] = acc[n][r2];
        }
        __syncthreads();
        { f32x4 o = (f32x4){0.f, 0.f, 0.f, 0.f};
#pragma unroll
          for (int k2 = 0; k2 < 4; ++k2) {
              const int h0 = k2 * 32 + g4 * 8;
              float hv[8];
#pragma unroll
              for (int j = 0; j < 8; ++j) { float s = bias1[(l * 2 + kv) * 128 + h0 + j];
#pragma unroll
                  for (int p = 0; p < 4; ++p) s += part[(p * 16 + l16) * 128 + h0 + j];
                  hv[j] = siluf_(s); }
              bf16x8 a; { v4u w; w.x = pk2(hv[0], hv[1]); w.y = pk2(hv[2], hv[3]); w.z = pk2(hv[4], hv[5]); w.w = pk2(hv[6], hv[7]); a = __builtin_bit_cast(bf16x8, w); }
              const bf16x8 bb = *(const bf16x8*)(w2 + (size_t)(q * 16 + l16) * 128 + h0);
              o = mfma16(a, bb, o);
          }
          const int r0 = tile * 16 + g4 * 4, bh = r0 >> 9, c0 = r0 & 511, d = q * 16 + l16;
          if (kv == 0) {
#pragma unroll
              for (int r2 = 0; r2 < 4; ++r2) KCC[(size_t)bh * 512 * 64 + kfrag_off(c0 + r2, d)] = (c0 + r2 == 511) ? (bf16)0 : (bf16)f2bf(o[r2]);
          } else {
              v2u w; w.x = pk2(o[0], o[1]); w.y = pk2(o[2], (c0 + 3 == 511) ? 0.f : o[3]);
              *(v2u*)(VCT + (((size_t)bh * 16 + (c0 >> 5)) * 64 + d) * 32 + slot32(c0 & 31)) = w;
          }
        }
        __syncthreads();
    }
}

DEV float hgrn_lb(const Frame& F, int l, int c) {
    if (l == 0) return 0.f;
    const float a = inp(7)[c], b = inp(7)[256 + c];
    return 1.0f / (1.0f + expf(a - b));
}
DEV float hgrn_logf(float z, float lb) {
    const float la = logf(fmaxf(lb, 1e-30f));
    const float ls = fminf(z, 0.f) - log1pf(expf(-fabsf(z)));
    const float lc = log1pf(-lb) + ls;
    const float mx = fmaxf(la, lc), mn = fminf(la, lc);
    return mx + log1pf(expf(mn - mx));
}
constexpr int HS = 68;
DEV f32x4 mfma4(float a, float b, f32x4 c) { return __builtin_amdgcn_mfma_f32_16x16x4f32(a, b, c, 0, 0, 0); }
DEV void hgrn_setup_chunk(Frame& F, float lb, const float (&z)[8], float* Bc, float* Kc, float* tot) {
    const int d = F.tid & 63, sg = F.tid >> 6;
    const float la = logf(fmaxf(lb, 1e-30f)), l1m = log1pf(-lb), onem = 1.0f - lb;
    float loc[8], kv[8]; float run = 0.f;
#pragma unroll
    for (int i = 0; i < 8; ++i) {
        const float ez = __expf(-fabsf(z[i]));
        const float lc = l1m + (fminf(z[i], 0.f) - __logf(1.0f + ez));
        const float mx = fmaxf(la, lc), mn = fminf(la, lc);
        run += mx + __logf(1.0f + __expf(mn - mx)); loc[i] = run;
        kv[i] = onem * (z[i] >= 0.f ? ez : 1.0f) / (1.0f + ez);
    }
    tot[sg * 64 + d] = run;
    __syncthreads();
    float off = 0.f;
    for (int g = 0; g < sg; ++g) off += tot[g * 64 + d];
#pragma unroll
    for (int i = 0; i < 8; ++i) { Bc[(sg * 8 + i) * HS + d] = off + loc[i]; Kc[(sg * 8 + i) * HS + d] = kv[i]; }
    __syncthreads();
}
DEV void hgrn_local_phase(Frame& F, int l) {
    float* Bc = (float*)F.ldsg; float* Kc = Bc + 64 * HS; float* Vc = Kc + 64 * HS; float* tot = Vc + 64 * HS;
    bf16* U = wsp<bf16>(F, WS_U); float* DEC = wsp<float>(F, WS_DEC);
    const int lane = F.lane, w = F.wave, li = lane & 15, kq = lane >> 4;
    for (int task = F.vcu; task < 2048; task += F.G) {
        const int bh = task >> 7, ch = task & 127, b = bh >> 2, h = bh & 3;
        { const int d = F.tid & 63, sg = F.tid >> 6;
          const size_t go = ((size_t)b * T + ch * 64 + sg * 8) * 256 + h * 64 + d;
          const float* HFp = wsp<float>(F, WS_HF) + go; const bf16* HIp = wsp<bf16>(F, WS_HI) + go;
          float z[8], vi[8];
#pragma unroll
          for (int i = 0; i < 8; ++i) { z[i] = HFp[(size_t)i * 256]; vi[i] = bf2f(HIp[(size_t)i * 256]); }
          hgrn_setup_chunk(F, hgrn_lb(F, l, h * 64 + d), z, Bc, Kc, tot);
          const float bl = Bc[63 * HS + d];
#pragma unroll
          for (int i = 0; i < 8; ++i) { const int s = sg * 8 + i; Kc[s * HS + d] *= __expf(bl - Bc[s * HS + d]); Vc[s * HS + d] = vi[i]; }
          if (sg == 0) DEC[(size_t)task * 64 + d] = expf(bl); }
        __syncthreads();
        { const int dI = w >> 1, e0 = (w & 1) * 32;
          f32x4 a0 = (f32x4){0.f, 0.f, 0.f, 0.f}, a1 = a0;
#pragma unroll 4
          for (int k0 = 0; k0 < 64; k0 += 4) { const int s = k0 + kq;
              const float a = Kc[s * HS + dI * 16 + li], b0 = Vc[s * HS + e0 + li], b1 = Vc[s * HS + e0 + 16 + li];
              a0 = mfma4(a, b0, a0); a1 = mfma4(a, b1, a1); }
#pragma unroll
          for (int r = 0; r < 4; ++r) { bf16* up = U + ((size_t)task * 64 + dI * 16 + 4 * kq + r) * 64 + e0 + li; up[0] = (bf16)f2bf(a0[r]); up[16] = (bf16)f2bf(a1[r]); } }
        __syncthreads();
    }
}
DEV void hgrn_scan_phase(Frame& F, int probe = 0) {
    const bf16* U = wsp<bf16>(F, WS_U); bf16* U2 = wsp<bf16>(F, probe ? WS_PROBE : WS_U2); const float* DEC = wsp<float>(F, WS_DEC);
    const int nact = (F.G * 256 >= 65536) ? 256 : 512;
    if (F.tid < nact)
    for (int gid = F.vcu * nact + F.tid; gid < 65536; gid += F.G * nact) {
        const int bh = gid >> 12, de = gid & 4095, d = de >> 6;
        float S = 0.f; const bf16* up = U + (size_t)bh * 128 * 4096 + de; bf16* op = U2 + (size_t)bh * 128 * 4096 + de; const float* dp = DEC + (size_t)bh * 128 * 64 + d;
#pragma unroll 16
        for (int ch = 0; ch < 128; ++ch) { const float u = bf2f(up[(size_t)ch * 4096]); const float dc = dp[ch * 64]; op[(size_t)ch * 4096] = (bf16)f2bf(S); S = dc * S + u; }
    }
}
DEV void hgrn_out_phase(Frame& F, int l) {
    float* Bc = (float*)F.ldsg; float* Kb = Bc + 64 * HS; float* Vc = Kb + 64 * HS; float* Qs = Vc + 64 * HS; float* Sc = Qs + 64 * HS; float* Ac = Sc + 64 * HS; float* tot = Ac + 64 * HS;
    float* Oc = Kb;
    const bf16* U = wsp<bf16>(F, WS_U2); bf16* CAT = wsp<bf16>(F, WS_CAT);
    const int lane = F.lane, w = F.wave, li = lane & 15, kq = lane >> 4;
    for (int task = F.vcu; task < 2048; task += F.G) {
        const int bh = task >> 7, ch = task & 127, b = bh >> 2, h = bh & 3;
        float gv[8];
        { const int d = F.tid & 63, sg = F.tid >> 6;
          const size_t go = ((size_t)b * T + ch * 64 + sg * 8) * 256 + h * 64 + d;
          const float* HFp = wsp<float>(F, WS_HF) + go; const bf16* HIp = wsp<bf16>(F, WS_HI) + go; const bf16* HQp = wsp<bf16>(F, WS_HQ) + go; const bf16* HGp = wsp<bf16>(F, WS_HG) + go;
          const bf16* Up = U + ((size_t)task * 64 + sg * 8) * 64 + d;
          float z[8], vi[8], qi[8], si[8];
#pragma unroll
          for (int i = 0; i < 8; ++i) { z[i] = HFp[(size_t)i * 256]; vi[i] = bf2f(HIp[(size_t)i * 256]); qi[i] = bf2f(HQp[(size_t)i * 256]); gv[i] = bf2f(HGp[(size_t)i * 256]); si[i] = bf2f(Up[(size_t)i * 64]); }
          hgrn_setup_chunk(F, hgrn_lb(F, l, h * 64 + d), z, Bc, Kb, tot);
#pragma unroll
          for (int i = 0; i < 8; ++i) { const int s = sg * 8 + i, J = s >> 4; const float rJ = J ? Bc[(16 * J - 1) * HS + d] : 0.f;
              Kb[s * HS + d] *= __expf(fminf(rJ - Bc[s * HS + d], 80.f));
              Vc[s * HS + d] = vi[i]; Qs[s * HS + d] = qi[i] * 0.125f; Sc[s * HS + d] = si[i]; } }
        __syncthreads();
#pragma unroll 1
        for (int ti = w; ti < 10; ti += 8) {
            const int I = ti < 1 ? 0 : (ti < 3 ? 1 : (ti < 6 ? 2 : 3)), J = ti - (I * (I + 1)) / 2;
            const int t = I * 16 + li; f32x4 acc = (f32x4){0.f, 0.f, 0.f, 0.f};
#pragma unroll 4
            for (int k0 = 0; k0 < 64; k0 += 4) { const int d = k0 + kq; const float rJ = J ? Bc[(16 * J - 1) * HS + d] : 0.f;
                const float a = Qs[t * HS + d] * __expf(Bc[t * HS + d] - rJ), bb = Kb[(J * 16 + li) * HS + d];
                acc = mfma4(a, bb, acc); }
#pragma unroll
            for (int r = 0; r < 4; ++r) { const int tt = I * 16 + 4 * kq + r, ss = J * 16 + li; Ac[tt * HS + ss] = (ss <= tt) ? acc[r] : 0.f; }
        }
        __syncthreads();
        { const int I = w >> 1, e0 = (w & 1) * 32, t = I * 16 + li;
          f32x4 a0 = (f32x4){0.f, 0.f, 0.f, 0.f}, a1 = a0;
#pragma unroll 4
          for (int k0 = 0; k0 < 64; k0 += 4) { const int d = k0 + kq;
              const float a = Qs[t * HS + d] * __expf(Bc[t * HS + d]), b0 = Sc[d * HS + e0 + li], b1 = Sc[d * HS + e0 + 16 + li];
              a0 = mfma4(a, b0, a0); a1 = mfma4(a, b1, a1); }
#pragma unroll 1
          for (int s0 = 0; s0 < 16 * (I + 1); s0 += 4) { const int s = s0 + kq;
              const float a = Ac[t * HS + s], b0 = Vc[s * HS + e0 + li], b1 = Vc[s * HS + e0 + 16 + li];
              a0 = mfma4(a, b0, a0); a1 = mfma4(a, b1, a1); }
#pragma unroll
          for (int r = 0; r < 4; ++r) { float* op = Oc + (I * 16 + 4 * kq + r) * HS + e0 + li; op[0] = a0[r]; op[16] = a1[r]; } }
        __syncthreads();
        { const float ng = inp(8)[l * 256 + h * 64 + lane];
          { const int t = w * 8 + (lane >> 3); const float* op = Oc + t * HS + (lane & 7) * 8; float s = 0.f;
#pragma unroll
            for (int j = 0; j < 8; ++j) s += op[j] * op[j];
            s += __shfl_xor(s, 1); s += __shfl_xor(s, 2); s += __shfl_xor(s, 4);
            if ((lane & 7) == 0) tot[t] = 1.0f / sqrtf(s * (1.0f / 64.0f) + RMS_EPS); }
          LDS_WAIT();
#pragma unroll
          for (int i = 0; i < 8; ++i) { const int t = w * 8 + i; const float o = Oc[t * HS + lane];
              const size_t row = (size_t)b * T + ch * 64 + t;
              CAT[row * 1024 + 768 + h * 64 + lane] = (bf16)f2bf(o * tot[t] * ng * siluf_(gv[i])); } }
        __syncthreads();
    }
}

DEV void conv_phase(Frame& F, int l) {
    const bf16* CB = wsp<bf16>(F, WS_CB); const bf16* CC = wsp<bf16>(F, WS_CC); const bf16* CH = wsp<bf16>(F, WS_CH); bf16* CAT = wsp<bf16>(F, WS_CAT);
    const float* cw = inp(3) + l * 3 * 256;
    for (int it = F.vcu * 512 + F.tid; it < NTOK * 32; it += F.G * 512) {
        const int m = it >> 5, c0 = (it & 31) * 8, t = m & (T - 1);
        const v4u bb = *(const v4u*)(CB + (size_t)m * 256 + c0);
        float y[8];
#pragma unroll
        for (int j = 0; j < 8; ++j) y[j] = 0.f;
#pragma unroll
        for (int k = 0; k < 3; ++k) {
            if (t + k - 2 >= 0) {
                const size_t o = (size_t)(m + k - 2) * 256 + c0;
                const v4u cc = *(const v4u*)(CC + o), hh = *(const v4u*)(CH + o);
#pragma unroll
                for (int j = 0; j < 4; ++j) { const float w0 = cw[k * 256 + c0 + 2 * j], w1 = cw[k * 256 + c0 + 2 * j + 1];
                    y[2 * j] += w0 * (bflo(cc[j]) * bflo(hh[j])); y[2 * j + 1] += w1 * (bfhi(cc[j]) * bfhi(hh[j])); }
            }
        }
        v4u o4;
#pragma unroll
        for (int j = 0; j < 4; ++j) o4[j] = pk2(bflo(bb[j]) * y[2 * j], bfhi(bb[j]) * y[2 * j + 1]);
        *(v4u*)(CAT + (size_t)m * 1024 + 512 + c0) = o4;
    }
}
struct SmState { float m, l; f32x4 o[4]; };
DEV void sm_reset(SmState& st) { st.m = -INFINITY; st.l = 0.f;
#pragma unroll
    for (int i = 0; i < 4; ++i) st.o[i] = (f32x4){0.f, 0.f, 0.f, 0.f}; }
DEV float sm_lsum(const SmState& st) { float l = st.l; l += __shfl_xor(l, 16); l += __shfl_xor(l, 32); return l; }
DEV void load_k(const bf16* kbase, int lane, bf16x8 (&kf)[2][2]) {
#pragma unroll
    for (int tt = 0; tt < 2; ++tt)
#pragma unroll
        for (int ks = 0; ks < 2; ++ks) kf[tt][ks] = *(const bf16x8*)(kbase + lane * 8 + (tt * 2 + ks) * 512);
}
DEV void load_v(const bf16* vbase, int lane, bf16x8 (&vf)[4]) {
    const int l16 = lane & 15, g4 = lane >> 4;
#pragma unroll
    for (int dt = 0; dt < 4; ++dt) vf[dt] = *(const bf16x8*)(vbase + (size_t)(dt * 16 + l16) * 32 + g4 * 8);
}
DEV void qk_tile(const bf16x8 (&kf)[2][2], const bf16x8 (&qf)[2], f32x4 (&s)[2]) {
#pragma unroll
    for (int tt = 0; tt < 2; ++tt) { s[tt] = mfma16(kf[tt][0], qf[0], (f32x4){0.f, 0.f, 0.f, 0.f}); s[tt] = mfma16(kf[tt][1], qf[1], s[tt]); }
}
DEV bf16x8 pack_p(const float (&p)[2][4]) {
    v4u w; w.x = pk2(p[0][0], p[0][1]); w.y = pk2(p[0][2], p[0][3]); w.z = pk2(p[1][0], p[1][1]); w.w = pk2(p[1][2], p[1][3]);
    return __builtin_bit_cast(bf16x8, w);
}
template <int MODE, class MaskF>
DEV void attn_compute(const bf16x8 (&kf)[2][2], const bf16x8 (&vf)[4], const bf16x8 (&qf)[2], SmState& st, int lane, bool colok, MaskF mask) {
    const int g4 = lane >> 4;
    f32x4 s[2]; qk_tile(kf, qf, s);
    float sv[2][4]; float tmax = -INFINITY;
#pragma unroll
    for (int tt = 0; tt < 2; ++tt)
#pragma unroll
        for (int r = 0; r < 4; ++r) { float x = s[tt][r]; if (MODE == 2) x = mask(16 * tt + 4 * g4 + r) ? x : -INFINITY; sv[tt][r] = x; tmax = fmaxf(tmax, x); }
    if (MODE == 1) tmax = colok ? tmax : -INFINITY;
    tmax = fmaxf(tmax, __shfl_xor(tmax, 16)); tmax = fmaxf(tmax, __shfl_xor(tmax, 32));
    const float mnew = fmaxf(st.m, tmax), muse = (mnew == -INFINITY) ? 0.f : mnew;
    const float alpha = ex2(st.m - muse);
    const float msub = (MODE == 1) ? (colok ? muse : INFINITY) : muse;
    float p[2][4]; float ps = 0.f;
#pragma unroll
    for (int tt = 0; tt < 2; ++tt)
#pragma unroll
        for (int r = 0; r < 4; ++r) { p[tt][r] = ex2(sv[tt][r] - msub); ps += p[tt][r]; }
    st.l = st.l * alpha + ps; st.m = mnew;
    const bf16x8 pf = pack_p(p);
#pragma unroll
    for (int dt = 0; dt < 4; ++dt) { st.o[dt] = st.o[dt] * alpha; st.o[dt] = mfma16(vf[dt], pf, st.o[dt]); }
}
template <int MODE, class MaskF>
DEV void attn_compute_fixed(const bf16x8 (&kf)[2][2], const bf16x8 (&vf)[4], const bf16x8 (&qf)[2], SmState& st, float mref, int lane, bool colok, MaskF mask) {
    const int g4 = lane >> 4;
    const float c0 = (MODE == 1) ? (colok ? -mref : -INFINITY) : -mref;
    const f32x4 ci = {c0, c0, c0, c0};
    f32x4 s[2];
#pragma unroll
    for (int tt = 0; tt < 2; ++tt) { s[tt] = mfma16(kf[tt][0], qf[0], ci); s[tt] = mfma16(kf[tt][1], qf[1], s[tt]); }
    float p[2][4];
#pragma unroll
    for (int tt = 0; tt < 2; ++tt)
#pragma unroll
        for (int r = 0; r < 4; ++r) { float x = s[tt][r]; if (MODE == 2) x = mask(16 * tt + 4 * g4 + r) ? x : -INFINITY; p[tt][r] = ex2(x); }
    st.l += ((p[0][0] + p[0][1]) + (p[0][2] + p[0][3])) + ((p[1][0] + p[1][1]) + (p[1][2] + p[1][3]));
    const bf16x8 pf = pack_p(p);
#pragma unroll
    for (int dt = 0; dt < 4; ++dt) st.o[dt] = mfma16(vf[dt], pf, st.o[dt]);
}
template <int MODE, class MaskF>
DEV void attn_max(const bf16x8 (&kf)[2][2], const bf16x8 (&qf)[2], float& mx, int lane, bool colok, MaskF mask) {
    const int g4 = lane >> 4;
    f32x4 s[2]; qk_tile(kf, qf, s);
    float tmax = -INFINITY;
#pragma unroll
    for (int tt = 0; tt < 2; ++tt)
#pragma unroll
        for (int r = 0; r < 4; ++r) { float x = s[tt][r]; if (MODE == 2) x = mask(16 * tt + 4 * g4 + r) ? x : -INFINITY; tmax = fmaxf(tmax, x); }
    if (MODE == 1) tmax = colok ? tmax : -INFINITY;
    mx = fmaxf(mx, tmax);
}
DEV float colmax_finish(float mx) { mx = fmaxf(mx, __shfl_xor(mx, 16)); mx = fmaxf(mx, __shfl_xor(mx, 32)); return mx == -INFINITY ? 0.f : mx; }
DEV float col_norm(const bf16x8 (&qf)[2]) {
    float s = 0.f;
#pragma unroll
    for (int ks = 0; ks < 2; ++ks) { const v4u w = __builtin_bit_cast(v4u, qf[ks]);
#pragma unroll
        for (int j = 0; j < 4; ++j) { const float a = bflo(w[j]), b = bfhi(w[j]); s += a * a + b * b; } }
    s += __shfl_xor(s, 16); s += __shfl_xor(s, 32);
    return sqrtf(s);
}
DEV float wave_max_uniform(float v) {
#pragma unroll
    for (int o = 1; o < 64; o <<= 1) v = fmaxf(v, __shfl_xor(v, o));
    return __builtin_bit_cast(float, __builtin_amdgcn_readfirstlane(__builtin_bit_cast(int, v)));
}
constexpr float FIXED_REF_MAX = 40.f;
DEV void kmax_phase(Frame& F, int l) {
    const int lane = F.lane; const int gw = F.vcu * NWAVES + F.wave, NGW = F.G * NWAVES;
    for (int item = gw; item < 2048; item += NGW) {
        const int br = item >> 10, bh = (item >> 7) & 7, key = (item & 127) * 64 + lane;
        const bf16* kp = wsp<bf16>(F, br ? WS_KW : WS_KS) + (size_t)bh * T * 64;
        float s = 0.f;
#pragma unroll
        for (int i = 0; i < 8; ++i) { const v4u w = *(const v4u*)(kp + kfrag_off(key, i * 8));
#pragma unroll
            for (int j = 0; j < 4; ++j) { const float a = bflo(w[j]), b = bfhi(w[j]); s += a * a + b * b; } }
#pragma unroll
        for (int o = 1; o < 64; o <<= 1) s = fmaxf(s, __shfl_xor(s, o));
        if (lane == 0) __hip_atomic_fetch_max((unsigned*)F.ctl + CW_KMAX + l * 16 + br * 8 + bh, __builtin_bit_cast(unsigned, s), RLX_AGENT);
    }
}
struct NoMask { DEV bool operator()(int) const { return true; } };
template <int D, bool WITHV, class AddrF, class BodyF>
DEV void pipe_run(int n, int lane, AddrF addr, BodyF body) {
    if (n <= 0) return;
    bf16x8 kf[D][2][2], vf[D][4];
#pragma unroll
    for (int d = 0; d < D; ++d) { const bf16* kb; const bf16* vb; addr(d < n ? d : n - 1, kb, vb); load_k(kb, lane, kf[d]); if (WITHV) load_v(vb, lane, vf[d]); }
#pragma unroll 1
    for (int i = 0; i < n; i += D) {
#pragma unroll
        for (int d = 0; d < D; ++d) { const int s = i + d;
            if (s < n) body(s, kf[d], vf[d]);
            if (D > 1 || s + 1 < n) { const bf16* kb; const bf16* vb; addr(s + D < n ? s + D : n - 1, kb, vb); load_k(kb, lane, kf[d]); if (WITHV) load_v(vb, lane, vf[d]); } }
    }
}
template <class AddrF, class BodyF>
DEV void pipe_run_k2(int n, int lane, AddrF addr, BodyF body) {
    if (n <= 0) return;
    bf16x8 kf[2][2][2], vf[4];
    { const bf16* kb; const bf16* vb; addr(0, kb, vb); load_k(kb, lane, kf[0]); }
#pragma unroll 1
    for (int i = 0; i < n; i += 2) {
#pragma unroll
        for (int d = 0; d < 2; ++d) { const int s = i + d;
            { const bf16* kb; const bf16* vb; addr(s < n ? s : n - 1, kb, vb); load_v(vb, lane, vf); }
            { const bf16* kb; const bf16* vb; addr(s + 1 < n ? s + 1 : n - 1, kb, vb); load_k(kb, lane, kf[d ^ 1]); }
            if (s < n) body(s, kf[d], vf); }
    }
}
template <class AddrF, class BodyA, class BodyB>
DEV void pipe_run_mt(int n_main, int n_tail, int lane, AddrF addr, BodyA mainb, BodyB tailb) {
    const int n = n_main + n_tail;
    bf16x8 kf[2][2][2], vf[4];
    { const bf16* kb; const bf16* vb; addr(0, kb, vb); load_k(kb, lane, kf[0]); }
    int i = 0;
#define PIPE_STEP_(s_, d_, BODY_) do { { const bf16* kb; const bf16* vb; addr((s_) < n ? (s_) : n - 1, kb, vb); load_v(vb, lane, vf); } \
        { const bf16* kb; const bf16* vb; addr((s_) + 1 < n ? (s_) + 1 : n - 1, kb, vb); load_k(kb, lane, kf[(d_) ^ 1]); } BODY_((s_), kf[d_], vf); } while (0)
#pragma unroll 1
    for (; i + 2 <= n_main; i += 2) { PIPE_STEP_(i, 0, mainb); PIPE_STEP_(i + 1, 1, mainb); }
    if (i < n_main) { PIPE_STEP_(i, 0, mainb); ++i;
#pragma unroll
        for (int a = 0; a < 2; ++a)
#pragma unroll
            for (int b = 0; b < 2; ++b) kf[0][a][b] = kf[1][a][b]; }
#pragma unroll 1
    for (; i < n; ++i) { PIPE_STEP_(i, 0, tailb);
#pragma unroll
        for (int a = 0; a < 2; ++a)
#pragma unroll
            for (int b = 0; b < 2; ++b) kf[0][a][b] = kf[1][a][b]; }
#undef PIPE_STEP_
}
constexpr int PIPE_D = 2;

DEV void acc_add_packed(unsigned (&pk)[4][4][2], int ct, const f32x4 (&o)[4], float sc, bool first) {
#pragma unroll
    for (int dt = 0; dt < 4; ++dt) {
        f32x4 v = o[dt] * sc;
        if (!first) { v[0] += bflo(pk[ct][dt][0]); v[1] += bfhi(pk[ct][dt][0]); v[2] += bflo(pk[ct][dt][1]); v[3] += bfhi(pk[ct][dt][1]); }
        pk[ct][dt][0] = pk2(v[0], v[1]); pk[ct][dt][1] = pk2(v[2], v[3]);
    }
}
template <int VAR>
DEV void nsa_phase_t(Frame& F, int l) {
#define NSA_RELANE() int ln_ = lane; asm volatile("" : "+v"(ln_)); const int l16 = ln_ & 15, g4 = ln_ >> 4, tq = l16 >> 2, gh = l16 & 3; const size_t mrow0 = (size_t)b * T + t0 + tq; const int tl0 = t0 + tq; (void)l16; (void)g4; (void)gh; (void)mrow0; (void)tl0
    float* IMP = (float*)(F.ldsg + F.wave * NSA_LDS_WAVE);
    float* VALS = IMP + 2048; int* BL = (int*)(IMP + 2176); unsigned* SELB = (unsigned*)(IMP + 2304); float* GL = IMP + 2432;
    const bf16* Q = wsp<bf16>(F, WS_Q);
    const bf16* KCC = wsp<bf16>(F, WS_KCC); const bf16* VCT = wsp<bf16>(F, WS_VCT);
    const bf16* KS = wsp<bf16>(F, WS_KS); const bf16* VST = wsp<bf16>(F, WS_VST);
    const bf16* KW = wsp<bf16>(F, WS_KW); const bf16* VWT = wsp<bf16>(F, WS_VWT);
    bf16* CAT = wsp<bf16>(F, WS_CAT);
    const int gw = F.vcu * NWAVES + F.wave, NGW = F.G * NWAVES;
    const bool xmap = (F.G == 256);
#pragma unroll 1
    for (int task = gw; task < 4096; task += NGW) {
        unsigned zl_ = 0u; asm volatile("" : "+v"(zl_)); const int lane = (int)__builtin_amdgcn_mbcnt_hi(~0u, __builtin_amdgcn_mbcnt_lo(~0u, zl_));
        const int bh = xmap ? (gw >> 8) : (task & 7), idx = xmap ? ((task >> 11) ? 511 - (gw & 255) : (gw & 255)) : (task >> 3);
        const int t0 = idx * 16, b = bh >> 1, hkv = bh & 1, cur = t0 >> 6;
        bf16x8 qf[4][2];
        unsigned opk[4][4][2];
        SmState st[4];
        float qnmax = 0.f;
        { NSA_RELANE();
#pragma unroll
        for (int ct = 0; ct < 4; ++ct)
#pragma unroll
            for (int ks = 0; ks < 2; ++ks) qf[ct][ks] = *(const bf16x8*)(Q + (mrow0 + 4 * ct) * 512 + hkv * 256 + gh * 64 + ks * 32 + g4 * 8);
        { NSA_RELANE();
          f32x4 ga[1]; ga[0] = (f32x4){0.f, 0.f, 0.f, 0.f};
          { const bf16* ap = wsp<bf16>(F, WS_HB) + ((size_t)b * T + t0 + l16) * 1024 + g4 * 8; const bf16* bp = wsp<bf16>(F, WS_WG) + (size_t)(l * 2 + hkv) * 16384 + ln_ * 8;
#pragma unroll 1
            for (int k0 = 0; k0 < (VAR == 11 ? 0 : 1024); k0 += 256) {
                bf16x8 av[8], bv[8];
#pragma unroll
                for (int i = 0; i < 8; ++i) { av[i] = *(const bf16x8*)(ap + k0 + 32 * i); bv[i] = *(const bf16x8*)(bp + (k0 + 32 * i) * 16); }
#pragma unroll
                for (int i = 0; i < 8; ++i) ga[0] = mfma16(av[i], bv[i], ga[0]);
            } }
          const float rs = (ln_ < 16) ? row_rstd_full(wsp<float>(F, WS_SSQ), b * T + t0 + ln_) : 0.f;
#pragma unroll
          for (int r = 0; r < 4; ++r) GL[(g4 * 4 + r) * 16 + l16] = sigmoidf_(ga[0][r] * __shfl(rs, g4 * 4 + r));
        }
        const int ngc = (VAR == 10) ? 0 : (t0 + 15 >= 31) ? (((t0 + 15 - 31) >> 4) >> 5) + 1 : 0;
        const bf16* kcb = KCC + (size_t)bh * 512 * 64; const bf16* vcb = VCT + (size_t)bh * 16 * 64 * 32;
        float cm[4], cl[4];
#pragma unroll
        for (int ct = 0; ct < 4; ++ct) { cm[ct] = -INFINITY; cl[ct] = 0.f; }
        pipe_run<1, false>(ngc, ln_, [&](int s, const bf16*& kb, const bf16*& vb) { kb = kcb + (size_t)s * 32 * 64; vb = vcb; },
            [&](int kg, const bf16x8 (&kf)[2][2], const bf16x8 (&)[4]) {
#pragma unroll
                for (int ct = 0; ct < 4; ++ct) {
                    const int tl = tl0 + 4 * ct;
                    f32x4 s[2]; qk_tile(kf, qf[ct], s);
                    float sv[2][4]; float tmax = -INFINITY;
#pragma unroll
                    for (int tt = 0; tt < 2; ++tt)
#pragma unroll
                        for (int r = 0; r < 4; ++r) { const int c = kg * 32 + 16 * tt + 4 * g4 + r; sv[tt][r] = (16 * c + 31 <= tl) ? s[tt][r] : -INFINITY; tmax = fmaxf(tmax, sv[tt][r]); }
                    tmax = fmaxf(tmax, __shfl_xor(tmax, 16)); tmax = fmaxf(tmax, __shfl_xor(tmax, 32));
                    const float mnew = fmaxf(cm[ct], tmax), muse = (mnew == -INFINITY) ? 0.f : mnew;
                    float ps = 0.f;
#pragma unroll
                    for (int tt = 0; tt < 2; ++tt)
#pragma unroll
                        for (int r = 0; r < 4; ++r) ps += ex2(sv[tt][r] - muse);
                    cl[ct] = cl[ct] * ex2(cm[ct] - muse) + ps; cm[ct] = mnew;
                }
            });
        {
            float cmu[4], cinv[4], carry[4];
#pragma unroll
            for (int ct = 0; ct < 4; ++ct) { float l = cl[ct]; l += __shfl_xor(l, 16); l += __shfl_xor(l, 32);
                cmu[ct] = (cm[ct] == -INFINITY) ? 0.f : cm[ct]; cinv[ct] = l > 0.f ? 1.0f / l : 0.f; carry[ct] = 0.f; sm_reset(st[ct]); }
            pipe_run<1, true>(ngc, ln_, [&](int s, const bf16*& kb, const bf16*& vb) { kb = kcb + (size_t)s * 32 * 64; vb = vcb + (size_t)s * 64 * 32; },
                [&](int kg, const bf16x8 (&kf)[2][2], const bf16x8 (&vf)[4]) {
#pragma unroll
                    for (int ct = 0; ct < 4; ++ct) {
                        const int tl = tl0 + 4 * ct;
                        f32x4 s[2]; qk_tile(kf, qf[ct], s);
                        float p[2][4];
#pragma unroll
                        for (int tt = 0; tt < 2; ++tt) {
#pragma unroll
                            for (int r = 0; r < 4; ++r) { const int c = kg * 32 + 16 * tt + 4 * g4 + r; p[tt][r] = (16 * c + 31 <= tl) ? ex2(s[tt][r] - cmu[ct]) * cinv[ct] : 0.f; }
                            const float hb = 0.5f * p[tt][3];
                            const float bsh = __shfl(hb, (ln_ + 48) & 63);
                            float v = ((p[tt][0] + p[tt][1]) + (p[tt][2] + hb)) + ((g4 == 0) ? carry[ct] : bsh);
                            carry[ct] = bsh;
                            v += __shfl_xor(v, 1); v += __shfl_xor(v, 2);
                            if (gh == 0) IMP[(4 * ct + tq) * 128 + kg * 8 + 4 * tt + g4] = v;
                        }
                        const bf16x8 pf = pack_p(p);
#pragma unroll
                        for (int dt = 0; dt < 4; ++dt) st[ct].o[dt] = mfma16(vf[dt], pf, st[ct].o[dt]);
                    }
                });
#pragma unroll
            for (int ct = 0; ct < 4; ++ct) acc_add_packed(opk, ct, st[ct].o, GL[(4 * ct + tq) * 16 + gh * 3 + 0], true);
        }
        }
        LDS_WAIT();
        unsigned sb0 = 0u, sb1 = 0u;
        if (cur < 16) { sb0 = (lane <= cur) ? 0xffffu : 0u; }
        else if (VAR == 6) {
#pragma unroll 1
            for (int q = 0; q < 16; ++q) { const bool s0 = (lane <= cur) && ((lane * 37 + q * 11) % (cur + 1)) < 16, s1 = (lane + 64 <= cur) && (((lane + 64) * 37 + q * 11) % (cur + 1)) < 16;
                sb0 |= (s0 ? 1u : 0u) << q; sb1 |= (s1 ? 1u : 0u) << q; }
        }
        else {
            const unsigned long long below = (1ull << lane) - 1ull;
#pragma unroll 1
            for (int q = 0; q < 16; ++q) {
                unsigned k0, k1;
                { const int j = lane; const float v = (j == 0 || j == cur || j == cur - 1) ? 1e6f : IMP[q * 128 + j]; k0 = (j > cur) ? 0u : __builtin_bit_cast(unsigned, v) + 1u; }
                { const int j = lane + 64; const float v = (j == cur || j == cur - 1) ? 1e6f : IMP[q * 128 + j]; k1 = (j > cur) ? 0u : __builtin_bit_cast(unsigned, v) + 1u; }
                unsigned lo = 0u, hi = 0xffffffffu;
                while (hi - lo > 1u) { const unsigned mid = lo + ((hi - lo) >> 1);
                    const int c = __builtin_popcountll(__ballot(k0 >= mid)) + __builtin_popcountll(__ballot(k1 >= mid));
                    if (c >= 16) lo = mid; else hi = mid; }
                const unsigned long long g0 = __ballot(k0 > lo), g1 = __ballot(k1 > lo), e0 = __ballot(k0 == lo), e1 = __ballot(k1 == lo);
                const int need = 16 - __builtin_popcountll(g0) - __builtin_popcountll(g1);
                const bool s0 = (k0 > lo) || (k0 == lo && __builtin_popcountll(e0 & below) < need);
                const bool s1 = (k1 > lo) || (k1 == lo && __builtin_popcountll(e0) + __builtin_popcountll(e1 & below) < need);
                sb0 |= (s0 ? 1u : 0u) << q; sb1 |= (s1 ? 1u : 0u) << q;
            }
        }
        SELB[lane] = sb0; SELB[lane + 64] = sb1;
        LDS_WAIT();
#define NSA_PARK() do { _Pragma("unroll") for (int i_ = 0; i_ < 8; ++i_) { v4u w_; w_.x = opk[i_ >> 1][(i_ & 1) * 2][0]; w_.y = opk[i_ >> 1][(i_ & 1) * 2][1]; w_.z = opk[i_ >> 1][(i_ & 1) * 2 + 1][0]; w_.w = opk[i_ >> 1][(i_ & 1) * 2 + 1][1]; ((v4u*)IMP)[i_ * 64 + lane] = w_; } } while (0)
#define NSA_UNPARK() do { _Pragma("unroll") for (int i_ = 0; i_ < 8; ++i_) { const v4u w_ = ((const v4u*)IMP)[i_ * 64 + lane]; opk[i_ >> 1][(i_ & 1) * 2][0] = w_.x; opk[i_ >> 1][(i_ & 1) * 2][1] = w_.y; opk[i_ >> 1][(i_ & 1) * 2 + 1][0] = w_.z; opk[i_ >> 1][(i_ & 1) * 2 + 1][1] = w_.w; } } while (0)
        NSA_PARK();
        { NSA_RELANE();
#pragma unroll
        for (int ct = 0; ct < 4; ++ct) {
            const float* rp = wsp<float>(F, WS_ROPE) + ((size_t)(tl0 + 4 * ct) * 32 + g4 * 8) * 2;
            const v4u a = __builtin_bit_cast(v4u, qf[ct][0]), b2 = __builtin_bit_cast(v4u, qf[ct][1]); v4u ra, rb;
#pragma unroll
            for (int jj = 0; jj < 4; ++jj) { const f32x4 cs = *(const f32x4*)(rp + 4 * jj);
                const float x1a = bflo(a[jj]), x1b = bfhi(a[jj]), x2a = bflo(b2[jj]), x2b = bfhi(b2[jj]);
                ra[jj] = pk2(x1a * cs[0] - x2a * cs[1], x1b * cs[2] - x2b * cs[3]);
                rb[jj] = pk2(x2a * cs[0] + x1a * cs[1], x2b * cs[2] + x1b * cs[3]); }
            qf[ct][0] = __builtin_bit_cast(bf16x8, ra); qf[ct][1] = __builtin_bit_cast(bf16x8, rb);
        }
        {
            const unsigned long long ulo = __ballot(sb0 != 0u), uhi = __ballot(sb1 != 0u);
            const unsigned long long below = (1ull << ln_) - 1ull;
            const int nlo = __builtin_popcountll(ulo), nblk = nlo + __builtin_popcountll(uhi);
            if (sb0 != 0u) BL[__builtin_popcountll(ulo & below)] = ln_;
            if (sb1 != 0u) BL[nlo + __builtin_popcountll(uhi & below)] = ln_ + 64;
            LDS_WAIT();
#pragma unroll
            for (int ct = 0; ct < 4; ++ct) sm_reset(st[ct]);
            const bf16* kb0 = KS + (size_t)bh * T * 64; const bf16* vb0 = VST + (size_t)bh * 256 * 64 * 32;
            float mr; bool fixed;
            { const float kmx = sqrtf(__builtin_bit_cast(float, __hip_atomic_load((const unsigned*)F.ctl + CW_KMAX + l * 16 + bh, RLX_AGENT))); float mm = 0.f;
#pragma unroll
              for (int ct = 0; ct < 4; ++ct) mm = fmaxf(mm, col_norm(qf[ct]));
              qnmax = wave_max_uniform(mm); mr = qnmax * kmx * 1.002f + 1e-3f;
              fixed = mr < FIXED_REF_MAX; }
            auto addr_sel = [&](int s, const bf16*& kb, const bf16*& vb) { const int g32 = (VAR == 7) ? (s & 1) : BL[s >> 1] * 2 + (s & 1); kb = kb0 + (size_t)g32 * 32 * 64; vb = vb0 + (size_t)g32 * 64 * 32; };
            asm volatile("" ::: "memory");
            if (!fixed) {
                float mx[4] = {-INFINITY, -INFINITY, -INFINITY, -INFINITY};
                pipe_run<1, false>(2 * nblk, ln_, addr_sel,
                    [&](int s, const bf16x8 (&kf)[2][2], const bf16x8 (&)[4]) {
                        const int j = BL[s >> 1], key0 = j * 64 + (s & 1) * 32;
                        const unsigned tm = (unsigned)__builtin_amdgcn_readfirstlane((int)SELB[j]);
#pragma unroll
                        for (int ct = 0; ct < 4; ++ct) { const unsigned tmk = (tm >> (4 * ct)) & 0xFu;
                            if (tmk) { const bool colok = (tmk >> tq) & 1u; const int tl = tl0 + 4 * ct;
                                if (j == cur) attn_max<2>(kf, qf[ct], mx[ct], ln_, true, [&](int kk) { return colok && (key0 + kk <= tl); });
                                else attn_max<1>(kf, qf[ct], mx[ct], ln_, colok, NoMask()); } }
                    });
                mr = wave_max_uniform(fmaxf(fmaxf(mx[0], mx[1]), fmaxf(mx[2], mx[3]))); if (mr == -INFINITY) mr = 0.f;
            }
            asm volatile("" ::: "memory");
            if (VAR != 4)
            pipe_run_mt(2 * nblk - 2, 2, ln_, addr_sel,
                [&](int s, const bf16x8 (&kf)[2][2], const bf16x8 (&vf)[4]) {
                    const int j = BL[s >> 1];
                    const unsigned tm = (unsigned)__builtin_amdgcn_readfirstlane((int)SELB[j]);
#pragma unroll
                    for (int ct = 0; ct < 4; ++ct) {
                        const unsigned tmk = (tm >> (4 * ct)) & 0xFu;
                        if (tmk) attn_compute_fixed<1>(kf, vf, qf[ct], st[ct], mr, ln_, (tmk >> tq) & 1u, NoMask());
                    }
                },
                [&](int s, const bf16x8 (&kf)[2][2], const bf16x8 (&vf)[4]) {
                    const int key0 = cur * 64 + (s & 1) * 32;
#pragma unroll
                    for (int ct = 0; ct < 4; ++ct) { const int tl = tl0 + 4 * ct;
                        attn_compute_fixed<2>(kf, vf, qf[ct], st[ct], mr, ln_, true, [&](int kk) { return key0 + kk <= tl; }); }
                });
            LDS_WAIT();
            NSA_UNPARK();
#pragma unroll
            for (int ct = 0; ct < 4; ++ct) { const float ls = sm_lsum(st[ct]); const float gs = GL[(4 * ct + tq) * 16 + gh * 3 + 1];
                acc_add_packed(opk, ct, st[ct].o, ls > 0.f ? gs / ls : 0.f, false); }
            NSA_PARK();
        }
        }
        { NSA_RELANE();
#pragma unroll
            for (int ct = 0; ct < 4; ++ct) sm_reset(st[ct]);
            const bf16* kb0 = (VAR == 3 ? KS : KW) + (size_t)bh * T * 64; const bf16* vb0 = (VAR == 3 ? VST : VWT) + (size_t)bh * 256 * 64 * 32;
            const int glo = (t0 - 511 > 0 ? t0 - 511 : 0) >> 5, ghi = (t0 + 15) >> 5;
            float mr; bool fixed;
            { const float kmx = sqrtf(__builtin_bit_cast(float, __hip_atomic_load((const unsigned*)F.ctl + CW_KMAX + l * 16 + 8 + bh, RLX_AGENT)));
              mr = qnmax * kmx * 1.002f + 1e-3f;
              fixed = mr < FIXED_REF_MAX; }
            auto addr_win = [&](int s, const bf16*& kb, const bf16*& vb) { kb = kb0 + (size_t)(glo + s) * 32 * 64; vb = vb0 + (size_t)(glo + s) * 64 * 32; };
            asm volatile("" ::: "memory");
            if (!fixed) {
                float mx[4] = {-INFINITY, -INFINITY, -INFINITY, -INFINITY};
                pipe_run<1, false>(ghi - glo + 1, ln_, addr_win,
                    [&](int s, const bf16x8 (&kf)[2][2], const bf16x8 (&)[4]) {
                        const int key0 = (glo + s) * 32;
#pragma unroll
                        for (int ct = 0; ct < 4; ++ct) { const int tl = tl0 + 4 * ct;
                            attn_max<2>(kf, qf[ct], mx[ct], ln_, true, [&](int kk) { const int kp = key0 + kk; return kp <= tl && kp + 512 > tl; }); }
                    });
                mr = wave_max_uniform(fmaxf(fmaxf(mx[0], mx[1]), fmaxf(mx[2], mx[3]))); if (mr == -INFINITY) mr = 0.f;
            }
            asm volatile("" ::: "memory");
            const int g_a = (t0 >= 497) ? ((t0 - 497) >> 5) + 1 : 0, g_b = (t0 - 31) >> 5;
            const int n_main = g_b >= g_a ? g_b - g_a + 1 : 0, n_up = ghi - (g_b >= g_a ? g_b : g_a - 1), n_tail = n_up + (g_a - glo);
            auto grp = [&](int s) { const int u = s - n_main; return s < n_main ? g_a + s : (u < n_up ? ghi - n_up + 1 + u : glo + (u - n_up)); };
            auto addr_w2 = [&](int s, const bf16*& kb, const bf16*& vb) { const int g = grp(s); kb = kb0 + (size_t)g * 32 * 64; vb = vb0 + (size_t)g * 64 * 32; };
            if (VAR != 5)
            pipe_run_mt(n_main, n_tail, ln_, addr_w2,
                [&](int, const bf16x8 (&kf)[2][2], const bf16x8 (&vf)[4]) {
#pragma unroll
                    for (int ct = 0; ct < 4; ++ct) attn_compute_fixed<0>(kf, vf, qf[ct], st[ct], mr, ln_, true, NoMask());
                },
                [&](int s, const bf16x8 (&kf)[2][2], const bf16x8 (&vf)[4]) {
                    const int key0 = grp(s) * 32;
#pragma unroll
                    for (int ct = 0; ct < 4; ++ct) {
                        const int tlo = t0 + 4 * ct, thi = tlo + 3, tl = tl0 + 4 * ct;
                        if (key0 > thi || key0 + 31 + 512 <= tlo) continue;
                        attn_compute_fixed<2>(kf, vf, qf[ct], st[ct], mr, ln_, true, [&](int kk) { const int kp = key0 + kk; return kp <= tl && kp + 512 > tl; });
                    }
                });
            NSA_UNPARK();
#pragma unroll
            for (int ct = 0; ct < 4; ++ct) { const float ls = sm_lsum(st[ct]); const float gwn = GL[(4 * ct + tq) * 16 + gh * 3 + 2];
                acc_add_packed(opk, ct, st[ct].o, ls > 0.f ? gwn / ls : 0.f, false); }
        }
        { NSA_RELANE();
#pragma unroll
        for (int ct = 0; ct < 4; ++ct)
#pragma unroll
            for (int dt = 0; dt < 4; ++dt) { v2u w; w.x = opk[ct][dt][0]; w.y = opk[ct][dt][1];
                if (VAR == 0 || w.x == 0x7fc17fc1u) *(v2u*)(CAT + (mrow0 + 4 * ct) * 1024 + hkv * 256 + gh * 64 + dt * 16 + g4 * 4) = w; }
        }
        LDS_WAIT();
        if (VAR == 0 && xmap) convert_experts(F, l, (bf16*)IMP, task >> 11);
    }
#undef NSA_RELANE
#undef NSA_PARK
#undef NSA_UNPARK
}

DEV void nsa_phase(Frame& F, int l) { nsa_phase_t<0>(F, l); }

DEV void cross_phase(Frame& F, int l) {
    const int lane = F.lane, l16 = lane & 15, g4 = lane >> 4;
    const bf16* XQ = wsp<bf16>(F, WS_XQ); bf16* XO = wsp<bf16>(F, WS_XO);
    const int gw = F.vcu * NWAVES + F.wave, NGW = F.G * NWAVES;
#pragma unroll 1
    for (int task = gw; task < 2048; task += NGW) {
        const int head = task & 3, m0 = (task >> 2) * 64, b = m0 >> 13;
        bf16x8 qf[4][2];
#pragma unroll
        for (int ct = 0; ct < 4; ++ct)
#pragma unroll
            for (int ks = 0; ks < 2; ++ks) qf[ct][ks] = *(const bf16x8*)(XQ + (size_t)(m0 + 16 * ct + l16) * 256 + head * 64 + ks * 32 + g4 * 8);
        const bf16* kb0 = wsp<bf16>(F, WS_MK) + (size_t)((l * 4 + b) * 4 + head) * 256 * 64;
        const bf16* vb0 = wsp<bf16>(F, WS_MVT) + (size_t)((l * 4 + b) * 4 + head) * 8 * 64 * 32;
        SmState st[4];
#pragma unroll
        for (int ct = 0; ct < 4; ++ct) sm_reset(st[ct]);
        pipe_run<PIPE_D, true>(8, lane, [&](int s, const bf16*& kb, const bf16*& vb) { kb = kb0 + (size_t)s * 32 * 64; vb = vb0 + (size_t)s * 64 * 32; },
            [&](int, const bf16x8 (&kf)[2][2], const bf16x8 (&vf)[4]) {
#pragma unroll
                for (int ct = 0; ct < 4; ++ct) attn_compute<0>(kf, vf, qf[ct], st[ct], lane, true, NoMask());
            });
#pragma unroll
        for (int ct = 0; ct < 4; ++ct) {
            const float inv = 1.0f / sm_lsum(st[ct]);
#pragma unroll
            for (int dt = 0; dt < 4; ++dt) { const f32x4 o = st[ct].o[dt] * inv; v2u w; w.x = pk2(o[0], o[1]); w.y = pk2(o[2], o[3]);
                *(v2u*)(XO + (size_t)(m0 + 16 * ct + l16) * 256 + head * 64 + dt * 16 + g4 * 4) = w; }
        }
    }
}


DEV void router_phase(Frame& F, int l, int probe = 0) {
    const int lane = F.lane, l16 = lane & 15, g4 = lane >> 4;
    float* LG = (float*)F.ldsg + F.wave * 768;
    const bf16* HB = wsp<bf16>(F, WS_HB); const float* SSQ = wsp<float>(F, WS_SSQ);
    const bf16* WR = wsp<bf16>(F, WS_WR) + (size_t)l * 96 * 1024;
    int* TOKE = wsp<int>(F, probe ? WS_PROBE : WS_TOKE); float* TOKG = wsp<float>(F, probe ? WS_PROBE + MiB : WS_TOKG); int* TOKP = wsp<int>(F, probe ? WS_PROBE + 2 * MiB : WS_TOKP);
    unsigned* CNT = (unsigned*)F.ctl + CW_CNT + l * 32 + (probe ? 64 : 0);
    const float* bg = inp(14) + l * 4; const float* be = inp(16) + l * 32;
    unsigned* HIST = (unsigned*)((float*)F.ldsg + 8 * 768);
#pragma unroll 1
    for (int tb = F.vcu * NWAVES; tb < NTOK / 16; tb += F.G * NWAVES) {
        const int task = tb + F.wave; const bool live = task < NTOK / 16;
        const int m0 = (live ? task : tb) * 16;
        if (F.tid < 64) HIST[F.tid] = 0u;
        f32x4 acc[3];
        {
            const bf16* ap = HB + (size_t)(m0 + l16) * 1024 + g4 * 8; const bf16* bp = WR + lane * 8;
#pragma unroll
            for (int n = 0; n < 3; ++n) acc[n] = (f32x4){0.f, 0.f, 0.f, 0.f};
#pragma unroll 4
            for (int k = 0; k < 1024; k += 32) {
                const bf16x8 a = *(const bf16x8*)(ap + k);
#pragma unroll
                for (int n = 0; n < 3; ++n) { const bf16x8 bh = *(const bf16x8*)(bp + ((k >> 5) * 6 + n * 2) * 512), bl = *(const bf16x8*)(bp + ((k >> 5) * 6 + n * 2 + 1) * 512);
                    acc[n] = mfma16(a, bh, acc[n]); acc[n] = mfma16(a, bl, acc[n]); }
            }
        }
#pragma unroll
        for (int nt = 0; nt < 3; ++nt)
#pragma unroll
            for (int r = 0; r < 4; ++r) LG[(g4 * 4 + r) * 48 + nt * 16 + l16] = acc[nt][r];
        LDS_WAIT();
        int id1 = 0, id2 = 0;
        if (lane < 16) {
            const int m = m0 + lane; const float rstd = row_rstd_full(SSQ, m); const float* lg = LG + lane * 48;
            float g[4];
#pragma unroll
            for (int j = 0; j < 4; ++j) g[j] = lg[j] * rstd + bg[j];
            float gmax = g[0]; int grp = 0;
#pragma unroll
            for (int j = 1; j < 4; ++j) if (g[j] > gmax) { gmax = g[j]; grp = j; }
            float den = 0.f;
#pragma unroll
            for (int j = 0; j < 4; ++j) den += expf(g[j] - gmax);
            const float psel = 1.0f / den;
            float e1 = -INFINITY, e2 = -INFINITY; int i1 = 0, i2 = 0;
            for (int j = 0; j < 8; ++j) { const float v = lg[4 + grp * 8 + j] * rstd + be[grp * 8 + j];
                if (v > e1) { e2 = e1; i2 = i1; e1 = v; i1 = j; } else if (v > e2) { e2 = v; i2 = j; } }
            const float x = expf(e2 - e1), w1 = 1.0f / (1.0f + x), w2 = x * w1;
            id1 = grp * 8 + i1; id2 = grp * 8 + i2;
            if (live) { TOKE[m * 2] = id1; TOKE[m * 2 + 1] = id2; TOKG[m * 2] = psel * w1; TOKG[m * 2 + 1] = psel * w2; }
        }
        __syncthreads();
        unsigned lp1 = 0u, lp2 = 0u;
        if (lane < 16 && live) { lp1 = __hip_atomic_fetch_add(HIST + id1, 1u, __ATOMIC_RELAXED, __HIP_MEMORY_SCOPE_WORKGROUP); lp2 = __hip_atomic_fetch_add(HIST + id2, 1u, __ATOMIC_RELAXED, __HIP_MEMORY_SCOPE_WORKGROUP); }
        __syncthreads();
        if (F.tid < 32) { const unsigned c = HIST[F.tid]; HIST[32 + F.tid] = c ? __hip_atomic_fetch_add(CNT + F.tid, c, RLX_AGENT) : 0u; }
        __syncthreads();
        if (lane < 16 && live) { const int m = m0 + lane; TOKP[m * 2] = (int)(HIST[32 + id1] + lp1); TOKP[m * 2 + 1] = (int)(HIST[32 + id2] + lp2); }
        __syncthreads();
    }
}
DEV int moe_tables(Frame& F, int l) {
    int* tab = (int*)(F.ldsg + TAB_OFF);
    if (F.tid == 0) {
        const unsigned* CNT = (const unsigned*)F.ctl + CW_CNT + l * 32; int off = 0;
#pragma unroll 1
        for (int e = 0; e < 32; ++e) { tab[e] = off; const int c = (int)__hip_atomic_load(CNT + e, RLX_AGENT); const int nt = (c + 255) >> 8;
            for (int i = 0; i < nt; ++i) tab[40 + (off >> 8) + i] = e;
            off += nt << 8; }
        tab[32] = off;
    }
    __syncthreads();
    return tab[32];
}
DEV void gather_phase(Frame& F, int l) {
    (void)moe_tables(F, l);
    const int* tab = (const int*)(F.ldsg + TAB_OFF);
    const int lane = F.lane; const int gw = F.vcu * NWAVES + F.wave, NGW = F.G * NWAVES;
    const bf16* HB = wsp<bf16>(F, WS_HB); const float* SSQ = wsp<float>(F, WS_SSQ); bf16* XS = wsp<bf16>(F, WS_XS);
    const int* TOKE = wsp<int>(F, WS_TOKE); const float* TOKG = wsp<float>(F, WS_TOKG); const int* TOKP = wsp<int>(F, WS_TOKP); int* TOKS = wsp<int>(F, WS_TOKS);
    float* SRSTD = wsp<float>(F, WS_SRSTD); float* SGATE = wsp<float>(F, WS_SGATE);
    const unsigned* CNT = (const unsigned*)F.ctl + CW_CNT + l * 32;
#pragma unroll 1
    for (int m0 = gw; m0 < NTOK; m0 += 4 * NGW) {
        int s0[4], s1[4]; float g0[4], g1[4], rs[4]; v4u a[4], c[4];
#pragma unroll
        for (int k = 0; k < 4; ++k) { const int m = m0 + k * NGW; const bool ok = m < NTOK; const int mm = ok ? m : m0;
            const int e0 = TOKE[mm * 2], e1 = TOKE[mm * 2 + 1], p0 = TOKP[mm * 2], p1 = TOKP[mm * 2 + 1];
            g0[k] = TOKG[mm * 2]; g1[k] = TOKG[mm * 2 + 1];
            a[k] = *(const v4u*)(HB + (size_t)mm * 1024 + lane * 8); c[k] = *(const v4u*)(HB + (size_t)mm * 1024 + 512 + lane * 8);
            rs[k] = row_rstd_full(SSQ, mm);
            s0[k] = tab[e0] + p0; s1[k] = tab[e1] + p1; }
#pragma unroll
        for (int k = 0; k < 4; ++k) { const int m = m0 + k * NGW;
            if (m < NTOK) {
                *(v4u*)(XS + (size_t)s0[k] * 1024 + lane * 8) = a[k]; *(v4u*)(XS + (size_t)s0[k] * 1024 + 512 + lane * 8) = c[k];
                *(v4u*)(XS + (size_t)s1[k] * 1024 + lane * 8) = a[k]; *(v4u*)(XS + (size_t)s1[k] * 1024 + 512 + lane * 8) = c[k];
                if (lane == 0) { SRSTD[s0[k]] = rs[k]; SRSTD[s1[k]] = rs[k]; SGATE[s0[k]] = g0[k]; SGATE[s1[k]] = g1[k]; TOKS[m * 2] = s0[k]; TOKS[m * 2 + 1] = s1[k]; } } }
    }
#pragma unroll 1
    for (int e = 0; e < 32; ++e) {
        const int c = (int)__hip_atomic_load(CNT + e, RLX_AGENT), base = tab[e], end = (e == 31 ? tab[32] : tab[e + 1]);
        for (int r = base + c + gw; r < end; r += NGW) {
            *(v4u*)(XS + (size_t)r * 1024 + lane * 8) = (v4u){0u, 0u, 0u, 0u}; *(v4u*)(XS + (size_t)r * 1024 + 512 + lane * 8) = (v4u){0u, 0u, 0u, 0u};
            if (lane == 0) { SRSTD[r] = 0.f; SGATE[r] = 0.f; }
        }
    }
}
DEV void combine_phase(Frame& F, int l, int probe = 0) {
    const int lane = F.lane; const int gw = F.vcu * NWAVES + F.wave, NGW = F.G * NWAVES;
    float* Ho = probe ? wsp<float>(F, WS_PROBE) : (float*)(GAS float*)F.out; const bf16* HBi = wsp<bf16>(F, WS_HB); bf16* HB = wsp<bf16>(F, probe ? WS_PROBE + 128 * MiB : WS_HB); float* SSQ = wsp<float>(F, probe ? WS_PROBE + 192 * MiB : WS_SSQ); const bf16* YS = wsp<bf16>(F, WS_YS); const int* TOKS = wsp<int>(F, WS_TOKS);
    const float* gf = inp(23);
#pragma unroll 1
    for (int m0 = gw; m0 < NTOK; m0 += 2 * NGW) {
        f32x4 v[2][4]; float ssum[2];
        int sl[2][2];
#pragma unroll
        for (int k = 0; k < 2; ++k) { const int m = (m0 + k * NGW < NTOK) ? m0 + k * NGW : m0; sl[k][0] = TOKS[m * 2]; sl[k][1] = TOKS[m * 2 + 1]; }
        v2u h[2][4]; v2u ya[2][4], yb[2][4];
#pragma unroll
        for (int k = 0; k < 2; ++k) { const int m = (m0 + k * NGW < NTOK) ? m0 + k * NGW : m0;
#pragma unroll
            for (int j = 0; j < 4; ++j) { const int c = lane * 4 + 256 * j;
                h[k][j] = *(const v2u*)(HBi + (size_t)m * 1024 + c);
                ya[k][j] = *(const v2u*)(YS + (size_t)sl[k][0] * 1024 + c); yb[k][j] = *(const v2u*)(YS + (size_t)sl[k][1] * 1024 + c); } }
#pragma unroll
        for (int k = 0; k < 2; ++k) { float ss = 0.f;
#pragma unroll
            for (int j = 0; j < 4; ++j) { const v2u a = ya[k][j], bq = yb[k][j]; const f32x4 hh = (f32x4){bflo(h[k][j].x), bfhi(h[k][j].x), bflo(h[k][j].y), bfhi(h[k][j].y)};
                f32x4 r; r[0] = hh[0] + (bflo(a.x) + bflo(bq.x)); r[1] = hh[1] + (bfhi(a.x) + bfhi(bq.x)); r[2] = hh[2] + (bflo(a.y) + bflo(bq.y)); r[3] = hh[3] + (bfhi(a.y) + bfhi(bq.y));
                v[k][j] = r; ss += (r[0] * r[0] + r[1] * r[1]) + (r[2] * r[2] + r[3] * r[3]); }
            ssum[k] = wave_sum(ss); }
#pragma unroll
        for (int k = 0; k < 2; ++k) { const int m = m0 + k * NGW;
            if (m < NTOK) {
                if (l == DEPTH - 1) {
                    const float rstd = 1.0f / sqrtf(ssum[k] * (1.0f / 1024.0f) + RMS_EPS);
#pragma unroll
                    for (int j = 0; j < 4; ++j) { const int c = lane * 4 + 256 * j; const f32x4 g = *(const f32x4*)(gf + c); *(f32x4*)(Ho + (size_t)m * 1024 + c) = v[k][j] * rstd * g; }
                } else {
#pragma unroll
                    for (int j = 0; j < 4; ++j) { const int c = lane * 4 + 256 * j;
                        v2u w; w.x = pk2(v[k][j][0], v[k][j][1]); w.y = pk2(v[k][j][2], v[k][j][3]); *(v2u*)(HB + (size_t)m * 1024 + c) = w; }
                    if (lane < 16) SSQ[(size_t)m * 16 + lane] = lane == 0 ? ssum[k] : 0.f;
                } } }
    }
}
#ifndef MK_ONE_LAUNCH
#define MK_ONE_LAUNCH 1
#endif
constexpr int NPH_LAYER = 13, NPHASES = 1 + DEPTH * NPH_LAYER;
struct Args { const float* in[24]; float* out; unsigned char* ws; int ph_lo, ph_hi; };
static_assert(sizeof(Args) == 24 * 8 + 8 + 8 + 8, "Args has no padding");

__global__ void __launch_bounds__(NWAVES * 64, 2) hymba_fwd(Args args) {
    extern __shared__ __attribute__((aligned(16))) unsigned char lds[];
    Frame F;
    F.lds = (LAS unsigned char*)lds; F.ldsg = lds;
    F.MISC = (volatile LAS unsigned*)(F.lds + MISC_OFF);
    F.tid = threadIdx.x; F.lane = F.tid & 63; F.wave = __builtin_amdgcn_readfirstlane(F.tid >> 6);
    F.G = gridDim.x; { const int bx = blockIdx.x; F.vcu = (F.G % 8 == 0) ? (bx % 8) * (F.G / 8) + bx / 8 : bx; }
    F.ws = args.ws; F.ctl = (gu32*)(args.ws + WS_CTL); F.out = args.out;
    if (F.tid < 64) ((LAS unsigned*)(F.lds + MISC_OFF))[F.tid] = 0u;
    __syncthreads();
    int wave0 = F.wave;
    const int lo = args.ph_lo, hi = args.ph_hi;
    XcdBarrier bar; bar.bar = (unsigned*)(F.ctl + CW_BAR); bar.x = 0; bar.st = nullptr;
    if (hi - lo > 1) bar = xcd_barrier_post((unsigned*)(F.ctl + CW_BAR), F.MISC + 8);
#ifndef PHMASK
#define PHMASK 0xFFFF
#endif
#define IN(k) (lo <= (k) && (k) < hi)
#define EN(j) ((PHMASK >> (j)) & 1)
#define RELAUNDER() do { asm volatile("" : "+s"(wave0)); unsigned z_ = 0u; asm volatile("" : "+v"(z_)); int t_ = wave0 * 64 + (int)__builtin_amdgcn_mbcnt_hi(~0u, __builtin_amdgcn_mbcnt_lo(~0u, z_)); F.tid = t_; F.lane = t_ & 63; F.wave = wave0; \
    size_t zo_ = 0; asm volatile("" : "+s"(zo_), "+s"(F.vcu), "+s"(F.G)); F.ws = args.ws + zo_; F.out = args.out + zo_; F.ctl = (gu32*)(F.ws + WS_CTL); } while (0)
#ifndef NSA_VAR
#define NSA_VAR 0
#endif
#ifndef BAR2X
#define BAR2X 0
#endif
#ifndef DUPMASK
#define DUPMASK 0
#endif
#define DUP(j) ((DUPMASK >> (j)) & 1)
#ifndef STAG_J0
#define STAG_J0 0
#endif
#ifndef STAG_MOE
#define STAG_MOE 0
#endif
#define STAGGER(ticks) do { if ((ticks) > 0 && (F.vcu & 1)) { const unsigned long long t0_ = __builtin_amdgcn_s_memrealtime(); while (__builtin_amdgcn_s_memrealtime() - t0_ < (unsigned long long)(ticks)) __builtin_amdgcn_s_sleep(32); } } while (0)
#define SEAM(k) do { if (IN(k) && IN((k) + 1)) { XcdBarrier b_ = bar; size_t zb_ = 0; asm volatile("" : "+s"(b_.x), "+s"(zb_)); b_.bar = (unsigned*)(args.ws + WS_CTL + zb_) + CW_BAR; xcd_barrier(b_); if (BAR2X) xcd_barrier(b_); } } while (0)

    if (IN(0) && EN(13)) { RELAUNDER(); p0_prologue(F); if (DUP(13)) { __syncthreads(); p0_prologue(F); } } SEAM(0);

#pragma unroll 1
    for (int l = 0; l < DEPTH; ++l) {
        const int pb = 1 + l * NPH_LAYER;
        bf16* HB = wsp<bf16>(F, WS_HB); float* SSQ = wsp<float>(F, WS_SSQ);
        if (IN(pb + 0) && EN(0)) for (int rep_ = 0; rep_ < (DUP(0) ? 2 : 1); ++rep_) { RELAUNDER(); if (rep_) __syncthreads();
            pg8::Gemm g{HB, wsp<bf16>(F, WS_WIN) + (size_t)l * NIN * 1024, NTOK, 3072, D};
            pg8::StaticOrder S; S.init(NTOK, 3072, F.G, (int)blockIdx.x);
            EpiIn E{F.ws};
            STAGGER(STAG_J0);
            pg8::gemm_phase<EpiIn, pg8::StaticOrder, true, true>(F.lds, g, S, E, F.wave);
        }
        SEAM(pb + 0);
        if (IN(pb + 1) && EN(1)) { RELAUNDER();
            compress_phase(F, l);
            hgrn_local_phase(F, l);
            conv_phase(F, l);
            kmax_phase(F, l);
            if (l == 0) memkv_phase(F);
            if (DUP(1)) { __syncthreads(); compress_phase(F, l); hgrn_local_phase(F, l); conv_phase(F, l); }
        }
        SEAM(pb + 1);
        if (IN(pb + 2) && EN(2)) { RELAUNDER(); hgrn_scan_phase(F); if (DUP(14)) hgrn_scan_phase(F, 1); nsa_phase(F, l); if (DUP(2)) { __syncthreads(); nsa_phase_t<NSA_VAR>(F, l); } }
        SEAM(pb + 2);
        if (IN(pb + 3) && EN(3)) { RELAUNDER(); hgrn_out_phase(F, l); if (DUP(3)) { __syncthreads(); hgrn_out_phase(F, l); } }
        SEAM(pb + 3);
        if (IN(pb + 4) && EN(4)) for (int rep_ = 0; rep_ < ((DUP(4) && l == 0) ? 2 : 1); ++rep_) { RELAUNDER(); if (rep_) __syncthreads();
            pg8::Gemm g{wsp<bf16>(F, WS_CAT), wsp<bf16>(F, WS_WOUT) + (size_t)l * 1024 * 1024, NTOK, D, D};
            pg8::StaticOrder S; S.init(NTOK, D, F.G, (int)blockIdx.x);
            EpiRes E{l == 0 ? inp(0) : (const float*)nullptr, HB, SSQ};
            pg8::gemm_phase<EpiRes, pg8::StaticOrder, true, true>(F.lds, g, S, E, F.wave);
        }
        SEAM(pb + 4);
        if (IN(pb + 5) && EN(5)) for (int rep_ = 0; rep_ < (DUP(5) ? 2 : 1); ++rep_) { RELAUNDER(); if (rep_) __syncthreads();
            pg8::Gemm g{HB, wsp<bf16>(F, WS_WQ) + (size_t)l * 256 * 1024, NTOK, 256, D};
            pg8::StaticOrder S; S.init(NTOK, 256, F.G, (int)blockIdx.x);
            EpiXQ E{SSQ, wsp<bf16>(F, WS_XQ)};
            pg8::gemm_phase<EpiXQ, pg8::StaticOrder, true, true>(F.lds, g, S, E, F.wave);
        }
        SEAM(pb + 5);
        if (IN(pb + 6) && EN(6)) { RELAUNDER(); cross_phase(F, l); if (DUP(6)) { __syncthreads(); cross_phase(F, l); } }
        SEAM(pb + 6);
        if (IN(pb + 7) && EN(7)) { RELAUNDER();
            pg8::Gemm g{wsp<bf16>(F, WS_XO), wsp<bf16>(F, WS_WO) + (size_t)l * 1024 * 256, NTOK, D, 256};
            pg8::StaticOrder S; S.init(NTOK, D, F.G, (int)blockIdx.x);
            EpiRes E{(const float*)nullptr, HB, SSQ};
            pg8::gemm_phase<EpiRes, pg8::StaticOrder, true, true>(F.lds, g, S, E, F.wave);
        }
        SEAM(pb + 7);
        if (IN(pb + 8) && EN(8)) { RELAUNDER(); router_phase(F, l); if (DUP(8)) router_phase(F, l, 1); }
        SEAM(pb + 8);
        if (IN(pb + 9) && EN(9)) { RELAUNDER(); gather_phase(F, l); if (DUP(9)) { __syncthreads(); gather_phase(F, l); } }
        SEAM(pb + 9);
        if (IN(pb + 10) && EN(10)) for (int rep_ = 0; rep_ < (DUP(10) ? 2 : 1); ++rep_) { RELAUNDER(); if (rep_) __syncthreads();
            const int ns = moe_tables(F, l);
            pg8::Gemm g{wsp<bf16>(F, WS_XS), wsp<bf16>(F, WS_WGU) + (size_t)l * 32 * 1024 * 1024, ns, 32 * 1024, D};
            MoeOrder S{(ns >> 8) * 4, F.G, (int)blockIdx.x, (const LAS int*)(F.lds + TAB_OFF) + 40};
            EpiGU E{wsp<float>(F, WS_SRSTD), wsp<bf16>(F, WS_ACT)};
            STAGGER(STAG_MOE);
            pg8::gemm_phase<EpiGU, MoeOrder, true, true>(F.lds, g, S, E, F.wave);
        }
        SEAM(pb + 10);
        if (IN(pb + 11) && EN(11)) for (int rep_ = 0; rep_ < (DUP(11) ? 2 : 1); ++rep_) { RELAUNDER(); if (rep_) __syncthreads();
            const int ns = moe_tables(F, l);
            pg8::Gemm g{wsp<bf16>(F, WS_ACT), wsp<bf16>(F, WS_WDN) + (size_t)l * 32 * 1024 * 512, ns, 32 * 1024, 512};
            MoeOrder S{(ns >> 8) * 4, F.G, (int)blockIdx.x, (const LAS int*)(F.lds + TAB_OFF) + 40};
            EpiDN E{wsp<float>(F, WS_SGATE), wsp<bf16>(F, WS_YS)};
            STAGGER(STAG_MOE / 2);
            pg8::gemm_phase<EpiDN, MoeOrder, true, true>(F.lds, g, S, E, F.wave);
        }
        SEAM(pb + 11);
        if (IN(pb + 12) && EN(12)) { RELAUNDER(); combine_phase(F, l); if (DUP(12)) combine_phase(F, l, 1); }
        SEAM(pb + 12);
    }
#undef IN
#undef SEAM
}

extern "C" void kernel_launch(void* const* d_in, const int* in_sizes, int n_in, void* d_out, int out_size, void* d_ws, size_t ws_size, hipStream_t stream) {
    static int grid = 0;
    if (grid == 0) {
        if (n_in != 24 || in_sizes[0] != NTOK * D || out_size != NTOK * D || ws_size < WS_END) {
            fprintf(stderr, "kernel_launch: unexpected shapes: n_in %d in0 %d out %d ws %zu (need %zu)\n", n_in, n_in > 0 ? in_sizes[0] : -1, out_size, ws_size, (size_t)WS_END); grid = -1; return; }
        int dev = 0, cus = 0, per_cu = 0;
        if (hipGetDevice(&dev) != hipSuccess || hipDeviceGetAttribute(&cus, hipDeviceAttributeMultiprocessorCount, dev) != hipSuccess) { grid = -1; return; }
        if (hipFuncSetAttribute((const void*)hymba_fwd, hipFuncAttributeMaxDynamicSharedMemorySize, LDS_BYTES) != hipSuccess) { fprintf(stderr, "kernel_launch: hipFuncSetAttribute failed\n"); grid = -1; return; }
        if (hipOccupancyMaxActiveBlocksPerMultiprocessor(&per_cu, (const void*)hymba_fwd, NWAVES * 64, LDS_BYTES) != hipSuccess || per_cu < 1)
            fprintf(stderr, "kernel_launch: note: occupancy query reports %d blocks per CU\n", per_cu);
        (void)hipGetLastError();
        grid = cus;
    }
    if (grid < 0) return;
    if (hipMemsetAsync((char*)d_ws + WS_CTL, 0, CTL_ZERO_BYTES, stream) != hipSuccess) { fprintf(stderr, "kernel_launch: memset failed\n"); return; }
    Args a{};
    for (int i = 0; i < 24; ++i) a.in[i] = (const float*)d_in[i];
    a.out = (float*)d_out; a.ws = (unsigned char*)d_ws;
#if MK_ONE_LAUNCH
    a.ph_lo = 0; a.ph_hi = NPHASES;
    hipLaunchKernelGGL(hymba_fwd, dim3(grid), dim3(NWAVES * 64), LDS_BYTES, stream, a);
#else
    for (int p = 0; p < NPHASES; ++p) { a.ph_lo = p; a.ph_hi = p + 1; hipLaunchKernelGGL(hymba_fwd, dim3(grid), dim3(NWAVES * 64), LDS_BYTES, stream, a); }
#endif
    const hipError_t le = hipPeekAtLastError();
    if (le != hipSuccess) fprintf(stderr, "kernel_launch: launch failed: %s\n", hipGetErrorName(le));
}
```

```cpp
#define MK_ONE_LAUNCH 1
#include <hip/hip_runtime.h>
#include <cstdio>
#include <cstdint>
#include <cmath>
namespace pg8 {
#define PG8_LAS __attribute__((address_space(3)))
typedef unsigned short bf16_t;
typedef short bf16x8 __attribute__((ext_vector_type(8)));
typedef float f32x4 __attribute__((ext_vector_type(4)));
typedef unsigned u32x4 __attribute__((ext_vector_type(4)));
constexpr int BM = 256, BK = 64, HALF = 128, HTB = HALF * BK * 2  , STAGE_BYTES = 8 * HTB, NXCD = 8, WGM = 8;

__host__ __device__ __forceinline__ int lds_byte(int r, int c) { const int st = (r >> 4) * 2 + (c >> 5), rr = r & 15, cc = c & 31, ob = rr * 64 + cc * 2; return st * 1024 + (ob ^ (((ob >> 9) & 1) << 5)); }
__host__ __device__ __forceinline__ void stage_rc(int b, int& R, int& C) { const int st = b / 1024, sb = b % 1024, swz = sb ^ (((sb >> 9) & 1) << 5); R = (st >> 1) * 16 + swz / 64; C = (st & 1) * 32 + (swz % 64) / 2; }
__host__ __device__ __forceinline__ int perm32(int rho) { const int n = rho >> 4, i = rho & 15; return 8 * (i >> 2) + 4 * n + (i & 3); }

struct Unit { int pm, pn; };
struct Gemm { const bf16_t* A; const bf16_t* Bt; int M, N, K; };

struct StaticOrder {
    int nM, nN, nwg, G, c;
    __host__ __device__ void init(int M, int N, int G_, int c_) { nM = M / BM; nN = N / BM; nwg = nM * nN; G = G_; c = c_; }
    __host__ __device__ bool next(int i, Unit& u) const {
        const long L = (long)i * G + c; if (L >= nwg) return false;
        int wgid = (int)L; { const int q = nwg / NXCD, r = nwg % NXCD, xcd = wgid % NXCD, off = wgid / NXCD; wgid = (xcd < r ? xcd * (q + 1) : r * (q + 1) + (xcd - r) * q) + off; }
        const int nig = WGM * nN, gid = wgid / nig, fm = gid * WGM, gsz = (nM - fm) < WGM ? (nM - fm) : WGM;
        u.pm = fm + ((wgid % nig) % gsz); u.pn = (wgid % nig) / gsz; return true;
    }
    __device__ __forceinline__ void a_ready(const Unit&) const {}
    __device__ __forceinline__ void done(const Unit&) const {}
};

__device__ __forceinline__ unsigned cvt_pk_bf16(float lo, float hi) { unsigned r; asm volatile("v_cvt_pk_bf16_f32 %0, %1, %2" : "=v"(r) : "v"(lo), "v"(hi)); return r; }
typedef float f32x2 __attribute__((ext_vector_type(2)));
template <class Epi, class Sched, bool ALIGN_EPI = false, bool SP2 = false>
__device__ __forceinline__ void gemm_phase(PG8_LAS unsigned char* lds, const Gemm g, const Sched& S, const Epi& E, int wave_id) {
    unsigned z_ = 0u; asm volatile("" : "+v"(z_)); int tid_ = wave_id * 64 + (int)__builtin_amdgcn_mbcnt_hi(~0u, __builtin_amdgcn_mbcnt_lo(~0u, z_));
    const int tid = tid_, wid = __builtin_amdgcn_readfirstlane(tid >> 6), lane = tid & 63, wr = wid >> 2, wc = wid & 3, fr = lane & 15, fq = lane >> 4;
    const int K = g.K, nt = K / BK;
    unsigned voffA[2], voffB[2];
#pragma unroll
    for (int i = 0; i < 2; ++i) { int R, C; stage_rc(tid * 16 + i * 8192, R, C); const int Rb = Epi::PERM ? ((R & ~31) + perm32(R & 31)) : R;
        voffA[i] = (unsigned)(R * K + C) * 2u; voffB[i] = (unsigned)(Rb * K + C) * 2u; }
    const size_t kstep = (size_t)(BK * 2);
    const size_t hstep = (size_t)HALF * K * 2;
    const size_t tstep = 2 * hstep;
    const unsigned ldsw = (unsigned)wid * 1024u;
    const int aoff = lds_byte(wr * 64 + fr, fq * 8), boff = lds_byte(wc * 32 + fr, fq * 8);
#define PG8_SA(b, h) (((b) * 2 + (h)) * HTB)
#define PG8_SB(b, h) ((4 + (b) * 2 + (h)) * HTB)
#define PG8_STAGE(bufoff, gbase, voff) do { _Pragma("unroll") for (int _i = 0; _i < 2; ++_i) \
        __builtin_amdgcn_global_load_lds((const unsigned*)((const char*)(gbase) + (voff)[_i]), (PG8_LAS unsigned*)(lds + (bufoff) + ldsw + _i * 8192), 16, 0, 0); } while (0)
#define PG8_LDA(dst, b, h) do { _Pragma("unroll") for (int m = 0; m < 4; ++m) _Pragma("unroll") for (int k = 0; k < 2; ++k) dst[m][k] = *(const PG8_LAS bf16x8*)(lds + PG8_SA(b, h) + aoff + m * 2048 + k * 1024); } while (0)
#define PG8_LDB(dst, b, h) do { _Pragma("unroll") for (int n = 0; n < 2; ++n) _Pragma("unroll") for (int k = 0; k < 2; ++k) dst[n][k] = *(const PG8_LAS bf16x8*)(lds + PG8_SB(b, h) + boff + n * 2048 + k * 1024); } while (0)
#define PG8_MMA(ai, bj, At, Bt) do { __builtin_amdgcn_s_setprio(1); _Pragma("unroll") for (int m = 0; m < 4; ++m) _Pragma("unroll") for (int n = 0; n < 2; ++n) _Pragma("unroll") for (int k = 0; k < 2; ++k) \
        acc[ai][bj][m][n] = __builtin_amdgcn_mfma_f32_16x16x32_bf16(Bt[n][k], At[m][k], acc[ai][bj][m][n], 0, 0, 0); __builtin_amdgcn_s_setprio(0); } while (0)
#define PG8_WAIT_V(n) asm volatile("s_waitcnt vmcnt(" #n ")" ::: "memory")
#define PG8_WAIT_L(n) asm volatile("s_waitcnt lgkmcnt(" #n ")" ::: "memory")
#define PG8_BAR __builtin_amdgcn_s_barrier()
#define PG8_SCHED __builtin_amdgcn_sched_barrier(0)
    Unit cur, nxt; int ui = 0;
    if (!S.next(0, cur)) return;
    f32x4 acc[2][2][4][2];
#pragma unroll
    for (int a = 0; a < 2; ++a)
#pragma unroll
        for (int b = 0; b < 2; ++b)
#pragma unroll
            for (int m = 0; m < 4; ++m)
#pragma unroll
                for (int n = 0; n < 2; ++n) acc[a][b][m][n] = (f32x4){0.f, 0.f, 0.f, 0.f};
    bf16x8 At[4][2], B0[2][2], B1[2][2];
    const char* cA = (const char*)g.A + (size_t)cur.pm * tstep; const char* cB = (const char*)g.Bt + (size_t)cur.pn * tstep;
    S.a_ready(cur);
    if constexpr (SP2) {
        PG8_STAGE(PG8_SB(0, 0), cB, voffB); PG8_STAGE(PG8_SB(0, 1), cB + hstep, voffB); PG8_STAGE(PG8_SA(0, 0), cA, voffA); PG8_STAGE(PG8_SA(0, 1), cA + hstep, voffA);
        if (wr == 1) PG8_BAR;
        PG8_WAIT_V(2); PG8_BAR;
        PG8_STAGE(PG8_SB(1, 0), cB + kstep, voffB); PG8_STAGE(PG8_SA(1, 0), cA + kstep, voffA); PG8_STAGE(PG8_SB(1, 1), cB + hstep + kstep, voffB);
        PG8_WAIT_V(6); PG8_BAR;
    } else {
        PG8_STAGE(PG8_SB(0, 0), cB, voffB); PG8_STAGE(PG8_SA(0, 0), cA, voffA); PG8_STAGE(PG8_SB(0, 1), cB + hstep, voffB); PG8_STAGE(PG8_SA(0, 1), cA + hstep, voffA);
        if (wr == 1) PG8_BAR;
        PG8_WAIT_V(4); PG8_BAR;
        PG8_STAGE(PG8_SB(1, 0), cB + kstep, voffB); PG8_STAGE(PG8_SA(1, 0), cA + kstep, voffA); PG8_STAGE(PG8_SB(1, 1), cB + hstep + kstep, voffB);
        PG8_WAIT_V(6); PG8_BAR;
    }
    for (;;) {
        const bool has_next = S.next(ui + 1, nxt);
        const char* nA = has_next ? (const char*)g.A + (size_t)nxt.pm * tstep : cA; const char* nB = has_next ? (const char*)g.Bt + (size_t)nxt.pn * tstep : cB;
        for (int t = 0; t < nt; t += 2) {
            const bool last = (t == nt - 2);
            const char* a1 = cA + (size_t)(t + 1) * kstep;
            const char* a2 = last ? nA : cA + (size_t)(t + 2) * kstep; const char* b2 = last ? nB : cB + (size_t)(t + 2) * kstep;
            const char* a3 = a2 + kstep; const char* b3 = b2 + kstep;
            if (last && has_next) S.a_ready(nxt);
            if constexpr (SP2) {
            PG8_LDB(B0, 0, 0); PG8_LDB(B1, 0, 1); PG8_SCHED; PG8_LDA(At, 0, 0); PG8_STAGE(PG8_SA(1, 1), a1 + hstep, voffA);
            PG8_WAIT_V(8); PG8_WAIT_L(0); PG8_BAR; PG8_MMA(0, 0, At, B0); PG8_MMA(0, 1, At, B1); PG8_BAR; PG8_SCHED;
            PG8_LDA(At, 0, 1); PG8_STAGE(PG8_SB(0, 0), b2, voffB); PG8_STAGE(PG8_SB(0, 1), b2 + hstep, voffB); PG8_STAGE(PG8_SA(0, 0), a2, voffA);
            PG8_WAIT_V(8); PG8_WAIT_L(0); PG8_BAR; PG8_MMA(1, 0, At, B0); PG8_MMA(1, 1, At, B1); PG8_BAR; PG8_SCHED;
            PG8_LDB(B0, 1, 0); PG8_LDB(B1, 1, 1); PG8_SCHED; PG8_LDA(At, 1, 0); PG8_STAGE(PG8_SA(0, 1), a2 + hstep, voffA);
            PG8_WAIT_V(8); PG8_WAIT_L(0); PG8_BAR; PG8_MMA(0, 0, At, B0); PG8_MMA(0, 1, At, B1); PG8_BAR; PG8_SCHED;
            PG8_LDA(At, 1, 1); PG8_STAGE(PG8_SB(1, 0), b3, voffB); PG8_STAGE(PG8_SB(1, 1), b3 + hstep, voffB); PG8_STAGE(PG8_SA(1, 0), a3, voffA);
            PG8_WAIT_V(8); PG8_WAIT_L(0); PG8_BAR; PG8_MMA(1, 0, At, B0); PG8_MMA(1, 1, At, B1); PG8_BAR; PG8_SCHED;
            } else {
            PG8_LDB(B0, 0, 0); PG8_SCHED; PG8_LDA(At, 0, 0); PG8_STAGE(PG8_SA(1, 1), a1 + hstep, voffA);
            PG8_WAIT_L(8); PG8_BAR; PG8_WAIT_L(0); PG8_MMA(0, 0, At, B0); PG8_BAR; PG8_SCHED;
            PG8_LDB(B1, 0, 1); PG8_STAGE(PG8_SB(0, 0), b2, voffB);
            PG8_BAR; PG8_WAIT_L(0); PG8_MMA(0, 1, At, B1); PG8_BAR;
            PG8_LDA(At, 0, 1); PG8_STAGE(PG8_SA(0, 0), a2, voffA);
            PG8_BAR; PG8_WAIT_L(0); PG8_MMA(1, 0, At, B0); PG8_BAR; PG8_SCHED;
            PG8_STAGE(PG8_SB(0, 1), b2 + hstep, voffB);
            PG8_WAIT_V(6); PG8_BAR; PG8_MMA(1, 1, At, B1); PG8_BAR;
            PG8_LDB(B0, 1, 0); PG8_SCHED; PG8_LDA(At, 1, 0); PG8_STAGE(PG8_SA(0, 1), a2 + hstep, voffA);
            PG8_WAIT_L(8); PG8_BAR; PG8_WAIT_L(0); PG8_MMA(0, 0, At, B0); PG8_BAR; PG8_SCHED;
            PG8_LDB(B1, 1, 1); PG8_STAGE(PG8_SB(1, 0), b3, voffB);
            PG8_BAR; PG8_WAIT_L(0); PG8_MMA(0, 1, At, B1); PG8_BAR;
            PG8_LDA(At, 1, 1); PG8_STAGE(PG8_SA(1, 0), a3, voffA);
            PG8_BAR; PG8_WAIT_L(0); PG8_MMA(1, 0, At, B0); PG8_BAR; PG8_SCHED;
            PG8_STAGE(PG8_SB(1, 1), b3 + hstep, voffB);
            PG8_WAIT_V(6); PG8_BAR; PG8_MMA(1, 1, At, B1); PG8_BAR;
            }
        }
        if constexpr (ALIGN_EPI) { if (wr == 0) PG8_BAR; }
        if constexpr (!Epi::AFTER_DRAIN) { E(acc, cur, wr, wc, fr, fq); S.done(cur); }
        if (!has_next) break;
#pragma unroll
        for (int a = 0; a < 2; ++a)
#pragma unroll
            for (int b = 0; b < 2; ++b)
#pragma unroll
                for (int m = 0; m < 4; ++m)
#pragma unroll
                    for (int n = 0; n < 2; ++n) acc[a][b][m][n] = (f32x4){0.f, 0.f, 0.f, 0.f};
        cur = nxt; cA = nA; cB = nB; ++ui;
        if constexpr (ALIGN_EPI) { if (wr == 1) PG8_BAR; }
    }
    PG8_WAIT_V(0);
    if constexpr (!ALIGN_EPI) { if (wr == 0) PG8_BAR; }
    PG8_BAR;
    if constexpr (Epi::AFTER_DRAIN) { E.fused(acc, cur, wr, wc, fr, fq, lds, wid, lane); S.done(cur); }
#undef PG8_SA
#undef PG8_SB
#undef PG8_STAGE
#undef PG8_LDA
#undef PG8_LDB
#undef PG8_MMA
#undef PG8_WAIT_V
#undef PG8_WAIT_L
#undef PG8_BAR
#undef PG8_SCHED
}
}
constexpr int NB = 4, T = 8192, D = 1024, NTOK = NB * T, DEPTH = 2;
constexpr int NIN = 3328;
constexpr int IN_W = 3096;
constexpr int NSLOT_MAX = 65536 + 32 * 256;
constexpr float RMS_EPS = 1e-6f;
constexpr float QSCALE = 0.125f * 1.44269504088896f;
constexpr int NWAVES = 8;

constexpr size_t MiB = 1u << 20;
constexpr size_t WS_CTL = 0, CTL_ZERO_BYTES = 1 * MiB;
constexpr size_t WS_ROPE = 1 * MiB;
constexpr size_t WS_SMALL = 3 * MiB;
constexpr size_t WS_WG = 3 * MiB + 65536;
constexpr size_t WS_SSQ = 4 * MiB;
constexpr size_t WS_WIN = 8 * MiB;
constexpr size_t WS_WOUT = 22 * MiB;
constexpr size_t WS_WQ = 26 * MiB;
constexpr size_t WS_WKV = 27 * MiB;
constexpr size_t WS_WO = 29 * MiB;
constexpr size_t WS_WR = 30 * MiB;
constexpr size_t WS_W1C = 31 * MiB;
constexpr size_t WS_W2C = 33 * MiB;
constexpr size_t WS_MEMB = 34 * MiB;
constexpr size_t WS_MK = 36 * MiB;
constexpr size_t WS_MVT = 37 * MiB;
constexpr size_t WS_WGU = 40 * MiB;
constexpr size_t WS_WDN = 168 * MiB;
constexpr size_t WS_HB = 232 * MiB;
constexpr size_t WS_Q = 296 * MiB, WS_QR = 328 * MiB, WS_KCR = 360 * MiB, WS_VCR = 368 * MiB, WS_KS = 376 * MiB, WS_KW = 384 * MiB;
constexpr size_t WS_VST = 392 * MiB, WS_VWT = 400 * MiB, WS_KCC = 408 * MiB, WS_VCT = 409 * MiB, WS_GATE = 410 * MiB;
constexpr size_t WS_CB = 414 * MiB, WS_CC = 430 * MiB, WS_CH = 446 * MiB;
constexpr size_t WS_HQ = 462 * MiB, WS_HF = 494 * MiB, WS_HI = 526 * MiB, WS_HG = 558 * MiB;
constexpr size_t WS_CAT = 590 * MiB, WS_U = 654 * MiB, WS_DEC = 686 * MiB;
constexpr size_t WS_XQ = 688 * MiB, WS_XO = 704 * MiB;
constexpr size_t WS_XS = 296 * MiB, WS_ACT = 440 * MiB, WS_YS = 512 * MiB;
constexpr size_t WS_TOKE = 720 * MiB, WS_TOKG = 721 * MiB, WS_TOKP = 722 * MiB, WS_TOKS = 723 * MiB, WS_SRSTD = 724 * MiB, WS_SGATE = 725 * MiB;
constexpr size_t WS_U2 = 728 * MiB;
constexpr size_t WS_PROBE = 760 * MiB;
constexpr size_t WS_END = 760 * MiB;
static_assert(WS_XS + (size_t)NSLOT_MAX * 1024 * 2 <= WS_ACT && WS_ACT + (size_t)NSLOT_MAX * 512 * 2 <= WS_YS && WS_YS + (size_t)NSLOT_MAX * 1024 * 2 <= WS_XQ, "moe map");
constexpr int CW_CNT = 64;
constexpr int CW_KMAX = 256;
constexpr int CW_NSAQ = 512;
constexpr int CW_BAR = 4096;

constexpr int RING_BYTES = 131072;
constexpr int NSA_LDS_WAVE = 10752;
constexpr int MISC_OFF = RING_BYTES;
constexpr int TAB_OFF = RING_BYTES + 512;
constexpr int LDS_BYTES = 147456;
static_assert(8 * NSA_LDS_WAVE <= RING_BYTES && TAB_OFF + 4 * (40 + 320) <= LDS_BYTES, "LDS map");

#define GAS __attribute__((address_space(1)))
#define LAS __attribute__((address_space(3)))
#define DEV __device__ __forceinline__
typedef unsigned short bf16;
typedef unsigned v4u __attribute__((ext_vector_type(4)));
typedef unsigned v2u __attribute__((ext_vector_type(2)));
typedef float f32x4 __attribute__((ext_vector_type(4)));
typedef short bf16x8 __attribute__((ext_vector_type(8)));
typedef GAS unsigned gu32;
#define RLX_AGENT __ATOMIC_RELAXED, __HIP_MEMORY_SCOPE_AGENT
#define LDS_WAIT() asm volatile("s_waitcnt lgkmcnt(0)" ::: "memory")
#define VM_WAIT() asm volatile("s_waitcnt vmcnt(0)" ::: "memory")
typedef __bf16 bf16x2_t __attribute__((ext_vector_type(2)));
typedef float f32x2_t __attribute__((ext_vector_type(2)));
DEV unsigned pk2(float lo, float hi) { const f32x2_t v = {lo, hi}; return __builtin_bit_cast(unsigned, __builtin_convertvector(v, bf16x2_t)); }
DEV unsigned f2bf(float f) { return pk2(f, 0.f) & 0xffffu; }
DEV float bf2f(unsigned short b) { return __builtin_bit_cast(float, (unsigned)b << 16); }
DEV float bflo(unsigned w) { return __builtin_bit_cast(float, w << 16); }
DEV float bfhi(unsigned w) { return __builtin_bit_cast(float, w & 0xffff0000u); }
DEV float ex2(float x) { return __builtin_amdgcn_exp2f(x); }
DEV float wave_sum(float v) {
#pragma unroll
    for (int o = 1; o < 64; o <<= 1) v += __shfl_xor(v, o);
    return v;
}
DEV f32x4 mfma16(bf16x8 a, bf16x8 b, f32x4 c) { return __builtin_amdgcn_mfma_f32_16x16x32_bf16(a, b, c, 0, 0, 0); }
DEV int slot32(int k) { return ((k >> 2) & 3) * 8 + (k >> 4) * 4 + (k & 3); }
DEV int kfrag_off(int key, int d) { return (key >> 5) * 2048 + ((((key >> 4) & 1) * 2 + (d >> 5)) * 64 + ((d >> 3) & 3) * 16 + (key & 15)) * 8 + (d & 7); }
DEV float sigmoidf_(float x) { return 1.0f / (1.0f + __expf(-x)); }
DEV float siluf_(float x) { return x / (1.0f + __expf(-x)); }
#define XB_TMO      128
#define XB_XCNT(j)  (256  + 64 * (j))
#define XB_XSUB(j)  (1280 + 64 * (j))
#define XB_XGEN(j)  (2304 + 64 * (j))
#define XB_TOP      3328
#define XB_TOPGEN   3392
#define XCD_BAR_WORDS 3456
#define XB_SPIN_CAP (1u << 18)

__device__ __forceinline__ unsigned xb_ld(unsigned* p)              { return __hip_atomic_load(p, __ATOMIC_RELAXED, __HIP_MEMORY_SCOPE_AGENT); }
__device__ __forceinline__ unsigned xb_add(unsigned* p, unsigned v) { return __hip_atomic_fetch_add(p, v, __ATOMIC_RELAXED, __HIP_MEMORY_SCOPE_AGENT); }
__device__ __forceinline__ unsigned xb_xcc_id() { return (unsigned)__builtin_amdgcn_s_getreg((3 << 11) | 20) & 0xFu; }
#define XB_SPIN(cond, bar) do { unsigned _sp = 0; while (cond) { __builtin_amdgcn_s_sleep(1); \
    if ((++_sp & 255u) == 0u) { if (xb_ld(&(bar)[XB_TMO])) break; if (_sp > XB_SPIN_CAP) { atomicAdd(&(bar)[XB_TMO], 1u); break; } } } } while (0)

struct XcdBarrier {
    unsigned* bar; unsigned x;
    volatile LAS unsigned* st;
};

__device__ __forceinline__ XcdBarrier xcd_barrier_post(unsigned* bar, volatile LAS unsigned* st) {
    XcdBarrier b; b.bar = bar; b.x = xb_xcc_id(); b.st = st;
    if (threadIdx.x == 0) (void)xb_add(&bar[XB_XCNT(b.x)], 1u);
    return b;
}
__device__ __forceinline__ void xcd_barrier_complete(unsigned* bar, unsigned x, unsigned& nloc, unsigned& nx) {
    const unsigned G = gridDim.x * gridDim.y * gridDim.z;
    unsigned sum, cnt, mine, sp = 0u;
    for (;;) {
        sum = 0u; cnt = 0u; mine = 0u;
#pragma unroll
        for (unsigned j = 0; j < 16; ++j) { const unsigned c = xb_ld(&bar[XB_XCNT(j)]); sum += c; cnt += (c > 0u) ? 1u : 0u; mine = (j == x) ? c : mine; }
        if (sum == G) break;
        __builtin_amdgcn_s_sleep(1);
        if ((++sp & 255u) == 0u) { if (xb_ld(&bar[XB_TMO])) break; if (sp > XB_SPIN_CAP) { atomicAdd(&bar[XB_TMO], 1u); break; } }
    }
    nloc = mine > 0u ? mine : 1u; nx = cnt > 0u ? cnt : 1u;
}

__device__ __forceinline__ void xcd_barrier(const XcdBarrier& b) {
    asm volatile("s_waitcnt vmcnt(0)" ::: "memory");
    __syncthreads();
    if (threadIdx.x == 0) {
        unsigned* bar = b.bar;
        __builtin_amdgcn_s_waitcnt(0);
        unsigned nloc = b.st[0], nx = b.st[1];
        if (nloc == 0u) { xcd_barrier_complete(bar, b.x, nloc, nx); b.st[0] = nloc; b.st[1] = nx; }
        const unsigned old = xb_add(&bar[XB_XSUB(b.x)], 1u);
        const unsigned gen = old / nloc;
        if (old + 1u == (gen + 1u) * nloc) {
            __builtin_amdgcn_fence(__ATOMIC_RELEASE, "agent");
            asm volatile("s_waitcnt vmcnt(0)" ::: "memory");
            const unsigned og = xb_add(&bar[XB_TOP], 1u);
            const unsigned tg = og / nx;
            if (og + 1u == (tg + 1u) * nx) xb_add(&bar[XB_TOPGEN], 1u);
            else XB_SPIN(xb_ld(&bar[XB_TOPGEN]) == tg, bar);
            __builtin_amdgcn_fence(__ATOMIC_ACQUIRE, "agent");
            xb_add(&bar[XB_XGEN(b.x)], 1u);
            asm volatile("s_waitcnt vmcnt(0)" ::: "memory");
        } else {
            XB_SPIN(xb_ld(&bar[XB_XGEN(b.x)]) == gen, bar);
            __builtin_amdgcn_fence(__ATOMIC_ACQUIRE, "agent");
            asm volatile("s_waitcnt vmcnt(0)" ::: "memory");
        }
    }
    __syncthreads();
}
DEV float row_rstd(const float* ssq, int row, int fq) {
    const f32x4 p = *(const f32x4*)(ssq + (size_t)row * 16 + fq * 4);
    float s = (p.x + p.y) + (p.z + p.w);
    s += __shfl_xor(s, 16); s += __shfl_xor(s, 32);
    return 1.0f / sqrtf(s * (1.0f / 1024.0f) + RMS_EPS);
}
DEV float row_rstd_full(const float* ssq, int row) {
    const f32x4* p = (const f32x4*)(ssq + (size_t)row * 16);
    const f32x4 a = p[0], b = p[1], c = p[2], d = p[3];
    const float s = ((a.x + a.y) + (a.z + a.w)) + ((b.x + b.y) + (b.z + b.w)) + ((c.x + c.y) + (c.z + c.w)) + ((d.x + d.y) + (d.z + d.w));
    return 1.0f / sqrtf(s * (1.0f / 1024.0f) + RMS_EPS);
}

DEV void rope4(const float* rope, int t, int i, const f32x4& v0, const f32x4& v1, float (&lo)[4], float (&hi)[4]) {
    const f32x4 c0 = *(const f32x4*)(rope + ((size_t)t * 32 + i) * 2), c1 = *(const f32x4*)(rope + ((size_t)t * 32 + i + 2) * 2);
    lo[0] = v0[0] * c0[0] - v0[1] * c0[1]; hi[0] = v0[1] * c0[0] + v0[0] * c0[1];
    lo[1] = v0[2] * c0[2] - v0[3] * c0[3]; hi[1] = v0[3] * c0[2] + v0[2] * c0[3];
    lo[2] = v1[0] * c1[0] - v1[1] * c1[1]; hi[2] = v1[1] * c1[0] + v1[0] * c1[1];
    lo[3] = v1[2] * c1[2] - v1[3] * c1[3]; hi[3] = v1[3] * c1[2] + v1[2] * c1[3];
}
struct EpiIn {
    static constexpr bool PERM = true, AFTER_DRAIN = false;
    unsigned char* ws;
    template <class Tp> DEV Tp* P(size_t off) const { return (Tp*)(GAS Tp*)(ws + off); }
    DEV void operator()(const f32x4 (&acc)[2][2][4][2], const pg8::Unit& u, int wr, int wc, int fr, int fq) const {
        asm volatile("" : "+v"(fr), "+v"(fq), "+s"(wr), "+s"(wc));
        const int pn = u.pn;
        const float* ssq = P<float>(WS_SSQ); const float* rope = P<float>(WS_ROPE);
#pragma unroll
        for (int ai = 0; ai < 2; ++ai)
#pragma unroll
            for (int m = 0; m < 4; ++m) {
                const int row = u.pm * 256 + ai * 128 + wr * 64 + m * 16 + fr;
                const float rstd = row_rstd(ssq, row, fq);
                const int t = row & (T - 1), b = row >> 13;
#pragma unroll
                for (int bj = 0; bj < 2; ++bj) {
                    const int col = bj * 128 + wc * 32 + fq * 8;
                    const f32x4 v0 = acc[ai][bj][m][0] * rstd, v1 = acc[ai][bj][m][1] * rstd;
                    if (pn < 2) {
                        const int g = pn * 256 + col, head = g >> 6, i = (g & 63) >> 1;
                        const size_t o = (size_t)row * 512 + head * 64 + i;
                        bf16* Q = P<bf16>(WS_Q);
                        v2u w;
                        w.x = pk2(v0[0] * QSCALE, v0[2] * QSCALE); w.y = pk2(v1[0] * QSCALE, v1[2] * QSCALE); *(v2u*)(Q + o) = w;
                        w.x = pk2(v0[1] * QSCALE, v0[3] * QSCALE); w.y = pk2(v1[1] * QSCALE, v1[3] * QSCALE); *(v2u*)(Q + o + 32) = w;
                    } else if (pn == 2) {
                        bf16* dst = P<bf16>((col < 128) ? WS_KCR : WS_VCR);
                        v4u w; w.x = pk2(v0[0], v0[1]); w.y = pk2(v0[2], v0[3]); w.z = pk2(v1[0], v1[1]); w.w = pk2(v1[2], v1[3]);
                        *(v4u*)(dst + (size_t)row * 128 + (col & 127)) = w;
                    } else if (pn == 3 || pn == 4) {
                        if (col < 128) {
                            bf16* dst = P<bf16>((pn == 3) ? WS_KS : WS_KW);
                            const int hkv = col >> 6, i = (col & 63) >> 1;
                            float lo[4], hi[4]; rope4(rope, t, i, v0, v1, lo, hi);
                            const size_t o = (size_t)(b * 2 + hkv) * T * 64 + kfrag_off(t, i);
                            v2u w;
                            w.x = pk2(lo[0], lo[1]); w.y = pk2(lo[2], lo[3]); *(v2u*)(dst + o) = w;
                            w.x = pk2(hi[0], hi[1]); w.y = pk2(hi[2], hi[3]); *(v2u*)(dst + o + 512) = w;
                        } else {
                            bf16* dst = P<bf16>((pn == 3) ? WS_VST : WS_VWT);
                            const int c2 = col - 128, hkv = c2 >> 6, d = c2 & 63;
                            const size_t o = (((size_t)(b * 2 + hkv) * 256 + (t >> 5)) * 64 + d) * 32 + slot32(t & 31);
#pragma unroll
                            for (int j = 0; j < 4; ++j) { dst[o + j * 32] = (bf16)f2bf(v0[j]); dst[o + (j + 4) * 32] = (bf16)f2bf(v1[j]); }
#if defined(DUPMASK) && ((DUPMASK >> 20) & 1)
                            { bf16* dst2 = P<bf16>(WS_U2) + (pn - 3) * (4u << 20);
#pragma unroll
                            for (int j = 0; j < 4; ++j) { dst2[o + j * 32] = (bf16)f2bf(v0[j]); dst2[o + (j + 4) * 32] = (bf16)f2bf(v1[j]); } }
#endif
                        }
                    } else if (pn == 9) {
                        float* dst = P<float>(WS_HF) + (size_t)row * 256 + col;
                        *(f32x4*)dst = v0; *(f32x4*)(dst + 4) = v1;
                    } else {
                        bf16* dst = (pn < 8) ? P<bf16>(WS_CB + (size_t)(pn - 5) * (WS_CC - WS_CB)) : P<bf16>(WS_HQ + (size_t)(pn - 8) * (WS_HF - WS_HQ));
                        v4u w; w.x = pk2(v0[0], v0[1]); w.y = pk2(v0[2], v0[3]); w.z = pk2(v1[0], v1[1]); w.w = pk2(v1[2], v1[3]);
                        *(v4u*)(dst + (size_t)row * 256 + col) = w;
                    }
                }
            }
    }
};

struct EpiRes {
    static constexpr bool PERM = true, AFTER_DRAIN = false;
    const float* base32; bf16* hb; float* ssq;
    DEV void operator()(const f32x4 (&acc)[2][2][4][2], const pg8::Unit& u, int wr, int wc, int fr, int fq) const {
        asm volatile("" : "+v"(fr), "+v"(fq), "+s"(wr), "+s"(wc));
#pragma unroll
        for (int ai = 0; ai < 2; ++ai)
#pragma unroll
            for (int m = 0; m < 4; ++m) {
                const int row = u.pm * 256 + ai * 128 + wr * 64 + m * 16 + fr;
                float ss = 0.f;
#pragma unroll
                for (int bj = 0; bj < 2; ++bj) {
                    const size_t o = (size_t)row * 1024 + u.pn * 256 + bj * 128 + wc * 32 + fq * 8;
                    f32x4 v0, v1;
                    if (base32) { v0 = *(const f32x4*)(base32 + o); v1 = *(const f32x4*)(base32 + o + 4); }
                    else { const v4u hw = *(const v4u*)(hb + o); v0 = (f32x4){bflo(hw.x), bfhi(hw.x), bflo(hw.y), bfhi(hw.y)}; v1 = (f32x4){bflo(hw.z), bfhi(hw.z), bflo(hw.w), bfhi(hw.w)}; }
                    v0 = v0 + acc[ai][bj][m][0]; v1 = v1 + acc[ai][bj][m][1];
                    v4u w; w.x = pk2(v0[0], v0[1]); w.y = pk2(v0[2], v0[3]); w.z = pk2(v1[0], v1[1]); w.w = pk2(v1[2], v1[3]);
                    *(v4u*)(hb + o) = w;
                    ss += ((v0[0] * v0[0] + v0[1] * v0[1]) + (v0[2] * v0[2] + v0[3] * v0[3])) + ((v1[0] * v1[0] + v1[1] * v1[1]) + (v1[2] * v1[2] + v1[3] * v1[3]));
                }
                ss += __shfl_xor(ss, 16); ss += __shfl_xor(ss, 32);
                if (fq == 0) ssq[(size_t)row * 16 + u.pn * 4 + wc] = ss;
            }
    }
};

struct EpiXQ {
    static constexpr bool PERM = true, AFTER_DRAIN = false;
    const float* ssq; bf16* XQ;
    DEV void operator()(const f32x4 (&acc)[2][2][4][2], const pg8::Unit& u, int wr, int wc, int fr, int fq) const {
        asm volatile("" : "+v"(fr), "+v"(fq), "+s"(wr), "+s"(wc));
#pragma unroll
        for (int ai = 0; ai < 2; ++ai)
#pragma unroll
            for (int m = 0; m < 4; ++m) {
                const int row = u.pm * 256 + ai * 128 + wr * 64 + m * 16 + fr;
                const float sc = row_rstd(ssq, row, fq) * QSCALE;
#pragma unroll
                for (int bj = 0; bj < 2; ++bj) {
                    const f32x4 v0 = acc[ai][bj][m][0] * sc, v1 = acc[ai][bj][m][1] * sc;
                    v4u w; w.x = pk2(v0[0], v0[1]); w.y = pk2(v0[2], v0[3]); w.z = pk2(v1[0], v1[1]); w.w = pk2(v1[2], v1[3]);
                    *(v4u*)(XQ + (size_t)row * 256 + bj * 128 + wc * 32 + fq * 8) = w;
                }
            }
    }
};

struct EpiGU {
    static constexpr bool PERM = true, AFTER_DRAIN = false;
    const float* srstd; bf16* ACT;
    DEV void operator()(const f32x4 (&acc)[2][2][4][2], const pg8::Unit& u, int wr, int wc, int fr, int fq) const {
        asm volatile("" : "+v"(fr), "+v"(fq), "+s"(wr), "+s"(wc));
        const int nt = u.pn & 3;
#pragma unroll
        for (int ai = 0; ai < 2; ++ai)
#pragma unroll
            for (int m = 0; m < 4; ++m) {
                const int row = u.pm * 256 + ai * 128 + wr * 64 + m * 16 + fr;
                const float rs = srstd[row];
#pragma unroll
                for (int bj = 0; bj < 2; ++bj) {
                    const f32x4 v0 = acc[ai][bj][m][0] * rs, v1 = acc[ai][bj][m][1] * rs;
                    const int j = (nt * 256 + bj * 128 + wc * 32 + fq * 8) >> 1;
                    v2u w; w.x = pk2(siluf_(v0[0]) * v0[1], siluf_(v0[2]) * v0[3]); w.y = pk2(siluf_(v1[0]) * v1[1], siluf_(v1[2]) * v1[3]);
                    *(v2u*)(ACT + (size_t)row * 512 + j) = w;
                }
            }
    }
};

struct EpiDN {
    static constexpr bool PERM = true, AFTER_DRAIN = false;
    const float* sgate; bf16* YS;
    DEV void operator()(const f32x4 (&acc)[2][2][4][2], const pg8::Unit& u, int wr, int wc, int fr, int fq) const {
        asm volatile("" : "+v"(fr), "+v"(fq), "+s"(wr), "+s"(wc));
        const int nt = u.pn & 3;
#pragma unroll
        for (int ai = 0; ai < 2; ++ai)
#pragma unroll
            for (int m = 0; m < 4; ++m) {
                const int row = u.pm * 256 + ai * 128 + wr * 64 + m * 16 + fr;
                const float gt = sgate[row];
#pragma unroll
                for (int bj = 0; bj < 2; ++bj) {
                    const f32x4 v0 = acc[ai][bj][m][0] * gt, v1 = acc[ai][bj][m][1] * gt;
                    v4u w; w.x = pk2(v0[0], v0[1]); w.y = pk2(v0[2], v0[3]); w.z = pk2(v1[0], v1[1]); w.w = pk2(v1[2], v1[3]);
                    *(v4u*)(YS + (size_t)row * 1024 + nt * 256 + bj * 128 + wc * 32 + fq * 8) = w;
                }
            }
    }
};

struct MoeOrder {
    int nunits, G, c; const LAS int* tileE;
    DEV bool next(int i, pg8::Unit& u) const {
        const int L = i * G + c; if (L >= nunits) return false;
        const int rt = L >> 2; u.pm = rt; u.pn = tileE[rt] * 4 + (L & 3); return true;
    }
    DEV void a_ready(const pg8::Unit&) const {}
    DEV void done(const pg8::Unit&) const {}
};
struct Frame {
    LAS unsigned char* lds;
    unsigned char* ldsg;
    volatile LAS unsigned* MISC;
    gu32* ctl;
    unsigned char* ws;
    int tid, lane, wave, vcu, G;
    float* out;
};
template <class Tp> DEV Tp* wsp(const Frame& F, size_t off) { return (Tp*)(F.ws + off); }
DEV const float* inp(int i) { const float* const* ka = (const float* const*)__builtin_amdgcn_kernarg_segment_ptr(); asm volatile("" : "+s"(i)); return (const float*)(const GAS float*)ka[i]; }

template <bool FRAG = false, class Map>
DEV void tr_item(const float* W, int K, int Nsrc, const float* gain, bf16* WT, float* scr, int item, int lane, Map map) {
    const int nblk = (Nsrc + 31) >> 5, kb = item / nblk, nb = item - kb * nblk, k0 = 64 * kb, n0 = 32 * nb;
    {
        const int nq = (lane & 7) * 4; f32x4 v[8];
#pragma unroll
        for (int i = 0; i < 8; ++i) { const int kk = 8 * i + (lane >> 3);
            v[i] = (n0 + nq < Nsrc) ? *(const f32x4*)(W + (size_t)(k0 + kk) * Nsrc + n0 + nq) : (f32x4){0.f, 0.f, 0.f, 0.f}; }
#pragma unroll
        for (int i = 0; i < 8; ++i) { const int kk = 8 * i + (lane >> 3); const float g = gain ? gain[k0 + kk] : 1.0f; float* s = scr + kk * 33 + nq;
            s[0] = v[i][0] * g; s[1] = v[i][1] * g; s[2] = v[i][2] * g; s[3] = v[i][3] * g; }
    }
    LDS_WAIT();
    const int c = lane & 7;
#pragma unroll
    for (int j = 0; j < 4; ++j) {
        const int n = (lane >> 3) + 8 * j; const float* s = scr + (8 * c) * 33 + n;
        if (n0 + n < Nsrc) {
            v4u o; o.x = pk2(s[0 * 33], s[1 * 33]); o.y = pk2(s[2 * 33], s[3 * 33]); o.z = pk2(s[4 * 33], s[5 * 33]); o.w = pk2(s[6 * 33], s[7 * 33]);
            const int nn = map(n0 + n), kk = k0 + 8 * c;
            if (FRAG) *(v4u*)(WT + ((size_t)((kk >> 5) * (Nsrc >> 4) + (nn >> 4)) * 64 + ((kk >> 3) & 3) * 16 + (nn & 15)) * 8) = o;
            else *(v4u*)(WT + (size_t)nn * K + kk) = o;
        }
    }
    LDS_WAIT();
}
template <class Map>
DEV void tr_experts(const float* W, int K, int Nsrc, const float* gain, bf16* WT, bf16* scr, int gw, int NGW, int lane, Map map) {
    const int nblk = Nsrc >> 6, per_e = (K >> 6) * nblk, NIT = 32 * per_e; const size_t esz = (size_t)K * Nsrc;
#pragma unroll 1
    for (int it = gw; it < NIT; it += NGW) {
        const int e = it / per_e, sub = it - e * per_e, kb = sub / nblk, nb = sub - kb * nblk, k0 = 64 * kb, n0 = 64 * nb, nq = (lane & 15) * 4;
        const float* Wp = W + (size_t)e * esz; bf16* Wo = WT + (size_t)e * esz;
        f32x4 v[16];
#pragma unroll
        for (int i = 0; i < 16; ++i) v[i] = *(const f32x4*)(Wp + (size_t)(k0 + 4 * i + (lane >> 4)) * Nsrc + n0 + nq);
#pragma unroll
        for (int i = 0; i < 16; ++i) { const int kk = 4 * i + (lane >> 4); const float g = gain ? gain[k0 + kk] : 1.0f;
            v2u w; w.x = pk2(v[i][0] * g, v[i][1] * g); w.y = pk2(v[i][2] * g, v[i][3] * g);
            *(v2u*)(scr + kk * 68 + nq) = w; }
        LDS_WAIT();
        const int cc = lane & 7;
#pragma unroll
        for (int j = 0; j < 8; ++j) { const int n = (lane >> 3) + 8 * j; const bf16* s = scr + (8 * cc) * 68 + n;
            v4u o; o.x = (unsigned)s[0] | ((unsigned)s[68] << 16); o.y = (unsigned)s[2 * 68] | ((unsigned)s[3 * 68] << 16);
            o.z = (unsigned)s[4 * 68] | ((unsigned)s[5 * 68] << 16); o.w = (unsigned)s[6 * 68] | ((unsigned)s[7 * 68] << 16);
            *(v4u*)(Wo + (size_t)map(n0 + n) * K + k0 + 8 * cc) = o; }
        LDS_WAIT();
    }
}
struct MapId { DEV int operator()(int n) const { return n; } };
struct MapIn {
    DEV int operator()(int n) const {
        if (n < 512) { const int d = n & 63; return (n & ~63) + 2 * (d & 31) + (d >> 5); }
        if (n < 768) return n;
        if (n < 1280) { const int r = n - 768; if ((r & 255) < 128) { const int d = r & 63; return 768 + (r & ~63) + 2 * (d & 31) + (d >> 5); } return n; }
        if (n < 1304) return 3072 + (n - 1280);
        return n - 24;
    }
};
struct MapGU { DEV int operator()(int n) const { return n < 512 ? 2 * n : 2 * (n - 512) + 1; } };

DEV void convert_experts(Frame& F, int l, bf16* scr, int part, int gw_ = -1, int ngw_ = 0) {
    unsigned zl_ = 0u; asm volatile("" : "+v"(zl_)); const int lane = (int)__builtin_amdgcn_mbcnt_hi(~0u, __builtin_amdgcn_mbcnt_lo(~0u, zl_));
    const int gw = gw_ >= 0 ? gw_ : F.vcu * NWAVES + F.wave, NGW = gw_ >= 0 ? ngw_ : F.G * NWAVES;
    if (part == 0) tr_experts(inp(17) + (size_t)l * 32 * 1024 * 1024, 1024, 1024, inp(22) + l * 1024, wsp<bf16>(F, WS_WGU) + (size_t)l * 32 * 1024 * 1024, scr, gw, NGW, lane, MapGU());
    else tr_experts(inp(18) + (size_t)l * 32 * 512 * 1024, 512, 1024, nullptr, wsp<bf16>(F, WS_WDN) + (size_t)l * 32 * 1024 * 512, scr, gw, NGW, lane, MapId());
}
DEV void p0_prologue(Frame& F) {
    float* scr = (float*)(F.ldsg + F.wave * 16384);
    const int gw = F.vcu * NWAVES + F.wave, NGW = F.G * NWAVES, lane = F.lane;
    for (int l = 0; l < DEPTH; ++l) {
        { const int NIT = 16 * 97; bf16* dst = wsp<bf16>(F, WS_WIN) + (size_t)l * NIN * 1024;
          for (int it = gw; it < NIT; it += NGW) tr_item(inp(2) + (size_t)l * 1024 * IN_W, 1024, IN_W, inp(19) + l * 1024, dst, scr, it, lane, MapIn());
          for (int i = gw * 64 + lane; i < (NIN - 3096) * 1024 / 8; i += NGW * 64) ((v4u*)(dst + (size_t)3096 * 1024))[i] = (v4u){0u, 0u, 0u, 0u}; }
        { const int NIT = 16 * 32; for (int it = gw; it < NIT; it += NGW) tr_item(inp(9) + (size_t)l * 1024 * 1024, 1024, 1024, nullptr, wsp<bf16>(F, WS_WOUT) + (size_t)l * 1024 * 1024, scr, it, lane, MapId()); }
        { const int NIT = 16 * 8; for (int it = gw; it < NIT; it += NGW) tr_item(inp(10) + (size_t)l * 1024 * 256, 1024, 256, inp(20) + l * 1024, wsp<bf16>(F, WS_WQ) + (size_t)l * 256 * 1024, scr, it, lane, MapId()); }
        { const int NIT = 16 * 16; for (int it = gw; it < NIT; it += NGW) tr_item(inp(11) + (size_t)l * 1024 * 512, 1024, 512, inp(21) + l * 1024, wsp<bf16>(F, WS_WKV) + (size_t)l * 512 * 1024, scr, it, lane, MapId()); }
        { const int NIT = 4 * 32; for (int it = gw; it < NIT; it += NGW) tr_item(inp(12) + (size_t)l * 256 * 1024, 256, 1024, nullptr, wsp<bf16>(F, WS_WO) + (size_t)l * 1024 * 256, scr, it, lane, MapId()); }
        for (int kv = 0; kv < 2; ++kv) {
            { const int NIT = 32 * 4; for (int it = gw; it < NIT; it += NGW) tr_item(inp(5) + (size_t)(l * 2 + kv) * 2048 * 128, 2048, 128, nullptr, wsp<bf16>(F, WS_W1C) + (size_t)(l * 2 + kv) * 128 * 2048, scr, it, lane, MapId()); }
            { const int NIT = 2 * 2; for (int it = gw; it < NIT; it += NGW) tr_item(inp(6) + (size_t)(l * 2 + kv) * 128 * 64, 128, 64, nullptr, wsp<bf16>(F, WS_W2C) + (size_t)(l * 2 + kv) * 64 * 128, scr, it, lane, MapId()); }
        }
        if (F.G != 256) { convert_experts(F, l, (bf16*)scr, 0); convert_experts(F, l, (bf16*)scr, 1); }
        { bf16* dst = wsp<bf16>(F, WS_WR) + (size_t)l * 96 * 1024; const float* gn = inp(22) + l * 1024;
          for (int i = gw * 64 + lane; i < 48 * 1024; i += NGW * 64) { const int n = i >> 10, k = i & 1023;
            float v = 0.f; if (n < 4) v = inp(13)[(size_t)(l * 1024 + k) * 4 + n]; else if (n < 36) v = inp(15)[(size_t)(l * 1024 + k) * 32 + (n - 4)];
            v *= gn[k]; const unsigned h = f2bf(v);
            const int fo = ((((k >> 5) * 3 + (n >> 4)) * 2) * 64 + ((k >> 3) & 3) * 16 + (n & 15)) * 8 + (k & 7);
            dst[fo] = (bf16)h; dst[fo + 512] = (bf16)f2bf(v - bf2f((unsigned short)h)); } }
    }
    { bf16* wg = wsp<bf16>(F, WS_WG);
      for (int i = gw * 64 + lane; i < DEPTH * 32 * 1024; i += NGW * 64) { const int l2 = i >> 15, row = (i >> 10) & 31, k = i & 1023, hk = row >> 4, gi = row & 15;
        const float v = gi < 12 ? inp(2)[((size_t)l2 * 1024 + k) * IN_W + 1280 + hk * 12 + gi] * inp(19)[l2 * 1024 + k] : 0.f;
        wg[(l2 * 2 + hk) * 16384 + ((k >> 5) * 64 + ((k >> 3) & 3) * 16 + gi) * 8 + (k & 7)] = (bf16)f2bf(v); } }
    { float* rope = wsp<float>(F, WS_ROPE);
      for (int i = gw * 64 + lane; i < T * 32; i += NGW * 64) { const int t = i >> 5, k = i & 31;
        const float inv = powf(10000.0f, -(float)k / 32.0f); const float ang = (float)t * inv;
        rope[2 * i] = cosf(ang); rope[2 * i + 1] = sinf(ang); } }
    { float* b1 = wsp<float>(F, WS_SMALL);
      for (int i = gw * 64 + lane; i < 4 * 128; i += NGW * 64) { const int lk = i >> 7, n = i & 127;
        const float* pe = inp(4) + (size_t)lk * 2048; const float* w1 = inp(5) + (size_t)lk * 2048 * 128 + n; float s = 0.f;
        for (int kk = 0; kk < 2048; ++kk) s += pe[kk] * w1[(size_t)kk * 128];
        b1[i] = s; } }
    { bf16* HB = wsp<bf16>(F, WS_HB); float* SSQ = wsp<float>(F, WS_SSQ); bf16* MB = wsp<bf16>(F, WS_MEMB); float* SSQM = wsp<float>(F, WS_SMALL) + 1024;
      for (int m = gw; m < NTOK + NB * 256; m += NGW) {
        const bool ism = m >= NTOK; const int r = ism ? m - NTOK : m;
        const f32x4* xr = (const f32x4*)((ism ? inp(1) : inp(0)) + (size_t)r * 1024) + lane;
        unsigned long long* o8 = (unsigned long long*)((ism ? MB : HB) + (size_t)r * 1024) + lane;
        float s = 0.f;
#pragma unroll
        for (int j = 0; j < 4; ++j) { const f32x4 v = xr[64 * j]; s += (v.x * v.x + v.y * v.y) + (v.z * v.z + v.w * v.w);
            o8[64 * j] = (unsigned long long)pk2(v.x, v.y) | ((unsigned long long)pk2(v.z, v.w) << 32); }
        s = wave_sum(s);
        if (ism) { if (lane == 0) SSQM[r] = s; }
        else if (lane < 16) SSQ[(size_t)r * 16 + lane] = lane == 0 ? s : 0.f;
      } }
}

template <int NT>
DEV void skinny16(const bf16* A, size_t lda, const bf16* Bt, size_t ldb, int K, int lane, f32x4 (&acc)[NT]) {
    const int l16 = lane & 15, g4 = lane >> 4;
    const bf16* ap = A + (size_t)l16 * lda + g4 * 8; const bf16* bp = Bt + (size_t)l16 * ldb + g4 * 8;
#pragma unroll
    for (int n = 0; n < NT; ++n) acc[n] = (f32x4){0.f, 0.f, 0.f, 0.f};
#pragma unroll 2
    for (int k = 0; k < K; k += 32) {
        const bf16x8 a = *(const bf16x8*)(ap + k);
#pragma unroll
        for (int n = 0; n < NT; ++n) { const bf16x8 b = *(const bf16x8*)(bp + (size_t)n * 16 * ldb + k); acc[n] = mfma16(a, b, acc[n]); }
    }
}

DEV void memkv_phase(Frame& F) {
    const int gw = F.vcu * NWAVES + F.wave, NGW = F.G * NWAVES, lane = F.lane, l16 = lane & 15, g4 = lane >> 4;
    const bf16* MB = wsp<bf16>(F, WS_MEMB); const float* SSQM = wsp<float>(F, WS_SMALL) + 1024;
    bf16* MK = wsp<bf16>(F, WS_MK); bf16* MVT = wsp<bf16>(F, WS_MVT);
    for (int task = gw; task < 1024; task += NGW) {
        const int l2 = task >> 9, rt = (task >> 3) & 63, chunk = task & 7;
        f32x4 acc[4];
        skinny16<4>(MB + (size_t)rt * 16 * 1024, 1024, wsp<bf16>(F, WS_WKV) + ((size_t)l2 * 512 + chunk * 64) * 1024, 1024, 1024, lane, acc);
        const int b = rt >> 4, key0 = (rt & 15) * 16 + g4 * 4;
        float rs[4];
#pragma unroll
        for (int r = 0; r < 4; ++r) rs[r] = 1.0f / sqrtf(SSQM[rt * 16 + g4 * 4 + r] * (1.0f / 1024.0f) + RMS_EPS);
#pragma unroll
        for (int nt = 0; nt < 4; ++nt) {
            const int n = chunk * 64 + nt * 16 + l16;
            if (chunk < 4) { const int head = n >> 6, d = n & 63;
#pragma unroll
                for (int r = 0; r < 4; ++r) MK[(size_t)((l2 * 4 + b) * 4 + head) * 256 * 64 + kfrag_off(key0 + r, d)] = (bf16)f2bf(acc[nt][r] * rs[r]);
            } else { const int n2 = n - 256, head = n2 >> 6, d = n2 & 63;
                v2u w; w.x = pk2(acc[nt][0] * rs[0], acc[nt][1] * rs[1]); w.y = pk2(acc[nt][2] * rs[2], acc[nt][3] * rs[3]);
                *(v2u*)(MVT + (((size_t)((l2 * 4 + b) * 4 + head) * 8 + (key0 >> 5)) * 64 + d) * 32 + slot32(key0 & 31)) = w; }
        }
    }
}

DEV void compress_phase(Frame& F, int l) {
    const int lane = F.lane, l16 = lane & 15, g4 = lane >> 4, quad = F.wave >> 2, q = F.wave & 3;
    float* part = (float*)F.ldsg + quad * (4 * 16 * 128);
    const bf16* KCR = wsp<bf16>(F, WS_KCR); const bf16* VCR = wsp<bf16>(F, WS_VCR);
    bf16* KCC = wsp<bf16>(F, WS_KCC); bf16* VCT = wsp<bf16>(F, WS_VCT);
    const float* bias1 = wsp<float>(F, WS_SMALL);
    for (int tk0 = F.vcu * 2; tk0 < 512; tk0 += F.G * 2) {
        const int tk = tk0 + quad; const int kv = tk >> 8, tile = tk & 255;
        const bf16* raw = kv ? VCR : KCR;
        const bf16* w1 = wsp<bf16>(F, WS_W1C) + (size_t)(l * 2 + kv) * 128 * 2048;
        const bf16* w2 = wsp<bf16>(F, WS_W2C) + (size_t)(l * 2 + kv) * 64 * 128;
        { const int r = tile * 16 + l16, bh = r >> 9, c = r & 511, b = bh >> 1, hkv = bh & 1;
          f32x4 acc[8];
#pragma unroll
          for (int n = 0; n < 8; ++n) acc[n] = (f32x4){0.f, 0.f, 0.f, 0.f};
#pragma unroll 2
          for (int ks = q * 16; ks < q * 16 + 16; ++ks) {
              const int kk = ks * 32 + g4 * 8, ll = kk >> 6, d = kk & 63;
              int tok = 16 * c + ll; tok = tok > T - 1 ? T - 1 : tok;
              const bf16x8 a = *(const bf16x8*)(raw + ((size_t)b * T + tok) * 128 + hkv * 64 + d);
#pragma unroll
              for (int n = 0; n < 8; ++n) { const bf16x8 bb = *(const bf16x8*)(w1 + (size_t)(n * 16 + l16) * 2048 + kk); acc[n] = mfma16(a, bb, acc[n]); }
          }
#pragma unroll
          for (int n = 0; n < 8; ++n)
#pragma unroll
              for (int r2 = 0; r2 < 4; ++r2) part[(q * 16 + g4 * 4 + r2) * 128 + n * 16 + l16] = acc[n][r2];
        }
        __syncthreads();
        { f32x4 o = (f32x4){0.f, 0.f, 0.f, 0.f};
#pragma unroll
          for (int k2 = 0; k2 < 4; ++k2) {
              const int h0 = k2 * 32 + g4 * 8;
              float hv[8];
#pragma unroll
              for (int j = 0; j < 8; ++j) { float s = bias1[(l * 2 + kv) * 128 + h0 + j];
#pragma unroll
                  for (int p = 0; p < 4; ++p) s += part[(p * 16 + l16) * 128 + h0 + j];
                  hv[j] = siluf_(s); }
              bf16x8 a; { v4u w; w.x = pk2(hv[0], hv[1]); w.y = pk2(hv[2], hv[3]); w.z = pk2(hv[4], hv[5]); w.w = pk2(hv[6], hv[7]); a = __builtin_bit_cast(bf16x8, w); }
              const bf16x8 bb = *(const bf16x8*)(w2 + (size_t)(q * 16 + l16) * 128 + h0);
              o = mfma16(a, bb, o);
          }
          const int r0 = tile * 16 + g4 * 4, bh = r0 >> 9, c0 = r0 & 511, d = q * 16 + l16;
          if (kv == 0) {
#pragma unroll
              for (int r2 = 0; r2 < 4; ++r2) KCC[(size_t)bh * 512 * 64 + kfrag_off(c0 + r2, d)] = (c0 + r2 == 511) ? (bf16)0 : (bf16)f2bf(o[r2]);
          } else {
              v2u w; w.x = pk2(o[0], o[1]); w.y = pk2(o[2], (c0 + 3 == 511) ? 0.f : o[3]);
              *(v2u*)(VCT + (((size_t)bh * 16 + (c0 >> 5)) * 64 + d) * 32 + slot32(c0 & 31)) = w;
          }
        }
        __syncthreads();
    }
}

DEV float hgrn_lb(const Frame& F, int l, int c) {
    if (l == 0) return 0.f;
    const float a = inp(7)[c], b = inp(7)[256 + c];
    return 1.0f / (1.0f + expf(a - b));
}
DEV float hgrn_logf(float z, float lb) {
    const float la = logf(fmaxf(lb, 1e-30f));
    const float ls = fminf(z, 0.f) - log1pf(expf(-fabsf(z)));
    const float lc = log1pf(-lb) + ls;
    const float mx = fmaxf(la, lc), mn = fminf(la, lc);
    return mx + log1pf(expf(mn - mx));
}
constexpr int HS = 68;
DEV f32x4 mfma4(float a, float b, f32x4 c) { return __builtin_amdgcn_mfma_f32_16x16x4f32(a, b, c, 0, 0, 0); }
DEV void hgrn_setup_chunk(Frame& F, float lb, const float (&z)[8], float* Bc, float* Kc, float* tot) {
    const int d = F.tid & 63, sg = F.tid >> 6;
    const float la = logf(fmaxf(lb, 1e-30f)), l1m = log1pf(-lb), onem = 1.0f - lb;
    float loc[8], kv[8]; float run = 0.f;
#pragma unroll
    for (int i = 0; i < 8; ++i) {
        const float ez = __expf(-fabsf(z[i]));
        const float lc = l1m + (fminf(z[i], 0.f) - __logf(1.0f + ez));
        const float mx = fmaxf(la, lc), mn = fminf(la, lc);
        run += mx + __logf(1.0f + __expf(mn - mx)); loc[i] = run;
        kv[i] = onem * (z[i] >= 0.f ? ez : 1.0f) / (1.0f + ez);
    }
    tot[sg * 64 + d] = run;
    __syncthreads();
    float off = 0.f;
    for (int g = 0; g < sg; ++g) off += tot[g * 64 + d];
#pragma unroll
    for (int i = 0; i < 8; ++i) { Bc[(sg * 8 + i) * HS + d] = off + loc[i]; Kc[(sg * 8 + i) * HS + d] = kv[i]; }
    __syncthreads();
}
DEV void hgrn_local_phase(Frame& F, int l) {
    float* Bc = (float*)F.ldsg; float* Kc = Bc + 64 * HS; float* Vc = Kc + 64 * HS; float* tot = Vc + 64 * HS;
    bf16* U = wsp<bf16>(F, WS_U); float* DEC = wsp<float>(F, WS_DEC);
    const int lane = F.lane, w = F.wave, li = lane & 15, kq = lane >> 4;
    for (int task = F.vcu; task < 2048; task += F.G) {
        const int bh = task >> 7, ch = task & 127, b = bh >> 2, h = bh & 3;
        { const int d = F.tid & 63, sg = F.tid >> 6;
          const size_t go = ((size_t)b * T + ch * 64 + sg * 8) * 256 + h * 64 + d;
          const float* HFp = wsp<float>(F, WS_HF) + go; const bf16* HIp = wsp<bf16>(F, WS_HI) + go;
          float z[8], vi[8];
#pragma unroll
          for (int i = 0; i < 8; ++i) { z[i] = HFp[(size_t)i * 256]; vi[i] = bf2f(HIp[(size_t)i * 256]); }
          hgrn_setup_chunk(F, hgrn_lb(F, l, h * 64 + d), z, Bc, Kc, tot);
          const float bl = Bc[63 * HS + d];
#pragma unroll
          for (int i = 0; i < 8; ++i) { const int s = sg * 8 + i; Kc[s * HS + d] *= __expf(bl - Bc[s * HS + d]); Vc[s * HS + d] = vi[i]; }
          if (sg == 0) DEC[(size_t)task * 64 + d] = expf(bl); }
        __syncthreads();
        { const int dI = w >> 1, e0 = (w & 1) * 32;
          f32x4 a0 = (f32x4){0.f, 0.f, 0.f, 0.f}, a1 = a0;
#pragma unroll 4
          for (int k0 = 0; k0 < 64; k0 += 4) { const int s = k0 + kq;
              const float a = Kc[s * HS + dI * 16 + li], b0 = Vc[s * HS + e0 + li], b1 = Vc[s * HS + e0 + 16 + li];
              a0 = mfma4(a, b0, a0); a1 = mfma4(a, b1, a1); }
#pragma unroll
          for (int r = 0; r < 4; ++r) { bf16* up = U + ((size_t)task * 64 + dI * 16 + 4 * kq + r) * 64 + e0 + li; up[0] = (bf16)f2bf(a0[r]); up[16] = (bf16)f2bf(a1[r]); } }
        __syncthreads();
    }
}
DEV void hgrn_scan_phase(Frame& F, int probe = 0) {
    const bf16* U = wsp<bf16>(F, WS_U); bf16* U2 = wsp<bf16>(F, probe ? WS_PROBE : WS_U2); const float* DEC = wsp<float>(F, WS_DEC);
    const int nact = (F.G * 256 >= 65536) ? 256 : 512;
    if (F.tid < nact)
    for (int gid = F.vcu * nact + F.tid; gid < 65536; gid += F.G * nact) {
        const int bh = gid >> 12, de = gid & 4095, d = de >> 6;
        float S = 0.f; const bf16* up = U + (size_t)bh * 128 * 4096 + de; bf16* op = U2 + (size_t)bh * 128 * 4096 + de; const float* dp = DEC + (size_t)bh * 128 * 64 + d;
#pragma unroll 16
        for (int ch = 0; ch < 128; ++ch) { const float u = bf2f(up[(size_t)ch * 4096]); const float dc = dp[ch * 64]; op[(size_t)ch * 4096] = (bf16)f2bf(S); S = dc * S + u; }
    }
}
DEV void hgrn_out_phase(Frame& F, int l) {
    float* Bc = (float*)F.ldsg; float* Kb = Bc + 64 * HS; float* Vc = Kb + 64 * HS; float* Qs = Vc + 64 * HS; float* Sc = Qs + 64 * HS; float* Ac = Sc + 64 * HS; float* tot = Ac + 64 * HS;
    float* Oc = Kb;
    const bf16* U = wsp<bf16>(F, WS_U2); bf16* CAT = wsp<bf16>(F, WS_CAT);
    const int lane = F.lane, w = F.wave, li = lane & 15, kq = lane >> 4;
    for (int task = F.vcu; task < 2048; task += F.G) {
        const int bh = task >> 7, ch = task & 127, b = bh >> 2, h = bh & 3;
        float gv[8];
        { const int d = F.tid & 63, sg = F.tid >> 6;
          const size_t go = ((size_t)b * T + ch * 64 + sg * 8) * 256 + h * 64 + d;
          const float* HFp = wsp<float>(F, WS_HF) + go; const bf16* HIp = wsp<bf16>(F, WS_HI) + go; const bf16* HQp = wsp<bf16>(F, WS_HQ) + go; const bf16* HGp = wsp<bf16>(F, WS_HG) + go;
          const bf16* Up = U + ((size_t)task * 64 + sg * 8) * 64 + d;
          float z[8], vi[8], qi[8], si[8];
#pragma unroll
          for (int i = 0; i < 8; ++i) { z[i] = HFp[(size_t)i * 256]; vi[i] = bf2f(HIp[(size_t)i * 256]); qi[i] = bf2f(HQp[(size_t)i * 256]); gv[i] = bf2f(HGp[(size_t)i * 256]); si[i] = bf2f(Up[(size_t)i * 64]); }
          hgrn_setup_chunk(F, hgrn_lb(F, l, h * 64 + d), z, Bc, Kb, tot);
#pragma unroll
          for (int i = 0; i < 8; ++i) { const int s = sg * 8 + i, J = s >> 4; const float rJ = J ? Bc[(16 * J - 1) * HS + d] : 0.f;
              Kb[s * HS + d] *= __expf(fminf(rJ - Bc[s * HS + d], 80.f));
              Vc[s * HS + d] = vi[i]; Qs[s * HS + d] = qi[i] * 0.125f; Sc[s * HS + d] = si[i]; } }
        __syncthreads();
#pragma unroll 1
        for (int ti = w; ti < 10; ti += 8) {
            const int I = ti < 1 ? 0 : (ti < 3 ? 1 : (ti < 6 ? 2 : 3)), J = ti - (I * (I + 1)) / 2;
            const int t = I * 16 + li; f32x4 acc = (f32x4){0.f, 0.f, 0.f, 0.f};
#pragma unroll 4
            for (int k0 = 0; k0 < 64; k0 += 4) { const int d = k0 + kq; const float rJ = J ? Bc[(16 * J - 1) * HS + d] : 0.f;
                const float a = Qs[t * HS + d] * __expf(Bc[t * HS + d] - rJ), bb = Kb[(J * 16 + li) * HS + d];
                acc = mfma4(a, bb, acc); }
#pragma unroll
            for (int r = 0; r < 4; ++r) { const int tt = I * 16 + 4 * kq + r, ss = J * 16 + li; Ac[tt * HS + ss] = (ss <= tt) ? acc[r] : 0.f; }
        }
        __syncthreads();
        { const int I = w >> 1, e0 = (w & 1) * 32, t = I * 16 + li;
          f32x4 a0 = (f32x4){0.f, 0.f, 0.f, 0.f}, a1 = a0;
#pragma unroll 4
          for (int k0 = 0; k0 < 64; k0 += 4) { const int d = k0 + kq;
              const float a = Qs[t * HS + d] * __expf(Bc[t * HS + d]), b0 = Sc[d * HS + e0 + li], b1 = Sc[d * HS + e0 + 16 + li];
              a0 = mfma4(a, b0, a0); a1 = mfma4(a, b1, a1); }
#pragma unroll 1
          for (int s0 = 0; s0 < 16 * (I + 1); s0 += 4) { const int s = s0 + kq;
              const float a = Ac[t * HS + s], b0 = Vc[s * HS + e0 + li], b1 = Vc[s * HS + e0 + 16 + li];
              a0 = mfma4(a, b0, a0); a1 = mfma4(a, b1, a1); }
#pragma unroll
          for (int r = 0; r < 4; ++r) { float* op = Oc + (I * 16 + 4 * kq + r) * HS + e0 + li; op[0] = a0[r]; op[16] = a1[r]; } }
        __syncthreads();
        { const float ng = inp(8)[l * 256 + h * 64 + lane];
          { const int t = w * 8 + (lane >> 3); const float* op = Oc + t * HS + (lane & 7) * 8; float s = 0.f;
#pragma unroll
            for (int j = 0; j < 8; ++j) s += op[j] * op[j];
            s += __shfl_xor(s, 1); s += __shfl_xor(s, 2); s += __shfl_xor(s, 4);
            if ((lane & 7) == 0) tot[t] = 1.0f / sqrtf(s * (1.0f / 64.0f) + RMS_EPS); }
          LDS_WAIT();
#pragma unroll
          for (int i = 0; i < 8; ++i) { const int t = w * 8 + i; const float o = Oc[t * HS + lane];
              const size_t row = (size_t)b * T + ch * 64 + t;
              CAT[row * 1024 + 768 + h * 64 + lane] = (bf16)f2bf(o * tot[t] * ng * siluf_(gv[i])); } }
        __syncthreads();
    }
}

DEV void conv_phase(Frame& F, int l) {
    const bf16* CB = wsp<bf16>(F, WS_CB); const bf16* CC = wsp<bf16>(F, WS_CC); const bf16* CH = wsp<bf16>(F, WS_CH); bf16* CAT = wsp<bf16>(F, WS_CAT);
    const float* cw = inp(3) + l * 3 * 256;
    for (int it = F.vcu * 512 + F.tid; it < NTOK * 32; it += F.G * 512) {
        const int m = it >> 5, c0 = (it & 31) * 8, t = m & (T - 1);
        const v4u bb = *(const v4u*)(CB + (size_t)m * 256 + c0);
        float y[8];
#pragma unroll
        for (int j = 0; j < 8; ++j) y[j] = 0.f;
#pragma unroll
        for (int k = 0; k < 3; ++k) {
            if (t + k - 2 >= 0) {
                const size_t o = (size_t)(m + k - 2) * 256 + c0;
                const v4u cc = *(const v4u*)(CC + o), hh = *(const v4u*)(CH + o);
#pragma unroll
                for (int j = 0; j < 4; ++j) { const float w0 = cw[k * 256 + c0 + 2 * j], w1 = cw[k * 256 + c0 + 2 * j + 1];
                    y[2 * j] += w0 * (bflo(cc[j]) * bflo(hh[j])); y[2 * j + 1] += w1 * (bfhi(cc[j]) * bfhi(hh[j])); }
            }
        }
        v4u o4;
#pragma unroll
        for (int j = 0; j < 4; ++j) o4[j] = pk2(bflo(bb[j]) * y[2 * j], bfhi(bb[j]) * y[2 * j + 1]);
        *(v4u*)(CAT + (size_t)m * 1024 + 512 + c0) = o4;
    }
}
struct SmState { float m, l; f32x4 o[4]; };
DEV void sm_reset(SmState& st) { st.m = -INFINITY; st.l = 0.f;
#pragma unroll
    for (int i = 0; i < 4; ++i) st.o[i] = (f32x4){0.f, 0.f, 0.f, 0.f}; }
DEV float sm_lsum(const SmState& st) { float l = st.l; l += __shfl_xor(l, 16); l += __shfl_xor(l, 32); return l; }
DEV void load_k(const bf16* kbase, int lane, bf16x8 (&kf)[2][2]) {
#pragma unroll
    for (int tt = 0; tt < 2; ++tt)
#pragma unroll
        for (int ks = 0; ks < 2; ++ks) kf[tt][ks] = *(const bf16x8*)(kbase + lane * 8 + (tt * 2 + ks) * 512);
}
DEV void load_v(const bf16* vbase, int lane, bf16x8 (&vf)[4]) {
    const int l16 = lane & 15, g4 = lane >> 4;
#pragma unroll
    for (int dt = 0; dt < 4; ++dt) vf[dt] = *(const bf16x8*)(vbase + (size_t)(dt * 16 + l16) * 32 + g4 * 8);
}
DEV void qk_tile(const bf16x8 (&kf)[2][2], const bf16x8 (&qf)[2], f32x4 (&s)[2]) {
#pragma unroll
    for (int tt = 0; tt < 2; ++tt) { s[tt] = mfma16(kf[tt][0], qf[0], (f32x4){0.f, 0.f, 0.f, 0.f}); s[tt] = mfma16(kf[tt][1], qf[1], s[tt]); }
}
DEV bf16x8 pack_p(const float (&p)[2][4]) {
    v4u w; w.x = pk2(p[0][0], p[0][1]); w.y = pk2(p[0][2], p[0][3]); w.z = pk2(p[1][0], p[1][1]); w.w = pk2(p[1][2], p[1][3]);
    return __builtin_bit_cast(bf16x8, w);
}
template <int MODE, class MaskF>
DEV void attn_compute(const bf16x8 (&kf)[2][2], const bf16x8 (&vf)[4], const bf16x8 (&qf)[2], SmState& st, int lane, bool colok, MaskF mask) {
    const int g4 = lane >> 4;
    f32x4 s[2]; qk_tile(kf, qf, s);
    float sv[2][4]; float tmax = -INFINITY;
#pragma unroll
    for (int tt = 0; tt < 2; ++tt)
#pragma unroll
        for (int r = 0; r < 4; ++r) { float x = s[tt][r]; if (MODE == 2) x = mask(16 * tt + 4 * g4 + r) ? x : -INFINITY; sv[tt][r] = x; tmax = fmaxf(tmax, x); }
    if (MODE == 1) tmax = colok ? tmax : -INFINITY;
    tmax = fmaxf(tmax, __shfl_xor(tmax, 16)); tmax = fmaxf(tmax, __shfl_xor(tmax, 32));
    const float mnew = fmaxf(st.m, tmax), muse = (mnew == -INFINITY) ? 0.f : mnew;
    const float alpha = ex2(st.m - muse);
    const float msub = (MODE == 1) ? (colok ? muse : INFINITY) : muse;
    float p[2][4]; float ps = 0.f;
#pragma unroll
    for (int tt = 0; tt < 2; ++tt)
#pragma unroll
        for (int r = 0; r < 4; ++r) { p[tt][r] = ex2(sv[tt][r] - msub); ps += p[tt][r]; }
    st.l = st.l * alpha + ps; st.m = mnew;
    const bf16x8 pf = pack_p(p);
#pragma unroll
    for (int dt = 0; dt < 4; ++dt) { st.o[dt] = st.o[dt] * alpha; st.o[dt] = mfma16(vf[dt], pf, st.o[dt]); }
}
template <int MODE, class MaskF>
DEV void attn_compute_fixed(const bf16x8 (&kf)[2][2], const bf16x8 (&vf)[4], const bf16x8 (&qf)[2], SmState& st, float mref, int lane, bool colok, MaskF mask) {
    const int g4 = lane >> 4;
    const float c0 = (MODE == 1) ? (colok ? -mref : -INFINITY) : -mref;
    const f32x4 ci = {c0, c0, c0, c0};
    f32x4 s[2];
#pragma unroll
    for (int tt = 0; tt < 2; ++tt) { s[tt] = mfma16(kf[tt][0], qf[0], ci); s[tt] = mfma16(kf[tt][1], qf[1], s[tt]); }
    float p[2][4];
#pragma unroll
    for (int tt = 0; tt < 2; ++tt)
#pragma unroll
        for (int r = 0; r < 4; ++r) { float x = s[tt][r]; if (MODE == 2) x = mask(16 * tt + 4 * g4 + r) ? x : -INFINITY; p[tt][r] = ex2(x); }
    st.l += ((p[0][0] + p[0][1]) + (p[0][2] + p[0][3])) + ((p[1][0] + p[1][1]) + (p[1][2] + p[1][3]));
    const bf16x8 pf = pack_p(p);
#pragma unroll
    for (int dt = 0; dt < 4; ++dt) st.o[dt] = mfma16(vf[dt], pf, st.o[dt]);
}
template <int MODE, class MaskF>
DEV void attn_max(const bf16x8 (&kf)[2][2], const bf16x8 (&qf)[2], float& mx, int lane, bool colok, MaskF mask) {
    const int g4 = lane >> 4;
    f32x4 s[2]; qk_tile(kf, qf, s);
    float tmax = -INFINITY;
#pragma unroll
    for (int tt = 0; tt < 2; ++tt)
#pragma unroll
        for (int r = 0; r < 4; ++r) { float x = s[tt][r]; if (MODE == 2) x = mask(16 * tt + 4 * g4 + r) ? x : -INFINITY; tmax = fmaxf(tmax, x); }
    if (MODE == 1) tmax = colok ? tmax : -INFINITY;
    mx = fmaxf(mx, tmax);
}
DEV float colmax_finish(float mx) { mx = fmaxf(mx, __shfl_xor(mx, 16)); mx = fmaxf(mx, __shfl_xor(mx, 32)); return mx == -INFINITY ? 0.f : mx; }
DEV float col_norm(const bf16x8 (&qf)[2]) {
    float s = 0.f;
#pragma unroll
    for (int ks = 0; ks < 2; ++ks) { const v4u w = __builtin_bit_cast(v4u, qf[ks]);
#pragma unroll
        for (int j = 0; j < 4; ++j) { const float a = bflo(w[j]), b = bfhi(w[j]); s += a * a + b * b; } }
    s += __shfl_xor(s, 16); s += __shfl_xor(s, 32);
    return sqrtf(s);
}
DEV float wave_max_uniform(float v) {
#pragma unroll
    for (int o = 1; o < 64; o <<= 1) v = fmaxf(v, __shfl_xor(v, o));
    return __builtin_bit_cast(float, __builtin_amdgcn_readfirstlane(__builtin_bit_cast(int, v)));
}
constexpr float FIXED_REF_MAX = 40.f;
DEV void kmax_phase(Frame& F, int l) {
    const int lane = F.lane; const int gw = F.vcu * NWAVES + F.wave, NGW = F.G * NWAVES;
    for (int item = gw; item < 2048; item += NGW) {
        const int br = item >> 10, bh = (item >> 7) & 7, key = (item & 127) * 64 + lane;
        const bf16* kp = wsp<bf16>(F, br ? WS_KW : WS_KS) + (size_t)bh * T * 64;
        float s = 0.f;
#pragma unroll
        for (int i = 0; i < 8; ++i) { const v4u w = *(const v4u*)(kp + kfrag_off(key, i * 8));
#pragma unroll
            for (int j = 0; j < 4; ++j) { const float a = bflo(w[j]), b = bfhi(w[j]); s += a * a + b * b; } }
#pragma unroll
        for (int o = 1; o < 64; o <<= 1) s = fmaxf(s, __shfl_xor(s, o));
        if (lane == 0) __hip_atomic_fetch_max((unsigned*)F.ctl + CW_KMAX + l * 16 + br * 8 + bh, __builtin_bit_cast(unsigned, s), RLX_AGENT);
    }
}
struct NoMask { DEV bool operator()(int) const { return true; } };
template <int D, bool WITHV, class AddrF, class BodyF>
DEV void pipe_run(int n, int lane, AddrF addr, BodyF body) {
    if (n <= 0) return;
    bf16x8 kf[D][2][2], vf[D][4];
#pragma unroll
    for (int d = 0; d < D; ++d) { const bf16* kb; const bf16* vb; addr(d < n ? d : n - 1, kb, vb); load_k(kb, lane, kf[d]); if (WITHV) load_v(vb, lane, vf[d]); }
#pragma unroll 1
    for (int i = 0; i < n; i += D) {
#pragma unroll
        for (int d = 0; d < D; ++d) { const int s = i + d;
            if (s < n) body(s, kf[d], vf[d]);
            if (D > 1 || s + 1 < n) { const bf16* kb; const bf16* vb; addr(s + D < n ? s + D : n - 1, kb, vb); load_k(kb, lane, kf[d]); if (WITHV) load_v(vb, lane, vf[d]); } }
    }
}
template <class AddrF, class BodyF>
DEV void pipe_run_k2(int n, int lane, AddrF addr, BodyF body) {
    if (n <= 0) return;
    bf16x8 kf[2][2][2], vf[4];
    { const bf16* kb; const bf16* vb; addr(0, kb, vb); load_k(kb, lane, kf[0]); }
#pragma unroll 1
    for (int i = 0; i < n; i += 2) {
#pragma unroll
        for (int d = 0; d < 2; ++d) { const int s = i + d;
            { const bf16* kb; const bf16* vb; addr(s < n ? s : n - 1, kb, vb); load_v(vb, lane, vf); }
            { const bf16* kb; const bf16* vb; addr(s + 1 < n ? s + 1 : n - 1, kb, vb); load_k(kb, lane, kf[d ^ 1]); }
            if (s < n) body(s, kf[d], vf); }
    }
}
template <class AddrF, class BodyA, class BodyB>
DEV void pipe_run_mt(int n_main, int n_tail, int lane, AddrF addr, BodyA mainb, BodyB tailb) {
    const int n = n_main + n_tail;
    bf16x8 kf[2][2][2], vf[4];
    { const bf16* kb; const bf16* vb; addr(0, kb, vb); load_k(kb, lane, kf[0]); }
    int i = 0;
#define PIPE_STEP_(s_, d_, BODY_) do { { const bf16* kb; const bf16* vb; addr((s_) < n ? (s_) : n - 1, kb, vb); load_v(vb, lane, vf); } \
        { const bf16* kb; const bf16* vb; addr((s_) + 1 < n ? (s_) + 1 : n - 1, kb, vb); load_k(kb, lane, kf[(d_) ^ 1]); } BODY_((s_), kf[d_], vf); } while (0)
#pragma unroll 1
    for (; i + 2 <= n_main; i += 2) { PIPE_STEP_(i, 0, mainb); PIPE_STEP_(i + 1, 1, mainb); }
    if (i < n_main) { PIPE_STEP_(i, 0, mainb); ++i;
#pragma unroll
        for (int a = 0; a < 2; ++a)
#pragma unroll
            for (int b = 0; b < 2; ++b) kf[0][a][b] = kf[1][a][b]; }
#pragma unroll 1
    for (; i < n; ++i) { PIPE_STEP_(i, 0, tailb);
#pragma unroll
        for (int a = 0; a < 2; ++a)
#pragma unroll
            for (int b = 0; b < 2; ++b) kf[0][a][b] = kf[1][a][b]; }
#undef PIPE_STEP_
}
constexpr int PIPE_D = 2;

DEV void acc_add_packed(unsigned (&pk)[4][4][2], int ct, const f32x4 (&o)[4], float sc, bool first) {
#pragma unroll
    for (int dt = 0; dt < 4; ++dt) {
        f32x4 v = o[dt] * sc;
        if (!first) { v[0] += bflo(pk[ct][dt][0]); v[1] += bfhi(pk[ct][dt][0]); v[2] += bflo(pk[ct][dt][1]); v[3] += bfhi(pk[ct][dt][1]); }
        pk[ct][dt][0] = pk2(v[0], v[1]); pk[ct][dt][1] = pk2(v[2], v[3]);
    }
}
template <int VAR>
DEV void nsa_phase_t(Frame& F, int l) {
#define NSA_RELANE() int ln_ = lane; asm volatile("" : "+v"(ln_)); const int l16 = ln_ & 15, g4 = ln_ >> 4, tq = l16 >> 2, gh = l16 & 3; const size_t mrow0 = (size_t)b * T + t0 + tq; const int tl0 = t0 + tq; (void)l16; (void)g4; (void)gh; (void)mrow0; (void)tl0
    float* IMP = (float*)(F.ldsg + F.wave * NSA_LDS_WAVE);
    float* VALS = IMP + 2048; int* BL = (int*)(IMP + 2176); unsigned* SELB = (unsigned*)(IMP + 2304); float* GL = IMP + 2432;
    const bf16* Q = wsp<bf16>(F, WS_Q);
    const bf16* KCC = wsp<bf16>(F, WS_KCC); const bf16* VCT = wsp<bf16>(F, WS_VCT);
    const bf16* KS = wsp<bf16>(F, WS_KS); const bf16* VST = wsp<bf16>(F, WS_VST);
    const bf16* KW = wsp<bf16>(F, WS_KW); const bf16* VWT = wsp<bf16>(F, WS_VWT);
    bf16* CAT = wsp<bf16>(F, WS_CAT);
    const int gw = F.vcu * NWAVES + F.wave, NGW = F.G * NWAVES;
    const bool xmap = (F.G == 256);
#pragma unroll 1
    for (int task = gw; task < 4096; task += NGW) {
        unsigned zl_ = 0u; asm volatile("" : "+v"(zl_)); const int lane = (int)__builtin_amdgcn_mbcnt_hi(~0u, __builtin_amdgcn_mbcnt_lo(~0u, zl_));
        const int u_ = (F.wave < 4) ? (F.vcu & 31) : 63 - (F.vcu & 31), first_ = 4 * u_ + (F.wave & 3);
        const int bh = xmap ? (gw >> 8) : (task & 7), idx = xmap ? ((task >> 11) ? 511 - first_ : first_) : (task >> 3);
        const int t0 = idx * 16, b = bh >> 1, hkv = bh & 1, cur = t0 >> 6;
        bf16x8 qf[4][2];
        unsigned opk[4][4][2];
        SmState st[4];
        float qnmax = 0.f;
        { NSA_RELANE();
#pragma unroll
        for (int ct = 0; ct < 4; ++ct)
#pragma unroll
            for (int ks = 0; ks < 2; ++ks) qf[ct][ks] = *(const bf16x8*)(Q + (mrow0 + 4 * ct) * 512 + hkv * 256 + gh * 64 + ks * 32 + g4 * 8);
        { NSA_RELANE();
          f32x4 ga[1]; ga[0] = (f32x4){0.f, 0.f, 0.f, 0.f};
          { const bf16* ap = wsp<bf16>(F, WS_HB) + ((size_t)b * T + t0 + l16) * 1024 + g4 * 8; const bf16* bp = wsp<bf16>(F, WS_WG) + (size_t)(l * 2 + hkv) * 16384 + ln_ * 8;
#pragma unroll 1
            for (int k0 = 0; k0 < (VAR == 11 ? 0 : 1024); k0 += 256) {
                bf16x8 av[8], bv[8];
#pragma unroll
                for (int i = 0; i < 8; ++i) { av[i] = *(const bf16x8*)(ap + k0 + 32 * i); bv[i] = *(const bf16x8*)(bp + (k0 + 32 * i) * 16); }
#pragma unroll
                for (int i = 0; i < 8; ++i) ga[0] = mfma16(av[i], bv[i], ga[0]);
            } }
          const float rs = (ln_ < 16) ? row_rstd_full(wsp<float>(F, WS_SSQ), b * T + t0 + ln_) : 0.f;
#pragma unroll
          for (int r = 0; r < 4; ++r) GL[(g4 * 4 + r) * 16 + l16] = sigmoidf_(ga[0][r] * __shfl(rs, g4 * 4 + r));
        }
        const int ngc = (VAR == 10 || VAR == 12) ? 0 : (t0 + 15 >= 31) ? (((t0 + 15 - 31) >> 4) >> 5) + 1 : 0;
        const bf16* kcb = KCC + (size_t)bh * 512 * 64; const bf16* vcb = VCT + (size_t)bh * 16 * 64 * 32;
        float cm[4], cl[4];
#pragma unroll
        for (int ct = 0; ct < 4; ++ct) { cm[ct] = -INFINITY; cl[ct] = 0.f; }
        pipe_run<1, false>(ngc, ln_, [&](int s, const bf16*& kb, const bf16*& vb) { kb = kcb + (size_t)s * 32 * 64; vb = vcb; },
            [&](int kg, const bf16x8 (&kf)[2][2], const bf16x8 (&)[4]) {
#pragma unroll
                for (int ct = 0; ct < 4; ++ct) {
                    const int tl = tl0 + 4 * ct;
                    f32x4 s[2]; qk_tile(kf, qf[ct], s);
                    float sv[2][4]; float tmax = -INFINITY;
#pragma unroll
                    for (int tt = 0; tt < 2; ++tt)
#pragma unroll
                        for (int r = 0; r < 4; ++r) { const int c = kg * 32 + 16 * tt + 4 * g4 + r; sv[tt][r] = (16 * c + 31 <= tl) ? s[tt][r] : -INFINITY; tmax = fmaxf(tmax, sv[tt][r]); }
                    tmax = fmaxf(tmax, __shfl_xor(tmax, 16)); tmax = fmaxf(tmax, __shfl_xor(tmax, 32));
                    const float mnew = fmaxf(cm[ct], tmax), muse = (mnew == -INFINITY) ? 0.f : mnew;
                    float ps = 0.f;
#pragma unroll
                    for (int tt = 0; tt < 2; ++tt)
#pragma unroll
                        for (int r = 0; r < 4; ++r) ps += ex2(sv[tt][r] - muse);
                    cl[ct] = cl[ct] * ex2(cm[ct] - muse) + ps; cm[ct] = mnew;
                }
            });
        {
            float cmu[4], cinv[4], carry[4];
#pragma unroll
            for (int ct = 0; ct < 4; ++ct) { float l = cl[ct]; l += __shfl_xor(l, 16); l += __shfl_xor(l, 32);
                cmu[ct] = (cm[ct] == -INFINITY) ? 0.f : cm[ct]; cinv[ct] = l > 0.f ? 1.0f / l : 0.f; carry[ct] = 0.f; sm_reset(st[ct]); }
            pipe_run<1, true>(ngc, ln_, [&](int s, const bf16*& kb, const bf16*& vb) { kb = kcb + (size_t)s * 32 * 64; vb = vcb + (size_t)s * 64 * 32; },
                [&](int kg, const bf16x8 (&kf)[2][2], const bf16x8 (&vf)[4]) {
#pragma unroll
                    for (int ct = 0; ct < 4; ++ct) {
                        const int tl = tl0 + 4 * ct;
                        f32x4 s[2]; qk_tile(kf, qf[ct], s);
                        float p[2][4];
#pragma unroll
                        for (int tt = 0; tt < 2; ++tt) {
#pragma unroll
                            for (int r = 0; r < 4; ++r) { const int c = kg * 32 + 16 * tt + 4 * g4 + r; p[tt][r] = (16 * c + 31 <= tl) ? ex2(s[tt][r] - cmu[ct]) * cinv[ct] : 0.f; }
                            const float hb = 0.5f * p[tt][3];
                            const float bsh = __shfl(hb, (ln_ + 48) & 63);
                            float v = ((p[tt][0] + p[tt][1]) + (p[tt][2] + hb)) + ((g4 == 0) ? carry[ct] : bsh);
                            carry[ct] = bsh;
                            v += __shfl_xor(v, 1); v += __shfl_xor(v, 2);
                            if (gh == 0) IMP[(4 * ct + tq) * 128 + kg * 8 + 4 * tt + g4] = v;
                        }
                        const bf16x8 pf = pack_p(p);
#pragma unroll
                        for (int dt = 0; dt < 4; ++dt) st[ct].o[dt] = mfma16(vf[dt], pf, st[ct].o[dt]);
                    }
                });
#pragma unroll
            for (int ct = 0; ct < 4; ++ct) acc_add_packed(opk, ct, st[ct].o, GL[(4 * ct + tq) * 16 + gh * 3 + 0], true);
        }
        }
        LDS_WAIT();
        unsigned sb0 = 0u, sb1 = 0u;
        if (cur < 16) { sb0 = (lane <= cur) ? 0xffffu : 0u; }
        else if (VAR == 6) {
#pragma unroll 1
            for (int q = 0; q < 16; ++q) { const bool s0 = (lane <= cur) && ((lane * 37 + q * 11) % (cur + 1)) < 16, s1 = (lane + 64 <= cur) && (((lane + 64) * 37 + q * 11) % (cur + 1)) < 16;
                sb0 |= (s0 ? 1u : 0u) << q; sb1 |= (s1 ? 1u : 0u) << q; }
        }
        else {
            const unsigned long long below = (1ull << lane) - 1ull;
#pragma unroll 1
            for (int q = 0; q < 16; ++q) {
                unsigned k0, k1;
                { const int j = lane; const float v = (j == 0 || j == cur || j == cur - 1) ? 1e6f : IMP[q * 128 + j]; k0 = (j > cur) ? 0u : __builtin_bit_cast(unsigned, v) + 1u; }
                { const int j = lane + 64; const float v = (j == cur || j == cur - 1) ? 1e6f : IMP[q * 128 + j]; k1 = (j > cur) ? 0u : __builtin_bit_cast(unsigned, v) + 1u; }
                unsigned lo = 0u, hi = 0xffffffffu;
                while (hi - lo > 1u) { const unsigned mid = lo + ((hi - lo) >> 1);
                    const int c = __builtin_popcountll(__ballot(k0 >= mid)) + __builtin_popcountll(__ballot(k1 >= mid));
                    if (c == 16) { lo = mid; break; }
                    if (c > 16) lo = mid; else hi = mid; }
                const unsigned long long g0 = __ballot(k0 > lo), g1 = __ballot(k1 > lo), e0 = __ballot(k0 == lo), e1 = __ballot(k1 == lo);
                const int need = 16 - __builtin_popcountll(g0) - __builtin_popcountll(g1);
                const bool s0 = (k0 > lo) || (k0 == lo && __builtin_popcountll(e0 & below) < need);
                const bool s1 = (k1 > lo) || (k1 == lo && __builtin_popcountll(e0) + __builtin_popcountll(e1 & below) < need);
                sb0 |= (s0 ? 1u : 0u) << q; sb1 |= (s1 ? 1u : 0u) << q;
            }
        }
        SELB[lane] = sb0; SELB[lane + 64] = sb1;
        LDS_WAIT();
#define NSA_PARK() do { _Pragma("unroll") for (int i_ = 0; i_ < 8; ++i_) { v4u w_; w_.x = opk[i_ >> 1][(i_ & 1) * 2][0]; w_.y = opk[i_ >> 1][(i_ & 1) * 2][1]; w_.z = opk[i_ >> 1][(i_ & 1) * 2 + 1][0]; w_.w = opk[i_ >> 1][(i_ & 1) * 2 + 1][1]; ((v4u*)IMP)[i_ * 64 + lane] = w_; } } while (0)
#define NSA_UNPARK() do { _Pragma("unroll") for (int i_ = 0; i_ < 8; ++i_) { const v4u w_ = ((const v4u*)IMP)[i_ * 64 + lane]; opk[i_ >> 1][(i_ & 1) * 2][0] = w_.x; opk[i_ >> 1][(i_ & 1) * 2][1] = w_.y; opk[i_ >> 1][(i_ & 1) * 2 + 1][0] = w_.z; opk[i_ >> 1][(i_ & 1) * 2 + 1][1] = w_.w; } } while (0)
        NSA_PARK();
        { NSA_RELANE();
#pragma unroll
        for (int ct = 0; ct < 4; ++ct) {
            const float* rp = wsp<float>(F, WS_ROPE) + ((size_t)(tl0 + 4 * ct) * 32 + g4 * 8) * 2;
            const v4u a = __builtin_bit_cast(v4u, qf[ct][0]), b2 = __builtin_bit_cast(v4u, qf[ct][1]); v4u ra, rb;
#pragma unroll
            for (int jj = 0; jj < 4; ++jj) { const f32x4 cs = *(const f32x4*)(rp + 4 * jj);
                const float x1a = bflo(a[jj]), x1b = bfhi(a[jj]), x2a = bflo(b2[jj]), x2b = bfhi(b2[jj]);
                ra[jj] = pk2(x1a * cs[0] - x2a * cs[1], x1b * cs[2] - x2b * cs[3]);
                rb[jj] = pk2(x2a * cs[0] + x1a * cs[1], x2b * cs[2] + x1b * cs[3]); }
            qf[ct][0] = __builtin_bit_cast(bf16x8, ra); qf[ct][1] = __builtin_bit_cast(bf16x8, rb);
        }
        {
            const unsigned long long ulo = __ballot(sb0 != 0u), uhi = __ballot(sb1 != 0u);
            const unsigned long long below = (1ull << ln_) - 1ull;
            const int nlo = __builtin_popcountll(ulo), nblk = nlo + __builtin_popcountll(uhi);
            if (sb0 != 0u) BL[__builtin_popcountll(ulo & below)] = ln_;
            if (sb1 != 0u) BL[nlo + __builtin_popcountll(uhi & below)] = ln_ + 64;
            LDS_WAIT();
#pragma unroll
            for (int ct = 0; ct < 4; ++ct) sm_reset(st[ct]);
            const bf16* kb0 = KS + (size_t)bh * T * 64; const bf16* vb0 = VST + (size_t)bh * 256 * 64 * 32;
            float mr; bool fixed;
            { const float kmx = sqrtf(__builtin_bit_cast(float, __hip_atomic_load((const unsigned*)F.ctl + CW_KMAX + l * 16 + bh, RLX_AGENT))); float mm = 0.f;
#pragma unroll
              for (int ct = 0; ct < 4; ++ct) mm = fmaxf(mm, col_norm(qf[ct]));
              qnmax = wave_max_uniform(mm); mr = qnmax * kmx * 1.002f + 1e-3f;
              fixed = mr < FIXED_REF_MAX; }
            auto addr_sel = [&](int s, const bf16*& kb, const bf16*& vb) { const int g32 = (VAR == 7) ? (s & 1) : BL[s >> 1] * 2 + (s & 1); kb = kb0 + (size_t)g32 * 32 * 64; vb = vb0 + (size_t)g32 * 64 * 32; };
            asm volatile("" ::: "memory");
            if (!fixed) {
                float mx[4] = {-INFINITY, -INFINITY, -INFINITY, -INFINITY};
                pipe_run<1, false>(2 * nblk, ln_, addr_sel,
                    [&](int s, const bf16x8 (&kf)[2][2], const bf16x8 (&)[4]) {
                        const int j = BL[s >> 1], key0 = j * 64 + (s & 1) * 32;
                        const unsigned tm = (unsigned)__builtin_amdgcn_readfirstlane((int)SELB[j]);
#pragma unroll
                        for (int ct = 0; ct < 4; ++ct) { const unsigned tmk = (tm >> (4 * ct)) & 0xFu;
                            if (tmk) { const bool colok = (tmk >> tq) & 1u; const int tl = tl0 + 4 * ct;
                                if (j == cur) attn_max<2>(kf, qf[ct], mx[ct], ln_, true, [&](int kk) { return colok && (key0 + kk <= tl); });
                                else attn_max<1>(kf, qf[ct], mx[ct], ln_, colok, NoMask()); } }
                    });
                mr = wave_max_uniform(fmaxf(fmaxf(mx[0], mx[1]), fmaxf(mx[2], mx[3]))); if (mr == -INFINITY) mr = 0.f;
            }
            asm volatile("" ::: "memory");
            if (VAR != 4 && VAR != 12)
            pipe_run_mt(2 * nblk - 2, 2, ln_, addr_sel,
                [&](int s, const bf16x8 (&kf)[2][2], const bf16x8 (&vf)[4]) {
                    const int j = BL[s >> 1];
                    const unsigned tm = (unsigned)__builtin_amdgcn_readfirstlane((int)SELB[j]);
#pragma unroll
                    for (int ct = 0; ct < 4; ++ct) {
                        const unsigned tmk = (tm >> (4 * ct)) & 0xFu;
                        if (tmk) attn_compute_fixed<1>(kf, vf, qf[ct], st[ct], mr, ln_, (tmk >> tq) & 1u, NoMask());
                    }
                },
                [&](int s, const bf16x8 (&kf)[2][2], const bf16x8 (&vf)[4]) {
                    const int key0 = cur * 64 + (s & 1) * 32;
#pragma unroll
                    for (int ct = 0; ct < 4; ++ct) { const int tl = tl0 + 4 * ct;
                        attn_compute_fixed<2>(kf, vf, qf[ct], st[ct], mr, ln_, true, [&](int kk) { return key0 + kk <= tl; }); }
                });
            LDS_WAIT();
            NSA_UNPARK();
#pragma unroll
            for (int ct = 0; ct < 4; ++ct) { const float ls = sm_lsum(st[ct]); const float gs = GL[(4 * ct + tq) * 16 + gh * 3 + 1];
                acc_add_packed(opk, ct, st[ct].o, ls > 0.f ? gs / ls : 0.f, false); }
            NSA_PARK();
        }
        }
        { NSA_RELANE();
#pragma unroll
            for (int ct = 0; ct < 4; ++ct) sm_reset(st[ct]);
            const bf16* kb0 = (VAR == 3 ? KS : KW) + (size_t)bh * T * 64; const bf16* vb0 = (VAR == 3 ? VST : VWT) + (size_t)bh * 256 * 64 * 32;
            const int glo = (t0 - 511 > 0 ? t0 - 511 : 0) >> 5, ghi = (t0 + 15) >> 5;
            float mr; bool fixed;
            { const float kmx = sqrtf(__builtin_bit_cast(float, __hip_atomic_load((const unsigned*)F.ctl + CW_KMAX + l * 16 + 8 + bh, RLX_AGENT)));
              mr = qnmax * kmx * 1.002f + 1e-3f;
              fixed = mr < FIXED_REF_MAX; }
            auto addr_win = [&](int s, const bf16*& kb, const bf16*& vb) { kb = kb0 + (size_t)(glo + s) * 32 * 64; vb = vb0 + (size_t)(glo + s) * 64 * 32; };
            asm volatile("" ::: "memory");
            if (!fixed) {
                float mx[4] = {-INFINITY, -INFINITY, -INFINITY, -INFINITY};
                pipe_run<1, false>(ghi - glo + 1, ln_, addr_win,
                    [&](int s, const bf16x8 (&kf)[2][2], const bf16x8 (&)[4]) {
                        const int key0 = (glo + s) * 32;
#pragma unroll
                        for (int ct = 0; ct < 4; ++ct) { const int tl = tl0 + 4 * ct;
                            attn_max<2>(kf, qf[ct], mx[ct], ln_, true, [&](int kk) { const int kp = key0 + kk; return kp <= tl && kp + 512 > tl; }); }
                    });
                mr = wave_max_uniform(fmaxf(fmaxf(mx[0], mx[1]), fmaxf(mx[2], mx[3]))); if (mr == -INFINITY) mr = 0.f;
            }
            asm volatile("" ::: "memory");
            const int g_a = (t0 >= 497) ? ((t0 - 497) >> 5) + 1 : 0, g_b = (t0 - 31) >> 5;
            const int n_main = g_b >= g_a ? g_b - g_a + 1 : 0, n_up = ghi - (g_b >= g_a ? g_b : g_a - 1), n_tail = n_up + (g_a - glo);
            auto grp = [&](int s) { const int u = s - n_main; return s < n_main ? g_a + s : (u < n_up ? ghi - n_up + 1 + u : glo + (u - n_up)); };
            auto addr_w2 = [&](int s, const bf16*& kb, const bf16*& vb) { const int g = grp(s); kb = kb0 + (size_t)g * 32 * 64; vb = vb0 + (size_t)g * 64 * 32; };
            if (VAR != 5 && VAR != 12)
            pipe_run_mt(n_main, n_tail, ln_, addr_w2,
                [&](int, const bf16x8 (&kf)[2][2], const bf16x8 (&vf)[4]) {
#pragma unroll
                    for (int ct = 0; ct < 4; ++ct) attn_compute_fixed<0>(kf, vf, qf[ct], st[ct], mr, ln_, true, NoMask());
                },
                [&](int s, const bf16x8 (&kf)[2][2], const bf16x8 (&vf)[4]) {
                    const int key0 = grp(s) * 32;
#pragma unroll
                    for (int ct = 0; ct < 4; ++ct) {
                        const int tlo = t0 + 4 * ct, thi = tlo + 3, tl = tl0 + 4 * ct;
                        if (key0 > thi || key0 + 31 + 512 <= tlo) continue;
                        attn_compute_fixed<2>(kf, vf, qf[ct], st[ct], mr, ln_, true, [&](int kk) { const int kp = key0 + kk; return kp <= tl && kp + 512 > tl; });
                    }
                });
            NSA_UNPARK();
#pragma unroll
            for (int ct = 0; ct < 4; ++ct) { const float ls = sm_lsum(st[ct]); const float gwn = GL[(4 * ct + tq) * 16 + gh * 3 + 2];
                acc_add_packed(opk, ct, st[ct].o, ls > 0.f ? gwn / ls : 0.f, false); }
        }
        { NSA_RELANE();
#pragma unroll
        for (int ct = 0; ct < 4; ++ct)
#pragma unroll
            for (int dt = 0; dt < 4; ++dt) { v2u w; w.x = opk[ct][dt][0]; w.y = opk[ct][dt][1];
                if (VAR == 0 || w.x == 0x7fc17fc1u) *(v2u*)(CAT + (mrow0 + 4 * ct) * 1024 + hkv * 256 + gh * 64 + dt * 16 + g4 * 4) = w; }
        }
        LDS_WAIT();
        if (VAR == 0 && xmap) convert_experts(F, l, (bf16*)IMP, task >> 11);
    }
#undef NSA_RELANE
#undef NSA_PARK
#undef NSA_UNPARK
}

DEV void nsa_phase(Frame& F, int l) { nsa_phase_t<0>(F, l); }

DEV void cross_phase(Frame& F, int l) {
    const int lane = F.lane, l16 = lane & 15, g4 = lane >> 4;
    const bf16* XQ = wsp<bf16>(F, WS_XQ); bf16* XO = wsp<bf16>(F, WS_XO);
    const int gw = F.vcu * NWAVES + F.wave, NGW = F.G * NWAVES;
#pragma unroll 1
    for (int task = gw; task < 2048; task += NGW) {
        const int head = task & 3, m0 = (task >> 2) * 64, b = m0 >> 13;
        bf16x8 qf[4][2];
#pragma unroll
        for (int ct = 0; ct < 4; ++ct)
#pragma unroll
            for (int ks = 0; ks < 2; ++ks) qf[ct][ks] = *(const bf16x8*)(XQ + (size_t)(m0 + 16 * ct + l16) * 256 + head * 64 + ks * 32 + g4 * 8);
        const bf16* kb0 = wsp<bf16>(F, WS_MK) + (size_t)((l * 4 + b) * 4 + head) * 256 * 64;
        const bf16* vb0 = wsp<bf16>(F, WS_MVT) + (size_t)((l * 4 + b) * 4 + head) * 8 * 64 * 32;
        SmState st[4];
#pragma unroll
        for (int ct = 0; ct < 4; ++ct) sm_reset(st[ct]);
        pipe_run<PIPE_D, true>(8, lane, [&](int s, const bf16*& kb, const bf16*& vb) { kb = kb0 + (size_t)s * 32 * 64; vb = vb0 + (size_t)s * 64 * 32; },
            [&](int, const bf16x8 (&kf)[2][2], const bf16x8 (&vf)[4]) {
#pragma unroll
                for (int ct = 0; ct < 4; ++ct) attn_compute<0>(kf, vf, qf[ct], st[ct], lane, true, NoMask());
            });
#pragma unroll
        for (int ct = 0; ct < 4; ++ct) {
            const float inv = 1.0f / sm_lsum(st[ct]);
#pragma unroll
            for (int dt = 0; dt < 4; ++dt) { const f32x4 o = st[ct].o[dt] * inv; v2u w; w.x = pk2(o[0], o[1]); w.y = pk2(o[2], o[3]);
                *(v2u*)(XO + (size_t)(m0 + 16 * ct + l16) * 256 + head * 64 + dt * 16 + g4 * 4) = w; }
        }
    }
}


DEV void router_phase(Frame& F, int l, int probe = 0) {
    const int lane = F.lane, l16 = lane & 15, g4 = lane >> 4;
    float* LG = (float*)F.ldsg + F.wave * 768;
    const bf16* HB = wsp<bf16>(F, WS_HB); const float* SSQ = wsp<float>(F, WS_SSQ);
    const bf16* WR = wsp<bf16>(F, WS_WR) + (size_t)l * 96 * 1024;
    int* TOKE = wsp<int>(F, probe ? WS_PROBE : WS_TOKE); float* TOKG = wsp<float>(F, probe ? WS_PROBE + MiB : WS_TOKG); int* TOKP = wsp<int>(F, probe ? WS_PROBE + 2 * MiB : WS_TOKP);
    unsigned* CNT = (unsigned*)F.ctl + CW_CNT + l * 32 + (probe ? 64 : 0);
    const float* bg = inp(14) + l * 4; const float* be = inp(16) + l * 32;
    unsigned* HIST = (unsigned*)((float*)F.ldsg + 8 * 768);
#pragma unroll 1
    for (int tb = F.vcu * NWAVES; tb < NTOK / 16; tb += F.G * NWAVES) {
        const int task = tb + F.wave; const bool live = task < NTOK / 16;
        const int m0 = (live ? task : tb) * 16;
        if (F.tid < 64) HIST[F.tid] = 0u;
        f32x4 acc[3];
        {
            const bf16* ap = HB + (size_t)(m0 + l16) * 1024 + g4 * 8; const bf16* bp = WR + lane * 8;
#pragma unroll
            for (int n = 0; n < 3; ++n) acc[n] = (f32x4){0.f, 0.f, 0.f, 0.f};
#pragma unroll 4
            for (int k = 0; k < 1024; k += 32) {
                const bf16x8 a = *(const bf16x8*)(ap + k);
#pragma unroll
                for (int n = 0; n < 3; ++n) { const bf16x8 bh = *(const bf16x8*)(bp + ((k >> 5) * 6 + n * 2) * 512), bl = *(const bf16x8*)(bp + ((k >> 5) * 6 + n * 2 + 1) * 512);
                    acc[n] = mfma16(a, bh, acc[n]); acc[n] = mfma16(a, bl, acc[n]); }
            }
        }
#pragma unroll
        for (int nt = 0; nt < 3; ++nt)
#pragma unroll
            for (int r = 0; r < 4; ++r) LG[(g4 * 4 + r) * 48 + nt * 16 + l16] = acc[nt][r];
        LDS_WAIT();
        int id1 = 0, id2 = 0;
        if (lane < 16) {
            const int m = m0 + lane; const float rstd = row_rstd_full(SSQ, m); const float* lg = LG + lane * 48;
            float g[4];
#pragma unroll
            for (int j = 0; j < 4; ++j) g[j] = lg[j] * rstd + bg[j];
            float gmax = g[0]; int grp = 0;
#pragma unroll
            for (int j = 1; j < 4; ++j) if (g[j] > gmax) { gmax = g[j]; grp = j; }
            float den = 0.f;
#pragma unroll
            for (int j = 0; j < 4; ++j) den += expf(g[j] - gmax);
            const float psel = 1.0f / den;
            float e1 = -INFINITY, e2 = -INFINITY; int i1 = 0, i2 = 0;
            for (int j = 0; j < 8; ++j) { const float v = lg[4 + grp * 8 + j] * rstd + be[grp * 8 + j];
                if (v > e1) { e2 = e1; i2 = i1; e1 = v; i1 = j; } else if (v > e2) { e2 = v; i2 = j; } }
            const float x = expf(e2 - e1), w1 = 1.0f / (1.0f + x), w2 = x * w1;
            id1 = grp * 8 + i1; id2 = grp * 8 + i2;
            if (live) { TOKE[m * 2] = id1; TOKE[m * 2 + 1] = id2; TOKG[m * 2] = psel * w1; TOKG[m * 2 + 1] = psel * w2; }
        }
        __syncthreads();
        unsigned lp1 = 0u, lp2 = 0u;
        if (lane < 16 && live) { lp1 = __hip_atomic_fetch_add(HIST + id1, 1u, __ATOMIC_RELAXED, __HIP_MEMORY_SCOPE_WORKGROUP); lp2 = __hip_atomic_fetch_add(HIST + id2, 1u, __ATOMIC_RELAXED, __HIP_MEMORY_SCOPE_WORKGROUP); }
        __syncthreads();
        if (F.tid < 32) { const unsigned c = HIST[F.tid]; HIST[32 + F.tid] = c ? __hip_atomic_fetch_add(CNT + F.tid, c, RLX_AGENT) : 0u; }
        __syncthreads();
        if (lane < 16 && live) { const int m = m0 + lane; TOKP[m * 2] = (int)(HIST[32 + id1] + lp1); TOKP[m * 2 + 1] = (int)(HIST[32 + id2] + lp2); }
        __syncthreads();
    }
}
DEV int moe_tables(Frame& F, int l) {
    int* tab = (int*)(F.ldsg + TAB_OFF);
    if (F.tid == 0) {
        const unsigned* CNT = (const unsigned*)F.ctl + CW_CNT + l * 32; int off = 0;
#pragma unroll 1
        for (int e = 0; e < 32; ++e) { tab[e] = off; const int c = (int)__hip_atomic_load(CNT + e, RLX_AGENT); const int nt = (c + 255) >> 8;
            for (int i = 0; i < nt; ++i) tab[40 + (off >> 8) + i] = e;
            off += nt << 8; }
        tab[32] = off;
    }
    __syncthreads();
    return tab[32];
}
DEV void gather_phase(Frame& F, int l) {
    (void)moe_tables(F, l);
    const int* tab = (const int*)(F.ldsg + TAB_OFF);
    const int lane = F.lane; const int gw = F.vcu * NWAVES + F.wave, NGW = F.G * NWAVES;
    const bf16* HB = wsp<bf16>(F, WS_HB); const float* SSQ = wsp<float>(F, WS_SSQ); bf16* XS = wsp<bf16>(F, WS_XS);
    const int* TOKE = wsp<int>(F, WS_TOKE); const float* TOKG = wsp<float>(F, WS_TOKG); const int* TOKP = wsp<int>(F, WS_TOKP); int* TOKS = wsp<int>(F, WS_TOKS);
    float* SRSTD = wsp<float>(F, WS_SRSTD); float* SGATE = wsp<float>(F, WS_SGATE);
    const unsigned* CNT = (const unsigned*)F.ctl + CW_CNT + l * 32;
#pragma unroll 1
    for (int m0 = gw; m0 < NTOK; m0 += 4 * NGW) {
        int s0[4], s1[4]; float g0[4], g1[4], rs[4]; v4u a[4], c[4];
#pragma unroll
        for (int k = 0; k < 4; ++k) { const int m = m0 + k * NGW; const bool ok = m < NTOK; const int mm = ok ? m : m0;
            const int e0 = TOKE[mm * 2], e1 = TOKE[mm * 2 + 1], p0 = TOKP[mm * 2], p1 = TOKP[mm * 2 + 1];
            g0[k] = TOKG[mm * 2]; g1[k] = TOKG[mm * 2 + 1];
            a[k] = *(const v4u*)(HB + (size_t)mm * 1024 + lane * 8); c[k] = *(const v4u*)(HB + (size_t)mm * 1024 + 512 + lane * 8);
            rs[k] = row_rstd_full(SSQ, mm);
            s0[k] = tab[e0] + p0; s1[k] = tab[e1] + p1; }
#pragma unroll
        for (int k = 0; k < 4; ++k) { const int m = m0 + k * NGW;
            if (m < NTOK) {
                *(v4u*)(XS + (size_t)s0[k] * 1024 + lane * 8) = a[k]; *(v4u*)(XS + (size_t)s0[k] * 1024 + 512 + lane * 8) = c[k];
                *(v4u*)(XS + (size_t)s1[k] * 1024 + lane * 8) = a[k]; *(v4u*)(XS + (size_t)s1[k] * 1024 + 512 + lane * 8) = c[k];
                if (lane == 0) { SRSTD[s0[k]] = rs[k]; SRSTD[s1[k]] = rs[k]; SGATE[s0[k]] = g0[k]; SGATE[s1[k]] = g1[k]; TOKS[m * 2] = s0[k]; TOKS[m * 2 + 1] = s1[k]; } } }
    }
#pragma unroll 1
    for (int e = 0; e < 32; ++e) {
        const int c = (int)__hip_atomic_load(CNT + e, RLX_AGENT), base = tab[e], end = (e == 31 ? tab[32] : tab[e + 1]);
        for (int r = base + c + gw; r < end; r += NGW) {
            *(v4u*)(XS + (size_t)r * 1024 + lane * 8) = (v4u){0u, 0u, 0u, 0u}; *(v4u*)(XS + (size_t)r * 1024 + 512 + lane * 8) = (v4u){0u, 0u, 0u, 0u};
            if (lane == 0) { SRSTD[r] = 0.f; SGATE[r] = 0.f; }
        }
    }
}
DEV void combine_phase(Frame& F, int l, int probe = 0) {
    const int lane = F.lane; const int gw = F.vcu * NWAVES + F.wave, NGW = F.G * NWAVES;
    float* Ho = probe ? wsp<float>(F, WS_PROBE) : (float*)(GAS float*)F.out; const bf16* HBi = wsp<bf16>(F, WS_HB); bf16* HB = wsp<bf16>(F, probe ? WS_PROBE + 128 * MiB : WS_HB); float* SSQ = wsp<float>(F, probe ? WS_PROBE + 192 * MiB : WS_SSQ); const bf16* YS = wsp<bf16>(F, WS_YS); const int* TOKS = wsp<int>(F, WS_TOKS);
    const float* gf = inp(23);
#pragma unroll 1
    for (int m0 = gw; m0 < NTOK; m0 += 2 * NGW) {
        f32x4 v[2][4]; float ssum[2];
        int sl[2][2];
#pragma unroll
        for (int k = 0; k < 2; ++k) { const int m = (m0 + k * NGW < NTOK) ? m0 + k * NGW : m0; sl[k][0] = TOKS[m * 2]; sl[k][1] = TOKS[m * 2 + 1]; }
        v2u h[2][4]; v2u ya[2][4], yb[2][4];
#pragma unroll
        for (int k = 0; k < 2; ++k) { const int m = (m0 + k * NGW < NTOK) ? m0 + k * NGW : m0;
#pragma unroll
            for (int j = 0; j < 4; ++j) { const int c = lane * 4 + 256 * j;
                h[k][j] = *(const v2u*)(HBi + (size_t)m * 1024 + c);
                ya[k][j] = *(const v2u*)(YS + (size_t)sl[k][0] * 1024 + c); yb[k][j] = *(const v2u*)(YS + (size_t)sl[k][1] * 1024 + c); } }
#pragma unroll
        for (int k = 0; k < 2; ++k) { float ss = 0.f;
#pragma unroll
            for (int j = 0; j < 4; ++j) { const v2u a = ya[k][j], bq = yb[k][j]; const f32x4 hh = (f32x4){bflo(h[k][j].x), bfhi(h[k][j].x), bflo(h[k][j].y), bfhi(h[k][j].y)};
                f32x4 r; r[0] = hh[0] + (bflo(a.x) + bflo(bq.x)); r[1] = hh[1] + (bfhi(a.x) + bfhi(bq.x)); r[2] = hh[2] + (bflo(a.y) + bflo(bq.y)); r[3] = hh[3] + (bfhi(a.y) + bfhi(bq.y));
                v[k][j] = r; ss += (r[0] * r[0] + r[1] * r[1]) + (r[2] * r[2] + r[3] * r[3]); }
            ssum[k] = wave_sum(ss); }
#pragma unroll
        for (int k = 0; k < 2; ++k) { const int m = m0 + k * NGW;
            if (m < NTOK) {
                if (l == DEPTH - 1) {
                    const float rstd = 1.0f / sqrtf(ssum[k] * (1.0f / 1024.0f) + RMS_EPS);
#pragma unroll
                    for (int j = 0; j < 4; ++j) { const int c = lane * 4 + 256 * j; const f32x4 g = *(const f32x4*)(gf + c); *(f32x4*)(Ho + (size_t)m * 1024 + c) = v[k][j] * rstd * g; }
                } else {
#pragma unroll
                    for (int j = 0; j < 4; ++j) { const int c = lane * 4 + 256 * j;
                        v2u w; w.x = pk2(v[k][j][0], v[k][j][1]); w.y = pk2(v[k][j][2], v[k][j][3]); *(v2u*)(HB + (size_t)m * 1024 + c) = w; }
                    if (lane < 16) SSQ[(size_t)m * 16 + lane] = lane == 0 ? ssum[k] : 0.f;
                } } }
    }
}
#ifndef MK_ONE_LAUNCH
#define MK_ONE_LAUNCH 1
#endif
constexpr int NPH_LAYER = 13, NPHASES = 1 + DEPTH * NPH_LAYER;
struct Args { const float* in[24]; float* out; unsigned char* ws; int ph_lo, ph_hi; };
static_assert(sizeof(Args) == 24 * 8 + 8 + 8 + 8, "Args has no padding");

__global__ void __launch_bounds__(NWAVES * 64, 2) hymba_fwd(Args args) {
    extern __shared__ __attribute__((aligned(16))) unsigned char lds[];
    Frame F;
    F.lds = (LAS unsigned char*)lds; F.ldsg = lds;
    F.MISC = (volatile LAS unsigned*)(F.lds + MISC_OFF);
    F.tid = threadIdx.x; F.lane = F.tid & 63; F.wave = __builtin_amdgcn_readfirstlane(F.tid >> 6);
    F.G = gridDim.x; { const int bx = blockIdx.x; F.vcu = (F.G % 8 == 0) ? (bx % 8) * (F.G / 8) + bx / 8 : bx; }
    F.ws = args.ws; F.ctl = (gu32*)(args.ws + WS_CTL); F.out = args.out;
    if (F.tid < 64) ((LAS unsigned*)(F.lds + MISC_OFF))[F.tid] = 0u;
    __syncthreads();
    int wave0 = F.wave;
    const int lo = args.ph_lo, hi = args.ph_hi;
    XcdBarrier bar; bar.bar = (unsigned*)(F.ctl + CW_BAR); bar.x = 0; bar.st = nullptr;
    if (hi - lo > 1) bar = xcd_barrier_post((unsigned*)(F.ctl + CW_BAR), F.MISC + 8);
#ifndef PHMASK
#define PHMASK 0xFFFF
#endif
#define IN(k) (lo <= (k) && (k) < hi)
#define EN(j) ((PHMASK >> (j)) & 1)
#define RELAUNDER() do { asm volatile("" : "+s"(wave0)); unsigned z_ = 0u; asm volatile("" : "+v"(z_)); int t_ = wave0 * 64 + (int)__builtin_amdgcn_mbcnt_hi(~0u, __builtin_amdgcn_mbcnt_lo(~0u, z_)); F.tid = t_; F.lane = t_ & 63; F.wave = wave0; \
    size_t zo_ = 0; asm volatile("" : "+s"(zo_), "+s"(F.vcu), "+s"(F.G)); F.ws = args.ws + zo_; F.out = args.out + zo_; F.ctl = (gu32*)(F.ws + WS_CTL); } while (0)
#ifndef NSA_VAR
#define NSA_VAR 0
#endif
#ifndef BAR2X
#define BAR2X 0
#endif
#ifndef DUPMASK
#define DUPMASK 0
#endif
#define DUP(j) ((DUPMASK >> (j)) & 1)
#ifndef STAG_J0
#define STAG_J0 0
#endif
#ifndef STAG_MOE
#define STAG_MOE 0
#endif
#define STAGGER(ticks) do { if ((ticks) > 0 && (F.vcu & 1)) { const unsigned long long t0_ = __builtin_amdgcn_s_memrealtime(); while (__builtin_amdgcn_s_memrealtime() - t0_ < (unsigned long long)(ticks)) __builtin_amdgcn_s_sleep(32); } } while (0)
#define SEAM(k) do { if (IN(k) && IN((k) + 1)) { XcdBarrier b_ = bar; size_t zb_ = 0; asm volatile("" : "+s"(b_.x), "+s"(zb_)); b_.bar = (unsigned*)(args.ws + WS_CTL + zb_) + CW_BAR; xcd_barrier(b_); if (BAR2X) xcd_barrier(b_); } } while (0)

    if (IN(0) && EN(13)) { RELAUNDER(); p0_prologue(F); if (DUP(13)) { __syncthreads(); p0_prologue(F); } } SEAM(0);

#pragma unroll 1
    for (int l = 0; l < DEPTH; ++l) {
        const int pb = 1 + l * NPH_LAYER;
        bf16* HB = wsp<bf16>(F, WS_HB); float* SSQ = wsp<float>(F, WS_SSQ);
        if (IN(pb + 0) && EN(0)) for (int rep_ = 0; rep_ < (DUP(0) ? 2 : 1); ++rep_) { RELAUNDER(); if (rep_) __syncthreads();
            pg8::Gemm g{HB, wsp<bf16>(F, WS_WIN) + (size_t)l * NIN * 1024, NTOK, 3072, D};
            pg8::StaticOrder S; S.init(NTOK, 3072, F.G, (int)blockIdx.x);
            EpiIn E{F.ws};
            STAGGER(STAG_J0);
            pg8::gemm_phase<EpiIn, pg8::StaticOrder, true, true>(F.lds, g, S, E, F.wave);
        }
        SEAM(pb + 0);
        if (IN(pb + 1) && EN(1)) { RELAUNDER();
            compress_phase(F, l);
            hgrn_local_phase(F, l);
            conv_phase(F, l);
            kmax_phase(F, l);
            if (l == 0) memkv_phase(F);
            if (DUP(1)) { __syncthreads(); compress_phase(F, l); hgrn_local_phase(F, l); conv_phase(F, l); }
        }
        SEAM(pb + 1);
        if (IN(pb + 2) && EN(2)) { RELAUNDER(); hgrn_scan_phase(F); if (DUP(14)) hgrn_scan_phase(F, 1); nsa_phase(F, l); if (DUP(2)) { __syncthreads(); nsa_phase_t<NSA_VAR>(F, l); } }
        SEAM(pb + 2);
        if (IN(pb + 3) && EN(3)) { RELAUNDER(); hgrn_out_phase(F, l); if (DUP(3)) { __syncthreads(); hgrn_out_phase(F, l); } }
        SEAM(pb + 3);
        if (IN(pb + 4) && EN(4)) for (int rep_ = 0; rep_ < ((DUP(4) && l == 0) ? 2 : 1); ++rep_) { RELAUNDER(); if (rep_) __syncthreads();
            pg8::Gemm g{wsp<bf16>(F, WS_CAT), wsp<bf16>(F, WS_WOUT) + (size_t)l * 1024 * 1024, NTOK, D, D};
            pg8::StaticOrder S; S.init(NTOK, D, F.G, (int)blockIdx.x);
            EpiRes E{l == 0 ? inp(0) : (const float*)nullptr, HB, SSQ};
            pg8::gemm_phase<EpiRes, pg8::StaticOrder, true, true>(F.lds, g, S, E, F.wave);
        }
        SEAM(pb + 4);
        if (IN(pb + 5) && EN(5)) for (int rep_ = 0; rep_ < (DUP(5) ? 2 : 1); ++rep_) { RELAUNDER(); if (rep_) __syncthreads();
            pg8::Gemm g{HB, wsp<bf16>(F, WS_WQ) + (size_t)l * 256 * 1024, NTOK, 256, D};
            pg8::StaticOrder S; S.init(NTOK, 256, F.G, (int)blockIdx.x);
            EpiXQ E{SSQ, wsp<bf16>(F, WS_XQ)};
            pg8::gemm_phase<EpiXQ, pg8::StaticOrder, true, true>(F.lds, g, S, E, F.wave);
        }
        SEAM(pb + 5);
        if (IN(pb + 6) && EN(6)) { RELAUNDER(); cross_phase(F, l); if (DUP(6)) { __syncthreads(); cross_phase(F, l); } }
        SEAM(pb + 6);
        if (IN(pb + 7) && EN(7)) { RELAUNDER();
            pg8::Gemm g{wsp<bf16>(F, WS_XO), wsp<bf16>(F, WS_WO) + (size_t)l * 1024 * 256, NTOK, D, 256};
            pg8::StaticOrder S; S.init(NTOK, D, F.G, (int)blockIdx.x);
            EpiRes E{(const float*)nullptr, HB, SSQ};
            pg8::gemm_phase<EpiRes, pg8::StaticOrder, true, true>(F.lds, g, S, E, F.wave);
        }
        SEAM(pb + 7);
        if (IN(pb + 8) && EN(8)) { RELAUNDER(); router_phase(F, l); if (DUP(8)) router_phase(F, l, 1); }
        SEAM(pb + 8);
        if (IN(pb + 9) && EN(9)) { RELAUNDER(); gather_phase(F, l); if (DUP(9)) { __syncthreads(); gather_phase(F, l); } }
        SEAM(pb + 9);
        if (IN(pb + 10) && EN(10)) for (int rep_ = 0; rep_ < (DUP(10) ? 2 : 1); ++rep_) { RELAUNDER(); if (rep_) __syncthreads();
            const int ns = moe_tables(F, l);
            pg8::Gemm g{wsp<bf16>(F, WS_XS), wsp<bf16>(F, WS_WGU) + (size_t)l * 32 * 1024 * 1024, ns, 32 * 1024, D};
            MoeOrder S{(ns >> 8) * 4, F.G, (int)blockIdx.x, (const LAS int*)(F.lds + TAB_OFF) + 40};
            EpiGU E{wsp<float>(F, WS_SRSTD), wsp<bf16>(F, WS_ACT)};
            STAGGER(STAG_MOE);
            pg8::gemm_phase<EpiGU, MoeOrder, true, true>(F.lds, g, S, E, F.wave);
        }
        SEAM(pb + 10);
        if (IN(pb + 11) && EN(11)) for (int rep_ = 0; rep_ < (DUP(11) ? 2 : 1); ++rep_) { RELAUNDER(); if (rep_) __syncthreads();
            const int ns = moe_tables(F, l);
            pg8::Gemm g{wsp<bf16>(F, WS_ACT), wsp<bf16>(F, WS_WDN) + (size_t)l * 32 * 1024 * 512, ns, 32 * 1024, 512};
            MoeOrder S{(ns >> 8) * 4, F.G, (int)blockIdx.x, (const LAS int*)(F.lds + TAB_OFF) + 40};
            EpiDN E{wsp<float>(F, WS_SGATE), wsp<bf16>(F, WS_YS)};
            STAGGER(STAG_MOE / 2);
            pg8::gemm_phase<EpiDN, MoeOrder, true, true>(F.lds, g, S, E, F.wave);
        }
        SEAM(pb + 11);
        if (IN(pb + 12) && EN(12)) { RELAUNDER(); combine_phase(F, l); if (DUP(12)) combine_phase(F, l, 1); }
        SEAM(pb + 12);
    }
#undef IN
#undef SEAM
}

extern "C" void kernel_launch(void* const* d_in, const int* in_sizes, int n_in, void* d_out, int out_size, void* d_ws, size_t ws_size, hipStream_t stream) {
    static int grid = 0;
    if (grid == 0) {
        if (n_in != 24 || in_sizes[0] != NTOK * D || out_size != NTOK * D || ws_size < WS_END) {
            fprintf(stderr, "kernel_launch: unexpected shapes: n_in %d in0 %d out %d ws %zu (need %zu)\n", n_in, n_in > 0 ? in_sizes[0] : -1, out_size, ws_size, (size_t)WS_END); grid = -1; return; }
        int dev = 0, cus = 0, per_cu = 0;
        if (hipGetDevice(&dev) != hipSuccess || hipDeviceGetAttribute(&cus, hipDeviceAttributeMultiprocessorCount, dev) != hipSuccess) { grid = -1; return; }
        if (hipFuncSetAttribute((const void*)hymba_fwd, hipFuncAttributeMaxDynamicSharedMemorySize, LDS_BYTES) != hipSuccess) { fprintf(stderr, "kernel_launch: hipFuncSetAttribute failed\n"); grid = -1; return; }
        if (hipOccupancyMaxActiveBlocksPerMultiprocessor(&per_cu, (const void*)hymba_fwd, NWAVES * 64, LDS_BYTES) != hipSuccess || per_cu < 1)
            fprintf(stderr, "kernel_launch: note: occupancy query reports %d blocks per CU\n", per_cu);
        (void)hipGetLastError();
        grid = cus;
    }
    if (grid < 0) return;
    if (hipMemsetAsync((char*)d_ws + WS_CTL, 0, CTL_ZERO_BYTES, stream) != hipSuccess) { fprintf(stderr, "kernel_launch: memset failed\n"); return; }
    Args a{};
    for (int i = 0; i < 24; ++i) a.in[i] = (const float*)d_in[i];
    a.out = (float*)d_out; a.ws = (unsigned char*)d_ws;
#if MK_ONE_LAUNCH
    a.ph_lo = 0; a.ph_hi = NPHASES;
    hipLaunchKernelGGL(hymba_fwd, dim3(grid), dim3(NWAVES * 64), LDS_BYTES, stream, a);
#else
    for (int p = 0; p < NPHASES; ++p) { a.ph_lo = p; a.ph_hi = p + 1; hipLaunchKernelGGL(hymba_fwd, dim3(grid), dim3(NWAVES * 64), LDS_BYTES, stream, a); }
#endif
    const hipError_t le = hipPeekAtLastError();
    if (le != hipSuccess) fprintf(stderr, "kernel_launch: launch failed: %s\n", hipGetErrorName(le));
}
```

```cpp
#define MK_ONE_LAUNCH 1
#include <hip/hip_runtime.h>
#include <cstdio>
#include <cstdint>
#include <cmath>
namespace pg8 {
#define PG8_LAS __attribute__((address_space(3)))
typedef unsigned short bf16_t;
typedef short bf16x8 __attribute__((ext_vector_type(8)));
typedef float f32x4 __attribute__((ext_vector_type(4)));
typedef unsigned u32x4 __attribute__((ext_vector_type(4)));
constexpr int BM = 256, BK = 64, HALF = 128, HTB = HALF * BK * 2  , STAGE_BYTES = 8 * HTB, NXCD = 8, WGM = 8;

__host__ __device__ __forceinline__ int lds_byte(int r, int c) { const int st = (r >> 4) * 2 + (c >> 5), rr = r & 15, cc = c & 31, ob = rr * 64 + cc * 2; return st * 1024 + (ob ^ (((ob >> 9) & 1) << 5)); }
__host__ __device__ __forceinline__ void stage_rc(int b, int& R, int& C) { const int st = b / 1024, sb = b % 1024, swz = sb ^ (((sb >> 9) & 1) << 5); R = (st >> 1) * 16 + swz / 64; C = (st & 1) * 32 + (swz % 64) / 2; }
__host__ __device__ __forceinline__ int perm32(int rho) { const int n = rho >> 4, i = rho & 15; return 8 * (i >> 2) + 4 * n + (i & 3); }

struct Unit { int pm, pn; };
struct Gemm { const bf16_t* A; const bf16_t* Bt; int M, N, K; };

struct StaticOrder {
    int nM, nN, nwg, G, c;
    __host__ __device__ void init(int M, int N, int G_, int c_) { nM = M / BM; nN = N / BM; nwg = nM * nN; G = G_; c = c_; }
    __host__ __device__ bool next(int i, Unit& u) const {
        const long L = (long)i * G + c; if (L >= nwg) return false;
        int wgid = (int)L; { const int q = nwg / NXCD, r = nwg % NXCD, xcd = wgid % NXCD, off = wgid / NXCD; wgid = (xcd < r ? xcd * (q + 1) : r * (q + 1) + (xcd - r) * q) + off; }
        const int nig = WGM * nN, gid = wgid / nig, fm = gid * WGM, gsz = (nM - fm) < WGM ? (nM - fm) : WGM;
        u.pm = fm + ((wgid % nig) % gsz); u.pn = (wgid % nig) / gsz; return true;
    }
    __device__ __forceinline__ void a_ready(const Unit&) const {}
    __device__ __forceinline__ void done(const Unit&) const {}
};

__device__ __forceinline__ unsigned cvt_pk_bf16(float lo, float hi) { unsigned r; asm volatile("v_cvt_pk_bf16_f32 %0, %1, %2" : "=v"(r) : "v"(lo), "v"(hi)); return r; }
typedef float f32x2 __attribute__((ext_vector_type(2)));
template <class Epi, class Sched, bool ALIGN_EPI = false, bool SP2 = false>
__device__ __forceinline__ void gemm_phase(PG8_LAS unsigned char* lds, const Gemm g, const Sched& S, const Epi& E, int wave_id) {
    unsigned z_ = 0u; asm volatile("" : "+v"(z_)); int tid_ = wave_id * 64 + (int)__builtin_amdgcn_mbcnt_hi(~0u, __builtin_amdgcn_mbcnt_lo(~0u, z_));
    const int tid = tid_, wid = __builtin_amdgcn_readfirstlane(tid >> 6), lane = tid & 63, wr = wid >> 2, wc = wid & 3, fr = lane & 15, fq = lane >> 4;
    const int K = g.K, nt = K / BK;
    unsigned voffA[2], voffB[2];
#pragma unroll
    for (int i = 0; i < 2; ++i) { int R, C; stage_rc(tid * 16 + i * 8192, R, C); const int Rb = Epi::PERM ? ((R & ~31) + perm32(R & 31)) : R;
        voffA[i] = (unsigned)(R * K + C) * 2u; voffB[i] = (unsigned)(Rb * K + C) * 2u; }
    const size_t kstep = (size_t)(BK * 2);
    const size_t hstep = (size_t)HALF * K * 2;
    const size_t tstep = 2 * hstep;
    const unsigned ldsw = (unsigned)wid * 1024u;
    const int aoff = lds_byte(wr * 64 + fr, fq * 8), boff = lds_byte(wc * 32 + fr, fq * 8);
#define PG8_SA(b, h) (((b) * 2 + (h)) * HTB)
#define PG8_SB(b, h) ((4 + (b) * 2 + (h)) * HTB)
#define PG8_STAGE(bufoff, gbase, voff) do { _Pragma("unroll") for (int _i = 0; _i < 2; ++_i) \
        __builtin_amdgcn_global_load_lds((const unsigned*)((const char*)(gbase) + (voff)[_i]), (PG8_LAS unsigned*)(lds + (bufoff) + ldsw + _i * 8192), 16, 0, 0); } while (0)
#define PG8_LDA(dst, b, h) do { _Pragma("unroll") for (int m = 0; m < 4; ++m) _Pragma("unroll") for (int k = 0; k < 2; ++k) dst[m][k] = *(const PG8_LAS bf16x8*)(lds + PG8_SA(b, h) + aoff + m * 2048 + k * 1024); } while (0)
#define PG8_LDB(dst, b, h) do { _Pragma("unroll") for (int n = 0; n < 2; ++n) _Pragma("unroll") for (int k = 0; k < 2; ++k) dst[n][k] = *(const PG8_LAS bf16x8*)(lds + PG8_SB(b, h) + boff + n * 2048 + k * 1024); } while (0)
#define PG8_MMA(ai, bj, At, Bt) do { __builtin_amdgcn_s_setprio(1); _Pragma("unroll") for (int m = 0; m < 4; ++m) _Pragma("unroll") for (int n = 0; n < 2; ++n) _Pragma("unroll") for (int k = 0; k < 2; ++k) \
        acc[ai][bj][m][n] = __builtin_amdgcn_mfma_f32_16x16x32_bf16(Bt[n][k], At[m][k], acc[ai][bj][m][n], 0, 0, 0); __builtin_amdgcn_s_setprio(0); } while (0)
#define PG8_WAIT_V(n) asm volatile("s_waitcnt vmcnt(" #n ")" ::: "memory")
#define PG8_WAIT_L(n) asm volatile("s_waitcnt lgkmcnt(" #n ")" ::: "memory")
#define PG8_BAR __builtin_amdgcn_s_barrier()
#define PG8_SCHED __builtin_amdgcn_sched_barrier(0)
    Unit cur, nxt; int ui = 0;
    if (!S.next(0, cur)) return;
    f32x4 acc[2][2][4][2];
#pragma unroll
    for (int a = 0; a < 2; ++a)
#pragma unroll
        for (int b = 0; b < 2; ++b)
#pragma unroll
            for (int m = 0; m < 4; ++m)
#pragma unroll
                for (int n = 0; n < 2; ++n) acc[a][b][m][n] = (f32x4){0.f, 0.f, 0.f, 0.f};
    bf16x8 At[4][2], B0[2][2], B1[2][2];
    const char* cA = (const char*)g.A + (size_t)cur.pm * tstep; const char* cB = (const char*)g.Bt + (size_t)cur.pn * tstep;
    S.a_ready(cur);
    if constexpr (SP2) {
        PG8_STAGE(PG8_SB(0, 0), cB, voffB); PG8_STAGE(PG8_SB(0, 1), cB + hstep, voffB); PG8_STAGE(PG8_SA(0, 0), cA, voffA); PG8_STAGE(PG8_SA(0, 1), cA + hstep, voffA);
        if (wr == 1) PG8_BAR;
        PG8_WAIT_V(2); PG8_BAR;
        PG8_STAGE(PG8_SB(1, 0), cB + kstep, voffB); PG8_STAGE(PG8_SA(1, 0), cA + kstep, voffA); PG8_STAGE(PG8_SB(1, 1), cB + hstep + kstep, voffB);
        PG8_WAIT_V(6); PG8_BAR;
    } else {
        PG8_STAGE(PG8_SB(0, 0), cB, voffB); PG8_STAGE(PG8_SA(0, 0), cA, voffA); PG8_STAGE(PG8_SB(0, 1), cB + hstep, voffB); PG8_STAGE(PG8_SA(0, 1), cA + hstep, voffA);
        if (wr == 1) PG8_BAR;
        PG8_WAIT_V(4); PG8_BAR;
        PG8_STAGE(PG8_SB(1, 0), cB + kstep, voffB); PG8_STAGE(PG8_SA(1, 0), cA + kstep, voffA); PG8_STAGE(PG8_SB(1, 1), cB + hstep + kstep, voffB);
        PG8_WAIT_V(6); PG8_BAR;
    }
    for (;;) {
        const bool has_next = S.next(ui + 1, nxt);
        const char* nA = has_next ? (const char*)g.A + (size_t)nxt.pm * tstep : cA; const char* nB = has_next ? (const char*)g.Bt + (size_t)nxt.pn * tstep : cB;
        for (int t = 0; t < nt; t += 2) {
            const bool last = (t == nt - 2);
            const char* a1 = cA + (size_t)(t + 1) * kstep;
            const char* a2 = last ? nA : cA + (size_t)(t + 2) * kstep; const char* b2 = last ? nB : cB + (size_t)(t + 2) * kstep;
            const char* a3 = a2 + kstep; const char* b3 = b2 + kstep;
            if (last && has_next) S.a_ready(nxt);
            if constexpr (SP2) {
            PG8_LDB(B0, 0, 0); PG8_LDB(B1, 0, 1); PG8_SCHED; PG8_LDA(At, 0, 0); PG8_STAGE(PG8_SA(1, 1), a1 + hstep, voffA);
            PG8_WAIT_V(8); PG8_WAIT_L(0); PG8_BAR; PG8_MMA(0, 0, At, B0); PG8_MMA(0, 1, At, B1); PG8_BAR; PG8_SCHED;
            PG8_LDA(At, 0, 1); PG8_STAGE(PG8_SB(0, 0), b2, voffB); PG8_STAGE(PG8_SB(0, 1), b2 + hstep, voffB); PG8_STAGE(PG8_SA(0, 0), a2, voffA);
            PG8_WAIT_V(8); PG8_WAIT_L(0); PG8_BAR; PG8_MMA(1, 0, At, B0); PG8_MMA(1, 1, At, B1); PG8_BAR; PG8_SCHED;
            PG8_LDB(B0, 1, 0); PG8_LDB(B1, 1, 1); PG8_SCHED; PG8_LDA(At, 1, 0); PG8_STAGE(PG8_SA(0, 1), a2 + hstep, voffA);
            PG8_WAIT_V(8); PG8_WAIT_L(0); PG8_BAR; PG8_MMA(0, 0, At, B0); PG8_MMA(0, 1, At, B1); PG8_BAR; PG8_SCHED;
            PG8_LDA(At, 1, 1); PG8_STAGE(PG8_SB(1, 0), b3, voffB); PG8_STAGE(PG8_SB(1, 1), b3 + hstep, voffB); PG8_STAGE(PG8_SA(1, 0), a3, voffA);
            PG8_WAIT_V(8); PG8_WAIT_L(0); PG8_BAR; PG8_MMA(1, 0, At, B0); PG8_MMA(1, 1, At, B1); PG8_BAR; PG8_SCHED;
            } else {
            PG8_LDB(B0, 0, 0); PG8_SCHED; PG8_LDA(At, 0, 0); PG8_STAGE(PG8_SA(1, 1), a1 + hstep, voffA);
            PG8_WAIT_L(8); PG8_BAR; PG8_WAIT_L(0); PG8_MMA(0, 0, At, B0); PG8_BAR; PG8_SCHED;
            PG8_LDB(B1, 0, 1); PG8_STAGE(PG8_SB(0, 0), b2, voffB);
            PG8_BAR; PG8_WAIT_L(0); PG8_MMA(0, 1, At, B1); PG8_BAR;
            PG8_LDA(At, 0, 1); PG8_STAGE(PG8_SA(0, 0), a2, voffA);
            PG8_BAR; PG8_WAIT_L(0); PG8_MMA(1, 0, At, B0); PG8_BAR; PG8_SCHED;
            PG8_STAGE(PG8_SB(0, 1), b2 + hstep, voffB);
            PG8_WAIT_V(6); PG8_BAR; PG8_MMA(1, 1, At, B1); PG8_BAR;
            PG8_LDB(B0, 1, 0); PG8_SCHED; PG8_LDA(At, 1, 0); PG8_STAGE(PG8_SA(0, 1), a2 + hstep, voffA);
            PG8_WAIT_L(8); PG8_BAR; PG8_WAIT_L(0); PG8_MMA(0, 0, At, B0); PG8_BAR; PG8_SCHED;
            PG8_LDB(B1, 1, 1); PG8_STAGE(PG8_SB(1, 0), b3, voffB);
            PG8_BAR; PG8_WAIT_L(0); PG8_MMA(0, 1, At, B1); PG8_BAR;
            PG8_LDA(At, 1, 1); PG8_STAGE(PG8_SA(1, 0), a3, voffA);
            PG8_BAR; PG8_WAIT_L(0); PG8_MMA(1, 0, At, B0); PG8_BAR; PG8_SCHED;
            PG8_STAGE(PG8_SB(1, 1), b3 + hstep, voffB);
            PG8_WAIT_V(6); PG8_BAR; PG8_MMA(1, 1, At, B1); PG8_BAR;
            }
        }
        if constexpr (ALIGN_EPI) { if (wr == 0) PG8_BAR; }
        if constexpr (!Epi::AFTER_DRAIN) { E(acc, cur, wr, wc, fr, fq); S.done(cur); }
        if (!has_next) break;
#pragma unroll
        for (int a = 0; a < 2; ++a)
#pragma unroll
            for (int b = 0; b < 2; ++b)
#pragma unroll
                for (int m = 0; m < 4; ++m)
#pragma unroll
                    for (int n = 0; n < 2; ++n) acc[a][b][m][n] = (f32x4){0.f, 0.f, 0.f, 0.f};
        cur = nxt; cA = nA; cB = nB; ++ui;
        if constexpr (ALIGN_EPI) { if (wr == 1) PG8_BAR; }
    }
    PG8_WAIT_V(0);
    if constexpr (!ALIGN_EPI) { if (wr == 0) PG8_BAR; }
    PG8_BAR;
    if constexpr (Epi::AFTER_DRAIN) { E.fused(acc, cur, wr, wc, fr, fq, lds, wid, lane); S.done(cur); }
#undef PG8_SA
#undef PG8_SB
#undef PG8_STAGE
#undef PG8_LDA
#undef PG8_LDB
#undef PG8_MMA
#undef PG8_WAIT_V
#undef PG8_WAIT_L
#undef PG8_BAR
#undef PG8_SCHED
}
}
constexpr int NB = 4, T = 8192, D = 1024, NTOK = NB * T, DEPTH = 2;
constexpr int NIN = 3328;
constexpr int IN_W = 3096;
constexpr int NSLOT_MAX = 65536 + 32 * 256;
constexpr float RMS_EPS = 1e-6f;
constexpr float QSCALE = 0.125f * 1.44269504088896f;
constexpr int NWAVES = 8;

constexpr size_t MiB = 1u << 20;
constexpr size_t WS_CTL = 0, CTL_ZERO_BYTES = 1 * MiB;
constexpr size_t WS_ROPE = 1 * MiB;
constexpr size_t WS_SMALL = 3 * MiB;
constexpr size_t WS_WG = 3 * MiB + 65536;
constexpr size_t WS_SSQ = 4 * MiB;
constexpr size_t WS_WIN = 8 * MiB;
constexpr size_t WS_WOUT = 22 * MiB;
constexpr size_t WS_WQ = 26 * MiB;
constexpr size_t WS_WKV = 27 * MiB;
constexpr size_t WS_WO = 29 * MiB;
constexpr size_t WS_WR = 30 * MiB;
constexpr size_t WS_W1C = 31 * MiB;
constexpr size_t WS_W2C = 33 * MiB;
constexpr size_t WS_MEMB = 34 * MiB;
constexpr size_t WS_MK = 36 * MiB;
constexpr size_t WS_MVT = 37 * MiB;
constexpr size_t WS_WGU = 40 * MiB;
constexpr size_t WS_WDN = 168 * MiB;
constexpr size_t WS_HB = 232 * MiB;
constexpr size_t WS_Q = 296 * MiB, WS_QR = 328 * MiB, WS_KCR = 360 * MiB, WS_VCR = 368 * MiB, WS_KS = 376 * MiB, WS_KW = 384 * MiB;
constexpr size_t WS_VST = 392 * MiB, WS_VWT = 400 * MiB, WS_KCC = 408 * MiB, WS_VCT = 409 * MiB, WS_GATE = 410 * MiB;
constexpr size_t WS_CB = 414 * MiB, WS_CC = 430 * MiB, WS_CH = 446 * MiB;
constexpr size_t WS_HQ = 462 * MiB, WS_HF = 494 * MiB, WS_HI = 526 * MiB, WS_HG = 558 * MiB;
constexpr size_t WS_CAT = 590 * MiB, WS_U = 654 * MiB, WS_DEC = 686 * MiB;
constexpr size_t WS_XQ = 688 * MiB, WS_XO = 704 * MiB;
constexpr size_t WS_XS = 296 * MiB, WS_ACT = 440 * MiB, WS_YS = 512 * MiB;
constexpr size_t WS_TOKE = 720 * MiB, WS_TOKG = 721 * MiB, WS_TOKP = 722 * MiB, WS_TOKS = 723 * MiB, WS_SRSTD = 724 * MiB, WS_SGATE = 725 * MiB;
constexpr size_t WS_U2 = 728 * MiB;
constexpr size_t WS_PROBE = 760 * MiB;
constexpr size_t WS_END = 760 * MiB;
static_assert(WS_XS + (size_t)NSLOT_MAX * 1024 * 2 <= WS_ACT && WS_ACT + (size_t)NSLOT_MAX * 512 * 2 <= WS_YS && WS_YS + (size_t)NSLOT_MAX * 1024 * 2 <= WS_XQ, "moe map");
constexpr int CW_CNT = 64;
constexpr int CW_KMAX = 256;
constexpr int CW_NSAQ = 512;
constexpr int CW_BAR = 4096;

constexpr int RING_BYTES = 131072;
constexpr int NSA_LDS_WAVE = 10752;
constexpr int MISC_OFF = RING_BYTES;
constexpr int TAB_OFF = RING_BYTES + 512;
constexpr int LDS_BYTES = 147456;
static_assert(8 * NSA_LDS_WAVE <= RING_BYTES && TAB_OFF + 4 * (40 + 320) <= LDS_BYTES, "LDS map");

#define GAS __attribute__((address_space(1)))
#define LAS __attribute__((address_space(3)))
#define DEV __device__ __forceinline__
typedef unsigned short bf16;
typedef unsigned v4u __attribute__((ext_vector_type(4)));
typedef unsigned v2u __attribute__((ext_vector_type(2)));
typedef float f32x4 __attribute__((ext_vector_type(4)));
typedef short bf16x8 __attribute__((ext_vector_type(8)));
typedef GAS unsigned gu32;
#define RLX_AGENT __ATOMIC_RELAXED, __HIP_MEMORY_SCOPE_AGENT
#define LDS_WAIT() asm volatile("s_waitcnt lgkmcnt(0)" ::: "memory")
#define VM_WAIT() asm volatile("s_waitcnt vmcnt(0)" ::: "memory")
typedef __bf16 bf16x2_t __attribute__((ext_vector_type(2)));
typedef float f32x2_t __attribute__((ext_vector_type(2)));
DEV unsigned pk2(float lo, float hi) { const f32x2_t v = {lo, hi}; return __builtin_bit_cast(unsigned, __builtin_convertvector(v, bf16x2_t)); }
DEV unsigned f2bf(float f) { return pk2(f, 0.f) & 0xffffu; }
DEV float bf2f(unsigned short b) { return __builtin_bit_cast(float, (unsigned)b << 16); }
DEV float bflo(unsigned w) { return __builtin_bit_cast(float, w << 16); }
DEV float bfhi(unsigned w) { return __builtin_bit_cast(float, w & 0xffff0000u); }
DEV float ex2(float x) { return __builtin_amdgcn_exp2f(x); }
DEV float wave_sum(float v) {
#pragma unroll
    for (int o = 1; o < 64; o <<= 1) v += __shfl_xor(v, o);
    return v;
}
DEV f32x4 mfma16(bf16x8 a, bf16x8 b, f32x4 c) { return __builtin_amdgcn_mfma_f32_16x16x32_bf16(a, b, c, 0, 0, 0); }
DEV int slot32(int k) { return ((k >> 2) & 3) * 8 + (k >> 4) * 4 + (k & 3); }
DEV int kfrag_off(int key, int d) { return (key >> 5) * 2048 + ((((key >> 4) & 1) * 2 + (d >> 5)) * 64 + ((d >> 3) & 3) * 16 + (key & 15)) * 8 + (d & 7); }
DEV float sigmoidf_(float x) { return 1.0f / (1.0f + __expf(-x)); }
DEV float siluf_(float x) { return x / (1.0f + __expf(-x)); }
#define XB_TMO      128
#define XB_XCNT(j)  (256  + 64 * (j))
#define XB_XSUB(j)  (1280 + 64 * (j))
#define XB_XGEN(j)  (2304 + 64 * (j))
#define XB_TOP      3328
#define XB_TOPGEN   3392
#define XCD_BAR_WORDS 3456
#define XB_SPIN_CAP (1u << 18)

__device__ __forceinline__ unsigned xb_ld(unsigned* p)              { return __hip_atomic_load(p, __ATOMIC_RELAXED, __HIP_MEMORY_SCOPE_AGENT); }
__device__ __forceinline__ unsigned xb_add(unsigned* p, unsigned v) { return __hip_atomic_fetch_add(p, v, __ATOMIC_RELAXED, __HIP_MEMORY_SCOPE_AGENT); }
__device__ __forceinline__ unsigned xb_xcc_id() { return (unsigned)__builtin_amdgcn_s_getreg((3 << 11) | 20) & 0xFu; }
#define XB_SPIN(cond, bar) do { unsigned _sp = 0; while (cond) { __builtin_amdgcn_s_sleep(1); \
    if ((++_sp & 255u) == 0u) { if (xb_ld(&(bar)[XB_TMO])) break; if (_sp > XB_SPIN_CAP) { atomicAdd(&(bar)[XB_TMO], 1u); break; } } } } while (0)

struct XcdBarrier {
    unsigned* bar; unsigned x;
    volatile LAS unsigned* st;
};

__device__ __forceinline__ XcdBarrier xcd_barrier_post(unsigned* bar, volatile LAS unsigned* st) {
    XcdBarrier b; b.bar = bar; b.x = xb_xcc_id(); b.st = st;
    if (threadIdx.x == 0) (void)xb_add(&bar[XB_XCNT(b.x)], 1u);
    return b;
}
__device__ __forceinline__ void xcd_barrier_complete(unsigned* bar, unsigned x, unsigned& nloc, unsigned& nx) {
    const unsigned G = gridDim.x * gridDim.y * gridDim.z;
    unsigned sum, cnt, mine, sp = 0u;
    for (;;) {
        sum = 0u; cnt = 0u; mine = 0u;
#pragma unroll
        for (unsigned j = 0; j < 16; ++j) { const unsigned c = xb_ld(&bar[XB_XCNT(j)]); sum += c; cnt += (c > 0u) ? 1u : 0u; mine = (j == x) ? c : mine; }
        if (sum == G) break;
        __builtin_amdgcn_s_sleep(1);
        if ((++sp & 255u) == 0u) { if (xb_ld(&bar[XB_TMO])) break; if (sp > XB_SPIN_CAP) { atomicAdd(&bar[XB_TMO], 1u); break; } }
    }
    nloc = mine > 0u ? mine : 1u; nx = cnt > 0u ? cnt : 1u;
}

__device__ __forceinline__ void xcd_barrier(const XcdBarrier& b) {
    asm volatile("s_waitcnt vmcnt(0)" ::: "memory");
    __syncthreads();
    if (threadIdx.x == 0) {
        unsigned* bar = b.bar;
        __builtin_amdgcn_s_waitcnt(0);
        unsigned nloc = b.st[0], nx = b.st[1];
        if (nloc == 0u) { xcd_barrier_complete(bar, b.x, nloc, nx); b.st[0] = nloc; b.st[1] = nx; }
        const unsigned old = xb_add(&bar[XB_XSUB(b.x)], 1u);
        const unsigned gen = old / nloc;
        if (old + 1u == (gen + 1u) * nloc) {
            __builtin_amdgcn_fence(__ATOMIC_RELEASE, "agent");
            asm volatile("s_waitcnt vmcnt(0)" ::: "memory");
            const unsigned og = xb_add(&bar[XB_TOP], 1u);
            const unsigned tg = og / nx;
            if (og + 1u == (tg + 1u) * nx) xb_add(&bar[XB_TOPGEN], 1u);
            else XB_SPIN(xb_ld(&bar[XB_TOPGEN]) == tg, bar);
            __builtin_amdgcn_fence(__ATOMIC_ACQUIRE, "agent");
            xb_add(&bar[XB_XGEN(b.x)], 1u);
            asm volatile("s_waitcnt vmcnt(0)" ::: "memory");
        } else {
            XB_SPIN(xb_ld(&bar[XB_XGEN(b.x)]) == gen, bar);
            __builtin_amdgcn_fence(__ATOMIC_ACQUIRE, "agent");
            asm volatile("s_waitcnt vmcnt(0)" ::: "memory");
        }
    }
    __syncthreads();
}
DEV float row_rstd(const float* ssq, int row, int fq) {
    const f32x4 p = *(const f32x4*)(ssq + (size_t)row * 16 + fq * 4);
    float s = (p.x + p.y) + (p.z + p.w);
    s += __shfl_xor(s, 16); s += __shfl_xor(s, 32);
    return 1.0f / sqrtf(s * (1.0f / 1024.0f) + RMS_EPS);
}
DEV float row_rstd_full(const float* ssq, int row) {
    const f32x4* p = (const f32x4*)(ssq + (size_t)row * 16);
    const f32x4 a = p[0], b = p[1], c = p[2], d = p[3];
    const float s = ((a.x + a.y) + (a.z + a.w)) + ((b.x + b.y) + (b.z + b.w)) + ((c.x + c.y) + (c.z + c.w)) + ((d.x + d.y) + (d.z + d.w));
    return 1.0f / sqrtf(s * (1.0f / 1024.0f) + RMS_EPS);
}

DEV void rope4(const float* rope, int t, int i, const f32x4& v0, const f32x4& v1, float (&lo)[4], float (&hi)[4]) {
    const f32x4 c0 = *(const f32x4*)(rope + ((size_t)t * 32 + i) * 2), c1 = *(const f32x4*)(rope + ((size_t)t * 32 + i + 2) * 2);
    lo[0] = v0[0] * c0[0] - v0[1] * c0[1]; hi[0] = v0[1] * c0[0] + v0[0] * c0[1];
    lo[1] = v0[2] * c0[2] - v0[3] * c0[3]; hi[1] = v0[3] * c0[2] + v0[2] * c0[3];
    lo[2] = v1[0] * c1[0] - v1[1] * c1[1]; hi[2] = v1[1] * c1[0] + v1[0] * c1[1];
    lo[3] = v1[2] * c1[2] - v1[3] * c1[3]; hi[3] = v1[3] * c1[2] + v1[2] * c1[3];
}
struct EpiIn {
    static constexpr bool PERM = true, AFTER_DRAIN = false;
    unsigned char* ws;
    template <class Tp> DEV Tp* P(size_t off) const { return (Tp*)(GAS Tp*)(ws + off); }
    DEV void operator()(const f32x4 (&acc)[2][2][4][2], const pg8::Unit& u, int wr, int wc, int fr, int fq) const {
        asm volatile("" : "+v"(fr), "+v"(fq), "+s"(wr), "+s"(wc));
        const int pn = u.pn;
        const float* ssq = P<float>(WS_SSQ); const float* rope = P<float>(WS_ROPE);
#pragma unroll
        for (int ai = 0; ai < 2; ++ai)
#pragma unroll
            for (int m = 0; m < 4; ++m) {
                const int row = u.pm * 256 + ai * 128 + wr * 64 + m * 16 + fr;
                const float rstd = row_rstd(ssq, row, fq);
                const int t = row & (T - 1), b = row >> 13;
#pragma unroll
                for (int bj = 0; bj < 2; ++bj) {
                    const int col = bj * 128 + wc * 32 + fq * 8;
                    const f32x4 v0 = acc[ai][bj][m][0] * rstd, v1 = acc[ai][bj][m][1] * rstd;
                    if (pn < 2) {
                        const int g = pn * 256 + col, head = g >> 6, i = (g & 63) >> 1;
                        const size_t o = (size_t)row * 512 + head * 64 + i;
                        bf16* Q = P<bf16>(WS_Q);
                        v2u w;
                        w.x = pk2(v0[0] * QSCALE, v0[2] * QSCALE); w.y = pk2(v1[0] * QSCALE, v1[2] * QSCALE); *(v2u*)(Q + o) = w;
                        w.x = pk2(v0[1] * QSCALE, v0[3] * QSCALE); w.y = pk2(v1[1] * QSCALE, v1[3] * QSCALE); *(v2u*)(Q + o + 32) = w;
                    } else if (pn == 2) {
                        bf16* dst = P<bf16>((col < 128) ? WS_KCR : WS_VCR);
                        v4u w; w.x = pk2(v0[0], v0[1]); w.y = pk2(v0[2], v0[3]); w.z = pk2(v1[0], v1[1]); w.w = pk2(v1[2], v1[3]);
                        *(v4u*)(dst + (size_t)row * 128 + (col & 127)) = w;
                    } else if (pn == 3 || pn == 4) {
                        if (col < 128) {
                            bf16* dst = P<bf16>((pn == 3) ? WS_KS : WS_KW);
                            const int hkv = col >> 6, i = (col & 63) >> 1;
                            float lo[4], hi[4]; rope4(rope, t, i, v0, v1, lo, hi);
                            const size_t o = (size_t)(b * 2 + hkv) * T * 64 + kfrag_off(t, i);
                            v2u w;
                            w.x = pk2(lo[0], lo[1]); w.y = pk2(lo[2], lo[3]); *(v2u*)(dst + o) = w;
                            w.x = pk2(hi[0], hi[1]); w.y = pk2(hi[2], hi[3]); *(v2u*)(dst + o + 512) = w;
                        } else {
                            bf16* dst = P<bf16>((pn == 3) ? WS_VST : WS_VWT);
                            const int c2 = col - 128, hkv = c2 >> 6, d = c2 & 63;
                            const size_t o = (((size_t)(b * 2 + hkv) * 256 + (t >> 5)) * 64 + d) * 32 + slot32(t & 31);
#pragma unroll
                            for (int j = 0; j < 4; ++j) { dst[o + j * 32] = (bf16)f2bf(v0[j]); dst[o + (j + 4) * 32] = (bf16)f2bf(v1[j]); }
#if defined(DUPMASK) && ((DUPMASK >> 20) & 1)
                            { bf16* dst2 = P<bf16>(WS_U2) + (pn - 3) * (4u << 20);
#pragma unroll
                            for (int j = 0; j < 4; ++j) { dst2[o + j * 32] = (bf16)f2bf(v0[j]); dst2[o + (j + 4) * 32] = (bf16)f2bf(v1[j]); } }
#endif
                        }
                    } else if (pn == 9) {
                        float* dst = P<float>(WS_HF) + (size_t)row * 256 + col;
                        *(f32x4*)dst = v0; *(f32x4*)(dst + 4) = v1;
                    } else {
                        bf16* dst = (pn < 8) ? P<bf16>(WS_CB + (size_t)(pn - 5) * (WS_CC - WS_CB)) : P<bf16>(WS_HQ + (size_t)(pn - 8) * (WS_HF - WS_HQ));
                        v4u w; w.x = pk2(v0[0], v0[1]); w.y = pk2(v0[2], v0[3]); w.z = pk2(v1[0], v1[1]); w.w = pk2(v1[2], v1[3]);
                        *(v4u*)(dst + (size_t)row * 256 + col) = w;
                    }
                }
            }
    }
};

struct EpiRes {
    static constexpr bool PERM = true, AFTER_DRAIN = false;
    const float* base32; bf16* hb; float* ssq;
    DEV void operator()(const f32x4 (&acc)[2][2][4][2], const pg8::Unit& u, int wr, int wc, int fr, int fq) const {
        asm volatile("" : "+v"(fr), "+v"(fq), "+s"(wr), "+s"(wc));
#pragma unroll
        for (int ai = 0; ai < 2; ++ai)
#pragma unroll
            for (int m = 0; m < 4; ++m) {
                const int row = u.pm * 256 + ai * 128 + wr * 64 + m * 16 + fr;
                float ss = 0.f;
#pragma unroll
                for (int bj = 0; bj < 2; ++bj) {
                    const size_t o = (size_t)row * 1024 + u.pn * 256 + bj * 128 + wc * 32 + fq * 8;
                    f32x4 v0, v1;
                    if (base32) { v0 = *(const f32x4*)(base32 + o); v1 = *(const f32x4*)(base32 + o + 4); }
                    else { const v4u hw = *(const v4u*)(hb + o); v0 = (f32x4){bflo(hw.x), bfhi(hw.x), bflo(hw.y), bfhi(hw.y)}; v1 = (f32x4){bflo(hw.z), bfhi(hw.z), bflo(hw.w), bfhi(hw.w)}; }
                    v0 = v0 + acc[ai][bj][m][0]; v1 = v1 + acc[ai][bj][m][1];
                    v4u w; w.x = pk2(v0[0], v0[1]); w.y = pk2(v0[2], v0[3]); w.z = pk2(v1[0], v1[1]); w.w = pk2(v1[2], v1[3]);
                    *(v4u*)(hb + o) = w;
                    ss += ((v0[0] * v0[0] + v0[1] * v0[1]) + (v0[2] * v0[2] + v0[3] * v0[3])) + ((v1[0] * v1[0] + v1[1] * v1[1]) + (v1[2] * v1[2] + v1[3] * v1[3]));
                }
                ss += __shfl_xor(ss, 16); ss += __shfl_xor(ss, 32);
                if (fq == 0) ssq[(size_t)row * 16 + u.pn * 4 + wc] = ss;
            }
    }
};

struct EpiXQ {
    static constexpr bool PERM = true, AFTER_DRAIN = false;
    const float* ssq; bf16* XQ;
    DEV void operator()(const f32x4 (&acc)[2][2][4][2], const pg8::Unit& u, int wr, int wc, int fr, int fq) const {
        asm volatile("" : "+v"(fr), "+v"(fq), "+s"(wr), "+s"(wc));
#pragma unroll
        for (int ai = 0; ai < 2; ++ai)
#pragma unroll
            for (int m = 0; m < 4; ++m) {
                const int row = u.pm * 256 + ai * 128 + wr * 64 + m * 16 + fr;
                const float sc = row_rstd(ssq, row, fq) * QSCALE;
#pragma unroll
                for (int bj = 0; bj < 2; ++bj) {
                    const f32x4 v0 = acc[ai][bj][m][0] * sc, v1 = acc[ai][bj][m][1] * sc;
                    v4u w; w.x = pk2(v0[0], v0[1]); w.y = pk2(v0[2], v0[3]); w.z = pk2(v1[0], v1[1]); w.w = pk2(v1[2], v1[3]);
                    *(v4u*)(XQ + (size_t)row * 256 + bj * 128 + wc * 32 + fq * 8) = w;
                }
            }
    }
};

struct EpiGU {
    static constexpr bool PERM = true, AFTER_DRAIN = false;
    const float* srstd; bf16* ACT;
    DEV void operator()(const f32x4 (&acc)[2][2][4][2], const pg8::Unit& u, int wr, int wc, int fr, int fq) const {
        asm volatile("" : "+v"(fr), "+v"(fq), "+s"(wr), "+s"(wc));
        const int nt = u.pn & 3;
#pragma unroll
        for (int ai = 0; ai < 2; ++ai)
#pragma unroll
            for (int m = 0; m < 4; ++m) {
                const int row = u.pm * 256 + ai * 128 + wr * 64 + m * 16 + fr;
                const float rs = srstd[row];
#pragma unroll
                for (int bj = 0; bj < 2; ++bj) {
                    const f32x4 v0 = acc[ai][bj][m][0] * rs, v1 = acc[ai][bj][m][1] * rs;
                    const int j = (nt * 256 + bj * 128 + wc * 32 + fq * 8) >> 1;
                    v2u w; w.x = pk2(siluf_(v0[0]) * v0[1], siluf_(v0[2]) * v0[3]); w.y = pk2(siluf_(v1[0]) * v1[1], siluf_(v1[2]) * v1[3]);
                    *(v2u*)(ACT + (size_t)row * 512 + j) = w;
                }
            }
    }
};

struct EpiDN {
    static constexpr bool PERM = true, AFTER_DRAIN = false;
    const float* sgate; bf16* YS;
    DEV void operator()(const f32x4 (&acc)[2][2][4][2], const pg8::Unit& u, int wr, int wc, int fr, int fq) const {
        asm volatile("" : "+v"(fr), "+v"(fq), "+s"(wr), "+s"(wc));
        const int nt = u.pn & 3;
#pragma unroll
        for (int ai = 0; ai < 2; ++ai)
#pragma unroll
            for (int m = 0; m < 4; ++m) {
                const int row = u.pm * 256 + ai * 128 + wr * 64 + m * 16 + fr;
                const float gt = sgate[row];
#pragma unroll
                for (int bj = 0; bj < 2; ++bj) {
                    const f32x4 v0 = acc[ai][bj][m][0] * gt, v1 = acc[ai][bj][m][1] * gt;
                    v4u w; w.x = pk2(v0[0], v0[1]); w.y = pk2(v0[2], v0[3]); w.z = pk2(v1[0], v1[1]); w.w = pk2(v1[2], v1[3]);
                    *(v4u*)(YS + (size_t)row * 1024 + nt * 256 + bj * 128 + wc * 32 + fq * 8) = w;
                }
            }
    }
};

struct MoeOrder {
    int nunits, G, c; const LAS int* tileE;
    DEV bool next(int i, pg8::Unit& u) const {
        const int L = i * G + c; if (L >= nunits) return false;
        const int rt = L >> 2; u.pm = rt; u.pn = tileE[rt] * 4 + (L & 3); return true;
    }
    DEV void a_ready(const pg8::Unit&) const {}
    DEV void done(const pg8::Unit&) const {}
};
struct Frame {
    LAS unsigned char* lds;
    unsigned char* ldsg;
    volatile LAS unsigned* MISC;
    gu32* ctl;
    unsigned char* ws;
    int tid, lane, wave, vcu, G;
    float* out;
};
template <class Tp> DEV Tp* wsp(const Frame& F, size_t off) { return (Tp*)(F.ws + off); }
DEV const float* inp(int i) { const float* const* ka = (const float* const*)__builtin_amdgcn_kernarg_segment_ptr(); asm volatile("" : "+s"(i)); return (const float*)(const GAS float*)ka[i]; }

template <bool FRAG = false, class Map>
DEV void tr_item(const float* W, int K, int Nsrc, const float* gain, bf16* WT, float* scr, int item, int lane, Map map) {
    const int nblk = (Nsrc + 31) >> 5, kb = item / nblk, nb = item - kb * nblk, k0 = 64 * kb, n0 = 32 * nb;
    {
        const int nq = (lane & 7) * 4; f32x4 v[8];
#pragma unroll
        for (int i = 0; i < 8; ++i) { const int kk = 8 * i + (lane >> 3);
            v[i] = (n0 + nq < Nsrc) ? *(const f32x4*)(W + (size_t)(k0 + kk) * Nsrc + n0 + nq) : (f32x4){0.f, 0.f, 0.f, 0.f}; }
#pragma unroll
        for (int i = 0; i < 8; ++i) { const int kk = 8 * i + (lane >> 3); const float g = gain ? gain[k0 + kk] : 1.0f; float* s = scr + kk * 33 + nq;
            s[0] = v[i][0] * g; s[1] = v[i][1] * g; s[2] = v[i][2] * g; s[3] = v[i][3] * g; }
    }
    LDS_WAIT();
    const int c = lane & 7;
#pragma unroll
    for (int j = 0; j < 4; ++j) {
        const int n = (lane >> 3) + 8 * j; const float* s = scr + (8 * c) * 33 + n;
        if (n0 + n < Nsrc) {
            v4u o; o.x = pk2(s[0 * 33], s[1 * 33]); o.y = pk2(s[2 * 33], s[3 * 33]); o.z = pk2(s[4 * 33], s[5 * 33]); o.w = pk2(s[6 * 33], s[7 * 33]);
            const int nn = map(n0 + n), kk = k0 + 8 * c;
            if (FRAG) *(v4u*)(WT + ((size_t)((kk >> 5) * (Nsrc >> 4) + (nn >> 4)) * 64 + ((kk >> 3) & 3) * 16 + (nn & 15)) * 8) = o;
            else *(v4u*)(WT + (size_t)nn * K + kk) = o;
        }
    }
    LDS_WAIT();
}
template <class Map>
DEV void tr_experts(const float* W, int K, int Nsrc, const float* gain, bf16* WT, bf16* scr, int gw, int NGW, int lane, Map map) {
    const int nblk = Nsrc >> 6, per_e = (K >> 6) * nblk, NIT = 32 * per_e; const size_t esz = (size_t)K * Nsrc;
#pragma unroll 1
    for (int it = gw; it < NIT; it += NGW) {
        const int e = it / per_e, sub = it - e * per_e, kb = sub / nblk, nb = sub - kb * nblk, k0 = 64 * kb, n0 = 64 * nb, nq = (lane & 15) * 4;
        const float* Wp = W + (size_t)e * esz; bf16* Wo = WT + (size_t)e * esz;
        f32x4 v[16];
#pragma unroll
        for (int i = 0; i < 16; ++i) v[i] = *(const f32x4*)(Wp + (size_t)(k0 + 4 * i + (lane >> 4)) * Nsrc + n0 + nq);
#pragma unroll
        for (int i = 0; i < 16; ++i) { const int kk = 4 * i + (lane >> 4); const float g = gain ? gain[k0 + kk] : 1.0f;
            v2u w; w.x = pk2(v[i][0] * g, v[i][1] * g); w.y = pk2(v[i][2] * g, v[i][3] * g);
            *(v2u*)(scr + kk * 68 + nq) = w; }
        LDS_WAIT();
        const int cc = lane & 7;
#pragma unroll
        for (int j = 0; j < 8; ++j) { const int n = (lane >> 3) + 8 * j; const bf16* s = scr + (8 * cc) * 68 + n;
            v4u o; o.x = (unsigned)s[0] | ((unsigned)s[68] << 16); o.y = (unsigned)s[2 * 68] | ((unsigned)s[3 * 68] << 16);
            o.z = (unsigned)s[4 * 68] | ((unsigned)s[5 * 68] << 16); o.w = (unsigned)s[6 * 68] | ((unsigned)s[7 * 68] << 16);
            *(v4u*)(Wo + (size_t)map(n0 + n) * K + k0 + 8 * cc) = o; }
        LDS_WAIT();
    }
}
struct MapId { DEV int operator()(int n) const { return n; } };
struct MapIn {
    DEV int operator()(int n) const {
        if (n < 512) { const int d = n & 63; return (n & ~63) + 2 * (d & 31) + (d >> 5); }
        if (n < 768) return n;
        if (n < 1280) { const int r = n - 768; if ((r & 255) < 128) { const int d = r & 63; return 768 + (r & ~63) + 2 * (d & 31) + (d >> 5); } return n; }
        if (n < 1304) return 3072 + (n - 1280);
        return n - 24;
    }
};
struct MapGU { DEV int operator()(int n) const { return n < 512 ? 2 * n : 2 * (n - 512) + 1; } };

DEV void convert_experts(Frame& F, int l, bf16* scr, int part, int gw_ = -1, int ngw_ = 0) {
    unsigned zl_ = 0u; asm volatile("" : "+v"(zl_)); const int lane = (int)__builtin_amdgcn_mbcnt_hi(~0u, __builtin_amdgcn_mbcnt_lo(~0u, zl_));
    const int gw = gw_ >= 0 ? gw_ : F.vcu * NWAVES + F.wave, NGW = gw_ >= 0 ? ngw_ : F.G * NWAVES;
    if (part == 0) tr_experts(inp(17) + (size_t)l * 32 * 1024 * 1024, 1024, 1024, inp(22) + l * 1024, wsp<bf16>(F, WS_WGU) + (size_t)l * 32 * 1024 * 1024, scr, gw, NGW, lane, MapGU());
    else tr_experts(inp(18) + (size_t)l * 32 * 512 * 1024, 512, 1024, nullptr, wsp<bf16>(F, WS_WDN) + (size_t)l * 32 * 1024 * 512, scr, gw, NGW, lane, MapId());
}
DEV void p0_prologue(Frame& F) {
    float* scr = (float*)(F.ldsg + F.wave * 16384);
    const int gw = F.vcu * NWAVES + F.wave, NGW = F.G * NWAVES, lane = F.lane;
    for (int l = 0; l < DEPTH; ++l) {
        { const int NIT = 16 * 97; bf16* dst = wsp<bf16>(F, WS_WIN) + (size_t)l * NIN * 1024;
          for (int it = gw; it < NIT; it += NGW) tr_item(inp(2) + (size_t)l * 1024 * IN_W, 1024, IN_W, inp(19) + l * 1024, dst, scr, it, lane, MapIn());
          for (int i = gw * 64 + lane; i < (NIN - 3096) * 1024 / 8; i += NGW * 64) ((v4u*)(dst + (size_t)3096 * 1024))[i] = (v4u){0u, 0u, 0u, 0u}; }
        { const int NIT = 16 * 32; for (int it = gw; it < NIT; it += NGW) tr_item(inp(9) + (size_t)l * 1024 * 1024, 1024, 1024, nullptr, wsp<bf16>(F, WS_WOUT) + (size_t)l * 1024 * 1024, scr, it, lane, MapId()); }
        { const int NIT = 16 * 8; for (int it = gw; it < NIT; it += NGW) tr_item(inp(10) + (size_t)l * 1024 * 256, 1024, 256, inp(20) + l * 1024, wsp<bf16>(F, WS_WQ) + (size_t)l * 256 * 1024, scr, it, lane, MapId()); }
        { const int NIT = 16 * 16; for (int it = gw; it < NIT; it += NGW) tr_item(inp(11) + (size_t)l * 1024 * 512, 1024, 512, inp(21) + l * 1024, wsp<bf16>(F, WS_WKV) + (size_t)l * 512 * 1024, scr, it, lane, MapId()); }
        { const int NIT = 4 * 32; for (int it = gw; it < NIT; it += NGW) tr_item(inp(12) + (size_t)l * 256 * 1024, 256, 1024, nullptr, wsp<bf16>(F, WS_WO) + (size_t)l * 1024 * 256, scr, it, lane, MapId()); }
        for (int kv = 0; kv < 2; ++kv) {
            { const int NIT = 32 * 4; for (int it = gw; it < NIT; it += NGW) tr_item(inp(5) + (size_t)(l * 2 + kv) * 2048 * 128, 2048, 128, nullptr, wsp<bf16>(F, WS_W1C) + (size_t)(l * 2 + kv) * 128 * 2048, scr, it, lane, MapId()); }
            { const int NIT = 2 * 2; for (int it = gw; it < NIT; it += NGW) tr_item(inp(6) + (size_t)(l * 2 + kv) * 128 * 64, 128, 64, nullptr, wsp<bf16>(F, WS_W2C) + (size_t)(l * 2 + kv) * 64 * 128, scr, it, lane, MapId()); }
        }
        if (F.G != 256) { convert_experts(F, l, (bf16*)scr, 0); convert_experts(F, l, (bf16*)scr, 1); }
        { bf16* dst = wsp<bf16>(F, WS_WR) + (size_t)l * 96 * 1024; const float* gn = inp(22) + l * 1024;
          for (int i = gw * 64 + lane; i < 48 * 1024; i += NGW * 64) { const int n = i >> 10, k = i & 1023;
            float v = 0.f; if (n < 4) v = inp(13)[(size_t)(l * 1024 + k) * 4 + n]; else if (n < 36) v = inp(15)[(size_t)(l * 1024 + k) * 32 + (n - 4)];
            v *= gn[k]; const unsigned h = f2bf(v);
            const int fo = ((((k >> 5) * 3 + (n >> 4)) * 2) * 64 + ((k >> 3) & 3) * 16 + (n & 15)) * 8 + (k & 7);
            dst[fo] = (bf16)h; dst[fo + 512] = (bf16)f2bf(v - bf2f((unsigned short)h)); } }
    }
    { bf16* wg = wsp<bf16>(F, WS_WG);
      for (int i = gw * 64 + lane; i < DEPTH * 32 * 1024; i += NGW * 64) { const int l2 = i >> 15, row = (i >> 10) & 31, k = i & 1023, hk = row >> 4, gi = row & 15;
        const float v = gi < 12 ? inp(2)[((size_t)l2 * 1024 + k) * IN_W + 1280 + hk * 12 + gi] * inp(19)[l2 * 1024 + k] : 0.f;
        wg[(l2 * 2 + hk) * 16384 + ((k >> 5) * 64 + ((k >> 3) & 3) * 16 + gi) * 8 + (k & 7)] = (bf16)f2bf(v); } }
    { float* rope = wsp<float>(F, WS_ROPE);
      for (int i = gw * 64 + lane; i < T * 32; i += NGW * 64) { const int t = i >> 5, k = i & 31;
        const float inv = powf(10000.0f, -(float)k / 32.0f); const float ang = (float)t * inv;
        rope[2 * i] = cosf(ang); rope[2 * i + 1] = sinf(ang); } }
    { float* b1 = wsp<float>(F, WS_SMALL);
      for (int i = gw * 64 + lane; i < 4 * 128; i += NGW * 64) { const int lk = i >> 7, n = i & 127;
        const float* pe = inp(4) + (size_t)lk * 2048; const float* w1 = inp(5) + (size_t)lk * 2048 * 128 + n; float s = 0.f;
        for (int kk = 0; kk < 2048; ++kk) s += pe[kk] * w1[(size_t)kk * 128];
        b1[i] = s; } }
    { bf16* HB = wsp<bf16>(F, WS_HB); float* SSQ = wsp<float>(F, WS_SSQ); bf16* MB = wsp<bf16>(F, WS_MEMB); float* SSQM = wsp<float>(F, WS_SMALL) + 1024;
      for (int m = gw; m < NTOK + NB * 256; m += NGW) {
        const bool ism = m >= NTOK; const int r = ism ? m - NTOK : m;
        const f32x4* xr = (const f32x4*)((ism ? inp(1) : inp(0)) + (size_t)r * 1024) + lane;
        unsigned long long* o8 = (unsigned long long*)((ism ? MB : HB) + (size_t)r * 1024) + lane;
        float s = 0.f;
#pragma unroll
        for (int j = 0; j < 4; ++j) { const f32x4 v = xr[64 * j]; s += (v.x * v.x + v.y * v.y) + (v.z * v.z + v.w * v.w);
            o8[64 * j] = (unsigned long long)pk2(v.x, v.y) | ((unsigned long long)pk2(v.z, v.w) << 32); }
        s = wave_sum(s);
        if (ism) { if (lane == 0) SSQM[r] = s; }
        else if (lane < 16) SSQ[(size_t)r * 16 + lane] = lane == 0 ? s : 0.f;
      } }
}

template <int NT>
DEV void skinny16(const bf16* A, size_t lda, const bf16* Bt, size_t ldb, int K, int lane, f32x4 (&acc)[NT]) {
    const int l16 = lane & 15, g4 = lane >> 4;
    const bf16* ap = A + (size_t)l16 * lda + g4 * 8; const bf16* bp = Bt + (size_t)l16 * ldb + g4 * 8;
#pragma unroll
    for (int n = 0; n < NT; ++n) acc[n] = (f32x4){0.f, 0.f, 0.f, 0.f};
#pragma unroll 2
    for (int k = 0; k < K; k += 32) {
        const bf16x8 a = *(const bf16x8*)(ap + k);
#pragma unroll
        for (int n = 0; n < NT; ++n) { const bf16x8 b = *(const bf16x8*)(bp + (size_t)n * 16 * ldb + k); acc[n] = mfma16(a, b, acc[n]); }
    }
}

DEV void memkv_phase(Frame& F) {
    const int gw = F.vcu * NWAVES + F.wave, NGW = F.G * NWAVES, lane = F.lane, l16 = lane & 15, g4 = lane >> 4;
    const bf16* MB = wsp<bf16>(F, WS_MEMB); const float* SSQM = wsp<float>(F, WS_SMALL) + 1024;
    bf16* MK = wsp<bf16>(F, WS_MK); bf16* MVT = wsp<bf16>(F, WS_MVT);
    for (int task = gw; task < 1024; task += NGW) {
        const int l2 = task >> 9, rt = (task >> 3) & 63, chunk = task & 7;
        f32x4 acc[4];
        skinny16<4>(MB + (size_t)rt * 16 * 1024, 1024, wsp<bf16>(F, WS_WKV) + ((size_t)l2 * 512 + chunk * 64) * 1024, 1024, 1024, lane, acc);
        const int b = rt >> 4, key0 = (rt & 15) * 16 + g4 * 4;
        float rs[4];
#pragma unroll
        for (int r = 0; r < 4; ++r) rs[r] = 1.0f / sqrtf(SSQM[rt * 16 + g4 * 4 + r] * (1.0f / 1024.0f) + RMS_EPS);
#pragma unroll
        for (int nt = 0; nt < 4; ++nt) {
            const int n = chunk * 64 + nt * 16 + l16;
            if (chunk < 4) { const int head = n >> 6, d = n & 63;
#pragma unroll
                for (int r = 0; r < 4; ++r) MK[(size_t)((l2 * 4 + b) * 4 + head) * 256 * 64 + kfrag_off(key0 + r, d)] = (bf16)f2bf(acc[nt][r] * rs[r]);
            } else { const int n2 = n - 256, head = n2 >> 6, d = n2 & 63;
                v2u w; w.x = pk2(acc[nt][0] * rs[0], acc[nt][1] * rs[1]); w.y = pk2(acc[nt][2] * rs[2], acc[nt][3] * rs[3]);
                *(v2u*)(MVT + (((size_t)((l2 * 4 + b) * 4 + head) * 8 + (key0 >> 5)) * 64 + d) * 32 + slot32(key0 & 31)) = w; }
        }
    }
}

DEV void compress_phase(Frame& F, int l) {
    const int lane = F.lane, l16 = lane & 15, g4 = lane >> 4, quad = F.wave >> 2, q = F.wave & 3;
    float* part = (float*)F.ldsg + quad * (4 * 16 * 128);
    const bf16* KCR = wsp<bf16>(F, WS_KCR); const bf16* VCR = wsp<bf16>(F, WS_VCR);
    bf16* KCC = wsp<bf16>(F, WS_KCC); bf16* VCT = wsp<bf16>(F, WS_VCT);
    const float* bias1 = wsp<float>(F, WS_SMALL);
    for (int tk0 = F.vcu * 2; tk0 < 512; tk0 += F.G * 2) {
        const int tk = tk0 + quad; const int kv = tk >> 8, tile = tk & 255;
        const bf16* raw = kv ? VCR : KCR;
        const bf16* w1 = wsp<bf16>(F, WS_W1C) + (size_t)(l * 2 + kv) * 128 * 2048;
        const bf16* w2 = wsp<bf16>(F, WS_W2C) + (size_t)(l * 2 + kv) * 64 * 128;
        { const int r = tile * 16 + l16, bh = r >> 9, c = r & 511, b = bh >> 1, hkv = bh & 1;
          f32x4 acc[8];
#pragma unroll
          for (int n = 0; n < 8; ++n) acc[n] = (f32x4){0.f, 0.f, 0.f, 0.f};
#pragma unroll 2
          for (int ks = q * 16; ks < q * 16 + 16; ++ks) {
              const int kk = ks * 32 + g4 * 8, ll = kk >> 6, d = kk & 63;
              int tok = 16 * c + ll; tok = tok > T - 1 ? T - 1 : tok;
              const bf16x8 a = *(const bf16x8*)(raw + ((size_t)b * T + tok) * 128 + hkv * 64 + d);
#pragma unroll
              for (int n = 0; n < 8; ++n) { const bf16x8 bb = *(const bf16x8*)(w1 + (size_t)(n * 16 + l16) * 2048 + kk); acc[n] = mfma16(a, bb, acc[n]); }
          }
#pragma unroll
          for (int n = 0; n < 8; ++n)
#pragma unroll
              for (int r2 = 0; r2 < 4; ++r2) part[(q * 16 + g4 * 4 + r2) * 128 + n * 16 + l16] = acc[n][r2];
        }
        __syncthreads();
        { f32x4 o = (f32x4){0.f, 0.f, 0.f, 0.f};
#pragma unroll
          for (int k2 = 0; k2 < 4; ++k2) {
              const int h0 = k2 * 32 + g4 * 8;
              float hv[8];
#pragma unroll
              for (int j = 0; j < 8; ++j) { float s = bias1[(l * 2 + kv) * 128 + h0 + j];
#pragma unroll
                  for (int p = 0; p < 4; ++p) s += part[(p * 16 + l16) * 128 + h0 + j];
                  hv[j] = siluf_(s); }
              bf16x8 a; { v4u w; w.x = pk2(hv[0], hv[1]); w.y = pk2(hv[2], hv[3]); w.z = pk2(hv[4], hv[5]); w.w = pk2(hv[6], hv[7]); a = __builtin_bit_cast(bf16x8, w); }
              const bf16x8 bb = *(const bf16x8*)(w2 + (size_t)(q * 16 + l16) * 128 + h0);
              o = mfma16(a, bb, o);
          }
          const int r0 = tile * 16 + g4 * 4, bh = r0 >> 9, c0 = r0 & 511, d = q * 16 + l16;
          if (kv == 0) {
#pragma unroll
              for (int r2 = 0; r2 < 4; ++r2) KCC[(size_t)bh * 512 * 64 + kfrag_off(c0 + r2, d)] = (c0 + r2 == 511) ? (bf16)0 : (bf16)f2bf(o[r2]);
          } else {
              v2u w; w.x = pk2(o[0], o[1]); w.y = pk2(o[2], (c0 + 3 == 511) ? 0.f : o[3]);
              *(v2u*)(VCT + (((size_t)bh * 16 + (c0 >> 5)) * 64 + d) * 32 + slot32(c0 & 31)) = w;
          }
        }
        __syncthreads();
    }
}

DEV float hgrn_lb(const Frame& F, int l, int c) {
    if (l == 0) return 0.f;
    const float a = inp(7)[c], b = inp(7)[256 + c];
    return 1.0f / (1.0f + expf(a - b));
}
DEV float hgrn_logf(float z, float lb) {
    const float la = logf(fmaxf(lb, 1e-30f));
    const float ls = fminf(z, 0.f) - log1pf(expf(-fabsf(z)));
    const float lc = log1pf(-lb) + ls;
    const float mx = fmaxf(la, lc), mn = fminf(la, lc);
    return mx + log1pf(expf(mn - mx));
}
constexpr int HS = 68;
DEV f32x4 mfma4(float a, float b, f32x4 c) { return __builtin_amdgcn_mfma_f32_16x16x4f32(a, b, c, 0, 0, 0); }
DEV void hgrn_setup_chunk(Frame& F, float lb, const float (&z)[8], float* Bc, float* Kc, float* tot) {
    const int d = F.tid & 63, sg = F.tid >> 6;
    const float la = logf(fmaxf(lb, 1e-30f)), l1m = log1pf(-lb), onem = 1.0f - lb;
    float loc[8], kv[8]; float run = 0.f;
#pragma unroll
    for (int i = 0; i < 8; ++i) {
        const float ez = __expf(-fabsf(z[i]));
        const float lc = l1m + (fminf(z[i], 0.f) - __logf(1.0f + ez));
        const float mx = fmaxf(la, lc), mn = fminf(la, lc);
        run += mx + __logf(1.0f + __expf(mn - mx)); loc[i] = run;
        kv[i] = onem * (z[i] >= 0.f ? ez : 1.0f) / (1.0f + ez);
    }
    tot[sg * 64 + d] = run;
    __syncthreads();
    float off = 0.f;
    for (int g = 0; g < sg; ++g) off += tot[g * 64 + d];
#pragma unroll
    for (int i = 0; i < 8; ++i) { Bc[(sg * 8 + i) * HS + d] = off + loc[i]; Kc[(sg * 8 + i) * HS + d] = kv[i]; }
    __syncthreads();
}
DEV void hgrn_local_phase(Frame& F, int l) {
    float* Bc = (float*)F.ldsg; float* Kc = Bc + 64 * HS; float* Vc = Kc + 64 * HS; float* tot = Vc + 64 * HS;
    bf16* U = wsp<bf16>(F, WS_U); float* DEC = wsp<float>(F, WS_DEC);
    const int lane = F.lane, w = F.wave, li = lane & 15, kq = lane >> 4;
    for (int task = F.vcu; task < 2048; task += F.G) {
        const int bh = task >> 7, ch = task & 127, b = bh >> 2, h = bh & 3;
        { const int d = F.tid & 63, sg = F.tid >> 6;
          const size_t go = ((size_t)b * T + ch * 64 + sg * 8) * 256 + h * 64 + d;
          const float* HFp = wsp<float>(F, WS_HF) + go; const bf16* HIp = wsp<bf16>(F, WS_HI) + go;
          float z[8], vi[8];
#pragma unroll
          for (int i = 0; i < 8; ++i) { z[i] = HFp[(size_t)i * 256]; vi[i] = bf2f(HIp[(size_t)i * 256]); }
          hgrn_setup_chunk(F, hgrn_lb(F, l, h * 64 + d), z, Bc, Kc, tot);
          const float bl = Bc[63 * HS + d];
#pragma unroll
          for (int i = 0; i < 8; ++i) { const int s = sg * 8 + i; Kc[s * HS + d] *= __expf(bl - Bc[s * HS + d]); Vc[s * HS + d] = vi[i]; }
          if (sg == 0) DEC[(size_t)task * 64 + d] = expf(bl); }
        __syncthreads();
        { const int dI = w >> 1, e0 = (w & 1) * 32;
          f32x4 a0 = (f32x4){0.f, 0.f, 0.f, 0.f}, a1 = a0;
#pragma unroll 4
          for (int k0 = 0; k0 < 64; k0 += 4) { const int s = k0 + kq;
              const float a = Kc[s * HS + dI * 16 + li], b0 = Vc[s * HS + e0 + li], b1 = Vc[s * HS + e0 + 16 + li];
              a0 = mfma4(a, b0, a0); a1 = mfma4(a, b1, a1); }
#pragma unroll
          for (int r = 0; r < 4; ++r) { bf16* up = U + ((size_t)task * 64 + dI * 16 + 4 * kq + r) * 64 + e0 + li; up[0] = (bf16)f2bf(a0[r]); up[16] = (bf16)f2bf(a1[r]); } }
        __syncthreads();
    }
}
DEV void hgrn_scan_phase(Frame& F, int probe = 0) {
    const bf16* U = wsp<bf16>(F, WS_U); bf16* U2 = wsp<bf16>(F, probe ? WS_PROBE : WS_U2); const float* DEC = wsp<float>(F, WS_DEC);
    const int nact = (F.G * 256 >= 65536) ? 256 : 512;
    if (F.tid < nact)
    for (int gid = F.vcu * nact + F.tid; gid < 65536; gid += F.G * nact) {
        const int bh = gid >> 12, de = gid & 4095, d = de >> 6;
        float S = 0.f; const bf16* up = U + (size_t)bh * 128 * 4096 + de; bf16* op = U2 + (size_t)bh * 128 * 4096 + de; const float* dp = DEC + (size_t)bh * 128 * 64 + d;
#pragma unroll 16
        for (int ch = 0; ch < 128; ++ch) { const float u = bf2f(up[(size_t)ch * 4096]); const float dc = dp[ch * 64]; op[(size_t)ch * 4096] = (bf16)f2bf(S); S = dc * S + u; }
    }
}
DEV void hgrn_out_phase(Frame& F, int l) {
    float* Bc = (float*)F.ldsg; float* Kb = Bc + 64 * HS; float* Vc = Kb + 64 * HS; float* Qs = Vc + 64 * HS; float* Sc = Qs + 64 * HS; float* Ac = Sc + 64 * HS; float* tot = Ac + 64 * HS;
    float* Oc = Kb;
    const bf16* U = wsp<bf16>(F, WS_U2); bf16* CAT = wsp<bf16>(F, WS_CAT);
    const int lane = F.lane, w = F.wave, li = lane & 15, kq = lane >> 4;
    for (int task = F.vcu; task < 2048; task += F.G) {
        const int bh = task >> 7, ch = task & 127, b = bh >> 2, h = bh & 3;
        float gv[8];
        { const int d = F.tid & 63, sg = F.tid >> 6;
          const size_t go = ((size_t)b * T + ch * 64 + sg * 8) * 256 + h * 64 + d;
          const float* HFp = wsp<float>(F, WS_HF) + go; const bf16* HIp = wsp<bf16>(F, WS_HI) + go; const bf16* HQp = wsp<bf16>(F, WS_HQ) + go; const bf16* HGp = wsp<bf16>(F, WS_HG) + go;
          const bf16* Up = U + ((size_t)task * 64 + sg * 8) * 64 + d;
          float z[8], vi[8], qi[8], si[8];
#pragma unroll
          for (int i = 0; i < 8; ++i) { z[i] = HFp[(size_t)i * 256]; vi[i] = bf2f(HIp[(size_t)i * 256]); qi[i] = bf2f(HQp[(size_t)i * 256]); gv[i] = bf2f(HGp[(size_t)i * 256]); si[i] = bf2f(Up[(size_t)i * 64]); }
          hgrn_setup_chunk(F, hgrn_lb(F, l, h * 64 + d), z, Bc, Kb, tot);
#pragma unroll
          for (int i = 0; i < 8; ++i) { const int s = sg * 8 + i, J = s >> 4; const float rJ = J ? Bc[(16 * J - 1) * HS + d] : 0.f;
              Kb[s * HS + d] *= __expf(fminf(rJ - Bc[s * HS + d], 80.f));
              Vc[s * HS + d] = vi[i]; Qs[s * HS + d] = qi[i] * 0.125f; Sc[s * HS + d] = si[i]; } }
        __syncthreads();
#pragma unroll 1
        for (int ti = w; ti < 10; ti += 8) {
            const int I = ti < 1 ? 0 : (ti < 3 ? 1 : (ti < 6 ? 2 : 3)), J = ti - (I * (I + 1)) / 2;
            const int t = I * 16 + li; f32x4 acc = (f32x4){0.f, 0.f, 0.f, 0.f};
#pragma unroll 4
            for (int k0 = 0; k0 < 64; k0 += 4) { const int d = k0 + kq; const float rJ = J ? Bc[(16 * J - 1) * HS + d] : 0.f;
                const float a = Qs[t * HS + d] * __expf(Bc[t * HS + d] - rJ), bb = Kb[(J * 16 + li) * HS + d];
                acc = mfma4(a, bb, acc); }
#pragma unroll
            for (int r = 0; r < 4; ++r) { const int tt = I * 16 + 4 * kq + r, ss = J * 16 + li; Ac[tt * HS + ss] = (ss <= tt) ? acc[r] : 0.f; }
        }
        __syncthreads();
        { const int I = w >> 1, e0 = (w & 1) * 32, t = I * 16 + li;
          f32x4 a0 = (f32x4){0.f, 0.f, 0.f, 0.f}, a1 = a0;
#pragma unroll 4
          for (int k0 = 0; k0 < 64; k0 += 4) { const int d = k0 + kq;
              const float a = Qs[t * HS + d] * __expf(Bc[t * HS + d]), b0 = Sc[d * HS + e0 + li], b1 = Sc[d * HS + e0 + 16 + li];
              a0 = mfma4(a, b0, a0); a1 = mfma4(a, b1, a1); }
#pragma unroll 1
          for (int s0 = 0; s0 < 16 * (I + 1); s0 += 4) { const int s = s0 + kq;
              const float a = Ac[t * HS + s], b0 = Vc[s * HS + e0 + li], b1 = Vc[s * HS + e0 + 16 + li];
              a0 = mfma4(a, b0, a0); a1 = mfma4(a, b1, a1); }
#pragma unroll
          for (int r = 0; r < 4; ++r) { float* op = Oc + (I * 16 + 4 * kq + r) * HS + e0 + li; op[0] = a0[r]; op[16] = a1[r]; } }
        __syncthreads();
        { const float ng = inp(8)[l * 256 + h * 64 + lane];
          { const int t = w * 8 + (lane >> 3); const float* op = Oc + t * HS + (lane & 7) * 8; float s = 0.f;
#pragma unroll
            for (int j = 0; j < 8; ++j) s += op[j] * op[j];
            s += __shfl_xor(s, 1); s += __shfl_xor(s, 2); s += __shfl_xor(s, 4);
            if ((lane & 7) == 0) tot[t] = 1.0f / sqrtf(s * (1.0f / 64.0f) + RMS_EPS); }
          LDS_WAIT();
#pragma unroll
          for (int i = 0; i < 8; ++i) { const int t = w * 8 + i; const float o = Oc[t * HS + lane];
              const size_t row = (size_t)b * T + ch * 64 + t;
              CAT[row * 1024 + 768 + h * 64 + lane] = (bf16)f2bf(o * tot[t] * ng * siluf_(gv[i])); } }
        __syncthreads();
    }
}

DEV void conv_phase(Frame& F, int l) {
    const bf16* CB = wsp<bf16>(F, WS_CB); const bf16* CC = wsp<bf16>(F, WS_CC); const bf16* CH = wsp<bf16>(F, WS_CH); bf16* CAT = wsp<bf16>(F, WS_CAT);
    const float* cw = inp(3) + l * 3 * 256;
    for (int it = F.vcu * 512 + F.tid; it < NTOK * 32; it += F.G * 512) {
        const int m = it >> 5, c0 = (it & 31) * 8, t = m & (T - 1);
        const v4u bb = *(const v4u*)(CB + (size_t)m * 256 + c0);
        float y[8];
#pragma unroll
        for (int j = 0; j < 8; ++j) y[j] = 0.f;
#pragma unroll
        for (int k = 0; k < 3; ++k) {
            if (t + k - 2 >= 0) {
                const size_t o = (size_t)(m + k - 2) * 256 + c0;
                const v4u cc = *(const v4u*)(CC + o), hh = *(const v4u*)(CH + o);
#pragma unroll
                for (int j = 0; j < 4; ++j) { const float w0 = cw[k * 256 + c0 + 2 * j], w1 = cw[k * 256 + c0 + 2 * j + 1];
                    y[2 * j] += w0 * (bflo(cc[j]) * bflo(hh[j])); y[2 * j + 1] += w1 * (bfhi(cc[j]) * bfhi(hh[j])); }
            }
        }
        v4u o4;
#pragma unroll
        for (int j = 0; j < 4; ++j) o4[j] = pk2(bflo(bb[j]) * y[2 * j], bfhi(bb[j]) * y[2 * j + 1]);
        *(v4u*)(CAT + (size_t)m * 1024 + 512 + c0) = o4;
    }
}
struct SmState { float m, l; f32x4 o[4]; };
DEV void sm_reset(SmState& st) { st.m = -INFINITY; st.l = 0.f;
#pragma unroll
    for (int i = 0; i < 4; ++i) st.o[i] = (f32x4){0.f, 0.f, 0.f, 0.f}; }
DEV float sm_lsum(const SmState& st) { float l = st.l; l += __shfl_xor(l, 16); l += __shfl_xor(l, 32); return l; }
DEV void load_k(const bf16* kbase, int lane, bf16x8 (&kf)[2][2]) {
#pragma unroll
    for (int tt = 0; tt < 2; ++tt)
#pragma unroll
        for (int ks = 0; ks < 2; ++ks) kf[tt][ks] = *(const bf16x8*)(kbase + lane * 8 + (tt * 2 + ks) * 512);
}
DEV void load_v(const bf16* vbase, int lane, bf16x8 (&vf)[4]) {
    const int l16 = lane & 15, g4 = lane >> 4;
#pragma unroll
    for (int dt = 0; dt < 4; ++dt) vf[dt] = *(const bf16x8*)(vbase + (size_t)(dt * 16 + l16) * 32 + g4 * 8);
}
DEV void qk_tile(const bf16x8 (&kf)[2][2], const bf16x8 (&qf)[2], f32x4 (&s)[2]) {
#pragma unroll
    for (int tt = 0; tt < 2; ++tt) { s[tt] = mfma16(kf[tt][0], qf[0], (f32x4){0.f, 0.f, 0.f, 0.f}); s[tt] = mfma16(kf[tt][1], qf[1], s[tt]); }
}
DEV bf16x8 pack_p(const float (&p)[2][4]) {
    v4u w; w.x = pk2(p[0][0], p[0][1]); w.y = pk2(p[0][2], p[0][3]); w.z = pk2(p[1][0], p[1][1]); w.w = pk2(p[1][2], p[1][3]);
    return __builtin_bit_cast(bf16x8, w);
}
template <int MODE, class MaskF>
DEV void attn_compute(const bf16x8 (&kf)[2][2], const bf16x8 (&vf)[4], const bf16x8 (&qf)[2], SmState& st, int lane, bool colok, MaskF mask) {
    const int g4 = lane >> 4;
    f32x4 s[2]; qk_tile(kf, qf, s);
    float sv[2][4]; float tmax = -INFINITY;
#pragma unroll
    for (int tt = 0; tt < 2; ++tt)
#pragma unroll
        for (int r = 0; r < 4; ++r) { float x = s[tt][r]; if (MODE == 2) x = mask(16 * tt + 4 * g4 + r) ? x : -INFINITY; sv[tt][r] = x; tmax = fmaxf(tmax, x); }
    if (MODE == 1) tmax = colok ? tmax : -INFINITY;
    tmax = fmaxf(tmax, __shfl_xor(tmax, 16)); tmax = fmaxf(tmax, __shfl_xor(tmax, 32));
    const float mnew = fmaxf(st.m, tmax), muse = (mnew == -INFINITY) ? 0.f : mnew;
    const float alpha = ex2(st.m - muse);
    const float msub = (MODE == 1) ? (colok ? muse : INFINITY) : muse;
    float p[2][4]; float ps = 0.f;
#pragma unroll
    for (int tt = 0; tt < 2; ++tt)
#pragma unroll
        for (int r = 0; r < 4; ++r) { p[tt][r] = ex2(sv[tt][r] - msub); ps += p[tt][r]; }
    st.l = st.l * alpha + ps; st.m = mnew;
    const bf16x8 pf = pack_p(p);
#pragma unroll
    for (int dt = 0; dt < 4; ++dt) { st.o[dt] = st.o[dt] * alpha; st.o[dt] = mfma16(vf[dt], pf, st.o[dt]); }
}
template <int MODE, class MaskF>
DEV void attn_compute_fixed(const bf16x8 (&kf)[2][2], const bf16x8 (&vf)[4], const bf16x8 (&qf)[2], SmState& st, float mref, int lane, bool colok, MaskF mask) {
    const int g4 = lane >> 4;
    const float c0 = (MODE == 1) ? (colok ? -mref : -INFINITY) : -mref;
    const f32x4 ci = {c0, c0, c0, c0};
    f32x4 s[2];
#pragma unroll
    for (int tt = 0; tt < 2; ++tt) { s[tt] = mfma16(kf[tt][0], qf[0], ci); s[tt] = mfma16(kf[tt][1], qf[1], s[tt]); }
    float p[2][4];
#pragma unroll
    for (int tt = 0; tt < 2; ++tt)
#pragma unroll
        for (int r = 0; r < 4; ++r) { float x = s[tt][r]; if (MODE == 2) x = mask(16 * tt + 4 * g4 + r) ? x : -INFINITY; p[tt][r] = ex2(x); }
    st.l += ((p[0][0] + p[0][1]) + (p[0][2] + p[0][3])) + ((p[1][0] + p[1][1]) + (p[1][2] + p[1][3]));
    const bf16x8 pf = pack_p(p);
#pragma unroll
    for (int dt = 0; dt < 4; ++dt) st.o[dt] = mfma16(vf[dt], pf, st.o[dt]);
}
template <int MODE, class MaskF>
DEV void attn_max(const bf16x8 (&kf)[2][2], const bf16x8 (&qf)[2], float& mx, int lane, bool colok, MaskF mask) {
    const int g4 = lane >> 4;
    f32x4 s[2]; qk_tile(kf, qf, s);
    float tmax = -INFINITY;
#pragma unroll
    for (int tt = 0; tt < 2; ++tt)
#pragma unroll
        for (int r = 0; r < 4; ++r) { float x = s[tt][r]; if (MODE == 2) x = mask(16 * tt + 4 * g4 + r) ? x : -INFINITY; tmax = fmaxf(tmax, x); }
    if (MODE == 1) tmax = colok ? tmax : -INFINITY;
    mx = fmaxf(mx, tmax);
}
DEV float colmax_finish(float mx) { mx = fmaxf(mx, __shfl_xor(mx, 16)); mx = fmaxf(mx, __shfl_xor(mx, 32)); return mx == -INFINITY ? 0.f : mx; }
DEV float col_norm(const bf16x8 (&qf)[2]) {
    float s = 0.f;
#pragma unroll
    for (int ks = 0; ks < 2; ++ks) { const v4u w = __builtin_bit_cast(v4u, qf[ks]);
#pragma unroll
        for (int j = 0; j < 4; ++j) { const float a = bflo(w[j]), b = bfhi(w[j]); s += a * a + b * b; } }
    s += __shfl_xor(s, 16); s += __shfl_xor(s, 32);
    return sqrtf(s);
}
DEV float wave_max_uniform(float v) {
#pragma unroll
    for (int o = 1; o < 64; o <<= 1) v = fmaxf(v, __shfl_xor(v, o));
    return __builtin_bit_cast(float, __builtin_amdgcn_readfirstlane(__builtin_bit_cast(int, v)));
}
constexpr float FIXED_REF_MAX = 40.f;
DEV void kmax_phase(Frame& F, int l) {
    const int lane = F.lane; const int gw = F.vcu * NWAVES + F.wave, NGW = F.G * NWAVES;
    for (int item = gw; item < 2048; item += NGW) {
        const int br = item >> 10, bh = (item >> 7) & 7, key = (item & 127) * 64 + lane;
        const bf16* kp = wsp<bf16>(F, br ? WS_KW : WS_KS) + (size_t)bh * T * 64;
        float s = 0.f;
#pragma unroll
        for (int i = 0; i < 8; ++i) { const v4u w = *(const v4u*)(kp + kfrag_off(key, i * 8));
#pragma unroll
            for (int j = 0; j < 4; ++j) { const float a = bflo(w[j]), b = bfhi(w[j]); s += a * a + b * b; } }
#pragma unroll
        for (int o = 1; o < 64; o <<= 1) s = fmaxf(s, __shfl_xor(s, o));
        if (lane == 0) __hip_atomic_fetch_max((unsigned*)F.ctl + CW_KMAX + l * 16 + br * 8 + bh, __builtin_bit_cast(unsigned, s), RLX_AGENT);
    }
}
struct NoMask { DEV bool operator()(int) const { return true; } };
template <int D, bool WITHV, class AddrF, class BodyF>
DEV void pipe_run(int n, int lane, AddrF addr, BodyF body) {
    if (n <= 0) return;
    bf16x8 kf[D][2][2], vf[D][4];
#pragma unroll
    for (int d = 0; d < D; ++d) { const bf16* kb; const bf16* vb; addr(d < n ? d : n - 1, kb, vb); load_k(kb, lane, kf[d]); if (WITHV) load_v(vb, lane, vf[d]); }
#pragma unroll 1
    for (int i = 0; i < n; i += D) {
#pragma unroll
        for (int d = 0; d < D; ++d) { const int s = i + d;
            if (s < n) body(s, kf[d], vf[d]);
            if (D > 1 || s + 1 < n) { const bf16* kb; const bf16* vb; addr(s + D < n ? s + D : n - 1, kb, vb); load_k(kb, lane, kf[d]); if (WITHV) load_v(vb, lane, vf[d]); } }
    }
}
template <class AddrF, class BodyF>
DEV void pipe_run_k2(int n, int lane, AddrF addr, BodyF body) {
    if (n <= 0) return;
    bf16x8 kf[2][2][2], vf[4];
    { const bf16* kb; const bf16* vb; addr(0, kb, vb); load_k(kb, lane, kf[0]); }
#pragma unroll 1
    for (int i = 0; i < n; i += 2) {
#pragma unroll
        for (int d = 0; d < 2; ++d) { const int s = i + d;
            { const bf16* kb; const bf16* vb; addr(s < n ? s : n - 1, kb, vb); load_v(vb, lane, vf); }
            { const bf16* kb; const bf16* vb; addr(s + 1 < n ? s + 1 : n - 1, kb, vb); load_k(kb, lane, kf[d ^ 1]); }
            if (s < n) body(s, kf[d], vf); }
    }
}
template <class AddrF, class BodyA, class BodyB>
DEV void pipe_run_mt(int n_main, int n_tail, int lane, AddrF addr, BodyA mainb, BodyB tailb) {
    const int n = n_main + n_tail;
    bf16x8 kf[2][2][2], vf[4];
    { const bf16* kb; const bf16* vb; addr(0, kb, vb); load_k(kb, lane, kf[0]); }
    int i = 0;
#define PIPE_STEP_(s_, d_, BODY_) do { { const bf16* kb; const bf16* vb; addr((s_) < n ? (s_) : n - 1, kb, vb); load_v(vb, lane, vf); } \
        { const bf16* kb; const bf16* vb; addr((s_) + 1 < n ? (s_) + 1 : n - 1, kb, vb); load_k(kb, lane, kf[(d_) ^ 1]); } BODY_((s_), kf[d_], vf); } while (0)
#pragma unroll 1
    for (; i + 2 <= n_main; i += 2) { PIPE_STEP_(i, 0, mainb); PIPE_STEP_(i + 1, 1, mainb); }
    if (i < n_main) { PIPE_STEP_(i, 0, mainb); ++i;
#pragma unroll
        for (int a = 0; a < 2; ++a)
#pragma unroll
            for (int b = 0; b < 2; ++b) kf[0][a][b] = kf[1][a][b]; }
#pragma unroll 1
    for (; i < n; ++i) { PIPE_STEP_(i, 0, tailb);
#pragma unroll
        for (int a = 0; a < 2; ++a)
#pragma unroll
            for (int b = 0; b < 2; ++b) kf[0][a][b] = kf[1][a][b]; }
#undef PIPE_STEP_
}
constexpr int PIPE_D = 2;

DEV void acc_add_packed(unsigned (&pk)[4][4][2], int ct, const f32x4 (&o)[4], float sc, bool first) {
#pragma unroll
    for (int dt = 0; dt < 4; ++dt) {
        f32x4 v = o[dt] * sc;
        if (!first) { v[0] += bflo(pk[ct][dt][0]); v[1] += bfhi(pk[ct][dt][0]); v[2] += bflo(pk[ct][dt][1]); v[3] += bfhi(pk[ct][dt][1]); }
        pk[ct][dt][0] = pk2(v[0], v[1]); pk[ct][dt][1] = pk2(v[2], v[3]);
    }
}
template <int VAR>
DEV void nsa_phase_t(Frame& F, int l) {
#define NSA_RELANE() int ln_ = lane; asm volatile("" : "+v"(ln_)); const int l16 = ln_ & 15, g4 = ln_ >> 4, tq = l16 >> 2, gh = l16 & 3; const size_t mrow0 = (size_t)b * T + t0 + tq; const int tl0 = t0 + tq; (void)l16; (void)g4; (void)gh; (void)mrow0; (void)tl0
    float* IMP = (float*)(F.ldsg + F.wave * NSA_LDS_WAVE);
    float* VALS = IMP + 2048; int* BL = (int*)(IMP + 2176); unsigned* SELB = (unsigned*)(IMP + 2304); float* GL = IMP + 2432;
    const bf16* Q = wsp<bf16>(F, WS_Q);
    const bf16* KCC = wsp<bf16>(F, WS_KCC); const bf16* VCT = wsp<bf16>(F, WS_VCT);
    const bf16* KS = wsp<bf16>(F, WS_KS); const bf16* VST = wsp<bf16>(F, WS_VST);
    const bf16* KW = wsp<bf16>(F, WS_KW); const bf16* VWT = wsp<bf16>(F, WS_VWT);
    bf16* CAT = wsp<bf16>(F, WS_CAT);
    const int gw = F.vcu * NWAVES + F.wave, NGW = F.G * NWAVES;
    const bool xmap = (F.G == 256);
#pragma unroll 1
    for (int task = gw; task < 4096; task += NGW) {
        unsigned zl_ = 0u; asm volatile("" : "+v"(zl_)); const int lane = (int)__builtin_amdgcn_mbcnt_hi(~0u, __builtin_amdgcn_mbcnt_lo(~0u, zl_));
        const int u_ = (F.wave < 4) ? (F.vcu & 31) : 63 - (F.vcu & 31), first_ = 4 * u_ + (F.wave & 3);
        const int bh = xmap ? (gw >> 8) : (task & 7), idx = xmap ? ((task >> 11) ? 511 - first_ : first_) : (task >> 3);
        const int t0 = idx * 16, b = bh >> 1, hkv = bh & 1, cur = t0 >> 6;
        bf16x8 qf[4][2];
        unsigned opk[4][4][2];
        SmState st[4];
        float qnmax = 0.f;
        { NSA_RELANE();
#pragma unroll
        for (int ct = 0; ct < 4; ++ct)
#pragma unroll
            for (int ks = 0; ks < 2; ++ks) qf[ct][ks] = *(const bf16x8*)(Q + (mrow0 + 4 * ct) * 512 + hkv * 256 + gh * 64 + ks * 32 + g4 * 8);
        { NSA_RELANE();
          f32x4 ga[1]; ga[0] = (f32x4){0.f, 0.f, 0.f, 0.f};
          { const bf16* ap = wsp<bf16>(F, WS_HB) + ((size_t)b * T + t0 + l16) * 1024 + g4 * 8; const bf16* bp = wsp<bf16>(F, WS_WG) + (size_t)(l * 2 + hkv) * 16384 + ln_ * 8;
#pragma unroll 1
            for (int k0 = 0; k0 < (VAR == 11 ? 0 : 1024); k0 += 256) {
                bf16x8 av[8], bv[8];
#pragma unroll
                for (int i = 0; i < 8; ++i) { av[i] = *(const bf16x8*)(ap + k0 + 32 * i); bv[i] = *(const bf16x8*)(bp + (k0 + 32 * i) * 16); }
#pragma unroll
                for (int i = 0; i < 8; ++i) ga[0] = mfma16(av[i], bv[i], ga[0]);
            } }
          const float rs = (ln_ < 16) ? row_rstd_full(wsp<float>(F, WS_SSQ), b * T + t0 + ln_) : 0.f;
#pragma unroll
          for (int r = 0; r < 4; ++r) GL[(g4 * 4 + r) * 16 + l16] = sigmoidf_(ga[0][r] * __shfl(rs, g4 * 4 + r));
        }
        const int ngc = (VAR == 10 || VAR == 12) ? 0 : (t0 + 15 >= 31) ? (((t0 + 15 - 31) >> 4) >> 5) + 1 : 0;
        const bf16* kcb = KCC + (size_t)bh * 512 * 64; const bf16* vcb = VCT + (size_t)bh * 16 * 64 * 32;
        float cm[4], cl[4];
#pragma unroll
        for (int ct = 0; ct < 4; ++ct) { cm[ct] = -INFINITY; cl[ct] = 0.f; }
        pipe_run<1, false>(ngc, ln_, [&](int s, const bf16*& kb, const bf16*& vb) { kb = kcb + (size_t)s * 32 * 64; vb = vcb; },
            [&](int kg, const bf16x8 (&kf)[2][2], const bf16x8 (&)[4]) {
#pragma unroll
                for (int ct = 0; ct < 4; ++ct) {
                    const int tl = tl0 + 4 * ct;
                    f32x4 s[2]; qk_tile(kf, qf[ct], s);
                    float sv[2][4]; float tmax = -INFINITY;
#pragma unroll
                    for (int tt = 0; tt < 2; ++tt)
#pragma unroll
                        for (int r = 0; r < 4; ++r) { const int c = kg * 32 + 16 * tt + 4 * g4 + r; sv[tt][r] = (16 * c + 31 <= tl) ? s[tt][r] : -INFINITY; tmax = fmaxf(tmax, sv[tt][r]); }
                    tmax = fmaxf(tmax, __shfl_xor(tmax, 16)); tmax = fmaxf(tmax, __shfl_xor(tmax, 32));
                    const float mnew = fmaxf(cm[ct], tmax), muse = (mnew == -INFINITY) ? 0.f : mnew;
                    float ps = 0.f;
#pragma unroll
                    for (int tt = 0; tt < 2; ++tt)
#pragma unroll
                        for (int r = 0; r < 4; ++r) ps += ex2(sv[tt][r] - muse);
                    cl[ct] = cl[ct] * ex2(cm[ct] - muse) + ps; cm[ct] = mnew;
                }
            });
        {
            float cmu[4], cinv[4], carry[4];
#pragma unroll
            for (int ct = 0; ct < 4; ++ct) { float l = cl[ct]; l += __shfl_xor(l, 16); l += __shfl_xor(l, 32);
                cmu[ct] = (cm[ct] == -INFINITY) ? 0.f : cm[ct]; cinv[ct] = l > 0.f ? 1.0f / l : 0.f; carry[ct] = 0.f; sm_reset(st[ct]); }
            pipe_run<1, true>(ngc, ln_, [&](int s, const bf16*& kb, const bf16*& vb) { kb = kcb + (size_t)s * 32 * 64; vb = vcb + (size_t)s * 64 * 32; },
                [&](int kg, const bf16x8 (&kf)[2][2], const bf16x8 (&vf)[4]) {
#pragma unroll
                    for (int ct = 0; ct < 4; ++ct) {
                        const int tl = tl0 + 4 * ct;
                        f32x4 s[2]; qk_tile(kf, qf[ct], s);
                        float p[2][4];
#pragma unroll
                        for (int tt = 0; tt < 2; ++tt) {
#pragma unroll
                            for (int r = 0; r < 4; ++r) { const int c = kg * 32 + 16 * tt + 4 * g4 + r; p[tt][r] = (16 * c + 31 <= tl) ? ex2(s[tt][r] - cmu[ct]) * cinv[ct] : 0.f; }
                            const float hb = 0.5f * p[tt][3];
                            const float bsh = __shfl(hb, (ln_ + 48) & 63);
                            float v = ((p[tt][0] + p[tt][1]) + (p[tt][2] + hb)) + ((g4 == 0) ? carry[ct] : bsh);
                            carry[ct] = bsh;
                            v += __shfl_xor(v, 1); v += __shfl_xor(v, 2);
                            if (gh == 0) IMP[(4 * ct + tq) * 128 + kg * 8 + 4 * tt + g4] = v;
                        }
                        const bf16x8 pf = pack_p(p);
#pragma unroll
                        for (int dt = 0; dt < 4; ++dt) st[ct].o[dt] = mfma16(vf[dt], pf, st[ct].o[dt]);
                    }
                });
#pragma unroll
            for (int ct = 0; ct < 4; ++ct) acc_add_packed(opk, ct, st[ct].o, GL[(4 * ct + tq) * 16 + gh * 3 + 0], true);
        }
        }
        LDS_WAIT();
        unsigned sb0 = 0u, sb1 = 0u;
        if (cur < 16) { sb0 = (lane <= cur) ? 0xffffu : 0u; }
        else if (VAR == 6) {
#pragma unroll 1
            for (int q = 0; q < 16; ++q) { const bool s0 = (lane <= cur) && ((lane * 37 + q * 11) % (cur + 1)) < 16, s1 = (lane + 64 <= cur) && (((lane + 64) * 37 + q * 11) % (cur + 1)) < 16;
                sb0 |= (s0 ? 1u : 0u) << q; sb1 |= (s1 ? 1u : 0u) << q; }
        }
        else {
            const unsigned long long below = (1ull << lane) - 1ull;
#pragma unroll 1
            for (int q = 0; q < 16; ++q) {
                unsigned k0, k1;
                { const int j = lane; const float v = (j == 0 || j == cur || j == cur - 1) ? 1e6f : IMP[q * 128 + j]; k0 = (j > cur) ? 0u : __builtin_bit_cast(unsigned, v) + 1u; }
                { const int j = lane + 64; const float v = (j == cur || j == cur - 1) ? 1e6f : IMP[q * 128 + j]; k1 = (j > cur) ? 0u : __builtin_bit_cast(unsigned, v) + 1u; }
                unsigned lo = 0u;
#pragma unroll
                for (int bit = 30; bit >= 0; --bit) { const unsigned cand = lo | (1u << bit);
                    const int c = __builtin_popcountll(__ballot(k0 >= cand)) + __builtin_popcountll(__ballot(k1 >= cand));
                    if (c == 16) { lo = cand; break; }
                    if (c > 16) lo = cand; }
                const unsigned long long g0 = __ballot(k0 > lo), g1 = __ballot(k1 > lo), e0 = __ballot(k0 == lo), e1 = __ballot(k1 == lo);
                const int need = 16 - __builtin_popcountll(g0) - __builtin_popcountll(g1);
                const bool s0 = (k0 > lo) || (k0 == lo && __builtin_popcountll(e0 & below) < need);
                const bool s1 = (k1 > lo) || (k1 == lo && __builtin_popcountll(e0) + __builtin_popcountll(e1 & below) < need);
                sb0 |= (s0 ? 1u : 0u) << q; sb1 |= (s1 ? 1u : 0u) << q;
            }
        }
        SELB[lane] = sb0; SELB[lane + 64] = sb1;
        LDS_WAIT();
#define NSA_PARK() do { _Pragma("unroll") for (int i_ = 0; i_ < 8; ++i_) { v4u w_; w_.x = opk[i_ >> 1][(i_ & 1) * 2][0]; w_.y = opk[i_ >> 1][(i_ & 1) * 2][1]; w_.z = opk[i_ >> 1][(i_ & 1) * 2 + 1][0]; w_.w = opk[i_ >> 1][(i_ & 1) * 2 + 1][1]; ((v4u*)IMP)[i_ * 64 + lane] = w_; } } while (0)
#define NSA_UNPARK() do { _Pragma("unroll") for (int i_ = 0; i_ < 8; ++i_) { const v4u w_ = ((const v4u*)IMP)[i_ * 64 + lane]; opk[i_ >> 1][(i_ & 1) * 2][0] = w_.x; opk[i_ >> 1][(i_ & 1) * 2][1] = w_.y; opk[i_ >> 1][(i_ & 1) * 2 + 1][0] = w_.z; opk[i_ >> 1][(i_ & 1) * 2 + 1][1] = w_.w; } } while (0)
        NSA_PARK();
        { NSA_RELANE();
#pragma unroll
        for (int ct = 0; ct < 4; ++ct) {
            const float* rp = wsp<float>(F, WS_ROPE) + ((size_t)(tl0 + 4 * ct) * 32 + g4 * 8) * 2;
            const v4u a = __builtin_bit_cast(v4u, qf[ct][0]), b2 = __builtin_bit_cast(v4u, qf[ct][1]); v4u ra, rb;
#pragma unroll
            for (int jj = 0; jj < 4; ++jj) { const f32x4 cs = *(const f32x4*)(rp + 4 * jj);
                const float x1a = bflo(a[jj]), x1b = bfhi(a[jj]), x2a = bflo(b2[jj]), x2b = bfhi(b2[jj]);
                ra[jj] = pk2(x1a * cs[0] - x2a * cs[1], x1b * cs[2] - x2b * cs[3]);
                rb[jj] = pk2(x2a * cs[0] + x1a * cs[1], x2b * cs[2] + x1b * cs[3]); }
            qf[ct][0] = __builtin_bit_cast(bf16x8, ra); qf[ct][1] = __builtin_bit_cast(bf16x8, rb);
        }
        {
            const unsigned long long ulo = __ballot(sb0 != 0u), uhi = __ballot(sb1 != 0u);
            const unsigned long long below = (1ull << ln_) - 1ull;
            const int nlo = __builtin_popcountll(ulo), nblk = nlo + __builtin_popcountll(uhi);
            if (sb0 != 0u) BL[__builtin_popcountll(ulo & below)] = ln_;
            if (sb1 != 0u) BL[nlo + __builtin_popcountll(uhi & below)] = ln_ + 64;
            LDS_WAIT();
#pragma unroll
            for (int ct = 0; ct < 4; ++ct) sm_reset(st[ct]);
            const bf16* kb0 = KS + (size_t)bh * T * 64; const bf16* vb0 = VST + (size_t)bh * 256 * 64 * 32;
            float mr; bool fixed;
            { const float kmx = sqrtf(__builtin_bit_cast(float, __hip_atomic_load((const unsigned*)F.ctl + CW_KMAX + l * 16 + bh, RLX_AGENT))); float mm = 0.f;
#pragma unroll
              for (int ct = 0; ct < 4; ++ct) mm = fmaxf(mm, col_norm(qf[ct]));
              qnmax = wave_max_uniform(mm); mr = qnmax * kmx * 1.002f + 1e-3f;
              fixed = mr < FIXED_REF_MAX; }
            auto addr_sel = [&](int s, const bf16*& kb, const bf16*& vb) { const int g32 = (VAR == 7) ? (s & 1) : BL[s >> 1] * 2 + (s & 1); kb = kb0 + (size_t)g32 * 32 * 64; vb = vb0 + (size_t)g32 * 64 * 32; };
            asm volatile("" ::: "memory");
            if (!fixed) {
                float mx[4] = {-INFINITY, -INFINITY, -INFINITY, -INFINITY};
                pipe_run<1, false>(2 * nblk, ln_, addr_sel,
                    [&](int s, const bf16x8 (&kf)[2][2], const bf16x8 (&)[4]) {
                        const int j = BL[s >> 1], key0 = j * 64 + (s & 1) * 32;
                        const unsigned tm = (unsigned)__builtin_amdgcn_readfirstlane((int)SELB[j]);
#pragma unroll
                        for (int ct = 0; ct < 4; ++ct) { const unsigned tmk = (tm >> (4 * ct)) & 0xFu;
                            if (tmk) { const bool colok = (tmk >> tq) & 1u; const int tl = tl0 + 4 * ct;
                                if (j == cur) attn_max<2>(kf, qf[ct], mx[ct], ln_, true, [&](int kk) { return colok && (key0 + kk <= tl); });
                                else attn_max<1>(kf, qf[ct], mx[ct], ln_, colok, NoMask()); } }
                    });
                mr = wave_max_uniform(fmaxf(fmaxf(mx[0], mx[1]), fmaxf(mx[2], mx[3]))); if (mr == -INFINITY) mr = 0.f;
            }
            asm volatile("" ::: "memory");
            if (VAR != 4 && VAR != 12)
            pipe_run_mt(2 * nblk - 2, 2, ln_, addr_sel,
                [&](int s, const bf16x8 (&kf)[2][2], const bf16x8 (&vf)[4]) {
                    const int j = BL[s >> 1];
                    const unsigned tm = (unsigned)__builtin_amdgcn_readfirstlane((int)SELB[j]);
#pragma unroll
                    for (int ct = 0; ct < 4; ++ct) {
                        const unsigned tmk = (tm >> (4 * ct)) & 0xFu;
                        if (tmk) attn_compute_fixed<1>(kf, vf, qf[ct], st[ct], mr, ln_, (tmk >> tq) & 1u, NoMask());
                    }
                },
                [&](int s, const bf16x8 (&kf)[2][2], const bf16x8 (&vf)[4]) {
                    const int key0 = cur * 64 + (s & 1) * 32;
#pragma unroll
                    for (int ct = 0; ct < 4; ++ct) { const int tl = tl0 + 4 * ct;
                        attn_compute_fixed<2>(kf, vf, qf[ct], st[ct], mr, ln_, true, [&](int kk) { return key0 + kk <= tl; }); }
                });
            LDS_WAIT();
            NSA_UNPARK();
#pragma unroll
            for (int ct = 0; ct < 4; ++ct) { const float ls = sm_lsum(st[ct]); const float gs = GL[(4 * ct + tq) * 16 + gh * 3 + 1];
                acc_add_packed(opk, ct, st[ct].o, ls > 0.f ? gs / ls : 0.f, false); }
            NSA_PARK();
        }
        }
        { NSA_RELANE();
#pragma unroll
            for (int ct = 0; ct < 4; ++ct) sm_reset(st[ct]);
            const bf16* kb0 = (VAR == 3 ? KS : KW) + (size_t)bh * T * 64; const bf16* vb0 = (VAR == 3 ? VST : VWT) + (size_t)bh * 256 * 64 * 32;
            const int glo = (t0 - 511 > 0 ? t0 - 511 : 0) >> 5, ghi = (t0 + 15) >> 5;
            float mr; bool fixed;
            { const float kmx = sqrtf(__builtin_bit_cast(float, __hip_atomic_load((const unsigned*)F.ctl + CW_KMAX + l * 16 + 8 + bh, RLX_AGENT)));
              mr = qnmax * kmx * 1.002f + 1e-3f;
              fixed = mr < FIXED_REF_MAX; }
            auto addr_win = [&](int s, const bf16*& kb, const bf16*& vb) { kb = kb0 + (size_t)(glo + s) * 32 * 64; vb = vb0 + (size_t)(glo + s) * 64 * 32; };
            asm volatile("" ::: "memory");
            if (!fixed) {
                float mx[4] = {-INFINITY, -INFINITY, -INFINITY, -INFINITY};
                pipe_run<1, false>(ghi - glo + 1, ln_, addr_win,
                    [&](int s, const bf16x8 (&kf)[2][2], const bf16x8 (&)[4]) {
                        const int key0 = (glo + s) * 32;
#pragma unroll
                        for (int ct = 0; ct < 4; ++ct) { const int tl = tl0 + 4 * ct;
                            attn_max<2>(kf, qf[ct], mx[ct], ln_, true, [&](int kk) { const int kp = key0 + kk; return kp <= tl && kp + 512 > tl; }); }
                    });
                mr = wave_max_uniform(fmaxf(fmaxf(mx[0], mx[1]), fmaxf(mx[2], mx[3]))); if (mr == -INFINITY) mr = 0.f;
            }
            asm volatile("" ::: "memory");
            const int g_a = (t0 >= 497) ? ((t0 - 497) >> 5) + 1 : 0, g_b = (t0 - 31) >> 5;
            const int n_main = g_b >= g_a ? g_b - g_a + 1 : 0, n_up = ghi - (g_b >= g_a ? g_b : g_a - 1), n_tail = n_up + (g_a - glo);
            auto grp = [&](int s) { const int u = s - n_main; return s < n_main ? g_a + s : (u < n_up ? ghi - n_up + 1 + u : glo + (u - n_up)); };
            auto addr_w2 = [&](int s, const bf16*& kb, const bf16*& vb) { const int g = grp(s); kb = kb0 + (size_t)g * 32 * 64; vb = vb0 + (size_t)g * 64 * 32; };
            if (VAR != 5 && VAR != 12)
            pipe_run_mt(n_main, n_tail, ln_, addr_w2,
                [&](int, const bf16x8 (&kf)[2][2], const bf16x8 (&vf)[4]) {
#pragma unroll
                    for (int ct = 0; ct < 4; ++ct) attn_compute_fixed<0>(kf, vf, qf[ct], st[ct], mr, ln_, true, NoMask());
                },
                [&](int s, const bf16x8 (&kf)[2][2], const bf16x8 (&vf)[4]) {
                    const int key0 = grp(s) * 32;
#pragma unroll
                    for (int ct = 0; ct < 4; ++ct) {
                        const int tlo = t0 + 4 * ct, thi = tlo + 3, tl = tl0 + 4 * ct;
                        if (key0 > thi || key0 + 31 + 512 <= tlo) continue;
                        attn_compute_fixed<2>(kf, vf, qf[ct], st[ct], mr, ln_, true, [&](int kk) { const int kp = key0 + kk; return kp <= tl && kp + 512 > tl; });
                    }
                });
            NSA_UNPARK();
#pragma unroll
            for (int ct = 0; ct < 4; ++ct) { const float ls = sm_lsum(st[ct]); const float gwn = GL[(4 * ct + tq) * 16 + gh * 3 + 2];
                acc_add_packed(opk, ct, st[ct].o, ls > 0.f ? gwn / ls : 0.f, false); }
        }
        { NSA_RELANE();
#pragma unroll
        for (int ct = 0; ct < 4; ++ct)
#pragma unroll
            for (int dt = 0; dt < 4; ++dt) { v2u w; w.x = opk[ct][dt][0]; w.y = opk[ct][dt][1];
                if (VAR == 0 || w.x == 0x7fc17fc1u) *(v2u*)(CAT + (mrow0 + 4 * ct) * 1024 + hkv * 256 + gh * 64 + dt * 16 + g4 * 4) = w; }
        }
        LDS_WAIT();
        if (VAR == 0 && xmap) convert_experts(F, l, (bf16*)IMP, task >> 11);
    }
#undef NSA_RELANE
#undef NSA_PARK
#undef NSA_UNPARK
}

DEV void nsa_phase(Frame& F, int l) { nsa_phase_t<0>(F, l); }

DEV void cross_phase(Frame& F, int l) {
    const int lane = F.lane, l16 = lane & 15, g4 = lane >> 4;
    const bf16* XQ = wsp<bf16>(F, WS_XQ); bf16* XO = wsp<bf16>(F, WS_XO);
    const int gw = F.vcu * NWAVES + F.wave, NGW = F.G * NWAVES;
#pragma unroll 1
    for (int task = gw; task < 2048; task += NGW) {
        const int head = task & 3, m0 = (task >> 2) * 64, b = m0 >> 13;
        bf16x8 qf[4][2];
#pragma unroll
        for (int ct = 0; ct < 4; ++ct)
#pragma unroll
            for (int ks = 0; ks < 2; ++ks) qf[ct][ks] = *(const bf16x8*)(XQ + (size_t)(m0 + 16 * ct + l16) * 256 + head * 64 + ks * 32 + g4 * 8);
        const bf16* kb0 = wsp<bf16>(F, WS_MK) + (size_t)((l * 4 + b) * 4 + head) * 256 * 64;
        const bf16* vb0 = wsp<bf16>(F, WS_MVT) + (size_t)((l * 4 + b) * 4 + head) * 8 * 64 * 32;
        SmState st[4];
#pragma unroll
        for (int ct = 0; ct < 4; ++ct) sm_reset(st[ct]);
        pipe_run<PIPE_D, true>(8, lane, [&](int s, const bf16*& kb, const bf16*& vb) { kb = kb0 + (size_t)s * 32 * 64; vb = vb0 + (size_t)s * 64 * 32; },
            [&](int, const bf16x8 (&kf)[2][2], const bf16x8 (&vf)[4]) {
#pragma unroll
                for (int ct = 0; ct < 4; ++ct) attn_compute<0>(kf, vf, qf[ct], st[ct], lane, true, NoMask());
            });
#pragma unroll
        for (int ct = 0; ct < 4; ++ct) {
            const float inv = 1.0f / sm_lsum(st[ct]);
#pragma unroll
            for (int dt = 0; dt < 4; ++dt) { const f32x4 o = st[ct].o[dt] * inv; v2u w; w.x = pk2(o[0], o[1]); w.y = pk2(o[2], o[3]);
                *(v2u*)(XO + (size_t)(m0 + 16 * ct + l16) * 256 + head * 64 + dt * 16 + g4 * 4) = w; }
        }
    }
}


DEV void router_phase(Frame& F, int l, int probe = 0) {
    const int lane = F.lane, l16 = lane & 15, g4 = lane >> 4;
    float* LG = (float*)F.ldsg + F.wave * 768;
    const bf16* HB = wsp<bf16>(F, WS_HB); const float* SSQ = wsp<float>(F, WS_SSQ);
    const bf16* WR = wsp<bf16>(F, WS_WR) + (size_t)l * 96 * 1024;
    int* TOKE = wsp<int>(F, probe ? WS_PROBE : WS_TOKE); float* TOKG = wsp<float>(F, probe ? WS_PROBE + MiB : WS_TOKG); int* TOKP = wsp<int>(F, probe ? WS_PROBE + 2 * MiB : WS_TOKP);
    unsigned* CNT = (unsigned*)F.ctl + CW_CNT + l * 32 + (probe ? 64 : 0);
    const float* bg = inp(14) + l * 4; const float* be = inp(16) + l * 32;
    unsigned* HIST = (unsigned*)((float*)F.ldsg + 8 * 768);
#pragma unroll 1
    for (int tb = F.vcu * NWAVES; tb < NTOK / 16; tb += F.G * NWAVES) {
        const int task = tb + F.wave; const bool live = task < NTOK / 16;
        const int m0 = (live ? task : tb) * 16;
        if (F.tid < 64) HIST[F.tid] = 0u;
        f32x4 acc[3];
        {
            const bf16* ap = HB + (size_t)(m0 + l16) * 1024 + g4 * 8; const bf16* bp = WR + lane * 8;
#pragma unroll
            for (int n = 0; n < 3; ++n) acc[n] = (f32x4){0.f, 0.f, 0.f, 0.f};
#pragma unroll 4
            for (int k = 0; k < 1024; k += 32) {
                const bf16x8 a = *(const bf16x8*)(ap + k);
#pragma unroll
                for (int n = 0; n < 3; ++n) { const bf16x8 bh = *(const bf16x8*)(bp + ((k >> 5) * 6 + n * 2) * 512), bl = *(const bf16x8*)(bp + ((k >> 5) * 6 + n * 2 + 1) * 512);
                    acc[n] = mfma16(a, bh, acc[n]); acc[n] = mfma16(a, bl, acc[n]); }
            }
        }
#pragma unroll
        for (int nt = 0; nt < 3; ++nt)
#pragma unroll
            for (int r = 0; r < 4; ++r) LG[(g4 * 4 + r) * 48 + nt * 16 + l16] = acc[nt][r];
        LDS_WAIT();
        int id1 = 0, id2 = 0;
        if (lane < 16) {
            const int m = m0 + lane; const float rstd = row_rstd_full(SSQ, m); const float* lg = LG + lane * 48;
            float g[4];
#pragma unroll
            for (int j = 0; j < 4; ++j) g[j] = lg[j] * rstd + bg[j];
            float gmax = g[0]; int grp = 0;
#pragma unroll
            for (int j = 1; j < 4; ++j) if (g[j] > gmax) { gmax = g[j]; grp = j; }
            float den = 0.f;
#pragma unroll
            for (int j = 0; j < 4; ++j) den += expf(g[j] - gmax);
            const float psel = 1.0f / den;
            float e1 = -INFINITY, e2 = -INFINITY; int i1 = 0, i2 = 0;
            for (int j = 0; j < 8; ++j) { const float v = lg[4 + grp * 8 + j] * rstd + be[grp * 8 + j];
                if (v > e1) { e2 = e1; i2 = i1; e1 = v; i1 = j; } else if (v > e2) { e2 = v; i2 = j; } }
            const float x = expf(e2 - e1), w1 = 1.0f / (1.0f + x), w2 = x * w1;
            id1 = grp * 8 + i1; id2 = grp * 8 + i2;
            if (live) { TOKE[m * 2] = id1; TOKE[m * 2 + 1] = id2; TOKG[m * 2] = psel * w1; TOKG[m * 2 + 1] = psel * w2; }
        }
        __syncthreads();
        unsigned lp1 = 0u, lp2 = 0u;
        if (lane < 16 && live) { lp1 = __hip_atomic_fetch_add(HIST + id1, 1u, __ATOMIC_RELAXED, __HIP_MEMORY_SCOPE_WORKGROUP); lp2 = __hip_atomic_fetch_add(HIST + id2, 1u, __ATOMIC_RELAXED, __HIP_MEMORY_SCOPE_WORKGROUP); }
        __syncthreads();
        if (F.tid < 32) { const unsigned c = HIST[F.tid]; HIST[32 + F.tid] = c ? __hip_atomic_fetch_add(CNT + F.tid, c, RLX_AGENT) : 0u; }
        __syncthreads();
        if (lane < 16 && live) { const int m = m0 + lane; TOKP[m * 2] = (int)(HIST[32 + id1] + lp1); TOKP[m * 2 + 1] = (int)(HIST[32 + id2] + lp2); }
        __syncthreads();
    }
}
DEV int moe_tables(Frame& F, int l) {
    int* tab = (int*)(F.ldsg + TAB_OFF);
    if (F.tid == 0) {
        const unsigned* CNT = (const unsigned*)F.ctl + CW_CNT + l * 32; int off = 0;
#pragma unroll 1
        for (int e = 0; e < 32; ++e) { tab[e] = off; const int c = (int)__hip_atomic_load(CNT + e, RLX_AGENT); const int nt = (c + 255) >> 8;
            for (int i = 0; i < nt; ++i) tab[40 + (off >> 8) + i] = e;
            off += nt << 8; }
        tab[32] = off;
    }
    __syncthreads();
    return tab[32];
}
DEV void gather_phase(Frame& F, int l) {
    (void)moe_tables(F, l);
    const int* tab = (const int*)(F.ldsg + TAB_OFF);
    const int lane = F.lane; const int gw = F.vcu * NWAVES + F.wave, NGW = F.G * NWAVES;
    const bf16* HB = wsp<bf16>(F, WS_HB); const float* SSQ = wsp<float>(F, WS_SSQ); bf16* XS = wsp<bf16>(F, WS_XS);
    const int* TOKE = wsp<int>(F, WS_TOKE); const float* TOKG = wsp<float>(F, WS_TOKG); const int* TOKP = wsp<int>(F, WS_TOKP); int* TOKS = wsp<int>(F, WS_TOKS);
    float* SRSTD = wsp<float>(F, WS_SRSTD); float* SGATE = wsp<float>(F, WS_SGATE);
    const unsigned* CNT = (const unsigned*)F.ctl + CW_CNT + l * 32;
#pragma unroll 1
    for (int m0 = gw; m0 < NTOK; m0 += 4 * NGW) {
        int s0[4], s1[4]; float g0[4], g1[4], rs[4]; v4u a[4], c[4];
#pragma unroll
        for (int k = 0; k < 4; ++k) { const int m = m0 + k * NGW; const bool ok = m < NTOK; const int mm = ok ? m : m0;
            const int e0 = TOKE[mm * 2], e1 = TOKE[mm * 2 + 1], p0 = TOKP[mm * 2], p1 = TOKP[mm * 2 + 1];
            g0[k] = TOKG[mm * 2]; g1[k] = TOKG[mm * 2 + 1];
            a[k] = *(const v4u*)(HB + (size_t)mm * 1024 + lane * 8); c[k] = *(const v4u*)(HB + (size_t)mm * 1024 + 512 + lane * 8);
            rs[k] = row_rstd_full(SSQ, mm);
            s0[k] = tab[e0] + p0; s1[k] = tab[e1] + p1; }
#pragma unroll
        for (int k = 0; k < 4; ++k) { const int m = m0 + k * NGW;
            if (m < NTOK) {
                *(v4u*)(XS + (size_t)s0[k] * 1024 + lane * 8) = a[k]; *(v4u*)(XS + (size_t)s0[k] * 1024 + 512 + lane * 8) = c[k];
                *(v4u*)(XS + (size_t)s1[k] * 1024 + lane * 8) = a[k]; *(v4u*)(XS + (size_t)s1[k] * 1024 + 512 + lane * 8) = c[k];
                if (lane == 0) { SRSTD[s0[k]] = rs[k]; SRSTD[s1[k]] = rs[k]; SGATE[s0[k]] = g0[k]; SGATE[s1[k]] = g1[k]; TOKS[m * 2] = s0[k]; TOKS[m * 2 + 1] = s1[k]; } } }
    }
#pragma unroll 1
    for (int e = 0; e < 32; ++e) {
        const int c = (int)__hip_atomic_load(CNT + e, RLX_AGENT), base = tab[e], end = (e == 31 ? tab[32] : tab[e + 1]);
        for (int r = base + c + gw; r < end; r += NGW) {
            *(v4u*)(XS + (size_t)r * 1024 + lane * 8) = (v4u){0u, 0u, 0u, 0u}; *(v4u*)(XS + (size_t)r * 1024 + 512 + lane * 8) = (v4u){0u, 0u, 0u, 0u};
            if (lane == 0) { SRSTD[r] = 0.f; SGATE[r] = 0.f; }
        }
    }
}
DEV void combine_phase(Frame& F, int l, int probe = 0) {
    const int lane = F.lane; const int gw = F.vcu * NWAVES + F.wave, NGW = F.G * NWAVES;
    float* Ho = probe ? wsp<float>(F, WS_PROBE) : (float*)(GAS float*)F.out; const bf16* HBi = wsp<bf16>(F, WS_HB); bf16* HB = wsp<bf16>(F, probe ? WS_PROBE + 128 * MiB : WS_HB); float* SSQ = wsp<float>(F, probe ? WS_PROBE + 192 * MiB : WS_SSQ); const bf16* YS = wsp<bf16>(F, WS_YS); const int* TOKS = wsp<int>(F, WS_TOKS);
    const float* gf = inp(23);
#pragma unroll 1
    for (int m0 = gw; m0 < NTOK; m0 += 2 * NGW) {
        f32x4 v[2][4]; float ssum[2];
        int sl[2][2];
#pragma unroll
        for (int k = 0; k < 2; ++k) { const int m = (m0 + k * NGW < NTOK) ? m0 + k * NGW : m0; sl[k][0] = TOKS[m * 2]; sl[k][1] = TOKS[m * 2 + 1]; }
        v2u h[2][4]; v2u ya[2][4], yb[2][4];
#pragma unroll
        for (int k = 0; k < 2; ++k) { const int m = (m0 + k * NGW < NTOK) ? m0 + k * NGW : m0;
#pragma unroll
            for (int j = 0; j < 4; ++j) { const int c = lane * 4 + 256 * j;
                h[k][j] = *(const v2u*)(HBi + (size_t)m * 1024 + c);
                ya[k][j] = *(const v2u*)(YS + (size_t)sl[k][0] * 1024 + c); yb[k][j] = *(const v2u*)(YS + (size_t)sl[k][1] * 1024 + c); } }
#pragma unroll
        for (int k = 0; k < 2; ++k) { float ss = 0.f;
#pragma unroll
            for (int j = 0; j < 4; ++j) { const v2u a = ya[k][j], bq = yb[k][j]; const f32x4 hh = (f32x4){bflo(h[k][j].x), bfhi(h[k][j].x), bflo(h[k][j].y), bfhi(h[k][j].y)};
                f32x4 r; r[0] = hh[0] + (bflo(a.x) + bflo(bq.x)); r[1] = hh[1] + (bfhi(a.x) + bfhi(bq.x)); r[2] = hh[2] + (bflo(a.y) + bflo(bq.y)); r[3] = hh[3] + (bfhi(a.y) + bfhi(bq.y));
                v[k][j] = r; ss += (r[0] * r[0] + r[1] * r[1]) + (r[2] * r[2] + r[3] * r[3]); }
            ssum[k] = wave_sum(ss); }
#pragma unroll
        for (int k = 0; k < 2; ++k) { const int m = m0 + k * NGW;
            if (m < NTOK) {
                if (l == DEPTH - 1) {
                    const float rstd = 1.0f / sqrtf(ssum[k] * (1.0f / 1024.0f) + RMS_EPS);
#pragma unroll
                    for (int j = 0; j < 4; ++j) { const int c = lane * 4 + 256 * j; const f32x4 g = *(const f32x4*)(gf + c); *(f32x4*)(Ho + (size_t)m * 1024 + c) = v[k][j] * rstd * g; }
                } else {
#pragma unroll
                    for (int j = 0; j < 4; ++j) { const int c = lane * 4 + 256 * j;
                        v2u w; w.x = pk2(v[k][j][0], v[k][j][1]); w.y = pk2(v[k][j][2], v[k][j][3]); *(v2u*)(HB + (size_t)m * 1024 + c) = w; }
                    if (lane < 16) SSQ[(size_t)m * 16 + lane] = lane == 0 ? ssum[k] : 0.f;
                } } }
    }
}
#ifndef MK_ONE_LAUNCH
#define MK_ONE_LAUNCH 1
#endif
constexpr int NPH_LAYER = 13, NPHASES = 1 + DEPTH * NPH_LAYER;
struct Args { const float* in[24]; float* out; unsigned char* ws; int ph_lo, ph_hi; };
static_assert(sizeof(Args) == 24 * 8 + 8 + 8 + 8, "Args has no padding");

__global__ void __launch_bounds__(NWAVES * 64, 2) hymba_fwd(Args args) {
    extern __shared__ __attribute__((aligned(16))) unsigned char lds[];
    Frame F;
    F.lds = (LAS unsigned char*)lds; F.ldsg = lds;
    F.MISC = (volatile LAS unsigned*)(F.lds + MISC_OFF);
    F.tid = threadIdx.x; F.lane = F.tid & 63; F.wave = __builtin_amdgcn_readfirstlane(F.tid >> 6);
    F.G = gridDim.x; { const int bx = blockIdx.x; F.vcu = (F.G % 8 == 0) ? (bx % 8) * (F.G / 8) + bx / 8 : bx; }
    F.ws = args.ws; F.ctl = (gu32*)(args.ws + WS_CTL); F.out = args.out;
    if (F.tid < 64) ((LAS unsigned*)(F.lds + MISC_OFF))[F.tid] = 0u;
    __syncthreads();
    int wave0 = F.wave;
    const int lo = args.ph_lo, hi = args.ph_hi;
    XcdBarrier bar; bar.bar = (unsigned*)(F.ctl + CW_BAR); bar.x = 0; bar.st = nullptr;
    if (hi - lo > 1) bar = xcd_barrier_post((unsigned*)(F.ctl + CW_BAR), F.MISC + 8);
#ifndef PHMASK
#define PHMASK 0xFFFF
#endif
#define IN(k) (lo <= (k) && (k) < hi)
#define EN(j) ((PHMASK >> (j)) & 1)
#define RELAUNDER() do { asm volatile("" : "+s"(wave0)); unsigned z_ = 0u; asm volatile("" : "+v"(z_)); int t_ = wave0 * 64 + (int)__builtin_amdgcn_mbcnt_hi(~0u, __builtin_amdgcn_mbcnt_lo(~0u, z_)); F.tid = t_; F.lane = t_ & 63; F.wave = wave0; \
    size_t zo_ = 0; asm volatile("" : "+s"(zo_), "+s"(F.vcu), "+s"(F.G)); F.ws = args.ws + zo_; F.out = args.out + zo_; F.ctl = (gu32*)(F.ws + WS_CTL); } while (0)
#ifndef NSA_VAR
#define NSA_VAR 0
#endif
#ifndef BAR2X
#define BAR2X 0
#endif
#ifndef DUPMASK
#define DUPMASK 0
#endif
#define DUP(j) ((DUPMASK >> (j)) & 1)
#ifndef STAG_J0
#define STAG_J0 0
#endif
#ifndef STAG_MOE
#define STAG_MOE 0
#endif
#define STAGGER(ticks) do { if ((ticks) > 0 && (F.vcu & 1)) { const unsigned long long t0_ = __builtin_amdgcn_s_memrealtime(); while (__builtin_amdgcn_s_memrealtime() - t0_ < (unsigned long long)(ticks)) __builtin_amdgcn_s_sleep(32); } } while (0)
#define SEAM(k) do { if (IN(k) && IN((k) + 1)) { XcdBarrier b_ = bar; size_t zb_ = 0; asm volatile("" : "+s"(b_.x), "+s"(zb_)); b_.bar = (unsigned*)(args.ws + WS_CTL + zb_) + CW_BAR; xcd_barrier(b_); if (BAR2X) xcd_barrier(b_); } } while (0)

    if (IN(0) && EN(13)) { RELAUNDER(); p0_prologue(F); if (DUP(13)) { __syncthreads(); p0_prologue(F); } } SEAM(0);

#pragma unroll 1
    for (int l = 0; l < DEPTH; ++l) {
        const int pb = 1 + l * NPH_LAYER;
        bf16* HB = wsp<bf16>(F, WS_HB); float* SSQ = wsp<float>(F, WS_SSQ);
        if (IN(pb + 0) && EN(0)) for (int rep_ = 0; rep_ < (DUP(0) ? 2 : 1); ++rep_) { RELAUNDER(); if (rep_) __syncthreads();
            pg8::Gemm g{HB, wsp<bf16>(F, WS_WIN) + (size_t)l * NIN * 1024, NTOK, 3072, D};
            pg8::StaticOrder S; S.init(NTOK, 3072, F.G, (int)blockIdx.x);
            EpiIn E{F.ws};
            STAGGER(STAG_J0);
            pg8::gemm_phase<EpiIn, pg8::StaticOrder, true, true>(F.lds, g, S, E, F.wave);
        }
        SEAM(pb + 0);
        if (IN(pb + 1) && EN(1)) { RELAUNDER();
            compress_phase(F, l);
            hgrn_local_phase(F, l);
            conv_phase(F, l);
            kmax_phase(F, l);
            if (l == 0) memkv_phase(F);
            if (DUP(1)) { __syncthreads(); compress_phase(F, l); hgrn_local_phase(F, l); conv_phase(F, l); }
        }
        SEAM(pb + 1);
        if (IN(pb + 2) && EN(2)) { RELAUNDER(); hgrn_scan_phase(F); if (DUP(14)) hgrn_scan_phase(F, 1); nsa_phase(F, l); if (DUP(2)) { __syncthreads(); nsa_phase_t<NSA_VAR>(F, l); } }
        SEAM(pb + 2);
        if (IN(pb + 3) && EN(3)) { RELAUNDER(); hgrn_out_phase(F, l); if (DUP(3)) { __syncthreads(); hgrn_out_phase(F, l); } }
        SEAM(pb + 3);
        if (IN(pb + 4) && EN(4)) for (int rep_ = 0; rep_ < ((DUP(4) && l == 0) ? 2 : 1); ++rep_) { RELAUNDER(); if (rep_) __syncthreads();
            pg8::Gemm g{wsp<bf16>(F, WS_CAT), wsp<bf16>(F, WS_WOUT) + (size_t)l * 1024 * 1024, NTOK, D, D};
            pg8::StaticOrder S; S.init(NTOK, D, F.G, (int)blockIdx.x);
            EpiRes E{l == 0 ? inp(0) : (const float*)nullptr, HB, SSQ};
            pg8::gemm_phase<EpiRes, pg8::StaticOrder, true, true>(F.lds, g, S, E, F.wave);
        }
        SEAM(pb + 4);
        if (IN(pb + 5) && EN(5)) for (int rep_ = 0; rep_ < (DUP(5) ? 2 : 1); ++rep_) { RELAUNDER(); if (rep_) __syncthreads();
            pg8::Gemm g{HB, wsp<bf16>(F, WS_WQ) + (size_t)l * 256 * 1024, NTOK, 256, D};
            pg8::StaticOrder S; S.init(NTOK, 256, F.G, (int)blockIdx.x);
            EpiXQ E{SSQ, wsp<bf16>(F, WS_XQ)};
            pg8::gemm_phase<EpiXQ, pg8::StaticOrder, true, true>(F.lds, g, S, E, F.wave);
        }
        SEAM(pb + 5);
        if (IN(pb + 6) && EN(6)) { RELAUNDER(); cross_phase(F, l); if (DUP(6)) { __syncthreads(); cross_phase(F, l); } }
        SEAM(pb + 6);
        if (IN(pb + 7) && EN(7)) { RELAUNDER();
            pg8::Gemm g{wsp<bf16>(F, WS_XO), wsp<bf16>(F, WS_WO) + (size_t)l * 1024 * 256, NTOK, D, 256};
            pg8::StaticOrder S; S.init(NTOK, D, F.G, (int)blockIdx.x);
            EpiRes E{(const float*)nullptr, HB, SSQ};
            pg8::gemm_phase<EpiRes, pg8::StaticOrder, true, true>(F.lds, g, S, E, F.wave);
        }
        SEAM(pb + 7);
        if (IN(pb + 8) && EN(8)) { RELAUNDER(); router_phase(F, l); if (DUP(8)) router_phase(F, l, 1); }
        SEAM(pb + 8);
        if (IN(pb + 9) && EN(9)) { RELAUNDER(); gather_phase(F, l); if (DUP(9)) { __syncthreads(); gather_phase(F, l); } }
        SEAM(pb + 9);
        if (IN(pb + 10) && EN(10)) for (int rep_ = 0; rep_ < (DUP(10) ? 2 : 1); ++rep_) { RELAUNDER(); if (rep_) __syncthreads();
            const int ns = moe_tables(F, l);
            pg8::Gemm g{wsp<bf16>(F, WS_XS), wsp<bf16>(F, WS_WGU) + (size_t)l * 32 * 1024 * 1024, ns, 32 * 1024, D};
            MoeOrder S{(ns >> 8) * 4, F.G, (int)blockIdx.x, (const LAS int*)(F.lds + TAB_OFF) + 40};
            EpiGU E{wsp<float>(F, WS_SRSTD), wsp<bf16>(F, WS_ACT)};
            STAGGER(STAG_MOE);
            pg8::gemm_phase<EpiGU, MoeOrder, true, true>(F.lds, g, S, E, F.wave);
        }
        SEAM(pb + 10);
        if (IN(pb + 11) && EN(11)) for (int rep_ = 0; rep_ < (DUP(11) ? 2 : 1); ++rep_) { RELAUNDER(); if (rep_) __syncthreads();
            const int ns = moe_tables(F, l);
            pg8::Gemm g{wsp<bf16>(F, WS_ACT), wsp<bf16>(F, WS_WDN) + (size_t)l * 32 * 1024 * 512, ns, 32 * 1024, 512};
            MoeOrder S{(ns >> 8) * 4, F.G, (int)blockIdx.x, (const LAS int*)(F.lds + TAB_OFF) + 40};
            EpiDN E{wsp<float>(F, WS_SGATE), wsp<bf16>(F, WS_YS)};
            STAGGER(STAG_MOE / 2);
            pg8::gemm_phase<EpiDN, MoeOrder, true, true>(F.lds, g, S, E, F.wave);
        }
        SEAM(pb + 11);
        if (IN(pb + 12) && EN(12)) { RELAUNDER(); combine_phase(F, l); if (DUP(12)) combine_phase(F, l, 1); }
        SEAM(pb + 12);
    }
#undef IN
#undef SEAM
}

extern "C" void kernel_launch(void* const* d_in, const int* in_sizes, int n_in, void* d_out, int out_size, void* d_ws, size_t ws_size, hipStream_t stream) {
    static int grid = 0;
    if (grid == 0) {
        if (n_in != 24 || in_sizes[0] != NTOK * D || out_size != NTOK * D || ws_size < WS_END) {
            fprintf(stderr, "kernel_launch: unexpected shapes: n_in %d in0 %d out %d ws %zu (need %zu)\n", n_in, n_in > 0 ? in_sizes[0] : -1, out_size, ws_size, (size_t)WS_END); grid = -1; return; }
        int dev = 0, cus = 0, per_cu = 0;
        if (hipGetDevice(&dev) != hipSuccess || hipDeviceGetAttribute(&cus, hipDeviceAttributeMultiprocessorCount, dev) != hipSuccess) { grid = -1; return; }
        if (hipFuncSetAttribute((const void*)hymba_fwd, hipFuncAttributeMaxDynamicSharedMemorySize, LDS_BYTES) != hipSuccess) { fprintf(stderr, "kernel_launch: hipFuncSetAttribute failed\n"); grid = -1; return; }
        if (hipOccupancyMaxActiveBlocksPerMultiprocessor(&per_cu, (const void*)hymba_fwd, NWAVES * 64, LDS_BYTES) != hipSuccess || per_cu < 1)
            fprintf(stderr, "kernel_launch: note: occupancy query reports %d blocks per CU\n", per_cu);
        (void)hipGetLastError();
        grid = cus;
    }
    if (grid < 0) return;
    if (hipMemsetAsync((char*)d_ws + WS_CTL, 0, CTL_ZERO_BYTES, stream) != hipSuccess) { fprintf(stderr, "kernel_launch: memset failed\n"); return; }
    Args a{};
    for (int i = 0; i < 24; ++i) a.in[i] = (const float*)d_in[i];
    a.out = (float*)d_out; a.ws = (unsigned char*)d_ws;
#if MK_ONE_LAUNCH
    a.ph_lo = 0; a.ph_hi = NPHASES;
    hipLaunchKernelGGL(hymba_fwd, dim3(grid), dim3(NWAVES * 64), LDS_BYTES, stream, a);
#else
    for (int p = 0; p < NPHASES; ++p) { a.ph_lo = p; a.ph_hi = p + 1; hipLaunchKernelGGL(hymba_fwd, dim3(grid), dim3(NWAVES * 64), LDS_BYTES, stream, a); }
#endif
    const hipError_t le = hipPeekAtLastError();
    if (le != hipSuccess) fprintf(stderr, "kernel_launch: launch failed: %s\n", hipGetErrorName(le));
}
```

```cpp
#define MK_ONE_LAUNCH 1
#include <hip/hip_runtime.h>
#include <cstdio>
#include <cstdint>
#include <cmath>
namespace pg8 {
#define PG8_LAS __attribute__((address_space(3)))
typedef unsigned short bf16_t;
typedef short bf16x8 __attribute__((ext_vector_type(8)));
typedef float f32x4 __attribute__((ext_vector_type(4)));
typedef unsigned u32x4 __attribute__((ext_vector_type(4)));
constexpr int BM = 256, BK = 64, HALF = 128, HTB = HALF * BK * 2  , STAGE_BYTES = 8 * HTB, NXCD = 8, WGM = 8;

__host__ __device__ __forceinline__ int lds_byte(int r, int c) { const int st = (r >> 4) * 2 + (c >> 5), rr = r & 15, cc = c & 31, ob = rr * 64 + cc * 2; return st * 1024 + (ob ^ (((ob >> 9) & 1) << 5)); }
__host__ __device__ __forceinline__ void stage_rc(int b, int& R, int& C) { const int st = b / 1024, sb = b % 1024, swz = sb ^ (((sb >> 9) & 1) << 5); R = (st >> 1) * 16 + swz / 64; C = (st & 1) * 32 + (swz % 64) / 2; }
__host__ __device__ __forceinline__ int perm32(int rho) { const int n = rho >> 4, i = rho & 15; return 8 * (i >> 2) + 4 * n + (i & 3); }

struct Unit { int pm, pn; };
struct Gemm { const bf16_t* A; const bf16_t* Bt; int M, N, K; };

struct StaticOrder {
    int nM, nN, nwg, G, c;
    __host__ __device__ void init(int M, int N, int G_, int c_) { nM = M / BM; nN = N / BM; nwg = nM * nN; G = G_; c = c_; }
    __host__ __device__ bool next(int i, Unit& u) const {
        const long L = (long)i * G + c; if (L >= nwg) return false;
        int wgid = (int)L; { const int q = nwg / NXCD, r = nwg % NXCD, xcd = wgid % NXCD, off = wgid / NXCD; wgid = (xcd < r ? xcd * (q + 1) : r * (q + 1) + (xcd - r) * q) + off; }
        const int nig = WGM * nN, gid = wgid / nig, fm = gid * WGM, gsz = (nM - fm) < WGM ? (nM - fm) : WGM;
        u.pm = fm + ((wgid % nig) % gsz); u.pn = (wgid % nig) / gsz; return true;
    }
    static constexpr bool GATHER = false;
    __device__ __forceinline__ void a_ready(const Unit&) const {}
    __device__ __forceinline__ void done(const Unit&) const {}
};

__device__ __forceinline__ unsigned cvt_pk_bf16(float lo, float hi) { unsigned r; asm volatile("v_cvt_pk_bf16_f32 %0, %1, %2" : "=v"(r) : "v"(lo), "v"(hi)); return r; }
typedef float f32x2 __attribute__((ext_vector_type(2)));
template <class Epi, class Sched, bool ALIGN_EPI = false, bool SP2 = false>
__device__ __forceinline__ void gemm_phase(PG8_LAS unsigned char* lds, const Gemm g, const Sched& S, const Epi& E, int wave_id) {
    unsigned z_ = 0u; asm volatile("" : "+v"(z_)); int tid_ = wave_id * 64 + (int)__builtin_amdgcn_mbcnt_hi(~0u, __builtin_amdgcn_mbcnt_lo(~0u, z_));
    const int tid = tid_, wid = __builtin_amdgcn_readfirstlane(tid >> 6), lane = tid & 63, wr = wid >> 2, wc = wid & 3, fr = lane & 15, fq = lane >> 4;
    const int K = g.K, nt = K / BK;
    unsigned voffA[2], voffB[2];
    constexpr bool GATHER = Sched::GATHER; constexpr int GOFF = 135168;
    static_assert(!GATHER || SP2, "gather is wired into the SP2 loop only");
    int gR[2]; unsigned gC[2]; unsigned curV[2][2], nxtV[2][2];
#pragma unroll
    for (int i = 0; i < 2; ++i) { int R, C; stage_rc(tid * 16 + i * 8192, R, C); const int Rb = Epi::PERM ? ((R & ~31) + perm32(R & 31)) : R;
        voffA[i] = (unsigned)(R * K + C) * 2u; voffB[i] = (unsigned)(Rb * K + C) * 2u; gR[i] = R; gC[i] = (unsigned)C * 2u; }
    const size_t kstep = (size_t)(BK * 2);
    const size_t hstep = (size_t)HALF * K * 2;
    const size_t tstep = 2 * hstep;
    const unsigned ldsw = (unsigned)wid * 1024u;
    const int aoff = lds_byte(wr * 64 + fr, fq * 8), boff = lds_byte(wc * 32 + fr, fq * 8);
#define PG8_SA(b, h) (((b) * 2 + (h)) * HTB)
#define PG8_SB(b, h) ((4 + (b) * 2 + (h)) * HTB)
#define PG8_STAGE(bufoff, gbase, voff) do { _Pragma("unroll") for (int _i = 0; _i < 2; ++_i) \
        __builtin_amdgcn_global_load_lds((const unsigned*)((const char*)(gbase) + (voff)[_i]), (PG8_LAS unsigned*)(lds + (bufoff) + ldsw + _i * 8192), 16, 0, 0); } while (0)
#define PG8_LDA(dst, b, h) do { _Pragma("unroll") for (int m = 0; m < 4; ++m) _Pragma("unroll") for (int k = 0; k < 2; ++k) dst[m][k] = *(const PG8_LAS bf16x8*)(lds + PG8_SA(b, h) + aoff + m * 2048 + k * 1024); } while (0)
#define PG8_LDB(dst, b, h) do { _Pragma("unroll") for (int n = 0; n < 2; ++n) _Pragma("unroll") for (int k = 0; k < 2; ++k) dst[n][k] = *(const PG8_LAS bf16x8*)(lds + PG8_SB(b, h) + boff + n * 2048 + k * 1024); } while (0)
#define PG8_MMA(ai, bj, At, Bt) do { __builtin_amdgcn_s_setprio(1); _Pragma("unroll") for (int m = 0; m < 4; ++m) _Pragma("unroll") for (int n = 0; n < 2; ++n) _Pragma("unroll") for (int k = 0; k < 2; ++k) \
        acc[ai][bj][m][n] = __builtin_amdgcn_mfma_f32_16x16x32_bf16(Bt[n][k], At[m][k], acc[ai][bj][m][n], 0, 0, 0); __builtin_amdgcn_s_setprio(0); } while (0)
#define PG8_WAIT_V(n) asm volatile("s_waitcnt vmcnt(" #n ")" ::: "memory")
#define PG8_WAIT_L(n) asm volatile("s_waitcnt lgkmcnt(" #n ")" ::: "memory")
#define PG8_BAR __builtin_amdgcn_s_barrier()
#define PG8_SCHED __builtin_amdgcn_sched_barrier(0)
    Unit cur, nxt; int ui = 0;
    if (!S.next(0, cur)) return;
    f32x4 acc[2][2][4][2];
#pragma unroll
    for (int a = 0; a < 2; ++a)
#pragma unroll
        for (int b = 0; b < 2; ++b)
#pragma unroll
            for (int m = 0; m < 4; ++m)
#pragma unroll
                for (int n = 0; n < 2; ++n) acc[a][b][m][n] = (f32x4){0.f, 0.f, 0.f, 0.f};
    bf16x8 At[4][2], B0[2][2], B1[2][2];
    const char* cA = (const char*)g.A + (size_t)cur.pm * tstep; const char* cB = (const char*)g.Bt + (size_t)cur.pn * tstep;
    S.a_ready(cur);
    if constexpr (SP2) {
        if constexpr (GATHER) {
#pragma unroll
            for (int h = 0; h < 2; ++h)
#pragma unroll
                for (int i = 0; i < 2; ++i) curV[h][i] = (unsigned)S.rowidx[cur.pm * 256 + h * 128 + gR[i]] * (unsigned)(K * 2) + gC[i];
            cA = (const char*)g.A;
            PG8_STAGE(PG8_SB(0, 0), cB, voffB); PG8_STAGE(PG8_SB(0, 1), cB + hstep, voffB); PG8_STAGE(PG8_SA(0, 0), cA, curV[0]); PG8_STAGE(PG8_SA(0, 1), cA, curV[1]);
        } else {
        PG8_STAGE(PG8_SB(0, 0), cB, voffB); PG8_STAGE(PG8_SB(0, 1), cB + hstep, voffB); PG8_STAGE(PG8_SA(0, 0), cA, voffA); PG8_STAGE(PG8_SA(0, 1), cA + hstep, voffA);
        }
        if (wr == 1) PG8_BAR;
        PG8_WAIT_V(2); PG8_BAR;
        if constexpr (GATHER) { PG8_STAGE(PG8_SB(1, 0), cB + kstep, voffB); PG8_STAGE(PG8_SA(1, 0), cA + kstep, curV[0]); PG8_STAGE(PG8_SB(1, 1), cB + hstep + kstep, voffB); } else {
        PG8_STAGE(PG8_SB(1, 0), cB + kstep, voffB); PG8_STAGE(PG8_SA(1, 0), cA + kstep, voffA); PG8_STAGE(PG8_SB(1, 1), cB + hstep + kstep, voffB); }
        PG8_WAIT_V(6); PG8_BAR;
    } else {
        PG8_STAGE(PG8_SB(0, 0), cB, voffB); PG8_STAGE(PG8_SA(0, 0), cA, voffA); PG8_STAGE(PG8_SB(0, 1), cB + hstep, voffB); PG8_STAGE(PG8_SA(0, 1), cA + hstep, voffA);
        if (wr == 1) PG8_BAR;
        PG8_WAIT_V(4); PG8_BAR;
        PG8_STAGE(PG8_SB(1, 0), cB + kstep, voffB); PG8_STAGE(PG8_SA(1, 0), cA + kstep, voffA); PG8_STAGE(PG8_SB(1, 1), cB + hstep + kstep, voffB);
        PG8_WAIT_V(6); PG8_BAR;
    }
    for (;;) {
        const bool has_next = S.next(ui + 1, nxt);
        const char* nA = GATHER ? cA : has_next ? (const char*)g.A + (size_t)nxt.pm * tstep : cA; const char* nB = has_next ? (const char*)g.Bt + (size_t)nxt.pn * tstep : cB;
        if constexpr (GATHER) {
            if (has_next) {
#pragma unroll
                for (int h = 0; h < 2; ++h)
#pragma unroll
                    for (int i = 0; i < 2; ++i)
                        __builtin_amdgcn_global_load_lds((const unsigned*)(S.rowidx + nxt.pm * 256 + h * 128 + gR[i]), (PG8_LAS unsigned*)(lds + GOFF + (h * 2 + i) * 2048 + wid * 256), 4, 0, 0);
            } else {
#pragma unroll
                for (int h = 0; h < 2; ++h)
#pragma unroll
                    for (int i = 0; i < 2; ++i) nxtV[h][i] = curV[h][i];
            }
        }
        for (int t = 0; t < nt; t += 2) {
            const bool last = (t == nt - 2);
            const char* a1 = cA + (size_t)(t + 1) * kstep;
            const char* a2 = last ? nA : cA + (size_t)(t + 2) * kstep; const char* b2 = last ? nB : cB + (size_t)(t + 2) * kstep;
            const char* a3 = a2 + kstep; const char* b3 = b2 + kstep;
            if (last && has_next) S.a_ready(nxt);
            if constexpr (GATHER) {
            if (last && has_next) {
#pragma unroll
                for (int h = 0; h < 2; ++h)
#pragma unroll
                    for (int i = 0; i < 2; ++i) nxtV[h][i] = *(const PG8_LAS unsigned*)(lds + GOFF + (h * 2 + i) * 2048 + tid * 4) * (unsigned)(K * 2) + gC[i];
            }
            unsigned uV[2][2];
#pragma unroll
            for (int h = 0; h < 2; ++h)
#pragma unroll
                for (int i = 0; i < 2; ++i) uV[h][i] = last ? nxtV[h][i] : curV[h][i];
            const char* ga1 = cA + (size_t)(t + 1) * kstep; const char* ga2 = last ? cA : cA + (size_t)(t + 2) * kstep;
            PG8_LDB(B0, 0, 0); PG8_LDB(B1, 0, 1); PG8_SCHED; PG8_LDA(At, 0, 0); PG8_STAGE(PG8_SA(1, 1), ga1, curV[1]);
            PG8_WAIT_V(8); PG8_WAIT_L(0); PG8_BAR; PG8_MMA(0, 0, At, B0); PG8_MMA(0, 1, At, B1); PG8_BAR; PG8_SCHED;
            PG8_LDA(At, 0, 1); PG8_STAGE(PG8_SB(0, 0), b2, voffB); PG8_STAGE(PG8_SB(0, 1), b2 + hstep, voffB); PG8_STAGE(PG8_SA(0, 0), ga2, uV[0]);
            PG8_WAIT_V(8); PG8_WAIT_L(0); PG8_BAR; PG8_MMA(1, 0, At, B0); PG8_MMA(1, 1, At, B1); PG8_BAR; PG8_SCHED;
            PG8_LDB(B0, 1, 0); PG8_LDB(B1, 1, 1); PG8_SCHED; PG8_LDA(At, 1, 0); PG8_STAGE(PG8_SA(0, 1), ga2, uV[1]);
            PG8_WAIT_V(8); PG8_WAIT_L(0); PG8_BAR; PG8_MMA(0, 0, At, B0); PG8_MMA(0, 1, At, B1); PG8_BAR; PG8_SCHED;
            PG8_LDA(At, 1, 1); PG8_STAGE(PG8_SB(1, 0), b3, voffB); PG8_STAGE(PG8_SB(1, 1), b3 + hstep, voffB); PG8_STAGE(PG8_SA(1, 0), ga2 + kstep, uV[0]);
            PG8_WAIT_V(8); PG8_WAIT_L(0); PG8_BAR; PG8_MMA(1, 0, At, B0); PG8_MMA(1, 1, At, B1); PG8_BAR; PG8_SCHED;
            } else if constexpr (SP2) {
            PG8_LDB(B0, 0, 0); PG8_LDB(B1, 0, 1); PG8_SCHED; PG8_LDA(At, 0, 0); PG8_STAGE(PG8_SA(1, 1), a1 + hstep, voffA);
            PG8_WAIT_V(8); PG8_WAIT_L(0); PG8_BAR; PG8_MMA(0, 0, At, B0); PG8_MMA(0, 1, At, B1); PG8_BAR; PG8_SCHED;
            PG8_LDA(At, 0, 1); PG8_STAGE(PG8_SB(0, 0), b2, voffB); PG8_STAGE(PG8_SB(0, 1), b2 + hstep, voffB); PG8_STAGE(PG8_SA(0, 0), a2, voffA);
            PG8_WAIT_V(8); PG8_WAIT_L(0); PG8_BAR; PG8_MMA(1, 0, At, B0); PG8_MMA(1, 1, At, B1); PG8_BAR; PG8_SCHED;
            PG8_LDB(B0, 1, 0); PG8_LDB(B1, 1, 1); PG8_SCHED; PG8_LDA(At, 1, 0); PG8_STAGE(PG8_SA(0, 1), a2 + hstep, voffA);
            PG8_WAIT_V(8); PG8_WAIT_L(0); PG8_BAR; PG8_MMA(0, 0, At, B0); PG8_MMA(0, 1, At, B1); PG8_BAR; PG8_SCHED;
            PG8_LDA(At, 1, 1); PG8_STAGE(PG8_SB(1, 0), b3, voffB); PG8_STAGE(PG8_SB(1, 1), b3 + hstep, voffB); PG8_STAGE(PG8_SA(1, 0), a3, voffA);
            PG8_WAIT_V(8); PG8_WAIT_L(0); PG8_BAR; PG8_MMA(1, 0, At, B0); PG8_MMA(1, 1, At, B1); PG8_BAR; PG8_SCHED;
            } else {
            PG8_LDB(B0, 0, 0); PG8_SCHED; PG8_LDA(At, 0, 0); PG8_STAGE(PG8_SA(1, 1), a1 + hstep, voffA);
            PG8_WAIT_L(8); PG8_BAR; PG8_WAIT_L(0); PG8_MMA(0, 0, At, B0); PG8_BAR; PG8_SCHED;
            PG8_LDB(B1, 0, 1); PG8_STAGE(PG8_SB(0, 0), b2, voffB);
            PG8_BAR; PG8_WAIT_L(0); PG8_MMA(0, 1, At, B1); PG8_BAR;
            PG8_LDA(At, 0, 1); PG8_STAGE(PG8_SA(0, 0), a2, voffA);
            PG8_BAR; PG8_WAIT_L(0); PG8_MMA(1, 0, At, B0); PG8_BAR; PG8_SCHED;
            PG8_STAGE(PG8_SB(0, 1), b2 + hstep, voffB);
            PG8_WAIT_V(6); PG8_BAR; PG8_MMA(1, 1, At, B1); PG8_BAR;
            PG8_LDB(B0, 1, 0); PG8_SCHED; PG8_LDA(At, 1, 0); PG8_STAGE(PG8_SA(0, 1), a2 + hstep, voffA);
            PG8_WAIT_L(8); PG8_BAR; PG8_WAIT_L(0); PG8_MMA(0, 0, At, B0); PG8_BAR; PG8_SCHED;
            PG8_LDB(B1, 1, 1); PG8_STAGE(PG8_SB(1, 0), b3, voffB);
            PG8_BAR; PG8_WAIT_L(0); PG8_MMA(0, 1, At, B1); PG8_BAR;
            PG8_LDA(At, 1, 1); PG8_STAGE(PG8_SA(1, 0), a3, voffA);
            PG8_BAR; PG8_WAIT_L(0); PG8_MMA(1, 0, At, B0); PG8_BAR; PG8_SCHED;
            PG8_STAGE(PG8_SB(1, 1), b3 + hstep, voffB);
            PG8_WAIT_V(6); PG8_BAR; PG8_MMA(1, 1, At, B1); PG8_BAR;
            }
        }
        if constexpr (ALIGN_EPI) { if (wr == 0) PG8_BAR; }
        if constexpr (!Epi::AFTER_DRAIN) { E(acc, cur, wr, wc, fr, fq); S.done(cur); }
        if (!has_next) break;
#pragma unroll
        for (int a = 0; a < 2; ++a)
#pragma unroll
            for (int b = 0; b < 2; ++b)
#pragma unroll
                for (int m = 0; m < 4; ++m)
#pragma unroll
                    for (int n = 0; n < 2; ++n) acc[a][b][m][n] = (f32x4){0.f, 0.f, 0.f, 0.f};
        cur = nxt; cA = nA; cB = nB; ++ui;
        if constexpr (GATHER) {
#pragma unroll
            for (int h = 0; h < 2; ++h)
#pragma unroll
                for (int i = 0; i < 2; ++i) curV[h][i] = nxtV[h][i];
        }
        if constexpr (ALIGN_EPI) { if (wr == 1) PG8_BAR; }
    }
    PG8_WAIT_V(0);
    if constexpr (!ALIGN_EPI) { if (wr == 0) PG8_BAR; }
    PG8_BAR;
    if constexpr (Epi::AFTER_DRAIN) { E.fused(acc, cur, wr, wc, fr, fq, lds, wid, lane); S.done(cur); }
#undef PG8_SA
#undef PG8_SB
#undef PG8_STAGE
#undef PG8_LDA
#undef PG8_LDB
#undef PG8_MMA
#undef PG8_WAIT_V
#undef PG8_WAIT_L
#undef PG8_BAR
#undef PG8_SCHED
}
}
constexpr int NB = 4, T = 8192, D = 1024, NTOK = NB * T, DEPTH = 2;
constexpr int NIN = 3328;
constexpr int IN_W = 3096;
constexpr int NSLOT_MAX = 65536 + 32 * 256;
constexpr float RMS_EPS = 1e-6f;
constexpr float QSCALE = 0.125f * 1.44269504088896f;
constexpr int NWAVES = 8;

constexpr size_t MiB = 1u << 20;
constexpr size_t WS_CTL = 0, CTL_ZERO_BYTES = 1 * MiB;
constexpr size_t WS_ROPE = 1 * MiB;
constexpr size_t WS_SMALL = 3 * MiB;
constexpr size_t WS_WG = 3 * MiB + 65536;
constexpr size_t WS_SSQ = 4 * MiB;
constexpr size_t WS_WIN = 8 * MiB;
constexpr size_t WS_WOUT = 22 * MiB;
constexpr size_t WS_WQ = 26 * MiB;
constexpr size_t WS_WKV = 27 * MiB;
constexpr size_t WS_WO = 29 * MiB;
constexpr size_t WS_WR = 30 * MiB;
constexpr size_t WS_W1C = 31 * MiB;
constexpr size_t WS_W2C = 33 * MiB;
constexpr size_t WS_MEMB = 34 * MiB;
constexpr size_t WS_MK = 36 * MiB;
constexpr size_t WS_MVT = 37 * MiB;
constexpr size_t WS_WGU = 40 * MiB;
constexpr size_t WS_WDN = 168 * MiB;
constexpr size_t WS_HB = 232 * MiB;
constexpr size_t WS_Q = 296 * MiB, WS_QR = 328 * MiB, WS_KCR = 360 * MiB, WS_VCR = 368 * MiB, WS_KS = 376 * MiB, WS_KW = 384 * MiB;
constexpr size_t WS_VST = 392 * MiB, WS_VWT = 400 * MiB, WS_KCC = 408 * MiB, WS_VCT = 409 * MiB, WS_GATE = 410 * MiB;
constexpr size_t WS_CB = 414 * MiB, WS_CC = 430 * MiB, WS_CH = 446 * MiB;
constexpr size_t WS_HQ = 462 * MiB, WS_HF = 494 * MiB, WS_HI = 526 * MiB, WS_HG = 558 * MiB;
constexpr size_t WS_CAT = 590 * MiB, WS_U = 654 * MiB, WS_DEC = 686 * MiB;
constexpr size_t WS_XQ = 688 * MiB, WS_XO = 704 * MiB;
constexpr size_t WS_XS = 296 * MiB, WS_ACT = 440 * MiB, WS_YS = 512 * MiB;
constexpr size_t WS_TOKE = 720 * MiB, WS_TOKG = 721 * MiB, WS_TOKP = 722 * MiB, WS_TOKS = 723 * MiB, WS_SRSTD = 724 * MiB, WS_SGATE = 725 * MiB;
constexpr size_t WS_STOK = 723 * MiB + 512 * 1024;
constexpr size_t WS_U2 = 728 * MiB;
constexpr size_t WS_PROBE = 760 * MiB;
constexpr size_t WS_END = 760 * MiB;
static_assert(WS_XS + (size_t)NSLOT_MAX * 1024 * 2 <= WS_ACT && WS_ACT + (size_t)NSLOT_MAX * 512 * 2 <= WS_YS && WS_YS + (size_t)NSLOT_MAX * 1024 * 2 <= WS_XQ, "moe map");
constexpr int CW_CNT = 64;
constexpr int CW_KMAX = 256;
constexpr int CW_NSAQ = 512;
constexpr int CW_BAR = 4096;

constexpr int RING_BYTES = 131072;
constexpr int NSA_LDS_WAVE = 10752;
constexpr int MISC_OFF = RING_BYTES;
constexpr int TAB_OFF = RING_BYTES + 512;
constexpr int LDS_BYTES = 147456;
static_assert(8 * NSA_LDS_WAVE <= RING_BYTES && TAB_OFF + 4 * (40 + 320) <= LDS_BYTES, "LDS map");

#define GAS __attribute__((address_space(1)))
#define LAS __attribute__((address_space(3)))
#define DEV __device__ __forceinline__
typedef unsigned short bf16;
typedef unsigned v4u __attribute__((ext_vector_type(4)));
typedef unsigned v2u __attribute__((ext_vector_type(2)));
typedef float f32x4 __attribute__((ext_vector_type(4)));
typedef short bf16x8 __attribute__((ext_vector_type(8)));
typedef GAS unsigned gu32;
#define RLX_AGENT __ATOMIC_RELAXED, __HIP_MEMORY_SCOPE_AGENT
#define LDS_WAIT() asm volatile("s_waitcnt lgkmcnt(0)" ::: "memory")
#define VM_WAIT() asm volatile("s_waitcnt vmcnt(0)" ::: "memory")
typedef __bf16 bf16x2_t __attribute__((ext_vector_type(2)));
typedef float f32x2_t __attribute__((ext_vector_type(2)));
DEV unsigned pk2(float lo, float hi) { const f32x2_t v = {lo, hi}; return __builtin_bit_cast(unsigned, __builtin_convertvector(v, bf16x2_t)); }
DEV unsigned f2bf(float f) { return pk2(f, 0.f) & 0xffffu; }
DEV float bf2f(unsigned short b) { return __builtin_bit_cast(float, (unsigned)b << 16); }
DEV float bflo(unsigned w) { return __builtin_bit_cast(float, w << 16); }
DEV float bfhi(unsigned w) { return __builtin_bit_cast(float, w & 0xffff0000u); }
DEV float ex2(float x) { return __builtin_amdgcn_exp2f(x); }
DEV float wave_sum(float v) {
#pragma unroll
    for (int o = 1; o < 64; o <<= 1) v += __shfl_xor(v, o);
    return v;
}
DEV f32x4 mfma16(bf16x8 a, bf16x8 b, f32x4 c) { return __builtin_amdgcn_mfma_f32_16x16x32_bf16(a, b, c, 0, 0, 0); }
DEV int slot32(int k) { return ((k >> 2) & 3) * 8 + (k >> 4) * 4 + (k & 3); }
DEV int kfrag_off(int key, int d) { return (key >> 5) * 2048 + ((((key >> 4) & 1) * 2 + (d >> 5)) * 64 + ((d >> 3) & 3) * 16 + (key & 15)) * 8 + (d & 7); }
DEV float sigmoidf_(float x) { return 1.0f / (1.0f + __expf(-x)); }
DEV float siluf_(float x) { return x / (1.0f + __expf(-x)); }
#define XB_TMO      128
#define XB_XCNT(j)  (256  + 64 * (j))
#define XB_XSUB(j)  (1280 + 64 * (j))
#define XB_XGEN(j)  (2304 + 64 * (j))
#define XB_TOP      3328
#define XB_TOPGEN   3392
#define XCD_BAR_WORDS 3456
#define XB_SPIN_CAP (1u << 18)

__device__ __forceinline__ unsigned xb_ld(unsigned* p)              { return __hip_atomic_load(p, __ATOMIC_RELAXED, __HIP_MEMORY_SCOPE_AGENT); }
__device__ __forceinline__ unsigned xb_add(unsigned* p, unsigned v) { return __hip_atomic_fetch_add(p, v, __ATOMIC_RELAXED, __HIP_MEMORY_SCOPE_AGENT); }
__device__ __forceinline__ unsigned xb_xcc_id() { return (unsigned)__builtin_amdgcn_s_getreg((3 << 11) | 20) & 0xFu; }
#define XB_SPIN(cond, bar) do { unsigned _sp = 0; while (cond) { __builtin_amdgcn_s_sleep(1); \
    if ((++_sp & 255u) == 0u) { if (xb_ld(&(bar)[XB_TMO])) break; if (_sp > XB_SPIN_CAP) { atomicAdd(&(bar)[XB_TMO], 1u); break; } } } } while (0)

struct XcdBarrier {
    unsigned* bar; unsigned x;
    volatile LAS unsigned* st;
};

__device__ __forceinline__ XcdBarrier xcd_barrier_post(unsigned* bar, volatile LAS unsigned* st) {
    XcdBarrier b; b.bar = bar; b.x = xb_xcc_id(); b.st = st;
    if (threadIdx.x == 0) (void)xb_add(&bar[XB_XCNT(b.x)], 1u);
    return b;
}
__device__ __forceinline__ void xcd_barrier_complete(unsigned* bar, unsigned x, unsigned& nloc, unsigned& nx) {
    const unsigned G = gridDim.x * gridDim.y * gridDim.z;
    unsigned sum, cnt, mine, sp = 0u;
    for (;;) {
        sum = 0u; cnt = 0u; mine = 0u;
#pragma unroll
        for (unsigned j = 0; j < 16; ++j) { const unsigned c = xb_ld(&bar[XB_XCNT(j)]); sum += c; cnt += (c > 0u) ? 1u : 0u; mine = (j == x) ? c : mine; }
        if (sum == G) break;
        __builtin_amdgcn_s_sleep(1);
        if ((++sp & 255u) == 0u) { if (xb_ld(&bar[XB_TMO])) break; if (sp > XB_SPIN_CAP) { atomicAdd(&bar[XB_TMO], 1u); break; } }
    }
    nloc = mine > 0u ? mine : 1u; nx = cnt > 0u ? cnt : 1u;
}

__device__ __forceinline__ void xcd_barrier(const XcdBarrier& b) {
    asm volatile("s_waitcnt vmcnt(0)" ::: "memory");
    __syncthreads();
    if (threadIdx.x == 0) {
        unsigned* bar = b.bar;
        __builtin_amdgcn_s_waitcnt(0);
        unsigned nloc = b.st[0], nx = b.st[1];
        if (nloc == 0u) { xcd_barrier_complete(bar, b.x, nloc, nx); b.st[0] = nloc; b.st[1] = nx; }
        const unsigned old = xb_add(&bar[XB_XSUB(b.x)], 1u);
        const unsigned gen = old / nloc;
        if (old + 1u == (gen + 1u) * nloc) {
            __builtin_amdgcn_fence(__ATOMIC_RELEASE, "agent");
            asm volatile("s_waitcnt vmcnt(0)" ::: "memory");
            const unsigned og = xb_add(&bar[XB_TOP], 1u);
            const unsigned tg = og / nx;
            if (og + 1u == (tg + 1u) * nx) xb_add(&bar[XB_TOPGEN], 1u);
            else XB_SPIN(xb_ld(&bar[XB_TOPGEN]) == tg, bar);
            __builtin_amdgcn_fence(__ATOMIC_ACQUIRE, "agent");
            xb_add(&bar[XB_XGEN(b.x)], 1u);
            asm volatile("s_waitcnt vmcnt(0)" ::: "memory");
        } else {
            XB_SPIN(xb_ld(&bar[XB_XGEN(b.x)]) == gen, bar);
            __builtin_amdgcn_fence(__ATOMIC_ACQUIRE, "agent");
            asm volatile("s_waitcnt vmcnt(0)" ::: "memory");
        }
    }
    __syncthreads();
}
DEV float row_rstd(const float* ssq, int row, int fq) {
    const f32x4 p = *(const f32x4*)(ssq + (size_t)row * 16 + fq * 4);
    float s = (p.x + p.y) + (p.z + p.w);
    s += __shfl_xor(s, 16); s += __shfl_xor(s, 32);
    return 1.0f / sqrtf(s * (1.0f / 1024.0f) + RMS_EPS);
}
DEV float row_rstd_full(const float* ssq, int row) {
    const f32x4* p = (const f32x4*)(ssq + (size_t)row * 16);
    const f32x4 a = p[0], b = p[1], c = p[2], d = p[3];
    const float s = ((a.x + a.y) + (a.z + a.w)) + ((b.x + b.y) + (b.z + b.w)) + ((c.x + c.y) + (c.z + c.w)) + ((d.x + d.y) + (d.z + d.w));
    return 1.0f / sqrtf(s * (1.0f / 1024.0f) + RMS_EPS);
}

DEV void rope4(const float* rope, int t, int i, const f32x4& v0, const f32x4& v1, float (&lo)[4], float (&hi)[4]) {
    const f32x4 c0 = *(const f32x4*)(rope + ((size_t)t * 32 + i) * 2), c1 = *(const f32x4*)(rope + ((size_t)t * 32 + i + 2) * 2);
    lo[0] = v0[0] * c0[0] - v0[1] * c0[1]; hi[0] = v0[1] * c0[0] + v0[0] * c0[1];
    lo[1] = v0[2] * c0[2] - v0[3] * c0[3]; hi[1] = v0[3] * c0[2] + v0[2] * c0[3];
    lo[2] = v1[0] * c1[0] - v1[1] * c1[1]; hi[2] = v1[1] * c1[0] + v1[0] * c1[1];
    lo[3] = v1[2] * c1[2] - v1[3] * c1[3]; hi[3] = v1[3] * c1[2] + v1[2] * c1[3];
}
struct EpiIn {
    static constexpr bool PERM = true, AFTER_DRAIN = false;
    unsigned char* ws;
    template <class Tp> DEV Tp* P(size_t off) const { return (Tp*)(GAS Tp*)(ws + off); }
    DEV void operator()(const f32x4 (&acc)[2][2][4][2], const pg8::Unit& u, int wr, int wc, int fr, int fq) const {
        asm volatile("" : "+v"(fr), "+v"(fq), "+s"(wr), "+s"(wc));
        const int pn = u.pn;
        const float* ssq = P<float>(WS_SSQ); const float* rope = P<float>(WS_ROPE);
#pragma unroll
        for (int ai = 0; ai < 2; ++ai)
#pragma unroll
            for (int m = 0; m < 4; ++m) {
                const int row = u.pm * 256 + ai * 128 + wr * 64 + m * 16 + fr;
                const float rstd = row_rstd(ssq, row, fq);
                const int t = row & (T - 1), b = row >> 13;
#pragma unroll
                for (int bj = 0; bj < 2; ++bj) {
                    const int col = bj * 128 + wc * 32 + fq * 8;
                    const f32x4 v0 = acc[ai][bj][m][0] * rstd, v1 = acc[ai][bj][m][1] * rstd;
                    if (pn < 2) {
                        const int g = pn * 256 + col, head = g >> 6, i = (g & 63) >> 1;
                        const size_t o = (size_t)row * 512 + head * 64 + i;
                        bf16* Q = P<bf16>(WS_Q);
                        v2u w;
                        w.x = pk2(v0[0] * QSCALE, v0[2] * QSCALE); w.y = pk2(v1[0] * QSCALE, v1[2] * QSCALE); *(v2u*)(Q + o) = w;
                        w.x = pk2(v0[1] * QSCALE, v0[3] * QSCALE); w.y = pk2(v1[1] * QSCALE, v1[3] * QSCALE); *(v2u*)(Q + o + 32) = w;
                    } else if (pn == 2) {
                        bf16* dst = P<bf16>((col < 128) ? WS_KCR : WS_VCR);
                        v4u w; w.x = pk2(v0[0], v0[1]); w.y = pk2(v0[2], v0[3]); w.z = pk2(v1[0], v1[1]); w.w = pk2(v1[2], v1[3]);
                        *(v4u*)(dst + (size_t)row * 128 + (col & 127)) = w;
                    } else if (pn == 3 || pn == 4) {
                        if (col < 128) {
                            bf16* dst = P<bf16>((pn == 3) ? WS_KS : WS_KW);
                            const int hkv = col >> 6, i = (col & 63) >> 1;
                            float lo[4], hi[4]; rope4(rope, t, i, v0, v1, lo, hi);
                            const size_t o = (size_t)(b * 2 + hkv) * T * 64 + kfrag_off(t, i);
                            v2u w;
                            w.x = pk2(lo[0], lo[1]); w.y = pk2(lo[2], lo[3]); *(v2u*)(dst + o) = w;
                            w.x = pk2(hi[0], hi[1]); w.y = pk2(hi[2], hi[3]); *(v2u*)(dst + o + 512) = w;
                        } else {
                            bf16* dst = P<bf16>((pn == 3) ? WS_VST : WS_VWT);
                            const int c2 = col - 128, hkv = c2 >> 6, d = c2 & 63;
                            const size_t o = (((size_t)(b * 2 + hkv) * 256 + (t >> 5)) * 64 + d) * 32 + slot32(t & 31);
#pragma unroll
                            for (int j = 0; j < 4; ++j) { dst[o + j * 32] = (bf16)f2bf(v0[j]); dst[o + (j + 4) * 32] = (bf16)f2bf(v1[j]); }
#if defined(DUPMASK) && ((DUPMASK >> 20) & 1)
                            { bf16* dst2 = P<bf16>(WS_U2) + (pn - 3) * (4u << 20);
#pragma unroll
                            for (int j = 0; j < 4; ++j) { dst2[o + j * 32] = (bf16)f2bf(v0[j]); dst2[o + (j + 4) * 32] = (bf16)f2bf(v1[j]); } }
#endif
                        }
                    } else if (pn == 9) {
                        float* dst = P<float>(WS_HF) + (size_t)row * 256 + col;
                        *(f32x4*)dst = v0; *(f32x4*)(dst + 4) = v1;
                    } else {
                        bf16* dst = (pn < 8) ? P<bf16>(WS_CB + (size_t)(pn - 5) * (WS_CC - WS_CB)) : P<bf16>(WS_HQ + (size_t)(pn - 8) * (WS_HF - WS_HQ));
                        v4u w; w.x = pk2(v0[0], v0[1]); w.y = pk2(v0[2], v0[3]); w.z = pk2(v1[0], v1[1]); w.w = pk2(v1[2], v1[3]);
                        *(v4u*)(dst + (size_t)row * 256 + col) = w;
                    }
                }
            }
    }
};

struct EpiRes {
    static constexpr bool PERM = true, AFTER_DRAIN = false;
    const float* base32; bf16* hb; float* ssq;
    DEV void operator()(const f32x4 (&acc)[2][2][4][2], const pg8::Unit& u, int wr, int wc, int fr, int fq) const {
        asm volatile("" : "+v"(fr), "+v"(fq), "+s"(wr), "+s"(wc));
#pragma unroll
        for (int ai = 0; ai < 2; ++ai)
#pragma unroll
            for (int m = 0; m < 4; ++m) {
                const int row = u.pm * 256 + ai * 128 + wr * 64 + m * 16 + fr;
                float ss = 0.f;
#pragma unroll
                for (int bj = 0; bj < 2; ++bj) {
                    const size_t o = (size_t)row * 1024 + u.pn * 256 + bj * 128 + wc * 32 + fq * 8;
                    f32x4 v0, v1;
                    if (base32) { v0 = *(const f32x4*)(base32 + o); v1 = *(const f32x4*)(base32 + o + 4); }
                    else { const v4u hw = *(const v4u*)(hb + o); v0 = (f32x4){bflo(hw.x), bfhi(hw.x), bflo(hw.y), bfhi(hw.y)}; v1 = (f32x4){bflo(hw.z), bfhi(hw.z), bflo(hw.w), bfhi(hw.w)}; }
                    v0 = v0 + acc[ai][bj][m][0]; v1 = v1 + acc[ai][bj][m][1];
                    v4u w; w.x = pk2(v0[0], v0[1]); w.y = pk2(v0[2], v0[3]); w.z = pk2(v1[0], v1[1]); w.w = pk2(v1[2], v1[3]);
                    *(v4u*)(hb + o) = w;
                    ss += ((v0[0] * v0[0] + v0[1] * v0[1]) + (v0[2] * v0[2] + v0[3] * v0[3])) + ((v1[0] * v1[0] + v1[1] * v1[1]) + (v1[2] * v1[2] + v1[3] * v1[3]));
                }
                ss += __shfl_xor(ss, 16); ss += __shfl_xor(ss, 32);
                if (fq == 0) ssq[(size_t)row * 16 + u.pn * 4 + wc] = ss;
            }
    }
};

struct EpiXQ {
    static constexpr bool PERM = true, AFTER_DRAIN = false;
    const float* ssq; bf16* XQ;
    DEV void operator()(const f32x4 (&acc)[2][2][4][2], const pg8::Unit& u, int wr, int wc, int fr, int fq) const {
        asm volatile("" : "+v"(fr), "+v"(fq), "+s"(wr), "+s"(wc));
#pragma unroll
        for (int ai = 0; ai < 2; ++ai)
#pragma unroll
            for (int m = 0; m < 4; ++m) {
                const int row = u.pm * 256 + ai * 128 + wr * 64 + m * 16 + fr;
                const float sc = row_rstd(ssq, row, fq) * QSCALE;
#pragma unroll
                for (int bj = 0; bj < 2; ++bj) {
                    const f32x4 v0 = acc[ai][bj][m][0] * sc, v1 = acc[ai][bj][m][1] * sc;
                    v4u w; w.x = pk2(v0[0], v0[1]); w.y = pk2(v0[2], v0[3]); w.z = pk2(v1[0], v1[1]); w.w = pk2(v1[2], v1[3]);
                    *(v4u*)(XQ + (size_t)row * 256 + bj * 128 + wc * 32 + fq * 8) = w;
                }
            }
    }
};

struct EpiGU {
    static constexpr bool PERM = true, AFTER_DRAIN = false;
    const float* srstd; bf16* ACT;
    DEV void operator()(const f32x4 (&acc)[2][2][4][2], const pg8::Unit& u, int wr, int wc, int fr, int fq) const {
        asm volatile("" : "+v"(fr), "+v"(fq), "+s"(wr), "+s"(wc));
        const int nt = u.pn & 3;
#pragma unroll
        for (int ai = 0; ai < 2; ++ai)
#pragma unroll
            for (int m = 0; m < 4; ++m) {
                const int row = u.pm * 256 + ai * 128 + wr * 64 + m * 16 + fr;
                const float rs = srstd[row];
#pragma unroll
                for (int bj = 0; bj < 2; ++bj) {
                    const f32x4 v0 = acc[ai][bj][m][0] * rs, v1 = acc[ai][bj][m][1] * rs;
                    const int j = (nt * 256 + bj * 128 + wc * 32 + fq * 8) >> 1;
                    v2u w; w.x = pk2(siluf_(v0[0]) * v0[1], siluf_(v0[2]) * v0[3]); w.y = pk2(siluf_(v1[0]) * v1[1], siluf_(v1[2]) * v1[3]);
                    *(v2u*)(ACT + (size_t)row * 512 + j) = w;
                }
            }
    }
};

struct EpiDN {
    static constexpr bool PERM = true, AFTER_DRAIN = false;
    const float* sgate; bf16* YS;
    DEV void operator()(const f32x4 (&acc)[2][2][4][2], const pg8::Unit& u, int wr, int wc, int fr, int fq) const {
        asm volatile("" : "+v"(fr), "+v"(fq), "+s"(wr), "+s"(wc));
        const int nt = u.pn & 3;
#pragma unroll
        for (int ai = 0; ai < 2; ++ai)
#pragma unroll
            for (int m = 0; m < 4; ++m) {
                const int row = u.pm * 256 + ai * 128 + wr * 64 + m * 16 + fr;
                const float gt = sgate[row];
#pragma unroll
                for (int bj = 0; bj < 2; ++bj) {
                    const f32x4 v0 = acc[ai][bj][m][0] * gt, v1 = acc[ai][bj][m][1] * gt;
                    v4u w; w.x = pk2(v0[0], v0[1]); w.y = pk2(v0[2], v0[3]); w.z = pk2(v1[0], v1[1]); w.w = pk2(v1[2], v1[3]);
                    *(v4u*)(YS + (size_t)row * 1024 + nt * 256 + bj * 128 + wc * 32 + fq * 8) = w;
                }
            }
    }
};

struct MoeOrder {
    int nunits, G, c; const LAS int* tileE;
    DEV bool next(int i, pg8::Unit& u) const {
        const int L = i * G + c; if (L >= nunits) return false;
        const int rt = L >> 2; u.pm = rt; u.pn = tileE[rt] * 4 + (L & 3); return true;
    }
    static constexpr bool GATHER = false;
    DEV void a_ready(const pg8::Unit&) const {}
    DEV void done(const pg8::Unit&) const {}
};
struct MoeOrderG {
    int nunits, G, c; const LAS int* tileE; const int* rowidx;
    static constexpr bool GATHER = true;
    DEV bool next(int i, pg8::Unit& u) const {
        const int L = i * G + c; if (L >= nunits) return false;
        const int rt = L >> 2; u.pm = rt; u.pn = tileE[rt] * 4 + (L & 3); return true;
    }
    DEV void a_ready(const pg8::Unit&) const {}
    DEV void done(const pg8::Unit&) const {}
};
struct Frame {
    LAS unsigned char* lds;
    unsigned char* ldsg;
    volatile LAS unsigned* MISC;
    gu32* ctl;
    unsigned char* ws;
    int tid, lane, wave, vcu, G;
    float* out;
};
template <class Tp> DEV Tp* wsp(const Frame& F, size_t off) { return (Tp*)(F.ws + off); }
DEV const float* inp(int i) { const float* const* ka = (const float* const*)__builtin_amdgcn_kernarg_segment_ptr(); asm volatile("" : "+s"(i)); return (const float*)(const GAS float*)ka[i]; }

template <bool FRAG = false, class Map>
DEV void tr_item(const float* W, int K, int Nsrc, const float* gain, bf16* WT, float* scr, int item, int lane, Map map) {
    const int nblk = (Nsrc + 31) >> 5, kb = item / nblk, nb = item - kb * nblk, k0 = 64 * kb, n0 = 32 * nb;
    {
        const int nq = (lane & 7) * 4; f32x4 v[8];
#pragma unroll
        for (int i = 0; i < 8; ++i) { const int kk = 8 * i + (lane >> 3);
            v[i] = (n0 + nq < Nsrc) ? *(const f32x4*)(W + (size_t)(k0 + kk) * Nsrc + n0 + nq) : (f32x4){0.f, 0.f, 0.f, 0.f}; }
#pragma unroll
        for (int i = 0; i < 8; ++i) { const int kk = 8 * i + (lane >> 3); const float g = gain ? gain[k0 + kk] : 1.0f; float* s = scr + kk * 33 + nq;
            s[0] = v[i][0] * g; s[1] = v[i][1] * g; s[2] = v[i][2] * g; s[3] = v[i][3] * g; }
    }
    LDS_WAIT();
    const int c = lane & 7;
#pragma unroll
    for (int j = 0; j < 4; ++j) {
        const int n = (lane >> 3) + 8 * j; const float* s = scr + (8 * c) * 33 + n;
        if (n0 + n < Nsrc) {
            v4u o; o.x = pk2(s[0 * 33], s[1 * 33]); o.y = pk2(s[2 * 33], s[3 * 33]); o.z = pk2(s[4 * 33], s[5 * 33]); o.w = pk2(s[6 * 33], s[7 * 33]);
            const int nn = map(n0 + n), kk = k0 + 8 * c;
            if (FRAG) *(v4u*)(WT + ((size_t)((kk >> 5) * (Nsrc >> 4) + (nn >> 4)) * 64 + ((kk >> 3) & 3) * 16 + (nn & 15)) * 8) = o;
            else *(v4u*)(WT + (size_t)nn * K + kk) = o;
        }
    }
    LDS_WAIT();
}
template <class Map>
DEV void tr_experts(const float* W, int K, int Nsrc, const float* gain, bf16* WT, bf16* scr, int gw, int NGW, int lane, Map map) {
    const int nblk = Nsrc >> 6, per_e = (K >> 6) * nblk, NIT = 32 * per_e; const size_t esz = (size_t)K * Nsrc;
#pragma unroll 1
    for (int it = gw; it < NIT; it += NGW) {
        const int e = it / per_e, sub = it - e * per_e, kb = sub / nblk, nb = sub - kb * nblk, k0 = 64 * kb, n0 = 64 * nb, nq = (lane & 15) * 4;
        const float* Wp = W + (size_t)e * esz; bf16* Wo = WT + (size_t)e * esz;
        f32x4 v[16];
#pragma unroll
        for (int i = 0; i < 16; ++i) v[i] = *(const f32x4*)(Wp + (size_t)(k0 + 4 * i + (lane >> 4)) * Nsrc + n0 + nq);
#pragma unroll
        for (int i = 0; i < 16; ++i) { const int kk = 4 * i + (lane >> 4); const float g = gain ? gain[k0 + kk] : 1.0f;
            v2u w; w.x = pk2(v[i][0] * g, v[i][1] * g); w.y = pk2(v[i][2] * g, v[i][3] * g);
            *(v2u*)(scr + kk * 68 + nq) = w; }
        LDS_WAIT();
        const int cc = lane & 7;
#pragma unroll
        for (int j = 0; j < 8; ++j) { const int n = (lane >> 3) + 8 * j; const bf16* s = scr + (8 * cc) * 68 + n;
            v4u o; o.x = (unsigned)s[0] | ((unsigned)s[68] << 16); o.y = (unsigned)s[2 * 68] | ((unsigned)s[3 * 68] << 16);
            o.z = (unsigned)s[4 * 68] | ((unsigned)s[5 * 68] << 16); o.w = (unsigned)s[6 * 68] | ((unsigned)s[7 * 68] << 16);
            *(v4u*)(Wo + (size_t)map(n0 + n) * K + k0 + 8 * cc) = o; }
        LDS_WAIT();
    }
}
struct MapId { DEV int operator()(int n) const { return n; } };
struct MapIn {
    DEV int operator()(int n) const {
        if (n < 512) { const int d = n & 63; return (n & ~63) + 2 * (d & 31) + (d >> 5); }
        if (n < 768) return n;
        if (n < 1280) { const int r = n - 768; if ((r & 255) < 128) { const int d = r & 63; return 768 + (r & ~63) + 2 * (d & 31) + (d >> 5); } return n; }
        if (n < 1304) return 3072 + (n - 1280);
        return n - 24;
    }
};
struct MapGU { DEV int operator()(int n) const { return n < 512 ? 2 * n : 2 * (n - 512) + 1; } };

DEV void convert_experts(Frame& F, int l, bf16* scr, int part, int gw_ = -1, int ngw_ = 0) {
    unsigned zl_ = 0u; asm volatile("" : "+v"(zl_)); const int lane = (int)__builtin_amdgcn_mbcnt_hi(~0u, __builtin_amdgcn_mbcnt_lo(~0u, zl_));
    const int gw = gw_ >= 0 ? gw_ : F.vcu * NWAVES + F.wave, NGW = gw_ >= 0 ? ngw_ : F.G * NWAVES;
    if (part == 0) tr_experts(inp(17) + (size_t)l * 32 * 1024 * 1024, 1024, 1024, inp(22) + l * 1024, wsp<bf16>(F, WS_WGU) + (size_t)l * 32 * 1024 * 1024, scr, gw, NGW, lane, MapGU());
    else tr_experts(inp(18) + (size_t)l * 32 * 512 * 1024, 512, 1024, nullptr, wsp<bf16>(F, WS_WDN) + (size_t)l * 32 * 1024 * 512, scr, gw, NGW, lane, MapId());
}
DEV void p0_prologue(Frame& F) {
    float* scr = (float*)(F.ldsg + F.wave * 16384);
    const int gw = F.vcu * NWAVES + F.wave, NGW = F.G * NWAVES, lane = F.lane;
    for (int l = 0; l < DEPTH; ++l) {
        { const int NIT = 16 * 97; bf16* dst = wsp<bf16>(F, WS_WIN) + (size_t)l * NIN * 1024;
          for (int it = gw; it < NIT; it += NGW) tr_item(inp(2) + (size_t)l * 1024 * IN_W, 1024, IN_W, inp(19) + l * 1024, dst, scr, it, lane, MapIn());
          for (int i = gw * 64 + lane; i < (NIN - 3096) * 1024 / 8; i += NGW * 64) ((v4u*)(dst + (size_t)3096 * 1024))[i] = (v4u){0u, 0u, 0u, 0u}; }
        { const int NIT = 16 * 32; for (int it = gw; it < NIT; it += NGW) tr_item(inp(9) + (size_t)l * 1024 * 1024, 1024, 1024, nullptr, wsp<bf16>(F, WS_WOUT) + (size_t)l * 1024 * 1024, scr, it, lane, MapId()); }
        { const int NIT = 16 * 8; for (int it = gw; it < NIT; it += NGW) tr_item(inp(10) + (size_t)l * 1024 * 256, 1024, 256, inp(20) + l * 1024, wsp<bf16>(F, WS_WQ) + (size_t)l * 256 * 1024, scr, it, lane, MapId()); }
        { const int NIT = 16 * 16; for (int it = gw; it < NIT; it += NGW) tr_item(inp(11) + (size_t)l * 1024 * 512, 1024, 512, inp(21) + l * 1024, wsp<bf16>(F, WS_WKV) + (size_t)l * 512 * 1024, scr, it, lane, MapId()); }
        { const int NIT = 4 * 32; for (int it = gw; it < NIT; it += NGW) tr_item(inp(12) + (size_t)l * 256 * 1024, 256, 1024, nullptr, wsp<bf16>(F, WS_WO) + (size_t)l * 1024 * 256, scr, it, lane, MapId()); }
        for (int kv = 0; kv < 2; ++kv) {
            { const int NIT = 32 * 4; for (int it = gw; it < NIT; it += NGW) tr_item(inp(5) + (size_t)(l * 2 + kv) * 2048 * 128, 2048, 128, nullptr, wsp<bf16>(F, WS_W1C) + (size_t)(l * 2 + kv) * 128 * 2048, scr, it, lane, MapId()); }
            { const int NIT = 2 * 2; for (int it = gw; it < NIT; it += NGW) tr_item(inp(6) + (size_t)(l * 2 + kv) * 128 * 64, 128, 64, nullptr, wsp<bf16>(F, WS_W2C) + (size_t)(l * 2 + kv) * 64 * 128, scr, it, lane, MapId()); }
        }
        if (F.G != 256) { convert_experts(F, l, (bf16*)scr, 0); convert_experts(F, l, (bf16*)scr, 1); }
        { bf16* dst = wsp<bf16>(F, WS_WR) + (size_t)l * 96 * 1024; const float* gn = inp(22) + l * 1024;
          for (int i = gw * 64 + lane; i < 48 * 1024; i += NGW * 64) { const int n = i >> 10, k = i & 1023;
            float v = 0.f; if (n < 4) v = inp(13)[(size_t)(l * 1024 + k) * 4 + n]; else if (n < 36) v = inp(15)[(size_t)(l * 1024 + k) * 32 + (n - 4)];
            v *= gn[k]; const unsigned h = f2bf(v);
            const int fo = ((((k >> 5) * 3 + (n >> 4)) * 2) * 64 + ((k >> 3) & 3) * 16 + (n & 15)) * 8 + (k & 7);
            dst[fo] = (bf16)h; dst[fo + 512] = (bf16)f2bf(v - bf2f((unsigned short)h)); } }
    }
    { bf16* wg = wsp<bf16>(F, WS_WG);
      for (int i = gw * 64 + lane; i < DEPTH * 32 * 1024; i += NGW * 64) { const int l2 = i >> 15, row = (i >> 10) & 31, k = i & 1023, hk = row >> 4, gi = row & 15;
        const float v = gi < 12 ? inp(2)[((size_t)l2 * 1024 + k) * IN_W + 1280 + hk * 12 + gi] * inp(19)[l2 * 1024 + k] : 0.f;
        wg[(l2 * 2 + hk) * 16384 + ((k >> 5) * 64 + ((k >> 3) & 3) * 16 + gi) * 8 + (k & 7)] = (bf16)f2bf(v); } }
    { float* rope = wsp<float>(F, WS_ROPE);
      for (int i = gw * 64 + lane; i < T * 32; i += NGW * 64) { const int t = i >> 5, k = i & 31;
        const float inv = powf(10000.0f, -(float)k / 32.0f); const float ang = (float)t * inv;
        rope[2 * i] = cosf(ang); rope[2 * i + 1] = sinf(ang); } }
    { float* b1 = wsp<float>(F, WS_SMALL);
      for (int i = gw * 64 + lane; i < 4 * 128; i += NGW * 64) { const int lk = i >> 7, n = i & 127;
        const float* pe = inp(4) + (size_t)lk * 2048; const float* w1 = inp(5) + (size_t)lk * 2048 * 128 + n; float s = 0.f;
        for (int kk = 0; kk < 2048; ++kk) s += pe[kk] * w1[(size_t)kk * 128];
        b1[i] = s; } }
    { bf16* HB = wsp<bf16>(F, WS_HB); float* SSQ = wsp<float>(F, WS_SSQ); bf16* MB = wsp<bf16>(F, WS_MEMB); float* SSQM = wsp<float>(F, WS_SMALL) + 1024;
      for (int m = gw; m < NTOK + NB * 256; m += NGW) {
        const bool ism = m >= NTOK; const int r = ism ? m - NTOK : m;
        const f32x4* xr = (const f32x4*)((ism ? inp(1) : inp(0)) + (size_t)r * 1024) + lane;
        unsigned long long* o8 = (unsigned long long*)((ism ? MB : HB) + (size_t)r * 1024) + lane;
        float s = 0.f;
#pragma unroll
        for (int j = 0; j < 4; ++j) { const f32x4 v = xr[64 * j]; s += (v.x * v.x + v.y * v.y) + (v.z * v.z + v.w * v.w);
            o8[64 * j] = (unsigned long long)pk2(v.x, v.y) | ((unsigned long long)pk2(v.z, v.w) << 32); }
        s = wave_sum(s);
        if (ism) { if (lane == 0) SSQM[r] = s; }
        else if (lane < 16) SSQ[(size_t)r * 16 + lane] = lane == 0 ? s : 0.f;
      } }
}

template <int NT>
DEV void skinny16(const bf16* A, size_t lda, const bf16* Bt, size_t ldb, int K, int lane, f32x4 (&acc)[NT]) {
    const int l16 = lane & 15, g4 = lane >> 4;
    const bf16* ap = A + (size_t)l16 * lda + g4 * 8; const bf16* bp = Bt + (size_t)l16 * ldb + g4 * 8;
#pragma unroll
    for (int n = 0; n < NT; ++n) acc[n] = (f32x4){0.f, 0.f, 0.f, 0.f};
#pragma unroll 2
    for (int k = 0; k < K; k += 32) {
        const bf16x8 a = *(const bf16x8*)(ap + k);
#pragma unroll
        for (int n = 0; n < NT; ++n) { const bf16x8 b = *(const bf16x8*)(bp + (size_t)n * 16 * ldb + k); acc[n] = mfma16(a, b, acc[n]); }
    }
}

DEV void memkv_phase(Frame& F) {
    const int gw = F.vcu * NWAVES + F.wave, NGW = F.G * NWAVES, lane = F.lane, l16 = lane & 15, g4 = lane >> 4;
    const bf16* MB = wsp<bf16>(F, WS_MEMB); const float* SSQM = wsp<float>(F, WS_SMALL) + 1024;
    bf16* MK = wsp<bf16>(F, WS_MK); bf16* MVT = wsp<bf16>(F, WS_MVT);
    for (int task = gw; task < 1024; task += NGW) {
        const int l2 = task >> 9, rt = (task >> 3) & 63, chunk = task & 7;
        f32x4 acc[4];
        skinny16<4>(MB + (size_t)rt * 16 * 1024, 1024, wsp<bf16>(F, WS_WKV) + ((size_t)l2 * 512 + chunk * 64) * 1024, 1024, 1024, lane, acc);
        const int b = rt >> 4, key0 = (rt & 15) * 16 + g4 * 4;
        float rs[4];
#pragma unroll
        for (int r = 0; r < 4; ++r) rs[r] = 1.0f / sqrtf(SSQM[rt * 16 + g4 * 4 + r] * (1.0f / 1024.0f) + RMS_EPS);
#pragma unroll
        for (int nt = 0; nt < 4; ++nt) {
            const int n = chunk * 64 + nt * 16 + l16;
            if (chunk < 4) { const int head = n >> 6, d = n & 63;
#pragma unroll
                for (int r = 0; r < 4; ++r) MK[(size_t)((l2 * 4 + b) * 4 + head) * 256 * 64 + kfrag_off(key0 + r, d)] = (bf16)f2bf(acc[nt][r] * rs[r]);
            } else { const int n2 = n - 256, head = n2 >> 6, d = n2 & 63;
                v2u w; w.x = pk2(acc[nt][0] * rs[0], acc[nt][1] * rs[1]); w.y = pk2(acc[nt][2] * rs[2], acc[nt][3] * rs[3]);
                *(v2u*)(MVT + (((size_t)((l2 * 4 + b) * 4 + head) * 8 + (key0 >> 5)) * 64 + d) * 32 + slot32(key0 & 31)) = w; }
        }
    }
}

DEV void compress_phase(Frame& F, int l) {
    const int lane = F.lane, l16 = lane & 15, g4 = lane >> 4, quad = F.wave >> 2, q = F.wave & 3;
    float* part = (float*)F.ldsg + quad * (4 * 16 * 128);
    const bf16* KCR = wsp<bf16>(F, WS_KCR); const bf16* VCR = wsp<bf16>(F, WS_VCR);
    bf16* KCC = wsp<bf16>(F, WS_KCC); bf16* VCT = wsp<bf16>(F, WS_VCT);
    const float* bias1 = wsp<float>(F, WS_SMALL);
    for (int tk0 = F.vcu * 2; tk0 < 512; tk0 += F.G * 2) {
        const int tk = tk0 + quad; const int kv = tk >> 8, tile = tk & 255;
        const bf16* raw = kv ? VCR : KCR;
        const bf16* w1 = wsp<bf16>(F, WS_W1C) + (size_t)(l * 2 + kv) * 128 * 2048;
        const bf16* w2 = wsp<bf16>(F, WS_W2C) + (size_t)(l * 2 + kv) * 64 * 128;
        { const int r = tile * 16 + l16, bh = r >> 9, c = r & 511, b = bh >> 1, hkv = bh & 1;
          f32x4 acc[8];
#pragma unroll
          for (int n = 0; n < 8; ++n) acc[n] = (f32x4){0.f, 0.f, 0.f, 0.f};
#pragma unroll 2
          for (int ks = q * 16; ks < q * 16 + 16; ++ks) {
              const int kk = ks * 32 + g4 * 8, ll = kk >> 6, d = kk & 63;
              int tok = 16 * c + ll; tok = tok > T - 1 ? T - 1 : tok;
              const bf16x8 a = *(const bf16x8*)(raw + ((size_t)b * T + tok) * 128 + hkv * 64 + d);
#pragma unroll
              for (int n = 0; n < 8; ++n) { const bf16x8 bb = *(const bf16x8*)(w1 + (size_t)(n * 16 + l16) * 2048 + kk); acc[n] = mfma16(a, bb, acc[n]); }
          }
#pragma unroll
          for (int n = 0; n < 8; ++n)
#pragma unroll
              for (int r2 = 0; r2 < 4; ++r2) part[(q * 16 + g4 * 4 + r2) * 128 + n * 16 + l16] = acc[n][r2];
        }
        __syncthreads();
        { f32x4 o = (f32x4){0.f, 0.f, 0.f, 0.f};
#pragma unroll
          for (int k2 = 0; k2 < 4; ++k2) {
              const int h0 = k2 * 32 + g4 * 8;
              float hv[8];
#pragma unroll
              for (int j = 0; j < 8; ++j) { float s = bias1[(l * 2 + kv) * 128 + h0 + j];
#pragma unroll
                  for (int p = 0; p < 4; ++p) s += part[(p * 16 + l16) * 128 + h0 + j];
                  hv[j] = siluf_(s); }
              bf16x8 a; { v4u w; w.x = pk2(hv[0], hv[1]); w.y = pk2(hv[2], hv[3]); w.z = pk2(hv[4], hv[5]); w.w = pk2(hv[6], hv[7]); a = __builtin_bit_cast(bf16x8, w); }
              const bf16x8 bb = *(const bf16x8*)(w2 + (size_t)(q * 16 + l16) * 128 + h0);
              o = mfma16(a, bb, o);
          }
          const int r0 = tile * 16 + g4 * 4, bh = r0 >> 9, c0 = r0 & 511, d = q * 16 + l16;
          if (kv == 0) {
#pragma unroll
              for (int r2 = 0; r2 < 4; ++r2) KCC[(size_t)bh * 512 * 64 + kfrag_off(c0 + r2, d)] = (c0 + r2 == 511) ? (bf16)0 : (bf16)f2bf(o[r2]);
          } else {
              v2u w; w.x = pk2(o[0], o[1]); w.y = pk2(o[2], (c0 + 3 == 511) ? 0.f : o[3]);
              *(v2u*)(VCT + (((size_t)bh * 16 + (c0 >> 5)) * 64 + d) * 32 + slot32(c0 & 31)) = w;
          }
        }
        __syncthreads();
    }
}

DEV float hgrn_lb(const Frame& F, int l, int c) {
    if (l == 0) return 0.f;
    const float a = inp(7)[c], b = inp(7)[256 + c];
    return 1.0f / (1.0f + expf(a - b));
}
DEV float hgrn_logf(float z, float lb) {
    const float la = logf(fmaxf(lb, 1e-30f));
    const float ls = fminf(z, 0.f) - log1pf(expf(-fabsf(z)));
    const float lc = log1pf(-lb) + ls;
    const float mx = fmaxf(la, lc), mn = fminf(la, lc);
    return mx + log1pf(expf(mn - mx));
}
constexpr int HS = 68;
DEV f32x4 mfma4(float a, float b, f32x4 c) { return __builtin_amdgcn_mfma_f32_16x16x4f32(a, b, c, 0, 0, 0); }
DEV void hgrn_setup_chunk(Frame& F, float lb, const float (&z)[8], float* Bc, float* Kc, float* tot) {
    const int d = F.tid & 63, sg = F.tid >> 6;
    const float la = logf(fmaxf(lb, 1e-30f)), l1m = log1pf(-lb), onem = 1.0f - lb;
    float loc[8], kv[8]; float run = 0.f;
#pragma unroll
    for (int i = 0; i < 8; ++i) {
        const float ez = __expf(-fabsf(z[i]));
        const float lc = l1m + (fminf(z[i], 0.f) - __logf(1.0f + ez));
        const float mx = fmaxf(la, lc), mn = fminf(la, lc);
        run += mx + __logf(1.0f + __expf(mn - mx)); loc[i] = run;
        kv[i] = onem * (z[i] >= 0.f ? ez : 1.0f) / (1.0f + ez);
    }
    tot[sg * 64 + d] = run;
    __syncthreads();
    float off = 0.f;
    for (int g = 0; g < sg; ++g) off += tot[g * 64 + d];
#pragma unroll
    for (int i = 0; i < 8; ++i) { Bc[(sg * 8 + i) * HS + d] = off + loc[i]; Kc[(sg * 8 + i) * HS + d] = kv[i]; }
    __syncthreads();
}
DEV void hgrn_local_phase(Frame& F, int l) {
    float* Bc = (float*)F.ldsg; float* Kc = Bc + 64 * HS; float* Vc = Kc + 64 * HS; float* tot = Vc + 64 * HS;
    bf16* U = wsp<bf16>(F, WS_U); float* DEC = wsp<float>(F, WS_DEC);
    const int lane = F.lane, w = F.wave, li = lane & 15, kq = lane >> 4;
    for (int task = F.vcu; task < 2048; task += F.G) {
        const int bh = task >> 7, ch = task & 127, b = bh >> 2, h = bh & 3;
        { const int d = F.tid & 63, sg = F.tid >> 6;
          const size_t go = ((size_t)b * T + ch * 64 + sg * 8) * 256 + h * 64 + d;
          const float* HFp = wsp<float>(F, WS_HF) + go; const bf16* HIp = wsp<bf16>(F, WS_HI) + go;
          float z[8], vi[8];
#pragma unroll
          for (int i = 0; i < 8; ++i) { z[i] = HFp[(size_t)i * 256]; vi[i] = bf2f(HIp[(size_t)i * 256]); }
          hgrn_setup_chunk(F, hgrn_lb(F, l, h * 64 + d), z, Bc, Kc, tot);
          const float bl = Bc[63 * HS + d];
#pragma unroll
          for (int i = 0; i < 8; ++i) { const int s = sg * 8 + i; Kc[s * HS + d] *= __expf(bl - Bc[s * HS + d]); Vc[s * HS + d] = vi[i]; }
          if (sg == 0) DEC[(size_t)task * 64 + d] = expf(bl); }
        __syncthreads();
        { const int dI = w >> 1, e0 = (w & 1) * 32;
          f32x4 a0 = (f32x4){0.f, 0.f, 0.f, 0.f}, a1 = a0;
#pragma unroll 4
          for (int k0 = 0; k0 < 64; k0 += 4) { const int s = k0 + kq;
              const float a = Kc[s * HS + dI * 16 + li], b0 = Vc[s * HS + e0 + li], b1 = Vc[s * HS + e0 + 16 + li];
              a0 = mfma4(a, b0, a0); a1 = mfma4(a, b1, a1); }
#pragma unroll
          for (int r = 0; r < 4; ++r) { bf16* up = U + ((size_t)task * 64 + dI * 16 + 4 * kq + r) * 64 + e0 + li; up[0] = (bf16)f2bf(a0[r]); up[16] = (bf16)f2bf(a1[r]); } }
        __syncthreads();
    }
}
DEV void hgrn_scan_phase(Frame& F, int probe = 0) {
    const bf16* U = wsp<bf16>(F, WS_U); bf16* U2 = wsp<bf16>(F, probe ? WS_PROBE : WS_U2); const float* DEC = wsp<float>(F, WS_DEC);
    const int nact = (F.G * 256 >= 65536) ? 256 : 512;
    if (F.tid < nact)
    for (int gid = F.vcu * nact + F.tid; gid < 65536; gid += F.G * nact) {
        const int bh = gid >> 12, de = gid & 4095, d = de >> 6;
        float S = 0.f; const bf16* up = U + (size_t)bh * 128 * 4096 + de; bf16* op = U2 + (size_t)bh * 128 * 4096 + de; const float* dp = DEC + (size_t)bh * 128 * 64 + d;
#pragma unroll 16
        for (int ch = 0; ch < 128; ++ch) { const float u = bf2f(up[(size_t)ch * 4096]); const float dc = dp[ch * 64]; op[(size_t)ch * 4096] = (bf16)f2bf(S); S = dc * S + u; }
    }
}
DEV void hgrn_out_phase(Frame& F, int l) {
    float* Bc = (float*)F.ldsg; float* Kb = Bc + 64 * HS; float* Vc = Kb + 64 * HS; float* Qs = Vc + 64 * HS; float* Sc = Qs + 64 * HS; float* Ac = Sc + 64 * HS; float* tot = Ac + 64 * HS;
    float* Oc = Kb;
    const bf16* U = wsp<bf16>(F, WS_U2); bf16* CAT = wsp<bf16>(F, WS_CAT);
    const int lane = F.lane, w = F.wave, li = lane & 15, kq = lane >> 4;
    for (int task = F.vcu; task < 2048; task += F.G) {
        const int bh = task >> 7, ch = task & 127, b = bh >> 2, h = bh & 3;
        float gv[8];
        { const int d = F.tid & 63, sg = F.tid >> 6;
          const size_t go = ((size_t)b * T + ch * 64 + sg * 8) * 256 + h * 64 + d;
          const float* HFp = wsp<float>(F, WS_HF) + go; const bf16* HIp = wsp<bf16>(F, WS_HI) + go; const bf16* HQp = wsp<bf16>(F, WS_HQ) + go; const bf16* HGp = wsp<bf16>(F, WS_HG) + go;
          const bf16* Up = U + ((size_t)task * 64 + sg * 8) * 64 + d;
          float z[8], vi[8], qi[8], si[8];
#pragma unroll
          for (int i = 0; i < 8; ++i) { z[i] = HFp[(size_t)i * 256]; vi[i] = bf2f(HIp[(size_t)i * 256]); qi[i] = bf2f(HQp[(size_t)i * 256]); gv[i] = bf2f(HGp[(size_t)i * 256]); si[i] = bf2f(Up[(size_t)i * 64]); }
          hgrn_setup_chunk(F, hgrn_lb(F, l, h * 64 + d), z, Bc, Kb, tot);
#pragma unroll
          for (int i = 0; i < 8; ++i) { const int s = sg * 8 + i, J = s >> 4; const float rJ = J ? Bc[(16 * J - 1) * HS + d] : 0.f;
              Kb[s * HS + d] *= __expf(fminf(rJ - Bc[s * HS + d], 80.f));
              Vc[s * HS + d] = vi[i]; Qs[s * HS + d] = qi[i] * 0.125f; Sc[s * HS + d] = si[i]; } }
        __syncthreads();
#pragma unroll 1
        for (int ti = w; ti < 10; ti += 8) {
            const int I = ti < 1 ? 0 : (ti < 3 ? 1 : (ti < 6 ? 2 : 3)), J = ti - (I * (I + 1)) / 2;
            const int t = I * 16 + li; f32x4 acc = (f32x4){0.f, 0.f, 0.f, 0.f};
#pragma unroll 4
            for (int k0 = 0; k0 < 64; k0 += 4) { const int d = k0 + kq; const float rJ = J ? Bc[(16 * J - 1) * HS + d] : 0.f;
                const float a = Qs[t * HS + d] * __expf(Bc[t * HS + d] - rJ), bb = Kb[(J * 16 + li) * HS + d];
                acc = mfma4(a, bb, acc); }
#pragma unroll
            for (int r = 0; r < 4; ++r) { const int tt = I * 16 + 4 * kq + r, ss = J * 16 + li; Ac[tt * HS + ss] = (ss <= tt) ? acc[r] : 0.f; }
        }
        __syncthreads();
        { const int I = w >> 1, e0 = (w & 1) * 32, t = I * 16 + li;
          f32x4 a0 = (f32x4){0.f, 0.f, 0.f, 0.f}, a1 = a0;
#pragma unroll 4
          for (int k0 = 0; k0 < 64; k0 += 4) { const int d = k0 + kq;
              const float a = Qs[t * HS + d] * __expf(Bc[t * HS + d]), b0 = Sc[d * HS + e0 + li], b1 = Sc[d * HS + e0 + 16 + li];
              a0 = mfma4(a, b0, a0); a1 = mfma4(a, b1, a1); }
#pragma unroll 1
          for (int s0 = 0; s0 < 16 * (I + 1); s0 += 4) { const int s = s0 + kq;
              const float a = Ac[t * HS + s], b0 = Vc[s * HS + e0 + li], b1 = Vc[s * HS + e0 + 16 + li];
              a0 = mfma4(a, b0, a0); a1 = mfma4(a, b1, a1); }
#pragma unroll
          for (int r = 0; r < 4; ++r) { float* op = Oc + (I * 16 + 4 * kq + r) * HS + e0 + li; op[0] = a0[r]; op[16] = a1[r]; } }
        __syncthreads();
        { const float ng = inp(8)[l * 256 + h * 64 + lane];
          { const int t = w * 8 + (lane >> 3); const float* op = Oc + t * HS + (lane & 7) * 8; float s = 0.f;
#pragma unroll
            for (int j = 0; j < 8; ++j) s += op[j] * op[j];
            s += __shfl_xor(s, 1); s += __shfl_xor(s, 2); s += __shfl_xor(s, 4);
            if ((lane & 7) == 0) tot[t] = 1.0f / sqrtf(s * (1.0f / 64.0f) + RMS_EPS); }
          LDS_WAIT();
#pragma unroll
          for (int i = 0; i < 8; ++i) { const int t = w * 8 + i; const float o = Oc[t * HS + lane];
              const size_t row = (size_t)b * T + ch * 64 + t;
              CAT[row * 1024 + 768 + h * 64 + lane] = (bf16)f2bf(o * tot[t] * ng * siluf_(gv[i])); } }
        __syncthreads();
    }
}

DEV void conv_phase(Frame& F, int l) {
    const bf16* CB = wsp<bf16>(F, WS_CB); const bf16* CC = wsp<bf16>(F, WS_CC); const bf16* CH = wsp<bf16>(F, WS_CH); bf16* CAT = wsp<bf16>(F, WS_CAT);
    const float* cw = inp(3) + l * 3 * 256;
    for (int it = F.vcu * 512 + F.tid; it < NTOK * 32; it += F.G * 512) {
        const int m = it >> 5, c0 = (it & 31) * 8, t = m & (T - 1);
        const v4u bb = *(const v4u*)(CB + (size_t)m * 256 + c0);
        float y[8];
#pragma unroll
        for (int j = 0; j < 8; ++j) y[j] = 0.f;
#pragma unroll
        for (int k = 0; k < 3; ++k) {
            if (t + k - 2 >= 0) {
                const size_t o = (size_t)(m + k - 2) * 256 + c0;
                const v4u cc = *(const v4u*)(CC + o), hh = *(const v4u*)(CH + o);
#pragma unroll
                for (int j = 0; j < 4; ++j) { const float w0 = cw[k * 256 + c0 + 2 * j], w1 = cw[k * 256 + c0 + 2 * j + 1];
                    y[2 * j] += w0 * (bflo(cc[j]) * bflo(hh[j])); y[2 * j + 1] += w1 * (bfhi(cc[j]) * bfhi(hh[j])); }
            }
        }
        v4u o4;
#pragma unroll
        for (int j = 0; j < 4; ++j) o4[j] = pk2(bflo(bb[j]) * y[2 * j], bfhi(bb[j]) * y[2 * j + 1]);
        *(v4u*)(CAT + (size_t)m * 1024 + 512 + c0) = o4;
    }
}
struct SmState { float m, l; f32x4 o[4]; };
DEV void sm_reset(SmState& st) { st.m = -INFINITY; st.l = 0.f;
#pragma unroll
    for (int i = 0; i < 4; ++i) st.o[i] = (f32x4){0.f, 0.f, 0.f, 0.f}; }
DEV float sm_lsum(const SmState& st) { float l = st.l; l += __shfl_xor(l, 16); l += __shfl_xor(l, 32); return l; }
DEV void load_k(const bf16* kbase, int lane, bf16x8 (&kf)[2][2]) {
#pragma unroll
    for (int tt = 0; tt < 2; ++tt)
#pragma unroll
        for (int ks = 0; ks < 2; ++ks) kf[tt][ks] = *(const bf16x8*)(kbase + lane * 8 + (tt * 2 + ks) * 512);
}
DEV void load_v(const bf16* vbase, int lane, bf16x8 (&vf)[4]) {
    const int l16 = lane & 15, g4 = lane >> 4;
#pragma unroll
    for (int dt = 0; dt < 4; ++dt) vf[dt] = *(const bf16x8*)(vbase + (size_t)(dt * 16 + l16) * 32 + g4 * 8);
}
DEV void qk_tile(const bf16x8 (&kf)[2][2], const bf16x8 (&qf)[2], f32x4 (&s)[2]) {
#pragma unroll
    for (int tt = 0; tt < 2; ++tt) { s[tt] = mfma16(kf[tt][0], qf[0], (f32x4){0.f, 0.f, 0.f, 0.f}); s[tt] = mfma16(kf[tt][1], qf[1], s[tt]); }
}
DEV bf16x8 pack_p(const float (&p)[2][4]) {
    v4u w; w.x = pk2(p[0][0], p[0][1]); w.y = pk2(p[0][2], p[0][3]); w.z = pk2(p[1][0], p[1][1]); w.w = pk2(p[1][2], p[1][3]);
    return __builtin_bit_cast(bf16x8, w);
}
template <int MODE, class MaskF>
DEV void attn_compute(const bf16x8 (&kf)[2][2], const bf16x8 (&vf)[4], const bf16x8 (&qf)[2], SmState& st, int lane, bool colok, MaskF mask) {
    const int g4 = lane >> 4;
    f32x4 s[2]; qk_tile(kf, qf, s);
    float sv[2][4]; float tmax = -INFINITY;
#pragma unroll
    for (int tt = 0; tt < 2; ++tt)
#pragma unroll
        for (int r = 0; r < 4; ++r) { float x = s[tt][r]; if (MODE == 2) x = mask(16 * tt + 4 * g4 + r) ? x : -INFINITY; sv[tt][r] = x; tmax = fmaxf(tmax, x); }
    if (MODE == 1) tmax = colok ? tmax : -INFINITY;
    tmax = fmaxf(tmax, __shfl_xor(tmax, 16)); tmax = fmaxf(tmax, __shfl_xor(tmax, 32));
    const float mnew = fmaxf(st.m, tmax), muse = (mnew == -INFINITY) ? 0.f : mnew;
    const float alpha = ex2(st.m - muse);
    const float msub = (MODE == 1) ? (colok ? muse : INFINITY) : muse;
    float p[2][4]; float ps = 0.f;
#pragma unroll
    for (int tt = 0; tt < 2; ++tt)
#pragma unroll
        for (int r = 0; r < 4; ++r) { p[tt][r] = ex2(sv[tt][r] - msub); ps += p[tt][r]; }
    st.l = st.l * alpha + ps; st.m = mnew;
    const bf16x8 pf = pack_p(p);
#pragma unroll
    for (int dt = 0; dt < 4; ++dt) { st.o[dt] = st.o[dt] * alpha; st.o[dt] = mfma16(vf[dt], pf, st.o[dt]); }
}
template <int MODE, class MaskF>
DEV void attn_compute_fixed(const bf16x8 (&kf)[2][2], const bf16x8 (&vf)[4], const bf16x8 (&qf)[2], SmState& st, float mref, int lane, bool colok, MaskF mask) {
    const int g4 = lane >> 4;
    const float c0 = (MODE == 1) ? (colok ? -mref : -INFINITY) : -mref;
    const f32x4 ci = {c0, c0, c0, c0};
    f32x4 s[2];
#pragma unroll
    for (int tt = 0; tt < 2; ++tt) { s[tt] = mfma16(kf[tt][0], qf[0], ci); s[tt] = mfma16(kf[tt][1], qf[1], s[tt]); }
    float p[2][4];
#pragma unroll
    for (int tt = 0; tt < 2; ++tt)
#pragma unroll
        for (int r = 0; r < 4; ++r) { float x = s[tt][r]; if (MODE == 2) x = mask(16 * tt + 4 * g4 + r) ? x : -INFINITY; p[tt][r] = ex2(x); }
    st.l += ((p[0][0] + p[0][1]) + (p[0][2] + p[0][3])) + ((p[1][0] + p[1][1]) + (p[1][2] + p[1][3]));
    const bf16x8 pf = pack_p(p);
#pragma unroll
    for (int dt = 0; dt < 4; ++dt) st.o[dt] = mfma16(vf[dt], pf, st.o[dt]);
}
template <int MODE, class MaskF>
DEV void attn_max(const bf16x8 (&kf)[2][2], const bf16x8 (&qf)[2], float& mx, int lane, bool colok, MaskF mask) {
    const int g4 = lane >> 4;
    f32x4 s[2]; qk_tile(kf, qf, s);
    float tmax = -INFINITY;
#pragma unroll
    for (int tt = 0; tt < 2; ++tt)
#pragma unroll
        for (int r = 0; r < 4; ++r) { float x = s[tt][r]; if (MODE == 2) x = mask(16 * tt + 4 * g4 + r) ? x : -INFINITY; tmax = fmaxf(tmax, x); }
    if (MODE == 1) tmax = colok ? tmax : -INFINITY;
    mx = fmaxf(mx, tmax);
}
DEV float colmax_finish(float mx) { mx = fmaxf(mx, __shfl_xor(mx, 16)); mx = fmaxf(mx, __shfl_xor(mx, 32)); return mx == -INFINITY ? 0.f : mx; }
DEV float col_norm(const bf16x8 (&qf)[2]) {
    float s = 0.f;
#pragma unroll
    for (int ks = 0; ks < 2; ++ks) { const v4u w = __builtin_bit_cast(v4u, qf[ks]);
#pragma unroll
        for (int j = 0; j < 4; ++j) { const float a = bflo(w[j]), b = bfhi(w[j]); s += a * a + b * b; } }
    s += __shfl_xor(s, 16); s += __shfl_xor(s, 32);
    return sqrtf(s);
}
DEV float wave_max_uniform(float v) {
#pragma unroll
    for (int o = 1; o < 64; o <<= 1) v = fmaxf(v, __shfl_xor(v, o));
    return __builtin_bit_cast(float, __builtin_amdgcn_readfirstlane(__builtin_bit_cast(int, v)));
}
constexpr float FIXED_REF_MAX = 40.f;
DEV void kmax_phase(Frame& F, int l) {
    const int lane = F.lane; const int gw = F.vcu * NWAVES + F.wave, NGW = F.G * NWAVES;
    for (int item = gw; item < 2048; item += NGW) {
        const int br = item >> 10, bh = (item >> 7) & 7, key = (item & 127) * 64 + lane;
        const bf16* kp = wsp<bf16>(F, br ? WS_KW : WS_KS) + (size_t)bh * T * 64;
        float s = 0.f;
#pragma unroll
        for (int i = 0; i < 8; ++i) { const v4u w = *(const v4u*)(kp + kfrag_off(key, i * 8));
#pragma unroll
            for (int j = 0; j < 4; ++j) { const float a = bflo(w[j]), b = bfhi(w[j]); s += a * a + b * b; } }
#pragma unroll
        for (int o = 1; o < 64; o <<= 1) s = fmaxf(s, __shfl_xor(s, o));
        if (lane == 0) __hip_atomic_fetch_max((unsigned*)F.ctl + CW_KMAX + l * 16 + br * 8 + bh, __builtin_bit_cast(unsigned, s), RLX_AGENT);
    }
}
struct NoMask { DEV bool operator()(int) const { return true; } };
template <int D, bool WITHV, class AddrF, class BodyF>
DEV void pipe_run(int n, int lane, AddrF addr, BodyF body) {
    if (n <= 0) return;
    bf16x8 kf[D][2][2], vf[D][4];
#pragma unroll
    for (int d = 0; d < D; ++d) { const bf16* kb; const bf16* vb; addr(d < n ? d : n - 1, kb, vb); load_k(kb, lane, kf[d]); if (WITHV) load_v(vb, lane, vf[d]); }
#pragma unroll 1
    for (int i = 0; i < n; i += D) {
#pragma unroll
        for (int d = 0; d < D; ++d) { const int s = i + d;
            if (s < n) body(s, kf[d], vf[d]);
            if (D > 1 || s + 1 < n) { const bf16* kb; const bf16* vb; addr(s + D < n ? s + D : n - 1, kb, vb); load_k(kb, lane, kf[d]); if (WITHV) load_v(vb, lane, vf[d]); } }
    }
}
template <class AddrF, class BodyF>
DEV void pipe_run_k2(int n, int lane, AddrF addr, BodyF body) {
    if (n <= 0) return;
    bf16x8 kf[2][2][2], vf[4];
    { const bf16* kb; const bf16* vb; addr(0, kb, vb); load_k(kb, lane, kf[0]); }
#pragma unroll 1
    for (int i = 0; i < n; i += 2) {
#pragma unroll
        for (int d = 0; d < 2; ++d) { const int s = i + d;
            { const bf16* kb; const bf16* vb; addr(s < n ? s : n - 1, kb, vb); load_v(vb, lane, vf); }
            { const bf16* kb; const bf16* vb; addr(s + 1 < n ? s + 1 : n - 1, kb, vb); load_k(kb, lane, kf[d ^ 1]); }
            if (s < n) body(s, kf[d], vf); }
    }
}
template <class AddrF, class BodyA, class BodyB>
DEV void pipe_run_mt(int n_main, int n_tail, int lane, AddrF addr, BodyA mainb, BodyB tailb) {
    const int n = n_main + n_tail;
    bf16x8 kf[2][2][2], vf[4];
    { const bf16* kb; const bf16* vb; addr(0, kb, vb); load_k(kb, lane, kf[0]); }
    int i = 0;
#define PIPE_STEP_(s_, d_, BODY_) do { { const bf16* kb; const bf16* vb; addr((s_) < n ? (s_) : n - 1, kb, vb); load_v(vb, lane, vf); } \
        { const bf16* kb; const bf16* vb; addr((s_) + 1 < n ? (s_) + 1 : n - 1, kb, vb); load_k(kb, lane, kf[(d_) ^ 1]); } BODY_((s_), kf[d_], vf); } while (0)
#pragma unroll 1
    for (; i + 2 <= n_main; i += 2) { PIPE_STEP_(i, 0, mainb); PIPE_STEP_(i + 1, 1, mainb); }
    if (i < n_main) { PIPE_STEP_(i, 0, mainb); ++i;
#pragma unroll
        for (int a = 0; a < 2; ++a)
#pragma unroll
            for (int b = 0; b < 2; ++b) kf[0][a][b] = kf[1][a][b]; }
#pragma unroll 1
    for (; i < n; ++i) { PIPE_STEP_(i, 0, tailb);
#pragma unroll
        for (int a = 0; a < 2; ++a)
#pragma unroll
            for (int b = 0; b < 2; ++b) kf[0][a][b] = kf[1][a][b]; }
#undef PIPE_STEP_
}
constexpr int PIPE_D = 2;

DEV void acc_add_packed(unsigned (&pk)[4][4][2], int ct, const f32x4 (&o)[4], float sc, bool first) {
#pragma unroll
    for (int dt = 0; dt < 4; ++dt) {
        f32x4 v = o[dt] * sc;
        if (!first) { v[0] += bflo(pk[ct][dt][0]); v[1] += bfhi(pk[ct][dt][0]); v[2] += bflo(pk[ct][dt][1]); v[3] += bfhi(pk[ct][dt][1]); }
        pk[ct][dt][0] = pk2(v[0], v[1]); pk[ct][dt][1] = pk2(v[2], v[3]);
    }
}
template <int VAR>
DEV void nsa_phase_t(Frame& F, int l) {
#define NSA_RELANE() int ln_ = lane; asm volatile("" : "+v"(ln_)); const int l16 = ln_ & 15, g4 = ln_ >> 4, tq = l16 >> 2, gh = l16 & 3; const size_t mrow0 = (size_t)b * T + t0 + tq; const int tl0 = t0 + tq; (void)l16; (void)g4; (void)gh; (void)mrow0; (void)tl0
    float* IMP = (float*)(F.ldsg + F.wave * NSA_LDS_WAVE);
    float* VALS = IMP + 2048; int* BL = (int*)(IMP + 2176); unsigned* SELB = (unsigned*)(IMP + 2304); float* GL = IMP + 2432;
    const bf16* Q = wsp<bf16>(F, WS_Q);
    const bf16* KCC = wsp<bf16>(F, WS_KCC); const bf16* VCT = wsp<bf16>(F, WS_VCT);
    const bf16* KS = wsp<bf16>(F, WS_KS); const bf16* VST = wsp<bf16>(F, WS_VST);
    const bf16* KW = wsp<bf16>(F, WS_KW); const bf16* VWT = wsp<bf16>(F, WS_VWT);
    bf16* CAT = wsp<bf16>(F, WS_CAT);
    const int gw = F.vcu * NWAVES + F.wave, NGW = F.G * NWAVES;
    const bool xmap = (F.G == 256);
#pragma unroll 1
    for (int task = gw; task < 4096; task += NGW) {
        unsigned zl_ = 0u; asm volatile("" : "+v"(zl_)); const int lane = (int)__builtin_amdgcn_mbcnt_hi(~0u, __builtin_amdgcn_mbcnt_lo(~0u, zl_));
        const int u_ = (F.wave < 4) ? (F.vcu & 31) : 63 - (F.vcu & 31), first_ = 4 * u_ + (F.wave & 3);
        const int bh = xmap ? (gw >> 8) : (task & 7), idx = xmap ? ((task >> 11) ? 511 - first_ : first_) : (task >> 3);
        const int t0 = idx * 16, b = bh >> 1, hkv = bh & 1, cur = t0 >> 6;
        bf16x8 qf[4][2];
        unsigned opk[4][4][2];
        SmState st[4];
        float qnmax = 0.f;
        { NSA_RELANE();
#pragma unroll
        for (int ct = 0; ct < 4; ++ct)
#pragma unroll
            for (int ks = 0; ks < 2; ++ks) qf[ct][ks] = *(const bf16x8*)(Q + (mrow0 + 4 * ct) * 512 + hkv * 256 + gh * 64 + ks * 32 + g4 * 8);
        { NSA_RELANE();
          f32x4 ga[1]; ga[0] = (f32x4){0.f, 0.f, 0.f, 0.f};
          { const bf16* ap = wsp<bf16>(F, WS_HB) + ((size_t)b * T + t0 + l16) * 1024 + g4 * 8; const bf16* bp = wsp<bf16>(F, WS_WG) + (size_t)(l * 2 + hkv) * 16384 + ln_ * 8;
#pragma unroll 1
            for (int k0 = 0; k0 < (VAR == 11 ? 0 : 1024); k0 += 256) {
                bf16x8 av[8], bv[8];
#pragma unroll
                for (int i = 0; i < 8; ++i) { av[i] = *(const bf16x8*)(ap + k0 + 32 * i); bv[i] = *(const bf16x8*)(bp + (k0 + 32 * i) * 16); }
#pragma unroll
                for (int i = 0; i < 8; ++i) ga[0] = mfma16(av[i], bv[i], ga[0]);
            } }
          const float rs = (ln_ < 16) ? row_rstd_full(wsp<float>(F, WS_SSQ), b * T + t0 + ln_) : 0.f;
#pragma unroll
          for (int r = 0; r < 4; ++r) GL[(g4 * 4 + r) * 16 + l16] = sigmoidf_(ga[0][r] * __shfl(rs, g4 * 4 + r));
        }
        const int ngc = (VAR == 10 || VAR == 12) ? 0 : (t0 + 15 >= 31) ? (((t0 + 15 - 31) >> 4) >> 5) + 1 : 0;
        const bf16* kcb = KCC + (size_t)bh * 512 * 64; const bf16* vcb = VCT + (size_t)bh * 16 * 64 * 32;
        float cm[4], cl[4];
#pragma unroll
        for (int ct = 0; ct < 4; ++ct) { cm[ct] = -INFINITY; cl[ct] = 0.f; }
        pipe_run<1, false>(ngc, ln_, [&](int s, const bf16*& kb, const bf16*& vb) { kb = kcb + (size_t)s * 32 * 64; vb = vcb; },
            [&](int kg, const bf16x8 (&kf)[2][2], const bf16x8 (&)[4]) {
#pragma unroll
                for (int ct = 0; ct < 4; ++ct) {
                    const int tl = tl0 + 4 * ct;
                    f32x4 s[2]; qk_tile(kf, qf[ct], s);
                    float sv[2][4]; float tmax = -INFINITY;
#pragma unroll
                    for (int tt = 0; tt < 2; ++tt)
#pragma unroll
                        for (int r = 0; r < 4; ++r) { const int c = kg * 32 + 16 * tt + 4 * g4 + r; sv[tt][r] = (16 * c + 31 <= tl) ? s[tt][r] : -INFINITY; tmax = fmaxf(tmax, sv[tt][r]); }
                    tmax = fmaxf(tmax, __shfl_xor(tmax, 16)); tmax = fmaxf(tmax, __shfl_xor(tmax, 32));
                    const float mnew = fmaxf(cm[ct], tmax), muse = (mnew == -INFINITY) ? 0.f : mnew;
                    float ps = 0.f;
#pragma unroll
                    for (int tt = 0; tt < 2; ++tt)
#pragma unroll
                        for (int r = 0; r < 4; ++r) ps += ex2(sv[tt][r] - muse);
                    cl[ct] = cl[ct] * ex2(cm[ct] - muse) + ps; cm[ct] = mnew;
                }
            });
        {
            float cmu[4], cinv[4], carry[4];
#pragma unroll
            for (int ct = 0; ct < 4; ++ct) { float l = cl[ct]; l += __shfl_xor(l, 16); l += __shfl_xor(l, 32);
                cmu[ct] = (cm[ct] == -INFINITY) ? 0.f : cm[ct]; cinv[ct] = l > 0.f ? 1.0f / l : 0.f; carry[ct] = 0.f; sm_reset(st[ct]); }
            pipe_run<1, true>(ngc, ln_, [&](int s, const bf16*& kb, const bf16*& vb) { kb = kcb + (size_t)s * 32 * 64; vb = vcb + (size_t)s * 64 * 32; },
                [&](int kg, const bf16x8 (&kf)[2][2], const bf16x8 (&vf)[4]) {
#pragma unroll
                    for (int ct = 0; ct < 4; ++ct) {
                        const int tl = tl0 + 4 * ct;
                        f32x4 s[2]; qk_tile(kf, qf[ct], s);
                        float p[2][4];
#pragma unroll
                        for (int tt = 0; tt < 2; ++tt) {
#pragma unroll
                            for (int r = 0; r < 4; ++r) { const int c = kg * 32 + 16 * tt + 4 * g4 + r; p[tt][r] = (16 * c + 31 <= tl) ? ex2(s[tt][r] - cmu[ct]) * cinv[ct] : 0.f; }
                            const float hb = 0.5f * p[tt][3];
                            const float bsh = __shfl(hb, (ln_ + 48) & 63);
                            float v = ((p[tt][0] + p[tt][1]) + (p[tt][2] + hb)) + ((g4 == 0) ? carry[ct] : bsh);
                            carry[ct] = bsh;
                            v += __shfl_xor(v, 1); v += __shfl_xor(v, 2);
                            if (gh == 0) IMP[(4 * ct + tq) * 128 + kg * 8 + 4 * tt + g4] = v;
                        }
                        const bf16x8 pf = pack_p(p);
#pragma unroll
                        for (int dt = 0; dt < 4; ++dt) st[ct].o[dt] = mfma16(vf[dt], pf, st[ct].o[dt]);
                    }
                });
#pragma unroll
            for (int ct = 0; ct < 4; ++ct) acc_add_packed(opk, ct, st[ct].o, GL[(4 * ct + tq) * 16 + gh * 3 + 0], true);
        }
        }
        LDS_WAIT();
        unsigned sb0 = 0u, sb1 = 0u;
        if (cur < 16) { sb0 = (lane <= cur) ? 0xffffu : 0u; }
        else if (VAR == 6) {
#pragma unroll 1
            for (int q = 0; q < 16; ++q) { const bool s0 = (lane <= cur) && ((lane * 37 + q * 11) % (cur + 1)) < 16, s1 = (lane + 64 <= cur) && (((lane + 64) * 37 + q * 11) % (cur + 1)) < 16;
                sb0 |= (s0 ? 1u : 0u) << q; sb1 |= (s1 ? 1u : 0u) << q; }
        }
        else {
            const unsigned long long below = (1ull << lane) - 1ull;
#pragma unroll 1
            for (int q = 0; q < 16; ++q) {
                unsigned k0, k1;
                { const int j = lane; const float v = (j == 0 || j == cur || j == cur - 1) ? 1e6f : IMP[q * 128 + j]; k0 = (j > cur) ? 0u : __builtin_bit_cast(unsigned, v) + 1u; }
                { const int j = lane + 64; const float v = (j == cur || j == cur - 1) ? 1e6f : IMP[q * 128 + j]; k1 = (j > cur) ? 0u : __builtin_bit_cast(unsigned, v) + 1u; }
                unsigned lo = 0u;
#pragma unroll
                for (int bit = 30; bit >= 0; --bit) { const unsigned cand = lo | (1u << bit);
                    const int c = __builtin_popcountll(__ballot(k0 >= cand)) + __builtin_popcountll(__ballot(k1 >= cand));
                    if (c == 16) { lo = cand; break; }
                    if (c > 16) lo = cand; }
                const unsigned long long g0 = __ballot(k0 > lo), g1 = __ballot(k1 > lo), e0 = __ballot(k0 == lo), e1 = __ballot(k1 == lo);
                const int need = 16 - __builtin_popcountll(g0) - __builtin_popcountll(g1);
                const bool s0 = (k0 > lo) || (k0 == lo && __builtin_popcountll(e0 & below) < need);
                const bool s1 = (k1 > lo) || (k1 == lo && __builtin_popcountll(e0) + __builtin_popcountll(e1 & below) < need);
                sb0 |= (s0 ? 1u : 0u) << q; sb1 |= (s1 ? 1u : 0u) << q;
            }
        }
        SELB[lane] = sb0; SELB[lane + 64] = sb1;
        LDS_WAIT();
#define NSA_PARK() do { _Pragma("unroll") for (int i_ = 0; i_ < 8; ++i_) { v4u w_; w_.x = opk[i_ >> 1][(i_ & 1) * 2][0]; w_.y = opk[i_ >> 1][(i_ & 1) * 2][1]; w_.z = opk[i_ >> 1][(i_ & 1) * 2 + 1][0]; w_.w = opk[i_ >> 1][(i_ & 1) * 2 + 1][1]; ((v4u*)IMP)[i_ * 64 + lane] = w_; } } while (0)
#define NSA_UNPARK() do { _Pragma("unroll") for (int i_ = 0; i_ < 8; ++i_) { const v4u w_ = ((const v4u*)IMP)[i_ * 64 + lane]; opk[i_ >> 1][(i_ & 1) * 2][0] = w_.x; opk[i_ >> 1][(i_ & 1) * 2][1] = w_.y; opk[i_ >> 1][(i_ & 1) * 2 + 1][0] = w_.z; opk[i_ >> 1][(i_ & 1) * 2 + 1][1] = w_.w; } } while (0)
        NSA_PARK();
        { NSA_RELANE();
#pragma unroll
        for (int ct = 0; ct < 4; ++ct) {
            const float* rp = wsp<float>(F, WS_ROPE) + ((size_t)(tl0 + 4 * ct) * 32 + g4 * 8) * 2;
            const v4u a = __builtin_bit_cast(v4u, qf[ct][0]), b2 = __builtin_bit_cast(v4u, qf[ct][1]); v4u ra, rb;
#pragma unroll
            for (int jj = 0; jj < 4; ++jj) { const f32x4 cs = *(const f32x4*)(rp + 4 * jj);
                const float x1a = bflo(a[jj]), x1b = bfhi(a[jj]), x2a = bflo(b2[jj]), x2b = bfhi(b2[jj]);
                ra[jj] = pk2(x1a * cs[0] - x2a * cs[1], x1b * cs[2] - x2b * cs[3]);
                rb[jj] = pk2(x2a * cs[0] + x1a * cs[1], x2b * cs[2] + x1b * cs[3]); }
            qf[ct][0] = __builtin_bit_cast(bf16x8, ra); qf[ct][1] = __builtin_bit_cast(bf16x8, rb);
        }
        {
            const unsigned long long ulo = __ballot(sb0 != 0u), uhi = __ballot(sb1 != 0u);
            const unsigned long long below = (1ull << ln_) - 1ull;
            const int nlo = __builtin_popcountll(ulo), nblk = nlo + __builtin_popcountll(uhi);
            if (sb0 != 0u) BL[__builtin_popcountll(ulo & below)] = ln_ | (int)(sb0 << 8);
            if (sb1 != 0u) BL[nlo + __builtin_popcountll(uhi & below)] = (ln_ + 64) | (int)(sb1 << 8);
            LDS_WAIT();
#pragma unroll
            for (int ct = 0; ct < 4; ++ct) sm_reset(st[ct]);
            const bf16* kb0 = KS + (size_t)bh * T * 64; const bf16* vb0 = VST + (size_t)bh * 256 * 64 * 32;
            float mr; bool fixed;
            { const float kmx = sqrtf(__builtin_bit_cast(float, __hip_atomic_load((const unsigned*)F.ctl + CW_KMAX + l * 16 + bh, RLX_AGENT))); float mm = 0.f;
#pragma unroll
              for (int ct = 0; ct < 4; ++ct) mm = fmaxf(mm, col_norm(qf[ct]));
              qnmax = wave_max_uniform(mm); mr = qnmax * kmx * 1.002f + 1e-3f;
              fixed = mr < FIXED_REF_MAX; }
            auto addr_sel = [&](int s, const bf16*& kb, const bf16*& vb) { const int g32 = (BL[s >> 1] & 0xff) * 2 + (s & 1); kb = kb0 + (size_t)g32 * 32 * 64; vb = vb0 + (size_t)g32 * 64 * 32; };
            asm volatile("" ::: "memory");
            if (!fixed) {
                float mx[4] = {-INFINITY, -INFINITY, -INFINITY, -INFINITY};
                pipe_run<1, false>(2 * nblk, ln_, addr_sel,
                    [&](int s, const bf16x8 (&kf)[2][2], const bf16x8 (&)[4]) {
                        const int e = __builtin_amdgcn_readfirstlane(BL[s >> 1]), j = e & 0xff, key0 = j * 64 + (s & 1) * 32;
                        const unsigned tm = (unsigned)e >> 8;
#pragma unroll
                        for (int ct = 0; ct < 4; ++ct) { const unsigned tmk = (tm >> (4 * ct)) & 0xFu;
                            if (tmk) { const bool colok = (tmk >> tq) & 1u; const int tl = tl0 + 4 * ct;
                                if (j == cur) attn_max<2>(kf, qf[ct], mx[ct], ln_, true, [&](int kk) { return colok && (key0 + kk <= tl); });
                                else attn_max<1>(kf, qf[ct], mx[ct], ln_, colok, NoMask()); } }
                    });
                mr = wave_max_uniform(fmaxf(fmaxf(mx[0], mx[1]), fmaxf(mx[2], mx[3]))); if (mr == -INFINITY) mr = 0.f;
            }
            asm volatile("" ::: "memory");
            if (VAR != 4 && VAR != 12) {
                bf16x8 kf[2][2][2], vf[4];
                int e_cur = __builtin_amdgcn_readfirstlane(BL[0]), e_nxt = __builtin_amdgcn_readfirstlane(BL[nblk > 1 ? 1 : 0]);
                load_k(kb0 + (size_t)(e_cur & 0xff) * 4096, ln_, kf[0]);
#pragma unroll 1
                for (int b2 = 0; b2 < nblk - 1; ++b2) {
                    const int e_raw = BL[b2 + 2 < nblk ? b2 + 2 : nblk - 1];
                    const int j = e_cur & 0xff; const unsigned tm = (unsigned)e_cur >> 8;
                    const bf16* kblk = kb0 + (size_t)j * 4096; const bf16* vblk = vb0 + (size_t)j * 4096;
#pragma unroll
                    for (int hf = 0; hf < 2; ++hf) {
                        load_v(vblk + hf * 2048, ln_, vf);
                        if (hf == 0) load_k(kblk + 2048, ln_, kf[1]); else load_k(kb0 + (size_t)(e_nxt & 0xff) * 4096, ln_, kf[0]);
#pragma unroll
                        for (int ct = 0; ct < 4; ++ct) {
                            const unsigned tmk = (tm >> (4 * ct)) & 0xFu;
                            if (tmk) attn_compute_fixed<1>(kf[hf], vf, qf[ct], st[ct], mr, ln_, (tmk >> tq) & 1u, NoMask());
                        }
                    }
                    e_cur = e_nxt; e_nxt = __builtin_amdgcn_readfirstlane(e_raw);
                }
#pragma unroll 1
                for (int u = 0; u < 2; ++u) {
                    load_v(vb0 + (size_t)cur * 4096 + u * 2048, ln_, vf); load_k(kb0 + (size_t)cur * 4096 + 2048, ln_, kf[1]);
                    const int key0 = cur * 64 + u * 32;
#pragma unroll
                    for (int ct = 0; ct < 4; ++ct) { const int tl = tl0 + 4 * ct;
                        attn_compute_fixed<2>(kf[0], vf, qf[ct], st[ct], mr, ln_, true, [&](int kk) { return key0 + kk <= tl; }); }
#pragma unroll
                    for (int a = 0; a < 2; ++a)
#pragma unroll
                        for (int c = 0; c < 2; ++c) kf[0][a][c] = kf[1][a][c];
                }
            }
            LDS_WAIT();
            NSA_UNPARK();
#pragma unroll
            for (int ct = 0; ct < 4; ++ct) { const float ls = sm_lsum(st[ct]); const float gs = GL[(4 * ct + tq) * 16 + gh * 3 + 1];
                acc_add_packed(opk, ct, st[ct].o, ls > 0.f ? gs / ls : 0.f, false); }
            NSA_PARK();
        }
        }
        { NSA_RELANE();
#pragma unroll
            for (int ct = 0; ct < 4; ++ct) sm_reset(st[ct]);
            const bf16* kb0 = (VAR == 3 ? KS : KW) + (size_t)bh * T * 64; const bf16* vb0 = (VAR == 3 ? VST : VWT) + (size_t)bh * 256 * 64 * 32;
            const int glo = (t0 - 511 > 0 ? t0 - 511 : 0) >> 5, ghi = (t0 + 15) >> 5;
            float mr; bool fixed;
            { const float kmx = sqrtf(__builtin_bit_cast(float, __hip_atomic_load((const unsigned*)F.ctl + CW_KMAX + l * 16 + 8 + bh, RLX_AGENT)));
              mr = qnmax * kmx * 1.002f + 1e-3f;
              fixed = mr < FIXED_REF_MAX; }
            auto addr_win = [&](int s, const bf16*& kb, const bf16*& vb) { kb = kb0 + (size_t)(glo + s) * 32 * 64; vb = vb0 + (size_t)(glo + s) * 64 * 32; };
            asm volatile("" ::: "memory");
            if (!fixed) {
                float mx[4] = {-INFINITY, -INFINITY, -INFINITY, -INFINITY};
                pipe_run<1, false>(ghi - glo + 1, ln_, addr_win,
                    [&](int s, const bf16x8 (&kf)[2][2], const bf16x8 (&)[4]) {
                        const int key0 = (glo + s) * 32;
#pragma unroll
                        for (int ct = 0; ct < 4; ++ct) { const int tl = tl0 + 4 * ct;
                            attn_max<2>(kf, qf[ct], mx[ct], ln_, true, [&](int kk) { const int kp = key0 + kk; return kp <= tl && kp + 512 > tl; }); }
                    });
                mr = wave_max_uniform(fmaxf(fmaxf(mx[0], mx[1]), fmaxf(mx[2], mx[3]))); if (mr == -INFINITY) mr = 0.f;
            }
            asm volatile("" ::: "memory");
            const int g_a = (t0 >= 497) ? ((t0 - 497) >> 5) + 1 : 0, g_b = (t0 - 31) >> 5;
            const int n_main = g_b >= g_a ? g_b - g_a + 1 : 0, n_up = ghi - (g_b >= g_a ? g_b : g_a - 1), n_tail = n_up + (g_a - glo);
            auto grp = [&](int s) { const int u = s - n_main; return s < n_main ? g_a + s : (u < n_up ? ghi - n_up + 1 + u : glo + (u - n_up)); };
            auto addr_w2 = [&](int s, const bf16*& kb, const bf16*& vb) { const int g = grp(s); kb = kb0 + (size_t)g * 32 * 64; vb = vb0 + (size_t)g * 64 * 32; };
            if (VAR != 5 && VAR != 12)
            pipe_run_mt(n_main, n_tail, ln_, addr_w2,
                [&](int, const bf16x8 (&kf)[2][2], const bf16x8 (&vf)[4]) {
#pragma unroll
                    for (int ct = 0; ct < 4; ++ct) attn_compute_fixed<0>(kf, vf, qf[ct], st[ct], mr, ln_, true, NoMask());
                },
                [&](int s, const bf16x8 (&kf)[2][2], const bf16x8 (&vf)[4]) {
                    const int key0 = grp(s) * 32;
#pragma unroll
                    for (int ct = 0; ct < 4; ++ct) {
                        const int tlo = t0 + 4 * ct, thi = tlo + 3, tl = tl0 + 4 * ct;
                        if (key0 > thi || key0 + 31 + 512 <= tlo) continue;
                        attn_compute_fixed<2>(kf, vf, qf[ct], st[ct], mr, ln_, true, [&](int kk) { const int kp = key0 + kk; return kp <= tl && kp + 512 > tl; });
                    }
                });
            NSA_UNPARK();
#pragma unroll
            for (int ct = 0; ct < 4; ++ct) { const float ls = sm_lsum(st[ct]); const float gwn = GL[(4 * ct + tq) * 16 + gh * 3 + 2];
                acc_add_packed(opk, ct, st[ct].o, ls > 0.f ? gwn / ls : 0.f, false); }
        }
        { NSA_RELANE();
#pragma unroll
        for (int ct = 0; ct < 4; ++ct)
#pragma unroll
            for (int dt = 0; dt < 4; ++dt) { v2u w; w.x = opk[ct][dt][0]; w.y = opk[ct][dt][1];
                if (VAR == 0 || w.x == 0x7fc17fc1u) *(v2u*)(CAT + (mrow0 + 4 * ct) * 1024 + hkv * 256 + gh * 64 + dt * 16 + g4 * 4) = w; }
        }
        LDS_WAIT();
        if (VAR == 0 && xmap) convert_experts(F, l, (bf16*)IMP, task >> 11);
    }
#undef NSA_RELANE
#undef NSA_PARK
#undef NSA_UNPARK
}

DEV void nsa_phase(Frame& F, int l) { nsa_phase_t<0>(F, l); }

DEV void cross_phase(Frame& F, int l) {
    const int lane = F.lane, l16 = lane & 15, g4 = lane >> 4;
    const bf16* XQ = wsp<bf16>(F, WS_XQ); bf16* XO = wsp<bf16>(F, WS_XO);
    const int gw = F.vcu * NWAVES + F.wave, NGW = F.G * NWAVES;
#pragma unroll 1
    for (int task = gw; task < 2048; task += NGW) {
        const int head = task & 3, m0 = (task >> 2) * 64, b = m0 >> 13;
        bf16x8 qf[4][2];
#pragma unroll
        for (int ct = 0; ct < 4; ++ct)
#pragma unroll
            for (int ks = 0; ks < 2; ++ks) qf[ct][ks] = *(const bf16x8*)(XQ + (size_t)(m0 + 16 * ct + l16) * 256 + head * 64 + ks * 32 + g4 * 8);
        const bf16* kb0 = wsp<bf16>(F, WS_MK) + (size_t)((l * 4 + b) * 4 + head) * 256 * 64;
        const bf16* vb0 = wsp<bf16>(F, WS_MVT) + (size_t)((l * 4 + b) * 4 + head) * 8 * 64 * 32;
        SmState st[4];
#pragma unroll
        for (int ct = 0; ct < 4; ++ct) sm_reset(st[ct]);
        pipe_run<PIPE_D, true>(8, lane, [&](int s, const bf16*& kb, const bf16*& vb) { kb = kb0 + (size_t)s * 32 * 64; vb = vb0 + (size_t)s * 64 * 32; },
            [&](int, const bf16x8 (&kf)[2][2], const bf16x8 (&vf)[4]) {
#pragma unroll
                for (int ct = 0; ct < 4; ++ct) attn_compute<0>(kf, vf, qf[ct], st[ct], lane, true, NoMask());
            });
#pragma unroll
        for (int ct = 0; ct < 4; ++ct) {
            const float inv = 1.0f / sm_lsum(st[ct]);
#pragma unroll
            for (int dt = 0; dt < 4; ++dt) { const f32x4 o = st[ct].o[dt] * inv; v2u w; w.x = pk2(o[0], o[1]); w.y = pk2(o[2], o[3]);
                *(v2u*)(XO + (size_t)(m0 + 16 * ct + l16) * 256 + head * 64 + dt * 16 + g4 * 4) = w; }
        }
    }
}


DEV void router_phase(Frame& F, int l, int probe = 0) {
    const int lane = F.lane, l16 = lane & 15, g4 = lane >> 4;
    float* LG = (float*)F.ldsg + F.wave * 768;
    const bf16* HB = wsp<bf16>(F, WS_HB); const float* SSQ = wsp<float>(F, WS_SSQ);
    const bf16* WR = wsp<bf16>(F, WS_WR) + (size_t)l * 96 * 1024;
    int* TOKE = wsp<int>(F, probe ? WS_PROBE : WS_TOKE); float* TOKG = wsp<float>(F, probe ? WS_PROBE + MiB : WS_TOKG); int* TOKP = wsp<int>(F, probe ? WS_PROBE + 2 * MiB : WS_TOKP);
    unsigned* CNT = (unsigned*)F.ctl + CW_CNT + l * 32 + (probe ? 64 : 0);
    const float* bg = inp(14) + l * 4; const float* be = inp(16) + l * 32;
    unsigned* HIST = (unsigned*)((float*)F.ldsg + 8 * 768);
#pragma unroll 1
    for (int tb = F.vcu * NWAVES; tb < NTOK / 16; tb += F.G * NWAVES) {
        const int task = tb + F.wave; const bool live = task < NTOK / 16;
        const int m0 = (live ? task : tb) * 16;
        if (F.tid < 64) HIST[F.tid] = 0u;
        f32x4 acc[3];
        {
            const bf16* ap = HB + (size_t)(m0 + l16) * 1024 + g4 * 8; const bf16* bp = WR + lane * 8;
#pragma unroll
            for (int n = 0; n < 3; ++n) acc[n] = (f32x4){0.f, 0.f, 0.f, 0.f};
#pragma unroll 4
            for (int k = 0; k < 1024; k += 32) {
                const bf16x8 a = *(const bf16x8*)(ap + k);
#pragma unroll
                for (int n = 0; n < 3; ++n) { const bf16x8 bh = *(const bf16x8*)(bp + ((k >> 5) * 6 + n * 2) * 512), bl = *(const bf16x8*)(bp + ((k >> 5) * 6 + n * 2 + 1) * 512);
                    acc[n] = mfma16(a, bh, acc[n]); acc[n] = mfma16(a, bl, acc[n]); }
            }
        }
#pragma unroll
        for (int nt = 0; nt < 3; ++nt)
#pragma unroll
            for (int r = 0; r < 4; ++r) LG[(g4 * 4 + r) * 48 + nt * 16 + l16] = acc[nt][r];
        LDS_WAIT();
        int id1 = 0, id2 = 0;
        if (lane < 16) {
            const int m = m0 + lane; const float rstd = row_rstd_full(SSQ, m); const float* lg = LG + lane * 48;
            float g[4];
#pragma unroll
            for (int j = 0; j < 4; ++j) g[j] = lg[j] * rstd + bg[j];
            float gmax = g[0]; int grp = 0;
#pragma unroll
            for (int j = 1; j < 4; ++j) if (g[j] > gmax) { gmax = g[j]; grp = j; }
            float den = 0.f;
#pragma unroll
            for (int j = 0; j < 4; ++j) den += expf(g[j] - gmax);
            const float psel = 1.0f / den;
            float e1 = -INFINITY, e2 = -INFINITY; int i1 = 0, i2 = 0;
            for (int j = 0; j < 8; ++j) { const float v = lg[4 + grp * 8 + j] * rstd + be[grp * 8 + j];
                if (v > e1) { e2 = e1; i2 = i1; e1 = v; i1 = j; } else if (v > e2) { e2 = v; i2 = j; } }
            const float x = expf(e2 - e1), w1 = 1.0f / (1.0f + x), w2 = x * w1;
            id1 = grp * 8 + i1; id2 = grp * 8 + i2;
            if (live) { TOKE[m * 2] = id1; TOKE[m * 2 + 1] = id2; TOKG[m * 2] = psel * w1; TOKG[m * 2 + 1] = psel * w2; }
        }
        __syncthreads();
        unsigned lp1 = 0u, lp2 = 0u;
        if (lane < 16 && live) { lp1 = __hip_atomic_fetch_add(HIST + id1, 1u, __ATOMIC_RELAXED, __HIP_MEMORY_SCOPE_WORKGROUP); lp2 = __hip_atomic_fetch_add(HIST + id2, 1u, __ATOMIC_RELAXED, __HIP_MEMORY_SCOPE_WORKGROUP); }
        __syncthreads();
        if (F.tid < 32) { const unsigned c = HIST[F.tid]; HIST[32 + F.tid] = c ? __hip_atomic_fetch_add(CNT + F.tid, c, RLX_AGENT) : 0u; }
        __syncthreads();
        if (lane < 16 && live) { const int m = m0 + lane; TOKP[m * 2] = (int)(HIST[32 + id1] + lp1); TOKP[m * 2 + 1] = (int)(HIST[32 + id2] + lp2); }
        __syncthreads();
    }
}
DEV int moe_tables(Frame& F, int l) {
    int* tab = (int*)(F.ldsg + TAB_OFF);
    if (F.tid == 0) {
        const unsigned* CNT = (const unsigned*)F.ctl + CW_CNT + l * 32; int off = 0;
#pragma unroll 1
        for (int e = 0; e < 32; ++e) { tab[e] = off; const int c = (int)__hip_atomic_load(CNT + e, RLX_AGENT); const int nt = (c + 255) >> 8;
            for (int i = 0; i < nt; ++i) tab[40 + (off >> 8) + i] = e;
            off += nt << 8; }
        tab[32] = off;
    }
    __syncthreads();
    return tab[32];
}
DEV void gather_phase(Frame& F, int l) {
    (void)moe_tables(F, l);
    const int* tab = (const int*)(F.ldsg + TAB_OFF);
    const int lane = F.lane; const int gw = F.vcu * NWAVES + F.wave, NGW = F.G * NWAVES;
    const float* SSQ = wsp<float>(F, WS_SSQ);
    const int* TOKE = wsp<int>(F, WS_TOKE); const float* TOKG = wsp<float>(F, WS_TOKG); const int* TOKP = wsp<int>(F, WS_TOKP); int* TOKS = wsp<int>(F, WS_TOKS); int* STOK = wsp<int>(F, WS_STOK);
    float* SRSTD = wsp<float>(F, WS_SRSTD); float* SGATE = wsp<float>(F, WS_SGATE);
    const unsigned* CNT = (const unsigned*)F.ctl + CW_CNT + l * 32;
#pragma unroll 1
    for (int m = gw * 64 + lane; m < NTOK; m += NGW * 64) {
        const v2u e = *(const v2u*)(TOKE + m * 2), p = *(const v2u*)(TOKP + m * 2); const f32x2_t gt = *(const f32x2_t*)(TOKG + m * 2);
        const float rs = row_rstd_full(SSQ, m);
        const int s0 = tab[e.x] + (int)p.x, s1 = tab[e.y] + (int)p.y;
        *(v2u*)(TOKS + m * 2) = (v2u){(unsigned)s0, (unsigned)s1};
        STOK[s0] = m; STOK[s1] = m; SRSTD[s0] = rs; SRSTD[s1] = rs; SGATE[s0] = gt[0]; SGATE[s1] = gt[1];
    }
#pragma unroll 1
    for (int e = 0; e < 32; ++e) {
        const int c = (int)__hip_atomic_load(CNT + e, RLX_AGENT), base = tab[e], end = (e == 31 ? tab[32] : tab[e + 1]);
        for (int r = base + c + gw * 64 + lane; r < end; r += NGW * 64) { STOK[r] = 0; SRSTD[r] = 0.f; SGATE[r] = 0.f; }
    }
}
DEV void combine_phase(Frame& F, int l, int probe = 0) {
    const int lane = F.lane; const int gw = F.vcu * NWAVES + F.wave, NGW = F.G * NWAVES;
    float* Ho = probe ? wsp<float>(F, WS_PROBE) : (float*)(GAS float*)F.out; const bf16* HBi = wsp<bf16>(F, WS_HB); bf16* HB = wsp<bf16>(F, probe ? WS_PROBE + 128 * MiB : WS_HB); float* SSQ = wsp<float>(F, probe ? WS_PROBE + 192 * MiB : WS_SSQ); const bf16* YS = wsp<bf16>(F, WS_YS); const int* TOKS = wsp<int>(F, WS_TOKS);
    const float* gf = inp(23);
#pragma unroll 1
    for (int m0 = gw; m0 < NTOK; m0 += 2 * NGW) {
        f32x4 v[2][4]; float ssum[2];
        int sl[2][2];
#pragma unroll
        for (int k = 0; k < 2; ++k) { const int m = (m0 + k * NGW < NTOK) ? m0 + k * NGW : m0; sl[k][0] = TOKS[m * 2]; sl[k][1] = TOKS[m * 2 + 1]; }
        v2u h[2][4]; v2u ya[2][4], yb[2][4];
#pragma unroll
        for (int k = 0; k < 2; ++k) { const int m = (m0 + k * NGW < NTOK) ? m0 + k * NGW : m0;
#pragma unroll
            for (int j = 0; j < 4; ++j) { const int c = lane * 4 + 256 * j;
                h[k][j] = *(const v2u*)(HBi + (size_t)m * 1024 + c);
                ya[k][j] = *(const v2u*)(YS + (size_t)sl[k][0] * 1024 + c); yb[k][j] = *(const v2u*)(YS + (size_t)sl[k][1] * 1024 + c); } }
#pragma unroll
        for (int k = 0; k < 2; ++k) { float ss = 0.f;
#pragma unroll
            for (int j = 0; j < 4; ++j) { const v2u a = ya[k][j], bq = yb[k][j]; const f32x4 hh = (f32x4){bflo(h[k][j].x), bfhi(h[k][j].x), bflo(h[k][j].y), bfhi(h[k][j].y)};
                f32x4 r; r[0] = hh[0] + (bflo(a.x) + bflo(bq.x)); r[1] = hh[1] + (bfhi(a.x) + bfhi(bq.x)); r[2] = hh[2] + (bflo(a.y) + bflo(bq.y)); r[3] = hh[3] + (bfhi(a.y) + bfhi(bq.y));
                v[k][j] = r; ss += (r[0] * r[0] + r[1] * r[1]) + (r[2] * r[2] + r[3] * r[3]); }
            ssum[k] = wave_sum(ss); }
#pragma unroll
        for (int k = 0; k < 2; ++k) { const int m = m0 + k * NGW;
            if (m < NTOK) {
                if (l == DEPTH - 1) {
                    const float rstd = 1.0f / sqrtf(ssum[k] * (1.0f / 1024.0f) + RMS_EPS);
#pragma unroll
                    for (int j = 0; j < 4; ++j) { const int c = lane * 4 + 256 * j; const f32x4 g = *(const f32x4*)(gf + c); *(f32x4*)(Ho + (size_t)m * 1024 + c) = v[k][j] * rstd * g; }
                } else {
#pragma unroll
                    for (int j = 0; j < 4; ++j) { const int c = lane * 4 + 256 * j;
                        v2u w; w.x = pk2(v[k][j][0], v[k][j][1]); w.y = pk2(v[k][j][2], v[k][j][3]); *(v2u*)(HB + (size_t)m * 1024 + c) = w; }
                    if (lane < 16) SSQ[(size_t)m * 16 + lane] = lane == 0 ? ssum[k] : 0.f;
                } } }
    }
}
#ifndef MK_ONE_LAUNCH
#define MK_ONE_LAUNCH 1
#endif
constexpr int NPH_LAYER = 13, NPHASES = 1 + DEPTH * NPH_LAYER;
struct Args { const float* in[24]; float* out; unsigned char* ws; int ph_lo, ph_hi; };
static_assert(sizeof(Args) == 24 * 8 + 8 + 8 + 8, "Args has no padding");

__global__ void __launch_bounds__(NWAVES * 64, 2) hymba_fwd(Args args) {
    extern __shared__ __attribute__((aligned(16))) unsigned char lds[];
    Frame F;
    F.lds = (LAS unsigned char*)lds; F.ldsg = lds;
    F.MISC = (volatile LAS unsigned*)(F.lds + MISC_OFF);
    F.tid = threadIdx.x; F.lane = F.tid & 63; F.wave = __builtin_amdgcn_readfirstlane(F.tid >> 6);
    F.G = gridDim.x; { const int bx = blockIdx.x; F.vcu = (F.G % 8 == 0) ? (bx % 8) * (F.G / 8) + bx / 8 : bx; }
    F.ws = args.ws; F.ctl = (gu32*)(args.ws + WS_CTL); F.out = args.out;
    if (F.tid < 64) ((LAS unsigned*)(F.lds + MISC_OFF))[F.tid] = 0u;
    __syncthreads();
    int wave0 = F.wave;
    const int lo = args.ph_lo, hi = args.ph_hi;
    XcdBarrier bar; bar.bar = (unsigned*)(F.ctl + CW_BAR); bar.x = 0; bar.st = nullptr;
    if (hi - lo > 1) bar = xcd_barrier_post((unsigned*)(F.ctl + CW_BAR), F.MISC + 8);
#ifndef PHMASK
#define PHMASK 0xFFFF
#endif
#define IN(k) (lo <= (k) && (k) < hi)
#define EN(j) ((PHMASK >> (j)) & 1)
#define RELAUNDER() do { asm volatile("" : "+s"(wave0)); unsigned z_ = 0u; asm volatile("" : "+v"(z_)); int t_ = wave0 * 64 + (int)__builtin_amdgcn_mbcnt_hi(~0u, __builtin_amdgcn_mbcnt_lo(~0u, z_)); F.tid = t_; F.lane = t_ & 63; F.wave = wave0; \
    size_t zo_ = 0; asm volatile("" : "+s"(zo_), "+s"(F.vcu), "+s"(F.G)); F.ws = args.ws + zo_; F.out = args.out + zo_; F.ctl = (gu32*)(F.ws + WS_CTL); } while (0)
#ifndef NSA_VAR
#define NSA_VAR 0
#endif
#ifndef BAR2X
#define BAR2X 0
#endif
#ifndef DUPMASK
#define DUPMASK 0
#endif
#define DUP(j) ((DUPMASK >> (j)) & 1)
#ifndef STAG_J0
#define STAG_J0 0
#endif
#ifndef STAG_MOE
#define STAG_MOE 0
#endif
#define STAGGER(ticks) do { if ((ticks) > 0 && (F.vcu & 1)) { const unsigned long long t0_ = __builtin_amdgcn_s_memrealtime(); while (__builtin_amdgcn_s_memrealtime() - t0_ < (unsigned long long)(ticks)) __builtin_amdgcn_s_sleep(32); } } while (0)
#define SEAM(k) do { if (IN(k) && IN((k) + 1)) { XcdBarrier b_ = bar; size_t zb_ = 0; asm volatile("" : "+s"(b_.x), "+s"(zb_)); b_.bar = (unsigned*)(args.ws + WS_CTL + zb_) + CW_BAR; xcd_barrier(b_); if (BAR2X) xcd_barrier(b_); } } while (0)

    if (IN(0) && EN(13)) { RELAUNDER(); p0_prologue(F); if (DUP(13)) { __syncthreads(); p0_prologue(F); } } SEAM(0);

#pragma unroll 1
    for (int l = 0; l < DEPTH; ++l) {
        const int pb = 1 + l * NPH_LAYER;
        bf16* HB = wsp<bf16>(F, WS_HB); float* SSQ = wsp<float>(F, WS_SSQ);
        if (IN(pb + 0) && EN(0)) for (int rep_ = 0; rep_ < (DUP(0) ? 2 : 1); ++rep_) { RELAUNDER(); if (rep_) __syncthreads();
            pg8::Gemm g{HB, wsp<bf16>(F, WS_WIN) + (size_t)l * NIN * 1024, NTOK, 3072, D};
            pg8::StaticOrder S; S.init(NTOK, 3072, F.G, (int)blockIdx.x);
            EpiIn E{F.ws};
            STAGGER(STAG_J0);
            pg8::gemm_phase<EpiIn, pg8::StaticOrder, true, true>(F.lds, g, S, E, F.wave);
        }
        SEAM(pb + 0);
        if (IN(pb + 1) && EN(1)) { RELAUNDER();
            compress_phase(F, l);
            hgrn_local_phase(F, l);
            conv_phase(F, l);
            kmax_phase(F, l);
            if (l == 0) memkv_phase(F);
            if (DUP(1)) { __syncthreads(); compress_phase(F, l); hgrn_local_phase(F, l); conv_phase(F, l); }
        }
        SEAM(pb + 1);
        if (IN(pb + 2) && EN(2)) { RELAUNDER(); hgrn_scan_phase(F); if (DUP(14)) hgrn_scan_phase(F, 1); nsa_phase(F, l); if (DUP(2)) { __syncthreads(); nsa_phase_t<NSA_VAR>(F, l); } }
        SEAM(pb + 2);
        if (IN(pb + 3) && EN(3)) { RELAUNDER(); hgrn_out_phase(F, l); if (DUP(3)) { __syncthreads(); hgrn_out_phase(F, l); } }
        SEAM(pb + 3);
        if (IN(pb + 4) && EN(4)) for (int rep_ = 0; rep_ < ((DUP(4) && l == 0) ? 2 : 1); ++rep_) { RELAUNDER(); if (rep_) __syncthreads();
            pg8::Gemm g{wsp<bf16>(F, WS_CAT), wsp<bf16>(F, WS_WOUT) + (size_t)l * 1024 * 1024, NTOK, D, D};
            pg8::StaticOrder S; S.init(NTOK, D, F.G, (int)blockIdx.x);
            EpiRes E{l == 0 ? inp(0) : (const float*)nullptr, HB, SSQ};
            pg8::gemm_phase<EpiRes, pg8::StaticOrder, true, true>(F.lds, g, S, E, F.wave);
        }
        SEAM(pb + 4);
        if (IN(pb + 5) && EN(5)) for (int rep_ = 0; rep_ < (DUP(5) ? 2 : 1); ++rep_) { RELAUNDER(); if (rep_) __syncthreads();
            pg8::Gemm g{HB, wsp<bf16>(F, WS_WQ) + (size_t)l * 256 * 1024, NTOK, 256, D};
            pg8::StaticOrder S; S.init(NTOK, 256, F.G, (int)blockIdx.x);
            EpiXQ E{SSQ, wsp<bf16>(F, WS_XQ)};
            pg8::gemm_phase<EpiXQ, pg8::StaticOrder, true, true>(F.lds, g, S, E, F.wave);
        }
        SEAM(pb + 5);
        if (IN(pb + 6) && EN(6)) { RELAUNDER(); cross_phase(F, l); if (DUP(6)) { __syncthreads(); cross_phase(F, l); } }
        SEAM(pb + 6);
        if (IN(pb + 7) && EN(7)) { RELAUNDER();
            pg8::Gemm g{wsp<bf16>(F, WS_XO), wsp<bf16>(F, WS_WO) + (size_t)l * 1024 * 256, NTOK, D, 256};
            pg8::StaticOrder S; S.init(NTOK, D, F.G, (int)blockIdx.x);
            EpiRes E{(const float*)nullptr, HB, SSQ};
            pg8::gemm_phase<EpiRes, pg8::StaticOrder, true, true>(F.lds, g, S, E, F.wave);
        }
        SEAM(pb + 7);
        if (IN(pb + 8) && EN(8)) { RELAUNDER(); router_phase(F, l); if (DUP(8)) router_phase(F, l, 1); }
        SEAM(pb + 8);
        if (IN(pb + 9) && EN(9)) { RELAUNDER(); gather_phase(F, l); if (DUP(9)) { __syncthreads(); gather_phase(F, l); } }
        SEAM(pb + 9);
        if (IN(pb + 10) && EN(10)) for (int rep_ = 0; rep_ < (DUP(10) ? 2 : 1); ++rep_) { RELAUNDER(); if (rep_) __syncthreads();
            const int ns = moe_tables(F, l);
            pg8::Gemm g{wsp<bf16>(F, WS_HB), wsp<bf16>(F, WS_WGU) + (size_t)l * 32 * 1024 * 1024, ns, 32 * 1024, D};
            MoeOrderG S{(ns >> 8) * 4, F.G, (int)blockIdx.x, (const LAS int*)(F.lds + TAB_OFF) + 40, wsp<int>(F, WS_STOK)};
            EpiGU E{wsp<float>(F, WS_SRSTD), wsp<bf16>(F, WS_ACT)};
            STAGGER(STAG_MOE);
            pg8::gemm_phase<EpiGU, MoeOrderG, true, true>(F.lds, g, S, E, F.wave);
        }
        SEAM(pb + 10);
        if (IN(pb + 11) && EN(11)) for (int rep_ = 0; rep_ < (DUP(11) ? 2 : 1); ++rep_) { RELAUNDER(); if (rep_) __syncthreads();
            const int ns = moe_tables(F, l);
            pg8::Gemm g{wsp<bf16>(F, WS_ACT), wsp<bf16>(F, WS_WDN) + (size_t)l * 32 * 1024 * 512, ns, 32 * 1024, 512};
            MoeOrder S{(ns >> 8) * 4, F.G, (int)blockIdx.x, (const LAS int*)(F.lds + TAB_OFF) + 40};
            EpiDN E{wsp<float>(F, WS_SGATE), wsp<bf16>(F, WS_YS)};
            STAGGER(STAG_MOE / 2);
            pg8::gemm_phase<EpiDN, MoeOrder, true, true>(F.lds, g, S, E, F.wave);
        }
        SEAM(pb + 11);
        if (IN(pb + 12) && EN(12)) { RELAUNDER(); combine_phase(F, l); if (DUP(12)) combine_phase(F, l, 1); }
        SEAM(pb + 12);
    }
#undef IN
#undef SEAM
}

extern "C" void kernel_launch(void* const* d_in, const int* in_sizes, int n_in, void* d_out, int out_size, void* d_ws, size_t ws_size, hipStream_t stream) {
    static int grid = 0;
    if (grid == 0) {
        if (n_in != 24 || in_sizes[0] != NTOK * D || out_size != NTOK * D || ws_size < WS_END) {
            fprintf(stderr, "kernel_launch: unexpected shapes: n_in %d in0 %d out %d ws %zu (need %zu)\n", n_in, n_in > 0 ? in_sizes[0] : -1, out_size, ws_size, (size_t)WS_END); grid = -1; return; }
        int dev = 0, cus = 0, per_cu = 0;
        if (hipGetDevice(&dev) != hipSuccess || hipDeviceGetAttribute(&cus, hipDeviceAttributeMultiprocessorCount, dev) != hipSuccess) { grid = -1; return; }
        if (hipFuncSetAttribute((const void*)hymba_fwd, hipFuncAttributeMaxDynamicSharedMemorySize, LDS_BYTES) != hipSuccess) { fprintf(stderr, "kernel_launch: hipFuncSetAttribute failed\n"); grid = -1; return; }
        if (hipOccupancyMaxActiveBlocksPerMultiprocessor(&per_cu, (const void*)hymba_fwd, NWAVES * 64, LDS_BYTES) != hipSuccess || per_cu < 1)
            fprintf(stderr, "kernel_launch: note: occupancy query reports %d blocks per CU\n", per_cu);
        (void)hipGetLastError();
        grid = cus;
    }
    if (grid < 0) return;
    if (hipMemsetAsync((char*)d_ws + WS_CTL, 0, CTL_ZERO_BYTES, stream) != hipSuccess) { fprintf(stderr, "kernel_launch: memset failed\n"); return; }
    Args a{};
    for (int i = 0; i < 24; ++i) a.in[i] = (const float*)d_in[i];
    a.out = (float*)d_out; a.ws = (unsigned char*)d_ws;
#if MK_ONE_LAUNCH
    a.ph_lo = 0; a.ph_hi = NPHASES;
    hipLaunchKernelGGL(hymba_fwd, dim3(grid), dim3(NWAVES * 64), LDS_BYTES, stream, a);
#else
    for (int p = 0; p < NPHASES; ++p) { a.ph_lo = p; a.ph_hi = p + 1; hipLaunchKernelGGL(hymba_fwd, dim3(grid), dim3(NWAVES * 64), LDS_BYTES, stream, a); }
#endif
    const hipError_t le = hipPeekAtLastError();
    if (le != hipSuccess) fprintf(stderr, "kernel_launch: launch failed: %s\n", hipGetErrorName(le));
}
```

```cpp
#define MK_ONE_LAUNCH 1
#include <hip/hip_runtime.h>
#include <cstdio>
#include <cstdint>
#include <cmath>
namespace pg8 {
#define PG8_LAS __attribute__((address_space(3)))
typedef unsigned short bf16_t;
typedef short bf16x8 __attribute__((ext_vector_type(8)));
typedef float f32x4 __attribute__((ext_vector_type(4)));
typedef unsigned u32x4 __attribute__((ext_vector_type(4)));
constexpr int BM = 256, BK = 64, HALF = 128, HTB = HALF * BK * 2  , STAGE_BYTES = 8 * HTB, NXCD = 8, WGM = 8;

__host__ __device__ __forceinline__ int lds_byte(int r, int c) { const int st = (r >> 4) * 2 + (c >> 5), rr = r & 15, cc = c & 31, ob = rr * 64 + cc * 2; return st * 1024 + (ob ^ (((ob >> 9) & 1) << 5)); }
__host__ __device__ __forceinline__ void stage_rc(int b, int& R, int& C) { const int st = b / 1024, sb = b % 1024, swz = sb ^ (((sb >> 9) & 1) << 5); R = (st >> 1) * 16 + swz / 64; C = (st & 1) * 32 + (swz % 64) / 2; }
__host__ __device__ __forceinline__ int perm32(int rho) { const int n = rho >> 4, i = rho & 15; return 8 * (i >> 2) + 4 * n + (i & 3); }

struct Unit { int pm, pn; };
struct Gemm { const bf16_t* A; const bf16_t* Bt; int M, N, K; };

struct StaticOrder {
    int nM, nN, nwg, G, c;
    __host__ __device__ void init(int M, int N, int G_, int c_) { nM = M / BM; nN = N / BM; nwg = nM * nN; G = G_; c = c_; }
    __host__ __device__ bool next(int i, Unit& u) const {
        const long L = (long)i * G + c; if (L >= nwg) return false;
        int wgid = (int)L; { const int q = nwg / NXCD, r = nwg % NXCD, xcd = wgid % NXCD, off = wgid / NXCD; wgid = (xcd < r ? xcd * (q + 1) : r * (q + 1) + (xcd - r) * q) + off; }
        const int nig = WGM * nN, gid = wgid / nig, fm = gid * WGM, gsz = (nM - fm) < WGM ? (nM - fm) : WGM;
        u.pm = fm + ((wgid % nig) % gsz); u.pn = (wgid % nig) / gsz; return true;
    }
    static constexpr bool GATHER = false;
    __device__ __forceinline__ void a_ready(const Unit&) const {}
    __device__ __forceinline__ void done(const Unit&) const {}
};

__device__ __forceinline__ unsigned cvt_pk_bf16(float lo, float hi) { unsigned r; asm volatile("v_cvt_pk_bf16_f32 %0, %1, %2" : "=v"(r) : "v"(lo), "v"(hi)); return r; }
typedef float f32x2 __attribute__((ext_vector_type(2)));
template <class Epi, class Sched, bool ALIGN_EPI = false, bool SP2 = false>
__device__ __forceinline__ void gemm_phase(PG8_LAS unsigned char* lds, const Gemm g, const Sched& S, const Epi& E, int wave_id) {
    unsigned z_ = 0u; asm volatile("" : "+v"(z_)); int tid_ = wave_id * 64 + (int)__builtin_amdgcn_mbcnt_hi(~0u, __builtin_amdgcn_mbcnt_lo(~0u, z_));
    const int tid = tid_, wid = __builtin_amdgcn_readfirstlane(tid >> 6), lane = tid & 63, wr = wid >> 2, wc = wid & 3, fr = lane & 15, fq = lane >> 4;
    const int K = g.K, nt = K / BK;
    unsigned voffA[2], voffB[2];
    constexpr bool GATHER = Sched::GATHER; constexpr int GOFF = 135168;
    static_assert(!GATHER || SP2, "gather is wired into the SP2 loop only");
    int gR[2]; unsigned gC[2]; unsigned curV[2][2], nxtV[2][2];
#pragma unroll
    for (int i = 0; i < 2; ++i) { int R, C; stage_rc(tid * 16 + i * 8192, R, C); const int Rb = Epi::PERM ? ((R & ~31) + perm32(R & 31)) : R;
        voffA[i] = (unsigned)(R * K + C) * 2u; voffB[i] = (unsigned)(Rb * K + C) * 2u; gR[i] = R; gC[i] = (unsigned)C * 2u; }
    const size_t kstep = (size_t)(BK * 2);
    const size_t hstep = (size_t)HALF * K * 2;
    const size_t tstep = 2 * hstep;
    const unsigned ldsw = (unsigned)wid * 1024u;
    const int aoff = lds_byte(wr * 64 + fr, fq * 8), boff = lds_byte(wc * 32 + fr, fq * 8);
#define PG8_SA(b, h) (((b) * 2 + (h)) * HTB)
#define PG8_SB(b, h) ((4 + (b) * 2 + (h)) * HTB)
#define PG8_STAGE(bufoff, gbase, voff) do { _Pragma("unroll") for (int _i = 0; _i < 2; ++_i) \
        __builtin_amdgcn_global_load_lds((const unsigned*)((const char*)(gbase) + (voff)[_i]), (PG8_LAS unsigned*)(lds + (bufoff) + ldsw + _i * 8192), 16, 0, 0); } while (0)
#define PG8_LDA(dst, b, h) do { _Pragma("unroll") for (int m = 0; m < 4; ++m) _Pragma("unroll") for (int k = 0; k < 2; ++k) dst[m][k] = *(const PG8_LAS bf16x8*)(lds + PG8_SA(b, h) + aoff + m * 2048 + k * 1024); } while (0)
#define PG8_LDB(dst, b, h) do { _Pragma("unroll") for (int n = 0; n < 2; ++n) _Pragma("unroll") for (int k = 0; k < 2; ++k) dst[n][k] = *(const PG8_LAS bf16x8*)(lds + PG8_SB(b, h) + boff + n * 2048 + k * 1024); } while (0)
#define PG8_MMA(ai, bj, At, Bt) do { __builtin_amdgcn_s_setprio(1); _Pragma("unroll") for (int m = 0; m < 4; ++m) _Pragma("unroll") for (int n = 0; n < 2; ++n) _Pragma("unroll") for (int k = 0; k < 2; ++k) \
        acc[ai][bj][m][n] = __builtin_amdgcn_mfma_f32_16x16x32_bf16(Bt[n][k], At[m][k], acc[ai][bj][m][n], 0, 0, 0); __builtin_amdgcn_s_setprio(0); } while (0)
#define PG8_WAIT_V(n) asm volatile("s_waitcnt vmcnt(" #n ")" ::: "memory")
#define PG8_WAIT_L(n) asm volatile("s_waitcnt lgkmcnt(" #n ")" ::: "memory")
#define PG8_BAR __builtin_amdgcn_s_barrier()
#define PG8_SCHED __builtin_amdgcn_sched_barrier(0)
    Unit cur, nxt; int ui = 0;
    if (!S.next(0, cur)) return;
    f32x4 acc[2][2][4][2];
#pragma unroll
    for (int a = 0; a < 2; ++a)
#pragma unroll
        for (int b = 0; b < 2; ++b)
#pragma unroll
            for (int m = 0; m < 4; ++m)
#pragma unroll
                for (int n = 0; n < 2; ++n) acc[a][b][m][n] = (f32x4){0.f, 0.f, 0.f, 0.f};
    bf16x8 At[4][2], B0[2][2], B1[2][2];
    const char* cA = (const char*)g.A + (size_t)cur.pm * tstep; const char* cB = (const char*)g.Bt + (size_t)cur.pn * tstep;
    S.a_ready(cur);
    if constexpr (SP2) {
        if constexpr (GATHER) {
#pragma unroll
            for (int h = 0; h < 2; ++h)
#pragma unroll
                for (int i = 0; i < 2; ++i) curV[h][i] = (unsigned)S.rowidx[cur.pm * 256 + h * 128 + gR[i]] * (unsigned)(K * 2) + gC[i];
            cA = (const char*)g.A;
            PG8_STAGE(PG8_SB(0, 0), cB, voffB); PG8_STAGE(PG8_SB(0, 1), cB + hstep, voffB); PG8_STAGE(PG8_SA(0, 0), cA, curV[0]); PG8_STAGE(PG8_SA(0, 1), cA, curV[1]);
        } else {
        PG8_STAGE(PG8_SB(0, 0), cB, voffB); PG8_STAGE(PG8_SB(0, 1), cB + hstep, voffB); PG8_STAGE(PG8_SA(0, 0), cA, voffA); PG8_STAGE(PG8_SA(0, 1), cA + hstep, voffA);
        }
        if (wr == 1) PG8_BAR;
        PG8_WAIT_V(2); PG8_BAR;
        if constexpr (GATHER) { PG8_STAGE(PG8_SB(1, 0), cB + kstep, voffB); PG8_STAGE(PG8_SA(1, 0), cA + kstep, curV[0]); PG8_STAGE(PG8_SB(1, 1), cB + hstep + kstep, voffB); } else {
        PG8_STAGE(PG8_SB(1, 0), cB + kstep, voffB); PG8_STAGE(PG8_SA(1, 0), cA + kstep, voffA); PG8_STAGE(PG8_SB(1, 1), cB + hstep + kstep, voffB); }
        PG8_WAIT_V(6); PG8_BAR;
    } else {
        PG8_STAGE(PG8_SB(0, 0), cB, voffB); PG8_STAGE(PG8_SA(0, 0), cA, voffA); PG8_STAGE(PG8_SB(0, 1), cB + hstep, voffB); PG8_STAGE(PG8_SA(0, 1), cA + hstep, voffA);
        if (wr == 1) PG8_BAR;
        PG8_WAIT_V(4); PG8_BAR;
        PG8_STAGE(PG8_SB(1, 0), cB + kstep, voffB); PG8_STAGE(PG8_SA(1, 0), cA + kstep, voffA); PG8_STAGE(PG8_SB(1, 1), cB + hstep + kstep, voffB);
        PG8_WAIT_V(6); PG8_BAR;
    }
    for (;;) {
        const bool has_next = S.next(ui + 1, nxt);
        const char* nA = GATHER ? cA : has_next ? (const char*)g.A + (size_t)nxt.pm * tstep : cA; const char* nB = has_next ? (const char*)g.Bt + (size_t)nxt.pn * tstep : cB;
        if constexpr (GATHER) {
            if (has_next) {
#pragma unroll
                for (int h = 0; h < 2; ++h)
#pragma unroll
                    for (int i = 0; i < 2; ++i)
                        __builtin_amdgcn_global_load_lds((const unsigned*)(S.rowidx + nxt.pm * 256 + h * 128 + gR[i]), (PG8_LAS unsigned*)(lds + GOFF + (h * 2 + i) * 2048 + wid * 256), 4, 0, 0);
            } else {
#pragma unroll
                for (int h = 0; h < 2; ++h)
#pragma unroll
                    for (int i = 0; i < 2; ++i) nxtV[h][i] = curV[h][i];
            }
        }
        for (int t = 0; t < nt; t += 2) {
            const bool last = (t == nt - 2);
            const char* a1 = cA + (size_t)(t + 1) * kstep;
            const char* a2 = last ? nA : cA + (size_t)(t + 2) * kstep; const char* b2 = last ? nB : cB + (size_t)(t + 2) * kstep;
            const char* a3 = a2 + kstep; const char* b3 = b2 + kstep;
            if (last && has_next) S.a_ready(nxt);
            if constexpr (GATHER) {
            if (last && has_next) {
#pragma unroll
                for (int h = 0; h < 2; ++h)
#pragma unroll
                    for (int i = 0; i < 2; ++i) nxtV[h][i] = *(const PG8_LAS unsigned*)(lds + GOFF + (h * 2 + i) * 2048 + tid * 4) * (unsigned)(K * 2) + gC[i];
            }
            unsigned uV[2][2];
#pragma unroll
            for (int h = 0; h < 2; ++h)
#pragma unroll
                for (int i = 0; i < 2; ++i) uV[h][i] = last ? nxtV[h][i] : curV[h][i];
            const char* ga1 = cA + (size_t)(t + 1) * kstep; const char* ga2 = last ? cA : cA + (size_t)(t + 2) * kstep;
            PG8_LDB(B0, 0, 0); PG8_LDB(B1, 0, 1); PG8_SCHED; PG8_LDA(At, 0, 0); PG8_STAGE(PG8_SA(1, 1), ga1, curV[1]);
            PG8_WAIT_V(8); PG8_WAIT_L(0); PG8_BAR; PG8_MMA(0, 0, At, B0); PG8_MMA(0, 1, At, B1); PG8_BAR; PG8_SCHED;
            PG8_LDA(At, 0, 1); PG8_STAGE(PG8_SB(0, 0), b2, voffB); PG8_STAGE(PG8_SB(0, 1), b2 + hstep, voffB); PG8_STAGE(PG8_SA(0, 0), ga2, uV[0]);
            PG8_WAIT_V(8); PG8_WAIT_L(0); PG8_BAR; PG8_MMA(1, 0, At, B0); PG8_MMA(1, 1, At, B1); PG8_BAR; PG8_SCHED;
            PG8_LDB(B0, 1, 0); PG8_LDB(B1, 1, 1); PG8_SCHED; PG8_LDA(At, 1, 0); PG8_STAGE(PG8_SA(0, 1), ga2, uV[1]);
            PG8_WAIT_V(8); PG8_WAIT_L(0); PG8_BAR; PG8_MMA(0, 0, At, B0); PG8_MMA(0, 1, At, B1); PG8_BAR; PG8_SCHED;
            PG8_LDA(At, 1, 1); PG8_STAGE(PG8_SB(1, 0), b3, voffB); PG8_STAGE(PG8_SB(1, 1), b3 + hstep, voffB); PG8_STAGE(PG8_SA(1, 0), ga2 + kstep, uV[0]);
            PG8_WAIT_V(8); PG8_WAIT_L(0); PG8_BAR; PG8_MMA(1, 0, At, B0); PG8_MMA(1, 1, At, B1); PG8_BAR; PG8_SCHED;
            } else if constexpr (SP2) {
            PG8_LDB(B0, 0, 0); PG8_LDB(B1, 0, 1); PG8_SCHED; PG8_LDA(At, 0, 0); PG8_STAGE(PG8_SA(1, 1), a1 + hstep, voffA);
            PG8_WAIT_V(8); PG8_WAIT_L(0); PG8_BAR; PG8_MMA(0, 0, At, B0); PG8_MMA(0, 1, At, B1); PG8_BAR; PG8_SCHED;
            PG8_LDA(At, 0, 1); PG8_STAGE(PG8_SB(0, 0), b2, voffB); PG8_STAGE(PG8_SB(0, 1), b2 + hstep, voffB); PG8_STAGE(PG8_SA(0, 0), a2, voffA);
            PG8_WAIT_V(8); PG8_WAIT_L(0); PG8_BAR; PG8_MMA(1, 0, At, B0); PG8_MMA(1, 1, At, B1); PG8_BAR; PG8_SCHED;
            PG8_LDB(B0, 1, 0); PG8_LDB(B1, 1, 1); PG8_SCHED; PG8_LDA(At, 1, 0); PG8_STAGE(PG8_SA(0, 1), a2 + hstep, voffA);
            PG8_WAIT_V(8); PG8_WAIT_L(0); PG8_BAR; PG8_MMA(0, 0, At, B0); PG8_MMA(0, 1, At, B1); PG8_BAR; PG8_SCHED;
            PG8_LDA(At, 1, 1); PG8_STAGE(PG8_SB(1, 0), b3, voffB); PG8_STAGE(PG8_SB(1, 1), b3 + hstep, voffB); PG8_STAGE(PG8_SA(1, 0), a3, voffA);
            PG8_WAIT_V(8); PG8_WAIT_L(0); PG8_BAR; PG8_MMA(1, 0, At, B0); PG8_MMA(1, 1, At, B1); PG8_BAR; PG8_SCHED;
            } else {
            PG8_LDB(B0, 0, 0); PG8_SCHED; PG8_LDA(At, 0, 0); PG8_STAGE(PG8_SA(1, 1), a1 + hstep, voffA);
            PG8_WAIT_L(8); PG8_BAR; PG8_WAIT_L(0); PG8_MMA(0, 0, At, B0); PG8_BAR; PG8_SCHED;
            PG8_LDB(B1, 0, 1); PG8_STAGE(PG8_SB(0, 0), b2, voffB);
            PG8_BAR; PG8_WAIT_L(0); PG8_MMA(0, 1, At, B1); PG8_BAR;
            PG8_LDA(At, 0, 1); PG8_STAGE(PG8_SA(0, 0), a2, voffA);
            PG8_BAR; PG8_WAIT_L(0); PG8_MMA(1, 0, At, B0); PG8_BAR; PG8_SCHED;
            PG8_STAGE(PG8_SB(0, 1), b2 + hstep, voffB);
            PG8_WAIT_V(6); PG8_BAR; PG8_MMA(1, 1, At, B1); PG8_BAR;
            PG8_LDB(B0, 1, 0); PG8_SCHED; PG8_LDA(At, 1, 0); PG8_STAGE(PG8_SA(0, 1), a2 + hstep, voffA);
            PG8_WAIT_L(8); PG8_BAR; PG8_WAIT_L(0); PG8_MMA(0, 0, At, B0); PG8_BAR; PG8_SCHED;
            PG8_LDB(B1, 1, 1); PG8_STAGE(PG8_SB(1, 0), b3, voffB);
            PG8_BAR; PG8_WAIT_L(0); PG8_MMA(0, 1, At, B1); PG8_BAR;
            PG8_LDA(At, 1, 1); PG8_STAGE(PG8_SA(1, 0), a3, voffA);
            PG8_BAR; PG8_WAIT_L(0); PG8_MMA(1, 0, At, B0); PG8_BAR; PG8_SCHED;
            PG8_STAGE(PG8_SB(1, 1), b3 + hstep, voffB);
            PG8_WAIT_V(6); PG8_BAR; PG8_MMA(1, 1, At, B1); PG8_BAR;
            }
        }
        if constexpr (ALIGN_EPI) { if (wr == 0) PG8_BAR; }
        if constexpr (!Epi::AFTER_DRAIN) { E(acc, cur, wr, wc, fr, fq); S.done(cur); }
        if (!has_next) break;
#pragma unroll
        for (int a = 0; a < 2; ++a)
#pragma unroll
            for (int b = 0; b < 2; ++b)
#pragma unroll
                for (int m = 0; m < 4; ++m)
#pragma unroll
                    for (int n = 0; n < 2; ++n) acc[a][b][m][n] = (f32x4){0.f, 0.f, 0.f, 0.f};
        cur = nxt; cA = nA; cB = nB; ++ui;
        if constexpr (GATHER) {
#pragma unroll
            for (int h = 0; h < 2; ++h)
#pragma unroll
                for (int i = 0; i < 2; ++i) curV[h][i] = nxtV[h][i];
        }
        if constexpr (ALIGN_EPI) { if (wr == 1) PG8_BAR; }
    }
    PG8_WAIT_V(0);
    if constexpr (!ALIGN_EPI) { if (wr == 0) PG8_BAR; }
    PG8_BAR;
    if constexpr (Epi::AFTER_DRAIN) { E.fused(acc, cur, wr, wc, fr, fq, lds, wid, lane); S.done(cur); }
#undef PG8_SA
#undef PG8_SB
#undef PG8_STAGE
#undef PG8_LDA
#undef PG8_LDB
#undef PG8_MMA
#undef PG8_WAIT_V
#undef PG8_WAIT_L
#undef PG8_BAR
#undef PG8_SCHED
}
}
constexpr int NB = 4, T = 8192, D = 1024, NTOK = NB * T, DEPTH = 2;
constexpr int NIN = 3328;
constexpr int IN_W = 3096;
constexpr int NSLOT_MAX = 65536 + 32 * 256;
constexpr float RMS_EPS = 1e-6f;
constexpr float QSCALE = 0.125f * 1.44269504088896f;
constexpr int NWAVES = 8;

constexpr size_t MiB = 1u << 20;
constexpr size_t WS_CTL = 0, CTL_ZERO_BYTES = 1 * MiB;
constexpr size_t WS_ROPE = 1 * MiB;
constexpr size_t WS_SMALL = 3 * MiB;
constexpr size_t WS_WG = 3 * MiB + 65536;
constexpr size_t WS_SSQ = 4 * MiB;
constexpr size_t WS_WIN = 8 * MiB;
constexpr size_t WS_WOUT = 22 * MiB;
constexpr size_t WS_WQ = 26 * MiB;
constexpr size_t WS_WKV = 27 * MiB;
constexpr size_t WS_WO = 29 * MiB;
constexpr size_t WS_WR = 30 * MiB;
constexpr size_t WS_W1C = 31 * MiB;
constexpr size_t WS_W2C = 33 * MiB;
constexpr size_t WS_MEMB = 34 * MiB;
constexpr size_t WS_MK = 36 * MiB;
constexpr size_t WS_MVT = 37 * MiB;
constexpr size_t WS_WGU = 40 * MiB;
constexpr size_t WS_WDN = 168 * MiB;
constexpr size_t WS_HB = 232 * MiB;
constexpr size_t WS_Q = 296 * MiB, WS_QR = 328 * MiB, WS_KCR = 360 * MiB, WS_VCR = 368 * MiB, WS_KS = 376 * MiB, WS_KW = 384 * MiB;
constexpr size_t WS_VST = 392 * MiB, WS_VWT = 400 * MiB, WS_KCC = 408 * MiB, WS_VCT = 409 * MiB, WS_GATE = 410 * MiB;
constexpr size_t WS_CB = 414 * MiB, WS_CC = 430 * MiB, WS_CH = 446 * MiB;
constexpr size_t WS_HQ = 462 * MiB, WS_HF = 494 * MiB, WS_HI = 526 * MiB, WS_HG = 558 * MiB;
constexpr size_t WS_CAT = 590 * MiB, WS_U = 654 * MiB, WS_DEC = 686 * MiB;
constexpr size_t WS_XQ = 688 * MiB, WS_XO = 704 * MiB;
constexpr size_t WS_XS = 296 * MiB, WS_ACT = 440 * MiB, WS_YS = 512 * MiB;
constexpr size_t WS_TOKE = 720 * MiB, WS_TOKG = 721 * MiB, WS_TOKP = 722 * MiB, WS_TOKS = 723 * MiB, WS_SRSTD = 724 * MiB, WS_SGATE = 725 * MiB;
constexpr size_t WS_STOK = 723 * MiB + 512 * 1024;
constexpr size_t WS_U2 = 728 * MiB;
constexpr size_t WS_PROBE = 760 * MiB;
constexpr size_t WS_END = 760 * MiB;
static_assert(WS_XS + (size_t)NSLOT_MAX * 1024 * 2 <= WS_ACT && WS_ACT + (size_t)NSLOT_MAX * 512 * 2 <= WS_YS && WS_YS + (size_t)NSLOT_MAX * 1024 * 2 <= WS_XQ, "moe map");
constexpr int CW_CNT = 64;
constexpr int CW_KMAX = 256;
constexpr int CW_NSAQ = 512;
constexpr int CW_BAR = 4096;

constexpr int RING_BYTES = 131072;
constexpr int NSA_LDS_WAVE = 10752;
constexpr int MISC_OFF = RING_BYTES;
constexpr int TAB_OFF = RING_BYTES + 512;
constexpr int LDS_BYTES = 147456;
static_assert(8 * NSA_LDS_WAVE <= RING_BYTES && TAB_OFF + 4 * (40 + 320) <= LDS_BYTES, "LDS map");

#define GAS __attribute__((address_space(1)))
#define LAS __attribute__((address_space(3)))
#define DEV __device__ __forceinline__
typedef unsigned short bf16;
typedef unsigned v4u __attribute__((ext_vector_type(4)));
typedef unsigned v2u __attribute__((ext_vector_type(2)));
typedef float f32x4 __attribute__((ext_vector_type(4)));
typedef short bf16x8 __attribute__((ext_vector_type(8)));
typedef GAS unsigned gu32;
#define RLX_AGENT __ATOMIC_RELAXED, __HIP_MEMORY_SCOPE_AGENT
#define LDS_WAIT() asm volatile("s_waitcnt lgkmcnt(0)" ::: "memory")
#define VM_WAIT() asm volatile("s_waitcnt vmcnt(0)" ::: "memory")
typedef __bf16 bf16x2_t __attribute__((ext_vector_type(2)));
typedef float f32x2_t __attribute__((ext_vector_type(2)));
DEV unsigned pk2(float lo, float hi) { const f32x2_t v = {lo, hi}; return __builtin_bit_cast(unsigned, __builtin_convertvector(v, bf16x2_t)); }
DEV unsigned f2bf(float f) { return pk2(f, 0.f) & 0xffffu; }
DEV float bf2f(unsigned short b) { return __builtin_bit_cast(float, (unsigned)b << 16); }
DEV float bflo(unsigned w) { return __builtin_bit_cast(float, w << 16); }
DEV float bfhi(unsigned w) { return __builtin_bit_cast(float, w & 0xffff0000u); }
DEV float ex2(float x) { return __builtin_amdgcn_exp2f(x); }
DEV float wave_sum(float v) {
#pragma unroll
    for (int o = 1; o < 64; o <<= 1) v += __shfl_xor(v, o);
    return v;
}
DEV f32x4 mfma16(bf16x8 a, bf16x8 b, f32x4 c) { return __builtin_amdgcn_mfma_f32_16x16x32_bf16(a, b, c, 0, 0, 0); }
DEV int slot32(int k) { return ((k >> 2) & 3) * 8 + (k >> 4) * 4 + (k & 3); }
DEV int kfrag_off(int key, int d) { return (key >> 5) * 2048 + ((((key >> 4) & 1) * 2 + (d >> 5)) * 64 + ((d >> 3) & 3) * 16 + (key & 15)) * 8 + (d & 7); }
DEV float sigmoidf_(float x) { return 1.0f / (1.0f + __expf(-x)); }
DEV float siluf_(float x) { return x / (1.0f + __expf(-x)); }
#define XB_TMO      128
#define XB_XCNT(j)  (256  + 64 * (j))
#define XB_XSUB(j)  (1280 + 64 * (j))
#define XB_XGEN(j)  (2304 + 64 * (j))
#define XB_TOP      3328
#define XB_TOPGEN   3392
#define XCD_BAR_WORDS 3456
#define XB_SPIN_CAP (1u << 18)

__device__ __forceinline__ unsigned xb_ld(unsigned* p)              { return __hip_atomic_load(p, __ATOMIC_RELAXED, __HIP_MEMORY_SCOPE_AGENT); }
__device__ __forceinline__ unsigned xb_add(unsigned* p, unsigned v) { return __hip_atomic_fetch_add(p, v, __ATOMIC_RELAXED, __HIP_MEMORY_SCOPE_AGENT); }
__device__ __forceinline__ unsigned xb_xcc_id() { return (unsigned)__builtin_amdgcn_s_getreg((3 << 11) | 20) & 0xFu; }
#define XB_SPIN(cond, bar) do { unsigned _sp = 0; while (cond) { __builtin_amdgcn_s_sleep(1); \
    if ((++_sp & 255u) == 0u) { if (xb_ld(&(bar)[XB_TMO])) break; if (_sp > XB_SPIN_CAP) { atomicAdd(&(bar)[XB_TMO], 1u); break; } } } } while (0)

struct XcdBarrier {
    unsigned* bar; unsigned x;
    volatile LAS unsigned* st;
};

__device__ __forceinline__ XcdBarrier xcd_barrier_post(unsigned* bar, volatile LAS unsigned* st) {
    XcdBarrier b; b.bar = bar; b.x = xb_xcc_id(); b.st = st;
    if (threadIdx.x == 0) (void)xb_add(&bar[XB_XCNT(b.x)], 1u);
    return b;
}
__device__ __forceinline__ void xcd_barrier_complete(unsigned* bar, unsigned x, unsigned& nloc, unsigned& nx) {
    const unsigned G = gridDim.x * gridDim.y * gridDim.z;
    unsigned sum, cnt, mine, sp = 0u;
    for (;;) {
        sum = 0u; cnt = 0u; mine = 0u;
#pragma unroll
        for (unsigned j = 0; j < 16; ++j) { const unsigned c = xb_ld(&bar[XB_XCNT(j)]); sum += c; cnt += (c > 0u) ? 1u : 0u; mine = (j == x) ? c : mine; }
        if (sum == G) break;
        __builtin_amdgcn_s_sleep(1);
        if ((++sp & 255u) == 0u) { if (xb_ld(&bar[XB_TMO])) break; if (sp > XB_SPIN_CAP) { atomicAdd(&bar[XB_TMO], 1u); break; } }
    }
    nloc = mine > 0u ? mine : 1u; nx = cnt > 0u ? cnt : 1u;
}

__device__ __forceinline__ void xcd_barrier(const XcdBarrier& b) {
    asm volatile("s_waitcnt vmcnt(0)" ::: "memory");
    __syncthreads();
    if (threadIdx.x == 0) {
        unsigned* bar = b.bar;
        __builtin_amdgcn_s_waitcnt(0);
        unsigned nloc = b.st[0], nx = b.st[1];
        if (nloc == 0u) { xcd_barrier_complete(bar, b.x, nloc, nx); b.st[0] = nloc; b.st[1] = nx; }
        const unsigned old = xb_add(&bar[XB_XSUB(b.x)], 1u);
        const unsigned gen = old / nloc;
        if (old + 1u == (gen + 1u) * nloc) {
            __builtin_amdgcn_fence(__ATOMIC_RELEASE, "agent");
            asm volatile("s_waitcnt vmcnt(0)" ::: "memory");
            const unsigned og = xb_add(&bar[XB_TOP], 1u);
            const unsigned tg = og / nx;
            if (og + 1u == (tg + 1u) * nx) xb_add(&bar[XB_TOPGEN], 1u);
            else XB_SPIN(xb_ld(&bar[XB_TOPGEN]) == tg, bar);
            __builtin_amdgcn_fence(__ATOMIC_ACQUIRE, "agent");
            xb_add(&bar[XB_XGEN(b.x)], 1u);
            asm volatile("s_waitcnt vmcnt(0)" ::: "memory");
        } else {
            XB_SPIN(xb_ld(&bar[XB_XGEN(b.x)]) == gen, bar);
            __builtin_amdgcn_fence(__ATOMIC_ACQUIRE, "agent");
            asm volatile("s_waitcnt vmcnt(0)" ::: "memory");
        }
    }
    __syncthreads();
}
DEV float row_rstd(const float* ssq, int row, int fq) {
    const f32x4 p = *(const f32x4*)(ssq + (size_t)row * 16 + fq * 4);
    float s = (p.x + p.y) + (p.z + p.w);
    s += __shfl_xor(s, 16); s += __shfl_xor(s, 32);
    return 1.0f / sqrtf(s * (1.0f / 1024.0f) + RMS_EPS);
}
DEV float row_rstd_full(const float* ssq, int row) {
    const f32x4* p = (const f32x4*)(ssq + (size_t)row * 16);
    const f32x4 a = p[0], b = p[1], c = p[2], d = p[3];
    const float s = ((a.x + a.y) + (a.z + a.w)) + ((b.x + b.y) + (b.z + b.w)) + ((c.x + c.y) + (c.z + c.w)) + ((d.x + d.y) + (d.z + d.w));
    return 1.0f / sqrtf(s * (1.0f / 1024.0f) + RMS_EPS);
}

DEV void rope4(const float* rope, int t, int i, const f32x4& v0, const f32x4& v1, float (&lo)[4], float (&hi)[4]) {
    const f32x4 c0 = *(const f32x4*)(rope + ((size_t)t * 32 + i) * 2), c1 = *(const f32x4*)(rope + ((size_t)t * 32 + i + 2) * 2);
    lo[0] = v0[0] * c0[0] - v0[1] * c0[1]; hi[0] = v0[1] * c0[0] + v0[0] * c0[1];
    lo[1] = v0[2] * c0[2] - v0[3] * c0[3]; hi[1] = v0[3] * c0[2] + v0[2] * c0[3];
    lo[2] = v1[0] * c1[0] - v1[1] * c1[1]; hi[2] = v1[1] * c1[0] + v1[0] * c1[1];
    lo[3] = v1[2] * c1[2] - v1[3] * c1[3]; hi[3] = v1[3] * c1[2] + v1[2] * c1[3];
}
struct EpiIn {
    static constexpr bool PERM = true, AFTER_DRAIN = false;
    unsigned char* ws;
    template <class Tp> DEV Tp* P(size_t off) const { return (Tp*)(GAS Tp*)(ws + off); }
    DEV void operator()(const f32x4 (&acc)[2][2][4][2], const pg8::Unit& u, int wr, int wc, int fr, int fq) const {
        asm volatile("" : "+v"(fr), "+v"(fq), "+s"(wr), "+s"(wc));
        const int pn = u.pn;
        const float* ssq = P<float>(WS_SSQ); const float* rope = P<float>(WS_ROPE);
#pragma unroll
        for (int ai = 0; ai < 2; ++ai)
#pragma unroll
            for (int m = 0; m < 4; ++m) {
                const int row = u.pm * 256 + ai * 128 + wr * 64 + m * 16 + fr;
                const float rstd = row_rstd(ssq, row, fq);
                const int t = row & (T - 1), b = row >> 13;
#pragma unroll
                for (int bj = 0; bj < 2; ++bj) {
                    const int col = bj * 128 + wc * 32 + fq * 8;
                    const f32x4 v0 = acc[ai][bj][m][0] * rstd, v1 = acc[ai][bj][m][1] * rstd;
                    if (pn < 2) {
                        const int g = pn * 256 + col, head = g >> 6, i = (g & 63) >> 1;
                        const size_t o = (size_t)row * 512 + head * 64 + i;
                        bf16* Q = P<bf16>(WS_Q);
                        v2u w;
                        w.x = pk2(v0[0] * QSCALE, v0[2] * QSCALE); w.y = pk2(v1[0] * QSCALE, v1[2] * QSCALE); *(v2u*)(Q + o) = w;
                        w.x = pk2(v0[1] * QSCALE, v0[3] * QSCALE); w.y = pk2(v1[1] * QSCALE, v1[3] * QSCALE); *(v2u*)(Q + o + 32) = w;
                    } else if (pn == 2) {
                        bf16* dst = P<bf16>((col < 128) ? WS_KCR : WS_VCR);
                        v4u w; w.x = pk2(v0[0], v0[1]); w.y = pk2(v0[2], v0[3]); w.z = pk2(v1[0], v1[1]); w.w = pk2(v1[2], v1[3]);
                        *(v4u*)(dst + (size_t)row * 128 + (col & 127)) = w;
                    } else if (pn == 3 || pn == 4) {
                        if (col < 128) {
                            bf16* dst = P<bf16>((pn == 3) ? WS_KS : WS_KW);
                            const int hkv = col >> 6, i = (col & 63) >> 1;
                            float lo[4], hi[4]; rope4(rope, t, i, v0, v1, lo, hi);
                            const size_t o = (size_t)(b * 2 + hkv) * T * 64 + kfrag_off(t, i);
                            v2u w;
                            w.x = pk2(lo[0], lo[1]); w.y = pk2(lo[2], lo[3]); *(v2u*)(dst + o) = w;
                            w.x = pk2(hi[0], hi[1]); w.y = pk2(hi[2], hi[3]); *(v2u*)(dst + o + 512) = w;
                        } else {
                            bf16* dst = P<bf16>((pn == 3) ? WS_VST : WS_VWT);
                            const int c2 = col - 128, hkv = c2 >> 6, d = c2 & 63;
                            const size_t o = (((size_t)(b * 2 + hkv) * 256 + (t >> 5)) * 64 + d) * 32 + slot32(t & 31);
#pragma unroll
                            for (int j = 0; j < 4; ++j) { dst[o + j * 32] = (bf16)f2bf(v0[j]); dst[o + (j + 4) * 32] = (bf16)f2bf(v1[j]); }
#if defined(DUPMASK) && ((DUPMASK >> 20) & 1)
                            { bf16* dst2 = P<bf16>(WS_U2) + (pn - 3) * (4u << 20);
#pragma unroll
                            for (int j = 0; j < 4; ++j) { dst2[o + j * 32] = (bf16)f2bf(v0[j]); dst2[o + (j + 4) * 32] = (bf16)f2bf(v1[j]); } }
#endif
                        }
                    } else if (pn == 9) {
                        float* dst = P<float>(WS_HF) + (size_t)row * 256 + col;
                        *(f32x4*)dst = v0; *(f32x4*)(dst + 4) = v1;
                    } else {
                        bf16* dst = (pn < 8) ? P<bf16>(WS_CB + (size_t)(pn - 5) * (WS_CC - WS_CB)) : P<bf16>(WS_HQ + (size_t)(pn - 8) * (WS_HF - WS_HQ));
                        v4u w; w.x = pk2(v0[0], v0[1]); w.y = pk2(v0[2], v0[3]); w.z = pk2(v1[0], v1[1]); w.w = pk2(v1[2], v1[3]);
                        *(v4u*)(dst + (size_t)row * 256 + col) = w;
                    }
                }
            }
    }
};

struct EpiRes {
    static constexpr bool PERM = true, AFTER_DRAIN = false;
    const float* base32; bf16* hb; float* ssq;
    DEV void operator()(const f32x4 (&acc)[2][2][4][2], const pg8::Unit& u, int wr, int wc, int fr, int fq) const {
        asm volatile("" : "+v"(fr), "+v"(fq), "+s"(wr), "+s"(wc));
#pragma unroll
        for (int ai = 0; ai < 2; ++ai)
#pragma unroll
            for (int m = 0; m < 4; ++m) {
                const int row = u.pm * 256 + ai * 128 + wr * 64 + m * 16 + fr;
                float ss = 0.f;
#pragma unroll
                for (int bj = 0; bj < 2; ++bj) {
                    const size_t o = (size_t)row * 1024 + u.pn * 256 + bj * 128 + wc * 32 + fq * 8;
                    f32x4 v0, v1;
                    if (base32) { v0 = *(const f32x4*)(base32 + o); v1 = *(const f32x4*)(base32 + o + 4); }
                    else { const v4u hw = *(const v4u*)(hb + o); v0 = (f32x4){bflo(hw.x), bfhi(hw.x), bflo(hw.y), bfhi(hw.y)}; v1 = (f32x4){bflo(hw.z), bfhi(hw.z), bflo(hw.w), bfhi(hw.w)}; }
                    v0 = v0 + acc[ai][bj][m][0]; v1 = v1 + acc[ai][bj][m][1];
                    v4u w; w.x = pk2(v0[0], v0[1]); w.y = pk2(v0[2], v0[3]); w.z = pk2(v1[0], v1[1]); w.w = pk2(v1[2], v1[3]);
                    *(v4u*)(hb + o) = w;
                    ss += ((v0[0] * v0[0] + v0[1] * v0[1]) + (v0[2] * v0[2] + v0[3] * v0[3])) + ((v1[0] * v1[0] + v1[1] * v1[1]) + (v1[2] * v1[2] + v1[3] * v1[3]));
                }
                ss += __shfl_xor(ss, 16); ss += __shfl_xor(ss, 32);
                if (fq == 0) ssq[(size_t)row * 16 + u.pn * 4 + wc] = ss;
            }
    }
};

struct EpiXQ {
    static constexpr bool PERM = true, AFTER_DRAIN = false;
    const float* ssq; bf16* XQ;
    DEV void operator()(const f32x4 (&acc)[2][2][4][2], const pg8::Unit& u, int wr, int wc, int fr, int fq) const {
        asm volatile("" : "+v"(fr), "+v"(fq), "+s"(wr), "+s"(wc));
#pragma unroll
        for (int ai = 0; ai < 2; ++ai)
#pragma unroll
            for (int m = 0; m < 4; ++m) {
                const int row = u.pm * 256 + ai * 128 + wr * 64 + m * 16 + fr;
                const float sc = row_rstd(ssq, row, fq) * QSCALE;
#pragma unroll
                for (int bj = 0; bj < 2; ++bj) {
                    const f32x4 v0 = acc[ai][bj][m][0] * sc, v1 = acc[ai][bj][m][1] * sc;
                    v4u w; w.x = pk2(v0[0], v0[1]); w.y = pk2(v0[2], v0[3]); w.z = pk2(v1[0], v1[1]); w.w = pk2(v1[2], v1[3]);
                    *(v4u*)(XQ + (size_t)row * 256 + bj * 128 + wc * 32 + fq * 8) = w;
                }
            }
    }
};

struct EpiGU {
    static constexpr bool PERM = true, AFTER_DRAIN = false;
    const float* srstd; bf16* ACT;
    DEV void operator()(const f32x4 (&acc)[2][2][4][2], const pg8::Unit& u, int wr, int wc, int fr, int fq) const {
        asm volatile("" : "+v"(fr), "+v"(fq), "+s"(wr), "+s"(wc));
        const int nt = u.pn & 3;
#pragma unroll
        for (int ai = 0; ai < 2; ++ai)
#pragma unroll
            for (int m = 0; m < 4; ++m) {
                const int row = u.pm * 256 + ai * 128 + wr * 64 + m * 16 + fr;
                const float rs = srstd[row];
#pragma unroll
                for (int bj = 0; bj < 2; ++bj) {
                    const f32x4 v0 = acc[ai][bj][m][0] * rs, v1 = acc[ai][bj][m][1] * rs;
                    const int j = (nt * 256 + bj * 128 + wc * 32 + fq * 8) >> 1;
                    v2u w; w.x = pk2(siluf_(v0[0]) * v0[1], siluf_(v0[2]) * v0[3]); w.y = pk2(siluf_(v1[0]) * v1[1], siluf_(v1[2]) * v1[3]);
                    *(v2u*)(ACT + (size_t)row * 512 + j) = w;
                }
            }
    }
};

struct EpiDN {
    static constexpr bool PERM = true, AFTER_DRAIN = false;
    const float* sgate; bf16* YS;
    DEV void operator()(const f32x4 (&acc)[2][2][4][2], const pg8::Unit& u, int wr, int wc, int fr, int fq) const {
        asm volatile("" : "+v"(fr), "+v"(fq), "+s"(wr), "+s"(wc));
        const int nt = u.pn & 3;
#pragma unroll
        for (int ai = 0; ai < 2; ++ai)
#pragma unroll
            for (int m = 0; m < 4; ++m) {
                const int row = u.pm * 256 + ai * 128 + wr * 64 + m * 16 + fr;
                const float gt = sgate[row];
#pragma unroll
                for (int bj = 0; bj < 2; ++bj) {
                    const f32x4 v0 = acc[ai][bj][m][0] * gt, v1 = acc[ai][bj][m][1] * gt;
                    v4u w; w.x = pk2(v0[0], v0[1]); w.y = pk2(v0[2], v0[3]); w.z = pk2(v1[0], v1[1]); w.w = pk2(v1[2], v1[3]);
                    *(v4u*)(YS + (size_t)row * 1024 + nt * 256 + bj * 128 + wc * 32 + fq * 8) = w;
                }
            }
    }
};

struct MoeOrder {
    int nunits, G, c; const LAS int* tileE;
    DEV bool next(int i, pg8::Unit& u) const {
        int L = i * G + c;
        if (G == 256 && i == 4) {
            const int extra = nunits - 1024, q = (extra + 7) >> 3, j = c & 31, k = (c >> 5) * q + j;
            if (j >= q || k >= extra) return false;
            L = 1024 + k;
        }
        if (L >= nunits) return false;
        const int rt = L >> 2; u.pm = rt; u.pn = tileE[rt] * 4 + (L & 3); return true;
    }
    static constexpr bool GATHER = false;
    DEV void a_ready(const pg8::Unit&) const {}
    DEV void done(const pg8::Unit&) const {}
};
struct MoeOrderG {
    int nunits, G, c; const LAS int* tileE; const int* rowidx;
    static constexpr bool GATHER = true;
    DEV bool next(int i, pg8::Unit& u) const {
        int L = i * G + c;
        if (G == 256 && i == 4) {
            const int extra = nunits - 1024, q = (extra + 7) >> 3, j = c & 31, k = (c >> 5) * q + j;
            if (j >= q || k >= extra) return false;
            L = 1024 + k;
        }
        if (L >= nunits) return false;
        const int rt = L >> 2; u.pm = rt; u.pn = tileE[rt] * 4 + (L & 3); return true;
    }
    DEV void a_ready(const pg8::Unit&) const {}
    DEV void done(const pg8::Unit&) const {}
};
struct Frame {
    LAS unsigned char* lds;
    unsigned char* ldsg;
    volatile LAS unsigned* MISC;
    gu32* ctl;
    unsigned char* ws;
    int tid, lane, wave, vcu, G;
    float* out;
};
template <class Tp> DEV Tp* wsp(const Frame& F, size_t off) { return (Tp*)(F.ws + off); }
DEV const float* inp(int i) { const float* const* ka = (const float* const*)__builtin_amdgcn_kernarg_segment_ptr(); asm volatile("" : "+s"(i)); return (const float*)(const GAS float*)ka[i]; }

template <bool FRAG = false, class Map>
DEV void tr_item(const float* W, int K, int Nsrc, const float* gain, bf16* WT, float* scr, int item, int lane, Map map) {
    const int nblk = (Nsrc + 31) >> 5, kb = item / nblk, nb = item - kb * nblk, k0 = 64 * kb, n0 = 32 * nb;
    {
        const int nq = (lane & 7) * 4; f32x4 v[8];
#pragma unroll
        for (int i = 0; i < 8; ++i) { const int kk = 8 * i + (lane >> 3);
            v[i] = (n0 + nq < Nsrc) ? *(const f32x4*)(W + (size_t)(k0 + kk) * Nsrc + n0 + nq) : (f32x4){0.f, 0.f, 0.f, 0.f}; }
#pragma unroll
        for (int i = 0; i < 8; ++i) { const int kk = 8 * i + (lane >> 3); const float g = gain ? gain[k0 + kk] : 1.0f; float* s = scr + kk * 33 + nq;
            s[0] = v[i][0] * g; s[1] = v[i][1] * g; s[2] = v[i][2] * g; s[3] = v[i][3] * g; }
    }
    LDS_WAIT();
    const int c = lane & 7;
#pragma unroll
    for (int j = 0; j < 4; ++j) {
        const int n = (lane >> 3) + 8 * j; const float* s = scr + (8 * c) * 33 + n;
        if (n0 + n < Nsrc) {
            v4u o; o.x = pk2(s[0 * 33], s[1 * 33]); o.y = pk2(s[2 * 33], s[3 * 33]); o.z = pk2(s[4 * 33], s[5 * 33]); o.w = pk2(s[6 * 33], s[7 * 33]);
            const int nn = map(n0 + n), kk = k0 + 8 * c;
            if (FRAG) *(v4u*)(WT + ((size_t)((kk >> 5) * (Nsrc >> 4) + (nn >> 4)) * 64 + ((kk >> 3) & 3) * 16 + (nn & 15)) * 8) = o;
            else *(v4u*)(WT + (size_t)nn * K + kk) = o;
        }
    }
    LDS_WAIT();
}
template <class Map>
DEV void tr_experts(const float* W, int K, int Nsrc, const float* gain, bf16* WT, bf16* scr, int gw, int NGW, int lane, Map map) {
    const int nblk = Nsrc >> 6, per_e = (K >> 6) * nblk, NIT = 32 * per_e; const size_t esz = (size_t)K * Nsrc;
#pragma unroll 1
    for (int it = gw; it < NIT; it += NGW) {
        const int e = it / per_e, sub = it - e * per_e, kb = sub / nblk, nb = sub - kb * nblk, k0 = 64 * kb, n0 = 64 * nb, nq = (lane & 15) * 4;
        const float* Wp = W + (size_t)e * esz; bf16* Wo = WT + (size_t)e * esz;
        f32x4 v[16];
#pragma unroll
        for (int i = 0; i < 16; ++i) v[i] = *(const f32x4*)(Wp + (size_t)(k0 + 4 * i + (lane >> 4)) * Nsrc + n0 + nq);
#pragma unroll
        for (int i = 0; i < 16; ++i) { const int kk = 4 * i + (lane >> 4); const float g = gain ? gain[k0 + kk] : 1.0f;
            v2u w; w.x = pk2(v[i][0] * g, v[i][1] * g); w.y = pk2(v[i][2] * g, v[i][3] * g);
            *(v2u*)(scr + kk * 68 + nq) = w; }
        LDS_WAIT();
        const int cc = lane & 7;
#pragma unroll
        for (int j = 0; j < 8; ++j) { const int n = (lane >> 3) + 8 * j; const bf16* s = scr + (8 * cc) * 68 + n;
            v4u o; o.x = (unsigned)s[0] | ((unsigned)s[68] << 16); o.y = (unsigned)s[2 * 68] | ((unsigned)s[3 * 68] << 16);
            o.z = (unsigned)s[4 * 68] | ((unsigned)s[5 * 68] << 16); o.w = (unsigned)s[6 * 68] | ((unsigned)s[7 * 68] << 16);
            *(v4u*)(Wo + (size_t)map(n0 + n) * K + k0 + 8 * cc) = o; }
        LDS_WAIT();
    }
}
struct MapId { DEV int operator()(int n) const { return n; } };
struct MapIn {
    DEV int operator()(int n) const {
        if (n < 512) { const int d = n & 63; return (n & ~63) + 2 * (d & 31) + (d >> 5); }
        if (n < 768) return n;
        if (n < 1280) { const int r = n - 768; if ((r & 255) < 128) { const int d = r & 63; return 768 + (r & ~63) + 2 * (d & 31) + (d >> 5); } return n; }
        if (n < 1304) return 3072 + (n - 1280);
        return n - 24;
    }
};
struct MapGU { DEV int operator()(int n) const { return n < 512 ? 2 * n : 2 * (n - 512) + 1; } };

DEV void convert_experts(Frame& F, int l, bf16* scr, int part, int gw_ = -1, int ngw_ = 0) {
    unsigned zl_ = 0u; asm volatile("" : "+v"(zl_)); const int lane = (int)__builtin_amdgcn_mbcnt_hi(~0u, __builtin_amdgcn_mbcnt_lo(~0u, zl_));
    const int gw = gw_ >= 0 ? gw_ : F.vcu * NWAVES + F.wave, NGW = gw_ >= 0 ? ngw_ : F.G * NWAVES;
    if (part == 0) tr_experts(inp(17) + (size_t)l * 32 * 1024 * 1024, 1024, 1024, inp(22) + l * 1024, wsp<bf16>(F, WS_WGU) + (size_t)l * 32 * 1024 * 1024, scr, gw, NGW, lane, MapGU());
    else tr_experts(inp(18) + (size_t)l * 32 * 512 * 1024, 512, 1024, nullptr, wsp<bf16>(F, WS_WDN) + (size_t)l * 32 * 1024 * 512, scr, gw, NGW, lane, MapId());
}
DEV void p0_prologue(Frame& F) {
    float* scr = (float*)(F.ldsg + F.wave * 16384);
    const int gw = F.vcu * NWAVES + F.wave, NGW = F.G * NWAVES, lane = F.lane;
    { constexpr int N_IN = 16 * 97, N_OUT = 16 * 32, N_Q = 16 * 8, N_KV = 16 * 16, N_O = 4 * 32, N_W1 = 32 * 4, N_W2 = 2 * 2;
      constexpr int PER_L = N_IN + N_OUT + N_Q + N_KV + N_O + 2 * N_W1 + 2 * N_W2;
#pragma unroll 1
      for (int g = gw; g < DEPTH * PER_L; g += NGW) {
          const int l = g / PER_L; int r = g - l * PER_L;
          if (r < N_IN) { tr_item(inp(2) + (size_t)l * 1024 * IN_W, 1024, IN_W, inp(19) + l * 1024, wsp<bf16>(F, WS_WIN) + (size_t)l * NIN * 1024, scr, r, lane, MapIn()); continue; }
          r -= N_IN;
          const float* W; const float* gain = nullptr; bf16* WT; int K, Ns;
          if (r < N_OUT) { W = inp(9) + (size_t)l * 1024 * 1024; K = 1024; Ns = 1024; WT = wsp<bf16>(F, WS_WOUT) + (size_t)l * 1024 * 1024; }
          else if ((r -= N_OUT) < N_Q) { W = inp(10) + (size_t)l * 1024 * 256; K = 1024; Ns = 256; gain = inp(20) + l * 1024; WT = wsp<bf16>(F, WS_WQ) + (size_t)l * 256 * 1024; }
          else if ((r -= N_Q) < N_KV) { W = inp(11) + (size_t)l * 1024 * 512; K = 1024; Ns = 512; gain = inp(21) + l * 1024; WT = wsp<bf16>(F, WS_WKV) + (size_t)l * 512 * 1024; }
          else if ((r -= N_KV) < N_O) { W = inp(12) + (size_t)l * 256 * 1024; K = 256; Ns = 1024; WT = wsp<bf16>(F, WS_WO) + (size_t)l * 1024 * 256; }
          else if ((r -= N_O) < 2 * N_W1) { const int kv = r / N_W1; r -= kv * N_W1; W = inp(5) + (size_t)(l * 2 + kv) * 2048 * 128; K = 2048; Ns = 128; WT = wsp<bf16>(F, WS_W1C) + (size_t)(l * 2 + kv) * 128 * 2048; }
          else { r -= 2 * N_W1; const int kv = r / N_W2; r -= kv * N_W2; W = inp(6) + (size_t)(l * 2 + kv) * 128 * 64; K = 128; Ns = 64; WT = wsp<bf16>(F, WS_W2C) + (size_t)(l * 2 + kv) * 64 * 128; }
          tr_item(W, K, Ns, gain, WT, scr, r, lane, MapId());
      } }
    for (int l = 0; l < DEPTH; ++l) {
        { bf16* dst = wsp<bf16>(F, WS_WIN) + (size_t)l * NIN * 1024;
          for (int i = gw * 64 + lane; i < (NIN - 3096) * 1024 / 8; i += NGW * 64) ((v4u*)(dst + (size_t)3096 * 1024))[i] = (v4u){0u, 0u, 0u, 0u}; }
        if (F.G != 256) { convert_experts(F, l, (bf16*)scr, 0); convert_experts(F, l, (bf16*)scr, 1); }
        { bf16* dst = wsp<bf16>(F, WS_WR) + (size_t)l * 96 * 1024; const float* gn = inp(22) + l * 1024;
          for (int i = gw * 64 + lane; i < 48 * 1024; i += NGW * 64) { const int n = i >> 10, k = i & 1023;
            float v = 0.f; if (n < 4) v = inp(13)[(size_t)(l * 1024 + k) * 4 + n]; else if (n < 36) v = inp(15)[(size_t)(l * 1024 + k) * 32 + (n - 4)];
            v *= gn[k]; const unsigned h = f2bf(v);
            const int fo = ((((k >> 5) * 3 + (n >> 4)) * 2) * 64 + ((k >> 3) & 3) * 16 + (n & 15)) * 8 + (k & 7);
            dst[fo] = (bf16)h; dst[fo + 512] = (bf16)f2bf(v - bf2f((unsigned short)h)); } }
    }
    { bf16* wg = wsp<bf16>(F, WS_WG);
      for (int i = gw * 64 + lane; i < DEPTH * 32 * 1024; i += NGW * 64) { const int l2 = i >> 15, row = (i >> 10) & 31, k = i & 1023, hk = row >> 4, gi = row & 15;
        const float v = gi < 12 ? inp(2)[((size_t)l2 * 1024 + k) * IN_W + 1280 + hk * 12 + gi] * inp(19)[l2 * 1024 + k] : 0.f;
        wg[(l2 * 2 + hk) * 16384 + ((k >> 5) * 64 + ((k >> 3) & 3) * 16 + gi) * 8 + (k & 7)] = (bf16)f2bf(v); } }
    { float* rope = wsp<float>(F, WS_ROPE);
      for (int i = gw * 64 + lane; i < T * 32; i += NGW * 64) { const int t = i >> 5, k = i & 31;
        const float inv = powf(10000.0f, -(float)k / 32.0f); const float ang = (float)t * inv;
        rope[2 * i] = cosf(ang); rope[2 * i + 1] = sinf(ang); } }
    { float* b1 = wsp<float>(F, WS_SMALL);
      for (int i = F.wave * F.G + F.vcu; i < 4 * 128; i += NGW) { const int lk = i >> 7, n = i & 127;
        const float* pe = inp(4) + (size_t)lk * 2048; const float* w1 = inp(5) + (size_t)lk * 2048 * 128 + n; float s = 0.f;
#pragma unroll 8
        for (int kk = lane; kk < 2048; kk += 64) s += pe[kk] * w1[(size_t)kk * 128];
        s = wave_sum(s);
        if (lane == 0) b1[i] = s; } }
    { bf16* HB = wsp<bf16>(F, WS_HB); float* SSQ = wsp<float>(F, WS_SSQ); bf16* MB = wsp<bf16>(F, WS_MEMB); float* SSQM = wsp<float>(F, WS_SMALL) + 1024;
#pragma unroll 1
      for (int m0 = gw; m0 < NTOK + NB * 256; m0 += 4 * NGW) {
        f32x4 v[4][4];
#pragma unroll
        for (int q = 0; q < 4; ++q) { const int m = m0 + q * NGW < NTOK + NB * 256 ? m0 + q * NGW : m0; const bool ism = m >= NTOK; const int r = ism ? m - NTOK : m;
            const f32x4* xr = (const f32x4*)((ism ? inp(1) : inp(0)) + (size_t)r * 1024) + lane * 2;
#pragma unroll
            for (int j = 0; j < 4; ++j) v[q][j] = xr[128 * (j >> 1) + (j & 1)]; }
#pragma unroll
        for (int q = 0; q < 4; ++q) { const int m = m0 + q * NGW;
            if (m < NTOK + NB * 256) { const bool ism = m >= NTOK; const int r = ism ? m - NTOK : m;
                v4u* o16 = (v4u*)((ism ? MB : HB) + (size_t)r * 1024) + lane;
                float s = 0.f;
#pragma unroll
                for (int j = 0; j < 2; ++j) { const f32x4 w0 = v[q][2 * j], w1 = v[q][2 * j + 1];
                    s += ((w0.x * w0.x + w0.y * w0.y) + (w0.z * w0.z + w0.w * w0.w)) + ((w1.x * w1.x + w1.y * w1.y) + (w1.z * w1.z + w1.w * w1.w));
                    v4u o; o.x = pk2(w0.x, w0.y); o.y = pk2(w0.z, w0.w); o.z = pk2(w1.x, w1.y); o.w = pk2(w1.z, w1.w); o16[64 * j] = o; }
                s = wave_sum(s);
                if (ism) { if (lane == 0) SSQM[r] = s; }
                else if (lane < 16) SSQ[(size_t)r * 16 + lane] = lane == 0 ? s : 0.f; } }
      } }
}

template <int NT>
DEV void skinny16(const bf16* A, size_t lda, const bf16* Bt, size_t ldb, int K, int lane, f32x4 (&acc)[NT]) {
    const int l16 = lane & 15, g4 = lane >> 4;
    const bf16* ap = A + (size_t)l16 * lda + g4 * 8; const bf16* bp = Bt + (size_t)l16 * ldb + g4 * 8;
#pragma unroll
    for (int n = 0; n < NT; ++n) acc[n] = (f32x4){0.f, 0.f, 0.f, 0.f};
#pragma unroll 8
    for (int k = 0; k < K; k += 32) {
        const bf16x8 a = *(const bf16x8*)(ap + k);
#pragma unroll
        for (int n = 0; n < NT; ++n) { const bf16x8 b = *(const bf16x8*)(bp + (size_t)n * 16 * ldb + k); acc[n] = mfma16(a, b, acc[n]); }
    }
}

DEV void memkv_phase(Frame& F) {
    const int gw = F.vcu * NWAVES + F.wave, NGW = F.G * NWAVES, lane = F.lane, l16 = lane & 15, g4 = lane >> 4;
    const bf16* MB = wsp<bf16>(F, WS_MEMB); const float* SSQM = wsp<float>(F, WS_SMALL) + 1024;
    bf16* MK = wsp<bf16>(F, WS_MK); bf16* MVT = wsp<bf16>(F, WS_MVT);
    for (int task = F.wave * F.G + F.vcu; task < 1024; task += NGW) {
        const int l2 = task >> 9, rt = (task >> 3) & 63, chunk = task & 7;
        f32x4 acc[4];
        skinny16<4>(MB + (size_t)rt * 16 * 1024, 1024, wsp<bf16>(F, WS_WKV) + ((size_t)l2 * 512 + chunk * 64) * 1024, 1024, 1024, lane, acc);
        const int b = rt >> 4, key0 = (rt & 15) * 16 + g4 * 4;
        float rs[4];
#pragma unroll
        for (int r = 0; r < 4; ++r) rs[r] = 1.0f / sqrtf(SSQM[rt * 16 + g4 * 4 + r] * (1.0f / 1024.0f) + RMS_EPS);
#pragma unroll
        for (int nt = 0; nt < 4; ++nt) {
            const int n = chunk * 64 + nt * 16 + l16;
            if (chunk < 4) { const int head = n >> 6, d = n & 63;
#pragma unroll
                for (int r = 0; r < 4; ++r) MK[(size_t)((l2 * 4 + b) * 4 + head) * 256 * 64 + kfrag_off(key0 + r, d)] = (bf16)f2bf(acc[nt][r] * rs[r]);
            } else { const int n2 = n - 256, head = n2 >> 6, d = n2 & 63;
                v2u w; w.x = pk2(acc[nt][0] * rs[0], acc[nt][1] * rs[1]); w.y = pk2(acc[nt][2] * rs[2], acc[nt][3] * rs[3]);
                *(v2u*)(MVT + (((size_t)((l2 * 4 + b) * 4 + head) * 8 + (key0 >> 5)) * 64 + d) * 32 + slot32(key0 & 31)) = w; }
        }
    }
}

DEV void compress_phase(Frame& F, int l) {
    const int lane = F.lane, l16 = lane & 15, g4 = lane >> 4, quad = F.wave >> 2, q = F.wave & 3;
    float* partall = (float*)F.ldsg;
    const bf16* KCR = wsp<bf16>(F, WS_KCR); const bf16* VCR = wsp<bf16>(F, WS_VCR);
    bf16* KCC = wsp<bf16>(F, WS_KCC); bf16* VCT = wsp<bf16>(F, WS_VCT);
    const float* bias1 = wsp<float>(F, WS_SMALL);
    for (int tk0 = F.vcu * 2; tk0 < 512; tk0 += F.G * 2) {
        const int tk = tk0 + quad; const int kv = tk >> 8, tile = tk & 255;
        const bf16* raw = kv ? VCR : KCR;
        const bf16* w1 = wsp<bf16>(F, WS_W1C) + (size_t)(l * 2 + kv) * 128 * 2048;
        const bf16* w2 = wsp<bf16>(F, WS_W2C) + (size_t)(l * 2 + kv) * 64 * 128;
        { const int w = F.wave;
          size_t abase[2];
#pragma unroll
          for (int tt = 0; tt < 2; ++tt) { const int r = ((tk0 + tt) & 255) * 16 + l16, bh = r >> 9, c = r & 511, b = bh >> 1, hkv = bh & 1;
              abase[tt] = ((size_t)b * T + 16 * c) * 128 + hkv * 64; }
          f32x4 acc[2][8];
#pragma unroll
          for (int tt = 0; tt < 2; ++tt)
#pragma unroll
              for (int n = 0; n < 8; ++n) acc[tt][n] = (f32x4){0.f, 0.f, 0.f, 0.f};
#pragma unroll 4
          for (int ks = w * 8; ks < w * 8 + 8; ++ks) {
              const int kk = ks * 32 + g4 * 8, ll = kk >> 6, d = kk & 63;
              bf16x8 a[2];
#pragma unroll
              for (int tt = 0; tt < 2; ++tt) { const int c = (((tk0 + tt) & 255) * 16 + l16) & 511; const int lim = T - 1 - 16 * c;
                  a[tt] = *(const bf16x8*)(raw + abase[tt] + (size_t)(ll < lim ? ll : lim) * 128 + d); }
#pragma unroll
              for (int n = 0; n < 8; ++n) { const bf16x8 bb = *(const bf16x8*)(w1 + (size_t)(n * 16 + l16) * 2048 + kk); acc[0][n] = mfma16(a[0], bb, acc[0][n]); acc[1][n] = mfma16(a[1], bb, acc[1][n]); }
          }
#pragma unroll
          for (int tt = 0; tt < 2; ++tt)
#pragma unroll
              for (int n = 0; n < 8; ++n)
#pragma unroll
                  for (int r2 = 0; r2 < 4; ++r2) partall[((w * 2 + tt) * 16 + g4 * 4 + r2) * 128 + n * 16 + l16] = acc[tt][n][r2];
        }
        __syncthreads();
        { f32x4 o = (f32x4){0.f, 0.f, 0.f, 0.f};
#pragma unroll
          for (int k2 = 0; k2 < 4; ++k2) {
              const int h0 = k2 * 32 + g4 * 8;
              float hv[8];
#pragma unroll
              for (int j = 0; j < 8; ++j) { float s = bias1[(l * 2 + kv) * 128 + h0 + j];
#pragma unroll
                  for (int p = 0; p < 8; ++p) s += partall[((p * 2 + quad) * 16 + l16) * 128 + h0 + j];
                  hv[j] = siluf_(s); }
              bf16x8 a; { v4u w; w.x = pk2(hv[0], hv[1]); w.y = pk2(hv[2], hv[3]); w.z = pk2(hv[4], hv[5]); w.w = pk2(hv[6], hv[7]); a = __builtin_bit_cast(bf16x8, w); }
              const bf16x8 bb = *(const bf16x8*)(w2 + (size_t)(q * 16 + l16) * 128 + h0);
              o = mfma16(a, bb, o);
          }
          const int r0 = tile * 16 + g4 * 4, bh = r0 >> 9, c0 = r0 & 511, d = q * 16 + l16;
          if (kv == 0) {
#pragma unroll
              for (int r2 = 0; r2 < 4; ++r2) KCC[(size_t)bh * 512 * 64 + kfrag_off(c0 + r2, d)] = (c0 + r2 == 511) ? (bf16)0 : (bf16)f2bf(o[r2]);
          } else {
              v2u w; w.x = pk2(o[0], o[1]); w.y = pk2(o[2], (c0 + 3 == 511) ? 0.f : o[3]);
              *(v2u*)(VCT + (((size_t)bh * 16 + (c0 >> 5)) * 64 + d) * 32 + slot32(c0 & 31)) = w;
          }
        }
        __syncthreads();
    }
}

DEV float hgrn_lb(const Frame& F, int l, int c) {
    if (l == 0) return 0.f;
    const float a = inp(7)[c], b = inp(7)[256 + c];
    return 1.0f / (1.0f + expf(a - b));
}
DEV float hgrn_logf(float z, float lb) {
    const float la = logf(fmaxf(lb, 1e-30f));
    const float ls = fminf(z, 0.f) - log1pf(expf(-fabsf(z)));
    const float lc = log1pf(-lb) + ls;
    const float mx = fmaxf(la, lc), mn = fminf(la, lc);
    return mx + log1pf(expf(mn - mx));
}
constexpr int HS = 68;
DEV f32x4 mfma4(float a, float b, f32x4 c) { return __builtin_amdgcn_mfma_f32_16x16x4f32(a, b, c, 0, 0, 0); }
DEV void hgrn_setup_chunk(Frame& F, float lb, const float (&z)[8], float* Bc, float* Kc, float* tot) {
    const int d = F.tid & 63, sg = F.tid >> 6;
    const float la = logf(fmaxf(lb, 1e-30f)), l1m = log1pf(-lb), onem = 1.0f - lb;
    float loc[8], kv[8]; float run = 0.f;
#pragma unroll
    for (int i = 0; i < 8; ++i) {
        const float ez = __expf(-fabsf(z[i]));
        const float lc = l1m + (fminf(z[i], 0.f) - __logf(1.0f + ez));
        const float mx = fmaxf(la, lc), mn = fminf(la, lc);
        run += mx + __logf(1.0f + __expf(mn - mx)); loc[i] = run;
        kv[i] = onem * (z[i] >= 0.f ? ez : 1.0f) / (1.0f + ez);
    }
    tot[sg * 64 + d] = run;
    __syncthreads();
    float off = 0.f;
    for (int g = 0; g < sg; ++g) off += tot[g * 64 + d];
#pragma unroll
    for (int i = 0; i < 8; ++i) { Bc[(sg * 8 + i) * HS + d] = off + loc[i]; Kc[(sg * 8 + i) * HS + d] = kv[i]; }
    __syncthreads();
}
DEV void hgrn_local_phase(Frame& F, int l) {
    constexpr int HB = 72;
    float* Bc = (float*)F.ldsg; float* Kc = Bc + 64 * HS; bf16* KT = (bf16*)(Kc + 64 * HS); bf16* VT = KT + 64 * HB; float* tot = (float*)(VT + 64 * HB);
    bf16* U = wsp<bf16>(F, WS_U); float* DEC = wsp<float>(F, WS_DEC);
    const int lane = F.lane, w = F.wave, li = lane & 15, g4 = lane >> 4;
    const int d = F.tid & 63, sg = F.tid >> 6;
    float z[8]; unsigned short vraw[8];
    auto issue = [&](int task) { const int bh = task >> 7, ch = task & 127, b = bh >> 2, h = bh & 3;
        const size_t go = ((size_t)b * T + ch * 64 + sg * 8) * 256 + h * 64 + d;
        const float* HFp = wsp<float>(F, WS_HF) + go; const bf16* HIp = wsp<bf16>(F, WS_HI) + go;
#pragma unroll
        for (int i = 0; i < 8; ++i) { z[i] = HFp[(size_t)i * 256]; vraw[i] = HIp[(size_t)i * 256]; } };
    if (F.vcu < 2048) issue(F.vcu);
    const bool two_ = (F.G == 256);
    float lb2[2];
#pragma unroll
    for (int k = 0; k < 2; ++k) lb2[k] = two_ ? hgrn_lb(F, l, ((((F.vcu >> 7) + 2 * k) & 3)) * 64 + d) : 0.f;
    int it_ = 0;
    for (int task = F.vcu; task < 2048; task += F.G, ++it_) {
        const int h = (task >> 7) & 3;
        { hgrn_setup_chunk(F, two_ ? ((it_ & 1) ? lb2[1] : lb2[0]) : hgrn_lb(F, l, h * 64 + d), z, Bc, Kc, tot);
          const float bl = Bc[63 * HS + d];
          float kk[8];
#pragma unroll
          for (int i = 0; i < 8; ++i) { const int s = sg * 8 + i; kk[i] = Kc[s * HS + d] * __expf(bl - Bc[s * HS + d]); }
          v4u kw, vw;
          kw.x = pk2(kk[0], kk[1]); kw.y = pk2(kk[2], kk[3]); kw.z = pk2(kk[4], kk[5]); kw.w = pk2(kk[6], kk[7]);
          vw.x = (unsigned)vraw[0] | ((unsigned)vraw[1] << 16); vw.y = (unsigned)vraw[2] | ((unsigned)vraw[3] << 16); vw.z = (unsigned)vraw[4] | ((unsigned)vraw[5] << 16); vw.w = (unsigned)vraw[6] | ((unsigned)vraw[7] << 16);
          *(v4u*)(KT + d * HB + sg * 8) = kw; *(v4u*)(VT + d * HB + sg * 8) = vw;
          if (sg == 0) DEC[(size_t)task * 64 + d] = expf(bl); }
        if (task + F.G < 2048) issue(task + F.G);
        __syncthreads();
        { const int dI = w >> 1, e0 = (w & 1) * 32;
          f32x4 a0 = (f32x4){0.f, 0.f, 0.f, 0.f}, a1 = a0;
#pragma unroll
          for (int ks = 0; ks < 2; ++ks) { const int s0 = 32 * ks + 8 * g4;
              const bf16x8 af = *(const bf16x8*)(KT + (dI * 16 + li) * HB + s0);
              a0 = mfma16(af, *(const bf16x8*)(VT + (e0 + li) * HB + s0), a0); a1 = mfma16(af, *(const bf16x8*)(VT + (e0 + 16 + li) * HB + s0), a1); }
#pragma unroll
          for (int r = 0; r < 4; ++r) { bf16* up = U + ((size_t)task * 64 + dI * 16 + 4 * g4 + r) * 64 + e0 + li; up[0] = (bf16)f2bf(a0[r]); up[16] = (bf16)f2bf(a1[r]); } }
        __syncthreads();
    }
}
DEV void hgrn_scan_phase(Frame& F, int probe = 0) {
    const bf16* U = wsp<bf16>(F, WS_U); bf16* U2 = wsp<bf16>(F, probe ? WS_PROBE : WS_U2); const float* DEC = wsp<float>(F, WS_DEC);
    const int nact = (F.G * 256 >= 65536) ? 256 : 512;
    if (F.tid < nact)
    for (int gid = F.vcu * nact + F.tid; gid < 65536; gid += F.G * nact) {
        const int bh = gid >> 12, de = gid & 4095, d = de >> 6;
        float S = 0.f; const bf16* up = U + (size_t)bh * 128 * 4096 + de; bf16* op = U2 + (size_t)bh * 128 * 4096 + de; const float* dp = DEC + (size_t)bh * 128 * 64 + d;
#pragma unroll 16
        for (int ch = 0; ch < 128; ++ch) { const float u = bf2f(up[(size_t)ch * 4096]); const float dc = dp[ch * 64]; op[(size_t)ch * 4096] = (bf16)f2bf(S); S = dc * S + u; }
    }
}
template <int PV = 0>
DEV void hgrn_out_phase(Frame& F, int l) {
    constexpr int HB = 72;
    float* Bc = (float*)F.ldsg; float* Qs = Bc + 64 * HS; float* Oc = Qs + 64 * HS;
    bf16* Kb = (bf16*)(Oc + 64 * HS); bf16* VT = Kb + 64 * HB; bf16* ST = VT + 64 * HB; bf16* Ab = ST + 64 * HB; float* tot = (float*)(Ab + 64 * HB);
    const bf16* U = wsp<bf16>(F, WS_U2); bf16* CAT = wsp<bf16>(F, WS_CAT);
    const int lane = F.lane, w = F.wave, li = lane & 15, g4 = lane >> 4;
    const int d = F.tid & 63, sg = F.tid >> 6;
    float z[8]; unsigned short vr[8], qr[8], gr[8], sr[8];
    auto issue = [&](int task) { const int bh = task >> 7, ch = task & 127, b = bh >> 2, h = bh & 3;
        const size_t go = ((size_t)b * T + ch * 64 + sg * 8) * 256 + h * 64 + d;
        const float* HFp = wsp<float>(F, WS_HF) + go; const bf16* HIp = wsp<bf16>(F, WS_HI) + go; const bf16* HQp = wsp<bf16>(F, WS_HQ) + go; const bf16* HGp = wsp<bf16>(F, WS_HG) + go;
        const bf16* Up = U + ((size_t)task * 64 + sg * 8) * 64 + d;
#pragma unroll
        for (int i = 0; i < 8; ++i) { z[i] = HFp[(size_t)i * 256]; vr[i] = HIp[(size_t)i * 256]; qr[i] = HQp[(size_t)i * 256]; gr[i] = HGp[(size_t)i * 256]; sr[i] = Up[(size_t)i * 64]; } };
    if (F.vcu < 2048) issue(F.vcu);
    const bool two_ = (F.G == 256);
    float lb2[2], ng2[2];
#pragma unroll
    for (int k = 0; k < 2; ++k) { const int hk = ((F.vcu >> 7) + 2 * k) & 3; lb2[k] = two_ ? hgrn_lb(F, l, hk * 64 + d) : 0.f; ng2[k] = two_ ? inp(8)[l * 256 + hk * 64 + d] : 0.f; }
    int it_ = 0;
    for (int task = F.vcu; task < 2048; task += F.G, ++it_) {
        const int bh = task >> 7, ch = task & 127, b = bh >> 2, h = bh & 3;
        float gv[8];
        { float* Kt = Oc;
#pragma unroll
          for (int i = 0; i < 8; ++i) gv[i] = bf2f(gr[i]);
          hgrn_setup_chunk(F, two_ ? ((it_ & 1) ? lb2[1] : lb2[0]) : hgrn_lb(F, l, h * 64 + d), z, Bc, Kt, tot);
          v4u vv, ss;
          vv.x = (unsigned)vr[0] | ((unsigned)vr[1] << 16); vv.y = (unsigned)vr[2] | ((unsigned)vr[3] << 16); vv.z = (unsigned)vr[4] | ((unsigned)vr[5] << 16); vv.w = (unsigned)vr[6] | ((unsigned)vr[7] << 16);
          ss.x = (unsigned)sr[0] | ((unsigned)sr[1] << 16); ss.y = (unsigned)sr[2] | ((unsigned)sr[3] << 16); ss.z = (unsigned)sr[4] | ((unsigned)sr[5] << 16); ss.w = (unsigned)sr[6] | ((unsigned)sr[7] << 16);
          *(v4u*)(VT + d * HB + sg * 8) = vv; *(v4u*)(ST + d * HB + sg * 8) = ss;
#pragma unroll
          for (int i = 0; i < 8; ++i) { const int s = sg * 8 + i, J = s >> 4; const float rJ = J ? Bc[(16 * J - 1) * HS + d] : 0.f;
              Kb[s * HB + d] = (bf16)f2bf(Kt[s * HS + d] * __expf(fminf(rJ - Bc[s * HS + d], 80.f)));
              Qs[s * HS + d] = bf2f(qr[i]) * 0.125f; } }
        if (task + F.G < 2048) issue(task + F.G);
        __syncthreads();
        if (PV == 1) { __syncthreads(); continue; }
#pragma unroll 1
        for (int ti = w; ti < 12; ti += 8) {
            if (ti >= 10) { const int I = (ti - 10) * 2;
#pragma unroll
                for (int r = 0; r < 4; ++r) Ab[(I * 16 + 4 * g4 + r) * HB + (I + 1) * 16 + li] = (bf16)0;
                continue; }
            const int I = ti < 1 ? 0 : (ti < 3 ? 1 : (ti < 6 ? 2 : 3)), J = ti - (I * (I + 1)) / 2;
            const int t = I * 16 + li; f32x4 acc = (f32x4){0.f, 0.f, 0.f, 0.f};
#pragma unroll
            for (int ks = 0; ks < 2; ++ks) { const int d0 = 32 * ks + 8 * g4;
                const f32x4 q0 = *(const f32x4*)(Qs + t * HS + d0), q1 = *(const f32x4*)(Qs + t * HS + d0 + 4), b0 = *(const f32x4*)(Bc + t * HS + d0), b1 = *(const f32x4*)(Bc + t * HS + d0 + 4);
                f32x4 r0 = (f32x4){0.f, 0.f, 0.f, 0.f}, r1 = r0;
                if (J) { r0 = *(const f32x4*)(Bc + (16 * J - 1) * HS + d0); r1 = *(const f32x4*)(Bc + (16 * J - 1) * HS + d0 + 4); }
                v4u aw; aw.x = pk2(q0[0] * __expf(b0[0] - r0[0]), q0[1] * __expf(b0[1] - r0[1])); aw.y = pk2(q0[2] * __expf(b0[2] - r0[2]), q0[3] * __expf(b0[3] - r0[3]));
                aw.z = pk2(q1[0] * __expf(b1[0] - r1[0]), q1[1] * __expf(b1[1] - r1[1])); aw.w = pk2(q1[2] * __expf(b1[2] - r1[2]), q1[3] * __expf(b1[3] - r1[3]));
                const bf16x8 bf = *(const bf16x8*)(Kb + (J * 16 + li) * HB + d0);
                acc = mfma16(__builtin_bit_cast(bf16x8, aw), bf, acc); }
#pragma unroll
            for (int r = 0; r < 4; ++r) { const int tt = I * 16 + 4 * g4 + r, ss = J * 16 + li; Ab[tt * HB + ss] = (bf16)f2bf((ss <= tt) ? acc[r] : 0.f); }
        }
        __syncthreads();
        { const int I = w >> 1, e0 = (w & 1) * 32, t = I * 16 + li;
          f32x4 a0 = (f32x4){0.f, 0.f, 0.f, 0.f}, a1 = a0;
#pragma unroll
          for (int ks = 0; ks < 2; ++ks) { const int d0 = 32 * ks + 8 * g4;
              const f32x4 q0 = *(const f32x4*)(Qs + t * HS + d0), q1 = *(const f32x4*)(Qs + t * HS + d0 + 4), b0 = *(const f32x4*)(Bc + t * HS + d0), b1 = *(const f32x4*)(Bc + t * HS + d0 + 4);
              v4u aw; aw.x = pk2(q0[0] * __expf(b0[0]), q0[1] * __expf(b0[1])); aw.y = pk2(q0[2] * __expf(b0[2]), q0[3] * __expf(b0[3]));
              aw.z = pk2(q1[0] * __expf(b1[0]), q1[1] * __expf(b1[1])); aw.w = pk2(q1[2] * __expf(b1[2]), q1[3] * __expf(b1[3]));
              const bf16x8 af = __builtin_bit_cast(bf16x8, aw);
              a0 = mfma16(af, *(const bf16x8*)(ST + (e0 + li) * HB + d0), a0); a1 = mfma16(af, *(const bf16x8*)(ST + (e0 + 16 + li) * HB + d0), a1); }
#pragma unroll 1
          for (int ks = 0; ks <= (I >> 1); ++ks) { const int s0 = 32 * ks + 8 * g4;
              const bf16x8 af = *(const bf16x8*)(Ab + t * HB + s0);
              a0 = mfma16(af, *(const bf16x8*)(VT + (e0 + li) * HB + s0), a0); a1 = mfma16(af, *(const bf16x8*)(VT + (e0 + 16 + li) * HB + s0), a1); }
#pragma unroll
          for (int r = 0; r < 4; ++r) { float* op = Oc + (I * 16 + 4 * g4 + r) * HS + e0 + li; op[0] = a0[r]; op[16] = a1[r]; } }
        __syncthreads();
        { const float ng = two_ ? ((it_ & 1) ? ng2[1] : ng2[0]) : inp(8)[l * 256 + h * 64 + lane];
          { const int t = w * 8 + (lane >> 3); const float* op = Oc + t * HS + (lane & 7) * 8; float s = 0.f;
#pragma unroll
            for (int j = 0; j < 8; ++j) s += op[j] * op[j];
            s += __shfl_xor(s, 1); s += __shfl_xor(s, 2); s += __shfl_xor(s, 4);
            if ((lane & 7) == 0) tot[t] = 1.0f / sqrtf(s * (1.0f / 64.0f) + RMS_EPS); }
          LDS_WAIT();
#pragma unroll
          for (int i = 0; i < 8; ++i) { const int t = w * 8 + i; const float o = Oc[t * HS + lane];
              const size_t row = (size_t)b * T + ch * 64 + t;
              const unsigned short ov = (unsigned short)f2bf(o * tot[t] * ng * siluf_(gv[i]));
              if (PV == 0 || ov == 0x7fc1u) CAT[row * 1024 + 768 + h * 64 + lane] = (bf16)ov; } }
        __syncthreads();
    }
}

DEV void conv_phase(Frame& F, int l) {
    const bf16* CB = wsp<bf16>(F, WS_CB); const bf16* CC = wsp<bf16>(F, WS_CC); const bf16* CH = wsp<bf16>(F, WS_CH); bf16* CAT = wsp<bf16>(F, WS_CAT);
    const float* cw = inp(3) + l * 3 * 256;
    float wk[3][8];
    { const int c0 = (F.tid & 31) * 8;
#pragma unroll
      for (int k = 0; k < 3; ++k) { const f32x4 a = *(const f32x4*)(cw + k * 256 + c0), b = *(const f32x4*)(cw + k * 256 + c0 + 4);
          wk[k][0] = a[0]; wk[k][1] = a[1]; wk[k][2] = a[2]; wk[k][3] = a[3]; wk[k][4] = b[0]; wk[k][5] = b[1]; wk[k][6] = b[2]; wk[k][7] = b[3]; } }
    const int stride = F.G * 512;
    for (int it0 = F.vcu * 512 + F.tid; it0 < NTOK * 32; it0 += 4 * stride) {
        const int c0 = (it0 & 31) * 8;
        v4u bb[4], cc[4][3], hh[4][3];
#pragma unroll
        for (int q = 0; q < 4; ++q) { const int it = it0 + q * stride < NTOK * 32 ? it0 + q * stride : it0; const int m = it >> 5, t = m & (T - 1);
            bb[q] = *(const v4u*)(CB + (size_t)m * 256 + c0);
#pragma unroll
            for (int k = 0; k < 3; ++k) { const int mk = (t + k - 2 >= 0) ? m + k - 2 : m; const size_t o = (size_t)mk * 256 + c0; cc[q][k] = *(const v4u*)(CC + o); hh[q][k] = *(const v4u*)(CH + o); } }
#pragma unroll
        for (int q = 0; q < 4; ++q) { const int it = it0 + q * stride;
            if (it < NTOK * 32) { const int m = it >> 5, t = m & (T - 1);
                float y[8];
#pragma unroll
                for (int jj = 0; jj < 8; ++jj) y[jj] = 0.f;
#pragma unroll
                for (int k = 0; k < 3; ++k) {
                    const float on = (t + k - 2 >= 0) ? 1.f : 0.f;
#pragma unroll
                    for (int jj = 0; jj < 4; ++jj) { const float w0 = wk[k][2 * jj] * on, w1 = wk[k][2 * jj + 1] * on;
                        y[2 * jj] += w0 * (bflo(cc[q][k][jj]) * bflo(hh[q][k][jj])); y[2 * jj + 1] += w1 * (bfhi(cc[q][k][jj]) * bfhi(hh[q][k][jj])); }
                }
                v4u o4;
#pragma unroll
                for (int jj = 0; jj < 4; ++jj) o4[jj] = pk2(bflo(bb[q][jj]) * y[2 * jj], bfhi(bb[q][jj]) * y[2 * jj + 1]);
                *(v4u*)(CAT + (size_t)m * 1024 + 512 + c0) = o4; } }
    }
}
struct SmState { float m, l; f32x4 o[4]; };
DEV void sm_reset(SmState& st) { st.m = -INFINITY; st.l = 0.f;
#pragma unroll
    for (int i = 0; i < 4; ++i) st.o[i] = (f32x4){0.f, 0.f, 0.f, 0.f}; }
DEV float sm_lsum(const SmState& st) { float l = st.l; l += __shfl_xor(l, 16); l += __shfl_xor(l, 32); return l; }
DEV void load_k(const bf16* kbase, int lane, bf16x8 (&kf)[2][2]) {
#pragma unroll
    for (int tt = 0; tt < 2; ++tt)
#pragma unroll
        for (int ks = 0; ks < 2; ++ks) kf[tt][ks] = *(const bf16x8*)(kbase + lane * 8 + (tt * 2 + ks) * 512);
}
DEV void load_v(const bf16* vbase, int lane, bf16x8 (&vf)[4]) {
    const int l16 = lane & 15, g4 = lane >> 4;
#pragma unroll
    for (int dt = 0; dt < 4; ++dt) vf[dt] = *(const bf16x8*)(vbase + (size_t)(dt * 16 + l16) * 32 + g4 * 8);
}
DEV void qk_tile(const bf16x8 (&kf)[2][2], const bf16x8 (&qf)[2], f32x4 (&s)[2]) {
#pragma unroll
    for (int tt = 0; tt < 2; ++tt) { s[tt] = mfma16(kf[tt][0], qf[0], (f32x4){0.f, 0.f, 0.f, 0.f}); s[tt] = mfma16(kf[tt][1], qf[1], s[tt]); }
}
DEV bf16x8 pack_p(const float (&p)[2][4]) {
    v4u w; w.x = pk2(p[0][0], p[0][1]); w.y = pk2(p[0][2], p[0][3]); w.z = pk2(p[1][0], p[1][1]); w.w = pk2(p[1][2], p[1][3]);
    return __builtin_bit_cast(bf16x8, w);
}
template <int MODE, class MaskF>
DEV void attn_compute(const bf16x8 (&kf)[2][2], const bf16x8 (&vf)[4], const bf16x8 (&qf)[2], SmState& st, int lane, bool colok, MaskF mask) {
    const int g4 = lane >> 4;
    f32x4 s[2]; qk_tile(kf, qf, s);
    float sv[2][4]; float tmax = -INFINITY;
#pragma unroll
    for (int tt = 0; tt < 2; ++tt)
#pragma unroll
        for (int r = 0; r < 4; ++r) { float x = s[tt][r]; if (MODE == 2) x = mask(16 * tt + 4 * g4 + r) ? x : -INFINITY; sv[tt][r] = x; tmax = fmaxf(tmax, x); }
    if (MODE == 1) tmax = colok ? tmax : -INFINITY;
    tmax = fmaxf(tmax, __shfl_xor(tmax, 16)); tmax = fmaxf(tmax, __shfl_xor(tmax, 32));
    const float mnew = fmaxf(st.m, tmax), muse = (mnew == -INFINITY) ? 0.f : mnew;
    const float alpha = ex2(st.m - muse);
    const float msub = (MODE == 1) ? (colok ? muse : INFINITY) : muse;
    float p[2][4]; float ps = 0.f;
#pragma unroll
    for (int tt = 0; tt < 2; ++tt)
#pragma unroll
        for (int r = 0; r < 4; ++r) { p[tt][r] = ex2(sv[tt][r] - msub); ps += p[tt][r]; }
    st.l = st.l * alpha + ps; st.m = mnew;
    const bf16x8 pf = pack_p(p);
#pragma unroll
    for (int dt = 0; dt < 4; ++dt) { st.o[dt] = st.o[dt] * alpha; st.o[dt] = mfma16(vf[dt], pf, st.o[dt]); }
}
template <int MODE, class MaskF>
DEV void attn_compute_fixed(const bf16x8 (&kf)[2][2], const bf16x8 (&vf)[4], const bf16x8 (&qf)[2], SmState& st, float mref, int lane, bool colok, MaskF mask) {
    const int g4 = lane >> 4;
    const float c0 = (MODE == 1) ? (colok ? -mref : -INFINITY) : -mref;
    const f32x4 ci = {c0, c0, c0, c0};
    f32x4 s[2];
#pragma unroll
    for (int tt = 0; tt < 2; ++tt) { s[tt] = mfma16(kf[tt][0], qf[0], ci); s[tt] = mfma16(kf[tt][1], qf[1], s[tt]); }
    float p[2][4];
#pragma unroll
    for (int tt = 0; tt < 2; ++tt)
#pragma unroll
        for (int r = 0; r < 4; ++r) { float x = s[tt][r]; if (MODE == 2) x = mask(16 * tt + 4 * g4 + r) ? x : -INFINITY; p[tt][r] = ex2(x); }
    st.l += ((p[0][0] + p[0][1]) + (p[0][2] + p[0][3])) + ((p[1][0] + p[1][1]) + (p[1][2] + p[1][3]));
    const bf16x8 pf = pack_p(p);
#pragma unroll
    for (int dt = 0; dt < 4; ++dt) st.o[dt] = mfma16(vf[dt], pf, st.o[dt]);
}
template <int MODE, class MaskF>
DEV void attn_max(const bf16x8 (&kf)[2][2], const bf16x8 (&qf)[2], float& mx, int lane, bool colok, MaskF mask) {
    const int g4 = lane >> 4;
    f32x4 s[2]; qk_tile(kf, qf, s);
    float tmax = -INFINITY;
#pragma unroll
    for (int tt = 0; tt < 2; ++tt)
#pragma unroll
        for (int r = 0; r < 4; ++r) { float x = s[tt][r]; if (MODE == 2) x = mask(16 * tt + 4 * g4 + r) ? x : -INFINITY; tmax = fmaxf(tmax, x); }
    if (MODE == 1) tmax = colok ? tmax : -INFINITY;
    mx = fmaxf(mx, tmax);
}
DEV float colmax_finish(float mx) { mx = fmaxf(mx, __shfl_xor(mx, 16)); mx = fmaxf(mx, __shfl_xor(mx, 32)); return mx == -INFINITY ? 0.f : mx; }
DEV float col_norm(const bf16x8 (&qf)[2]) {
    float s = 0.f;
#pragma unroll
    for (int ks = 0; ks < 2; ++ks) { const v4u w = __builtin_bit_cast(v4u, qf[ks]);
#pragma unroll
        for (int j = 0; j < 4; ++j) { const float a = bflo(w[j]), b = bfhi(w[j]); s += a * a + b * b; } }
    s += __shfl_xor(s, 16); s += __shfl_xor(s, 32);
    return sqrtf(s);
}
DEV float wave_max_uniform(float v) {
#pragma unroll
    for (int o = 1; o < 64; o <<= 1) v = fmaxf(v, __shfl_xor(v, o));
    return __builtin_bit_cast(float, __builtin_amdgcn_readfirstlane(__builtin_bit_cast(int, v)));
}
constexpr float FIXED_REF_MAX = 40.f;
DEV void kmax_phase(Frame& F, int l) {
    const int lane = F.lane; const int gw = F.vcu * NWAVES + F.wave, NGW = F.G * NWAVES;
    if (F.G == 256) {
        float* red = (float*)F.ldsg;
        const int item = gw, br = item >> 10, bh = (item >> 7) & 7, key = (item & 127) * 64 + lane;
        const bf16* kp = wsp<bf16>(F, br ? WS_KW : WS_KS) + (size_t)bh * T * 64;
        float s = 0.f;
#pragma unroll
        for (int i = 0; i < 8; ++i) { const v4u w = *(const v4u*)(kp + kfrag_off(key, i * 8));
#pragma unroll
            for (int j = 0; j < 4; ++j) { const float a = bflo(w[j]), b = bfhi(w[j]); s += a * a + b * b; } }
#pragma unroll
        for (int o = 1; o < 64; o <<= 1) s = fmaxf(s, __shfl_xor(s, o));
        if (lane == 0) red[F.wave] = s;
        __syncthreads();
        if (F.tid == 0) { float m = red[0];
#pragma unroll
            for (int w = 1; w < 8; ++w) m = fmaxf(m, red[w]);
            __hip_atomic_fetch_max((unsigned*)F.ctl + CW_KMAX + l * 16 + br * 8 + bh, __builtin_bit_cast(unsigned, m), RLX_AGENT); }
        __syncthreads();
        return;
    }
    for (int item = gw; item < 2048; item += NGW) {
        const int br = item >> 10, bh = (item >> 7) & 7, key = (item & 127) * 64 + lane;
        const bf16* kp = wsp<bf16>(F, br ? WS_KW : WS_KS) + (size_t)bh * T * 64;
        float s = 0.f;
#pragma unroll
        for (int i = 0; i < 8; ++i) { const v4u w = *(const v4u*)(kp + kfrag_off(key, i * 8));
#pragma unroll
            for (int j = 0; j < 4; ++j) { const float a = bflo(w[j]), b = bfhi(w[j]); s += a * a + b * b; } }
#pragma unroll
        for (int o = 1; o < 64; o <<= 1) s = fmaxf(s, __shfl_xor(s, o));
        if (lane == 0) __hip_atomic_fetch_max((unsigned*)F.ctl + CW_KMAX + l * 16 + br * 8 + bh, __builtin_bit_cast(unsigned, s), RLX_AGENT);
    }
}
struct NoMask { DEV bool operator()(int) const { return true; } };
template <int D, bool WITHV, class AddrF, class BodyF>
DEV void pipe_run(int n, int lane, AddrF addr, BodyF body) {
    if (n <= 0) return;
    bf16x8 kf[D][2][2], vf[D][4];
#pragma unroll
    for (int d = 0; d < D; ++d) { const bf16* kb; const bf16* vb; addr(d < n ? d : n - 1, kb, vb); load_k(kb, lane, kf[d]); if (WITHV) load_v(vb, lane, vf[d]); }
#pragma unroll 1
    for (int i = 0; i < n; i += D) {
#pragma unroll
        for (int d = 0; d < D; ++d) { const int s = i + d;
            if (s < n) body(s, kf[d], vf[d]);
            if (D > 1 || s + 1 < n) { const bf16* kb; const bf16* vb; addr(s + D < n ? s + D : n - 1, kb, vb); load_k(kb, lane, kf[d]); if (WITHV) load_v(vb, lane, vf[d]); } }
    }
}
template <class AddrF, class BodyF>
DEV void pipe_run_k2(int n, int lane, AddrF addr, BodyF body) {
    if (n <= 0) return;
    bf16x8 kf[2][2][2], vf[4];
    { const bf16* kb; const bf16* vb; addr(0, kb, vb); load_k(kb, lane, kf[0]); }
#pragma unroll 1
    for (int i = 0; i < n; i += 2) {
#pragma unroll
        for (int d = 0; d < 2; ++d) { const int s = i + d;
            { const bf16* kb; const bf16* vb; addr(s < n ? s : n - 1, kb, vb); load_v(vb, lane, vf); }
            { const bf16* kb; const bf16* vb; addr(s + 1 < n ? s + 1 : n - 1, kb, vb); load_k(kb, lane, kf[d ^ 1]); }
            if (s < n) body(s, kf[d], vf); }
    }
}
template <class AddrF, class BodyA, class BodyB>
DEV void pipe_run_mt(int n_main, int n_tail, int lane, AddrF addr, BodyA mainb, BodyB tailb) {
    const int n = n_main + n_tail;
    bf16x8 kf[2][2][2], vf[4];
    { const bf16* kb; const bf16* vb; addr(0, kb, vb); load_k(kb, lane, kf[0]); }
    int i = 0;
#define PIPE_STEP_(s_, d_, BODY_) do { { const bf16* kb; const bf16* vb; addr((s_) < n ? (s_) : n - 1, kb, vb); load_v(vb, lane, vf); } \
        { const bf16* kb; const bf16* vb; addr((s_) + 1 < n ? (s_) + 1 : n - 1, kb, vb); load_k(kb, lane, kf[(d_) ^ 1]); } BODY_((s_), kf[d_], vf); } while (0)
#pragma unroll 1
    for (; i + 2 <= n_main; i += 2) { PIPE_STEP_(i, 0, mainb); PIPE_STEP_(i + 1, 1, mainb); }
    if (i < n_main) { PIPE_STEP_(i, 0, mainb); ++i;
#pragma unroll
        for (int a = 0; a < 2; ++a)
#pragma unroll
            for (int b = 0; b < 2; ++b) kf[0][a][b] = kf[1][a][b]; }
#pragma unroll 1
    for (; i < n; ++i) { PIPE_STEP_(i, 0, tailb);
#pragma unroll
        for (int a = 0; a < 2; ++a)
#pragma unroll
            for (int b = 0; b < 2; ++b) kf[0][a][b] = kf[1][a][b]; }
#undef PIPE_STEP_
}
constexpr int PIPE_D = 2;

DEV void acc_add_packed(unsigned (&pk)[4][4][2], int ct, const f32x4 (&o)[4], float sc, bool first) {
#pragma unroll
    for (int dt = 0; dt < 4; ++dt) {
        f32x4 v = o[dt] * sc;
        if (!first) { v[0] += bflo(pk[ct][dt][0]); v[1] += bfhi(pk[ct][dt][0]); v[2] += bflo(pk[ct][dt][1]); v[3] += bfhi(pk[ct][dt][1]); }
        pk[ct][dt][0] = pk2(v[0], v[1]); pk[ct][dt][1] = pk2(v[2], v[3]);
    }
}
template <int VAR>
DEV void nsa_phase_t(Frame& F, int l) {
#define NSA_RELANE() int ln_ = lane; asm volatile("" : "+v"(ln_)); const int l16 = ln_ & 15, g4 = ln_ >> 4, tq = l16 >> 2, gh = l16 & 3; const size_t mrow0 = (size_t)b * T + t0 + tq; const int tl0 = t0 + tq; (void)l16; (void)g4; (void)gh; (void)mrow0; (void)tl0
    float* IMP = (float*)(F.ldsg + F.wave * NSA_LDS_WAVE);
    float* VALS = IMP + 2048; int* BL = (int*)(IMP + 2176); unsigned* SELB = (unsigned*)(IMP + 2304); float* GL = IMP + 2432;
    const bf16* Q = wsp<bf16>(F, WS_Q);
    const bf16* KCC = wsp<bf16>(F, WS_KCC); const bf16* VCT = wsp<bf16>(F, WS_VCT);
    const bf16* KS = wsp<bf16>(F, WS_KS); const bf16* VST = wsp<bf16>(F, WS_VST);
    const bf16* KW = wsp<bf16>(F, WS_KW); const bf16* VWT = wsp<bf16>(F, WS_VWT);
    bf16* CAT = wsp<bf16>(F, WS_CAT);
    const int gw = F.vcu * NWAVES + F.wave, NGW = F.G * NWAVES;
    const bool xmap = (F.G == 256);
#pragma unroll 1
    for (int task = gw; task < 4096; task += NGW) {
        unsigned zl_ = 0u; asm volatile("" : "+v"(zl_)); const int lane = (int)__builtin_amdgcn_mbcnt_hi(~0u, __builtin_amdgcn_mbcnt_lo(~0u, zl_));
        const int u_ = (F.wave < 4) ? (F.vcu & 31) : 63 - (F.vcu & 31), first_ = 4 * u_ + (F.wave & 3);
        const int bh = xmap ? (gw >> 8) : (task & 7), idx = xmap ? ((((task >> 11) != 0) != (F.wave >= 4)) ? 511 - first_ : first_) : (task >> 3);
        const int t0 = idx * 16, b = bh >> 1, hkv = bh & 1, cur = t0 >> 6;
        bf16x8 qf[4][2];
        unsigned opk[4][4][2];
        SmState st[4];
        float qnmax = 0.f;
        { NSA_RELANE();
#pragma unroll
        for (int ct = 0; ct < 4; ++ct)
#pragma unroll
            for (int ks = 0; ks < 2; ++ks) qf[ct][ks] = *(const bf16x8*)(Q + (mrow0 + 4 * ct) * 512 + hkv * 256 + gh * 64 + ks * 32 + g4 * 8);
        { NSA_RELANE();
          f32x4 ga[1]; ga[0] = (f32x4){0.f, 0.f, 0.f, 0.f};
          { const bf16* ap = wsp<bf16>(F, WS_HB) + ((size_t)b * T + t0 + l16) * 1024 + g4 * 8; const bf16* bp = wsp<bf16>(F, WS_WG) + (size_t)(l * 2 + hkv) * 16384 + ln_ * 8;
#pragma unroll 1
            for (int k0 = 0; k0 < (VAR == 11 ? 0 : 1024); k0 += 256) {
                bf16x8 av[8], bv[8];
#pragma unroll
                for (int i = 0; i < 8; ++i) { av[i] = *(const bf16x8*)(ap + k0 + 32 * i); bv[i] = *(const bf16x8*)(bp + (k0 + 32 * i) * 16); }
#pragma unroll
                for (int i = 0; i < 8; ++i) ga[0] = mfma16(av[i], bv[i], ga[0]);
            } }
          const float rs = (ln_ < 16) ? row_rstd_full(wsp<float>(F, WS_SSQ), b * T + t0 + ln_) : 0.f;
#pragma unroll
          for (int r = 0; r < 4; ++r) GL[(g4 * 4 + r) * 16 + l16] = sigmoidf_(ga[0][r] * __shfl(rs, g4 * 4 + r));
        }
        const int ngc = (VAR == 10 || VAR == 12) ? 0 : (t0 + 15 >= 31) ? (((t0 + 15 - 31) >> 4) >> 5) + 1 : 0;
        const bf16* kcb = KCC + (size_t)bh * 512 * 64; const bf16* vcb = VCT + (size_t)bh * 16 * 64 * 32;
        float cm[4], cl[4];
#pragma unroll
        for (int ct = 0; ct < 4; ++ct) { cm[ct] = -INFINITY; cl[ct] = 0.f; }
        pipe_run<2, false>(ngc, ln_, [&](int s, const bf16*& kb, const bf16*& vb) { kb = kcb + (size_t)s * 32 * 64; vb = vcb; },
            [&](int kg, const bf16x8 (&kf)[2][2], const bf16x8 (&)[4]) {
#pragma unroll
                for (int ct = 0; ct < 4; ++ct) {
                    const int tl = tl0 + 4 * ct;
                    f32x4 s[2]; qk_tile(kf, qf[ct], s);
                    float sv[2][4]; float tmax = -INFINITY;
#pragma unroll
                    for (int tt = 0; tt < 2; ++tt)
#pragma unroll
                        for (int r = 0; r < 4; ++r) { const int c = kg * 32 + 16 * tt + 4 * g4 + r; sv[tt][r] = (16 * c + 31 <= tl) ? s[tt][r] : -INFINITY; tmax = fmaxf(tmax, sv[tt][r]); }
                    tmax = fmaxf(tmax, __shfl_xor(tmax, 16)); tmax = fmaxf(tmax, __shfl_xor(tmax, 32));
                    const float mnew = fmaxf(cm[ct], tmax), muse = (mnew == -INFINITY) ? 0.f : mnew;
                    float ps = 0.f;
#pragma unroll
                    for (int tt = 0; tt < 2; ++tt)
#pragma unroll
                        for (int r = 0; r < 4; ++r) ps += ex2(sv[tt][r] - muse);
                    cl[ct] = cl[ct] * ex2(cm[ct] - muse) + ps; cm[ct] = mnew;
                }
            });
        {
            float cmu[4], cinv[4], carry[4];
#pragma unroll
            for (int ct = 0; ct < 4; ++ct) { float l = cl[ct]; l += __shfl_xor(l, 16); l += __shfl_xor(l, 32);
                cmu[ct] = (cm[ct] == -INFINITY) ? 0.f : cm[ct]; cinv[ct] = l > 0.f ? 1.0f / l : 0.f; carry[ct] = 0.f; sm_reset(st[ct]); }
            pipe_run<2, true>(ngc, ln_, [&](int s, const bf16*& kb, const bf16*& vb) { kb = kcb + (size_t)s * 32 * 64; vb = vcb + (size_t)s * 64 * 32; },
                [&](int kg, const bf16x8 (&kf)[2][2], const bf16x8 (&vf)[4]) {
#pragma unroll
                    for (int ct = 0; ct < 4; ++ct) {
                        const int tl = tl0 + 4 * ct;
                        f32x4 s[2]; qk_tile(kf, qf[ct], s);
                        float p[2][4];
#pragma unroll
                        for (int tt = 0; tt < 2; ++tt) {
#pragma unroll
                            for (int r = 0; r < 4; ++r) { const int c = kg * 32 + 16 * tt + 4 * g4 + r; p[tt][r] = (16 * c + 31 <= tl) ? ex2(s[tt][r] - cmu[ct]) * cinv[ct] : 0.f; }
                            const float hb = 0.5f * p[tt][3];
                            const float bsh = __shfl(hb, (ln_ + 48) & 63);
                            float v = ((p[tt][0] + p[tt][1]) + (p[tt][2] + hb)) + ((g4 == 0) ? carry[ct] : bsh);
                            carry[ct] = bsh;
                            v += __shfl_xor(v, 1); v += __shfl_xor(v, 2);
                            if (gh == 0) IMP[(4 * ct + tq) * 128 + kg * 8 + 4 * tt + g4] = v;
                        }
                        const bf16x8 pf = pack_p(p);
#pragma unroll
                        for (int dt = 0; dt < 4; ++dt) st[ct].o[dt] = mfma16(vf[dt], pf, st[ct].o[dt]);
                    }
                });
#pragma unroll
            for (int ct = 0; ct < 4; ++ct) acc_add_packed(opk, ct, st[ct].o, GL[(4 * ct + tq) * 16 + gh * 3 + 0], true);
        }
        }
        LDS_WAIT();
        unsigned sb0 = 0u, sb1 = 0u;
        if (cur < 16) { sb0 = (lane <= cur) ? 0xffffu : 0u; }
        else if (VAR == 6) {
#pragma unroll 1
            for (int q = 0; q < 16; ++q) { const bool s0 = (lane <= cur) && ((lane * 37 + q * 11) % (cur + 1)) < 16, s1 = (lane + 64 <= cur) && (((lane + 64) * 37 + q * 11) % (cur + 1)) < 16;
                sb0 |= (s0 ? 1u : 0u) << q; sb1 |= (s1 ? 1u : 0u) << q; }
        }
        else {
            const unsigned long long below = (1ull << lane) - 1ull;
#pragma unroll 1
            for (int q = 0; q < 16; ++q) {
                unsigned k0, k1;
                { const int j = lane; const float v = (j == 0 || j == cur || j == cur - 1) ? 1e6f : IMP[q * 128 + j]; k0 = (j > cur) ? 0u : __builtin_bit_cast(unsigned, v) + 1u; }
                { const int j = lane + 64; const float v = (j == cur || j == cur - 1) ? 1e6f : IMP[q * 128 + j]; k1 = (j > cur) ? 0u : __builtin_bit_cast(unsigned, v) + 1u; }
                unsigned lo = 0u;
#pragma unroll
                for (int bit = 30; bit >= 0; --bit) { const unsigned cand = lo | (1u << bit);
                    const int c = __builtin_popcountll(__ballot(k0 >= cand)) + __builtin_popcountll(__ballot(k1 >= cand));
                    if (c == 16) { lo = cand; break; }
                    if (c > 16) lo = cand; }
                const unsigned long long g0 = __ballot(k0 > lo), g1 = __ballot(k1 > lo), e0 = __ballot(k0 == lo), e1 = __ballot(k1 == lo);
                const int need = 16 - __builtin_popcountll(g0) - __builtin_popcountll(g1);
                const bool s0 = (k0 > lo) || (k0 == lo && __builtin_popcountll(e0 & below) < need);
                const bool s1 = (k1 > lo) || (k1 == lo && __builtin_popcountll(e0) + __builtin_popcountll(e1 & below) < need);
                sb0 |= (s0 ? 1u : 0u) << q; sb1 |= (s1 ? 1u : 0u) << q;
            }
        }
        SELB[lane] = sb0; SELB[lane + 64] = sb1;
        LDS_WAIT();
#define NSA_PARK() do { _Pragma("unroll") for (int i_ = 0; i_ < 8; ++i_) { v4u w_; w_.x = opk[i_ >> 1][(i_ & 1) * 2][0]; w_.y = opk[i_ >> 1][(i_ & 1) * 2][1]; w_.z = opk[i_ >> 1][(i_ & 1) * 2 + 1][0]; w_.w = opk[i_ >> 1][(i_ & 1) * 2 + 1][1]; ((v4u*)IMP)[i_ * 64 + lane] = w_; } } while (0)
#define NSA_UNPARK() do { _Pragma("unroll") for (int i_ = 0; i_ < 8; ++i_) { const v4u w_ = ((const v4u*)IMP)[i_ * 64 + lane]; opk[i_ >> 1][(i_ & 1) * 2][0] = w_.x; opk[i_ >> 1][(i_ & 1) * 2][1] = w_.y; opk[i_ >> 1][(i_ & 1) * 2 + 1][0] = w_.z; opk[i_ >> 1][(i_ & 1) * 2 + 1][1] = w_.w; } } while (0)
        NSA_PARK();
        { NSA_RELANE();
#pragma unroll
        for (int ct = 0; ct < 4; ++ct) {
            const float* rp = wsp<float>(F, WS_ROPE) + ((size_t)(tl0 + 4 * ct) * 32 + g4 * 8) * 2;
            const v4u a = __builtin_bit_cast(v4u, qf[ct][0]), b2 = __builtin_bit_cast(v4u, qf[ct][1]); v4u ra, rb;
#pragma unroll
            for (int jj = 0; jj < 4; ++jj) { const f32x4 cs = *(const f32x4*)(rp + 4 * jj);
                const float x1a = bflo(a[jj]), x1b = bfhi(a[jj]), x2a = bflo(b2[jj]), x2b = bfhi(b2[jj]);
                ra[jj] = pk2(x1a * cs[0] - x2a * cs[1], x1b * cs[2] - x2b * cs[3]);
                rb[jj] = pk2(x2a * cs[0] + x1a * cs[1], x2b * cs[2] + x1b * cs[3]); }
            qf[ct][0] = __builtin_bit_cast(bf16x8, ra); qf[ct][1] = __builtin_bit_cast(bf16x8, rb);
        }
        {
            const unsigned long long ulo = __ballot(sb0 != 0u), uhi = __ballot(sb1 != 0u);
            const unsigned long long below = (1ull << ln_) - 1ull;
            const int nlo = __builtin_popcountll(ulo), nblk = nlo + __builtin_popcountll(uhi);
            if (sb0 != 0u) BL[__builtin_popcountll(ulo & below)] = ln_ | (int)(sb0 << 8);
            if (sb1 != 0u) BL[nlo + __builtin_popcountll(uhi & below)] = (ln_ + 64) | (int)(sb1 << 8);
            LDS_WAIT();
#pragma unroll
            for (int ct = 0; ct < 4; ++ct) sm_reset(st[ct]);
            const bf16* kb0 = KS + (size_t)bh * T * 64; const bf16* vb0 = VST + (size_t)bh * 256 * 64 * 32;
            float mr; bool fixed;
            { const float kmx = sqrtf(__builtin_bit_cast(float, __hip_atomic_load((const unsigned*)F.ctl + CW_KMAX + l * 16 + bh, RLX_AGENT))); float mm = 0.f;
#pragma unroll
              for (int ct = 0; ct < 4; ++ct) mm = fmaxf(mm, col_norm(qf[ct]));
              qnmax = wave_max_uniform(mm); mr = qnmax * kmx * 1.002f + 1e-3f;
              fixed = mr < FIXED_REF_MAX; }
            auto addr_sel = [&](int s, const bf16*& kb, const bf16*& vb) { const int g32 = (BL[s >> 1] & 0xff) * 2 + (s & 1); kb = kb0 + (size_t)g32 * 32 * 64; vb = vb0 + (size_t)g32 * 64 * 32; };
            asm volatile("" ::: "memory");
            if (!fixed) {
                float mx[4] = {-INFINITY, -INFINITY, -INFINITY, -INFINITY};
                pipe_run<1, false>(2 * nblk, ln_, addr_sel,
                    [&](int s, const bf16x8 (&kf)[2][2], const bf16x8 (&)[4]) {
                        const int e = __builtin_amdgcn_readfirstlane(BL[s >> 1]), j = e & 0xff, key0 = j * 64 + (s & 1) * 32;
                        const unsigned tm = (unsigned)e >> 8;
#pragma unroll
                        for (int ct = 0; ct < 4; ++ct) { const unsigned tmk = (tm >> (4 * ct)) & 0xFu;
                            if (tmk) { const bool colok = (tmk >> tq) & 1u; const int tl = tl0 + 4 * ct;
                                if (j == cur) attn_max<2>(kf, qf[ct], mx[ct], ln_, true, [&](int kk) { return colok && (key0 + kk <= tl); });
                                else attn_max<1>(kf, qf[ct], mx[ct], ln_, colok, NoMask()); } }
                    });
                mr = wave_max_uniform(fmaxf(fmaxf(mx[0], mx[1]), fmaxf(mx[2], mx[3]))); if (mr == -INFINITY) mr = 0.f;
            }
            asm volatile("" ::: "memory");
            if (VAR != 4 && VAR != 12) {
                bf16x8 kf[2][2][2], vf[4];
                int e_cur = __builtin_amdgcn_readfirstlane(BL[0]), e_nxt = __builtin_amdgcn_readfirstlane(BL[nblk > 1 ? 1 : 0]);
                load_k(kb0 + (size_t)(e_cur & 0xff) * 4096, ln_, kf[0]);
#pragma unroll 1
                for (int b2 = 0; b2 < nblk - 1; ++b2) {
                    const int e_raw = BL[b2 + 2 < nblk ? b2 + 2 : nblk - 1];
                    const int j = e_cur & 0xff; const unsigned tm = (unsigned)e_cur >> 8;
                    const bf16* kblk = kb0 + (size_t)j * 4096; const bf16* vblk = vb0 + (size_t)j * 4096;
#pragma unroll
                    for (int hf = 0; hf < 2; ++hf) {
                        load_v(vblk + hf * 2048, ln_, vf);
                        if (hf == 0) load_k(kblk + 2048, ln_, kf[1]); else load_k(kb0 + (size_t)(e_nxt & 0xff) * 4096, ln_, kf[0]);
#pragma unroll
                        for (int ct = 0; ct < 4; ++ct) {
                            const unsigned tmk = (tm >> (4 * ct)) & 0xFu;
                            if (tmk) attn_compute_fixed<1>(kf[hf], vf, qf[ct], st[ct], mr, ln_, (tmk >> tq) & 1u, NoMask());
                        }
                    }
                    e_cur = e_nxt; e_nxt = __builtin_amdgcn_readfirstlane(e_raw);
                }
#pragma unroll 1
                for (int u = 0; u < 2; ++u) {
                    load_v(vb0 + (size_t)cur * 4096 + u * 2048, ln_, vf); load_k(kb0 + (size_t)cur * 4096 + 2048, ln_, kf[1]);
                    const int key0 = cur * 64 + u * 32;
#pragma unroll
                    for (int ct = 0; ct < 4; ++ct) { const int tl = tl0 + 4 * ct;
                        attn_compute_fixed<2>(kf[0], vf, qf[ct], st[ct], mr, ln_, true, [&](int kk) { return key0 + kk <= tl; }); }
#pragma unroll
                    for (int a = 0; a < 2; ++a)
#pragma unroll
                        for (int c = 0; c < 2; ++c) kf[0][a][c] = kf[1][a][c];
                }
            }
            LDS_WAIT();
            NSA_UNPARK();
#pragma unroll
            for (int ct = 0; ct < 4; ++ct) { const float ls = sm_lsum(st[ct]); const float gs = GL[(4 * ct + tq) * 16 + gh * 3 + 1];
                acc_add_packed(opk, ct, st[ct].o, ls > 0.f ? gs / ls : 0.f, false); }
            NSA_PARK();
        }
        }
        { NSA_RELANE();
#pragma unroll
            for (int ct = 0; ct < 4; ++ct) sm_reset(st[ct]);
            const bf16* kb0 = (VAR == 3 ? KS : KW) + (size_t)bh * T * 64; const bf16* vb0 = (VAR == 3 ? VST : VWT) + (size_t)bh * 256 * 64 * 32;
            const int glo = (t0 - 511 > 0 ? t0 - 511 : 0) >> 5, ghi = (t0 + 15) >> 5;
            float mr; bool fixed;
            { const float kmx = sqrtf(__builtin_bit_cast(float, __hip_atomic_load((const unsigned*)F.ctl + CW_KMAX + l * 16 + 8 + bh, RLX_AGENT)));
              mr = qnmax * kmx * 1.002f + 1e-3f;
              fixed = mr < FIXED_REF_MAX; }
            auto addr_win = [&](int s, const bf16*& kb, const bf16*& vb) { kb = kb0 + (size_t)(glo + s) * 32 * 64; vb = vb0 + (size_t)(glo + s) * 64 * 32; };
            asm volatile("" ::: "memory");
            if (!fixed) {
                float mx[4] = {-INFINITY, -INFINITY, -INFINITY, -INFINITY};
                pipe_run<1, false>(ghi - glo + 1, ln_, addr_win,
                    [&](int s, const bf16x8 (&kf)[2][2], const bf16x8 (&)[4]) {
                        const int key0 = (glo + s) * 32;
#pragma unroll
                        for (int ct = 0; ct < 4; ++ct) { const int tl = tl0 + 4 * ct;
                            attn_max<2>(kf, qf[ct], mx[ct], ln_, true, [&](int kk) { const int kp = key0 + kk; return kp <= tl && kp + 512 > tl; }); }
                    });
                mr = wave_max_uniform(fmaxf(fmaxf(mx[0], mx[1]), fmaxf(mx[2], mx[3]))); if (mr == -INFINITY) mr = 0.f;
            }
            asm volatile("" ::: "memory");
            const int g_a = (t0 >= 497) ? ((t0 - 497) >> 5) + 1 : 0, g_b = (t0 - 31) >> 5;
            const int n_main = g_b >= g_a ? g_b - g_a + 1 : 0, n_up = ghi - (g_b >= g_a ? g_b : g_a - 1), n_tail = n_up + (g_a - glo);
            auto grp = [&](int s) { const int u = s - n_main; return s < n_main ? g_a + s : (u < n_up ? ghi - n_up + 1 + u : glo + (u - n_up)); };
            auto addr_w2 = [&](int s, const bf16*& kb, const bf16*& vb) { const int g = grp(s); kb = kb0 + (size_t)g * 32 * 64; vb = vb0 + (size_t)g * 64 * 32; };
            if (VAR != 5 && VAR != 12)
            pipe_run_mt(n_main, n_tail, ln_, addr_w2,
                [&](int, const bf16x8 (&kf)[2][2], const bf16x8 (&vf)[4]) {
#pragma unroll
                    for (int ct = 0; ct < 4; ++ct) attn_compute_fixed<0>(kf, vf, qf[ct], st[ct], mr, ln_, true, NoMask());
                },
                [&](int s, const bf16x8 (&kf)[2][2], const bf16x8 (&vf)[4]) {
                    const int key0 = grp(s) * 32;
#pragma unroll
                    for (int ct = 0; ct < 4; ++ct) {
                        const int tlo = t0 + 4 * ct, thi = tlo + 3, tl = tl0 + 4 * ct;
                        if (key0 > thi || key0 + 31 + 512 <= tlo) continue;
                        attn_compute_fixed<2>(kf, vf, qf[ct], st[ct], mr, ln_, true, [&](int kk) { const int kp = key0 + kk; return kp <= tl && kp + 512 > tl; });
                    }
                });
            NSA_UNPARK();
#pragma unroll
            for (int ct = 0; ct < 4; ++ct) { const float ls = sm_lsum(st[ct]); const float gwn = GL[(4 * ct + tq) * 16 + gh * 3 + 2];
                acc_add_packed(opk, ct, st[ct].o, ls > 0.f ? gwn / ls : 0.f, false); }
        }
        { NSA_RELANE();
#pragma unroll
        for (int ct = 0; ct < 4; ++ct)
#pragma unroll
            for (int dt = 0; dt < 4; ++dt) { v2u w; w.x = opk[ct][dt][0]; w.y = opk[ct][dt][1];
                if (VAR == 0 || w.x == 0x7fc17fc1u) *(v2u*)(CAT + (mrow0 + 4 * ct) * 1024 + hkv * 256 + gh * 64 + dt * 16 + g4 * 4) = w; }
        }
        LDS_WAIT();
        if (VAR == 0 && xmap) convert_experts(F, l, (bf16*)IMP, task >> 11);
    }
#undef NSA_RELANE
#undef NSA_PARK
#undef NSA_UNPARK
}

DEV void nsa_phase(Frame& F, int l) { nsa_phase_t<0>(F, l); }

DEV void cross_phase(Frame& F, int l) {
    const int lane = F.lane, l16 = lane & 15, g4 = lane >> 4;
    const bf16* XQ = wsp<bf16>(F, WS_XQ); bf16* XO = wsp<bf16>(F, WS_XO);
    const int gw = F.vcu * NWAVES + F.wave, NGW = F.G * NWAVES;
#pragma unroll 1
    for (int task = gw; task < 2048; task += NGW) {
        const int head = task & 3, m0 = (task >> 2) * 64, b = m0 >> 13;
        bf16x8 qf[4][2];
#pragma unroll
        for (int ct = 0; ct < 4; ++ct)
#pragma unroll
            for (int ks = 0; ks < 2; ++ks) qf[ct][ks] = *(const bf16x8*)(XQ + (size_t)(m0 + 16 * ct + l16) * 256 + head * 64 + ks * 32 + g4 * 8);
        const bf16* kb0 = wsp<bf16>(F, WS_MK) + (size_t)((l * 4 + b) * 4 + head) * 256 * 64;
        const bf16* vb0 = wsp<bf16>(F, WS_MVT) + (size_t)((l * 4 + b) * 4 + head) * 8 * 64 * 32;
        SmState st[4];
#pragma unroll
        for (int ct = 0; ct < 4; ++ct) sm_reset(st[ct]);
        pipe_run<PIPE_D, true>(8, lane, [&](int s, const bf16*& kb, const bf16*& vb) { kb = kb0 + (size_t)s * 32 * 64; vb = vb0 + (size_t)s * 64 * 32; },
            [&](int, const bf16x8 (&kf)[2][2], const bf16x8 (&vf)[4]) {
#pragma unroll
                for (int ct = 0; ct < 4; ++ct) attn_compute<0>(kf, vf, qf[ct], st[ct], lane, true, NoMask());
            });
#pragma unroll
        for (int ct = 0; ct < 4; ++ct) {
            const float inv = 1.0f / sm_lsum(st[ct]);
#pragma unroll
            for (int dt = 0; dt < 4; ++dt) { const f32x4 o = st[ct].o[dt] * inv; v2u w; w.x = pk2(o[0], o[1]); w.y = pk2(o[2], o[3]);
                *(v2u*)(XO + (size_t)(m0 + 16 * ct + l16) * 256 + head * 64 + dt * 16 + g4 * 4) = w; }
        }
    }
}


DEV void router_phase(Frame& F, int l, int probe = 0) {
    const int lane = F.lane, l16 = lane & 15, g4 = lane >> 4;
    float* LG = (float*)F.ldsg + F.wave * 768;
    const bf16* HB = wsp<bf16>(F, WS_HB); const float* SSQ = wsp<float>(F, WS_SSQ);
    const bf16* WR = wsp<bf16>(F, WS_WR) + (size_t)l * 96 * 1024;
    int* TOKE = wsp<int>(F, probe ? WS_PROBE : WS_TOKE); float* TOKG = wsp<float>(F, probe ? WS_PROBE + MiB : WS_TOKG); int* TOKP = wsp<int>(F, probe ? WS_PROBE + 2 * MiB : WS_TOKP);
    unsigned* CNT = (unsigned*)F.ctl + CW_CNT + l * 32 + (probe ? 64 : 0);
    const float* bg = inp(14) + l * 4; const float* be = inp(16) + l * 32;
    unsigned* HIST = (unsigned*)((float*)F.ldsg + 8 * 768);
#pragma unroll 1
    for (int tb = F.vcu * NWAVES; tb < NTOK / 16; tb += F.G * NWAVES) {
        const int task = tb + F.wave; const bool live = task < NTOK / 16;
        const int m0 = (live ? task : tb) * 16;
        if (F.tid < 64) HIST[F.tid] = 0u;
        f32x4 acc[3];
        {
            const bf16* ap = HB + (size_t)(m0 + l16) * 1024 + g4 * 8; const bf16* bp = WR + lane * 8;
#pragma unroll
            for (int n = 0; n < 3; ++n) acc[n] = (f32x4){0.f, 0.f, 0.f, 0.f};
#pragma unroll 4
            for (int k = 0; k < 1024; k += 32) {
                const bf16x8 a = *(const bf16x8*)(ap + k);
#pragma unroll
                for (int n = 0; n < 3; ++n) { const bf16x8 bh = *(const bf16x8*)(bp + ((k >> 5) * 6 + n * 2) * 512), bl = *(const bf16x8*)(bp + ((k >> 5) * 6 + n * 2 + 1) * 512);
                    acc[n] = mfma16(a, bh, acc[n]); acc[n] = mfma16(a, bl, acc[n]); }
            }
        }
#pragma unroll
        for (int nt = 0; nt < 3; ++nt)
#pragma unroll
            for (int r = 0; r < 4; ++r) LG[(g4 * 4 + r) * 48 + nt * 16 + l16] = acc[nt][r];
        LDS_WAIT();
        int id1 = 0, id2 = 0;
        if (lane < 16) {
            const int m = m0 + lane; const float rstd = row_rstd_full(SSQ, m); const float* lg = LG + lane * 48;
            float g[4];
#pragma unroll
            for (int j = 0; j < 4; ++j) g[j] = lg[j] * rstd + bg[j];
            float gmax = g[0]; int grp = 0;
#pragma unroll
            for (int j = 1; j < 4; ++j) if (g[j] > gmax) { gmax = g[j]; grp = j; }
            float den = 0.f;
#pragma unroll
            for (int j = 0; j < 4; ++j) den += expf(g[j] - gmax);
            const float psel = 1.0f / den;
            float e1 = -INFINITY, e2 = -INFINITY; int i1 = 0, i2 = 0;
            for (int j = 0; j < 8; ++j) { const float v = lg[4 + grp * 8 + j] * rstd + be[grp * 8 + j];
                if (v > e1) { e2 = e1; i2 = i1; e1 = v; i1 = j; } else if (v > e2) { e2 = v; i2 = j; } }
            const float x = expf(e2 - e1), w1 = 1.0f / (1.0f + x), w2 = x * w1;
            id1 = grp * 8 + i1; id2 = grp * 8 + i2;
            if (live) { TOKE[m * 2] = id1; TOKE[m * 2 + 1] = id2; TOKG[m * 2] = psel * w1; TOKG[m * 2 + 1] = psel * w2; }
        }
        __syncthreads();
        unsigned lp1 = 0u, lp2 = 0u;
        if (lane < 16 && live) { lp1 = __hip_atomic_fetch_add(HIST + id1, 1u, __ATOMIC_RELAXED, __HIP_MEMORY_SCOPE_WORKGROUP); lp2 = __hip_atomic_fetch_add(HIST + id2, 1u, __ATOMIC_RELAXED, __HIP_MEMORY_SCOPE_WORKGROUP); }
        __syncthreads();
        if (F.tid < 32) { const unsigned c = HIST[F.tid]; HIST[32 + F.tid] = c ? __hip_atomic_fetch_add(CNT + F.tid, c, RLX_AGENT) : 0u; }
        __syncthreads();
        if (lane < 16 && live) { const int m = m0 + lane; TOKP[m * 2] = (int)(HIST[32 + id1] + lp1); TOKP[m * 2 + 1] = (int)(HIST[32 + id2] + lp2); }
        __syncthreads();
    }
}
DEV int moe_tables(Frame& F, int l) {
    int* tab = (int*)(F.ldsg + TAB_OFF);
    if (F.tid < 32) {
        const unsigned* CNT = (const unsigned*)F.ctl + CW_CNT + l * 32; const int e = F.tid;
        const int c = (int)__hip_atomic_load(CNT + e, RLX_AGENT), nt = (c + 255) >> 8;
        int incl = nt;
#pragma unroll
        for (int o = 1; o < 32; o <<= 1) { const int t = __shfl_up(incl, o, 32); if (e >= o) incl += t; }
        const int excl = incl - nt;
        tab[e] = excl << 8;
        for (int i = 0; i < nt; ++i) tab[40 + excl + i] = e;
        if (e == 31) tab[32] = incl << 8;
    }
    __syncthreads();
    return tab[32];
}
DEV void gather_phase(Frame& F, int l) {
    (void)moe_tables(F, l);
    const int* tab = (const int*)(F.ldsg + TAB_OFF);
    const int lane = F.lane; const int gw = F.vcu * NWAVES + F.wave, NGW = F.G * NWAVES;
    const float* SSQ = wsp<float>(F, WS_SSQ);
    const int* TOKE = wsp<int>(F, WS_TOKE); const float* TOKG = wsp<float>(F, WS_TOKG); const int* TOKP = wsp<int>(F, WS_TOKP); int* TOKS = wsp<int>(F, WS_TOKS); int* STOK = wsp<int>(F, WS_STOK);
    float* SRSTD = wsp<float>(F, WS_SRSTD); float* SGATE = wsp<float>(F, WS_SGATE);
    const unsigned* CNT = (const unsigned*)F.ctl + CW_CNT + l * 32;
#pragma unroll 1
    for (int m = (F.wave * F.G + F.vcu) * 64 + lane; m < NTOK; m += NGW * 64) {
        const v2u e = *(const v2u*)(TOKE + m * 2), p = *(const v2u*)(TOKP + m * 2); const f32x2_t gt = *(const f32x2_t*)(TOKG + m * 2);
        const float rs = row_rstd_full(SSQ, m);
        const int s0 = tab[e.x] + (int)p.x, s1 = tab[e.y] + (int)p.y;
        *(v2u*)(TOKS + m * 2) = (v2u){(unsigned)s0, (unsigned)s1};
        STOK[s0] = m; STOK[s1] = m; SRSTD[s0] = rs; SRSTD[s1] = rs; SGATE[s0] = gt[0]; SGATE[s1] = gt[1];
    }
    { const int idx = F.wave * F.G + F.vcu;
      if (idx < 128) { const int e = idx & 31, chunk = idx >> 5;
          const int c = (int)__hip_atomic_load(CNT + e, RLX_AGENT), base = tab[e], end = (e == 31 ? tab[32] : tab[e + 1]);
          const int r = base + c + chunk * 64 + lane;
          if (r < end) { STOK[r] = 0; SRSTD[r] = 0.f; SGATE[r] = 0.f; } } }
}
DEV void combine_phase(Frame& F, int l, int probe = 0) {
    const int lane = F.lane; const int gw = F.vcu * NWAVES + F.wave, NGW = F.G * NWAVES;
    float* Ho = probe ? wsp<float>(F, WS_PROBE) : (float*)(GAS float*)F.out; const bf16* HBi = wsp<bf16>(F, WS_HB); bf16* HB = wsp<bf16>(F, probe ? WS_PROBE + 128 * MiB : WS_HB); float* SSQ = wsp<float>(F, probe ? WS_PROBE + 192 * MiB : WS_SSQ); const bf16* YS = wsp<bf16>(F, WS_YS); const int* TOKS = wsp<int>(F, WS_TOKS);
    const float* gf = inp(23);
    constexpr int CT = 4;
    f32x4 gq[4];
#pragma unroll
    for (int j = 0; j < 4; ++j) gq[j] = (l == DEPTH - 1) ? *(const f32x4*)(gf + lane * 8 + 512 * (j >> 1) + 4 * (j & 1)) : (f32x4){0.f, 0.f, 0.f, 0.f};
#pragma unroll 1
    for (int m0 = gw; m0 < NTOK; m0 += CT * NGW) {
        f32x4 v[CT][4]; float ssum[CT];
        int sl[CT][2];
#pragma unroll
        for (int k = 0; k < CT; ++k) { const int m = (m0 + k * NGW < NTOK) ? m0 + k * NGW : m0; sl[k][0] = TOKS[m * 2]; sl[k][1] = TOKS[m * 2 + 1]; }
        v4u h[CT][2], ya[CT][2], yb[CT][2];
#pragma unroll
        for (int k = 0; k < CT; ++k) { const int m = (m0 + k * NGW < NTOK) ? m0 + k * NGW : m0;
#pragma unroll
            for (int j = 0; j < 2; ++j) { const int c = lane * 8 + 512 * j;
                h[k][j] = *(const v4u*)(HBi + (size_t)m * 1024 + c);
                ya[k][j] = *(const v4u*)(YS + (size_t)sl[k][0] * 1024 + c); yb[k][j] = *(const v4u*)(YS + (size_t)sl[k][1] * 1024 + c); } }
#pragma unroll
        for (int k = 0; k < CT; ++k) { float ss = 0.f;
#pragma unroll
            for (int j = 0; j < 2; ++j)
#pragma unroll
                for (int q = 0; q < 2; ++q) { const unsigned hx = h[k][j][2 * q], hy = h[k][j][2 * q + 1], ax = ya[k][j][2 * q], ay = ya[k][j][2 * q + 1], bx = yb[k][j][2 * q], by = yb[k][j][2 * q + 1];
                    f32x4 r; r[0] = bflo(hx) + (bflo(ax) + bflo(bx)); r[1] = bfhi(hx) + (bfhi(ax) + bfhi(bx)); r[2] = bflo(hy) + (bflo(ay) + bflo(by)); r[3] = bfhi(hy) + (bfhi(ay) + bfhi(by));
                    v[k][j * 2 + q] = r; ss += (r[0] * r[0] + r[1] * r[1]) + (r[2] * r[2] + r[3] * r[3]); }
            ssum[k] = wave_sum(ss); }
#pragma unroll
        for (int k = 0; k < CT; ++k) { const int m = m0 + k * NGW;
            if (m < NTOK) {
                if (l == DEPTH - 1) {
                    const float rstd = 1.0f / sqrtf(ssum[k] * (1.0f / 1024.0f) + RMS_EPS);
#pragma unroll
                    for (int j = 0; j < 4; ++j) { const int c = lane * 8 + 512 * (j >> 1) + 4 * (j & 1); *(f32x4*)(Ho + (size_t)m * 1024 + c) = v[k][j] * rstd * gq[j]; }
                } else {
#pragma unroll
                    for (int j = 0; j < 2; ++j) { const int c = lane * 8 + 512 * j;
                        v4u w; w.x = pk2(v[k][2 * j][0], v[k][2 * j][1]); w.y = pk2(v[k][2 * j][2], v[k][2 * j][3]); w.z = pk2(v[k][2 * j + 1][0], v[k][2 * j + 1][1]); w.w = pk2(v[k][2 * j + 1][2], v[k][2 * j + 1][3]);
                        *(v4u*)(HB + (size_t)m * 1024 + c) = w; }
                    if (lane < 16) SSQ[(size_t)m * 16 + lane] = lane == 0 ? ssum[k] : 0.f;
                } } }
    }
}
#ifndef MK_ONE_LAUNCH
#define MK_ONE_LAUNCH 1
#endif
constexpr int NPH_LAYER = 13, NPHASES = 1 + DEPTH * NPH_LAYER;
struct Args { const float* in[24]; float* out; unsigned char* ws; int ph_lo, ph_hi; };
static_assert(sizeof(Args) == 24 * 8 + 8 + 8 + 8, "Args has no padding");

__global__ void __launch_bounds__(NWAVES * 64, 2) hymba_fwd(Args args) {
    extern __shared__ __attribute__((aligned(16))) unsigned char lds[];
    Frame F;
    F.lds = (LAS unsigned char*)lds; F.ldsg = lds;
    F.MISC = (volatile LAS unsigned*)(F.lds + MISC_OFF);
    F.tid = threadIdx.x; F.lane = F.tid & 63; F.wave = __builtin_amdgcn_readfirstlane(F.tid >> 6);
    F.G = gridDim.x; { const int bx = blockIdx.x; F.vcu = (F.G % 8 == 0) ? (bx % 8) * (F.G / 8) + bx / 8 : bx; }
    F.ws = args.ws; F.ctl = (gu32*)(args.ws + WS_CTL); F.out = args.out;
    if (F.tid < 64) ((LAS unsigned*)(F.lds + MISC_OFF))[F.tid] = 0u;
    __syncthreads();
    int wave0 = F.wave;
    const int lo = args.ph_lo, hi = args.ph_hi;
    XcdBarrier bar; bar.bar = (unsigned*)(F.ctl + CW_BAR); bar.x = 0; bar.st = nullptr;
    if (hi - lo > 1) bar = xcd_barrier_post((unsigned*)(F.ctl + CW_BAR), F.MISC + 8);
#ifndef PHMASK
#define PHMASK 0xFFFF
#endif
#define IN(k) (lo <= (k) && (k) < hi)
#define EN(j) ((PHMASK >> (j)) & 1)
#define RELAUNDER() do { asm volatile("" : "+s"(wave0)); unsigned z_ = 0u; asm volatile("" : "+v"(z_)); int t_ = wave0 * 64 + (int)__builtin_amdgcn_mbcnt_hi(~0u, __builtin_amdgcn_mbcnt_lo(~0u, z_)); F.tid = t_; F.lane = t_ & 63; F.wave = wave0; \
    size_t zo_ = 0; asm volatile("" : "+s"(zo_), "+s"(F.vcu), "+s"(F.G)); F.ws = args.ws + zo_; F.out = args.out + zo_; F.ctl = (gu32*)(F.ws + WS_CTL); } while (0)
#ifndef NSA_VAR
#define NSA_VAR 0
#endif
#ifndef BAR2X
#define BAR2X 0
#endif
#ifndef DUPMASK
#define DUPMASK 0
#endif
#define DUP(j) ((DUPMASK >> (j)) & 1)
#ifndef STAG_J0
#define STAG_J0 0
#endif
#ifndef STAG_MOE
#define STAG_MOE 0
#endif
#define STAGGER(ticks) do { if ((ticks) > 0 && (F.vcu & 1)) { const unsigned long long t0_ = __builtin_amdgcn_s_memrealtime(); while (__builtin_amdgcn_s_memrealtime() - t0_ < (unsigned long long)(ticks)) __builtin_amdgcn_s_sleep(32); } } while (0)
#define SEAM(k) do { if (IN(k) && IN((k) + 1)) { XcdBarrier b_ = bar; size_t zb_ = 0; asm volatile("" : "+s"(b_.x), "+s"(zb_)); b_.bar = (unsigned*)(args.ws + WS_CTL + zb_) + CW_BAR; xcd_barrier(b_); if (BAR2X) xcd_barrier(b_); } } while (0)

    if (IN(0) && EN(13)) { RELAUNDER(); p0_prologue(F); if (DUP(13)) { __syncthreads(); p0_prologue(F); } } SEAM(0);

#pragma unroll 1
    for (int l = 0; l < DEPTH; ++l) {
        const int pb = 1 + l * NPH_LAYER;
        bf16* HB = wsp<bf16>(F, WS_HB); float* SSQ = wsp<float>(F, WS_SSQ);
        if (IN(pb + 0) && EN(0)) for (int rep_ = 0; rep_ < (DUP(0) ? 2 : 1); ++rep_) { RELAUNDER(); if (rep_) __syncthreads();
            pg8::Gemm g{HB, wsp<bf16>(F, WS_WIN) + (size_t)l * NIN * 1024, NTOK, 3072, D};
            pg8::StaticOrder S; S.init(NTOK, 3072, F.G, (int)blockIdx.x);
            EpiIn E{F.ws};
            STAGGER(STAG_J0);
            pg8::gemm_phase<EpiIn, pg8::StaticOrder, true, true>(F.lds, g, S, E, F.wave);
        }
        SEAM(pb + 0);
        if (IN(pb + 1) && EN(1)) { RELAUNDER();
            { const int rot_ = F.vcu % 3;
              if (rot_ == 0) { compress_phase(F, l); hgrn_local_phase(F, l); conv_phase(F, l); }
              else if (rot_ == 1) { hgrn_local_phase(F, l); conv_phase(F, l); compress_phase(F, l); }
              else { conv_phase(F, l); compress_phase(F, l); hgrn_local_phase(F, l); } }
            kmax_phase(F, l);
            if (l == 0) memkv_phase(F);
            if (DUP(1)) { __syncthreads(); compress_phase(F, l); hgrn_local_phase(F, l); conv_phase(F, l); }
            if (DUP(21)) { __syncthreads(); compress_phase(F, l); }
            if (DUP(22)) { __syncthreads(); hgrn_local_phase(F, l); }
            if (DUP(23)) { __syncthreads(); conv_phase(F, l); }
        }
        SEAM(pb + 1);
        if (IN(pb + 2) && EN(2)) { RELAUNDER(); hgrn_scan_phase(F); if (DUP(14)) hgrn_scan_phase(F, 1); nsa_phase(F, l); if (DUP(2)) { __syncthreads(); nsa_phase_t<NSA_VAR>(F, l); } }
        SEAM(pb + 2);
        if (IN(pb + 3) && EN(3)) { RELAUNDER(); hgrn_out_phase(F, l); if (DUP(3)) { __syncthreads(); hgrn_out_phase(F, l); } if (DUP(24)) { __syncthreads(); hgrn_out_phase<1>(F, l); } if (DUP(25)) { __syncthreads(); hgrn_out_phase<2>(F, l); } }
        SEAM(pb + 3);
        if (IN(pb + 4) && EN(4)) for (int rep_ = 0; rep_ < ((DUP(4) && l == 0) ? 2 : 1); ++rep_) { RELAUNDER(); if (rep_) __syncthreads();
            pg8::Gemm g{wsp<bf16>(F, WS_CAT), wsp<bf16>(F, WS_WOUT) + (size_t)l * 1024 * 1024, NTOK, D, D};
            pg8::StaticOrder S; S.init(NTOK, D, F.G, (int)blockIdx.x);
            EpiRes E{l == 0 ? inp(0) : (const float*)nullptr, HB, SSQ};
            pg8::gemm_phase<EpiRes, pg8::StaticOrder, true, true>(F.lds, g, S, E, F.wave);
        }
        SEAM(pb + 4);
        if (IN(pb + 5) && EN(5)) for (int rep_ = 0; rep_ < (DUP(5) ? 2 : 1); ++rep_) { RELAUNDER(); if (rep_) __syncthreads();
            pg8::Gemm g{HB, wsp<bf16>(F, WS_WQ) + (size_t)l * 256 * 1024, NTOK, 256, D};
            pg8::StaticOrder S; S.init(NTOK, 256, F.G, (int)blockIdx.x);
            EpiXQ E{SSQ, wsp<bf16>(F, WS_XQ)};
            pg8::gemm_phase<EpiXQ, pg8::StaticOrder, true, true>(F.lds, g, S, E, F.wave);
        }
        SEAM(pb + 5);
        if (IN(pb + 6) && EN(6)) { RELAUNDER(); cross_phase(F, l); if (DUP(6)) { __syncthreads(); cross_phase(F, l); } }
        SEAM(pb + 6);
        if (IN(pb + 7) && EN(7)) { RELAUNDER();
            pg8::Gemm g{wsp<bf16>(F, WS_XO), wsp<bf16>(F, WS_WO) + (size_t)l * 1024 * 256, NTOK, D, 256};
            pg8::StaticOrder S; S.init(NTOK, D, F.G, (int)blockIdx.x);
            EpiRes E{(const float*)nullptr, HB, SSQ};
            pg8::gemm_phase<EpiRes, pg8::StaticOrder, true, true>(F.lds, g, S, E, F.wave);
        }
        SEAM(pb + 7);
        if (IN(pb + 8) && EN(8)) { RELAUNDER(); router_phase(F, l); if (DUP(8)) router_phase(F, l, 1); }
        SEAM(pb + 8);
        if (IN(pb + 9) && EN(9)) { RELAUNDER(); gather_phase(F, l); if (DUP(9)) { __syncthreads(); gather_phase(F, l); } }
        SEAM(pb + 9);
        if (IN(pb + 10) && EN(10)) for (int rep_ = 0; rep_ < (DUP(10) ? 2 : 1); ++rep_) { RELAUNDER(); if (rep_) __syncthreads();
            const int ns = IN(pb + 9) ? ((const int*)(F.ldsg + TAB_OFF))[32] : moe_tables(F, l);
            pg8::Gemm g{wsp<bf16>(F, WS_HB), wsp<bf16>(F, WS_WGU) + (size_t)l * 32 * 1024 * 1024, ns, 32 * 1024, D};
            MoeOrderG S{(ns >> 8) * 4, F.G, F.vcu, (const LAS int*)(F.lds + TAB_OFF) + 40, wsp<int>(F, WS_STOK)};
            EpiGU E{wsp<float>(F, WS_SRSTD), wsp<bf16>(F, WS_ACT)};
            STAGGER(STAG_MOE);
            pg8::gemm_phase<EpiGU, MoeOrderG, true, true>(F.lds, g, S, E, F.wave);
        }
        SEAM(pb + 10);
        if (IN(pb + 11) && EN(11)) for (int rep_ = 0; rep_ < (DUP(11) ? 2 : 1); ++rep_) { RELAUNDER(); if (rep_) __syncthreads();
            const int ns = IN(pb + 9) ? ((const int*)(F.ldsg + TAB_OFF))[32] : moe_tables(F, l);
            pg8::Gemm g{wsp<bf16>(F, WS_ACT), wsp<bf16>(F, WS_WDN) + (size_t)l * 32 * 1024 * 512, ns, 32 * 1024, 512};
            MoeOrder S{(ns >> 8) * 4, F.G, F.vcu, (const LAS int*)(F.lds + TAB_OFF) + 40};
            EpiDN E{wsp<float>(F, WS_SGATE), wsp<bf16>(F, WS_YS)};
            STAGGER(STAG_MOE / 2);
            pg8::gemm_phase<EpiDN, MoeOrder, true, true>(F.lds, g, S, E, F.wave);
        }
        SEAM(pb + 11);
        if (IN(pb + 12) && EN(12)) { RELAUNDER(); combine_phase(F, l); if (DUP(12)) combine_phase(F, l, 1); }
        SEAM(pb + 12);
    }
#undef IN
#undef SEAM
}

extern "C" void kernel_launch(void* const* d_in, const int* in_sizes, int n_in, void* d_out, int out_size, void* d_ws, size_t ws_size, hipStream_t stream) {
    static int grid = 0;
    if (grid == 0) {
        if (n_in != 24 || in_sizes[0] != NTOK * D || out_size != NTOK * D || ws_size < WS_END) {
            fprintf(stderr, "kernel_launch: unexpected shapes: n_in %d in0 %d out %d ws %zu (need %zu)\n", n_in, n_in > 0 ? in_sizes[0] : -1, out_size, ws_size, (size_t)WS_END); grid = -1; return; }
        int dev = 0, cus = 0, per_cu = 0;
        if (hipGetDevice(&dev) != hipSuccess || hipDeviceGetAttribute(&cus, hipDeviceAttributeMultiprocessorCount, dev) != hipSuccess) { grid = -1; return; }
        if (hipFuncSetAttribute((const void*)hymba_fwd, hipFuncAttributeMaxDynamicSharedMemorySize, LDS_BYTES) != hipSuccess) { fprintf(stderr, "kernel_launch: hipFuncSetAttribute failed\n"); grid = -1; return; }
        if (hipOccupancyMaxActiveBlocksPerMultiprocessor(&per_cu, (const void*)hymba_fwd, NWAVES * 64, LDS_BYTES) != hipSuccess || per_cu < 1)
            fprintf(stderr, "kernel_launch: note: occupancy query reports %d blocks per CU\n", per_cu);
        (void)hipGetLastError();
        grid = cus;
    }
    if (grid < 0) return;
    if (hipMemsetAsync((char*)d_ws + WS_CTL, 0, CTL_ZERO_BYTES, stream) != hipSuccess) { fprintf(stderr, "kernel_launch: memset failed\n"); return; }
    Args a{};
    for (int i = 0; i < 24; ++i) a.in[i] = (const float*)d_in[i];
    a.out = (float*)d_out; a.ws = (unsigned char*)d_ws;
#if MK_ONE_LAUNCH
    a.ph_lo = 0; a.ph_hi = NPHASES;
    hipLaunchKernelGGL(hymba_fwd, dim3(grid), dim3(NWAVES * 64), LDS_BYTES, stream, a);
#else
    for (int p = 0; p < NPHASES; ++p) { a.ph_lo = p; a.ph_hi = p + 1; hipLaunchKernelGGL(hymba_fwd, dim3(grid), dim3(NWAVES * 64), LDS_BYTES, stream, a); }
#endif
    const hipError_t le = hipPeekAtLastError();
    if (le != hipSuccess) fprintf(stderr, "kernel_launch: launch failed: %s\n", hipGetErrorName(le));
}
```
